# Optimizing an MI355X kernel written in HIP

```python
import math
import jax
import jax.numpy as jnp
from jax import lax
import numpy as np


D_MODEL = 2048
BATCH = 1
SEQ = 8192
DEPTH = 2

N_META = 16
NORM_EPS = 1e-6

A_WIDTH = D_MODEL // 2
A_HEAD_DIM = 64
A_HEADS = A_WIDTH // A_HEAD_DIM
A_DECAY_LORA = 64
A_ICL_LORA = 64
A_GATE_LORA = 160
A_GN_EPS = 64e-5
A_COLS = 3 * A_WIDTH + A_DECAY_LORA + A_ICL_LORA + A_GATE_LORA

B_WIDTH = D_MODEL // 2
B_BLOCKS = 16
B_BLOCK_DIM = B_WIDTH // B_BLOCKS
B_CONV = 4
LRU_C = 8.0
B_COLS = 2 * B_WIDTH
EVEN_COLS = A_COLS + B_COLS

C_HEAD_K = 128
C_HEAD_V = 128
C_K_HEADS = D_MODEL // C_HEAD_K
C_V_HEADS = 2 * C_K_HEADS
C_CONV = 4
C_CHUNK = 64
C_QK = C_K_HEADS * C_HEAD_K
C_V = C_V_HEADS * C_HEAD_V
ODD_COLS = 2 * C_QK + 2 * C_V + 2 * C_V_HEADS

MOE_GROUPS = 4
MOE_PER_GROUP = 8
MOE_EXPERTS = MOE_GROUPS * MOE_PER_GROUP
MOE_TOPK = 2
MOE_FF = 512
MOE_BLOCK = 128

kernel_name = "hybrid_rwkv7_rglru_gdn_hmoe"


def rms_norm(x, w):
    xf = x.astype(jnp.float32)
    y = xf * lax.rsqrt(jnp.mean(xf * xf, axis=-1, keepdims=True) + NORM_EPS)
    return (y * w).astype(x.dtype)


def l2_normalize(x):
    return x * lax.rsqrt(jnp.sum(x * x, axis=-1, keepdims=True) + NORM_EPS)


def causal_dwconv(x, w):
    K = w.shape[0]
    T = x.shape[1]
    xp = jnp.pad(x, ((0, 0), (K - 1, 0), (0, 0)))
    out = xp[:, 0:T] * w[0]
    for j in range(1, K):
        out = out + xp[:, j:j + T] * w[j]
    return out


def rwkv7_scan(r, w, k, v, a, b):
    Bsz, T, H, N = r.shape

    def step(S, inp):
        r_t, w_t, k_t, v_t, a_t, b_t = inp
        sa = jnp.einsum('bhij,bhj->bhi', S, a_t)
        S = S * w_t[:, :, None, :] + sa[..., None] * b_t[:, :, None, :] + v_t[..., None] * k_t[:, :, None, :]
        return S, jnp.einsum('bhij,bhj->bhi', S, r_t)

    xs = tuple(jnp.moveaxis(t, 1, 0) for t in (r, w, k, v, a, b))
    S0 = jnp.zeros((Bsz, H, N, N), jnp.float32)
    _, y = lax.scan(step, S0, xs)
    return jnp.moveaxis(y, 0, 1)


def rwkv7_mixer(p, mu, w0, w_up, a0, a_up, g_up, k_k, k_a, r_k, ln_w, ln_b):
    Bsz, T, _ = p.shape
    p = p.astype(jnp.float32)
    prev = jnp.pad(p, ((0, 0), (1, 0), (0, 0)))[:, :-1]
    p = p + (prev - p) * mu
    s1 = A_WIDTH
    s2 = 2 * A_WIDTH
    s3 = 3 * A_WIDTH
    s4 = s3 + A_DECAY_LORA
    s5 = s4 + A_ICL_LORA
    r, k, v, wd, ad, gd = jnp.split(p, [s1, s2, s3, s4, s5], axis=-1)
    w_log = -jax.nn.softplus(-(w0 + jnp.tanh(wd) @ w_up)) - 0.5
    decay = jnp.exp(-jnp.exp(w_log))
    icl = jax.nn.sigmoid(a0 + ad @ a_up)
    gate = jax.nn.sigmoid(gd) @ g_up
    kk = k * k_k
    k = k * (1.0 + (icl - 1.0) * k_a)

    def heads(t):
        return t.reshape(Bsz, T, A_HEADS, A_HEAD_DIM)

    r, k, v, decay, icl, kk = map(heads, (r, k, v, decay, icl, kk))
    kk = kk / jnp.maximum(jnp.linalg.norm(kk, axis=-1, keepdims=True), 1e-12)
    y = rwkv7_scan(r, decay, k, v, -kk, kk * icl)
    mean = jnp.mean(y, axis=-1, keepdims=True)
    var = jnp.mean((y - mean) ** 2, axis=-1, keepdims=True)
    y = ((y - mean) * lax.rsqrt(var + A_GN_EPS)).reshape(Bsz, T, A_WIDTH) * ln_w + ln_b
    bonus = (jnp.sum(r * k * r_k, axis=-1, keepdims=True) * v).reshape(Bsz, T, A_WIDTH)
    return (y + bonus) * gate


def linear_combine(left, right):
    a_l, b_l = left
    a_r, b_r = right
    return a_l * a_r, a_r * b_l + b_r


def rglru_mixer(p, conv_w, conv_b, gate_a_w, gate_a_b, gate_x_w, gate_x_b, lru_lambda):
    Bsz, T, _ = p.shape
    p = p.astype(jnp.float32)
    gate_branch, rec = p[..., :B_WIDTH], p[..., B_WIDTH:]
    xr = causal_dwconv(rec, conv_w) + conv_b
    xg = xr.reshape(Bsz, T, B_BLOCKS, B_BLOCK_DIM)
    r_gate = jax.nn.sigmoid(jnp.einsum('btgi,gij->btgj', xg, gate_a_w) + gate_a_b).reshape(Bsz, T, B_WIDTH)
    i_gate = jax.nn.sigmoid(jnp.einsum('btgi,gij->btgj', xg, gate_x_w) + gate_x_b).reshape(Bsz, T, B_WIDTH)
    log_a = -LRU_C * r_gate * jax.nn.softplus(-lru_lambda)
    a = jnp.exp(log_a)
    u = jnp.sqrt(-jnp.expm1(2.0 * log_a)) * (i_gate * xr)
    _, h = lax.associative_scan(linear_combine, (a, u), axis=1)
    return h * jax.nn.gelu(gate_branch, approximate=True)


def even_mixer(hn, w_in, mu, w0, w_up, a0, a_up, g_up, k_k, k_a, r_k, ln_w, ln_b,
               conv_w, conv_b, gate_a_w, gate_a_b, gate_x_w, gate_x_b, lru_lambda, w_out):
    proj = hn @ w_in
    y_a = rwkv7_mixer(proj[..., :A_COLS], mu, w0, w_up, a0, a_up, g_up, k_k, k_a, r_k, ln_w, ln_b)
    y_b = rglru_mixer(proj[..., A_COLS:], conv_w, conv_b, gate_a_w, gate_a_b, gate_x_w, gate_x_b, lru_lambda)
    return jnp.concatenate([y_a, y_b], axis=-1) @ w_out


def chunk_gated_delta_rule(q, k, v, g, beta):
    Bsz, H, T, DK = q.shape
    DV = v.shape[-1]
    n = T // C_CHUNK

    def chunks(t):
        return t.reshape((Bsz, H, n, C_CHUNK) + t.shape[3:])

    q = chunks(q * (DK ** -0.5))
    k = chunks(k)
    v = chunks(v)
    beta = chunks(beta)
    g = jnp.cumsum(chunks(g), axis=-1)
    idx = jnp.arange(C_CHUNK)
    causal = idx[:, None] >= idx[None, :]
    strict = idx[:, None] > idx[None, :]
    decay = jnp.exp(jnp.where(causal, g[..., :, None] - g[..., None, :], -jnp.inf))
    k_beta = k * beta[..., None]
    lower = jnp.where(strict, jnp.einsum('bhnid,bhnjd->bhnij', k_beta, k) * decay, 0.0)
    eye = jnp.eye(C_CHUNK, dtype=q.dtype)
    rhs = jnp.concatenate([v * beta[..., None], k_beta * jnp.exp(g)[..., None]], axis=-1)
    sol = lax.linalg.triangular_solve(eye + lower, rhs, left_side=True, lower=True, unit_diagonal=True)
    u, w = sol[..., :DV], sol[..., DV:]
    intra = jnp.where(causal, jnp.einsum('bhnid,bhnjd->bhnij', q, k) * decay, 0.0)

    def step(S, inp):
        q_c, k_c, u_c, w_c, g_c, a_c = inp
        v_new = u_c - jnp.einsum('bhck,bhkv->bhcv', w_c, S)
        o = (jnp.einsum('bhck,bhkv->bhcv', q_c * jnp.exp(g_c)[..., None], S)
             + jnp.einsum('bhij,bhjv->bhiv', a_c, v_new))
        g_last = g_c[..., -1:]
        S = (S * jnp.exp(g_last)[..., None]
             + jnp.einsum('bhck,bhcv->bhkv', k_c * jnp.exp(g_last - g_c)[..., None], v_new))
        return S, o

    xs = tuple(jnp.moveaxis(t, 2, 0) for t in (q, k, u, w, g, intra))
    S0 = jnp.zeros((Bsz, H, DK, DV), q.dtype)
    _, o = lax.scan(step, S0, xs)
    return jnp.moveaxis(o, 0, 2).reshape(Bsz, H, T, DV)


def odd_mixer(hn, w_in, conv_w, a_log, dt_bias, norm_w, w_out):
    Bsz, T, _ = hn.shape
    proj = (hn @ w_in).astype(jnp.float32)
    e_qkv = 2 * C_QK + C_V
    qkv, z, b, a = jnp.split(proj, [e_qkv, e_qkv + C_V, e_qkv + C_V + C_V_HEADS], axis=-1)
    qkv = jax.nn.silu(causal_dwconv(qkv, conv_w))
    q, k, v = jnp.split(qkv, [C_QK, 2 * C_QK], axis=-1)
    rep = C_V_HEADS // C_K_HEADS
    q = jnp.repeat(l2_normalize(q.reshape(Bsz, T, C_K_HEADS, C_HEAD_K)), rep, axis=2)
    k = jnp.repeat(l2_normalize(k.reshape(Bsz, T, C_K_HEADS, C_HEAD_K)), rep, axis=2)
    v = v.reshape(Bsz, T, C_V_HEADS, C_HEAD_V)
    beta = jax.nn.sigmoid(b)
    g = -jnp.exp(a_log.astype(jnp.float32)) * jax.nn.softplus(a + dt_bias)
    pad = (-T) % C_CHUNK

    def to_heads(t):
        t = jnp.moveaxis(t, 2, 1)
        return jnp.pad(t, ((0, 0), (0, 0), (pad, 0)) + ((0, 0),) * (t.ndim - 3))

    o = chunk_gated_delta_rule(to_heads(q), to_heads(k), to_heads(v), to_heads(g), to_heads(beta))
    o = jnp.moveaxis(o[:, :, pad:], 1, 2)
    o = o * lax.rsqrt(jnp.mean(o * o, axis=-1, keepdims=True) + NORM_EPS) * norm_w
    o = o * jax.nn.silu(z.reshape(Bsz, T, C_V_HEADS, C_HEAD_V))
    return o.reshape(Bsz, T, C_V) @ w_out


def hmoe(xn, router_group, router_expert, w1, w3, w2):
    Bsz, T, D = xn.shape
    x = xn.reshape(Bsz * T, D)
    n_tok = x.shape[0]
    xf = x.astype(jnp.float32)
    group_prob = jax.nn.softmax(xf @ router_group.astype(jnp.float32), axis=-1)
    top_gp, top_g = lax.top_k(group_prob, 1)
    exp_logits = (xf @ router_expert.astype(jnp.float32)).reshape(n_tok, MOE_GROUPS, MOE_PER_GROUP)
    in_group = exp_logits[jnp.arange(n_tok), top_g[:, 0]]
    top_ep, top_e = lax.top_k(jax.nn.softmax(in_group, axis=-1), MOE_TOPK)
    weights = top_gp * top_ep / jnp.sum(top_ep, axis=-1, keepdims=True)
    expert_ids = top_g * MOE_PER_GROUP + top_e

    e_flat = expert_ids.reshape(-1)
    tok_flat = jnp.repeat(jnp.arange(n_tok, dtype=jnp.int32), MOE_TOPK)
    w_flat = weights.reshape(-1)
    n_assign = n_tok * MOE_TOPK
    order = jnp.argsort(e_flat)
    e_s = e_flat[order]
    tok_s = tok_flat[order]
    w_s = w_flat[order]
    counts = jnp.zeros((MOE_EXPERTS,), jnp.int32).at[e_flat].add(1)
    padded = (counts + MOE_BLOCK - 1) // MOE_BLOCK * MOE_BLOCK
    start = jnp.cumsum(counts) - counts
    pend = jnp.cumsum(padded)
    pstart = pend - padded
    dest = pstart[e_s] + jnp.arange(n_assign, dtype=jnp.int32) - start[e_s]
    n_blocks = -(-(n_assign + MOE_EXPERTS * (MOE_BLOCK - 1)) // MOE_BLOCK)
    n_rows = n_blocks * MOE_BLOCK
    row_tok = jnp.full((n_rows,), n_tok, jnp.int32).at[dest].set(tok_s)
    block_start = jnp.arange(n_blocks, dtype=jnp.int32) * MOE_BLOCK
    block_exp = jnp.minimum(jnp.sum(pend[None, :] <= block_start[:, None], axis=1), MOE_EXPERTS - 1)
    xp = jnp.concatenate([x, jnp.zeros((1, D), x.dtype)], axis=0)
    xb = xp[row_tok].reshape(n_blocks, MOE_BLOCK, D)

    def expert_block(args):
        e, xblk = args
        return (jax.nn.silu(xblk @ w1[e]) * (xblk @ w3[e])) @ w2[e]

    yb = lax.map(expert_block, (block_exp, xb)).reshape(n_rows, D)
    y = jnp.zeros((n_tok, D), jnp.float32).at[tok_s].add(yb[dest].astype(jnp.float32) * w_s[:, None])
    return y.reshape(Bsz, T, D)


def setup_inputs(seed: int = 0) -> dict:
    key = jax.random.key(seed)
    keys = iter(jax.random.split(key, 40))
    n_even = (DEPTH + 1) // 2
    n_odd = DEPTH // 2
    f32 = jnp.float32

    def nrm(shape, scale):
        return jax.random.normal(next(keys), shape, f32) * scale

    def unif(shape, lo, hi):
        return jax.random.uniform(next(keys), shape, f32, lo, hi)

    u = unif((n_even, B_WIDTH), 0.9, 0.999)
    s = u ** (1.0 / LRU_C)
    lru_lambda = jnp.log(s) - jnp.log1p(-s)
    dt = jnp.exp(unif((n_odd, C_V_HEADS), math.log(1e-3), math.log(1e-1)))
    dt_bias = dt + jnp.log(-jnp.expm1(-dt))
    return {
        "x": nrm((BATCH, SEQ, D_MODEL), 1.0),
        "meta_tokens": nrm((N_META, D_MODEL), 1.0),
        "norm_mix": 1.0 + nrm((DEPTH, D_MODEL), 0.02),
        "norm_ffn": 1.0 + nrm((DEPTH, D_MODEL), 0.02),
        "norm_final": 1.0 + nrm((D_MODEL,), 0.02),
        "ev_w_in": nrm((n_even, D_MODEL, EVEN_COLS), D_MODEL ** -0.5),
        "ev_mu": unif((n_even, A_COLS), 0.0, 1.0),
        "ev_w0": unif((n_even, A_WIDTH), -6.0, 1.0),
        "ev_w_up": nrm((n_even, A_DECAY_LORA, A_WIDTH), 0.1 * A_DECAY_LORA ** -0.5),
        "ev_a0": nrm((n_even, A_WIDTH), 0.1),
        "ev_a_up": nrm((n_even, A_ICL_LORA, A_WIDTH), 0.1 * A_ICL_LORA ** -0.5),
        "ev_g_up": nrm((n_even, A_GATE_LORA, A_WIDTH), A_GATE_LORA ** -0.5),
        "ev_k_k": 0.85 + nrm((n_even, A_WIDTH), 0.02),
        "ev_k_a": 1.0 + nrm((n_even, A_WIDTH), 0.02),
        "ev_r_k": nrm((n_even, A_HEADS, A_HEAD_DIM), 0.1),
        "ev_ln_w": 1.0 + nrm((n_even, A_WIDTH), 0.02),
        "ev_ln_b": nrm((n_even, A_WIDTH), 0.02),
        "ev_conv_w": nrm((n_even, B_CONV, B_WIDTH), B_CONV ** -0.5),
        "ev_conv_b": nrm((n_even, B_WIDTH), 0.02),
        "ev_gate_a_w": nrm((n_even, B_BLOCKS, B_BLOCK_DIM, B_BLOCK_DIM), B_BLOCK_DIM ** -0.5),
        "ev_gate_a_b": nrm((n_even, B_BLOCKS, B_BLOCK_DIM), 0.02),
        "ev_gate_x_w": nrm((n_even, B_BLOCKS, B_BLOCK_DIM, B_BLOCK_DIM), B_BLOCK_DIM ** -0.5),
        "ev_gate_x_b": nrm((n_even, B_BLOCKS, B_BLOCK_DIM), 0.02),
        "ev_lambda": lru_lambda,
        "ev_w_out": nrm((n_even, A_WIDTH + B_WIDTH, D_MODEL), (A_WIDTH + B_WIDTH) ** -0.5),
        "od_w_in": nrm((n_odd, D_MODEL, ODD_COLS), D_MODEL ** -0.5),
        "od_conv_w": nrm((n_odd, C_CONV, 2 * C_QK + C_V), C_CONV ** -0.5),
        "od_a_log": jnp.log(unif((n_odd, C_V_HEADS), 1.0, 16.0)),
        "od_dt_bias": dt_bias,
        "od_norm_w": 1.0 + nrm((n_odd, C_HEAD_V), 0.02),
        "od_w_out": nrm((n_odd, C_V, D_MODEL), C_V ** -0.5),
        "moe_router_group": nrm((DEPTH, D_MODEL, MOE_GROUPS), D_MODEL ** -0.5),
        "moe_router_expert": nrm((DEPTH, D_MODEL, MOE_EXPERTS), D_MODEL ** -0.5),
        "moe_w1": nrm((DEPTH, MOE_EXPERTS, D_MODEL, MOE_FF), D_MODEL ** -0.5),
        "moe_w3": nrm((DEPTH, MOE_EXPERTS, D_MODEL, MOE_FF), D_MODEL ** -0.5),
        "moe_w2": nrm((DEPTH, MOE_EXPERTS, MOE_FF, D_MODEL), MOE_FF ** -0.5),
    }


def reference(x, meta_tokens, norm_mix, norm_ffn, norm_final,
              ev_w_in, ev_mu, ev_w0, ev_w_up, ev_a0, ev_a_up, ev_g_up, ev_k_k, ev_k_a, ev_r_k,
              ev_ln_w, ev_ln_b, ev_conv_w, ev_conv_b, ev_gate_a_w, ev_gate_a_b, ev_gate_x_w,
              ev_gate_x_b, ev_lambda, ev_w_out,
              od_w_in, od_conv_w, od_a_log, od_dt_bias, od_norm_w, od_w_out,
              moe_router_group, moe_router_expert, moe_w1, moe_w3, moe_w2):
    Bsz = x.shape[0]
    meta = jnp.broadcast_to(meta_tokens.astype(x.dtype)[None], (Bsz, N_META, D_MODEL))
    h = jnp.concatenate([meta, x], axis=1)
    for layer in range(DEPTH):
        i = layer // 2
        hn = rms_norm(h, norm_mix[layer])
        if layer % 2 == 0:
            mix = even_mixer(hn, ev_w_in[i], ev_mu[i], ev_w0[i], ev_w_up[i], ev_a0[i], ev_a_up[i],
                             ev_g_up[i], ev_k_k[i], ev_k_a[i], ev_r_k[i], ev_ln_w[i], ev_ln_b[i],
                             ev_conv_w[i], ev_conv_b[i], ev_gate_a_w[i], ev_gate_a_b[i],
                             ev_gate_x_w[i], ev_gate_x_b[i], ev_lambda[i], ev_w_out[i])
        else:
            mix = odd_mixer(hn, od_w_in[i], od_conv_w[i], od_a_log[i], od_dt_bias[i],
                            od_norm_w[i], od_w_out[i])
        h = h + mix.astype(h.dtype)
        ffn = hmoe(rms_norm(h, norm_ffn[layer]), moe_router_group[layer], moe_router_expert[layer],
                   moe_w1[layer], moe_w3[layer], moe_w2[layer])
        h = h + ffn.astype(h.dtype)
    h = rms_norm(h, norm_final)
    return h[:, N_META:].astype(x.dtype)
```

```cpp
#include <hip/hip_runtime.h>
#include <cstdio>
#include <cstdint>
#include <cmath>

#ifndef MK_ONE_LAUNCH
#define MK_ONE_LAUNCH 1
#endif

namespace pg8 {
#define PG8_LAS __attribute__((address_space(3)))
typedef unsigned short bf16_t;
typedef short bf16x8 __attribute__((ext_vector_type(8)));
typedef float f32x4 __attribute__((ext_vector_type(4)));
typedef unsigned u32x4 __attribute__((ext_vector_type(4)));
typedef unsigned u32x2 __attribute__((ext_vector_type(2)));
constexpr int BM = 256, BK = 64, HALF = 128, HTB = HALF * BK * 2  , STAGE_BYTES = 8 * HTB, NXCD = 8, WGM = 8;

__host__ __device__ __forceinline__ int lds_byte(int r, int c) { const int st = (r >> 4) * 2 + (c >> 5), rr = r & 15, cc = c & 31, ob = rr * 64 + cc * 2; return st * 1024 + (ob ^ (((ob >> 9) & 1) << 5)); }
__host__ __device__ __forceinline__ void stage_rc(int b, int& R, int& C) { const int st = b / 1024, sb = b % 1024, swz = sb ^ (((sb >> 9) & 1) << 5); R = (st >> 1) * 16 + swz / 64; C = (st & 1) * 32 + (swz % 64) / 2; }
__host__ __device__ __forceinline__ int perm32(int rho) { const int n = rho >> 4, i = rho & 15; return 8 * (i >> 2) + 4 * n + (i & 3); }

struct Unit { int pm, pn; long aoff, boff; };
struct Gemm { const bf16_t* A; const bf16_t* Bt; int K, lda, ldb; };

struct StaticOrder {
    int nM, nN, nwg, G, c, amod; long astep;
    __host__ __device__ void init(int M, int N, int G_, int c_) { nM = M / BM; nN = N / BM; nwg = nM * nN; G = G_; c = c_; amod = 0; astep = 0; }
    __host__ __device__ bool next(int i, Unit& u) const {
        const long L = (long)i * G + c; if (L >= nwg) return false;
        int wgid = (int)L; { const int q = nwg / NXCD, r = nwg % NXCD, xcd = wgid % NXCD, off = wgid / NXCD; wgid = (xcd < r ? xcd * (q + 1) : r * (q + 1) + (xcd - r) * q) + off; }
        const int nig = WGM * nN, gid = wgid / nig, fm = gid * WGM, gsz = (nM - fm) < WGM ? (nM - fm) : WGM;
        u.pm = fm + ((wgid % nig) % gsz); u.pn = (wgid % nig) / gsz; u.boff = 0; u.aoff = amod ? (long)(u.pn % amod) * astep : 0; return true;
    }
    __device__ __forceinline__ void a_ready(const Unit&) const {}
    __device__ __forceinline__ void done(const Unit&) const {}
};
struct MoeOrder {
    const int* tile_e; int ntiles, npn, G, c; long bstride;
    __device__ __forceinline__ bool next(int i, Unit& u) const {
        const long L = (long)i * G + c; if (L >= (long)ntiles * npn) return false;
        const int t = (int)(L / npn); u.pm = t; u.pn = (int)(L % npn); u.aoff = 0; u.boff = (long)tile_e[t] * bstride; return true;
    }
    __device__ __forceinline__ void a_ready(const Unit&) const {}
    __device__ __forceinline__ void done(const Unit&) const {}
};

__device__ __forceinline__ unsigned cvt_pk_bf16(float lo, float hi) { unsigned r; asm volatile("v_cvt_pk_bf16_f32 %0, %1, %2" : "=v"(r) : "v"(lo), "v"(hi)); return r; }
__device__ __forceinline__ float bf_lo(unsigned w) { return __uint_as_float(w << 16); }
__device__ __forceinline__ float bf_hi(unsigned w) { return __uint_as_float(w & 0xffff0000u); }
__device__ __forceinline__ float sigmoidf_(float x) { return 1.0f / (1.0f + __expf(-x)); }
__device__ __forceinline__ float softplusf_(float x) { return fmaxf(x, 0.f) + __logf(1.0f + __expf(-fabsf(x))); }

struct EpiBf16 {
    static constexpr bool PERM = true, AFTER_DRAIN = false;
    bf16_t* O; int ldc;
    __device__ __forceinline__ void operator()(const f32x4 (&acc)[2][2][4][2], const Unit& u, int wr, int wc, int fr, int fq) const {
        const int row0 = u.pm * BM + wr * 64 + fr; const int col0 = u.pn * BM + wc * 32 + 8 * fq;
#pragma unroll
        for (int ai = 0; ai < 2; ++ai)
#pragma unroll
            for (int m = 0; m < 4; ++m) { bf16_t* rowp = O + (size_t)(row0 + ai * HALF + m * 16) * ldc + col0;
#pragma unroll
                for (int bj = 0; bj < 2; ++bj) { const f32x4 v0 = acc[ai][bj][m][0], v1 = acc[ai][bj][m][1];
                    u32x4 w; w.x = cvt_pk_bf16(v0[0], v0[1]); w.y = cvt_pk_bf16(v0[2], v0[3]); w.z = cvt_pk_bf16(v1[0], v1[1]); w.w = cvt_pk_bf16(v1[2], v1[3]);
                    *(u32x4*)(rowp + bj * HALF) = w; } }
    }
};
struct EpiSwiglu {
    static constexpr bool PERM = true, AFTER_DRAIN = false;
    bf16_t* O; int ldc;
    __device__ __forceinline__ void operator()(const f32x4 (&acc)[2][2][4][2], const Unit& u, int wr, int wc, int fr, int fq) const {
        const int row0 = u.pm * BM + wr * 64 + fr; const int col0 = u.pn * HALF + wc * 32 + 8 * fq;
#pragma unroll
        for (int ai = 0; ai < 2; ++ai)
#pragma unroll
            for (int m = 0; m < 4; ++m) { bf16_t* rowp = O + (size_t)(row0 + ai * HALF + m * 16) * ldc + col0;
                float o[8];
#pragma unroll
                for (int n = 0; n < 2; ++n)
#pragma unroll
                    for (int j = 0; j < 4; ++j) { const float gq = acc[ai][0][m][n][j], uq = acc[ai][1][m][n][j]; o[4 * n + j] = gq * sigmoidf_(gq) * uq; }
                u32x4 w; w.x = cvt_pk_bf16(o[0], o[1]); w.y = cvt_pk_bf16(o[2], o[3]); w.z = cvt_pk_bf16(o[4], o[5]); w.w = cvt_pk_bf16(o[6], o[7]);
                *(u32x4*)rowp = w; }
    }
};
struct EpiResid {
    static constexpr bool PERM = false, AFTER_DRAIN = false;
    float* out; const float* x; const float* meta; int mode;
    __device__ __forceinline__ void operator()(const f32x4 (&acc)[2][2][4][2], const Unit& u, int wr, int wc, int fr, int fq) const {
        const int row0 = u.pm * BM + wr * 64 + fr, col0 = u.pn * BM + wc * 32 + 4 * fq;
#pragma unroll
        for (int ai = 0; ai < 2; ++ai)
#pragma unroll
            for (int m = 0; m < 4; ++m) { const int row = row0 + ai * HALF + m * 16; float* rowp = out + (size_t)row * 2048 + col0;
                const float* bp = mode ? rowp : (row < 8192 ? x + (size_t)row * 2048 + col0 : (row < 8208 ? meta + (size_t)(row - 8192) * 2048 + col0 : nullptr));
#pragma unroll
                for (int bj = 0; bj < 2; ++bj)
#pragma unroll
                    for (int n = 0; n < 2; ++n) { f32x4 b = (f32x4){0.f, 0.f, 0.f, 0.f}; if (bp) b = *(const f32x4*)(bp + bj * HALF + n * 16);
                        *(f32x4*)(rowp + bj * HALF + n * 16) = acc[ai][bj][m][n] + b; } }
    }
};
struct EpiLora {
    static constexpr bool PERM = false, AFTER_DRAIN = false;
    float* base; long gstride; const float* w0; const float* a0;
    __device__ __forceinline__ void operator()(const f32x4 (&acc)[2][2][4][2], const Unit& u, int wr, int wc, int fr, int fq) const {
        const int grp = u.pn >> 2; const int row0 = u.pm * BM + wr * 64 + fr, col0 = (u.pn & 3) * BM + wc * 32 + 4 * fq;
        float* O = base + (size_t)grp * gstride;
#pragma unroll
        for (int bj = 0; bj < 2; ++bj)
#pragma unroll
            for (int n = 0; n < 2; ++n) { const int c = col0 + bj * HALF + n * 16;
                f32x4 bv = (f32x4){0.f, 0.f, 0.f, 0.f}; if (grp == 0) bv = *(const f32x4*)(w0 + c); else if (grp == 1) bv = *(const f32x4*)(a0 + c);
#pragma unroll
                for (int ai = 0; ai < 2; ++ai)
#pragma unroll
                    for (int m = 0; m < 4; ++m) { f32x4 v = acc[ai][bj][m][n] + bv;
                        if (grp == 0) {
#pragma unroll
                            for (int j = 0; j < 4; ++j) { const float wl = -softplusf_(-v[j]) - 0.5f; v[j] = __expf(-__expf(wl)); }
                        } else if (grp == 1) {
#pragma unroll
                            for (int j = 0; j < 4; ++j) v[j] = sigmoidf_(v[j]);
                        }
                        *(f32x4*)(O + (size_t)(row0 + ai * HALF + m * 16) * 1024 + c) = v; } }
    }
};
struct EpiGates {
    static constexpr bool PERM = false, AFTER_DRAIN = false;
    float* lru_a; float* lru_ix; const float* ba; const float* bx; const float* lam; const bf16_t* xr;
    __device__ __forceinline__ void operator()(const f32x4 (&acc)[2][2][4][2], const Unit& u, int wr, int wc, int fr, int fq) const {
        const int grp = u.pn >> 2; const int row0 = u.pm * BM + wr * 64 + fr, col0 = (u.pn & 3) * BM + wc * 32 + 4 * fq;
#pragma unroll
        for (int bj = 0; bj < 2; ++bj)
#pragma unroll
            for (int n = 0; n < 2; ++n) { const int c = col0 + bj * HALF + n * 16;
                const f32x4 bv = *(const f32x4*)((grp == 0 ? ba : bx) + c); f32x4 sp = (f32x4){0.f, 0.f, 0.f, 0.f};
                if (grp == 0) { const f32x4 l = *(const f32x4*)(lam + c);
#pragma unroll
                    for (int j = 0; j < 4; ++j) sp[j] = -8.0f * softplusf_(-l[j]); }
#pragma unroll
                for (int ai = 0; ai < 2; ++ai)
#pragma unroll
                    for (int m = 0; m < 4; ++m) { const int row = row0 + ai * HALF + m * 16; f32x4 v = acc[ai][bj][m][n] + bv;
                        if (grp == 0) {
#pragma unroll
                            for (int j = 0; j < 4; ++j) v[j] = __expf(sigmoidf_(v[j]) * sp[j]);
                            *(f32x4*)(lru_a + (size_t)row * 1024 + c) = v;
                        } else { const u32x2 xw = *(const u32x2*)(xr + (size_t)row * 1024 + c);
                            v[0] = sigmoidf_(v[0]) * bf_lo(xw.x); v[1] = sigmoidf_(v[1]) * bf_hi(xw.x); v[2] = sigmoidf_(v[2]) * bf_lo(xw.y); v[3] = sigmoidf_(v[3]) * bf_hi(xw.y);
                            *(f32x4*)(lru_ix + (size_t)row * 1024 + c) = v; } } }
    }
};

template <class Epi, class Sched, bool ALIGN_EPI = false, bool SP2 = false>
__device__ __forceinline__ void gemm_phase(PG8_LAS unsigned char* lds, const Gemm g, const Sched& S, const Epi& E) {
    const int tid = threadIdx.x, wid = __builtin_amdgcn_readfirstlane(tid >> 6), lane = tid & 63, wr = wid >> 2, wc = wid & 3, fr = lane & 15, fq = lane >> 4;
    const int K = g.K, nt = K / BK;
    unsigned voffA[2], voffB[2];
#pragma unroll
    for (int i = 0; i < 2; ++i) { int R, C; stage_rc(tid * 16 + i * 8192, R, C); const int Rb = Epi::PERM ? ((R & ~31) + perm32(R & 31)) : R;
        voffA[i] = (unsigned)(R * g.lda + C) * 2u; voffB[i] = (unsigned)(Rb * g.ldb + C) * 2u; }
    const size_t kstep = (size_t)(BK * 2);
    const size_t hstepA = (size_t)HALF * g.lda * 2, hstepB = (size_t)HALF * g.ldb * 2;
    const size_t tstepA = 2 * hstepA, tstepB = 2 * hstepB;
    const unsigned ldsw = (unsigned)wid * 1024u;
    const int aoff = lds_byte(wr * 64 + fr, fq * 8), boff = lds_byte(wc * 32 + fr, fq * 8);
#define PG8_SA(b, h) (((b) * 2 + (h)) * HTB)
#define PG8_SB(b, h) ((4 + (b) * 2 + (h)) * HTB)
#define PG8_STAGE(bufoff, gbase, voff) do { _Pragma("unroll") for (int _i = 0; _i < 2; ++_i) \
        __builtin_amdgcn_global_load_lds((const unsigned*)((const char*)(gbase) + (voff)[_i]), (PG8_LAS unsigned*)(lds + (bufoff) + ldsw + _i * 8192), 16, 0, 0); } while (0)
#define PG8_LDA(dst, b, h) do { _Pragma("unroll") for (int m = 0; m < 4; ++m) _Pragma("unroll") for (int k = 0; k < 2; ++k) dst[m][k] = *(const PG8_LAS bf16x8*)(lds + PG8_SA(b, h) + aoff + m * 2048 + k * 1024); } while (0)
#define PG8_LDB(dst, b, h) do { _Pragma("unroll") for (int n = 0; n < 2; ++n) _Pragma("unroll") for (int k = 0; k < 2; ++k) dst[n][k] = *(const PG8_LAS bf16x8*)(lds + PG8_SB(b, h) + boff + n * 2048 + k * 1024); } while (0)
#define PG8_MMA(ai, bj, At, Bt) do { __builtin_amdgcn_s_setprio(1); _Pragma("unroll") for (int m = 0; m < 4; ++m) _Pragma("unroll") for (int n = 0; n < 2; ++n) _Pragma("unroll") for (int k = 0; k < 2; ++k) \
        acc[ai][bj][m][n] = __builtin_amdgcn_mfma_f32_16x16x32_bf16(Bt[n][k], At[m][k], acc[ai][bj][m][n], 0, 0, 0); __builtin_amdgcn_s_setprio(0); } while (0)
#define PG8_WAIT_V(n) asm volatile("s_waitcnt vmcnt(" #n ")" ::: "memory")
#define PG8_WAIT_L(n) asm volatile("s_waitcnt lgkmcnt(" #n ")" ::: "memory")
#define PG8_BAR __builtin_amdgcn_s_barrier()
#define PG8_SCHED __builtin_amdgcn_sched_barrier(0)
    Unit cur, nxt; int ui = 0;
    if (!S.next(0, cur)) return;
    f32x4 acc[2][2][4][2];
#pragma unroll
    for (int a = 0; a < 2; ++a)
#pragma unroll
        for (int b = 0; b < 2; ++b)
#pragma unroll
            for (int m = 0; m < 4; ++m)
#pragma unroll
                for (int n = 0; n < 2; ++n) acc[a][b][m][n] = (f32x4){0.f, 0.f, 0.f, 0.f};
    bf16x8 At[4][2], B0[2][2], B1[2][2];
    const char* cA = (const char*)g.A + (size_t)cur.pm * tstepA + cur.aoff; const char* cB = (const char*)g.Bt + (size_t)cur.pn * tstepB + cur.boff;
    S.a_ready(cur);
    if constexpr (SP2) {
        PG8_STAGE(PG8_SB(0, 0), cB, voffB); PG8_STAGE(PG8_SB(0, 1), cB + hstepB, voffB); PG8_STAGE(PG8_SA(0, 0), cA, voffA); PG8_STAGE(PG8_SA(0, 1), cA + hstepA, voffA);
        if (wr == 1) PG8_BAR;
        PG8_WAIT_V(2); PG8_BAR;
        PG8_STAGE(PG8_SB(1, 0), cB + kstep, voffB); PG8_STAGE(PG8_SA(1, 0), cA + kstep, voffA); PG8_STAGE(PG8_SB(1, 1), cB + hstepB + kstep, voffB);
        PG8_WAIT_V(6); PG8_BAR;
    } else {
        PG8_STAGE(PG8_SB(0, 0), cB, voffB); PG8_STAGE(PG8_SA(0, 0), cA, voffA); PG8_STAGE(PG8_SB(0, 1), cB + hstepB, voffB); PG8_STAGE(PG8_SA(0, 1), cA + hstepA, voffA);
        if (wr == 1) PG8_BAR;
        PG8_WAIT_V(4); PG8_BAR;
        PG8_STAGE(PG8_SB(1, 0), cB + kstep, voffB); PG8_STAGE(PG8_SA(1, 0), cA + kstep, voffA); PG8_STAGE(PG8_SB(1, 1), cB + hstepB + kstep, voffB);
        PG8_WAIT_V(6); PG8_BAR;
    }
    for (;;) {
        const bool has_next = S.next(ui + 1, nxt);
        const char* nA = has_next ? (const char*)g.A + (size_t)nxt.pm * tstepA + nxt.aoff : cA; const char* nB = has_next ? (const char*)g.Bt + (size_t)nxt.pn * tstepB + nxt.boff : cB;
        for (int t = 0; t < nt; t += 2) {
            const bool last = (t == nt - 2);
            const char* a1 = cA + (size_t)(t + 1) * kstep;
            const char* a2 = last ? nA : cA + (size_t)(t + 2) * kstep; const char* b2 = last ? nB : cB + (size_t)(t + 2) * kstep;
            const char* a3 = a2 + kstep; const char* b3 = b2 + kstep;
            if (last && has_next) S.a_ready(nxt);
            if constexpr (SP2) {
            PG8_LDB(B0, 0, 0); PG8_LDB(B1, 0, 1); PG8_SCHED; PG8_LDA(At, 0, 0); PG8_STAGE(PG8_SA(1, 1), a1 + hstepA, voffA);
            PG8_WAIT_V(8); PG8_WAIT_L(0); PG8_BAR; PG8_MMA(0, 0, At, B0); PG8_MMA(0, 1, At, B1); PG8_BAR; PG8_SCHED;
            PG8_LDA(At, 0, 1); PG8_STAGE(PG8_SB(0, 0), b2, voffB); PG8_STAGE(PG8_SB(0, 1), b2 + hstepB, voffB); PG8_STAGE(PG8_SA(0, 0), a2, voffA);
            PG8_WAIT_V(8); PG8_WAIT_L(0); PG8_BAR; PG8_MMA(1, 0, At, B0); PG8_MMA(1, 1, At, B1); PG8_BAR; PG8_SCHED;
            PG8_LDB(B0, 1, 0); PG8_LDB(B1, 1, 1); PG8_SCHED; PG8_LDA(At, 1, 0); PG8_STAGE(PG8_SA(0, 1), a2 + hstepA, voffA);
            PG8_WAIT_V(8); PG8_WAIT_L(0); PG8_BAR; PG8_MMA(0, 0, At, B0); PG8_MMA(0, 1, At, B1); PG8_BAR; PG8_SCHED;
            PG8_LDA(At, 1, 1); PG8_STAGE(PG8_SB(1, 0), b3, voffB); PG8_STAGE(PG8_SB(1, 1), b3 + hstepB, voffB); PG8_STAGE(PG8_SA(1, 0), a3, voffA);
            PG8_WAIT_V(8); PG8_WAIT_L(0); PG8_BAR; PG8_MMA(1, 0, At, B0); PG8_MMA(1, 1, At, B1); PG8_BAR; PG8_SCHED;
            } else {
            PG8_LDB(B0, 0, 0); PG8_SCHED; PG8_LDA(At, 0, 0); PG8_STAGE(PG8_SA(1, 1), a1 + hstepA, voffA);
            PG8_WAIT_L(8); PG8_BAR; PG8_WAIT_L(0); PG8_MMA(0, 0, At, B0); PG8_BAR; PG8_SCHED;
            PG8_LDB(B1, 0, 1); PG8_STAGE(PG8_SB(0, 0), b2, voffB);
            PG8_BAR; PG8_WAIT_L(0); PG8_MMA(0, 1, At, B1); PG8_BAR;
            PG8_LDA(At, 0, 1); PG8_STAGE(PG8_SA(0, 0), a2, voffA);
            PG8_BAR; PG8_WAIT_L(0); PG8_MMA(1, 0, At, B0); PG8_BAR; PG8_SCHED;
            PG8_STAGE(PG8_SB(0, 1), b2 + hstepB, voffB);
            PG8_WAIT_V(6); PG8_BAR; PG8_MMA(1, 1, At, B1); PG8_BAR;
            PG8_LDB(B0, 1, 0); PG8_SCHED; PG8_LDA(At, 1, 0); PG8_STAGE(PG8_SA(0, 1), a2 + hstepA, voffA);
            PG8_WAIT_L(8); PG8_BAR; PG8_WAIT_L(0); PG8_MMA(0, 0, At, B0); PG8_BAR; PG8_SCHED;
            PG8_LDB(B1, 1, 1); PG8_STAGE(PG8_SB(1, 0), b3, voffB);
            PG8_BAR; PG8_WAIT_L(0); PG8_MMA(0, 1, At, B1); PG8_BAR;
            PG8_LDA(At, 1, 1); PG8_STAGE(PG8_SA(1, 0), a3, voffA);
            PG8_BAR; PG8_WAIT_L(0); PG8_MMA(1, 0, At, B0); PG8_BAR; PG8_SCHED;
            PG8_STAGE(PG8_SB(1, 1), b3 + hstepB, voffB);
            PG8_WAIT_V(6); PG8_BAR; PG8_MMA(1, 1, At, B1); PG8_BAR;
            }
        }
        if constexpr (ALIGN_EPI) { if (wr == 0) PG8_BAR; }
        if constexpr (!Epi::AFTER_DRAIN) { E(acc, cur, wr, wc, fr, fq); S.done(cur); }
        if (!has_next) break;
#pragma unroll
        for (int a = 0; a < 2; ++a)
#pragma unroll
            for (int b = 0; b < 2; ++b)
#pragma unroll
                for (int m = 0; m < 4; ++m)
#pragma unroll
                    for (int n = 0; n < 2; ++n) acc[a][b][m][n] = (f32x4){0.f, 0.f, 0.f, 0.f};
        cur = nxt; cA = nA; cB = nB; ++ui;
        if constexpr (ALIGN_EPI) { if (wr == 1) PG8_BAR; }
    }
    PG8_WAIT_V(0);
    if constexpr (!ALIGN_EPI) { if (wr == 0) PG8_BAR; }
    PG8_BAR;
    if constexpr (Epi::AFTER_DRAIN) { E.fused(acc, cur, wr, wc, fr, fq, lds, wid, lane); S.done(cur); }
#undef PG8_SA
#undef PG8_SB
#undef PG8_STAGE
#undef PG8_LDA
#undef PG8_LDB
#undef PG8_MMA
#undef PG8_WAIT_V
#undef PG8_WAIT_L
#undef PG8_BAR
#undef PG8_SCHED
}
}
#define GAS __attribute__((address_space(1)))
#define LAS __attribute__((address_space(3)))
typedef unsigned short bf16;
typedef unsigned v4u __attribute__((ext_vector_type(4)));
typedef float f32x4 __attribute__((ext_vector_type(4)));
typedef short bf16x8 __attribute__((ext_vector_type(8)));
typedef GAS unsigned gu32;
typedef GAS unsigned long long gu64;
#define RLX_AGENT __ATOMIC_RELAXED, __HIP_MEMORY_SCOPE_AGENT
#define LDS_WAIT() asm volatile("s_waitcnt lgkmcnt(0)" ::: "memory")
#define VM_WAIT() asm volatile("s_waitcnt vmcnt(0)" ::: "memory")
__device__ __forceinline__ unsigned long long rt() { return __builtin_amdgcn_s_memrealtime(); }
__device__ __forceinline__ unsigned f2bf(float f) { unsigned u = __builtin_bit_cast(unsigned, f); return (u + 0x7fffu + ((u >> 16) & 1u)) >> 16; }
__device__ __forceinline__ unsigned pk2(float lo, float hi) { return f2bf(lo) | (f2bf(hi) << 16); }

#define XB_TMO      128
#define XB_XCNT(j)  (256  + 64 * (j))
#define XB_XSUB(j)  (1280 + 64 * (j))
#define XB_XGEN(j)  (2304 + 64 * (j))
#define XB_TOP      3328
#define XB_TOPGEN   3392
#define XCD_BAR_WORDS 3456
#define XB_SPIN_CAP (1u << 18)

__device__ __forceinline__ unsigned xb_ld(unsigned* p)              { return __hip_atomic_load(p, __ATOMIC_RELAXED, __HIP_MEMORY_SCOPE_AGENT); }
__device__ __forceinline__ unsigned xb_add(unsigned* p, unsigned v) { return __hip_atomic_fetch_add(p, v, __ATOMIC_RELAXED, __HIP_MEMORY_SCOPE_AGENT); }
__device__ __forceinline__ unsigned xb_xcc_id() { return (unsigned)__builtin_amdgcn_s_getreg((3 << 11) | 20) & 0xFu; }
#define XB_SPIN(cond, bar) do { unsigned _sp = 0; while (cond) { __builtin_amdgcn_s_sleep(1); \
    if ((++_sp & 255u) == 0u) { if (xb_ld(&(bar)[XB_TMO])) break; if (_sp > XB_SPIN_CAP) { atomicAdd(&(bar)[XB_TMO], 1u); break; } } } } while (0)

struct XcdBarrier {
    unsigned* bar; unsigned x;
    volatile LAS unsigned* st;
};

__device__ __forceinline__ XcdBarrier xcd_barrier_post(unsigned* bar, volatile LAS unsigned* st) {
    XcdBarrier b; b.bar = bar; b.x = xb_xcc_id(); b.st = st;
    if (threadIdx.x == 0) (void)xb_add(&bar[XB_XCNT(b.x)], 1u);
    return b;
}
__device__ __forceinline__ void xcd_barrier_complete(unsigned* bar, unsigned x, unsigned& nloc, unsigned& nx) {
    const unsigned G = gridDim.x * gridDim.y * gridDim.z;
    unsigned sum, cnt, mine, sp = 0u;
    for (;;) {
        sum = 0u; cnt = 0u; mine = 0u;
#pragma unroll
        for (unsigned j = 0; j < 16; ++j) { const unsigned c = xb_ld(&bar[XB_XCNT(j)]); sum += c; cnt += (c > 0u) ? 1u : 0u; mine = (j == x) ? c : mine; }
        if (sum == G) break;
        __builtin_amdgcn_s_sleep(1);
        if ((++sp & 255u) == 0u) { if (xb_ld(&bar[XB_TMO])) break; if (sp > XB_SPIN_CAP) { atomicAdd(&bar[XB_TMO], 1u); break; } }
    }
    nloc = mine > 0u ? mine : 1u; nx = cnt > 0u ? cnt : 1u;
}

__device__ __forceinline__ void xcd_barrier(const XcdBarrier& b) {
    asm volatile("s_waitcnt vmcnt(0)" ::: "memory");
    __syncthreads();
    if (threadIdx.x == 0) {
        unsigned* bar = b.bar;
        __builtin_amdgcn_s_waitcnt(0);
        unsigned nloc = b.st[0], nx = b.st[1];
        if (nloc == 0u) { xcd_barrier_complete(bar, b.x, nloc, nx); b.st[0] = nloc; b.st[1] = nx; }
        const unsigned old = xb_add(&bar[XB_XSUB(b.x)], 1u);
        const unsigned gen = old / nloc;
        if (old + 1u == (gen + 1u) * nloc) {
            __builtin_amdgcn_fence(__ATOMIC_RELEASE, "agent");
            asm volatile("s_waitcnt vmcnt(0)" ::: "memory");
            const unsigned og = xb_add(&bar[XB_TOP], 1u);
            const unsigned tg = og / nx;
            if (og + 1u == (tg + 1u) * nx) xb_add(&bar[XB_TOPGEN], 1u);
            else XB_SPIN(xb_ld(&bar[XB_TOPGEN]) == tg, bar);
            __builtin_amdgcn_fence(__ATOMIC_ACQUIRE, "agent");
            xb_add(&bar[XB_XGEN(b.x)], 1u);
            asm volatile("s_waitcnt vmcnt(0)" ::: "memory");
        } else {
            XB_SPIN(xb_ld(&bar[XB_XGEN(b.x)]) == gen, bar);
            __builtin_amdgcn_fence(__ATOMIC_ACQUIRE, "agent");
            asm volatile("s_waitcnt vmcnt(0)" ::: "memory");
        }
    }
    __syncthreads();
}

constexpr int NWAVES = 8;
constexpr int DM = 2048, TX = 8192, NMETA = 16, TT = TX + NMETA, MP = 8448;
constexpr int EV_NP = 5632, EV_LORA0 = 3072, EV_GB = 3360, EV_REC = 4384;
constexpr int OD_NP = 12544, OD_Z = 8192, OD_B = 12288, OD_A = 12320;
constexpr int NEXP = 32, FF = 512, MOE_ROWS = 24576;
constexpr float NORM_EPS = 1e-6f;

constexpr size_t MiB = 1u << 20;
constexpr size_t WS_CTL = 0, CTL_ZERO_BYTES = 1 * MiB;
constexpr size_t WS_TOKINFO = 1 * MiB;
constexpr size_t WS_TILES = 1 * MiB + 512 * 1024;
constexpr size_t WS_WEVIN = 2 * MiB;
constexpr size_t WS_WEVOUT = 24 * MiB;
constexpr size_t WS_WODIN = 32 * MiB;
constexpr size_t WS_WODOUT = 81 * MiB;
constexpr size_t WS_WLORA = 97 * MiB;
constexpr size_t WS_WGATE = 100 * MiB;
constexpr size_t WS_MOEW = 102 * MiB;
constexpr size_t MOE_E_BYTES = 6 * MiB, MOE_W2_OFF = 4 * MiB;
constexpr size_t WS_H = 294 * MiB;
constexpr size_t WS_HN = 360 * MiB;
constexpr size_t WS_YMIX = 393 * MiB;
constexpr size_t WS_PROJ = 459 * MiB;
constexpr size_t WS_SCR = 662 * MiB;
constexpr size_t WS_END = 932 * MiB;
constexpr size_t SC_ALORA = 0;
constexpr size_t SC_XR = 8 * MiB;
constexpr size_t SC_DEC = 26 * MiB, SC_ICL = 60 * MiB, SC_GATE = 94 * MiB;
constexpr size_t SC_LA = 128 * MiB, SC_LIX = 162 * MiB;
constexpr size_t SC_QN = 0, SC_KN = 34 * MiB;
constexpr size_t SC_VC = 68 * MiB;
constexpr size_t SC_BETA = 134 * MiB, SC_G = 136 * MiB;
constexpr size_t SC_O = 138 * MiB;
constexpr size_t SC_XG = 0;
constexpr size_t SC_ACT = 96 * MiB;
constexpr size_t SC_YB = 120 * MiB;
static_assert(SC_O + (size_t)MP * 4096 * 4 <= WS_END - WS_SCR && SC_YB + (size_t)MOE_ROWS * 2048 * 2 <= WS_END - WS_SCR && SC_LIX + (size_t)MP * 1024 * 4 <= WS_END - WS_SCR, "scratch map");
constexpr int CW_TMO = 0, CW_CODE = 1;
constexpr int CW_BAR = 4096;
constexpr int CW_MOECNT = 16384;

constexpr int RING_OFF = 0, RING_BYTES = 131072;
constexpr int LDSCTL_OFF = RING_BYTES, MISC_OFF = LDSCTL_OFF + 320;
constexpr int LDS_BYTES = 147456;


#define DI __device__ __forceinline__
typedef unsigned v2u __attribute__((ext_vector_type(2)));
struct Args { const float* in[36]; float* out; unsigned char* ws; int ph_lo, ph_hi; };
struct Frame {
    LAS unsigned char* lds; volatile LAS unsigned* MISC; gu32* ctl;
    int tid, lane, wave, vcu, G, gw, NGW;
};
DI float bf2f(bf16 v) { return __uint_as_float((unsigned)v << 16); }
DI float bflo(unsigned w) { return __uint_as_float(w << 16); }
DI float bfhi(unsigned w) { return __uint_as_float(w & 0xffff0000u); }
DI float wave_sum(float v) {
#pragma unroll
    for (int o = 1; o < 64; o <<= 1) v += __shfl_xor(v, o);
    return v;
}
DI float sigm(float x) { return 1.0f / (1.0f + __expf(-x)); }
DI float softplus(float x) { return fmaxf(x, 0.f) + __logf(1.0f + __expf(-fabsf(x))); }
DI float gelu_tanh(float x) { const float u = 0.7978845608028654f * (x + 0.044715f * x * x * x); return 0.5f * x * (1.0f + tanhf(u)); }
DI int pos_row(int p) { return p < NMETA ? TX + p : p - NMETA; }
DI int row_pos(int r) { return r < TX ? r + NMETA : r - TX; }

DI void tr_item(const float* W, int N, int k0, int n0, bf16* WT, int ldk, int drow0, LAS float* scr, int lane) {
#pragma unroll 8
    for (int i = 0; i < 32; ++i) { const int kk = 2 * i + (lane >> 5); scr[kk * 33 + (lane & 31)] = W[(size_t)(k0 + kk) * N + n0 + (lane & 31)]; }
    LDS_WAIT(); asm volatile("" ::: "memory");
    const int c = lane & 7;
#pragma unroll
    for (int j = 0; j < 4; ++j) { const int n = (lane >> 3) + 8 * j; const LAS float* s = scr + (8 * c) * 33 + n;
        v4u o; o.x = pk2(s[0 * 33], s[1 * 33]); o.y = pk2(s[2 * 33], s[3 * 33]); o.z = pk2(s[4 * 33], s[5 * 33]); o.w = pk2(s[6 * 33], s[7 * 33]);
        *(v4u*)(WT + (size_t)(drow0 + n) * ldk + k0 + 8 * c) = o; }
    LDS_WAIT(); asm volatile("" ::: "memory");
}
DI void moe_convert(const Frame& F, const Args& a, int l) {
    LAS float* scr = (LAS float*)(F.lds + RING_OFF + F.wave * 16384);
    bf16* base = (bf16*)(a.ws + WS_MOEW);
    for (int it = F.gw; it < NEXP * 1536; it += F.NGW) {
        const int e = it / 1536; int j = it % 1536; bf16* eb = base + (size_t)e * (MOE_E_BYTES / 2);
        const size_t eoff = (size_t)(l * NEXP + e) * DM * FF;
        if (j < 1024) { const float* W = (j < 512 ? a.in[33] : a.in[34]) + eoff; const int hi = j >= 512; j &= 511; const int kb = j >> 4, nb = j & 15, n0 = 32 * nb;
            tr_item(W, FF, 64 * kb, n0, eb, DM, 256 * (n0 >> 7) + 128 * hi + (n0 & 127), scr, F.lane); }
        else { j -= 1024; const int kb = j >> 6, nb = j & 63; tr_item(a.in[35] + eoff, DM, 64 * kb, 32 * nb, eb + MOE_W2_OFF / 2, FF, 32 * nb, scr, F.lane); }
    }
}
DI void norm_row_bf16(int lane, const float* src, const float* w, bf16* dst) {
    f32x4 v[8]; float s = 0.f;
#pragma unroll
    for (int j = 0; j < 8; ++j) { v[j] = ((const f32x4*)src)[lane + 64 * j]; s += (v[j].x * v[j].x + v[j].y * v[j].y) + (v[j].z * v[j].z + v[j].w * v[j].w); }
    const float rs = 1.0f / sqrtf(wave_sum(s) * (1.0f / DM) + NORM_EPS);
#pragma unroll
    for (int j = 0; j < 8; ++j) { const f32x4 wv = ((const f32x4*)w)[lane + 64 * j]; v2u o; o.x = pk2(v[j].x * rs * wv.x, v[j].y * rs * wv.y); o.y = pk2(v[j].z * rs * wv.z, v[j].w * rs * wv.w);
        ((v2u*)dst)[lane + 64 * j] = o; }
}

DI void ph_prologue(const Frame& F, const Args& a) {
    LAS float* scr = (LAS float*)(F.lds + RING_OFF + F.wave * 16384);
    constexpr int I_A = 32 * 169, I_B = 32 * 64, I_C = 32 * 386, I_D = 64 * 64, NIT = I_A + I_B + I_C + I_D;
    for (int it = F.gw; it < NIT; it += F.NGW) {
        int r = it;
        if (r < I_A) { const int kb = r / 169, nb = r % 169; tr_item(a.in[5], 5408, 64 * kb, 32 * nb, (bf16*)(a.ws + WS_WEVIN), DM, 32 * nb, scr, F.lane); continue; } r -= I_A;
        if (r < I_B) { const int kb = r / 64, nb = r % 64; tr_item(a.in[24], DM, 64 * kb, 32 * nb, (bf16*)(a.ws + WS_WEVOUT), DM, 32 * nb, scr, F.lane); continue; } r -= I_B;
        if (r < I_C) { const int kb = r / 386, nb = r % 386; tr_item(a.in[25], 12352, 64 * kb, 32 * nb, (bf16*)(a.ws + WS_WODIN), DM, 32 * nb, scr, F.lane); continue; } r -= I_C;
        { const int kb = r / 64, nb = r % 64; tr_item(a.in[30], DM, 64 * kb, 32 * nb, (bf16*)(a.ws + WS_WODOUT), 4096, 32 * nb, scr, F.lane); }
    }
    moe_convert(F, a, 0);
    const int gt = F.vcu * (NWAVES * 64) + F.tid, NGT = F.G * NWAVES * 64;
    { bf16* WL = (bf16*)(a.ws + WS_WLORA); const float* wup = a.in[8]; const float* aup = a.in[10]; const float* gup = a.in[11];
      for (int idx = gt; idx < 3072 * 384; idx += NGT) { const int n = idx / 384, k = idx % 384; float v = 0.f;
          if (n < 1024) { if (k < 64) v = wup[k * 1024 + n]; }
          else if (n < 2048) { if (k >= 64 && k < 128) v = aup[(k - 64) * 1024 + n - 1024]; }
          else { if (k >= 128 && k < 288) v = gup[(k - 128) * 1024 + n - 2048]; }
          WL[idx] = (bf16)f2bf(v); } }
    { bf16* WG = (bf16*)(a.ws + WS_WGATE);
      for (int idx = gt; idx < 2048 * 256; idx += NGT) { const int n = idx >> 8, kk = idx & 255, nn = n & 1023, blk = nn >> 6, j = nn & 63, cin = (nn & ~255) + kk;
          const float* W = n < 1024 ? a.in[19] : a.in[21];
          const float v = (cin >> 6) == blk ? W[blk * 4096 + (cin & 63) * 64 + j] : 0.f;
          WG[idx] = (bf16)f2bf(v); } }
    bf16* HN = (bf16*)(a.ws + WS_HN);
    for (int r = F.gw; r < TT; r += F.NGW) norm_row_bf16(F.lane, r < TX ? a.in[0] + (size_t)r * DM : a.in[1] + (size_t)(r - TX) * DM, a.in[2], HN + (size_t)r * DM);
}

DI void ph_even_prep(const Frame& F, const Args& a) {
    const bf16* P = (const bf16*)(a.ws + WS_PROJ); bf16* AL = (bf16*)(a.ws + WS_SCR + SC_ALORA); bf16* XR = (bf16*)(a.ws + WS_SCR + SC_XR);
    const float* mu = a.in[6]; const float* cw = a.in[17]; const float* cb = a.in[18];
    const int lane = F.lane;
    for (int r = F.gw; r < TT; r += F.NGW) {
        const int pos = row_pos(r); const bf16* cur = P + (size_t)r * EV_NP; const bf16* prv = pos > 0 ? P + (size_t)pos_row(pos - 1) * EV_NP : nullptr;
#pragma unroll
        for (int i = 0; i < 6; ++i) { const int idx = lane + 64 * i; float v = 0.f;
            if (idx < 288) { const int col = EV_LORA0 + idx; const float c = bf2f(cur[col]), p = prv ? bf2f(prv[col]) : 0.f; v = c + (p - c) * mu[col];
                if (idx < 64) v = tanhf(v); else if (idx >= 128) v = sigm(v); }
            AL[(size_t)r * 384 + idx] = (bf16)f2bf(v); }
        const int c0 = lane * 16; float acc[16];
#pragma unroll
        for (int i = 0; i < 4; ++i) { const f32x4 b = *(const f32x4*)(cb + c0 + 4 * i); acc[4 * i] = b.x; acc[4 * i + 1] = b.y; acc[4 * i + 2] = b.z; acc[4 * i + 3] = b.w; }
#pragma unroll
        for (int j = 0; j < 4; ++j) { const int pj = pos - 3 + j; if (pj < 0) continue;
            const bf16* src = P + (size_t)pos_row(pj) * EV_NP + EV_REC + c0; const v4u x0 = *(const v4u*)src, x1 = *(const v4u*)(src + 8);
            const unsigned xw[8] = {x0.x, x0.y, x0.z, x0.w, x1.x, x1.y, x1.z, x1.w};
#pragma unroll
            for (int i = 0; i < 4; ++i) { const f32x4 w = *(const f32x4*)(cw + j * 1024 + c0 + 4 * i);
                acc[4 * i] += w.x * bflo(xw[2 * i]); acc[4 * i + 1] += w.y * bfhi(xw[2 * i]); acc[4 * i + 2] += w.z * bflo(xw[2 * i + 1]); acc[4 * i + 3] += w.w * bfhi(xw[2 * i + 1]); } }
        v4u o0, o1; o0.x = pk2(acc[0], acc[1]); o0.y = pk2(acc[2], acc[3]); o0.z = pk2(acc[4], acc[5]); o0.w = pk2(acc[6], acc[7]);
        o1.x = pk2(acc[8], acc[9]); o1.y = pk2(acc[10], acc[11]); o1.z = pk2(acc[12], acc[13]); o1.w = pk2(acc[14], acc[15]);
        bf16* dst = XR + (size_t)r * 1024 + c0; *(v4u*)dst = o0; *(v4u*)(dst + 8) = o1;
    }
}

DI void rwkv_scan_simple(const Frame& F, const Args& a, int h) {
    const int lane = F.lane, c = h * 64 + lane;
    LAS float* scr = (LAS float*)(F.lds + RING_OFF + F.wave * 16384);
    const bf16* P = (const bf16*)(a.ws + WS_PROJ); const float* DEC = (const float*)(a.ws + WS_SCR + SC_DEC); const float* ICL = (const float*)(a.ws + WS_SCR + SC_ICL);
    const float* GATE = (const float*)(a.ws + WS_SCR + SC_GATE); bf16* Y = (bf16*)(a.ws + WS_YMIX);
    const float* mu = a.in[6];
    const float mu_r = mu[c], mu_k = mu[1024 + c], mu_v = mu[2048 + c], kkc = a.in[12][c], kac = a.in[13][c], rkc = a.in[14][c], lnw = a.in[15][c], lnb = a.in[16][c];
    float s[64];
#pragma unroll
    for (int j = 0; j < 64; ++j) s[j] = 0.f;
    float pr = 0.f, pk = 0.f, pv = 0.f;
    int r1 = pos_row(0);
    float n_r = bf2f(P[(size_t)r1 * EV_NP + c]), n_k = bf2f(P[(size_t)r1 * EV_NP + 1024 + c]), n_v = bf2f(P[(size_t)r1 * EV_NP + 2048 + c]);
    float n_w = DEC[(size_t)r1 * 1024 + c], n_i = ICL[(size_t)r1 * 1024 + c], n_g = GATE[(size_t)r1 * 1024 + c];
    for (int pos = 0; pos < TT; ++pos) {
        const int r = r1; const float cr = n_r, ck = n_k, cv = n_v, w = n_w, icl = n_i, g = n_g;
        if (pos + 1 < TT) { r1 = pos_row(pos + 1);
            n_r = bf2f(P[(size_t)r1 * EV_NP + c]); n_k = bf2f(P[(size_t)r1 * EV_NP + 1024 + c]); n_v = bf2f(P[(size_t)r1 * EV_NP + 2048 + c]);
            n_w = DEC[(size_t)r1 * 1024 + c]; n_i = ICL[(size_t)r1 * 1024 + c]; n_g = GATE[(size_t)r1 * 1024 + c]; }
        const float rr = cr + (pr - cr) * mu_r, kk = ck + (pk - ck) * mu_k, vv = cv + (pv - cv) * mu_v;
        pr = cr; pk = ck; pv = cv;
        const float kkv = kk * kkc; const float nrm = sqrtf(wave_sum(kkv * kkv)); const float kkn = kkv / fmaxf(nrm, 1e-12f);
        const float kmod = kk * (1.0f + (icl - 1.0f) * kac);
        scr[lane] = w; scr[64 + lane] = -kkn; scr[128 + lane] = kkn * icl; scr[192 + lane] = kmod; scr[256 + lane] = rr;
        LDS_WAIT(); __builtin_amdgcn_wave_barrier();
        float sa = 0.f;
#pragma unroll
        for (int j = 0; j < 64; ++j) sa += s[j] * scr[64 + j];
        float y = 0.f;
#pragma unroll
        for (int j = 0; j < 64; ++j) { s[j] = s[j] * scr[j] + sa * scr[128 + j] + vv * scr[192 + j]; y += s[j] * scr[256 + j]; }
        const float mean = wave_sum(y) * (1.0f / 64.0f), d = y - mean, var = wave_sum(d * d) * (1.0f / 64.0f);
        const float yn = d * (1.0f / sqrtf(var + 64e-5f)) * lnw + lnb;
        const float bonus = wave_sum(rr * kmod * rkc) * vv;
        Y[(size_t)r * DM + c] = (bf16)f2bf((yn + bonus) * g);
        __builtin_amdgcn_wave_barrier(); asm volatile("" ::: "memory");
    }
}
DI void lru_scan_simple(const Frame& F, const Args& a, int c) {
    const bf16* P = (const bf16*)(a.ws + WS_PROJ); const float* LA = (const float*)(a.ws + WS_SCR + SC_LA); const float* LIX = (const float*)(a.ws + WS_SCR + SC_LIX);
    bf16* Y = (bf16*)(a.ws + WS_YMIX);
    float hst = 0.f;
#pragma unroll 8
    for (int pos = 0; pos < TT; ++pos) { const int r = pos_row(pos);
        const float av = LA[(size_t)r * 1024 + c], ix = LIX[(size_t)r * 1024 + c], gb = bf2f(P[(size_t)r * EV_NP + EV_GB + c]);
        hst = av * hst + sqrtf(fmaxf(1.0f - av * av, 0.f)) * ix;
        Y[(size_t)r * DM + 1024 + c] = (bf16)f2bf(hst * gelu_tanh(gb)); }
}
DI void ph_even_scan(const Frame& F, const Args& a) {
    if (F.gw < 16) rwkv_scan_simple(F, a, F.gw);
    else if (F.gw < 32) lru_scan_simple(F, a, (F.gw - 16) * 64 + F.lane);
}

DI void ph_route(const Frame& F, const Args& a, int l) {
    const float* H = (const float*)(a.ws + WS_H); const float* nw = a.in[3] + (size_t)l * DM;
    const float* RG = a.in[31] + (size_t)l * DM * 4; const float* RE = a.in[32] + (size_t)l * DM * NEXP;
    unsigned* TI = (unsigned*)(a.ws + WS_TOKINFO); const int lane = F.lane;
    for (int r = F.gw; r < TT; r += F.NGW) {
        const float* hr = H + (size_t)r * DM; float s = 0.f;
#pragma unroll
        for (int j = 0; j < 8; ++j) { const f32x4 v = ((const f32x4*)hr)[lane + 64 * j]; s += (v.x * v.x + v.y * v.y) + (v.z * v.z + v.w * v.w); }
        const float rs = 1.0f / sqrtf(wave_sum(s) * (1.0f / DM) + NORM_EPS);
        float acc[36];
#pragma unroll
        for (int i = 0; i < 36; ++i) acc[i] = 0.f;
#pragma unroll 1
        for (int j = 0; j < 8; ++j) { const f32x4 v = ((const f32x4*)hr)[lane + 64 * j]; const f32x4 wv = ((const f32x4*)nw)[lane + 64 * j]; const float xn[4] = {v.x * rs * wv.x, v.y * rs * wv.y, v.z * rs * wv.z, v.w * rs * wv.w};
#pragma unroll
            for (int q = 0; q < 4; ++q) { const int k = (lane + 64 * j) * 4 + q; const f32x4* we = (const f32x4*)(RE + (size_t)k * NEXP);
#pragma unroll
                for (int t = 0; t < 8; ++t) { const f32x4 w = we[t]; acc[4 * t] += xn[q] * w.x; acc[4 * t + 1] += xn[q] * w.y; acc[4 * t + 2] += xn[q] * w.z; acc[4 * t + 3] += xn[q] * w.w; }
                const f32x4 wg = *(const f32x4*)(RG + (size_t)k * 4); acc[32] += xn[q] * wg.x; acc[33] += xn[q] * wg.y; acc[34] += xn[q] * wg.z; acc[35] += xn[q] * wg.w;
                asm volatile("" ::: "memory"); } }
#pragma unroll
        for (int i = 0; i < 36; ++i) acc[i] = wave_sum(acc[i]);
        int gi = 0; float gm = acc[32];
#pragma unroll
        for (int i = 1; i < 4; ++i) if (acc[32 + i] > gm) { gm = acc[32 + i]; gi = i; }
        float den = 0.f;
#pragma unroll
        for (int i = 0; i < 4; ++i) den += __expf(acc[32 + i] - gm);
        const float gp = 1.0f / den;
        float l8[8];
#pragma unroll
        for (int i = 0; i < 8; ++i) l8[i] = gi == 0 ? acc[i] : (gi == 1 ? acc[8 + i] : (gi == 2 ? acc[16 + i] : acc[24 + i]));
        int i1 = 0; float m1 = l8[0];
#pragma unroll
        for (int i = 1; i < 8; ++i) if (l8[i] > m1) { m1 = l8[i]; i1 = i; }
        int i2 = -1; float m2 = -INFINITY;
#pragma unroll
        for (int i = 0; i < 8; ++i) if (i != i1 && l8[i] > m2) { m2 = l8[i]; i2 = i; }
        const float e21 = __expf(m2 - m1); const float w1 = gp / (1.0f + e21), w2 = gp * e21 / (1.0f + e21);
        if (lane == 0) { const int ea = gi * 8 + i1, eb = gi * 8 + i2;
            const unsigned sa = atomicAdd((unsigned*)(F.ctl + CW_MOECNT + (l * NEXP + ea) * 16), 1u), sb = atomicAdd((unsigned*)(F.ctl + CW_MOECNT + (l * NEXP + eb) * 16), 1u);
            unsigned* t = TI + (size_t)r * 8; t[0] = ea; t[1] = sa; t[2] = __float_as_uint(w1); t[3] = eb; t[4] = sb; t[5] = __float_as_uint(w2); t[6] = __float_as_uint(rs); t[7] = 0u; }
    }
}
DI void moe_prefix(const Frame& F, int l, LAS int* ps) {
    if (F.tid == 0) { int t = 0;
        for (int e = 0; e < NEXP; ++e) { const unsigned c = __hip_atomic_load(F.ctl + CW_MOECNT + (l * NEXP + e) * 16, RLX_AGENT); ps[e] = t * 256; t += (int)((c + 255u) >> 8); }
        ps[32] = t; }
    __syncthreads();
}
DI void ph_gather(const Frame& F, const Args& a, int l) {
    LAS int* ps = (LAS int*)(F.lds + RING_OFF); moe_prefix(F, l, ps);
    if (F.vcu == 0 && F.tid < NEXP) { int* TE = (int*)(a.ws + WS_TILES); const int e = F.tid; const int t0 = ps[e] >> 8, t1 = (e == NEXP - 1 ? ps[32] : ps[e + 1] >> 8);
        for (int t = t0; t < t1; ++t) TE[t] = e; if (e == 0) TE[127] = ps[32]; }
    const float* H = (const float*)(a.ws + WS_H); const float* nw = a.in[3] + (size_t)l * DM; unsigned* TI = (unsigned*)(a.ws + WS_TOKINFO); bf16* XG = (bf16*)(a.ws + WS_SCR + SC_XG);
    const int lane = F.lane;
    for (int r = F.gw; r < TT; r += F.NGW) {
        unsigned* t = TI + (size_t)r * 8; const int g0 = ps[t[0]] + (int)t[1], g1 = ps[t[3]] + (int)t[4]; const float rs = __uint_as_float(t[6]);
        if (lane == 0) { t[1] = (unsigned)g0; t[4] = (unsigned)g1; }
        const float* hr = H + (size_t)r * DM;
#pragma unroll
        for (int j = 0; j < 4; ++j) { const int e0 = (lane + 64 * j) * 8; const f32x4 x0 = *(const f32x4*)(hr + e0), x1 = *(const f32x4*)(hr + e0 + 4), w0 = *(const f32x4*)(nw + e0), w1 = *(const f32x4*)(nw + e0 + 4);
            v4u o; o.x = pk2(x0.x * rs * w0.x, x0.y * rs * w0.y); o.y = pk2(x0.z * rs * w0.z, x0.w * rs * w0.w); o.z = pk2(x1.x * rs * w1.x, x1.y * rs * w1.y); o.w = pk2(x1.z * rs * w1.z, x1.w * rs * w1.w);
            *(v4u*)(XG + (size_t)g0 * DM + e0) = o; *(v4u*)(XG + (size_t)g1 * DM + e0) = o; }
    }
}
DI void ph_combine(const Frame& F, const Args& a, int l) {
    float* H = (float*)(a.ws + WS_H); const unsigned* TI = (const unsigned*)(a.ws + WS_TOKINFO); const bf16* YB = (const bf16*)(a.ws + WS_SCR + SC_YB); bf16* HN = (bf16*)(a.ws + WS_HN);
    const int lane = F.lane; const int nrows = l == 0 ? TT : TX;
    for (int r = F.gw; r < nrows; r += F.NGW) {
        const unsigned* t = TI + (size_t)r * 8; const int g0 = (int)t[1], g1 = (int)t[4]; const float w0 = __uint_as_float(t[2]), w1 = __uint_as_float(t[5]);
        float* hr = H + (size_t)r * DM; float hv[32]; float s = 0.f;
#pragma unroll
        for (int j = 0; j < 4; ++j) { const int e0 = (lane + 64 * j) * 8; const f32x4 x0 = *(const f32x4*)(hr + e0), x1 = *(const f32x4*)(hr + e0 + 4);
            const v4u ya = *(const v4u*)(YB + (size_t)g0 * DM + e0), yc = *(const v4u*)(YB + (size_t)g1 * DM + e0);
            float* o = hv + 8 * j;
            o[0] = x0.x + w0 * bflo(ya.x) + w1 * bflo(yc.x); o[1] = x0.y + w0 * bfhi(ya.x) + w1 * bfhi(yc.x); o[2] = x0.z + w0 * bflo(ya.y) + w1 * bflo(yc.y); o[3] = x0.w + w0 * bfhi(ya.y) + w1 * bfhi(yc.y);
            o[4] = x1.x + w0 * bflo(ya.z) + w1 * bflo(yc.z); o[5] = x1.y + w0 * bfhi(ya.z) + w1 * bfhi(yc.z); o[6] = x1.z + w0 * bflo(ya.w) + w1 * bflo(yc.w); o[7] = x1.w + w0 * bfhi(ya.w) + w1 * bfhi(yc.w);
#pragma unroll
            for (int q = 0; q < 8; ++q) s += o[q] * o[q]; }
        const float rs = 1.0f / sqrtf(wave_sum(s) * (1.0f / DM) + NORM_EPS);
        if (l == 0) { const float* nw = a.in[2] + DM;
#pragma unroll
            for (int j = 0; j < 4; ++j) { const int e0 = (lane + 64 * j) * 8; const float* o = hv + 8 * j; const f32x4 wa = *(const f32x4*)(nw + e0), wb = *(const f32x4*)(nw + e0 + 4);
                *(f32x4*)(hr + e0) = (f32x4){o[0], o[1], o[2], o[3]}; *(f32x4*)(hr + e0 + 4) = (f32x4){o[4], o[5], o[6], o[7]};
                v4u p; p.x = pk2(o[0] * rs * wa.x, o[1] * rs * wa.y); p.y = pk2(o[2] * rs * wa.z, o[3] * rs * wa.w); p.z = pk2(o[4] * rs * wb.x, o[5] * rs * wb.y); p.w = pk2(o[6] * rs * wb.z, o[7] * rs * wb.w);
                *(v4u*)(HN + (size_t)r * DM + e0) = p; }
        } else { const float* nw = a.in[4]; float* orow = a.out + (size_t)r * DM;
#pragma unroll
            for (int j = 0; j < 4; ++j) { const int e0 = (lane + 64 * j) * 8; const float* o = hv + 8 * j; const f32x4 wa = *(const f32x4*)(nw + e0), wb = *(const f32x4*)(nw + e0 + 4);
                *(f32x4*)(orow + e0) = (f32x4){o[0] * rs * wa.x, o[1] * rs * wa.y, o[2] * rs * wa.z, o[3] * rs * wa.w};
                *(f32x4*)(orow + e0 + 4) = (f32x4){o[4] * rs * wb.x, o[5] * rs * wb.y, o[6] * rs * wb.z, o[7] * rs * wb.w}; } }
    }
}

DI void ph_odd_prep(const Frame& F, const Args& a) {
    const bf16* P = (const bf16*)(a.ws + WS_PROJ); bf16* QN = (bf16*)(a.ws + WS_SCR + SC_QN); bf16* KN = (bf16*)(a.ws + WS_SCR + SC_KN); bf16* VC = (bf16*)(a.ws + WS_SCR + SC_VC);
    float* BETA = (float*)(a.ws + WS_SCR + SC_BETA); float* GG = (float*)(a.ws + WS_SCR + SC_G);
    const float* cw = a.in[26]; const int lane = F.lane;
    for (int r = F.gw; r < TT; r += F.NGW) {
        const int pos = row_pos(r); const bf16* rows[4];
#pragma unroll
        for (int j = 0; j < 4; ++j) { const int pj = pos - 3 + j; rows[j] = pj >= 0 ? P + (size_t)pos_row(pj) * OD_NP : nullptr; }
#pragma unroll 2
        for (int i = 0; i < 16; ++i) { const int ch = i * 512 + lane * 8; float acc[8];
#pragma unroll
            for (int q = 0; q < 8; ++q) acc[q] = 0.f;
#pragma unroll
            for (int j = 0; j < 4; ++j) { if (!rows[j]) continue; const v4u x = *(const v4u*)(rows[j] + ch); const f32x4 w0 = *(const f32x4*)(cw + j * 8192 + ch), w1 = *(const f32x4*)(cw + j * 8192 + ch + 4);
                acc[0] += w0.x * bflo(x.x); acc[1] += w0.y * bfhi(x.x); acc[2] += w0.z * bflo(x.y); acc[3] += w0.w * bfhi(x.y);
                acc[4] += w1.x * bflo(x.z); acc[5] += w1.y * bfhi(x.z); acc[6] += w1.z * bflo(x.w); acc[7] += w1.w * bfhi(x.w); }
            float ss = 0.f;
#pragma unroll
            for (int q = 0; q < 8; ++q) { acc[q] = acc[q] * sigm(acc[q]); ss += acc[q] * acc[q]; }
            float sc = 1.0f;
            if (i < 8) { ss += __shfl_xor(ss, 1); ss += __shfl_xor(ss, 2); ss += __shfl_xor(ss, 4); ss += __shfl_xor(ss, 8);
                sc = (1.0f / sqrtf(ss + NORM_EPS)) * (i < 4 ? 0.08838834764831845f : 1.0f); }
            v4u o; o.x = pk2(acc[0] * sc, acc[1] * sc); o.y = pk2(acc[2] * sc, acc[3] * sc); o.z = pk2(acc[4] * sc, acc[5] * sc); o.w = pk2(acc[6] * sc, acc[7] * sc);
            bf16* dst = i < 4 ? QN + (size_t)r * 2048 + ch : (i < 8 ? KN + (size_t)r * 2048 + ch - 2048 : VC + (size_t)r * 4096 + ch - 4096);
            *(v4u*)dst = o; }
        if (lane < 32) { const float bb = bf2f(P[(size_t)r * OD_NP + OD_B + lane]), aa = bf2f(P[(size_t)r * OD_NP + OD_A + lane]);
            BETA[(size_t)r * 32 + lane] = sigm(bb); GG[(size_t)r * 32 + lane] = -__expf(a.in[27][lane]) * softplus(aa + a.in[28][lane]); }
    }
}
DI void gdn_scan_simple(const Frame& F, const Args& a, int hv, int half) {
    const int lane = F.lane, hk = hv >> 1, vcol = hv * 128 + half * 64 + lane;
    LAS float* scr = (LAS float*)(F.lds + RING_OFF + F.wave * 16384);
    const bf16* QN = (const bf16*)(a.ws + WS_SCR + SC_QN); const bf16* KN = (const bf16*)(a.ws + WS_SCR + SC_KN); const bf16* VC = (const bf16*)(a.ws + WS_SCR + SC_VC);
    const float* BETA = (const float*)(a.ws + WS_SCR + SC_BETA); const float* GG = (const float*)(a.ws + WS_SCR + SC_G); float* O = (float*)(a.ws + WS_SCR + SC_O);
    float s[128];
#pragma unroll
    for (int j = 0; j < 128; ++j) s[j] = 0.f;
    int r1 = pos_row(0);
    unsigned n_k = *(const unsigned*)(KN + (size_t)r1 * 2048 + hk * 128 + 2 * lane), n_q = *(const unsigned*)(QN + (size_t)r1 * 2048 + hk * 128 + 2 * lane);
    float n_v = bf2f(VC[(size_t)r1 * 4096 + vcol]), n_b = BETA[(size_t)r1 * 32 + hv], n_g = GG[(size_t)r1 * 32 + hv];
    for (int pos = 0; pos < TT; ++pos) {
        const int r = r1; const unsigned kw = n_k, qw = n_q; const float v = n_v, beta = n_b, eg = __expf(n_g);
        if (pos + 1 < TT) { r1 = pos_row(pos + 1);
            n_k = *(const unsigned*)(KN + (size_t)r1 * 2048 + hk * 128 + 2 * lane); n_q = *(const unsigned*)(QN + (size_t)r1 * 2048 + hk * 128 + 2 * lane);
            n_v = bf2f(VC[(size_t)r1 * 4096 + vcol]); n_b = BETA[(size_t)r1 * 32 + hv]; n_g = GG[(size_t)r1 * 32 + hv]; }
        scr[2 * lane] = bflo(kw); scr[2 * lane + 1] = bfhi(kw); scr[128 + 2 * lane] = bflo(qw); scr[128 + 2 * lane + 1] = bfhi(qw);
        LDS_WAIT(); __builtin_amdgcn_wave_barrier();
        float ks = 0.f;
#pragma unroll
        for (int jb = 0; jb < 128; jb += 16) {
#pragma unroll
            for (int j = jb; j < jb + 16; ++j) ks += scr[j] * s[j];
            asm volatile("" ::: "memory"); }
        const float vn = beta * (v - eg * ks); float o = 0.f;
#pragma unroll
        for (int jb = 0; jb < 128; jb += 16) {
#pragma unroll
            for (int j = jb; j < jb + 16; ++j) { s[j] = eg * s[j] + scr[j] * vn; o += scr[128 + j] * s[j]; }
            asm volatile("" ::: "memory"); }
        O[(size_t)r * 4096 + vcol] = o;
        __builtin_amdgcn_wave_barrier(); asm volatile("" ::: "memory");
    }
}
DI void ph_odd_post(const Frame& F, const Args& a) {
    const bf16* P = (const bf16*)(a.ws + WS_PROJ); const float* O = (const float*)(a.ws + WS_SCR + SC_O); bf16* Y = (bf16*)(a.ws + WS_YMIX); const float* nw = a.in[29];
    const int lane = F.lane;
    for (int r = F.gw; r < TT; r += F.NGW) {
#pragma unroll 2
        for (int i = 0; i < 8; ++i) { const int ch = i * 512 + lane * 8; const f32x4 o0 = *(const f32x4*)(O + (size_t)r * 4096 + ch), o1 = *(const f32x4*)(O + (size_t)r * 4096 + ch + 4);
            float ss = (o0.x * o0.x + o0.y * o0.y) + (o0.z * o0.z + o0.w * o0.w) + (o1.x * o1.x + o1.y * o1.y) + (o1.z * o1.z + o1.w * o1.w);
            ss += __shfl_xor(ss, 1); ss += __shfl_xor(ss, 2); ss += __shfl_xor(ss, 4); ss += __shfl_xor(ss, 8);
            const float rs = 1.0f / sqrtf(ss * (1.0f / 128.0f) + NORM_EPS);
            const v4u z = *(const v4u*)(P + (size_t)r * OD_NP + OD_Z + ch); const int c0 = ch & 127; const f32x4 w0 = *(const f32x4*)(nw + c0), w1 = *(const f32x4*)(nw + c0 + 4);
            const float zf[8] = {bflo(z.x), bfhi(z.x), bflo(z.y), bfhi(z.y), bflo(z.z), bfhi(z.z), bflo(z.w), bfhi(z.w)};
            const float of[8] = {o0.x * w0.x, o0.y * w0.y, o0.z * w0.z, o0.w * w0.w, o1.x * w1.x, o1.y * w1.y, o1.z * w1.z, o1.w * w1.w};
            float y[8];
#pragma unroll
            for (int q = 0; q < 8; ++q) y[q] = of[q] * rs * zf[q] * sigm(zf[q]);
            v4u p; p.x = pk2(y[0], y[1]); p.y = pk2(y[2], y[3]); p.z = pk2(y[4], y[5]); p.w = pk2(y[6], y[7]);
            *(v4u*)(Y + (size_t)r * 4096 + ch) = p; }
    }
}

constexpr int N_PHASES = 21;
template <class Epi, class Sched> DI void run_gemm(const Frame& F, const pg8::Gemm& g, const Sched& S, const Epi& E) {
    pg8::gemm_phase<Epi, Sched, true, true>(F.lds + RING_OFF, g, S, E);
}
DI void ph_moe_up(const Frame& F, const Args& a) {
    const int nt = (int)__hip_atomic_load((gu32*)(a.ws + WS_TILES) + 127, RLX_AGENT);
    pg8::Gemm g{(const bf16*)(a.ws + WS_SCR + SC_XG), (const bf16*)(a.ws + WS_MOEW), DM, DM, DM};
    pg8::MoeOrder S{(const int*)(a.ws + WS_TILES), nt, 4, F.G, (int)blockIdx.x, (long)MOE_E_BYTES};
    pg8::EpiSwiglu E{(bf16*)(a.ws + WS_SCR + SC_ACT), FF};
    run_gemm(F, g, S, E);
}
DI void ph_moe_down(const Frame& F, const Args& a) {
    const int nt = (int)__hip_atomic_load((gu32*)(a.ws + WS_TILES) + 127, RLX_AGENT);
    pg8::Gemm g{(const bf16*)(a.ws + WS_SCR + SC_ACT), (const bf16*)(a.ws + WS_MOEW + MOE_W2_OFF), FF, FF, FF};
    pg8::MoeOrder S{(const int*)(a.ws + WS_TILES), nt, 8, F.G, (int)blockIdx.x, (long)MOE_E_BYTES};
    pg8::EpiBf16 E{(bf16*)(a.ws + WS_SCR + SC_YB), DM};
    run_gemm(F, g, S, E);
}

__global__ void __launch_bounds__(NWAVES * 64, 2) hyb_fwd(Args a) {
    extern __shared__ __attribute__((aligned(16))) unsigned char lds[];
    Frame F;
    F.lds = (LAS unsigned char*)lds;
    F.MISC = (volatile LAS unsigned*)(F.lds + MISC_OFF);
    F.tid = threadIdx.x; F.lane = F.tid & 63; F.wave = __builtin_amdgcn_readfirstlane(F.tid >> 6);
    F.G = gridDim.x; { const int bx = blockIdx.x; F.vcu = (F.G % 8 == 0) ? (bx % 8) * (F.G / 8) + bx / 8 : bx; }
    F.gw = F.vcu * NWAVES + F.wave; F.NGW = F.G * NWAVES;
    F.ctl = (gu32*)(a.ws + WS_CTL);
    for (int u = F.tid; u < (LDS_BYTES - LDSCTL_OFF) / 4; u += NWAVES * 64) ((LAS unsigned*)(F.lds + LDSCTL_OFF))[u] = 0u;
    __syncthreads();
    XcdBarrier bar; bar.bar = (unsigned*)(F.ctl + CW_BAR); bar.x = 0; bar.st = nullptr;
    if (MK_ONE_LAUNCH) bar = xcd_barrier_post((unsigned*)(F.ctl + CW_BAR), F.MISC + 8);
    const int lo = a.ph_lo, hi = a.ph_hi;
#ifndef PH_MASK
#define PH_MASK 0xFFFFFFFFu
#endif
#define IN(k) (((PH_MASK >> (k)) & 1u) && lo <= (k) && (k) < hi)
#define SEAM(k) do { if (IN(k) && IN((k) + 1)) xcd_barrier(bar); } while (0)
    const bf16* HN = (const bf16*)(a.ws + WS_HN); bf16* PROJ = (bf16*)(a.ws + WS_PROJ); const bf16* YMIX = (const bf16*)(a.ws + WS_YMIX); float* H = (float*)(a.ws + WS_H);

    if (IN(0)) ph_prologue(F, a);
    SEAM(0);
    if (IN(1)) { pg8::Gemm g{HN, (const bf16*)(a.ws + WS_WEVIN), DM, DM, DM}; pg8::StaticOrder S; S.init(MP, EV_NP, F.G, (int)blockIdx.x); pg8::EpiBf16 E{PROJ, EV_NP}; run_gemm(F, g, S, E); }
    SEAM(1);
    if (IN(2)) ph_even_prep(F, a);
    SEAM(2);
    if (IN(3)) {
#ifndef NO_LORA
        { pg8::Gemm g{(const bf16*)(a.ws + WS_SCR + SC_ALORA), (const bf16*)(a.ws + WS_WLORA), 384, 384, 384}; pg8::StaticOrder S; S.init(MP, 3072, F.G, (int)blockIdx.x);
          static_assert(SC_ICL - SC_DEC == SC_GATE - SC_ICL, "lora outputs equally spaced");
          pg8::EpiLora E{(float*)(a.ws + WS_SCR + SC_DEC), (long)((SC_ICL - SC_DEC) / 4), a.in[7], a.in[9]}; run_gemm(F, g, S, E); }
#endif
#ifndef NO_GATES
        { pg8::Gemm g{(const bf16*)(a.ws + WS_SCR + SC_XR), (const bf16*)(a.ws + WS_WGATE), 256, 1024, 256}; pg8::StaticOrder S; S.init(MP, 2048, F.G, (int)blockIdx.x); S.amod = 4; S.astep = 512;
          pg8::EpiGates E{(float*)(a.ws + WS_SCR + SC_LA), (float*)(a.ws + WS_SCR + SC_LIX), a.in[20], a.in[22], a.in[23], (const bf16*)(a.ws + WS_SCR + SC_XR)}; run_gemm(F, g, S, E); }
#endif
    }
    SEAM(3);
    if (IN(4)) ph_even_scan(F, a);
    SEAM(4);
    if (IN(5)) { pg8::Gemm g{YMIX, (const bf16*)(a.ws + WS_WEVOUT), DM, DM, DM}; pg8::StaticOrder S; S.init(MP, DM, F.G, (int)blockIdx.x); pg8::EpiResid E{H, a.in[0], a.in[1], 0}; run_gemm(F, g, S, E); }
    SEAM(5);
    if (IN(6)) ph_route(F, a, 0);
    SEAM(6);
    if (IN(7)) ph_gather(F, a, 0);
    SEAM(7);
    if (IN(8)) ph_moe_up(F, a);
    SEAM(8);
    if (IN(9)) ph_moe_down(F, a);
    SEAM(9);
    if (IN(10)) { ph_combine(F, a, 0); moe_convert(F, a, 1); }
    SEAM(10);
    if (IN(11)) { pg8::Gemm g{HN, (const bf16*)(a.ws + WS_WODIN), DM, DM, DM}; pg8::StaticOrder S; S.init(MP, OD_NP, F.G, (int)blockIdx.x); pg8::EpiBf16 E{PROJ, OD_NP}; run_gemm(F, g, S, E); }
    SEAM(11);
    if (IN(12)) ph_odd_prep(F, a);
    SEAM(12);
    if (IN(13)) { if (F.gw < 64) gdn_scan_simple(F, a, F.gw >> 1, F.gw & 1); }
    SEAM(13);
    if (IN(14)) ph_odd_post(F, a);
    SEAM(14);
    if (IN(15)) { pg8::Gemm g{YMIX, (const bf16*)(a.ws + WS_WODOUT), 4096, 4096, 4096}; pg8::StaticOrder S; S.init(MP, DM, F.G, (int)blockIdx.x); pg8::EpiResid E{H, a.in[0], a.in[1], 1}; run_gemm(F, g, S, E); }
    SEAM(15);
    if (IN(16)) ph_route(F, a, 1);
    SEAM(16);
    if (IN(17)) ph_gather(F, a, 1);
    SEAM(17);
    if (IN(18)) ph_moe_up(F, a);
    SEAM(18);
    if (IN(19)) ph_moe_down(F, a);
    SEAM(19);
    if (IN(20)) ph_combine(F, a, 1);
#undef IN
#undef SEAM
}

extern "C" void kernel_launch(void* const* d_in, const int* in_sizes, int n_in, void* d_out, int out_size, void* d_ws, size_t ws_size, hipStream_t stream) {
    static int grid = 0;
    if (grid == 0) {
        if (n_in != 36 || out_size != TX * DM || ws_size < WS_END) { fprintf(stderr, "kernel_launch: unexpected shapes (n_in %d, out %d, ws %zu)\n", n_in, out_size, ws_size); grid = -1; return; }
        int dev = 0, cus = 0, per_cu = 0;
        if (hipGetDevice(&dev) != hipSuccess || hipDeviceGetAttribute(&cus, hipDeviceAttributeMultiprocessorCount, dev) != hipSuccess) { grid = -1; return; }
        if (hipFuncSetAttribute((const void*)hyb_fwd, hipFuncAttributeMaxDynamicSharedMemorySize, LDS_BYTES) != hipSuccess) { fprintf(stderr, "kernel_launch: hipFuncSetAttribute failed\n"); grid = -1; return; }
        if (hipOccupancyMaxActiveBlocksPerMultiprocessor(&per_cu, (const void*)hyb_fwd, NWAVES * 64, LDS_BYTES) != hipSuccess || per_cu < 1) { fprintf(stderr, "kernel_launch: occupancy query says %d\n", per_cu); per_cu = 1; }
        (void)hipGetLastError();
        grid = cus;
    }
    if (grid < 0) return;
    if (hipMemsetAsync((char*)d_ws + WS_CTL, 0, CTL_ZERO_BYTES, stream) != hipSuccess) return;
    Args a{};
    for (int i = 0; i < 36; ++i) a.in[i] = (const float*)d_in[i];
    a.out = (float*)d_out; a.ws = (unsigned char*)d_ws;
#if MK_ONE_LAUNCH
    a.ph_lo = 0; a.ph_hi = N_PHASES;
    hipLaunchKernelGGL(hyb_fwd, dim3(grid), dim3(NWAVES * 64), LDS_BYTES, stream, a);
#else
    for (int p = 0; p < N_PHASES; ++p) { a.ph_lo = p; a.ph_hi = p + 1; hipLaunchKernelGGL(hyb_fwd, dim3(grid), dim3(NWAVES * 64), LDS_BYTES, stream, a); }
#endif
}
```

```cpp
#include <hip/hip_runtime.h>
#include <cstdio>
#include <cstdint>
#include <cmath>

#ifndef MK_ONE_LAUNCH
#define MK_ONE_LAUNCH 1
#endif

namespace pg8 {
#define PG8_LAS __attribute__((address_space(3)))
typedef unsigned short bf16_t;
typedef short bf16x8 __attribute__((ext_vector_type(8)));
typedef float f32x4 __attribute__((ext_vector_type(4)));
typedef unsigned u32x4 __attribute__((ext_vector_type(4)));
typedef unsigned u32x2 __attribute__((ext_vector_type(2)));
constexpr int BM = 256, BK = 64, HALF = 128, HTB = HALF * BK * 2  , STAGE_BYTES = 8 * HTB, NXCD = 8, WGM = 8;

__host__ __device__ __forceinline__ int lds_byte(int r, int c) { const int st = (r >> 4) * 2 + (c >> 5), rr = r & 15, cc = c & 31, ob = rr * 64 + cc * 2; return st * 1024 + (ob ^ (((ob >> 9) & 1) << 5)); }
__host__ __device__ __forceinline__ void stage_rc(int b, int& R, int& C) { const int st = b / 1024, sb = b % 1024, swz = sb ^ (((sb >> 9) & 1) << 5); R = (st >> 1) * 16 + swz / 64; C = (st & 1) * 32 + (swz % 64) / 2; }
__host__ __device__ __forceinline__ int perm32(int rho) { const int n = rho >> 4, i = rho & 15; return 8 * (i >> 2) + 4 * n + (i & 3); }

struct Unit { int pm, pn; long aoff, boff; };
struct Gemm { const bf16_t* A; const bf16_t* Bt; int K, lda, ldb; };

struct StaticOrder {
    int nM, nN, nwg, G, c, amod; long astep;
    __host__ __device__ void init(int M, int N, int G_, int c_) { nM = M / BM; nN = N / BM; nwg = nM * nN; G = G_; c = c_; amod = 0; astep = 0; }
    __host__ __device__ bool next(int i, Unit& u) const {
        const long L = (long)i * G + c; if (L >= nwg) return false;
        int wgid = (int)L; { const int q = nwg / NXCD, r = nwg % NXCD, xcd = wgid % NXCD, off = wgid / NXCD; wgid = (xcd < r ? xcd * (q + 1) : r * (q + 1) + (xcd - r) * q) + off; }
        const int nig = WGM * nN, gid = wgid / nig, fm = gid * WGM, gsz = (nM - fm) < WGM ? (nM - fm) : WGM;
        u.pm = fm + ((wgid % nig) % gsz); u.pn = (wgid % nig) / gsz; u.boff = 0; u.aoff = amod ? (long)(u.pn % amod) * astep : 0; return true;
    }
    __device__ __forceinline__ void a_ready(const Unit&) const {}
    __device__ __forceinline__ void done(const Unit&) const {}
};
struct MoeOrder {
    const int* tile_e; int ntiles, npn, G, c; long bstride;
    __device__ __forceinline__ bool next(int i, Unit& u) const {
        const long L = (long)i * G + c; if (L >= (long)ntiles * npn) return false;
        const int t = (int)(L / npn); u.pm = t; u.pn = (int)(L % npn); u.aoff = 0; u.boff = (long)tile_e[t] * bstride; return true;
    }
    __device__ __forceinline__ void a_ready(const Unit&) const {}
    __device__ __forceinline__ void done(const Unit&) const {}
};

__device__ __forceinline__ unsigned cvt_pk_bf16(float lo, float hi) { unsigned r; asm volatile("v_cvt_pk_bf16_f32 %0, %1, %2" : "=v"(r) : "v"(lo), "v"(hi)); return r; }
__device__ __forceinline__ float bf_lo(unsigned w) { return __uint_as_float(w << 16); }
__device__ __forceinline__ float bf_hi(unsigned w) { return __uint_as_float(w & 0xffff0000u); }
__device__ __forceinline__ float sigmoidf_(float x) { return 1.0f / (1.0f + __expf(-x)); }
__device__ __forceinline__ float softplusf_(float x) { return fmaxf(x, 0.f) + __logf(1.0f + __expf(-fabsf(x))); }

struct EpiBf16 {
    static constexpr bool PERM = true, AFTER_DRAIN = false;
    bf16_t* O; int ldc;
    __device__ __forceinline__ void operator()(const f32x4 (&acc)[2][2][4][2], const Unit& u, int wr, int wc, int fr, int fq) const {
        const int row0 = u.pm * BM + wr * 64 + fr; const int col0 = u.pn * BM + wc * 32 + 8 * fq;
#pragma unroll
        for (int ai = 0; ai < 2; ++ai)
#pragma unroll
            for (int m = 0; m < 4; ++m) { bf16_t* rowp = O + (size_t)(row0 + ai * HALF + m * 16) * ldc + col0;
#pragma unroll
                for (int bj = 0; bj < 2; ++bj) { const f32x4 v0 = acc[ai][bj][m][0], v1 = acc[ai][bj][m][1];
                    u32x4 w; w.x = cvt_pk_bf16(v0[0], v0[1]); w.y = cvt_pk_bf16(v0[2], v0[3]); w.z = cvt_pk_bf16(v1[0], v1[1]); w.w = cvt_pk_bf16(v1[2], v1[3]);
                    *(u32x4*)(rowp + bj * HALF) = w; } }
    }
};
struct EpiSwiglu {
    static constexpr bool PERM = true, AFTER_DRAIN = false;
    bf16_t* O; int ldc;
    __device__ __forceinline__ void operator()(const f32x4 (&acc)[2][2][4][2], const Unit& u, int wr, int wc, int fr, int fq) const {
        const int row0 = u.pm * BM + wr * 64 + fr; const int col0 = u.pn * HALF + wc * 32 + 8 * fq;
#pragma unroll
        for (int ai = 0; ai < 2; ++ai)
#pragma unroll
            for (int m = 0; m < 4; ++m) { bf16_t* rowp = O + (size_t)(row0 + ai * HALF + m * 16) * ldc + col0;
                float o[8];
#pragma unroll
                for (int n = 0; n < 2; ++n)
#pragma unroll
                    for (int j = 0; j < 4; ++j) { const float gq = acc[ai][0][m][n][j], uq = acc[ai][1][m][n][j]; o[4 * n + j] = gq * sigmoidf_(gq) * uq; }
                u32x4 w; w.x = cvt_pk_bf16(o[0], o[1]); w.y = cvt_pk_bf16(o[2], o[3]); w.z = cvt_pk_bf16(o[4], o[5]); w.w = cvt_pk_bf16(o[6], o[7]);
                *(u32x4*)rowp = w; }
    }
};
struct EpiResid {
    static constexpr bool PERM = false, AFTER_DRAIN = false;
    float* out; const float* x; const float* meta; int mode;
    __device__ __forceinline__ void operator()(const f32x4 (&acc)[2][2][4][2], const Unit& u, int wr, int wc, int fr, int fq) const {
        const int row0 = u.pm * BM + wr * 64 + fr, col0 = u.pn * BM + wc * 32 + 4 * fq;
#pragma unroll
        for (int ai = 0; ai < 2; ++ai)
#pragma unroll
            for (int m = 0; m < 4; ++m) { const int row = row0 + ai * HALF + m * 16; float* rowp = out + (size_t)row * 2048 + col0;
                const float* bp = mode ? rowp : (row < 8192 ? x + (size_t)row * 2048 + col0 : (row < 8208 ? meta + (size_t)(row - 8192) * 2048 + col0 : nullptr));
#pragma unroll
                for (int bj = 0; bj < 2; ++bj)
#pragma unroll
                    for (int n = 0; n < 2; ++n) { f32x4 b = (f32x4){0.f, 0.f, 0.f, 0.f}; if (bp) b = *(const f32x4*)(bp + bj * HALF + n * 16);
                        *(f32x4*)(rowp + bj * HALF + n * 16) = acc[ai][bj][m][n] + b; } }
    }
};
struct EpiLora {
    static constexpr bool PERM = false, AFTER_DRAIN = false;
    float* base; long gstride; const float* w0; const float* a0;
    __device__ __forceinline__ void operator()(const f32x4 (&acc)[2][2][4][2], const Unit& u, int wr, int wc, int fr, int fq) const {
        const int grp = u.pn >> 2; const int row0 = u.pm * BM + wr * 64 + fr, col0 = (u.pn & 3) * BM + wc * 32 + 4 * fq;
        float* O = base + (size_t)grp * gstride;
#pragma unroll
        for (int bj = 0; bj < 2; ++bj)
#pragma unroll
            for (int n = 0; n < 2; ++n) { const int c = col0 + bj * HALF + n * 16;
                f32x4 bv = (f32x4){0.f, 0.f, 0.f, 0.f}; if (grp == 0) bv = *(const f32x4*)(w0 + c); else if (grp == 1) bv = *(const f32x4*)(a0 + c);
#pragma unroll
                for (int ai = 0; ai < 2; ++ai)
#pragma unroll
                    for (int m = 0; m < 4; ++m) { f32x4 v = acc[ai][bj][m][n] + bv;
                        if (grp == 0) {
#pragma unroll
                            for (int j = 0; j < 4; ++j) { const float wl = -softplusf_(-v[j]) - 0.5f; v[j] = __expf(-__expf(wl)); }
                        } else if (grp == 1) {
#pragma unroll
                            for (int j = 0; j < 4; ++j) v[j] = sigmoidf_(v[j]);
                        }
                        *(f32x4*)(O + (size_t)(row0 + ai * HALF + m * 16) * 1024 + c) = v; } }
    }
};
struct EpiGates {
    static constexpr bool PERM = false, AFTER_DRAIN = false;
    float* lru_a; float* lru_ix; const float* ba; const float* bx; const float* lam; const bf16_t* xr;
    __device__ __forceinline__ void operator()(const f32x4 (&acc)[2][2][4][2], const Unit& u, int wr, int wc, int fr, int fq) const {
        const int grp = u.pn >> 2; const int row0 = u.pm * BM + wr * 64 + fr, col0 = (u.pn & 3) * BM + wc * 32 + 4 * fq;
#pragma unroll
        for (int bj = 0; bj < 2; ++bj)
#pragma unroll
            for (int n = 0; n < 2; ++n) { const int c = col0 + bj * HALF + n * 16;
                const f32x4 bv = *(const f32x4*)((grp == 0 ? ba : bx) + c); f32x4 sp = (f32x4){0.f, 0.f, 0.f, 0.f};
                if (grp == 0) { const f32x4 l = *(const f32x4*)(lam + c);
#pragma unroll
                    for (int j = 0; j < 4; ++j) sp[j] = -8.0f * softplusf_(-l[j]); }
#pragma unroll
                for (int ai = 0; ai < 2; ++ai)
#pragma unroll
                    for (int m = 0; m < 4; ++m) { const int row = row0 + ai * HALF + m * 16; f32x4 v = acc[ai][bj][m][n] + bv;
                        if (grp == 0) {
#pragma unroll
                            for (int j = 0; j < 4; ++j) v[j] = __expf(sigmoidf_(v[j]) * sp[j]);
                            *(f32x4*)(lru_a + (size_t)row * 1024 + c) = v;
                        } else { const u32x2 xw = *(const u32x2*)(xr + (size_t)row * 1024 + c);
                            v[0] = sigmoidf_(v[0]) * bf_lo(xw.x); v[1] = sigmoidf_(v[1]) * bf_hi(xw.x); v[2] = sigmoidf_(v[2]) * bf_lo(xw.y); v[3] = sigmoidf_(v[3]) * bf_hi(xw.y);
                            *(f32x4*)(lru_ix + (size_t)row * 1024 + c) = v; } } }
    }
};

template <class Epi, class Sched, bool ALIGN_EPI = false, bool SP2 = false>
__device__ __forceinline__ void gemm_phase(PG8_LAS unsigned char* lds, const Gemm g, const Sched& S, const Epi& E) {
    const int tid = threadIdx.x, wid = __builtin_amdgcn_readfirstlane(tid >> 6), lane = tid & 63, wr = wid >> 2, wc = wid & 3, fr = lane & 15, fq = lane >> 4;
    const int K = g.K, nt = K / BK;
    unsigned voffA[2], voffB[2];
#pragma unroll
    for (int i = 0; i < 2; ++i) { int R, C; stage_rc(tid * 16 + i * 8192, R, C); const int Rb = Epi::PERM ? ((R & ~31) + perm32(R & 31)) : R;
        voffA[i] = (unsigned)(R * g.lda + C) * 2u; voffB[i] = (unsigned)(Rb * g.ldb + C) * 2u; }
    const size_t kstep = (size_t)(BK * 2);
    const size_t hstepA = (size_t)HALF * g.lda * 2, hstepB = (size_t)HALF * g.ldb * 2;
    const size_t tstepA = 2 * hstepA, tstepB = 2 * hstepB;
    const unsigned ldsw = (unsigned)wid * 1024u;
    const int aoff = lds_byte(wr * 64 + fr, fq * 8), boff = lds_byte(wc * 32 + fr, fq * 8);
#define PG8_SA(b, h) (((b) * 2 + (h)) * HTB)
#define PG8_SB(b, h) ((4 + (b) * 2 + (h)) * HTB)
#define PG8_STAGE(bufoff, gbase, voff) do { _Pragma("unroll") for (int _i = 0; _i < 2; ++_i) \
        __builtin_amdgcn_global_load_lds((const unsigned*)((const char*)(gbase) + (voff)[_i]), (PG8_LAS unsigned*)(lds + (bufoff) + ldsw + _i * 8192), 16, 0, 0); } while (0)
#define PG8_LDA(dst, b, h) do { _Pragma("unroll") for (int m = 0; m < 4; ++m) _Pragma("unroll") for (int k = 0; k < 2; ++k) dst[m][k] = *(const PG8_LAS bf16x8*)(lds + PG8_SA(b, h) + aoff + m * 2048 + k * 1024); } while (0)
#define PG8_LDB(dst, b, h) do { _Pragma("unroll") for (int n = 0; n < 2; ++n) _Pragma("unroll") for (int k = 0; k < 2; ++k) dst[n][k] = *(const PG8_LAS bf16x8*)(lds + PG8_SB(b, h) + boff + n * 2048 + k * 1024); } while (0)
#define PG8_MMA(ai, bj, At, Bt) do { __builtin_amdgcn_s_setprio(1); _Pragma("unroll") for (int m = 0; m < 4; ++m) _Pragma("unroll") for (int n = 0; n < 2; ++n) _Pragma("unroll") for (int k = 0; k < 2; ++k) \
        acc[ai][bj][m][n] = __builtin_amdgcn_mfma_f32_16x16x32_bf16(Bt[n][k], At[m][k], acc[ai][bj][m][n], 0, 0, 0); __builtin_amdgcn_s_setprio(0); } while (0)
#define PG8_WAIT_V(n) asm volatile("s_waitcnt vmcnt(" #n ")" ::: "memory")
#define PG8_WAIT_L(n) asm volatile("s_waitcnt lgkmcnt(" #n ")" ::: "memory")
#define PG8_BAR __builtin_amdgcn_s_barrier()
#define PG8_SCHED __builtin_amdgcn_sched_barrier(0)
    Unit cur, nxt; int ui = 0;
    if (!S.next(0, cur)) return;
    f32x4 acc[2][2][4][2];
#pragma unroll
    for (int a = 0; a < 2; ++a)
#pragma unroll
        for (int b = 0; b < 2; ++b)
#pragma unroll
            for (int m = 0; m < 4; ++m)
#pragma unroll
                for (int n = 0; n < 2; ++n) acc[a][b][m][n] = (f32x4){0.f, 0.f, 0.f, 0.f};
    bf16x8 At[4][2], B0[2][2], B1[2][2];
    const char* cA = (const char*)g.A + (size_t)cur.pm * tstepA + cur.aoff; const char* cB = (const char*)g.Bt + (size_t)cur.pn * tstepB + cur.boff;
    S.a_ready(cur);
    if constexpr (SP2) {
        PG8_STAGE(PG8_SB(0, 0), cB, voffB); PG8_STAGE(PG8_SB(0, 1), cB + hstepB, voffB); PG8_STAGE(PG8_SA(0, 0), cA, voffA); PG8_STAGE(PG8_SA(0, 1), cA + hstepA, voffA);
        if (wr == 1) PG8_BAR;
        PG8_WAIT_V(2); PG8_BAR;
        PG8_STAGE(PG8_SB(1, 0), cB + kstep, voffB); PG8_STAGE(PG8_SA(1, 0), cA + kstep, voffA); PG8_STAGE(PG8_SB(1, 1), cB + hstepB + kstep, voffB);
        PG8_WAIT_V(6); PG8_BAR;
    } else {
        PG8_STAGE(PG8_SB(0, 0), cB, voffB); PG8_STAGE(PG8_SA(0, 0), cA, voffA); PG8_STAGE(PG8_SB(0, 1), cB + hstepB, voffB); PG8_STAGE(PG8_SA(0, 1), cA + hstepA, voffA);
        if (wr == 1) PG8_BAR;
        PG8_WAIT_V(4); PG8_BAR;
        PG8_STAGE(PG8_SB(1, 0), cB + kstep, voffB); PG8_STAGE(PG8_SA(1, 0), cA + kstep, voffA); PG8_STAGE(PG8_SB(1, 1), cB + hstepB + kstep, voffB);
        PG8_WAIT_V(6); PG8_BAR;
    }
    for (;;) {
        const bool has_next = S.next(ui + 1, nxt);
        const char* nA = has_next ? (const char*)g.A + (size_t)nxt.pm * tstepA + nxt.aoff : cA; const char* nB = has_next ? (const char*)g.Bt + (size_t)nxt.pn * tstepB + nxt.boff : cB;
        for (int t = 0; t < nt; t += 2) {
            const bool last = (t == nt - 2);
            const char* a1 = cA + (size_t)(t + 1) * kstep;
            const char* a2 = last ? nA : cA + (size_t)(t + 2) * kstep; const char* b2 = last ? nB : cB + (size_t)(t + 2) * kstep;
            const char* a3 = a2 + kstep; const char* b3 = b2 + kstep;
            if (last && has_next) S.a_ready(nxt);
            if constexpr (SP2) {
            PG8_LDB(B0, 0, 0); PG8_LDB(B1, 0, 1); PG8_SCHED; PG8_LDA(At, 0, 0); PG8_STAGE(PG8_SA(1, 1), a1 + hstepA, voffA);
            PG8_WAIT_V(8); PG8_WAIT_L(0); PG8_BAR; PG8_MMA(0, 0, At, B0); PG8_MMA(0, 1, At, B1); PG8_BAR; PG8_SCHED;
            PG8_LDA(At, 0, 1); PG8_STAGE(PG8_SB(0, 0), b2, voffB); PG8_STAGE(PG8_SB(0, 1), b2 + hstepB, voffB); PG8_STAGE(PG8_SA(0, 0), a2, voffA);
            PG8_WAIT_V(8); PG8_WAIT_L(0); PG8_BAR; PG8_MMA(1, 0, At, B0); PG8_MMA(1, 1, At, B1); PG8_BAR; PG8_SCHED;
            PG8_LDB(B0, 1, 0); PG8_LDB(B1, 1, 1); PG8_SCHED; PG8_LDA(At, 1, 0); PG8_STAGE(PG8_SA(0, 1), a2 + hstepA, voffA);
            PG8_WAIT_V(8); PG8_WAIT_L(0); PG8_BAR; PG8_MMA(0, 0, At, B0); PG8_MMA(0, 1, At, B1); PG8_BAR; PG8_SCHED;
            PG8_LDA(At, 1, 1); PG8_STAGE(PG8_SB(1, 0), b3, voffB); PG8_STAGE(PG8_SB(1, 1), b3 + hstepB, voffB); PG8_STAGE(PG8_SA(1, 0), a3, voffA);
            PG8_WAIT_V(8); PG8_WAIT_L(0); PG8_BAR; PG8_MMA(1, 0, At, B0); PG8_MMA(1, 1, At, B1); PG8_BAR; PG8_SCHED;
            } else {
            PG8_LDB(B0, 0, 0); PG8_SCHED; PG8_LDA(At, 0, 0); PG8_STAGE(PG8_SA(1, 1), a1 + hstepA, voffA);
            PG8_WAIT_L(8); PG8_BAR; PG8_WAIT_L(0); PG8_MMA(0, 0, At, B0); PG8_BAR; PG8_SCHED;
            PG8_LDB(B1, 0, 1); PG8_STAGE(PG8_SB(0, 0), b2, voffB);
            PG8_BAR; PG8_WAIT_L(0); PG8_MMA(0, 1, At, B1); PG8_BAR;
            PG8_LDA(At, 0, 1); PG8_STAGE(PG8_SA(0, 0), a2, voffA);
            PG8_BAR; PG8_WAIT_L(0); PG8_MMA(1, 0, At, B0); PG8_BAR; PG8_SCHED;
            PG8_STAGE(PG8_SB(0, 1), b2 + hstepB, voffB);
            PG8_WAIT_V(6); PG8_BAR; PG8_MMA(1, 1, At, B1); PG8_BAR;
            PG8_LDB(B0, 1, 0); PG8_SCHED; PG8_LDA(At, 1, 0); PG8_STAGE(PG8_SA(0, 1), a2 + hstepA, voffA);
            PG8_WAIT_L(8); PG8_BAR; PG8_WAIT_L(0); PG8_MMA(0, 0, At, B0); PG8_BAR; PG8_SCHED;
            PG8_LDB(B1, 1, 1); PG8_STAGE(PG8_SB(1, 0), b3, voffB);
            PG8_BAR; PG8_WAIT_L(0); PG8_MMA(0, 1, At, B1); PG8_BAR;
            PG8_LDA(At, 1, 1); PG8_STAGE(PG8_SA(1, 0), a3, voffA);
            PG8_BAR; PG8_WAIT_L(0); PG8_MMA(1, 0, At, B0); PG8_BAR; PG8_SCHED;
            PG8_STAGE(PG8_SB(1, 1), b3 + hstepB, voffB);
            PG8_WAIT_V(6); PG8_BAR; PG8_MMA(1, 1, At, B1); PG8_BAR;
            }
        }
        if constexpr (ALIGN_EPI) { if (wr == 0) PG8_BAR; }
        if constexpr (!Epi::AFTER_DRAIN) { E(acc, cur, wr, wc, fr, fq); S.done(cur); }
        if (!has_next) break;
#pragma unroll
        for (int a = 0; a < 2; ++a)
#pragma unroll
            for (int b = 0; b < 2; ++b)
#pragma unroll
                for (int m = 0; m < 4; ++m)
#pragma unroll
                    for (int n = 0; n < 2; ++n) acc[a][b][m][n] = (f32x4){0.f, 0.f, 0.f, 0.f};
        cur = nxt; cA = nA; cB = nB; ++ui;
        if constexpr (ALIGN_EPI) { if (wr == 1) PG8_BAR; }
    }
    PG8_WAIT_V(0);
    if constexpr (!ALIGN_EPI) { if (wr == 0) PG8_BAR; }
    PG8_BAR;
    if constexpr (Epi::AFTER_DRAIN) { E.fused(acc, cur, wr, wc, fr, fq, lds, wid, lane); S.done(cur); }
#undef PG8_SA
#undef PG8_SB
#undef PG8_STAGE
#undef PG8_LDA
#undef PG8_LDB
#undef PG8_MMA
#undef PG8_WAIT_V
#undef PG8_WAIT_L
#undef PG8_BAR
#undef PG8_SCHED
}
}
#define GAS __attribute__((address_space(1)))
#define LAS __attribute__((address_space(3)))
typedef unsigned short bf16;
typedef unsigned v4u __attribute__((ext_vector_type(4)));
typedef float f32x4 __attribute__((ext_vector_type(4)));
typedef short bf16x8 __attribute__((ext_vector_type(8)));
typedef GAS unsigned gu32;
typedef GAS unsigned long long gu64;
#define RLX_AGENT __ATOMIC_RELAXED, __HIP_MEMORY_SCOPE_AGENT
#define LDS_WAIT() asm volatile("s_waitcnt lgkmcnt(0)" ::: "memory")
#define VM_WAIT() asm volatile("s_waitcnt vmcnt(0)" ::: "memory")
__device__ __forceinline__ unsigned long long rt() { return __builtin_amdgcn_s_memrealtime(); }
__device__ __forceinline__ unsigned f2bf(float f) { unsigned u = __builtin_bit_cast(unsigned, f); return (u + 0x7fffu + ((u >> 16) & 1u)) >> 16; }
__device__ __forceinline__ unsigned pk2(float lo, float hi) { return f2bf(lo) | (f2bf(hi) << 16); }

#define XB_TMO      128
#define XB_XCNT(j)  (256  + 64 * (j))
#define XB_XSUB(j)  (1280 + 64 * (j))
#define XB_XGEN(j)  (2304 + 64 * (j))
#define XB_TOP      3328
#define XB_TOPGEN   3392
#define XCD_BAR_WORDS 3456
#define XB_SPIN_CAP (1u << 18)

__device__ __forceinline__ unsigned xb_ld(unsigned* p)              { return __hip_atomic_load(p, __ATOMIC_RELAXED, __HIP_MEMORY_SCOPE_AGENT); }
__device__ __forceinline__ unsigned xb_add(unsigned* p, unsigned v) { return __hip_atomic_fetch_add(p, v, __ATOMIC_RELAXED, __HIP_MEMORY_SCOPE_AGENT); }
__device__ __forceinline__ unsigned xb_xcc_id() { return (unsigned)__builtin_amdgcn_s_getreg((3 << 11) | 20) & 0xFu; }
#define XB_SPIN(cond, bar) do { unsigned _sp = 0; while (cond) { __builtin_amdgcn_s_sleep(1); \
    if ((++_sp & 255u) == 0u) { if (xb_ld(&(bar)[XB_TMO])) break; if (_sp > XB_SPIN_CAP) { atomicAdd(&(bar)[XB_TMO], 1u); break; } } } } while (0)

struct XcdBarrier {
    unsigned* bar; unsigned x;
    volatile LAS unsigned* st;
};

__device__ __forceinline__ XcdBarrier xcd_barrier_post(unsigned* bar, volatile LAS unsigned* st) {
    XcdBarrier b; b.bar = bar; b.x = xb_xcc_id(); b.st = st;
    if (threadIdx.x == 0) (void)xb_add(&bar[XB_XCNT(b.x)], 1u);
    return b;
}
__device__ __forceinline__ void xcd_barrier_complete(unsigned* bar, unsigned x, unsigned& nloc, unsigned& nx) {
    const unsigned G = gridDim.x * gridDim.y * gridDim.z;
    unsigned sum, cnt, mine, sp = 0u;
    for (;;) {
        sum = 0u; cnt = 0u; mine = 0u;
#pragma unroll
        for (unsigned j = 0; j < 16; ++j) { const unsigned c = xb_ld(&bar[XB_XCNT(j)]); sum += c; cnt += (c > 0u) ? 1u : 0u; mine = (j == x) ? c : mine; }
        if (sum == G) break;
        __builtin_amdgcn_s_sleep(1);
        if ((++sp & 255u) == 0u) { if (xb_ld(&bar[XB_TMO])) break; if (sp > XB_SPIN_CAP) { atomicAdd(&bar[XB_TMO], 1u); break; } }
    }
    nloc = mine > 0u ? mine : 1u; nx = cnt > 0u ? cnt : 1u;
}

__device__ __forceinline__ void xcd_barrier(const XcdBarrier& b) {
    asm volatile("s_waitcnt vmcnt(0)" ::: "memory");
    __syncthreads();
    if (threadIdx.x == 0) {
        unsigned* bar = b.bar;
        __builtin_amdgcn_s_waitcnt(0);
        unsigned nloc = b.st[0], nx = b.st[1];
        if (nloc == 0u) { xcd_barrier_complete(bar, b.x, nloc, nx); b.st[0] = nloc; b.st[1] = nx; }
        const unsigned old = xb_add(&bar[XB_XSUB(b.x)], 1u);
        const unsigned gen = old / nloc;
        if (old + 1u == (gen + 1u) * nloc) {
            __builtin_amdgcn_fence(__ATOMIC_RELEASE, "agent");
            asm volatile("s_waitcnt vmcnt(0)" ::: "memory");
            const unsigned og = xb_add(&bar[XB_TOP], 1u);
            const unsigned tg = og / nx;
            if (og + 1u == (tg + 1u) * nx) xb_add(&bar[XB_TOPGEN], 1u);
            else XB_SPIN(xb_ld(&bar[XB_TOPGEN]) == tg, bar);
            __builtin_amdgcn_fence(__ATOMIC_ACQUIRE, "agent");
            xb_add(&bar[XB_XGEN(b.x)], 1u);
            asm volatile("s_waitcnt vmcnt(0)" ::: "memory");
        } else {
            XB_SPIN(xb_ld(&bar[XB_XGEN(b.x)]) == gen, bar);
            __builtin_amdgcn_fence(__ATOMIC_ACQUIRE, "agent");
            asm volatile("s_waitcnt vmcnt(0)" ::: "memory");
        }
    }
    __syncthreads();
}

constexpr int NWAVES = 8;
constexpr int DM = 2048, TX = 8192, NMETA = 16, TT = TX + NMETA, MP = 8448;
constexpr int EV_NP = 5632, EV_LORA0 = 3072, EV_GB = 3360, EV_REC = 4384;
constexpr int OD_NP = 12544, OD_Z = 8192, OD_B = 12288, OD_A = 12320;
constexpr int NEXP = 32, FF = 512, MOE_ROWS = 24576;
constexpr float NORM_EPS = 1e-6f;

constexpr size_t MiB = 1u << 20;
constexpr size_t WS_CTL = 0, CTL_ZERO_BYTES = 1 * MiB;
constexpr size_t WS_TOKINFO = 1 * MiB;
constexpr size_t WS_TILES = 1 * MiB + 512 * 1024;
constexpr size_t WS_WEVIN = 2 * MiB;
constexpr size_t WS_WEVOUT = 24 * MiB;
constexpr size_t WS_WODIN = 32 * MiB;
constexpr size_t WS_WODOUT = 81 * MiB;
constexpr size_t WS_WLORA = 97 * MiB;
constexpr size_t WS_WGATE = 100 * MiB;
constexpr size_t WS_MOEW = 102 * MiB;
constexpr size_t MOE_E_BYTES = 6 * MiB, MOE_W2_OFF = 4 * MiB;
constexpr size_t WS_H = 294 * MiB;
constexpr size_t WS_HN = 360 * MiB;
constexpr size_t WS_YMIX = 393 * MiB;
constexpr size_t WS_PROJ = 459 * MiB;
constexpr size_t WS_SCR = 662 * MiB;
constexpr size_t WS_END = 932 * MiB;
constexpr size_t SC_ALORA = 0;
constexpr size_t SC_XR = 8 * MiB;
constexpr size_t SC_DEC = 26 * MiB, SC_ICL = 60 * MiB, SC_GATE = 94 * MiB;
constexpr size_t SC_LA = 128 * MiB, SC_LIX = 162 * MiB;
constexpr size_t SC_QN = 0, SC_KN = 34 * MiB;
constexpr size_t SC_VC = 68 * MiB;
constexpr size_t SC_BETA = 134 * MiB, SC_G = 136 * MiB;
constexpr size_t SC_O = 138 * MiB;
constexpr size_t SC_XG = 0;
constexpr size_t SC_ACT = 96 * MiB;
constexpr size_t SC_YB = 120 * MiB;
static_assert(SC_O + (size_t)MP * 4096 * 4 <= WS_END - WS_SCR && SC_YB + (size_t)MOE_ROWS * 2048 * 2 <= WS_END - WS_SCR && SC_LIX + (size_t)MP * 1024 * 4 <= WS_END - WS_SCR, "scratch map");
constexpr int CW_TMO = 0, CW_CODE = 1;
constexpr int CW_BAR = 4096;
constexpr int CW_MOECNT = 16384;

constexpr int RING_OFF = 0, RING_BYTES = 131072;
constexpr int LDSCTL_OFF = 146944, MISC_OFF = LDSCTL_OFF + 320;
constexpr int LDS_BYTES = 147456;


#define DI __device__ __forceinline__
typedef unsigned v2u __attribute__((ext_vector_type(2)));
struct Args { const float* in[36]; float* out; unsigned char* ws; int ph_lo, ph_hi; };
struct Frame {
    LAS unsigned char* lds; volatile LAS unsigned* MISC; gu32* ctl;
    int tid, lane, wave, vcu, G, gw, NGW;
};
DI float bf2f(bf16 v) { return __uint_as_float((unsigned)v << 16); }
DI float bflo(unsigned w) { return __uint_as_float(w << 16); }
DI float bfhi(unsigned w) { return __uint_as_float(w & 0xffff0000u); }
DI float wave_sum(float v) {
#pragma unroll
    for (int o = 1; o < 64; o <<= 1) v += __shfl_xor(v, o);
    return v;
}
DI float sigm(float x) { return 1.0f / (1.0f + __expf(-x)); }
DI float softplus(float x) { return fmaxf(x, 0.f) + __logf(1.0f + __expf(-fabsf(x))); }
DI float gelu_tanh(float x) { const float u = 0.7978845608028654f * (x + 0.044715f * x * x * x); return 0.5f * x * (1.0f + tanhf(u)); }
DI int pos_row(int p) { return p < NMETA ? TX + p : p - NMETA; }
DI int row_pos(int r) { return r < TX ? r + NMETA : r - TX; }

DI void tr_item(const float* W, int N, int k0, int n0, bf16* WT, int ldk, int drow0, LAS float* scr, int lane) {
#pragma unroll 8
    for (int i = 0; i < 32; ++i) { const int kk = 2 * i + (lane >> 5); scr[kk * 33 + (lane & 31)] = W[(size_t)(k0 + kk) * N + n0 + (lane & 31)]; }
    LDS_WAIT(); asm volatile("" ::: "memory");
    const int c = lane & 7;
#pragma unroll
    for (int j = 0; j < 4; ++j) { const int n = (lane >> 3) + 8 * j; const LAS float* s = scr + (8 * c) * 33 + n;
        v4u o; o.x = pk2(s[0 * 33], s[1 * 33]); o.y = pk2(s[2 * 33], s[3 * 33]); o.z = pk2(s[4 * 33], s[5 * 33]); o.w = pk2(s[6 * 33], s[7 * 33]);
        *(v4u*)(WT + (size_t)(drow0 + n) * ldk + k0 + 8 * c) = o; }
    LDS_WAIT(); asm volatile("" ::: "memory");
}
DI void moe_convert(const Frame& F, const Args& a, int l) {
    LAS float* scr = (LAS float*)(F.lds + RING_OFF + F.wave * 16384);
    bf16* base = (bf16*)(a.ws + WS_MOEW);
    for (int it = F.gw; it < NEXP * 1536; it += F.NGW) {
        const int e = it / 1536; int j = it % 1536; bf16* eb = base + (size_t)e * (MOE_E_BYTES / 2);
        const size_t eoff = (size_t)(l * NEXP + e) * DM * FF;
        if (j < 1024) { const float* W = (j < 512 ? a.in[33] : a.in[34]) + eoff; const int hi = j >= 512; j &= 511; const int kb = j >> 4, nb = j & 15, n0 = 32 * nb;
            tr_item(W, FF, 64 * kb, n0, eb, DM, 256 * (n0 >> 7) + 128 * hi + (n0 & 127), scr, F.lane); }
        else { j -= 1024; const int kb = j >> 6, nb = j & 63; tr_item(a.in[35] + eoff, DM, 64 * kb, 32 * nb, eb + MOE_W2_OFF / 2, FF, 32 * nb, scr, F.lane); }
    }
}
DI void norm_row_bf16(int lane, const float* src, const float* w, bf16* dst) {
    f32x4 v[8]; float s = 0.f;
#pragma unroll
    for (int j = 0; j < 8; ++j) { v[j] = ((const f32x4*)src)[lane + 64 * j]; s += (v[j].x * v[j].x + v[j].y * v[j].y) + (v[j].z * v[j].z + v[j].w * v[j].w); }
    const float rs = 1.0f / sqrtf(wave_sum(s) * (1.0f / DM) + NORM_EPS);
#pragma unroll
    for (int j = 0; j < 8; ++j) { const f32x4 wv = ((const f32x4*)w)[lane + 64 * j]; v2u o; o.x = pk2(v[j].x * rs * wv.x, v[j].y * rs * wv.y); o.y = pk2(v[j].z * rs * wv.z, v[j].w * rs * wv.w);
        ((v2u*)dst)[lane + 64 * j] = o; }
}

DI void ph_prologue(const Frame& F, const Args& a) {
    LAS float* scr = (LAS float*)(F.lds + RING_OFF + F.wave * 16384);
    constexpr int I_A = 32 * 169, I_B = 32 * 64, I_C = 32 * 386, I_D = 64 * 64, NIT = I_A + I_B + I_C + I_D;
    for (int it = F.gw; it < NIT; it += F.NGW) {
        int r = it;
        if (r < I_A) { const int kb = r / 169, nb = r % 169; tr_item(a.in[5], 5408, 64 * kb, 32 * nb, (bf16*)(a.ws + WS_WEVIN), DM, 32 * nb, scr, F.lane); continue; } r -= I_A;
        if (r < I_B) { const int kb = r / 64, nb = r % 64; tr_item(a.in[24], DM, 64 * kb, 32 * nb, (bf16*)(a.ws + WS_WEVOUT), DM, 32 * nb, scr, F.lane); continue; } r -= I_B;
        if (r < I_C) { const int kb = r / 386, nb = r % 386; tr_item(a.in[25], 12352, 64 * kb, 32 * nb, (bf16*)(a.ws + WS_WODIN), DM, 32 * nb, scr, F.lane); continue; } r -= I_C;
        { const int kb = r / 64, nb = r % 64; tr_item(a.in[30], DM, 64 * kb, 32 * nb, (bf16*)(a.ws + WS_WODOUT), 4096, 32 * nb, scr, F.lane); }
    }
    moe_convert(F, a, 0);
    const int gt = F.vcu * (NWAVES * 64) + F.tid, NGT = F.G * NWAVES * 64;
    { bf16* WL = (bf16*)(a.ws + WS_WLORA); const float* wup = a.in[8]; const float* aup = a.in[10]; const float* gup = a.in[11];
      for (int idx = gt; idx < 3072 * 384; idx += NGT) { const int n = idx / 384, k = idx % 384; float v = 0.f;
          if (n < 1024) { if (k < 64) v = wup[k * 1024 + n]; }
          else if (n < 2048) { if (k >= 64 && k < 128) v = aup[(k - 64) * 1024 + n - 1024]; }
          else { if (k >= 128 && k < 288) v = gup[(k - 128) * 1024 + n - 2048]; }
          WL[idx] = (bf16)f2bf(v); } }
    { bf16* WG = (bf16*)(a.ws + WS_WGATE);
      for (int idx = gt; idx < 2048 * 256; idx += NGT) { const int n = idx >> 8, kk = idx & 255, nn = n & 1023, blk = nn >> 6, j = nn & 63, cin = (nn & ~255) + kk;
          const float* W = n < 1024 ? a.in[19] : a.in[21];
          const float v = (cin >> 6) == blk ? W[blk * 4096 + (cin & 63) * 64 + j] : 0.f;
          WG[idx] = (bf16)f2bf(v); } }
    bf16* HN = (bf16*)(a.ws + WS_HN);
    for (int r = F.gw; r < TT; r += F.NGW) norm_row_bf16(F.lane, r < TX ? a.in[0] + (size_t)r * DM : a.in[1] + (size_t)(r - TX) * DM, a.in[2], HN + (size_t)r * DM);
}

DI void ph_even_prep(const Frame& F, const Args& a) {
    const bf16* P = (const bf16*)(a.ws + WS_PROJ); bf16* AL = (bf16*)(a.ws + WS_SCR + SC_ALORA); bf16* XR = (bf16*)(a.ws + WS_SCR + SC_XR);
    const float* mu = a.in[6]; const float* cw = a.in[17]; const float* cb = a.in[18];
    const int lane = F.lane;
    for (int r = F.gw; r < TT; r += F.NGW) {
        const int pos = row_pos(r); const bf16* cur = P + (size_t)r * EV_NP; const bf16* prv = pos > 0 ? P + (size_t)pos_row(pos - 1) * EV_NP : nullptr;
#pragma unroll
        for (int i = 0; i < 6; ++i) { const int idx = lane + 64 * i; float v = 0.f;
            if (idx < 288) { const int col = EV_LORA0 + idx; const float c = bf2f(cur[col]), p = prv ? bf2f(prv[col]) : 0.f; v = c + (p - c) * mu[col];
                if (idx < 64) v = tanhf(v); else if (idx >= 128) v = sigm(v); }
            AL[(size_t)r * 384 + idx] = (bf16)f2bf(v); }
        const int c0 = lane * 16; float acc[16];
#pragma unroll
        for (int i = 0; i < 4; ++i) { const f32x4 b = *(const f32x4*)(cb + c0 + 4 * i); acc[4 * i] = b.x; acc[4 * i + 1] = b.y; acc[4 * i + 2] = b.z; acc[4 * i + 3] = b.w; }
#pragma unroll
        for (int j = 0; j < 4; ++j) { const int pj = pos - 3 + j; if (pj < 0) continue;
            const bf16* src = P + (size_t)pos_row(pj) * EV_NP + EV_REC + c0; const v4u x0 = *(const v4u*)src, x1 = *(const v4u*)(src + 8);
            const unsigned xw[8] = {x0.x, x0.y, x0.z, x0.w, x1.x, x1.y, x1.z, x1.w};
#pragma unroll
            for (int i = 0; i < 4; ++i) { const f32x4 w = *(const f32x4*)(cw + j * 1024 + c0 + 4 * i);
                acc[4 * i] += w.x * bflo(xw[2 * i]); acc[4 * i + 1] += w.y * bfhi(xw[2 * i]); acc[4 * i + 2] += w.z * bflo(xw[2 * i + 1]); acc[4 * i + 3] += w.w * bfhi(xw[2 * i + 1]); } }
        v4u o0, o1; o0.x = pk2(acc[0], acc[1]); o0.y = pk2(acc[2], acc[3]); o0.z = pk2(acc[4], acc[5]); o0.w = pk2(acc[6], acc[7]);
        o1.x = pk2(acc[8], acc[9]); o1.y = pk2(acc[10], acc[11]); o1.z = pk2(acc[12], acc[13]); o1.w = pk2(acc[14], acc[15]);
        bf16* dst = XR + (size_t)r * 1024 + c0; *(v4u*)dst = o0; *(v4u*)(dst + 8) = o1;
    }
}

DI void ph_route(const Frame& F, const Args& a, int l) {
    const float* H = (const float*)(a.ws + WS_H); const float* nw = a.in[3] + (size_t)l * DM;
    const float* RG = a.in[31] + (size_t)l * DM * 4; const float* RE = a.in[32] + (size_t)l * DM * NEXP;
    unsigned* TI = (unsigned*)(a.ws + WS_TOKINFO); const int lane = F.lane;
    for (int r = F.gw; r < TT; r += F.NGW) {
        const float* hr = H + (size_t)r * DM; float s = 0.f;
#pragma unroll
        for (int j = 0; j < 8; ++j) { const f32x4 v = ((const f32x4*)hr)[lane + 64 * j]; s += (v.x * v.x + v.y * v.y) + (v.z * v.z + v.w * v.w); }
        const float rs = 1.0f / sqrtf(wave_sum(s) * (1.0f / DM) + NORM_EPS);
        float acc[36];
#pragma unroll
        for (int i = 0; i < 36; ++i) acc[i] = 0.f;
#pragma unroll 1
        for (int j = 0; j < 8; ++j) { const f32x4 v = ((const f32x4*)hr)[lane + 64 * j]; const f32x4 wv = ((const f32x4*)nw)[lane + 64 * j]; const float xn[4] = {v.x * rs * wv.x, v.y * rs * wv.y, v.z * rs * wv.z, v.w * rs * wv.w};
#pragma unroll
            for (int q = 0; q < 4; ++q) { const int k = (lane + 64 * j) * 4 + q; const f32x4* we = (const f32x4*)(RE + (size_t)k * NEXP);
#pragma unroll
                for (int t = 0; t < 8; ++t) { const f32x4 w = we[t]; acc[4 * t] += xn[q] * w.x; acc[4 * t + 1] += xn[q] * w.y; acc[4 * t + 2] += xn[q] * w.z; acc[4 * t + 3] += xn[q] * w.w; }
                const f32x4 wg = *(const f32x4*)(RG + (size_t)k * 4); acc[32] += xn[q] * wg.x; acc[33] += xn[q] * wg.y; acc[34] += xn[q] * wg.z; acc[35] += xn[q] * wg.w;
                asm volatile("" ::: "memory"); } }
#pragma unroll
        for (int i = 0; i < 36; ++i) acc[i] = wave_sum(acc[i]);
        int gi = 0; float gm = acc[32];
#pragma unroll
        for (int i = 1; i < 4; ++i) if (acc[32 + i] > gm) { gm = acc[32 + i]; gi = i; }
        float den = 0.f;
#pragma unroll
        for (int i = 0; i < 4; ++i) den += __expf(acc[32 + i] - gm);
        const float gp = 1.0f / den;
        float l8[8];
#pragma unroll
        for (int i = 0; i < 8; ++i) l8[i] = gi == 0 ? acc[i] : (gi == 1 ? acc[8 + i] : (gi == 2 ? acc[16 + i] : acc[24 + i]));
        int i1 = 0; float m1 = l8[0];
#pragma unroll
        for (int i = 1; i < 8; ++i) if (l8[i] > m1) { m1 = l8[i]; i1 = i; }
        int i2 = -1; float m2 = -INFINITY;
#pragma unroll
        for (int i = 0; i < 8; ++i) if (i != i1 && l8[i] > m2) { m2 = l8[i]; i2 = i; }
        const float e21 = __expf(m2 - m1); const float w1 = gp / (1.0f + e21), w2 = gp * e21 / (1.0f + e21);
        if (lane == 0) { const int ea = gi * 8 + i1, eb = gi * 8 + i2;
            const unsigned sa = atomicAdd((unsigned*)(F.ctl + CW_MOECNT + (l * NEXP + ea) * 16), 1u), sb = atomicAdd((unsigned*)(F.ctl + CW_MOECNT + (l * NEXP + eb) * 16), 1u);
            unsigned* t = TI + (size_t)r * 8; t[0] = ea; t[1] = sa; t[2] = __float_as_uint(w1); t[3] = eb; t[4] = sb; t[5] = __float_as_uint(w2); t[6] = __float_as_uint(rs); t[7] = 0u; }
    }
}
DI void moe_prefix(const Frame& F, int l, LAS int* ps) {
    if (F.tid == 0) { int t = 0;
        for (int e = 0; e < NEXP; ++e) { const unsigned c = __hip_atomic_load(F.ctl + CW_MOECNT + (l * NEXP + e) * 16, RLX_AGENT); ps[e] = t * 256; t += (int)((c + 255u) >> 8); }
        ps[32] = t; }
    __syncthreads();
}
DI void ph_gather(const Frame& F, const Args& a, int l) {
    LAS int* ps = (LAS int*)(F.lds + RING_OFF); moe_prefix(F, l, ps);
    if (F.vcu == 0 && F.tid < NEXP) { int* TE = (int*)(a.ws + WS_TILES); const int e = F.tid; const int t0 = ps[e] >> 8, t1 = (e == NEXP - 1 ? ps[32] : ps[e + 1] >> 8);
        for (int t = t0; t < t1; ++t) TE[t] = e; if (e == 0) TE[127] = ps[32]; }
    const float* H = (const float*)(a.ws + WS_H); const float* nw = a.in[3] + (size_t)l * DM; unsigned* TI = (unsigned*)(a.ws + WS_TOKINFO); bf16* XG = (bf16*)(a.ws + WS_SCR + SC_XG);
    const int lane = F.lane;
    for (int r = F.gw; r < TT; r += F.NGW) {
        unsigned* t = TI + (size_t)r * 8; const int g0 = ps[t[0]] + (int)t[1], g1 = ps[t[3]] + (int)t[4]; const float rs = __uint_as_float(t[6]);
        if (lane == 0) { t[1] = (unsigned)g0; t[4] = (unsigned)g1; }
        const float* hr = H + (size_t)r * DM;
#pragma unroll
        for (int j = 0; j < 4; ++j) { const int e0 = (lane + 64 * j) * 8; const f32x4 x0 = *(const f32x4*)(hr + e0), x1 = *(const f32x4*)(hr + e0 + 4), w0 = *(const f32x4*)(nw + e0), w1 = *(const f32x4*)(nw + e0 + 4);
            v4u o; o.x = pk2(x0.x * rs * w0.x, x0.y * rs * w0.y); o.y = pk2(x0.z * rs * w0.z, x0.w * rs * w0.w); o.z = pk2(x1.x * rs * w1.x, x1.y * rs * w1.y); o.w = pk2(x1.z * rs * w1.z, x1.w * rs * w1.w);
            *(v4u*)(XG + (size_t)g0 * DM + e0) = o; *(v4u*)(XG + (size_t)g1 * DM + e0) = o; }
    }
}
DI void ph_combine(const Frame& F, const Args& a, int l) {
    float* H = (float*)(a.ws + WS_H); const unsigned* TI = (const unsigned*)(a.ws + WS_TOKINFO); const bf16* YB = (const bf16*)(a.ws + WS_SCR + SC_YB); bf16* HN = (bf16*)(a.ws + WS_HN);
    const int lane = F.lane; const int nrows = l == 0 ? TT : TX;
    for (int r = F.gw; r < nrows; r += F.NGW) {
        const unsigned* t = TI + (size_t)r * 8; const int g0 = (int)t[1], g1 = (int)t[4]; const float w0 = __uint_as_float(t[2]), w1 = __uint_as_float(t[5]);
        float* hr = H + (size_t)r * DM; float hv[32]; float s = 0.f;
#pragma unroll
        for (int j = 0; j < 4; ++j) { const int e0 = (lane + 64 * j) * 8; const f32x4 x0 = *(const f32x4*)(hr + e0), x1 = *(const f32x4*)(hr + e0 + 4);
            const v4u ya = *(const v4u*)(YB + (size_t)g0 * DM + e0), yc = *(const v4u*)(YB + (size_t)g1 * DM + e0);
            float* o = hv + 8 * j;
            o[0] = x0.x + w0 * bflo(ya.x) + w1 * bflo(yc.x); o[1] = x0.y + w0 * bfhi(ya.x) + w1 * bfhi(yc.x); o[2] = x0.z + w0 * bflo(ya.y) + w1 * bflo(yc.y); o[3] = x0.w + w0 * bfhi(ya.y) + w1 * bfhi(yc.y);
            o[4] = x1.x + w0 * bflo(ya.z) + w1 * bflo(yc.z); o[5] = x1.y + w0 * bfhi(ya.z) + w1 * bfhi(yc.z); o[6] = x1.z + w0 * bflo(ya.w) + w1 * bflo(yc.w); o[7] = x1.w + w0 * bfhi(ya.w) + w1 * bfhi(yc.w);
#pragma unroll
            for (int q = 0; q < 8; ++q) s += o[q] * o[q]; }
        const float rs = 1.0f / sqrtf(wave_sum(s) * (1.0f / DM) + NORM_EPS);
        if (l == 0) { const float* nw = a.in[2] + DM;
#pragma unroll
            for (int j = 0; j < 4; ++j) { const int e0 = (lane + 64 * j) * 8; const float* o = hv + 8 * j; const f32x4 wa = *(const f32x4*)(nw + e0), wb = *(const f32x4*)(nw + e0 + 4);
                *(f32x4*)(hr + e0) = (f32x4){o[0], o[1], o[2], o[3]}; *(f32x4*)(hr + e0 + 4) = (f32x4){o[4], o[5], o[6], o[7]};
                v4u p; p.x = pk2(o[0] * rs * wa.x, o[1] * rs * wa.y); p.y = pk2(o[2] * rs * wa.z, o[3] * rs * wa.w); p.z = pk2(o[4] * rs * wb.x, o[5] * rs * wb.y); p.w = pk2(o[6] * rs * wb.z, o[7] * rs * wb.w);
                *(v4u*)(HN + (size_t)r * DM + e0) = p; }
        } else { const float* nw = a.in[4]; float* orow = a.out + (size_t)r * DM;
#pragma unroll
            for (int j = 0; j < 4; ++j) { const int e0 = (lane + 64 * j) * 8; const float* o = hv + 8 * j; const f32x4 wa = *(const f32x4*)(nw + e0), wb = *(const f32x4*)(nw + e0 + 4);
                *(f32x4*)(orow + e0) = (f32x4){o[0] * rs * wa.x, o[1] * rs * wa.y, o[2] * rs * wa.z, o[3] * rs * wa.w};
                *(f32x4*)(orow + e0 + 4) = (f32x4){o[4] * rs * wb.x, o[5] * rs * wb.y, o[6] * rs * wb.z, o[7] * rs * wb.w}; } }
    }
}

DI void ph_odd_prep(const Frame& F, const Args& a) {
    const bf16* P = (const bf16*)(a.ws + WS_PROJ); bf16* QN = (bf16*)(a.ws + WS_SCR + SC_QN); bf16* KN = (bf16*)(a.ws + WS_SCR + SC_KN); bf16* VC = (bf16*)(a.ws + WS_SCR + SC_VC);
    float* BETA = (float*)(a.ws + WS_SCR + SC_BETA); float* GG = (float*)(a.ws + WS_SCR + SC_G);
    const float* cw = a.in[26]; const int lane = F.lane;
    for (int r = F.gw; r < TT; r += F.NGW) {
        const int pos = row_pos(r); const bf16* rows[4];
#pragma unroll
        for (int j = 0; j < 4; ++j) { const int pj = pos - 3 + j; rows[j] = pj >= 0 ? P + (size_t)pos_row(pj) * OD_NP : nullptr; }
#pragma unroll 2
        for (int i = 0; i < 16; ++i) { const int ch = i * 512 + lane * 8; float acc[8];
#pragma unroll
            for (int q = 0; q < 8; ++q) acc[q] = 0.f;
#pragma unroll
            for (int j = 0; j < 4; ++j) { if (!rows[j]) continue; const v4u x = *(const v4u*)(rows[j] + ch); const f32x4 w0 = *(const f32x4*)(cw + j * 8192 + ch), w1 = *(const f32x4*)(cw + j * 8192 + ch + 4);
                acc[0] += w0.x * bflo(x.x); acc[1] += w0.y * bfhi(x.x); acc[2] += w0.z * bflo(x.y); acc[3] += w0.w * bfhi(x.y);
                acc[4] += w1.x * bflo(x.z); acc[5] += w1.y * bfhi(x.z); acc[6] += w1.z * bflo(x.w); acc[7] += w1.w * bfhi(x.w); }
            float ss = 0.f;
#pragma unroll
            for (int q = 0; q < 8; ++q) { acc[q] = acc[q] * sigm(acc[q]); ss += acc[q] * acc[q]; }
            float sc = 1.0f;
            if (i < 8) { ss += __shfl_xor(ss, 1); ss += __shfl_xor(ss, 2); ss += __shfl_xor(ss, 4); ss += __shfl_xor(ss, 8);
                sc = (1.0f / sqrtf(ss + NORM_EPS)) * (i < 4 ? 0.08838834764831845f : 1.0f); }
            v4u o; o.x = pk2(acc[0] * sc, acc[1] * sc); o.y = pk2(acc[2] * sc, acc[3] * sc); o.z = pk2(acc[4] * sc, acc[5] * sc); o.w = pk2(acc[6] * sc, acc[7] * sc);
            bf16* dst = i < 4 ? QN + (size_t)r * 2048 + ch : (i < 8 ? KN + (size_t)r * 2048 + ch - 2048 : VC + (size_t)r * 4096 + ch - 4096);
            *(v4u*)dst = o; }
        if (lane < 32) { const float bb = bf2f(P[(size_t)r * OD_NP + OD_B + lane]), aa = bf2f(P[(size_t)r * OD_NP + OD_A + lane]);
            BETA[(size_t)r * 32 + lane] = sigm(bb); GG[(size_t)r * 32 + lane] = -__expf(a.in[27][lane]) * softplus(aa + a.in[28][lane]); }
    }
}
DI void ph_odd_post(const Frame& F, const Args& a) {
    const bf16* P = (const bf16*)(a.ws + WS_PROJ); const bf16* O = (const bf16*)(a.ws + WS_SCR + SC_O); bf16* Y = (bf16*)(a.ws + WS_YMIX); const float* nw = a.in[29];
    const int lane = F.lane;
    for (int r = F.gw; r < TT; r += F.NGW) {
#pragma unroll 2
        for (int i = 0; i < 8; ++i) { const int ch = i * 512 + lane * 8; const v4u ow = *(const v4u*)(O + (size_t)r * 4096 + ch); const f32x4 o0 = (f32x4){bflo(ow.x), bfhi(ow.x), bflo(ow.y), bfhi(ow.y)}, o1 = (f32x4){bflo(ow.z), bfhi(ow.z), bflo(ow.w), bfhi(ow.w)};
            float ss = (o0.x * o0.x + o0.y * o0.y) + (o0.z * o0.z + o0.w * o0.w) + (o1.x * o1.x + o1.y * o1.y) + (o1.z * o1.z + o1.w * o1.w);
            ss += __shfl_xor(ss, 1); ss += __shfl_xor(ss, 2); ss += __shfl_xor(ss, 4); ss += __shfl_xor(ss, 8);
            const float rs = 1.0f / sqrtf(ss * (1.0f / 128.0f) + NORM_EPS);
            const v4u z = *(const v4u*)(P + (size_t)r * OD_NP + OD_Z + ch); const int c0 = ch & 127; const f32x4 w0 = *(const f32x4*)(nw + c0), w1 = *(const f32x4*)(nw + c0 + 4);
            const float zf[8] = {bflo(z.x), bfhi(z.x), bflo(z.y), bfhi(z.y), bflo(z.z), bfhi(z.z), bflo(z.w), bfhi(z.w)};
            const float of[8] = {o0.x * w0.x, o0.y * w0.y, o0.z * w0.z, o0.w * w0.w, o1.x * w1.x, o1.y * w1.y, o1.z * w1.z, o1.w * w1.w};
            float y[8];
#pragma unroll
            for (int q = 0; q < 8; ++q) y[q] = of[q] * rs * zf[q] * sigm(zf[q]);
            v4u p; p.x = pk2(y[0], y[1]); p.y = pk2(y[2], y[3]); p.z = pk2(y[4], y[5]); p.w = pk2(y[6], y[7]);
            *(v4u*)(Y + (size_t)r * 4096 + ch) = p; }
    }
}

typedef float f32x16 __attribute__((ext_vector_type(16)));
#define MFMA32(a, b, c) __builtin_amdgcn_mfma_f32_32x32x16_bf16((a), (b), (c), 0, 0, 0)
DI int crow(int reg, int h) { return (reg & 3) + 8 * (reg >> 2) + 4 * h; }
DI int chunk_row(int n, int c) { return n == 0 ? (c >= 48 ? TX + (c - 48) : -1) : 64 * (n - 1) + c; }
constexpr int GDN_NCH = 129, GDN_UNITS = GDN_NCH * 32, GDN_KUNITS = GDN_NCH * 16, GC_STRIDE = 72;
constexpr size_t GD_WF = WS_MOEW, GD_UF = WS_MOEW + 65 * MiB, GD_IN = WS_MOEW + 130 * MiB, GD_GC = WS_MOEW + 163 * MiB, GD_KT = WS_HN;
static_assert((size_t)GDN_UNITS * 16384 <= 65 * MiB && (size_t)GDN_UNITS * 8192 <= 33 * MiB && (size_t)GDN_KUNITS * 16384 <= 33 * MiB && GD_GC + (size_t)GDN_UNITS * GC_STRIDE * 4 <= WS_H, "gdn map");

DI void ph_gdn_chunk(const Frame& F, const Args& a) {
    const bf16* QN = (const bf16*)(a.ws + WS_SCR + SC_QN); const bf16* KN = (const bf16*)(a.ws + WS_SCR + SC_KN); const bf16* VC = (const bf16*)(a.ws + WS_SCR + SC_VC);
    const float* BETA = (const float*)(a.ws + WS_SCR + SC_BETA); const float* GG = (const float*)(a.ws + WS_SCR + SC_G);
    bf16* WF = (bf16*)(a.ws + GD_WF); bf16* UF = (bf16*)(a.ws + GD_UF); bf16* INF = (bf16*)(a.ws + GD_IN); bf16* KTF = (bf16*)(a.ws + GD_KT); float* GC = (float*)(a.ws + GD_GC);
    LAS unsigned char* L = F.lds + RING_OFF;
    LAS unsigned char* kS = L; LAS unsigned char* qS = L + 17408; LAS unsigned char* vS = L + 34816; LAS unsigned char* kbS = L + 52224;
    LAS float* Lm = (LAS float*)(L + 69632); LAS bf16* IS = (LAS bf16*)(L + 87040); LAS bf16* XS = (LAS bf16*)(L + 96256);
    LAS float* betaS = (LAS float*)(L + 130048); LAS float* gcS = betaS + 64; LAS float* egcS = betaS + 128;
    const int tid = F.tid, lane = F.lane, wave = F.wave, l31 = lane & 31, h = lane >> 5;
    for (int unit = F.vcu; unit < GDN_UNITS; unit += F.G) {
        const int n = unit >> 5, hv = unit & 31, hk = hv >> 1;
#pragma unroll
        for (int i = 0; i < 2; ++i) { const int p = tid + 512 * i, row = p >> 4, ch = p & 15; const int rr = chunk_row(n, row);
            v4u kx = (v4u){0u, 0u, 0u, 0u}, qx = kx, vx = kx;
            if (rr >= 0) { kx = *(const v4u*)(KN + (size_t)rr * 2048 + hk * 128 + ch * 8); qx = *(const v4u*)(QN + (size_t)rr * 2048 + hk * 128 + ch * 8); vx = *(const v4u*)(VC + (size_t)rr * 4096 + hv * 128 + ch * 8); }
            *(LAS v4u*)(kS + row * 272 + ch * 16) = kx; *(LAS v4u*)(qS + row * 272 + ch * 16) = qx; *(LAS v4u*)(vS + row * 272 + ch * 16) = vx; }
        if (wave == 0) { const int rr = chunk_row(n, lane); float b = 0.f, g = 0.f; if (rr >= 0) { b = BETA[(size_t)rr * 32 + hv]; g = GG[(size_t)rr * 32 + hv]; }
#pragma unroll
            for (int o = 1; o < 64; o <<= 1) { const float t = __shfl_up(g, o); if (lane >= o) g += t; }
            betaS[lane] = b; gcS[lane] = g; egcS[lane] = __expf(g); }
        __syncthreads();
#pragma unroll
        for (int i = 0; i < 2; ++i) { const int p = tid + 512 * i, row = p >> 4, ch = p & 15; const v4u kx = *(const LAS v4u*)(kS + row * 272 + ch * 16); const float b = betaS[row];
            v4u o; o.x = pk2(bflo(kx.x) * b, bfhi(kx.x) * b); o.y = pk2(bflo(kx.y) * b, bfhi(kx.y) * b); o.z = pk2(bflo(kx.z) * b, bfhi(kx.z) * b); o.w = pk2(bflo(kx.w) * b, bfhi(kx.w) * b);
            *(LAS v4u*)(kbS + row * 272 + ch * 16) = o; }
        __syncthreads();
        { const int which = wave >> 2, ti = (wave >> 1) & 1, tj = wave & 1;
          f32x16 acc;
#pragma unroll
          for (int r = 0; r < 16; ++r) acc[r] = 0.f;
          if (!(ti == 0 && tj == 1)) { const LAS unsigned char* Ab = (which == 0 ? kbS : qS) + (32 * ti + l31) * 272 + 16 * h; const LAS unsigned char* Bb = kS + (32 * tj + l31) * 272 + 16 * h;
#pragma unroll
              for (int s = 0; s < 8; ++s) acc = MFMA32(*(const LAS bf16x8*)(Ab + 32 * s), *(const LAS bf16x8*)(Bb + 32 * s), acc); }
          const int j = 32 * tj + l31; const float gj = gcS[j];
#pragma unroll
          for (int r = 0; r < 16; ++r) { const int i = 32 * ti + crow(r, h); const float e = __expf(fminf(gcS[i] - gj, 0.f));
              if (which == 0) Lm[i * 68 + j] = i > j ? acc[r] * e : 0.f;
              else IS[i * 72 + j] = (bf16)f2bf(i >= j ? acc[r] * e : 0.f); } }
        __syncthreads();
        if (wave < 4) { const int col = tid; float x[64];
            int lz; asm volatile("v_mov_b32 %0, 0" : "=v"(lz));
            const LAS float* Lz = Lm + lz; const LAS float* bz = (col < 128 ? betaS : egcS) + lz; const LAS unsigned char* rz = col < 128 ? vS + col * 2 : kbS + (col - 128) * 2;
#pragma unroll
            for (int i = 0; i < 64; ++i) { float acc = bf2f(*(const LAS bf16*)(rz + i * 272)) * bz[i];
#pragma unroll
                for (int j = 0; j < i; ++j) acc -= Lz[i * 68 + j] * x[j];
                x[i] = acc; XS[i * 264 + col] = (bf16)f2bf(acc); }
        } else { const int t2 = tid - 256;
#pragma unroll
            for (int i = 0; i < 2; ++i) { const int p = t2 + 256 * i, comb = p >> 6, ln = p & 63, t = comb >> 2, s = comb & 3; const int c = 32 * t + (ln & 31), j0 = 16 * s + 8 * (ln >> 5);
                *(v4u*)(INF + ((size_t)unit * 8 + comb) * 512 + ln * 8) = *(const LAS v4u*)(IS + c * 72 + j0); }
            if ((hv & 1) == 0) { const size_t kunit = (size_t)n * 16 + hk;
#pragma unroll
                for (int i = 0; i < 4; ++i) { const int p = t2 + 256 * i, comb = p >> 6, ln = p & 63, kt = comb >> 2, s = comb & 3; const int kd = 32 * kt + (ln & 31), c0 = 16 * s + 8 * (ln >> 5);
                    unsigned w[4];
#pragma unroll
                    for (int jj = 0; jj < 4; ++jj) { const unsigned lo = *(const LAS bf16*)(kS + (c0 + 2 * jj) * 272 + kd * 2), hi = *(const LAS bf16*)(kS + (c0 + 2 * jj + 1) * 272 + kd * 2); w[jj] = lo | (hi << 16); }
                    *(v4u*)(KTF + (kunit * 16 + comb) * 512 + ln * 8) = (v4u){w[0], w[1], w[2], w[3]}; } }
            if (t2 < 64) GC[(size_t)unit * GC_STRIDE + t2] = gcS[t2];
            else if (t2 == 64) GC[(size_t)unit * GC_STRIDE + 64] = gcS[63];
            else if (t2 == 65) GC[(size_t)unit * GC_STRIDE + 65] = egcS[63];
        }
        __syncthreads();
#pragma unroll
        for (int i = 0; i < 2; ++i) { const int p = tid + 512 * i, comb = p >> 6, ln = p & 63, t = comb >> 3, s = comb & 7; const int c = 32 * t + (ln & 31), k0 = 16 * s + 8 * (ln >> 5);
            *(v4u*)(WF + ((size_t)unit * 16 + comb) * 512 + ln * 8) = *(const LAS v4u*)(XS + c * 264 + 128 + k0); }
        { const int t = wave >> 2, ns = wave & 3; unsigned w[8];
#pragma unroll
          for (int r = 0; r < 8; ++r) { const unsigned lo = XS[(32 * t + crow(2 * r, h)) * 264 + 32 * ns + l31], hi = XS[(32 * t + crow(2 * r + 1, h)) * 264 + 32 * ns + l31]; w[r] = lo | (hi << 16); }
          bf16* dst = UF + (((size_t)unit * 8 + wave) * 64 + lane) * 16; *(v4u*)dst = (v4u){w[0], w[1], w[2], w[3]}; *(v4u*)(dst + 8) = (v4u){w[4], w[5], w[6], w[7]}; }
        __syncthreads();
    }
}

DI void ph_gdn_chain(const Frame& F, const Args& a) {
    if (F.vcu >= 128) return;
    const int hv = F.vcu >> 2, ns = F.vcu & 3, hk = hv >> 1;
    const bf16* QN = (const bf16*)(a.ws + WS_SCR + SC_QN);
    const bf16* WF = (const bf16*)(a.ws + GD_WF); const bf16* UF = (const bf16*)(a.ws + GD_UF); const bf16* INF = (const bf16*)(a.ws + GD_IN); const bf16* KTF = (const bf16*)(a.ws + GD_KT); const float* GC = (const float*)(a.ws + GD_GC);
    bf16* O = (bf16*)(a.ws + WS_SCR + SC_O);
    LAS unsigned char* ST = F.lds + RING_OFF; LAS unsigned char* VN = ST + 8704; LAS unsigned char* VND = ST + 13312;
    const int lane = F.lane, wave = F.wave, l31 = lane & 31, h = lane >> 5;
    for (int i = F.tid; i < 8704 / 4; i += NWAVES * 64) ((LAS unsigned*)ST)[i] = 0u;
    __syncthreads();
    f32x16 S;
#pragma unroll
    for (int r = 0; r < 16; ++r) S[r] = 0.f;
    const int role = wave < 2 ? 0 : (wave < 4 ? 1 : 2); const int t = wave & 1, kt = wave & 3;
    bf16x8 A8[8]; bf16x8 A4[4]; v4u U0 = (v4u){0u, 0u, 0u, 0u}, U1 = U0; f32x4 G4[4]; float gl = 0.f, egl = 1.f;
#pragma unroll
    for (int s = 0; s < 8; ++s) A8[s] = (bf16x8){0, 0, 0, 0, 0, 0, 0, 0};
#pragma unroll
    for (int s = 0; s < 4; ++s) { A4[s] = (bf16x8){0, 0, 0, 0, 0, 0, 0, 0}; G4[s] = (f32x4){0.f, 0.f, 0.f, 0.f}; }
#define GDN_LOAD(nn) do { const size_t unit_ = (size_t)(nn) * 32 + hv; const float* gc_ = GC + unit_ * GC_STRIDE; \
        if (role == 0) { _Pragma("unroll") for (int s = 0; s < 8; ++s) A8[s] = *(const bf16x8*)(WF + ((unit_ * 2 + t) * 8 + s) * 512 + lane * 8); \
            const bf16* up_ = UF + (((unit_ * 2 + t) * 4 + ns) * 64 + lane) * 16; U0 = *(const v4u*)up_; U1 = *(const v4u*)(up_ + 8); \
            _Pragma("unroll") for (int g = 0; g < 4; ++g) G4[g] = *(const f32x4*)(gc_ + 32 * t + 8 * g + 4 * h); gl = gc_[64]; } \
        else if (role == 1) { const int rr_ = chunk_row((nn), 32 * t + l31); \
            _Pragma("unroll") for (int s = 0; s < 8; ++s) A8[s] = rr_ >= 0 ? *(const bf16x8*)(QN + (size_t)rr_ * 2048 + hk * 128 + 16 * s + 8 * h) : (bf16x8){0, 0, 0, 0, 0, 0, 0, 0}; \
            _Pragma("unroll") for (int s = 0; s < 4; ++s) A4[s] = *(const bf16x8*)(INF + ((unit_ * 2 + t) * 4 + s) * 512 + lane * 8); \
            _Pragma("unroll") for (int g = 0; g < 4; ++g) G4[g] = *(const f32x4*)(gc_ + 32 * t + 8 * g + 4 * h); } \
        else { const size_t kunit_ = (size_t)(nn) * 16 + hk; \
            _Pragma("unroll") for (int s = 0; s < 4; ++s) A4[s] = *(const bf16x8*)(KTF + ((kunit_ * 4 + kt) * 4 + s) * 512 + lane * 8); egl = gc_[65]; } } while (0)
    GDN_LOAD(0);
    for (int n = 0; n < GDN_NCH; ++n) {
        bf16x8 a8[8], a4[4]; const v4u u0 = U0, u1 = U1; f32x4 g4[4]; const float cgl = gl, cegl = egl;
#pragma unroll
        for (int s = 0; s < 8; ++s) a8[s] = A8[s];
#pragma unroll
        for (int s = 0; s < 4; ++s) { a4[s] = A4[s]; g4[s] = G4[s]; }
        if (n + 1 < GDN_NCH) GDN_LOAD(n + 1);
        f32x16 acc;
#pragma unroll
        for (int r = 0; r < 16; ++r) acc[r] = 0.f;
        if (role < 2) {
#pragma unroll
            for (int s = 0; s < 8; ++s) acc = MFMA32(a8[s], *(const LAS bf16x8*)(ST + l31 * 272 + 32 * s + 16 * h), acc);
        }
        if (role == 0) { const unsigned uw[8] = {u0.x, u0.y, u0.z, u0.w, u1.x, u1.y, u1.z, u1.w};
#pragma unroll
            for (int g = 0; g < 4; ++g) { float vn[4], vd[4];
#pragma unroll
                for (int q = 0; q < 4; ++q) { const int r = 4 * g + q; const float uv = (r & 1) ? bfhi(uw[r >> 1]) : bflo(uw[r >> 1]); vn[q] = uv - acc[r]; vd[q] = vn[q] * __expf(cgl - g4[g][q]); }
                *(LAS v2u*)(VN + l31 * 144 + (32 * t + 8 * g + 4 * h) * 2) = (v2u){pk2(vn[0], vn[1]), pk2(vn[2], vn[3])};
                *(LAS v2u*)(VND + l31 * 144 + (32 * t + 8 * g + 4 * h) * 2) = (v2u){pk2(vd[0], vd[1]), pk2(vd[2], vd[3])}; }
        } else if (role == 1) {
#pragma unroll
            for (int g = 0; g < 4; ++g)
#pragma unroll
                for (int q = 0; q < 4; ++q) acc[4 * g + q] *= __expf(g4[g][q]);
        }
        __syncthreads();
        if (role == 1) {
#pragma unroll
            for (int s = 0; s < 4; ++s) acc = MFMA32(a4[s], *(const LAS bf16x8*)(VN + l31 * 144 + 32 * s + 16 * h), acc);
#pragma unroll
            for (int r = 0; r < 16; ++r) { const int rr = chunk_row(n, 32 * t + crow(r, h)); if (rr >= 0) O[(size_t)rr * 4096 + hv * 128 + 32 * ns + l31] = (bf16)f2bf(acc[r]); }
        } else if (role == 2) {
#pragma unroll
            for (int r = 0; r < 16; ++r) S[r] *= cegl;
#pragma unroll
            for (int s = 0; s < 4; ++s) S = MFMA32(a4[s], *(const LAS bf16x8*)(VND + l31 * 144 + 32 * s + 16 * h), S);
#pragma unroll
            for (int g = 0; g < 4; ++g) *(LAS v2u*)(ST + l31 * 272 + (32 * kt + 8 * g + 4 * h) * 2) = (v2u){pk2(S[4 * g], S[4 * g + 1]), pk2(S[4 * g + 2], S[4 * g + 3])};
        }
        __syncthreads();
    }
#undef GDN_LOAD
}

constexpr int RW_NSC = 258, RW_UNITS = 129 * 16;
DI int sub_row(int sc, int t) { const int n = sc >> 1, sub = sc & 1; return n == 0 ? ((sub == 0 && t >= 16) ? TX + t - 16 : -1) : 64 * (n - 1) + 32 * sub + t; }
constexpr size_t RW_BASE = WS_PROJ + 92 * MiB;
constexpr size_t RW_RH = RW_BASE, RW_RL = RW_BASE + 33 * MiB, RW_GT = RW_BASE + 66 * MiB, RW_GAM = RW_BASE + 99 * MiB;
constexpr size_t RW_PR = WS_SCR + 195 * MiB, RW_AT = WS_SCR + 211 * MiB + 256 * 1024, RW_VTF = WS_SCR + 219 * MiB + 512 * 1024, RW_SALL = WS_SCR + 235 * MiB + 768 * 1024;
constexpr size_t RW_VV = WS_YMIX + 34 * MiB, RW_BON = WS_YMIX + 52 * MiB, LR_H = WS_YMIX + 54 * MiB, LR_A = WS_YMIX + 56 * MiB, LR_C = WS_YMIX + 58 * MiB;
constexpr size_t RW_SCH = (size_t)RW_NSC * 16;
static_assert((size_t)MP * EV_NP * 2 <= 92 * MiB && RW_SCH * 8192 <= 33 * MiB && RW_GAM + RW_SCH * 256 <= WS_SCR, "rwkv map (proj region)");
static_assert(WS_SCR + SC_LIX + (size_t)MP * 4096 <= RW_PR && RW_PR + RW_SCH * 4096 <= RW_AT && RW_AT + RW_SCH * 2048 <= RW_VTF && RW_VTF + RW_SCH * 4096 <= RW_SALL && RW_SALL + RW_SCH * 8192 <= WS_END, "rwkv map (scratch region)");
static_assert((size_t)MP * DM * 2 <= 34 * MiB && RW_VV + (size_t)MP * 2048 <= RW_BON && RW_BON + (size_t)MP * 64 <= LR_H && LR_H + RW_SCH * 256 <= LR_A && LR_A + RW_SCH * 256 <= LR_C && LR_C + RW_SCH * 256 <= WS_PROJ, "rwkv map (ymix region)");

DI void lru_local(const Frame& F, const Args& a) {
    const float* LA = (const float*)(a.ws + WS_SCR + SC_LA); const float* LIX = (const float*)(a.ws + WS_SCR + SC_LIX);
    float* HL = (float*)(a.ws + LR_H); float* AP = (float*)(a.ws + LR_A);
    for (int item = F.gw; item < RW_NSC * 16; item += F.NGW) { const int sc = item >> 4, c = (item & 15) * 64 + F.lane; float h = 0.f, p = 1.f;
#pragma unroll 8
        for (int t = 0; t < 32; ++t) { const int rr = sub_row(sc, t); if (rr < 0) continue; const float av = LA[(size_t)rr * 1024 + c], ix = LIX[(size_t)rr * 1024 + c];
            h = av * h + sqrtf(fmaxf(1.0f - av * av, 0.f)) * ix; p *= av; }
        HL[sc * 1024 + c] = h; AP[sc * 1024 + c] = p; }
}
DI void lru_apply(const Frame& F, const Args& a) {
    const bf16* P = (const bf16*)(a.ws + WS_PROJ); const float* LA = (const float*)(a.ws + WS_SCR + SC_LA); const float* LIX = (const float*)(a.ws + WS_SCR + SC_LIX);
    const float* CR = (const float*)(a.ws + LR_C); bf16* Y = (bf16*)(a.ws + WS_YMIX);
    for (int item = F.gw; item < RW_NSC * 16; item += F.NGW) { const int sc = item >> 4, c = (item & 15) * 64 + F.lane; float h = CR[sc * 1024 + c];
#pragma unroll 8
        for (int t = 0; t < 32; ++t) { const int rr = sub_row(sc, t); if (rr < 0) continue; const float av = LA[(size_t)rr * 1024 + c], ix = LIX[(size_t)rr * 1024 + c], gb = bf2f(P[(size_t)rr * EV_NP + EV_GB + c]);
            h = av * h + sqrtf(fmaxf(1.0f - av * av, 0.f)) * ix; Y[(size_t)rr * DM + 1024 + c] = (bf16)f2bf(h * gelu_tanh(gb)); } }
}

DI void ph_rwkv_chunk(const Frame& F, const Args& a) {
    lru_local(F, a);
    const bf16* P = (const bf16*)(a.ws + WS_PROJ); const float* DEC = (const float*)(a.ws + WS_SCR + SC_DEC); const float* ICL = (const float*)(a.ws + WS_SCR + SC_ICL);
    bf16* RH = (bf16*)(a.ws + RW_RH); bf16* RL = (bf16*)(a.ws + RW_RL); bf16* GT = (bf16*)(a.ws + RW_GT); float* GAM = (float*)(a.ws + RW_GAM); bf16* PR = (bf16*)(a.ws + RW_PR); bf16* ATG = (bf16*)(a.ws + RW_AT); bf16* VTF = (bf16*)(a.ws + RW_VTF);
    bf16* VV = (bf16*)(a.ws + RW_VV); float* BON = (float*)(a.ws + RW_BON);
    LAS unsigned char* L = F.lds + RING_OFF;
    LAS float* wS = (LAS float*)L; LAS float* aS = wS + 4096; LAS float* bS = wS + 8192; LAS float* rS = wS + 12288; LAS float* kS = wS + 16384;
    LAS unsigned char* vT = L + 81920; LAS unsigned char* aT = L + 91136; LAS unsigned char* rT = L + 100352; LAS unsigned char* kT = L + 109568; LAS unsigned char* bT = L + 118784;
    LAS unsigned char* AT = L + 128000; LAS unsigned char* NT = L + 133120; LAS float* gam = (LAS float*)(L + 138240);
    LAS unsigned char* aTl = L; LAS unsigned char* bTl = L + 9216;
    const int tid = F.tid, lane = F.lane, wave = F.wave, l31 = lane & 31, h = lane >> 5;
    const float* mu = a.in[6];
    for (int unit = F.vcu; unit < RW_UNITS; unit += F.G) {
        const int n = unit >> 4, hd = unit & 15;
        { const int tok = tid >> 3, cg = tid & 7, c0 = hd * 64 + cg * 8; const int rr = sub_row(2 * n + (tok >> 5), tok & 31);
          float wv[8], av[8], bv[8], rv[8], kv[8], vv[8];
#pragma unroll
          for (int q = 0; q < 8; ++q) { wv[q] = 1.f; av[q] = 0.f; bv[q] = 0.f; rv[q] = 0.f; kv[q] = 0.f; vv[q] = 0.f; }
          if (rr >= 0) { const int pos = row_pos(rr); const bf16* cur = P + (size_t)rr * EV_NP + c0; const bf16* prv = pos > 0 ? P + (size_t)pos_row(pos - 1) * EV_NP + c0 : nullptr;
              const v4u z4 = (v4u){0u, 0u, 0u, 0u};
              const v4u cr = *(const v4u*)cur, ck = *(const v4u*)(cur + 1024), cv = *(const v4u*)(cur + 2048);
              const v4u qr = prv ? *(const v4u*)prv : z4, qk = prv ? *(const v4u*)(prv + 1024) : z4, qv = prv ? *(const v4u*)(prv + 2048) : z4;
              const unsigned crw[4] = {cr.x, cr.y, cr.z, cr.w}, ckw[4] = {ck.x, ck.y, ck.z, ck.w}, cvw[4] = {cv.x, cv.y, cv.z, cv.w}, qrw[4] = {qr.x, qr.y, qr.z, qr.w}, qkw[4] = {qk.x, qk.y, qk.z, qk.w}, qvw[4] = {qv.x, qv.y, qv.z, qv.w};
              float ss = 0.f, bon = 0.f; float kk[8], ic[8];
#pragma unroll
              for (int q = 0; q < 8; ++q) { const int c = c0 + q; const float crf = (q & 1) ? bfhi(crw[q >> 1]) : bflo(crw[q >> 1]), ckf = (q & 1) ? bfhi(ckw[q >> 1]) : bflo(ckw[q >> 1]), cvf = (q & 1) ? bfhi(cvw[q >> 1]) : bflo(cvw[q >> 1]);
                  const float prf = (q & 1) ? bfhi(qrw[q >> 1]) : bflo(qrw[q >> 1]), pkf = (q & 1) ? bfhi(qkw[q >> 1]) : bflo(qkw[q >> 1]), pvf = (q & 1) ? bfhi(qvw[q >> 1]) : bflo(qvw[q >> 1]);
                  rv[q] = crf + (prf - crf) * mu[c]; kk[q] = ckf + (pkf - ckf) * mu[1024 + c]; vv[q] = cvf + (pvf - cvf) * mu[2048 + c];
                  wv[q] = DEC[(size_t)rr * 1024 + c]; ic[q] = ICL[(size_t)rr * 1024 + c];
                  const float kkv = kk[q] * a.in[12][c]; av[q] = kkv; ss += kkv * kkv; kv[q] = kk[q] * (1.0f + (ic[q] - 1.0f) * a.in[13][c]); bon += rv[q] * kv[q] * a.in[14][c]; }
              ss += __shfl_xor(ss, 1); ss += __shfl_xor(ss, 2); ss += __shfl_xor(ss, 4); bon += __shfl_xor(bon, 1); bon += __shfl_xor(bon, 2); bon += __shfl_xor(bon, 4);
              const float inv = 1.0f / fmaxf(sqrtf(ss), 1e-12f);
#pragma unroll
              for (int q = 0; q < 8; ++q) { const float kkn = av[q] * inv; av[q] = -kkn; bv[q] = kkn * ic[q]; }
              if (cg == 0) BON[(size_t)rr * 16 + hd] = bon;
              *(v4u*)(VV + (size_t)rr * 1024 + c0) = (v4u){pk2(vv[0], vv[1]), pk2(vv[2], vv[3]), pk2(vv[4], vv[5]), pk2(vv[6], vv[7])}; }
          const int o = tok * 64 + cg * 8;
          *(LAS f32x4*)(wS + o) = (f32x4){wv[0], wv[1], wv[2], wv[3]}; *(LAS f32x4*)(wS + o + 4) = (f32x4){wv[4], wv[5], wv[6], wv[7]};
          *(LAS f32x4*)(aS + o) = (f32x4){av[0], av[1], av[2], av[3]}; *(LAS f32x4*)(aS + o + 4) = (f32x4){av[4], av[5], av[6], av[7]};
          *(LAS f32x4*)(bS + o) = (f32x4){bv[0], bv[1], bv[2], bv[3]}; *(LAS f32x4*)(bS + o + 4) = (f32x4){bv[4], bv[5], bv[6], bv[7]};
          *(LAS f32x4*)(rS + o) = (f32x4){rv[0], rv[1], rv[2], rv[3]}; *(LAS f32x4*)(rS + o + 4) = (f32x4){rv[4], rv[5], rv[6], rv[7]};
          *(LAS f32x4*)(kS + o) = (f32x4){kv[0], kv[1], kv[2], kv[3]}; *(LAS f32x4*)(kS + o + 4) = (f32x4){kv[4], kv[5], kv[6], kv[7]};
#pragma unroll
          for (int q = 0; q < 8; ++q) *(LAS bf16*)(vT + (cg * 8 + q) * 144 + tok * 2) = (bf16)f2bf(vv[q]); }
        __syncthreads();
        if (wave < 2) {
            const int sub = h, s = l31; const LAS float* x0p = (wave == 0 ? kS : bS) + lane * 64; LAS unsigned char* OUT = wave == 0 ? AT : NT;
            float x[64];
#pragma unroll
            for (int j = 0; j < 64; j += 4) { const f32x4 t4 = *(const LAS f32x4*)(x0p + j); x[j] = t4.x; x[j + 1] = t4.y; x[j + 2] = t4.z; x[j + 3] = t4.w; }
#pragma unroll 1
            for (int tp = 0; tp < 32; ++tp) { const int base = (32 * sub + tp) * 64; const bool run = tp > s;
                float c = 0.f;
#pragma unroll
                for (int j = 0; j < 64; j += 4) { const f32x4 a4 = *(const LAS f32x4*)(aS + base + j); c += x[j] * a4.x; c += x[j + 1] * a4.y; c += x[j + 2] * a4.z; c += x[j + 3] * a4.w; }
                float o = 0.f;
#pragma unroll
                for (int j = 0; j < 64; j += 4) { const f32x4 w4 = *(const LAS f32x4*)(wS + base + j), b4 = *(const LAS f32x4*)(bS + base + j), r4 = *(const LAS f32x4*)(rS + base + j);
                    const float n0 = x[j] * w4.x + c * b4.x, n1 = x[j + 1] * w4.y + c * b4.y, n2 = x[j + 2] * w4.z + c * b4.z, n3 = x[j + 3] * w4.w + c * b4.w;
                    x[j] = run ? n0 : x[j]; x[j + 1] = run ? n1 : x[j + 1]; x[j + 2] = run ? n2 : x[j + 2]; x[j + 3] = run ? n3 : x[j + 3];
                    o += x[j] * r4.x; o += x[j + 1] * r4.y; o += x[j + 2] * r4.z; o += x[j + 3] * r4.w; }
                *(LAS bf16*)(OUT + ((sub * 32 + tp) * 40 + s) * 2) = (bf16)f2bf(tp >= s ? o : 0.f); }
            LAS unsigned char* XT = wave == 0 ? kT : bT;
#pragma unroll
            for (int j = 0; j < 64; ++j) { const unsigned hi = f2bf(x[j]); *(LAS bf16*)(XT + j * 144 + lane * 2) = (bf16)hi; x[j] -= __uint_as_float(hi << 16); }
            __syncthreads();
            if (wave == 1) {
#pragma unroll
                for (int j = 0; j < 64; ++j) *(LAS bf16*)(bTl + j * 144 + lane * 2) = (bf16)f2bf(x[j]); }
        } else if (wave < 4) { const int t2 = tid - 128, sub = t2 >> 6, j = t2 & 63; float g = 1.f; float alo[32];
#pragma unroll
            for (int tp = 0; tp < 32; ++tp) { const int tok = 32 * sub + tp; const float w_ = wS[tok * 64 + j], a_ = aS[tok * 64 + j], r_ = rS[tok * 64 + j];
                const float at = a_ * g; const unsigned hi = f2bf(at); *(LAS bf16*)(aT + j * 144 + tok * 2) = (bf16)hi; alo[tp] = at - __uint_as_float(hi << 16);
                g *= w_; *(LAS bf16*)(rT + j * 144 + tok * 2) = (bf16)f2bf(r_ * g); }
            gam[sub * 64 + j] = g;
            __syncthreads();
#pragma unroll
            for (int tp = 0; tp < 32; ++tp) *(LAS bf16*)(aTl + j * 144 + (32 * sub + tp) * 2) = (bf16)f2bf(alo[tp]);
        } else __syncthreads();
        __syncthreads();
        { const int sub = wave >> 2, t1 = (wave >> 1) & 1, t0 = wave & 1; const size_t sch = (size_t)(2 * n + sub) * 16 + hd;
          { f32x16 acc;
#pragma unroll
            for (int r = 0; r < 16; ++r) acc[r] = 0.f;
#pragma unroll
            for (int ks = 0; ks < 2; ++ks) { const int ao = (32 * t1 + l31) * 144 + (32 * sub + 16 * ks + 8 * h) * 2, bo = (32 * t0 + l31) * 144 + (32 * sub + 16 * ks + 8 * h) * 2;
                const bf16x8 ah = *(const LAS bf16x8*)(aT + ao), al = *(const LAS bf16x8*)(aTl + ao), bh = *(const LAS bf16x8*)(bT + bo), bl = *(const LAS bf16x8*)(bTl + bo);
                acc = MFMA32(al, bh, acc); acc = MFMA32(ah, bl, acc); acc = MFMA32(ah, bh, acc); }
            const int jp = 32 * t0 + l31;
#pragma unroll
            for (int g = 0; g < 4; ++g) { unsigned hi[4]; float lo[4];
#pragma unroll
                for (int q = 0; q < 4; ++q) { hi[q] = f2bf(acc[4 * g + q]); lo[q] = acc[4 * g + q] - __uint_as_float(hi[q] << 16); }
                *(v2u*)(RH + (sch * 64 + jp) * 64 + 32 * t1 + 8 * g + 4 * h) = (v2u){hi[0] | (hi[1] << 16), hi[2] | (hi[3] << 16)};
                *(v2u*)(RL + (sch * 64 + jp) * 64 + 32 * t1 + 8 * g + 4 * h) = (v2u){pk2(lo[0], lo[1]), pk2(lo[2], lo[3])}; }
            if (t1 == 0 && t0 == 0) GAM[sch * 64 + lane] = gam[sub * 64 + lane]; }
          { f32x16 acc;
#pragma unroll
            for (int r = 0; r < 16; ++r) acc[r] = 0.f;
#pragma unroll
            for (int ks = 0; ks < 2; ++ks) acc = MFMA32(*(const LAS bf16x8*)(kT + (32 * t1 + l31) * 144 + (32 * sub + 16 * ks + 8 * h) * 2), *(const LAS bf16x8*)(vT + (32 * t0 + l31) * 144 + (32 * sub + 16 * ks + 8 * h) * 2), acc);
            bf16* dst = GT + ((sch * 4 + t1 * 2 + t0) * 64 + lane) * 16;
            *(v4u*)dst = (v4u){pk2(acc[0], acc[1]), pk2(acc[2], acc[3]), pk2(acc[4], acc[5]), pk2(acc[6], acc[7])}; *(v4u*)(dst + 8) = (v4u){pk2(acc[8], acc[9]), pk2(acc[10], acc[11]), pk2(acc[12], acc[13]), pk2(acc[14], acc[15])}; } }
        if (wave < 4) { const int sub = wave >> 1, jt = wave & 1; const size_t sch = (size_t)(2 * n + sub) * 16 + hd;
            f32x16 acc;
#pragma unroll
            for (int r = 0; r < 16; ++r) acc[r] = bf2f(*(const LAS bf16*)(rT + (32 * jt + crow(r, h)) * 144 + (32 * sub + l31) * 2));
#pragma unroll
            for (int ks = 0; ks < 2; ++ks) acc = MFMA32(*(const LAS bf16x8*)(aT + (32 * jt + l31) * 144 + (32 * sub + 16 * ks + 8 * h) * 2), *(const LAS bf16x8*)(NT + (sub * 32 + l31) * 80 + (16 * ks + 8 * h) * 2), acc);
#pragma unroll
            for (int g = 0; g < 4; ++g) *(v2u*)(PR + (sch * 32 + l31) * 64 + 32 * jt + 8 * g + 4 * h) = (v2u){pk2(acc[4 * g], acc[4 * g + 1]), pk2(acc[4 * g + 2], acc[4 * g + 3])};
        } else { const int t2 = tid - 256, sub = t2 >> 7, t = (t2 >> 2) & 31, s8 = (t2 & 3) * 8; const size_t sch = (size_t)(2 * n + sub) * 16 + hd;
            *(v4u*)(ATG + (sch * 32 + t) * 32 + s8) = *(const LAS v4u*)(AT + (sub * 32 + t) * 80 + s8 * 2); }
        { const int sub = tid >> 8, it = (tid >> 7) & 1, ks = (tid >> 6) & 1; const size_t sch = (size_t)(2 * n + sub) * 16 + hd;
          *(v4u*)(VTF + ((sch * 4 + it * 2 + ks) * 64 + lane) * 8) = *(const LAS v4u*)(vT + (32 * it + l31) * 144 + (32 * sub + 16 * ks + 8 * h) * 2); }
        __syncthreads();
    }
}

DI void ph_rwkv_chain(const Frame& F, const Args& a) {
    if (F.vcu >= 16 && F.vcu < 18) { const int c = (F.vcu - 16) * 512 + F.tid; const float* HL = (const float*)(a.ws + LR_H); const float* AP = (const float*)(a.ws + LR_A); float* CR = (float*)(a.ws + LR_C);
        float carry = 0.f;
#pragma unroll 8
        for (int sc = 0; sc < RW_NSC; ++sc) { const float hl = HL[sc * 1024 + c], ap = AP[sc * 1024 + c]; CR[sc * 1024 + c] = carry; carry = ap * carry + hl; }
        return; }
    if (F.vcu >= 16) return;
    const int hd = F.vcu; const bf16* RH = (const bf16*)(a.ws + RW_RH); const bf16* RL = (const bf16*)(a.ws + RW_RL); const bf16* GT = (const bf16*)(a.ws + RW_GT); const float* GAM = (const float*)(a.ws + RW_GAM); bf16* SALL = (bf16*)(a.ws + RW_SALL);
    LAS unsigned char* XS = F.lds + RING_OFF;
    const int lane = F.lane, wave = F.wave, l31 = lane & 31, h = lane >> 5, jt = (wave >> 1) & 1, it = wave & 1;
    for (int i = F.tid; i < 2 * 9216 / 4; i += NWAVES * 64) ((LAS unsigned*)XS)[i] = 0u;
    __syncthreads();
    f32x16 X;
#pragma unroll
    for (int r = 0; r < 16; ++r) X[r] = 0.f;
    bf16x8 Ahn[4], Aln[4]; v4u G0n, G1n; f32x4 Mn[4];
#define RW_LOAD(scn) do { const size_t sch_ = (size_t)(scn) * 16 + hd; \
        _Pragma("unroll") for (int ks = 0; ks < 4; ++ks) { Ahn[ks] = *(const bf16x8*)(RH + (sch_ * 64 + 32 * jt + l31) * 64 + 16 * ks + 8 * h); Aln[ks] = *(const bf16x8*)(RL + (sch_ * 64 + 32 * jt + l31) * 64 + 16 * ks + 8 * h); } \
        { const bf16* gp_ = GT + ((sch_ * 4 + jt * 2 + it) * 64 + lane) * 16; G0n = *(const v4u*)gp_; G1n = *(const v4u*)(gp_ + 8); } \
        _Pragma("unroll") for (int g = 0; g < 4; ++g) Mn[g] = *(const f32x4*)(GAM + sch_ * 64 + 32 * jt + 8 * g + 4 * h); } while (0)
    if (wave < 4) RW_LOAD(0);
    for (int sc = 0; sc < RW_NSC; ++sc) {
        if (wave < 4) {
            bf16x8 Ah[4], Al[4]; f32x16 acc; const unsigned gw_[8] = {G0n.x, G0n.y, G0n.z, G0n.w, G1n.x, G1n.y, G1n.z, G1n.w};
#pragma unroll
            for (int ks = 0; ks < 4; ++ks) { Ah[ks] = Ahn[ks]; Al[ks] = Aln[ks]; }
#pragma unroll
            for (int g = 0; g < 4; ++g) { acc[4 * g] = bflo(gw_[2 * g]) + Mn[g].x * X[4 * g]; acc[4 * g + 1] = bfhi(gw_[2 * g]) + Mn[g].y * X[4 * g + 1]; acc[4 * g + 2] = bflo(gw_[2 * g + 1]) + Mn[g].z * X[4 * g + 2]; acc[4 * g + 3] = bfhi(gw_[2 * g + 1]) + Mn[g].w * X[4 * g + 3]; }
            const size_t sch = (size_t)sc * 16 + hd;
#pragma unroll
            for (int g = 0; g < 4; ++g) *(v2u*)(SALL + (sch * 64 + 32 * it + l31) * 64 + 32 * jt + 8 * g + 4 * h) = (v2u){pk2(X[4 * g], X[4 * g + 1]), pk2(X[4 * g + 2], X[4 * g + 3])};
            if (sc + 1 < RW_NSC) RW_LOAD(sc + 1);
            const LAS unsigned char* xb = XS + (sc & 1) * 9216 + (32 * it + l31) * 144 + 16 * h;
#pragma unroll
            for (int ks = 0; ks < 4; ++ks) { const bf16x8 xf = *(const LAS bf16x8*)(xb + 32 * ks); acc = MFMA32(Al[ks], xf, acc); acc = MFMA32(Ah[ks], xf, acc); }
            X = acc;
            LAS unsigned char* xn = XS + ((sc + 1) & 1) * 9216 + (32 * it + l31) * 144;
#pragma unroll
            for (int g = 0; g < 4; ++g) *(LAS v2u*)(xn + (32 * jt + 8 * g + 4 * h) * 2) = (v2u){pk2(X[4 * g], X[4 * g + 1]), pk2(X[4 * g + 2], X[4 * g + 3])};
        }
        __syncthreads();
    }
#undef RW_LOAD
}

DI void ph_rwkv_out(const Frame& F, const Args& a) {
    const bf16* SALL = (const bf16*)(a.ws + RW_SALL); const bf16* PR = (const bf16*)(a.ws + RW_PR); const bf16* ATG = (const bf16*)(a.ws + RW_AT); const bf16* VTF = (const bf16*)(a.ws + RW_VTF);
    const bf16* VV = (const bf16*)(a.ws + RW_VV); const float* BON = (const float*)(a.ws + RW_BON); const float* GATE = (const float*)(a.ws + WS_SCR + SC_GATE); bf16* Y = (bf16*)(a.ws + WS_YMIX);
    const int lane = F.lane, l31 = lane & 31, h = lane >> 5;
    for (int item = F.gw; item < RW_NSC * 16; item += F.NGW) { const int sc = item >> 4, hd = item & 15; if (sc == 1) continue;
        const size_t sch = (size_t)sc * 16 + hd; f32x16 acc[2];
#pragma unroll
        for (int it = 0; it < 2; ++it) {
#pragma unroll
            for (int r = 0; r < 16; ++r) acc[it][r] = 0.f;
#pragma unroll
            for (int ks = 0; ks < 4; ++ks) acc[it] = MFMA32(*(const bf16x8*)(SALL + (sch * 64 + 32 * it + l31) * 64 + 16 * ks + 8 * h), *(const bf16x8*)(PR + (sch * 32 + l31) * 64 + 16 * ks + 8 * h), acc[it]);
#pragma unroll
            for (int ks = 0; ks < 2; ++ks) acc[it] = MFMA32(*(const bf16x8*)(VTF + ((sch * 4 + it * 2 + ks) * 64 + lane) * 8), *(const bf16x8*)(ATG + (sch * 32 + l31) * 32 + 16 * ks + 8 * h), acc[it]); }
        float s1 = 0.f;
#pragma unroll
        for (int it = 0; it < 2; ++it)
#pragma unroll
            for (int r = 0; r < 16; ++r) s1 += acc[it][r];
        s1 += __shfl_xor(s1, 32); const float mean = s1 * (1.0f / 64.0f); float s2 = 0.f;
#pragma unroll
        for (int it = 0; it < 2; ++it)
#pragma unroll
            for (int r = 0; r < 16; ++r) { const float d = acc[it][r] - mean; s2 += d * d; }
        s2 += __shfl_xor(s2, 32); const float rstd = 1.0f / sqrtf(s2 * (1.0f / 64.0f) + 64e-5f);
        const int rr = sub_row(sc, l31);
        if (rr >= 0) { const float bon = BON[(size_t)rr * 16 + hd];
#pragma unroll
            for (int it = 0; it < 2; ++it)
#pragma unroll
                for (int g = 0; g < 4; ++g) { const int c = hd * 64 + 32 * it + 8 * g + 4 * h;
                    const f32x4 lw = *(const f32x4*)(a.in[15] + c), lb = *(const f32x4*)(a.in[16] + c), gt = *(const f32x4*)(GATE + (size_t)rr * 1024 + c); const v2u vw = *(const v2u*)(VV + (size_t)rr * 1024 + c);
                    const float o0 = ((acc[it][4 * g] - mean) * rstd * lw.x + lb.x + bon * bflo(vw.x)) * gt.x, o1 = ((acc[it][4 * g + 1] - mean) * rstd * lw.y + lb.y + bon * bfhi(vw.x)) * gt.y;
                    const float o2 = ((acc[it][4 * g + 2] - mean) * rstd * lw.z + lb.z + bon * bflo(vw.y)) * gt.z, o3 = ((acc[it][4 * g + 3] - mean) * rstd * lw.w + lb.w + bon * bfhi(vw.y)) * gt.w;
                    *(v2u*)(Y + (size_t)rr * DM + c) = (v2u){pk2(o0, o1), pk2(o2, o3)}; } }
    }
    lru_apply(F, a);
}

constexpr int N_PHASES = 24;
template <class Epi, class Sched> DI void run_gemm(const Frame& F, const pg8::Gemm& g, const Sched& S, const Epi& E) {
    pg8::gemm_phase<Epi, Sched, true, true>(F.lds + RING_OFF, g, S, E);
}
DI void ph_moe_up(const Frame& F, const Args& a) {
    const int nt = (int)__hip_atomic_load((gu32*)(a.ws + WS_TILES) + 127, RLX_AGENT);
    pg8::Gemm g{(const bf16*)(a.ws + WS_SCR + SC_XG), (const bf16*)(a.ws + WS_MOEW), DM, DM, DM};
    pg8::MoeOrder S{(const int*)(a.ws + WS_TILES), nt, 4, F.G, (int)blockIdx.x, (long)MOE_E_BYTES};
    pg8::EpiSwiglu E{(bf16*)(a.ws + WS_SCR + SC_ACT), FF};
    run_gemm(F, g, S, E);
}
DI void ph_moe_down(const Frame& F, const Args& a) {
    const int nt = (int)__hip_atomic_load((gu32*)(a.ws + WS_TILES) + 127, RLX_AGENT);
    pg8::Gemm g{(const bf16*)(a.ws + WS_SCR + SC_ACT), (const bf16*)(a.ws + WS_MOEW + MOE_W2_OFF), FF, FF, FF};
    pg8::MoeOrder S{(const int*)(a.ws + WS_TILES), nt, 8, F.G, (int)blockIdx.x, (long)MOE_E_BYTES};
    pg8::EpiBf16 E{(bf16*)(a.ws + WS_SCR + SC_YB), DM};
    run_gemm(F, g, S, E);
}

__global__ void __launch_bounds__(NWAVES * 64, 2) hyb_fwd(Args a) {
    extern __shared__ __attribute__((aligned(16))) unsigned char lds[];
    Frame F;
    F.lds = (LAS unsigned char*)lds;
    F.MISC = (volatile LAS unsigned*)(F.lds + MISC_OFF);
    F.tid = threadIdx.x; F.lane = F.tid & 63; F.wave = __builtin_amdgcn_readfirstlane(F.tid >> 6);
    F.G = gridDim.x; { const int bx = blockIdx.x; F.vcu = (F.G % 8 == 0) ? (bx % 8) * (F.G / 8) + bx / 8 : bx; }
    F.gw = F.vcu * NWAVES + F.wave; F.NGW = F.G * NWAVES;
    F.ctl = (gu32*)(a.ws + WS_CTL);
    for (int u = F.tid; u < (LDS_BYTES - LDSCTL_OFF) / 4; u += NWAVES * 64) ((LAS unsigned*)(F.lds + LDSCTL_OFF))[u] = 0u;
    __syncthreads();
    XcdBarrier bar; bar.bar = (unsigned*)(F.ctl + CW_BAR); bar.x = 0; bar.st = nullptr;
    if (MK_ONE_LAUNCH) bar = xcd_barrier_post((unsigned*)(F.ctl + CW_BAR), F.MISC + 8);
    const int lo = a.ph_lo, hi = a.ph_hi;
#ifndef PH_MASK
#define PH_MASK 0xFFFFFFFFu
#endif
#define IN(k) (((PH_MASK >> (k)) & 1u) && lo <= (k) && (k) < hi)
#define SEAM(k) do { if (IN(k) && IN((k) + 1)) xcd_barrier(bar); } while (0)
    const bf16* HN = (const bf16*)(a.ws + WS_HN); bf16* PROJ = (bf16*)(a.ws + WS_PROJ); const bf16* YMIX = (const bf16*)(a.ws + WS_YMIX); float* H = (float*)(a.ws + WS_H);

    if (IN(0)) ph_prologue(F, a);
    SEAM(0);
    if (IN(1)) { pg8::Gemm g{HN, (const bf16*)(a.ws + WS_WEVIN), DM, DM, DM}; pg8::StaticOrder S; S.init(MP, EV_NP, F.G, (int)blockIdx.x); pg8::EpiBf16 E{PROJ, EV_NP}; run_gemm(F, g, S, E); }
    SEAM(1);
    if (IN(2)) ph_even_prep(F, a);
    SEAM(2);
    if (IN(3)) {
#ifndef NO_LORA
        { pg8::Gemm g{(const bf16*)(a.ws + WS_SCR + SC_ALORA), (const bf16*)(a.ws + WS_WLORA), 384, 384, 384}; pg8::StaticOrder S; S.init(MP, 3072, F.G, (int)blockIdx.x);
          static_assert(SC_ICL - SC_DEC == SC_GATE - SC_ICL, "lora outputs equally spaced");
          pg8::EpiLora E{(float*)(a.ws + WS_SCR + SC_DEC), (long)((SC_ICL - SC_DEC) / 4), a.in[7], a.in[9]}; run_gemm(F, g, S, E); }
#endif
#ifndef NO_GATES
        { pg8::Gemm g{(const bf16*)(a.ws + WS_SCR + SC_XR), (const bf16*)(a.ws + WS_WGATE), 256, 1024, 256}; pg8::StaticOrder S; S.init(MP, 2048, F.G, (int)blockIdx.x); S.amod = 4; S.astep = 512;
          pg8::EpiGates E{(float*)(a.ws + WS_SCR + SC_LA), (float*)(a.ws + WS_SCR + SC_LIX), a.in[20], a.in[22], a.in[23], (const bf16*)(a.ws + WS_SCR + SC_XR)}; run_gemm(F, g, S, E); }
#endif
    }
    SEAM(3);
    if (IN(4)) ph_rwkv_chunk(F, a);
    SEAM(4);
    if (IN(5)) ph_rwkv_chain(F, a);
    SEAM(5);
    if (IN(6)) ph_rwkv_out(F, a);
    SEAM(6);
    if (IN(7)) { pg8::Gemm g{YMIX, (const bf16*)(a.ws + WS_WEVOUT), DM, DM, DM}; pg8::StaticOrder S; S.init(MP, DM, F.G, (int)blockIdx.x); pg8::EpiResid E{H, a.in[0], a.in[1], 0}; run_gemm(F, g, S, E); }
    SEAM(7);
    if (IN(8)) ph_route(F, a, 0);
    SEAM(8);
    if (IN(9)) ph_gather(F, a, 0);
    SEAM(9);
    if (IN(10)) ph_moe_up(F, a);
    SEAM(10);
    if (IN(11)) ph_moe_down(F, a);
    SEAM(11);
    if (IN(12)) ph_combine(F, a, 0);
    SEAM(12);
    if (IN(13)) { pg8::Gemm g{HN, (const bf16*)(a.ws + WS_WODIN), DM, DM, DM}; pg8::StaticOrder S; S.init(MP, OD_NP, F.G, (int)blockIdx.x); pg8::EpiBf16 E{PROJ, OD_NP}; run_gemm(F, g, S, E); }
    SEAM(13);
    if (IN(14)) ph_odd_prep(F, a);
    SEAM(14);
    if (IN(15)) ph_gdn_chunk(F, a);
    SEAM(15);
    if (IN(16)) ph_gdn_chain(F, a);
    SEAM(16);
    if (IN(17)) { ph_odd_post(F, a); moe_convert(F, a, 1); }
    SEAM(17);
    if (IN(18)) { pg8::Gemm g{YMIX, (const bf16*)(a.ws + WS_WODOUT), 4096, 4096, 4096}; pg8::StaticOrder S; S.init(MP, DM, F.G, (int)blockIdx.x); pg8::EpiResid E{H, a.in[0], a.in[1], 1}; run_gemm(F, g, S, E); }
    SEAM(18);
    if (IN(19)) ph_route(F, a, 1);
    SEAM(19);
    if (IN(20)) ph_gather(F, a, 1);
    SEAM(20);
    if (IN(21)) ph_moe_up(F, a);
    SEAM(21);
    if (IN(22)) ph_moe_down(F, a);
    SEAM(22);
    if (IN(23)) ph_combine(F, a, 1);
#undef IN
#undef SEAM
}

extern "C" void kernel_launch(void* const* d_in, const int* in_sizes, int n_in, void* d_out, int out_size, void* d_ws, size_t ws_size, hipStream_t stream) {
    static int grid = 0;
    if (grid == 0) {
        if (n_in != 36 || out_size != TX * DM || ws_size < WS_END) { fprintf(stderr, "kernel_launch: unexpected shapes (n_in %d, out %d, ws %zu)\n", n_in, out_size, ws_size); grid = -1; return; }
        int dev = 0, cus = 0, per_cu = 0;
        if (hipGetDevice(&dev) != hipSuccess || hipDeviceGetAttribute(&cus, hipDeviceAttributeMultiprocessorCount, dev) != hipSuccess) { grid = -1; return; }
        if (hipFuncSetAttribute((const void*)hyb_fwd, hipFuncAttributeMaxDynamicSharedMemorySize, LDS_BYTES) != hipSuccess) { fprintf(stderr, "kernel_launch: hipFuncSetAttribute failed\n"); grid = -1; return; }
        if (hipOccupancyMaxActiveBlocksPerMultiprocessor(&per_cu, (const void*)hyb_fwd, NWAVES * 64, LDS_BYTES) != hipSuccess || per_cu < 1) { fprintf(stderr, "kernel_launch: occupancy query says %d\n", per_cu); per_cu = 1; }
        (void)hipGetLastError();
        grid = cus;
    }
    if (grid < 0) return;
    if (hipMemsetAsync((char*)d_ws + WS_CTL, 0, CTL_ZERO_BYTES, stream) != hipSuccess) return;
    Args a{};
    for (int i = 0; i < 36; ++i) a.in[i] = (const float*)d_in[i];
    a.out = (float*)d_out; a.ws = (unsigned char*)d_ws;
#if MK_ONE_LAUNCH
    a.ph_lo = 0; a.ph_hi = N_PHASES;
    hipLaunchKernelGGL(hyb_fwd, dim3(grid), dim3(NWAVES * 64), LDS_BYTES, stream, a);
#else
    for (int p = 0; p < N_PHASES; ++p) { a.ph_lo = p; a.ph_hi = p + 1; hipLaunchKernelGGL(hyb_fwd, dim3(grid), dim3(NWAVES * 64), LDS_BYTES, stream, a); }
#endif
}
```

```cpp
#include <hip/hip_runtime.h>
#include <cstdio>
#include <cstdint>
#include <cmath>

#ifndef MK_ONE_LAUNCH
#define MK_ONE_LAUNCH 1
#endif

namespace pg8 {
#define PG8_LAS __attribute__((address_space(3)))
typedef unsigned short bf16_t;
typedef short bf16x8 __attribute__((ext_vector_type(8)));
typedef float f32x4 __attribute__((ext_vector_type(4)));
typedef unsigned u32x4 __attribute__((ext_vector_type(4)));
typedef unsigned u32x2 __attribute__((ext_vector_type(2)));
constexpr int BM = 256, BK = 64, HALF = 128, HTB = HALF * BK * 2  , STAGE_BYTES = 8 * HTB, NXCD = 8, WGM = 8;

__host__ __device__ __forceinline__ int lds_byte(int r, int c) { const int st = (r >> 4) * 2 + (c >> 5), rr = r & 15, cc = c & 31, ob = rr * 64 + cc * 2; return st * 1024 + (ob ^ (((ob >> 9) & 1) << 5)); }
__host__ __device__ __forceinline__ void stage_rc(int b, int& R, int& C) { const int st = b / 1024, sb = b % 1024, swz = sb ^ (((sb >> 9) & 1) << 5); R = (st >> 1) * 16 + swz / 64; C = (st & 1) * 32 + (swz % 64) / 2; }
__host__ __device__ __forceinline__ int perm32(int rho) { const int n = rho >> 4, i = rho & 15; return 8 * (i >> 2) + 4 * n + (i & 3); }

struct Unit { int pm, pn; long aoff, boff; };
struct Gemm { const bf16_t* A; const bf16_t* Bt; int K, lda, ldb; };

struct StaticOrder {
    int nM, nN, nwg, G, c, amod; long astep;
    __host__ __device__ void init(int M, int N, int G_, int c_) { nM = M / BM; nN = N / BM; nwg = nM * nN; G = G_; c = c_; amod = 0; astep = 0; }
    __host__ __device__ bool next(int i, Unit& u) const {
        const long L = (long)i * G + c; if (L >= nwg) return false;
        int wgid = (int)L; { const int q = nwg / NXCD, r = nwg % NXCD, xcd = wgid % NXCD, off = wgid / NXCD; wgid = (xcd < r ? xcd * (q + 1) : r * (q + 1) + (xcd - r) * q) + off; }
        const int nig = WGM * nN, gid = wgid / nig, fm = gid * WGM, gsz = (nM - fm) < WGM ? (nM - fm) : WGM;
        u.pm = fm + ((wgid % nig) % gsz); u.pn = (wgid % nig) / gsz; u.boff = 0; u.aoff = amod ? (long)(u.pn % amod) * astep : 0; return true;
    }
    __device__ __forceinline__ void a_ready(const Unit&) const {}
    __device__ __forceinline__ void done(const Unit&) const {}
};
struct MoeOrder {
    const int* tile_e; int ntiles, npn, G, c; long bstride;
    __device__ __forceinline__ bool next(int i, Unit& u) const {
        const long L = (long)i * G + c; if (L >= (long)ntiles * npn) return false;
        const int t = (int)(L / npn); u.pm = t; u.pn = (int)(L % npn); u.aoff = 0; u.boff = (long)tile_e[t] * bstride; return true;
    }
    __device__ __forceinline__ void a_ready(const Unit&) const {}
    __device__ __forceinline__ void done(const Unit&) const {}
};

__device__ __forceinline__ unsigned cvt_pk_bf16(float lo, float hi) { unsigned r; asm volatile("v_cvt_pk_bf16_f32 %0, %1, %2" : "=v"(r) : "v"(lo), "v"(hi)); return r; }
__device__ __forceinline__ float bf_lo(unsigned w) { return __uint_as_float(w << 16); }
__device__ __forceinline__ float bf_hi(unsigned w) { return __uint_as_float(w & 0xffff0000u); }
__device__ __forceinline__ float sigmoidf_(float x) { return 1.0f / (1.0f + __expf(-x)); }
__device__ __forceinline__ float softplusf_(float x) { return fmaxf(x, 0.f) + __logf(1.0f + __expf(-fabsf(x))); }

struct EpiBf16 {
    static constexpr bool PERM = true, AFTER_DRAIN = false;
    bf16_t* O; int ldc;
    __device__ __forceinline__ void operator()(const f32x4 (&acc)[2][2][4][2], const Unit& u, int wr, int wc, int fr, int fq) const {
        const int row0 = u.pm * BM + wr * 64 + fr; const int col0 = u.pn * BM + wc * 32 + 8 * fq;
#pragma unroll
        for (int ai = 0; ai < 2; ++ai)
#pragma unroll
            for (int m = 0; m < 4; ++m) { bf16_t* rowp = O + (size_t)(row0 + ai * HALF + m * 16) * ldc + col0;
#pragma unroll
                for (int bj = 0; bj < 2; ++bj) { const f32x4 v0 = acc[ai][bj][m][0], v1 = acc[ai][bj][m][1];
                    u32x4 w; w.x = cvt_pk_bf16(v0[0], v0[1]); w.y = cvt_pk_bf16(v0[2], v0[3]); w.z = cvt_pk_bf16(v1[0], v1[1]); w.w = cvt_pk_bf16(v1[2], v1[3]);
                    *(u32x4*)(rowp + bj * HALF) = w; } }
    }
};
struct EpiSwiglu {
    static constexpr bool PERM = true, AFTER_DRAIN = false;
    bf16_t* O; int ldc;
    __device__ __forceinline__ void operator()(const f32x4 (&acc)[2][2][4][2], const Unit& u, int wr, int wc, int fr, int fq) const {
        const int row0 = u.pm * BM + wr * 64 + fr; const int col0 = u.pn * HALF + wc * 32 + 8 * fq;
#pragma unroll
        for (int ai = 0; ai < 2; ++ai)
#pragma unroll
            for (int m = 0; m < 4; ++m) { bf16_t* rowp = O + (size_t)(row0 + ai * HALF + m * 16) * ldc + col0;
                float o[8];
#pragma unroll
                for (int n = 0; n < 2; ++n)
#pragma unroll
                    for (int j = 0; j < 4; ++j) { const float gq = acc[ai][0][m][n][j], uq = acc[ai][1][m][n][j]; o[4 * n + j] = gq * sigmoidf_(gq) * uq; }
                u32x4 w; w.x = cvt_pk_bf16(o[0], o[1]); w.y = cvt_pk_bf16(o[2], o[3]); w.z = cvt_pk_bf16(o[4], o[5]); w.w = cvt_pk_bf16(o[6], o[7]);
                *(u32x4*)rowp = w; }
    }
};
struct EpiResid {
    static constexpr bool PERM = false, AFTER_DRAIN = false;
    float* out; const float* x; const float* meta; int mode;
    __device__ __forceinline__ void operator()(const f32x4 (&acc)[2][2][4][2], const Unit& u, int wr, int wc, int fr, int fq) const {
        const int row0 = u.pm * BM + wr * 64 + fr, col0 = u.pn * BM + wc * 32 + 4 * fq;
#pragma unroll
        for (int ai = 0; ai < 2; ++ai)
#pragma unroll
            for (int m = 0; m < 4; ++m) { const int row = row0 + ai * HALF + m * 16; float* rowp = out + (size_t)row * 2048 + col0;
                const float* bp = mode ? rowp : (row < 8192 ? x + (size_t)row * 2048 + col0 : (row < 8208 ? meta + (size_t)(row - 8192) * 2048 + col0 : nullptr));
#pragma unroll
                for (int bj = 0; bj < 2; ++bj)
#pragma unroll
                    for (int n = 0; n < 2; ++n) { f32x4 b = (f32x4){0.f, 0.f, 0.f, 0.f}; if (bp) b = *(const f32x4*)(bp + bj * HALF + n * 16);
                        *(f32x4*)(rowp + bj * HALF + n * 16) = acc[ai][bj][m][n] + b; } }
    }
};
struct EpiLora {
    static constexpr bool PERM = false, AFTER_DRAIN = false;
    float* base; long gstride; const float* w0; const float* a0;
    __device__ __forceinline__ void operator()(const f32x4 (&acc)[2][2][4][2], const Unit& u, int wr, int wc, int fr, int fq) const {
        const int grp = u.pn >> 2; const int row0 = u.pm * BM + wr * 64 + fr, col0 = (u.pn & 3) * BM + wc * 32 + 4 * fq;
        float* O = base + (size_t)grp * gstride;
#pragma unroll
        for (int bj = 0; bj < 2; ++bj)
#pragma unroll
            for (int n = 0; n < 2; ++n) { const int c = col0 + bj * HALF + n * 16;
                f32x4 bv = (f32x4){0.f, 0.f, 0.f, 0.f}; if (grp == 0) bv = *(const f32x4*)(w0 + c); else if (grp == 1) bv = *(const f32x4*)(a0 + c);
#pragma unroll
                for (int ai = 0; ai < 2; ++ai)
#pragma unroll
                    for (int m = 0; m < 4; ++m) { f32x4 v = acc[ai][bj][m][n] + bv;
                        if (grp == 0) {
#pragma unroll
                            for (int j = 0; j < 4; ++j) { const float wl = -softplusf_(-v[j]) - 0.5f; v[j] = __expf(-__expf(wl)); }
                        } else if (grp == 1) {
#pragma unroll
                            for (int j = 0; j < 4; ++j) v[j] = sigmoidf_(v[j]);
                        }
                        *(f32x4*)(O + (size_t)(row0 + ai * HALF + m * 16) * 1024 + c) = v; } }
    }
};
struct EpiGates {
    static constexpr bool PERM = false, AFTER_DRAIN = false;
    float* lru_a; float* lru_ix; const float* ba; const float* bx; const float* lam; const bf16_t* xr;
    __device__ __forceinline__ void operator()(const f32x4 (&acc)[2][2][4][2], const Unit& u, int wr, int wc, int fr, int fq) const {
        const int grp = u.pn >> 2; const int row0 = u.pm * BM + wr * 64 + fr, col0 = (u.pn & 3) * BM + wc * 32 + 4 * fq;
#pragma unroll
        for (int bj = 0; bj < 2; ++bj)
#pragma unroll
            for (int n = 0; n < 2; ++n) { const int c = col0 + bj * HALF + n * 16;
                const f32x4 bv = *(const f32x4*)((grp == 0 ? ba : bx) + c); f32x4 sp = (f32x4){0.f, 0.f, 0.f, 0.f};
                if (grp == 0) { const f32x4 l = *(const f32x4*)(lam + c);
#pragma unroll
                    for (int j = 0; j < 4; ++j) sp[j] = -8.0f * softplusf_(-l[j]); }
#pragma unroll
                for (int ai = 0; ai < 2; ++ai)
#pragma unroll
                    for (int m = 0; m < 4; ++m) { const int row = row0 + ai * HALF + m * 16; f32x4 v = acc[ai][bj][m][n] + bv;
                        if (grp == 0) {
#pragma unroll
                            for (int j = 0; j < 4; ++j) v[j] = __expf(sigmoidf_(v[j]) * sp[j]);
                            *(f32x4*)(lru_a + (size_t)row * 1024 + c) = v;
                        } else { const u32x2 xw = *(const u32x2*)(xr + (size_t)row * 1024 + c);
                            v[0] = sigmoidf_(v[0]) * bf_lo(xw.x); v[1] = sigmoidf_(v[1]) * bf_hi(xw.x); v[2] = sigmoidf_(v[2]) * bf_lo(xw.y); v[3] = sigmoidf_(v[3]) * bf_hi(xw.y);
                            *(f32x4*)(lru_ix + (size_t)row * 1024 + c) = v; } } }
    }
};

template <class Epi, class Sched, bool ALIGN_EPI = false, bool SP2 = false>
__device__ __forceinline__ void gemm_phase(PG8_LAS unsigned char* lds, const Gemm g, const Sched& S, const Epi& E) {
    const int tid = threadIdx.x, wid = __builtin_amdgcn_readfirstlane(tid >> 6), lane = tid & 63, wr = wid >> 2, wc = wid & 3, fr = lane & 15, fq = lane >> 4;
    const int K = g.K, nt = K / BK;
    unsigned voffA[2], voffB[2];
#pragma unroll
    for (int i = 0; i < 2; ++i) { int R, C; stage_rc(tid * 16 + i * 8192, R, C); const int Rb = Epi::PERM ? ((R & ~31) + perm32(R & 31)) : R;
        voffA[i] = (unsigned)(R * g.lda + C) * 2u; voffB[i] = (unsigned)(Rb * g.ldb + C) * 2u; }
    const size_t kstep = (size_t)(BK * 2);
    const size_t hstepA = (size_t)HALF * g.lda * 2, hstepB = (size_t)HALF * g.ldb * 2;
    const size_t tstepA = 2 * hstepA, tstepB = 2 * hstepB;
    const unsigned ldsw = (unsigned)wid * 1024u;
    const int aoff = lds_byte(wr * 64 + fr, fq * 8), boff = lds_byte(wc * 32 + fr, fq * 8);
#define PG8_SA(b, h) (((b) * 2 + (h)) * HTB)
#define PG8_SB(b, h) ((4 + (b) * 2 + (h)) * HTB)
#define PG8_STAGE(bufoff, gbase, voff) do { _Pragma("unroll") for (int _i = 0; _i < 2; ++_i) \
        __builtin_amdgcn_global_load_lds((const unsigned*)((const char*)(gbase) + (voff)[_i]), (PG8_LAS unsigned*)(lds + (bufoff) + ldsw + _i * 8192), 16, 0, 0); } while (0)
#define PG8_LDA(dst, b, h) do { _Pragma("unroll") for (int m = 0; m < 4; ++m) _Pragma("unroll") for (int k = 0; k < 2; ++k) dst[m][k] = *(const PG8_LAS bf16x8*)(lds + PG8_SA(b, h) + aoff + m * 2048 + k * 1024); } while (0)
#define PG8_LDB(dst, b, h) do { _Pragma("unroll") for (int n = 0; n < 2; ++n) _Pragma("unroll") for (int k = 0; k < 2; ++k) dst[n][k] = *(const PG8_LAS bf16x8*)(lds + PG8_SB(b, h) + boff + n * 2048 + k * 1024); } while (0)
#define PG8_MMA(ai, bj, At, Bt) do { __builtin_amdgcn_s_setprio(1); _Pragma("unroll") for (int m = 0; m < 4; ++m) _Pragma("unroll") for (int n = 0; n < 2; ++n) _Pragma("unroll") for (int k = 0; k < 2; ++k) \
        acc[ai][bj][m][n] = __builtin_amdgcn_mfma_f32_16x16x32_bf16(Bt[n][k], At[m][k], acc[ai][bj][m][n], 0, 0, 0); __builtin_amdgcn_s_setprio(0); } while (0)
#define PG8_WAIT_V(n) asm volatile("s_waitcnt vmcnt(" #n ")" ::: "memory")
#define PG8_WAIT_L(n) asm volatile("s_waitcnt lgkmcnt(" #n ")" ::: "memory")
#define PG8_BAR __builtin_amdgcn_s_barrier()
#define PG8_SCHED __builtin_amdgcn_sched_barrier(0)
    Unit cur, nxt; int ui = 0;
    if (!S.next(0, cur)) return;
    f32x4 acc[2][2][4][2];
#pragma unroll
    for (int a = 0; a < 2; ++a)
#pragma unroll
        for (int b = 0; b < 2; ++b)
#pragma unroll
            for (int m = 0; m < 4; ++m)
#pragma unroll
                for (int n = 0; n < 2; ++n) acc[a][b][m][n] = (f32x4){0.f, 0.f, 0.f, 0.f};
    bf16x8 At[4][2], B0[2][2], B1[2][2];
    const char* cA = (const char*)g.A + (size_t)cur.pm * tstepA + cur.aoff; const char* cB = (const char*)g.Bt + (size_t)cur.pn * tstepB + cur.boff;
    S.a_ready(cur);
    if constexpr (SP2) {
        PG8_STAGE(PG8_SB(0, 0), cB, voffB); PG8_STAGE(PG8_SB(0, 1), cB + hstepB, voffB); PG8_STAGE(PG8_SA(0, 0), cA, voffA); PG8_STAGE(PG8_SA(0, 1), cA + hstepA, voffA);
        if (wr == 1) PG8_BAR;
        PG8_WAIT_V(2); PG8_BAR;
        PG8_STAGE(PG8_SB(1, 0), cB + kstep, voffB); PG8_STAGE(PG8_SA(1, 0), cA + kstep, voffA); PG8_STAGE(PG8_SB(1, 1), cB + hstepB + kstep, voffB);
        PG8_WAIT_V(6); PG8_BAR;
    } else {
        PG8_STAGE(PG8_SB(0, 0), cB, voffB); PG8_STAGE(PG8_SA(0, 0), cA, voffA); PG8_STAGE(PG8_SB(0, 1), cB + hstepB, voffB); PG8_STAGE(PG8_SA(0, 1), cA + hstepA, voffA);
        if (wr == 1) PG8_BAR;
        PG8_WAIT_V(4); PG8_BAR;
        PG8_STAGE(PG8_SB(1, 0), cB + kstep, voffB); PG8_STAGE(PG8_SA(1, 0), cA + kstep, voffA); PG8_STAGE(PG8_SB(1, 1), cB + hstepB + kstep, voffB);
        PG8_WAIT_V(6); PG8_BAR;
    }
    for (;;) {
        const bool has_next = S.next(ui + 1, nxt);
        const char* nA = has_next ? (const char*)g.A + (size_t)nxt.pm * tstepA + nxt.aoff : cA; const char* nB = has_next ? (const char*)g.Bt + (size_t)nxt.pn * tstepB + nxt.boff : cB;
        for (int t = 0; t < nt; t += 2) {
            const bool last = (t == nt - 2);
            const char* a1 = cA + (size_t)(t + 1) * kstep;
            const char* a2 = last ? nA : cA + (size_t)(t + 2) * kstep; const char* b2 = last ? nB : cB + (size_t)(t + 2) * kstep;
            const char* a3 = a2 + kstep; const char* b3 = b2 + kstep;
            if (last && has_next) S.a_ready(nxt);
            if constexpr (SP2) {
            PG8_LDB(B0, 0, 0); PG8_LDB(B1, 0, 1); PG8_SCHED; PG8_LDA(At, 0, 0); PG8_STAGE(PG8_SA(1, 1), a1 + hstepA, voffA);
            PG8_WAIT_V(8); PG8_WAIT_L(0); PG8_BAR; PG8_MMA(0, 0, At, B0); PG8_MMA(0, 1, At, B1); PG8_BAR; PG8_SCHED;
            PG8_LDA(At, 0, 1); PG8_STAGE(PG8_SB(0, 0), b2, voffB); PG8_STAGE(PG8_SB(0, 1), b2 + hstepB, voffB); PG8_STAGE(PG8_SA(0, 0), a2, voffA);
            PG8_WAIT_V(8); PG8_WAIT_L(0); PG8_BAR; PG8_MMA(1, 0, At, B0); PG8_MMA(1, 1, At, B1); PG8_BAR; PG8_SCHED;
            PG8_LDB(B0, 1, 0); PG8_LDB(B1, 1, 1); PG8_SCHED; PG8_LDA(At, 1, 0); PG8_STAGE(PG8_SA(0, 1), a2 + hstepA, voffA);
            PG8_WAIT_V(8); PG8_WAIT_L(0); PG8_BAR; PG8_MMA(0, 0, At, B0); PG8_MMA(0, 1, At, B1); PG8_BAR; PG8_SCHED;
            PG8_LDA(At, 1, 1); PG8_STAGE(PG8_SB(1, 0), b3, voffB); PG8_STAGE(PG8_SB(1, 1), b3 + hstepB, voffB); PG8_STAGE(PG8_SA(1, 0), a3, voffA);
            PG8_WAIT_V(8); PG8_WAIT_L(0); PG8_BAR; PG8_MMA(1, 0, At, B0); PG8_MMA(1, 1, At, B1); PG8_BAR; PG8_SCHED;
            } else {
            PG8_LDB(B0, 0, 0); PG8_SCHED; PG8_LDA(At, 0, 0); PG8_STAGE(PG8_SA(1, 1), a1 + hstepA, voffA);
            PG8_WAIT_L(8); PG8_BAR; PG8_WAIT_L(0); PG8_MMA(0, 0, At, B0); PG8_BAR; PG8_SCHED;
            PG8_LDB(B1, 0, 1); PG8_STAGE(PG8_SB(0, 0), b2, voffB);
            PG8_BAR; PG8_WAIT_L(0); PG8_MMA(0, 1, At, B1); PG8_BAR;
            PG8_LDA(At, 0, 1); PG8_STAGE(PG8_SA(0, 0), a2, voffA);
            PG8_BAR; PG8_WAIT_L(0); PG8_MMA(1, 0, At, B0); PG8_BAR; PG8_SCHED;
            PG8_STAGE(PG8_SB(0, 1), b2 + hstepB, voffB);
            PG8_WAIT_V(6); PG8_BAR; PG8_MMA(1, 1, At, B1); PG8_BAR;
            PG8_LDB(B0, 1, 0); PG8_SCHED; PG8_LDA(At, 1, 0); PG8_STAGE(PG8_SA(0, 1), a2 + hstepA, voffA);
            PG8_WAIT_L(8); PG8_BAR; PG8_WAIT_L(0); PG8_MMA(0, 0, At, B0); PG8_BAR; PG8_SCHED;
            PG8_LDB(B1, 1, 1); PG8_STAGE(PG8_SB(1, 0), b3, voffB);
            PG8_BAR; PG8_WAIT_L(0); PG8_MMA(0, 1, At, B1); PG8_BAR;
            PG8_LDA(At, 1, 1); PG8_STAGE(PG8_SA(1, 0), a3, voffA);
            PG8_BAR; PG8_WAIT_L(0); PG8_MMA(1, 0, At, B0); PG8_BAR; PG8_SCHED;
            PG8_STAGE(PG8_SB(1, 1), b3 + hstepB, voffB);
            PG8_WAIT_V(6); PG8_BAR; PG8_MMA(1, 1, At, B1); PG8_BAR;
            }
        }
        if constexpr (ALIGN_EPI) { if (wr == 0) PG8_BAR; }
        if constexpr (!Epi::AFTER_DRAIN) { E(acc, cur, wr, wc, fr, fq); S.done(cur); }
        if (!has_next) break;
#pragma unroll
        for (int a = 0; a < 2; ++a)
#pragma unroll
            for (int b = 0; b < 2; ++b)
#pragma unroll
                for (int m = 0; m < 4; ++m)
#pragma unroll
                    for (int n = 0; n < 2; ++n) acc[a][b][m][n] = (f32x4){0.f, 0.f, 0.f, 0.f};
        cur = nxt; cA = nA; cB = nB; ++ui;
        if constexpr (ALIGN_EPI) { if (wr == 1) PG8_BAR; }
    }
    PG8_WAIT_V(0);
    if constexpr (!ALIGN_EPI) { if (wr == 0) PG8_BAR; }
    PG8_BAR;
    if constexpr (Epi::AFTER_DRAIN) { E.fused(acc, cur, wr, wc, fr, fq, lds, wid, lane); S.done(cur); }
#undef PG8_SA
#undef PG8_SB
#undef PG8_STAGE
#undef PG8_LDA
#undef PG8_LDB
#undef PG8_MMA
#undef PG8_WAIT_V
#undef PG8_WAIT_L
#undef PG8_BAR
#undef PG8_SCHED
}
}
#define GAS __attribute__((address_space(1)))
#define LAS __attribute__((address_space(3)))
typedef unsigned short bf16;
typedef unsigned v4u __attribute__((ext_vector_type(4)));
typedef float f32x4 __attribute__((ext_vector_type(4)));
typedef short bf16x8 __attribute__((ext_vector_type(8)));
typedef GAS unsigned gu32;
typedef GAS unsigned long long gu64;
#define RLX_AGENT __ATOMIC_RELAXED, __HIP_MEMORY_SCOPE_AGENT
#define LDS_WAIT() asm volatile("s_waitcnt lgkmcnt(0)" ::: "memory")
#define VM_WAIT() asm volatile("s_waitcnt vmcnt(0)" ::: "memory")
__device__ __forceinline__ unsigned long long rt() { return __builtin_amdgcn_s_memrealtime(); }
__device__ __forceinline__ unsigned f2bf(float f) { unsigned u = __builtin_bit_cast(unsigned, f); return (u + 0x7fffu + ((u >> 16) & 1u)) >> 16; }
__device__ __forceinline__ unsigned pk2(float lo, float hi) { return f2bf(lo) | (f2bf(hi) << 16); }

#define XB_TMO      128
#define XB_XCNT(j)  (256  + 64 * (j))
#define XB_XSUB(j)  (1280 + 64 * (j))
#define XB_XGEN(j)  (2304 + 64 * (j))
#define XB_TOP      3328
#define XB_TOPGEN   3392
#define XCD_BAR_WORDS 3456
#define XB_SPIN_CAP (1u << 18)

__device__ __forceinline__ unsigned xb_ld(unsigned* p)              { return __hip_atomic_load(p, __ATOMIC_RELAXED, __HIP_MEMORY_SCOPE_AGENT); }
__device__ __forceinline__ unsigned xb_add(unsigned* p, unsigned v) { return __hip_atomic_fetch_add(p, v, __ATOMIC_RELAXED, __HIP_MEMORY_SCOPE_AGENT); }
__device__ __forceinline__ unsigned xb_xcc_id() { return (unsigned)__builtin_amdgcn_s_getreg((3 << 11) | 20) & 0xFu; }
#define XB_SPIN(cond, bar) do { unsigned _sp = 0; while (cond) { __builtin_amdgcn_s_sleep(1); \
    if ((++_sp & 255u) == 0u) { if (xb_ld(&(bar)[XB_TMO])) break; if (_sp > XB_SPIN_CAP) { atomicAdd(&(bar)[XB_TMO], 1u); break; } } } } while (0)

struct XcdBarrier {
    unsigned* bar; unsigned x;
    volatile LAS unsigned* st;
};

__device__ __forceinline__ XcdBarrier xcd_barrier_post(unsigned* bar, volatile LAS unsigned* st) {
    XcdBarrier b; b.bar = bar; b.x = xb_xcc_id(); b.st = st;
    if (threadIdx.x == 0) (void)xb_add(&bar[XB_XCNT(b.x)], 1u);
    return b;
}
__device__ __forceinline__ void xcd_barrier_complete(unsigned* bar, unsigned x, unsigned& nloc, unsigned& nx) {
    const unsigned G = gridDim.x * gridDim.y * gridDim.z;
    unsigned sum, cnt, mine, sp = 0u;
    for (;;) {
        sum = 0u; cnt = 0u; mine = 0u;
#pragma unroll
        for (unsigned j = 0; j < 16; ++j) { const unsigned c = xb_ld(&bar[XB_XCNT(j)]); sum += c; cnt += (c > 0u) ? 1u : 0u; mine = (j == x) ? c : mine; }
        if (sum == G) break;
        __builtin_amdgcn_s_sleep(1);
        if ((++sp & 255u) == 0u) { if (xb_ld(&bar[XB_TMO])) break; if (sp > XB_SPIN_CAP) { atomicAdd(&bar[XB_TMO], 1u); break; } }
    }
    nloc = mine > 0u ? mine : 1u; nx = cnt > 0u ? cnt : 1u;
}

__device__ __forceinline__ void xcd_barrier(const XcdBarrier& b) {
    asm volatile("s_waitcnt vmcnt(0)" ::: "memory");
    __syncthreads();
    if (threadIdx.x == 0) {
        unsigned* bar = b.bar;
        __builtin_amdgcn_s_waitcnt(0);
        unsigned nloc = b.st[0], nx = b.st[1];
        if (nloc == 0u) { xcd_barrier_complete(bar, b.x, nloc, nx); b.st[0] = nloc; b.st[1] = nx; }
        const unsigned old = xb_add(&bar[XB_XSUB(b.x)], 1u);
        const unsigned gen = old / nloc;
        if (old + 1u == (gen + 1u) * nloc) {
            __builtin_amdgcn_fence(__ATOMIC_RELEASE, "agent");
            asm volatile("s_waitcnt vmcnt(0)" ::: "memory");
            const unsigned og = xb_add(&bar[XB_TOP], 1u);
            const unsigned tg = og / nx;
            if (og + 1u == (tg + 1u) * nx) xb_add(&bar[XB_TOPGEN], 1u);
            else XB_SPIN(xb_ld(&bar[XB_TOPGEN]) == tg, bar);
            __builtin_amdgcn_fence(__ATOMIC_ACQUIRE, "agent");
            xb_add(&bar[XB_XGEN(b.x)], 1u);
            asm volatile("s_waitcnt vmcnt(0)" ::: "memory");
        } else {
            XB_SPIN(xb_ld(&bar[XB_XGEN(b.x)]) == gen, bar);
            __builtin_amdgcn_fence(__ATOMIC_ACQUIRE, "agent");
            asm volatile("s_waitcnt vmcnt(0)" ::: "memory");
        }
    }
    __syncthreads();
}

constexpr int NWAVES = 8;
constexpr int DM = 2048, TX = 8192, NMETA = 16, TT = TX + NMETA, MP = 8448;
constexpr int EV_NP = 5632, EV_LORA0 = 3072, EV_GB = 3360, EV_REC = 4384;
constexpr int OD_NP = 12544, OD_Z = 8192, OD_B = 12288, OD_A = 12320;
constexpr int NEXP = 32, FF = 512, MOE_ROWS = 24576;
constexpr float NORM_EPS = 1e-6f;

constexpr size_t MiB = 1u << 20;
constexpr size_t WS_CTL = 0, CTL_ZERO_BYTES = 1 * MiB;
constexpr size_t WS_TOKINFO = 1 * MiB;
constexpr size_t WS_TILES = 1 * MiB + 512 * 1024;
constexpr size_t WS_WEVIN = 2 * MiB;
constexpr size_t WS_WEVOUT = 24 * MiB;
constexpr size_t WS_WODIN = 32 * MiB;
constexpr size_t WS_WODOUT = 81 * MiB;
constexpr size_t WS_WLORA = 97 * MiB;
constexpr size_t WS_WGATE = 100 * MiB;
constexpr size_t WS_MOEW = 102 * MiB;
constexpr size_t MOE_E_BYTES = 6 * MiB, MOE_W2_OFF = 4 * MiB;
constexpr size_t WS_H = 294 * MiB;
constexpr size_t WS_HN = 360 * MiB;
constexpr size_t WS_YMIX = 393 * MiB;
constexpr size_t WS_PROJ = 459 * MiB;
constexpr size_t WS_SCR = 662 * MiB;
constexpr size_t WS_END = 932 * MiB;
constexpr size_t SC_ALORA = 0;
constexpr size_t SC_XR = 8 * MiB;
constexpr size_t SC_DEC = 26 * MiB, SC_ICL = 60 * MiB, SC_GATE = 94 * MiB;
constexpr size_t SC_LA = 128 * MiB, SC_LIX = 162 * MiB;
constexpr size_t SC_QN = 0, SC_KN = 34 * MiB;
constexpr size_t SC_VC = 68 * MiB;
constexpr size_t SC_BETA = 134 * MiB, SC_G = 136 * MiB;
constexpr size_t SC_O = 138 * MiB;
constexpr size_t SC_XG = 0;
constexpr size_t SC_ACT = 96 * MiB;
constexpr size_t SC_YB = 120 * MiB;
static_assert(SC_O + (size_t)MP * 4096 * 4 <= WS_END - WS_SCR && SC_YB + (size_t)MOE_ROWS * 2048 * 2 <= WS_END - WS_SCR && SC_LIX + (size_t)MP * 1024 * 4 <= WS_END - WS_SCR, "scratch map");
constexpr int CW_TMO = 0, CW_CODE = 1;
constexpr int CW_BAR = 4096;
constexpr int CW_PROG = 20480;
constexpr int CW_TS = 24576;
constexpr int CW_MOECNT = 16384;

constexpr int RING_OFF = 0, RING_BYTES = 131072;
constexpr int LDSCTL_OFF = 146944, MISC_OFF = LDSCTL_OFF + 320;
constexpr int LDS_BYTES = 147456;


#define DI __device__ __forceinline__
typedef unsigned v2u __attribute__((ext_vector_type(2)));
struct Args { const float* in[36]; float* out; unsigned char* ws; int ph_lo, ph_hi; };
struct Frame {
    LAS unsigned char* lds; volatile LAS unsigned* MISC; gu32* ctl;
    int tid, lane, wave, vcu, G, gw, NGW;
};
DI float bf2f(bf16 v) { return __uint_as_float((unsigned)v << 16); }
DI float bflo(unsigned w) { return __uint_as_float(w << 16); }
DI float bfhi(unsigned w) { return __uint_as_float(w & 0xffff0000u); }
DI float wave_sum(float v) {
#pragma unroll
    for (int o = 1; o < 64; o <<= 1) v += __shfl_xor(v, o);
    return v;
}
DI float sigm(float x) { return 1.0f / (1.0f + __expf(-x)); }
DI float softplus(float x) { return fmaxf(x, 0.f) + __logf(1.0f + __expf(-fabsf(x))); }
DI float gelu_tanh(float x) { const float u = 0.7978845608028654f * (x + 0.044715f * x * x * x); return 0.5f * x * (1.0f + tanhf(u)); }
DI int pos_row(int p) { return p < NMETA ? TX + p : p - NMETA; }
DI int row_pos(int r) { return r < TX ? r + NMETA : r - TX; }

DI void tr_item(const float* W, int N, int k0, int n0, bf16* WT, int ldk, int drow0, LAS float* scr, int lane) {
#pragma unroll 8
    for (int i = 0; i < 32; ++i) { const int kk = 2 * i + (lane >> 5); scr[kk * 33 + (lane & 31)] = W[(size_t)(k0 + kk) * N + n0 + (lane & 31)]; }
    LDS_WAIT(); asm volatile("" ::: "memory");
    const int c = lane & 7;
#pragma unroll
    for (int j = 0; j < 4; ++j) { const int n = (lane >> 3) + 8 * j; const LAS float* s = scr + (8 * c) * 33 + n;
        v4u o; o.x = pk2(s[0 * 33], s[1 * 33]); o.y = pk2(s[2 * 33], s[3 * 33]); o.z = pk2(s[4 * 33], s[5 * 33]); o.w = pk2(s[6 * 33], s[7 * 33]);
        *(v4u*)(WT + (size_t)(drow0 + n) * ldk + k0 + 8 * c) = o; }
    LDS_WAIT(); asm volatile("" ::: "memory");
}
DI void moe_convert(const Frame& F, const Args& a, int l) {
    LAS float* scr = (LAS float*)(F.lds + RING_OFF + F.wave * 16384);
    bf16* base = (bf16*)(a.ws + WS_MOEW);
    for (int it = F.gw; it < NEXP * 1536; it += F.NGW) {
        const int e = it / 1536; int j = it % 1536; bf16* eb = base + (size_t)e * (MOE_E_BYTES / 2);
        const size_t eoff = (size_t)(l * NEXP + e) * DM * FF;
        if (j < 1024) { const float* W = (j < 512 ? a.in[33] : a.in[34]) + eoff; const int hi = j >= 512; j &= 511; const int kb = j >> 4, nb = j & 15, n0 = 32 * nb;
            tr_item(W, FF, 64 * kb, n0, eb, DM, 256 * (n0 >> 7) + 128 * hi + (n0 & 127), scr, F.lane); }
        else { j -= 1024; const int kb = j >> 6, nb = j & 63; tr_item(a.in[35] + eoff, DM, 64 * kb, 32 * nb, eb + MOE_W2_OFF / 2, FF, 32 * nb, scr, F.lane); }
    }
}
DI void norm_row_bf16(int lane, const float* src, const float* w, bf16* dst) {
    f32x4 v[8]; float s = 0.f;
#pragma unroll
    for (int j = 0; j < 8; ++j) { v[j] = ((const f32x4*)src)[lane + 64 * j]; s += (v[j].x * v[j].x + v[j].y * v[j].y) + (v[j].z * v[j].z + v[j].w * v[j].w); }
    const float rs = 1.0f / sqrtf(wave_sum(s) * (1.0f / DM) + NORM_EPS);
#pragma unroll
    for (int j = 0; j < 8; ++j) { const f32x4 wv = ((const f32x4*)w)[lane + 64 * j]; v2u o; o.x = pk2(v[j].x * rs * wv.x, v[j].y * rs * wv.y); o.y = pk2(v[j].z * rs * wv.z, v[j].w * rs * wv.w);
        ((v2u*)dst)[lane + 64 * j] = o; }
}

DI void ph_prologue(const Frame& F, const Args& a) {
    LAS float* scr = (LAS float*)(F.lds + RING_OFF + F.wave * 16384);
    constexpr int I_A = 32 * 169, I_B = 32 * 64, I_C = 32 * 386, I_D = 64 * 64, NIT = I_A + I_B + I_C + I_D;
    for (int it = F.gw; it < NIT; it += F.NGW) {
        int r = it;
        if (r < I_A) { const int kb = r / 169, nb = r % 169; tr_item(a.in[5], 5408, 64 * kb, 32 * nb, (bf16*)(a.ws + WS_WEVIN), DM, 32 * nb, scr, F.lane); continue; } r -= I_A;
        if (r < I_B) { const int kb = r / 64, nb = r % 64; tr_item(a.in[24], DM, 64 * kb, 32 * nb, (bf16*)(a.ws + WS_WEVOUT), DM, 32 * nb, scr, F.lane); continue; } r -= I_B;
        if (r < I_C) { const int kb = r / 386, nb = r % 386; tr_item(a.in[25], 12352, 64 * kb, 32 * nb, (bf16*)(a.ws + WS_WODIN), DM, 32 * nb, scr, F.lane); continue; } r -= I_C;
        { const int kb = r / 64, nb = r % 64; tr_item(a.in[30], DM, 64 * kb, 32 * nb, (bf16*)(a.ws + WS_WODOUT), 4096, 32 * nb, scr, F.lane); }
    }
    moe_convert(F, a, 0);
    const int gt = F.vcu * (NWAVES * 64) + F.tid, NGT = F.G * NWAVES * 64;
    { bf16* WL = (bf16*)(a.ws + WS_WLORA); const float* wup = a.in[8]; const float* aup = a.in[10]; const float* gup = a.in[11];
      for (int idx = gt; idx < 3072 * 384; idx += NGT) { const int n = idx / 384, k = idx % 384; float v = 0.f;
          if (n < 1024) { if (k < 64) v = wup[k * 1024 + n]; }
          else if (n < 2048) { if (k >= 64 && k < 128) v = aup[(k - 64) * 1024 + n - 1024]; }
          else { if (k >= 128 && k < 288) v = gup[(k - 128) * 1024 + n - 2048]; }
          WL[idx] = (bf16)f2bf(v); } }
    { bf16* WG = (bf16*)(a.ws + WS_WGATE);
      for (int idx = gt; idx < 2048 * 256; idx += NGT) { const int n = idx >> 8, kk = idx & 255, nn = n & 1023, blk = nn >> 6, j = nn & 63, cin = (nn & ~255) + kk;
          const float* W = n < 1024 ? a.in[19] : a.in[21];
          const float v = (cin >> 6) == blk ? W[blk * 4096 + (cin & 63) * 64 + j] : 0.f;
          WG[idx] = (bf16)f2bf(v); } }
    bf16* HN = (bf16*)(a.ws + WS_HN);
    for (int r = F.gw; r < TT; r += F.NGW) norm_row_bf16(F.lane, r < TX ? a.in[0] + (size_t)r * DM : a.in[1] + (size_t)(r - TX) * DM, a.in[2], HN + (size_t)r * DM);
}

DI void ph_even_prep(const Frame& F, const Args& a) {
    const bf16* P = (const bf16*)(a.ws + WS_PROJ); bf16* AL = (bf16*)(a.ws + WS_SCR + SC_ALORA); bf16* XR = (bf16*)(a.ws + WS_SCR + SC_XR);
    const float* mu = a.in[6]; const float* cw = a.in[17]; const float* cb = a.in[18];
    const int lane = F.lane;
    for (int r = F.gw; r < TT; r += F.NGW) {
        const int pos = row_pos(r); const bf16* cur = P + (size_t)r * EV_NP; const bf16* prv = pos > 0 ? P + (size_t)pos_row(pos - 1) * EV_NP : nullptr;
#pragma unroll
        for (int i = 0; i < 6; ++i) { const int idx = lane + 64 * i; float v = 0.f;
            if (idx < 288) { const int col = EV_LORA0 + idx; const float c = bf2f(cur[col]), p = prv ? bf2f(prv[col]) : 0.f; v = c + (p - c) * mu[col];
                if (idx < 64) v = tanhf(v); else if (idx >= 128) v = sigm(v); }
            AL[(size_t)r * 384 + idx] = (bf16)f2bf(v); }
        const int c0 = lane * 16; float acc[16];
#pragma unroll
        for (int i = 0; i < 4; ++i) { const f32x4 b = *(const f32x4*)(cb + c0 + 4 * i); acc[4 * i] = b.x; acc[4 * i + 1] = b.y; acc[4 * i + 2] = b.z; acc[4 * i + 3] = b.w; }
#pragma unroll
        for (int j = 0; j < 4; ++j) { const int pj = pos - 3 + j; if (pj < 0) continue;
            const bf16* src = P + (size_t)pos_row(pj) * EV_NP + EV_REC + c0; const v4u x0 = *(const v4u*)src, x1 = *(const v4u*)(src + 8);
            const unsigned xw[8] = {x0.x, x0.y, x0.z, x0.w, x1.x, x1.y, x1.z, x1.w};
#pragma unroll
            for (int i = 0; i < 4; ++i) { const f32x4 w = *(const f32x4*)(cw + j * 1024 + c0 + 4 * i);
                acc[4 * i] += w.x * bflo(xw[2 * i]); acc[4 * i + 1] += w.y * bfhi(xw[2 * i]); acc[4 * i + 2] += w.z * bflo(xw[2 * i + 1]); acc[4 * i + 3] += w.w * bfhi(xw[2 * i + 1]); } }
        v4u o0, o1; o0.x = pk2(acc[0], acc[1]); o0.y = pk2(acc[2], acc[3]); o0.z = pk2(acc[4], acc[5]); o0.w = pk2(acc[6], acc[7]);
        o1.x = pk2(acc[8], acc[9]); o1.y = pk2(acc[10], acc[11]); o1.z = pk2(acc[12], acc[13]); o1.w = pk2(acc[14], acc[15]);
        bf16* dst = XR + (size_t)r * 1024 + c0; *(v4u*)dst = o0; *(v4u*)(dst + 8) = o1;
    }
}

DI void ph_route(const Frame& F, const Args& a, int l, int dummy) {
    const float* H = (const float*)(a.ws + WS_H); const float* nw = a.in[3] + (size_t)l * DM;
    const float* RG = a.in[31] + (size_t)l * DM * 4; const float* RE = a.in[32] + (size_t)l * DM * NEXP;
    unsigned* TI = (unsigned*)(a.ws + WS_TOKINFO) + (dummy ? (WS_SCR + 250 * MiB - WS_TOKINFO) / 4 : 0); const int lane = F.lane; const int cl = dummy ? l + 2 : l;
    for (int r = F.gw; r < TT; r += F.NGW) {
        const float* hr = H + (size_t)r * DM; float s = 0.f;
#pragma unroll
        for (int j = 0; j < 8; ++j) { const f32x4 v = ((const f32x4*)hr)[lane + 64 * j]; s += (v.x * v.x + v.y * v.y) + (v.z * v.z + v.w * v.w); }
        const float rs = 1.0f / sqrtf(wave_sum(s) * (1.0f / DM) + NORM_EPS);
        float acc[36];
#pragma unroll
        for (int i = 0; i < 36; ++i) acc[i] = 0.f;
#pragma unroll 1
        for (int j = 0; j < 8; ++j) { const f32x4 v = ((const f32x4*)hr)[lane + 64 * j]; const f32x4 wv = ((const f32x4*)nw)[lane + 64 * j]; const float xn[4] = {v.x * rs * wv.x, v.y * rs * wv.y, v.z * rs * wv.z, v.w * rs * wv.w};
#pragma unroll
            for (int q = 0; q < 4; ++q) { const int k = (lane + 64 * j) * 4 + q; const f32x4* we = (const f32x4*)(RE + (size_t)k * NEXP);
#pragma unroll
                for (int t = 0; t < 8; ++t) { const f32x4 w = we[t]; acc[4 * t] += xn[q] * w.x; acc[4 * t + 1] += xn[q] * w.y; acc[4 * t + 2] += xn[q] * w.z; acc[4 * t + 3] += xn[q] * w.w; }
                const f32x4 wg = *(const f32x4*)(RG + (size_t)k * 4); acc[32] += xn[q] * wg.x; acc[33] += xn[q] * wg.y; acc[34] += xn[q] * wg.z; acc[35] += xn[q] * wg.w;
                asm volatile("" ::: "memory"); } }
#pragma unroll
        for (int i = 0; i < 36; ++i) acc[i] = wave_sum(acc[i]);
        int gi = 0; float gm = acc[32];
#pragma unroll
        for (int i = 1; i < 4; ++i) if (acc[32 + i] > gm) { gm = acc[32 + i]; gi = i; }
        float den = 0.f;
#pragma unroll
        for (int i = 0; i < 4; ++i) den += __expf(acc[32 + i] - gm);
        const float gp = 1.0f / den;
        float l8[8];
#pragma unroll
        for (int i = 0; i < 8; ++i) l8[i] = gi == 0 ? acc[i] : (gi == 1 ? acc[8 + i] : (gi == 2 ? acc[16 + i] : acc[24 + i]));
        int i1 = 0; float m1 = l8[0];
#pragma unroll
        for (int i = 1; i < 8; ++i) if (l8[i] > m1) { m1 = l8[i]; i1 = i; }
        int i2 = -1; float m2 = -INFINITY;
#pragma unroll
        for (int i = 0; i < 8; ++i) if (i != i1 && l8[i] > m2) { m2 = l8[i]; i2 = i; }
        const float e21 = __expf(m2 - m1); const float w1 = gp / (1.0f + e21), w2 = gp * e21 / (1.0f + e21);
        if (lane == 0) { const int ea = gi * 8 + i1, eb = gi * 8 + i2;
            const unsigned sa = atomicAdd((unsigned*)(F.ctl + CW_MOECNT + (cl * NEXP + ea) * 16), 1u), sb = atomicAdd((unsigned*)(F.ctl + CW_MOECNT + (cl * NEXP + eb) * 16), 1u);
            unsigned* t = TI + (size_t)r * 8; t[0] = ea; t[1] = sa; t[2] = __float_as_uint(w1); t[3] = eb; t[4] = sb; t[5] = __float_as_uint(w2); t[6] = __float_as_uint(rs); t[7] = 0u; }
    }
}
DI void moe_prefix(const Frame& F, int l, LAS int* ps) {
    if (F.tid == 0) { int t = 0;
        for (int e = 0; e < NEXP; ++e) { const unsigned c = __hip_atomic_load(F.ctl + CW_MOECNT + (l * NEXP + e) * 16, RLX_AGENT); ps[e] = t * 256; t += (int)((c + 255u) >> 8); }
        ps[32] = t; }
    __syncthreads();
}
DI void ph_gather(const Frame& F, const Args& a, int l) {
    LAS int* ps = (LAS int*)(F.lds + RING_OFF); moe_prefix(F, l, ps);
    if (F.vcu == 0 && F.tid < NEXP) { int* TE = (int*)(a.ws + WS_TILES); const int e = F.tid; const int t0 = ps[e] >> 8, t1 = (e == NEXP - 1 ? ps[32] : ps[e + 1] >> 8);
        for (int t = t0; t < t1; ++t) TE[t] = e; if (e == 0) TE[127] = ps[32]; }
    const float* H = (const float*)(a.ws + WS_H); const float* nw = a.in[3] + (size_t)l * DM; unsigned* TI = (unsigned*)(a.ws + WS_TOKINFO); bf16* XG = (bf16*)(a.ws + WS_SCR + SC_XG);
    const int lane = F.lane;
    for (int r = F.gw; r < TT; r += F.NGW) {
        unsigned* t = TI + (size_t)r * 8; const int g0 = ps[t[0]] + (int)t[1], g1 = ps[t[3]] + (int)t[4]; const float rs = __uint_as_float(t[6]);
        if (lane == 0) { t[1] = (unsigned)g0; t[4] = (unsigned)g1; }
        const float* hr = H + (size_t)r * DM;
#pragma unroll
        for (int j = 0; j < 4; ++j) { const int e0 = (lane + 64 * j) * 8; const f32x4 x0 = *(const f32x4*)(hr + e0), x1 = *(const f32x4*)(hr + e0 + 4), w0 = *(const f32x4*)(nw + e0), w1 = *(const f32x4*)(nw + e0 + 4);
            v4u o; o.x = pk2(x0.x * rs * w0.x, x0.y * rs * w0.y); o.y = pk2(x0.z * rs * w0.z, x0.w * rs * w0.w); o.z = pk2(x1.x * rs * w1.x, x1.y * rs * w1.y); o.w = pk2(x1.z * rs * w1.z, x1.w * rs * w1.w);
            *(v4u*)(XG + (size_t)g0 * DM + e0) = o; *(v4u*)(XG + (size_t)g1 * DM + e0) = o; }
    }
}
DI void ph_combine(const Frame& F, const Args& a, int l) {
    float* H = (float*)(a.ws + WS_H); const unsigned* TI = (const unsigned*)(a.ws + WS_TOKINFO); const bf16* YB = (const bf16*)(a.ws + WS_SCR + SC_YB); bf16* HN = (bf16*)(a.ws + WS_HN);
    const int lane = F.lane; const int nrows = l == 0 ? TT : TX;
    for (int r = F.gw; r < nrows; r += F.NGW) {
        const unsigned* t = TI + (size_t)r * 8; const int g0 = (int)t[1], g1 = (int)t[4]; const float w0 = __uint_as_float(t[2]), w1 = __uint_as_float(t[5]);
        float* hr = H + (size_t)r * DM; float hv[32]; float s = 0.f;
#pragma unroll
        for (int j = 0; j < 4; ++j) { const int e0 = (lane + 64 * j) * 8; const f32x4 x0 = *(const f32x4*)(hr + e0), x1 = *(const f32x4*)(hr + e0 + 4);
            const v4u ya = *(const v4u*)(YB + (size_t)g0 * DM + e0), yc = *(const v4u*)(YB + (size_t)g1 * DM + e0);
            float* o = hv + 8 * j;
            o[0] = x0.x + w0 * bflo(ya.x) + w1 * bflo(yc.x); o[1] = x0.y + w0 * bfhi(ya.x) + w1 * bfhi(yc.x); o[2] = x0.z + w0 * bflo(ya.y) + w1 * bflo(yc.y); o[3] = x0.w + w0 * bfhi(ya.y) + w1 * bfhi(yc.y);
            o[4] = x1.x + w0 * bflo(ya.z) + w1 * bflo(yc.z); o[5] = x1.y + w0 * bfhi(ya.z) + w1 * bfhi(yc.z); o[6] = x1.z + w0 * bflo(ya.w) + w1 * bflo(yc.w); o[7] = x1.w + w0 * bfhi(ya.w) + w1 * bfhi(yc.w);
#pragma unroll
            for (int q = 0; q < 8; ++q) s += o[q] * o[q]; }
        const float rs = 1.0f / sqrtf(wave_sum(s) * (1.0f / DM) + NORM_EPS);
        if (l == 0) { const float* nw = a.in[2] + DM;
#pragma unroll
            for (int j = 0; j < 4; ++j) { const int e0 = (lane + 64 * j) * 8; const float* o = hv + 8 * j; const f32x4 wa = *(const f32x4*)(nw + e0), wb = *(const f32x4*)(nw + e0 + 4);
                *(f32x4*)(hr + e0) = (f32x4){o[0], o[1], o[2], o[3]}; *(f32x4*)(hr + e0 + 4) = (f32x4){o[4], o[5], o[6], o[7]};
                v4u p; p.x = pk2(o[0] * rs * wa.x, o[1] * rs * wa.y); p.y = pk2(o[2] * rs * wa.z, o[3] * rs * wa.w); p.z = pk2(o[4] * rs * wb.x, o[5] * rs * wb.y); p.w = pk2(o[6] * rs * wb.z, o[7] * rs * wb.w);
                *(v4u*)(HN + (size_t)r * DM + e0) = p; }
        } else { const float* nw = a.in[4]; float* orow = a.out + (size_t)r * DM;
#ifdef PROBE_TS
            { const unsigned long long* ts = (const unsigned long long*)(F.ctl + CW_TS); const float dt_us = (float)(__hip_atomic_load(ts + PROBE_TS + 1, RLX_AGENT) - __hip_atomic_load(ts + PROBE_TS, RLX_AGENT)) * 0.01f;
#pragma unroll
              for (int q = 0; q < 32; ++q) hv[q] *= 1.0f + dt_us * 0.01f; }
#endif
#pragma unroll
            for (int j = 0; j < 4; ++j) { const int e0 = (lane + 64 * j) * 8; const float* o = hv + 8 * j; const f32x4 wa = *(const f32x4*)(nw + e0), wb = *(const f32x4*)(nw + e0 + 4);
                *(f32x4*)(orow + e0) = (f32x4){o[0] * rs * wa.x, o[1] * rs * wa.y, o[2] * rs * wa.z, o[3] * rs * wa.w};
                *(f32x4*)(orow + e0 + 4) = (f32x4){o[4] * rs * wb.x, o[5] * rs * wb.y, o[6] * rs * wb.z, o[7] * rs * wb.w}; } }
    }
}

DI void ph_odd_prep(const Frame& F, const Args& a) {
    const bf16* P = (const bf16*)(a.ws + WS_PROJ); bf16* QN = (bf16*)(a.ws + WS_SCR + SC_QN); bf16* KN = (bf16*)(a.ws + WS_SCR + SC_KN); bf16* VC = (bf16*)(a.ws + WS_SCR + SC_VC);
    float* BETA = (float*)(a.ws + WS_SCR + SC_BETA); float* GG = (float*)(a.ws + WS_SCR + SC_G);
    const float* cw = a.in[26]; const int lane = F.lane;
    for (int r = F.gw; r < TT; r += F.NGW) {
        const int pos = row_pos(r); const bf16* rows[4];
#pragma unroll
        for (int j = 0; j < 4; ++j) { const int pj = pos - 3 + j; rows[j] = pj >= 0 ? P + (size_t)pos_row(pj) * OD_NP : nullptr; }
#pragma unroll 2
        for (int i = 0; i < 16; ++i) { const int ch = i * 512 + lane * 8; float acc[8];
#pragma unroll
            for (int q = 0; q < 8; ++q) acc[q] = 0.f;
#pragma unroll
            for (int j = 0; j < 4; ++j) { if (!rows[j]) continue; const v4u x = *(const v4u*)(rows[j] + ch); const f32x4 w0 = *(const f32x4*)(cw + j * 8192 + ch), w1 = *(const f32x4*)(cw + j * 8192 + ch + 4);
                acc[0] += w0.x * bflo(x.x); acc[1] += w0.y * bfhi(x.x); acc[2] += w0.z * bflo(x.y); acc[3] += w0.w * bfhi(x.y);
                acc[4] += w1.x * bflo(x.z); acc[5] += w1.y * bfhi(x.z); acc[6] += w1.z * bflo(x.w); acc[7] += w1.w * bfhi(x.w); }
            float ss = 0.f;
#pragma unroll
            for (int q = 0; q < 8; ++q) { acc[q] = acc[q] * sigm(acc[q]); ss += acc[q] * acc[q]; }
            float sc = 1.0f;
            if (i < 8) { ss += __shfl_xor(ss, 1); ss += __shfl_xor(ss, 2); ss += __shfl_xor(ss, 4); ss += __shfl_xor(ss, 8);
                sc = (1.0f / sqrtf(ss + NORM_EPS)) * (i < 4 ? 0.08838834764831845f : 1.0f); }
            v4u o; o.x = pk2(acc[0] * sc, acc[1] * sc); o.y = pk2(acc[2] * sc, acc[3] * sc); o.z = pk2(acc[4] * sc, acc[5] * sc); o.w = pk2(acc[6] * sc, acc[7] * sc);
            bf16* dst = i < 4 ? QN + (size_t)r * 2048 + ch : (i < 8 ? KN + (size_t)r * 2048 + ch - 2048 : VC + (size_t)r * 4096 + ch - 4096);
            *(v4u*)dst = o; }
        if (lane < 32) { const float bb = bf2f(P[(size_t)r * OD_NP + OD_B + lane]), aa = bf2f(P[(size_t)r * OD_NP + OD_A + lane]);
            BETA[(size_t)r * 32 + lane] = sigm(bb); GG[(size_t)r * 32 + lane] = -__expf(a.in[27][lane]) * softplus(aa + a.in[28][lane]); }
    }
}
DI void ph_odd_post(const Frame& F, const Args& a) {
    const bf16* P = (const bf16*)(a.ws + WS_PROJ); const bf16* O = (const bf16*)(a.ws + WS_SCR + SC_O); bf16* Y = (bf16*)(a.ws + WS_YMIX); const float* nw = a.in[29];
    const int lane = F.lane;
    for (int r = F.gw; r < TT; r += F.NGW) {
#pragma unroll 2
        for (int i = 0; i < 8; ++i) { const int ch = i * 512 + lane * 8; const v4u ow = *(const v4u*)(O + (size_t)r * 4096 + ch); const f32x4 o0 = (f32x4){bflo(ow.x), bfhi(ow.x), bflo(ow.y), bfhi(ow.y)}, o1 = (f32x4){bflo(ow.z), bfhi(ow.z), bflo(ow.w), bfhi(ow.w)};
            float ss = (o0.x * o0.x + o0.y * o0.y) + (o0.z * o0.z + o0.w * o0.w) + (o1.x * o1.x + o1.y * o1.y) + (o1.z * o1.z + o1.w * o1.w);
            ss += __shfl_xor(ss, 1); ss += __shfl_xor(ss, 2); ss += __shfl_xor(ss, 4); ss += __shfl_xor(ss, 8);
            const float rs = 1.0f / sqrtf(ss * (1.0f / 128.0f) + NORM_EPS);
            const v4u z = *(const v4u*)(P + (size_t)r * OD_NP + OD_Z + ch); const int c0 = ch & 127; const f32x4 w0 = *(const f32x4*)(nw + c0), w1 = *(const f32x4*)(nw + c0 + 4);
            const float zf[8] = {bflo(z.x), bfhi(z.x), bflo(z.y), bfhi(z.y), bflo(z.z), bfhi(z.z), bflo(z.w), bfhi(z.w)};
            const float of[8] = {o0.x * w0.x, o0.y * w0.y, o0.z * w0.z, o0.w * w0.w, o1.x * w1.x, o1.y * w1.y, o1.z * w1.z, o1.w * w1.w};
            float y[8];
#pragma unroll
            for (int q = 0; q < 8; ++q) y[q] = of[q] * rs * zf[q] * sigm(zf[q]);
            v4u p; p.x = pk2(y[0], y[1]); p.y = pk2(y[2], y[3]); p.z = pk2(y[4], y[5]); p.w = pk2(y[6], y[7]);
            *(v4u*)(Y + (size_t)r * 4096 + ch) = p; }
    }
}

typedef float f32x16 __attribute__((ext_vector_type(16)));
#define MFMA32(a, b, c) __builtin_amdgcn_mfma_f32_32x32x16_bf16((a), (b), (c), 0, 0, 0)
DI int crow(int reg, int h) { return (reg & 3) + 8 * (reg >> 2) + 4 * h; }
DI int chunk_row(int n, int c) { return n == 0 ? (c >= 48 ? TX + (c - 48) : -1) : 64 * (n - 1) + c; }
constexpr int GDN_NCH = 129, GDN_UNITS = GDN_NCH * 32, GDN_KUNITS = GDN_NCH * 16, GC_STRIDE = 72;
constexpr size_t GD_WF = WS_MOEW, GD_UF = WS_MOEW + 65 * MiB, GD_IN = WS_MOEW + 130 * MiB, GD_GC = WS_MOEW + 163 * MiB, GD_KT = WS_HN;
static_assert((size_t)GDN_UNITS * 16384 <= 65 * MiB && (size_t)GDN_UNITS * 8192 <= 33 * MiB && (size_t)GDN_KUNITS * 16384 <= 33 * MiB && GD_GC + (size_t)GDN_UNITS * GC_STRIDE * 4 <= WS_H, "gdn map");

DI void ph_gdn_chunk(const Frame& F, const Args& a) {
    const bf16* QN = (const bf16*)(a.ws + WS_SCR + SC_QN); const bf16* KN = (const bf16*)(a.ws + WS_SCR + SC_KN); const bf16* VC = (const bf16*)(a.ws + WS_SCR + SC_VC);
    const float* BETA = (const float*)(a.ws + WS_SCR + SC_BETA); const float* GG = (const float*)(a.ws + WS_SCR + SC_G);
    bf16* WF = (bf16*)(a.ws + GD_WF); bf16* UF = (bf16*)(a.ws + GD_UF); bf16* INF = (bf16*)(a.ws + GD_IN); bf16* KTF = (bf16*)(a.ws + GD_KT); float* GC = (float*)(a.ws + GD_GC);
    LAS unsigned char* L = F.lds + RING_OFF;
    LAS unsigned char* kS = L; LAS unsigned char* qS = L + 17408; LAS unsigned char* vS = L + 34816; LAS unsigned char* kbS = L + 52224;
    LAS float* Lm = (LAS float*)(L + 69632); LAS bf16* IS = (LAS bf16*)(L + 87040); LAS bf16* XS = (LAS bf16*)(L + 96256);
    LAS float* betaS = (LAS float*)(L + 130048); LAS float* gcS = betaS + 64; LAS float* egcS = betaS + 128;
    LAS unsigned char* Lb = L + 17408; LAS unsigned char* TDs = L + 26624; LAS unsigned char* YT0 = L + 28672; LAS unsigned char* XT0 = L + 130816;
    static_assert(130816 + 8 * 1792 <= LDSCTL_OFF, "gdn lds map");
    const int tid = F.tid, lane = F.lane, wave = F.wave, l31 = lane & 31, h = lane >> 5;
    for (int unit = F.vcu; unit < GDN_UNITS; unit += F.G) {
        const int n = unit >> 5, hv = unit & 31, hk = hv >> 1;
#pragma unroll
        for (int i = 0; i < 2; ++i) { const int p = tid + 512 * i, row = p >> 4, ch = p & 15; const int rr = chunk_row(n, row);
            v4u kx = (v4u){0u, 0u, 0u, 0u}, qx = kx, vx = kx;
            if (rr >= 0) { kx = *(const v4u*)(KN + (size_t)rr * 2048 + hk * 128 + ch * 8); qx = *(const v4u*)(QN + (size_t)rr * 2048 + hk * 128 + ch * 8); vx = *(const v4u*)(VC + (size_t)rr * 4096 + hv * 128 + ch * 8); }
            *(LAS v4u*)(kS + row * 272 + ch * 16) = kx; *(LAS v4u*)(qS + row * 272 + ch * 16) = qx; *(LAS v4u*)(vS + row * 272 + ch * 16) = vx; }
        if (wave == 0) { const int rr = chunk_row(n, lane); float b = 0.f, g = 0.f; if (rr >= 0) { b = BETA[(size_t)rr * 32 + hv]; g = GG[(size_t)rr * 32 + hv]; }
#pragma unroll
            for (int o = 1; o < 64; o <<= 1) { const float t = __shfl_up(g, o); if (lane >= o) g += t; }
            betaS[lane] = b; gcS[lane] = g; egcS[lane] = __expf(g); }
        __syncthreads();
#pragma unroll
        for (int i = 0; i < 2; ++i) { const int p = tid + 512 * i, row = p >> 4, ch = p & 15; const v4u kx = *(const LAS v4u*)(kS + row * 272 + ch * 16); const float b = betaS[row];
            v4u o; o.x = pk2(bflo(kx.x) * b, bfhi(kx.x) * b); o.y = pk2(bflo(kx.y) * b, bfhi(kx.y) * b); o.z = pk2(bflo(kx.z) * b, bfhi(kx.z) * b); o.w = pk2(bflo(kx.w) * b, bfhi(kx.w) * b);
            *(LAS v4u*)(kbS + row * 272 + ch * 16) = o; }
        __syncthreads();
        { const int which = wave >> 2, ti = (wave >> 1) & 1, tj = wave & 1;
          f32x16 acc;
#pragma unroll
          for (int r = 0; r < 16; ++r) acc[r] = 0.f;
          if (!(ti == 0 && tj == 1)) { const LAS unsigned char* Ab = (which == 0 ? kbS : qS) + (32 * ti + l31) * 272 + 16 * h; const LAS unsigned char* Bb = kS + (32 * tj + l31) * 272 + 16 * h;
#pragma unroll
              for (int s = 0; s < 8; ++s) acc = MFMA32(*(const LAS bf16x8*)(Ab + 32 * s), *(const LAS bf16x8*)(Bb + 32 * s), acc); }
          const int j = 32 * tj + l31; const float gj = gcS[j];
#pragma unroll
          for (int r = 0; r < 16; ++r) { const int i = 32 * ti + crow(r, h); const float e = __expf(fminf(gcS[i] - gj, 0.f));
              if (which == 0) Lm[i * 68 + j] = i > j ? acc[r] * e : 0.f;
              else IS[i * 72 + j] = (bf16)f2bf(i >= j ? acc[r] * e : 0.f); } }
        __syncthreads();
#pragma unroll
        for (int i = 0; i < 8; ++i) { const int e = tid + 512 * i, r = e >> 6, c = e & 63; *(LAS bf16*)(Lb + r * 144 + c * 2) = (bf16)f2bf(Lm[r * 68 + c]); }
        if (wave == 0) { const int b = lane >> 4, c = lane & 15; float t[16]; const LAS float* Ld = Lm + (16 * b) * 68 + 16 * b;
#pragma unroll
            for (int i = 0; i < 16; ++i) { float acc = i == c ? 1.f : 0.f;
#pragma unroll
                for (int j = 0; j < i; ++j) acc -= Ld[i * 68 + j] * t[j];
                t[i] = acc; *(LAS bf16*)(TDs + (b * 16 + i) * 32 + c * 2) = (bf16)f2bf(acc); }
        } else if (wave >= 4) { const int t2 = tid - 256;
#pragma unroll
            for (int i = 0; i < 2; ++i) { const int p = t2 + 256 * i, comb = p >> 6, ln = p & 63, t = comb >> 2, s = comb & 3; const int c = 32 * t + (ln & 31), j0 = 16 * s + 8 * (ln >> 5);
                *(v4u*)(INF + ((size_t)unit * 8 + comb) * 512 + ln * 8) = *(const LAS v4u*)(IS + c * 72 + j0); }
            if ((hv & 1) == 0) { const size_t kunit = (size_t)n * 16 + hk;
#pragma unroll
                for (int i = 0; i < 4; ++i) { const int p = t2 + 256 * i, comb = p >> 6, ln = p & 63, kt = comb >> 2, s = comb & 3; const int kd = 32 * kt + (ln & 31), c0 = 16 * s + 8 * (ln >> 5);
                    unsigned w[4];
#pragma unroll
                    for (int jj = 0; jj < 4; ++jj) { const unsigned lo = *(const LAS bf16*)(kS + (c0 + 2 * jj) * 272 + kd * 2), hi = *(const LAS bf16*)(kS + (c0 + 2 * jj + 1) * 272 + kd * 2); w[jj] = lo | (hi << 16); }
                    *(v4u*)(KTF + (kunit * 16 + comb) * 512 + ln * 8) = (v4u){w[0], w[1], w[2], w[3]}; } }
            if (t2 < 64) GC[(size_t)unit * GC_STRIDE + t2] = gcS[t2];
            else if (t2 == 64) GC[(size_t)unit * GC_STRIDE + 64] = gcS[63];
            else if (t2 == 65) GC[(size_t)unit * GC_STRIDE + 65] = egcS[63];
        }
        __syncthreads();
        { const int quad = lane >> 4, lc = lane & 15; LAS unsigned char* XTw = XT0 + wave * 1792; LAS unsigned char* YTw = YT0 + wave * 768;
          const bf16x8 z8 = (bf16x8){0, 0, 0, 0, 0, 0, 0, 0}; const f32x4 z4 = (f32x4){0.f, 0.f, 0.f, 0.f};
          bf16x8 tdf[4];
#pragma unroll
          for (int b = 0; b < 4; ++b) tdf[b] = quad < 2 ? *(const LAS bf16x8*)(TDs + (b * 16 + lc) * 32 + quad * 16) : z8;
#pragma unroll 1
          for (int tl = 0; tl < 2; ++tl) { const int col = 32 * wave + 16 * tl + lc;
              const LAS unsigned char* rz = wave < 4 ? vS + col * 2 : kbS + (col - 128) * 2; const LAS float* bz = wave < 4 ? betaS : egcS;
#pragma unroll
              for (int b = 0; b < 4; ++b) { f32x4 y;
#pragma unroll
                  for (int r = 0; r < 4; ++r) { const int i = 16 * b + 4 * quad + r; y[r] = bf2f(*(const LAS bf16*)(rz + i * 272)) * bz[i]; }
                  if (b >= 1) { f32x4 p = z4;
#pragma unroll
                      for (int kk = 0; kk < (b >= 3 ? 2 : 1); ++kk) { const bf16x8 af = *(const LAS bf16x8*)(Lb + (16 * b + lc) * 144 + (32 * kk + 8 * quad) * 2);
                          const bf16x8 bfv = (32 * kk + 8 * quad < 16 * b) ? *(const LAS bf16x8*)(XTw + lc * 112 + (32 * kk + 8 * quad) * 2) : z8;
                          p = __builtin_amdgcn_mfma_f32_16x16x32_bf16(af, bfv, p, 0, 0, 0); }
                      y = y - p; }
                  *(LAS v2u*)(YTw + lc * 48 + quad * 8) = (v2u){pk2(y[0], y[1]), pk2(y[2], y[3])};
                  asm volatile("" ::: "memory");
                  const bf16x8 yb = quad < 2 ? *(const LAS bf16x8*)(YTw + lc * 48 + quad * 16) : z8;
                  const f32x4 x = __builtin_amdgcn_mfma_f32_16x16x32_bf16(tdf[b], yb, z4, 0, 0, 0);
                  if (b < 3) *(LAS v2u*)(XTw + lc * 112 + (16 * b + 4 * quad) * 2) = (v2u){pk2(x[0], x[1]), pk2(x[2], x[3])};
                  asm volatile("" ::: "memory");
#pragma unroll
                  for (int r = 0; r < 4; ++r) XS[(16 * b + 4 * quad + r) * 264 + col] = (bf16)f2bf(x[r]); } } }
        __syncthreads();
#pragma unroll
        for (int i = 0; i < 2; ++i) { const int p = tid + 512 * i, comb = p >> 6, ln = p & 63, t = comb >> 3, s = comb & 7; const int c = 32 * t + (ln & 31), k0 = 16 * s + 8 * (ln >> 5);
            *(v4u*)(WF + ((size_t)unit * 16 + comb) * 512 + ln * 8) = *(const LAS v4u*)(XS + c * 264 + 128 + k0); }
        { const int t = wave >> 2, ns = wave & 3; unsigned w[8];
#pragma unroll
          for (int r = 0; r < 8; ++r) { const unsigned lo = XS[(32 * t + crow(2 * r, h)) * 264 + 32 * ns + l31], hi = XS[(32 * t + crow(2 * r + 1, h)) * 264 + 32 * ns + l31]; w[r] = lo | (hi << 16); }
          bf16* dst = UF + (((size_t)unit * 8 + wave) * 64 + lane) * 16; *(v4u*)dst = (v4u){w[0], w[1], w[2], w[3]}; *(v4u*)(dst + 8) = (v4u){w[4], w[5], w[6], w[7]}; }
        __syncthreads();
    }
}

DI void ph_gdn_chain(const Frame& F, const Args& a) {
    const int xg = F.vcu >> 5, wx = F.vcu & 31; if (F.G != 256 ? F.vcu >= 128 : wx >= 20) return;
    const bool helper = F.G == 256 && wx >= 16;
    const int hv = F.G == 256 ? 4 * xg + (helper ? wx - 16 : wx >> 2) : F.vcu >> 2, ns = F.G == 256 ? wx & 3 : F.vcu & 3, hk = hv >> 1;
    const bf16* QN = (const bf16*)(a.ws + WS_SCR + SC_QN);
    const bf16* WF = (const bf16*)(a.ws + GD_WF); const bf16* UF = (const bf16*)(a.ws + GD_UF); const bf16* INF = (const bf16*)(a.ws + GD_IN); const bf16* KTF = (const bf16*)(a.ws + GD_KT); const float* GC = (const float*)(a.ws + GD_GC);
    bf16* O = (bf16*)(a.ws + WS_SCR + SC_O);
    gu32* prog = F.ctl + CW_PROG + hv * 16;
    if (helper) { unsigned sink = 0u; const int tid = F.tid;
        for (int n0 = 0; n0 < GDN_NCH; n0 += 4) {
            if (n0 >= 8) { if (tid == 0) { unsigned sp = 0; while ((int)__hip_atomic_load(prog, RLX_AGENT) < n0 - 4 && ++sp < 20000u) __builtin_amdgcn_s_sleep(8); } __syncthreads(); }
            unsigned v[5];
#pragma unroll
            for (int i = 0; i < 5; ++i) { const int li = tid + 512 * i;
                const int st = li / 580, ln = li % 580, n = n0 + st; const unsigned* p = nullptr;
                if (st < 4 && n < GDN_NCH) { const size_t unit = (size_t)n * 32 + hv, kunit = (size_t)n * 16 + hk;
                    if (ln < 128) p = (const unsigned*)(WF + unit * 8192 + ln * 64);
                    else if (ln < 256) p = (const unsigned*)(UF + unit * 8192 + (ln - 128) * 64);
                    else if (ln < 320) p = (const unsigned*)(INF + unit * 4096 + (ln - 256) * 64);
                    else if (ln < 448) p = (const unsigned*)(KTF + kunit * 8192 + (ln - 320) * 64);
                    else if (ln < 576) { const int rr = chunk_row(n, (ln - 448) >> 1); if (rr >= 0) p = (const unsigned*)(QN + (size_t)rr * 2048 + hk * 128 + ((ln - 448) & 1) * 64); }
                    else if (ln < 579) p = (const unsigned*)(GC + unit * GC_STRIDE + (ln - 576) * 32); }
                v[i] = p ? *p : 0u; }
#pragma unroll
            for (int i = 0; i < 5; ++i) sink += v[i];
        }
        if (sink == 0x12345u) __hip_atomic_store(F.ctl + CW_TMO + 2, sink, RLX_AGENT);
        return; }
    LAS unsigned char* ST = F.lds + RING_OFF; LAS unsigned char* VN = ST + 8704; LAS unsigned char* VND = ST + 13312;
    const int lane = F.lane, wave = F.wave, l31 = lane & 31, h = lane >> 5;
    for (int i = F.tid; i < 8704 / 4; i += NWAVES * 64) ((LAS unsigned*)ST)[i] = 0u;
#define GDN_BAR() do { asm volatile("s_waitcnt lgkmcnt(0)" ::: "memory"); __builtin_amdgcn_s_barrier(); asm volatile("" ::: "memory"); } while (0)
    GDN_BAR();
    f32x16 S;
#pragma unroll
    for (int r = 0; r < 16; ++r) S[r] = 0.f;
    const int role = wave < 2 ? 0 : (wave < 4 ? 1 : 2); const int t = wave & 1, kt = wave & 3;
    bf16x8 A8[8]; bf16x8 A4[4]; v4u U0 = (v4u){0u, 0u, 0u, 0u}, U1 = U0; f32x4 G4[4]; float gl = 0.f, egl = 1.f;
#pragma unroll
    for (int s = 0; s < 8; ++s) A8[s] = (bf16x8){0, 0, 0, 0, 0, 0, 0, 0};
#pragma unroll
    for (int s = 0; s < 4; ++s) { A4[s] = (bf16x8){0, 0, 0, 0, 0, 0, 0, 0}; G4[s] = (f32x4){0.f, 0.f, 0.f, 0.f}; }
#define GDN_LOAD(nn) do { const size_t unit_ = (size_t)(nn) * 32 + hv; const float* gc_ = GC + unit_ * GC_STRIDE; \
        if (role == 0) { _Pragma("unroll") for (int s = 0; s < 8; ++s) A8[s] = *(const bf16x8*)(WF + ((unit_ * 2 + t) * 8 + s) * 512 + lane * 8); \
            const bf16* up_ = UF + (((unit_ * 2 + t) * 4 + ns) * 64 + lane) * 16; U0 = *(const v4u*)up_; U1 = *(const v4u*)(up_ + 8); \
            _Pragma("unroll") for (int g = 0; g < 4; ++g) G4[g] = *(const f32x4*)(gc_ + 32 * t + 8 * g + 4 * h); gl = gc_[64]; } \
        else if (role == 1) { const int rr_ = chunk_row((nn), 32 * t + l31); \
            _Pragma("unroll") for (int s = 0; s < 8; ++s) A8[s] = rr_ >= 0 ? *(const bf16x8*)(QN + (size_t)rr_ * 2048 + hk * 128 + 16 * s + 8 * h) : (bf16x8){0, 0, 0, 0, 0, 0, 0, 0}; \
            _Pragma("unroll") for (int s = 0; s < 4; ++s) A4[s] = *(const bf16x8*)(INF + ((unit_ * 2 + t) * 4 + s) * 512 + lane * 8); \
            _Pragma("unroll") for (int g = 0; g < 4; ++g) G4[g] = *(const f32x4*)(gc_ + 32 * t + 8 * g + 4 * h); } \
        else { const size_t kunit_ = (size_t)(nn) * 16 + hk; \
            _Pragma("unroll") for (int s = 0; s < 4; ++s) A4[s] = *(const bf16x8*)(KTF + ((kunit_ * 4 + kt) * 4 + s) * 512 + lane * 8); egl = gc_[65]; } } while (0)
    GDN_LOAD(0);
    for (int n = 0; n < GDN_NCH; ++n) {
        bf16x8 a8[8], a4[4]; const v4u u0 = U0, u1 = U1; f32x4 g4[4]; const float cgl = gl, cegl = egl;
#pragma unroll
        for (int s = 0; s < 8; ++s) a8[s] = A8[s];
#pragma unroll
        for (int s = 0; s < 4; ++s) { a4[s] = A4[s]; g4[s] = G4[s]; }
        if (n + 1 < GDN_NCH) GDN_LOAD(n + 1);
        if (ns == 0 && F.tid == 0) __hip_atomic_store(prog, (unsigned)n, RLX_AGENT);
        f32x16 acc;
#pragma unroll
        for (int r = 0; r < 16; ++r) acc[r] = 0.f;
        if (role < 2) {
#pragma unroll
            for (int s = 0; s < 8; ++s) acc = MFMA32(a8[s], *(const LAS bf16x8*)(ST + l31 * 272 + 32 * s + 16 * h), acc);
        }
        if (role == 0) { const unsigned uw[8] = {u0.x, u0.y, u0.z, u0.w, u1.x, u1.y, u1.z, u1.w};
#pragma unroll
            for (int g = 0; g < 4; ++g) { float vn[4], vd[4];
#pragma unroll
                for (int q = 0; q < 4; ++q) { const int r = 4 * g + q; const float uv = (r & 1) ? bfhi(uw[r >> 1]) : bflo(uw[r >> 1]); vn[q] = uv - acc[r]; vd[q] = vn[q] * __expf(cgl - g4[g][q]); }
                *(LAS v2u*)(VN + l31 * 144 + (32 * t + 8 * g + 4 * h) * 2) = (v2u){pk2(vn[0], vn[1]), pk2(vn[2], vn[3])};
                *(LAS v2u*)(VND + l31 * 144 + (32 * t + 8 * g + 4 * h) * 2) = (v2u){pk2(vd[0], vd[1]), pk2(vd[2], vd[3])}; }
        } else if (role == 1) {
#pragma unroll
            for (int g = 0; g < 4; ++g)
#pragma unroll
                for (int q = 0; q < 4; ++q) acc[4 * g + q] *= __expf(g4[g][q]);
        }
        GDN_BAR();
        if (role == 1) {
#pragma unroll
            for (int s = 0; s < 4; ++s) acc = MFMA32(a4[s], *(const LAS bf16x8*)(VN + l31 * 144 + 32 * s + 16 * h), acc);
#pragma unroll
            for (int r = 0; r < 16; ++r) { const int rr = chunk_row(n, 32 * t + crow(r, h)); if (rr >= 0) O[(size_t)rr * 4096 + hv * 128 + 32 * ns + l31] = (bf16)f2bf(acc[r]); }
        } else if (role == 2) {
#pragma unroll
            for (int r = 0; r < 16; ++r) S[r] *= cegl;
#pragma unroll
            for (int s = 0; s < 4; ++s) S = MFMA32(a4[s], *(const LAS bf16x8*)(VND + l31 * 144 + 32 * s + 16 * h), S);
#pragma unroll
            for (int g = 0; g < 4; ++g) *(LAS v2u*)(ST + l31 * 272 + (32 * kt + 8 * g + 4 * h) * 2) = (v2u){pk2(S[4 * g], S[4 * g + 1]), pk2(S[4 * g + 2], S[4 * g + 3])};
        }
        GDN_BAR();
    }
#undef GDN_LOAD
#undef GDN_BAR
}

constexpr int RW_NSC = 258, RW_UNITS = 129 * 16;
DI int sub_row(int sc, int t) { const int n = sc >> 1, sub = sc & 1; return n == 0 ? ((sub == 0 && t >= 16) ? TX + t - 16 : -1) : 64 * (n - 1) + 32 * sub + t; }
constexpr size_t RW_BASE = WS_PROJ + 92 * MiB;
constexpr size_t RW_RH = RW_BASE, RW_RL = RW_BASE + 33 * MiB, RW_GT = RW_BASE + 66 * MiB, RW_GAM = RW_BASE + 99 * MiB;
constexpr size_t RW_PR = WS_SCR + 195 * MiB, RW_AT = WS_SCR + 211 * MiB + 256 * 1024, RW_VTF = WS_SCR + 219 * MiB + 512 * 1024, RW_SALL = WS_SCR + 235 * MiB + 768 * 1024;
constexpr size_t RW_VV = WS_YMIX + 34 * MiB, RW_BON = WS_YMIX + 52 * MiB, LR_H = WS_YMIX + 54 * MiB, LR_A = WS_YMIX + 56 * MiB, LR_C = WS_YMIX + 58 * MiB;
constexpr size_t RW_SCH = (size_t)RW_NSC * 16;
static_assert((size_t)MP * EV_NP * 2 <= 92 * MiB && RW_SCH * 8192 <= 33 * MiB && RW_GAM + RW_SCH * 256 <= WS_SCR, "rwkv map (proj region)");
static_assert(WS_SCR + SC_LIX + (size_t)MP * 4096 <= RW_PR && RW_PR + RW_SCH * 4096 <= RW_AT && RW_AT + RW_SCH * 2048 <= RW_VTF && RW_VTF + RW_SCH * 4096 <= RW_SALL && RW_SALL + RW_SCH * 8192 <= WS_END, "rwkv map (scratch region)");
static_assert((size_t)MP * DM * 2 <= 34 * MiB && RW_VV + (size_t)MP * 2048 <= RW_BON && RW_BON + (size_t)MP * 64 <= LR_H && LR_H + RW_SCH * 256 <= LR_A && LR_A + RW_SCH * 256 <= LR_C && LR_C + RW_SCH * 256 <= WS_PROJ, "rwkv map (ymix region)");

DI void sub_rows(int sc, int& t0, int& rbase) { if (sc >= 2) { t0 = 0; rbase = 64 * ((sc >> 1) - 1) + 32 * (sc & 1); } else if (sc == 0) { t0 = 16; rbase = TX - 16; } else { t0 = 32; rbase = 0; } }
DI void lru_local(const Frame& F, const Args& a) {
    const float* LA = (const float*)(a.ws + WS_SCR + SC_LA); const float* LIX = (const float*)(a.ws + WS_SCR + SC_LIX);
    float* HL = (float*)(a.ws + LR_H); float* AP = (float*)(a.ws + LR_A);
    for (int item = F.gw; item < RW_NSC * 16; item += F.NGW) { const int sc = item >> 4, c = (item & 15) * 64 + F.lane; int t0, rbase; sub_rows(sc, t0, rbase);
        float av[32], ix[32];
#pragma unroll
        for (int t = 0; t < 32; ++t) { const size_t o = (size_t)(rbase + (t >= t0 ? t : 32)) * 1024 + c; av[t] = LA[o]; ix[t] = LIX[o]; }
        float h = 0.f, p = 1.f;
#pragma unroll
        for (int t = 0; t < 32; ++t) { const float a_ = t >= t0 ? av[t] : 1.f, x_ = t >= t0 ? ix[t] : 0.f; h = a_ * h + sqrtf(fmaxf(1.0f - a_ * a_, 0.f)) * x_; p *= a_; }
        HL[sc * 1024 + c] = h; AP[sc * 1024 + c] = p; }
}
DI void lru_apply(const Frame& F, const Args& a) {
    const bf16* P = (const bf16*)(a.ws + WS_PROJ); const float* LA = (const float*)(a.ws + WS_SCR + SC_LA); const float* LIX = (const float*)(a.ws + WS_SCR + SC_LIX);
    const float* CR = (const float*)(a.ws + LR_C); bf16* Y = (bf16*)(a.ws + WS_YMIX);
    for (int item = F.gw; item < RW_NSC * 16; item += F.NGW) { const int sc = item >> 4, c = (item & 15) * 64 + F.lane; int t0, rbase; sub_rows(sc, t0, rbase); if (t0 >= 32) continue;
        float h = CR[sc * 1024 + c];
#pragma unroll
        for (int tb = 0; tb < 32; tb += 16) { float av[16], ix[16], gb[16];
#pragma unroll
            for (int t = 0; t < 16; ++t) { const size_t r_ = (size_t)(rbase + (tb + t >= t0 ? tb + t : 32)); av[t] = LA[r_ * 1024 + c]; ix[t] = LIX[r_ * 1024 + c]; gb[t] = bf2f(P[r_ * EV_NP + EV_GB + c]); }
#pragma unroll
            for (int t = 0; t < 16; ++t) { if (tb + t >= t0) { h = av[t] * h + sqrtf(fmaxf(1.0f - av[t] * av[t], 0.f)) * ix[t]; Y[(size_t)(rbase + tb + t) * DM + 1024 + c] = (bf16)f2bf(h * gelu_tanh(gb[t])); } } } }
}

DI void ph_rwkv_chunk(const Frame& F, const Args& a) {
    lru_local(F, a);
    const bf16* P = (const bf16*)(a.ws + WS_PROJ); const float* DEC = (const float*)(a.ws + WS_SCR + SC_DEC); const float* ICL = (const float*)(a.ws + WS_SCR + SC_ICL);
    bf16* RH = (bf16*)(a.ws + RW_RH); bf16* RL = (bf16*)(a.ws + RW_RL); bf16* GT = (bf16*)(a.ws + RW_GT); float* GAM = (float*)(a.ws + RW_GAM); bf16* PR = (bf16*)(a.ws + RW_PR); bf16* ATG = (bf16*)(a.ws + RW_AT); bf16* VTF = (bf16*)(a.ws + RW_VTF);
    bf16* VV = (bf16*)(a.ws + RW_VV); float* BON = (float*)(a.ws + RW_BON);
    LAS unsigned char* L = F.lds + RING_OFF;
    LAS float* wS = (LAS float*)L; LAS float* aS = wS + 4096; LAS float* bS = wS + 8192; LAS float* rS = wS + 12288; LAS float* kS = wS + 16384;
    LAS unsigned char* vT = L + 81920; LAS unsigned char* aT = L + 91136; LAS unsigned char* rT = L + 100352; LAS unsigned char* kT = L + 109568; LAS unsigned char* bT = L + 118784;
    LAS unsigned char* AT = L + 128000; LAS unsigned char* NT = L + 133120; LAS float* gam = (LAS float*)(L + 138240);
    LAS unsigned char* aTl = L; LAS unsigned char* bTl = L + 9216;
    const int tid = F.tid, lane = F.lane, wave = F.wave, l31 = lane & 31, h = lane >> 5;
    const float* mu = a.in[6];
    for (int unit = F.vcu; unit < RW_UNITS; unit += F.G) {
        const int n = unit >> 4, hd = unit & 15;
        { const int tok = tid >> 3, cg = tid & 7, c0 = hd * 64 + cg * 8; const int rr = sub_row(2 * n + (tok >> 5), tok & 31);
          float wv[8], av[8], bv[8], rv[8], kv[8], vv[8];
#pragma unroll
          for (int q = 0; q < 8; ++q) { wv[q] = 1.f; av[q] = 0.f; bv[q] = 0.f; rv[q] = 0.f; kv[q] = 0.f; vv[q] = 0.f; }
          if (rr >= 0) { const int pos = row_pos(rr); const bf16* cur = P + (size_t)rr * EV_NP + c0; const bf16* prv = pos > 0 ? P + (size_t)pos_row(pos - 1) * EV_NP + c0 : nullptr;
              const v4u z4 = (v4u){0u, 0u, 0u, 0u};
              const v4u cr = *(const v4u*)cur, ck = *(const v4u*)(cur + 1024), cv = *(const v4u*)(cur + 2048);
              const v4u qr = prv ? *(const v4u*)prv : z4, qk = prv ? *(const v4u*)(prv + 1024) : z4, qv = prv ? *(const v4u*)(prv + 2048) : z4;
              const unsigned crw[4] = {cr.x, cr.y, cr.z, cr.w}, ckw[4] = {ck.x, ck.y, ck.z, ck.w}, cvw[4] = {cv.x, cv.y, cv.z, cv.w}, qrw[4] = {qr.x, qr.y, qr.z, qr.w}, qkw[4] = {qk.x, qk.y, qk.z, qk.w}, qvw[4] = {qv.x, qv.y, qv.z, qv.w};
              float ss = 0.f, bon = 0.f; float kk[8], ic[8];
#pragma unroll
              for (int q = 0; q < 8; ++q) { const int c = c0 + q; const float crf = (q & 1) ? bfhi(crw[q >> 1]) : bflo(crw[q >> 1]), ckf = (q & 1) ? bfhi(ckw[q >> 1]) : bflo(ckw[q >> 1]), cvf = (q & 1) ? bfhi(cvw[q >> 1]) : bflo(cvw[q >> 1]);
                  const float prf = (q & 1) ? bfhi(qrw[q >> 1]) : bflo(qrw[q >> 1]), pkf = (q & 1) ? bfhi(qkw[q >> 1]) : bflo(qkw[q >> 1]), pvf = (q & 1) ? bfhi(qvw[q >> 1]) : bflo(qvw[q >> 1]);
                  rv[q] = crf + (prf - crf) * mu[c]; kk[q] = ckf + (pkf - ckf) * mu[1024 + c]; vv[q] = cvf + (pvf - cvf) * mu[2048 + c];
                  wv[q] = DEC[(size_t)rr * 1024 + c]; ic[q] = ICL[(size_t)rr * 1024 + c];
                  const float kkv = kk[q] * a.in[12][c]; av[q] = kkv; ss += kkv * kkv; kv[q] = kk[q] * (1.0f + (ic[q] - 1.0f) * a.in[13][c]); bon += rv[q] * kv[q] * a.in[14][c]; }
              ss += __shfl_xor(ss, 1); ss += __shfl_xor(ss, 2); ss += __shfl_xor(ss, 4); bon += __shfl_xor(bon, 1); bon += __shfl_xor(bon, 2); bon += __shfl_xor(bon, 4);
              const float inv = 1.0f / fmaxf(sqrtf(ss), 1e-12f);
#pragma unroll
              for (int q = 0; q < 8; ++q) { const float kkn = av[q] * inv; av[q] = -kkn; bv[q] = kkn * ic[q]; }
              if (cg == 0) BON[(size_t)rr * 16 + hd] = bon;
              *(v4u*)(VV + (size_t)rr * 1024 + c0) = (v4u){pk2(vv[0], vv[1]), pk2(vv[2], vv[3]), pk2(vv[4], vv[5]), pk2(vv[6], vv[7])}; }
          const int o = tok * 64 + cg * 8;
          *(LAS f32x4*)(wS + o) = (f32x4){wv[0], wv[1], wv[2], wv[3]}; *(LAS f32x4*)(wS + o + 4) = (f32x4){wv[4], wv[5], wv[6], wv[7]};
          *(LAS f32x4*)(aS + o) = (f32x4){av[0], av[1], av[2], av[3]}; *(LAS f32x4*)(aS + o + 4) = (f32x4){av[4], av[5], av[6], av[7]};
          *(LAS f32x4*)(bS + o) = (f32x4){bv[0], bv[1], bv[2], bv[3]}; *(LAS f32x4*)(bS + o + 4) = (f32x4){bv[4], bv[5], bv[6], bv[7]};
          *(LAS f32x4*)(rS + o) = (f32x4){rv[0], rv[1], rv[2], rv[3]}; *(LAS f32x4*)(rS + o + 4) = (f32x4){rv[4], rv[5], rv[6], rv[7]};
          *(LAS f32x4*)(kS + o) = (f32x4){kv[0], kv[1], kv[2], kv[3]}; *(LAS f32x4*)(kS + o + 4) = (f32x4){kv[4], kv[5], kv[6], kv[7]};
#pragma unroll
          for (int q = 0; q < 8; ++q) *(LAS bf16*)(vT + (cg * 8 + q) * 144 + tok * 2) = (bf16)f2bf(vv[q]); }
        __syncthreads();
        { const int p = wave >> 2, sub = (wave >> 1) & 1, half = wave & 1, sl = lane >> 2, q = lane & 3, s = 16 * half + sl, tok = 32 * sub + s, jq = 16 * q;
          const LAS float* x0p = (p == 0 ? kS : bS) + tok * 64 + jq; LAS unsigned char* OUT = p == 0 ? AT : NT;
          float x[16];
#pragma unroll
          for (int j = 0; j < 16; j += 4) { const f32x4 t4 = *(const LAS f32x4*)(x0p + j); x[j] = t4.x; x[j + 1] = t4.y; x[j + 2] = t4.z; x[j + 3] = t4.w; }
          if (half) {
#pragma unroll
              for (int i = 0; i < 4; ++i) *(LAS bf16*)(OUT + ((sub * 32 + 4 * q + i) * 40 + s) * 2) = (bf16)0; }
#pragma unroll 2
          for (int tp = 16 * half; tp < 32; ++tp) { const LAS float* bp = wS + (32 * sub + tp) * 64 + jq; const bool run = tp > s;
              f32x4 a4[4], w4[4], b4[4], r4[4];
#pragma unroll
              for (int g = 0; g < 4; ++g) { a4[g] = *(const LAS f32x4*)(bp + 4096 + 4 * g); w4[g] = *(const LAS f32x4*)(bp + 4 * g); b4[g] = *(const LAS f32x4*)(bp + 8192 + 4 * g); r4[g] = *(const LAS f32x4*)(bp + 12288 + 4 * g); }
              float c = 0.f;
#pragma unroll
              for (int g = 0; g < 4; ++g) { c += x[4 * g] * a4[g].x; c += x[4 * g + 1] * a4[g].y; c += x[4 * g + 2] * a4[g].z; c += x[4 * g + 3] * a4[g].w; }
              c += __builtin_bit_cast(float, __builtin_amdgcn_mov_dpp(__builtin_bit_cast(int, c), 0xB1, 0xF, 0xF, true));
              c += __builtin_bit_cast(float, __builtin_amdgcn_mov_dpp(__builtin_bit_cast(int, c), 0x4E, 0xF, 0xF, true));
              float o = 0.f;
#pragma unroll
              for (int g = 0; g < 4; ++g) { const float n0 = x[4 * g] * w4[g].x + c * b4[g].x, n1 = x[4 * g + 1] * w4[g].y + c * b4[g].y, n2 = x[4 * g + 2] * w4[g].z + c * b4[g].z, n3 = x[4 * g + 3] * w4[g].w + c * b4[g].w;
                  x[4 * g] = run ? n0 : x[4 * g]; x[4 * g + 1] = run ? n1 : x[4 * g + 1]; x[4 * g + 2] = run ? n2 : x[4 * g + 2]; x[4 * g + 3] = run ? n3 : x[4 * g + 3];
                  o += x[4 * g] * r4[g].x; o += x[4 * g + 1] * r4[g].y; o += x[4 * g + 2] * r4[g].z; o += x[4 * g + 3] * r4[g].w; }
              o += __builtin_bit_cast(float, __builtin_amdgcn_mov_dpp(__builtin_bit_cast(int, o), 0xB1, 0xF, 0xF, true));
              o += __builtin_bit_cast(float, __builtin_amdgcn_mov_dpp(__builtin_bit_cast(int, o), 0x4E, 0xF, 0xF, true));
              if (q == 0) *(LAS bf16*)(OUT + ((sub * 32 + tp) * 40 + s) * 2) = (bf16)f2bf(tp >= s ? o : 0.f); }
          LAS unsigned char* XT = p == 0 ? kT : bT;
#pragma unroll
          for (int j = 0; j < 16; ++j) { const unsigned hi = f2bf(x[j]); *(LAS bf16*)(XT + (jq + j) * 144 + tok * 2) = (bf16)hi; x[j] -= __uint_as_float(hi << 16); }
          float alo[32]; const bool gwave = (p == 0 && half == 1); const int j = lane;
          if (gwave) { float g = 1.f;
#pragma unroll
              for (int tp = 0; tp < 32; ++tp) { const int tk = 32 * sub + tp; const float w_ = wS[tk * 64 + j], a_ = aS[tk * 64 + j], r_ = rS[tk * 64 + j];
                  const float at = a_ * g; const unsigned hi = f2bf(at); *(LAS bf16*)(aT + j * 144 + tk * 2) = (bf16)hi; alo[tp] = at - __uint_as_float(hi << 16);
                  g *= w_; *(LAS bf16*)(rT + j * 144 + tk * 2) = (bf16)f2bf(r_ * g); }
              gam[sub * 64 + j] = g; }
          __syncthreads();
          if (p == 1) {
#pragma unroll
              for (int jj = 0; jj < 16; ++jj) *(LAS bf16*)(bTl + (jq + jj) * 144 + tok * 2) = (bf16)f2bf(x[jj]); }
          if (gwave) {
#pragma unroll
              for (int tp = 0; tp < 32; ++tp) *(LAS bf16*)(aTl + j * 144 + (32 * sub + tp) * 2) = (bf16)f2bf(alo[tp]); }
        }
        __syncthreads();
        { const int sub = wave >> 2, t1 = (wave >> 1) & 1, t0 = wave & 1; const size_t sch = (size_t)(2 * n + sub) * 16 + hd;
          { f32x16 acc;
#pragma unroll
            for (int r = 0; r < 16; ++r) acc[r] = 0.f;
#pragma unroll
            for (int ks = 0; ks < 2; ++ks) { const int ao = (32 * t1 + l31) * 144 + (32 * sub + 16 * ks + 8 * h) * 2, bo = (32 * t0 + l31) * 144 + (32 * sub + 16 * ks + 8 * h) * 2;
                const bf16x8 ah = *(const LAS bf16x8*)(aT + ao), al = *(const LAS bf16x8*)(aTl + ao), bh = *(const LAS bf16x8*)(bT + bo), bl = *(const LAS bf16x8*)(bTl + bo);
                acc = MFMA32(al, bh, acc); acc = MFMA32(ah, bl, acc); acc = MFMA32(ah, bh, acc); }
            const int jp = 32 * t0 + l31;
#pragma unroll
            for (int g = 0; g < 4; ++g) { unsigned hi[4]; float lo[4];
#pragma unroll
                for (int q = 0; q < 4; ++q) { hi[q] = f2bf(acc[4 * g + q]); lo[q] = acc[4 * g + q] - __uint_as_float(hi[q] << 16); }
                *(v2u*)(RH + (sch * 64 + jp) * 64 + 32 * t1 + 8 * g + 4 * h) = (v2u){hi[0] | (hi[1] << 16), hi[2] | (hi[3] << 16)};
                *(v2u*)(RL + (sch * 64 + jp) * 64 + 32 * t1 + 8 * g + 4 * h) = (v2u){pk2(lo[0], lo[1]), pk2(lo[2], lo[3])}; }
            if (t1 == 0 && t0 == 0) GAM[sch * 64 + lane] = gam[sub * 64 + lane]; }
          { f32x16 acc;
#pragma unroll
            for (int r = 0; r < 16; ++r) acc[r] = 0.f;
#pragma unroll
            for (int ks = 0; ks < 2; ++ks) acc = MFMA32(*(const LAS bf16x8*)(kT + (32 * t1 + l31) * 144 + (32 * sub + 16 * ks + 8 * h) * 2), *(const LAS bf16x8*)(vT + (32 * t0 + l31) * 144 + (32 * sub + 16 * ks + 8 * h) * 2), acc);
            bf16* dst = GT + ((sch * 4 + t1 * 2 + t0) * 64 + lane) * 16;
            *(v4u*)dst = (v4u){pk2(acc[0], acc[1]), pk2(acc[2], acc[3]), pk2(acc[4], acc[5]), pk2(acc[6], acc[7])}; *(v4u*)(dst + 8) = (v4u){pk2(acc[8], acc[9]), pk2(acc[10], acc[11]), pk2(acc[12], acc[13]), pk2(acc[14], acc[15])}; } }
        if (wave < 4) { const int sub = wave >> 1, jt = wave & 1; const size_t sch = (size_t)(2 * n + sub) * 16 + hd;
            f32x16 acc;
#pragma unroll
            for (int r = 0; r < 16; ++r) acc[r] = bf2f(*(const LAS bf16*)(rT + (32 * jt + crow(r, h)) * 144 + (32 * sub + l31) * 2));
#pragma unroll
            for (int ks = 0; ks < 2; ++ks) acc = MFMA32(*(const LAS bf16x8*)(aT + (32 * jt + l31) * 144 + (32 * sub + 16 * ks + 8 * h) * 2), *(const LAS bf16x8*)(NT + (sub * 32 + l31) * 80 + (16 * ks + 8 * h) * 2), acc);
#pragma unroll
            for (int g = 0; g < 4; ++g) *(v2u*)(PR + (sch * 32 + l31) * 64 + 32 * jt + 8 * g + 4 * h) = (v2u){pk2(acc[4 * g], acc[4 * g + 1]), pk2(acc[4 * g + 2], acc[4 * g + 3])};
        } else { const int t2 = tid - 256, sub = t2 >> 7, t = (t2 >> 2) & 31, s8 = (t2 & 3) * 8; const size_t sch = (size_t)(2 * n + sub) * 16 + hd;
            *(v4u*)(ATG + (sch * 32 + t) * 32 + s8) = *(const LAS v4u*)(AT + (sub * 32 + t) * 80 + s8 * 2); }
        { const int sub = tid >> 8, it = (tid >> 7) & 1, ks = (tid >> 6) & 1; const size_t sch = (size_t)(2 * n + sub) * 16 + hd;
          *(v4u*)(VTF + ((sch * 4 + it * 2 + ks) * 64 + lane) * 8) = *(const LAS v4u*)(vT + (32 * it + l31) * 144 + (32 * sub + 16 * ks + 8 * h) * 2); }
        __syncthreads();
    }
}

DI void ph_rwkv_chain(const Frame& F, const Args& a) {
    if (F.vcu >= 16 && F.vcu < 18) { const int c = (F.vcu - 16) * 512 + F.tid; const float* HL = (const float*)(a.ws + LR_H); const float* AP = (const float*)(a.ws + LR_A); float* CR = (float*)(a.ws + LR_C);
        float carry = 0.f;
#pragma unroll 8
        for (int sc = 0; sc < RW_NSC; ++sc) { const float hl = HL[sc * 1024 + c], ap = AP[sc * 1024 + c]; CR[sc * 1024 + c] = carry; carry = ap * carry + hl; }
        return; }
    if (F.vcu >= 16) return;
    const int hd = F.vcu; const bf16* RH = (const bf16*)(a.ws + RW_RH); const bf16* RL = (const bf16*)(a.ws + RW_RL); const bf16* GT = (const bf16*)(a.ws + RW_GT); const float* GAM = (const float*)(a.ws + RW_GAM); bf16* SALL = (bf16*)(a.ws + RW_SALL);
    constexpr int RW_NS = 5, SLOT = 8192 + 8192 + 8192 + 1024; static_assert(2 * 9216 + RW_NS * SLOT <= LDSCTL_OFF, "chain ring");
    LAS unsigned char* XS = F.lds + RING_OFF; LAS unsigned char* RG = XS + 2 * 9216;
    const int lane = F.lane, wave = F.wave, l31 = lane & 31, h = lane >> 5, jt = (wave >> 1) & 1, it = wave & 1, lw = wave & 3;
    for (int i = F.tid; i < 2 * 9216 / 4; i += NWAVES * 64) ((LAS unsigned*)XS)[i] = 0u;
#define RW_BAR() do { asm volatile("s_waitcnt lgkmcnt(0)" ::: "memory"); __builtin_amdgcn_s_barrier(); asm volatile("" ::: "memory"); } while (0)
    const unsigned rg0 = (unsigned)(uintptr_t)RG;
    int offR[2], offG[2];
#pragma unroll
    for (int i = 0; i < 2; ++i) { const int b = 2 * lw + i, row = 8 * b + (lane >> 3), pc = lane & 7; offR[i] = row * 64 + ((pc ^ (row & 7)) * 8); offG[i] = (b * 64 + lane) * 8; }
    const int offM = (lane & 15) * 4;
#define RW_DMA(src, dst) do { unsigned keep_; asm volatile("s_mov_b32 %0, m0\n\ts_mov_b32 m0, %2\n\ts_nop 0\n\tglobal_load_lds_dwordx4 %1, off\n\ts_mov_b32 m0, %0" : "=&s"(keep_) : "v"(src), "s"(dst) : "memory"); } while (0)
#define RW_ISSUE(scn) do { const int s_ = (scn) < RW_NSC ? (scn) : RW_NSC - 1; const size_t sch_ = (size_t)s_ * 16 + hd; \
        const unsigned sb_ = (unsigned)__builtin_amdgcn_readfirstlane((int)(rg0 + (unsigned)((scn) % RW_NS) * SLOT)); \
        _Pragma("unroll") for (int i_ = 0; i_ < 2; ++i_) { const unsigned bo_ = (unsigned)__builtin_amdgcn_readfirstlane((2 * lw + i_) * 1024); \
            RW_DMA(RH + sch_ * 4096 + offR[i_], sb_ + bo_); RW_DMA(RL + sch_ * 4096 + offR[i_], sb_ + 8192 + bo_); RW_DMA(GT + sch_ * 4096 + offG[i_], sb_ + 16384 + bo_); } \
        RW_DMA(GAM + sch_ * 64 + offM, sb_ + 24576); } while (0)
#define RW_WAITV(n) asm volatile("s_waitcnt vmcnt(" #n ")" ::: "memory")
    f32x16 X;
#pragma unroll
    for (int r = 0; r < 16; ++r) X[r] = 0.f;
    if (wave >= 4) { RW_ISSUE(0); RW_ISSUE(1); RW_ISSUE(2); RW_ISSUE(3); RW_WAITV(21); }
    RW_BAR();
    for (int sc = 0; sc < RW_NSC; ++sc) {
        if (wave < 4) {
            const LAS unsigned char* sb = RG + (sc % RW_NS) * SLOT;
            f32x16 acc; const size_t sch = (size_t)sc * 16 + hd;
            { const v4u g0 = *(const LAS v4u*)(sb + 16384 + ((jt * 2 + it) * 64 + lane) * 32), g1 = *(const LAS v4u*)(sb + 16384 + ((jt * 2 + it) * 64 + lane) * 32 + 16);
              const unsigned gw_[8] = {g0.x, g0.y, g0.z, g0.w, g1.x, g1.y, g1.z, g1.w};
#pragma unroll
              for (int g = 0; g < 4; ++g) { const f32x4 m = *(const LAS f32x4*)(sb + 24576 + (32 * jt + 8 * g + 4 * h) * 4);
                  acc[4 * g] = bflo(gw_[2 * g]) + m.x * X[4 * g]; acc[4 * g + 1] = bfhi(gw_[2 * g]) + m.y * X[4 * g + 1]; acc[4 * g + 2] = bflo(gw_[2 * g + 1]) + m.z * X[4 * g + 2]; acc[4 * g + 3] = bfhi(gw_[2 * g + 1]) + m.w * X[4 * g + 3]; } }
#pragma unroll
            for (int g = 0; g < 4; ++g) *(v2u*)(SALL + (sch * 64 + 32 * it + l31) * 64 + 32 * jt + 8 * g + 4 * h) = (v2u){pk2(X[4 * g], X[4 * g + 1]), pk2(X[4 * g + 2], X[4 * g + 3])};
            const LAS unsigned char* xb = XS + (sc & 1) * 9216 + (32 * it + l31) * 144 + 16 * h; const int ar = 32 * jt + l31; const LAS unsigned char* ab = sb + ar * 128;
#pragma unroll
            for (int ks = 0; ks < 4; ++ks) { const bf16x8 xf = *(const LAS bf16x8*)(xb + 32 * ks); const int po = (((2 * ks + h) ^ (ar & 7)) * 16);
                acc = MFMA32(*(const LAS bf16x8*)(ab + 8192 + po), xf, acc); acc = MFMA32(*(const LAS bf16x8*)(ab + po), xf, acc); }
            X = acc;
            LAS unsigned char* xn = XS + ((sc + 1) & 1) * 9216 + (32 * it + l31) * 144;
#pragma unroll
            for (int g = 0; g < 4; ++g) *(LAS v2u*)(xn + (32 * jt + 8 * g + 4 * h) * 2) = (v2u){pk2(X[4 * g], X[4 * g + 1]), pk2(X[4 * g + 2], X[4 * g + 3])};
        } else {
            RW_ISSUE(sc + RW_NS - 1);
            RW_WAITV(21);
        }
        RW_BAR();
    }
    if (wave >= 4) RW_WAITV(0);
#undef RW_ISSUE
#undef RW_DMA
#undef RW_WAITV
#undef RW_BAR
}

DI void ph_rwkv_out(const Frame& F, const Args& a) {
    const bf16* SALL = (const bf16*)(a.ws + RW_SALL); const bf16* PR = (const bf16*)(a.ws + RW_PR); const bf16* ATG = (const bf16*)(a.ws + RW_AT); const bf16* VTF = (const bf16*)(a.ws + RW_VTF);
    const bf16* VV = (const bf16*)(a.ws + RW_VV); const float* BON = (const float*)(a.ws + RW_BON); const float* GATE = (const float*)(a.ws + WS_SCR + SC_GATE); bf16* Y = (bf16*)(a.ws + WS_YMIX);
    const int lane = F.lane, l31 = lane & 31, h = lane >> 5;
    for (int item = F.gw; item < RW_NSC * 16; item += F.NGW) { const int sc = item >> 4, hd = item & 15; if (sc == 1) continue;
        const size_t sch = (size_t)sc * 16 + hd; f32x16 acc[2];
#pragma unroll
        for (int it = 0; it < 2; ++it) {
#pragma unroll
            for (int r = 0; r < 16; ++r) acc[it][r] = 0.f;
#pragma unroll
            for (int ks = 0; ks < 4; ++ks) acc[it] = MFMA32(*(const bf16x8*)(SALL + (sch * 64 + 32 * it + l31) * 64 + 16 * ks + 8 * h), *(const bf16x8*)(PR + (sch * 32 + l31) * 64 + 16 * ks + 8 * h), acc[it]);
#pragma unroll
            for (int ks = 0; ks < 2; ++ks) acc[it] = MFMA32(*(const bf16x8*)(VTF + ((sch * 4 + it * 2 + ks) * 64 + lane) * 8), *(const bf16x8*)(ATG + (sch * 32 + l31) * 32 + 16 * ks + 8 * h), acc[it]); }
        float s1 = 0.f;
#pragma unroll
        for (int it = 0; it < 2; ++it)
#pragma unroll
            for (int r = 0; r < 16; ++r) s1 += acc[it][r];
        s1 += __shfl_xor(s1, 32); const float mean = s1 * (1.0f / 64.0f); float s2 = 0.f;
#pragma unroll
        for (int it = 0; it < 2; ++it)
#pragma unroll
            for (int r = 0; r < 16; ++r) { const float d = acc[it][r] - mean; s2 += d * d; }
        s2 += __shfl_xor(s2, 32); const float rstd = 1.0f / sqrtf(s2 * (1.0f / 64.0f) + 64e-5f);
        const int rr = sub_row(sc, l31);
        if (rr >= 0) { const float bon = BON[(size_t)rr * 16 + hd];
#pragma unroll
            for (int it = 0; it < 2; ++it)
#pragma unroll
                for (int g = 0; g < 4; ++g) { const int c = hd * 64 + 32 * it + 8 * g + 4 * h;
                    const f32x4 lw = *(const f32x4*)(a.in[15] + c), lb = *(const f32x4*)(a.in[16] + c), gt = *(const f32x4*)(GATE + (size_t)rr * 1024 + c); const v2u vw = *(const v2u*)(VV + (size_t)rr * 1024 + c);
                    const float o0 = ((acc[it][4 * g] - mean) * rstd * lw.x + lb.x + bon * bflo(vw.x)) * gt.x, o1 = ((acc[it][4 * g + 1] - mean) * rstd * lw.y + lb.y + bon * bfhi(vw.x)) * gt.y;
                    const float o2 = ((acc[it][4 * g + 2] - mean) * rstd * lw.z + lb.z + bon * bflo(vw.y)) * gt.z, o3 = ((acc[it][4 * g + 3] - mean) * rstd * lw.w + lb.w + bon * bfhi(vw.y)) * gt.w;
                    *(v2u*)(Y + (size_t)rr * DM + c) = (v2u){pk2(o0, o1), pk2(o2, o3)}; } }
    }
    lru_apply(F, a);
}

constexpr int N_PHASES = 24;
template <class Epi, class Sched> DI void run_gemm(const Frame& F, const pg8::Gemm& g, const Sched& S, const Epi& E) {
    pg8::gemm_phase<Epi, Sched, true, true>(F.lds + RING_OFF, g, S, E);
}
DI void ph_moe_up(const Frame& F, const Args& a) {
    const int nt = (int)__hip_atomic_load((gu32*)(a.ws + WS_TILES) + 127, RLX_AGENT);
    pg8::Gemm g{(const bf16*)(a.ws + WS_SCR + SC_XG), (const bf16*)(a.ws + WS_MOEW), DM, DM, DM};
    pg8::MoeOrder S{(const int*)(a.ws + WS_TILES), nt, 4, F.G, (int)blockIdx.x, (long)MOE_E_BYTES};
    pg8::EpiSwiglu E{(bf16*)(a.ws + WS_SCR + SC_ACT), FF};
    run_gemm(F, g, S, E);
}
DI void ph_moe_down(const Frame& F, const Args& a) {
    const int nt = (int)__hip_atomic_load((gu32*)(a.ws + WS_TILES) + 127, RLX_AGENT);
    pg8::Gemm g{(const bf16*)(a.ws + WS_SCR + SC_ACT), (const bf16*)(a.ws + WS_MOEW + MOE_W2_OFF), FF, FF, FF};
    pg8::MoeOrder S{(const int*)(a.ws + WS_TILES), nt, 8, F.G, (int)blockIdx.x, (long)MOE_E_BYTES};
    pg8::EpiBf16 E{(bf16*)(a.ws + WS_SCR + SC_YB), DM};
    run_gemm(F, g, S, E);
}

__global__ void __launch_bounds__(NWAVES * 64, 2) hyb_fwd(Args a) {
    extern __shared__ __attribute__((aligned(16))) unsigned char lds[];
    Frame F;
    F.lds = (LAS unsigned char*)lds;
    F.MISC = (volatile LAS unsigned*)(F.lds + MISC_OFF);
    F.tid = threadIdx.x; F.lane = F.tid & 63; F.wave = __builtin_amdgcn_readfirstlane(F.tid >> 6);
    F.G = gridDim.x; { const int bx = blockIdx.x; F.vcu = (F.G % 8 == 0) ? (bx % 8) * (F.G / 8) + bx / 8 : bx; }
    F.gw = F.vcu * NWAVES + F.wave; F.NGW = F.G * NWAVES;
    F.ctl = (gu32*)(a.ws + WS_CTL);
    for (int u = F.tid; u < (LDS_BYTES - LDSCTL_OFF) / 4; u += NWAVES * 64) ((LAS unsigned*)(F.lds + LDSCTL_OFF))[u] = 0u;
    __syncthreads();
    XcdBarrier bar; bar.bar = (unsigned*)(F.ctl + CW_BAR); bar.x = 0; bar.st = nullptr;
    if (MK_ONE_LAUNCH) bar = xcd_barrier_post((unsigned*)(F.ctl + CW_BAR), F.MISC + 8);
    const int lo = a.ph_lo, hi = a.ph_hi;
#ifndef PH_MASK
#define PH_MASK 0xFFFFFFFFu
#endif
#define IN(k) (((PH_MASK >> (k)) & 1u) && lo <= (k) && (k) < hi)
#ifndef PROBE_REP
#define PROBE_REP 0u
#endif
#define REP(k) ((((unsigned)PROBE_REP >> (k)) & 1u) ? 2 : 1)
#ifdef PROBE_TS
#define STAMP(k) do { if (blockIdx.x == 0 && F.tid == 0) ((unsigned long long*)(F.ctl + CW_TS))[(k)] = __builtin_amdgcn_s_memrealtime(); } while (0)
#else
#define STAMP(k) do { } while (0)
#endif
#define SEAM(k) do { if (IN(k) && IN((k) + 1)) xcd_barrier(bar); STAMP((k) + 1); } while (0)
    const bf16* HN = (const bf16*)(a.ws + WS_HN); bf16* PROJ = (bf16*)(a.ws + WS_PROJ); const bf16* YMIX = (const bf16*)(a.ws + WS_YMIX); float* H = (float*)(a.ws + WS_H);

    STAMP(0);
    if (IN(0)) for (int rep_ = 0; rep_ < REP(0); ++rep_) ph_prologue(F, a);
    SEAM(0);
    if (IN(1)) for (int rep_ = 0; rep_ < REP(1); ++rep_) { pg8::Gemm g{HN, (const bf16*)(a.ws + WS_WEVIN), DM, DM, DM}; pg8::StaticOrder S; S.init(MP, EV_NP, F.G, (int)blockIdx.x); pg8::EpiBf16 E{PROJ, EV_NP}; run_gemm(F, g, S, E); }
    SEAM(1);
    if (IN(2)) for (int rep_ = 0; rep_ < REP(2); ++rep_) ph_even_prep(F, a);
    SEAM(2);
    if (IN(3)) for (int rep_ = 0; rep_ < REP(3); ++rep_) {
#ifndef NO_LORA
        { pg8::Gemm g{(const bf16*)(a.ws + WS_SCR + SC_ALORA), (const bf16*)(a.ws + WS_WLORA), 384, 384, 384}; pg8::StaticOrder S; S.init(MP, 3072, F.G, (int)blockIdx.x);
          static_assert(SC_ICL - SC_DEC == SC_GATE - SC_ICL, "lora outputs equally spaced");
          pg8::EpiLora E{(float*)(a.ws + WS_SCR + SC_DEC), (long)((SC_ICL - SC_DEC) / 4), a.in[7], a.in[9]}; run_gemm(F, g, S, E); }
#endif
#ifndef NO_GATES
        { pg8::Gemm g{(const bf16*)(a.ws + WS_SCR + SC_XR), (const bf16*)(a.ws + WS_WGATE), 256, 1024, 256}; pg8::StaticOrder S; S.init(MP, 2048, F.G, (int)blockIdx.x); S.amod = 4; S.astep = 512;
          pg8::EpiGates E{(float*)(a.ws + WS_SCR + SC_LA), (float*)(a.ws + WS_SCR + SC_LIX), a.in[20], a.in[22], a.in[23], (const bf16*)(a.ws + WS_SCR + SC_XR)}; run_gemm(F, g, S, E); }
#endif
    }
    SEAM(3);
    if (IN(4)) for (int rep_ = 0; rep_ < REP(4); ++rep_) ph_rwkv_chunk(F, a);
    SEAM(4);
    if (IN(5)) { ph_rwkv_chain(F, a); if (REP(5) == 2) { __syncthreads(); ph_rwkv_chain(F, a); } }
    SEAM(5);
    if (IN(6)) for (int rep_ = 0; rep_ < REP(6); ++rep_) ph_rwkv_out(F, a);
    SEAM(6);
    if (IN(7)) for (int rep_ = 0; rep_ < REP(7); ++rep_) { pg8::Gemm g{YMIX, (const bf16*)(a.ws + WS_WEVOUT), DM, DM, DM}; pg8::StaticOrder S; S.init(MP, DM, F.G, (int)blockIdx.x); pg8::EpiResid E{H, a.in[0], a.in[1], 0}; run_gemm(F, g, S, E); }
    SEAM(7);
    if (IN(8)) for (int rep_ = 0; rep_ < REP(8); ++rep_) ph_route(F, a, 0, rep_);
    SEAM(8);
    if (IN(9)) for (int rep_ = 0; rep_ < REP(9); ++rep_) ph_gather(F, a, 0);
    SEAM(9);
    if (IN(10)) for (int rep_ = 0; rep_ < REP(10); ++rep_) ph_moe_up(F, a);
    SEAM(10);
    if (IN(11)) for (int rep_ = 0; rep_ < REP(11); ++rep_) ph_moe_down(F, a);
    SEAM(11);
    if (IN(12)) for (int rep_ = 0; rep_ < REP(12); ++rep_) ph_combine(F, a, 0);
    SEAM(12);
    if (IN(13)) for (int rep_ = 0; rep_ < REP(13); ++rep_) { pg8::Gemm g{HN, (const bf16*)(a.ws + WS_WODIN), DM, DM, DM}; pg8::StaticOrder S; S.init(MP, OD_NP, F.G, (int)blockIdx.x); pg8::EpiBf16 E{PROJ, OD_NP}; run_gemm(F, g, S, E); }
    SEAM(13);
    if (IN(14)) for (int rep_ = 0; rep_ < REP(14); ++rep_) ph_odd_prep(F, a);
    SEAM(14);
    if (IN(15)) for (int rep_ = 0; rep_ < REP(15); ++rep_) ph_gdn_chunk(F, a);
    SEAM(15);
    if (IN(16)) { ph_gdn_chain(F, a); if (REP(16) == 2) { __syncthreads(); ph_gdn_chain(F, a); } }
    SEAM(16);
    if (IN(17)) for (int rep_ = 0; rep_ < REP(17); ++rep_) { ph_odd_post(F, a); moe_convert(F, a, 1); }
    SEAM(17);
    if (IN(18)) for (int rep_ = 0; rep_ < REP(18); ++rep_) { pg8::Gemm g{YMIX, (const bf16*)(a.ws + WS_WODOUT), 4096, 4096, 4096}; pg8::StaticOrder S; S.init(MP, DM, F.G, (int)blockIdx.x); pg8::EpiResid E{H, a.in[0], a.in[1], 1}; run_gemm(F, g, S, E); }
    SEAM(18);
    if (IN(19)) for (int rep_ = 0; rep_ < REP(19); ++rep_) ph_route(F, a, 1, rep_);
    SEAM(19);
    if (IN(20)) for (int rep_ = 0; rep_ < REP(20); ++rep_) ph_gather(F, a, 1);
    SEAM(20);
    if (IN(21)) for (int rep_ = 0; rep_ < REP(21); ++rep_) ph_moe_up(F, a);
    SEAM(21);
    if (IN(22)) for (int rep_ = 0; rep_ < REP(22); ++rep_) ph_moe_down(F, a);
    SEAM(22);
    if (IN(23)) for (int rep_ = 0; rep_ < REP(23); ++rep_) ph_combine(F, a, 1);
#undef IN
#undef SEAM
}

extern "C" void kernel_launch(void* const* d_in, const int* in_sizes, int n_in, void* d_out, int out_size, void* d_ws, size_t ws_size, hipStream_t stream) {
    static int grid = 0;
    if (grid == 0) {
        if (n_in != 36 || out_size != TX * DM || ws_size < WS_END) { fprintf(stderr, "kernel_launch: unexpected shapes (n_in %d, out %d, ws %zu)\n", n_in, out_size, ws_size); grid = -1; return; }
        int dev = 0, cus = 0, per_cu = 0;
        if (hipGetDevice(&dev) != hipSuccess || hipDeviceGetAttribute(&cus, hipDeviceAttributeMultiprocessorCount, dev) != hipSuccess) { grid = -1; return; }
        if (hipFuncSetAttribute((const void*)hyb_fwd, hipFuncAttributeMaxDynamicSharedMemorySize, LDS_BYTES) != hipSuccess) { fprintf(stderr, "kernel_launch: hipFuncSetAttribute failed\n"); grid = -1; return; }
        if (hipOccupancyMaxActiveBlocksPerMultiprocessor(&per_cu, (const void*)hyb_fwd, NWAVES * 64, LDS_BYTES) != hipSuccess || per_cu < 1) { fprintf(stderr, "kernel_launch: occupancy query says %d\n", per_cu); per_cu = 1; }
        (void)hipGetLastError();
        grid = cus;
    }
    if (grid < 0) return;
    if (hipMemsetAsync((char*)d_ws + WS_CTL, 0, CTL_ZERO_BYTES, stream) != hipSuccess) return;
    Args a{};
    for (int i = 0; i < 36; ++i) a.in[i] = (const float*)d_in[i];
    a.out = (float*)d_out; a.ws = (unsigned char*)d_ws;
#if MK_ONE_LAUNCH
    a.ph_lo = 0; a.ph_hi = N_PHASES;
    hipLaunchKernelGGL(hyb_fwd, dim3(grid), dim3(NWAVES * 64), LDS_BYTES, stream, a);
#else
    for (int p = 0; p < N_PHASES; ++p) { a.ph_lo = p; a.ph_hi = p + 1; hipLaunchKernelGGL(hyb_fwd, dim3(grid), dim3(NWAVES * 64), LDS_BYTES, stream, a); }
#endif
}
```

```cpp
#include <hip/hip_runtime.h>
#include <cstdio>
#include <cstdint>
#include <cmath>

#ifndef MK_ONE_LAUNCH
#define MK_ONE_LAUNCH 1
#endif

namespace pg8 {
#define PG8_LAS __attribute__((address_space(3)))
typedef unsigned short bf16_t;
typedef short bf16x8 __attribute__((ext_vector_type(8)));
typedef float f32x4 __attribute__((ext_vector_type(4)));
typedef unsigned u32x4 __attribute__((ext_vector_type(4)));
typedef unsigned u32x2 __attribute__((ext_vector_type(2)));
constexpr int BM = 256, BK = 64, HALF = 128, HTB = HALF * BK * 2  , STAGE_BYTES = 8 * HTB, NXCD = 8, WGM = 8;

__host__ __device__ __forceinline__ int lds_byte(int r, int c) { const int st = (r >> 4) * 2 + (c >> 5), rr = r & 15, cc = c & 31, ob = rr * 64 + cc * 2; return st * 1024 + (ob ^ (((ob >> 9) & 1) << 5)); }
__host__ __device__ __forceinline__ void stage_rc(int b, int& R, int& C) { const int st = b / 1024, sb = b % 1024, swz = sb ^ (((sb >> 9) & 1) << 5); R = (st >> 1) * 16 + swz / 64; C = (st & 1) * 32 + (swz % 64) / 2; }
__host__ __device__ __forceinline__ int perm32(int rho) { const int n = rho >> 4, i = rho & 15; return 8 * (i >> 2) + 4 * n + (i & 3); }

struct Unit { int pm, pn; long aoff, boff; };
struct Gemm { const bf16_t* A; const bf16_t* Bt; int K, lda, ldb; };

struct StaticOrder {
    int nM, nN, nwg, G, c, amod; long astep;
    __host__ __device__ void init(int M, int N, int G_, int c_) { nM = M / BM; nN = N / BM; nwg = nM * nN; G = G_; c = c_; amod = 0; astep = 0; }
    __host__ __device__ bool next(int i, Unit& u) const {
        const long L = (long)i * G + c; if (L >= nwg) return false;
        int wgid = (int)L; { const int q = nwg / NXCD, r = nwg % NXCD, xcd = wgid % NXCD, off = wgid / NXCD; wgid = (xcd < r ? xcd * (q + 1) : r * (q + 1) + (xcd - r) * q) + off; }
        const int nig = WGM * nN, gid = wgid / nig, fm = gid * WGM, gsz = (nM - fm) < WGM ? (nM - fm) : WGM;
        u.pm = fm + ((wgid % nig) % gsz); u.pn = (wgid % nig) / gsz; u.boff = 0; u.aoff = amod ? (long)(u.pn % amod) * astep : 0; return true;
    }
    __device__ __forceinline__ void a_ready(const Unit&) const {}
    __device__ __forceinline__ void done(const Unit&) const {}
};
struct MoeOrder {
    const int* tile_e; int ntiles, npn, G, c; long bstride;
    __device__ __forceinline__ bool next(int i, Unit& u) const {
        const long L = (long)i * G + c; if (L >= (long)ntiles * npn) return false;
        const int t = (int)(L / npn); u.pm = t; u.pn = (int)(L % npn); u.aoff = 0; u.boff = (long)tile_e[t] * bstride; return true;
    }
    __device__ __forceinline__ void a_ready(const Unit&) const {}
    __device__ __forceinline__ void done(const Unit&) const {}
};

__device__ __forceinline__ unsigned cvt_pk_bf16(float lo, float hi) { unsigned r; asm volatile("v_cvt_pk_bf16_f32 %0, %1, %2" : "=v"(r) : "v"(lo), "v"(hi)); return r; }
__device__ __forceinline__ float bf_lo(unsigned w) { return __uint_as_float(w << 16); }
__device__ __forceinline__ float bf_hi(unsigned w) { return __uint_as_float(w & 0xffff0000u); }
__device__ __forceinline__ float sigmoidf_(float x) { return 1.0f / (1.0f + __expf(-x)); }
__device__ __forceinline__ float softplusf_(float x) { return fmaxf(x, 0.f) + __logf(1.0f + __expf(-fabsf(x))); }

struct EpiBf16 {
    static constexpr bool PERM = true, AFTER_DRAIN = false;
    bf16_t* O; int ldc;
    __device__ __forceinline__ void operator()(const f32x4 (&acc)[2][2][4][2], const Unit& u, int wr, int wc, int fr, int fq) const {
        const int row0 = u.pm * BM + wr * 64 + fr; const int col0 = u.pn * BM + wc * 32 + 8 * fq;
#pragma unroll
        for (int ai = 0; ai < 2; ++ai)
#pragma unroll
            for (int m = 0; m < 4; ++m) { bf16_t* rowp = O + (size_t)(row0 + ai * HALF + m * 16) * ldc + col0;
#pragma unroll
                for (int bj = 0; bj < 2; ++bj) { const f32x4 v0 = acc[ai][bj][m][0], v1 = acc[ai][bj][m][1];
                    u32x4 w; w.x = cvt_pk_bf16(v0[0], v0[1]); w.y = cvt_pk_bf16(v0[2], v0[3]); w.z = cvt_pk_bf16(v1[0], v1[1]); w.w = cvt_pk_bf16(v1[2], v1[3]);
                    *(u32x4*)(rowp + bj * HALF) = w; } }
    }
};
struct EpiSwiglu {
    static constexpr bool PERM = true, AFTER_DRAIN = false;
    bf16_t* O; int ldc;
    __device__ __forceinline__ void operator()(const f32x4 (&acc)[2][2][4][2], const Unit& u, int wr, int wc, int fr, int fq) const {
        const int row0 = u.pm * BM + wr * 64 + fr; const int col0 = u.pn * HALF + wc * 32 + 8 * fq;
#pragma unroll
        for (int ai = 0; ai < 2; ++ai)
#pragma unroll
            for (int m = 0; m < 4; ++m) { bf16_t* rowp = O + (size_t)(row0 + ai * HALF + m * 16) * ldc + col0;
                float o[8];
#pragma unroll
                for (int n = 0; n < 2; ++n)
#pragma unroll
                    for (int j = 0; j < 4; ++j) { const float gq = acc[ai][0][m][n][j], uq = acc[ai][1][m][n][j]; o[4 * n + j] = gq * sigmoidf_(gq) * uq; }
                u32x4 w; w.x = cvt_pk_bf16(o[0], o[1]); w.y = cvt_pk_bf16(o[2], o[3]); w.z = cvt_pk_bf16(o[4], o[5]); w.w = cvt_pk_bf16(o[6], o[7]);
                *(u32x4*)rowp = w; }
    }
};
struct EpiResid {
    static constexpr bool PERM = false, AFTER_DRAIN = false;
    float* out; const float* x; const float* meta; int mode;
    __device__ __forceinline__ void operator()(const f32x4 (&acc)[2][2][4][2], const Unit& u, int wr, int wc, int fr, int fq) const {
        const int row0 = u.pm * BM + wr * 64 + fr, col0 = u.pn * BM + wc * 32 + 4 * fq;
#pragma unroll
        for (int ai = 0; ai < 2; ++ai)
#pragma unroll
            for (int m = 0; m < 4; ++m) { const int row = row0 + ai * HALF + m * 16; float* rowp = out + (size_t)row * 2048 + col0;
                const float* bp = mode ? rowp : (row < 8192 ? x + (size_t)row * 2048 + col0 : (row < 8208 ? meta + (size_t)(row - 8192) * 2048 + col0 : nullptr));
#pragma unroll
                for (int bj = 0; bj < 2; ++bj)
#pragma unroll
                    for (int n = 0; n < 2; ++n) { f32x4 b = (f32x4){0.f, 0.f, 0.f, 0.f}; if (bp) b = *(const f32x4*)(bp + bj * HALF + n * 16);
                        *(f32x4*)(rowp + bj * HALF + n * 16) = acc[ai][bj][m][n] + b; } }
    }
};
struct EpiLora {
    static constexpr bool PERM = false, AFTER_DRAIN = false;
    float* base; long gstride; const float* w0; const float* a0;
    __device__ __forceinline__ void operator()(const f32x4 (&acc)[2][2][4][2], const Unit& u, int wr, int wc, int fr, int fq) const {
        const int grp = u.pn >> 2; const int row0 = u.pm * BM + wr * 64 + fr, col0 = (u.pn & 3) * BM + wc * 32 + 4 * fq;
        float* O = base + (size_t)grp * gstride;
#pragma unroll
        for (int bj = 0; bj < 2; ++bj)
#pragma unroll
            for (int n = 0; n < 2; ++n) { const int c = col0 + bj * HALF + n * 16;
                f32x4 bv = (f32x4){0.f, 0.f, 0.f, 0.f}; if (grp == 0) bv = *(const f32x4*)(w0 + c); else if (grp == 1) bv = *(const f32x4*)(a0 + c);
#pragma unroll
                for (int ai = 0; ai < 2; ++ai)
#pragma unroll
                    for (int m = 0; m < 4; ++m) { f32x4 v = acc[ai][bj][m][n] + bv;
                        if (grp == 0) {
#pragma unroll
                            for (int j = 0; j < 4; ++j) { const float wl = -softplusf_(-v[j]) - 0.5f; v[j] = __expf(-__expf(wl)); }
                        } else if (grp == 1) {
#pragma unroll
                            for (int j = 0; j < 4; ++j) v[j] = sigmoidf_(v[j]);
                        }
                        *(f32x4*)(O + (size_t)(row0 + ai * HALF + m * 16) * 1024 + c) = v; } }
    }
};
struct EpiGates {
    static constexpr bool PERM = false, AFTER_DRAIN = false;
    float* lru_a; float* lru_ix; const float* ba; const float* bx; const float* lam; const bf16_t* xr;
    __device__ __forceinline__ void operator()(const f32x4 (&acc)[2][2][4][2], const Unit& u, int wr, int wc, int fr, int fq) const {
        const int grp = u.pn >> 2; const int row0 = u.pm * BM + wr * 64 + fr, col0 = (u.pn & 3) * BM + wc * 32 + 4 * fq;
#pragma unroll
        for (int bj = 0; bj < 2; ++bj)
#pragma unroll
            for (int n = 0; n < 2; ++n) { const int c = col0 + bj * HALF + n * 16;
                const f32x4 bv = *(const f32x4*)((grp == 0 ? ba : bx) + c); f32x4 sp = (f32x4){0.f, 0.f, 0.f, 0.f};
                if (grp == 0) { const f32x4 l = *(const f32x4*)(lam + c);
#pragma unroll
                    for (int j = 0; j < 4; ++j) sp[j] = -8.0f * softplusf_(-l[j]); }
#pragma unroll
                for (int ai = 0; ai < 2; ++ai)
#pragma unroll
                    for (int m = 0; m < 4; ++m) { const int row = row0 + ai * HALF + m * 16; f32x4 v = acc[ai][bj][m][n] + bv;
                        if (grp == 0) {
#pragma unroll
                            for (int j = 0; j < 4; ++j) v[j] = __expf(sigmoidf_(v[j]) * sp[j]);
                            *(f32x4*)(lru_a + (size_t)row * 1024 + c) = v;
                        } else { const u32x2 xw = *(const u32x2*)(xr + (size_t)row * 1024 + c);
                            v[0] = sigmoidf_(v[0]) * bf_lo(xw.x); v[1] = sigmoidf_(v[1]) * bf_hi(xw.x); v[2] = sigmoidf_(v[2]) * bf_lo(xw.y); v[3] = sigmoidf_(v[3]) * bf_hi(xw.y);
                            *(f32x4*)(lru_ix + (size_t)row * 1024 + c) = v; } } }
    }
};

template <class Epi, class Sched, bool ALIGN_EPI = false, bool SP2 = false>
__device__ __forceinline__ void gemm_phase(PG8_LAS unsigned char* lds, const Gemm g, const Sched& S, const Epi& E) {
    const int tid = threadIdx.x, wid = __builtin_amdgcn_readfirstlane(tid >> 6), lane = tid & 63, wr = wid >> 2, wc = wid & 3, fr = lane & 15, fq = lane >> 4;
    const int K = g.K, nt = K / BK;
    unsigned voffA[2], voffB[2];
#pragma unroll
    for (int i = 0; i < 2; ++i) { int R, C; stage_rc(tid * 16 + i * 8192, R, C); const int Rb = Epi::PERM ? ((R & ~31) + perm32(R & 31)) : R;
        voffA[i] = (unsigned)(R * g.lda + C) * 2u; voffB[i] = (unsigned)(Rb * g.ldb + C) * 2u; }
    const size_t kstep = (size_t)(BK * 2);
    const size_t hstepA = (size_t)HALF * g.lda * 2, hstepB = (size_t)HALF * g.ldb * 2;
    const size_t tstepA = 2 * hstepA, tstepB = 2 * hstepB;
    const unsigned ldsw = (unsigned)wid * 1024u;
    const int aoff = lds_byte(wr * 64 + fr, fq * 8), boff = lds_byte(wc * 32 + fr, fq * 8);
#define PG8_SA(b, h) (((b) * 2 + (h)) * HTB)
#define PG8_SB(b, h) ((4 + (b) * 2 + (h)) * HTB)
#define PG8_STAGE(bufoff, gbase, voff) do { _Pragma("unroll") for (int _i = 0; _i < 2; ++_i) \
        __builtin_amdgcn_global_load_lds((const unsigned*)((const char*)(gbase) + (voff)[_i]), (PG8_LAS unsigned*)(lds + (bufoff) + ldsw + _i * 8192), 16, 0, 0); } while (0)
#define PG8_LDA(dst, b, h) do { _Pragma("unroll") for (int m = 0; m < 4; ++m) _Pragma("unroll") for (int k = 0; k < 2; ++k) dst[m][k] = *(const PG8_LAS bf16x8*)(lds + PG8_SA(b, h) + aoff + m * 2048 + k * 1024); } while (0)
#define PG8_LDB(dst, b, h) do { _Pragma("unroll") for (int n = 0; n < 2; ++n) _Pragma("unroll") for (int k = 0; k < 2; ++k) dst[n][k] = *(const PG8_LAS bf16x8*)(lds + PG8_SB(b, h) + boff + n * 2048 + k * 1024); } while (0)
#define PG8_MMA(ai, bj, At, Bt) do { __builtin_amdgcn_s_setprio(1); _Pragma("unroll") for (int m = 0; m < 4; ++m) _Pragma("unroll") for (int n = 0; n < 2; ++n) _Pragma("unroll") for (int k = 0; k < 2; ++k) \
        acc[ai][bj][m][n] = __builtin_amdgcn_mfma_f32_16x16x32_bf16(Bt[n][k], At[m][k], acc[ai][bj][m][n], 0, 0, 0); __builtin_amdgcn_s_setprio(0); } while (0)
#define PG8_WAIT_V(n) asm volatile("s_waitcnt vmcnt(" #n ")" ::: "memory")
#define PG8_WAIT_L(n) asm volatile("s_waitcnt lgkmcnt(" #n ")" ::: "memory")
#define PG8_BAR __builtin_amdgcn_s_barrier()
#define PG8_SCHED __builtin_amdgcn_sched_barrier(0)
    Unit cur, nxt; int ui = 0;
    if (!S.next(0, cur)) return;
    f32x4 acc[2][2][4][2];
#pragma unroll
    for (int a = 0; a < 2; ++a)
#pragma unroll
        for (int b = 0; b < 2; ++b)
#pragma unroll
            for (int m = 0; m < 4; ++m)
#pragma unroll
                for (int n = 0; n < 2; ++n) acc[a][b][m][n] = (f32x4){0.f, 0.f, 0.f, 0.f};
    bf16x8 At[4][2], B0[2][2], B1[2][2];
    const char* cA = (const char*)g.A + (size_t)cur.pm * tstepA + cur.aoff; const char* cB = (const char*)g.Bt + (size_t)cur.pn * tstepB + cur.boff;
    S.a_ready(cur);
    if constexpr (SP2) {
        PG8_STAGE(PG8_SB(0, 0), cB, voffB); PG8_STAGE(PG8_SB(0, 1), cB + hstepB, voffB); PG8_STAGE(PG8_SA(0, 0), cA, voffA); PG8_STAGE(PG8_SA(0, 1), cA + hstepA, voffA);
        if (wr == 1) PG8_BAR;
        PG8_WAIT_V(2); PG8_BAR;
        PG8_STAGE(PG8_SB(1, 0), cB + kstep, voffB); PG8_STAGE(PG8_SA(1, 0), cA + kstep, voffA); PG8_STAGE(PG8_SB(1, 1), cB + hstepB + kstep, voffB);
        PG8_WAIT_V(6); PG8_BAR;
    } else {
        PG8_STAGE(PG8_SB(0, 0), cB, voffB); PG8_STAGE(PG8_SA(0, 0), cA, voffA); PG8_STAGE(PG8_SB(0, 1), cB + hstepB, voffB); PG8_STAGE(PG8_SA(0, 1), cA + hstepA, voffA);
        if (wr == 1) PG8_BAR;
        PG8_WAIT_V(4); PG8_BAR;
        PG8_STAGE(PG8_SB(1, 0), cB + kstep, voffB); PG8_STAGE(PG8_SA(1, 0), cA + kstep, voffA); PG8_STAGE(PG8_SB(1, 1), cB + hstepB + kstep, voffB);
        PG8_WAIT_V(6); PG8_BAR;
    }
    for (;;) {
        const bool has_next = S.next(ui + 1, nxt);
        const char* nA = has_next ? (const char*)g.A + (size_t)nxt.pm * tstepA + nxt.aoff : cA; const char* nB = has_next ? (const char*)g.Bt + (size_t)nxt.pn * tstepB + nxt.boff : cB;
        for (int t = 0; t < nt; t += 2) {
            const bool last = (t == nt - 2);
            const char* a1 = cA + (size_t)(t + 1) * kstep;
            const char* a2 = last ? nA : cA + (size_t)(t + 2) * kstep; const char* b2 = last ? nB : cB + (size_t)(t + 2) * kstep;
            const char* a3 = a2 + kstep; const char* b3 = b2 + kstep;
            if (last && has_next) S.a_ready(nxt);
            if constexpr (SP2) {
            PG8_LDB(B0, 0, 0); PG8_LDB(B1, 0, 1); PG8_SCHED; PG8_LDA(At, 0, 0); PG8_STAGE(PG8_SA(1, 1), a1 + hstepA, voffA);
            PG8_WAIT_V(8); PG8_WAIT_L(0); PG8_BAR; PG8_MMA(0, 0, At, B0); PG8_MMA(0, 1, At, B1); PG8_BAR; PG8_SCHED;
            PG8_LDA(At, 0, 1); PG8_STAGE(PG8_SB(0, 0), b2, voffB); PG8_STAGE(PG8_SB(0, 1), b2 + hstepB, voffB); PG8_STAGE(PG8_SA(0, 0), a2, voffA);
            PG8_WAIT_V(8); PG8_WAIT_L(0); PG8_BAR; PG8_MMA(1, 0, At, B0); PG8_MMA(1, 1, At, B1); PG8_BAR; PG8_SCHED;
            PG8_LDB(B0, 1, 0); PG8_LDB(B1, 1, 1); PG8_SCHED; PG8_LDA(At, 1, 0); PG8_STAGE(PG8_SA(0, 1), a2 + hstepA, voffA);
            PG8_WAIT_V(8); PG8_WAIT_L(0); PG8_BAR; PG8_MMA(0, 0, At, B0); PG8_MMA(0, 1, At, B1); PG8_BAR; PG8_SCHED;
            PG8_LDA(At, 1, 1); PG8_STAGE(PG8_SB(1, 0), b3, voffB); PG8_STAGE(PG8_SB(1, 1), b3 + hstepB, voffB); PG8_STAGE(PG8_SA(1, 0), a3, voffA);
            PG8_WAIT_V(8); PG8_WAIT_L(0); PG8_BAR; PG8_MMA(1, 0, At, B0); PG8_MMA(1, 1, At, B1); PG8_BAR; PG8_SCHED;
            } else {
            PG8_LDB(B0, 0, 0); PG8_SCHED; PG8_LDA(At, 0, 0); PG8_STAGE(PG8_SA(1, 1), a1 + hstepA, voffA);
            PG8_WAIT_L(8); PG8_BAR; PG8_WAIT_L(0); PG8_MMA(0, 0, At, B0); PG8_BAR; PG8_SCHED;
            PG8_LDB(B1, 0, 1); PG8_STAGE(PG8_SB(0, 0), b2, voffB);
            PG8_BAR; PG8_WAIT_L(0); PG8_MMA(0, 1, At, B1); PG8_BAR;
            PG8_LDA(At, 0, 1); PG8_STAGE(PG8_SA(0, 0), a2, voffA);
            PG8_BAR; PG8_WAIT_L(0); PG8_MMA(1, 0, At, B0); PG8_BAR; PG8_SCHED;
            PG8_STAGE(PG8_SB(0, 1), b2 + hstepB, voffB);
            PG8_WAIT_V(6); PG8_BAR; PG8_MMA(1, 1, At, B1); PG8_BAR;
            PG8_LDB(B0, 1, 0); PG8_SCHED; PG8_LDA(At, 1, 0); PG8_STAGE(PG8_SA(0, 1), a2 + hstepA, voffA);
            PG8_WAIT_L(8); PG8_BAR; PG8_WAIT_L(0); PG8_MMA(0, 0, At, B0); PG8_BAR; PG8_SCHED;
            PG8_LDB(B1, 1, 1); PG8_STAGE(PG8_SB(1, 0), b3, voffB);
            PG8_BAR; PG8_WAIT_L(0); PG8_MMA(0, 1, At, B1); PG8_BAR;
            PG8_LDA(At, 1, 1); PG8_STAGE(PG8_SA(1, 0), a3, voffA);
            PG8_BAR; PG8_WAIT_L(0); PG8_MMA(1, 0, At, B0); PG8_BAR; PG8_SCHED;
            PG8_STAGE(PG8_SB(1, 1), b3 + hstepB, voffB);
            PG8_WAIT_V(6); PG8_BAR; PG8_MMA(1, 1, At, B1); PG8_BAR;
            }
        }
        if constexpr (ALIGN_EPI) { if (wr == 0) PG8_BAR; }
        if constexpr (!Epi::AFTER_DRAIN) { E(acc, cur, wr, wc, fr, fq); S.done(cur); }
        if (!has_next) break;
#pragma unroll
        for (int a = 0; a < 2; ++a)
#pragma unroll
            for (int b = 0; b < 2; ++b)
#pragma unroll
                for (int m = 0; m < 4; ++m)
#pragma unroll
                    for (int n = 0; n < 2; ++n) acc[a][b][m][n] = (f32x4){0.f, 0.f, 0.f, 0.f};
        cur = nxt; cA = nA; cB = nB; ++ui;
        if constexpr (ALIGN_EPI) { if (wr == 1) PG8_BAR; }
    }
    PG8_WAIT_V(0);
    if constexpr (!ALIGN_EPI) { if (wr == 0) PG8_BAR; }
    PG8_BAR;
    if constexpr (Epi::AFTER_DRAIN) { E.fused(acc, cur, wr, wc, fr, fq, lds, wid, lane); S.done(cur); }
#undef PG8_SA
#undef PG8_SB
#undef PG8_STAGE
#undef PG8_LDA
#undef PG8_LDB
#undef PG8_MMA
#undef PG8_WAIT_V
#undef PG8_WAIT_L
#undef PG8_BAR
#undef PG8_SCHED
}
}
#define GAS __attribute__((address_space(1)))
#define LAS __attribute__((address_space(3)))
typedef unsigned short bf16;
typedef unsigned v4u __attribute__((ext_vector_type(4)));
typedef float f32x4 __attribute__((ext_vector_type(4)));
typedef short bf16x8 __attribute__((ext_vector_type(8)));
typedef GAS unsigned gu32;
typedef GAS unsigned long long gu64;
#define RLX_AGENT __ATOMIC_RELAXED, __HIP_MEMORY_SCOPE_AGENT
#define LDS_WAIT() asm volatile("s_waitcnt lgkmcnt(0)" ::: "memory")
#define VM_WAIT() asm volatile("s_waitcnt vmcnt(0)" ::: "memory")
__device__ __forceinline__ unsigned long long rt() { return __builtin_amdgcn_s_memrealtime(); }
__device__ __forceinline__ unsigned f2bf(float f) { unsigned u = __builtin_bit_cast(unsigned, f); return (u + 0x7fffu + ((u >> 16) & 1u)) >> 16; }
__device__ __forceinline__ unsigned pk2(float lo, float hi) { return f2bf(lo) | (f2bf(hi) << 16); }

#define XB_TMO      128
#define XB_XCNT(j)  (256  + 64 * (j))
#define XB_XSUB(j)  (1280 + 64 * (j))
#define XB_XGEN(j)  (2304 + 64 * (j))
#define XB_TOP      3328
#define XB_TOPGEN   3392
#define XCD_BAR_WORDS 3456
#define XB_SPIN_CAP (1u << 18)

__device__ __forceinline__ unsigned xb_ld(unsigned* p)              { return __hip_atomic_load(p, __ATOMIC_RELAXED, __HIP_MEMORY_SCOPE_AGENT); }
__device__ __forceinline__ unsigned xb_add(unsigned* p, unsigned v) { return __hip_atomic_fetch_add(p, v, __ATOMIC_RELAXED, __HIP_MEMORY_SCOPE_AGENT); }
__device__ __forceinline__ unsigned xb_xcc_id() { return (unsigned)__builtin_amdgcn_s_getreg((3 << 11) | 20) & 0xFu; }
#define XB_SPIN(cond, bar) do { unsigned _sp = 0; while (cond) { __builtin_amdgcn_s_sleep(1); \
    if ((++_sp & 255u) == 0u) { if (xb_ld(&(bar)[XB_TMO])) break; if (_sp > XB_SPIN_CAP) { atomicAdd(&(bar)[XB_TMO], 1u); break; } } } } while (0)

struct XcdBarrier {
    unsigned* bar; unsigned x;
    volatile LAS unsigned* st;
};

__device__ __forceinline__ XcdBarrier xcd_barrier_post(unsigned* bar, volatile LAS unsigned* st) {
    XcdBarrier b; b.bar = bar; b.x = xb_xcc_id(); b.st = st;
    if (threadIdx.x == 0) (void)xb_add(&bar[XB_XCNT(b.x)], 1u);
    return b;
}
__device__ __forceinline__ void xcd_barrier_complete(unsigned* bar, unsigned x, unsigned& nloc, unsigned& nx) {
    const unsigned G = gridDim.x * gridDim.y * gridDim.z;
    unsigned sum, cnt, mine, sp = 0u;
    for (;;) {
        sum = 0u; cnt = 0u; mine = 0u;
#pragma unroll
        for (unsigned j = 0; j < 16; ++j) { const unsigned c = xb_ld(&bar[XB_XCNT(j)]); sum += c; cnt += (c > 0u) ? 1u : 0u; mine = (j == x) ? c : mine; }
        if (sum == G) break;
        __builtin_amdgcn_s_sleep(1);
        if ((++sp & 255u) == 0u) { if (xb_ld(&bar[XB_TMO])) break; if (sp > XB_SPIN_CAP) { atomicAdd(&bar[XB_TMO], 1u); break; } }
    }
    nloc = mine > 0u ? mine : 1u; nx = cnt > 0u ? cnt : 1u;
}

__device__ __forceinline__ void xcd_barrier(const XcdBarrier& b) {
    asm volatile("s_waitcnt vmcnt(0)" ::: "memory");
    __syncthreads();
    if (threadIdx.x == 0) {
        unsigned* bar = b.bar;
        __builtin_amdgcn_s_waitcnt(0);
        unsigned nloc = b.st[0], nx = b.st[1];
        if (nloc == 0u) { xcd_barrier_complete(bar, b.x, nloc, nx); b.st[0] = nloc; b.st[1] = nx; }
        const unsigned old = xb_add(&bar[XB_XSUB(b.x)], 1u);
        const unsigned gen = old / nloc;
        if (old + 1u == (gen + 1u) * nloc) {
            __builtin_amdgcn_fence(__ATOMIC_RELEASE, "agent");
            asm volatile("s_waitcnt vmcnt(0)" ::: "memory");
            const unsigned og = xb_add(&bar[XB_TOP], 1u);
            const unsigned tg = og / nx;
            if (og + 1u == (tg + 1u) * nx) xb_add(&bar[XB_TOPGEN], 1u);
            else XB_SPIN(xb_ld(&bar[XB_TOPGEN]) == tg, bar);
            __builtin_amdgcn_fence(__ATOMIC_ACQUIRE, "agent");
            xb_add(&bar[XB_XGEN(b.x)], 1u);
            asm volatile("s_waitcnt vmcnt(0)" ::: "memory");
        } else {
            XB_SPIN(xb_ld(&bar[XB_XGEN(b.x)]) == gen, bar);
            __builtin_amdgcn_fence(__ATOMIC_ACQUIRE, "agent");
            asm volatile("s_waitcnt vmcnt(0)" ::: "memory");
        }
    }
    __syncthreads();
}

constexpr int NWAVES = 8;
constexpr int DM = 2048, TX = 8192, NMETA = 16, TT = TX + NMETA, MP = 8448;
constexpr int EV_NP = 5632, EV_LORA0 = 3072, EV_GB = 3360, EV_REC = 4384;
constexpr int OD_NP = 12544, OD_Z = 8192, OD_B = 12288, OD_A = 12320;
constexpr int NEXP = 32, FF = 512, MOE_ROWS = 24576;
constexpr float NORM_EPS = 1e-6f;

constexpr size_t MiB = 1u << 20;
constexpr size_t WS_CTL = 0, CTL_ZERO_BYTES = 1 * MiB;
constexpr size_t WS_TOKINFO = 1 * MiB;
constexpr size_t WS_TILES = 1 * MiB + 512 * 1024;
constexpr size_t WS_WEVIN = 2 * MiB;
constexpr size_t WS_WEVOUT = 24 * MiB;
constexpr size_t WS_WODIN = 32 * MiB;
constexpr size_t WS_WODOUT = 81 * MiB;
constexpr size_t WS_WLORA = 97 * MiB;
constexpr size_t WS_WGATE = 100 * MiB;
constexpr size_t WS_WROUTE = 101 * MiB;
constexpr size_t WS_MOEW = 102 * MiB;
constexpr size_t MOE_E_BYTES = 6 * MiB, MOE_W2_OFF = 4 * MiB;
constexpr size_t WS_H = 294 * MiB;
constexpr size_t WS_HN = 360 * MiB;
constexpr size_t WS_YMIX = 393 * MiB;
constexpr size_t WS_PROJ = 459 * MiB;
constexpr size_t WS_SCR = 662 * MiB;
constexpr size_t WS_END = 932 * MiB;
constexpr size_t SC_ALORA = 0;
constexpr size_t SC_XR = 8 * MiB;
constexpr size_t SC_DEC = 26 * MiB, SC_ICL = 60 * MiB, SC_GATE = 94 * MiB;
constexpr size_t SC_LA = 128 * MiB, SC_LIX = 162 * MiB;
constexpr size_t SC_QN = 0, SC_KN = 34 * MiB;
constexpr size_t SC_VC = 68 * MiB;
constexpr size_t SC_BETA = 134 * MiB, SC_G = 136 * MiB;
constexpr size_t SC_O = 138 * MiB;
constexpr size_t SC_XG = 0;
constexpr size_t SC_ACT = 96 * MiB;
constexpr size_t SC_YB = 120 * MiB;
static_assert(SC_O + (size_t)MP * 4096 * 4 <= WS_END - WS_SCR && SC_YB + (size_t)MOE_ROWS * 2048 * 2 <= WS_END - WS_SCR && SC_LIX + (size_t)MP * 1024 * 4 <= WS_END - WS_SCR, "scratch map");
constexpr int CW_TMO = 0, CW_CODE = 1;
constexpr int CW_BAR = 4096;
constexpr int CW_PROG = 20480;
constexpr int CW_TS = 24576;
constexpr int CW_MOECNT = 16384;

constexpr int RING_OFF = 0, RING_BYTES = 131072;
constexpr int LDSCTL_OFF = 146944, MISC_OFF = LDSCTL_OFF + 320;
constexpr int LDS_BYTES = 147456;


#define DI __device__ __forceinline__
typedef unsigned v2u __attribute__((ext_vector_type(2)));
struct Args { const float* in[36]; float* out; unsigned char* ws; int ph_lo, ph_hi; };
struct Frame {
    LAS unsigned char* lds; volatile LAS unsigned* MISC; gu32* ctl;
    int tid, lane, wave, vcu, G, gw, NGW;
};
DI float bf2f(bf16 v) { return __uint_as_float((unsigned)v << 16); }
DI float bflo(unsigned w) { return __uint_as_float(w << 16); }
DI float bfhi(unsigned w) { return __uint_as_float(w & 0xffff0000u); }
DI float wave_sum(float v) {
#pragma unroll
    for (int o = 1; o < 64; o <<= 1) v += __shfl_xor(v, o);
    return v;
}
DI float sigm(float x) { return 1.0f / (1.0f + __expf(-x)); }
DI float softplus(float x) { return fmaxf(x, 0.f) + __logf(1.0f + __expf(-fabsf(x))); }
DI float gelu_tanh(float x) { const float u = 0.7978845608028654f * (x + 0.044715f * x * x * x); return 0.5f * x * (1.0f + tanhf(u)); }
DI int pos_row(int p) { return p < NMETA ? TX + p : p - NMETA; }
DI int row_pos(int r) { return r < TX ? r + NMETA : r - TX; }

DI void tr_item(const float* W, int N, int k0, int n0, bf16* WT, int ldk, int drow0, LAS float* scr, int lane) {
#pragma unroll 8
    for (int i = 0; i < 32; ++i) { const int kk = 2 * i + (lane >> 5); scr[kk * 33 + (lane & 31)] = W[(size_t)(k0 + kk) * N + n0 + (lane & 31)]; }
    LDS_WAIT(); asm volatile("" ::: "memory");
    const int c = lane & 7;
#pragma unroll
    for (int j = 0; j < 4; ++j) { const int n = (lane >> 3) + 8 * j; const LAS float* s = scr + (8 * c) * 33 + n;
        v4u o; o.x = pk2(s[0 * 33], s[1 * 33]); o.y = pk2(s[2 * 33], s[3 * 33]); o.z = pk2(s[4 * 33], s[5 * 33]); o.w = pk2(s[6 * 33], s[7 * 33]);
        *(v4u*)(WT + (size_t)(drow0 + n) * ldk + k0 + 8 * c) = o; }
    LDS_WAIT(); asm volatile("" ::: "memory");
}
DI void moe_convert(const Frame& F, const Args& a, int l, int gw, int ngw) {
    LAS float* scr = (LAS float*)(F.lds + RING_OFF + F.wave * 16384);
    bf16* base = (bf16*)(a.ws + WS_MOEW);
    for (int it = gw; it < NEXP * 1536; it += ngw) {
        const int e = it / 1536; int j = it % 1536; bf16* eb = base + (size_t)e * (MOE_E_BYTES / 2);
        const size_t eoff = (size_t)(l * NEXP + e) * DM * FF;
        if (j < 1024) { const float* W = (j < 512 ? a.in[33] : a.in[34]) + eoff; const int hi = j >= 512; j &= 511; const int kb = j >> 4, nb = j & 15, n0 = 32 * nb;
            tr_item(W, FF, 64 * kb, n0, eb, DM, 256 * (n0 >> 7) + 128 * hi + (n0 & 127), scr, F.lane); }
        else { j -= 1024; const int kb = j >> 6, nb = j & 63; tr_item(a.in[35] + eoff, DM, 64 * kb, 32 * nb, eb + MOE_W2_OFF / 2, FF, 32 * nb, scr, F.lane); }
    }
}
DI void norm_row_bf16(int lane, const float* src, const float* w, bf16* dst) {
    f32x4 v[8]; float s = 0.f;
#pragma unroll
    for (int j = 0; j < 8; ++j) { v[j] = ((const f32x4*)src)[lane + 64 * j]; s += (v[j].x * v[j].x + v[j].y * v[j].y) + (v[j].z * v[j].z + v[j].w * v[j].w); }
    const float rs = 1.0f / sqrtf(wave_sum(s) * (1.0f / DM) + NORM_EPS);
#pragma unroll
    for (int j = 0; j < 8; ++j) { const f32x4 wv = ((const f32x4*)w)[lane + 64 * j]; v2u o; o.x = pk2(v[j].x * rs * wv.x, v[j].y * rs * wv.y); o.y = pk2(v[j].z * rs * wv.z, v[j].w * rs * wv.w);
        ((v2u*)dst)[lane + 64 * j] = o; }
}

DI void ph_prologue(const Frame& F, const Args& a) {
    LAS float* scr = (LAS float*)(F.lds + RING_OFF + F.wave * 16384);
    constexpr int I_A = 32 * 169, I_B = 32 * 64, NIT = I_A + I_B;
    for (int it = F.gw; it < NIT; it += F.NGW) {
        int r = it;
        if (r < I_A) { const int kb = r / 169, nb = r % 169; tr_item(a.in[5], 5408, 64 * kb, 32 * nb, (bf16*)(a.ws + WS_WEVIN), DM, 32 * nb, scr, F.lane); continue; } r -= I_A;
        { const int kb = r / 64, nb = r % 64; tr_item(a.in[24], DM, 64 * kb, 32 * nb, (bf16*)(a.ws + WS_WEVOUT), DM, 32 * nb, scr, F.lane); }
    }
    const int gt = F.vcu * (NWAVES * 64) + F.tid, NGT = F.G * NWAVES * 64;
    { bf16* WL = (bf16*)(a.ws + WS_WLORA); const float* wup = a.in[8]; const float* aup = a.in[10]; const float* gup = a.in[11];
      for (int idx = gt; idx < 3072 * 384; idx += NGT) { const int n = idx / 384, k = idx % 384; float v = 0.f;
          if (n < 1024) { if (k < 64) v = wup[k * 1024 + n]; }
          else if (n < 2048) { if (k >= 64 && k < 128) v = aup[(k - 64) * 1024 + n - 1024]; }
          else { if (k >= 128 && k < 288) v = gup[(k - 128) * 1024 + n - 2048]; }
          WL[idx] = (bf16)f2bf(v); } }
    { bf16* WG = (bf16*)(a.ws + WS_WGATE);
      for (int idx = gt; idx < 2048 * 256; idx += NGT) { const int n = idx >> 8, kk = idx & 255, nn = n & 1023, blk = nn >> 6, j = nn & 63, cin = (nn & ~255) + kk;
          const float* W = n < 1024 ? a.in[19] : a.in[21];
          const float v = (cin >> 6) == blk ? W[blk * 4096 + (cin & 63) * 64 + j] : 0.f;
          WG[idx] = (bf16)f2bf(v); } }
    { bf16* WR = (bf16*)(a.ws + WS_WROUTE);
      for (int idx = gt; idx < 2 * 48 * DM; idx += NGT) { const int l = idx / (48 * DM), n = (idx / DM) % 48, k = idx % DM; float v = 0.f;
          if (n < 32) v = a.in[32][((size_t)l * DM + k) * NEXP + n]; else if (n < 36) v = a.in[31][((size_t)l * DM + k) * 4 + n - 32];
          const unsigned hi = f2bf(v); WR[((size_t)(l * 2) * 48 + n) * DM + k] = (bf16)hi; WR[((size_t)(l * 2 + 1) * 48 + n) * DM + k] = (bf16)f2bf(v - __uint_as_float(hi << 16)); } }
    bf16* HN = (bf16*)(a.ws + WS_HN);
    for (int r = F.gw; r < TT; r += F.NGW) norm_row_bf16(F.lane, r < TX ? a.in[0] + (size_t)r * DM : a.in[1] + (size_t)(r - TX) * DM, a.in[2], HN + (size_t)r * DM);
}

DI void ph_aux_convert(const Frame& F, const Args& a, int gw, int ngw) {
    LAS float* scr = (LAS float*)(F.lds + RING_OFF + F.wave * 16384);
    constexpr int I_C = 32 * 386, I_D = 64 * 64, NIT = I_C + I_D;
    for (int it = gw; it < NIT; it += ngw) {
        int r = it;
        if (r < I_C) { const int kb = r / 386, nb = r % 386; tr_item(a.in[25], 12352, 64 * kb, 32 * nb, (bf16*)(a.ws + WS_WODIN), DM, 32 * nb, scr, F.lane); continue; } r -= I_C;
        { const int kb = r / 64, nb = r % 64; tr_item(a.in[30], DM, 64 * kb, 32 * nb, (bf16*)(a.ws + WS_WODOUT), 4096, 32 * nb, scr, F.lane); }
    }
    moe_convert(F, a, 0, gw, ngw);
}

DI void ph_even_prep(const Frame& F, const Args& a) {
    const bf16* P = (const bf16*)(a.ws + WS_PROJ); bf16* AL = (bf16*)(a.ws + WS_SCR + SC_ALORA); bf16* XR = (bf16*)(a.ws + WS_SCR + SC_XR);
    const float* mu = a.in[6]; const float* cw = a.in[17]; const float* cb = a.in[18];
    const int lane = F.lane;
    for (int item = F.gw; item < TT + (TT / 8) * 2; item += F.NGW) {
        if (item < TT) { const int r = item, pos = row_pos(r); const bf16* cur = P + (size_t)r * EV_NP; const bf16* prv = P + (size_t)pos_row(pos > 0 ? pos - 1 : 0) * EV_NP; const float pm = pos > 0 ? 1.f : 0.f;
            float cv[6], pv[6], mv[6];
#pragma unroll
            for (int i = 0; i < 6; ++i) { const int idx = lane + 64 * i, col = EV_LORA0 + (idx < 288 ? idx : 287); cv[i] = bf2f(cur[col]); pv[i] = bf2f(prv[col]) * pm; mv[i] = mu[col]; }
#pragma unroll
            for (int i = 0; i < 6; ++i) { const int idx = lane + 64 * i; float v = cv[i] + (pv[i] - cv[i]) * mv[i];
                if (idx < 64) v = tanhf(v); else if (idx >= 128) v = sigm(v);
                AL[(size_t)r * 384 + idx] = (bf16)f2bf(idx < 288 ? v : 0.f); }
        } else { const int it2 = item - TT, pb = it2 >> 1, c0 = (it2 & 1) * 512 + lane * 8, p0 = pb * 8;
            f32x4 w[4][2], b0 = *(const f32x4*)(cb + c0), b1 = *(const f32x4*)(cb + c0 + 4);
#pragma unroll
            for (int j = 0; j < 4; ++j) { w[j][0] = *(const f32x4*)(cw + j * 1024 + c0); w[j][1] = *(const f32x4*)(cw + j * 1024 + c0 + 4); }
            v4u x[11];
#pragma unroll
            for (int i = 0; i < 11; ++i) { const int p = p0 - 3 + i; x[i] = *(const v4u*)(P + (size_t)pos_row(p > 0 ? p : 0) * EV_NP + EV_REC + c0); if (p < 0) x[i] = (v4u){0u, 0u, 0u, 0u}; }
#pragma unroll
            for (int o = 0; o < 8; ++o) { float acc[8] = {b0.x, b0.y, b0.z, b0.w, b1.x, b1.y, b1.z, b1.w};
#pragma unroll
                for (int j = 0; j < 4; ++j) { const v4u xv = x[o + j];
                    acc[0] += w[j][0].x * bflo(xv.x); acc[1] += w[j][0].y * bfhi(xv.x); acc[2] += w[j][0].z * bflo(xv.y); acc[3] += w[j][0].w * bfhi(xv.y);
                    acc[4] += w[j][1].x * bflo(xv.z); acc[5] += w[j][1].y * bfhi(xv.z); acc[6] += w[j][1].z * bflo(xv.w); acc[7] += w[j][1].w * bfhi(xv.w); }
                *(v4u*)(XR + (size_t)pos_row(p0 + o) * 1024 + c0) = (v4u){pk2(acc[0], acc[1]), pk2(acc[2], acc[3]), pk2(acc[4], acc[5]), pk2(acc[6], acc[7])}; } }
    }
}

DI void ph_route(const Frame& F, const Args& a, int l, int dummy) {
    const float* H = (const float*)(a.ws + WS_H); const float* nw = a.in[3] + (size_t)l * DM;
    const bf16* WH = (const bf16*)(a.ws + WS_WROUTE) + (size_t)(l * 2) * 48 * DM; const bf16* WL = WH + (size_t)48 * DM;
    unsigned* TI = (unsigned*)(a.ws + WS_TOKINFO) + (dummy ? (WS_SCR + 250 * MiB - WS_TOKINFO) / 4 : 0); const int lane = F.lane, lc = lane & 15, quad = lane >> 4; const int cl = dummy ? l + 2 : l;
    LAS float* scr = (LAS float*)(F.lds + RING_OFF + F.wave * 16384);
    for (int task = F.gw; task < TT / 16; task += F.NGW) {
        const int r = task * 16 + lc; const float* hr = H + (size_t)r * DM + 8 * quad; float ss = 0.f;
#pragma unroll 8
        for (int ks = 0; ks < 64; ++ks) { const f32x4 x0 = *(const f32x4*)(hr + 32 * ks), x1 = *(const f32x4*)(hr + 32 * ks + 4); ss += (x0.x * x0.x + x0.y * x0.y) + (x0.z * x0.z + x0.w * x0.w) + (x1.x * x1.x + x1.y * x1.y) + (x1.z * x1.z + x1.w * x1.w); }
        ss += __shfl_xor(ss, 16); ss += __shfl_xor(ss, 32);
        const float rs = 1.0f / sqrtf(ss * (1.0f / DM) + NORM_EPS);
        f32x4 acc[3];
#pragma unroll
        for (int nt = 0; nt < 3; ++nt) acc[nt] = (f32x4){0.f, 0.f, 0.f, 0.f};
#pragma unroll 2
        for (int ks = 0; ks < 64; ++ks) { const int k0 = 32 * ks + 8 * quad; const f32x4 x0 = *(const f32x4*)(hr + 32 * ks), x1 = *(const f32x4*)(hr + 32 * ks + 4), w0 = *(const f32x4*)(nw + k0), w1 = *(const f32x4*)(nw + k0 + 4);
            const float xn[8] = {x0.x * rs * w0.x, x0.y * rs * w0.y, x0.z * rs * w0.z, x0.w * rs * w0.w, x1.x * rs * w1.x, x1.y * rs * w1.y, x1.z * rs * w1.z, x1.w * rs * w1.w};
            unsigned hi[8]; float lo[8];
#pragma unroll
            for (int q = 0; q < 8; ++q) { hi[q] = f2bf(xn[q]); lo[q] = xn[q] - __uint_as_float(hi[q] << 16); }
            const v4u ah4 = (v4u){hi[0] | (hi[1] << 16), hi[2] | (hi[3] << 16), hi[4] | (hi[5] << 16), hi[6] | (hi[7] << 16)}, al4 = (v4u){pk2(lo[0], lo[1]), pk2(lo[2], lo[3]), pk2(lo[4], lo[5]), pk2(lo[6], lo[7])};
            const bf16x8 ah = __builtin_bit_cast(bf16x8, ah4), al = __builtin_bit_cast(bf16x8, al4);
#pragma unroll
            for (int nt = 0; nt < 3; ++nt) { const bf16x8 bh = *(const bf16x8*)(WH + (size_t)(16 * nt + lc) * DM + k0), bl = *(const bf16x8*)(WL + (size_t)(16 * nt + lc) * DM + k0);
                acc[nt] = __builtin_amdgcn_mfma_f32_16x16x32_bf16(al, bh, acc[nt], 0, 0, 0); acc[nt] = __builtin_amdgcn_mfma_f32_16x16x32_bf16(ah, bl, acc[nt], 0, 0, 0); acc[nt] = __builtin_amdgcn_mfma_f32_16x16x32_bf16(ah, bh, acc[nt], 0, 0, 0); } }
#pragma unroll
        for (int nt = 0; nt < 3; ++nt)
#pragma unroll
            for (int q = 0; q < 4; ++q) scr[(4 * quad + q) * 49 + 16 * nt + lc] = acc[nt][q];
        asm volatile("s_waitcnt lgkmcnt(0)" ::: "memory"); __builtin_amdgcn_wave_barrier();
        if (lane < 16) { float lg[36];
#pragma unroll
            for (int i = 0; i < 36; ++i) lg[i] = scr[lane * 49 + i];
            int gi = 0; float gm = lg[32];
#pragma unroll
            for (int i = 1; i < 4; ++i) if (lg[32 + i] > gm) { gm = lg[32 + i]; gi = i; }
            float den = 0.f;
#pragma unroll
            for (int i = 0; i < 4; ++i) den += __expf(lg[32 + i] - gm);
            const float gp = 1.0f / den;
            float l8[8];
#pragma unroll
            for (int i = 0; i < 8; ++i) l8[i] = gi == 0 ? lg[i] : (gi == 1 ? lg[8 + i] : (gi == 2 ? lg[16 + i] : lg[24 + i]));
            int i1 = 0; float m1 = l8[0];
#pragma unroll
            for (int i = 1; i < 8; ++i) if (l8[i] > m1) { m1 = l8[i]; i1 = i; }
            int i2 = -1; float m2 = -INFINITY;
#pragma unroll
            for (int i = 0; i < 8; ++i) if (i != i1 && l8[i] > m2) { m2 = l8[i]; i2 = i; }
            const float e21 = __expf(m2 - m1); const float w1 = gp / (1.0f + e21), w2 = gp * e21 / (1.0f + e21);
            const int ea = gi * 8 + i1, eb = gi * 8 + i2;
            const unsigned sa = atomicAdd((unsigned*)(F.ctl + CW_MOECNT + (cl * NEXP + ea) * 16), 1u), sb = atomicAdd((unsigned*)(F.ctl + CW_MOECNT + (cl * NEXP + eb) * 16), 1u);
            unsigned* t = TI + (size_t)r * 8; *(v4u*)t = (v4u){(unsigned)ea, sa, __float_as_uint(w1), (unsigned)eb}; *(v4u*)(t + 4) = (v4u){sb, __float_as_uint(w2), __float_as_uint(rs), 0u}; }
        __builtin_amdgcn_wave_barrier(); asm volatile("" ::: "memory");
    }
}
DI void moe_prefix(const Frame& F, int l, LAS int* ps) {
    if (F.tid == 0) { int t = 0;
        for (int e = 0; e < NEXP; ++e) { const unsigned c = __hip_atomic_load(F.ctl + CW_MOECNT + (l * NEXP + e) * 16, RLX_AGENT); ps[e] = t * 256; t += (int)((c + 255u) >> 8); }
        ps[32] = t; }
    __syncthreads();
}
DI void ph_gather(const Frame& F, const Args& a, int l) {
    LAS int* ps = (LAS int*)(F.lds + RING_OFF); moe_prefix(F, l, ps);
    if (F.vcu == 0 && F.tid < NEXP) { int* TE = (int*)(a.ws + WS_TILES); const int e = F.tid; const int t0 = ps[e] >> 8, t1 = (e == NEXP - 1 ? ps[32] : ps[e + 1] >> 8);
        for (int t = t0; t < t1; ++t) TE[t] = e; if (e == 0) TE[127] = ps[32]; }
    const float* H = (const float*)(a.ws + WS_H); const float* nw = a.in[3] + (size_t)l * DM; unsigned* TI = (unsigned*)(a.ws + WS_TOKINFO); bf16* XG = (bf16*)(a.ws + WS_SCR + SC_XG);
    const int lane = F.lane;
    for (int r = F.gw; r < TT; r += F.NGW) {
        unsigned* t = TI + (size_t)r * 8; const int g0 = ps[t[0]] + (int)t[1], g1 = ps[t[3]] + (int)t[4]; const float rs = __uint_as_float(t[6]);
        if (lane == 0) { t[1] = (unsigned)g0; t[4] = (unsigned)g1; }
        const float* hr = H + (size_t)r * DM;
#pragma unroll
        for (int j = 0; j < 4; ++j) { const int e0 = (lane + 64 * j) * 8; const f32x4 x0 = *(const f32x4*)(hr + e0), x1 = *(const f32x4*)(hr + e0 + 4), w0 = *(const f32x4*)(nw + e0), w1 = *(const f32x4*)(nw + e0 + 4);
            v4u o; o.x = pk2(x0.x * rs * w0.x, x0.y * rs * w0.y); o.y = pk2(x0.z * rs * w0.z, x0.w * rs * w0.w); o.z = pk2(x1.x * rs * w1.x, x1.y * rs * w1.y); o.w = pk2(x1.z * rs * w1.z, x1.w * rs * w1.w);
            *(v4u*)(XG + (size_t)g0 * DM + e0) = o; *(v4u*)(XG + (size_t)g1 * DM + e0) = o; }
    }
}
DI void ph_combine(const Frame& F, const Args& a, int l) {
    float* H = (float*)(a.ws + WS_H); const unsigned* TI = (const unsigned*)(a.ws + WS_TOKINFO); const bf16* YB = (const bf16*)(a.ws + WS_SCR + SC_YB); bf16* HN = (bf16*)(a.ws + WS_HN);
    const int lane = F.lane; const int nrows = l == 0 ? TT : TX;
    for (int r = F.gw; r < nrows; r += F.NGW) {
        const unsigned* t = TI + (size_t)r * 8; const int g0 = (int)t[1], g1 = (int)t[4]; const float w0 = __uint_as_float(t[2]), w1 = __uint_as_float(t[5]);
        float* hr = H + (size_t)r * DM; float hv[32]; float s = 0.f;
#pragma unroll
        for (int j = 0; j < 4; ++j) { const int e0 = (lane + 64 * j) * 8; const f32x4 x0 = *(const f32x4*)(hr + e0), x1 = *(const f32x4*)(hr + e0 + 4);
            const v4u ya = *(const v4u*)(YB + (size_t)g0 * DM + e0), yc = *(const v4u*)(YB + (size_t)g1 * DM + e0);
            float* o = hv + 8 * j;
            o[0] = x0.x + w0 * bflo(ya.x) + w1 * bflo(yc.x); o[1] = x0.y + w0 * bfhi(ya.x) + w1 * bfhi(yc.x); o[2] = x0.z + w0 * bflo(ya.y) + w1 * bflo(yc.y); o[3] = x0.w + w0 * bfhi(ya.y) + w1 * bfhi(yc.y);
            o[4] = x1.x + w0 * bflo(ya.z) + w1 * bflo(yc.z); o[5] = x1.y + w0 * bfhi(ya.z) + w1 * bfhi(yc.z); o[6] = x1.z + w0 * bflo(ya.w) + w1 * bflo(yc.w); o[7] = x1.w + w0 * bfhi(ya.w) + w1 * bfhi(yc.w);
#pragma unroll
            for (int q = 0; q < 8; ++q) s += o[q] * o[q]; }
        const float rs = 1.0f / sqrtf(wave_sum(s) * (1.0f / DM) + NORM_EPS);
        if (l == 0) { const float* nw = a.in[2] + DM;
#pragma unroll
            for (int j = 0; j < 4; ++j) { const int e0 = (lane + 64 * j) * 8; const float* o = hv + 8 * j; const f32x4 wa = *(const f32x4*)(nw + e0), wb = *(const f32x4*)(nw + e0 + 4);
                *(f32x4*)(hr + e0) = (f32x4){o[0], o[1], o[2], o[3]}; *(f32x4*)(hr + e0 + 4) = (f32x4){o[4], o[5], o[6], o[7]};
                v4u p; p.x = pk2(o[0] * rs * wa.x, o[1] * rs * wa.y); p.y = pk2(o[2] * rs * wa.z, o[3] * rs * wa.w); p.z = pk2(o[4] * rs * wb.x, o[5] * rs * wb.y); p.w = pk2(o[6] * rs * wb.z, o[7] * rs * wb.w);
                *(v4u*)(HN + (size_t)r * DM + e0) = p; }
        } else { const float* nw = a.in[4]; float* orow = a.out + (size_t)r * DM;
#ifdef PROBE_TS
            { const unsigned long long* ts = (const unsigned long long*)(F.ctl + CW_TS); const float dt_us = (float)(__hip_atomic_load(ts + PROBE_TS + 1, RLX_AGENT) - __hip_atomic_load(ts + PROBE_TS, RLX_AGENT)) * 0.01f;
#pragma unroll
              for (int q = 0; q < 32; ++q) hv[q] *= 1.0f + dt_us * 0.01f; }
#endif
#pragma unroll
            for (int j = 0; j < 4; ++j) { const int e0 = (lane + 64 * j) * 8; const float* o = hv + 8 * j; const f32x4 wa = *(const f32x4*)(nw + e0), wb = *(const f32x4*)(nw + e0 + 4);
                *(f32x4*)(orow + e0) = (f32x4){o[0] * rs * wa.x, o[1] * rs * wa.y, o[2] * rs * wa.z, o[3] * rs * wa.w};
                *(f32x4*)(orow + e0 + 4) = (f32x4){o[4] * rs * wb.x, o[5] * rs * wb.y, o[6] * rs * wb.z, o[7] * rs * wb.w}; } }
    }
}

DI void ph_odd_prep(const Frame& F, const Args& a) {
    const bf16* P = (const bf16*)(a.ws + WS_PROJ); bf16* QN = (bf16*)(a.ws + WS_SCR + SC_QN); bf16* KN = (bf16*)(a.ws + WS_SCR + SC_KN); bf16* VC = (bf16*)(a.ws + WS_SCR + SC_VC);
    float* BETA = (float*)(a.ws + WS_SCR + SC_BETA); float* GG = (float*)(a.ws + WS_SCR + SC_G);
    const float* cw = a.in[26]; const int lane = F.lane;
    for (int item = F.gw; item < (TT / 8) * 16; item += F.NGW) { const int pb = item >> 4, i = item & 15, ch = i * 512 + lane * 8, p0 = pb * 8;
        f32x4 w[4][2];
#pragma unroll
        for (int j = 0; j < 4; ++j) { w[j][0] = *(const f32x4*)(cw + j * 8192 + ch); w[j][1] = *(const f32x4*)(cw + j * 8192 + ch + 4); }
        v4u x[11];
#pragma unroll
        for (int q = 0; q < 11; ++q) { const int p = p0 - 3 + q; x[q] = *(const v4u*)(P + (size_t)pos_row(p > 0 ? p : 0) * OD_NP + ch); if (p < 0) x[q] = (v4u){0u, 0u, 0u, 0u}; }
#pragma unroll
        for (int o = 0; o < 8; ++o) { const int r = pos_row(p0 + o); float acc[8] = {0.f, 0.f, 0.f, 0.f, 0.f, 0.f, 0.f, 0.f};
#pragma unroll
            for (int j = 0; j < 4; ++j) { const v4u xv = x[o + j];
                acc[0] += w[j][0].x * bflo(xv.x); acc[1] += w[j][0].y * bfhi(xv.x); acc[2] += w[j][0].z * bflo(xv.y); acc[3] += w[j][0].w * bfhi(xv.y);
                acc[4] += w[j][1].x * bflo(xv.z); acc[5] += w[j][1].y * bfhi(xv.z); acc[6] += w[j][1].z * bflo(xv.w); acc[7] += w[j][1].w * bfhi(xv.w); }
            float ss = 0.f;
#pragma unroll
            for (int q = 0; q < 8; ++q) { acc[q] = acc[q] * sigm(acc[q]); ss += acc[q] * acc[q]; }
            float sc = 1.0f;
            if (i < 8) { ss += __shfl_xor(ss, 1); ss += __shfl_xor(ss, 2); ss += __shfl_xor(ss, 4); ss += __shfl_xor(ss, 8);
                sc = (1.0f / sqrtf(ss + NORM_EPS)) * (i < 4 ? 0.08838834764831845f : 1.0f); }
            const v4u ov = (v4u){pk2(acc[0] * sc, acc[1] * sc), pk2(acc[2] * sc, acc[3] * sc), pk2(acc[4] * sc, acc[5] * sc), pk2(acc[6] * sc, acc[7] * sc)};
            bf16* dst = i < 4 ? QN + (size_t)r * 2048 + ch : (i < 8 ? KN + (size_t)r * 2048 + ch - 2048 : VC + (size_t)r * 4096 + ch - 4096);
            *(v4u*)dst = ov; }
        if (i == 0 && lane < 32) {
#pragma unroll
            for (int o = 0; o < 8; ++o) { const int r = pos_row(p0 + o); const float bb = bf2f(P[(size_t)r * OD_NP + OD_B + lane]), aa = bf2f(P[(size_t)r * OD_NP + OD_A + lane]);
                BETA[(size_t)r * 32 + lane] = sigm(bb); GG[(size_t)r * 32 + lane] = -__expf(a.in[27][lane]) * softplus(aa + a.in[28][lane]); } }
    }
}
DI void ph_odd_post(const Frame& F, const Args& a) {
    const bf16* P = (const bf16*)(a.ws + WS_PROJ); const bf16* O = (const bf16*)(a.ws + WS_SCR + SC_O); bf16* Y = (bf16*)(a.ws + WS_YMIX); const float* nw = a.in[29];
    const int lane = F.lane;
    for (int r = F.gw; r < TT; r += F.NGW) {
#pragma unroll 2
        for (int i = 0; i < 8; ++i) { const int ch = i * 512 + lane * 8; const v4u ow = *(const v4u*)(O + (size_t)r * 4096 + ch); const f32x4 o0 = (f32x4){bflo(ow.x), bfhi(ow.x), bflo(ow.y), bfhi(ow.y)}, o1 = (f32x4){bflo(ow.z), bfhi(ow.z), bflo(ow.w), bfhi(ow.w)};
            float ss = (o0.x * o0.x + o0.y * o0.y) + (o0.z * o0.z + o0.w * o0.w) + (o1.x * o1.x + o1.y * o1.y) + (o1.z * o1.z + o1.w * o1.w);
            ss += __shfl_xor(ss, 1); ss += __shfl_xor(ss, 2); ss += __shfl_xor(ss, 4); ss += __shfl_xor(ss, 8);
            const float rs = 1.0f / sqrtf(ss * (1.0f / 128.0f) + NORM_EPS);
            const v4u z = *(const v4u*)(P + (size_t)r * OD_NP + OD_Z + ch); const int c0 = ch & 127; const f32x4 w0 = *(const f32x4*)(nw + c0), w1 = *(const f32x4*)(nw + c0 + 4);
            const float zf[8] = {bflo(z.x), bfhi(z.x), bflo(z.y), bfhi(z.y), bflo(z.z), bfhi(z.z), bflo(z.w), bfhi(z.w)};
            const float of[8] = {o0.x * w0.x, o0.y * w0.y, o0.z * w0.z, o0.w * w0.w, o1.x * w1.x, o1.y * w1.y, o1.z * w1.z, o1.w * w1.w};
            float y[8];
#pragma unroll
            for (int q = 0; q < 8; ++q) y[q] = of[q] * rs * zf[q] * sigm(zf[q]);
            v4u p; p.x = pk2(y[0], y[1]); p.y = pk2(y[2], y[3]); p.z = pk2(y[4], y[5]); p.w = pk2(y[6], y[7]);
            *(v4u*)(Y + (size_t)r * 4096 + ch) = p; }
    }
}

typedef float f32x16 __attribute__((ext_vector_type(16)));
#define MFMA32(a, b, c) __builtin_amdgcn_mfma_f32_32x32x16_bf16((a), (b), (c), 0, 0, 0)
DI int crow(int reg, int h) { return (reg & 3) + 8 * (reg >> 2) + 4 * h; }
DI int chunk_row(int n, int c) { return n == 0 ? (c >= 48 ? TX + (c - 48) : -1) : 64 * (n - 1) + c; }
constexpr int GDN_NCH = 129, GDN_UNITS = GDN_NCH * 32, GDN_KUNITS = GDN_NCH * 16, GC_STRIDE = 72;
constexpr size_t GD_WF = WS_MOEW, GD_UF = WS_MOEW + 65 * MiB, GD_IN = WS_MOEW + 130 * MiB, GD_GC = WS_MOEW + 163 * MiB, GD_KT = WS_HN;
static_assert((size_t)GDN_UNITS * 16384 <= 65 * MiB && (size_t)GDN_UNITS * 8192 <= 33 * MiB && (size_t)GDN_KUNITS * 16384 <= 33 * MiB && GD_GC + (size_t)GDN_UNITS * GC_STRIDE * 4 <= WS_H, "gdn map");

DI void ph_gdn_chunk(const Frame& F, const Args& a) {
    const bf16* QN = (const bf16*)(a.ws + WS_SCR + SC_QN); const bf16* KN = (const bf16*)(a.ws + WS_SCR + SC_KN); const bf16* VC = (const bf16*)(a.ws + WS_SCR + SC_VC);
    const float* BETA = (const float*)(a.ws + WS_SCR + SC_BETA); const float* GG = (const float*)(a.ws + WS_SCR + SC_G);
    bf16* WF = (bf16*)(a.ws + GD_WF); bf16* UF = (bf16*)(a.ws + GD_UF); bf16* INF = (bf16*)(a.ws + GD_IN); bf16* KTF = (bf16*)(a.ws + GD_KT); float* GC = (float*)(a.ws + GD_GC);
    LAS unsigned char* L = F.lds + RING_OFF;
    LAS unsigned char* kS = L; LAS unsigned char* qS = L + 17408; LAS unsigned char* vS = L + 34816; LAS unsigned char* kbS = L + 52224;
    LAS float* Lm = (LAS float*)(L + 69632); LAS bf16* IS = (LAS bf16*)(L + 87040); LAS bf16* XS = (LAS bf16*)(L + 96256);
    LAS float* betaS = (LAS float*)(L + 130048); LAS float* gcS = betaS + 64; LAS float* egcS = betaS + 128;
    LAS unsigned char* Lb = L + 17408; LAS unsigned char* TDs = L + 26624; LAS unsigned char* YT0 = L + 28672; LAS unsigned char* XT0 = L + 130816;
    static_assert(130816 + 8 * 1792 <= LDSCTL_OFF, "gdn lds map");
    const int tid = F.tid, lane = F.lane, wave = F.wave, l31 = lane & 31, h = lane >> 5;
    for (int unit = F.vcu; unit < GDN_UNITS; unit += F.G) {
        const int n = unit >> 5, hv = unit & 31, hk = hv >> 1; const size_t su = (size_t)hv * GDN_NCH + n;
#pragma unroll
        for (int i = 0; i < 2; ++i) { const int p = tid + 512 * i, row = p >> 4, ch = p & 15; const int rr = chunk_row(n, row);
            v4u kx = (v4u){0u, 0u, 0u, 0u}, qx = kx, vx = kx;
            if (rr >= 0) { kx = *(const v4u*)(KN + (size_t)rr * 2048 + hk * 128 + ch * 8); qx = *(const v4u*)(QN + (size_t)rr * 2048 + hk * 128 + ch * 8); vx = *(const v4u*)(VC + (size_t)rr * 4096 + hv * 128 + ch * 8); }
            *(LAS v4u*)(kS + row * 272 + ch * 16) = kx; *(LAS v4u*)(qS + row * 272 + ch * 16) = qx; *(LAS v4u*)(vS + row * 272 + ch * 16) = vx; }
        if (wave == 0) { const int rr = chunk_row(n, lane); float b = 0.f, g = 0.f; if (rr >= 0) { b = BETA[(size_t)rr * 32 + hv]; g = GG[(size_t)rr * 32 + hv]; }
#pragma unroll
            for (int o = 1; o < 64; o <<= 1) { const float t = __shfl_up(g, o); if (lane >= o) g += t; }
            betaS[lane] = b; gcS[lane] = g; egcS[lane] = __expf(g); }
        __syncthreads();
#pragma unroll
        for (int i = 0; i < 2; ++i) { const int p = tid + 512 * i, row = p >> 4, ch = p & 15; const v4u kx = *(const LAS v4u*)(kS + row * 272 + ch * 16); const float b = betaS[row];
            v4u o; o.x = pk2(bflo(kx.x) * b, bfhi(kx.x) * b); o.y = pk2(bflo(kx.y) * b, bfhi(kx.y) * b); o.z = pk2(bflo(kx.z) * b, bfhi(kx.z) * b); o.w = pk2(bflo(kx.w) * b, bfhi(kx.w) * b);
            *(LAS v4u*)(kbS + row * 272 + ch * 16) = o; }
        __syncthreads();
        { const int which = wave >> 2, ti = (wave >> 1) & 1, tj = wave & 1;
          f32x16 acc;
#pragma unroll
          for (int r = 0; r < 16; ++r) acc[r] = 0.f;
          if (!(ti == 0 && tj == 1)) { const LAS unsigned char* Ab = (which == 0 ? kbS : qS) + (32 * ti + l31) * 272 + 16 * h; const LAS unsigned char* Bb = kS + (32 * tj + l31) * 272 + 16 * h;
#pragma unroll
              for (int s = 0; s < 8; ++s) acc = MFMA32(*(const LAS bf16x8*)(Ab + 32 * s), *(const LAS bf16x8*)(Bb + 32 * s), acc); }
          const int j = 32 * tj + l31; const float gj = gcS[j];
#pragma unroll
          for (int r = 0; r < 16; ++r) { const int i = 32 * ti + crow(r, h); const float e = __expf(fminf(gcS[i] - gj, 0.f));
              if (which == 0) Lm[i * 68 + j] = i > j ? acc[r] * e : 0.f;
              else IS[i * 72 + j] = (bf16)f2bf(i >= j ? acc[r] * e : 0.f); } }
        __syncthreads();
#pragma unroll
        for (int i = 0; i < 8; ++i) { const int e = tid + 512 * i, r = e >> 6, c = e & 63; *(LAS bf16*)(Lb + r * 144 + c * 2) = (bf16)f2bf(Lm[r * 68 + c]); }
        if (wave == 0) { const int b = lane >> 4, c = lane & 15; float t[16]; const LAS float* Ld = Lm + (16 * b) * 68 + 16 * b;
#pragma unroll
            for (int i = 0; i < 16; ++i) { float acc = i == c ? 1.f : 0.f;
#pragma unroll
                for (int j = 0; j < i; ++j) acc -= Ld[i * 68 + j] * t[j];
                t[i] = acc; *(LAS bf16*)(TDs + (b * 16 + i) * 32 + c * 2) = (bf16)f2bf(acc); }
        } else if (wave >= 4) { const int t2 = tid - 256;
#pragma unroll
            for (int i = 0; i < 2; ++i) { const int p = t2 + 256 * i, comb = p >> 6, ln = p & 63, t = comb >> 2, s = comb & 3; const int c = 32 * t + (ln & 31), j0 = 16 * s + 8 * (ln >> 5);
                *(v4u*)(INF + (su * 8 + comb) * 512 + ln * 8) = *(const LAS v4u*)(IS + c * 72 + j0); }
            if ((hv & 1) == 0) { const size_t kunit = (size_t)hk * GDN_NCH + n;
#pragma unroll
                for (int i = 0; i < 4; ++i) { const int p = t2 + 256 * i, comb = p >> 6, ln = p & 63, kt = comb >> 2, s = comb & 3; const int kd = 32 * kt + (ln & 31), c0 = 16 * s + 8 * (ln >> 5);
                    unsigned w[4];
#pragma unroll
                    for (int jj = 0; jj < 4; ++jj) { const unsigned lo = *(const LAS bf16*)(kS + (c0 + 2 * jj) * 272 + kd * 2), hi = *(const LAS bf16*)(kS + (c0 + 2 * jj + 1) * 272 + kd * 2); w[jj] = lo | (hi << 16); }
                    *(v4u*)(KTF + (kunit * 16 + comb) * 512 + ln * 8) = (v4u){w[0], w[1], w[2], w[3]}; } }
            if (t2 < 64) GC[su * GC_STRIDE + t2] = gcS[t2];
            else if (t2 == 64) GC[su * GC_STRIDE + 64] = gcS[63];
            else if (t2 == 65) GC[su * GC_STRIDE + 65] = egcS[63];
        }
        __syncthreads();
        { const int quad = lane >> 4, lc = lane & 15; LAS unsigned char* XTw = XT0 + wave * 1792; LAS unsigned char* YTw = YT0 + wave * 768;
          const bf16x8 z8 = (bf16x8){0, 0, 0, 0, 0, 0, 0, 0}; const f32x4 z4 = (f32x4){0.f, 0.f, 0.f, 0.f};
          bf16x8 tdf[4];
#pragma unroll
          for (int b = 0; b < 4; ++b) tdf[b] = quad < 2 ? *(const LAS bf16x8*)(TDs + (b * 16 + lc) * 32 + quad * 16) : z8;
#pragma unroll 1
          for (int tl = 0; tl < 2; ++tl) { const int col = 32 * wave + 16 * tl + lc;
              const LAS unsigned char* rz = wave < 4 ? vS + col * 2 : kbS + (col - 128) * 2; const LAS float* bz = wave < 4 ? betaS : egcS;
#pragma unroll
              for (int b = 0; b < 4; ++b) { f32x4 y;
#pragma unroll
                  for (int r = 0; r < 4; ++r) { const int i = 16 * b + 4 * quad + r; y[r] = bf2f(*(const LAS bf16*)(rz + i * 272)) * bz[i]; }
                  if (b >= 1) { f32x4 p = z4;
#pragma unroll
                      for (int kk = 0; kk < (b >= 3 ? 2 : 1); ++kk) { const bf16x8 af = *(const LAS bf16x8*)(Lb + (16 * b + lc) * 144 + (32 * kk + 8 * quad) * 2);
                          const bf16x8 bfv = (32 * kk + 8 * quad < 16 * b) ? *(const LAS bf16x8*)(XTw + lc * 112 + (32 * kk + 8 * quad) * 2) : z8;
                          p = __builtin_amdgcn_mfma_f32_16x16x32_bf16(af, bfv, p, 0, 0, 0); }
                      y = y - p; }
                  *(LAS v2u*)(YTw + lc * 48 + quad * 8) = (v2u){pk2(y[0], y[1]), pk2(y[2], y[3])};
                  asm volatile("" ::: "memory");
                  const bf16x8 yb = quad < 2 ? *(const LAS bf16x8*)(YTw + lc * 48 + quad * 16) : z8;
                  const f32x4 x = __builtin_amdgcn_mfma_f32_16x16x32_bf16(tdf[b], yb, z4, 0, 0, 0);
                  if (b < 3) *(LAS v2u*)(XTw + lc * 112 + (16 * b + 4 * quad) * 2) = (v2u){pk2(x[0], x[1]), pk2(x[2], x[3])};
                  asm volatile("" ::: "memory");
#pragma unroll
                  for (int r = 0; r < 4; ++r) XS[(16 * b + 4 * quad + r) * 264 + col] = (bf16)f2bf(x[r]); } } }
        __syncthreads();
#pragma unroll
        for (int i = 0; i < 2; ++i) { const int p = tid + 512 * i, comb = p >> 6, ln = p & 63, t = comb >> 3, s = comb & 7; const int c = 32 * t + (ln & 31), k0 = 16 * s + 8 * (ln >> 5);
            *(v4u*)(WF + (su * 16 + comb) * 512 + ln * 8) = *(const LAS v4u*)(XS + c * 264 + 128 + k0); }
        { const int t = wave >> 2, ns = wave & 3; unsigned w[8];
#pragma unroll
          for (int r = 0; r < 8; ++r) { const unsigned lo = XS[(32 * t + crow(2 * r, h)) * 264 + 32 * ns + l31], hi = XS[(32 * t + crow(2 * r + 1, h)) * 264 + 32 * ns + l31]; w[r] = lo | (hi << 16); }
          bf16* dst = UF + ((su * 8 + wave) * 64 + lane) * 16; *(v4u*)dst = (v4u){w[0], w[1], w[2], w[3]}; *(v4u*)(dst + 8) = (v4u){w[4], w[5], w[6], w[7]}; }
        __syncthreads();
    }
}

DI void ph_gdn_chain(const Frame& F, const Args& a) {
    const int xg = F.vcu >> 5, wx = F.vcu & 31; if (F.G != 256 ? F.vcu >= 128 : wx >= 20) return;
    const bool helper = F.G == 256 && wx >= 16;
    const int hv = F.G == 256 ? 4 * xg + (helper ? wx - 16 : wx >> 2) : F.vcu >> 2, ns = F.G == 256 ? wx & 3 : F.vcu & 3, hk = hv >> 1;
    const bf16* QN = (const bf16*)(a.ws + WS_SCR + SC_QN);
    const bf16* WF = (const bf16*)(a.ws + GD_WF); const bf16* UF = (const bf16*)(a.ws + GD_UF); const bf16* INF = (const bf16*)(a.ws + GD_IN); const bf16* KTF = (const bf16*)(a.ws + GD_KT); const float* GC = (const float*)(a.ws + GD_GC);
    bf16* O = (bf16*)(a.ws + WS_SCR + SC_O);
    gu32* prog = F.ctl + CW_PROG + hv * 16;
    if (helper) { unsigned sink = 0u; const int tid = F.tid;
        for (int n0 = 0; n0 < GDN_NCH; n0 += 4) {
            if (n0 >= 8) { if (tid == 0) { unsigned sp = 0; while ((int)__hip_atomic_load(prog, RLX_AGENT) < n0 - 4 && ++sp < 20000u) __builtin_amdgcn_s_sleep(8); } __syncthreads(); }
            unsigned v[5];
#pragma unroll
            for (int i = 0; i < 5; ++i) { const int li = tid + 512 * i;
                const int st = li / 580, ln = li % 580, n = n0 + st; const unsigned* p = nullptr;
                if (st < 4 && n < GDN_NCH) { const size_t unit = (size_t)hv * GDN_NCH + n, kunit = (size_t)hk * GDN_NCH + n;
                    if (ln < 128) p = (const unsigned*)(WF + unit * 8192 + ln * 64);
                    else if (ln < 256) p = (const unsigned*)(UF + unit * 8192 + (ln - 128) * 64);
                    else if (ln < 320) p = (const unsigned*)(INF + unit * 4096 + (ln - 256) * 64);
                    else if (ln < 448) p = (const unsigned*)(KTF + kunit * 8192 + (ln - 320) * 64);
                    else if (ln < 576) { const int rr = chunk_row(n, (ln - 448) >> 1); if (rr >= 0) p = (const unsigned*)(QN + (size_t)rr * 2048 + hk * 128 + ((ln - 448) & 1) * 64); }
                    else if (ln < 579) p = (const unsigned*)(GC + unit * GC_STRIDE + (ln - 576) * 32); }
                v[i] = p ? *p : 0u; }
#pragma unroll
            for (int i = 0; i < 5; ++i) sink += v[i];
        }
        if (sink == 0x12345u) __hip_atomic_store(F.ctl + CW_TMO + 2, sink, RLX_AGENT);
        return; }
    LAS unsigned char* ST = F.lds + RING_OFF; LAS unsigned char* VN = ST + 8704; LAS unsigned char* VND = ST + 13312;
    const int lane = F.lane, wave = F.wave, l31 = lane & 31, h = lane >> 5;
    for (int i = F.tid; i < 8704 / 4; i += NWAVES * 64) ((LAS unsigned*)ST)[i] = 0u;
#define GDN_BAR() do { asm volatile("s_waitcnt lgkmcnt(0)" ::: "memory"); __builtin_amdgcn_s_barrier(); asm volatile("" ::: "memory"); } while (0)
    GDN_BAR();
    f32x16 S;
#pragma unroll
    for (int r = 0; r < 16; ++r) S[r] = 0.f;
    const int role = wave < 2 ? 0 : (wave < 4 ? 1 : 2); const int t = wave & 1, kt = wave & 3;
    bf16x8 A8[8]; bf16x8 A4[4]; v4u U0 = (v4u){0u, 0u, 0u, 0u}, U1 = U0; f32x4 G4[4]; float gl = 0.f, egl = 1.f;
#pragma unroll
    for (int s = 0; s < 8; ++s) A8[s] = (bf16x8){0, 0, 0, 0, 0, 0, 0, 0};
#pragma unroll
    for (int s = 0; s < 4; ++s) { A4[s] = (bf16x8){0, 0, 0, 0, 0, 0, 0, 0}; G4[s] = (f32x4){0.f, 0.f, 0.f, 0.f}; }
#define GDN_LOAD(nn) do { const size_t unit_ = (size_t)hv * GDN_NCH + (nn); const float* gc_ = GC + unit_ * GC_STRIDE; \
        if (role == 0) { _Pragma("unroll") for (int s = 0; s < 8; ++s) A8[s] = *(const bf16x8*)(WF + ((unit_ * 2 + t) * 8 + s) * 512 + lane * 8); \
            const bf16* up_ = UF + (((unit_ * 2 + t) * 4 + ns) * 64 + lane) * 16; U0 = *(const v4u*)up_; U1 = *(const v4u*)(up_ + 8); \
            _Pragma("unroll") for (int g = 0; g < 4; ++g) G4[g] = *(const f32x4*)(gc_ + 32 * t + 8 * g + 4 * h); gl = gc_[64]; } \
        else if (role == 1) { const int rr_ = chunk_row((nn), 32 * t + l31); \
            _Pragma("unroll") for (int s = 0; s < 8; ++s) A8[s] = rr_ >= 0 ? *(const bf16x8*)(QN + (size_t)rr_ * 2048 + hk * 128 + 16 * s + 8 * h) : (bf16x8){0, 0, 0, 0, 0, 0, 0, 0}; \
            _Pragma("unroll") for (int s = 0; s < 4; ++s) A4[s] = *(const bf16x8*)(INF + ((unit_ * 2 + t) * 4 + s) * 512 + lane * 8); \
            _Pragma("unroll") for (int g = 0; g < 4; ++g) G4[g] = *(const f32x4*)(gc_ + 32 * t + 8 * g + 4 * h); } \
        else { const size_t kunit_ = (size_t)hk * GDN_NCH + (nn); \
            _Pragma("unroll") for (int s = 0; s < 4; ++s) A4[s] = *(const bf16x8*)(KTF + ((kunit_ * 4 + kt) * 4 + s) * 512 + lane * 8); egl = gc_[65]; } } while (0)
    GDN_LOAD(0);
    for (int n = 0; n < GDN_NCH; ++n) {
        bf16x8 a8[8], a4[4]; const v4u u0 = U0, u1 = U1; f32x4 g4[4]; const float cgl = gl, cegl = egl;
#pragma unroll
        for (int s = 0; s < 8; ++s) a8[s] = A8[s];
#pragma unroll
        for (int s = 0; s < 4; ++s) { a4[s] = A4[s]; g4[s] = G4[s]; }
        if (n + 1 < GDN_NCH) GDN_LOAD(n + 1);
        if (ns == 0 && F.tid == 0) __hip_atomic_store(prog, (unsigned)n, RLX_AGENT);
        f32x16 acc;
#pragma unroll
        for (int r = 0; r < 16; ++r) acc[r] = 0.f;
        if (role < 2) {
#pragma unroll
            for (int s = 0; s < 8; ++s) acc = MFMA32(a8[s], *(const LAS bf16x8*)(ST + l31 * 272 + 32 * s + 16 * h), acc);
        }
        if (role == 0) { const unsigned uw[8] = {u0.x, u0.y, u0.z, u0.w, u1.x, u1.y, u1.z, u1.w};
#pragma unroll
            for (int g = 0; g < 4; ++g) { float vn[4], vd[4];
#pragma unroll
                for (int q = 0; q < 4; ++q) { const int r = 4 * g + q; const float uv = (r & 1) ? bfhi(uw[r >> 1]) : bflo(uw[r >> 1]); vn[q] = uv - acc[r]; vd[q] = vn[q] * __expf(cgl - g4[g][q]); }
                *(LAS v2u*)(VN + l31 * 144 + (32 * t + 8 * g + 4 * h) * 2) = (v2u){pk2(vn[0], vn[1]), pk2(vn[2], vn[3])};
                *(LAS v2u*)(VND + l31 * 144 + (32 * t + 8 * g + 4 * h) * 2) = (v2u){pk2(vd[0], vd[1]), pk2(vd[2], vd[3])}; }
        } else if (role == 1) {
#pragma unroll
            for (int g = 0; g < 4; ++g)
#pragma unroll
                for (int q = 0; q < 4; ++q) acc[4 * g + q] *= __expf(g4[g][q]);
        }
        GDN_BAR();
        if (role == 1) {
#pragma unroll
            for (int s = 0; s < 4; ++s) acc = MFMA32(a4[s], *(const LAS bf16x8*)(VN + l31 * 144 + 32 * s + 16 * h), acc);
#pragma unroll
            for (int r = 0; r < 16; ++r) { const int rr = chunk_row(n, 32 * t + crow(r, h)); if (rr >= 0) O[(size_t)rr * 4096 + hv * 128 + 32 * ns + l31] = (bf16)f2bf(acc[r]); }
        } else if (role == 2) {
#pragma unroll
            for (int r = 0; r < 16; ++r) S[r] *= cegl;
#pragma unroll
            for (int s = 0; s < 4; ++s) S = MFMA32(a4[s], *(const LAS bf16x8*)(VND + l31 * 144 + 32 * s + 16 * h), S);
#pragma unroll
            for (int g = 0; g < 4; ++g) *(LAS v2u*)(ST + l31 * 272 + (32 * kt + 8 * g + 4 * h) * 2) = (v2u){pk2(S[4 * g], S[4 * g + 1]), pk2(S[4 * g + 2], S[4 * g + 3])};
        }
        GDN_BAR();
    }
#undef GDN_LOAD
#undef GDN_BAR
}

constexpr int RW_NSC = 258, RW_UNITS = 129 * 16;
DI int sub_row(int sc, int t) { const int n = sc >> 1, sub = sc & 1; return n == 0 ? ((sub == 0 && t >= 16) ? TX + t - 16 : -1) : 64 * (n - 1) + 32 * sub + t; }
constexpr size_t RW_BASE = WS_PROJ + 92 * MiB;
constexpr size_t RW_RH = RW_BASE, RW_RL = RW_BASE + 33 * MiB, RW_GT = RW_BASE + 66 * MiB, RW_GAM = RW_BASE + 99 * MiB;
constexpr size_t RW_PR = WS_SCR + 195 * MiB, RW_AT = WS_SCR + 211 * MiB + 256 * 1024, RW_VTF = WS_SCR + 219 * MiB + 512 * 1024, RW_SALL = WS_SCR + 235 * MiB + 768 * 1024;
constexpr size_t RW_VV = WS_YMIX + 34 * MiB, RW_BON = WS_YMIX + 52 * MiB, LR_H = WS_YMIX + 54 * MiB, LR_A = WS_YMIX + 56 * MiB, LR_C = WS_YMIX + 58 * MiB;
constexpr size_t RW_SCH = (size_t)RW_NSC * 16;
static_assert((size_t)MP * EV_NP * 2 <= 92 * MiB && RW_SCH * 8192 <= 33 * MiB && RW_GAM + RW_SCH * 256 <= WS_SCR, "rwkv map (proj region)");
static_assert(WS_SCR + SC_LIX + (size_t)MP * 4096 <= RW_PR && RW_PR + RW_SCH * 4096 <= RW_AT && RW_AT + RW_SCH * 2048 <= RW_VTF && RW_VTF + RW_SCH * 4096 <= RW_SALL && RW_SALL + RW_SCH * 8192 <= WS_END, "rwkv map (scratch region)");
static_assert((size_t)MP * DM * 2 <= 34 * MiB && RW_VV + (size_t)MP * 2048 <= RW_BON && RW_BON + (size_t)MP * 64 <= LR_H && LR_H + RW_SCH * 256 <= LR_A && LR_A + RW_SCH * 256 <= LR_C && LR_C + RW_SCH * 256 <= WS_PROJ, "rwkv map (ymix region)");

DI void sub_rows(int sc, int& t0, int& rbase) { if (sc >= 2) { t0 = 0; rbase = 64 * ((sc >> 1) - 1) + 32 * (sc & 1); } else if (sc == 0) { t0 = 16; rbase = TX - 16; } else { t0 = 32; rbase = 0; } }
DI void lru_local(const Frame& F, const Args& a) {
    const float* LA = (const float*)(a.ws + WS_SCR + SC_LA); const float* LIX = (const float*)(a.ws + WS_SCR + SC_LIX);
    float* HL = (float*)(a.ws + LR_H); float* AP = (float*)(a.ws + LR_A);
    for (int item = F.gw; item < RW_NSC * 16; item += F.NGW) { const int sc = item >> 4, c = (item & 15) * 64 + F.lane; int t0, rbase; sub_rows(sc, t0, rbase);
        float av[32], ix[32];
#pragma unroll
        for (int t = 0; t < 32; ++t) { const size_t o = (size_t)(rbase + (t >= t0 ? t : 32)) * 1024 + c; av[t] = LA[o]; ix[t] = LIX[o]; }
        float h = 0.f, p = 1.f;
#pragma unroll
        for (int t = 0; t < 32; ++t) { const float a_ = t >= t0 ? av[t] : 1.f, x_ = t >= t0 ? ix[t] : 0.f; h = a_ * h + sqrtf(fmaxf(1.0f - a_ * a_, 0.f)) * x_; p *= a_; }
        HL[sc * 1024 + c] = h; AP[sc * 1024 + c] = p; }
}
DI void lru_apply(const Frame& F, const Args& a) {
    const bf16* P = (const bf16*)(a.ws + WS_PROJ); const float* LA = (const float*)(a.ws + WS_SCR + SC_LA); const float* LIX = (const float*)(a.ws + WS_SCR + SC_LIX);
    const float* CR = (const float*)(a.ws + LR_C); bf16* Y = (bf16*)(a.ws + WS_YMIX);
    for (int item = F.gw; item < RW_NSC * 16; item += F.NGW) { const int sc = item >> 4, c = (item & 15) * 64 + F.lane; int t0, rbase; sub_rows(sc, t0, rbase); if (t0 >= 32) continue;
        float h = CR[sc * 1024 + c];
#pragma unroll
        for (int tb = 0; tb < 32; tb += 16) { float av[16], ix[16], gb[16];
#pragma unroll
            for (int t = 0; t < 16; ++t) { const size_t r_ = (size_t)(rbase + (tb + t >= t0 ? tb + t : 32)); av[t] = LA[r_ * 1024 + c]; ix[t] = LIX[r_ * 1024 + c]; gb[t] = bf2f(P[r_ * EV_NP + EV_GB + c]); }
#pragma unroll
            for (int t = 0; t < 16; ++t) { if (tb + t >= t0) { h = av[t] * h + sqrtf(fmaxf(1.0f - av[t] * av[t], 0.f)) * ix[t]; Y[(size_t)(rbase + tb + t) * DM + 1024 + c] = (bf16)f2bf(h * gelu_tanh(gb[t])); } } } }
}

DI void ph_rwkv_chunk(const Frame& F, const Args& a) {
    lru_local(F, a);
    const bf16* P = (const bf16*)(a.ws + WS_PROJ); const float* DEC = (const float*)(a.ws + WS_SCR + SC_DEC); const float* ICL = (const float*)(a.ws + WS_SCR + SC_ICL);
    bf16* RH = (bf16*)(a.ws + RW_RH); bf16* RL = (bf16*)(a.ws + RW_RL); bf16* GT = (bf16*)(a.ws + RW_GT); float* GAM = (float*)(a.ws + RW_GAM); bf16* PR = (bf16*)(a.ws + RW_PR); bf16* ATG = (bf16*)(a.ws + RW_AT); bf16* VTF = (bf16*)(a.ws + RW_VTF);
    bf16* VV = (bf16*)(a.ws + RW_VV); float* BON = (float*)(a.ws + RW_BON);
    LAS unsigned char* L = F.lds + RING_OFF;
    LAS float* wS = (LAS float*)L; LAS float* aS = wS + 4096; LAS float* bS = wS + 8192; LAS float* rS = wS + 12288; LAS float* kS = wS + 16384;
    LAS unsigned char* vT = L + 81920; LAS unsigned char* aT = L + 91136; LAS unsigned char* rT = L + 100352; LAS unsigned char* kT = L + 109568; LAS unsigned char* bT = L + 118784;
    LAS unsigned char* AT = L + 128000; LAS unsigned char* NT = L + 133120; LAS float* gam = (LAS float*)(L + 138240);
    LAS unsigned char* aTl = L; LAS unsigned char* bTl = L + 9216;
    const int tid = F.tid, lane = F.lane, wave = F.wave, l31 = lane & 31, h = lane >> 5;
    const float* mu = a.in[6];
    for (int unit = F.vcu; unit < RW_UNITS; unit += F.G) {
        const int n = unit >> 4, hd = unit & 15;
        { const int tok = tid >> 3, cg = tid & 7, c0 = hd * 64 + cg * 8; const int rr = sub_row(2 * n + (tok >> 5), tok & 31);
          float wv[8], av[8], bv[8], rv[8], kv[8], vv[8];
#pragma unroll
          for (int q = 0; q < 8; ++q) { wv[q] = 1.f; av[q] = 0.f; bv[q] = 0.f; rv[q] = 0.f; kv[q] = 0.f; vv[q] = 0.f; }
          if (rr >= 0) { const int pos = row_pos(rr); const bf16* cur = P + (size_t)rr * EV_NP + c0; const bf16* prv = pos > 0 ? P + (size_t)pos_row(pos - 1) * EV_NP + c0 : nullptr;
              const v4u z4 = (v4u){0u, 0u, 0u, 0u};
              const v4u cr = *(const v4u*)cur, ck = *(const v4u*)(cur + 1024), cv = *(const v4u*)(cur + 2048);
              const v4u qr = prv ? *(const v4u*)prv : z4, qk = prv ? *(const v4u*)(prv + 1024) : z4, qv = prv ? *(const v4u*)(prv + 2048) : z4;
              const unsigned crw[4] = {cr.x, cr.y, cr.z, cr.w}, ckw[4] = {ck.x, ck.y, ck.z, ck.w}, cvw[4] = {cv.x, cv.y, cv.z, cv.w}, qrw[4] = {qr.x, qr.y, qr.z, qr.w}, qkw[4] = {qk.x, qk.y, qk.z, qk.w}, qvw[4] = {qv.x, qv.y, qv.z, qv.w};
              float ss = 0.f, bon = 0.f; float kk[8], ic[8];
#pragma unroll
              for (int q = 0; q < 8; ++q) { const int c = c0 + q; const float crf = (q & 1) ? bfhi(crw[q >> 1]) : bflo(crw[q >> 1]), ckf = (q & 1) ? bfhi(ckw[q >> 1]) : bflo(ckw[q >> 1]), cvf = (q & 1) ? bfhi(cvw[q >> 1]) : bflo(cvw[q >> 1]);
                  const float prf = (q & 1) ? bfhi(qrw[q >> 1]) : bflo(qrw[q >> 1]), pkf = (q & 1) ? bfhi(qkw[q >> 1]) : bflo(qkw[q >> 1]), pvf = (q & 1) ? bfhi(qvw[q >> 1]) : bflo(qvw[q >> 1]);
                  rv[q] = crf + (prf - crf) * mu[c]; kk[q] = ckf + (pkf - ckf) * mu[1024 + c]; vv[q] = cvf + (pvf - cvf) * mu[2048 + c];
                  wv[q] = DEC[(size_t)rr * 1024 + c]; ic[q] = ICL[(size_t)rr * 1024 + c];
                  const float kkv = kk[q] * a.in[12][c]; av[q] = kkv; ss += kkv * kkv; kv[q] = kk[q] * (1.0f + (ic[q] - 1.0f) * a.in[13][c]); bon += rv[q] * kv[q] * a.in[14][c]; }
              ss += __shfl_xor(ss, 1); ss += __shfl_xor(ss, 2); ss += __shfl_xor(ss, 4); bon += __shfl_xor(bon, 1); bon += __shfl_xor(bon, 2); bon += __shfl_xor(bon, 4);
              const float inv = 1.0f / fmaxf(sqrtf(ss), 1e-12f);
#pragma unroll
              for (int q = 0; q < 8; ++q) { const float kkn = av[q] * inv; av[q] = -kkn; bv[q] = kkn * ic[q]; }
              if (cg == 0) BON[(size_t)rr * 16 + hd] = bon;
              *(v4u*)(VV + (size_t)rr * 1024 + c0) = (v4u){pk2(vv[0], vv[1]), pk2(vv[2], vv[3]), pk2(vv[4], vv[5]), pk2(vv[6], vv[7])}; }
          const int o = tok * 64 + cg * 8;
          *(LAS f32x4*)(wS + o) = (f32x4){wv[0], wv[1], wv[2], wv[3]}; *(LAS f32x4*)(wS + o + 4) = (f32x4){wv[4], wv[5], wv[6], wv[7]};
          *(LAS f32x4*)(aS + o) = (f32x4){av[0], av[1], av[2], av[3]}; *(LAS f32x4*)(aS + o + 4) = (f32x4){av[4], av[5], av[6], av[7]};
          *(LAS f32x4*)(bS + o) = (f32x4){bv[0], bv[1], bv[2], bv[3]}; *(LAS f32x4*)(bS + o + 4) = (f32x4){bv[4], bv[5], bv[6], bv[7]};
          *(LAS f32x4*)(rS + o) = (f32x4){rv[0], rv[1], rv[2], rv[3]}; *(LAS f32x4*)(rS + o + 4) = (f32x4){rv[4], rv[5], rv[6], rv[7]};
          *(LAS f32x4*)(kS + o) = (f32x4){kv[0], kv[1], kv[2], kv[3]}; *(LAS f32x4*)(kS + o + 4) = (f32x4){kv[4], kv[5], kv[6], kv[7]};
#pragma unroll
          for (int q = 0; q < 8; ++q) *(LAS bf16*)(vT + (cg * 8 + q) * 144 + tok * 2) = (bf16)f2bf(vv[q]); }
        __syncthreads();
        { const int p = wave >> 2, sub = (wave >> 1) & 1, half = wave & 1, sl = lane >> 2, q = lane & 3, s = 16 * half + sl, tok = 32 * sub + s, jq = 16 * q;
          const LAS float* x0p = (p == 0 ? kS : bS) + tok * 64 + jq; LAS unsigned char* OUT = p == 0 ? AT : NT;
          float x[16];
#pragma unroll
          for (int j = 0; j < 16; j += 4) { const f32x4 t4 = *(const LAS f32x4*)(x0p + j); x[j] = t4.x; x[j + 1] = t4.y; x[j + 2] = t4.z; x[j + 3] = t4.w; }
          if (half) {
#pragma unroll
              for (int i = 0; i < 4; ++i) *(LAS bf16*)(OUT + ((sub * 32 + 4 * q + i) * 40 + s) * 2) = (bf16)0; }
#pragma unroll 2
          for (int tp = 16 * half; tp < 32; ++tp) { const LAS float* bp = wS + (32 * sub + tp) * 64 + jq; const bool run = tp > s;
              f32x4 a4[4], w4[4], b4[4], r4[4];
#pragma unroll
              for (int g = 0; g < 4; ++g) { a4[g] = *(const LAS f32x4*)(bp + 4096 + 4 * g); w4[g] = *(const LAS f32x4*)(bp + 4 * g); b4[g] = *(const LAS f32x4*)(bp + 8192 + 4 * g); r4[g] = *(const LAS f32x4*)(bp + 12288 + 4 * g); }
              float c = 0.f;
#pragma unroll
              for (int g = 0; g < 4; ++g) { c += x[4 * g] * a4[g].x; c += x[4 * g + 1] * a4[g].y; c += x[4 * g + 2] * a4[g].z; c += x[4 * g + 3] * a4[g].w; }
              c += __builtin_bit_cast(float, __builtin_amdgcn_mov_dpp(__builtin_bit_cast(int, c), 0xB1, 0xF, 0xF, true));
              c += __builtin_bit_cast(float, __builtin_amdgcn_mov_dpp(__builtin_bit_cast(int, c), 0x4E, 0xF, 0xF, true));
              float o = 0.f;
#pragma unroll
              for (int g = 0; g < 4; ++g) { const float n0 = x[4 * g] * w4[g].x + c * b4[g].x, n1 = x[4 * g + 1] * w4[g].y + c * b4[g].y, n2 = x[4 * g + 2] * w4[g].z + c * b4[g].z, n3 = x[4 * g + 3] * w4[g].w + c * b4[g].w;
                  x[4 * g] = run ? n0 : x[4 * g]; x[4 * g + 1] = run ? n1 : x[4 * g + 1]; x[4 * g + 2] = run ? n2 : x[4 * g + 2]; x[4 * g + 3] = run ? n3 : x[4 * g + 3];
                  o += x[4 * g] * r4[g].x; o += x[4 * g + 1] * r4[g].y; o += x[4 * g + 2] * r4[g].z; o += x[4 * g + 3] * r4[g].w; }
              o += __builtin_bit_cast(float, __builtin_amdgcn_mov_dpp(__builtin_bit_cast(int, o), 0xB1, 0xF, 0xF, true));
              o += __builtin_bit_cast(float, __builtin_amdgcn_mov_dpp(__builtin_bit_cast(int, o), 0x4E, 0xF, 0xF, true));
              if (q == 0) *(LAS bf16*)(OUT + ((sub * 32 + tp) * 40 + s) * 2) = (bf16)f2bf(tp >= s ? o : 0.f); }
          LAS unsigned char* XT = p == 0 ? kT : bT;
#pragma unroll
          for (int j = 0; j < 16; ++j) { const unsigned hi = f2bf(x[j]); *(LAS bf16*)(XT + (jq + j) * 144 + tok * 2) = (bf16)hi; x[j] -= __uint_as_float(hi << 16); }
          float alo[32]; const bool gwave = (p == 0 && half == 1); const int j = lane;
          if (gwave) { float g = 1.f;
#pragma unroll
              for (int tp = 0; tp < 32; ++tp) { const int tk = 32 * sub + tp; const float w_ = wS[tk * 64 + j], a_ = aS[tk * 64 + j], r_ = rS[tk * 64 + j];
                  const float at = a_ * g; const unsigned hi = f2bf(at); *(LAS bf16*)(aT + j * 144 + tk * 2) = (bf16)hi; alo[tp] = at - __uint_as_float(hi << 16);
                  g *= w_; *(LAS bf16*)(rT + j * 144 + tk * 2) = (bf16)f2bf(r_ * g); }
              gam[sub * 64 + j] = g; }
          __syncthreads();
          if (p == 1) {
#pragma unroll
              for (int jj = 0; jj < 16; ++jj) *(LAS bf16*)(bTl + (jq + jj) * 144 + tok * 2) = (bf16)f2bf(x[jj]); }
          if (gwave) {
#pragma unroll
              for (int tp = 0; tp < 32; ++tp) *(LAS bf16*)(aTl + j * 144 + (32 * sub + tp) * 2) = (bf16)f2bf(alo[tp]); }
        }
        __syncthreads();
        { const int sub = wave >> 2, t1 = (wave >> 1) & 1, t0 = wave & 1; const size_t sch = (size_t)hd * RW_NSC + (2 * n + sub);
          { f32x16 acc;
#pragma unroll
            for (int r = 0; r < 16; ++r) acc[r] = 0.f;
#pragma unroll
            for (int ks = 0; ks < 2; ++ks) { const int ao = (32 * t1 + l31) * 144 + (32 * sub + 16 * ks + 8 * h) * 2, bo = (32 * t0 + l31) * 144 + (32 * sub + 16 * ks + 8 * h) * 2;
                const bf16x8 ah = *(const LAS bf16x8*)(aT + ao), al = *(const LAS bf16x8*)(aTl + ao), bh = *(const LAS bf16x8*)(bT + bo), bl = *(const LAS bf16x8*)(bTl + bo);
                acc = MFMA32(al, bh, acc); acc = MFMA32(ah, bl, acc); acc = MFMA32(ah, bh, acc); }
            const int jp = 32 * t0 + l31;
#pragma unroll
            for (int g = 0; g < 4; ++g) { unsigned hi[4]; float lo[4];
#pragma unroll
                for (int q = 0; q < 4; ++q) { hi[q] = f2bf(acc[4 * g + q]); lo[q] = acc[4 * g + q] - __uint_as_float(hi[q] << 16); }
                *(v2u*)(RH + (sch * 64 + jp) * 64 + 32 * t1 + 8 * g + 4 * h) = (v2u){hi[0] | (hi[1] << 16), hi[2] | (hi[3] << 16)};
                *(v2u*)(RL + (sch * 64 + jp) * 64 + 32 * t1 + 8 * g + 4 * h) = (v2u){pk2(lo[0], lo[1]), pk2(lo[2], lo[3])}; }
            if (t1 == 0 && t0 == 0) GAM[sch * 64 + lane] = gam[sub * 64 + lane]; }
          { f32x16 acc;
#pragma unroll
            for (int r = 0; r < 16; ++r) acc[r] = 0.f;
#pragma unroll
            for (int ks = 0; ks < 2; ++ks) acc = MFMA32(*(const LAS bf16x8*)(kT + (32 * t1 + l31) * 144 + (32 * sub + 16 * ks + 8 * h) * 2), *(const LAS bf16x8*)(vT + (32 * t0 + l31) * 144 + (32 * sub + 16 * ks + 8 * h) * 2), acc);
            bf16* dst = GT + ((sch * 4 + t1 * 2 + t0) * 64 + lane) * 16;
            *(v4u*)dst = (v4u){pk2(acc[0], acc[1]), pk2(acc[2], acc[3]), pk2(acc[4], acc[5]), pk2(acc[6], acc[7])}; *(v4u*)(dst + 8) = (v4u){pk2(acc[8], acc[9]), pk2(acc[10], acc[11]), pk2(acc[12], acc[13]), pk2(acc[14], acc[15])}; } }
        if (wave < 4) { const int sub = wave >> 1, jt = wave & 1; const size_t sch = (size_t)hd * RW_NSC + (2 * n + sub);
            f32x16 acc;
#pragma unroll
            for (int r = 0; r < 16; ++r) acc[r] = bf2f(*(const LAS bf16*)(rT + (32 * jt + crow(r, h)) * 144 + (32 * sub + l31) * 2));
#pragma unroll
            for (int ks = 0; ks < 2; ++ks) acc = MFMA32(*(const LAS bf16x8*)(aT + (32 * jt + l31) * 144 + (32 * sub + 16 * ks + 8 * h) * 2), *(const LAS bf16x8*)(NT + (sub * 32 + l31) * 80 + (16 * ks + 8 * h) * 2), acc);
#pragma unroll
            for (int g = 0; g < 4; ++g) *(v2u*)(PR + (sch * 32 + l31) * 64 + 32 * jt + 8 * g + 4 * h) = (v2u){pk2(acc[4 * g], acc[4 * g + 1]), pk2(acc[4 * g + 2], acc[4 * g + 3])};
        } else { const int t2 = tid - 256, sub = t2 >> 7, t = (t2 >> 2) & 31, s8 = (t2 & 3) * 8; const size_t sch = (size_t)hd * RW_NSC + (2 * n + sub);
            *(v4u*)(ATG + (sch * 32 + t) * 32 + s8) = *(const LAS v4u*)(AT + (sub * 32 + t) * 80 + s8 * 2); }
        { const int sub = tid >> 8, it = (tid >> 7) & 1, ks = (tid >> 6) & 1; const size_t sch = (size_t)hd * RW_NSC + (2 * n + sub);
          *(v4u*)(VTF + ((sch * 4 + it * 2 + ks) * 64 + lane) * 8) = *(const LAS v4u*)(vT + (32 * it + l31) * 144 + (32 * sub + 16 * ks + 8 * h) * 2); }
        __syncthreads();
    }
}

DI void ph_rwkv_chain(const Frame& F, const Args& a) {
    if (F.vcu >= 16 && F.vcu < 18) { const int c = (F.vcu - 16) * 512 + F.tid; const float* HL = (const float*)(a.ws + LR_H); const float* AP = (const float*)(a.ws + LR_A); float* CR = (float*)(a.ws + LR_C);
        float carry = 0.f;
#pragma unroll 8
        for (int sc = 0; sc < RW_NSC; ++sc) { const float hl = HL[sc * 1024 + c], ap = AP[sc * 1024 + c]; CR[sc * 1024 + c] = carry; carry = ap * carry + hl; }
        return; }
    if (F.vcu >= 16) return;
    const int hd = F.vcu; const bf16* RH = (const bf16*)(a.ws + RW_RH); const bf16* RL = (const bf16*)(a.ws + RW_RL); const bf16* GT = (const bf16*)(a.ws + RW_GT); const float* GAM = (const float*)(a.ws + RW_GAM); bf16* SALL = (bf16*)(a.ws + RW_SALL);
    constexpr int RW_NS = 7, SLOT = 8192 + 8192 + 1024;
    LAS unsigned char* XS = F.lds + RING_OFF; LAS unsigned char* RG = XS + 2 * 9216;
    const int lane = F.lane, wave = F.wave, l31 = lane & 31, h = lane >> 5, jt = (wave >> 1) & 1, it = wave & 1, lw = wave & 3;
    for (int i = F.tid; i < 2 * 9216 / 4; i += NWAVES * 64) ((LAS unsigned*)XS)[i] = 0u;
#define RW_BAR() do { asm volatile("s_waitcnt lgkmcnt(0)" ::: "memory"); __builtin_amdgcn_s_barrier(); asm volatile("" ::: "memory"); } while (0)
    const unsigned rg0 = (unsigned)(uintptr_t)RG;
    int offR[2], offG[2];
#pragma unroll
    for (int i = 0; i < 2; ++i) { const int b = 2 * lw + i, row = 8 * b + (lane >> 3), pc = lane & 7; offR[i] = row * 64 + ((pc ^ (row & 7)) * 8); offG[i] = (b * 64 + lane) * 8; }
    const int offM = (lane & 15) * 4;
#define RW_DMA(src, dst) do { unsigned keep_; asm volatile("s_mov_b32 %0, m0\n\ts_mov_b32 m0, %2\n\ts_nop 0\n\tglobal_load_lds_dwordx4 %1, off\n\ts_mov_b32 m0, %0" : "=&s"(keep_) : "v"(src), "s"(dst) : "memory"); } while (0)
#define RW_ISSUE(scn) do { const int s_ = (scn) < RW_NSC ? (scn) : RW_NSC - 1; const size_t sch_ = (size_t)hd * RW_NSC + s_; \
        const unsigned sb_ = (unsigned)__builtin_amdgcn_readfirstlane((int)(rg0 + (unsigned)((scn) % RW_NS) * SLOT)); \
        _Pragma("unroll") for (int i_ = 0; i_ < 2; ++i_) { const unsigned bo_ = (unsigned)__builtin_amdgcn_readfirstlane((2 * lw + i_) * 1024); \
            RW_DMA(RH + sch_ * 4096 + offR[i_], sb_ + bo_); RW_DMA(GT + sch_ * 4096 + offG[i_], sb_ + 8192 + bo_); } \
        RW_DMA(GAM + sch_ * 64 + offM, sb_ + 16384); } while (0)
#define RW_WAITV(n) asm volatile("s_waitcnt vmcnt(" #n ")" ::: "memory")
    f32x16 X;
#pragma unroll
    for (int r = 0; r < 16; ++r) X[r] = 0.f;
    if (wave >= 4) { RW_ISSUE(0); RW_ISSUE(1); RW_ISSUE(2); RW_ISSUE(3); RW_ISSUE(4); RW_ISSUE(5); RW_WAITV(25); }
    RW_BAR();
    for (int sc = 0; sc < RW_NSC; ++sc) {
        if (wave < 4) {
            const LAS unsigned char* sb = RG + (sc % RW_NS) * SLOT;
            f32x16 acc; const size_t sch = (size_t)hd * RW_NSC + sc;
            { const v4u g0 = *(const LAS v4u*)(sb + 8192 + ((jt * 2 + it) * 64 + lane) * 32), g1 = *(const LAS v4u*)(sb + 8192 + ((jt * 2 + it) * 64 + lane) * 32 + 16);
              const unsigned gw_[8] = {g0.x, g0.y, g0.z, g0.w, g1.x, g1.y, g1.z, g1.w};
#pragma unroll
              for (int g = 0; g < 4; ++g) { const f32x4 m = *(const LAS f32x4*)(sb + 16384 + (32 * jt + 8 * g + 4 * h) * 4);
                  acc[4 * g] = bflo(gw_[2 * g]) + m.x * X[4 * g]; acc[4 * g + 1] = bfhi(gw_[2 * g]) + m.y * X[4 * g + 1]; acc[4 * g + 2] = bflo(gw_[2 * g + 1]) + m.z * X[4 * g + 2]; acc[4 * g + 3] = bfhi(gw_[2 * g + 1]) + m.w * X[4 * g + 3]; } }
#pragma unroll
            for (int g = 0; g < 4; ++g) *(v2u*)(SALL + (sch * 64 + 32 * it + l31) * 64 + 32 * jt + 8 * g + 4 * h) = (v2u){pk2(X[4 * g], X[4 * g + 1]), pk2(X[4 * g + 2], X[4 * g + 3])};
            const LAS unsigned char* xb = XS + (sc & 1) * 9216 + (32 * it + l31) * 144 + 16 * h; const int ar = 32 * jt + l31; const LAS unsigned char* ab = sb + ar * 128;
#pragma unroll
            for (int ks = 0; ks < 4; ++ks) { const bf16x8 xf = *(const LAS bf16x8*)(xb + 32 * ks); const int po = (((2 * ks + h) ^ (ar & 7)) * 16);
                acc = MFMA32(*(const LAS bf16x8*)(ab + po), xf, acc); }
            X = acc;
            LAS unsigned char* xn = XS + ((sc + 1) & 1) * 9216 + (32 * it + l31) * 144;
#pragma unroll
            for (int g = 0; g < 4; ++g) *(LAS v2u*)(xn + (32 * jt + 8 * g + 4 * h) * 2) = (v2u){pk2(X[4 * g], X[4 * g + 1]), pk2(X[4 * g + 2], X[4 * g + 3])};
        } else {
            RW_ISSUE(sc + RW_NS - 1);
            RW_WAITV(25);
        }
        RW_BAR();
    }
    if (wave >= 4) RW_WAITV(0);
#undef RW_ISSUE
#undef RW_DMA
#undef RW_WAITV
#undef RW_BAR
}

DI void ph_rwkv_out(const Frame& F, const Args& a) {
    const bf16* SALL = (const bf16*)(a.ws + RW_SALL); const bf16* PR = (const bf16*)(a.ws + RW_PR); const bf16* ATG = (const bf16*)(a.ws + RW_AT); const bf16* VTF = (const bf16*)(a.ws + RW_VTF);
    const bf16* VV = (const bf16*)(a.ws + RW_VV); const float* BON = (const float*)(a.ws + RW_BON); const float* GATE = (const float*)(a.ws + WS_SCR + SC_GATE); bf16* Y = (bf16*)(a.ws + WS_YMIX);
    const int lane = F.lane, l31 = lane & 31, h = lane >> 5;
    for (int item = F.gw; item < RW_NSC * 16; item += F.NGW) { const int sc = item >> 4, hd = item & 15; if (sc == 1) continue;
        const size_t sch = (size_t)hd * RW_NSC + sc; f32x16 acc[2];
#pragma unroll
        for (int it = 0; it < 2; ++it) {
#pragma unroll
            for (int r = 0; r < 16; ++r) acc[it][r] = 0.f;
#pragma unroll
            for (int ks = 0; ks < 4; ++ks) acc[it] = MFMA32(*(const bf16x8*)(SALL + (sch * 64 + 32 * it + l31) * 64 + 16 * ks + 8 * h), *(const bf16x8*)(PR + (sch * 32 + l31) * 64 + 16 * ks + 8 * h), acc[it]);
#pragma unroll
            for (int ks = 0; ks < 2; ++ks) acc[it] = MFMA32(*(const bf16x8*)(VTF + ((sch * 4 + it * 2 + ks) * 64 + lane) * 8), *(const bf16x8*)(ATG + (sch * 32 + l31) * 32 + 16 * ks + 8 * h), acc[it]); }
        float s1 = 0.f;
#pragma unroll
        for (int it = 0; it < 2; ++it)
#pragma unroll
            for (int r = 0; r < 16; ++r) s1 += acc[it][r];
        s1 += __shfl_xor(s1, 32); const float mean = s1 * (1.0f / 64.0f); float s2 = 0.f;
#pragma unroll
        for (int it = 0; it < 2; ++it)
#pragma unroll
            for (int r = 0; r < 16; ++r) { const float d = acc[it][r] - mean; s2 += d * d; }
        s2 += __shfl_xor(s2, 32); const float rstd = 1.0f / sqrtf(s2 * (1.0f / 64.0f) + 64e-5f);
        const int rr = sub_row(sc, l31);
        if (rr >= 0) { const float bon = BON[(size_t)rr * 16 + hd];
#pragma unroll
            for (int it = 0; it < 2; ++it)
#pragma unroll
                for (int g = 0; g < 4; ++g) { const int c = hd * 64 + 32 * it + 8 * g + 4 * h;
                    const f32x4 lw = *(const f32x4*)(a.in[15] + c), lb = *(const f32x4*)(a.in[16] + c), gt = *(const f32x4*)(GATE + (size_t)rr * 1024 + c); const v2u vw = *(const v2u*)(VV + (size_t)rr * 1024 + c);
                    const float o0 = ((acc[it][4 * g] - mean) * rstd * lw.x + lb.x + bon * bflo(vw.x)) * gt.x, o1 = ((acc[it][4 * g + 1] - mean) * rstd * lw.y + lb.y + bon * bfhi(vw.x)) * gt.y;
                    const float o2 = ((acc[it][4 * g + 2] - mean) * rstd * lw.z + lb.z + bon * bflo(vw.y)) * gt.z, o3 = ((acc[it][4 * g + 3] - mean) * rstd * lw.w + lb.w + bon * bfhi(vw.y)) * gt.w;
                    *(v2u*)(Y + (size_t)rr * DM + c) = (v2u){pk2(o0, o1), pk2(o2, o3)}; } }
    }
    lru_apply(F, a);
}

constexpr int N_PHASES = 24;
template <class Epi, class Sched> DI void run_gemm(const Frame& F, const pg8::Gemm& g, const Sched& S, const Epi& E) {
    pg8::gemm_phase<Epi, Sched, true, true>(F.lds + RING_OFF, g, S, E);
}
DI void ph_moe_up(const Frame& F, const Args& a) {
    const int nt = (int)__hip_atomic_load((gu32*)(a.ws + WS_TILES) + 127, RLX_AGENT);
    pg8::Gemm g{(const bf16*)(a.ws + WS_SCR + SC_XG), (const bf16*)(a.ws + WS_MOEW), DM, DM, DM};
    pg8::MoeOrder S{(const int*)(a.ws + WS_TILES), nt, 4, F.G, (int)blockIdx.x, (long)MOE_E_BYTES};
    pg8::EpiSwiglu E{(bf16*)(a.ws + WS_SCR + SC_ACT), FF};
    run_gemm(F, g, S, E);
}
DI void ph_moe_down(const Frame& F, const Args& a) {
    const int nt = (int)__hip_atomic_load((gu32*)(a.ws + WS_TILES) + 127, RLX_AGENT);
    pg8::Gemm g{(const bf16*)(a.ws + WS_SCR + SC_ACT), (const bf16*)(a.ws + WS_MOEW + MOE_W2_OFF), FF, FF, FF};
    pg8::MoeOrder S{(const int*)(a.ws + WS_TILES), nt, 8, F.G, (int)blockIdx.x, (long)MOE_E_BYTES};
    pg8::EpiBf16 E{(bf16*)(a.ws + WS_SCR + SC_YB), DM};
    run_gemm(F, g, S, E);
}

__global__ void __launch_bounds__(NWAVES * 64, 2) hyb_fwd(Args a) {
    extern __shared__ __attribute__((aligned(16))) unsigned char lds[];
    Frame F;
    F.lds = (LAS unsigned char*)lds;
    F.MISC = (volatile LAS unsigned*)(F.lds + MISC_OFF);
    F.tid = threadIdx.x; F.lane = F.tid & 63; F.wave = __builtin_amdgcn_readfirstlane(F.tid >> 6);
    F.G = gridDim.x; { const int bx = blockIdx.x; F.vcu = (F.G % 8 == 0) ? (bx % 8) * (F.G / 8) + bx / 8 : bx; }
    F.gw = F.vcu * NWAVES + F.wave; F.NGW = F.G * NWAVES;
    F.ctl = (gu32*)(a.ws + WS_CTL);
    for (int u = F.tid; u < (LDS_BYTES - LDSCTL_OFF) / 4; u += NWAVES * 64) ((LAS unsigned*)(F.lds + LDSCTL_OFF))[u] = 0u;
    __syncthreads();
    XcdBarrier bar; bar.bar = (unsigned*)(F.ctl + CW_BAR); bar.x = 0; bar.st = nullptr;
    if (MK_ONE_LAUNCH) bar = xcd_barrier_post((unsigned*)(F.ctl + CW_BAR), F.MISC + 8);
    const int lo = a.ph_lo, hi = a.ph_hi;
#ifndef PH_MASK
#define PH_MASK 0xFFFFFFFFu
#endif
#define IN(k) (((PH_MASK >> (k)) & 1u) && lo <= (k) && (k) < hi)
#ifndef PROBE_REP
#define PROBE_REP 0u
#endif
#define REP(k) ((((unsigned)PROBE_REP >> (k)) & 1u) ? 2 : 1)
#ifdef PROBE_TS
#define STAMP(k) do { if (blockIdx.x == 0 && F.tid == 0) ((unsigned long long*)(F.ctl + CW_TS))[(k)] = __builtin_amdgcn_s_memrealtime(); } while (0)
#else
#define STAMP(k) do { } while (0)
#endif
#define SEAM(k) do { if (IN(k) && IN((k) + 1)) xcd_barrier(bar); STAMP((k) + 1); } while (0)
    const bf16* HN = (const bf16*)(a.ws + WS_HN); bf16* PROJ = (bf16*)(a.ws + WS_PROJ); const bf16* YMIX = (const bf16*)(a.ws + WS_YMIX); float* H = (float*)(a.ws + WS_H);

    STAMP(0);
    if (IN(0)) for (int rep_ = 0; rep_ < REP(0); ++rep_) ph_prologue(F, a);
    SEAM(0);
    if (IN(1)) for (int rep_ = 0; rep_ < REP(1); ++rep_) { pg8::Gemm g{HN, (const bf16*)(a.ws + WS_WEVIN), DM, DM, DM}; pg8::StaticOrder S; S.init(MP, EV_NP, F.G, (int)blockIdx.x); pg8::EpiBf16 E{PROJ, EV_NP}; run_gemm(F, g, S, E); }
    SEAM(1);
    if (IN(2)) for (int rep_ = 0; rep_ < REP(2); ++rep_) ph_even_prep(F, a);
    SEAM(2);
    if (IN(3)) for (int rep_ = 0; rep_ < REP(3); ++rep_) {
#ifndef NO_LORA
        { pg8::Gemm g{(const bf16*)(a.ws + WS_SCR + SC_ALORA), (const bf16*)(a.ws + WS_WLORA), 384, 384, 384}; pg8::StaticOrder S; S.init(MP, 3072, F.G, (int)blockIdx.x);
          static_assert(SC_ICL - SC_DEC == SC_GATE - SC_ICL, "lora outputs equally spaced");
          pg8::EpiLora E{(float*)(a.ws + WS_SCR + SC_DEC), (long)((SC_ICL - SC_DEC) / 4), a.in[7], a.in[9]}; run_gemm(F, g, S, E); }
#endif
#ifndef NO_GATES
        { pg8::Gemm g{(const bf16*)(a.ws + WS_SCR + SC_XR), (const bf16*)(a.ws + WS_WGATE), 256, 1024, 256}; pg8::StaticOrder S; S.init(MP, 2048, F.G, (int)blockIdx.x); S.amod = 4; S.astep = 512;
          pg8::EpiGates E{(float*)(a.ws + WS_SCR + SC_LA), (float*)(a.ws + WS_SCR + SC_LIX), a.in[20], a.in[22], a.in[23], (const bf16*)(a.ws + WS_SCR + SC_XR)}; run_gemm(F, g, S, E); }
#endif
    }
    SEAM(3);
    if (IN(4)) for (int rep_ = 0; rep_ < REP(4); ++rep_) ph_rwkv_chunk(F, a);
    SEAM(4);
    if (IN(5)) { if (F.vcu < 18) { ph_rwkv_chain(F, a); if (REP(5) == 2) { __syncthreads(); ph_rwkv_chain(F, a); } } else ph_aux_convert(F, a, (F.vcu - 18) * NWAVES + F.wave, (F.G - 18) * NWAVES); }
    SEAM(5);
    if (IN(6)) for (int rep_ = 0; rep_ < REP(6); ++rep_) ph_rwkv_out(F, a);
    SEAM(6);
    if (IN(7)) for (int rep_ = 0; rep_ < REP(7); ++rep_) { pg8::Gemm g{YMIX, (const bf16*)(a.ws + WS_WEVOUT), DM, DM, DM}; pg8::StaticOrder S; S.init(MP, DM, F.G, (int)blockIdx.x); pg8::EpiResid E{H, a.in[0], a.in[1], 0}; run_gemm(F, g, S, E); }
    SEAM(7);
    if (IN(8)) for (int rep_ = 0; rep_ < REP(8); ++rep_) ph_route(F, a, 0, rep_);
    SEAM(8);
    if (IN(9)) for (int rep_ = 0; rep_ < REP(9); ++rep_) ph_gather(F, a, 0);
    SEAM(9);
    if (IN(10)) for (int rep_ = 0; rep_ < REP(10); ++rep_) ph_moe_up(F, a);
    SEAM(10);
    if (IN(11)) for (int rep_ = 0; rep_ < REP(11); ++rep_) ph_moe_down(F, a);
    SEAM(11);
    if (IN(12)) for (int rep_ = 0; rep_ < REP(12); ++rep_) ph_combine(F, a, 0);
    SEAM(12);
    if (IN(13)) for (int rep_ = 0; rep_ < REP(13); ++rep_) { pg8::Gemm g{HN, (const bf16*)(a.ws + WS_WODIN), DM, DM, DM}; pg8::StaticOrder S; S.init(MP, OD_NP, F.G, (int)blockIdx.x); pg8::EpiBf16 E{PROJ, OD_NP}; run_gemm(F, g, S, E); }
    SEAM(13);
    if (IN(14)) for (int rep_ = 0; rep_ < REP(14); ++rep_) ph_odd_prep(F, a);
    SEAM(14);
    if (IN(15)) for (int rep_ = 0; rep_ < REP(15); ++rep_) ph_gdn_chunk(F, a);
    SEAM(15);
    if (IN(16)) { ph_gdn_chain(F, a); if (REP(16) == 2) { __syncthreads(); ph_gdn_chain(F, a); } }
    SEAM(16);
    if (IN(17)) for (int rep_ = 0; rep_ < REP(17); ++rep_) { ph_odd_post(F, a); moe_convert(F, a, 1, F.gw, F.NGW); }
    SEAM(17);
    if (IN(18)) for (int rep_ = 0; rep_ < REP(18); ++rep_) { pg8::Gemm g{YMIX, (const bf16*)(a.ws + WS_WODOUT), 4096, 4096, 4096}; pg8::StaticOrder S; S.init(MP, DM, F.G, (int)blockIdx.x); pg8::EpiResid E{H, a.in[0], a.in[1], 1}; run_gemm(F, g, S, E); }
    SEAM(18);
    if (IN(19)) for (int rep_ = 0; rep_ < REP(19); ++rep_) ph_route(F, a, 1, rep_);
    SEAM(19);
    if (IN(20)) for (int rep_ = 0; rep_ < REP(20); ++rep_) ph_gather(F, a, 1);
    SEAM(20);
    if (IN(21)) for (int rep_ = 0; rep_ < REP(21); ++rep_) ph_moe_up(F, a);
    SEAM(21);
    if (IN(22)) for (int rep_ = 0; rep_ < REP(22); ++rep_) ph_moe_down(F, a);
    SEAM(22);
    if (IN(23)) for (int rep_ = 0; rep_ < REP(23); ++rep_) ph_combine(F, a, 1);
#undef IN
#undef SEAM
}

extern "C" void kernel_launch(void* const* d_in, const int* in_sizes, int n_in, void* d_out, int out_size, void* d_ws, size_t ws_size, hipStream_t stream) {
    static int grid = 0;
    if (grid == 0) {
        if (n_in != 36 || out_size != TX * DM || ws_size < WS_END) { fprintf(stderr, "kernel_launch: unexpected shapes (n_in %d, out %d, ws %zu)\n", n_in, out_size, ws_size); grid = -1; return; }
        int dev = 0, cus = 0, per_cu = 0;
        if (hipGetDevice(&dev) != hipSuccess || hipDeviceGetAttribute(&cus, hipDeviceAttributeMultiprocessorCount, dev) != hipSuccess) { grid = -1; return; }
        if (hipFuncSetAttribute((const void*)hyb_fwd, hipFuncAttributeMaxDynamicSharedMemorySize, LDS_BYTES) != hipSuccess) { fprintf(stderr, "kernel_launch: hipFuncSetAttribute failed\n"); grid = -1; return; }
        if (hipOccupancyMaxActiveBlocksPerMultiprocessor(&per_cu, (const void*)hyb_fwd, NWAVES * 64, LDS_BYTES) != hipSuccess || per_cu < 1) { fprintf(stderr, "kernel_launch: occupancy query says %d\n", per_cu); per_cu = 1; }
        (void)hipGetLastError();
        grid = cus;
    }
    if (grid < 0) return;
    if (hipMemsetAsync((char*)d_ws + WS_CTL, 0, CTL_ZERO_BYTES, stream) != hipSuccess) return;
    Args a{};
    for (int i = 0; i < 36; ++i) a.in[i] = (const float*)d_in[i];
    a.out = (float*)d_out; a.ws = (unsigned char*)d_ws;
#if MK_ONE_LAUNCH
    a.ph_lo = 0; a.ph_hi = N_PHASES;
    hipLaunchKernelGGL(hyb_fwd, dim3(grid), dim3(NWAVES * 64), LDS_BYTES, stream, a);
#else
    for (int p = 0; p < N_PHASES; ++p) { a.ph_lo = p; a.ph_hi = p + 1; hipLaunchKernelGGL(hyb_fwd, dim3(grid), dim3(NWAVES * 64), LDS_BYTES, stream, a); }
#endif
}
```

```cpp
#include <hip/hip_runtime.h>
#include <cstdio>
#include <cstdint>
#include <cmath>

#ifndef MK_ONE_LAUNCH
#define MK_ONE_LAUNCH 1
#endif

namespace pg8 {
#define PG8_LAS __attribute__((address_space(3)))
typedef unsigned short bf16_t;
typedef short bf16x8 __attribute__((ext_vector_type(8)));
typedef float f32x4 __attribute__((ext_vector_type(4)));
typedef unsigned u32x4 __attribute__((ext_vector_type(4)));
typedef unsigned u32x2 __attribute__((ext_vector_type(2)));
constexpr int BM = 256, BK = 64, HALF = 128, HTB = HALF * BK * 2  , STAGE_BYTES = 8 * HTB, NXCD = 8, WGM = 8;

__host__ __device__ __forceinline__ int lds_byte(int r, int c) { const int st = (r >> 4) * 2 + (c >> 5), rr = r & 15, cc = c & 31, ob = rr * 64 + cc * 2; return st * 1024 + (ob ^ (((ob >> 9) & 1) << 5)); }
__host__ __device__ __forceinline__ void stage_rc(int b, int& R, int& C) { const int st = b / 1024, sb = b % 1024, swz = sb ^ (((sb >> 9) & 1) << 5); R = (st >> 1) * 16 + swz / 64; C = (st & 1) * 32 + (swz % 64) / 2; }
__host__ __device__ __forceinline__ int perm32(int rho) { const int n = rho >> 4, i = rho & 15; return 8 * (i >> 2) + 4 * n + (i & 3); }

struct Unit { int pm, pn; long aoff, boff; };
struct Gemm { const bf16_t* A; const bf16_t* Bt; int K, lda, ldb; };

struct StaticOrder {
    int nM, nN, nwg, G, c, amod; long astep;
    __host__ __device__ void init(int M, int N, int G_, int c_) { nM = M / BM; nN = N / BM; nwg = nM * nN; G = G_; c = c_; amod = 0; astep = 0; }
    __host__ __device__ bool next(int i, Unit& u) const {
        const long L = (long)i * G + c; if (L >= nwg) return false;
        int wgid = (int)L; { const int q = nwg / NXCD, r = nwg % NXCD, xcd = wgid % NXCD, off = wgid / NXCD; wgid = (xcd < r ? xcd * (q + 1) : r * (q + 1) + (xcd - r) * q) + off; }
        const int nig = WGM * nN, gid = wgid / nig, fm = gid * WGM, gsz = (nM - fm) < WGM ? (nM - fm) : WGM;
        u.pm = fm + ((wgid % nig) % gsz); u.pn = (wgid % nig) / gsz; u.boff = 0; u.aoff = amod ? (long)(u.pn % amod) * astep : 0; return true;
    }
    __device__ __forceinline__ void a_ready(const Unit&) const {}
    __device__ __forceinline__ void done(const Unit&) const {}
};
struct MoeOrder {
    const int* tile_e; int ntiles, npn, G, c; long bstride;
    __device__ __forceinline__ bool next(int i, Unit& u) const {
        const long L = (long)i * G + c; if (L >= (long)ntiles * npn) return false;
        const int t = (int)(L / npn); u.pm = t; u.pn = (int)(L % npn); u.aoff = 0; u.boff = (long)tile_e[t] * bstride; return true;
    }
    __device__ __forceinline__ void a_ready(const Unit&) const {}
    __device__ __forceinline__ void done(const Unit&) const {}
};

__device__ __forceinline__ unsigned cvt_pk_bf16(float lo, float hi) { unsigned r; asm volatile("v_cvt_pk_bf16_f32 %0, %1, %2" : "=v"(r) : "v"(lo), "v"(hi)); return r; }
__device__ __forceinline__ float bf_lo(unsigned w) { return __uint_as_float(w << 16); }
__device__ __forceinline__ float bf_hi(unsigned w) { return __uint_as_float(w & 0xffff0000u); }
__device__ __forceinline__ float sigmoidf_(float x) { return 1.0f / (1.0f + __expf(-x)); }
__device__ __forceinline__ float softplusf_(float x) { return fmaxf(x, 0.f) + __logf(1.0f + __expf(-fabsf(x))); }

struct EpiBf16 {
    static constexpr bool PERM = true, AFTER_DRAIN = false;
    bf16_t* O; int ldc;
    __device__ __forceinline__ void operator()(const f32x4 (&acc)[2][2][4][2], const Unit& u, int wr, int wc, int fr, int fq) const {
        const int row0 = u.pm * BM + wr * 64 + fr; const int col0 = u.pn * BM + wc * 32 + 8 * fq;
#pragma unroll
        for (int ai = 0; ai < 2; ++ai)
#pragma unroll
            for (int m = 0; m < 4; ++m) { bf16_t* rowp = O + (size_t)(row0 + ai * HALF + m * 16) * ldc + col0;
#pragma unroll
                for (int bj = 0; bj < 2; ++bj) { const f32x4 v0 = acc[ai][bj][m][0], v1 = acc[ai][bj][m][1];
                    u32x4 w; w.x = cvt_pk_bf16(v0[0], v0[1]); w.y = cvt_pk_bf16(v0[2], v0[3]); w.z = cvt_pk_bf16(v1[0], v1[1]); w.w = cvt_pk_bf16(v1[2], v1[3]);
                    *(u32x4*)(rowp + bj * HALF) = w; } }
    }
};
struct EpiSwiglu {
    static constexpr bool PERM = true, AFTER_DRAIN = false;
    bf16_t* O; int ldc;
    __device__ __forceinline__ void operator()(const f32x4 (&acc)[2][2][4][2], const Unit& u, int wr, int wc, int fr, int fq) const {
        const int row0 = u.pm * BM + wr * 64 + fr; const int col0 = u.pn * HALF + wc * 32 + 8 * fq;
#pragma unroll
        for (int ai = 0; ai < 2; ++ai)
#pragma unroll
            for (int m = 0; m < 4; ++m) { bf16_t* rowp = O + (size_t)(row0 + ai * HALF + m * 16) * ldc + col0;
                float o[8];
#pragma unroll
                for (int n = 0; n < 2; ++n)
#pragma unroll
                    for (int j = 0; j < 4; ++j) { const float gq = acc[ai][0][m][n][j], uq = acc[ai][1][m][n][j]; o[4 * n + j] = gq * sigmoidf_(gq) * uq; }
                u32x4 w; w.x = cvt_pk_bf16(o[0], o[1]); w.y = cvt_pk_bf16(o[2], o[3]); w.z = cvt_pk_bf16(o[4], o[5]); w.w = cvt_pk_bf16(o[6], o[7]);
                *(u32x4*)rowp = w; }
    }
};
struct EpiResid {
    static constexpr bool PERM = false, AFTER_DRAIN = false;
    float* out; const float* x; const float* meta; int mode;
    __device__ __forceinline__ void operator()(const f32x4 (&acc)[2][2][4][2], const Unit& u, int wr, int wc, int fr, int fq) const {
        const int row0 = u.pm * BM + wr * 64 + fr, col0 = u.pn * BM + wc * 32 + 4 * fq;
#pragma unroll
        for (int ai = 0; ai < 2; ++ai)
#pragma unroll
            for (int m = 0; m < 4; ++m) { const int row = row0 + ai * HALF + m * 16; float* rowp = out + (size_t)row * 2048 + col0;
                const float* bp = mode ? rowp : (row < 8192 ? x + (size_t)row * 2048 + col0 : (row < 8208 ? meta + (size_t)(row - 8192) * 2048 + col0 : nullptr));
#pragma unroll
                for (int bj = 0; bj < 2; ++bj)
#pragma unroll
                    for (int n = 0; n < 2; ++n) { f32x4 b = (f32x4){0.f, 0.f, 0.f, 0.f}; if (bp) b = *(const f32x4*)(bp + bj * HALF + n * 16);
                        *(f32x4*)(rowp + bj * HALF + n * 16) = acc[ai][bj][m][n] + b; } }
    }
};
struct EpiLora {
    static constexpr bool PERM = false, AFTER_DRAIN = false;
    float* base; long gstride; const float* w0; const float* a0;
    __device__ __forceinline__ void operator()(const f32x4 (&acc)[2][2][4][2], const Unit& u, int wr, int wc, int fr, int fq) const {
        const int grp = u.pn >> 2; const int row0 = u.pm * BM + wr * 64 + fr, col0 = (u.pn & 3) * BM + wc * 32 + 4 * fq;
        float* O = base + (size_t)grp * gstride;
#pragma unroll
        for (int bj = 0; bj < 2; ++bj)
#pragma unroll
            for (int n = 0; n < 2; ++n) { const int c = col0 + bj * HALF + n * 16;
                f32x4 bv = (f32x4){0.f, 0.f, 0.f, 0.f}; if (grp == 0) bv = *(const f32x4*)(w0 + c); else if (grp == 1) bv = *(const f32x4*)(a0 + c);
#pragma unroll
                for (int ai = 0; ai < 2; ++ai)
#pragma unroll
                    for (int m = 0; m < 4; ++m) { f32x4 v = acc[ai][bj][m][n] + bv;
                        if (grp == 0) {
#pragma unroll
                            for (int j = 0; j < 4; ++j) { const float wl = -softplusf_(-v[j]) - 0.5f; v[j] = __expf(-__expf(wl)); }
                        } else if (grp == 1) {
#pragma unroll
                            for (int j = 0; j < 4; ++j) v[j] = sigmoidf_(v[j]);
                        }
                        *(f32x4*)(O + (size_t)(row0 + ai * HALF + m * 16) * 1024 + c) = v; } }
    }
};
struct EpiGates {
    static constexpr bool PERM = false, AFTER_DRAIN = false;
    float* lru_a; float* lru_ix; const float* ba; const float* bx; const float* lam; const bf16_t* xr;
    __device__ __forceinline__ void operator()(const f32x4 (&acc)[2][2][4][2], const Unit& u, int wr, int wc, int fr, int fq) const {
        const int grp = u.pn >> 2; const int row0 = u.pm * BM + wr * 64 + fr, col0 = (u.pn & 3) * BM + wc * 32 + 4 * fq;
#pragma unroll
        for (int bj = 0; bj < 2; ++bj)
#pragma unroll
            for (int n = 0; n < 2; ++n) { const int c = col0 + bj * HALF + n * 16;
                const f32x4 bv = *(const f32x4*)((grp == 0 ? ba : bx) + c); f32x4 sp = (f32x4){0.f, 0.f, 0.f, 0.f};
                if (grp == 0) { const f32x4 l = *(const f32x4*)(lam + c);
#pragma unroll
                    for (int j = 0; j < 4; ++j) sp[j] = -8.0f * softplusf_(-l[j]); }
#pragma unroll
                for (int ai = 0; ai < 2; ++ai)
#pragma unroll
                    for (int m = 0; m < 4; ++m) { const int row = row0 + ai * HALF + m * 16; f32x4 v = acc[ai][bj][m][n] + bv;
                        if (grp == 0) {
#pragma unroll
                            for (int j = 0; j < 4; ++j) v[j] = __expf(sigmoidf_(v[j]) * sp[j]);
                            *(f32x4*)(lru_a + (size_t)row * 1024 + c) = v;
                        } else { const u32x2 xw = *(const u32x2*)(xr + (size_t)row * 1024 + c);
                            v[0] = sigmoidf_(v[0]) * bf_lo(xw.x); v[1] = sigmoidf_(v[1]) * bf_hi(xw.x); v[2] = sigmoidf_(v[2]) * bf_lo(xw.y); v[3] = sigmoidf_(v[3]) * bf_hi(xw.y);
                            *(f32x4*)(lru_ix + (size_t)row * 1024 + c) = v; } } }
    }
};

template <class Epi, class Sched, bool ALIGN_EPI = false, bool SP2 = false>
__device__ __forceinline__ void gemm_phase(PG8_LAS unsigned char* lds, const Gemm g, const Sched& S, const Epi& E) {
    const int tid = threadIdx.x, wid = __builtin_amdgcn_readfirstlane(tid >> 6), lane = tid & 63, wr = wid >> 2, wc = wid & 3, fr = lane & 15, fq = lane >> 4;
    const int K = g.K, nt = K / BK;
    unsigned voffA[2], voffB[2];
#pragma unroll
    for (int i = 0; i < 2; ++i) { int R, C; stage_rc(tid * 16 + i * 8192, R, C); const int Rb = Epi::PERM ? ((R & ~31) + perm32(R & 31)) : R;
        voffA[i] = (unsigned)(R * g.lda + C) * 2u; voffB[i] = (unsigned)(Rb * g.ldb + C) * 2u; }
    const size_t kstep = (size_t)(BK * 2);
    const size_t hstepA = (size_t)HALF * g.lda * 2, hstepB = (size_t)HALF * g.ldb * 2;
    const size_t tstepA = 2 * hstepA, tstepB = 2 * hstepB;
    const unsigned ldsw = (unsigned)wid * 1024u;
    const int aoff = lds_byte(wr * 64 + fr, fq * 8), boff = lds_byte(wc * 32 + fr, fq * 8);
#define PG8_SA(b, h) (((b) * 2 + (h)) * HTB)
#define PG8_SB(b, h) ((4 + (b) * 2 + (h)) * HTB)
#define PG8_STAGE(bufoff, gbase, voff) do { _Pragma("unroll") for (int _i = 0; _i < 2; ++_i) \
        __builtin_amdgcn_global_load_lds((const unsigned*)((const char*)(gbase) + (voff)[_i]), (PG8_LAS unsigned*)(lds + (bufoff) + ldsw + _i * 8192), 16, 0, 0); } while (0)
#define PG8_LDA(dst, b, h) do { _Pragma("unroll") for (int m = 0; m < 4; ++m) _Pragma("unroll") for (int k = 0; k < 2; ++k) dst[m][k] = *(const PG8_LAS bf16x8*)(lds + PG8_SA(b, h) + aoff + m * 2048 + k * 1024); } while (0)
#define PG8_LDB(dst, b, h) do { _Pragma("unroll") for (int n = 0; n < 2; ++n) _Pragma("unroll") for (int k = 0; k < 2; ++k) dst[n][k] = *(const PG8_LAS bf16x8*)(lds + PG8_SB(b, h) + boff + n * 2048 + k * 1024); } while (0)
#define PG8_MMA(ai, bj, At, Bt) do { __builtin_amdgcn_s_setprio(1); _Pragma("unroll") for (int m = 0; m < 4; ++m) _Pragma("unroll") for (int n = 0; n < 2; ++n) _Pragma("unroll") for (int k = 0; k < 2; ++k) \
        acc[ai][bj][m][n] = __builtin_amdgcn_mfma_f32_16x16x32_bf16(Bt[n][k], At[m][k], acc[ai][bj][m][n], 0, 0, 0); __builtin_amdgcn_s_setprio(0); } while (0)
#define PG8_WAIT_V(n) asm volatile("s_waitcnt vmcnt(" #n ")" ::: "memory")
#define PG8_WAIT_L(n) asm volatile("s_waitcnt lgkmcnt(" #n ")" ::: "memory")
#define PG8_BAR __builtin_amdgcn_s_barrier()
#define PG8_SCHED __builtin_amdgcn_sched_barrier(0)
    Unit cur, nxt; int ui = 0;
    if (!S.next(0, cur)) return;
    f32x4 acc[2][2][4][2];
#pragma unroll
    for (int a = 0; a < 2; ++a)
#pragma unroll
        for (int b = 0; b < 2; ++b)
#pragma unroll
            for (int m = 0; m < 4; ++m)
#pragma unroll
                for (int n = 0; n < 2; ++n) acc[a][b][m][n] = (f32x4){0.f, 0.f, 0.f, 0.f};
    bf16x8 At[4][2], B0[2][2], B1[2][2];
    const char* cA = (const char*)g.A + (size_t)cur.pm * tstepA + cur.aoff; const char* cB = (const char*)g.Bt + (size_t)cur.pn * tstepB + cur.boff;
    S.a_ready(cur);
    if constexpr (SP2) {
        PG8_STAGE(PG8_SB(0, 0), cB, voffB); PG8_STAGE(PG8_SB(0, 1), cB + hstepB, voffB); PG8_STAGE(PG8_SA(0, 0), cA, voffA); PG8_STAGE(PG8_SA(0, 1), cA + hstepA, voffA);
        if (wr == 1) PG8_BAR;
        PG8_WAIT_V(2); PG8_BAR;
        PG8_STAGE(PG8_SB(1, 0), cB + kstep, voffB); PG8_STAGE(PG8_SA(1, 0), cA + kstep, voffA); PG8_STAGE(PG8_SB(1, 1), cB + hstepB + kstep, voffB);
        PG8_WAIT_V(6); PG8_BAR;
    } else {
        PG8_STAGE(PG8_SB(0, 0), cB, voffB); PG8_STAGE(PG8_SA(0, 0), cA, voffA); PG8_STAGE(PG8_SB(0, 1), cB + hstepB, voffB); PG8_STAGE(PG8_SA(0, 1), cA + hstepA, voffA);
        if (wr == 1) PG8_BAR;
        PG8_WAIT_V(4); PG8_BAR;
        PG8_STAGE(PG8_SB(1, 0), cB + kstep, voffB); PG8_STAGE(PG8_SA(1, 0), cA + kstep, voffA); PG8_STAGE(PG8_SB(1, 1), cB + hstepB + kstep, voffB);
        PG8_WAIT_V(6); PG8_BAR;
    }
    for (;;) {
        const bool has_next = S.next(ui + 1, nxt);
        const char* nA = has_next ? (const char*)g.A + (size_t)nxt.pm * tstepA + nxt.aoff : cA; const char* nB = has_next ? (const char*)g.Bt + (size_t)nxt.pn * tstepB + nxt.boff : cB;
        for (int t = 0; t < nt; t += 2) {
            const bool last = (t == nt - 2);
            const char* a1 = cA + (size_t)(t + 1) * kstep;
            const char* a2 = last ? nA : cA + (size_t)(t + 2) * kstep; const char* b2 = last ? nB : cB + (size_t)(t + 2) * kstep;
            const char* a3 = a2 + kstep; const char* b3 = b2 + kstep;
            if (last && has_next) S.a_ready(nxt);
            if constexpr (SP2) {
            PG8_LDB(B0, 0, 0); PG8_LDB(B1, 0, 1); PG8_SCHED; PG8_LDA(At, 0, 0); PG8_STAGE(PG8_SA(1, 1), a1 + hstepA, voffA);
            PG8_WAIT_V(8); PG8_WAIT_L(0); PG8_BAR; PG8_MMA(0, 0, At, B0); PG8_MMA(0, 1, At, B1); PG8_BAR; PG8_SCHED;
            PG8_LDA(At, 0, 1); PG8_STAGE(PG8_SB(0, 0), b2, voffB); PG8_STAGE(PG8_SB(0, 1), b2 + hstepB, voffB); PG8_STAGE(PG8_SA(0, 0), a2, voffA);
            PG8_WAIT_V(8); PG8_WAIT_L(0); PG8_BAR; PG8_MMA(1, 0, At, B0); PG8_MMA(1, 1, At, B1); PG8_BAR; PG8_SCHED;
            PG8_LDB(B0, 1, 0); PG8_LDB(B1, 1, 1); PG8_SCHED; PG8_LDA(At, 1, 0); PG8_STAGE(PG8_SA(0, 1), a2 + hstepA, voffA);
            PG8_WAIT_V(8); PG8_WAIT_L(0); PG8_BAR; PG8_MMA(0, 0, At, B0); PG8_MMA(0, 1, At, B1); PG8_BAR; PG8_SCHED;
            PG8_LDA(At, 1, 1); PG8_STAGE(PG8_SB(1, 0), b3, voffB); PG8_STAGE(PG8_SB(1, 1), b3 + hstepB, voffB); PG8_STAGE(PG8_SA(1, 0), a3, voffA);
            PG8_WAIT_V(8); PG8_WAIT_L(0); PG8_BAR; PG8_MMA(1, 0, At, B0); PG8_MMA(1, 1, At, B1); PG8_BAR; PG8_SCHED;
            } else {
            PG8_LDB(B0, 0, 0); PG8_SCHED; PG8_LDA(At, 0, 0); PG8_STAGE(PG8_SA(1, 1), a1 + hstepA, voffA);
            PG8_WAIT_L(8); PG8_BAR; PG8_WAIT_L(0); PG8_MMA(0, 0, At, B0); PG8_BAR; PG8_SCHED;
            PG8_LDB(B1, 0, 1); PG8_STAGE(PG8_SB(0, 0), b2, voffB);
            PG8_BAR; PG8_WAIT_L(0); PG8_MMA(0, 1, At, B1); PG8_BAR;
            PG8_LDA(At, 0, 1); PG8_STAGE(PG8_SA(0, 0), a2, voffA);
            PG8_BAR; PG8_WAIT_L(0); PG8_MMA(1, 0, At, B0); PG8_BAR; PG8_SCHED;
            PG8_STAGE(PG8_SB(0, 1), b2 + hstepB, voffB);
            PG8_WAIT_V(6); PG8_BAR; PG8_MMA(1, 1, At, B1); PG8_BAR;
            PG8_LDB(B0, 1, 0); PG8_SCHED; PG8_LDA(At, 1, 0); PG8_STAGE(PG8_SA(0, 1), a2 + hstepA, voffA);
            PG8_WAIT_L(8); PG8_BAR; PG8_WAIT_L(0); PG8_MMA(0, 0, At, B0); PG8_BAR; PG8_SCHED;
            PG8_LDB(B1, 1, 1); PG8_STAGE(PG8_SB(1, 0), b3, voffB);
            PG8_BAR; PG8_WAIT_L(0); PG8_MMA(0, 1, At, B1); PG8_BAR;
            PG8_LDA(At, 1, 1); PG8_STAGE(PG8_SA(1, 0), a3, voffA);
            PG8_BAR; PG8_WAIT_L(0); PG8_MMA(1, 0, At, B0); PG8_BAR; PG8_SCHED;
            PG8_STAGE(PG8_SB(1, 1), b3 + hstepB, voffB);
            PG8_WAIT_V(6); PG8_BAR; PG8_MMA(1, 1, At, B1); PG8_BAR;
            }
        }
        if constexpr (ALIGN_EPI) { if (wr == 0) PG8_BAR; }
        if constexpr (!Epi::AFTER_DRAIN) { E(acc, cur, wr, wc, fr, fq); S.done(cur); }
        if (!has_next) break;
#pragma unroll
        for (int a = 0; a < 2; ++a)
#pragma unroll
            for (int b = 0; b < 2; ++b)
#pragma unroll
                for (int m = 0; m < 4; ++m)
#pragma unroll
                    for (int n = 0; n < 2; ++n) acc[a][b][m][n] = (f32x4){0.f, 0.f, 0.f, 0.f};
        cur = nxt; cA = nA; cB = nB; ++ui;
        if constexpr (ALIGN_EPI) { if (wr == 1) PG8_BAR; }
    }
    PG8_WAIT_V(0);
    if constexpr (!ALIGN_EPI) { if (wr == 0) PG8_BAR; }
    PG8_BAR;
    if constexpr (Epi::AFTER_DRAIN) { E.fused(acc, cur, wr, wc, fr, fq, lds, wid, lane); S.done(cur); }
#undef PG8_SA
#undef PG8_SB
#undef PG8_STAGE
#undef PG8_LDA
#undef PG8_LDB
#undef PG8_MMA
#undef PG8_WAIT_V
#undef PG8_WAIT_L
#undef PG8_BAR
#undef PG8_SCHED
}
}
#define GAS __attribute__((address_space(1)))
#define LAS __attribute__((address_space(3)))
typedef unsigned short bf16;
typedef unsigned v4u __attribute__((ext_vector_type(4)));
typedef float f32x4 __attribute__((ext_vector_type(4)));
typedef short bf16x8 __attribute__((ext_vector_type(8)));
typedef GAS unsigned gu32;
typedef GAS unsigned long long gu64;
#define RLX_AGENT __ATOMIC_RELAXED, __HIP_MEMORY_SCOPE_AGENT
#define LDS_WAIT() asm volatile("s_waitcnt lgkmcnt(0)" ::: "memory")
#define VM_WAIT() asm volatile("s_waitcnt vmcnt(0)" ::: "memory")
__device__ __forceinline__ unsigned long long rt() { return __builtin_amdgcn_s_memrealtime(); }
__device__ __forceinline__ unsigned f2bf(float f) { unsigned u = __builtin_bit_cast(unsigned, f); return (u + 0x7fffu + ((u >> 16) & 1u)) >> 16; }
__device__ __forceinline__ unsigned pk2(float lo, float hi) { return f2bf(lo) | (f2bf(hi) << 16); }

#define XB_TMO      128
#define XB_XCNT(j)  (256  + 64 * (j))
#define XB_XSUB(j)  (1280 + 64 * (j))
#define XB_XGEN(j)  (2304 + 64 * (j))
#define XB_TOP      3328
#define XB_TOPGEN   3392
#define XCD_BAR_WORDS 3456
#define XB_SPIN_CAP (1u << 18)

__device__ __forceinline__ unsigned xb_ld(unsigned* p)              { return __hip_atomic_load(p, __ATOMIC_RELAXED, __HIP_MEMORY_SCOPE_AGENT); }
__device__ __forceinline__ unsigned xb_add(unsigned* p, unsigned v) { return __hip_atomic_fetch_add(p, v, __ATOMIC_RELAXED, __HIP_MEMORY_SCOPE_AGENT); }
__device__ __forceinline__ unsigned xb_xcc_id() { return (unsigned)__builtin_amdgcn_s_getreg((3 << 11) | 20) & 0xFu; }
#define XB_SPIN(cond, bar) do { unsigned _sp = 0; while (cond) { __builtin_amdgcn_s_sleep(1); \
    if ((++_sp & 255u) == 0u) { if (xb_ld(&(bar)[XB_TMO])) break; if (_sp > XB_SPIN_CAP) { atomicAdd(&(bar)[XB_TMO], 1u); break; } } } } while (0)

struct XcdBarrier {
    unsigned* bar; unsigned x;
    volatile LAS unsigned* st;
};

__device__ __forceinline__ XcdBarrier xcd_barrier_post(unsigned* bar, volatile LAS unsigned* st) {
    XcdBarrier b; b.bar = bar; b.x = xb_xcc_id(); b.st = st;
    if (threadIdx.x == 0) (void)xb_add(&bar[XB_XCNT(b.x)], 1u);
    return b;
}
__device__ __forceinline__ void xcd_barrier_complete(unsigned* bar, unsigned x, unsigned& nloc, unsigned& nx) {
    const unsigned G = gridDim.x * gridDim.y * gridDim.z;
    unsigned sum, cnt, mine, sp = 0u;
    for (;;) {
        sum = 0u; cnt = 0u; mine = 0u;
#pragma unroll
        for (unsigned j = 0; j < 16; ++j) { const unsigned c = xb_ld(&bar[XB_XCNT(j)]); sum += c; cnt += (c > 0u) ? 1u : 0u; mine = (j == x) ? c : mine; }
        if (sum == G) break;
        __builtin_amdgcn_s_sleep(1);
        if ((++sp & 255u) == 0u) { if (xb_ld(&bar[XB_TMO])) break; if (sp > XB_SPIN_CAP) { atomicAdd(&bar[XB_TMO], 1u); break; } }
    }
    nloc = mine > 0u ? mine : 1u; nx = cnt > 0u ? cnt : 1u;
}

__device__ __forceinline__ void xcd_barrier(const XcdBarrier& b) {
    asm volatile("s_waitcnt vmcnt(0)" ::: "memory");
    __syncthreads();
    if (threadIdx.x == 0) {
        unsigned* bar = b.bar;
        __builtin_amdgcn_s_waitcnt(0);
        unsigned nloc = b.st[0], nx = b.st[1];
        if (nloc == 0u) { xcd_barrier_complete(bar, b.x, nloc, nx); b.st[0] = nloc; b.st[1] = nx; }
        const unsigned old = xb_add(&bar[XB_XSUB(b.x)], 1u);
        const unsigned gen = old / nloc;
        if (old + 1u == (gen + 1u) * nloc) {
            __builtin_amdgcn_fence(__ATOMIC_RELEASE, "agent");
            asm volatile("s_waitcnt vmcnt(0)" ::: "memory");
            const unsigned og = xb_add(&bar[XB_TOP], 1u);
            const unsigned tg = og / nx;
            if (og + 1u == (tg + 1u) * nx) xb_add(&bar[XB_TOPGEN], 1u);
            else XB_SPIN(xb_ld(&bar[XB_TOPGEN]) == tg, bar);
            __builtin_amdgcn_fence(__ATOMIC_ACQUIRE, "agent");
            xb_add(&bar[XB_XGEN(b.x)], 1u);
            asm volatile("s_waitcnt vmcnt(0)" ::: "memory");
        } else {
            XB_SPIN(xb_ld(&bar[XB_XGEN(b.x)]) == gen, bar);
            __builtin_amdgcn_fence(__ATOMIC_ACQUIRE, "agent");
            asm volatile("s_waitcnt vmcnt(0)" ::: "memory");
        }
    }
    __syncthreads();
}

constexpr int NWAVES = 8;
constexpr int DM = 2048, TX = 8192, NMETA = 16, TT = TX + NMETA, MP = 8448;
constexpr int EV_NP = 5632, EV_LORA0 = 3072, EV_GB = 3360, EV_REC = 4384;
constexpr int OD_NP = 12544, OD_Z = 8192, OD_B = 12288, OD_A = 12320;
constexpr int NEXP = 32, FF = 512, MOE_ROWS = 24576;
constexpr float NORM_EPS = 1e-6f;

constexpr size_t MiB = 1u << 20;
constexpr size_t WS_CTL = 0, CTL_ZERO_BYTES = 1 * MiB;
constexpr size_t WS_TOKINFO = 1 * MiB;
constexpr size_t WS_TILES = 1 * MiB + 512 * 1024;
constexpr size_t WS_WEVIN = 2 * MiB;
constexpr size_t WS_WEVOUT = 24 * MiB;
constexpr size_t WS_WODIN = 32 * MiB;
constexpr size_t WS_WODOUT = 81 * MiB;
constexpr size_t WS_WLORA = 97 * MiB;
constexpr size_t WS_WGATE = 100 * MiB;
constexpr size_t WS_WROUTE = 101 * MiB;
constexpr size_t WS_MOEW = 102 * MiB;
constexpr size_t MOE_E_BYTES = 6 * MiB, MOE_W2_OFF = 4 * MiB;
constexpr size_t WS_H = 294 * MiB;
constexpr size_t WS_HN = 360 * MiB;
constexpr size_t WS_YMIX = 393 * MiB;
constexpr size_t WS_PROJ = 459 * MiB;
constexpr size_t WS_SCR = 662 * MiB;
constexpr size_t WS_END = 932 * MiB;
constexpr size_t SC_ALORA = 0;
constexpr size_t SC_XR = 8 * MiB;
constexpr size_t SC_DEC = 26 * MiB, SC_ICL = 60 * MiB, SC_GATE = 94 * MiB;
constexpr size_t SC_LA = 128 * MiB, SC_LIX = 162 * MiB;
constexpr size_t SC_QN = 0, SC_KN = 34 * MiB;
constexpr size_t SC_VC = 68 * MiB;
constexpr size_t SC_BETA = 134 * MiB, SC_G = 136 * MiB;
constexpr size_t SC_O = 138 * MiB;
constexpr size_t SC_XG = 0;
constexpr size_t SC_ACT = 96 * MiB;
constexpr size_t SC_YB = 120 * MiB;
static_assert(SC_O + (size_t)MP * 4096 * 4 <= WS_END - WS_SCR && SC_YB + (size_t)MOE_ROWS * 2048 * 2 <= WS_END - WS_SCR && SC_LIX + (size_t)MP * 1024 * 4 <= WS_END - WS_SCR, "scratch map");
constexpr int CW_TMO = 0, CW_CODE = 1;
constexpr int CW_BAR = 4096;
constexpr int CW_PROG = 20480;
constexpr int CW_TS = 24576;
constexpr int CW_MOECNT = 16384;

constexpr int RING_OFF = 0, RING_BYTES = 131072;
constexpr int LDSCTL_OFF = 146944, MISC_OFF = LDSCTL_OFF + 320;
constexpr int LDS_BYTES = 147456;


#define DI __device__ __forceinline__
typedef unsigned v2u __attribute__((ext_vector_type(2)));
struct Args { const float* in[36]; float* out; unsigned char* ws; int ph_lo, ph_hi; };
struct Frame {
    LAS unsigned char* lds; volatile LAS unsigned* MISC; gu32* ctl;
    int tid, lane, wave, vcu, G, gw, NGW;
};
DI float bf2f(bf16 v) { return __uint_as_float((unsigned)v << 16); }
DI float bflo(unsigned w) { return __uint_as_float(w << 16); }
DI float bfhi(unsigned w) { return __uint_as_float(w & 0xffff0000u); }
DI float wave_sum(float v) {
#pragma unroll
    for (int o = 1; o < 64; o <<= 1) v += __shfl_xor(v, o);
    return v;
}
DI float sigm(float x) { return 1.0f / (1.0f + __expf(-x)); }
DI float softplus(float x) { return fmaxf(x, 0.f) + __logf(1.0f + __expf(-fabsf(x))); }
DI float gelu_tanh(float x) { const float u = 0.7978845608028654f * (x + 0.044715f * x * x * x); return 0.5f * x * (1.0f + tanhf(u)); }
DI int pos_row(int p) { return p < NMETA ? TX + p : p - NMETA; }
DI int row_pos(int r) { return r < TX ? r + NMETA : r - TX; }

DI void tr_item(const float* W, int N, int k0, int n0, bf16* WT, int ldk, int drow0, LAS float* scr, int lane) {
#pragma unroll 8
    for (int i = 0; i < 32; ++i) { const int kk = 2 * i + (lane >> 5); scr[kk * 33 + (lane & 31)] = W[(size_t)(k0 + kk) * N + n0 + (lane & 31)]; }
    LDS_WAIT(); asm volatile("" ::: "memory");
    const int c = lane & 7;
#pragma unroll
    for (int j = 0; j < 4; ++j) { const int n = (lane >> 3) + 8 * j; const LAS float* s = scr + (8 * c) * 33 + n;
        v4u o; o.x = pk2(s[0 * 33], s[1 * 33]); o.y = pk2(s[2 * 33], s[3 * 33]); o.z = pk2(s[4 * 33], s[5 * 33]); o.w = pk2(s[6 * 33], s[7 * 33]);
        *(v4u*)(WT + (size_t)(drow0 + n) * ldk + k0 + 8 * c) = o; }
    LDS_WAIT(); asm volatile("" ::: "memory");
}
DI void moe_convert(const Frame& F, const Args& a, int l, int gw, int ngw) {
    LAS float* scr = (LAS float*)(F.lds + RING_OFF + F.wave * 16384);
    bf16* base = (bf16*)(a.ws + WS_MOEW);
    for (int it = gw; it < NEXP * 1536; it += ngw) {
        const int e = it / 1536; int j = it % 1536; bf16* eb = base + (size_t)e * (MOE_E_BYTES / 2);
        const size_t eoff = (size_t)(l * NEXP + e) * DM * FF;
        if (j < 1024) { const float* W = (j < 512 ? a.in[33] : a.in[34]) + eoff; const int hi = j >= 512; j &= 511; const int kb = j >> 4, nb = j & 15, n0 = 32 * nb;
            tr_item(W, FF, 64 * kb, n0, eb, DM, 256 * (n0 >> 7) + 128 * hi + (n0 & 127), scr, F.lane); }
        else { j -= 1024; const int kb = j >> 6, nb = j & 63; tr_item(a.in[35] + eoff, DM, 64 * kb, 32 * nb, eb + MOE_W2_OFF / 2, FF, 32 * nb, scr, F.lane); }
    }
}
DI void norm_row_bf16(int lane, const float* src, const float* w, bf16* dst) {
    f32x4 v[8]; float s = 0.f;
#pragma unroll
    for (int j = 0; j < 8; ++j) { v[j] = ((const f32x4*)src)[lane + 64 * j]; s += (v[j].x * v[j].x + v[j].y * v[j].y) + (v[j].z * v[j].z + v[j].w * v[j].w); }
    const float rs = 1.0f / sqrtf(wave_sum(s) * (1.0f / DM) + NORM_EPS);
#pragma unroll
    for (int j = 0; j < 8; ++j) { const f32x4 wv = ((const f32x4*)w)[lane + 64 * j]; v2u o; o.x = pk2(v[j].x * rs * wv.x, v[j].y * rs * wv.y); o.y = pk2(v[j].z * rs * wv.z, v[j].w * rs * wv.w);
        ((v2u*)dst)[lane + 64 * j] = o; }
}

DI void ph_prologue(const Frame& F, const Args& a) {
    LAS float* scr = (LAS float*)(F.lds + RING_OFF + F.wave * 16384);
    constexpr int I_A = 32 * 169, I_B = 32 * 64, NIT = I_A + I_B;
    for (int it = F.gw; it < NIT; it += F.NGW) {
        int r = it;
        if (r < I_A) { const int kb = r / 169, nb = r % 169; tr_item(a.in[5], 5408, 64 * kb, 32 * nb, (bf16*)(a.ws + WS_WEVIN), DM, 32 * nb, scr, F.lane); continue; } r -= I_A;
        { const int kb = r / 64, nb = r % 64; tr_item(a.in[24], DM, 64 * kb, 32 * nb, (bf16*)(a.ws + WS_WEVOUT), DM, 32 * nb, scr, F.lane); }
    }
    const int gt = F.vcu * (NWAVES * 64) + F.tid, NGT = F.G * NWAVES * 64;
    { bf16* WL = (bf16*)(a.ws + WS_WLORA); const float* wup = a.in[8]; const float* aup = a.in[10]; const float* gup = a.in[11];
      for (int idx = gt; idx < 3072 * 384; idx += NGT) { const int n = idx / 384, k = idx % 384; float v = 0.f;
          if (n < 1024) { if (k < 64) v = wup[k * 1024 + n]; }
          else if (n < 2048) { if (k >= 64 && k < 128) v = aup[(k - 64) * 1024 + n - 1024]; }
          else { if (k >= 128 && k < 288) v = gup[(k - 128) * 1024 + n - 2048]; }
          WL[idx] = (bf16)f2bf(v); } }
    { bf16* WG = (bf16*)(a.ws + WS_WGATE);
      for (int idx = gt; idx < 2048 * 256; idx += NGT) { const int n = idx >> 8, kk = idx & 255, nn = n & 1023, blk = nn >> 6, j = nn & 63, cin = (nn & ~255) + kk;
          const float* W = n < 1024 ? a.in[19] : a.in[21];
          const float v = (cin >> 6) == blk ? W[blk * 4096 + (cin & 63) * 64 + j] : 0.f;
          WG[idx] = (bf16)f2bf(v); } }
    { bf16* WR = (bf16*)(a.ws + WS_WROUTE);
      for (int idx = gt; idx < 2 * 48 * DM; idx += NGT) { const int l = idx / (48 * DM), n = (idx / DM) % 48, k = idx % DM; float v = 0.f;
          if (n < 32) v = a.in[32][((size_t)l * DM + k) * NEXP + n]; else if (n < 36) v = a.in[31][((size_t)l * DM + k) * 4 + n - 32];
          const unsigned hi = f2bf(v); WR[((size_t)(l * 2) * 48 + n) * DM + k] = (bf16)hi; WR[((size_t)(l * 2 + 1) * 48 + n) * DM + k] = (bf16)f2bf(v - __uint_as_float(hi << 16)); } }
    bf16* HN = (bf16*)(a.ws + WS_HN);
    for (int r = F.gw; r < TT; r += F.NGW) norm_row_bf16(F.lane, r < TX ? a.in[0] + (size_t)r * DM : a.in[1] + (size_t)(r - TX) * DM, a.in[2], HN + (size_t)r * DM);
}

DI void ph_aux_convert(const Frame& F, const Args& a, int gw, int ngw) {
    LAS float* scr = (LAS float*)(F.lds + RING_OFF + F.wave * 16384);
    constexpr int I_C = 32 * 386, I_D = 64 * 64, NIT = I_C + I_D;
    for (int it = gw; it < NIT; it += ngw) {
        int r = it;
        if (r < I_C) { const int kb = r / 386, nb = r % 386; tr_item(a.in[25], 12352, 64 * kb, 32 * nb, (bf16*)(a.ws + WS_WODIN), DM, 32 * nb, scr, F.lane); continue; } r -= I_C;
        { const int kb = r / 64, nb = r % 64; tr_item(a.in[30], DM, 64 * kb, 32 * nb, (bf16*)(a.ws + WS_WODOUT), 4096, 32 * nb, scr, F.lane); }
    }
    moe_convert(F, a, 0, gw, ngw);
}

DI void ph_even_prep(const Frame& F, const Args& a) {
    const bf16* P = (const bf16*)(a.ws + WS_PROJ); bf16* AL = (bf16*)(a.ws + WS_SCR + SC_ALORA); bf16* XR = (bf16*)(a.ws + WS_SCR + SC_XR);
    const float* mu = a.in[6]; const float* cw = a.in[17]; const float* cb = a.in[18];
    const int lane = F.lane;
    for (int item = F.gw; item < TT + (TT / 8) * 2; item += F.NGW) {
        if (item < TT) { const int r = item, pos = row_pos(r); const bf16* cur = P + (size_t)r * EV_NP; const bf16* prv = P + (size_t)pos_row(pos > 0 ? pos - 1 : 0) * EV_NP; const float pm = pos > 0 ? 1.f : 0.f;
            float cv[6], pv[6], mv[6];
#pragma unroll
            for (int i = 0; i < 6; ++i) { const int idx = lane + 64 * i, col = EV_LORA0 + (idx < 288 ? idx : 287); cv[i] = bf2f(cur[col]); pv[i] = bf2f(prv[col]) * pm; mv[i] = mu[col]; }
#pragma unroll
            for (int i = 0; i < 6; ++i) { const int idx = lane + 64 * i; float v = cv[i] + (pv[i] - cv[i]) * mv[i];
                if (idx < 64) v = tanhf(v); else if (idx >= 128) v = sigm(v);
                AL[(size_t)r * 384 + idx] = (bf16)f2bf(idx < 288 ? v : 0.f); }
        } else { const int it2 = item - TT, pb = it2 >> 1, c0 = (it2 & 1) * 512 + lane * 8, p0 = pb * 8;
            f32x4 w[4][2], b0 = *(const f32x4*)(cb + c0), b1 = *(const f32x4*)(cb + c0 + 4);
#pragma unroll
            for (int j = 0; j < 4; ++j) { w[j][0] = *(const f32x4*)(cw + j * 1024 + c0); w[j][1] = *(const f32x4*)(cw + j * 1024 + c0 + 4); }
            v4u x[11];
#pragma unroll
            for (int i = 0; i < 11; ++i) { const int p = p0 - 3 + i; x[i] = *(const v4u*)(P + (size_t)pos_row(p > 0 ? p : 0) * EV_NP + EV_REC + c0); if (p < 0) x[i] = (v4u){0u, 0u, 0u, 0u}; }
#pragma unroll
            for (int o = 0; o < 8; ++o) { float acc[8] = {b0.x, b0.y, b0.z, b0.w, b1.x, b1.y, b1.z, b1.w};
#pragma unroll
                for (int j = 0; j < 4; ++j) { const v4u xv = x[o + j];
                    acc[0] += w[j][0].x * bflo(xv.x); acc[1] += w[j][0].y * bfhi(xv.x); acc[2] += w[j][0].z * bflo(xv.y); acc[3] += w[j][0].w * bfhi(xv.y);
                    acc[4] += w[j][1].x * bflo(xv.z); acc[5] += w[j][1].y * bfhi(xv.z); acc[6] += w[j][1].z * bflo(xv.w); acc[7] += w[j][1].w * bfhi(xv.w); }
                *(v4u*)(XR + (size_t)pos_row(p0 + o) * 1024 + c0) = (v4u){pk2(acc[0], acc[1]), pk2(acc[2], acc[3]), pk2(acc[4], acc[5]), pk2(acc[6], acc[7])}; } }
    }
}

DI void ph_route(const Frame& F, const Args& a, int l, int dummy) {
    const float* H = (const float*)(a.ws + WS_H); const float* nw = a.in[3] + (size_t)l * DM;
    const bf16* WH = (const bf16*)(a.ws + WS_WROUTE) + (size_t)(l * 2) * 48 * DM; const bf16* WL = WH + (size_t)48 * DM;
    unsigned* TI = (unsigned*)(a.ws + WS_TOKINFO) + (dummy ? (WS_SCR + 250 * MiB - WS_TOKINFO) / 4 : 0); const int lane = F.lane, lc = lane & 15, quad = lane >> 4; const int cl = dummy ? l + 2 : l;
    LAS float* scr = (LAS float*)(F.lds + RING_OFF + F.wave * 16384);
    for (int task = F.gw; task < TT / 16; task += F.NGW) {
        const int r = task * 16 + lc; const float* hr = H + (size_t)r * DM + 8 * quad; float ss = 0.f;
#pragma unroll 8
        for (int ks = 0; ks < 64; ++ks) { const f32x4 x0 = *(const f32x4*)(hr + 32 * ks), x1 = *(const f32x4*)(hr + 32 * ks + 4); ss += (x0.x * x0.x + x0.y * x0.y) + (x0.z * x0.z + x0.w * x0.w) + (x1.x * x1.x + x1.y * x1.y) + (x1.z * x1.z + x1.w * x1.w); }
        ss += __shfl_xor(ss, 16); ss += __shfl_xor(ss, 32);
        const float rs = 1.0f / sqrtf(ss * (1.0f / DM) + NORM_EPS);
        f32x4 acc[3];
#pragma unroll
        for (int nt = 0; nt < 3; ++nt) acc[nt] = (f32x4){0.f, 0.f, 0.f, 0.f};
#pragma unroll 2
        for (int ks = 0; ks < 64; ++ks) { const int k0 = 32 * ks + 8 * quad; const f32x4 x0 = *(const f32x4*)(hr + 32 * ks), x1 = *(const f32x4*)(hr + 32 * ks + 4), w0 = *(const f32x4*)(nw + k0), w1 = *(const f32x4*)(nw + k0 + 4);
            const float xn[8] = {x0.x * rs * w0.x, x0.y * rs * w0.y, x0.z * rs * w0.z, x0.w * rs * w0.w, x1.x * rs * w1.x, x1.y * rs * w1.y, x1.z * rs * w1.z, x1.w * rs * w1.w};
            unsigned hi[8]; float lo[8];
#pragma unroll
            for (int q = 0; q < 8; ++q) { hi[q] = f2bf(xn[q]); lo[q] = xn[q] - __uint_as_float(hi[q] << 16); }
            const v4u ah4 = (v4u){hi[0] | (hi[1] << 16), hi[2] | (hi[3] << 16), hi[4] | (hi[5] << 16), hi[6] | (hi[7] << 16)}, al4 = (v4u){pk2(lo[0], lo[1]), pk2(lo[2], lo[3]), pk2(lo[4], lo[5]), pk2(lo[6], lo[7])};
            const bf16x8 ah = __builtin_bit_cast(bf16x8, ah4), al = __builtin_bit_cast(bf16x8, al4);
#pragma unroll
            for (int nt = 0; nt < 3; ++nt) { const bf16x8 bh = *(const bf16x8*)(WH + (size_t)(16 * nt + lc) * DM + k0), bl = *(const bf16x8*)(WL + (size_t)(16 * nt + lc) * DM + k0);
                acc[nt] = __builtin_amdgcn_mfma_f32_16x16x32_bf16(al, bh, acc[nt], 0, 0, 0); acc[nt] = __builtin_amdgcn_mfma_f32_16x16x32_bf16(ah, bl, acc[nt], 0, 0, 0); acc[nt] = __builtin_amdgcn_mfma_f32_16x16x32_bf16(ah, bh, acc[nt], 0, 0, 0); } }
#pragma unroll
        for (int nt = 0; nt < 3; ++nt)
#pragma unroll
            for (int q = 0; q < 4; ++q) scr[(4 * quad + q) * 49 + 16 * nt + lc] = acc[nt][q];
        asm volatile("s_waitcnt lgkmcnt(0)" ::: "memory"); __builtin_amdgcn_wave_barrier();
        if (lane < 16) { float lg[36];
#pragma unroll
            for (int i = 0; i < 36; ++i) lg[i] = scr[lane * 49 + i];
            int gi = 0; float gm = lg[32];
#pragma unroll
            for (int i = 1; i < 4; ++i) if (lg[32 + i] > gm) { gm = lg[32 + i]; gi = i; }
            float den = 0.f;
#pragma unroll
            for (int i = 0; i < 4; ++i) den += __expf(lg[32 + i] - gm);
            const float gp = 1.0f / den;
            float l8[8];
#pragma unroll
            for (int i = 0; i < 8; ++i) l8[i] = gi == 0 ? lg[i] : (gi == 1 ? lg[8 + i] : (gi == 2 ? lg[16 + i] : lg[24 + i]));
            int i1 = 0; float m1 = l8[0];
#pragma unroll
            for (int i = 1; i < 8; ++i) if (l8[i] > m1) { m1 = l8[i]; i1 = i; }
            int i2 = -1; float m2 = -INFINITY;
#pragma unroll
            for (int i = 0; i < 8; ++i) if (i != i1 && l8[i] > m2) { m2 = l8[i]; i2 = i; }
            const float e21 = __expf(m2 - m1); const float w1 = gp / (1.0f + e21), w2 = gp * e21 / (1.0f + e21);
            const int ea = gi * 8 + i1, eb = gi * 8 + i2;
            const unsigned sa = atomicAdd((unsigned*)(F.ctl + CW_MOECNT + (cl * NEXP + ea) * 16), 1u), sb = atomicAdd((unsigned*)(F.ctl + CW_MOECNT + (cl * NEXP + eb) * 16), 1u);
            unsigned* t = TI + (size_t)r * 8; *(v4u*)t = (v4u){(unsigned)ea, sa, __float_as_uint(w1), (unsigned)eb}; *(v4u*)(t + 4) = (v4u){sb, __float_as_uint(w2), __float_as_uint(rs), 0u}; }
        __builtin_amdgcn_wave_barrier(); asm volatile("" ::: "memory");
    }
}
DI void moe_prefix(const Frame& F, int l, LAS int* ps) {
    if (F.tid == 0) { int t = 0;
        for (int e = 0; e < NEXP; ++e) { const unsigned c = __hip_atomic_load(F.ctl + CW_MOECNT + (l * NEXP + e) * 16, RLX_AGENT); ps[e] = t * 256; t += (int)((c + 255u) >> 8); }
        ps[32] = t; }
    __syncthreads();
}
DI void ph_gather(const Frame& F, const Args& a, int l) {
    LAS int* ps = (LAS int*)(F.lds + RING_OFF); moe_prefix(F, l, ps);
    if (F.vcu == 0 && F.tid < NEXP) { int* TE = (int*)(a.ws + WS_TILES); const int e = F.tid; const int t0 = ps[e] >> 8, t1 = (e == NEXP - 1 ? ps[32] : ps[e + 1] >> 8);
        for (int t = t0; t < t1; ++t) TE[t] = e; if (e == 0) TE[127] = ps[32]; }
    const float* H = (const float*)(a.ws + WS_H); const float* nw = a.in[3] + (size_t)l * DM; unsigned* TI = (unsigned*)(a.ws + WS_TOKINFO); bf16* XG = (bf16*)(a.ws + WS_SCR + SC_XG);
    const int lane = F.lane;
    for (int r = F.gw; r < TT; r += F.NGW) {
        unsigned* t = TI + (size_t)r * 8; const int g0 = ps[t[0]] + (int)t[1], g1 = ps[t[3]] + (int)t[4]; const float rs = __uint_as_float(t[6]);
        if (lane == 0) { t[1] = (unsigned)g0; t[4] = (unsigned)g1; }
        const float* hr = H + (size_t)r * DM;
#pragma unroll
        for (int j = 0; j < 4; ++j) { const int e0 = (lane + 64 * j) * 8; const f32x4 x0 = *(const f32x4*)(hr + e0), x1 = *(const f32x4*)(hr + e0 + 4), w0 = *(const f32x4*)(nw + e0), w1 = *(const f32x4*)(nw + e0 + 4);
            v4u o; o.x = pk2(x0.x * rs * w0.x, x0.y * rs * w0.y); o.y = pk2(x0.z * rs * w0.z, x0.w * rs * w0.w); o.z = pk2(x1.x * rs * w1.x, x1.y * rs * w1.y); o.w = pk2(x1.z * rs * w1.z, x1.w * rs * w1.w);
            *(v4u*)(XG + (size_t)g0 * DM + e0) = o; *(v4u*)(XG + (size_t)g1 * DM + e0) = o; }
    }
}
DI void ph_combine(const Frame& F, const Args& a, int l) {
    float* H = (float*)(a.ws + WS_H); const unsigned* TI = (const unsigned*)(a.ws + WS_TOKINFO); const bf16* YB = (const bf16*)(a.ws + WS_SCR + SC_YB); bf16* HN = (bf16*)(a.ws + WS_HN);
    const int lane = F.lane; const int nrows = l == 0 ? TT : TX;
    for (int r = F.gw; r < nrows; r += F.NGW) {
        const unsigned* t = TI + (size_t)r * 8; const int g0 = (int)t[1], g1 = (int)t[4]; const float w0 = __uint_as_float(t[2]), w1 = __uint_as_float(t[5]);
        float* hr = H + (size_t)r * DM; float hv[32]; float s = 0.f;
#pragma unroll
        for (int j = 0; j < 4; ++j) { const int e0 = (lane + 64 * j) * 8; const f32x4 x0 = *(const f32x4*)(hr + e0), x1 = *(const f32x4*)(hr + e0 + 4);
            const v4u ya = *(const v4u*)(YB + (size_t)g0 * DM + e0), yc = *(const v4u*)(YB + (size_t)g1 * DM + e0);
            float* o = hv + 8 * j;
            o[0] = x0.x + w0 * bflo(ya.x) + w1 * bflo(yc.x); o[1] = x0.y + w0 * bfhi(ya.x) + w1 * bfhi(yc.x); o[2] = x0.z + w0 * bflo(ya.y) + w1 * bflo(yc.y); o[3] = x0.w + w0 * bfhi(ya.y) + w1 * bfhi(yc.y);
            o[4] = x1.x + w0 * bflo(ya.z) + w1 * bflo(yc.z); o[5] = x1.y + w0 * bfhi(ya.z) + w1 * bfhi(yc.z); o[6] = x1.z + w0 * bflo(ya.w) + w1 * bflo(yc.w); o[7] = x1.w + w0 * bfhi(ya.w) + w1 * bfhi(yc.w);
#pragma unroll
            for (int q = 0; q < 8; ++q) s += o[q] * o[q]; }
        const float rs = 1.0f / sqrtf(wave_sum(s) * (1.0f / DM) + NORM_EPS);
        if (l == 0) { const float* nw = a.in[2] + DM;
#pragma unroll
            for (int j = 0; j < 4; ++j) { const int e0 = (lane + 64 * j) * 8; const float* o = hv + 8 * j; const f32x4 wa = *(const f32x4*)(nw + e0), wb = *(const f32x4*)(nw + e0 + 4);
                *(f32x4*)(hr + e0) = (f32x4){o[0], o[1], o[2], o[3]}; *(f32x4*)(hr + e0 + 4) = (f32x4){o[4], o[5], o[6], o[7]};
                v4u p; p.x = pk2(o[0] * rs * wa.x, o[1] * rs * wa.y); p.y = pk2(o[2] * rs * wa.z, o[3] * rs * wa.w); p.z = pk2(o[4] * rs * wb.x, o[5] * rs * wb.y); p.w = pk2(o[6] * rs * wb.z, o[7] * rs * wb.w);
                *(v4u*)(HN + (size_t)r * DM + e0) = p; }
        } else { const float* nw = a.in[4]; float* orow = a.out + (size_t)r * DM;
#ifdef PROBE_TS
            { const unsigned long long* ts = (const unsigned long long*)(F.ctl + CW_TS); const float dt_us = (float)(__hip_atomic_load(ts + PROBE_TS + 1, RLX_AGENT) - __hip_atomic_load(ts + PROBE_TS, RLX_AGENT)) * 0.01f;
#pragma unroll
              for (int q = 0; q < 32; ++q) hv[q] *= 1.0f + dt_us * 0.01f; }
#endif
#pragma unroll
            for (int j = 0; j < 4; ++j) { const int e0 = (lane + 64 * j) * 8; const float* o = hv + 8 * j; const f32x4 wa = *(const f32x4*)(nw + e0), wb = *(const f32x4*)(nw + e0 + 4);
                *(f32x4*)(orow + e0) = (f32x4){o[0] * rs * wa.x, o[1] * rs * wa.y, o[2] * rs * wa.z, o[3] * rs * wa.w};
                *(f32x4*)(orow + e0 + 4) = (f32x4){o[4] * rs * wb.x, o[5] * rs * wb.y, o[6] * rs * wb.z, o[7] * rs * wb.w}; } }
    }
}

DI void ph_odd_prep(const Frame& F, const Args& a) {
    const bf16* P = (const bf16*)(a.ws + WS_PROJ); bf16* QN = (bf16*)(a.ws + WS_SCR + SC_QN); bf16* KN = (bf16*)(a.ws + WS_SCR + SC_KN); bf16* VC = (bf16*)(a.ws + WS_SCR + SC_VC);
    float* BETA = (float*)(a.ws + WS_SCR + SC_BETA); float* GG = (float*)(a.ws + WS_SCR + SC_G);
    const float* cw = a.in[26]; const int lane = F.lane;
    for (int item = F.gw; item < (TT / 8) * 16; item += F.NGW) { const int pb = item >> 4, i = item & 15, ch = i * 512 + lane * 8, p0 = pb * 8;
        f32x4 w[4][2];
#pragma unroll
        for (int j = 0; j < 4; ++j) { w[j][0] = *(const f32x4*)(cw + j * 8192 + ch); w[j][1] = *(const f32x4*)(cw + j * 8192 + ch + 4); }
        v4u x[11];
#pragma unroll
        for (int q = 0; q < 11; ++q) { const int p = p0 - 3 + q; x[q] = *(const v4u*)(P + (size_t)pos_row(p > 0 ? p : 0) * OD_NP + ch); if (p < 0) x[q] = (v4u){0u, 0u, 0u, 0u}; }
#pragma unroll
        for (int o = 0; o < 8; ++o) { const int r = pos_row(p0 + o); float acc[8] = {0.f, 0.f, 0.f, 0.f, 0.f, 0.f, 0.f, 0.f};
#pragma unroll
            for (int j = 0; j < 4; ++j) { const v4u xv = x[o + j];
                acc[0] += w[j][0].x * bflo(xv.x); acc[1] += w[j][0].y * bfhi(xv.x); acc[2] += w[j][0].z * bflo(xv.y); acc[3] += w[j][0].w * bfhi(xv.y);
                acc[4] += w[j][1].x * bflo(xv.z); acc[5] += w[j][1].y * bfhi(xv.z); acc[6] += w[j][1].z * bflo(xv.w); acc[7] += w[j][1].w * bfhi(xv.w); }
            float ss = 0.f;
#pragma unroll
            for (int q = 0; q < 8; ++q) { acc[q] = acc[q] * sigm(acc[q]); ss += acc[q] * acc[q]; }
            float sc = 1.0f;
            if (i < 8) { ss += __shfl_xor(ss, 1); ss += __shfl_xor(ss, 2); ss += __shfl_xor(ss, 4); ss += __shfl_xor(ss, 8);
                sc = (1.0f / sqrtf(ss + NORM_EPS)) * (i < 4 ? 0.08838834764831845f : 1.0f); }
            const v4u ov = (v4u){pk2(acc[0] * sc, acc[1] * sc), pk2(acc[2] * sc, acc[3] * sc), pk2(acc[4] * sc, acc[5] * sc), pk2(acc[6] * sc, acc[7] * sc)};
            bf16* dst = i < 4 ? QN + (size_t)r * 2048 + ch : (i < 8 ? KN + (size_t)r * 2048 + ch - 2048 : VC + (size_t)r * 4096 + ch - 4096);
            *(v4u*)dst = ov; }
        if (i == 0 && lane < 32) {
#pragma unroll
            for (int o = 0; o < 8; ++o) { const int r = pos_row(p0 + o); const float bb = bf2f(P[(size_t)r * OD_NP + OD_B + lane]), aa = bf2f(P[(size_t)r * OD_NP + OD_A + lane]);
                BETA[(size_t)r * 32 + lane] = sigm(bb); GG[(size_t)r * 32 + lane] = -__expf(a.in[27][lane]) * softplus(aa + a.in[28][lane]); } }
    }
}
DI void ph_odd_post(const Frame& F, const Args& a) {
    const bf16* P = (const bf16*)(a.ws + WS_PROJ); const bf16* O = (const bf16*)(a.ws + WS_SCR + SC_O); bf16* Y = (bf16*)(a.ws + WS_YMIX); const float* nw = a.in[29];
    const int lane = F.lane;
    for (int r = F.gw; r < TT; r += F.NGW) {
#pragma unroll 2
        for (int i = 0; i < 8; ++i) { const int ch = i * 512 + lane * 8; const v4u ow = *(const v4u*)(O + (size_t)r * 4096 + ch); const f32x4 o0 = (f32x4){bflo(ow.x), bfhi(ow.x), bflo(ow.y), bfhi(ow.y)}, o1 = (f32x4){bflo(ow.z), bfhi(ow.z), bflo(ow.w), bfhi(ow.w)};
            float ss = (o0.x * o0.x + o0.y * o0.y) + (o0.z * o0.z + o0.w * o0.w) + (o1.x * o1.x + o1.y * o1.y) + (o1.z * o1.z + o1.w * o1.w);
            ss += __shfl_xor(ss, 1); ss += __shfl_xor(ss, 2); ss += __shfl_xor(ss, 4); ss += __shfl_xor(ss, 8);
            const float rs = 1.0f / sqrtf(ss * (1.0f / 128.0f) + NORM_EPS);
            const v4u z = *(const v4u*)(P + (size_t)r * OD_NP + OD_Z + ch); const int c0 = ch & 127; const f32x4 w0 = *(const f32x4*)(nw + c0), w1 = *(const f32x4*)(nw + c0 + 4);
            const float zf[8] = {bflo(z.x), bfhi(z.x), bflo(z.y), bfhi(z.y), bflo(z.z), bfhi(z.z), bflo(z.w), bfhi(z.w)};
            const float of[8] = {o0.x * w0.x, o0.y * w0.y, o0.z * w0.z, o0.w * w0.w, o1.x * w1.x, o1.y * w1.y, o1.z * w1.z, o1.w * w1.w};
            float y[8];
#pragma unroll
            for (int q = 0; q < 8; ++q) y[q] = of[q] * rs * zf[q] * sigm(zf[q]);
            v4u p; p.x = pk2(y[0], y[1]); p.y = pk2(y[2], y[3]); p.z = pk2(y[4], y[5]); p.w = pk2(y[6], y[7]);
            *(v4u*)(Y + (size_t)r * 4096 + ch) = p; }
    }
}

typedef float f32x16 __attribute__((ext_vector_type(16)));
#define MFMA32(a, b, c) __builtin_amdgcn_mfma_f32_32x32x16_bf16((a), (b), (c), 0, 0, 0)
DI int crow(int reg, int h) { return (reg & 3) + 8 * (reg >> 2) + 4 * h; }
DI int chunk_row(int n, int c) { return n == 0 ? (c >= 48 ? TX + (c - 48) : -1) : 64 * (n - 1) + c; }
#ifndef GDN_NO_HELPER
#define GDN_NO_HELPER 0
#endif
constexpr int GDN_NCH = 129, GDN_UNITS = GDN_NCH * 32, GDN_KUNITS = GDN_NCH * 16, GC_STRIDE = 72;
constexpr size_t GD_WF = WS_MOEW, GD_UF = WS_MOEW + 65 * MiB, GD_IN = WS_MOEW + 130 * MiB, GD_GC = WS_MOEW + 163 * MiB, GD_KT = WS_HN;
static_assert((size_t)GDN_UNITS * 16384 <= 65 * MiB && (size_t)GDN_UNITS * 8192 <= 33 * MiB && (size_t)GDN_KUNITS * 16384 <= 33 * MiB && GD_GC + (size_t)GDN_UNITS * GC_STRIDE * 4 <= WS_H, "gdn map");

DI void ph_gdn_chunk(const Frame& F, const Args& a) {
    const bf16* QN = (const bf16*)(a.ws + WS_SCR + SC_QN); const bf16* KN = (const bf16*)(a.ws + WS_SCR + SC_KN); const bf16* VC = (const bf16*)(a.ws + WS_SCR + SC_VC);
    const float* BETA = (const float*)(a.ws + WS_SCR + SC_BETA); const float* GG = (const float*)(a.ws + WS_SCR + SC_G);
    bf16* WF = (bf16*)(a.ws + GD_WF); bf16* UF = (bf16*)(a.ws + GD_UF); bf16* INF = (bf16*)(a.ws + GD_IN); bf16* KTF = (bf16*)(a.ws + GD_KT); float* GC = (float*)(a.ws + GD_GC);
    LAS unsigned char* L = F.lds + RING_OFF;
    LAS unsigned char* kS = L; LAS unsigned char* qS = L + 17408; LAS unsigned char* vS = L + 34816; LAS unsigned char* kbS = L + 52224;
    LAS float* Lm = (LAS float*)(L + 69632); LAS bf16* IS = (LAS bf16*)(L + 87040); LAS bf16* XS = (LAS bf16*)(L + 96256);
    LAS float* betaS = (LAS float*)(L + 130048); LAS float* gcS = betaS + 64; LAS float* egcS = betaS + 128;
    LAS unsigned char* Lb = L + 17408; LAS unsigned char* TDs = L + 26624; LAS unsigned char* YT0 = L + 28672; LAS unsigned char* XT0 = L + 130816;
    static_assert(130816 + 8 * 1792 <= LDSCTL_OFF, "gdn lds map");
    const int tid = F.tid, lane = F.lane, wave = F.wave, l31 = lane & 31, h = lane >> 5;
    for (int unit = F.vcu; unit < GDN_UNITS; unit += F.G) {
        const int n = unit >> 5, hv = unit & 31, hk = hv >> 1; const size_t su = (size_t)hv * GDN_NCH + n;
#pragma unroll
        for (int i = 0; i < 2; ++i) { const int p = tid + 512 * i, row = p >> 4, ch = p & 15; const int rr = chunk_row(n, row);
            v4u kx = (v4u){0u, 0u, 0u, 0u}, qx = kx, vx = kx;
            if (rr >= 0) { kx = *(const v4u*)(KN + (size_t)rr * 2048 + hk * 128 + ch * 8); qx = *(const v4u*)(QN + (size_t)rr * 2048 + hk * 128 + ch * 8); vx = *(const v4u*)(VC + (size_t)rr * 4096 + hv * 128 + ch * 8); }
            *(LAS v4u*)(kS + row * 272 + ch * 16) = kx; *(LAS v4u*)(qS + row * 272 + ch * 16) = qx; *(LAS v4u*)(vS + row * 272 + ch * 16) = vx; }
        if (wave == 0) { const int rr = chunk_row(n, lane); float b = 0.f, g = 0.f; if (rr >= 0) { b = BETA[(size_t)rr * 32 + hv]; g = GG[(size_t)rr * 32 + hv]; }
#pragma unroll
            for (int o = 1; o < 64; o <<= 1) { const float t = __shfl_up(g, o); if (lane >= o) g += t; }
            betaS[lane] = b; gcS[lane] = g; egcS[lane] = __expf(g); }
        __syncthreads();
#pragma unroll
        for (int i = 0; i < 2; ++i) { const int p = tid + 512 * i, row = p >> 4, ch = p & 15; const v4u kx = *(const LAS v4u*)(kS + row * 272 + ch * 16); const float b = betaS[row];
            v4u o; o.x = pk2(bflo(kx.x) * b, bfhi(kx.x) * b); o.y = pk2(bflo(kx.y) * b, bfhi(kx.y) * b); o.z = pk2(bflo(kx.z) * b, bfhi(kx.z) * b); o.w = pk2(bflo(kx.w) * b, bfhi(kx.w) * b);
            *(LAS v4u*)(kbS + row * 272 + ch * 16) = o; }
        __syncthreads();
        { const int which = wave >> 2, ti = (wave >> 1) & 1, tj = wave & 1;
          f32x16 acc;
#pragma unroll
          for (int r = 0; r < 16; ++r) acc[r] = 0.f;
          if (!(ti == 0 && tj == 1)) { const LAS unsigned char* Ab = (which == 0 ? kbS : qS) + (32 * ti + l31) * 272 + 16 * h; const LAS unsigned char* Bb = kS + (32 * tj + l31) * 272 + 16 * h;
#pragma unroll
              for (int s = 0; s < 8; ++s) acc = MFMA32(*(const LAS bf16x8*)(Ab + 32 * s), *(const LAS bf16x8*)(Bb + 32 * s), acc); }
          const int j = 32 * tj + l31; const float gj = gcS[j];
#pragma unroll
          for (int r = 0; r < 16; ++r) { const int i = 32 * ti + crow(r, h); const float e = __expf(fminf(gcS[i] - gj, 0.f));
              if (which == 0) Lm[i * 68 + j] = i > j ? acc[r] * e : 0.f;
              else IS[i * 72 + j] = (bf16)f2bf(i >= j ? acc[r] * e : 0.f); } }
        __syncthreads();
#pragma unroll
        for (int i = 0; i < 8; ++i) { const int e = tid + 512 * i, r = e >> 6, c = e & 63; *(LAS bf16*)(Lb + r * 144 + c * 2) = (bf16)f2bf(Lm[r * 68 + c]); }
        if (wave == 0) { const int b = lane >> 4, c = lane & 15; float t[16]; const LAS float* Ld = Lm + (16 * b) * 68 + 16 * b;
#pragma unroll
            for (int i = 0; i < 16; ++i) { float acc = i == c ? 1.f : 0.f;
#pragma unroll
                for (int j = 0; j < i; ++j) acc -= Ld[i * 68 + j] * t[j];
                t[i] = acc; *(LAS bf16*)(TDs + (b * 16 + i) * 32 + c * 2) = (bf16)f2bf(acc); }
        } else if (wave >= 4) { const int t2 = tid - 256;
#pragma unroll
            for (int i = 0; i < 2; ++i) { const int p = t2 + 256 * i, comb = p >> 6, ln = p & 63, t = comb >> 2, s = comb & 3; const int c = 32 * t + (ln & 31), j0 = 16 * s + 8 * (ln >> 5);
                *(v4u*)(INF + (su * 8 + comb) * 512 + ln * 8) = *(const LAS v4u*)(IS + c * 72 + j0); }
            if ((hv & 1) == 0) { const size_t kunit = (size_t)hk * GDN_NCH + n;
#pragma unroll
                for (int i = 0; i < 4; ++i) { const int p = t2 + 256 * i, comb = p >> 6, ln = p & 63, kt = comb >> 2, s = comb & 3; const int kd = 32 * kt + (ln & 31), c0 = 16 * s + 8 * (ln >> 5);
                    unsigned w[4];
#pragma unroll
                    for (int jj = 0; jj < 4; ++jj) { const unsigned lo = *(const LAS bf16*)(kS + (c0 + 2 * jj) * 272 + kd * 2), hi = *(const LAS bf16*)(kS + (c0 + 2 * jj + 1) * 272 + kd * 2); w[jj] = lo | (hi << 16); }
                    *(v4u*)(KTF + (kunit * 16 + comb) * 512 + ln * 8) = (v4u){w[0], w[1], w[2], w[3]}; } }
            if (t2 < 64) GC[su * GC_STRIDE + t2] = gcS[t2];
            else if (t2 == 64) GC[su * GC_STRIDE + 64] = gcS[63];
            else if (t2 == 65) GC[su * GC_STRIDE + 65] = egcS[63];
        }
        __syncthreads();
        { const int quad = lane >> 4, lc = lane & 15; LAS unsigned char* XTw = XT0 + wave * 1792; LAS unsigned char* YTw = YT0 + wave * 768;
          const bf16x8 z8 = (bf16x8){0, 0, 0, 0, 0, 0, 0, 0}; const f32x4 z4 = (f32x4){0.f, 0.f, 0.f, 0.f};
          bf16x8 tdf[4];
#pragma unroll
          for (int b = 0; b < 4; ++b) tdf[b] = quad < 2 ? *(const LAS bf16x8*)(TDs + (b * 16 + lc) * 32 + quad * 16) : z8;
#pragma unroll 1
          for (int tl = 0; tl < 2; ++tl) { const int col = 32 * wave + 16 * tl + lc;
              const LAS unsigned char* rz = wave < 4 ? vS + col * 2 : kbS + (col - 128) * 2; const LAS float* bz = wave < 4 ? betaS : egcS;
#pragma unroll
              for (int b = 0; b < 4; ++b) { f32x4 y;
#pragma unroll
                  for (int r = 0; r < 4; ++r) { const int i = 16 * b + 4 * quad + r; y[r] = bf2f(*(const LAS bf16*)(rz + i * 272)) * bz[i]; }
                  if (b >= 1) { f32x4 p = z4;
#pragma unroll
                      for (int kk = 0; kk < (b >= 3 ? 2 : 1); ++kk) { const bf16x8 af = *(const LAS bf16x8*)(Lb + (16 * b + lc) * 144 + (32 * kk + 8 * quad) * 2);
                          const bf16x8 bfv = (32 * kk + 8 * quad < 16 * b) ? *(const LAS bf16x8*)(XTw + lc * 112 + (32 * kk + 8 * quad) * 2) : z8;
                          p = __builtin_amdgcn_mfma_f32_16x16x32_bf16(af, bfv, p, 0, 0, 0); }
                      y = y - p; }
                  *(LAS v2u*)(YTw + lc * 48 + quad * 8) = (v2u){pk2(y[0], y[1]), pk2(y[2], y[3])};
                  asm volatile("" ::: "memory");
                  const bf16x8 yb = quad < 2 ? *(const LAS bf16x8*)(YTw + lc * 48 + quad * 16) : z8;
                  const f32x4 x = __builtin_amdgcn_mfma_f32_16x16x32_bf16(tdf[b], yb, z4, 0, 0, 0);
                  if (b < 3) *(LAS v2u*)(XTw + lc * 112 + (16 * b + 4 * quad) * 2) = (v2u){pk2(x[0], x[1]), pk2(x[2], x[3])};
                  asm volatile("" ::: "memory");
#pragma unroll
                  for (int r = 0; r < 4; ++r) XS[(16 * b + 4 * quad + r) * 264 + col] = (bf16)f2bf(x[r]); } } }
        __syncthreads();
#pragma unroll
        for (int i = 0; i < 2; ++i) { const int p = tid + 512 * i, comb = p >> 6, ln = p & 63, t = comb >> 3, s = comb & 7; const int c = 32 * t + (ln & 31), k0 = 16 * s + 8 * (ln >> 5);
            *(v4u*)(WF + (su * 16 + comb) * 512 + ln * 8) = *(const LAS v4u*)(XS + c * 264 + 128 + k0); }
        { const int t = wave >> 2, ns = wave & 3; unsigned w[8];
#pragma unroll
          for (int r = 0; r < 8; ++r) { const unsigned lo = XS[(32 * t + crow(2 * r, h)) * 264 + 32 * ns + l31], hi = XS[(32 * t + crow(2 * r + 1, h)) * 264 + 32 * ns + l31]; w[r] = lo | (hi << 16); }
          bf16* dst = UF + ((su * 8 + wave) * 64 + lane) * 16; *(v4u*)dst = (v4u){w[0], w[1], w[2], w[3]}; *(v4u*)(dst + 8) = (v4u){w[4], w[5], w[6], w[7]}; }
        __syncthreads();
    }
}

DI void ph_gdn_chain(const Frame& F, const Args& a) {
    const int xg = F.vcu >> 5, wx = F.vcu & 31; if (F.G != 256 ? F.vcu >= 128 : wx >= 20) return;
    const bool helper = F.G == 256 && wx >= 16;
    const int hv = F.G == 256 ? 4 * xg + (helper ? wx - 16 : wx >> 2) : F.vcu >> 2, ns = F.G == 256 ? wx & 3 : F.vcu & 3, hk = hv >> 1;
    const bf16* QN = (const bf16*)(a.ws + WS_SCR + SC_QN);
    const bf16* WF = (const bf16*)(a.ws + GD_WF); const bf16* UF = (const bf16*)(a.ws + GD_UF); const bf16* INF = (const bf16*)(a.ws + GD_IN); const bf16* KTF = (const bf16*)(a.ws + GD_KT); const float* GC = (const float*)(a.ws + GD_GC);
    bf16* O = (bf16*)(a.ws + WS_SCR + SC_O);
    gu32* prog = F.ctl + CW_PROG + hv * 16;
    if (helper && GDN_NO_HELPER) return;
    if (helper) { unsigned sink = 0u; const int tid = F.tid;
        for (int n0 = 0; n0 < GDN_NCH; n0 += 4) {
            if (n0 >= 8) { if (tid == 0) { unsigned sp = 0; while ((int)__hip_atomic_load(prog, RLX_AGENT) < n0 - 4 && ++sp < 20000u) __builtin_amdgcn_s_sleep(8); } __syncthreads(); }
            unsigned v[5];
#pragma unroll
            for (int i = 0; i < 5; ++i) { const int li = tid + 512 * i;
                const int st = li / 580, ln = li % 580, n = n0 + st; const unsigned* p = nullptr;
                if (st < 4 && n < GDN_NCH) { const size_t unit = (size_t)hv * GDN_NCH + n, kunit = (size_t)hk * GDN_NCH + n;
                    if (ln < 128) p = (const unsigned*)(WF + unit * 8192 + ln * 64);
                    else if (ln < 256) p = (const unsigned*)(UF + unit * 8192 + (ln - 128) * 64);
                    else if (ln < 320) p = (const unsigned*)(INF + unit * 4096 + (ln - 256) * 64);
                    else if (ln < 448) p = (const unsigned*)(KTF + kunit * 8192 + (ln - 320) * 64);
                    else if (ln < 576) { const int rr = chunk_row(n, (ln - 448) >> 1); if (rr >= 0) p = (const unsigned*)(QN + (size_t)rr * 2048 + hk * 128 + ((ln - 448) & 1) * 64); }
                    else if (ln < 579) p = (const unsigned*)(GC + unit * GC_STRIDE + (ln - 576) * 32); }
                v[i] = p ? *p : 0u; }
#pragma unroll
            for (int i = 0; i < 5; ++i) sink += v[i];
        }
        if (sink == 0x12345u) __hip_atomic_store(F.ctl + CW_TMO + 2, sink, RLX_AGENT);
        return; }
    LAS unsigned char* ST = F.lds + RING_OFF; LAS unsigned char* VN = ST + 8704; LAS unsigned char* VND = ST + 13312;
    const int lane = F.lane, wave = F.wave, l31 = lane & 31, h = lane >> 5;
    for (int i = F.tid; i < 8704 / 4; i += NWAVES * 64) ((LAS unsigned*)ST)[i] = 0u;
#define GDN_BAR() do { asm volatile("s_waitcnt lgkmcnt(0)" ::: "memory"); __builtin_amdgcn_s_barrier(); asm volatile("" ::: "memory"); } while (0)
    GDN_BAR();
    f32x16 S;
#pragma unroll
    for (int r = 0; r < 16; ++r) S[r] = 0.f;
    const int role = wave < 2 ? 0 : (wave < 4 ? 1 : 2); const int t = wave & 1, kt = wave & 3;
    bf16x8 A8[8]; bf16x8 A4[4]; v4u U0 = (v4u){0u, 0u, 0u, 0u}, U1 = U0; f32x4 G4[4]; float gl = 0.f, egl = 1.f;
#pragma unroll
    for (int s = 0; s < 8; ++s) A8[s] = (bf16x8){0, 0, 0, 0, 0, 0, 0, 0};
#pragma unroll
    for (int s = 0; s < 4; ++s) { A4[s] = (bf16x8){0, 0, 0, 0, 0, 0, 0, 0}; G4[s] = (f32x4){0.f, 0.f, 0.f, 0.f}; }
#define GDN_LOAD(nn) do { const size_t unit_ = (size_t)hv * GDN_NCH + (nn); const float* gc_ = GC + unit_ * GC_STRIDE; \
        if (role == 0) { _Pragma("unroll") for (int s = 0; s < 8; ++s) A8[s] = *(const bf16x8*)(WF + ((unit_ * 2 + t) * 8 + s) * 512 + lane * 8); \
            const bf16* up_ = UF + (((unit_ * 2 + t) * 4 + ns) * 64 + lane) * 16; U0 = *(const v4u*)up_; U1 = *(const v4u*)(up_ + 8); \
            _Pragma("unroll") for (int g = 0; g < 4; ++g) G4[g] = *(const f32x4*)(gc_ + 32 * t + 8 * g + 4 * h); gl = gc_[64]; } \
        else if (role == 1) { const int rr_ = chunk_row((nn), 32 * t + l31); \
            _Pragma("unroll") for (int s = 0; s < 8; ++s) A8[s] = rr_ >= 0 ? *(const bf16x8*)(QN + (size_t)rr_ * 2048 + hk * 128 + 16 * s + 8 * h) : (bf16x8){0, 0, 0, 0, 0, 0, 0, 0}; \
            _Pragma("unroll") for (int s = 0; s < 4; ++s) A4[s] = *(const bf16x8*)(INF + ((unit_ * 2 + t) * 4 + s) * 512 + lane * 8); \
            _Pragma("unroll") for (int g = 0; g < 4; ++g) G4[g] = *(const f32x4*)(gc_ + 32 * t + 8 * g + 4 * h); } \
        else { const size_t kunit_ = (size_t)hk * GDN_NCH + (nn); \
            _Pragma("unroll") for (int s = 0; s < 4; ++s) A4[s] = *(const bf16x8*)(KTF + ((kunit_ * 4 + kt) * 4 + s) * 512 + lane * 8); egl = gc_[65]; } } while (0)
    GDN_LOAD(0);
    for (int n = 0; n < GDN_NCH; ++n) {
        bf16x8 a8[8], a4[4]; const v4u u0 = U0, u1 = U1; f32x4 g4[4]; const float cgl = gl, cegl = egl;
#pragma unroll
        for (int s = 0; s < 8; ++s) a8[s] = A8[s];
#pragma unroll
        for (int s = 0; s < 4; ++s) { a4[s] = A4[s]; g4[s] = G4[s]; }
        if (n + 1 < GDN_NCH) GDN_LOAD(n + 1);
        if (ns == 0 && F.tid == 0) __hip_atomic_store(prog, (unsigned)n, RLX_AGENT);
        f32x16 acc;
#pragma unroll
        for (int r = 0; r < 16; ++r) acc[r] = 0.f;
        if (role < 2) {
#pragma unroll
            for (int s = 0; s < 8; ++s) acc = MFMA32(a8[s], *(const LAS bf16x8*)(ST + l31 * 272 + 32 * s + 16 * h), acc);
        }
        if (role == 0) { const unsigned uw[8] = {u0.x, u0.y, u0.z, u0.w, u1.x, u1.y, u1.z, u1.w};
#pragma unroll
            for (int g = 0; g < 4; ++g) { float vn[4], vd[4];
#pragma unroll
                for (int q = 0; q < 4; ++q) { const int r = 4 * g + q; const float uv = (r & 1) ? bfhi(uw[r >> 1]) : bflo(uw[r >> 1]); vn[q] = uv - acc[r]; vd[q] = vn[q] * __expf(cgl - g4[g][q]); }
                *(LAS v2u*)(VN + l31 * 144 + (32 * t + 8 * g + 4 * h) * 2) = (v2u){pk2(vn[0], vn[1]), pk2(vn[2], vn[3])};
                *(LAS v2u*)(VND + l31 * 144 + (32 * t + 8 * g + 4 * h) * 2) = (v2u){pk2(vd[0], vd[1]), pk2(vd[2], vd[3])}; }
        } else if (role == 1) {
#pragma unroll
            for (int g = 0; g < 4; ++g)
#pragma unroll
                for (int q = 0; q < 4; ++q) acc[4 * g + q] *= __expf(g4[g][q]);
        }
        GDN_BAR();
        if (role == 1) {
#pragma unroll
            for (int s = 0; s < 4; ++s) acc = MFMA32(a4[s], *(const LAS bf16x8*)(VN + l31 * 144 + 32 * s + 16 * h), acc);
#pragma unroll
            for (int r = 0; r < 16; ++r) { const int rr = chunk_row(n, 32 * t + crow(r, h)); if (rr >= 0) O[(size_t)rr * 4096 + hv * 128 + 32 * ns + l31] = (bf16)f2bf(acc[r]); }
        } else if (role == 2) {
#pragma unroll
            for (int r = 0; r < 16; ++r) S[r] *= cegl;
#pragma unroll
            for (int s = 0; s < 4; ++s) S = MFMA32(a4[s], *(const LAS bf16x8*)(VND + l31 * 144 + 32 * s + 16 * h), S);
#pragma unroll
            for (int g = 0; g < 4; ++g) *(LAS v2u*)(ST + l31 * 272 + (32 * kt + 8 * g + 4 * h) * 2) = (v2u){pk2(S[4 * g], S[4 * g + 1]), pk2(S[4 * g + 2], S[4 * g + 3])};
        }
        GDN_BAR();
    }
#undef GDN_LOAD
#undef GDN_BAR
}

constexpr int RW_NSC = 258, RW_UNITS = 129 * 16;
DI int sub_row(int sc, int t) { const int n = sc >> 1, sub = sc & 1; return n == 0 ? ((sub == 0 && t >= 16) ? TX + t - 16 : -1) : 64 * (n - 1) + 32 * sub + t; }
constexpr size_t RW_BASE = WS_PROJ + 92 * MiB;
constexpr size_t RW_RH = RW_BASE, RW_RL = RW_BASE + 33 * MiB, RW_GT = RW_BASE + 66 * MiB, RW_GAM = RW_BASE + 99 * MiB;
constexpr size_t RW_PR = WS_SCR + 195 * MiB, RW_AT = WS_SCR + 211 * MiB + 256 * 1024, RW_VTF = WS_SCR + 219 * MiB + 512 * 1024, RW_SALL = WS_SCR + 235 * MiB + 768 * 1024;
constexpr size_t RW_XSAVE = 1 * MiB + 640 * 1024;
constexpr size_t RW_VV = WS_YMIX + 34 * MiB, RW_BON = WS_YMIX + 52 * MiB, LR_H = WS_YMIX + 54 * MiB, LR_A = WS_YMIX + 56 * MiB, LR_C = WS_YMIX + 58 * MiB;
constexpr size_t RW_SCH = (size_t)RW_NSC * 16;
static_assert((size_t)MP * EV_NP * 2 <= 92 * MiB && RW_SCH * 8192 <= 33 * MiB && RW_GAM + RW_SCH * 256 <= WS_SCR, "rwkv map (proj region)");
static_assert(WS_SCR + SC_LIX + (size_t)MP * 4096 <= RW_PR && RW_PR + RW_SCH * 4096 <= RW_AT && RW_AT + RW_SCH * 2048 <= RW_VTF && RW_VTF + RW_SCH * 4096 <= RW_SALL && RW_SALL + RW_SCH * 8192 <= WS_END, "rwkv map (scratch region)");
static_assert((size_t)MP * DM * 2 <= 34 * MiB && RW_VV + (size_t)MP * 2048 <= RW_BON && RW_BON + (size_t)MP * 64 <= LR_H && LR_H + RW_SCH * 256 <= LR_A && LR_A + RW_SCH * 256 <= LR_C && LR_C + RW_SCH * 256 <= WS_PROJ, "rwkv map (ymix region)");

DI void sub_rows(int sc, int& t0, int& rbase) { if (sc >= 2) { t0 = 0; rbase = 64 * ((sc >> 1) - 1) + 32 * (sc & 1); } else if (sc == 0) { t0 = 16; rbase = TX - 16; } else { t0 = 32; rbase = 0; } }
DI void lru_local(const Frame& F, const Args& a) {
    const float* LA = (const float*)(a.ws + WS_SCR + SC_LA); const float* LIX = (const float*)(a.ws + WS_SCR + SC_LIX);
    float* HL = (float*)(a.ws + LR_H); float* AP = (float*)(a.ws + LR_A);
    for (int item = F.gw; item < RW_NSC * 16; item += F.NGW) { const int sc = item >> 4, c = (item & 15) * 64 + F.lane; int t0, rbase; sub_rows(sc, t0, rbase);
        float av[32], ix[32];
#pragma unroll
        for (int t = 0; t < 32; ++t) { const size_t o = (size_t)(rbase + (t >= t0 ? t : 32)) * 1024 + c; av[t] = LA[o]; ix[t] = LIX[o]; }
        float h = 0.f, p = 1.f;
#pragma unroll
        for (int t = 0; t < 32; ++t) { const float a_ = t >= t0 ? av[t] : 1.f, x_ = t >= t0 ? ix[t] : 0.f; h = a_ * h + sqrtf(fmaxf(1.0f - a_ * a_, 0.f)) * x_; p *= a_; }
        HL[sc * 1024 + c] = h; AP[sc * 1024 + c] = p; }
}
DI void lru_apply(const Frame& F, const Args& a) {
    const bf16* P = (const bf16*)(a.ws + WS_PROJ); const float* LA = (const float*)(a.ws + WS_SCR + SC_LA); const float* LIX = (const float*)(a.ws + WS_SCR + SC_LIX);
    const float* CR = (const float*)(a.ws + LR_C); bf16* Y = (bf16*)(a.ws + WS_YMIX);
    for (int item = F.gw; item < RW_NSC * 16; item += F.NGW) { const int sc = item >> 4, c = (item & 15) * 64 + F.lane; int t0, rbase; sub_rows(sc, t0, rbase); if (t0 >= 32) continue;
        float h = CR[sc * 1024 + c];
#pragma unroll
        for (int tb = 0; tb < 32; tb += 16) { float av[16], ix[16], gb[16];
#pragma unroll
            for (int t = 0; t < 16; ++t) { const size_t r_ = (size_t)(rbase + (tb + t >= t0 ? tb + t : 32)); av[t] = LA[r_ * 1024 + c]; ix[t] = LIX[r_ * 1024 + c]; gb[t] = bf2f(P[r_ * EV_NP + EV_GB + c]); }
#pragma unroll
            for (int t = 0; t < 16; ++t) { if (tb + t >= t0) { h = av[t] * h + sqrtf(fmaxf(1.0f - av[t] * av[t], 0.f)) * ix[t]; Y[(size_t)(rbase + tb + t) * DM + 1024 + c] = (bf16)f2bf(h * gelu_tanh(gb[t])); } } } }
}

DI void ph_rwkv_chunk(const Frame& F, const Args& a, int n_lo, int n_hi, int wg0) {
    if (F.vcu < wg0) return;
    const bf16* P = (const bf16*)(a.ws + WS_PROJ); const float* DEC = (const float*)(a.ws + WS_SCR + SC_DEC); const float* ICL = (const float*)(a.ws + WS_SCR + SC_ICL);
    bf16* RH = (bf16*)(a.ws + RW_RH); bf16* RL = (bf16*)(a.ws + RW_RL); bf16* GT = (bf16*)(a.ws + RW_GT); float* GAM = (float*)(a.ws + RW_GAM); bf16* PR = (bf16*)(a.ws + RW_PR); bf16* ATG = (bf16*)(a.ws + RW_AT); bf16* VTF = (bf16*)(a.ws + RW_VTF);
    bf16* VV = (bf16*)(a.ws + RW_VV); float* BON = (float*)(a.ws + RW_BON);
    LAS unsigned char* L = F.lds + RING_OFF;
    LAS float* wS = (LAS float*)L; LAS float* aS = wS + 4096; LAS float* bS = wS + 8192; LAS float* rS = wS + 12288; LAS float* kS = wS + 16384;
    LAS unsigned char* vT = L + 81920; LAS unsigned char* aT = L + 91136; LAS unsigned char* rT = L + 100352; LAS unsigned char* kT = L + 109568; LAS unsigned char* bT = L + 118784;
    LAS unsigned char* AT = L + 128000; LAS unsigned char* NT = L + 133120; LAS float* gam = (LAS float*)(L + 138240);
    LAS unsigned char* aTl = L; LAS unsigned char* bTl = L + 9216;
    const int tid = F.tid, lane = F.lane, wave = F.wave, l31 = lane & 31, h = lane >> 5;
    const float* mu = a.in[6];
    for (int unit = n_lo * 16 + (F.vcu - wg0); unit < n_hi * 16; unit += F.G - wg0) {
        const int n = unit >> 4, hd = unit & 15;
        { const int tok = tid >> 3, cg = tid & 7, c0 = hd * 64 + cg * 8; const int rr = sub_row(2 * n + (tok >> 5), tok & 31);
          float wv[8], av[8], bv[8], rv[8], kv[8], vv[8];
#pragma unroll
          for (int q = 0; q < 8; ++q) { wv[q] = 1.f; av[q] = 0.f; bv[q] = 0.f; rv[q] = 0.f; kv[q] = 0.f; vv[q] = 0.f; }
          if (rr >= 0) { const int pos = row_pos(rr); const bf16* cur = P + (size_t)rr * EV_NP + c0; const bf16* prv = pos > 0 ? P + (size_t)pos_row(pos - 1) * EV_NP + c0 : nullptr;
              const v4u z4 = (v4u){0u, 0u, 0u, 0u};
              const v4u cr = *(const v4u*)cur, ck = *(const v4u*)(cur + 1024), cv = *(const v4u*)(cur + 2048);
              const v4u qr = prv ? *(const v4u*)prv : z4, qk = prv ? *(const v4u*)(prv + 1024) : z4, qv = prv ? *(const v4u*)(prv + 2048) : z4;
              const unsigned crw[4] = {cr.x, cr.y, cr.z, cr.w}, ckw[4] = {ck.x, ck.y, ck.z, ck.w}, cvw[4] = {cv.x, cv.y, cv.z, cv.w}, qrw[4] = {qr.x, qr.y, qr.z, qr.w}, qkw[4] = {qk.x, qk.y, qk.z, qk.w}, qvw[4] = {qv.x, qv.y, qv.z, qv.w};
              float ss = 0.f, bon = 0.f; float kk[8], ic[8];
#pragma unroll
              for (int q = 0; q < 8; ++q) { const int c = c0 + q; const float crf = (q & 1) ? bfhi(crw[q >> 1]) : bflo(crw[q >> 1]), ckf = (q & 1) ? bfhi(ckw[q >> 1]) : bflo(ckw[q >> 1]), cvf = (q & 1) ? bfhi(cvw[q >> 1]) : bflo(cvw[q >> 1]);
                  const float prf = (q & 1) ? bfhi(qrw[q >> 1]) : bflo(qrw[q >> 1]), pkf = (q & 1) ? bfhi(qkw[q >> 1]) : bflo(qkw[q >> 1]), pvf = (q & 1) ? bfhi(qvw[q >> 1]) : bflo(qvw[q >> 1]);
                  rv[q] = crf + (prf - crf) * mu[c]; kk[q] = ckf + (pkf - ckf) * mu[1024 + c]; vv[q] = cvf + (pvf - cvf) * mu[2048 + c];
                  wv[q] = DEC[(size_t)rr * 1024 + c]; ic[q] = ICL[(size_t)rr * 1024 + c];
                  const float kkv = kk[q] * a.in[12][c]; av[q] = kkv; ss += kkv * kkv; kv[q] = kk[q] * (1.0f + (ic[q] - 1.0f) * a.in[13][c]); bon += rv[q] * kv[q] * a.in[14][c]; }
              ss += __shfl_xor(ss, 1); ss += __shfl_xor(ss, 2); ss += __shfl_xor(ss, 4); bon += __shfl_xor(bon, 1); bon += __shfl_xor(bon, 2); bon += __shfl_xor(bon, 4);
              const float inv = 1.0f / fmaxf(sqrtf(ss), 1e-12f);
#pragma unroll
              for (int q = 0; q < 8; ++q) { const float kkn = av[q] * inv; av[q] = -kkn; bv[q] = kkn * ic[q]; }
              if (cg == 0) BON[(size_t)rr * 16 + hd] = bon;
              *(v4u*)(VV + (size_t)rr * 1024 + c0) = (v4u){pk2(vv[0], vv[1]), pk2(vv[2], vv[3]), pk2(vv[4], vv[5]), pk2(vv[6], vv[7])}; }
          const int o = tok * 64 + cg * 8;
          *(LAS f32x4*)(wS + o) = (f32x4){wv[0], wv[1], wv[2], wv[3]}; *(LAS f32x4*)(wS + o + 4) = (f32x4){wv[4], wv[5], wv[6], wv[7]};
          *(LAS f32x4*)(aS + o) = (f32x4){av[0], av[1], av[2], av[3]}; *(LAS f32x4*)(aS + o + 4) = (f32x4){av[4], av[5], av[6], av[7]};
          *(LAS f32x4*)(bS + o) = (f32x4){bv[0], bv[1], bv[2], bv[3]}; *(LAS f32x4*)(bS + o + 4) = (f32x4){bv[4], bv[5], bv[6], bv[7]};
          *(LAS f32x4*)(rS + o) = (f32x4){rv[0], rv[1], rv[2], rv[3]}; *(LAS f32x4*)(rS + o + 4) = (f32x4){rv[4], rv[5], rv[6], rv[7]};
          *(LAS f32x4*)(kS + o) = (f32x4){kv[0], kv[1], kv[2], kv[3]}; *(LAS f32x4*)(kS + o + 4) = (f32x4){kv[4], kv[5], kv[6], kv[7]};
#pragma unroll
          for (int q = 0; q < 8; ++q) *(LAS bf16*)(vT + (cg * 8 + q) * 144 + tok * 2) = (bf16)f2bf(vv[q]); }
        __syncthreads();
        { const int p = wave >> 2, sub = (wave >> 1) & 1, half = wave & 1, sl = lane >> 2, q = lane & 3, s = 16 * half + sl, tok = 32 * sub + s, jq = 16 * q;
          const LAS float* x0p = (p == 0 ? kS : bS) + tok * 64 + jq; LAS unsigned char* OUT = p == 0 ? AT : NT;
          float x[16];
#pragma unroll
          for (int j = 0; j < 16; j += 4) { const f32x4 t4 = *(const LAS f32x4*)(x0p + j); x[j] = t4.x; x[j + 1] = t4.y; x[j + 2] = t4.z; x[j + 3] = t4.w; }
          if (half) {
#pragma unroll
              for (int i = 0; i < 4; ++i) *(LAS bf16*)(OUT + ((sub * 32 + 4 * q + i) * 40 + s) * 2) = (bf16)0; }
#pragma unroll 2
          for (int tp = 16 * half; tp < 32; ++tp) { const LAS float* bp = wS + (32 * sub + tp) * 64 + jq; const bool run = tp > s;
              f32x4 a4[4], w4[4], b4[4], r4[4];
#pragma unroll
              for (int g = 0; g < 4; ++g) { a4[g] = *(const LAS f32x4*)(bp + 4096 + 4 * g); w4[g] = *(const LAS f32x4*)(bp + 4 * g); b4[g] = *(const LAS f32x4*)(bp + 8192 + 4 * g); r4[g] = *(const LAS f32x4*)(bp + 12288 + 4 * g); }
              float c = 0.f;
#pragma unroll
              for (int g = 0; g < 4; ++g) { c += x[4 * g] * a4[g].x; c += x[4 * g + 1] * a4[g].y; c += x[4 * g + 2] * a4[g].z; c += x[4 * g + 3] * a4[g].w; }
              c += __builtin_bit_cast(float, __builtin_amdgcn_mov_dpp(__builtin_bit_cast(int, c), 0xB1, 0xF, 0xF, true));
              c += __builtin_bit_cast(float, __builtin_amdgcn_mov_dpp(__builtin_bit_cast(int, c), 0x4E, 0xF, 0xF, true));
              float o = 0.f;
#pragma unroll
              for (int g = 0; g < 4; ++g) { const float n0 = x[4 * g] * w4[g].x + c * b4[g].x, n1 = x[4 * g + 1] * w4[g].y + c * b4[g].y, n2 = x[4 * g + 2] * w4[g].z + c * b4[g].z, n3 = x[4 * g + 3] * w4[g].w + c * b4[g].w;
                  x[4 * g] = run ? n0 : x[4 * g]; x[4 * g + 1] = run ? n1 : x[4 * g + 1]; x[4 * g + 2] = run ? n2 : x[4 * g + 2]; x[4 * g + 3] = run ? n3 : x[4 * g + 3];
                  o += x[4 * g] * r4[g].x; o += x[4 * g + 1] * r4[g].y; o += x[4 * g + 2] * r4[g].z; o += x[4 * g + 3] * r4[g].w; }
              o += __builtin_bit_cast(float, __builtin_amdgcn_mov_dpp(__builtin_bit_cast(int, o), 0xB1, 0xF, 0xF, true));
              o += __builtin_bit_cast(float, __builtin_amdgcn_mov_dpp(__builtin_bit_cast(int, o), 0x4E, 0xF, 0xF, true));
              if (q == 0) *(LAS bf16*)(OUT + ((sub * 32 + tp) * 40 + s) * 2) = (bf16)f2bf(tp >= s ? o : 0.f); }
          LAS unsigned char* XT = p == 0 ? kT : bT;
#pragma unroll
          for (int j = 0; j < 16; ++j) { const unsigned hi = f2bf(x[j]); *(LAS bf16*)(XT + (jq + j) * 144 + tok * 2) = (bf16)hi; x[j] -= __uint_as_float(hi << 16); }
          float alo[32]; const bool gwave = (p == 0 && half == 1); const int j = lane;
          if (gwave) { float g = 1.f;
#pragma unroll
              for (int tp = 0; tp < 32; ++tp) { const int tk = 32 * sub + tp; const float w_ = wS[tk * 64 + j], a_ = aS[tk * 64 + j], r_ = rS[tk * 64 + j];
                  const float at = a_ * g; const unsigned hi = f2bf(at); *(LAS bf16*)(aT + j * 144 + tk * 2) = (bf16)hi; alo[tp] = at - __uint_as_float(hi << 16);
                  g *= w_; *(LAS bf16*)(rT + j * 144 + tk * 2) = (bf16)f2bf(r_ * g); }
              gam[sub * 64 + j] = g; }
          __syncthreads();
          if (p == 1) {
#pragma unroll
              for (int jj = 0; jj < 16; ++jj) *(LAS bf16*)(bTl + (jq + jj) * 144 + tok * 2) = (bf16)f2bf(x[jj]); }
          if (gwave) {
#pragma unroll
              for (int tp = 0; tp < 32; ++tp) *(LAS bf16*)(aTl + j * 144 + (32 * sub + tp) * 2) = (bf16)f2bf(alo[tp]); }
        }
        __syncthreads();
        { const int sub = wave >> 2, t1 = (wave >> 1) & 1, t0 = wave & 1; const size_t sch = (size_t)hd * RW_NSC + (2 * n + sub);
          { f32x16 acc;
#pragma unroll
            for (int r = 0; r < 16; ++r) acc[r] = 0.f;
#pragma unroll
            for (int ks = 0; ks < 2; ++ks) { const int ao = (32 * t1 + l31) * 144 + (32 * sub + 16 * ks + 8 * h) * 2, bo = (32 * t0 + l31) * 144 + (32 * sub + 16 * ks + 8 * h) * 2;
                const bf16x8 ah = *(const LAS bf16x8*)(aT + ao), al = *(const LAS bf16x8*)(aTl + ao), bh = *(const LAS bf16x8*)(bT + bo), bl = *(const LAS bf16x8*)(bTl + bo);
                acc = MFMA32(al, bh, acc); acc = MFMA32(ah, bl, acc); acc = MFMA32(ah, bh, acc); }
            const int jp = 32 * t0 + l31;
#pragma unroll
            for (int g = 0; g < 4; ++g) { unsigned hi[4]; float lo[4];
#pragma unroll
                for (int q = 0; q < 4; ++q) { hi[q] = f2bf(acc[4 * g + q]); lo[q] = acc[4 * g + q] - __uint_as_float(hi[q] << 16); }
                *(v2u*)(RH + (sch * 64 + jp) * 64 + 32 * t1 + 8 * g + 4 * h) = (v2u){hi[0] | (hi[1] << 16), hi[2] | (hi[3] << 16)};
                *(v2u*)(RL + (sch * 64 + jp) * 64 + 32 * t1 + 8 * g + 4 * h) = (v2u){pk2(lo[0], lo[1]), pk2(lo[2], lo[3])}; }
            if (t1 == 0 && t0 == 0) GAM[sch * 64 + lane] = gam[sub * 64 + lane]; }
          { f32x16 acc;
#pragma unroll
            for (int r = 0; r < 16; ++r) acc[r] = 0.f;
#pragma unroll
            for (int ks = 0; ks < 2; ++ks) acc = MFMA32(*(const LAS bf16x8*)(kT + (32 * t1 + l31) * 144 + (32 * sub + 16 * ks + 8 * h) * 2), *(const LAS bf16x8*)(vT + (32 * t0 + l31) * 144 + (32 * sub + 16 * ks + 8 * h) * 2), acc);
            bf16* dst = GT + ((sch * 4 + t1 * 2 + t0) * 64 + lane) * 16;
            *(v4u*)dst = (v4u){pk2(acc[0], acc[1]), pk2(acc[2], acc[3]), pk2(acc[4], acc[5]), pk2(acc[6], acc[7])}; *(v4u*)(dst + 8) = (v4u){pk2(acc[8], acc[9]), pk2(acc[10], acc[11]), pk2(acc[12], acc[13]), pk2(acc[14], acc[15])}; } }
        if (wave < 4) { const int sub = wave >> 1, jt = wave & 1; const size_t sch = (size_t)hd * RW_NSC + (2 * n + sub);
            f32x16 acc;
#pragma unroll
            for (int r = 0; r < 16; ++r) acc[r] = bf2f(*(const LAS bf16*)(rT + (32 * jt + crow(r, h)) * 144 + (32 * sub + l31) * 2));
#pragma unroll
            for (int ks = 0; ks < 2; ++ks) acc = MFMA32(*(const LAS bf16x8*)(aT + (32 * jt + l31) * 144 + (32 * sub + 16 * ks + 8 * h) * 2), *(const LAS bf16x8*)(NT + (sub * 32 + l31) * 80 + (16 * ks + 8 * h) * 2), acc);
#pragma unroll
            for (int g = 0; g < 4; ++g) *(v2u*)(PR + (sch * 32 + l31) * 64 + 32 * jt + 8 * g + 4 * h) = (v2u){pk2(acc[4 * g], acc[4 * g + 1]), pk2(acc[4 * g + 2], acc[4 * g + 3])};
        } else { const int t2 = tid - 256, sub = t2 >> 7, t = (t2 >> 2) & 31, s8 = (t2 & 3) * 8; const size_t sch = (size_t)hd * RW_NSC + (2 * n + sub);
            *(v4u*)(ATG + (sch * 32 + t) * 32 + s8) = *(const LAS v4u*)(AT + (sub * 32 + t) * 80 + s8 * 2); }
        { const int sub = tid >> 8, it = (tid >> 7) & 1, ks = (tid >> 6) & 1; const size_t sch = (size_t)hd * RW_NSC + (2 * n + sub);
          *(v4u*)(VTF + ((sch * 4 + it * 2 + ks) * 64 + lane) * 8) = *(const LAS v4u*)(vT + (32 * it + l31) * 144 + (32 * sub + 16 * ks + 8 * h) * 2); }
        __syncthreads();
    }
}

DI void ph_rwkv_chain(const Frame& F, const Args& a, int sc_lo, int sc_hi) {
    if (F.vcu >= 16 && F.vcu < 18) { if (sc_hi < RW_NSC) return; const int c = (F.vcu - 16) * 512 + F.tid; const float* HL = (const float*)(a.ws + LR_H); const float* AP = (const float*)(a.ws + LR_A); float* CR = (float*)(a.ws + LR_C);
        float carry = 0.f;
#pragma unroll 8
        for (int sc = 0; sc < RW_NSC; ++sc) { const float hl = HL[sc * 1024 + c], ap = AP[sc * 1024 + c]; CR[sc * 1024 + c] = carry; carry = ap * carry + hl; }
        return; }
    if (F.vcu >= 16) return;
    const int hd = F.vcu; const bf16* RH = (const bf16*)(a.ws + RW_RH); const bf16* RL = (const bf16*)(a.ws + RW_RL); const bf16* GT = (const bf16*)(a.ws + RW_GT); const float* GAM = (const float*)(a.ws + RW_GAM); bf16* SALL = (bf16*)(a.ws + RW_SALL);
    constexpr int RW_NS = 7, SLOT = 8192 + 8192 + 1024;
    LAS unsigned char* XS = F.lds + RING_OFF; LAS unsigned char* RG = XS + 2 * 9216;
    const int lane = F.lane, wave = F.wave, l31 = lane & 31, h = lane >> 5, jt = (wave >> 1) & 1, it = wave & 1, lw = wave & 3;
    for (int i = F.tid; i < 2 * 9216 / 4; i += NWAVES * 64) ((LAS unsigned*)XS)[i] = 0u;
    __syncthreads();
#define RW_BAR() do { asm volatile("s_waitcnt lgkmcnt(0)" ::: "memory"); __builtin_amdgcn_s_barrier(); asm volatile("" ::: "memory"); } while (0)
    const unsigned rg0 = (unsigned)(uintptr_t)RG;
    int offR[2], offG[2];
#pragma unroll
    for (int i = 0; i < 2; ++i) { const int b = 2 * lw + i, row = 8 * b + (lane >> 3), pc = lane & 7; offR[i] = row * 64 + ((pc ^ (row & 7)) * 8); offG[i] = (b * 64 + lane) * 8; }
    const int offM = (lane & 15) * 4;
#define RW_DMA(src, dst) do { unsigned keep_; asm volatile("s_mov_b32 %0, m0\n\ts_mov_b32 m0, %2\n\ts_nop 0\n\tglobal_load_lds_dwordx4 %1, off\n\ts_mov_b32 m0, %0" : "=&s"(keep_) : "v"(src), "s"(dst) : "memory"); } while (0)
#define RW_ISSUE(scn) do { const int s_ = (scn) < RW_NSC ? (scn) : RW_NSC - 1; const size_t sch_ = (size_t)hd * RW_NSC + s_; \
        const unsigned sb_ = (unsigned)__builtin_amdgcn_readfirstlane((int)(rg0 + (unsigned)((scn) % RW_NS) * SLOT)); \
        _Pragma("unroll") for (int i_ = 0; i_ < 2; ++i_) { const unsigned bo_ = (unsigned)__builtin_amdgcn_readfirstlane((2 * lw + i_) * 1024); \
            RW_DMA(RH + sch_ * 4096 + offR[i_], sb_ + bo_); RW_DMA(GT + sch_ * 4096 + offG[i_], sb_ + 8192 + bo_); } \
        RW_DMA(GAM + sch_ * 64 + offM, sb_ + 16384); } while (0)
#define RW_WAITV(n) asm volatile("s_waitcnt vmcnt(" #n ")" ::: "memory")
    f32x16 X;
#pragma unroll
    for (int r = 0; r < 16; ++r) X[r] = 0.f;
    float* XSV = (float*)(a.ws + RW_XSAVE) + ((size_t)(hd * 4 + (wave & 3)) * 64 + lane) * 16;
    if (wave < 4 && sc_lo > 0) {
#pragma unroll
        for (int g = 0; g < 4; ++g) { const f32x4 v = *(const f32x4*)(XSV + 4 * g); X[4 * g] = v.x; X[4 * g + 1] = v.y; X[4 * g + 2] = v.z; X[4 * g + 3] = v.w;
            *(LAS v2u*)(XS + (32 * it + l31) * 144 + (32 * jt + 8 * g + 4 * h) * 2) = (v2u){pk2(v.x, v.y), pk2(v.z, v.w)}; } }
    if (wave >= 4) { RW_ISSUE(sc_lo); RW_ISSUE(sc_lo + 1); RW_ISSUE(sc_lo + 2); RW_ISSUE(sc_lo + 3); RW_ISSUE(sc_lo + 4); RW_ISSUE(sc_lo + 5); RW_WAITV(25); }
    RW_BAR();
    for (int sc = sc_lo; sc < sc_hi; ++sc) {
        if (wave < 4) {
            const LAS unsigned char* sb = RG + (sc % RW_NS) * SLOT;
            f32x16 acc; const size_t sch = (size_t)hd * RW_NSC + sc;
            { const v4u g0 = *(const LAS v4u*)(sb + 8192 + ((jt * 2 + it) * 64 + lane) * 32), g1 = *(const LAS v4u*)(sb + 8192 + ((jt * 2 + it) * 64 + lane) * 32 + 16);
              const unsigned gw_[8] = {g0.x, g0.y, g0.z, g0.w, g1.x, g1.y, g1.z, g1.w};
#pragma unroll
              for (int g = 0; g < 4; ++g) { const f32x4 m = *(const LAS f32x4*)(sb + 16384 + (32 * jt + 8 * g + 4 * h) * 4);
                  acc[4 * g] = bflo(gw_[2 * g]) + m.x * X[4 * g]; acc[4 * g + 1] = bfhi(gw_[2 * g]) + m.y * X[4 * g + 1]; acc[4 * g + 2] = bflo(gw_[2 * g + 1]) + m.z * X[4 * g + 2]; acc[4 * g + 3] = bfhi(gw_[2 * g + 1]) + m.w * X[4 * g + 3]; } }
#pragma unroll
            for (int g = 0; g < 4; ++g) *(v2u*)(SALL + (sch * 64 + 32 * it + l31) * 64 + 32 * jt + 8 * g + 4 * h) = (v2u){pk2(X[4 * g], X[4 * g + 1]), pk2(X[4 * g + 2], X[4 * g + 3])};
            const LAS unsigned char* xb = XS + (sc & 1) * 9216 + (32 * it + l31) * 144 + 16 * h; const int ar = 32 * jt + l31; const LAS unsigned char* ab = sb + ar * 128;
#pragma unroll
            for (int ks = 0; ks < 4; ++ks) { const bf16x8 xf = *(const LAS bf16x8*)(xb + 32 * ks); const int po = (((2 * ks + h) ^ (ar & 7)) * 16);
                acc = MFMA32(*(const LAS bf16x8*)(ab + po), xf, acc); }
            X = acc;
            LAS unsigned char* xn = XS + ((sc + 1) & 1) * 9216 + (32 * it + l31) * 144;
#pragma unroll
            for (int g = 0; g < 4; ++g) *(LAS v2u*)(xn + (32 * jt + 8 * g + 4 * h) * 2) = (v2u){pk2(X[4 * g], X[4 * g + 1]), pk2(X[4 * g + 2], X[4 * g + 3])};
        } else {
            RW_ISSUE(sc + RW_NS - 1);
            RW_WAITV(25);
        }
        RW_BAR();
    }
    if (wave >= 4) RW_WAITV(0);
    else if (sc_hi < RW_NSC) {
#pragma unroll
        for (int g = 0; g < 4; ++g) *(f32x4*)(XSV + 4 * g) = (f32x4){X[4 * g], X[4 * g + 1], X[4 * g + 2], X[4 * g + 3]}; }
#undef RW_ISSUE
#undef RW_DMA
#undef RW_WAITV
#undef RW_BAR
}

DI void ph_rwkv_out(const Frame& F, const Args& a) {
    const bf16* SALL = (const bf16*)(a.ws + RW_SALL); const bf16* PR = (const bf16*)(a.ws + RW_PR); const bf16* ATG = (const bf16*)(a.ws + RW_AT); const bf16* VTF = (const bf16*)(a.ws + RW_VTF);
    const bf16* VV = (const bf16*)(a.ws + RW_VV); const float* BON = (const float*)(a.ws + RW_BON); const float* GATE = (const float*)(a.ws + WS_SCR + SC_GATE); bf16* Y = (bf16*)(a.ws + WS_YMIX);
    const int lane = F.lane, l31 = lane & 31, h = lane >> 5;
    for (int item = F.gw; item < RW_NSC * 16; item += F.NGW) { const int sc = item >> 4, hd = item & 15; if (sc == 1) continue;
        const size_t sch = (size_t)hd * RW_NSC + sc; f32x16 acc[2];
#pragma unroll
        for (int it = 0; it < 2; ++it) {
#pragma unroll
            for (int r = 0; r < 16; ++r) acc[it][r] = 0.f;
#pragma unroll
            for (int ks = 0; ks < 4; ++ks) acc[it] = MFMA32(*(const bf16x8*)(SALL + (sch * 64 + 32 * it + l31) * 64 + 16 * ks + 8 * h), *(const bf16x8*)(PR + (sch * 32 + l31) * 64 + 16 * ks + 8 * h), acc[it]);
#pragma unroll
            for (int ks = 0; ks < 2; ++ks) acc[it] = MFMA32(*(const bf16x8*)(VTF + ((sch * 4 + it * 2 + ks) * 64 + lane) * 8), *(const bf16x8*)(ATG + (sch * 32 + l31) * 32 + 16 * ks + 8 * h), acc[it]); }
        float s1 = 0.f;
#pragma unroll
        for (int it = 0; it < 2; ++it)
#pragma unroll
            for (int r = 0; r < 16; ++r) s1 += acc[it][r];
        s1 += __shfl_xor(s1, 32); const float mean = s1 * (1.0f / 64.0f); float s2 = 0.f;
#pragma unroll
        for (int it = 0; it < 2; ++it)
#pragma unroll
            for (int r = 0; r < 16; ++r) { const float d = acc[it][r] - mean; s2 += d * d; }
        s2 += __shfl_xor(s2, 32); const float rstd = 1.0f / sqrtf(s2 * (1.0f / 64.0f) + 64e-5f);
        const int rr = sub_row(sc, l31);
        if (rr >= 0) { const float bon = BON[(size_t)rr * 16 + hd];
#pragma unroll
            for (int it = 0; it < 2; ++it)
#pragma unroll
                for (int g = 0; g < 4; ++g) { const int c = hd * 64 + 32 * it + 8 * g + 4 * h;
                    const f32x4 lw = *(const f32x4*)(a.in[15] + c), lb = *(const f32x4*)(a.in[16] + c), gt = *(const f32x4*)(GATE + (size_t)rr * 1024 + c); const v2u vw = *(const v2u*)(VV + (size_t)rr * 1024 + c);
                    const float o0 = ((acc[it][4 * g] - mean) * rstd * lw.x + lb.x + bon * bflo(vw.x)) * gt.x, o1 = ((acc[it][4 * g + 1] - mean) * rstd * lw.y + lb.y + bon * bfhi(vw.x)) * gt.y;
                    const float o2 = ((acc[it][4 * g + 2] - mean) * rstd * lw.z + lb.z + bon * bflo(vw.y)) * gt.z, o3 = ((acc[it][4 * g + 3] - mean) * rstd * lw.w + lb.w + bon * bfhi(vw.y)) * gt.w;
                    *(v2u*)(Y + (size_t)rr * DM + c) = (v2u){pk2(o0, o1), pk2(o2, o3)}; } }
    }
    lru_apply(F, a);
}

constexpr int N_PHASES = 28;
template <class Epi, class Sched> DI void run_gemm(const Frame& F, const pg8::Gemm& g, const Sched& S, const Epi& E) {
    pg8::gemm_phase<Epi, Sched, true, true>(F.lds + RING_OFF, g, S, E);
}
DI void ph_moe_up(const Frame& F, const Args& a) {
    const int nt = (int)__hip_atomic_load((gu32*)(a.ws + WS_TILES) + 127, RLX_AGENT);
    pg8::Gemm g{(const bf16*)(a.ws + WS_SCR + SC_XG), (const bf16*)(a.ws + WS_MOEW), DM, DM, DM};
    pg8::MoeOrder S{(const int*)(a.ws + WS_TILES), nt, 4, F.G, (int)blockIdx.x, (long)MOE_E_BYTES};
    pg8::EpiSwiglu E{(bf16*)(a.ws + WS_SCR + SC_ACT), FF};
    run_gemm(F, g, S, E);
}
DI void ph_moe_down(const Frame& F, const Args& a) {
    const int nt = (int)__hip_atomic_load((gu32*)(a.ws + WS_TILES) + 127, RLX_AGENT);
    pg8::Gemm g{(const bf16*)(a.ws + WS_SCR + SC_ACT), (const bf16*)(a.ws + WS_MOEW + MOE_W2_OFF), FF, FF, FF};
    pg8::MoeOrder S{(const int*)(a.ws + WS_TILES), nt, 8, F.G, (int)blockIdx.x, (long)MOE_E_BYTES};
    pg8::EpiBf16 E{(bf16*)(a.ws + WS_SCR + SC_YB), DM};
    run_gemm(F, g, S, E);
}

DI void gemm_tail16(const Frame& F, const Args& a, const bf16* A, int lda, const bf16* Wt, int K, int mode) {
    if (F.vcu >= 128) return;
    const int lane = F.lane, lc = lane & 15, quad = lane >> 4, w = F.vcu; LAS float* red = (LAS float*)(F.lds + RING_OFF);
    f32x4 acc = (f32x4){0.f, 0.f, 0.f, 0.f}; const int kw = K / NWAVES, kb = F.wave * kw;
    const bf16* ap = A + (size_t)(TX + lc) * lda + kb + 8 * quad; const bf16* bp = Wt + (size_t)(16 * w + lc) * K + kb + 8 * quad;
#pragma unroll 4
    for (int ks = 0; ks < kw / 32; ++ks) acc = __builtin_amdgcn_mfma_f32_16x16x32_bf16(*(const bf16x8*)(ap + 32 * ks), *(const bf16x8*)(bp + 32 * ks), acc, 0, 0, 0);
    *(LAS f32x4*)(red + (F.wave * 64 + lane) * 4) = acc;
    __syncthreads();
    if (F.wave == 0) { f32x4 s = *(const LAS f32x4*)(red + lane * 4);
#pragma unroll
        for (int v = 1; v < NWAVES; ++v) s = s + *(const LAS f32x4*)(red + (v * 64 + lane) * 4);
        float* H = (float*)(a.ws + WS_H);
#pragma unroll
        for (int r = 0; r < 4; ++r) { const int row = 4 * quad + r, col = 16 * w + lc; const float base = mode ? H[(size_t)(TX + row) * DM + col] : a.in[1][(size_t)row * DM + col];
            H[(size_t)(TX + row) * DM + col] = base + s[r]; } }
    __syncthreads();
}

__global__ void __launch_bounds__(NWAVES * 64, 2) hyb_fwd(Args a) {
    extern __shared__ __attribute__((aligned(16))) unsigned char lds[];
    Frame F;
    F.lds = (LAS unsigned char*)lds;
    F.MISC = (volatile LAS unsigned*)(F.lds + MISC_OFF);
    F.tid = threadIdx.x; F.lane = F.tid & 63; F.wave = __builtin_amdgcn_readfirstlane(F.tid >> 6);
    F.G = gridDim.x; { const int bx = blockIdx.x; F.vcu = (F.G % 8 == 0) ? (bx % 8) * (F.G / 8) + bx / 8 : bx; }
    F.gw = F.vcu * NWAVES + F.wave; F.NGW = F.G * NWAVES;
    F.ctl = (gu32*)(a.ws + WS_CTL);
    for (int u = F.tid; u < (LDS_BYTES - LDSCTL_OFF) / 4; u += NWAVES * 64) ((LAS unsigned*)(F.lds + LDSCTL_OFF))[u] = 0u;
    __syncthreads();
    XcdBarrier bar; bar.bar = (unsigned*)(F.ctl + CW_BAR); bar.x = 0; bar.st = nullptr;
    if (MK_ONE_LAUNCH) bar = xcd_barrier_post((unsigned*)(F.ctl + CW_BAR), F.MISC + 8);
    const int lo = a.ph_lo, hi = a.ph_hi;
#ifndef PH_MASK
#define PH_MASK 0xFFFFFFFFu
#endif
#define IN(k) (((PH_MASK >> (k)) & 1u) && lo <= (k) && (k) < hi)
#ifndef PROBE_REP
#define PROBE_REP 0u
#endif
#define REP(k) ((((unsigned)PROBE_REP >> (k)) & 1u) ? 2 : 1)
#ifdef PROBE_TS
#define STAMP(k) do { if (blockIdx.x == 0 && F.tid == 0) ((unsigned long long*)(F.ctl + CW_TS))[(k)] = __builtin_amdgcn_s_memrealtime(); } while (0)
#else
#define STAMP(k) do { } while (0)
#endif
#define SEAM(k) do { if (IN(k) && IN((k) + 1)) xcd_barrier(bar); STAMP((k) + 1); } while (0)
    const bf16* HN = (const bf16*)(a.ws + WS_HN); bf16* PROJ = (bf16*)(a.ws + WS_PROJ); const bf16* YMIX = (const bf16*)(a.ws + WS_YMIX); float* H = (float*)(a.ws + WS_H);

    STAMP(0);
    if (IN(0)) for (int rep_ = 0; rep_ < REP(0); ++rep_) { ph_prologue(F, a); ph_aux_convert(F, a, F.gw, F.NGW); }
    SEAM(0);
    if (IN(1)) for (int rep_ = 0; rep_ < REP(1); ++rep_) { pg8::Gemm g{HN, (const bf16*)(a.ws + WS_WEVIN), DM, DM, DM}; pg8::StaticOrder S; S.init(MP, EV_NP, F.G, (int)blockIdx.x); pg8::EpiBf16 E{PROJ, EV_NP}; run_gemm(F, g, S, E); }
    SEAM(1);
    if (IN(2)) for (int rep_ = 0; rep_ < REP(2); ++rep_) ph_even_prep(F, a);
    SEAM(2);
    if (IN(3)) for (int rep_ = 0; rep_ < REP(3); ++rep_) {
#ifndef NO_LORA
        { pg8::Gemm g{(const bf16*)(a.ws + WS_SCR + SC_ALORA), (const bf16*)(a.ws + WS_WLORA), 384, 384, 384}; pg8::StaticOrder S; S.init(MP, 3072, F.G, (int)blockIdx.x);
          static_assert(SC_ICL - SC_DEC == SC_GATE - SC_ICL, "lora outputs equally spaced");
          pg8::EpiLora E{(float*)(a.ws + WS_SCR + SC_DEC), (long)((SC_ICL - SC_DEC) / 4), a.in[7], a.in[9]}; run_gemm(F, g, S, E); }
#endif
#ifndef NO_GATES
        { pg8::Gemm g{(const bf16*)(a.ws + WS_SCR + SC_XR), (const bf16*)(a.ws + WS_WGATE), 256, 1024, 256}; pg8::StaticOrder S; S.init(MP, 2048, F.G, (int)blockIdx.x); S.amod = 4; S.astep = 512;
          pg8::EpiGates E{(float*)(a.ws + WS_SCR + SC_LA), (float*)(a.ws + WS_SCR + SC_LIX), a.in[20], a.in[22], a.in[23], (const bf16*)(a.ws + WS_SCR + SC_XR)}; run_gemm(F, g, S, E); }
#endif
    }
    SEAM(3);
    if (IN(4)) { lru_local(F, a); ph_rwkv_chunk(F, a, 0, 32, 0); }
    SEAM(4);
    if (IN(5)) { if (F.vcu < 16) ph_rwkv_chain(F, a, 0, 64); else ph_rwkv_chunk(F, a, 32, 62, 16); }
    SEAM(5);
    if (IN(6)) { if (F.vcu < 16) ph_rwkv_chain(F, a, 64, 124); else ph_rwkv_chunk(F, a, 62, 92, 16); }
    SEAM(6);
    if (IN(7)) { if (F.vcu < 16) ph_rwkv_chain(F, a, 124, 184); else ph_rwkv_chunk(F, a, 92, 122, 16); }
    SEAM(7);
    if (IN(8)) { if (F.vcu < 16) ph_rwkv_chain(F, a, 184, 244); else ph_rwkv_chunk(F, a, 122, 129, 16); }
    SEAM(8);
    if (IN(9)) { if (F.vcu < 18) ph_rwkv_chain(F, a, 244, RW_NSC); }
    SEAM(9);
    if (IN(10)) for (int rep_ = 0; rep_ < REP(10); ++rep_) ph_rwkv_out(F, a);
    SEAM(10);
    if (IN(11)) for (int rep_ = 0; rep_ < REP(11); ++rep_) { pg8::Gemm g{YMIX, (const bf16*)(a.ws + WS_WEVOUT), DM, DM, DM}; pg8::StaticOrder S; S.init(TX, DM, F.G, (int)blockIdx.x); pg8::EpiResid E{H, a.in[0], a.in[1], 0}; run_gemm(F, g, S, E); gemm_tail16(F, a, YMIX, DM, (const bf16*)(a.ws + WS_WEVOUT), DM, 0); }
    SEAM(11);
    if (IN(12)) for (int rep_ = 0; rep_ < REP(12); ++rep_) ph_route(F, a, 0, rep_);
    SEAM(12);
    if (IN(13)) for (int rep_ = 0; rep_ < REP(13); ++rep_) ph_gather(F, a, 0);
    SEAM(13);
    if (IN(14)) for (int rep_ = 0; rep_ < REP(14); ++rep_) ph_moe_up(F, a);
    SEAM(14);
    if (IN(15)) for (int rep_ = 0; rep_ < REP(15); ++rep_) ph_moe_down(F, a);
    SEAM(15);
    if (IN(16)) for (int rep_ = 0; rep_ < REP(16); ++rep_) ph_combine(F, a, 0);
    SEAM(16);
    if (IN(17)) for (int rep_ = 0; rep_ < REP(17); ++rep_) { pg8::Gemm g{HN, (const bf16*)(a.ws + WS_WODIN), DM, DM, DM}; pg8::StaticOrder S; S.init(MP, OD_NP, F.G, (int)blockIdx.x); pg8::EpiBf16 E{PROJ, OD_NP}; run_gemm(F, g, S, E); }
    SEAM(17);
    if (IN(18)) for (int rep_ = 0; rep_ < REP(18); ++rep_) ph_odd_prep(F, a);
    SEAM(18);
    if (IN(19)) for (int rep_ = 0; rep_ < REP(19); ++rep_) ph_gdn_chunk(F, a);
    SEAM(19);
    if (IN(20)) { ph_gdn_chain(F, a); if (REP(20) == 2) { __syncthreads(); ph_gdn_chain(F, a); } }
    SEAM(20);
    if (IN(21)) for (int rep_ = 0; rep_ < REP(21); ++rep_) { ph_odd_post(F, a); moe_convert(F, a, 1, F.gw, F.NGW); }
    SEAM(21);
    if (IN(22)) for (int rep_ = 0; rep_ < REP(22); ++rep_) { pg8::Gemm g{YMIX, (const bf16*)(a.ws + WS_WODOUT), 4096, 4096, 4096}; pg8::StaticOrder S; S.init(TX, DM, F.G, (int)blockIdx.x); pg8::EpiResid E{H, a.in[0], a.in[1], 1}; run_gemm(F, g, S, E); gemm_tail16(F, a, YMIX, 4096, (const bf16*)(a.ws + WS_WODOUT), 4096, 1); }
    SEAM(22);
    if (IN(23)) for (int rep_ = 0; rep_ < REP(23); ++rep_) ph_route(F, a, 1, rep_);
    SEAM(23);
    if (IN(24)) for (int rep_ = 0; rep_ < REP(24); ++rep_) ph_gather(F, a, 1);
    SEAM(24);
    if (IN(25)) for (int rep_ = 0; rep_ < REP(25); ++rep_) ph_moe_up(F, a);
    SEAM(25);
    if (IN(26)) for (int rep_ = 0; rep_ < REP(26); ++rep_) ph_moe_down(F, a);
    SEAM(26);
    if (IN(27)) for (int rep_ = 0; rep_ < REP(27); ++rep_) ph_combine(F, a, 1);
#undef IN
#undef SEAM
}

extern "C" void kernel_launch(void* const* d_in, const int* in_sizes, int n_in, void* d_out, int out_size, void* d_ws, size_t ws_size, hipStream_t stream) {
    static int grid = 0;
    if (grid == 0) {
        if (n_in != 36 || out_size != TX * DM || ws_size < WS_END) { fprintf(stderr, "kernel_launch: unexpected shapes (n_in %d, out %d, ws %zu)\n", n_in, out_size, ws_size); grid = -1; return; }
        int dev = 0, cus = 0, per_cu = 0;
        if (hipGetDevice(&dev) != hipSuccess || hipDeviceGetAttribute(&cus, hipDeviceAttributeMultiprocessorCount, dev) != hipSuccess) { grid = -1; return; }
        if (hipFuncSetAttribute((const void*)hyb_fwd, hipFuncAttributeMaxDynamicSharedMemorySize, LDS_BYTES) != hipSuccess) { fprintf(stderr, "kernel_launch: hipFuncSetAttribute failed\n"); grid = -1; return; }
        if (hipOccupancyMaxActiveBlocksPerMultiprocessor(&per_cu, (const void*)hyb_fwd, NWAVES * 64, LDS_BYTES) != hipSuccess || per_cu < 1) { fprintf(stderr, "kernel_launch: occupancy query says %d\n", per_cu); per_cu = 1; }
        (void)hipGetLastError();
        grid = cus;
    }
    if (grid < 0) return;
    if (hipMemsetAsync((char*)d_ws + WS_CTL, 0, CTL_ZERO_BYTES, stream) != hipSuccess) return;
    Args a{};
    for (int i = 0; i < 36; ++i) a.in[i] = (const float*)d_in[i];
    a.out = (float*)d_out; a.ws = (unsigned char*)d_ws;
#if MK_ONE_LAUNCH
    a.ph_lo = 0; a.ph_hi = N_PHASES;
    hipLaunchKernelGGL(hyb_fwd, dim3(grid), dim3(NWAVES * 64), LDS_BYTES, stream, a);
#else
    for (int p = 0; p < N_PHASES; ++p) { a.ph_lo = p; a.ph_hi = p + 1; hipLaunchKernelGGL(hyb_fwd, dim3(grid), dim3(NWAVES * 64), LDS_BYTES, stream, a); }
#endif
}
```

```cpp
#include <hip/hip_runtime.h>
#include <cstdio>
#include <cstdint>
#include <cmath>

#ifndef MK_ONE_LAUNCH
#define MK_ONE_LAUNCH 1
#endif

namespace pg8 {
#define PG8_LAS __attribute__((address_space(3)))
typedef unsigned short bf16_t;
typedef short bf16x8 __attribute__((ext_vector_type(8)));
typedef float f32x4 __attribute__((ext_vector_type(4)));
typedef unsigned u32x4 __attribute__((ext_vector_type(4)));
typedef unsigned u32x2 __attribute__((ext_vector_type(2)));
constexpr int BM = 256, BK = 64, HALF = 128, HTB = HALF * BK * 2  , STAGE_BYTES = 8 * HTB, NXCD = 8, WGM = 8;

__host__ __device__ __forceinline__ int lds_byte(int r, int c) { const int st = (r >> 4) * 2 + (c >> 5), rr = r & 15, cc = c & 31, ob = rr * 64 + cc * 2; return st * 1024 + (ob ^ (((ob >> 9) & 1) << 5)); }
__host__ __device__ __forceinline__ void stage_rc(int b, int& R, int& C) { const int st = b / 1024, sb = b % 1024, swz = sb ^ (((sb >> 9) & 1) << 5); R = (st >> 1) * 16 + swz / 64; C = (st & 1) * 32 + (swz % 64) / 2; }
__host__ __device__ __forceinline__ int perm32(int rho) { const int n = rho >> 4, i = rho & 15; return 8 * (i >> 2) + 4 * n + (i & 3); }

struct Unit { int pm, pn; long aoff, boff; };
struct Gemm { const bf16_t* A; const bf16_t* Bt; int K, lda, ldb; };

struct StaticOrder {
    int nM, nN, nwg, G, c, amod; long astep;
    __host__ __device__ void init(int M, int N, int G_, int c_) { nM = M / BM; nN = N / BM; nwg = nM * nN; G = G_; c = c_; amod = 0; astep = 0; }
    __host__ __device__ bool next(int i, Unit& u) const {
        const long L = (long)i * G + c; if (L >= nwg) return false;
        int wgid = (int)L; { const int q = nwg / NXCD, r = nwg % NXCD, xcd = wgid % NXCD, off = wgid / NXCD; wgid = (xcd < r ? xcd * (q + 1) : r * (q + 1) + (xcd - r) * q) + off; }
        const int nig = WGM * nN, gid = wgid / nig, fm = gid * WGM, gsz = (nM - fm) < WGM ? (nM - fm) : WGM;
        u.pm = fm + ((wgid % nig) % gsz); u.pn = (wgid % nig) / gsz; u.boff = 0; u.aoff = amod ? (long)(u.pn % amod) * astep : 0; return true;
    }
    __device__ __forceinline__ void a_ready(const Unit&) const {}
    __device__ __forceinline__ void done(const Unit&) const {}
};
struct MoeOrder {
    const int* tile_e; int ntiles, npn, G, c; long bstride;
    __device__ __forceinline__ bool next(int i, Unit& u) const {
        const long L = (long)i * G + c; if (L >= (long)ntiles * npn) return false;
        const int t = (int)(L / npn); u.pm = t; u.pn = (int)(L % npn); u.aoff = 0; u.boff = (long)tile_e[t] * bstride; return true;
    }
    __device__ __forceinline__ void a_ready(const Unit&) const {}
    __device__ __forceinline__ void done(const Unit&) const {}
};

__device__ __forceinline__ unsigned cvt_pk_bf16(float lo, float hi) { unsigned r; asm volatile("v_cvt_pk_bf16_f32 %0, %1, %2" : "=v"(r) : "v"(lo), "v"(hi)); return r; }
__device__ __forceinline__ float bf_lo(unsigned w) { return __uint_as_float(w << 16); }
__device__ __forceinline__ float bf_hi(unsigned w) { return __uint_as_float(w & 0xffff0000u); }
__device__ __forceinline__ float sigmoidf_(float x) { return 1.0f / (1.0f + __expf(-x)); }
__device__ __forceinline__ float softplusf_(float x) { return fmaxf(x, 0.f) + __logf(1.0f + __expf(-fabsf(x))); }

struct EpiBf16 {
    static constexpr bool PERM = true, AFTER_DRAIN = false;
    bf16_t* O; int ldc;
    __device__ __forceinline__ void operator()(const f32x4 (&acc)[2][2][4][2], const Unit& u, int wr, int wc, int fr, int fq) const {
        const int row0 = u.pm * BM + wr * 64 + fr; const int col0 = u.pn * BM + wc * 32 + 8 * fq;
#pragma unroll
        for (int ai = 0; ai < 2; ++ai)
#pragma unroll
            for (int m = 0; m < 4; ++m) { bf16_t* rowp = O + (size_t)(row0 + ai * HALF + m * 16) * ldc + col0;
#pragma unroll
                for (int bj = 0; bj < 2; ++bj) { const f32x4 v0 = acc[ai][bj][m][0], v1 = acc[ai][bj][m][1];
                    u32x4 w; w.x = cvt_pk_bf16(v0[0], v0[1]); w.y = cvt_pk_bf16(v0[2], v0[3]); w.z = cvt_pk_bf16(v1[0], v1[1]); w.w = cvt_pk_bf16(v1[2], v1[3]);
                    *(u32x4*)(rowp + bj * HALF) = w; } }
    }
};
struct EpiSwiglu {
    static constexpr bool PERM = true, AFTER_DRAIN = false;
    bf16_t* O; int ldc;
    __device__ __forceinline__ void operator()(const f32x4 (&acc)[2][2][4][2], const Unit& u, int wr, int wc, int fr, int fq) const {
        const int row0 = u.pm * BM + wr * 64 + fr; const int col0 = u.pn * HALF + wc * 32 + 8 * fq;
#pragma unroll
        for (int ai = 0; ai < 2; ++ai)
#pragma unroll
            for (int m = 0; m < 4; ++m) { bf16_t* rowp = O + (size_t)(row0 + ai * HALF + m * 16) * ldc + col0;
                float o[8];
#pragma unroll
                for (int n = 0; n < 2; ++n)
#pragma unroll
                    for (int j = 0; j < 4; ++j) { const float gq = acc[ai][0][m][n][j], uq = acc[ai][1][m][n][j]; o[4 * n + j] = gq * sigmoidf_(gq) * uq; }
                u32x4 w; w.x = cvt_pk_bf16(o[0], o[1]); w.y = cvt_pk_bf16(o[2], o[3]); w.z = cvt_pk_bf16(o[4], o[5]); w.w = cvt_pk_bf16(o[6], o[7]);
                *(u32x4*)rowp = w; }
    }
};
struct EpiResid {
    static constexpr bool PERM = false, AFTER_DRAIN = false;
    float* out; const float* x; const float* meta; int mode;
    __device__ __forceinline__ void operator()(const f32x4 (&acc)[2][2][4][2], const Unit& u, int wr, int wc, int fr, int fq) const {
        const int row0 = u.pm * BM + wr * 64 + fr, col0 = u.pn * BM + wc * 32 + 4 * fq;
#pragma unroll
        for (int ai = 0; ai < 2; ++ai)
#pragma unroll
            for (int m = 0; m < 4; ++m) { const int row = row0 + ai * HALF + m * 16; float* rowp = out + (size_t)row * 2048 + col0;
                const float* bp = mode ? rowp : (row < 8192 ? x + (size_t)row * 2048 + col0 : (row < 8208 ? meta + (size_t)(row - 8192) * 2048 + col0 : nullptr));
#pragma unroll
                for (int bj = 0; bj < 2; ++bj)
#pragma unroll
                    for (int n = 0; n < 2; ++n) { f32x4 b = (f32x4){0.f, 0.f, 0.f, 0.f}; if (bp) b = *(const f32x4*)(bp + bj * HALF + n * 16);
                        *(f32x4*)(rowp + bj * HALF + n * 16) = acc[ai][bj][m][n] + b; } }
    }
};
struct EpiLora {
    static constexpr bool PERM = false, AFTER_DRAIN = false;
    float* base; long gstride; const float* w0; const float* a0;
    __device__ __forceinline__ void operator()(const f32x4 (&acc)[2][2][4][2], const Unit& u, int wr, int wc, int fr, int fq) const {
        const int grp = u.pn >> 2; const int row0 = u.pm * BM + wr * 64 + fr, col0 = (u.pn & 3) * BM + wc * 32 + 4 * fq;
        float* O = base + (size_t)grp * gstride;
#pragma unroll
        for (int bj = 0; bj < 2; ++bj)
#pragma unroll
            for (int n = 0; n < 2; ++n) { const int c = col0 + bj * HALF + n * 16;
                f32x4 bv = (f32x4){0.f, 0.f, 0.f, 0.f}; if (grp == 0) bv = *(const f32x4*)(w0 + c); else if (grp == 1) bv = *(const f32x4*)(a0 + c);
#pragma unroll
                for (int ai = 0; ai < 2; ++ai)
#pragma unroll
                    for (int m = 0; m < 4; ++m) { f32x4 v = acc[ai][bj][m][n] + bv;
                        if (grp == 0) {
#pragma unroll
                            for (int j = 0; j < 4; ++j) { const float wl = -softplusf_(-v[j]) - 0.5f; v[j] = __expf(-__expf(wl)); }
                        } else if (grp == 1) {
#pragma unroll
                            for (int j = 0; j < 4; ++j) v[j] = sigmoidf_(v[j]);
                        }
                        *(f32x4*)(O + (size_t)(row0 + ai * HALF + m * 16) * 1024 + c) = v; } }
    }
};
struct EpiGates {
    static constexpr bool PERM = false, AFTER_DRAIN = false;
    float* lru_a; float* lru_ix; const float* ba; const float* bx; const float* lam; const bf16_t* xr;
    __device__ __forceinline__ void operator()(const f32x4 (&acc)[2][2][4][2], const Unit& u, int wr, int wc, int fr, int fq) const {
        const int grp = u.pn >> 2; const int row0 = u.pm * BM + wr * 64 + fr, col0 = (u.pn & 3) * BM + wc * 32 + 4 * fq;
#pragma unroll
        for (int bj = 0; bj < 2; ++bj)
#pragma unroll
            for (int n = 0; n < 2; ++n) { const int c = col0 + bj * HALF + n * 16;
                const f32x4 bv = *(const f32x4*)((grp == 0 ? ba : bx) + c); f32x4 sp = (f32x4){0.f, 0.f, 0.f, 0.f};
                if (grp == 0) { const f32x4 l = *(const f32x4*)(lam + c);
#pragma unroll
                    for (int j = 0; j < 4; ++j) sp[j] = -8.0f * softplusf_(-l[j]); }
#pragma unroll
                for (int ai = 0; ai < 2; ++ai)
#pragma unroll
                    for (int m = 0; m < 4; ++m) { const int row = row0 + ai * HALF + m * 16; f32x4 v = acc[ai][bj][m][n] + bv;
                        if (grp == 0) {
#pragma unroll
                            for (int j = 0; j < 4; ++j) v[j] = __expf(sigmoidf_(v[j]) * sp[j]);
                            *(f32x4*)(lru_a + (size_t)row * 1024 + c) = v;
                        } else { const u32x2 xw = *(const u32x2*)(xr + (size_t)row * 1024 + c);
                            v[0] = sigmoidf_(v[0]) * bf_lo(xw.x); v[1] = sigmoidf_(v[1]) * bf_hi(xw.x); v[2] = sigmoidf_(v[2]) * bf_lo(xw.y); v[3] = sigmoidf_(v[3]) * bf_hi(xw.y);
                            *(f32x4*)(lru_ix + (size_t)row * 1024 + c) = v; } } }
    }
};

template <class Epi, class Sched, bool ALIGN_EPI = false, bool SP2 = false>
__device__ __forceinline__ void gemm_phase(PG8_LAS unsigned char* lds, const Gemm g, const Sched& S, const Epi& E) {
    const int tid = threadIdx.x, wid = __builtin_amdgcn_readfirstlane(tid >> 6), lane = tid & 63, wr = wid >> 2, wc = wid & 3, fr = lane & 15, fq = lane >> 4;
    const int K = g.K, nt = K / BK;
    unsigned voffA[2], voffB[2];
#pragma unroll
    for (int i = 0; i < 2; ++i) { int R, C; stage_rc(tid * 16 + i * 8192, R, C); const int Rb = Epi::PERM ? ((R & ~31) + perm32(R & 31)) : R;
        voffA[i] = (unsigned)(R * g.lda + C) * 2u; voffB[i] = (unsigned)(Rb * g.ldb + C) * 2u; }
    const size_t kstep = (size_t)(BK * 2);
    const size_t hstepA = (size_t)HALF * g.lda * 2, hstepB = (size_t)HALF * g.ldb * 2;
    const size_t tstepA = 2 * hstepA, tstepB = 2 * hstepB;
    const unsigned ldsw = (unsigned)wid * 1024u;
    const int aoff = lds_byte(wr * 64 + fr, fq * 8), boff = lds_byte(wc * 32 + fr, fq * 8);
#define PG8_SA(b, h) (((b) * 2 + (h)) * HTB)
#define PG8_SB(b, h) ((4 + (b) * 2 + (h)) * HTB)
#define PG8_STAGE(bufoff, gbase, voff) do { _Pragma("unroll") for (int _i = 0; _i < 2; ++_i) \
        __builtin_amdgcn_global_load_lds((const unsigned*)((const char*)(gbase) + (voff)[_i]), (PG8_LAS unsigned*)(lds + (bufoff) + ldsw + _i * 8192), 16, 0, 0); } while (0)
#define PG8_LDA(dst, b, h) do { _Pragma("unroll") for (int m = 0; m < 4; ++m) _Pragma("unroll") for (int k = 0; k < 2; ++k) dst[m][k] = *(const PG8_LAS bf16x8*)(lds + PG8_SA(b, h) + aoff + m * 2048 + k * 1024); } while (0)
#define PG8_LDB(dst, b, h) do { _Pragma("unroll") for (int n = 0; n < 2; ++n) _Pragma("unroll") for (int k = 0; k < 2; ++k) dst[n][k] = *(const PG8_LAS bf16x8*)(lds + PG8_SB(b, h) + boff + n * 2048 + k * 1024); } while (0)
#define PG8_MMA(ai, bj, At, Bt) do { __builtin_amdgcn_s_setprio(1); _Pragma("unroll") for (int m = 0; m < 4; ++m) _Pragma("unroll") for (int n = 0; n < 2; ++n) _Pragma("unroll") for (int k = 0; k < 2; ++k) \
        acc[ai][bj][m][n] = __builtin_amdgcn_mfma_f32_16x16x32_bf16(Bt[n][k], At[m][k], acc[ai][bj][m][n], 0, 0, 0); __builtin_amdgcn_s_setprio(0); } while (0)
#define PG8_WAIT_V(n) asm volatile("s_waitcnt vmcnt(" #n ")" ::: "memory")
#define PG8_WAIT_L(n) asm volatile("s_waitcnt lgkmcnt(" #n ")" ::: "memory")
#define PG8_BAR __builtin_amdgcn_s_barrier()
#define PG8_SCHED __builtin_amdgcn_sched_barrier(0)
    Unit cur, nxt; int ui = 0;
    if (!S.next(0, cur)) return;
    f32x4 acc[2][2][4][2];
#pragma unroll
    for (int a = 0; a < 2; ++a)
#pragma unroll
        for (int b = 0; b < 2; ++b)
#pragma unroll
            for (int m = 0; m < 4; ++m)
#pragma unroll
                for (int n = 0; n < 2; ++n) acc[a][b][m][n] = (f32x4){0.f, 0.f, 0.f, 0.f};
    bf16x8 At[4][2], B0[2][2], B1[2][2];
    const char* cA = (const char*)g.A + (size_t)cur.pm * tstepA + cur.aoff; const char* cB = (const char*)g.Bt + (size_t)cur.pn * tstepB + cur.boff;
    S.a_ready(cur);
    if constexpr (SP2) {
        PG8_STAGE(PG8_SB(0, 0), cB, voffB); PG8_STAGE(PG8_SB(0, 1), cB + hstepB, voffB); PG8_STAGE(PG8_SA(0, 0), cA, voffA); PG8_STAGE(PG8_SA(0, 1), cA + hstepA, voffA);
        if (wr == 1) PG8_BAR;
        PG8_WAIT_V(2); PG8_BAR;
        PG8_STAGE(PG8_SB(1, 0), cB + kstep, voffB); PG8_STAGE(PG8_SA(1, 0), cA + kstep, voffA); PG8_STAGE(PG8_SB(1, 1), cB + hstepB + kstep, voffB);
        PG8_WAIT_V(6); PG8_BAR;
    } else {
        PG8_STAGE(PG8_SB(0, 0), cB, voffB); PG8_STAGE(PG8_SA(0, 0), cA, voffA); PG8_STAGE(PG8_SB(0, 1), cB + hstepB, voffB); PG8_STAGE(PG8_SA(0, 1), cA + hstepA, voffA);
        if (wr == 1) PG8_BAR;
        PG8_WAIT_V(4); PG8_BAR;
        PG8_STAGE(PG8_SB(1, 0), cB + kstep, voffB); PG8_STAGE(PG8_SA(1, 0), cA + kstep, voffA); PG8_STAGE(PG8_SB(1, 1), cB + hstepB + kstep, voffB);
        PG8_WAIT_V(6); PG8_BAR;
    }
    for (;;) {
        const bool has_next = S.next(ui + 1, nxt);
        const char* nA = has_next ? (const char*)g.A + (size_t)nxt.pm * tstepA + nxt.aoff : cA; const char* nB = has_next ? (const char*)g.Bt + (size_t)nxt.pn * tstepB + nxt.boff : cB;
        for (int t = 0; t < nt; t += 2) {
            const bool last = (t == nt - 2);
            const char* a1 = cA + (size_t)(t + 1) * kstep;
            const char* a2 = last ? nA : cA + (size_t)(t + 2) * kstep; const char* b2 = last ? nB : cB + (size_t)(t + 2) * kstep;
            const char* a3 = a2 + kstep; const char* b3 = b2 + kstep;
            if (last && has_next) S.a_ready(nxt);
            if constexpr (SP2) {
            PG8_LDB(B0, 0, 0); PG8_LDB(B1, 0, 1); PG8_SCHED; PG8_LDA(At, 0, 0); PG8_STAGE(PG8_SA(1, 1), a1 + hstepA, voffA);
            PG8_WAIT_V(8); PG8_WAIT_L(0); PG8_BAR; PG8_MMA(0, 0, At, B0); PG8_MMA(0, 1, At, B1); PG8_BAR; PG8_SCHED;
            PG8_LDA(At, 0, 1); PG8_STAGE(PG8_SB(0, 0), b2, voffB); PG8_STAGE(PG8_SB(0, 1), b2 + hstepB, voffB); PG8_STAGE(PG8_SA(0, 0), a2, voffA);
            PG8_WAIT_V(8); PG8_WAIT_L(0); PG8_BAR; PG8_MMA(1, 0, At, B0); PG8_MMA(1, 1, At, B1); PG8_BAR; PG8_SCHED;
            PG8_LDB(B0, 1, 0); PG8_LDB(B1, 1, 1); PG8_SCHED; PG8_LDA(At, 1, 0); PG8_STAGE(PG8_SA(0, 1), a2 + hstepA, voffA);
            PG8_WAIT_V(8); PG8_WAIT_L(0); PG8_BAR; PG8_MMA(0, 0, At, B0); PG8_MMA(0, 1, At, B1); PG8_BAR; PG8_SCHED;
            PG8_LDA(At, 1, 1); PG8_STAGE(PG8_SB(1, 0), b3, voffB); PG8_STAGE(PG8_SB(1, 1), b3 + hstepB, voffB); PG8_STAGE(PG8_SA(1, 0), a3, voffA);
            PG8_WAIT_V(8); PG8_WAIT_L(0); PG8_BAR; PG8_MMA(1, 0, At, B0); PG8_MMA(1, 1, At, B1); PG8_BAR; PG8_SCHED;
            } else {
            PG8_LDB(B0, 0, 0); PG8_SCHED; PG8_LDA(At, 0, 0); PG8_STAGE(PG8_SA(1, 1), a1 + hstepA, voffA);
            PG8_WAIT_L(8); PG8_BAR; PG8_WAIT_L(0); PG8_MMA(0, 0, At, B0); PG8_BAR; PG8_SCHED;
            PG8_LDB(B1, 0, 1); PG8_STAGE(PG8_SB(0, 0), b2, voffB);
            PG8_BAR; PG8_WAIT_L(0); PG8_MMA(0, 1, At, B1); PG8_BAR;
            PG8_LDA(At, 0, 1); PG8_STAGE(PG8_SA(0, 0), a2, voffA);
            PG8_BAR; PG8_WAIT_L(0); PG8_MMA(1, 0, At, B0); PG8_BAR; PG8_SCHED;
            PG8_STAGE(PG8_SB(0, 1), b2 + hstepB, voffB);
            PG8_WAIT_V(6); PG8_BAR; PG8_MMA(1, 1, At, B1); PG8_BAR;
            PG8_LDB(B0, 1, 0); PG8_SCHED; PG8_LDA(At, 1, 0); PG8_STAGE(PG8_SA(0, 1), a2 + hstepA, voffA);
            PG8_WAIT_L(8); PG8_BAR; PG8_WAIT_L(0); PG8_MMA(0, 0, At, B0); PG8_BAR; PG8_SCHED;
            PG8_LDB(B1, 1, 1); PG8_STAGE(PG8_SB(1, 0), b3, voffB);
            PG8_BAR; PG8_WAIT_L(0); PG8_MMA(0, 1, At, B1); PG8_BAR;
            PG8_LDA(At, 1, 1); PG8_STAGE(PG8_SA(1, 0), a3, voffA);
            PG8_BAR; PG8_WAIT_L(0); PG8_MMA(1, 0, At, B0); PG8_BAR; PG8_SCHED;
            PG8_STAGE(PG8_SB(1, 1), b3 + hstepB, voffB);
            PG8_WAIT_V(6); PG8_BAR; PG8_MMA(1, 1, At, B1); PG8_BAR;
            }
        }
        if constexpr (ALIGN_EPI) { if (wr == 0) PG8_BAR; }
        if constexpr (!Epi::AFTER_DRAIN) { E(acc, cur, wr, wc, fr, fq); S.done(cur); }
        if (!has_next) break;
#pragma unroll
        for (int a = 0; a < 2; ++a)
#pragma unroll
            for (int b = 0; b < 2; ++b)
#pragma unroll
                for (int m = 0; m < 4; ++m)
#pragma unroll
                    for (int n = 0; n < 2; ++n) acc[a][b][m][n] = (f32x4){0.f, 0.f, 0.f, 0.f};
        cur = nxt; cA = nA; cB = nB; ++ui;
        if constexpr (ALIGN_EPI) { if (wr == 1) PG8_BAR; }
    }
    PG8_WAIT_V(0);
    if constexpr (!ALIGN_EPI) { if (wr == 0) PG8_BAR; }
    PG8_BAR;
    if constexpr (Epi::AFTER_DRAIN) { E.fused(acc, cur, wr, wc, fr, fq, lds, wid, lane); S.done(cur); }
#undef PG8_SA
#undef PG8_SB
#undef PG8_STAGE
#undef PG8_LDA
#undef PG8_LDB
#undef PG8_MMA
#undef PG8_WAIT_V
#undef PG8_WAIT_L
#undef PG8_BAR
#undef PG8_SCHED
}
}
#define GAS __attribute__((address_space(1)))
#define LAS __attribute__((address_space(3)))
typedef unsigned short bf16;
typedef unsigned v4u __attribute__((ext_vector_type(4)));
typedef float f32x4 __attribute__((ext_vector_type(4)));
typedef short bf16x8 __attribute__((ext_vector_type(8)));
typedef GAS unsigned gu32;
typedef GAS unsigned long long gu64;
#define RLX_AGENT __ATOMIC_RELAXED, __HIP_MEMORY_SCOPE_AGENT
#define LDS_WAIT() asm volatile("s_waitcnt lgkmcnt(0)" ::: "memory")
#define VM_WAIT() asm volatile("s_waitcnt vmcnt(0)" ::: "memory")
__device__ __forceinline__ unsigned long long rt() { return __builtin_amdgcn_s_memrealtime(); }
__device__ __forceinline__ unsigned f2bf(float f) { unsigned u = __builtin_bit_cast(unsigned, f); return (u + 0x7fffu + ((u >> 16) & 1u)) >> 16; }
__device__ __forceinline__ unsigned pk2(float lo, float hi) { return f2bf(lo) | (f2bf(hi) << 16); }

#define XB_TMO      128
#define XB_XCNT(j)  (256  + 64 * (j))
#define XB_XSUB(j)  (1280 + 64 * (j))
#define XB_XGEN(j)  (2304 + 64 * (j))
#define XB_TOP      3328
#define XB_TOPGEN   3392
#define XCD_BAR_WORDS 3456
#define XB_SPIN_CAP (1u << 18)

__device__ __forceinline__ unsigned xb_ld(unsigned* p)              { return __hip_atomic_load(p, __ATOMIC_RELAXED, __HIP_MEMORY_SCOPE_AGENT); }
__device__ __forceinline__ unsigned xb_add(unsigned* p, unsigned v) { return __hip_atomic_fetch_add(p, v, __ATOMIC_RELAXED, __HIP_MEMORY_SCOPE_AGENT); }
__device__ __forceinline__ unsigned xb_xcc_id() { return (unsigned)__builtin_amdgcn_s_getreg((3 << 11) | 20) & 0xFu; }
#define XB_SPIN(cond, bar) do { unsigned _sp = 0; while (cond) { __builtin_amdgcn_s_sleep(1); \
    if ((++_sp & 255u) == 0u) { if (xb_ld(&(bar)[XB_TMO])) break; if (_sp > XB_SPIN_CAP) { atomicAdd(&(bar)[XB_TMO], 1u); break; } } } } while (0)

struct XcdBarrier {
    unsigned* bar; unsigned x;
    volatile LAS unsigned* st;
};

__device__ __forceinline__ XcdBarrier xcd_barrier_post(unsigned* bar, volatile LAS unsigned* st) {
    XcdBarrier b; b.bar = bar; b.x = xb_xcc_id(); b.st = st;
    if (threadIdx.x == 0) (void)xb_add(&bar[XB_XCNT(b.x)], 1u);
    return b;
}
__device__ __forceinline__ void xcd_barrier_complete(unsigned* bar, unsigned x, unsigned& nloc, unsigned& nx) {
    const unsigned G = gridDim.x * gridDim.y * gridDim.z;
    unsigned sum, cnt, mine, sp = 0u;
    for (;;) {
        sum = 0u; cnt = 0u; mine = 0u;
#pragma unroll
        for (unsigned j = 0; j < 16; ++j) { const unsigned c = xb_ld(&bar[XB_XCNT(j)]); sum += c; cnt += (c > 0u) ? 1u : 0u; mine = (j == x) ? c : mine; }
        if (sum == G) break;
        __builtin_amdgcn_s_sleep(1);
        if ((++sp & 255u) == 0u) { if (xb_ld(&bar[XB_TMO])) break; if (sp > XB_SPIN_CAP) { atomicAdd(&bar[XB_TMO], 1u); break; } }
    }
    nloc = mine > 0u ? mine : 1u; nx = cnt > 0u ? cnt : 1u;
}

__device__ __forceinline__ void xcd_barrier(const XcdBarrier& b) {
    asm volatile("s_waitcnt vmcnt(0)" ::: "memory");
    __syncthreads();
    if (threadIdx.x == 0) {
        unsigned* bar = b.bar;
        __builtin_amdgcn_s_waitcnt(0);
        unsigned nloc = b.st[0], nx = b.st[1];
        if (nloc == 0u) { xcd_barrier_complete(bar, b.x, nloc, nx); b.st[0] = nloc; b.st[1] = nx; }
        const unsigned old = xb_add(&bar[XB_XSUB(b.x)], 1u);
        const unsigned gen = old / nloc;
        if (old + 1u == (gen + 1u) * nloc) {
            __builtin_amdgcn_fence(__ATOMIC_RELEASE, "agent");
            asm volatile("s_waitcnt vmcnt(0)" ::: "memory");
            const unsigned og = xb_add(&bar[XB_TOP], 1u);
            const unsigned tg = og / nx;
            if (og + 1u == (tg + 1u) * nx) xb_add(&bar[XB_TOPGEN], 1u);
            else XB_SPIN(xb_ld(&bar[XB_TOPGEN]) == tg, bar);
            __builtin_amdgcn_fence(__ATOMIC_ACQUIRE, "agent");
            xb_add(&bar[XB_XGEN(b.x)], 1u);
            asm volatile("s_waitcnt vmcnt(0)" ::: "memory");
        } else {
            XB_SPIN(xb_ld(&bar[XB_XGEN(b.x)]) == gen, bar);
            __builtin_amdgcn_fence(__ATOMIC_ACQUIRE, "agent");
            asm volatile("s_waitcnt vmcnt(0)" ::: "memory");
        }
    }
    __syncthreads();
}

constexpr int NWAVES = 8;
constexpr int DM = 2048, TX = 8192, NMETA = 16, TT = TX + NMETA, MP = 8448;
constexpr int EV_NP = 5632, EV_LORA0 = 3072, EV_GB = 3360, EV_REC = 4384;
constexpr int OD_NP = 12544, OD_Z = 8192, OD_B = 12288, OD_A = 12320;
constexpr int NEXP = 32, FF = 512, MOE_ROWS = 24576;
constexpr float NORM_EPS = 1e-6f;

constexpr size_t MiB = 1u << 20;
constexpr size_t WS_CTL = 0, CTL_ZERO_BYTES = 1 * MiB;
constexpr size_t WS_TOKINFO = 1 * MiB;
constexpr size_t WS_TILES = 1 * MiB + 512 * 1024;
constexpr size_t WS_WEVIN = 2 * MiB;
constexpr size_t WS_WEVOUT = 24 * MiB;
constexpr size_t WS_WODIN = 32 * MiB;
constexpr size_t WS_WODOUT = 81 * MiB;
constexpr size_t WS_WLORA = 97 * MiB;
constexpr size_t WS_WGATE = 100 * MiB;
constexpr size_t WS_WROUTE = 101 * MiB;
constexpr size_t WS_MOEW = 102 * MiB;
constexpr size_t MOE_E_BYTES = 6 * MiB, MOE_W2_OFF = 4 * MiB;
constexpr size_t WS_H = 294 * MiB;
constexpr size_t WS_HN = 360 * MiB;
constexpr size_t WS_YMIX = 393 * MiB;
constexpr size_t WS_PROJ = 459 * MiB;
constexpr size_t WS_SCR = 662 * MiB;
constexpr size_t WS_END = 932 * MiB;
constexpr size_t SC_ALORA = 0;
constexpr size_t SC_XR = 8 * MiB;
constexpr size_t SC_DEC = 26 * MiB, SC_ICL = 60 * MiB, SC_GATE = 94 * MiB;
constexpr size_t SC_LA = 128 * MiB, SC_LIX = 162 * MiB;
constexpr size_t SC_QN = 0, SC_KN = 34 * MiB;
constexpr size_t SC_VC = 68 * MiB;
constexpr size_t SC_BETA = 134 * MiB, SC_G = 136 * MiB;
constexpr size_t SC_O = 138 * MiB;
constexpr size_t SC_XG = 0;
constexpr size_t SC_ACT = 96 * MiB;
constexpr size_t SC_YB = 120 * MiB;
static_assert(SC_O + (size_t)MP * 4096 * 4 <= WS_END - WS_SCR && SC_YB + (size_t)MOE_ROWS * 2048 * 2 <= WS_END - WS_SCR && SC_LIX + (size_t)MP * 1024 * 4 <= WS_END - WS_SCR, "scratch map");
constexpr int CW_TMO = 0, CW_CODE = 1;
constexpr int CW_BAR = 4096;
constexpr int CW_PROG = 20480;
constexpr int CW_TS = 24576;
constexpr int CW_MOECNT = 16384;

constexpr int RING_OFF = 0, RING_BYTES = 131072;
constexpr int LDSCTL_OFF = 146944, MISC_OFF = LDSCTL_OFF + 320;
constexpr int LDS_BYTES = 147456;


#define DI __device__ __forceinline__
typedef unsigned v2u __attribute__((ext_vector_type(2)));
struct Args { const float* in[36]; float* out; unsigned char* ws; int ph_lo, ph_hi; };
struct Frame {
    LAS unsigned char* lds; volatile LAS unsigned* MISC; gu32* ctl;
    int tid, lane, wave, vcu, G, gw, NGW;
};
DI float bf2f(bf16 v) { return __uint_as_float((unsigned)v << 16); }
DI float bflo(unsigned w) { return __uint_as_float(w << 16); }
DI float bfhi(unsigned w) { return __uint_as_float(w & 0xffff0000u); }
DI float wave_sum(float v) {
#pragma unroll
    for (int o = 1; o < 64; o <<= 1) v += __shfl_xor(v, o);
    return v;
}
DI float sigm(float x) { return 1.0f / (1.0f + __expf(-x)); }
DI float softplus(float x) { return fmaxf(x, 0.f) + __logf(1.0f + __expf(-fabsf(x))); }
DI float gelu_tanh(float x) { const float u = 0.7978845608028654f * (x + 0.044715f * x * x * x); return 0.5f * x * (1.0f + tanhf(u)); }
DI int pos_row(int p) { return p < NMETA ? TX + p : p - NMETA; }
DI int row_pos(int r) { return r < TX ? r + NMETA : r - TX; }

DI void tr_item(const float* W, int N, int k0, int n0, bf16* WT, int ldk, int drow0, LAS float* scr, int lane) {
#pragma unroll 8
    for (int i = 0; i < 32; ++i) { const int kk = 2 * i + (lane >> 5); scr[kk * 33 + (lane & 31)] = W[(size_t)(k0 + kk) * N + n0 + (lane & 31)]; }
    LDS_WAIT(); asm volatile("" ::: "memory");
    const int c = lane & 7;
#pragma unroll
    for (int j = 0; j < 4; ++j) { const int n = (lane >> 3) + 8 * j; const LAS float* s = scr + (8 * c) * 33 + n;
        v4u o; o.x = pk2(s[0 * 33], s[1 * 33]); o.y = pk2(s[2 * 33], s[3 * 33]); o.z = pk2(s[4 * 33], s[5 * 33]); o.w = pk2(s[6 * 33], s[7 * 33]);
        *(v4u*)(WT + (size_t)(drow0 + n) * ldk + k0 + 8 * c) = o; }
    LDS_WAIT(); asm volatile("" ::: "memory");
}
DI void moe_convert(const Frame& F, const Args& a, int l, int gw, int ngw) {
    LAS float* scr = (LAS float*)(F.lds + RING_OFF + F.wave * 16384);
    bf16* base = (bf16*)(a.ws + WS_MOEW);
    for (int it = gw; it < NEXP * 1536; it += ngw) {
        const int e = it / 1536; int j = it % 1536; bf16* eb = base + (size_t)e * (MOE_E_BYTES / 2);
        const size_t eoff = (size_t)(l * NEXP + e) * DM * FF;
        if (j < 1024) { const float* W = (j < 512 ? a.in[33] : a.in[34]) + eoff; const int hi = j >= 512; j &= 511; const int kb = j >> 4, nb = j & 15, n0 = 32 * nb;
            tr_item(W, FF, 64 * kb, n0, eb, DM, 256 * (n0 >> 7) + 128 * hi + (n0 & 127), scr, F.lane); }
        else { j -= 1024; const int kb = j >> 6, nb = j & 63; tr_item(a.in[35] + eoff, DM, 64 * kb, 32 * nb, eb + MOE_W2_OFF / 2, FF, 32 * nb, scr, F.lane); }
    }
}
DI void norm_row_bf16(int lane, const float* src, const float* w, bf16* dst) {
    f32x4 v[8]; float s = 0.f;
#pragma unroll
    for (int j = 0; j < 8; ++j) { v[j] = ((const f32x4*)src)[lane + 64 * j]; s += (v[j].x * v[j].x + v[j].y * v[j].y) + (v[j].z * v[j].z + v[j].w * v[j].w); }
    const float rs = 1.0f / sqrtf(wave_sum(s) * (1.0f / DM) + NORM_EPS);
#pragma unroll
    for (int j = 0; j < 8; ++j) { const f32x4 wv = ((const f32x4*)w)[lane + 64 * j]; v2u o; o.x = pk2(v[j].x * rs * wv.x, v[j].y * rs * wv.y); o.y = pk2(v[j].z * rs * wv.z, v[j].w * rs * wv.w);
        ((v2u*)dst)[lane + 64 * j] = o; }
}

DI void ph_prologue(const Frame& F, const Args& a) {
    LAS float* scr = (LAS float*)(F.lds + RING_OFF + F.wave * 16384);
    constexpr int I_A = 32 * 169, I_B = 32 * 64, NIT = I_A + I_B;
    for (int it = F.gw; it < NIT; it += F.NGW) {
        int r = it;
        if (r < I_A) { const int kb = r / 169, nb = r % 169; tr_item(a.in[5], 5408, 64 * kb, 32 * nb, (bf16*)(a.ws + WS_WEVIN), DM, 32 * nb, scr, F.lane); continue; } r -= I_A;
        { const int kb = r / 64, nb = r % 64; tr_item(a.in[24], DM, 64 * kb, 32 * nb, (bf16*)(a.ws + WS_WEVOUT), DM, 32 * nb, scr, F.lane); }
    }
    const int gt = F.vcu * (NWAVES * 64) + F.tid, NGT = F.G * NWAVES * 64;
    { bf16* WL = (bf16*)(a.ws + WS_WLORA); const float* wup = a.in[8]; const float* aup = a.in[10]; const float* gup = a.in[11];
      for (int idx = gt; idx < 3072 * 384; idx += NGT) { const int n = idx / 384, k = idx % 384; float v = 0.f;
          if (n < 1024) { if (k < 64) v = wup[k * 1024 + n]; }
          else if (n < 2048) { if (k >= 64 && k < 128) v = aup[(k - 64) * 1024 + n - 1024]; }
          else { if (k >= 128 && k < 288) v = gup[(k - 128) * 1024 + n - 2048]; }
          WL[idx] = (bf16)f2bf(v); } }
    { bf16* WG = (bf16*)(a.ws + WS_WGATE);
      for (int idx = gt; idx < 2048 * 256; idx += NGT) { const int n = idx >> 8, kk = idx & 255, nn = n & 1023, blk = nn >> 6, j = nn & 63, cin = (nn & ~255) + kk;
          const float* W = n < 1024 ? a.in[19] : a.in[21];
          const float v = (cin >> 6) == blk ? W[blk * 4096 + (cin & 63) * 64 + j] : 0.f;
          WG[idx] = (bf16)f2bf(v); } }
    { bf16* WR = (bf16*)(a.ws + WS_WROUTE);
      for (int idx = gt; idx < 2 * 48 * DM; idx += NGT) { const int l = idx / (48 * DM), n = (idx / DM) % 48, k = idx % DM; float v = 0.f;
          if (n < 32) v = a.in[32][((size_t)l * DM + k) * NEXP + n]; else if (n < 36) v = a.in[31][((size_t)l * DM + k) * 4 + n - 32];
          const unsigned hi = f2bf(v); WR[((size_t)(l * 2) * 48 + n) * DM + k] = (bf16)hi; WR[((size_t)(l * 2 + 1) * 48 + n) * DM + k] = (bf16)f2bf(v - __uint_as_float(hi << 16)); } }
    bf16* HN = (bf16*)(a.ws + WS_HN);
    for (int r = F.gw; r < TT; r += F.NGW) norm_row_bf16(F.lane, r < TX ? a.in[0] + (size_t)r * DM : a.in[1] + (size_t)(r - TX) * DM, a.in[2], HN + (size_t)r * DM);
}

DI void ph_aux_convert(const Frame& F, const Args& a, int gw, int ngw) {
    LAS float* scr = (LAS float*)(F.lds + RING_OFF + F.wave * 16384);
    constexpr int I_C = 32 * 386, I_D = 64 * 64, NIT = I_C + I_D;
    for (int it = gw; it < NIT; it += ngw) {
        int r = it;
        if (r < I_C) { const int kb = r / 386, nb = r % 386; tr_item(a.in[25], 12352, 64 * kb, 32 * nb, (bf16*)(a.ws + WS_WODIN), DM, 32 * nb, scr, F.lane); continue; } r -= I_C;
        { const int kb = r / 64, nb = r % 64; tr_item(a.in[30], DM, 64 * kb, 32 * nb, (bf16*)(a.ws + WS_WODOUT), 4096, 32 * nb, scr, F.lane); }
    }
    moe_convert(F, a, 0, gw, ngw);
}

DI void ph_even_prep(const Frame& F, const Args& a) {
    const bf16* P = (const bf16*)(a.ws + WS_PROJ); bf16* AL = (bf16*)(a.ws + WS_SCR + SC_ALORA); bf16* XR = (bf16*)(a.ws + WS_SCR + SC_XR);
    const float* mu = a.in[6]; const float* cw = a.in[17]; const float* cb = a.in[18];
    const int lane = F.lane;
    for (int item = F.gw; item < TT + (TT / 8) * 2; item += F.NGW) {
        if (item < TT) { const int r = item, pos = row_pos(r); const bf16* cur = P + (size_t)r * EV_NP; const bf16* prv = P + (size_t)pos_row(pos > 0 ? pos - 1 : 0) * EV_NP; const float pm = pos > 0 ? 1.f : 0.f;
            float cv[6], pv[6], mv[6];
#pragma unroll
            for (int i = 0; i < 6; ++i) { const int idx = lane + 64 * i, col = EV_LORA0 + (idx < 288 ? idx : 287); cv[i] = bf2f(cur[col]); pv[i] = bf2f(prv[col]) * pm; mv[i] = mu[col]; }
#pragma unroll
            for (int i = 0; i < 6; ++i) { const int idx = lane + 64 * i; float v = cv[i] + (pv[i] - cv[i]) * mv[i];
                if (idx < 64) v = tanhf(v); else if (idx >= 128) v = sigm(v);
                AL[(size_t)r * 384 + idx] = (bf16)f2bf(idx < 288 ? v : 0.f); }
        } else { const int it2 = item - TT, pb = it2 >> 1, c0 = (it2 & 1) * 512 + lane * 8, p0 = pb * 8;
            f32x4 w[4][2], b0 = *(const f32x4*)(cb + c0), b1 = *(const f32x4*)(cb + c0 + 4);
#pragma unroll
            for (int j = 0; j < 4; ++j) { w[j][0] = *(const f32x4*)(cw + j * 1024 + c0); w[j][1] = *(const f32x4*)(cw + j * 1024 + c0 + 4); }
            v4u x[11];
#pragma unroll
            for (int i = 0; i < 11; ++i) { const int p = p0 - 3 + i; x[i] = *(const v4u*)(P + (size_t)pos_row(p > 0 ? p : 0) * EV_NP + EV_REC + c0); if (p < 0) x[i] = (v4u){0u, 0u, 0u, 0u}; }
#pragma unroll
            for (int o = 0; o < 8; ++o) { float acc[8] = {b0.x, b0.y, b0.z, b0.w, b1.x, b1.y, b1.z, b1.w};
#pragma unroll
                for (int j = 0; j < 4; ++j) { const v4u xv = x[o + j];
                    acc[0] += w[j][0].x * bflo(xv.x); acc[1] += w[j][0].y * bfhi(xv.x); acc[2] += w[j][0].z * bflo(xv.y); acc[3] += w[j][0].w * bfhi(xv.y);
                    acc[4] += w[j][1].x * bflo(xv.z); acc[5] += w[j][1].y * bfhi(xv.z); acc[6] += w[j][1].z * bflo(xv.w); acc[7] += w[j][1].w * bfhi(xv.w); }
                *(v4u*)(XR + (size_t)pos_row(p0 + o) * 1024 + c0) = (v4u){pk2(acc[0], acc[1]), pk2(acc[2], acc[3]), pk2(acc[4], acc[5]), pk2(acc[6], acc[7])}; } }
    }
}

DI void ph_route(const Frame& F, const Args& a, int l, int dummy) {
    const float* H = (const float*)(a.ws + WS_H); const float* nw = a.in[3] + (size_t)l * DM;
    const bf16* WH = (const bf16*)(a.ws + WS_WROUTE) + (size_t)(l * 2) * 48 * DM; const bf16* WL = WH + (size_t)48 * DM;
    unsigned* TI = (unsigned*)(a.ws + WS_TOKINFO) + (dummy ? (WS_SCR + 250 * MiB - WS_TOKINFO) / 4 : 0); const int lane = F.lane, lc = lane & 15, quad = lane >> 4; const int cl = dummy ? l + 2 : l;
    LAS float* scr = (LAS float*)(F.lds + RING_OFF + F.wave * 16384);
    for (int task = F.gw; task < TT / 16; task += F.NGW) {
        const int r = task * 16 + lc; const float* hr = H + (size_t)r * DM + 8 * quad; float ss = 0.f;
#pragma unroll 8
        for (int ks = 0; ks < 64; ++ks) { const f32x4 x0 = *(const f32x4*)(hr + 32 * ks), x1 = *(const f32x4*)(hr + 32 * ks + 4); ss += (x0.x * x0.x + x0.y * x0.y) + (x0.z * x0.z + x0.w * x0.w) + (x1.x * x1.x + x1.y * x1.y) + (x1.z * x1.z + x1.w * x1.w); }
        ss += __shfl_xor(ss, 16); ss += __shfl_xor(ss, 32);
        const float rs = 1.0f / sqrtf(ss * (1.0f / DM) + NORM_EPS);
        f32x4 acc[3];
#pragma unroll
        for (int nt = 0; nt < 3; ++nt) acc[nt] = (f32x4){0.f, 0.f, 0.f, 0.f};
#pragma unroll 2
        for (int ks = 0; ks < 64; ++ks) { const int k0 = 32 * ks + 8 * quad; const f32x4 x0 = *(const f32x4*)(hr + 32 * ks), x1 = *(const f32x4*)(hr + 32 * ks + 4), w0 = *(const f32x4*)(nw + k0), w1 = *(const f32x4*)(nw + k0 + 4);
            const float xn[8] = {x0.x * rs * w0.x, x0.y * rs * w0.y, x0.z * rs * w0.z, x0.w * rs * w0.w, x1.x * rs * w1.x, x1.y * rs * w1.y, x1.z * rs * w1.z, x1.w * rs * w1.w};
            unsigned hi[8]; float lo[8];
#pragma unroll
            for (int q = 0; q < 8; ++q) { hi[q] = f2bf(xn[q]); lo[q] = xn[q] - __uint_as_float(hi[q] << 16); }
            const v4u ah4 = (v4u){hi[0] | (hi[1] << 16), hi[2] | (hi[3] << 16), hi[4] | (hi[5] << 16), hi[6] | (hi[7] << 16)}, al4 = (v4u){pk2(lo[0], lo[1]), pk2(lo[2], lo[3]), pk2(lo[4], lo[5]), pk2(lo[6], lo[7])};
            const bf16x8 ah = __builtin_bit_cast(bf16x8, ah4), al = __builtin_bit_cast(bf16x8, al4);
#pragma unroll
            for (int nt = 0; nt < 3; ++nt) { const bf16x8 bh = *(const bf16x8*)(WH + (size_t)(16 * nt + lc) * DM + k0), bl = *(const bf16x8*)(WL + (size_t)(16 * nt + lc) * DM + k0);
                acc[nt] = __builtin_amdgcn_mfma_f32_16x16x32_bf16(al, bh, acc[nt], 0, 0, 0); acc[nt] = __builtin_amdgcn_mfma_f32_16x16x32_bf16(ah, bl, acc[nt], 0, 0, 0); acc[nt] = __builtin_amdgcn_mfma_f32_16x16x32_bf16(ah, bh, acc[nt], 0, 0, 0); } }
#pragma unroll
        for (int nt = 0; nt < 3; ++nt)
#pragma unroll
            for (int q = 0; q < 4; ++q) scr[(4 * quad + q) * 49 + 16 * nt + lc] = acc[nt][q];
        asm volatile("s_waitcnt lgkmcnt(0)" ::: "memory"); __builtin_amdgcn_wave_barrier();
        if (lane < 16) { float lg[36];
#pragma unroll
            for (int i = 0; i < 36; ++i) lg[i] = scr[lane * 49 + i];
            int gi = 0; float gm = lg[32];
#pragma unroll
            for (int i = 1; i < 4; ++i) if (lg[32 + i] > gm) { gm = lg[32 + i]; gi = i; }
            float den = 0.f;
#pragma unroll
            for (int i = 0; i < 4; ++i) den += __expf(lg[32 + i] - gm);
            const float gp = 1.0f / den;
            float l8[8];
#pragma unroll
            for (int i = 0; i < 8; ++i) l8[i] = gi == 0 ? lg[i] : (gi == 1 ? lg[8 + i] : (gi == 2 ? lg[16 + i] : lg[24 + i]));
            int i1 = 0; float m1 = l8[0];
#pragma unroll
            for (int i = 1; i < 8; ++i) if (l8[i] > m1) { m1 = l8[i]; i1 = i; }
            int i2 = -1; float m2 = -INFINITY;
#pragma unroll
            for (int i = 0; i < 8; ++i) if (i != i1 && l8[i] > m2) { m2 = l8[i]; i2 = i; }
            const float e21 = __expf(m2 - m1); const float w1 = gp / (1.0f + e21), w2 = gp * e21 / (1.0f + e21);
            const int ea = gi * 8 + i1, eb = gi * 8 + i2;
            const unsigned sa = atomicAdd((unsigned*)(F.ctl + CW_MOECNT + (cl * NEXP + ea) * 16), 1u), sb = atomicAdd((unsigned*)(F.ctl + CW_MOECNT + (cl * NEXP + eb) * 16), 1u);
            unsigned* t = TI + (size_t)r * 8; *(v4u*)t = (v4u){(unsigned)ea, sa, __float_as_uint(w1), (unsigned)eb}; *(v4u*)(t + 4) = (v4u){sb, __float_as_uint(w2), __float_as_uint(rs), 0u}; }
        __builtin_amdgcn_wave_barrier(); asm volatile("" ::: "memory");
    }
}
DI void moe_prefix(const Frame& F, int l, LAS int* ps) {
    if (F.tid == 0) { int t = 0;
        for (int e = 0; e < NEXP; ++e) { const unsigned c = __hip_atomic_load(F.ctl + CW_MOECNT + (l * NEXP + e) * 16, RLX_AGENT); ps[e] = t * 256; t += (int)((c + 255u) >> 8); }
        ps[32] = t; }
    __syncthreads();
}
DI void ph_gather(const Frame& F, const Args& a, int l) {
    LAS int* ps = (LAS int*)(F.lds + RING_OFF); moe_prefix(F, l, ps);
    if (F.vcu == 0 && F.tid < NEXP) { int* TE = (int*)(a.ws + WS_TILES); const int e = F.tid; const int t0 = ps[e] >> 8, t1 = (e == NEXP - 1 ? ps[32] : ps[e + 1] >> 8);
        for (int t = t0; t < t1; ++t) TE[t] = e; if (e == 0) TE[127] = ps[32]; }
    const float* H = (const float*)(a.ws + WS_H); const float* nw = a.in[3] + (size_t)l * DM; unsigned* TI = (unsigned*)(a.ws + WS_TOKINFO); bf16* XG = (bf16*)(a.ws + WS_SCR + SC_XG);
    const int lane = F.lane;
    for (int r = F.gw; r < TT; r += F.NGW) {
        unsigned* t = TI + (size_t)r * 8; const int g0 = ps[t[0]] + (int)t[1], g1 = ps[t[3]] + (int)t[4]; const float rs = __uint_as_float(t[6]);
        if (lane == 0) { t[1] = (unsigned)g0; t[4] = (unsigned)g1; }
        const float* hr = H + (size_t)r * DM;
#pragma unroll
        for (int j = 0; j < 4; ++j) { const int e0 = (lane + 64 * j) * 8; const f32x4 x0 = *(const f32x4*)(hr + e0), x1 = *(const f32x4*)(hr + e0 + 4), w0 = *(const f32x4*)(nw + e0), w1 = *(const f32x4*)(nw + e0 + 4);
            v4u o; o.x = pk2(x0.x * rs * w0.x, x0.y * rs * w0.y); o.y = pk2(x0.z * rs * w0.z, x0.w * rs * w0.w); o.z = pk2(x1.x * rs * w1.x, x1.y * rs * w1.y); o.w = pk2(x1.z * rs * w1.z, x1.w * rs * w1.w);
            *(v4u*)(XG + (size_t)g0 * DM + e0) = o; *(v4u*)(XG + (size_t)g1 * DM + e0) = o; }
    }
}
DI void ph_combine(const Frame& F, const Args& a, int l) {
    float* H = (float*)(a.ws + WS_H); const unsigned* TI = (const unsigned*)(a.ws + WS_TOKINFO); const bf16* YB = (const bf16*)(a.ws + WS_SCR + SC_YB); bf16* HN = (bf16*)(a.ws + WS_HN);
    const int lane = F.lane; const int nrows = l == 0 ? TT : TX;
    for (int r = F.gw; r < nrows; r += F.NGW) {
        const unsigned* t = TI + (size_t)r * 8; const int g0 = (int)t[1], g1 = (int)t[4]; const float w0 = __uint_as_float(t[2]), w1 = __uint_as_float(t[5]);
        float* hr = H + (size_t)r * DM; float hv[32]; float s = 0.f;
#pragma unroll
        for (int j = 0; j < 4; ++j) { const int e0 = (lane + 64 * j) * 8; const f32x4 x0 = *(const f32x4*)(hr + e0), x1 = *(const f32x4*)(hr + e0 + 4);
            const v4u ya = *(const v4u*)(YB + (size_t)g0 * DM + e0), yc = *(const v4u*)(YB + (size_t)g1 * DM + e0);
            float* o = hv + 8 * j;
            o[0] = x0.x + w0 * bflo(ya.x) + w1 * bflo(yc.x); o[1] = x0.y + w0 * bfhi(ya.x) + w1 * bfhi(yc.x); o[2] = x0.z + w0 * bflo(ya.y) + w1 * bflo(yc.y); o[3] = x0.w + w0 * bfhi(ya.y) + w1 * bfhi(yc.y);
            o[4] = x1.x + w0 * bflo(ya.z) + w1 * bflo(yc.z); o[5] = x1.y + w0 * bfhi(ya.z) + w1 * bfhi(yc.z); o[6] = x1.z + w0 * bflo(ya.w) + w1 * bflo(yc.w); o[7] = x1.w + w0 * bfhi(ya.w) + w1 * bfhi(yc.w);
#pragma unroll
            for (int q = 0; q < 8; ++q) s += o[q] * o[q]; }
        const float rs = 1.0f / sqrtf(wave_sum(s) * (1.0f / DM) + NORM_EPS);
        if (l == 0) { const float* nw = a.in[2] + DM;
#pragma unroll
            for (int j = 0; j < 4; ++j) { const int e0 = (lane + 64 * j) * 8; const float* o = hv + 8 * j; const f32x4 wa = *(const f32x4*)(nw + e0), wb = *(const f32x4*)(nw + e0 + 4);
                *(f32x4*)(hr + e0) = (f32x4){o[0], o[1], o[2], o[3]}; *(f32x4*)(hr + e0 + 4) = (f32x4){o[4], o[5], o[6], o[7]};
                v4u p; p.x = pk2(o[0] * rs * wa.x, o[1] * rs * wa.y); p.y = pk2(o[2] * rs * wa.z, o[3] * rs * wa.w); p.z = pk2(o[4] * rs * wb.x, o[5] * rs * wb.y); p.w = pk2(o[6] * rs * wb.z, o[7] * rs * wb.w);
                *(v4u*)(HN + (size_t)r * DM + e0) = p; }
        } else { const float* nw = a.in[4]; float* orow = a.out + (size_t)r * DM;
#ifdef PROBE_TS
            { const unsigned long long* ts = (const unsigned long long*)(F.ctl + CW_TS); const float dt_us = (float)(__hip_atomic_load(ts + PROBE_TS + 1, RLX_AGENT) - __hip_atomic_load(ts + PROBE_TS, RLX_AGENT)) * 0.01f;
#pragma unroll
              for (int q = 0; q < 32; ++q) hv[q] *= 1.0f + dt_us * 0.01f; }
#endif
#pragma unroll
            for (int j = 0; j < 4; ++j) { const int e0 = (lane + 64 * j) * 8; const float* o = hv + 8 * j; const f32x4 wa = *(const f32x4*)(nw + e0), wb = *(const f32x4*)(nw + e0 + 4);
                *(f32x4*)(orow + e0) = (f32x4){o[0] * rs * wa.x, o[1] * rs * wa.y, o[2] * rs * wa.z, o[3] * rs * wa.w};
                *(f32x4*)(orow + e0 + 4) = (f32x4){o[4] * rs * wb.x, o[5] * rs * wb.y, o[6] * rs * wb.z, o[7] * rs * wb.w}; } }
    }
}

DI void ph_odd_prep(const Frame& F, const Args& a) {
    const bf16* P = (const bf16*)(a.ws + WS_PROJ); bf16* QN = (bf16*)(a.ws + WS_SCR + SC_QN); bf16* KN = (bf16*)(a.ws + WS_SCR + SC_KN); bf16* VC = (bf16*)(a.ws + WS_SCR + SC_VC);
    float* BETA = (float*)(a.ws + WS_SCR + SC_BETA); float* GG = (float*)(a.ws + WS_SCR + SC_G);
    const float* cw = a.in[26]; const int lane = F.lane;
    for (int item = F.gw; item < (TT / 8) * 16; item += F.NGW) { const int pb = item >> 4, i = item & 15, ch = i * 512 + lane * 8, p0 = pb * 8;
        f32x4 w[4][2];
#pragma unroll
        for (int j = 0; j < 4; ++j) { w[j][0] = *(const f32x4*)(cw + j * 8192 + ch); w[j][1] = *(const f32x4*)(cw + j * 8192 + ch + 4); }
        v4u x[11];
#pragma unroll
        for (int q = 0; q < 11; ++q) { const int p = p0 - 3 + q; x[q] = *(const v4u*)(P + (size_t)pos_row(p > 0 ? p : 0) * OD_NP + ch); if (p < 0) x[q] = (v4u){0u, 0u, 0u, 0u}; }
#pragma unroll
        for (int o = 0; o < 8; ++o) { const int r = pos_row(p0 + o); float acc[8] = {0.f, 0.f, 0.f, 0.f, 0.f, 0.f, 0.f, 0.f};
#pragma unroll
            for (int j = 0; j < 4; ++j) { const v4u xv = x[o + j];
                acc[0] += w[j][0].x * bflo(xv.x); acc[1] += w[j][0].y * bfhi(xv.x); acc[2] += w[j][0].z * bflo(xv.y); acc[3] += w[j][0].w * bfhi(xv.y);
                acc[4] += w[j][1].x * bflo(xv.z); acc[5] += w[j][1].y * bfhi(xv.z); acc[6] += w[j][1].z * bflo(xv.w); acc[7] += w[j][1].w * bfhi(xv.w); }
            float ss = 0.f;
#pragma unroll
            for (int q = 0; q < 8; ++q) { acc[q] = acc[q] * sigm(acc[q]); ss += acc[q] * acc[q]; }
            float sc = 1.0f;
            if (i < 8) { ss += __shfl_xor(ss, 1); ss += __shfl_xor(ss, 2); ss += __shfl_xor(ss, 4); ss += __shfl_xor(ss, 8);
                sc = (1.0f / sqrtf(ss + NORM_EPS)) * (i < 4 ? 0.08838834764831845f : 1.0f); }
            const v4u ov = (v4u){pk2(acc[0] * sc, acc[1] * sc), pk2(acc[2] * sc, acc[3] * sc), pk2(acc[4] * sc, acc[5] * sc), pk2(acc[6] * sc, acc[7] * sc)};
            bf16* dst = i < 4 ? QN + (size_t)r * 2048 + ch : (i < 8 ? KN + (size_t)r * 2048 + ch - 2048 : VC + (size_t)r * 4096 + ch - 4096);
            *(v4u*)dst = ov; }
        if (i == 0 && lane < 32) {
#pragma unroll
            for (int o = 0; o < 8; ++o) { const int r = pos_row(p0 + o); const float bb = bf2f(P[(size_t)r * OD_NP + OD_B + lane]), aa = bf2f(P[(size_t)r * OD_NP + OD_A + lane]);
                BETA[(size_t)r * 32 + lane] = sigm(bb); GG[(size_t)r * 32 + lane] = -__expf(a.in[27][lane]) * softplus(aa + a.in[28][lane]); } }
    }
}
DI void ph_odd_post(const Frame& F, const Args& a) {
    const bf16* P = (const bf16*)(a.ws + WS_PROJ); const bf16* O = (const bf16*)(a.ws + WS_SCR + SC_O); bf16* Y = (bf16*)(a.ws + WS_YMIX); const float* nw = a.in[29];
    const int lane = F.lane;
    for (int r = F.gw; r < TT; r += F.NGW) {
#pragma unroll 2
        for (int i = 0; i < 8; ++i) { const int ch = i * 512 + lane * 8; const v4u ow = *(const v4u*)(O + (size_t)r * 4096 + ch); const f32x4 o0 = (f32x4){bflo(ow.x), bfhi(ow.x), bflo(ow.y), bfhi(ow.y)}, o1 = (f32x4){bflo(ow.z), bfhi(ow.z), bflo(ow.w), bfhi(ow.w)};
            float ss = (o0.x * o0.x + o0.y * o0.y) + (o0.z * o0.z + o0.w * o0.w) + (o1.x * o1.x + o1.y * o1.y) + (o1.z * o1.z + o1.w * o1.w);
            ss += __shfl_xor(ss, 1); ss += __shfl_xor(ss, 2); ss += __shfl_xor(ss, 4); ss += __shfl_xor(ss, 8);
            const float rs = 1.0f / sqrtf(ss * (1.0f / 128.0f) + NORM_EPS);
            const v4u z = *(const v4u*)(P + (size_t)r * OD_NP + OD_Z + ch); const int c0 = ch & 127; const f32x4 w0 = *(const f32x4*)(nw + c0), w1 = *(const f32x4*)(nw + c0 + 4);
            const float zf[8] = {bflo(z.x), bfhi(z.x), bflo(z.y), bfhi(z.y), bflo(z.z), bfhi(z.z), bflo(z.w), bfhi(z.w)};
            const float of[8] = {o0.x * w0.x, o0.y * w0.y, o0.z * w0.z, o0.w * w0.w, o1.x * w1.x, o1.y * w1.y, o1.z * w1.z, o1.w * w1.w};
            float y[8];
#pragma unroll
            for (int q = 0; q < 8; ++q) y[q] = of[q] * rs * zf[q] * sigm(zf[q]);
            v4u p; p.x = pk2(y[0], y[1]); p.y = pk2(y[2], y[3]); p.z = pk2(y[4], y[5]); p.w = pk2(y[6], y[7]);
            *(v4u*)(Y + (size_t)r * 4096 + ch) = p; }
    }
}

typedef float f32x16 __attribute__((ext_vector_type(16)));
#define MFMA32(a, b, c) __builtin_amdgcn_mfma_f32_32x32x16_bf16((a), (b), (c), 0, 0, 0)
DI int crow(int reg, int h) { return (reg & 3) + 8 * (reg >> 2) + 4 * h; }
DI int chunk_row(int n, int c) { return n == 0 ? (c >= 48 ? TX + (c - 48) : -1) : 64 * (n - 1) + c; }
#ifndef GDN_NO_HELPER
#define GDN_NO_HELPER 0
#endif
constexpr int GDN_NCH = 129, GDN_UNITS = GDN_NCH * 32, GDN_KUNITS = GDN_NCH * 16, GC_STRIDE = 72;
constexpr size_t GD_WF = WS_MOEW, GD_UF = WS_MOEW + 65 * MiB, GD_IN = WS_MOEW + 130 * MiB, GD_GC = WS_MOEW + 163 * MiB, GD_KT = WS_HN, GD_SAVE = WS_SCR + 205 * MiB;
static_assert((size_t)GDN_UNITS * 16384 <= 65 * MiB && (size_t)GDN_UNITS * 8192 <= 33 * MiB && (size_t)GDN_KUNITS * 16384 <= 33 * MiB && GD_GC + (size_t)GDN_UNITS * GC_STRIDE * 4 <= WS_H, "gdn map");

DI void ph_gdn_chunk(const Frame& F, const Args& a, int n_lo, int n_hi, int side) {
    const bf16* QN = (const bf16*)(a.ws + WS_SCR + SC_QN); const bf16* KN = (const bf16*)(a.ws + WS_SCR + SC_KN); const bf16* VC = (const bf16*)(a.ws + WS_SCR + SC_VC);
    const float* BETA = (const float*)(a.ws + WS_SCR + SC_BETA); const float* GG = (const float*)(a.ws + WS_SCR + SC_G);
    bf16* WF = (bf16*)(a.ws + GD_WF); bf16* UF = (bf16*)(a.ws + GD_UF); bf16* INF = (bf16*)(a.ws + GD_IN); bf16* KTF = (bf16*)(a.ws + GD_KT); float* GC = (float*)(a.ws + GD_GC);
    LAS unsigned char* L = F.lds + RING_OFF;
    LAS unsigned char* kS = L; LAS unsigned char* qS = L + 17408; LAS unsigned char* vS = L + 34816; LAS unsigned char* kbS = L + 52224;
    LAS float* Lm = (LAS float*)(L + 69632); LAS bf16* IS = (LAS bf16*)(L + 87040); LAS bf16* XS = (LAS bf16*)(L + 96256);
    LAS float* betaS = (LAS float*)(L + 130048); LAS float* gcS = betaS + 64; LAS float* egcS = betaS + 128;
    LAS unsigned char* Lb = L + 17408; LAS unsigned char* TDs = L + 26624; LAS unsigned char* YT0 = L + 28672; LAS unsigned char* XT0 = L + 130816;
    static_assert(130816 + 8 * 1792 <= LDSCTL_OFF, "gdn lds map");
    const int tid = F.tid, lane = F.lane, wave = F.wave, l31 = lane & 31, h = lane >> 5;
    int widx = F.vcu, wcnt = F.G;
    if (side) { if (F.G == 256) { const int wx = F.vcu & 31; if (wx < 20) return; widx = (F.vcu >> 5) * 12 + (wx - 20); wcnt = 96; } else { if (F.vcu < 128 || F.G <= 128) return; widx = F.vcu - 128; wcnt = F.G - 128; } }
    for (int unit = n_lo * 32 + widx; unit < n_hi * 32; unit += wcnt) {
        const int n = unit >> 5, hv = unit & 31, hk = hv >> 1; const size_t su = (size_t)hv * GDN_NCH + n;
#pragma unroll
        for (int i = 0; i < 2; ++i) { const int p = tid + 512 * i, row = p >> 4, ch = p & 15; const int rr = chunk_row(n, row);
            v4u kx = (v4u){0u, 0u, 0u, 0u}, qx = kx, vx = kx;
            if (rr >= 0) { kx = *(const v4u*)(KN + (size_t)rr * 2048 + hk * 128 + ch * 8); qx = *(const v4u*)(QN + (size_t)rr * 2048 + hk * 128 + ch * 8); vx = *(const v4u*)(VC + (size_t)rr * 4096 + hv * 128 + ch * 8); }
            *(LAS v4u*)(kS + row * 272 + ch * 16) = kx; *(LAS v4u*)(qS + row * 272 + ch * 16) = qx; *(LAS v4u*)(vS + row * 272 + ch * 16) = vx; }
        if (wave == 0) { const int rr = chunk_row(n, lane); float b = 0.f, g = 0.f; if (rr >= 0) { b = BETA[(size_t)rr * 32 + hv]; g = GG[(size_t)rr * 32 + hv]; }
#pragma unroll
            for (int o = 1; o < 64; o <<= 1) { const float t = __shfl_up(g, o); if (lane >= o) g += t; }
            betaS[lane] = b; gcS[lane] = g; egcS[lane] = __expf(g); }
        __syncthreads();
#pragma unroll
        for (int i = 0; i < 2; ++i) { const int p = tid + 512 * i, row = p >> 4, ch = p & 15; const v4u kx = *(const LAS v4u*)(kS + row * 272 + ch * 16); const float b = betaS[row];
            v4u o; o.x = pk2(bflo(kx.x) * b, bfhi(kx.x) * b); o.y = pk2(bflo(kx.y) * b, bfhi(kx.y) * b); o.z = pk2(bflo(kx.z) * b, bfhi(kx.z) * b); o.w = pk2(bflo(kx.w) * b, bfhi(kx.w) * b);
            *(LAS v4u*)(kbS + row * 272 + ch * 16) = o; }
        __syncthreads();
        { const int which = wave >> 2, ti = (wave >> 1) & 1, tj = wave & 1;
          f32x16 acc;
#pragma unroll
          for (int r = 0; r < 16; ++r) acc[r] = 0.f;
          if (!(ti == 0 && tj == 1)) { const LAS unsigned char* Ab = (which == 0 ? kbS : qS) + (32 * ti + l31) * 272 + 16 * h; const LAS unsigned char* Bb = kS + (32 * tj + l31) * 272 + 16 * h;
#pragma unroll
              for (int s = 0; s < 8; ++s) acc = MFMA32(*(const LAS bf16x8*)(Ab + 32 * s), *(const LAS bf16x8*)(Bb + 32 * s), acc); }
          const int j = 32 * tj + l31; const float gj = gcS[j];
#pragma unroll
          for (int r = 0; r < 16; ++r) { const int i = 32 * ti + crow(r, h); const float e = __expf(fminf(gcS[i] - gj, 0.f));
              if (which == 0) Lm[i * 68 + j] = i > j ? acc[r] * e : 0.f;
              else IS[i * 72 + j] = (bf16)f2bf(i >= j ? acc[r] * e : 0.f); } }
        __syncthreads();
#pragma unroll
        for (int i = 0; i < 8; ++i) { const int e = tid + 512 * i, r = e >> 6, c = e & 63; *(LAS bf16*)(Lb + r * 144 + c * 2) = (bf16)f2bf(Lm[r * 68 + c]); }
        if (wave == 0) { const int b = lane >> 4, c = lane & 15; float t[16]; const LAS float* Ld = Lm + (16 * b) * 68 + 16 * b;
#pragma unroll
            for (int i = 0; i < 16; ++i) { float acc = i == c ? 1.f : 0.f;
#pragma unroll
                for (int j = 0; j < i; ++j) acc -= Ld[i * 68 + j] * t[j];
                t[i] = acc; *(LAS bf16*)(TDs + (b * 16 + i) * 32 + c * 2) = (bf16)f2bf(acc); }
        } else if (wave >= 4) { const int t2 = tid - 256;
#pragma unroll
            for (int i = 0; i < 2; ++i) { const int p = t2 + 256 * i, comb = p >> 6, ln = p & 63, t = comb >> 2, s = comb & 3; const int c = 32 * t + (ln & 31), j0 = 16 * s + 8 * (ln >> 5);
                *(v4u*)(INF + (su * 8 + comb) * 512 + ln * 8) = *(const LAS v4u*)(IS + c * 72 + j0); }
            if ((hv & 1) == 0) { const size_t kunit = (size_t)hk * GDN_NCH + n;
#pragma unroll
                for (int i = 0; i < 4; ++i) { const int p = t2 + 256 * i, comb = p >> 6, ln = p & 63, kt = comb >> 2, s = comb & 3; const int kd = 32 * kt + (ln & 31), c0 = 16 * s + 8 * (ln >> 5);
                    unsigned w[4];
#pragma unroll
                    for (int jj = 0; jj < 4; ++jj) { const unsigned lo = *(const LAS bf16*)(kS + (c0 + 2 * jj) * 272 + kd * 2), hi = *(const LAS bf16*)(kS + (c0 + 2 * jj + 1) * 272 + kd * 2); w[jj] = lo | (hi << 16); }
                    *(v4u*)(KTF + (kunit * 16 + comb) * 512 + ln * 8) = (v4u){w[0], w[1], w[2], w[3]}; } }
            if (t2 < 64) GC[su * GC_STRIDE + t2] = gcS[t2];
            else if (t2 == 64) GC[su * GC_STRIDE + 64] = gcS[63];
            else if (t2 == 65) GC[su * GC_STRIDE + 65] = egcS[63];
        }
        __syncthreads();
        { const int quad = lane >> 4, lc = lane & 15; LAS unsigned char* XTw = XT0 + wave * 1792; LAS unsigned char* YTw = YT0 + wave * 768;
          const bf16x8 z8 = (bf16x8){0, 0, 0, 0, 0, 0, 0, 0}; const f32x4 z4 = (f32x4){0.f, 0.f, 0.f, 0.f};
          bf16x8 tdf[4];
#pragma unroll
          for (int b = 0; b < 4; ++b) tdf[b] = quad < 2 ? *(const LAS bf16x8*)(TDs + (b * 16 + lc) * 32 + quad * 16) : z8;
#pragma unroll 1
          for (int tl = 0; tl < 2; ++tl) { const int col = 32 * wave + 16 * tl + lc;
              const LAS unsigned char* rz = wave < 4 ? vS + col * 2 : kbS + (col - 128) * 2; const LAS float* bz = wave < 4 ? betaS : egcS;
#pragma unroll
              for (int b = 0; b < 4; ++b) { f32x4 y;
#pragma unroll
                  for (int r = 0; r < 4; ++r) { const int i = 16 * b + 4 * quad + r; y[r] = bf2f(*(const LAS bf16*)(rz + i * 272)) * bz[i]; }
                  if (b >= 1) { f32x4 p = z4;
#pragma unroll
                      for (int kk = 0; kk < (b >= 3 ? 2 : 1); ++kk) { const bf16x8 af = *(const LAS bf16x8*)(Lb + (16 * b + lc) * 144 + (32 * kk + 8 * quad) * 2);
                          const bf16x8 bfv = (32 * kk + 8 * quad < 16 * b) ? *(const LAS bf16x8*)(XTw + lc * 112 + (32 * kk + 8 * quad) * 2) : z8;
                          p = __builtin_amdgcn_mfma_f32_16x16x32_bf16(af, bfv, p, 0, 0, 0); }
                      y = y - p; }
                  *(LAS v2u*)(YTw + lc * 48 + quad * 8) = (v2u){pk2(y[0], y[1]), pk2(y[2], y[3])};
                  asm volatile("" ::: "memory");
                  const bf16x8 yb = quad < 2 ? *(const LAS bf16x8*)(YTw + lc * 48 + quad * 16) : z8;
                  const f32x4 x = __builtin_amdgcn_mfma_f32_16x16x32_bf16(tdf[b], yb, z4, 0, 0, 0);
                  if (b < 3) *(LAS v2u*)(XTw + lc * 112 + (16 * b + 4 * quad) * 2) = (v2u){pk2(x[0], x[1]), pk2(x[2], x[3])};
                  asm volatile("" ::: "memory");
#pragma unroll
                  for (int r = 0; r < 4; ++r) XS[(16 * b + 4 * quad + r) * 264 + col] = (bf16)f2bf(x[r]); } } }
        __syncthreads();
#pragma unroll
        for (int i = 0; i < 2; ++i) { const int p = tid + 512 * i, comb = p >> 6, ln = p & 63, t = comb >> 3, s = comb & 7; const int c = 32 * t + (ln & 31), k0 = 16 * s + 8 * (ln >> 5);
            *(v4u*)(WF + (su * 16 + comb) * 512 + ln * 8) = *(const LAS v4u*)(XS + c * 264 + 128 + k0); }
        { const int t = wave >> 2, ns = wave & 3; unsigned w[8];
#pragma unroll
          for (int r = 0; r < 8; ++r) { const unsigned lo = XS[(32 * t + crow(2 * r, h)) * 264 + 32 * ns + l31], hi = XS[(32 * t + crow(2 * r + 1, h)) * 264 + 32 * ns + l31]; w[r] = lo | (hi << 16); }
          bf16* dst = UF + ((su * 8 + wave) * 64 + lane) * 16; *(v4u*)dst = (v4u){w[0], w[1], w[2], w[3]}; *(v4u*)(dst + 8) = (v4u){w[4], w[5], w[6], w[7]}; }
        __syncthreads();
    }
}

DI void ph_gdn_chain(const Frame& F, const Args& a, int n_lo, int n_hi) {
    const int xg = F.vcu >> 5, wx = F.vcu & 31; if (F.G != 256 ? F.vcu >= 128 : wx >= 20) return;
    const bool helper = F.G == 256 && wx >= 16;
    const int hv = F.G == 256 ? 4 * xg + (helper ? wx - 16 : wx >> 2) : F.vcu >> 2, ns = F.G == 256 ? wx & 3 : F.vcu & 3, hk = hv >> 1;
    const bf16* QN = (const bf16*)(a.ws + WS_SCR + SC_QN);
    const bf16* WF = (const bf16*)(a.ws + GD_WF); const bf16* UF = (const bf16*)(a.ws + GD_UF); const bf16* INF = (const bf16*)(a.ws + GD_IN); const bf16* KTF = (const bf16*)(a.ws + GD_KT); const float* GC = (const float*)(a.ws + GD_GC);
    bf16* O = (bf16*)(a.ws + WS_SCR + SC_O);
    gu32* prog = F.ctl + CW_PROG + hv * 16;
    if (helper && GDN_NO_HELPER) return;
    if (helper) { unsigned sink = 0u; const int tid = F.tid;
        for (int n0 = n_lo; n0 < n_hi; n0 += 4) {
            if (n0 >= n_lo + 8) { if (tid == 0) { unsigned sp = 0; while ((int)__hip_atomic_load(prog, RLX_AGENT) < n0 - 4 && ++sp < 20000u) __builtin_amdgcn_s_sleep(8); } __syncthreads(); }
            unsigned v[5];
#pragma unroll
            for (int i = 0; i < 5; ++i) { const int li = tid + 512 * i;
                const int st = li / 580, ln = li % 580, n = n0 + st; const unsigned* p = nullptr;
                if (st < 4 && n < n_hi) { const size_t unit = (size_t)hv * GDN_NCH + n, kunit = (size_t)hk * GDN_NCH + n;
                    if (ln < 128) p = (const unsigned*)(WF + unit * 8192 + ln * 64);
                    else if (ln < 256) p = (const unsigned*)(UF + unit * 8192 + (ln - 128) * 64);
                    else if (ln < 320) p = (const unsigned*)(INF + unit * 4096 + (ln - 256) * 64);
                    else if (ln < 448) p = (const unsigned*)(KTF + kunit * 8192 + (ln - 320) * 64);
                    else if (ln < 576) { const int rr = chunk_row(n, (ln - 448) >> 1); if (rr >= 0) p = (const unsigned*)(QN + (size_t)rr * 2048 + hk * 128 + ((ln - 448) & 1) * 64); }
                    else if (ln < 579) p = (const unsigned*)(GC + unit * GC_STRIDE + (ln - 576) * 32); }
                v[i] = p ? *p : 0u; }
#pragma unroll
            for (int i = 0; i < 5; ++i) sink += v[i];
        }
        if (sink == 0x12345u) __hip_atomic_store(F.ctl + CW_TMO + 2, sink, RLX_AGENT);
        return; }
    LAS unsigned char* ST = F.lds + RING_OFF; LAS unsigned char* VN = ST + 8704; LAS unsigned char* VND = ST + 13312;
    const int lane = F.lane, wave = F.wave, l31 = lane & 31, h = lane >> 5;
    for (int i = F.tid; i < 8704 / 4; i += NWAVES * 64) ((LAS unsigned*)ST)[i] = 0u;
#define GDN_BAR() do { asm volatile("s_waitcnt lgkmcnt(0)" ::: "memory"); __builtin_amdgcn_s_barrier(); asm volatile("" ::: "memory"); } while (0)
    GDN_BAR();
    f32x16 S;
#pragma unroll
    for (int r = 0; r < 16; ++r) S[r] = 0.f;
    const int role = wave < 2 ? 0 : (wave < 4 ? 1 : 2); const int t = wave & 1, kt = wave & 3;
    bf16x8 A8[8]; bf16x8 A4[4]; v4u U0 = (v4u){0u, 0u, 0u, 0u}, U1 = U0; f32x4 G4[4]; float gl = 0.f, egl = 1.f;
#pragma unroll
    for (int s = 0; s < 8; ++s) A8[s] = (bf16x8){0, 0, 0, 0, 0, 0, 0, 0};
#pragma unroll
    for (int s = 0; s < 4; ++s) { A4[s] = (bf16x8){0, 0, 0, 0, 0, 0, 0, 0}; G4[s] = (f32x4){0.f, 0.f, 0.f, 0.f}; }
#define GDN_LOAD(nn) do { const size_t unit_ = (size_t)hv * GDN_NCH + (nn); const float* gc_ = GC + unit_ * GC_STRIDE; \
        if (role == 0) { _Pragma("unroll") for (int s = 0; s < 8; ++s) A8[s] = *(const bf16x8*)(WF + ((unit_ * 2 + t) * 8 + s) * 512 + lane * 8); \
            const bf16* up_ = UF + (((unit_ * 2 + t) * 4 + ns) * 64 + lane) * 16; U0 = *(const v4u*)up_; U1 = *(const v4u*)(up_ + 8); \
            _Pragma("unroll") for (int g = 0; g < 4; ++g) G4[g] = *(const f32x4*)(gc_ + 32 * t + 8 * g + 4 * h); gl = gc_[64]; } \
        else if (role == 1) { const int rr_ = chunk_row((nn), 32 * t + l31); \
            _Pragma("unroll") for (int s = 0; s < 8; ++s) A8[s] = rr_ >= 0 ? *(const bf16x8*)(QN + (size_t)rr_ * 2048 + hk * 128 + 16 * s + 8 * h) : (bf16x8){0, 0, 0, 0, 0, 0, 0, 0}; \
            _Pragma("unroll") for (int s = 0; s < 4; ++s) A4[s] = *(const bf16x8*)(INF + ((unit_ * 2 + t) * 4 + s) * 512 + lane * 8); \
            _Pragma("unroll") for (int g = 0; g < 4; ++g) G4[g] = *(const f32x4*)(gc_ + 32 * t + 8 * g + 4 * h); } \
        else { const size_t kunit_ = (size_t)hk * GDN_NCH + (nn); \
            _Pragma("unroll") for (int s = 0; s < 4; ++s) A4[s] = *(const bf16x8*)(KTF + ((kunit_ * 4 + kt) * 4 + s) * 512 + lane * 8); egl = gc_[65]; } } while (0)
    float* SV = (float*)(a.ws + GD_SAVE) + ((size_t)((hv * 4 + ns) * 4 + kt) * 64 + lane) * 16;
    if (n_lo > 0 && role == 2) {
#pragma unroll
        for (int g = 0; g < 4; ++g) { const f32x4 v = *(const f32x4*)(SV + 4 * g); S[4 * g] = v.x; S[4 * g + 1] = v.y; S[4 * g + 2] = v.z; S[4 * g + 3] = v.w;
            *(LAS v2u*)(ST + l31 * 272 + (32 * kt + 8 * g + 4 * h) * 2) = (v2u){pk2(v.x, v.y), pk2(v.z, v.w)}; }
    }
    GDN_BAR();
    GDN_LOAD(n_lo);
    for (int n = n_lo; n < n_hi; ++n) {
        bf16x8 a8[8], a4[4]; const v4u u0 = U0, u1 = U1; f32x4 g4[4]; const float cgl = gl, cegl = egl;
#pragma unroll
        for (int s = 0; s < 8; ++s) a8[s] = A8[s];
#pragma unroll
        for (int s = 0; s < 4; ++s) { a4[s] = A4[s]; g4[s] = G4[s]; }
        if (n + 1 < n_hi) GDN_LOAD(n + 1);
        if (ns == 0 && F.tid == 0) __hip_atomic_store(prog, (unsigned)n, RLX_AGENT);
        f32x16 acc;
#pragma unroll
        for (int r = 0; r < 16; ++r) acc[r] = 0.f;
        if (role < 2) {
#pragma unroll
            for (int s = 0; s < 8; ++s) acc = MFMA32(a8[s], *(const LAS bf16x8*)(ST + l31 * 272 + 32 * s + 16 * h), acc);
        }
        if (role == 0) { const unsigned uw[8] = {u0.x, u0.y, u0.z, u0.w, u1.x, u1.y, u1.z, u1.w};
#pragma unroll
            for (int g = 0; g < 4; ++g) { float vn[4], vd[4];
#pragma unroll
                for (int q = 0; q < 4; ++q) { const int r = 4 * g + q; const float uv = (r & 1) ? bfhi(uw[r >> 1]) : bflo(uw[r >> 1]); vn[q] = uv - acc[r]; vd[q] = vn[q] * __expf(cgl - g4[g][q]); }
                *(LAS v2u*)(VN + l31 * 144 + (32 * t + 8 * g + 4 * h) * 2) = (v2u){pk2(vn[0], vn[1]), pk2(vn[2], vn[3])};
                *(LAS v2u*)(VND + l31 * 144 + (32 * t + 8 * g + 4 * h) * 2) = (v2u){pk2(vd[0], vd[1]), pk2(vd[2], vd[3])}; }
        } else if (role == 1) {
#pragma unroll
            for (int g = 0; g < 4; ++g)
#pragma unroll
                for (int q = 0; q < 4; ++q) acc[4 * g + q] *= __expf(g4[g][q]);
        }
        GDN_BAR();
        if (role == 1) {
#pragma unroll
            for (int s = 0; s < 4; ++s) acc = MFMA32(a4[s], *(const LAS bf16x8*)(VN + l31 * 144 + 32 * s + 16 * h), acc);
#pragma unroll
            for (int r = 0; r < 16; ++r) { const int rr = chunk_row(n, 32 * t + crow(r, h)); if (rr >= 0) O[(size_t)rr * 4096 + hv * 128 + 32 * ns + l31] = (bf16)f2bf(acc[r]); }
        } else if (role == 2) {
#pragma unroll
            for (int r = 0; r < 16; ++r) S[r] *= cegl;
#pragma unroll
            for (int s = 0; s < 4; ++s) S = MFMA32(a4[s], *(const LAS bf16x8*)(VND + l31 * 144 + 32 * s + 16 * h), S);
#pragma unroll
            for (int g = 0; g < 4; ++g) *(LAS v2u*)(ST + l31 * 272 + (32 * kt + 8 * g + 4 * h) * 2) = (v2u){pk2(S[4 * g], S[4 * g + 1]), pk2(S[4 * g + 2], S[4 * g + 3])};
        }
        GDN_BAR();
    }
    if (n_hi < GDN_NCH && role == 2) {
#pragma unroll
        for (int g = 0; g < 4; ++g) *(f32x4*)(SV + 4 * g) = (f32x4){S[4 * g], S[4 * g + 1], S[4 * g + 2], S[4 * g + 3]}; }
#undef GDN_LOAD
#undef GDN_BAR
}

constexpr int RW_NSC = 258, RW_UNITS = 129 * 16;
DI int sub_row(int sc, int t) { const int n = sc >> 1, sub = sc & 1; return n == 0 ? ((sub == 0 && t >= 16) ? TX + t - 16 : -1) : 64 * (n - 1) + 32 * sub + t; }
constexpr size_t RW_BASE = WS_PROJ + 92 * MiB;
constexpr size_t RW_RH = RW_BASE, RW_RL = RW_BASE + 33 * MiB, RW_GT = RW_BASE + 66 * MiB, RW_GAM = RW_BASE + 99 * MiB;
constexpr size_t RW_PR = WS_SCR + 195 * MiB, RW_AT = WS_SCR + 211 * MiB + 256 * 1024, RW_VTF = WS_SCR + 219 * MiB + 512 * 1024, RW_SALL = WS_SCR + 235 * MiB + 768 * 1024;
constexpr size_t RW_XSAVE = 1 * MiB + 640 * 1024;
constexpr size_t RW_VV = WS_YMIX + 34 * MiB, RW_BON = WS_YMIX + 52 * MiB, LR_H = WS_YMIX + 54 * MiB, LR_A = WS_YMIX + 56 * MiB, LR_C = WS_YMIX + 58 * MiB;
constexpr size_t RW_SCH = (size_t)RW_NSC * 16;
static_assert((size_t)MP * EV_NP * 2 <= 92 * MiB && RW_SCH * 8192 <= 33 * MiB && RW_GAM + RW_SCH * 256 <= WS_SCR, "rwkv map (proj region)");
static_assert(WS_SCR + SC_LIX + (size_t)MP * 4096 <= RW_PR && RW_PR + RW_SCH * 4096 <= RW_AT && RW_AT + RW_SCH * 2048 <= RW_VTF && RW_VTF + RW_SCH * 4096 <= RW_SALL && RW_SALL + RW_SCH * 8192 <= WS_END, "rwkv map (scratch region)");
static_assert((size_t)MP * DM * 2 <= 34 * MiB && RW_VV + (size_t)MP * 2048 <= RW_BON && RW_BON + (size_t)MP * 64 <= LR_H && LR_H + RW_SCH * 256 <= LR_A && LR_A + RW_SCH * 256 <= LR_C && LR_C + RW_SCH * 256 <= WS_PROJ, "rwkv map (ymix region)");

DI void sub_rows(int sc, int& t0, int& rbase) { if (sc >= 2) { t0 = 0; rbase = 64 * ((sc >> 1) - 1) + 32 * (sc & 1); } else if (sc == 0) { t0 = 16; rbase = TX - 16; } else { t0 = 32; rbase = 0; } }
DI void lru_local(const Frame& F, const Args& a) {
    const float* LA = (const float*)(a.ws + WS_SCR + SC_LA); const float* LIX = (const float*)(a.ws + WS_SCR + SC_LIX);
    float* HL = (float*)(a.ws + LR_H); float* AP = (float*)(a.ws + LR_A);
    for (int item = F.gw; item < RW_NSC * 16; item += F.NGW) { const int sc = item >> 4, c = (item & 15) * 64 + F.lane; int t0, rbase; sub_rows(sc, t0, rbase);
        float av[32], ix[32];
#pragma unroll
        for (int t = 0; t < 32; ++t) { const size_t o = (size_t)(rbase + (t >= t0 ? t : 32)) * 1024 + c; av[t] = LA[o]; ix[t] = LIX[o]; }
        float h = 0.f, p = 1.f;
#pragma unroll
        for (int t = 0; t < 32; ++t) { const float a_ = t >= t0 ? av[t] : 1.f, x_ = t >= t0 ? ix[t] : 0.f; h = a_ * h + sqrtf(fmaxf(1.0f - a_ * a_, 0.f)) * x_; p *= a_; }
        HL[sc * 1024 + c] = h; AP[sc * 1024 + c] = p; }
}
DI void lru_apply(const Frame& F, const Args& a) {
    const bf16* P = (const bf16*)(a.ws + WS_PROJ); const float* LA = (const float*)(a.ws + WS_SCR + SC_LA); const float* LIX = (const float*)(a.ws + WS_SCR + SC_LIX);
    const float* CR = (const float*)(a.ws + LR_C); bf16* Y = (bf16*)(a.ws + WS_YMIX);
    for (int item = F.gw; item < RW_NSC * 16; item += F.NGW) { const int sc = item >> 4, c = (item & 15) * 64 + F.lane; int t0, rbase; sub_rows(sc, t0, rbase); if (t0 >= 32) continue;
        float h = CR[sc * 1024 + c];
#pragma unroll
        for (int tb = 0; tb < 32; tb += 16) { float av[16], ix[16], gb[16];
#pragma unroll
            for (int t = 0; t < 16; ++t) { const size_t r_ = (size_t)(rbase + (tb + t >= t0 ? tb + t : 32)); av[t] = LA[r_ * 1024 + c]; ix[t] = LIX[r_ * 1024 + c]; gb[t] = bf2f(P[r_ * EV_NP + EV_GB + c]); }
#pragma unroll
            for (int t = 0; t < 16; ++t) { if (tb + t >= t0) { h = av[t] * h + sqrtf(fmaxf(1.0f - av[t] * av[t], 0.f)) * ix[t]; Y[(size_t)(rbase + tb + t) * DM + 1024 + c] = (bf16)f2bf(h * gelu_tanh(gb[t])); } } } }
}

DI void ph_rwkv_chunk(const Frame& F, const Args& a, int n_lo, int n_hi, int wg0) {
    if (F.vcu < wg0) return;
    const bf16* P = (const bf16*)(a.ws + WS_PROJ); const float* DEC = (const float*)(a.ws + WS_SCR + SC_DEC); const float* ICL = (const float*)(a.ws + WS_SCR + SC_ICL);
    bf16* RH = (bf16*)(a.ws + RW_RH); bf16* RL = (bf16*)(a.ws + RW_RL); bf16* GT = (bf16*)(a.ws + RW_GT); float* GAM = (float*)(a.ws + RW_GAM); bf16* PR = (bf16*)(a.ws + RW_PR); bf16* ATG = (bf16*)(a.ws + RW_AT); bf16* VTF = (bf16*)(a.ws + RW_VTF);
    bf16* VV = (bf16*)(a.ws + RW_VV); float* BON = (float*)(a.ws + RW_BON);
    LAS unsigned char* L = F.lds + RING_OFF;
    LAS float* wS = (LAS float*)L; LAS float* aS = wS + 4096; LAS float* bS = wS + 8192; LAS float* rS = wS + 12288; LAS float* kS = wS + 16384;
    LAS unsigned char* vT = L + 81920; LAS unsigned char* aT = L + 91136; LAS unsigned char* rT = L + 100352; LAS unsigned char* kT = L + 109568; LAS unsigned char* bT = L + 118784;
    LAS unsigned char* AT = L + 128000; LAS unsigned char* NT = L + 133120; LAS float* gam = (LAS float*)(L + 138240);
    LAS unsigned char* aTl = L; LAS unsigned char* bTl = L + 9216;
    const int tid = F.tid, lane = F.lane, wave = F.wave, l31 = lane & 31, h = lane >> 5;
    const float* mu = a.in[6];
    for (int unit = n_lo * 16 + (F.vcu - wg0); unit < n_hi * 16; unit += F.G - wg0) {
        const int n = unit >> 4, hd = unit & 15;
        { const int tok = tid >> 3, cg = tid & 7, c0 = hd * 64 + cg * 8; const int rr = sub_row(2 * n + (tok >> 5), tok & 31);
          float wv[8], av[8], bv[8], rv[8], kv[8], vv[8];
#pragma unroll
          for (int q = 0; q < 8; ++q) { wv[q] = 1.f; av[q] = 0.f; bv[q] = 0.f; rv[q] = 0.f; kv[q] = 0.f; vv[q] = 0.f; }
          if (rr >= 0) { const int pos = row_pos(rr); const bf16* cur = P + (size_t)rr * EV_NP + c0; const bf16* prv = pos > 0 ? P + (size_t)pos_row(pos - 1) * EV_NP + c0 : nullptr;
              const v4u z4 = (v4u){0u, 0u, 0u, 0u};
              const v4u cr = *(const v4u*)cur, ck = *(const v4u*)(cur + 1024), cv = *(const v4u*)(cur + 2048);
              const v4u qr = prv ? *(const v4u*)prv : z4, qk = prv ? *(const v4u*)(prv + 1024) : z4, qv = prv ? *(const v4u*)(prv + 2048) : z4;
              const unsigned crw[4] = {cr.x, cr.y, cr.z, cr.w}, ckw[4] = {ck.x, ck.y, ck.z, ck.w}, cvw[4] = {cv.x, cv.y, cv.z, cv.w}, qrw[4] = {qr.x, qr.y, qr.z, qr.w}, qkw[4] = {qk.x, qk.y, qk.z, qk.w}, qvw[4] = {qv.x, qv.y, qv.z, qv.w};
              float ss = 0.f, bon = 0.f; float kk[8], ic[8];
#pragma unroll
              for (int q = 0; q < 8; ++q) { const int c = c0 + q; const float crf = (q & 1) ? bfhi(crw[q >> 1]) : bflo(crw[q >> 1]), ckf = (q & 1) ? bfhi(ckw[q >> 1]) : bflo(ckw[q >> 1]), cvf = (q & 1) ? bfhi(cvw[q >> 1]) : bflo(cvw[q >> 1]);
                  const float prf = (q & 1) ? bfhi(qrw[q >> 1]) : bflo(qrw[q >> 1]), pkf = (q & 1) ? bfhi(qkw[q >> 1]) : bflo(qkw[q >> 1]), pvf = (q & 1) ? bfhi(qvw[q >> 1]) : bflo(qvw[q >> 1]);
                  rv[q] = crf + (prf - crf) * mu[c]; kk[q] = ckf + (pkf - ckf) * mu[1024 + c]; vv[q] = cvf + (pvf - cvf) * mu[2048 + c];
                  wv[q] = DEC[(size_t)rr * 1024 + c]; ic[q] = ICL[(size_t)rr * 1024 + c];
                  const float kkv = kk[q] * a.in[12][c]; av[q] = kkv; ss += kkv * kkv; kv[q] = kk[q] * (1.0f + (ic[q] - 1.0f) * a.in[13][c]); bon += rv[q] * kv[q] * a.in[14][c]; }
              ss += __shfl_xor(ss, 1); ss += __shfl_xor(ss, 2); ss += __shfl_xor(ss, 4); bon += __shfl_xor(bon, 1); bon += __shfl_xor(bon, 2); bon += __shfl_xor(bon, 4);
              const float inv = 1.0f / fmaxf(sqrtf(ss), 1e-12f);
#pragma unroll
              for (int q = 0; q < 8; ++q) { const float kkn = av[q] * inv; av[q] = -kkn; bv[q] = kkn * ic[q]; }
              if (cg == 0) BON[(size_t)rr * 16 + hd] = bon;
              *(v4u*)(VV + (size_t)rr * 1024 + c0) = (v4u){pk2(vv[0], vv[1]), pk2(vv[2], vv[3]), pk2(vv[4], vv[5]), pk2(vv[6], vv[7])}; }
          const int o = tok * 64 + cg * 8;
          *(LAS f32x4*)(wS + o) = (f32x4){wv[0], wv[1], wv[2], wv[3]}; *(LAS f32x4*)(wS + o + 4) = (f32x4){wv[4], wv[5], wv[6], wv[7]};
          *(LAS f32x4*)(aS + o) = (f32x4){av[0], av[1], av[2], av[3]}; *(LAS f32x4*)(aS + o + 4) = (f32x4){av[4], av[5], av[6], av[7]};
          *(LAS f32x4*)(bS + o) = (f32x4){bv[0], bv[1], bv[2], bv[3]}; *(LAS f32x4*)(bS + o + 4) = (f32x4){bv[4], bv[5], bv[6], bv[7]};
          *(LAS f32x4*)(rS + o) = (f32x4){rv[0], rv[1], rv[2], rv[3]}; *(LAS f32x4*)(rS + o + 4) = (f32x4){rv[4], rv[5], rv[6], rv[7]};
          *(LAS f32x4*)(kS + o) = (f32x4){kv[0], kv[1], kv[2], kv[3]}; *(LAS f32x4*)(kS + o + 4) = (f32x4){kv[4], kv[5], kv[6], kv[7]};
#pragma unroll
          for (int q = 0; q < 8; ++q) *(LAS bf16*)(vT + (cg * 8 + q) * 144 + tok * 2) = (bf16)f2bf(vv[q]); }
        __syncthreads();
        { const int p = wave >> 2, sub = (wave >> 1) & 1, half = wave & 1, sl = lane >> 2, q = lane & 3, s = 16 * half + sl, tok = 32 * sub + s, jq = 16 * q;
          const LAS float* x0p = (p == 0 ? kS : bS) + tok * 64 + jq; LAS unsigned char* OUT = p == 0 ? AT : NT;
          float x[16];
#pragma unroll
          for (int j = 0; j < 16; j += 4) { const f32x4 t4 = *(const LAS f32x4*)(x0p + j); x[j] = t4.x; x[j + 1] = t4.y; x[j + 2] = t4.z; x[j + 3] = t4.w; }
          if (half) {
#pragma unroll
              for (int i = 0; i < 4; ++i) *(LAS bf16*)(OUT + ((sub * 32 + 4 * q + i) * 40 + s) * 2) = (bf16)0; }
#pragma unroll 2
          for (int tp = 16 * half; tp < 32; ++tp) { const LAS float* bp = wS + (32 * sub + tp) * 64 + jq; const bool run = tp > s;
              f32x4 a4[4], w4[4], b4[4], r4[4];
#pragma unroll
              for (int g = 0; g < 4; ++g) { a4[g] = *(const LAS f32x4*)(bp + 4096 + 4 * g); w4[g] = *(const LAS f32x4*)(bp + 4 * g); b4[g] = *(const LAS f32x4*)(bp + 8192 + 4 * g); r4[g] = *(const LAS f32x4*)(bp + 12288 + 4 * g); }
              float c = 0.f;
#pragma unroll
              for (int g = 0; g < 4; ++g) { c += x[4 * g] * a4[g].x; c += x[4 * g + 1] * a4[g].y; c += x[4 * g + 2] * a4[g].z; c += x[4 * g + 3] * a4[g].w; }
              c += __builtin_bit_cast(float, __builtin_amdgcn_mov_dpp(__builtin_bit_cast(int, c), 0xB1, 0xF, 0xF, true));
              c += __builtin_bit_cast(float, __builtin_amdgcn_mov_dpp(__builtin_bit_cast(int, c), 0x4E, 0xF, 0xF, true));
              float o = 0.f;
#pragma unroll
              for (int g = 0; g < 4; ++g) { const float n0 = x[4 * g] * w4[g].x + c * b4[g].x, n1 = x[4 * g + 1] * w4[g].y + c * b4[g].y, n2 = x[4 * g + 2] * w4[g].z + c * b4[g].z, n3 = x[4 * g + 3] * w4[g].w + c * b4[g].w;
                  x[4 * g] = run ? n0 : x[4 * g]; x[4 * g + 1] = run ? n1 : x[4 * g + 1]; x[4 * g + 2] = run ? n2 : x[4 * g + 2]; x[4 * g + 3] = run ? n3 : x[4 * g + 3];
                  o += x[4 * g] * r4[g].x; o += x[4 * g + 1] * r4[g].y; o += x[4 * g + 2] * r4[g].z; o += x[4 * g + 3] * r4[g].w; }
              o += __builtin_bit_cast(float, __builtin_amdgcn_mov_dpp(__builtin_bit_cast(int, o), 0xB1, 0xF, 0xF, true));
              o += __builtin_bit_cast(float, __builtin_amdgcn_mov_dpp(__builtin_bit_cast(int, o), 0x4E, 0xF, 0xF, true));
              if (q == 0) *(LAS bf16*)(OUT + ((sub * 32 + tp) * 40 + s) * 2) = (bf16)f2bf(tp >= s ? o : 0.f); }
          LAS unsigned char* XT = p == 0 ? kT : bT;
#pragma unroll
          for (int j = 0; j < 16; ++j) { const unsigned hi = f2bf(x[j]); *(LAS bf16*)(XT + (jq + j) * 144 + tok * 2) = (bf16)hi; x[j] -= __uint_as_float(hi << 16); }
          float alo[32]; const bool gwave = (p == 0 && half == 1); const int j = lane;
          if (gwave) { float g = 1.f;
#pragma unroll
              for (int tp = 0; tp < 32; ++tp) { const int tk = 32 * sub + tp; const float w_ = wS[tk * 64 + j], a_ = aS[tk * 64 + j], r_ = rS[tk * 64 + j];
                  const float at = a_ * g; const unsigned hi = f2bf(at); *(LAS bf16*)(aT + j * 144 + tk * 2) = (bf16)hi; alo[tp] = at - __uint_as_float(hi << 16);
                  g *= w_; *(LAS bf16*)(rT + j * 144 + tk * 2) = (bf16)f2bf(r_ * g); }
              gam[sub * 64 + j] = g; }
          __syncthreads();
          if (p == 1) {
#pragma unroll
              for (int jj = 0; jj < 16; ++jj) *(LAS bf16*)(bTl + (jq + jj) * 144 + tok * 2) = (bf16)f2bf(x[jj]); }
          if (gwave) {
#pragma unroll
              for (int tp = 0; tp < 32; ++tp) *(LAS bf16*)(aTl + j * 144 + (32 * sub + tp) * 2) = (bf16)f2bf(alo[tp]); }
        }
        __syncthreads();
        { const int sub = wave >> 2, t1 = (wave >> 1) & 1, t0 = wave & 1; const size_t sch = (size_t)hd * RW_NSC + (2 * n + sub);
          { f32x16 acc;
#pragma unroll
            for (int r = 0; r < 16; ++r) acc[r] = 0.f;
#pragma unroll
            for (int ks = 0; ks < 2; ++ks) { const int ao = (32 * t1 + l31) * 144 + (32 * sub + 16 * ks + 8 * h) * 2, bo = (32 * t0 + l31) * 144 + (32 * sub + 16 * ks + 8 * h) * 2;
                const bf16x8 ah = *(const LAS bf16x8*)(aT + ao), al = *(const LAS bf16x8*)(aTl + ao), bh = *(const LAS bf16x8*)(bT + bo), bl = *(const LAS bf16x8*)(bTl + bo);
                acc = MFMA32(al, bh, acc); acc = MFMA32(ah, bl, acc); acc = MFMA32(ah, bh, acc); }
            const int jp = 32 * t0 + l31;
#pragma unroll
            for (int g = 0; g < 4; ++g) { unsigned hi[4]; float lo[4];
#pragma unroll
                for (int q = 0; q < 4; ++q) { hi[q] = f2bf(acc[4 * g + q]); lo[q] = acc[4 * g + q] - __uint_as_float(hi[q] << 16); }
                *(v2u*)(RH + (sch * 64 + jp) * 64 + 32 * t1 + 8 * g + 4 * h) = (v2u){hi[0] | (hi[1] << 16), hi[2] | (hi[3] << 16)};
                *(v2u*)(RL + (sch * 64 + jp) * 64 + 32 * t1 + 8 * g + 4 * h) = (v2u){pk2(lo[0], lo[1]), pk2(lo[2], lo[3])}; }
            if (t1 == 0 && t0 == 0) GAM[sch * 64 + lane] = gam[sub * 64 + lane]; }
          { f32x16 acc;
#pragma unroll
            for (int r = 0; r < 16; ++r) acc[r] = 0.f;
#pragma unroll
            for (int ks = 0; ks < 2; ++ks) acc = MFMA32(*(const LAS bf16x8*)(kT + (32 * t1 + l31) * 144 + (32 * sub + 16 * ks + 8 * h) * 2), *(const LAS bf16x8*)(vT + (32 * t0 + l31) * 144 + (32 * sub + 16 * ks + 8 * h) * 2), acc);
            bf16* dst = GT + ((sch * 4 + t1 * 2 + t0) * 64 + lane) * 16;
            *(v4u*)dst = (v4u){pk2(acc[0], acc[1]), pk2(acc[2], acc[3]), pk2(acc[4], acc[5]), pk2(acc[6], acc[7])}; *(v4u*)(dst + 8) = (v4u){pk2(acc[8], acc[9]), pk2(acc[10], acc[11]), pk2(acc[12], acc[13]), pk2(acc[14], acc[15])}; } }
        if (wave < 4) { const int sub = wave >> 1, jt = wave & 1; const size_t sch = (size_t)hd * RW_NSC + (2 * n + sub);
            f32x16 acc;
#pragma unroll
            for (int r = 0; r < 16; ++r) acc[r] = bf2f(*(const LAS bf16*)(rT + (32 * jt + crow(r, h)) * 144 + (32 * sub + l31) * 2));
#pragma unroll
            for (int ks = 0; ks < 2; ++ks) acc = MFMA32(*(const LAS bf16x8*)(aT + (32 * jt + l31) * 144 + (32 * sub + 16 * ks + 8 * h) * 2), *(const LAS bf16x8*)(NT + (sub * 32 + l31) * 80 + (16 * ks + 8 * h) * 2), acc);
#pragma unroll
            for (int g = 0; g < 4; ++g) *(v2u*)(PR + (sch * 32 + l31) * 64 + 32 * jt + 8 * g + 4 * h) = (v2u){pk2(acc[4 * g], acc[4 * g + 1]), pk2(acc[4 * g + 2], acc[4 * g + 3])};
        } else { const int t2 = tid - 256, sub = t2 >> 7, t = (t2 >> 2) & 31, s8 = (t2 & 3) * 8; const size_t sch = (size_t)hd * RW_NSC + (2 * n + sub);
            *(v4u*)(ATG + (sch * 32 + t) * 32 + s8) = *(const LAS v4u*)(AT + (sub * 32 + t) * 80 + s8 * 2); }
        { const int sub = tid >> 8, it = (tid >> 7) & 1, ks = (tid >> 6) & 1; const size_t sch = (size_t)hd * RW_NSC + (2 * n + sub);
          *(v4u*)(VTF + ((sch * 4 + it * 2 + ks) * 64 + lane) * 8) = *(const LAS v4u*)(vT + (32 * it + l31) * 144 + (32 * sub + 16 * ks + 8 * h) * 2); }
        __syncthreads();
    }
}

DI void ph_rwkv_chain(const Frame& F, const Args& a, int sc_lo, int sc_hi) {
    if (F.vcu >= 16 && F.vcu < 18) { if (sc_hi < RW_NSC) return; const int c = (F.vcu - 16) * 512 + F.tid; const float* HL = (const float*)(a.ws + LR_H); const float* AP = (const float*)(a.ws + LR_A); float* CR = (float*)(a.ws + LR_C);
        float carry = 0.f;
#pragma unroll 8
        for (int sc = 0; sc < RW_NSC; ++sc) { const float hl = HL[sc * 1024 + c], ap = AP[sc * 1024 + c]; CR[sc * 1024 + c] = carry; carry = ap * carry + hl; }
        return; }
    if (F.vcu >= 16) return;
    const int hd = F.vcu; const bf16* RH = (const bf16*)(a.ws + RW_RH); const bf16* RL = (const bf16*)(a.ws + RW_RL); const bf16* GT = (const bf16*)(a.ws + RW_GT); const float* GAM = (const float*)(a.ws + RW_GAM); bf16* SALL = (bf16*)(a.ws + RW_SALL);
    constexpr int RW_NS = 7, SLOT = 8192 + 8192 + 1024;
    LAS unsigned char* XS = F.lds + RING_OFF; LAS unsigned char* RG = XS + 2 * 9216;
    const int lane = F.lane, wave = F.wave, l31 = lane & 31, h = lane >> 5, jt = (wave >> 1) & 1, it = wave & 1, lw = wave & 3;
    for (int i = F.tid; i < 2 * 9216 / 4; i += NWAVES * 64) ((LAS unsigned*)XS)[i] = 0u;
    __syncthreads();
#define RW_BAR() do { asm volatile("s_waitcnt lgkmcnt(0)" ::: "memory"); __builtin_amdgcn_s_barrier(); asm volatile("" ::: "memory"); } while (0)
    const unsigned rg0 = (unsigned)(uintptr_t)RG;
    int offR[2], offG[2];
#pragma unroll
    for (int i = 0; i < 2; ++i) { const int b = 2 * lw + i, row = 8 * b + (lane >> 3), pc = lane & 7; offR[i] = row * 64 + ((pc ^ (row & 7)) * 8); offG[i] = (b * 64 + lane) * 8; }
    const int offM = (lane & 15) * 4;
#define RW_DMA(src, dst) do { unsigned keep_; asm volatile("s_mov_b32 %0, m0\n\ts_mov_b32 m0, %2\n\ts_nop 0\n\tglobal_load_lds_dwordx4 %1, off\n\ts_mov_b32 m0, %0" : "=&s"(keep_) : "v"(src), "s"(dst) : "memory"); } while (0)
#define RW_ISSUE(scn) do { const int s_ = (scn) < RW_NSC ? (scn) : RW_NSC - 1; const size_t sch_ = (size_t)hd * RW_NSC + s_; \
        const unsigned sb_ = (unsigned)__builtin_amdgcn_readfirstlane((int)(rg0 + (unsigned)((scn) % RW_NS) * SLOT)); \
        _Pragma("unroll") for (int i_ = 0; i_ < 2; ++i_) { const unsigned bo_ = (unsigned)__builtin_amdgcn_readfirstlane((2 * lw + i_) * 1024); \
            RW_DMA(RH + sch_ * 4096 + offR[i_], sb_ + bo_); RW_DMA(GT + sch_ * 4096 + offG[i_], sb_ + 8192 + bo_); } \
        RW_DMA(GAM + sch_ * 64 + offM, sb_ + 16384); } while (0)
#define RW_WAITV(n) asm volatile("s_waitcnt vmcnt(" #n ")" ::: "memory")
    f32x16 X;
#pragma unroll
    for (int r = 0; r < 16; ++r) X[r] = 0.f;
    float* XSV = (float*)(a.ws + RW_XSAVE) + ((size_t)(hd * 4 + (wave & 3)) * 64 + lane) * 16;
    if (wave < 4 && sc_lo > 0) {
#pragma unroll
        for (int g = 0; g < 4; ++g) { const f32x4 v = *(const f32x4*)(XSV + 4 * g); X[4 * g] = v.x; X[4 * g + 1] = v.y; X[4 * g + 2] = v.z; X[4 * g + 3] = v.w;
            *(LAS v2u*)(XS + (32 * it + l31) * 144 + (32 * jt + 8 * g + 4 * h) * 2) = (v2u){pk2(v.x, v.y), pk2(v.z, v.w)}; } }
    if (wave >= 4) { RW_ISSUE(sc_lo); RW_ISSUE(sc_lo + 1); RW_ISSUE(sc_lo + 2); RW_ISSUE(sc_lo + 3); RW_ISSUE(sc_lo + 4); RW_ISSUE(sc_lo + 5); RW_WAITV(25); }
    RW_BAR();
    for (int sc = sc_lo; sc < sc_hi; ++sc) {
        if (wave < 4) {
            const LAS unsigned char* sb = RG + (sc % RW_NS) * SLOT;
            f32x16 acc; const size_t sch = (size_t)hd * RW_NSC + sc;
            { const v4u g0 = *(const LAS v4u*)(sb + 8192 + ((jt * 2 + it) * 64 + lane) * 32), g1 = *(const LAS v4u*)(sb + 8192 + ((jt * 2 + it) * 64 + lane) * 32 + 16);
              const unsigned gw_[8] = {g0.x, g0.y, g0.z, g0.w, g1.x, g1.y, g1.z, g1.w};
#pragma unroll
              for (int g = 0; g < 4; ++g) { const f32x4 m = *(const LAS f32x4*)(sb + 16384 + (32 * jt + 8 * g + 4 * h) * 4);
                  acc[4 * g] = bflo(gw_[2 * g]) + m.x * X[4 * g]; acc[4 * g + 1] = bfhi(gw_[2 * g]) + m.y * X[4 * g + 1]; acc[4 * g + 2] = bflo(gw_[2 * g + 1]) + m.z * X[4 * g + 2]; acc[4 * g + 3] = bfhi(gw_[2 * g + 1]) + m.w * X[4 * g + 3]; } }
#pragma unroll
            for (int g = 0; g < 4; ++g) *(v2u*)(SALL + (sch * 64 + 32 * it + l31) * 64 + 32 * jt + 8 * g + 4 * h) = (v2u){pk2(X[4 * g], X[4 * g + 1]), pk2(X[4 * g + 2], X[4 * g + 3])};
            const LAS unsigned char* xb = XS + (sc & 1) * 9216 + (32 * it + l31) * 144 + 16 * h; const int ar = 32 * jt + l31; const LAS unsigned char* ab = sb + ar * 128;
#pragma unroll
            for (int ks = 0; ks < 4; ++ks) { const bf16x8 xf = *(const LAS bf16x8*)(xb + 32 * ks); const int po = (((2 * ks + h) ^ (ar & 7)) * 16);
                acc = MFMA32(*(const LAS bf16x8*)(ab + po), xf, acc); }
            X = acc;
            LAS unsigned char* xn = XS + ((sc + 1) & 1) * 9216 + (32 * it + l31) * 144;
#pragma unroll
            for (int g = 0; g < 4; ++g) *(LAS v2u*)(xn + (32 * jt + 8 * g + 4 * h) * 2) = (v2u){pk2(X[4 * g], X[4 * g + 1]), pk2(X[4 * g + 2], X[4 * g + 3])};
        } else {
            RW_ISSUE(sc + RW_NS - 1);
            RW_WAITV(25);
        }
        RW_BAR();
    }
    if (wave >= 4) RW_WAITV(0);
    else if (sc_hi < RW_NSC) {
#pragma unroll
        for (int g = 0; g < 4; ++g) *(f32x4*)(XSV + 4 * g) = (f32x4){X[4 * g], X[4 * g + 1], X[4 * g + 2], X[4 * g + 3]}; }
#undef RW_ISSUE
#undef RW_DMA
#undef RW_WAITV
#undef RW_BAR
}

DI void ph_rwkv_out(const Frame& F, const Args& a) {
    const bf16* SALL = (const bf16*)(a.ws + RW_SALL); const bf16* PR = (const bf16*)(a.ws + RW_PR); const bf16* ATG = (const bf16*)(a.ws + RW_AT); const bf16* VTF = (const bf16*)(a.ws + RW_VTF);
    const bf16* VV = (const bf16*)(a.ws + RW_VV); const float* BON = (const float*)(a.ws + RW_BON); const float* GATE = (const float*)(a.ws + WS_SCR + SC_GATE); bf16* Y = (bf16*)(a.ws + WS_YMIX);
    const int lane = F.lane, l31 = lane & 31, h = lane >> 5;
    for (int item = F.gw; item < RW_NSC * 16; item += F.NGW) { const int sc = item >> 4, hd = item & 15; if (sc == 1) continue;
        const size_t sch = (size_t)hd * RW_NSC + sc; f32x16 acc[2];
#pragma unroll
        for (int it = 0; it < 2; ++it) {
#pragma unroll
            for (int r = 0; r < 16; ++r) acc[it][r] = 0.f;
#pragma unroll
            for (int ks = 0; ks < 4; ++ks) acc[it] = MFMA32(*(const bf16x8*)(SALL + (sch * 64 + 32 * it + l31) * 64 + 16 * ks + 8 * h), *(const bf16x8*)(PR + (sch * 32 + l31) * 64 + 16 * ks + 8 * h), acc[it]);
#pragma unroll
            for (int ks = 0; ks < 2; ++ks) acc[it] = MFMA32(*(const bf16x8*)(VTF + ((sch * 4 + it * 2 + ks) * 64 + lane) * 8), *(const bf16x8*)(ATG + (sch * 32 + l31) * 32 + 16 * ks + 8 * h), acc[it]); }
        float s1 = 0.f;
#pragma unroll
        for (int it = 0; it < 2; ++it)
#pragma unroll
            for (int r = 0; r < 16; ++r) s1 += acc[it][r];
        s1 += __shfl_xor(s1, 32); const float mean = s1 * (1.0f / 64.0f); float s2 = 0.f;
#pragma unroll
        for (int it = 0; it < 2; ++it)
#pragma unroll
            for (int r = 0; r < 16; ++r) { const float d = acc[it][r] - mean; s2 += d * d; }
        s2 += __shfl_xor(s2, 32); const float rstd = 1.0f / sqrtf(s2 * (1.0f / 64.0f) + 64e-5f);
        const int rr = sub_row(sc, l31);
        if (rr >= 0) { const float bon = BON[(size_t)rr * 16 + hd];
#pragma unroll
            for (int it = 0; it < 2; ++it)
#pragma unroll
                for (int g = 0; g < 4; ++g) { const int c = hd * 64 + 32 * it + 8 * g + 4 * h;
                    const f32x4 lw = *(const f32x4*)(a.in[15] + c), lb = *(const f32x4*)(a.in[16] + c), gt = *(const f32x4*)(GATE + (size_t)rr * 1024 + c); const v2u vw = *(const v2u*)(VV + (size_t)rr * 1024 + c);
                    const float o0 = ((acc[it][4 * g] - mean) * rstd * lw.x + lb.x + bon * bflo(vw.x)) * gt.x, o1 = ((acc[it][4 * g + 1] - mean) * rstd * lw.y + lb.y + bon * bfhi(vw.x)) * gt.y;
                    const float o2 = ((acc[it][4 * g + 2] - mean) * rstd * lw.z + lb.z + bon * bflo(vw.y)) * gt.z, o3 = ((acc[it][4 * g + 3] - mean) * rstd * lw.w + lb.w + bon * bfhi(vw.y)) * gt.w;
                    *(v2u*)(Y + (size_t)rr * DM + c) = (v2u){pk2(o0, o1), pk2(o2, o3)}; } }
    }
    lru_apply(F, a);
}

constexpr int N_PHASES = 31;
template <class Epi, class Sched> DI void run_gemm(const Frame& F, const pg8::Gemm& g, const Sched& S, const Epi& E) {
    pg8::gemm_phase<Epi, Sched, true, true>(F.lds + RING_OFF, g, S, E);
}
DI void ph_moe_up(const Frame& F, const Args& a) {
    const int nt = (int)__hip_atomic_load((gu32*)(a.ws + WS_TILES) + 127, RLX_AGENT);
    pg8::Gemm g{(const bf16*)(a.ws + WS_SCR + SC_XG), (const bf16*)(a.ws + WS_MOEW), DM, DM, DM};
    pg8::MoeOrder S{(const int*)(a.ws + WS_TILES), nt, 4, F.G, (int)blockIdx.x, (long)MOE_E_BYTES};
    pg8::EpiSwiglu E{(bf16*)(a.ws + WS_SCR + SC_ACT), FF};
    run_gemm(F, g, S, E);
}
DI void ph_moe_down(const Frame& F, const Args& a) {
    const int nt = (int)__hip_atomic_load((gu32*)(a.ws + WS_TILES) + 127, RLX_AGENT);
    pg8::Gemm g{(const bf16*)(a.ws + WS_SCR + SC_ACT), (const bf16*)(a.ws + WS_MOEW + MOE_W2_OFF), FF, FF, FF};
    pg8::MoeOrder S{(const int*)(a.ws + WS_TILES), nt, 8, F.G, (int)blockIdx.x, (long)MOE_E_BYTES};
    pg8::EpiBf16 E{(bf16*)(a.ws + WS_SCR + SC_YB), DM};
    run_gemm(F, g, S, E);
}

DI void gemm_tail16(const Frame& F, const Args& a, const bf16* A, int lda, const bf16* Wt, int K, int mode) {
    if (F.vcu >= 128) return;
    const int lane = F.lane, lc = lane & 15, quad = lane >> 4, w = F.vcu; LAS float* red = (LAS float*)(F.lds + RING_OFF);
    f32x4 acc = (f32x4){0.f, 0.f, 0.f, 0.f}; const int kw = K / NWAVES, kb = F.wave * kw;
    const bf16* ap = A + (size_t)(TX + lc) * lda + kb + 8 * quad; const bf16* bp = Wt + (size_t)(16 * w + lc) * K + kb + 8 * quad;
#pragma unroll 4
    for (int ks = 0; ks < kw / 32; ++ks) acc = __builtin_amdgcn_mfma_f32_16x16x32_bf16(*(const bf16x8*)(ap + 32 * ks), *(const bf16x8*)(bp + 32 * ks), acc, 0, 0, 0);
    *(LAS f32x4*)(red + (F.wave * 64 + lane) * 4) = acc;
    __syncthreads();
    if (F.wave == 0) { f32x4 s = *(const LAS f32x4*)(red + lane * 4);
#pragma unroll
        for (int v = 1; v < NWAVES; ++v) s = s + *(const LAS f32x4*)(red + (v * 64 + lane) * 4);
        float* H = (float*)(a.ws + WS_H);
#pragma unroll
        for (int r = 0; r < 4; ++r) { const int row = 4 * quad + r, col = 16 * w + lc; const float base = mode ? H[(size_t)(TX + row) * DM + col] : a.in[1][(size_t)row * DM + col];
            H[(size_t)(TX + row) * DM + col] = base + s[r]; } }
    __syncthreads();
}

__global__ void __launch_bounds__(NWAVES * 64, 2) hyb_fwd(Args a) {
    extern __shared__ __attribute__((aligned(16))) unsigned char lds[];
    Frame F;
    F.lds = (LAS unsigned char*)lds;
    F.MISC = (volatile LAS unsigned*)(F.lds + MISC_OFF);
    F.tid = threadIdx.x; F.lane = F.tid & 63; F.wave = __builtin_amdgcn_readfirstlane(F.tid >> 6);
    F.G = gridDim.x; { const int bx = blockIdx.x; F.vcu = (F.G % 8 == 0) ? (bx % 8) * (F.G / 8) + bx / 8 : bx; }
    F.gw = F.vcu * NWAVES + F.wave; F.NGW = F.G * NWAVES;
    F.ctl = (gu32*)(a.ws + WS_CTL);
    for (int u = F.tid; u < (LDS_BYTES - LDSCTL_OFF) / 4; u += NWAVES * 64) ((LAS unsigned*)(F.lds + LDSCTL_OFF))[u] = 0u;
    __syncthreads();
    XcdBarrier bar; bar.bar = (unsigned*)(F.ctl + CW_BAR); bar.x = 0; bar.st = nullptr;
    if (MK_ONE_LAUNCH) bar = xcd_barrier_post((unsigned*)(F.ctl + CW_BAR), F.MISC + 8);
    const int lo = a.ph_lo, hi = a.ph_hi;
#ifndef PH_MASK
#define PH_MASK 0xFFFFFFFFu
#endif
#define IN(k) (((PH_MASK >> (k)) & 1u) && lo <= (k) && (k) < hi)
#ifndef PROBE_REP
#define PROBE_REP 0u
#endif
#define REP(k) ((((unsigned)PROBE_REP >> (k)) & 1u) ? 2 : 1)
#ifdef PROBE_TS
#define STAMP(k) do { if (blockIdx.x == 0 && F.tid == 0) ((unsigned long long*)(F.ctl + CW_TS))[(k)] = __builtin_amdgcn_s_memrealtime(); } while (0)
#else
#define STAMP(k) do { } while (0)
#endif
#define SEAM(k) do { if (IN(k) && IN((k) + 1)) xcd_barrier(bar); STAMP((k) + 1); } while (0)
    const bf16* HN = (const bf16*)(a.ws + WS_HN); bf16* PROJ = (bf16*)(a.ws + WS_PROJ); const bf16* YMIX = (const bf16*)(a.ws + WS_YMIX); float* H = (float*)(a.ws + WS_H);

    STAMP(0);
    if (IN(0)) for (int rep_ = 0; rep_ < REP(0); ++rep_) { ph_prologue(F, a); ph_aux_convert(F, a, F.gw, F.NGW); }
    SEAM(0);
    if (IN(1)) for (int rep_ = 0; rep_ < REP(1); ++rep_) { pg8::Gemm g{HN, (const bf16*)(a.ws + WS_WEVIN), DM, DM, DM}; pg8::StaticOrder S; S.init(MP, EV_NP, F.G, (int)blockIdx.x); pg8::EpiBf16 E{PROJ, EV_NP}; run_gemm(F, g, S, E); }
    SEAM(1);
    if (IN(2)) for (int rep_ = 0; rep_ < REP(2); ++rep_) ph_even_prep(F, a);
    SEAM(2);
    if (IN(3)) for (int rep_ = 0; rep_ < REP(3); ++rep_) {
#ifndef NO_LORA
        { pg8::Gemm g{(const bf16*)(a.ws + WS_SCR + SC_ALORA), (const bf16*)(a.ws + WS_WLORA), 384, 384, 384}; pg8::StaticOrder S; S.init(MP, 3072, F.G, (int)blockIdx.x);
          static_assert(SC_ICL - SC_DEC == SC_GATE - SC_ICL, "lora outputs equally spaced");
          pg8::EpiLora E{(float*)(a.ws + WS_SCR + SC_DEC), (long)((SC_ICL - SC_DEC) / 4), a.in[7], a.in[9]}; run_gemm(F, g, S, E); }
#endif
#ifndef NO_GATES
        { pg8::Gemm g{(const bf16*)(a.ws + WS_SCR + SC_XR), (const bf16*)(a.ws + WS_WGATE), 256, 1024, 256}; pg8::StaticOrder S; S.init(MP, 2048, F.G, (int)blockIdx.x); S.amod = 4; S.astep = 512;
          pg8::EpiGates E{(float*)(a.ws + WS_SCR + SC_LA), (float*)(a.ws + WS_SCR + SC_LIX), a.in[20], a.in[22], a.in[23], (const bf16*)(a.ws + WS_SCR + SC_XR)}; run_gemm(F, g, S, E); }
#endif
    }
    SEAM(3);
    if (IN(4)) { lru_local(F, a); ph_rwkv_chunk(F, a, 0, 32, 0); }
    SEAM(4);
    if (IN(5)) { if (F.vcu < 16) ph_rwkv_chain(F, a, 0, 64); else ph_rwkv_chunk(F, a, 32, 62, 16); }
    SEAM(5);
    if (IN(6)) { if (F.vcu < 16) ph_rwkv_chain(F, a, 64, 124); else ph_rwkv_chunk(F, a, 62, 92, 16); }
    SEAM(6);
    if (IN(7)) { if (F.vcu < 16) ph_rwkv_chain(F, a, 124, 184); else ph_rwkv_chunk(F, a, 92, 122, 16); }
    SEAM(7);
    if (IN(8)) { if (F.vcu < 16) ph_rwkv_chain(F, a, 184, 244); else ph_rwkv_chunk(F, a, 122, 129, 16); }
    SEAM(8);
    if (IN(9)) { if (F.vcu < 18) ph_rwkv_chain(F, a, 244, RW_NSC); }
    SEAM(9);
    if (IN(10)) for (int rep_ = 0; rep_ < REP(10); ++rep_) ph_rwkv_out(F, a);
    SEAM(10);
    if (IN(11)) for (int rep_ = 0; rep_ < REP(11); ++rep_) { pg8::Gemm g{YMIX, (const bf16*)(a.ws + WS_WEVOUT), DM, DM, DM}; pg8::StaticOrder S; S.init(TX, DM, F.G, (int)blockIdx.x); pg8::EpiResid E{H, a.in[0], a.in[1], 0}; run_gemm(F, g, S, E); gemm_tail16(F, a, YMIX, DM, (const bf16*)(a.ws + WS_WEVOUT), DM, 0); }
    SEAM(11);
    if (IN(12)) for (int rep_ = 0; rep_ < REP(12); ++rep_) ph_route(F, a, 0, rep_);
    SEAM(12);
    if (IN(13)) for (int rep_ = 0; rep_ < REP(13); ++rep_) ph_gather(F, a, 0);
    SEAM(13);
    if (IN(14)) for (int rep_ = 0; rep_ < REP(14); ++rep_) ph_moe_up(F, a);
    SEAM(14);
    if (IN(15)) for (int rep_ = 0; rep_ < REP(15); ++rep_) ph_moe_down(F, a);
    SEAM(15);
    if (IN(16)) for (int rep_ = 0; rep_ < REP(16); ++rep_) ph_combine(F, a, 0);
    SEAM(16);
    if (IN(17)) for (int rep_ = 0; rep_ < REP(17); ++rep_) { pg8::Gemm g{HN, (const bf16*)(a.ws + WS_WODIN), DM, DM, DM}; pg8::StaticOrder S; S.init(MP, OD_NP, F.G, (int)blockIdx.x); pg8::EpiBf16 E{PROJ, OD_NP}; run_gemm(F, g, S, E); }
    SEAM(17);
    if (IN(18)) for (int rep_ = 0; rep_ < REP(18); ++rep_) ph_odd_prep(F, a);
    SEAM(18);
    if (IN(19)) ph_gdn_chunk(F, a, 0, 33, 0);
    SEAM(19);
    if (IN(20)) { ph_gdn_chain(F, a, 0, 33); ph_gdn_chunk(F, a, 33, 65, 1); }
    SEAM(20);
    if (IN(21)) { ph_gdn_chain(F, a, 33, 65); ph_gdn_chunk(F, a, 65, 97, 1); }
    SEAM(21);
    if (IN(22)) { ph_gdn_chain(F, a, 65, 97); ph_gdn_chunk(F, a, 97, 129, 1); }
    SEAM(22);
    if (IN(23)) ph_gdn_chain(F, a, 97, 129);
    SEAM(23);
    if (IN(24)) for (int rep_ = 0; rep_ < REP(24); ++rep_) { ph_odd_post(F, a); moe_convert(F, a, 1, F.gw, F.NGW); }
    SEAM(24);
    if (IN(25)) for (int rep_ = 0; rep_ < REP(25); ++rep_) { pg8::Gemm g{YMIX, (const bf16*)(a.ws + WS_WODOUT), 4096, 4096, 4096}; pg8::StaticOrder S; S.init(TX, DM, F.G, (int)blockIdx.x); pg8::EpiResid E{H, a.in[0], a.in[1], 1}; run_gemm(F, g, S, E); gemm_tail16(F, a, YMIX, 4096, (const bf16*)(a.ws + WS_WODOUT), 4096, 1); }
    SEAM(25);
    if (IN(26)) for (int rep_ = 0; rep_ < REP(26); ++rep_) ph_route(F, a, 1, rep_);
    SEAM(26);
    if (IN(27)) for (int rep_ = 0; rep_ < REP(27); ++rep_) ph_gather(F, a, 1);
    SEAM(27);
    if (IN(28)) for (int rep_ = 0; rep_ < REP(28); ++rep_) ph_moe_up(F, a);
    SEAM(28);
    if (IN(29)) for (int rep_ = 0; rep_ < REP(29); ++rep_) ph_moe_down(F, a);
    SEAM(29);
    if (IN(30)) for (int rep_ = 0; rep_ < REP(30); ++rep_) ph_combine(F, a, 1);
#undef IN
#undef SEAM
}

extern "C" void kernel_launch(void* const* d_in, const int* in_sizes, int n_in, void* d_out, int out_size, void* d_ws, size_t ws_size, hipStream_t stream) {
    static int grid = 0;
    if (grid == 0) {
        if (n_in != 36 || out_size != TX * DM || ws_size < WS_END) { fprintf(stderr, "kernel_launch: unexpected shapes (n_in %d, out %d, ws %zu)\n", n_in, out_size, ws_size); grid = -1; return; }
        int dev = 0, cus = 0, per_cu = 0;
        if (hipGetDevice(&dev) != hipSuccess || hipDeviceGetAttribute(&cus, hipDeviceAttributeMultiprocessorCount, dev) != hipSuccess) { grid = -1; return; }
        if (hipFuncSetAttribute((const void*)hyb_fwd, hipFuncAttributeMaxDynamicSharedMemorySize, LDS_BYTES) != hipSuccess) { fprintf(stderr, "kernel_launch: hipFuncSetAttribute failed\n"); grid = -1; return; }
        if (hipOccupancyMaxActiveBlocksPerMultiprocessor(&per_cu, (const void*)hyb_fwd, NWAVES * 64, LDS_BYTES) != hipSuccess || per_cu < 1) { fprintf(stderr, "kernel_launch: occupancy query says %d\n", per_cu); per_cu = 1; }
        (void)hipGetLastError();
        grid = cus;
    }
    if (grid < 0) return;
    if (hipMemsetAsync((char*)d_ws + WS_CTL, 0, CTL_ZERO_BYTES, stream) != hipSuccess) return;
    Args a{};
    for (int i = 0; i < 36; ++i) a.in[i] = (const float*)d_in[i];
    a.out = (float*)d_out; a.ws = (unsigned char*)d_ws;
#if MK_ONE_LAUNCH
    a.ph_lo = 0; a.ph_hi = N_PHASES;
    hipLaunchKernelGGL(hyb_fwd, dim3(grid), dim3(NWAVES * 64), LDS_BYTES, stream, a);
#else
    for (int p = 0; p < N_PHASES; ++p) { a.ph_lo = p; a.ph_hi = p + 1; hipLaunchKernelGGL(hyb_fwd, dim3(grid), dim3(NWAVES * 64), LDS_BYTES, stream, a); }
#endif
}
```

```cpp
#include <hip/hip_runtime.h>
#include <cstdio>
#include <cstdint>
#include <cmath>

#ifndef MK_ONE_LAUNCH
#define MK_ONE_LAUNCH 1
#endif

namespace pg8 {
#define PG8_LAS __attribute__((address_space(3)))
typedef unsigned short bf16_t;
typedef short bf16x8 __attribute__((ext_vector_type(8)));
typedef float f32x4 __attribute__((ext_vector_type(4)));
typedef unsigned u32x4 __attribute__((ext_vector_type(4)));
typedef unsigned u32x2 __attribute__((ext_vector_type(2)));
constexpr int BM = 256, BK = 64, HALF = 128, HTB = HALF * BK * 2  , STAGE_BYTES = 8 * HTB, NXCD = 8, WGM = 8;

__host__ __device__ __forceinline__ int lds_byte(int r, int c) { const int st = (r >> 4) * 2 + (c >> 5), rr = r & 15, cc = c & 31, ob = rr * 64 + cc * 2; return st * 1024 + (ob ^ (((ob >> 9) & 1) << 5)); }
__host__ __device__ __forceinline__ void stage_rc(int b, int& R, int& C) { const int st = b / 1024, sb = b % 1024, swz = sb ^ (((sb >> 9) & 1) << 5); R = (st >> 1) * 16 + swz / 64; C = (st & 1) * 32 + (swz % 64) / 2; }
__host__ __device__ __forceinline__ int perm32(int rho) { const int n = rho >> 4, i = rho & 15; return 8 * (i >> 2) + 4 * n + (i & 3); }

struct Unit { int pm, pn; long aoff, boff; };
struct Gemm { const bf16_t* A; const bf16_t* Bt; int K, lda, ldb; };

struct StaticOrder {
    int nM, nN, nwg, G, c, amod; long astep;
    __host__ __device__ void init(int M, int N, int G_, int c_) { nM = M / BM; nN = N / BM; nwg = nM * nN; G = G_; c = c_; amod = 0; astep = 0; }
    __host__ __device__ bool next(int i, Unit& u) const {
        const long L = (long)i * G + c; if (L >= nwg) return false;
        int wgid = (int)L; { const int q = nwg / NXCD, r = nwg % NXCD, xcd = wgid % NXCD, off = wgid / NXCD; wgid = (xcd < r ? xcd * (q + 1) : r * (q + 1) + (xcd - r) * q) + off; }
        const int nig = WGM * nN, gid = wgid / nig, fm = gid * WGM, gsz = (nM - fm) < WGM ? (nM - fm) : WGM;
        u.pm = fm + ((wgid % nig) % gsz); u.pn = (wgid % nig) / gsz; u.boff = 0; u.aoff = amod ? (long)(u.pn % amod) * astep : 0; return true;
    }
    __device__ __forceinline__ void a_ready(const Unit&) const {}
    __device__ __forceinline__ void done(const Unit&) const {}
};
struct MoeOrder {
    const int* tile_e; int t0, ntiles, npn, G, c; long bstride;
    __device__ __forceinline__ bool next(int i, Unit& u) const {
        const long L = (long)i * G + c; if (c < 0 || L >= (long)ntiles * npn) return false;
        const int t = t0 + (int)(L / npn); u.pm = t; u.pn = (int)(L % npn); u.aoff = 0; u.boff = (long)tile_e[t] * bstride; return true;
    }
    __device__ __forceinline__ void a_ready(const Unit&) const {}
    __device__ __forceinline__ void done(const Unit&) const {}
};

__device__ __forceinline__ unsigned cvt_pk_bf16(float lo, float hi) { unsigned r; asm volatile("v_cvt_pk_bf16_f32 %0, %1, %2" : "=v"(r) : "v"(lo), "v"(hi)); return r; }
__device__ __forceinline__ float bf_lo(unsigned w) { return __uint_as_float(w << 16); }
__device__ __forceinline__ float bf_hi(unsigned w) { return __uint_as_float(w & 0xffff0000u); }
__device__ __forceinline__ float sigmoidf_(float x) { return 1.0f / (1.0f + __expf(-x)); }
__device__ __forceinline__ float softplusf_(float x) { return fmaxf(x, 0.f) + __logf(1.0f + __expf(-fabsf(x))); }

struct EpiBf16 {
    static constexpr bool PERM = true, AFTER_DRAIN = false;
    bf16_t* O; int ldc;
    __device__ __forceinline__ void operator()(const f32x4 (&acc)[2][2][4][2], const Unit& u, int wr, int wc, int fr, int fq) const {
        const int row0 = u.pm * BM + wr * 64 + fr; const int col0 = u.pn * BM + wc * 32 + 8 * fq;
#pragma unroll
        for (int ai = 0; ai < 2; ++ai)
#pragma unroll
            for (int m = 0; m < 4; ++m) { bf16_t* rowp = O + (size_t)(row0 + ai * HALF + m * 16) * ldc + col0;
#pragma unroll
                for (int bj = 0; bj < 2; ++bj) { const f32x4 v0 = acc[ai][bj][m][0], v1 = acc[ai][bj][m][1];
                    u32x4 w; w.x = cvt_pk_bf16(v0[0], v0[1]); w.y = cvt_pk_bf16(v0[2], v0[3]); w.z = cvt_pk_bf16(v1[0], v1[1]); w.w = cvt_pk_bf16(v1[2], v1[3]);
                    *(u32x4*)(rowp + bj * HALF) = w; } }
    }
};
struct EpiSwiglu {
    static constexpr bool PERM = true, AFTER_DRAIN = false;
    bf16_t* O; int ldc;
    __device__ __forceinline__ void operator()(const f32x4 (&acc)[2][2][4][2], const Unit& u, int wr, int wc, int fr, int fq) const {
        const int row0 = u.pm * BM + wr * 64 + fr; const int col0 = u.pn * HALF + wc * 32 + 8 * fq;
#pragma unroll
        for (int ai = 0; ai < 2; ++ai)
#pragma unroll
            for (int m = 0; m < 4; ++m) { bf16_t* rowp = O + (size_t)(row0 + ai * HALF + m * 16) * ldc + col0;
                float o[8];
#pragma unroll
                for (int n = 0; n < 2; ++n)
#pragma unroll
                    for (int j = 0; j < 4; ++j) { const float gq = acc[ai][0][m][n][j], uq = acc[ai][1][m][n][j]; o[4 * n + j] = gq * sigmoidf_(gq) * uq; }
                u32x4 w; w.x = cvt_pk_bf16(o[0], o[1]); w.y = cvt_pk_bf16(o[2], o[3]); w.z = cvt_pk_bf16(o[4], o[5]); w.w = cvt_pk_bf16(o[6], o[7]);
                *(u32x4*)rowp = w; }
    }
};
struct EpiResid {
    static constexpr bool PERM = false, AFTER_DRAIN = false;
    float* out; const float* x; const float* meta; int mode;
    __device__ __forceinline__ void operator()(const f32x4 (&acc)[2][2][4][2], const Unit& u, int wr, int wc, int fr, int fq) const {
        const int row0 = u.pm * BM + wr * 64 + fr, col0 = u.pn * BM + wc * 32 + 4 * fq;
#pragma unroll
        for (int ai = 0; ai < 2; ++ai)
#pragma unroll
            for (int m = 0; m < 4; ++m) { const int row = row0 + ai * HALF + m * 16; float* rowp = out + (size_t)row * 2048 + col0;
                const float* bp = mode ? rowp : (row < 8192 ? x + (size_t)row * 2048 + col0 : (row < 8208 ? meta + (size_t)(row - 8192) * 2048 + col0 : nullptr));
#pragma unroll
                for (int bj = 0; bj < 2; ++bj)
#pragma unroll
                    for (int n = 0; n < 2; ++n) { f32x4 b = (f32x4){0.f, 0.f, 0.f, 0.f}; if (bp) b = *(const f32x4*)(bp + bj * HALF + n * 16);
                        *(f32x4*)(rowp + bj * HALF + n * 16) = acc[ai][bj][m][n] + b; } }
    }
};
struct EpiLora {
    static constexpr bool PERM = false, AFTER_DRAIN = false;
    float* base; long gstride; const float* w0; const float* a0;
    __device__ __forceinline__ void operator()(const f32x4 (&acc)[2][2][4][2], const Unit& u, int wr, int wc, int fr, int fq) const {
        const int grp = u.pn >> 2; const int row0 = u.pm * BM + wr * 64 + fr, col0 = (u.pn & 3) * BM + wc * 32 + 4 * fq;
        float* O = base + (size_t)grp * gstride;
#pragma unroll
        for (int bj = 0; bj < 2; ++bj)
#pragma unroll
            for (int n = 0; n < 2; ++n) { const int c = col0 + bj * HALF + n * 16;
                f32x4 bv = (f32x4){0.f, 0.f, 0.f, 0.f}; if (grp == 0) bv = *(const f32x4*)(w0 + c); else if (grp == 1) bv = *(const f32x4*)(a0 + c);
#pragma unroll
                for (int ai = 0; ai < 2; ++ai)
#pragma unroll
                    for (int m = 0; m < 4; ++m) { f32x4 v = acc[ai][bj][m][n] + bv;
                        if (grp == 0) {
#pragma unroll
                            for (int j = 0; j < 4; ++j) { const float wl = -softplusf_(-v[j]) - 0.5f; v[j] = __expf(-__expf(wl)); }
                        } else if (grp == 1) {
#pragma unroll
                            for (int j = 0; j < 4; ++j) v[j] = sigmoidf_(v[j]);
                        }
                        *(f32x4*)(O + (size_t)(row0 + ai * HALF + m * 16) * 1024 + c) = v; } }
    }
};
struct EpiGates {
    static constexpr bool PERM = false, AFTER_DRAIN = false;
    float* lru_a; float* lru_ix; const float* ba; const float* bx; const float* lam; const bf16_t* xr;
    __device__ __forceinline__ void operator()(const f32x4 (&acc)[2][2][4][2], const Unit& u, int wr, int wc, int fr, int fq) const {
        const int grp = u.pn >> 2; const int row0 = u.pm * BM + wr * 64 + fr, col0 = (u.pn & 3) * BM + wc * 32 + 4 * fq;
#pragma unroll
        for (int bj = 0; bj < 2; ++bj)
#pragma unroll
            for (int n = 0; n < 2; ++n) { const int c = col0 + bj * HALF + n * 16;
                const f32x4 bv = *(const f32x4*)((grp == 0 ? ba : bx) + c); f32x4 sp = (f32x4){0.f, 0.f, 0.f, 0.f};
                if (grp == 0) { const f32x4 l = *(const f32x4*)(lam + c);
#pragma unroll
                    for (int j = 0; j < 4; ++j) sp[j] = -8.0f * softplusf_(-l[j]); }
#pragma unroll
                for (int ai = 0; ai < 2; ++ai)
#pragma unroll
                    for (int m = 0; m < 4; ++m) { const int row = row0 + ai * HALF + m * 16; f32x4 v = acc[ai][bj][m][n] + bv;
                        if (grp == 0) {
#pragma unroll
                            for (int j = 0; j < 4; ++j) v[j] = __expf(sigmoidf_(v[j]) * sp[j]);
                            *(f32x4*)(lru_a + (size_t)row * 1024 + c) = v;
                        } else { const u32x2 xw = *(const u32x2*)(xr + (size_t)row * 1024 + c);
                            v[0] = sigmoidf_(v[0]) * bf_lo(xw.x); v[1] = sigmoidf_(v[1]) * bf_hi(xw.x); v[2] = sigmoidf_(v[2]) * bf_lo(xw.y); v[3] = sigmoidf_(v[3]) * bf_hi(xw.y);
                            *(f32x4*)(lru_ix + (size_t)row * 1024 + c) = v; } } }
    }
};

template <class Epi, class Sched, bool ALIGN_EPI = false, bool SP2 = false>
__device__ __forceinline__ void gemm_phase(PG8_LAS unsigned char* lds, const Gemm g, const Sched& S, const Epi& E) {
    const int tid = threadIdx.x, wid = __builtin_amdgcn_readfirstlane(tid >> 6), lane = tid & 63, wr = wid >> 2, wc = wid & 3, fr = lane & 15, fq = lane >> 4;
    const int K = g.K, nt = K / BK;
    unsigned voffA[2], voffB[2];
#pragma unroll
    for (int i = 0; i < 2; ++i) { int R, C; stage_rc(tid * 16 + i * 8192, R, C); const int Rb = Epi::PERM ? ((R & ~31) + perm32(R & 31)) : R;
        voffA[i] = (unsigned)(R * g.lda + C) * 2u; voffB[i] = (unsigned)(Rb * g.ldb + C) * 2u; }
    const size_t kstep = (size_t)(BK * 2);
    const size_t hstepA = (size_t)HALF * g.lda * 2, hstepB = (size_t)HALF * g.ldb * 2;
    const size_t tstepA = 2 * hstepA, tstepB = 2 * hstepB;
    const unsigned ldsw = (unsigned)wid * 1024u;
    const int aoff = lds_byte(wr * 64 + fr, fq * 8), boff = lds_byte(wc * 32 + fr, fq * 8);
#define PG8_SA(b, h) (((b) * 2 + (h)) * HTB)
#define PG8_SB(b, h) ((4 + (b) * 2 + (h)) * HTB)
#define PG8_STAGE(bufoff, gbase, voff) do { _Pragma("unroll") for (int _i = 0; _i < 2; ++_i) \
        __builtin_amdgcn_global_load_lds((const unsigned*)((const char*)(gbase) + (voff)[_i]), (PG8_LAS unsigned*)(lds + (bufoff) + ldsw + _i * 8192), 16, 0, 0); } while (0)
#define PG8_LDA(dst, b, h) do { _Pragma("unroll") for (int m = 0; m < 4; ++m) _Pragma("unroll") for (int k = 0; k < 2; ++k) dst[m][k] = *(const PG8_LAS bf16x8*)(lds + PG8_SA(b, h) + aoff + m * 2048 + k * 1024); } while (0)
#define PG8_LDB(dst, b, h) do { _Pragma("unroll") for (int n = 0; n < 2; ++n) _Pragma("unroll") for (int k = 0; k < 2; ++k) dst[n][k] = *(const PG8_LAS bf16x8*)(lds + PG8_SB(b, h) + boff + n * 2048 + k * 1024); } while (0)
#define PG8_MMA(ai, bj, At, Bt) do { __builtin_amdgcn_s_setprio(1); _Pragma("unroll") for (int m = 0; m < 4; ++m) _Pragma("unroll") for (int n = 0; n < 2; ++n) _Pragma("unroll") for (int k = 0; k < 2; ++k) \
        acc[ai][bj][m][n] = __builtin_amdgcn_mfma_f32_16x16x32_bf16(Bt[n][k], At[m][k], acc[ai][bj][m][n], 0, 0, 0); __builtin_amdgcn_s_setprio(0); } while (0)
#define PG8_WAIT_V(n) asm volatile("s_waitcnt vmcnt(" #n ")" ::: "memory")
#define PG8_WAIT_L(n) asm volatile("s_waitcnt lgkmcnt(" #n ")" ::: "memory")
#define PG8_BAR __builtin_amdgcn_s_barrier()
#define PG8_SCHED __builtin_amdgcn_sched_barrier(0)
    Unit cur, nxt; int ui = 0;
    if (!S.next(0, cur)) return;
    f32x4 acc[2][2][4][2];
#pragma unroll
    for (int a = 0; a < 2; ++a)
#pragma unroll
        for (int b = 0; b < 2; ++b)
#pragma unroll
            for (int m = 0; m < 4; ++m)
#pragma unroll
                for (int n = 0; n < 2; ++n) acc[a][b][m][n] = (f32x4){0.f, 0.f, 0.f, 0.f};
    bf16x8 At[4][2], B0[2][2], B1[2][2];
    const char* cA = (const char*)g.A + (size_t)cur.pm * tstepA + cur.aoff; const char* cB = (const char*)g.Bt + (size_t)cur.pn * tstepB + cur.boff;
    S.a_ready(cur);
    if constexpr (SP2) {
        PG8_STAGE(PG8_SB(0, 0), cB, voffB); PG8_STAGE(PG8_SB(0, 1), cB + hstepB, voffB); PG8_STAGE(PG8_SA(0, 0), cA, voffA); PG8_STAGE(PG8_SA(0, 1), cA + hstepA, voffA);
        if (wr == 1) PG8_BAR;
        PG8_WAIT_V(2); PG8_BAR;
        PG8_STAGE(PG8_SB(1, 0), cB + kstep, voffB); PG8_STAGE(PG8_SA(1, 0), cA + kstep, voffA); PG8_STAGE(PG8_SB(1, 1), cB + hstepB + kstep, voffB);
        PG8_WAIT_V(6); PG8_BAR;
    } else {
        PG8_STAGE(PG8_SB(0, 0), cB, voffB); PG8_STAGE(PG8_SA(0, 0), cA, voffA); PG8_STAGE(PG8_SB(0, 1), cB + hstepB, voffB); PG8_STAGE(PG8_SA(0, 1), cA + hstepA, voffA);
        if (wr == 1) PG8_BAR;
        PG8_WAIT_V(4); PG8_BAR;
        PG8_STAGE(PG8_SB(1, 0), cB + kstep, voffB); PG8_STAGE(PG8_SA(1, 0), cA + kstep, voffA); PG8_STAGE(PG8_SB(1, 1), cB + hstepB + kstep, voffB);
        PG8_WAIT_V(6); PG8_BAR;
    }
    for (;;) {
        const bool has_next = S.next(ui + 1, nxt);
        const char* nA = has_next ? (const char*)g.A + (size_t)nxt.pm * tstepA + nxt.aoff : cA; const char* nB = has_next ? (const char*)g.Bt + (size_t)nxt.pn * tstepB + nxt.boff : cB;
        for (int t = 0; t < nt; t += 2) {
            const bool last = (t == nt - 2);
            const char* a1 = cA + (size_t)(t + 1) * kstep;
            const char* a2 = last ? nA : cA + (size_t)(t + 2) * kstep; const char* b2 = last ? nB : cB + (size_t)(t + 2) * kstep;
            const char* a3 = a2 + kstep; const char* b3 = b2 + kstep;
            if (last && has_next) S.a_ready(nxt);
            if constexpr (SP2) {
            PG8_LDB(B0, 0, 0); PG8_LDB(B1, 0, 1); PG8_SCHED; PG8_LDA(At, 0, 0); PG8_STAGE(PG8_SA(1, 1), a1 + hstepA, voffA);
            PG8_WAIT_V(8); PG8_WAIT_L(0); PG8_BAR; PG8_MMA(0, 0, At, B0); PG8_MMA(0, 1, At, B1); PG8_BAR; PG8_SCHED;
            PG8_LDA(At, 0, 1); PG8_STAGE(PG8_SB(0, 0), b2, voffB); PG8_STAGE(PG8_SB(0, 1), b2 + hstepB, voffB); PG8_STAGE(PG8_SA(0, 0), a2, voffA);
            PG8_WAIT_V(8); PG8_WAIT_L(0); PG8_BAR; PG8_MMA(1, 0, At, B0); PG8_MMA(1, 1, At, B1); PG8_BAR; PG8_SCHED;
            PG8_LDB(B0, 1, 0); PG8_LDB(B1, 1, 1); PG8_SCHED; PG8_LDA(At, 1, 0); PG8_STAGE(PG8_SA(0, 1), a2 + hstepA, voffA);
            PG8_WAIT_V(8); PG8_WAIT_L(0); PG8_BAR; PG8_MMA(0, 0, At, B0); PG8_MMA(0, 1, At, B1); PG8_BAR; PG8_SCHED;
            PG8_LDA(At, 1, 1); PG8_STAGE(PG8_SB(1, 0), b3, voffB); PG8_STAGE(PG8_SB(1, 1), b3 + hstepB, voffB); PG8_STAGE(PG8_SA(1, 0), a3, voffA);
            PG8_WAIT_V(8); PG8_WAIT_L(0); PG8_BAR; PG8_MMA(1, 0, At, B0); PG8_MMA(1, 1, At, B1); PG8_BAR; PG8_SCHED;
            } else {
            PG8_LDB(B0, 0, 0); PG8_SCHED; PG8_LDA(At, 0, 0); PG8_STAGE(PG8_SA(1, 1), a1 + hstepA, voffA);
            PG8_WAIT_L(8); PG8_BAR; PG8_WAIT_L(0); PG8_MMA(0, 0, At, B0); PG8_BAR; PG8_SCHED;
            PG8_LDB(B1, 0, 1); PG8_STAGE(PG8_SB(0, 0), b2, voffB);
            PG8_BAR; PG8_WAIT_L(0); PG8_MMA(0, 1, At, B1); PG8_BAR;
            PG8_LDA(At, 0, 1); PG8_STAGE(PG8_SA(0, 0), a2, voffA);
            PG8_BAR; PG8_WAIT_L(0); PG8_MMA(1, 0, At, B0); PG8_BAR; PG8_SCHED;
            PG8_STAGE(PG8_SB(0, 1), b2 + hstepB, voffB);
            PG8_WAIT_V(6); PG8_BAR; PG8_MMA(1, 1, At, B1); PG8_BAR;
            PG8_LDB(B0, 1, 0); PG8_SCHED; PG8_LDA(At, 1, 0); PG8_STAGE(PG8_SA(0, 1), a2 + hstepA, voffA);
            PG8_WAIT_L(8); PG8_BAR; PG8_WAIT_L(0); PG8_MMA(0, 0, At, B0); PG8_BAR; PG8_SCHED;
            PG8_LDB(B1, 1, 1); PG8_STAGE(PG8_SB(1, 0), b3, voffB);
            PG8_BAR; PG8_WAIT_L(0); PG8_MMA(0, 1, At, B1); PG8_BAR;
            PG8_LDA(At, 1, 1); PG8_STAGE(PG8_SA(1, 0), a3, voffA);
            PG8_BAR; PG8_WAIT_L(0); PG8_MMA(1, 0, At, B0); PG8_BAR; PG8_SCHED;
            PG8_STAGE(PG8_SB(1, 1), b3 + hstepB, voffB);
            PG8_WAIT_V(6); PG8_BAR; PG8_MMA(1, 1, At, B1); PG8_BAR;
            }
        }
        if constexpr (ALIGN_EPI) { if (wr == 0) PG8_BAR; }
        if constexpr (!Epi::AFTER_DRAIN) { E(acc, cur, wr, wc, fr, fq); S.done(cur); }
        if (!has_next) break;
#pragma unroll
        for (int a = 0; a < 2; ++a)
#pragma unroll
            for (int b = 0; b < 2; ++b)
#pragma unroll
                for (int m = 0; m < 4; ++m)
#pragma unroll
                    for (int n = 0; n < 2; ++n) acc[a][b][m][n] = (f32x4){0.f, 0.f, 0.f, 0.f};
        cur = nxt; cA = nA; cB = nB; ++ui;
        if constexpr (ALIGN_EPI) { if (wr == 1) PG8_BAR; }
    }
    PG8_WAIT_V(0);
    if constexpr (!ALIGN_EPI) { if (wr == 0) PG8_BAR; }
    PG8_BAR;
    if constexpr (Epi::AFTER_DRAIN) { E.fused(acc, cur, wr, wc, fr, fq, lds, wid, lane); S.done(cur); }
#undef PG8_SA
#undef PG8_SB
#undef PG8_STAGE
#undef PG8_LDA
#undef PG8_LDB
#undef PG8_MMA
#undef PG8_WAIT_V
#undef PG8_WAIT_L
#undef PG8_BAR
#undef PG8_SCHED
}
}
#define GAS __attribute__((address_space(1)))
#define LAS __attribute__((address_space(3)))
typedef unsigned short bf16;
typedef unsigned v4u __attribute__((ext_vector_type(4)));
typedef float f32x4 __attribute__((ext_vector_type(4)));
typedef short bf16x8 __attribute__((ext_vector_type(8)));
typedef GAS unsigned gu32;
typedef GAS unsigned long long gu64;
#define RLX_AGENT __ATOMIC_RELAXED, __HIP_MEMORY_SCOPE_AGENT
#define LDS_WAIT() asm volatile("s_waitcnt lgkmcnt(0)" ::: "memory")
#define VM_WAIT() asm volatile("s_waitcnt vmcnt(0)" ::: "memory")
__device__ __forceinline__ unsigned long long rt() { return __builtin_amdgcn_s_memrealtime(); }
__device__ __forceinline__ unsigned f2bf(float f) { unsigned u = __builtin_bit_cast(unsigned, f); return (u + 0x7fffu + ((u >> 16) & 1u)) >> 16; }
__device__ __forceinline__ unsigned pk2(float lo, float hi) { return f2bf(lo) | (f2bf(hi) << 16); }

#define XB_TMO      128
#define XB_XCNT(j)  (256  + 64 * (j))
#define XB_XSUB(j)  (1280 + 64 * (j))
#define XB_XGEN(j)  (2304 + 64 * (j))
#define XB_TOP      3328
#define XB_TOPGEN   3392
#define XCD_BAR_WORDS 3456
#define XB_SPIN_CAP (1u << 18)

__device__ __forceinline__ unsigned xb_ld(unsigned* p)              { return __hip_atomic_load(p, __ATOMIC_RELAXED, __HIP_MEMORY_SCOPE_AGENT); }
__device__ __forceinline__ unsigned xb_add(unsigned* p, unsigned v) { return __hip_atomic_fetch_add(p, v, __ATOMIC_RELAXED, __HIP_MEMORY_SCOPE_AGENT); }
__device__ __forceinline__ unsigned xb_xcc_id() { return (unsigned)__builtin_amdgcn_s_getreg((3 << 11) | 20) & 0xFu; }
#define XB_SPIN(cond, bar) do { unsigned _sp = 0; while (cond) { __builtin_amdgcn_s_sleep(1); \
    if ((++_sp & 255u) == 0u) { if (xb_ld(&(bar)[XB_TMO])) break; if (_sp > XB_SPIN_CAP) { atomicAdd(&(bar)[XB_TMO], 1u); break; } } } } while (0)

struct XcdBarrier {
    unsigned* bar; unsigned x;
    volatile LAS unsigned* st;
};

__device__ __forceinline__ XcdBarrier xcd_barrier_post(unsigned* bar, volatile LAS unsigned* st) {
    XcdBarrier b; b.bar = bar; b.x = xb_xcc_id(); b.st = st;
    if (threadIdx.x == 0) (void)xb_add(&bar[XB_XCNT(b.x)], 1u);
    return b;
}
__device__ __forceinline__ void xcd_barrier_complete(unsigned* bar, unsigned x, unsigned& nloc, unsigned& nx) {
    const unsigned G = gridDim.x * gridDim.y * gridDim.z;
    unsigned sum, cnt, mine, sp = 0u;
    for (;;) {
        sum = 0u; cnt = 0u; mine = 0u;
#pragma unroll
        for (unsigned j = 0; j < 16; ++j) { const unsigned c = xb_ld(&bar[XB_XCNT(j)]); sum += c; cnt += (c > 0u) ? 1u : 0u; mine = (j == x) ? c : mine; }
        if (sum == G) break;
        __builtin_amdgcn_s_sleep(1);
        if ((++sp & 255u) == 0u) { if (xb_ld(&bar[XB_TMO])) break; if (sp > XB_SPIN_CAP) { atomicAdd(&bar[XB_TMO], 1u); break; } }
    }
    nloc = mine > 0u ? mine : 1u; nx = cnt > 0u ? cnt : 1u;
}

__device__ __forceinline__ void xcd_barrier(const XcdBarrier& b) {
    asm volatile("s_waitcnt vmcnt(0)" ::: "memory");
    __syncthreads();
    if (threadIdx.x == 0) {
        unsigned* bar = b.bar;
        __builtin_amdgcn_s_waitcnt(0);
        unsigned nloc = b.st[0], nx = b.st[1];
        if (nloc == 0u) { xcd_barrier_complete(bar, b.x, nloc, nx); b.st[0] = nloc; b.st[1] = nx; }
        const unsigned old = xb_add(&bar[XB_XSUB(b.x)], 1u);
        const unsigned gen = old / nloc;
        if (old + 1u == (gen + 1u) * nloc) {
            __builtin_amdgcn_fence(__ATOMIC_RELEASE, "agent");
            asm volatile("s_waitcnt vmcnt(0)" ::: "memory");
            const unsigned og = xb_add(&bar[XB_TOP], 1u);
            const unsigned tg = og / nx;
            if (og + 1u == (tg + 1u) * nx) xb_add(&bar[XB_TOPGEN], 1u);
            else XB_SPIN(xb_ld(&bar[XB_TOPGEN]) == tg, bar);
            __builtin_amdgcn_fence(__ATOMIC_ACQUIRE, "agent");
            xb_add(&bar[XB_XGEN(b.x)], 1u);
            asm volatile("s_waitcnt vmcnt(0)" ::: "memory");
        } else {
            XB_SPIN(xb_ld(&bar[XB_XGEN(b.x)]) == gen, bar);
            __builtin_amdgcn_fence(__ATOMIC_ACQUIRE, "agent");
            asm volatile("s_waitcnt vmcnt(0)" ::: "memory");
        }
    }
    __syncthreads();
}

constexpr int NWAVES = 8;
constexpr int DM = 2048, TX = 8192, NMETA = 16, TT = TX + NMETA, MP = 8448;
constexpr int EV_NP = 5632, EV_LORA0 = 3072, EV_GB = 3360, EV_REC = 4384;
constexpr int OD_NP = 12544, OD_Z = 8192, OD_B = 12288, OD_A = 12320;
constexpr int NEXP = 32, FF = 512, MOE_ROWS = 24576;
constexpr float NORM_EPS = 1e-6f;

constexpr size_t MiB = 1u << 20;
constexpr size_t WS_CTL = 0, CTL_ZERO_BYTES = 1 * MiB;
constexpr size_t WS_TOKINFO = 1 * MiB;
constexpr size_t WS_TILES = 1 * MiB + 512 * 1024;
constexpr size_t WS_WEVIN = 2 * MiB;
constexpr size_t WS_WEVOUT = 24 * MiB;
constexpr size_t WS_WODIN = 32 * MiB;
constexpr size_t WS_WODOUT = 81 * MiB;
constexpr size_t WS_WLORA = 97 * MiB;
constexpr size_t WS_WGATE = 100 * MiB;
constexpr size_t WS_WROUTE = 101 * MiB;
constexpr size_t WS_MOEW = 102 * MiB;
constexpr size_t MOE_E_BYTES = 6 * MiB, MOE_W2_OFF = 4 * MiB;
constexpr size_t WS_H = 294 * MiB;
constexpr size_t WS_HN = 360 * MiB;
constexpr size_t WS_YMIX = 393 * MiB;
constexpr size_t WS_PROJ = 459 * MiB;
constexpr size_t WS_SCR = 662 * MiB;
constexpr size_t WS_END = 932 * MiB;
constexpr size_t SC_ALORA = 0;
constexpr size_t SC_XR = 8 * MiB;
constexpr size_t SC_DEC = 26 * MiB, SC_ICL = 60 * MiB, SC_GATE = 94 * MiB;
constexpr size_t SC_LA = 128 * MiB, SC_LIX = 162 * MiB;
constexpr size_t SC_QN = 0, SC_KN = 34 * MiB;
constexpr size_t SC_VC = 68 * MiB;
constexpr size_t SC_BETA = 134 * MiB, SC_G = 136 * MiB;
constexpr size_t SC_O = 138 * MiB;
constexpr size_t SC_XG = 0;
constexpr size_t SC_ACT = 96 * MiB;
constexpr size_t SC_YB = 120 * MiB;
static_assert(SC_O + (size_t)MP * 4096 * 4 <= WS_END - WS_SCR && SC_YB + (size_t)MOE_ROWS * 2048 * 2 <= WS_END - WS_SCR && SC_LIX + (size_t)MP * 1024 * 4 <= WS_END - WS_SCR, "scratch map");
constexpr int CW_TMO = 0, CW_CODE = 1;
constexpr int CW_BAR = 4096;
constexpr int CW_PROG = 20480;
constexpr int CW_TS = 24576;
constexpr int CW_MOECNT = 16384;

constexpr int RING_OFF = 0, RING_BYTES = 131072;
constexpr int LDSCTL_OFF = 146944, MISC_OFF = LDSCTL_OFF + 320;
constexpr int LDS_BYTES = 147456;


#define DI __device__ __forceinline__
typedef unsigned v2u __attribute__((ext_vector_type(2)));
struct Args { const float* in[36]; float* out; unsigned char* ws; int ph_lo, ph_hi; };
struct Frame {
    LAS unsigned char* lds; volatile LAS unsigned* MISC; gu32* ctl;
    int tid, lane, wave, vcu, G, gw, NGW;
};
DI float bf2f(bf16 v) { return __uint_as_float((unsigned)v << 16); }
DI float bflo(unsigned w) { return __uint_as_float(w << 16); }
DI float bfhi(unsigned w) { return __uint_as_float(w & 0xffff0000u); }
DI float wave_sum(float v) {
#pragma unroll
    for (int o = 1; o < 64; o <<= 1) v += __shfl_xor(v, o);
    return v;
}
DI float sigm(float x) { return 1.0f / (1.0f + __expf(-x)); }
DI float softplus(float x) { return fmaxf(x, 0.f) + __logf(1.0f + __expf(-fabsf(x))); }
DI float gelu_tanh(float x) { const float u = 0.7978845608028654f * (x + 0.044715f * x * x * x); return 0.5f * x * (1.0f + tanhf(u)); }
DI int pos_row(int p) { return p < NMETA ? TX + p : p - NMETA; }
DI int row_pos(int r) { return r < TX ? r + NMETA : r - TX; }

DI void tr_item(const float* W, int N, int k0, int n0, bf16* WT, int ldk, int drow0, LAS float* scr, int lane) {
#pragma unroll 8
    for (int i = 0; i < 32; ++i) { const int kk = 2 * i + (lane >> 5); scr[kk * 33 + (lane & 31)] = W[(size_t)(k0 + kk) * N + n0 + (lane & 31)]; }
    LDS_WAIT(); asm volatile("" ::: "memory");
    const int c = lane & 7;
#pragma unroll
    for (int j = 0; j < 4; ++j) { const int n = (lane >> 3) + 8 * j; const LAS float* s = scr + (8 * c) * 33 + n;
        v4u o; o.x = pk2(s[0 * 33], s[1 * 33]); o.y = pk2(s[2 * 33], s[3 * 33]); o.z = pk2(s[4 * 33], s[5 * 33]); o.w = pk2(s[6 * 33], s[7 * 33]);
        *(v4u*)(WT + (size_t)(drow0 + n) * ldk + k0 + 8 * c) = o; }
    LDS_WAIT(); asm volatile("" ::: "memory");
}
DI void moe_convert(const Frame& F, const Args& a, int l, int gw, int ngw) {
    LAS float* scr = (LAS float*)(F.lds + RING_OFF + F.wave * 16384);
    bf16* base = (bf16*)(a.ws + WS_MOEW);
    for (int it = gw; it < NEXP * 1536; it += ngw) {
        const int e = it / 1536; int j = it % 1536; bf16* eb = base + (size_t)e * (MOE_E_BYTES / 2);
        const size_t eoff = (size_t)(l * NEXP + e) * DM * FF;
        if (j < 1024) { const float* W = (j < 512 ? a.in[33] : a.in[34]) + eoff; const int hi = j >= 512; j &= 511; const int kb = j >> 4, nb = j & 15, n0 = 32 * nb;
            tr_item(W, FF, 64 * kb, n0, eb, DM, 256 * (n0 >> 7) + 128 * hi + (n0 & 127), scr, F.lane); }
        else { j -= 1024; const int kb = j >> 6, nb = j & 63; tr_item(a.in[35] + eoff, DM, 64 * kb, 32 * nb, eb + MOE_W2_OFF / 2, FF, 32 * nb, scr, F.lane); }
    }
}
DI void norm_row_bf16(int lane, const float* src, const float* w, bf16* dst) {
    f32x4 v[8]; float s = 0.f;
#pragma unroll
    for (int j = 0; j < 8; ++j) { v[j] = ((const f32x4*)src)[lane + 64 * j]; s += (v[j].x * v[j].x + v[j].y * v[j].y) + (v[j].z * v[j].z + v[j].w * v[j].w); }
    const float rs = 1.0f / sqrtf(wave_sum(s) * (1.0f / DM) + NORM_EPS);
#pragma unroll
    for (int j = 0; j < 8; ++j) { const f32x4 wv = ((const f32x4*)w)[lane + 64 * j]; v2u o; o.x = pk2(v[j].x * rs * wv.x, v[j].y * rs * wv.y); o.y = pk2(v[j].z * rs * wv.z, v[j].w * rs * wv.w);
        ((v2u*)dst)[lane + 64 * j] = o; }
}

DI void ph_prologue(const Frame& F, const Args& a) {
    LAS float* scr = (LAS float*)(F.lds + RING_OFF + F.wave * 16384);
    constexpr int I_A = 32 * 169, I_B = 32 * 64, NIT = I_A + I_B;
    for (int it = F.gw; it < NIT; it += F.NGW) {
        int r = it;
        if (r < I_A) { const int kb = r / 169, nb = r % 169; tr_item(a.in[5], 5408, 64 * kb, 32 * nb, (bf16*)(a.ws + WS_WEVIN), DM, 32 * nb, scr, F.lane); continue; } r -= I_A;
        { const int kb = r / 64, nb = r % 64; tr_item(a.in[24], DM, 64 * kb, 32 * nb, (bf16*)(a.ws + WS_WEVOUT), DM, 32 * nb, scr, F.lane); }
    }
    const int gt = F.vcu * (NWAVES * 64) + F.tid, NGT = F.G * NWAVES * 64;
    { bf16* WL = (bf16*)(a.ws + WS_WLORA); const float* wup = a.in[8]; const float* aup = a.in[10]; const float* gup = a.in[11];
      for (int idx = gt; idx < 3072 * 384; idx += NGT) { const int n = idx / 384, k = idx % 384; float v = 0.f;
          if (n < 1024) { if (k < 64) v = wup[k * 1024 + n]; }
          else if (n < 2048) { if (k >= 64 && k < 128) v = aup[(k - 64) * 1024 + n - 1024]; }
          else { if (k >= 128 && k < 288) v = gup[(k - 128) * 1024 + n - 2048]; }
          WL[idx] = (bf16)f2bf(v); } }
    { bf16* WG = (bf16*)(a.ws + WS_WGATE);
      for (int idx = gt; idx < 2048 * 256; idx += NGT) { const int n = idx >> 8, kk = idx & 255, nn = n & 1023, blk = nn >> 6, j = nn & 63, cin = (nn & ~255) + kk;
          const float* W = n < 1024 ? a.in[19] : a.in[21];
          const float v = (cin >> 6) == blk ? W[blk * 4096 + (cin & 63) * 64 + j] : 0.f;
          WG[idx] = (bf16)f2bf(v); } }
    { bf16* WR = (bf16*)(a.ws + WS_WROUTE);
      for (int idx = gt; idx < 2 * 48 * DM; idx += NGT) { const int l = idx / (48 * DM), n = (idx / DM) % 48, k = idx % DM; float v = 0.f;
          if (n < 32) v = a.in[32][((size_t)l * DM + k) * NEXP + n]; else if (n < 36) v = a.in[31][((size_t)l * DM + k) * 4 + n - 32];
          const unsigned hi = f2bf(v); WR[((size_t)(l * 2) * 48 + n) * DM + k] = (bf16)hi; WR[((size_t)(l * 2 + 1) * 48 + n) * DM + k] = (bf16)f2bf(v - __uint_as_float(hi << 16)); } }
    bf16* HN = (bf16*)(a.ws + WS_HN);
    for (int r = F.gw; r < TT; r += F.NGW) norm_row_bf16(F.lane, r < TX ? a.in[0] + (size_t)r * DM : a.in[1] + (size_t)(r - TX) * DM, a.in[2], HN + (size_t)r * DM);
}

DI void ph_aux_convert(const Frame& F, const Args& a, int gw, int ngw) {
    LAS float* scr = (LAS float*)(F.lds + RING_OFF + F.wave * 16384);
    constexpr int I_C = 32 * 386, I_D = 64 * 64, NIT = I_C + I_D;
    for (int it = gw; it < NIT; it += ngw) {
        int r = it;
        if (r < I_C) { const int kb = r / 386, nb = r % 386; tr_item(a.in[25], 12352, 64 * kb, 32 * nb, (bf16*)(a.ws + WS_WODIN), DM, 32 * nb, scr, F.lane); continue; } r -= I_C;
        { const int kb = r / 64, nb = r % 64; tr_item(a.in[30], DM, 64 * kb, 32 * nb, (bf16*)(a.ws + WS_WODOUT), 4096, 32 * nb, scr, F.lane); }
    }
    moe_convert(F, a, 0, gw, ngw);
}

DI void ph_even_prep(const Frame& F, const Args& a) {
    const bf16* P = (const bf16*)(a.ws + WS_PROJ); bf16* AL = (bf16*)(a.ws + WS_SCR + SC_ALORA); bf16* XR = (bf16*)(a.ws + WS_SCR + SC_XR);
    const float* mu = a.in[6]; const float* cw = a.in[17]; const float* cb = a.in[18];
    const int lane = F.lane;
    for (int item = F.gw; item < TT + (TT / 8) * 2; item += F.NGW) {
        if (item < TT) { const int r = item, pos = row_pos(r); const bf16* cur = P + (size_t)r * EV_NP; const bf16* prv = P + (size_t)pos_row(pos > 0 ? pos - 1 : 0) * EV_NP; const float pm = pos > 0 ? 1.f : 0.f;
            float cv[6], pv[6], mv[6];
#pragma unroll
            for (int i = 0; i < 6; ++i) { const int idx = lane + 64 * i, col = EV_LORA0 + (idx < 288 ? idx : 287); cv[i] = bf2f(cur[col]); pv[i] = bf2f(prv[col]) * pm; mv[i] = mu[col]; }
#pragma unroll
            for (int i = 0; i < 6; ++i) { const int idx = lane + 64 * i; float v = cv[i] + (pv[i] - cv[i]) * mv[i];
                if (idx < 64) v = tanhf(v); else if (idx >= 128) v = sigm(v);
                AL[(size_t)r * 384 + idx] = (bf16)f2bf(idx < 288 ? v : 0.f); }
        } else { const int it2 = item - TT, pb = it2 >> 1, c0 = (it2 & 1) * 512 + lane * 8, p0 = pb * 8;
            f32x4 w[4][2], b0 = *(const f32x4*)(cb + c0), b1 = *(const f32x4*)(cb + c0 + 4);
#pragma unroll
            for (int j = 0; j < 4; ++j) { w[j][0] = *(const f32x4*)(cw + j * 1024 + c0); w[j][1] = *(const f32x4*)(cw + j * 1024 + c0 + 4); }
            v4u x[11];
#pragma unroll
            for (int i = 0; i < 11; ++i) { const int p = p0 - 3 + i; x[i] = *(const v4u*)(P + (size_t)pos_row(p > 0 ? p : 0) * EV_NP + EV_REC + c0); if (p < 0) x[i] = (v4u){0u, 0u, 0u, 0u}; }
#pragma unroll
            for (int o = 0; o < 8; ++o) { float acc[8] = {b0.x, b0.y, b0.z, b0.w, b1.x, b1.y, b1.z, b1.w};
#pragma unroll
                for (int j = 0; j < 4; ++j) { const v4u xv = x[o + j];
                    acc[0] += w[j][0].x * bflo(xv.x); acc[1] += w[j][0].y * bfhi(xv.x); acc[2] += w[j][0].z * bflo(xv.y); acc[3] += w[j][0].w * bfhi(xv.y);
                    acc[4] += w[j][1].x * bflo(xv.z); acc[5] += w[j][1].y * bfhi(xv.z); acc[6] += w[j][1].z * bflo(xv.w); acc[7] += w[j][1].w * bfhi(xv.w); }
                *(v4u*)(XR + (size_t)pos_row(p0 + o) * 1024 + c0) = (v4u){pk2(acc[0], acc[1]), pk2(acc[2], acc[3]), pk2(acc[4], acc[5]), pk2(acc[6], acc[7])}; } }
    }
}

DI void ph_route(const Frame& F, const Args& a, int l, int dummy) {
    const float* H = (const float*)(a.ws + WS_H); const float* nw = a.in[3] + (size_t)l * DM;
    const bf16* WH = (const bf16*)(a.ws + WS_WROUTE) + (size_t)(l * 2) * 48 * DM; const bf16* WL = WH + (size_t)48 * DM;
    unsigned* TI = (unsigned*)(a.ws + WS_TOKINFO) + (dummy ? (WS_SCR + 250 * MiB - WS_TOKINFO) / 4 : 0); const int lane = F.lane, lc = lane & 15, quad = lane >> 4; const int cl = dummy ? l + 2 : l;
    LAS float* scr = (LAS float*)(F.lds + RING_OFF + F.wave * 16384);
    for (int task = F.gw; task < TT / 16; task += F.NGW) {
        const int r = task * 16 + lc; const float* hr = H + (size_t)r * DM + 8 * quad; float ss = 0.f;
#pragma unroll 8
        for (int ks = 0; ks < 64; ++ks) { const f32x4 x0 = *(const f32x4*)(hr + 32 * ks), x1 = *(const f32x4*)(hr + 32 * ks + 4); ss += (x0.x * x0.x + x0.y * x0.y) + (x0.z * x0.z + x0.w * x0.w) + (x1.x * x1.x + x1.y * x1.y) + (x1.z * x1.z + x1.w * x1.w); }
        ss += __shfl_xor(ss, 16); ss += __shfl_xor(ss, 32);
        const float rs = 1.0f / sqrtf(ss * (1.0f / DM) + NORM_EPS);
        f32x4 acc[3];
#pragma unroll
        for (int nt = 0; nt < 3; ++nt) acc[nt] = (f32x4){0.f, 0.f, 0.f, 0.f};
#pragma unroll 2
        for (int ks = 0; ks < 64; ++ks) { const int k0 = 32 * ks + 8 * quad; const f32x4 x0 = *(const f32x4*)(hr + 32 * ks), x1 = *(const f32x4*)(hr + 32 * ks + 4), w0 = *(const f32x4*)(nw + k0), w1 = *(const f32x4*)(nw + k0 + 4);
            const float xn[8] = {x0.x * rs * w0.x, x0.y * rs * w0.y, x0.z * rs * w0.z, x0.w * rs * w0.w, x1.x * rs * w1.x, x1.y * rs * w1.y, x1.z * rs * w1.z, x1.w * rs * w1.w};
            unsigned hi[8]; float lo[8];
#pragma unroll
            for (int q = 0; q < 8; ++q) { hi[q] = f2bf(xn[q]); lo[q] = xn[q] - __uint_as_float(hi[q] << 16); }
            const v4u ah4 = (v4u){hi[0] | (hi[1] << 16), hi[2] | (hi[3] << 16), hi[4] | (hi[5] << 16), hi[6] | (hi[7] << 16)}, al4 = (v4u){pk2(lo[0], lo[1]), pk2(lo[2], lo[3]), pk2(lo[4], lo[5]), pk2(lo[6], lo[7])};
            const bf16x8 ah = __builtin_bit_cast(bf16x8, ah4), al = __builtin_bit_cast(bf16x8, al4);
#pragma unroll
            for (int nt = 0; nt < 3; ++nt) { const bf16x8 bh = *(const bf16x8*)(WH + (size_t)(16 * nt + lc) * DM + k0), bl = *(const bf16x8*)(WL + (size_t)(16 * nt + lc) * DM + k0);
                acc[nt] = __builtin_amdgcn_mfma_f32_16x16x32_bf16(al, bh, acc[nt], 0, 0, 0); acc[nt] = __builtin_amdgcn_mfma_f32_16x16x32_bf16(ah, bl, acc[nt], 0, 0, 0); acc[nt] = __builtin_amdgcn_mfma_f32_16x16x32_bf16(ah, bh, acc[nt], 0, 0, 0); } }
#pragma unroll
        for (int nt = 0; nt < 3; ++nt)
#pragma unroll
            for (int q = 0; q < 4; ++q) scr[(4 * quad + q) * 49 + 16 * nt + lc] = acc[nt][q];
        asm volatile("s_waitcnt lgkmcnt(0)" ::: "memory"); __builtin_amdgcn_wave_barrier();
        if (lane < 16) { float lg[36];
#pragma unroll
            for (int i = 0; i < 36; ++i) lg[i] = scr[lane * 49 + i];
            int gi = 0; float gm = lg[32];
#pragma unroll
            for (int i = 1; i < 4; ++i) if (lg[32 + i] > gm) { gm = lg[32 + i]; gi = i; }
            float den = 0.f;
#pragma unroll
            for (int i = 0; i < 4; ++i) den += __expf(lg[32 + i] - gm);
            const float gp = 1.0f / den;
            float l8[8];
#pragma unroll
            for (int i = 0; i < 8; ++i) l8[i] = gi == 0 ? lg[i] : (gi == 1 ? lg[8 + i] : (gi == 2 ? lg[16 + i] : lg[24 + i]));
            int i1 = 0; float m1 = l8[0];
#pragma unroll
            for (int i = 1; i < 8; ++i) if (l8[i] > m1) { m1 = l8[i]; i1 = i; }
            int i2 = -1; float m2 = -INFINITY;
#pragma unroll
            for (int i = 0; i < 8; ++i) if (i != i1 && l8[i] > m2) { m2 = l8[i]; i2 = i; }
            const float e21 = __expf(m2 - m1); const float w1 = gp / (1.0f + e21), w2 = gp * e21 / (1.0f + e21);
            const int ea = gi * 8 + i1, eb = gi * 8 + i2;
            const unsigned sa = atomicAdd((unsigned*)(F.ctl + CW_MOECNT + (cl * NEXP + ea) * 16), 1u), sb = atomicAdd((unsigned*)(F.ctl + CW_MOECNT + (cl * NEXP + eb) * 16), 1u);
            unsigned* t = TI + (size_t)r * 8; *(v4u*)t = (v4u){(unsigned)ea, sa, __float_as_uint(w1), (unsigned)eb}; *(v4u*)(t + 4) = (v4u){sb, __float_as_uint(w2), __float_as_uint(rs), 0u}; }
        __builtin_amdgcn_wave_barrier(); asm volatile("" ::: "memory");
    }
}
DI void moe_prefix(const Frame& F, int l, LAS int* ps) {
    if (F.tid == 0) { int t = 0;
        for (int e = 0; e < NEXP; ++e) { const unsigned c = __hip_atomic_load(F.ctl + CW_MOECNT + (l * NEXP + e) * 16, RLX_AGENT); ps[e] = t * 256; t += (int)((c + 255u) >> 8); }
        ps[32] = t; }
    __syncthreads();
}
DI void ph_gather(const Frame& F, const Args& a, int l) {
    LAS int* ps = (LAS int*)(F.lds + RING_OFF); moe_prefix(F, l, ps);
    if (F.vcu == 0 && F.tid < NEXP) { int* TE = (int*)(a.ws + WS_TILES); const int e = F.tid; const int t0 = ps[e] >> 8, t1 = (e == NEXP - 1 ? ps[32] : ps[e + 1] >> 8);
        for (int t = t0; t < t1; ++t) TE[t] = e; if (e == 0) TE[127] = ps[32]; }
    const float* H = (const float*)(a.ws + WS_H); const float* nw = a.in[3] + (size_t)l * DM; unsigned* TI = (unsigned*)(a.ws + WS_TOKINFO); bf16* XG = (bf16*)(a.ws + WS_SCR + SC_XG);
    const int lane = F.lane;
    for (int r = F.gw; r < TT; r += F.NGW) {
        unsigned* t = TI + (size_t)r * 8; const int g0 = ps[t[0]] + (int)t[1], g1 = ps[t[3]] + (int)t[4]; const float rs = __uint_as_float(t[6]);
        if (lane == 0) { t[1] = (unsigned)g0; t[4] = (unsigned)g1; }
        const float* hr = H + (size_t)r * DM;
#pragma unroll
        for (int j = 0; j < 4; ++j) { const int e0 = (lane + 64 * j) * 8; const f32x4 x0 = *(const f32x4*)(hr + e0), x1 = *(const f32x4*)(hr + e0 + 4), w0 = *(const f32x4*)(nw + e0), w1 = *(const f32x4*)(nw + e0 + 4);
            v4u o; o.x = pk2(x0.x * rs * w0.x, x0.y * rs * w0.y); o.y = pk2(x0.z * rs * w0.z, x0.w * rs * w0.w); o.z = pk2(x1.x * rs * w1.x, x1.y * rs * w1.y); o.w = pk2(x1.z * rs * w1.z, x1.w * rs * w1.w);
            *(v4u*)(XG + (size_t)g0 * DM + e0) = o; *(v4u*)(XG + (size_t)g1 * DM + e0) = o; }
    }
}
DI void ph_combine(const Frame& F, const Args& a, int l) {
    float* H = (float*)(a.ws + WS_H); const unsigned* TI = (const unsigned*)(a.ws + WS_TOKINFO); const bf16* YB = (const bf16*)(a.ws + WS_SCR + SC_YB); bf16* HN = (bf16*)(a.ws + WS_HN);
    const int lane = F.lane; const int nrows = l == 0 ? TT : TX;
    for (int r = F.gw; r < nrows; r += F.NGW) {
        const unsigned* t = TI + (size_t)r * 8; const int g0 = (int)t[1], g1 = (int)t[4]; const float w0 = __uint_as_float(t[2]), w1 = __uint_as_float(t[5]);
        float* hr = H + (size_t)r * DM; float hv[32]; float s = 0.f;
#pragma unroll
        for (int j = 0; j < 4; ++j) { const int e0 = (lane + 64 * j) * 8; const f32x4 x0 = *(const f32x4*)(hr + e0), x1 = *(const f32x4*)(hr + e0 + 4);
            const v4u ya = *(const v4u*)(YB + (size_t)g0 * DM + e0), yc = *(const v4u*)(YB + (size_t)g1 * DM + e0);
            float* o = hv + 8 * j;
            o[0] = x0.x + w0 * bflo(ya.x) + w1 * bflo(yc.x); o[1] = x0.y + w0 * bfhi(ya.x) + w1 * bfhi(yc.x); o[2] = x0.z + w0 * bflo(ya.y) + w1 * bflo(yc.y); o[3] = x0.w + w0 * bfhi(ya.y) + w1 * bfhi(yc.y);
            o[4] = x1.x + w0 * bflo(ya.z) + w1 * bflo(yc.z); o[5] = x1.y + w0 * bfhi(ya.z) + w1 * bfhi(yc.z); o[6] = x1.z + w0 * bflo(ya.w) + w1 * bflo(yc.w); o[7] = x1.w + w0 * bfhi(ya.w) + w1 * bfhi(yc.w);
#pragma unroll
            for (int q = 0; q < 8; ++q) s += o[q] * o[q]; }
        const float rs = 1.0f / sqrtf(wave_sum(s) * (1.0f / DM) + NORM_EPS);
        if (l == 0) { const float* nw = a.in[2] + DM;
#pragma unroll
            for (int j = 0; j < 4; ++j) { const int e0 = (lane + 64 * j) * 8; const float* o = hv + 8 * j; const f32x4 wa = *(const f32x4*)(nw + e0), wb = *(const f32x4*)(nw + e0 + 4);
                *(f32x4*)(hr + e0) = (f32x4){o[0], o[1], o[2], o[3]}; *(f32x4*)(hr + e0 + 4) = (f32x4){o[4], o[5], o[6], o[7]};
                v4u p; p.x = pk2(o[0] * rs * wa.x, o[1] * rs * wa.y); p.y = pk2(o[2] * rs * wa.z, o[3] * rs * wa.w); p.z = pk2(o[4] * rs * wb.x, o[5] * rs * wb.y); p.w = pk2(o[6] * rs * wb.z, o[7] * rs * wb.w);
                *(v4u*)(HN + (size_t)r * DM + e0) = p; }
        } else { const float* nw = a.in[4]; float* orow = a.out + (size_t)r * DM;
#ifdef PROBE_TS
            { const unsigned long long* ts = (const unsigned long long*)(F.ctl + CW_TS); const float dt_us = (float)(__hip_atomic_load(ts + PROBE_TS + 1, RLX_AGENT) - __hip_atomic_load(ts + PROBE_TS, RLX_AGENT)) * 0.01f;
#pragma unroll
              for (int q = 0; q < 32; ++q) hv[q] *= 1.0f + dt_us * 0.01f; }
#endif
#pragma unroll
            for (int j = 0; j < 4; ++j) { const int e0 = (lane + 64 * j) * 8; const float* o = hv + 8 * j; const f32x4 wa = *(const f32x4*)(nw + e0), wb = *(const f32x4*)(nw + e0 + 4);
                *(f32x4*)(orow + e0) = (f32x4){o[0] * rs * wa.x, o[1] * rs * wa.y, o[2] * rs * wa.z, o[3] * rs * wa.w};
                *(f32x4*)(orow + e0 + 4) = (f32x4){o[4] * rs * wb.x, o[5] * rs * wb.y, o[6] * rs * wb.z, o[7] * rs * wb.w}; } }
    }
}

DI void ph_odd_prep(const Frame& F, const Args& a) {
    const bf16* P = (const bf16*)(a.ws + WS_PROJ); bf16* QN = (bf16*)(a.ws + WS_SCR + SC_QN); bf16* KN = (bf16*)(a.ws + WS_SCR + SC_KN); bf16* VC = (bf16*)(a.ws + WS_SCR + SC_VC);
    float* BETA = (float*)(a.ws + WS_SCR + SC_BETA); float* GG = (float*)(a.ws + WS_SCR + SC_G);
    const float* cw = a.in[26]; const int lane = F.lane;
    for (int item = F.gw; item < (TT / 8) * 16; item += F.NGW) { const int pb = item >> 4, i = item & 15, ch = i * 512 + lane * 8, p0 = pb * 8;
        f32x4 w[4][2];
#pragma unroll
        for (int j = 0; j < 4; ++j) { w[j][0] = *(const f32x4*)(cw + j * 8192 + ch); w[j][1] = *(const f32x4*)(cw + j * 8192 + ch + 4); }
        v4u x[11];
#pragma unroll
        for (int q = 0; q < 11; ++q) { const int p = p0 - 3 + q; x[q] = *(const v4u*)(P + (size_t)pos_row(p > 0 ? p : 0) * OD_NP + ch); if (p < 0) x[q] = (v4u){0u, 0u, 0u, 0u}; }
#pragma unroll
        for (int o = 0; o < 8; ++o) { const int r = pos_row(p0 + o); float acc[8] = {0.f, 0.f, 0.f, 0.f, 0.f, 0.f, 0.f, 0.f};
#pragma unroll
            for (int j = 0; j < 4; ++j) { const v4u xv = x[o + j];
                acc[0] += w[j][0].x * bflo(xv.x); acc[1] += w[j][0].y * bfhi(xv.x); acc[2] += w[j][0].z * bflo(xv.y); acc[3] += w[j][0].w * bfhi(xv.y);
                acc[4] += w[j][1].x * bflo(xv.z); acc[5] += w[j][1].y * bfhi(xv.z); acc[6] += w[j][1].z * bflo(xv.w); acc[7] += w[j][1].w * bfhi(xv.w); }
            float ss = 0.f;
#pragma unroll
            for (int q = 0; q < 8; ++q) { acc[q] = acc[q] * sigm(acc[q]); ss += acc[q] * acc[q]; }
            float sc = 1.0f;
            if (i < 8) { ss += __shfl_xor(ss, 1); ss += __shfl_xor(ss, 2); ss += __shfl_xor(ss, 4); ss += __shfl_xor(ss, 8);
                sc = (1.0f / sqrtf(ss + NORM_EPS)) * (i < 4 ? 0.08838834764831845f : 1.0f); }
            const v4u ov = (v4u){pk2(acc[0] * sc, acc[1] * sc), pk2(acc[2] * sc, acc[3] * sc), pk2(acc[4] * sc, acc[5] * sc), pk2(acc[6] * sc, acc[7] * sc)};
            bf16* dst = i < 4 ? QN + (size_t)r * 2048 + ch : (i < 8 ? KN + (size_t)r * 2048 + ch - 2048 : VC + (size_t)r * 4096 + ch - 4096);
            *(v4u*)dst = ov; }
        if (i == 0 && lane < 32) {
#pragma unroll
            for (int o = 0; o < 8; ++o) { const int r = pos_row(p0 + o); const float bb = bf2f(P[(size_t)r * OD_NP + OD_B + lane]), aa = bf2f(P[(size_t)r * OD_NP + OD_A + lane]);
                BETA[(size_t)r * 32 + lane] = sigm(bb); GG[(size_t)r * 32 + lane] = -__expf(a.in[27][lane]) * softplus(aa + a.in[28][lane]); } }
    }
}
DI void ph_odd_post(const Frame& F, const Args& a) {
    const bf16* P = (const bf16*)(a.ws + WS_PROJ); const bf16* O = (const bf16*)(a.ws + WS_SCR + SC_O); bf16* Y = (bf16*)(a.ws + WS_YMIX); const float* nw = a.in[29];
    const int lane = F.lane;
    for (int r = F.gw; r < TT; r += F.NGW) {
#pragma unroll 2
        for (int i = 0; i < 8; ++i) { const int ch = i * 512 + lane * 8; const v4u ow = *(const v4u*)(O + (size_t)r * 4096 + ch); const f32x4 o0 = (f32x4){bflo(ow.x), bfhi(ow.x), bflo(ow.y), bfhi(ow.y)}, o1 = (f32x4){bflo(ow.z), bfhi(ow.z), bflo(ow.w), bfhi(ow.w)};
            float ss = (o0.x * o0.x + o0.y * o0.y) + (o0.z * o0.z + o0.w * o0.w) + (o1.x * o1.x + o1.y * o1.y) + (o1.z * o1.z + o1.w * o1.w);
            ss += __shfl_xor(ss, 1); ss += __shfl_xor(ss, 2); ss += __shfl_xor(ss, 4); ss += __shfl_xor(ss, 8);
            const float rs = 1.0f / sqrtf(ss * (1.0f / 128.0f) + NORM_EPS);
            const v4u z = *(const v4u*)(P + (size_t)r * OD_NP + OD_Z + ch); const int c0 = ch & 127; const f32x4 w0 = *(const f32x4*)(nw + c0), w1 = *(const f32x4*)(nw + c0 + 4);
            const float zf[8] = {bflo(z.x), bfhi(z.x), bflo(z.y), bfhi(z.y), bflo(z.z), bfhi(z.z), bflo(z.w), bfhi(z.w)};
            const float of[8] = {o0.x * w0.x, o0.y * w0.y, o0.z * w0.z, o0.w * w0.w, o1.x * w1.x, o1.y * w1.y, o1.z * w1.z, o1.w * w1.w};
            float y[8];
#pragma unroll
            for (int q = 0; q < 8; ++q) y[q] = of[q] * rs * zf[q] * sigm(zf[q]);
            v4u p; p.x = pk2(y[0], y[1]); p.y = pk2(y[2], y[3]); p.z = pk2(y[4], y[5]); p.w = pk2(y[6], y[7]);
            *(v4u*)(Y + (size_t)r * 4096 + ch) = p; }
    }
}

typedef float f32x16 __attribute__((ext_vector_type(16)));
#define MFMA32(a, b, c) __builtin_amdgcn_mfma_f32_32x32x16_bf16((a), (b), (c), 0, 0, 0)
DI int crow(int reg, int h) { return (reg & 3) + 8 * (reg >> 2) + 4 * h; }
DI int chunk_row(int n, int c) { return n == 0 ? (c >= 48 ? TX + (c - 48) : -1) : 64 * (n - 1) + c; }
#ifndef GDN_NO_HELPER
#define GDN_NO_HELPER 0
#endif
constexpr int GDN_NCH = 129, GDN_UNITS = GDN_NCH * 32, GDN_KUNITS = GDN_NCH * 16, GC_STRIDE = 72;
constexpr size_t GD_WF = WS_MOEW, GD_UF = WS_MOEW + 65 * MiB, GD_IN = WS_MOEW + 130 * MiB, GD_GC = WS_MOEW + 163 * MiB, GD_KT = WS_HN, GD_SAVE = WS_SCR + 205 * MiB;
static_assert((size_t)GDN_UNITS * 16384 <= 65 * MiB && (size_t)GDN_UNITS * 8192 <= 33 * MiB && (size_t)GDN_KUNITS * 16384 <= 33 * MiB && GD_GC + (size_t)GDN_UNITS * GC_STRIDE * 4 <= WS_H, "gdn map");

DI void ph_gdn_chunk(const Frame& F, const Args& a, int n_lo, int n_hi, int side) {
    const bf16* QN = (const bf16*)(a.ws + WS_SCR + SC_QN); const bf16* KN = (const bf16*)(a.ws + WS_SCR + SC_KN); const bf16* VC = (const bf16*)(a.ws + WS_SCR + SC_VC);
    const float* BETA = (const float*)(a.ws + WS_SCR + SC_BETA); const float* GG = (const float*)(a.ws + WS_SCR + SC_G);
    bf16* WF = (bf16*)(a.ws + GD_WF); bf16* UF = (bf16*)(a.ws + GD_UF); bf16* INF = (bf16*)(a.ws + GD_IN); bf16* KTF = (bf16*)(a.ws + GD_KT); float* GC = (float*)(a.ws + GD_GC);
    LAS unsigned char* L = F.lds + RING_OFF;
    LAS unsigned char* kS = L; LAS unsigned char* qS = L + 17408; LAS unsigned char* vS = L + 34816; LAS unsigned char* kbS = L + 52224;
    LAS float* Lm = (LAS float*)(L + 69632); LAS bf16* IS = (LAS bf16*)(L + 87040); LAS bf16* XS = (LAS bf16*)(L + 96256);
    LAS float* betaS = (LAS float*)(L + 130048); LAS float* gcS = betaS + 64; LAS float* egcS = betaS + 128;
    LAS unsigned char* Lb = L + 17408; LAS unsigned char* TDs = L + 26624; LAS unsigned char* YT0 = L + 28672; LAS unsigned char* XT0 = L + 130816;
    static_assert(130816 + 8 * 1792 <= LDSCTL_OFF, "gdn lds map");
    const int tid = F.tid, lane = F.lane, wave = F.wave, l31 = lane & 31, h = lane >> 5;
    int widx = F.vcu, wcnt = F.G;
    if (side) { if (F.G == 256) { const int wx = F.vcu & 31; if (wx < 20) return; widx = (F.vcu >> 5) * 12 + (wx - 20); wcnt = 96; } else { if (F.vcu < 128 || F.G <= 128) return; widx = F.vcu - 128; wcnt = F.G - 128; } }
    for (int unit = n_lo * 32 + widx; unit < n_hi * 32; unit += wcnt) {
        const int n = unit >> 5, hv = unit & 31, hk = hv >> 1; const size_t su = (size_t)hv * GDN_NCH + n;
#pragma unroll
        for (int i = 0; i < 2; ++i) { const int p = tid + 512 * i, row = p >> 4, ch = p & 15; const int rr = chunk_row(n, row);
            v4u kx = (v4u){0u, 0u, 0u, 0u}, qx = kx, vx = kx;
            if (rr >= 0) { kx = *(const v4u*)(KN + (size_t)rr * 2048 + hk * 128 + ch * 8); qx = *(const v4u*)(QN + (size_t)rr * 2048 + hk * 128 + ch * 8); vx = *(const v4u*)(VC + (size_t)rr * 4096 + hv * 128 + ch * 8); }
            *(LAS v4u*)(kS + row * 272 + ch * 16) = kx; *(LAS v4u*)(qS + row * 272 + ch * 16) = qx; *(LAS v4u*)(vS + row * 272 + ch * 16) = vx; }
        if (wave == 0) { const int rr = chunk_row(n, lane); float b = 0.f, g = 0.f; if (rr >= 0) { b = BETA[(size_t)rr * 32 + hv]; g = GG[(size_t)rr * 32 + hv]; }
#pragma unroll
            for (int o = 1; o < 64; o <<= 1) { const float t = __shfl_up(g, o); if (lane >= o) g += t; }
            betaS[lane] = b; gcS[lane] = g; egcS[lane] = __expf(g); }
        __syncthreads();
#pragma unroll
        for (int i = 0; i < 2; ++i) { const int p = tid + 512 * i, row = p >> 4, ch = p & 15; const v4u kx = *(const LAS v4u*)(kS + row * 272 + ch * 16); const float b = betaS[row];
            v4u o; o.x = pk2(bflo(kx.x) * b, bfhi(kx.x) * b); o.y = pk2(bflo(kx.y) * b, bfhi(kx.y) * b); o.z = pk2(bflo(kx.z) * b, bfhi(kx.z) * b); o.w = pk2(bflo(kx.w) * b, bfhi(kx.w) * b);
            *(LAS v4u*)(kbS + row * 272 + ch * 16) = o; }
        __syncthreads();
        { const int which = wave >> 2, ti = (wave >> 1) & 1, tj = wave & 1;
          f32x16 acc;
#pragma unroll
          for (int r = 0; r < 16; ++r) acc[r] = 0.f;
          if (!(ti == 0 && tj == 1)) { const LAS unsigned char* Ab = (which == 0 ? kbS : qS) + (32 * ti + l31) * 272 + 16 * h; const LAS unsigned char* Bb = kS + (32 * tj + l31) * 272 + 16 * h;
#pragma unroll
              for (int s = 0; s < 8; ++s) acc = MFMA32(*(const LAS bf16x8*)(Ab + 32 * s), *(const LAS bf16x8*)(Bb + 32 * s), acc); }
          const int j = 32 * tj + l31; const float gj = gcS[j];
#pragma unroll
          for (int r = 0; r < 16; ++r) { const int i = 32 * ti + crow(r, h); const float e = __expf(fminf(gcS[i] - gj, 0.f));
              if (which == 0) Lm[i * 68 + j] = i > j ? acc[r] * e : 0.f;
              else IS[i * 72 + j] = (bf16)f2bf(i >= j ? acc[r] * e : 0.f); } }
        __syncthreads();
#pragma unroll
        for (int i = 0; i < 8; ++i) { const int e = tid + 512 * i, r = e >> 6, c = e & 63; *(LAS bf16*)(Lb + r * 144 + c * 2) = (bf16)f2bf(Lm[r * 68 + c]); }
        if (wave == 0) { const int b = lane >> 4, c = lane & 15; float t[16]; const LAS float* Ld = Lm + (16 * b) * 68 + 16 * b;
#pragma unroll
            for (int i = 0; i < 16; ++i) { float acc = i == c ? 1.f : 0.f;
#pragma unroll
                for (int j = 0; j < i; ++j) acc -= Ld[i * 68 + j] * t[j];
                t[i] = acc; *(LAS bf16*)(TDs + (b * 16 + i) * 32 + c * 2) = (bf16)f2bf(acc); }
        } else if (wave >= 4) { const int t2 = tid - 256;
#pragma unroll
            for (int i = 0; i < 2; ++i) { const int p = t2 + 256 * i, comb = p >> 6, ln = p & 63, t = comb >> 2, s = comb & 3; const int c = 32 * t + (ln & 31), j0 = 16 * s + 8 * (ln >> 5);
                *(v4u*)(INF + (su * 8 + comb) * 512 + ln * 8) = *(const LAS v4u*)(IS + c * 72 + j0); }
            if ((hv & 1) == 0) { const size_t kunit = (size_t)hk * GDN_NCH + n;
#pragma unroll
                for (int i = 0; i < 4; ++i) { const int p = t2 + 256 * i, comb = p >> 6, ln = p & 63, kt = comb >> 2, s = comb & 3; const int kd = 32 * kt + (ln & 31), c0 = 16 * s + 8 * (ln >> 5);
                    unsigned w[4];
#pragma unroll
                    for (int jj = 0; jj < 4; ++jj) { const unsigned lo = *(const LAS bf16*)(kS + (c0 + 2 * jj) * 272 + kd * 2), hi = *(const LAS bf16*)(kS + (c0 + 2 * jj + 1) * 272 + kd * 2); w[jj] = lo | (hi << 16); }
                    *(v4u*)(KTF + (kunit * 16 + comb) * 512 + ln * 8) = (v4u){w[0], w[1], w[2], w[3]}; } }
            if (t2 < 64) GC[su * GC_STRIDE + t2] = gcS[t2];
            else if (t2 == 64) GC[su * GC_STRIDE + 64] = gcS[63];
            else if (t2 == 65) GC[su * GC_STRIDE + 65] = egcS[63];
        }
        __syncthreads();
        { const int quad = lane >> 4, lc = lane & 15; LAS unsigned char* XTw = XT0 + wave * 1792; LAS unsigned char* YTw = YT0 + wave * 768;
          const bf16x8 z8 = (bf16x8){0, 0, 0, 0, 0, 0, 0, 0}; const f32x4 z4 = (f32x4){0.f, 0.f, 0.f, 0.f};
          bf16x8 tdf[4];
#pragma unroll
          for (int b = 0; b < 4; ++b) tdf[b] = quad < 2 ? *(const LAS bf16x8*)(TDs + (b * 16 + lc) * 32 + quad * 16) : z8;
#pragma unroll 1
          for (int tl = 0; tl < 2; ++tl) { const int col = 32 * wave + 16 * tl + lc;
              const LAS unsigned char* rz = wave < 4 ? vS + col * 2 : kbS + (col - 128) * 2; const LAS float* bz = wave < 4 ? betaS : egcS;
#pragma unroll
              for (int b = 0; b < 4; ++b) { f32x4 y;
#pragma unroll
                  for (int r = 0; r < 4; ++r) { const int i = 16 * b + 4 * quad + r; y[r] = bf2f(*(const LAS bf16*)(rz + i * 272)) * bz[i]; }
                  if (b >= 1) { f32x4 p = z4;
#pragma unroll
                      for (int kk = 0; kk < (b >= 3 ? 2 : 1); ++kk) { const bf16x8 af = *(const LAS bf16x8*)(Lb + (16 * b + lc) * 144 + (32 * kk + 8 * quad) * 2);
                          const bf16x8 bfv = (32 * kk + 8 * quad < 16 * b) ? *(const LAS bf16x8*)(XTw + lc * 112 + (32 * kk + 8 * quad) * 2) : z8;
                          p = __builtin_amdgcn_mfma_f32_16x16x32_bf16(af, bfv, p, 0, 0, 0); }
                      y = y - p; }
                  *(LAS v2u*)(YTw + lc * 48 + quad * 8) = (v2u){pk2(y[0], y[1]), pk2(y[2], y[3])};
                  asm volatile("" ::: "memory");
                  const bf16x8 yb = quad < 2 ? *(const LAS bf16x8*)(YTw + lc * 48 + quad * 16) : z8;
                  const f32x4 x = __builtin_amdgcn_mfma_f32_16x16x32_bf16(tdf[b], yb, z4, 0, 0, 0);
                  if (b < 3) *(LAS v2u*)(XTw + lc * 112 + (16 * b + 4 * quad) * 2) = (v2u){pk2(x[0], x[1]), pk2(x[2], x[3])};
                  asm volatile("" ::: "memory");
#pragma unroll
                  for (int r = 0; r < 4; ++r) XS[(16 * b + 4 * quad + r) * 264 + col] = (bf16)f2bf(x[r]); } } }
        __syncthreads();
#pragma unroll
        for (int i = 0; i < 2; ++i) { const int p = tid + 512 * i, comb = p >> 6, ln = p & 63, t = comb >> 3, s = comb & 7; const int c = 32 * t + (ln & 31), k0 = 16 * s + 8 * (ln >> 5);
            *(v4u*)(WF + (su * 16 + comb) * 512 + ln * 8) = *(const LAS v4u*)(XS + c * 264 + 128 + k0); }
        { const int t = wave >> 2, ns = wave & 3; unsigned w[8];
#pragma unroll
          for (int r = 0; r < 8; ++r) { const unsigned lo = XS[(32 * t + crow(2 * r, h)) * 264 + 32 * ns + l31], hi = XS[(32 * t + crow(2 * r + 1, h)) * 264 + 32 * ns + l31]; w[r] = lo | (hi << 16); }
          bf16* dst = UF + ((su * 8 + wave) * 64 + lane) * 16; *(v4u*)dst = (v4u){w[0], w[1], w[2], w[3]}; *(v4u*)(dst + 8) = (v4u){w[4], w[5], w[6], w[7]}; }
        __syncthreads();
    }
}

DI void ph_gdn_chain(const Frame& F, const Args& a, int n_lo, int n_hi) {
    const int xg = F.vcu >> 5, wx = F.vcu & 31; if (F.G != 256 ? F.vcu >= 128 : wx >= 20) return;
    const bool helper = F.G == 256 && wx >= 16;
    const int hv = F.G == 256 ? 4 * xg + (helper ? wx - 16 : wx >> 2) : F.vcu >> 2, ns = F.G == 256 ? wx & 3 : F.vcu & 3, hk = hv >> 1;
    const bf16* QN = (const bf16*)(a.ws + WS_SCR + SC_QN);
    const bf16* WF = (const bf16*)(a.ws + GD_WF); const bf16* UF = (const bf16*)(a.ws + GD_UF); const bf16* INF = (const bf16*)(a.ws + GD_IN); const bf16* KTF = (const bf16*)(a.ws + GD_KT); const float* GC = (const float*)(a.ws + GD_GC);
    bf16* O = (bf16*)(a.ws + WS_SCR + SC_O);
    gu32* prog = F.ctl + CW_PROG + hv * 16;
    if (helper && GDN_NO_HELPER) return;
    if (helper) { unsigned sink = 0u; const int tid = F.tid;
        for (int n0 = n_lo; n0 < n_hi; n0 += 4) {
            if (n0 >= n_lo + 8) { if (tid == 0) { unsigned sp = 0; while ((int)__hip_atomic_load(prog, RLX_AGENT) < n0 - 4 && ++sp < 20000u) __builtin_amdgcn_s_sleep(8); } __syncthreads(); }
            unsigned v[5];
#pragma unroll
            for (int i = 0; i < 5; ++i) { const int li = tid + 512 * i;
                const int st = li / 580, ln = li % 580, n = n0 + st; const unsigned* p = nullptr;
                if (st < 4 && n < n_hi) { const size_t unit = (size_t)hv * GDN_NCH + n, kunit = (size_t)hk * GDN_NCH + n;
                    if (ln < 128) p = (const unsigned*)(WF + unit * 8192 + ln * 64);
                    else if (ln < 256) p = (const unsigned*)(UF + unit * 8192 + (ln - 128) * 64);
                    else if (ln < 320) p = (const unsigned*)(INF + unit * 4096 + (ln - 256) * 64);
                    else if (ln < 448) p = (const unsigned*)(KTF + kunit * 8192 + (ln - 320) * 64);
                    else if (ln < 576) { const int rr = chunk_row(n, (ln - 448) >> 1); if (rr >= 0) p = (const unsigned*)(QN + (size_t)rr * 2048 + hk * 128 + ((ln - 448) & 1) * 64); }
                    else if (ln < 579) p = (const unsigned*)(GC + unit * GC_STRIDE + (ln - 576) * 32); }
                v[i] = p ? *p : 0u; }
#pragma unroll
            for (int i = 0; i < 5; ++i) sink += v[i];
        }
        if (sink == 0x12345u) __hip_atomic_store(F.ctl + CW_TMO + 2, sink, RLX_AGENT);
        return; }
    LAS unsigned char* ST = F.lds + RING_OFF; LAS unsigned char* VN = ST + 8704; LAS unsigned char* VND = ST + 13312;
    const int lane = F.lane, wave = F.wave, l31 = lane & 31, h = lane >> 5;
    for (int i = F.tid; i < 8704 / 4; i += NWAVES * 64) ((LAS unsigned*)ST)[i] = 0u;
#define GDN_BAR() do { asm volatile("s_waitcnt lgkmcnt(0)" ::: "memory"); __builtin_amdgcn_s_barrier(); asm volatile("" ::: "memory"); } while (0)
    GDN_BAR();
    f32x16 S;
#pragma unroll
    for (int r = 0; r < 16; ++r) S[r] = 0.f;
    const int role = wave < 2 ? 0 : (wave < 4 ? 1 : 2); const int t = wave & 1, kt = wave & 3;
    bf16x8 A8[8]; bf16x8 A4[4]; v4u U0 = (v4u){0u, 0u, 0u, 0u}, U1 = U0; f32x4 G4[4]; float gl = 0.f, egl = 1.f;
#pragma unroll
    for (int s = 0; s < 8; ++s) A8[s] = (bf16x8){0, 0, 0, 0, 0, 0, 0, 0};
#pragma unroll
    for (int s = 0; s < 4; ++s) { A4[s] = (bf16x8){0, 0, 0, 0, 0, 0, 0, 0}; G4[s] = (f32x4){0.f, 0.f, 0.f, 0.f}; }
#define GDN_LOAD(nn) do { const size_t unit_ = (size_t)hv * GDN_NCH + (nn); const float* gc_ = GC + unit_ * GC_STRIDE; \
        if (role == 0) { _Pragma("unroll") for (int s = 0; s < 8; ++s) A8[s] = *(const bf16x8*)(WF + ((unit_ * 2 + t) * 8 + s) * 512 + lane * 8); \
            const bf16* up_ = UF + (((unit_ * 2 + t) * 4 + ns) * 64 + lane) * 16; U0 = *(const v4u*)up_; U1 = *(const v4u*)(up_ + 8); \
            _Pragma("unroll") for (int g = 0; g < 4; ++g) G4[g] = *(const f32x4*)(gc_ + 32 * t + 8 * g + 4 * h); gl = gc_[64]; } \
        else if (role == 1) { const int rr_ = chunk_row((nn), 32 * t + l31); \
            _Pragma("unroll") for (int s = 0; s < 8; ++s) A8[s] = rr_ >= 0 ? *(const bf16x8*)(QN + (size_t)rr_ * 2048 + hk * 128 + 16 * s + 8 * h) : (bf16x8){0, 0, 0, 0, 0, 0, 0, 0}; \
            _Pragma("unroll") for (int s = 0; s < 4; ++s) A4[s] = *(const bf16x8*)(INF + ((unit_ * 2 + t) * 4 + s) * 512 + lane * 8); \
            _Pragma("unroll") for (int g = 0; g < 4; ++g) G4[g] = *(const f32x4*)(gc_ + 32 * t + 8 * g + 4 * h); } \
        else { const size_t kunit_ = (size_t)hk * GDN_NCH + (nn); \
            _Pragma("unroll") for (int s = 0; s < 4; ++s) A4[s] = *(const bf16x8*)(KTF + ((kunit_ * 4 + kt) * 4 + s) * 512 + lane * 8); egl = gc_[65]; } } while (0)
    float* SV = (float*)(a.ws + GD_SAVE) + ((size_t)((hv * 4 + ns) * 4 + kt) * 64 + lane) * 16;
    if (n_lo > 0 && role == 2) {
#pragma unroll
        for (int g = 0; g < 4; ++g) { const f32x4 v = *(const f32x4*)(SV + 4 * g); S[4 * g] = v.x; S[4 * g + 1] = v.y; S[4 * g + 2] = v.z; S[4 * g + 3] = v.w;
            *(LAS v2u*)(ST + l31 * 272 + (32 * kt + 8 * g + 4 * h) * 2) = (v2u){pk2(v.x, v.y), pk2(v.z, v.w)}; }
    }
    GDN_BAR();
    GDN_LOAD(n_lo);
    for (int n = n_lo; n < n_hi; ++n) {
        bf16x8 a8[8], a4[4]; const v4u u0 = U0, u1 = U1; f32x4 g4[4]; const float cgl = gl, cegl = egl;
#pragma unroll
        for (int s = 0; s < 8; ++s) a8[s] = A8[s];
#pragma unroll
        for (int s = 0; s < 4; ++s) { a4[s] = A4[s]; g4[s] = G4[s]; }
        if (n + 1 < n_hi) GDN_LOAD(n + 1);
        if (ns == 0 && F.tid == 0) __hip_atomic_store(prog, (unsigned)n, RLX_AGENT);
        f32x16 acc;
#pragma unroll
        for (int r = 0; r < 16; ++r) acc[r] = 0.f;
        if (role < 2) {
#pragma unroll
            for (int s = 0; s < 8; ++s) acc = MFMA32(a8[s], *(const LAS bf16x8*)(ST + l31 * 272 + 32 * s + 16 * h), acc);
        }
        if (role == 0) { const unsigned uw[8] = {u0.x, u0.y, u0.z, u0.w, u1.x, u1.y, u1.z, u1.w};
#pragma unroll
            for (int g = 0; g < 4; ++g) { float vn[4], vd[4];
#pragma unroll
                for (int q = 0; q < 4; ++q) { const int r = 4 * g + q; const float uv = (r & 1) ? bfhi(uw[r >> 1]) : bflo(uw[r >> 1]); vn[q] = uv - acc[r]; vd[q] = vn[q] * __expf(cgl - g4[g][q]); }
                *(LAS v2u*)(VN + l31 * 144 + (32 * t + 8 * g + 4 * h) * 2) = (v2u){pk2(vn[0], vn[1]), pk2(vn[2], vn[3])};
                *(LAS v2u*)(VND + l31 * 144 + (32 * t + 8 * g + 4 * h) * 2) = (v2u){pk2(vd[0], vd[1]), pk2(vd[2], vd[3])}; }
        } else if (role == 1) {
#pragma unroll
            for (int g = 0; g < 4; ++g)
#pragma unroll
                for (int q = 0; q < 4; ++q) acc[4 * g + q] *= __expf(g4[g][q]);
        }
        GDN_BAR();
        if (role == 1) {
#pragma unroll
            for (int s = 0; s < 4; ++s) acc = MFMA32(a4[s], *(const LAS bf16x8*)(VN + l31 * 144 + 32 * s + 16 * h), acc);
#pragma unroll
            for (int r = 0; r < 16; ++r) { const int rr = chunk_row(n, 32 * t + crow(r, h)); if (rr >= 0) O[(size_t)rr * 4096 + hv * 128 + 32 * ns + l31] = (bf16)f2bf(acc[r]); }
        } else if (role == 2) {
#pragma unroll
            for (int r = 0; r < 16; ++r) S[r] *= cegl;
#pragma unroll
            for (int s = 0; s < 4; ++s) S = MFMA32(a4[s], *(const LAS bf16x8*)(VND + l31 * 144 + 32 * s + 16 * h), S);
#pragma unroll
            for (int g = 0; g < 4; ++g) *(LAS v2u*)(ST + l31 * 272 + (32 * kt + 8 * g + 4 * h) * 2) = (v2u){pk2(S[4 * g], S[4 * g + 1]), pk2(S[4 * g + 2], S[4 * g + 3])};
        }
        GDN_BAR();
    }
    if (n_hi < GDN_NCH && role == 2) {
#pragma unroll
        for (int g = 0; g < 4; ++g) *(f32x4*)(SV + 4 * g) = (f32x4){S[4 * g], S[4 * g + 1], S[4 * g + 2], S[4 * g + 3]}; }
#undef GDN_LOAD
#undef GDN_BAR
}

constexpr int RW_NSC = 258, RW_UNITS = 129 * 16;
DI int sub_row(int sc, int t) { const int n = sc >> 1, sub = sc & 1; return n == 0 ? ((sub == 0 && t >= 16) ? TX + t - 16 : -1) : 64 * (n - 1) + 32 * sub + t; }
constexpr size_t RW_BASE = WS_PROJ + 92 * MiB;
constexpr size_t RW_RH = RW_BASE, RW_RL = RW_BASE + 33 * MiB, RW_GT = RW_BASE + 66 * MiB, RW_GAM = RW_BASE + 99 * MiB;
constexpr size_t RW_PR = WS_SCR + 195 * MiB, RW_AT = WS_SCR + 211 * MiB + 256 * 1024, RW_VTF = WS_SCR + 219 * MiB + 512 * 1024, RW_SALL = WS_SCR + 235 * MiB + 768 * 1024;
constexpr size_t RW_XSAVE = 1 * MiB + 640 * 1024;
constexpr size_t RW_VV = WS_YMIX + 34 * MiB, RW_BON = WS_YMIX + 52 * MiB, LR_H = WS_YMIX + 54 * MiB, LR_A = WS_YMIX + 56 * MiB, LR_C = WS_YMIX + 58 * MiB;
constexpr size_t RW_SCH = (size_t)RW_NSC * 16;
static_assert((size_t)MP * EV_NP * 2 <= 92 * MiB && RW_SCH * 8192 <= 33 * MiB && RW_GAM + RW_SCH * 256 <= WS_SCR, "rwkv map (proj region)");
static_assert(WS_SCR + SC_LIX + (size_t)MP * 4096 <= RW_PR && RW_PR + RW_SCH * 4096 <= RW_AT && RW_AT + RW_SCH * 2048 <= RW_VTF && RW_VTF + RW_SCH * 4096 <= RW_SALL && RW_SALL + RW_SCH * 8192 <= WS_END, "rwkv map (scratch region)");
static_assert((size_t)MP * DM * 2 <= 34 * MiB && RW_VV + (size_t)MP * 2048 <= RW_BON && RW_BON + (size_t)MP * 64 <= LR_H && LR_H + RW_SCH * 256 <= LR_A && LR_A + RW_SCH * 256 <= LR_C && LR_C + RW_SCH * 256 <= WS_PROJ, "rwkv map (ymix region)");

DI void sub_rows(int sc, int& t0, int& rbase) { if (sc >= 2) { t0 = 0; rbase = 64 * ((sc >> 1) - 1) + 32 * (sc & 1); } else if (sc == 0) { t0 = 16; rbase = TX - 16; } else { t0 = 32; rbase = 0; } }
DI void lru_local(const Frame& F, const Args& a) {
    const float* LA = (const float*)(a.ws + WS_SCR + SC_LA); const float* LIX = (const float*)(a.ws + WS_SCR + SC_LIX);
    float* HL = (float*)(a.ws + LR_H); float* AP = (float*)(a.ws + LR_A);
    for (int item = F.gw; item < RW_NSC * 16; item += F.NGW) { const int sc = item >> 4, c = (item & 15) * 64 + F.lane; int t0, rbase; sub_rows(sc, t0, rbase);
        float av[32], ix[32];
#pragma unroll
        for (int t = 0; t < 32; ++t) { const size_t o = (size_t)(rbase + (t >= t0 ? t : 32)) * 1024 + c; av[t] = LA[o]; ix[t] = LIX[o]; }
        float h = 0.f, p = 1.f;
#pragma unroll
        for (int t = 0; t < 32; ++t) { const float a_ = t >= t0 ? av[t] : 1.f, x_ = t >= t0 ? ix[t] : 0.f; h = a_ * h + sqrtf(fmaxf(1.0f - a_ * a_, 0.f)) * x_; p *= a_; }
        HL[sc * 1024 + c] = h; AP[sc * 1024 + c] = p; }
}
DI void lru_apply(const Frame& F, const Args& a) {
    const bf16* P = (const bf16*)(a.ws + WS_PROJ); const float* LA = (const float*)(a.ws + WS_SCR + SC_LA); const float* LIX = (const float*)(a.ws + WS_SCR + SC_LIX);
    const float* CR = (const float*)(a.ws + LR_C); bf16* Y = (bf16*)(a.ws + WS_YMIX);
    for (int item = F.gw; item < RW_NSC * 16; item += F.NGW) { const int sc = item >> 4, c = (item & 15) * 64 + F.lane; int t0, rbase; sub_rows(sc, t0, rbase); if (t0 >= 32) continue;
        float h = CR[sc * 1024 + c];
#pragma unroll
        for (int tb = 0; tb < 32; tb += 16) { float av[16], ix[16], gb[16];
#pragma unroll
            for (int t = 0; t < 16; ++t) { const size_t r_ = (size_t)(rbase + (tb + t >= t0 ? tb + t : 32)); av[t] = LA[r_ * 1024 + c]; ix[t] = LIX[r_ * 1024 + c]; gb[t] = bf2f(P[r_ * EV_NP + EV_GB + c]); }
#pragma unroll
            for (int t = 0; t < 16; ++t) { if (tb + t >= t0) { h = av[t] * h + sqrtf(fmaxf(1.0f - av[t] * av[t], 0.f)) * ix[t]; Y[(size_t)(rbase + tb + t) * DM + 1024 + c] = (bf16)f2bf(h * gelu_tanh(gb[t])); } } } }
}

DI void ph_rwkv_chunk(const Frame& F, const Args& a, int n_lo, int n_hi, int wg0) {
    if (F.vcu < wg0) return;
    const bf16* P = (const bf16*)(a.ws + WS_PROJ); const float* DEC = (const float*)(a.ws + WS_SCR + SC_DEC); const float* ICL = (const float*)(a.ws + WS_SCR + SC_ICL);
    bf16* RH = (bf16*)(a.ws + RW_RH); bf16* RL = (bf16*)(a.ws + RW_RL); bf16* GT = (bf16*)(a.ws + RW_GT); float* GAM = (float*)(a.ws + RW_GAM); bf16* PR = (bf16*)(a.ws + RW_PR); bf16* ATG = (bf16*)(a.ws + RW_AT); bf16* VTF = (bf16*)(a.ws + RW_VTF);
    bf16* VV = (bf16*)(a.ws + RW_VV); float* BON = (float*)(a.ws + RW_BON);
    LAS unsigned char* L = F.lds + RING_OFF;
    LAS float* wS = (LAS float*)L; LAS float* aS = wS + 4096; LAS float* bS = wS + 8192; LAS float* rS = wS + 12288; LAS float* kS = wS + 16384;
    LAS unsigned char* vT = L + 81920; LAS unsigned char* aT = L + 91136; LAS unsigned char* rT = L + 100352; LAS unsigned char* kT = L + 109568; LAS unsigned char* bT = L + 118784;
    LAS unsigned char* AT = L + 128000; LAS unsigned char* NT = L + 133120; LAS float* gam = (LAS float*)(L + 138240);
    LAS unsigned char* aTl = L; LAS unsigned char* bTl = L + 9216;
    const int tid = F.tid, lane = F.lane, wave = F.wave, l31 = lane & 31, h = lane >> 5;
    const float* mu = a.in[6];
    for (int unit = n_lo * 16 + (F.vcu - wg0); unit < n_hi * 16; unit += F.G - wg0) {
        const int n = unit >> 4, hd = unit & 15;
        { const int tok = tid >> 3, cg = tid & 7, c0 = hd * 64 + cg * 8; const int rr = sub_row(2 * n + (tok >> 5), tok & 31);
          float wv[8], av[8], bv[8], rv[8], kv[8], vv[8];
#pragma unroll
          for (int q = 0; q < 8; ++q) { wv[q] = 1.f; av[q] = 0.f; bv[q] = 0.f; rv[q] = 0.f; kv[q] = 0.f; vv[q] = 0.f; }
          if (rr >= 0) { const int pos = row_pos(rr); const bf16* cur = P + (size_t)rr * EV_NP + c0; const bf16* prv = pos > 0 ? P + (size_t)pos_row(pos - 1) * EV_NP + c0 : nullptr;
              const v4u z4 = (v4u){0u, 0u, 0u, 0u};
              const v4u cr = *(const v4u*)cur, ck = *(const v4u*)(cur + 1024), cv = *(const v4u*)(cur + 2048);
              const v4u qr = prv ? *(const v4u*)prv : z4, qk = prv ? *(const v4u*)(prv + 1024) : z4, qv = prv ? *(const v4u*)(prv + 2048) : z4;
              const unsigned crw[4] = {cr.x, cr.y, cr.z, cr.w}, ckw[4] = {ck.x, ck.y, ck.z, ck.w}, cvw[4] = {cv.x, cv.y, cv.z, cv.w}, qrw[4] = {qr.x, qr.y, qr.z, qr.w}, qkw[4] = {qk.x, qk.y, qk.z, qk.w}, qvw[4] = {qv.x, qv.y, qv.z, qv.w};
              float ss = 0.f, bon = 0.f; float kk[8], ic[8];
#pragma unroll
              for (int q = 0; q < 8; ++q) { const int c = c0 + q; const float crf = (q & 1) ? bfhi(crw[q >> 1]) : bflo(crw[q >> 1]), ckf = (q & 1) ? bfhi(ckw[q >> 1]) : bflo(ckw[q >> 1]), cvf = (q & 1) ? bfhi(cvw[q >> 1]) : bflo(cvw[q >> 1]);
                  const float prf = (q & 1) ? bfhi(qrw[q >> 1]) : bflo(qrw[q >> 1]), pkf = (q & 1) ? bfhi(qkw[q >> 1]) : bflo(qkw[q >> 1]), pvf = (q & 1) ? bfhi(qvw[q >> 1]) : bflo(qvw[q >> 1]);
                  rv[q] = crf + (prf - crf) * mu[c]; kk[q] = ckf + (pkf - ckf) * mu[1024 + c]; vv[q] = cvf + (pvf - cvf) * mu[2048 + c];
                  wv[q] = DEC[(size_t)rr * 1024 + c]; ic[q] = ICL[(size_t)rr * 1024 + c];
                  const float kkv = kk[q] * a.in[12][c]; av[q] = kkv; ss += kkv * kkv; kv[q] = kk[q] * (1.0f + (ic[q] - 1.0f) * a.in[13][c]); bon += rv[q] * kv[q] * a.in[14][c]; }
              ss += __shfl_xor(ss, 1); ss += __shfl_xor(ss, 2); ss += __shfl_xor(ss, 4); bon += __shfl_xor(bon, 1); bon += __shfl_xor(bon, 2); bon += __shfl_xor(bon, 4);
              const float inv = 1.0f / fmaxf(sqrtf(ss), 1e-12f);
#pragma unroll
              for (int q = 0; q < 8; ++q) { const float kkn = av[q] * inv; av[q] = -kkn; bv[q] = kkn * ic[q]; }
              if (cg == 0) BON[(size_t)rr * 16 + hd] = bon;
              *(v4u*)(VV + (size_t)rr * 1024 + c0) = (v4u){pk2(vv[0], vv[1]), pk2(vv[2], vv[3]), pk2(vv[4], vv[5]), pk2(vv[6], vv[7])}; }
          const int o = tok * 64 + cg * 8;
          *(LAS f32x4*)(wS + o) = (f32x4){wv[0], wv[1], wv[2], wv[3]}; *(LAS f32x4*)(wS + o + 4) = (f32x4){wv[4], wv[5], wv[6], wv[7]};
          *(LAS f32x4*)(aS + o) = (f32x4){av[0], av[1], av[2], av[3]}; *(LAS f32x4*)(aS + o + 4) = (f32x4){av[4], av[5], av[6], av[7]};
          *(LAS f32x4*)(bS + o) = (f32x4){bv[0], bv[1], bv[2], bv[3]}; *(LAS f32x4*)(bS + o + 4) = (f32x4){bv[4], bv[5], bv[6], bv[7]};
          *(LAS f32x4*)(rS + o) = (f32x4){rv[0], rv[1], rv[2], rv[3]}; *(LAS f32x4*)(rS + o + 4) = (f32x4){rv[4], rv[5], rv[6], rv[7]};
          *(LAS f32x4*)(kS + o) = (f32x4){kv[0], kv[1], kv[2], kv[3]}; *(LAS f32x4*)(kS + o + 4) = (f32x4){kv[4], kv[5], kv[6], kv[7]};
#pragma unroll
          for (int q = 0; q < 8; ++q) *(LAS bf16*)(vT + (cg * 8 + q) * 144 + tok * 2) = (bf16)f2bf(vv[q]); }
        __syncthreads();
        { const int p = wave >> 2, sub = (wave >> 1) & 1, half = wave & 1, sl = lane >> 2, q = lane & 3, s = 16 * half + sl, tok = 32 * sub + s, jq = 16 * q;
          const LAS float* x0p = (p == 0 ? kS : bS) + tok * 64 + jq; LAS unsigned char* OUT = p == 0 ? AT : NT;
          float x[16];
#pragma unroll
          for (int j = 0; j < 16; j += 4) { const f32x4 t4 = *(const LAS f32x4*)(x0p + j); x[j] = t4.x; x[j + 1] = t4.y; x[j + 2] = t4.z; x[j + 3] = t4.w; }
          if (half) {
#pragma unroll
              for (int i = 0; i < 4; ++i) *(LAS bf16*)(OUT + ((sub * 32 + 4 * q + i) * 40 + s) * 2) = (bf16)0; }
#pragma unroll 2
          for (int tp = 16 * half; tp < 32; ++tp) { const LAS float* bp = wS + (32 * sub + tp) * 64 + jq; const bool run = tp > s;
              f32x4 a4[4], w4[4], b4[4], r4[4];
#pragma unroll
              for (int g = 0; g < 4; ++g) { a4[g] = *(const LAS f32x4*)(bp + 4096 + 4 * g); w4[g] = *(const LAS f32x4*)(bp + 4 * g); b4[g] = *(const LAS f32x4*)(bp + 8192 + 4 * g); r4[g] = *(const LAS f32x4*)(bp + 12288 + 4 * g); }
              float c = 0.f;
#pragma unroll
              for (int g = 0; g < 4; ++g) { c += x[4 * g] * a4[g].x; c += x[4 * g + 1] * a4[g].y; c += x[4 * g + 2] * a4[g].z; c += x[4 * g + 3] * a4[g].w; }
              c += __builtin_bit_cast(float, __builtin_amdgcn_mov_dpp(__builtin_bit_cast(int, c), 0xB1, 0xF, 0xF, true));
              c += __builtin_bit_cast(float, __builtin_amdgcn_mov_dpp(__builtin_bit_cast(int, c), 0x4E, 0xF, 0xF, true));
              float o = 0.f;
#pragma unroll
              for (int g = 0; g < 4; ++g) { const float n0 = x[4 * g] * w4[g].x + c * b4[g].x, n1 = x[4 * g + 1] * w4[g].y + c * b4[g].y, n2 = x[4 * g + 2] * w4[g].z + c * b4[g].z, n3 = x[4 * g + 3] * w4[g].w + c * b4[g].w;
                  x[4 * g] = run ? n0 : x[4 * g]; x[4 * g + 1] = run ? n1 : x[4 * g + 1]; x[4 * g + 2] = run ? n2 : x[4 * g + 2]; x[4 * g + 3] = run ? n3 : x[4 * g + 3];
                  o += x[4 * g] * r4[g].x; o += x[4 * g + 1] * r4[g].y; o += x[4 * g + 2] * r4[g].z; o += x[4 * g + 3] * r4[g].w; }
              o += __builtin_bit_cast(float, __builtin_amdgcn_mov_dpp(__builtin_bit_cast(int, o), 0xB1, 0xF, 0xF, true));
              o += __builtin_bit_cast(float, __builtin_amdgcn_mov_dpp(__builtin_bit_cast(int, o), 0x4E, 0xF, 0xF, true));
              if (q == 0) *(LAS bf16*)(OUT + ((sub * 32 + tp) * 40 + s) * 2) = (bf16)f2bf(tp >= s ? o : 0.f); }
          LAS unsigned char* XT = p == 0 ? kT : bT;
#pragma unroll
          for (int j = 0; j < 16; ++j) { const unsigned hi = f2bf(x[j]); *(LAS bf16*)(XT + (jq + j) * 144 + tok * 2) = (bf16)hi; x[j] -= __uint_as_float(hi << 16); }
          float alo[32]; const bool gwave = (p == 0 && half == 1); const int j = lane;
          if (gwave) { float g = 1.f;
#pragma unroll
              for (int tp = 0; tp < 32; ++tp) { const int tk = 32 * sub + tp; const float w_ = wS[tk * 64 + j], a_ = aS[tk * 64 + j], r_ = rS[tk * 64 + j];
                  const float at = a_ * g; const unsigned hi = f2bf(at); *(LAS bf16*)(aT + j * 144 + tk * 2) = (bf16)hi; alo[tp] = at - __uint_as_float(hi << 16);
                  g *= w_; *(LAS bf16*)(rT + j * 144 + tk * 2) = (bf16)f2bf(r_ * g); }
              gam[sub * 64 + j] = g; }
          __syncthreads();
          if (p == 1) {
#pragma unroll
              for (int jj = 0; jj < 16; ++jj) *(LAS bf16*)(bTl + (jq + jj) * 144 + tok * 2) = (bf16)f2bf(x[jj]); }
          if (gwave) {
#pragma unroll
              for (int tp = 0; tp < 32; ++tp) *(LAS bf16*)(aTl + j * 144 + (32 * sub + tp) * 2) = (bf16)f2bf(alo[tp]); }
        }
        __syncthreads();
        { const int sub = wave >> 2, t1 = (wave >> 1) & 1, t0 = wave & 1; const size_t sch = (size_t)hd * RW_NSC + (2 * n + sub);
          { f32x16 acc;
#pragma unroll
            for (int r = 0; r < 16; ++r) acc[r] = 0.f;
#pragma unroll
            for (int ks = 0; ks < 2; ++ks) { const int ao = (32 * t1 + l31) * 144 + (32 * sub + 16 * ks + 8 * h) * 2, bo = (32 * t0 + l31) * 144 + (32 * sub + 16 * ks + 8 * h) * 2;
                const bf16x8 ah = *(const LAS bf16x8*)(aT + ao), al = *(const LAS bf16x8*)(aTl + ao), bh = *(const LAS bf16x8*)(bT + bo), bl = *(const LAS bf16x8*)(bTl + bo);
                acc = MFMA32(al, bh, acc); acc = MFMA32(ah, bl, acc); acc = MFMA32(ah, bh, acc); }
            const int jp = 32 * t0 + l31;
#pragma unroll
            for (int g = 0; g < 4; ++g) { unsigned hi[4]; float lo[4];
#pragma unroll
                for (int q = 0; q < 4; ++q) { hi[q] = f2bf(acc[4 * g + q]); lo[q] = acc[4 * g + q] - __uint_as_float(hi[q] << 16); }
                *(v2u*)(RH + (sch * 64 + jp) * 64 + 32 * t1 + 8 * g + 4 * h) = (v2u){hi[0] | (hi[1] << 16), hi[2] | (hi[3] << 16)};
                *(v2u*)(RL + (sch * 64 + jp) * 64 + 32 * t1 + 8 * g + 4 * h) = (v2u){pk2(lo[0], lo[1]), pk2(lo[2], lo[3])}; }
            if (t1 == 0 && t0 == 0) GAM[sch * 64 + lane] = gam[sub * 64 + lane]; }
          { f32x16 acc;
#pragma unroll
            for (int r = 0; r < 16; ++r) acc[r] = 0.f;
#pragma unroll
            for (int ks = 0; ks < 2; ++ks) acc = MFMA32(*(const LAS bf16x8*)(kT + (32 * t1 + l31) * 144 + (32 * sub + 16 * ks + 8 * h) * 2), *(const LAS bf16x8*)(vT + (32 * t0 + l31) * 144 + (32 * sub + 16 * ks + 8 * h) * 2), acc);
            bf16* dst = GT + ((sch * 4 + t1 * 2 + t0) * 64 + lane) * 16;
            *(v4u*)dst = (v4u){pk2(acc[0], acc[1]), pk2(acc[2], acc[3]), pk2(acc[4], acc[5]), pk2(acc[6], acc[7])}; *(v4u*)(dst + 8) = (v4u){pk2(acc[8], acc[9]), pk2(acc[10], acc[11]), pk2(acc[12], acc[13]), pk2(acc[14], acc[15])}; } }
        if (wave < 4) { const int sub = wave >> 1, jt = wave & 1; const size_t sch = (size_t)hd * RW_NSC + (2 * n + sub);
            f32x16 acc;
#pragma unroll
            for (int r = 0; r < 16; ++r) acc[r] = bf2f(*(const LAS bf16*)(rT + (32 * jt + crow(r, h)) * 144 + (32 * sub + l31) * 2));
#pragma unroll
            for (int ks = 0; ks < 2; ++ks) acc = MFMA32(*(const LAS bf16x8*)(aT + (32 * jt + l31) * 144 + (32 * sub + 16 * ks + 8 * h) * 2), *(const LAS bf16x8*)(NT + (sub * 32 + l31) * 80 + (16 * ks + 8 * h) * 2), acc);
#pragma unroll
            for (int g = 0; g < 4; ++g) *(v2u*)(PR + (sch * 32 + l31) * 64 + 32 * jt + 8 * g + 4 * h) = (v2u){pk2(acc[4 * g], acc[4 * g + 1]), pk2(acc[4 * g + 2], acc[4 * g + 3])};
        } else { const int t2 = tid - 256, sub = t2 >> 7, t = (t2 >> 2) & 31, s8 = (t2 & 3) * 8; const size_t sch = (size_t)hd * RW_NSC + (2 * n + sub);
            *(v4u*)(ATG + (sch * 32 + t) * 32 + s8) = *(const LAS v4u*)(AT + (sub * 32 + t) * 80 + s8 * 2); }
        { const int sub = tid >> 8, it = (tid >> 7) & 1, ks = (tid >> 6) & 1; const size_t sch = (size_t)hd * RW_NSC + (2 * n + sub);
          *(v4u*)(VTF + ((sch * 4 + it * 2 + ks) * 64 + lane) * 8) = *(const LAS v4u*)(vT + (32 * it + l31) * 144 + (32 * sub + 16 * ks + 8 * h) * 2); }
        __syncthreads();
    }
}

DI void ph_rwkv_chain(const Frame& F, const Args& a, int sc_lo, int sc_hi) {
    if (F.vcu >= 16 && F.vcu < 18) { if (sc_hi < RW_NSC) return; const int c = (F.vcu - 16) * 512 + F.tid; const float* HL = (const float*)(a.ws + LR_H); const float* AP = (const float*)(a.ws + LR_A); float* CR = (float*)(a.ws + LR_C);
        float carry = 0.f;
#pragma unroll 8
        for (int sc = 0; sc < RW_NSC; ++sc) { const float hl = HL[sc * 1024 + c], ap = AP[sc * 1024 + c]; CR[sc * 1024 + c] = carry; carry = ap * carry + hl; }
        return; }
    if (F.vcu >= 16) return;
    const int hd = F.vcu; const bf16* RH = (const bf16*)(a.ws + RW_RH); const bf16* RL = (const bf16*)(a.ws + RW_RL); const bf16* GT = (const bf16*)(a.ws + RW_GT); const float* GAM = (const float*)(a.ws + RW_GAM); bf16* SALL = (bf16*)(a.ws + RW_SALL);
    constexpr int RW_NS = 7, SLOT = 8192 + 8192 + 1024;
    LAS unsigned char* XS = F.lds + RING_OFF; LAS unsigned char* RG = XS + 2 * 9216;
    const int lane = F.lane, wave = F.wave, l31 = lane & 31, h = lane >> 5, jt = (wave >> 1) & 1, it = wave & 1, lw = wave & 3;
    for (int i = F.tid; i < 2 * 9216 / 4; i += NWAVES * 64) ((LAS unsigned*)XS)[i] = 0u;
    __syncthreads();
#define RW_BAR() do { asm volatile("s_waitcnt lgkmcnt(0)" ::: "memory"); __builtin_amdgcn_s_barrier(); asm volatile("" ::: "memory"); } while (0)
    const unsigned rg0 = (unsigned)(uintptr_t)RG;
    int offR[2], offG[2];
#pragma unroll
    for (int i = 0; i < 2; ++i) { const int b = 2 * lw + i, row = 8 * b + (lane >> 3), pc = lane & 7; offR[i] = row * 64 + ((pc ^ (row & 7)) * 8); offG[i] = (b * 64 + lane) * 8; }
    const int offM = (lane & 15) * 4;
#define RW_DMA(src, dst) do { unsigned keep_; asm volatile("s_mov_b32 %0, m0\n\ts_mov_b32 m0, %2\n\ts_nop 0\n\tglobal_load_lds_dwordx4 %1, off\n\ts_mov_b32 m0, %0" : "=&s"(keep_) : "v"(src), "s"(dst) : "memory"); } while (0)
#define RW_ISSUE(scn) do { const int s_ = (scn) < RW_NSC ? (scn) : RW_NSC - 1; const size_t sch_ = (size_t)hd * RW_NSC + s_; \
        const unsigned sb_ = (unsigned)__builtin_amdgcn_readfirstlane((int)(rg0 + (unsigned)((scn) % RW_NS) * SLOT)); \
        _Pragma("unroll") for (int i_ = 0; i_ < 2; ++i_) { const unsigned bo_ = (unsigned)__builtin_amdgcn_readfirstlane((2 * lw + i_) * 1024); \
            RW_DMA(RH + sch_ * 4096 + offR[i_], sb_ + bo_); RW_DMA(GT + sch_ * 4096 + offG[i_], sb_ + 8192 + bo_); } \
        RW_DMA(GAM + sch_ * 64 + offM, sb_ + 16384); } while (0)
#define RW_WAITV(n) asm volatile("s_waitcnt vmcnt(" #n ")" ::: "memory")
    f32x16 X;
#pragma unroll
    for (int r = 0; r < 16; ++r) X[r] = 0.f;
    float* XSV = (float*)(a.ws + RW_XSAVE) + ((size_t)(hd * 4 + (wave & 3)) * 64 + lane) * 16;
    if (wave < 4 && sc_lo > 0) {
#pragma unroll
        for (int g = 0; g < 4; ++g) { const f32x4 v = *(const f32x4*)(XSV + 4 * g); X[4 * g] = v.x; X[4 * g + 1] = v.y; X[4 * g + 2] = v.z; X[4 * g + 3] = v.w;
            *(LAS v2u*)(XS + (32 * it + l31) * 144 + (32 * jt + 8 * g + 4 * h) * 2) = (v2u){pk2(v.x, v.y), pk2(v.z, v.w)}; } }
    if (wave >= 4) { RW_ISSUE(sc_lo); RW_ISSUE(sc_lo + 1); RW_ISSUE(sc_lo + 2); RW_ISSUE(sc_lo + 3); RW_ISSUE(sc_lo + 4); RW_ISSUE(sc_lo + 5); RW_WAITV(25); }
    RW_BAR();
    for (int sc = sc_lo; sc < sc_hi; ++sc) {
        if (wave < 4) {
            const LAS unsigned char* sb = RG + (sc % RW_NS) * SLOT;
            f32x16 acc; const size_t sch = (size_t)hd * RW_NSC + sc;
            { const v4u g0 = *(const LAS v4u*)(sb + 8192 + ((jt * 2 + it) * 64 + lane) * 32), g1 = *(const LAS v4u*)(sb + 8192 + ((jt * 2 + it) * 64 + lane) * 32 + 16);
              const unsigned gw_[8] = {g0.x, g0.y, g0.z, g0.w, g1.x, g1.y, g1.z, g1.w};
#pragma unroll
              for (int g = 0; g < 4; ++g) { const f32x4 m = *(const LAS f32x4*)(sb + 16384 + (32 * jt + 8 * g + 4 * h) * 4);
                  acc[4 * g] = bflo(gw_[2 * g]) + m.x * X[4 * g]; acc[4 * g + 1] = bfhi(gw_[2 * g]) + m.y * X[4 * g + 1]; acc[4 * g + 2] = bflo(gw_[2 * g + 1]) + m.z * X[4 * g + 2]; acc[4 * g + 3] = bfhi(gw_[2 * g + 1]) + m.w * X[4 * g + 3]; } }
#pragma unroll
            for (int g = 0; g < 4; ++g) *(v2u*)(SALL + (sch * 64 + 32 * it + l31) * 64 + 32 * jt + 8 * g + 4 * h) = (v2u){pk2(X[4 * g], X[4 * g + 1]), pk2(X[4 * g + 2], X[4 * g + 3])};
            const LAS unsigned char* xb = XS + (sc & 1) * 9216 + (32 * it + l31) * 144 + 16 * h; const int ar = 32 * jt + l31; const LAS unsigned char* ab = sb + ar * 128;
#pragma unroll
            for (int ks = 0; ks < 4; ++ks) { const bf16x8 xf = *(const LAS bf16x8*)(xb + 32 * ks); const int po = (((2 * ks + h) ^ (ar & 7)) * 16);
                acc = MFMA32(*(const LAS bf16x8*)(ab + po), xf, acc); }
            X = acc;
            LAS unsigned char* xn = XS + ((sc + 1) & 1) * 9216 + (32 * it + l31) * 144;
#pragma unroll
            for (int g = 0; g < 4; ++g) *(LAS v2u*)(xn + (32 * jt + 8 * g + 4 * h) * 2) = (v2u){pk2(X[4 * g], X[4 * g + 1]), pk2(X[4 * g + 2], X[4 * g + 3])};
        } else {
            RW_ISSUE(sc + RW_NS - 1);
            RW_WAITV(25);
        }
        RW_BAR();
    }
    if (wave >= 4) RW_WAITV(0);
    else if (sc_hi < RW_NSC) {
#pragma unroll
        for (int g = 0; g < 4; ++g) *(f32x4*)(XSV + 4 * g) = (f32x4){X[4 * g], X[4 * g + 1], X[4 * g + 2], X[4 * g + 3]}; }
#undef RW_ISSUE
#undef RW_DMA
#undef RW_WAITV
#undef RW_BAR
}

DI void ph_rwkv_out(const Frame& F, const Args& a) {
    const bf16* SALL = (const bf16*)(a.ws + RW_SALL); const bf16* PR = (const bf16*)(a.ws + RW_PR); const bf16* ATG = (const bf16*)(a.ws + RW_AT); const bf16* VTF = (const bf16*)(a.ws + RW_VTF);
    const bf16* VV = (const bf16*)(a.ws + RW_VV); const float* BON = (const float*)(a.ws + RW_BON); const float* GATE = (const float*)(a.ws + WS_SCR + SC_GATE); bf16* Y = (bf16*)(a.ws + WS_YMIX);
    const int lane = F.lane, l31 = lane & 31, h = lane >> 5;
    for (int item = F.gw; item < RW_NSC * 16; item += F.NGW) { const int sc = item >> 4, hd = item & 15; if (sc == 1) continue;
        const size_t sch = (size_t)hd * RW_NSC + sc; f32x16 acc[2];
#pragma unroll
        for (int it = 0; it < 2; ++it) {
#pragma unroll
            for (int r = 0; r < 16; ++r) acc[it][r] = 0.f;
#pragma unroll
            for (int ks = 0; ks < 4; ++ks) acc[it] = MFMA32(*(const bf16x8*)(SALL + (sch * 64 + 32 * it + l31) * 64 + 16 * ks + 8 * h), *(const bf16x8*)(PR + (sch * 32 + l31) * 64 + 16 * ks + 8 * h), acc[it]);
#pragma unroll
            for (int ks = 0; ks < 2; ++ks) acc[it] = MFMA32(*(const bf16x8*)(VTF + ((sch * 4 + it * 2 + ks) * 64 + lane) * 8), *(const bf16x8*)(ATG + (sch * 32 + l31) * 32 + 16 * ks + 8 * h), acc[it]); }
        float s1 = 0.f;
#pragma unroll
        for (int it = 0; it < 2; ++it)
#pragma unroll
            for (int r = 0; r < 16; ++r) s1 += acc[it][r];
        s1 += __shfl_xor(s1, 32); const float mean = s1 * (1.0f / 64.0f); float s2 = 0.f;
#pragma unroll
        for (int it = 0; it < 2; ++it)
#pragma unroll
            for (int r = 0; r < 16; ++r) { const float d = acc[it][r] - mean; s2 += d * d; }
        s2 += __shfl_xor(s2, 32); const float rstd = 1.0f / sqrtf(s2 * (1.0f / 64.0f) + 64e-5f);
        const int rr = sub_row(sc, l31);
        if (rr >= 0) { const float bon = BON[(size_t)rr * 16 + hd];
#pragma unroll
            for (int it = 0; it < 2; ++it)
#pragma unroll
                for (int g = 0; g < 4; ++g) { const int c = hd * 64 + 32 * it + 8 * g + 4 * h;
                    const f32x4 lw = *(const f32x4*)(a.in[15] + c), lb = *(const f32x4*)(a.in[16] + c), gt = *(const f32x4*)(GATE + (size_t)rr * 1024 + c); const v2u vw = *(const v2u*)(VV + (size_t)rr * 1024 + c);
                    const float o0 = ((acc[it][4 * g] - mean) * rstd * lw.x + lb.x + bon * bflo(vw.x)) * gt.x, o1 = ((acc[it][4 * g + 1] - mean) * rstd * lw.y + lb.y + bon * bfhi(vw.x)) * gt.y;
                    const float o2 = ((acc[it][4 * g + 2] - mean) * rstd * lw.z + lb.z + bon * bflo(vw.y)) * gt.z, o3 = ((acc[it][4 * g + 3] - mean) * rstd * lw.w + lb.w + bon * bfhi(vw.y)) * gt.w;
                    *(v2u*)(Y + (size_t)rr * DM + c) = (v2u){pk2(o0, o1), pk2(o2, o3)}; } }
    }
    lru_apply(F, a);
}

constexpr int N_PHASES = 33;
template <class Epi, class Sched> DI void run_gemm(const Frame& F, const pg8::Gemm& g, const Sched& S, const Epi& E) {
    pg8::gemm_phase<Epi, Sched, true, true>(F.lds + RING_OFF, g, S, E);
}
DI void moe_up_units(const Frame& F, const Args& a, int t0, int ntl, int G, int c) {
    pg8::Gemm g{(const bf16*)(a.ws + WS_SCR + SC_XG), (const bf16*)(a.ws + WS_MOEW), DM, DM, DM};
    pg8::MoeOrder S{(const int*)(a.ws + WS_TILES), t0, ntl, 4, G, c, (long)MOE_E_BYTES};
    pg8::EpiSwiglu E{(bf16*)(a.ws + WS_SCR + SC_ACT), FF};
    run_gemm(F, g, S, E);
}
DI void moe_down_units(const Frame& F, const Args& a, int t0, int ntl, int G, int c) {
    pg8::Gemm g{(const bf16*)(a.ws + WS_SCR + SC_ACT), (const bf16*)(a.ws + WS_MOEW + MOE_W2_OFF), FF, FF, FF};
    pg8::MoeOrder S{(const int*)(a.ws + WS_TILES), t0, ntl, 8, G, c, (long)MOE_E_BYTES};
    pg8::EpiBf16 E{(bf16*)(a.ws + WS_SCR + SC_YB), DM};
    run_gemm(F, g, S, E);
}
DI void ph_moe_a(const Frame& F, const Args& a) {
    const int nt = (int)__hip_atomic_load((gu32*)(a.ws + WS_TILES) + 127, RLX_AGENT), n1 = nt < 64 ? nt : 64;
    moe_up_units(F, a, 0, n1, F.G, (int)blockIdx.x);
}
DI void ph_moe_b(const Frame& F, const Args& a) {
    const int nt = (int)__hip_atomic_load((gu32*)(a.ws + WS_TILES) + 127, RLX_AGENT), n1 = nt < 64 ? nt : 64; const int c = (int)blockIdx.x;
    int nu = 4 * (nt - n1); if (nu > F.G / 2) nu = F.G / 2;
    if (c < nu) moe_up_units(F, a, n1, nt - n1, nu, c); else moe_down_units(F, a, 0, n1, F.G - nu, c - nu);
}
DI void ph_moe_c(const Frame& F, const Args& a) {
    const int nt = (int)__hip_atomic_load((gu32*)(a.ws + WS_TILES) + 127, RLX_AGENT), n1 = nt < 64 ? nt : 64;
    moe_down_units(F, a, n1, nt - n1, F.G, (int)blockIdx.x);
}

DI void gemm_tail16(const Frame& F, const Args& a, const bf16* A, int lda, const bf16* Wt, int K, int mode) {
    if (F.vcu >= 128) return;
    const int lane = F.lane, lc = lane & 15, quad = lane >> 4, w = F.vcu; LAS float* red = (LAS float*)(F.lds + RING_OFF);
    f32x4 acc = (f32x4){0.f, 0.f, 0.f, 0.f}; const int kw = K / NWAVES, kb = F.wave * kw;
    const bf16* ap = A + (size_t)(TX + lc) * lda + kb + 8 * quad; const bf16* bp = Wt + (size_t)(16 * w + lc) * K + kb + 8 * quad;
#pragma unroll 4
    for (int ks = 0; ks < kw / 32; ++ks) acc = __builtin_amdgcn_mfma_f32_16x16x32_bf16(*(const bf16x8*)(ap + 32 * ks), *(const bf16x8*)(bp + 32 * ks), acc, 0, 0, 0);
    *(LAS f32x4*)(red + (F.wave * 64 + lane) * 4) = acc;
    __syncthreads();
    if (F.wave == 0) { f32x4 s = *(const LAS f32x4*)(red + lane * 4);
#pragma unroll
        for (int v = 1; v < NWAVES; ++v) s = s + *(const LAS f32x4*)(red + (v * 64 + lane) * 4);
        float* H = (float*)(a.ws + WS_H);
#pragma unroll
        for (int r = 0; r < 4; ++r) { const int row = 4 * quad + r, col = 16 * w + lc; const float base = mode ? H[(size_t)(TX + row) * DM + col] : a.in[1][(size_t)row * DM + col];
            H[(size_t)(TX + row) * DM + col] = base + s[r]; } }
    __syncthreads();
}

__global__ void __launch_bounds__(NWAVES * 64, 2) hyb_fwd(Args a) {
    extern __shared__ __attribute__((aligned(16))) unsigned char lds[];
    Frame F;
    F.lds = (LAS unsigned char*)lds;
    F.MISC = (volatile LAS unsigned*)(F.lds + MISC_OFF);
    F.tid = threadIdx.x; F.lane = F.tid & 63; F.wave = __builtin_amdgcn_readfirstlane(F.tid >> 6);
    F.G = gridDim.x; { const int bx = blockIdx.x; F.vcu = (F.G % 8 == 0) ? (bx % 8) * (F.G / 8) + bx / 8 : bx; }
    F.gw = F.vcu * NWAVES + F.wave; F.NGW = F.G * NWAVES;
    F.ctl = (gu32*)(a.ws + WS_CTL);
    for (int u = F.tid; u < (LDS_BYTES - LDSCTL_OFF) / 4; u += NWAVES * 64) ((LAS unsigned*)(F.lds + LDSCTL_OFF))[u] = 0u;
    __syncthreads();
    XcdBarrier bar; bar.bar = (unsigned*)(F.ctl + CW_BAR); bar.x = 0; bar.st = nullptr;
    if (MK_ONE_LAUNCH) bar = xcd_barrier_post((unsigned*)(F.ctl + CW_BAR), F.MISC + 8);
    const int lo = a.ph_lo, hi = a.ph_hi;
#ifndef PH_MASK
#define PH_MASK 0xFFFFFFFFFFFFFFFFull
#endif
#define IN(k) ((((unsigned long long)(PH_MASK) >> (k)) & 1ull) && lo <= (k) && (k) < hi)
#ifndef PROBE_REP
#define PROBE_REP 0u
#endif
#define REP(k) ((((unsigned long long)(PROBE_REP) >> (k)) & 1ull) ? 2 : 1)
#ifdef PROBE_TS
#define STAMP(k) do { if (blockIdx.x == 0 && F.tid == 0) ((unsigned long long*)(F.ctl + CW_TS))[(k)] = __builtin_amdgcn_s_memrealtime(); } while (0)
#else
#define STAMP(k) do { } while (0)
#endif
#define SEAM(k) do { if (IN(k) && IN((k) + 1)) xcd_barrier(bar); STAMP((k) + 1); } while (0)
    const bf16* HN = (const bf16*)(a.ws + WS_HN); bf16* PROJ = (bf16*)(a.ws + WS_PROJ); const bf16* YMIX = (const bf16*)(a.ws + WS_YMIX); float* H = (float*)(a.ws + WS_H);

    STAMP(0);
    if (IN(0)) for (int rep_ = 0; rep_ < REP(0); ++rep_) { ph_prologue(F, a); ph_aux_convert(F, a, F.gw, F.NGW); }
    SEAM(0);
    if (IN(1)) for (int rep_ = 0; rep_ < REP(1); ++rep_) { pg8::Gemm g{HN, (const bf16*)(a.ws + WS_WEVIN), DM, DM, DM}; pg8::StaticOrder S; S.init(MP, EV_NP, F.G, (int)blockIdx.x); pg8::EpiBf16 E{PROJ, EV_NP}; run_gemm(F, g, S, E); }
    SEAM(1);
    if (IN(2)) for (int rep_ = 0; rep_ < REP(2); ++rep_) ph_even_prep(F, a);
    SEAM(2);
    if (IN(3)) for (int rep_ = 0; rep_ < REP(3); ++rep_) {
#ifndef NO_LORA
        { pg8::Gemm g{(const bf16*)(a.ws + WS_SCR + SC_ALORA), (const bf16*)(a.ws + WS_WLORA), 384, 384, 384}; pg8::StaticOrder S; S.init(MP, 3072, F.G, (int)blockIdx.x);
          static_assert(SC_ICL - SC_DEC == SC_GATE - SC_ICL, "lora outputs equally spaced");
          pg8::EpiLora E{(float*)(a.ws + WS_SCR + SC_DEC), (long)((SC_ICL - SC_DEC) / 4), a.in[7], a.in[9]}; run_gemm(F, g, S, E); }
#endif
#ifndef NO_GATES
        { pg8::Gemm g{(const bf16*)(a.ws + WS_SCR + SC_XR), (const bf16*)(a.ws + WS_WGATE), 256, 1024, 256}; pg8::StaticOrder S; S.init(MP, 2048, F.G, (int)blockIdx.x); S.amod = 4; S.astep = 512;
          pg8::EpiGates E{(float*)(a.ws + WS_SCR + SC_LA), (float*)(a.ws + WS_SCR + SC_LIX), a.in[20], a.in[22], a.in[23], (const bf16*)(a.ws + WS_SCR + SC_XR)}; run_gemm(F, g, S, E); }
#endif
    }
    SEAM(3);
    if (IN(4)) { lru_local(F, a); ph_rwkv_chunk(F, a, 0, 32, 0); }
    SEAM(4);
    if (IN(5)) { if (F.vcu < 16) ph_rwkv_chain(F, a, 0, 64); else ph_rwkv_chunk(F, a, 32, 62, 16); }
    SEAM(5);
    if (IN(6)) { if (F.vcu < 16) ph_rwkv_chain(F, a, 64, 124); else ph_rwkv_chunk(F, a, 62, 92, 16); }
    SEAM(6);
    if (IN(7)) { if (F.vcu < 16) ph_rwkv_chain(F, a, 124, 184); else ph_rwkv_chunk(F, a, 92, 122, 16); }
    SEAM(7);
    if (IN(8)) { if (F.vcu < 16) ph_rwkv_chain(F, a, 184, 244); else ph_rwkv_chunk(F, a, 122, 129, 16); }
    SEAM(8);
    if (IN(9)) { if (F.vcu < 18) ph_rwkv_chain(F, a, 244, RW_NSC); }
    SEAM(9);
    if (IN(10)) for (int rep_ = 0; rep_ < REP(10); ++rep_) ph_rwkv_out(F, a);
    SEAM(10);
    if (IN(11)) for (int rep_ = 0; rep_ < REP(11); ++rep_) { pg8::Gemm g{YMIX, (const bf16*)(a.ws + WS_WEVOUT), DM, DM, DM}; pg8::StaticOrder S; S.init(TX, DM, F.G, (int)blockIdx.x); pg8::EpiResid E{H, a.in[0], a.in[1], 0}; run_gemm(F, g, S, E); gemm_tail16(F, a, YMIX, DM, (const bf16*)(a.ws + WS_WEVOUT), DM, 0); }
    SEAM(11);
    if (IN(12)) for (int rep_ = 0; rep_ < REP(12); ++rep_) ph_route(F, a, 0, rep_);
    SEAM(12);
    if (IN(13)) for (int rep_ = 0; rep_ < REP(13); ++rep_) ph_gather(F, a, 0);
    SEAM(13);
    if (IN(14)) ph_moe_a(F, a);
    SEAM(14);
    if (IN(15)) ph_moe_b(F, a);
    SEAM(15);
    if (IN(16)) ph_moe_c(F, a);
    SEAM(16);
    if (IN(17)) for (int rep_ = 0; rep_ < REP(17); ++rep_) ph_combine(F, a, 0);
    SEAM(17);
    if (IN(18)) for (int rep_ = 0; rep_ < REP(18); ++rep_) { pg8::Gemm g{HN, (const bf16*)(a.ws + WS_WODIN), DM, DM, DM}; pg8::StaticOrder S; S.init(MP, OD_NP, F.G, (int)blockIdx.x); pg8::EpiBf16 E{PROJ, OD_NP}; run_gemm(F, g, S, E); }
    SEAM(18);
    if (IN(19)) for (int rep_ = 0; rep_ < REP(19); ++rep_) ph_odd_prep(F, a);
    SEAM(19);
    if (IN(20)) ph_gdn_chunk(F, a, 0, 33, 0);
    SEAM(20);
    if (IN(21)) { ph_gdn_chain(F, a, 0, 33); ph_gdn_chunk(F, a, 33, 65, 1); }
    SEAM(21);
    if (IN(22)) { ph_gdn_chain(F, a, 33, 65); ph_gdn_chunk(F, a, 65, 97, 1); }
    SEAM(22);
    if (IN(23)) { ph_gdn_chain(F, a, 65, 97); ph_gdn_chunk(F, a, 97, 129, 1); }
    SEAM(23);
    if (IN(24)) ph_gdn_chain(F, a, 97, 129);
    SEAM(24);
    if (IN(25)) for (int rep_ = 0; rep_ < REP(25); ++rep_) { ph_odd_post(F, a); moe_convert(F, a, 1, F.gw, F.NGW); }
    SEAM(25);
    if (IN(26)) for (int rep_ = 0; rep_ < REP(26); ++rep_) { pg8::Gemm g{YMIX, (const bf16*)(a.ws + WS_WODOUT), 4096, 4096, 4096}; pg8::StaticOrder S; S.init(TX, DM, F.G, (int)blockIdx.x); pg8::EpiResid E{H, a.in[0], a.in[1], 1}; run_gemm(F, g, S, E); gemm_tail16(F, a, YMIX, 4096, (const bf16*)(a.ws + WS_WODOUT), 4096, 1); }
    SEAM(26);
    if (IN(27)) for (int rep_ = 0; rep_ < REP(27); ++rep_) ph_route(F, a, 1, rep_);
    SEAM(27);
    if (IN(28)) for (int rep_ = 0; rep_ < REP(28); ++rep_) ph_gather(F, a, 1);
    SEAM(28);
    if (IN(29)) ph_moe_a(F, a);
    SEAM(29);
    if (IN(30)) ph_moe_b(F, a);
    SEAM(30);
    if (IN(31)) ph_moe_c(F, a);
    SEAM(31);
    if (IN(32)) for (int rep_ = 0; rep_ < REP(32); ++rep_) ph_combine(F, a, 1);
#undef IN
#undef SEAM
}

extern "C" void kernel_launch(void* const* d_in, const int* in_sizes, int n_in, void* d_out, int out_size, void* d_ws, size_t ws_size, hipStream_t stream) {
    static int grid = 0;
    if (grid == 0) {
        if (n_in != 36 || out_size != TX * DM || ws_size < WS_END) { fprintf(stderr, "kernel_launch: unexpected shapes (n_in %d, out %d, ws %zu)\n", n_in, out_size, ws_size); grid = -1; return; }
        int dev = 0, cus = 0, per_cu = 0;
        if (hipGetDevice(&dev) != hipSuccess || hipDeviceGetAttribute(&cus, hipDeviceAttributeMultiprocessorCount, dev) != hipSuccess) { grid = -1; return; }
        if (hipFuncSetAttribute((const void*)hyb_fwd, hipFuncAttributeMaxDynamicSharedMemorySize, LDS_BYTES) != hipSuccess) { fprintf(stderr, "kernel_launch: hipFuncSetAttribute failed\n"); grid = -1; return; }
        if (hipOccupancyMaxActiveBlocksPerMultiprocessor(&per_cu, (const void*)hyb_fwd, NWAVES * 64, LDS_BYTES) != hipSuccess || per_cu < 1) { fprintf(stderr, "kernel_launch: occupancy query says %d\n", per_cu); per_cu = 1; }
        (void)hipGetLastError();
        grid = cus;
    }
    if (grid < 0) return;
    if (hipMemsetAsync((char*)d_ws + WS_CTL, 0, CTL_ZERO_BYTES, stream) != hipSuccess) return;
    Args a{};
    for (int i = 0; i < 36; ++i) a.in[i] = (const float*)d_in[i];
    a.out = (float*)d_out; a.ws = (unsigned char*)d_ws;
#if MK_ONE_LAUNCH
    a.ph_lo = 0; a.ph_hi = N_PHASES;
    hipLaunchKernelGGL(hyb_fwd, dim3(grid), dim3(NWAVES * 64), LDS_BYTES, stream, a);
#else
    for (int p = 0; p < N_PHASES; ++p) { a.ph_lo = p; a.ph_hi = p + 1; hipLaunchKernelGGL(hyb_fwd, dim3(grid), dim3(NWAVES * 64), LDS_BYTES, stream, a); }
#endif
}
```

```cpp
#include <hip/hip_runtime.h>
#include <cstdio>
#include <cstdint>
#include <cmath>

#ifndef MK_ONE_LAUNCH
#define MK_ONE_LAUNCH 1
#endif

namespace pg8 {
#define PG8_LAS __attribute__((address_space(3)))
typedef unsigned short bf16_t;
typedef short bf16x8 __attribute__((ext_vector_type(8)));
typedef float f32x4 __attribute__((ext_vector_type(4)));
typedef unsigned u32x4 __attribute__((ext_vector_type(4)));
typedef unsigned u32x2 __attribute__((ext_vector_type(2)));
constexpr int BM = 256, BK = 64, HALF = 128, HTB = HALF * BK * 2  , STAGE_BYTES = 8 * HTB, NXCD = 8, WGM = 8;

__host__ __device__ __forceinline__ int lds_byte(int r, int c) { const int st = (r >> 4) * 2 + (c >> 5), rr = r & 15, cc = c & 31, ob = rr * 64 + cc * 2; return st * 1024 + (ob ^ (((ob >> 9) & 1) << 5)); }
__host__ __device__ __forceinline__ void stage_rc(int b, int& R, int& C) { const int st = b / 1024, sb = b % 1024, swz = sb ^ (((sb >> 9) & 1) << 5); R = (st >> 1) * 16 + swz / 64; C = (st & 1) * 32 + (swz % 64) / 2; }
__host__ __device__ __forceinline__ int perm32(int rho) { const int n = rho >> 4, i = rho & 15; return 8 * (i >> 2) + 4 * n + (i & 3); }

struct Unit { int pm, pn; long aoff, boff; };
struct Gemm { const bf16_t* A; const bf16_t* Bt; int K, lda, ldb; };

struct StaticOrder {
    int nM, nN, nwg, G, c, amod; long astep;
    __host__ __device__ void init(int M, int N, int G_, int c_) { nM = M / BM; nN = N / BM; nwg = nM * nN; G = G_; c = c_; amod = 0; astep = 0; }
    __host__ __device__ bool next(int i, Unit& u) const {
        const long L = (long)i * G + c; if (L >= nwg) return false;
        int wgid = (int)L; { const int q = nwg / NXCD, r = nwg % NXCD, xcd = wgid % NXCD, off = wgid / NXCD; wgid = (xcd < r ? xcd * (q + 1) : r * (q + 1) + (xcd - r) * q) + off; }
        const int nig = WGM * nN, gid = wgid / nig, fm = gid * WGM, gsz = (nM - fm) < WGM ? (nM - fm) : WGM;
        u.pm = fm + ((wgid % nig) % gsz); u.pn = (wgid % nig) / gsz; u.boff = 0; u.aoff = amod ? (long)(u.pn % amod) * astep : 0; return true;
    }
    __device__ __forceinline__ void a_ready(const Unit&) const {}
    __device__ __forceinline__ void done(const Unit&) const {}
};
struct MoeOrder {
    const int* tile_e; int t0, ntiles, npn, G, c; long bstride;
    __device__ __forceinline__ bool next(int i, Unit& u) const {
        const long L = (long)i * G + c; if (c < 0 || L >= (long)ntiles * npn) return false;
        const int t = t0 + (int)(L / npn); u.pm = t; u.pn = (int)(L % npn); u.aoff = 0; u.boff = (long)tile_e[t] * bstride; return true;
    }
    __device__ __forceinline__ void a_ready(const Unit&) const {}
    __device__ __forceinline__ void done(const Unit&) const {}
};

__device__ __forceinline__ unsigned cvt_pk_bf16(float lo, float hi) { unsigned r; asm volatile("v_cvt_pk_bf16_f32 %0, %1, %2" : "=v"(r) : "v"(lo), "v"(hi)); return r; }
__device__ __forceinline__ float bf_lo(unsigned w) { return __uint_as_float(w << 16); }
__device__ __forceinline__ float bf_hi(unsigned w) { return __uint_as_float(w & 0xffff0000u); }
__device__ __forceinline__ float sigmoidf_(float x) { return 1.0f / (1.0f + __expf(-x)); }
__device__ __forceinline__ float softplusf_(float x) { return fmaxf(x, 0.f) + __logf(1.0f + __expf(-fabsf(x))); }

struct EpiBf16 {
    static constexpr bool PERM = true, AFTER_DRAIN = false;
    bf16_t* O; int ldc;
    __device__ __forceinline__ void operator()(const f32x4 (&acc)[2][2][4][2], const Unit& u, int wr, int wc, int fr, int fq) const {
        const int row0 = u.pm * BM + wr * 64 + fr; const int col0 = u.pn * BM + wc * 32 + 8 * fq;
#pragma unroll
        for (int ai = 0; ai < 2; ++ai)
#pragma unroll
            for (int m = 0; m < 4; ++m) { bf16_t* rowp = O + (size_t)(row0 + ai * HALF + m * 16) * ldc + col0;
#pragma unroll
                for (int bj = 0; bj < 2; ++bj) { const f32x4 v0 = acc[ai][bj][m][0], v1 = acc[ai][bj][m][1];
                    u32x4 w; w.x = cvt_pk_bf16(v0[0], v0[1]); w.y = cvt_pk_bf16(v0[2], v0[3]); w.z = cvt_pk_bf16(v1[0], v1[1]); w.w = cvt_pk_bf16(v1[2], v1[3]);
                    *(u32x4*)(rowp + bj * HALF) = w; } }
    }
};
struct EpiSwiglu {
    static constexpr bool PERM = true, AFTER_DRAIN = false;
    bf16_t* O; int ldc;
    __device__ __forceinline__ void operator()(const f32x4 (&acc)[2][2][4][2], const Unit& u, int wr, int wc, int fr, int fq) const {
        const int row0 = u.pm * BM + wr * 64 + fr; const int col0 = u.pn * HALF + wc * 32 + 8 * fq;
#pragma unroll
        for (int ai = 0; ai < 2; ++ai)
#pragma unroll
            for (int m = 0; m < 4; ++m) { bf16_t* rowp = O + (size_t)(row0 + ai * HALF + m * 16) * ldc + col0;
                float o[8];
#pragma unroll
                for (int n = 0; n < 2; ++n)
#pragma unroll
                    for (int j = 0; j < 4; ++j) { const float gq = acc[ai][0][m][n][j], uq = acc[ai][1][m][n][j]; o[4 * n + j] = gq * sigmoidf_(gq) * uq; }
                u32x4 w; w.x = cvt_pk_bf16(o[0], o[1]); w.y = cvt_pk_bf16(o[2], o[3]); w.z = cvt_pk_bf16(o[4], o[5]); w.w = cvt_pk_bf16(o[6], o[7]);
                *(u32x4*)rowp = w; }
    }
};
struct EpiResid {
    static constexpr bool PERM = false, AFTER_DRAIN = false;
    float* out; const float* x; const float* meta; int mode;
    __device__ __forceinline__ void operator()(const f32x4 (&acc)[2][2][4][2], const Unit& u, int wr, int wc, int fr, int fq) const {
        const int row0 = u.pm * BM + wr * 64 + fr, col0 = u.pn * BM + wc * 32 + 4 * fq;
#pragma unroll
        for (int ai = 0; ai < 2; ++ai)
#pragma unroll
            for (int m = 0; m < 4; ++m) { const int row = row0 + ai * HALF + m * 16; float* rowp = out + (size_t)row * 2048 + col0;
                const float* bp = mode ? rowp : (row < 8192 ? x + (size_t)row * 2048 + col0 : (row < 8208 ? meta + (size_t)(row - 8192) * 2048 + col0 : nullptr));
#pragma unroll
                for (int bj = 0; bj < 2; ++bj)
#pragma unroll
                    for (int n = 0; n < 2; ++n) { f32x4 b = (f32x4){0.f, 0.f, 0.f, 0.f}; if (bp) b = *(const f32x4*)(bp + bj * HALF + n * 16);
                        *(f32x4*)(rowp + bj * HALF + n * 16) = acc[ai][bj][m][n] + b; } }
    }
};
struct EpiLora {
    static constexpr bool PERM = false, AFTER_DRAIN = false;
    float* base; long gstride; const float* w0; const float* a0;
    __device__ __forceinline__ void operator()(const f32x4 (&acc)[2][2][4][2], const Unit& u, int wr, int wc, int fr, int fq) const {
        const int grp = u.pn >> 2; const int row0 = u.pm * BM + wr * 64 + fr, col0 = (u.pn & 3) * BM + wc * 32 + 4 * fq;
        float* O = base + (size_t)grp * gstride;
#pragma unroll
        for (int bj = 0; bj < 2; ++bj)
#pragma unroll
            for (int n = 0; n < 2; ++n) { const int c = col0 + bj * HALF + n * 16;
                f32x4 bv = (f32x4){0.f, 0.f, 0.f, 0.f}; if (grp == 0) bv = *(const f32x4*)(w0 + c); else if (grp == 1) bv = *(const f32x4*)(a0 + c);
#pragma unroll
                for (int ai = 0; ai < 2; ++ai)
#pragma unroll
                    for (int m = 0; m < 4; ++m) { f32x4 v = acc[ai][bj][m][n] + bv;
                        if (grp == 0) {
#pragma unroll
                            for (int j = 0; j < 4; ++j) { const float wl = -softplusf_(-v[j]) - 0.5f; v[j] = __expf(-__expf(wl)); }
                        } else if (grp == 1) {
#pragma unroll
                            for (int j = 0; j < 4; ++j) v[j] = sigmoidf_(v[j]);
                        }
                        *(f32x4*)(O + (size_t)(row0 + ai * HALF + m * 16) * 1024 + c) = v; } }
    }
};
struct EpiGates {
    static constexpr bool PERM = false, AFTER_DRAIN = false;
    float* lru_a; float* lru_ix; const float* ba; const float* bx; const float* lam; const bf16_t* xr;
    __device__ __forceinline__ void operator()(const f32x4 (&acc)[2][2][4][2], const Unit& u, int wr, int wc, int fr, int fq) const {
        const int grp = u.pn >> 2; const int row0 = u.pm * BM + wr * 64 + fr, col0 = (u.pn & 3) * BM + wc * 32 + 4 * fq;
#pragma unroll
        for (int bj = 0; bj < 2; ++bj)
#pragma unroll
            for (int n = 0; n < 2; ++n) { const int c = col0 + bj * HALF + n * 16;
                const f32x4 bv = *(const f32x4*)((grp == 0 ? ba : bx) + c); f32x4 sp = (f32x4){0.f, 0.f, 0.f, 0.f};
                if (grp == 0) { const f32x4 l = *(const f32x4*)(lam + c);
#pragma unroll
                    for (int j = 0; j < 4; ++j) sp[j] = -8.0f * softplusf_(-l[j]); }
#pragma unroll
                for (int ai = 0; ai < 2; ++ai)
#pragma unroll
                    for (int m = 0; m < 4; ++m) { const int row = row0 + ai * HALF + m * 16; f32x4 v = acc[ai][bj][m][n] + bv;
                        if (grp == 0) {
#pragma unroll
                            for (int j = 0; j < 4; ++j) v[j] = __expf(sigmoidf_(v[j]) * sp[j]);
                            *(f32x4*)(lru_a + (size_t)row * 1024 + c) = v;
                        } else { const u32x2 xw = *(const u32x2*)(xr + (size_t)row * 1024 + c);
                            v[0] = sigmoidf_(v[0]) * bf_lo(xw.x); v[1] = sigmoidf_(v[1]) * bf_hi(xw.x); v[2] = sigmoidf_(v[2]) * bf_lo(xw.y); v[3] = sigmoidf_(v[3]) * bf_hi(xw.y);
                            *(f32x4*)(lru_ix + (size_t)row * 1024 + c) = v; } } }
    }
};

template <class Epi, class Sched, bool ALIGN_EPI = false, bool SP2 = false>
__device__ __forceinline__ void gemm_phase(PG8_LAS unsigned char* lds, const Gemm g, const Sched& S, const Epi& E) {
    const int tid = threadIdx.x, wid = __builtin_amdgcn_readfirstlane(tid >> 6), lane = tid & 63, wr = wid >> 2, wc = wid & 3, fr = lane & 15, fq = lane >> 4;
    const int K = g.K, nt = K / BK;
    unsigned voffA[2], voffB[2];
#pragma unroll
    for (int i = 0; i < 2; ++i) { int R, C; stage_rc(tid * 16 + i * 8192, R, C); const int Rb = Epi::PERM ? ((R & ~31) + perm32(R & 31)) : R;
        voffA[i] = (unsigned)(R * g.lda + C) * 2u; voffB[i] = (unsigned)(Rb * g.ldb + C) * 2u; }
    const size_t kstep = (size_t)(BK * 2);
    const size_t hstepA = (size_t)HALF * g.lda * 2, hstepB = (size_t)HALF * g.ldb * 2;
    const size_t tstepA = 2 * hstepA, tstepB = 2 * hstepB;
    const unsigned ldsw = (unsigned)wid * 1024u;
    const int aoff = lds_byte(wr * 64 + fr, fq * 8), boff = lds_byte(wc * 32 + fr, fq * 8);
#define PG8_SA(b, h) (((b) * 2 + (h)) * HTB)
#define PG8_SB(b, h) ((4 + (b) * 2 + (h)) * HTB)
#define PG8_STAGE(bufoff, gbase, voff) do { _Pragma("unroll") for (int _i = 0; _i < 2; ++_i) \
        __builtin_amdgcn_global_load_lds((const unsigned*)((const char*)(gbase) + (voff)[_i]), (PG8_LAS unsigned*)(lds + (bufoff) + ldsw + _i * 8192), 16, 0, 0); } while (0)
#define PG8_LDA(dst, b, h) do { _Pragma("unroll") for (int m = 0; m < 4; ++m) _Pragma("unroll") for (int k = 0; k < 2; ++k) dst[m][k] = *(const PG8_LAS bf16x8*)(lds + PG8_SA(b, h) + aoff + m * 2048 + k * 1024); } while (0)
#define PG8_LDB(dst, b, h) do { _Pragma("unroll") for (int n = 0; n < 2; ++n) _Pragma("unroll") for (int k = 0; k < 2; ++k) dst[n][k] = *(const PG8_LAS bf16x8*)(lds + PG8_SB(b, h) + boff + n * 2048 + k * 1024); } while (0)
#define PG8_MMA(ai, bj, At, Bt) do { __builtin_amdgcn_s_setprio(1); _Pragma("unroll") for (int m = 0; m < 4; ++m) _Pragma("unroll") for (int n = 0; n < 2; ++n) _Pragma("unroll") for (int k = 0; k < 2; ++k) \
        acc[ai][bj][m][n] = __builtin_amdgcn_mfma_f32_16x16x32_bf16(Bt[n][k], At[m][k], acc[ai][bj][m][n], 0, 0, 0); __builtin_amdgcn_s_setprio(0); } while (0)
#define PG8_WAIT_V(n) asm volatile("s_waitcnt vmcnt(" #n ")" ::: "memory")
#define PG8_WAIT_L(n) asm volatile("s_waitcnt lgkmcnt(" #n ")" ::: "memory")
#define PG8_BAR __builtin_amdgcn_s_barrier()
#define PG8_SCHED __builtin_amdgcn_sched_barrier(0)
    Unit cur, nxt; int ui = 0;
    if (!S.next(0, cur)) return;
    f32x4 acc[2][2][4][2];
#pragma unroll
    for (int a = 0; a < 2; ++a)
#pragma unroll
        for (int b = 0; b < 2; ++b)
#pragma unroll
            for (int m = 0; m < 4; ++m)
#pragma unroll
                for (int n = 0; n < 2; ++n) acc[a][b][m][n] = (f32x4){0.f, 0.f, 0.f, 0.f};
    bf16x8 At[4][2], B0[2][2], B1[2][2];
    const char* cA = (const char*)g.A + (size_t)cur.pm * tstepA + cur.aoff; const char* cB = (const char*)g.Bt + (size_t)cur.pn * tstepB + cur.boff;
    S.a_ready(cur);
    if constexpr (SP2) {
        PG8_STAGE(PG8_SB(0, 0), cB, voffB); PG8_STAGE(PG8_SB(0, 1), cB + hstepB, voffB); PG8_STAGE(PG8_SA(0, 0), cA, voffA); PG8_STAGE(PG8_SA(0, 1), cA + hstepA, voffA);
        if (wr == 1) PG8_BAR;
        PG8_WAIT_V(2); PG8_BAR;
        PG8_STAGE(PG8_SB(1, 0), cB + kstep, voffB); PG8_STAGE(PG8_SA(1, 0), cA + kstep, voffA); PG8_STAGE(PG8_SB(1, 1), cB + hstepB + kstep, voffB);
        PG8_WAIT_V(6); PG8_BAR;
    } else {
        PG8_STAGE(PG8_SB(0, 0), cB, voffB); PG8_STAGE(PG8_SA(0, 0), cA, voffA); PG8_STAGE(PG8_SB(0, 1), cB + hstepB, voffB); PG8_STAGE(PG8_SA(0, 1), cA + hstepA, voffA);
        if (wr == 1) PG8_BAR;
        PG8_WAIT_V(4); PG8_BAR;
        PG8_STAGE(PG8_SB(1, 0), cB + kstep, voffB); PG8_STAGE(PG8_SA(1, 0), cA + kstep, voffA); PG8_STAGE(PG8_SB(1, 1), cB + hstepB + kstep, voffB);
        PG8_WAIT_V(6); PG8_BAR;
    }
    for (;;) {
        const bool has_next = S.next(ui + 1, nxt);
        const char* nA = has_next ? (const char*)g.A + (size_t)nxt.pm * tstepA + nxt.aoff : cA; const char* nB = has_next ? (const char*)g.Bt + (size_t)nxt.pn * tstepB + nxt.boff : cB;
        for (int t = 0; t < nt; t += 2) {
            const bool last = (t == nt - 2);
            const char* a1 = cA + (size_t)(t + 1) * kstep;
            const char* a2 = last ? nA : cA + (size_t)(t + 2) * kstep; const char* b2 = last ? nB : cB + (size_t)(t + 2) * kstep;
            const char* a3 = a2 + kstep; const char* b3 = b2 + kstep;
            if (last && has_next) S.a_ready(nxt);
            if constexpr (SP2) {
            PG8_LDB(B0, 0, 0); PG8_LDB(B1, 0, 1); PG8_SCHED; PG8_LDA(At, 0, 0); PG8_STAGE(PG8_SA(1, 1), a1 + hstepA, voffA);
            PG8_WAIT_V(8); PG8_WAIT_L(0); PG8_BAR; PG8_MMA(0, 0, At, B0); PG8_MMA(0, 1, At, B1); PG8_BAR; PG8_SCHED;
            PG8_LDA(At, 0, 1); PG8_STAGE(PG8_SB(0, 0), b2, voffB); PG8_STAGE(PG8_SB(0, 1), b2 + hstepB, voffB); PG8_STAGE(PG8_SA(0, 0), a2, voffA);
            PG8_WAIT_V(8); PG8_WAIT_L(0); PG8_BAR; PG8_MMA(1, 0, At, B0); PG8_MMA(1, 1, At, B1); PG8_BAR; PG8_SCHED;
            PG8_LDB(B0, 1, 0); PG8_LDB(B1, 1, 1); PG8_SCHED; PG8_LDA(At, 1, 0); PG8_STAGE(PG8_SA(0, 1), a2 + hstepA, voffA);
            PG8_WAIT_V(8); PG8_WAIT_L(0); PG8_BAR; PG8_MMA(0, 0, At, B0); PG8_MMA(0, 1, At, B1); PG8_BAR; PG8_SCHED;
            PG8_LDA(At, 1, 1); PG8_STAGE(PG8_SB(1, 0), b3, voffB); PG8_STAGE(PG8_SB(1, 1), b3 + hstepB, voffB); PG8_STAGE(PG8_SA(1, 0), a3, voffA);
            PG8_WAIT_V(8); PG8_WAIT_L(0); PG8_BAR; PG8_MMA(1, 0, At, B0); PG8_MMA(1, 1, At, B1); PG8_BAR; PG8_SCHED;
            } else {
            PG8_LDB(B0, 0, 0); PG8_SCHED; PG8_LDA(At, 0, 0); PG8_STAGE(PG8_SA(1, 1), a1 + hstepA, voffA);
            PG8_WAIT_L(8); PG8_BAR; PG8_WAIT_L(0); PG8_MMA(0, 0, At, B0); PG8_BAR; PG8_SCHED;
            PG8_LDB(B1, 0, 1); PG8_STAGE(PG8_SB(0, 0), b2, voffB);
            PG8_BAR; PG8_WAIT_L(0); PG8_MMA(0, 1, At, B1); PG8_BAR;
            PG8_LDA(At, 0, 1); PG8_STAGE(PG8_SA(0, 0), a2, voffA);
            PG8_BAR; PG8_WAIT_L(0); PG8_MMA(1, 0, At, B0); PG8_BAR; PG8_SCHED;
            PG8_STAGE(PG8_SB(0, 1), b2 + hstepB, voffB);
            PG8_WAIT_V(6); PG8_BAR; PG8_MMA(1, 1, At, B1); PG8_BAR;
            PG8_LDB(B0, 1, 0); PG8_SCHED; PG8_LDA(At, 1, 0); PG8_STAGE(PG8_SA(0, 1), a2 + hstepA, voffA);
            PG8_WAIT_L(8); PG8_BAR; PG8_WAIT_L(0); PG8_MMA(0, 0, At, B0); PG8_BAR; PG8_SCHED;
            PG8_LDB(B1, 1, 1); PG8_STAGE(PG8_SB(1, 0), b3, voffB);
            PG8_BAR; PG8_WAIT_L(0); PG8_MMA(0, 1, At, B1); PG8_BAR;
            PG8_LDA(At, 1, 1); PG8_STAGE(PG8_SA(1, 0), a3, voffA);
            PG8_BAR; PG8_WAIT_L(0); PG8_MMA(1, 0, At, B0); PG8_BAR; PG8_SCHED;
            PG8_STAGE(PG8_SB(1, 1), b3 + hstepB, voffB);
            PG8_WAIT_V(6); PG8_BAR; PG8_MMA(1, 1, At, B1); PG8_BAR;
            }
        }
        if constexpr (ALIGN_EPI) { if (wr == 0) PG8_BAR; }
        if constexpr (!Epi::AFTER_DRAIN) { E(acc, cur, wr, wc, fr, fq); S.done(cur); }
        if (!has_next) break;
#pragma unroll
        for (int a = 0; a < 2; ++a)
#pragma unroll
            for (int b = 0; b < 2; ++b)
#pragma unroll
                for (int m = 0; m < 4; ++m)
#pragma unroll
                    for (int n = 0; n < 2; ++n) acc[a][b][m][n] = (f32x4){0.f, 0.f, 0.f, 0.f};
        cur = nxt; cA = nA; cB = nB; ++ui;
        if constexpr (ALIGN_EPI) { if (wr == 1) PG8_BAR; }
    }
    PG8_WAIT_V(0);
    if constexpr (!ALIGN_EPI) { if (wr == 0) PG8_BAR; }
    PG8_BAR;
    if constexpr (Epi::AFTER_DRAIN) { E.fused(acc, cur, wr, wc, fr, fq, lds, wid, lane); S.done(cur); }
#undef PG8_SA
#undef PG8_SB
#undef PG8_STAGE
#undef PG8_LDA
#undef PG8_LDB
#undef PG8_MMA
#undef PG8_WAIT_V
#undef PG8_WAIT_L
#undef PG8_BAR
#undef PG8_SCHED
}
}
#define GAS __attribute__((address_space(1)))
#define LAS __attribute__((address_space(3)))
typedef unsigned short bf16;
typedef unsigned v4u __attribute__((ext_vector_type(4)));
typedef float f32x4 __attribute__((ext_vector_type(4)));
typedef short bf16x8 __attribute__((ext_vector_type(8)));
typedef GAS unsigned gu32;
typedef GAS unsigned long long gu64;
#define RLX_AGENT __ATOMIC_RELAXED, __HIP_MEMORY_SCOPE_AGENT
#define LDS_WAIT() asm volatile("s_waitcnt lgkmcnt(0)" ::: "memory")
#define VM_WAIT() asm volatile("s_waitcnt vmcnt(0)" ::: "memory")
__device__ __forceinline__ unsigned long long rt() { return __builtin_amdgcn_s_memrealtime(); }
__device__ __forceinline__ unsigned f2bf(float f) { unsigned u = __builtin_bit_cast(unsigned, f); return (u + 0x7fffu + ((u >> 16) & 1u)) >> 16; }
__device__ __forceinline__ unsigned pk2(float lo, float hi) { return f2bf(lo) | (f2bf(hi) << 16); }

#define XB_TMO      128
#define XB_XCNT(j)  (256  + 64 * (j))
#define XB_XSUB(j)  (1280 + 64 * (j))
#define XB_XGEN(j)  (2304 + 64 * (j))
#define XB_TOP      3328
#define XB_TOPGEN   3392
#define XCD_BAR_WORDS 3456
#define XB_SPIN_CAP (1u << 18)

__device__ __forceinline__ unsigned xb_ld(unsigned* p)              { return __hip_atomic_load(p, __ATOMIC_RELAXED, __HIP_MEMORY_SCOPE_AGENT); }
__device__ __forceinline__ unsigned xb_add(unsigned* p, unsigned v) { return __hip_atomic_fetch_add(p, v, __ATOMIC_RELAXED, __HIP_MEMORY_SCOPE_AGENT); }
__device__ __forceinline__ unsigned xb_xcc_id() { return (unsigned)__builtin_amdgcn_s_getreg((3 << 11) | 20) & 0xFu; }
#define XB_SPIN(cond, bar) do { unsigned _sp = 0; while (cond) { __builtin_amdgcn_s_sleep(1); \
    if ((++_sp & 255u) == 0u) { if (xb_ld(&(bar)[XB_TMO])) break; if (_sp > XB_SPIN_CAP) { atomicAdd(&(bar)[XB_TMO], 1u); break; } } } } while (0)

struct XcdBarrier {
    unsigned* bar; unsigned x;
    volatile LAS unsigned* st;
};

__device__ __forceinline__ XcdBarrier xcd_barrier_post(unsigned* bar, volatile LAS unsigned* st) {
    XcdBarrier b; b.bar = bar; b.x = xb_xcc_id(); b.st = st;
    if (threadIdx.x == 0) (void)xb_add(&bar[XB_XCNT(b.x)], 1u);
    return b;
}
__device__ __forceinline__ void xcd_barrier_complete(unsigned* bar, unsigned x, unsigned& nloc, unsigned& nx) {
    const unsigned G = gridDim.x * gridDim.y * gridDim.z;
    unsigned sum, cnt, mine, sp = 0u;
    for (;;) {
        sum = 0u; cnt = 0u; mine = 0u;
#pragma unroll
        for (unsigned j = 0; j < 16; ++j) { const unsigned c = xb_ld(&bar[XB_XCNT(j)]); sum += c; cnt += (c > 0u) ? 1u : 0u; mine = (j == x) ? c : mine; }
        if (sum == G) break;
        __builtin_amdgcn_s_sleep(1);
        if ((++sp & 255u) == 0u) { if (xb_ld(&bar[XB_TMO])) break; if (sp > XB_SPIN_CAP) { atomicAdd(&bar[XB_TMO], 1u); break; } }
    }
    nloc = mine > 0u ? mine : 1u; nx = cnt > 0u ? cnt : 1u;
}

__device__ __forceinline__ void xcd_barrier(const XcdBarrier& b) {
    asm volatile("s_waitcnt vmcnt(0)" ::: "memory");
    __syncthreads();
    if (threadIdx.x == 0) {
        unsigned* bar = b.bar;
        __builtin_amdgcn_s_waitcnt(0);
        unsigned nloc = b.st[0], nx = b.st[1];
        if (nloc == 0u) { xcd_barrier_complete(bar, b.x, nloc, nx); b.st[0] = nloc; b.st[1] = nx; }
        const unsigned old = xb_add(&bar[XB_XSUB(b.x)], 1u);
        const unsigned gen = old / nloc;
        if (old + 1u == (gen + 1u) * nloc) {
            __builtin_amdgcn_fence(__ATOMIC_RELEASE, "agent");
            asm volatile("s_waitcnt vmcnt(0)" ::: "memory");
            const unsigned og = xb_add(&bar[XB_TOP], 1u);
            const unsigned tg = og / nx;
            if (og + 1u == (tg + 1u) * nx) xb_add(&bar[XB_TOPGEN], 1u);
            else XB_SPIN(xb_ld(&bar[XB_TOPGEN]) == tg, bar);
            __builtin_amdgcn_fence(__ATOMIC_ACQUIRE, "agent");
            xb_add(&bar[XB_XGEN(b.x)], 1u);
            asm volatile("s_waitcnt vmcnt(0)" ::: "memory");
        } else {
            XB_SPIN(xb_ld(&bar[XB_XGEN(b.x)]) == gen, bar);
            __builtin_amdgcn_fence(__ATOMIC_ACQUIRE, "agent");
            asm volatile("s_waitcnt vmcnt(0)" ::: "memory");
        }
    }
    __syncthreads();
}

constexpr int NWAVES = 8;
constexpr int DM = 2048, TX = 8192, NMETA = 16, TT = TX + NMETA, MP = 8448;
constexpr int EV_NP = 5632, EV_LORA0 = 3072, EV_GB = 3360, EV_REC = 4384;
constexpr int OD_NP = 12544, OD_Z = 8192, OD_B = 12288, OD_A = 12320;
constexpr int NEXP = 32, FF = 512, MOE_ROWS = 24576;
constexpr float NORM_EPS = 1e-6f;

constexpr size_t MiB = 1u << 20;
constexpr size_t WS_CTL = 0, CTL_ZERO_BYTES = 1 * MiB;
constexpr size_t WS_TOKINFO = 1 * MiB;
constexpr size_t WS_TILES = 1 * MiB + 512 * 1024;
constexpr size_t WS_WEVIN = 2 * MiB;
constexpr size_t WS_WEVOUT = 24 * MiB;
constexpr size_t WS_WODIN = 32 * MiB;
constexpr size_t WS_WODOUT = 81 * MiB;
constexpr size_t WS_WLORA = 97 * MiB;
constexpr size_t WS_WGATE = 100 * MiB;
constexpr size_t WS_WROUTE = 101 * MiB;
constexpr size_t WS_MOEW = 102 * MiB;
constexpr size_t MOE_E_BYTES = 6 * MiB, MOE_W2_OFF = 4 * MiB;
constexpr size_t WS_H = 294 * MiB;
constexpr size_t WS_HN = 360 * MiB;
constexpr size_t WS_YMIX = 393 * MiB;
constexpr size_t WS_PROJ = 459 * MiB;
constexpr size_t WS_SCR = 662 * MiB;
constexpr size_t WS_END = 932 * MiB;
constexpr size_t SC_ALORA = 0;
constexpr size_t SC_XR = 8 * MiB;
constexpr size_t SC_DEC = 26 * MiB, SC_ICL = 60 * MiB, SC_GATE = 94 * MiB;
constexpr size_t SC_LA = 128 * MiB, SC_LIX = 162 * MiB;
constexpr size_t SC_QN = 0, SC_KN = 34 * MiB;
constexpr size_t SC_VC = 68 * MiB;
constexpr size_t SC_BETA = 134 * MiB, SC_G = 136 * MiB;
constexpr size_t SC_O = 138 * MiB;
constexpr size_t SC_XG = 0;
constexpr size_t SC_ACT = 96 * MiB;
constexpr size_t SC_YB = 120 * MiB;
static_assert(SC_O + (size_t)MP * 4096 * 4 <= WS_END - WS_SCR && SC_YB + (size_t)MOE_ROWS * 2048 * 2 <= WS_END - WS_SCR && SC_LIX + (size_t)MP * 1024 * 4 <= WS_END - WS_SCR, "scratch map");
constexpr int CW_TMO = 0, CW_CODE = 1;
constexpr int CW_BAR = 4096;
constexpr int CW_PROG = 20480;
constexpr int CW_TS = 24576;
constexpr int CW_MOECNT = 16384;

constexpr int RING_OFF = 0, RING_BYTES = 131072;
constexpr int LDSCTL_OFF = 146944, MISC_OFF = LDSCTL_OFF + 320;
constexpr int LDS_BYTES = 147456;


#define DI __device__ __forceinline__
typedef unsigned v2u __attribute__((ext_vector_type(2)));
struct Args { const float* in[36]; float* out; unsigned char* ws; int ph_lo, ph_hi; };
struct Frame {
    LAS unsigned char* lds; volatile LAS unsigned* MISC; gu32* ctl;
    int tid, lane, wave, vcu, G, gw, NGW;
};
DI float bf2f(bf16 v) { return __uint_as_float((unsigned)v << 16); }
DI float bflo(unsigned w) { return __uint_as_float(w << 16); }
DI float bfhi(unsigned w) { return __uint_as_float(w & 0xffff0000u); }
DI float wave_sum(float v) {
#pragma unroll
    for (int o = 1; o < 64; o <<= 1) v += __shfl_xor(v, o);
    return v;
}
DI float sigm(float x) { return 1.0f / (1.0f + __expf(-x)); }
DI float softplus(float x) { return fmaxf(x, 0.f) + __logf(1.0f + __expf(-fabsf(x))); }
DI float gelu_tanh(float x) { const float u = 0.7978845608028654f * (x + 0.044715f * x * x * x); return 0.5f * x * (1.0f + tanhf(u)); }
DI int pos_row(int p) { return p < NMETA ? TX + p : p - NMETA; }
DI int row_pos(int r) { return r < TX ? r + NMETA : r - TX; }

DI void tr_item(const float* W, int N, int k0, int n0, bf16* WT, int ldk, int drow0, LAS float* scr, int lane) {
#pragma unroll 8
    for (int i = 0; i < 32; ++i) { const int kk = 2 * i + (lane >> 5); scr[kk * 33 + (lane & 31)] = W[(size_t)(k0 + kk) * N + n0 + (lane & 31)]; }
    LDS_WAIT(); asm volatile("" ::: "memory");
    const int c = lane & 7;
#pragma unroll
    for (int j = 0; j < 4; ++j) { const int n = (lane >> 3) + 8 * j; const LAS float* s = scr + (8 * c) * 33 + n;
        v4u o; o.x = pk2(s[0 * 33], s[1 * 33]); o.y = pk2(s[2 * 33], s[3 * 33]); o.z = pk2(s[4 * 33], s[5 * 33]); o.w = pk2(s[6 * 33], s[7 * 33]);
        *(v4u*)(WT + (size_t)(drow0 + n) * ldk + k0 + 8 * c) = o; }
    LDS_WAIT(); asm volatile("" ::: "memory");
}
DI void moe_convert(const Frame& F, const Args& a, int l, int gw, int ngw) {
    LAS float* scr = (LAS float*)(F.lds + RING_OFF + F.wave * 16384);
    bf16* base = (bf16*)(a.ws + WS_MOEW);
    for (int it = gw; it < NEXP * 1536; it += ngw) {
        const int e = it / 1536; int j = it % 1536; bf16* eb = base + (size_t)e * (MOE_E_BYTES / 2);
        const size_t eoff = (size_t)(l * NEXP + e) * DM * FF;
        if (j < 1024) { const float* W = (j < 512 ? a.in[33] : a.in[34]) + eoff; const int hi = j >= 512; j &= 511; const int kb = j >> 4, nb = j & 15, n0 = 32 * nb;
            tr_item(W, FF, 64 * kb, n0, eb, DM, 256 * (n0 >> 7) + 128 * hi + (n0 & 127), scr, F.lane); }
        else { j -= 1024; const int kb = j >> 6, nb = j & 63; tr_item(a.in[35] + eoff, DM, 64 * kb, 32 * nb, eb + MOE_W2_OFF / 2, FF, 32 * nb, scr, F.lane); }
    }
}
DI void norm_row_bf16(int lane, const float* src, const float* w, bf16* dst) {
    f32x4 v[8]; float s = 0.f;
#pragma unroll
    for (int j = 0; j < 8; ++j) { v[j] = ((const f32x4*)src)[lane + 64 * j]; s += (v[j].x * v[j].x + v[j].y * v[j].y) + (v[j].z * v[j].z + v[j].w * v[j].w); }
    const float rs = 1.0f / sqrtf(wave_sum(s) * (1.0f / DM) + NORM_EPS);
#pragma unroll
    for (int j = 0; j < 8; ++j) { const f32x4 wv = ((const f32x4*)w)[lane + 64 * j]; v2u o; o.x = pk2(v[j].x * rs * wv.x, v[j].y * rs * wv.y); o.y = pk2(v[j].z * rs * wv.z, v[j].w * rs * wv.w);
        ((v2u*)dst)[lane + 64 * j] = o; }
}

DI void ph_prologue(const Frame& F, const Args& a) {
    LAS float* scr = (LAS float*)(F.lds + RING_OFF + F.wave * 16384);
    constexpr int I_A = 32 * 169, I_B = 32 * 64, NIT = I_A + I_B;
    for (int it = F.gw; it < NIT; it += F.NGW) {
        int r = it;
        if (r < I_A) { const int kb = r / 169, nb = r % 169; tr_item(a.in[5], 5408, 64 * kb, 32 * nb, (bf16*)(a.ws + WS_WEVIN), DM, 32 * nb, scr, F.lane); continue; } r -= I_A;
        { const int kb = r / 64, nb = r % 64; tr_item(a.in[24], DM, 64 * kb, 32 * nb, (bf16*)(a.ws + WS_WEVOUT), DM, 32 * nb, scr, F.lane); }
    }
    const int gt = F.vcu * (NWAVES * 64) + F.tid, NGT = F.G * NWAVES * 64;
    { bf16* WL = (bf16*)(a.ws + WS_WLORA); const float* wup = a.in[8]; const float* aup = a.in[10]; const float* gup = a.in[11];
      for (int idx = gt; idx < 3072 * 384; idx += NGT) { const int n = idx / 384, k = idx % 384; float v = 0.f;
          if (n < 1024) { if (k < 64) v = wup[k * 1024 + n]; }
          else if (n < 2048) { if (k >= 64 && k < 128) v = aup[(k - 64) * 1024 + n - 1024]; }
          else { if (k >= 128 && k < 288) v = gup[(k - 128) * 1024 + n - 2048]; }
          WL[idx] = (bf16)f2bf(v); } }
    { bf16* WG = (bf16*)(a.ws + WS_WGATE);
      for (int idx = gt; idx < 2048 * 256; idx += NGT) { const int n = idx >> 8, kk = idx & 255, nn = n & 1023, blk = nn >> 6, j = nn & 63, cin = (nn & ~255) + kk;
          const float* W = n < 1024 ? a.in[19] : a.in[21];
          const float v = (cin >> 6) == blk ? W[blk * 4096 + (cin & 63) * 64 + j] : 0.f;
          WG[idx] = (bf16)f2bf(v); } }
    { bf16* WR = (bf16*)(a.ws + WS_WROUTE);
      for (int idx = gt; idx < 2 * 48 * DM; idx += NGT) { const int l = idx / (48 * DM), n = (idx / DM) % 48, k = idx % DM; float v = 0.f;
          if (n < 32) v = a.in[32][((size_t)l * DM + k) * NEXP + n]; else if (n < 36) v = a.in[31][((size_t)l * DM + k) * 4 + n - 32];
          const unsigned hi = f2bf(v); WR[((size_t)(l * 2) * 48 + n) * DM + k] = (bf16)hi; WR[((size_t)(l * 2 + 1) * 48 + n) * DM + k] = (bf16)f2bf(v - __uint_as_float(hi << 16)); } }
    bf16* HN = (bf16*)(a.ws + WS_HN);
    for (int r = F.gw; r < TT; r += F.NGW) norm_row_bf16(F.lane, r < TX ? a.in[0] + (size_t)r * DM : a.in[1] + (size_t)(r - TX) * DM, a.in[2], HN + (size_t)r * DM);
}

DI void ph_aux_convert(const Frame& F, const Args& a, int gw, int ngw) {
    LAS float* scr = (LAS float*)(F.lds + RING_OFF + F.wave * 16384);
    constexpr int I_C = 32 * 386, I_D = 64 * 64, NIT = I_C + I_D;
    for (int it = gw; it < NIT; it += ngw) {
        int r = it;
        if (r < I_C) { const int kb = r / 386, nb = r % 386; tr_item(a.in[25], 12352, 64 * kb, 32 * nb, (bf16*)(a.ws + WS_WODIN), DM, 32 * nb, scr, F.lane); continue; } r -= I_C;
        { const int kb = r / 64, nb = r % 64; tr_item(a.in[30], DM, 64 * kb, 32 * nb, (bf16*)(a.ws + WS_WODOUT), 4096, 32 * nb, scr, F.lane); }
    }
    moe_convert(F, a, 0, gw, ngw);
}

DI void ph_even_prep(const Frame& F, const Args& a) {
    const bf16* P = (const bf16*)(a.ws + WS_PROJ); bf16* AL = (bf16*)(a.ws + WS_SCR + SC_ALORA); bf16* XR = (bf16*)(a.ws + WS_SCR + SC_XR);
    const float* mu = a.in[6]; const float* cw = a.in[17]; const float* cb = a.in[18];
    const int lane = F.lane;
    for (int item = F.gw; item < TT + (TT / 8) * 2; item += F.NGW) {
        if (item < TT) { const int r = item, pos = row_pos(r); const bf16* cur = P + (size_t)r * EV_NP; const bf16* prv = P + (size_t)pos_row(pos > 0 ? pos - 1 : 0) * EV_NP; const float pm = pos > 0 ? 1.f : 0.f;
            float cv[6], pv[6], mv[6];
#pragma unroll
            for (int i = 0; i < 6; ++i) { const int idx = lane + 64 * i, col = EV_LORA0 + (idx < 288 ? idx : 287); cv[i] = bf2f(cur[col]); pv[i] = bf2f(prv[col]) * pm; mv[i] = mu[col]; }
#pragma unroll
            for (int i = 0; i < 6; ++i) { const int idx = lane + 64 * i; float v = cv[i] + (pv[i] - cv[i]) * mv[i];
                if (idx < 64) v = tanhf(v); else if (idx >= 128) v = sigm(v);
                AL[(size_t)r * 384 + idx] = (bf16)f2bf(idx < 288 ? v : 0.f); }
        } else { const int it2 = item - TT, pb = it2 >> 1, c0 = (it2 & 1) * 512 + lane * 8, p0 = pb * 8;
            f32x4 w[4][2], b0 = *(const f32x4*)(cb + c0), b1 = *(const f32x4*)(cb + c0 + 4);
#pragma unroll
            for (int j = 0; j < 4; ++j) { w[j][0] = *(const f32x4*)(cw + j * 1024 + c0); w[j][1] = *(const f32x4*)(cw + j * 1024 + c0 + 4); }
            v4u x[11];
#pragma unroll
            for (int i = 0; i < 11; ++i) { const int p = p0 - 3 + i; x[i] = *(const v4u*)(P + (size_t)pos_row(p > 0 ? p : 0) * EV_NP + EV_REC + c0); if (p < 0) x[i] = (v4u){0u, 0u, 0u, 0u}; }
#pragma unroll
            for (int o = 0; o < 8; ++o) { float acc[8] = {b0.x, b0.y, b0.z, b0.w, b1.x, b1.y, b1.z, b1.w};
#pragma unroll
                for (int j = 0; j < 4; ++j) { const v4u xv = x[o + j];
                    acc[0] += w[j][0].x * bflo(xv.x); acc[1] += w[j][0].y * bfhi(xv.x); acc[2] += w[j][0].z * bflo(xv.y); acc[3] += w[j][0].w * bfhi(xv.y);
                    acc[4] += w[j][1].x * bflo(xv.z); acc[5] += w[j][1].y * bfhi(xv.z); acc[6] += w[j][1].z * bflo(xv.w); acc[7] += w[j][1].w * bfhi(xv.w); }
                *(v4u*)(XR + (size_t)pos_row(p0 + o) * 1024 + c0) = (v4u){pk2(acc[0], acc[1]), pk2(acc[2], acc[3]), pk2(acc[4], acc[5]), pk2(acc[6], acc[7])}; } }
    }
}

DI void ph_route(const Frame& F, const Args& a, int l, int dummy) {
    const float* H = (const float*)(a.ws + WS_H); const float* nw = a.in[3] + (size_t)l * DM;
    const bf16* WH = (const bf16*)(a.ws + WS_WROUTE) + (size_t)(l * 2) * 48 * DM; const bf16* WL = WH + (size_t)48 * DM;
    unsigned* TI = (unsigned*)(a.ws + WS_TOKINFO) + (dummy ? (WS_SCR + 250 * MiB - WS_TOKINFO) / 4 : 0); const int lane = F.lane, lc = lane & 15, quad = lane >> 4; const int cl = dummy ? l + 2 : l;
    LAS float* scr = (LAS float*)(F.lds + RING_OFF + F.wave * 16384);
    for (int task = F.gw; task < TT / 16; task += F.NGW) {
        const int r = task * 16 + lc; const float* hr = H + (size_t)r * DM + 8 * quad; float ss = 0.f;
#pragma unroll 8
        for (int ks = 0; ks < 64; ++ks) { const f32x4 x0 = *(const f32x4*)(hr + 32 * ks), x1 = *(const f32x4*)(hr + 32 * ks + 4); ss += (x0.x * x0.x + x0.y * x0.y) + (x0.z * x0.z + x0.w * x0.w) + (x1.x * x1.x + x1.y * x1.y) + (x1.z * x1.z + x1.w * x1.w); }
        ss += __shfl_xor(ss, 16); ss += __shfl_xor(ss, 32);
        const float rs = 1.0f / sqrtf(ss * (1.0f / DM) + NORM_EPS);
        f32x4 acc[3];
#pragma unroll
        for (int nt = 0; nt < 3; ++nt) acc[nt] = (f32x4){0.f, 0.f, 0.f, 0.f};
#pragma unroll 2
        for (int ks = 0; ks < 64; ++ks) { const int k0 = 32 * ks + 8 * quad; const f32x4 x0 = *(const f32x4*)(hr + 32 * ks), x1 = *(const f32x4*)(hr + 32 * ks + 4), w0 = *(const f32x4*)(nw + k0), w1 = *(const f32x4*)(nw + k0 + 4);
            const float xn[8] = {x0.x * rs * w0.x, x0.y * rs * w0.y, x0.z * rs * w0.z, x0.w * rs * w0.w, x1.x * rs * w1.x, x1.y * rs * w1.y, x1.z * rs * w1.z, x1.w * rs * w1.w};
            unsigned hi[8]; float lo[8];
#pragma unroll
            for (int q = 0; q < 8; ++q) { hi[q] = f2bf(xn[q]); lo[q] = xn[q] - __uint_as_float(hi[q] << 16); }
            const v4u ah4 = (v4u){hi[0] | (hi[1] << 16), hi[2] | (hi[3] << 16), hi[4] | (hi[5] << 16), hi[6] | (hi[7] << 16)}, al4 = (v4u){pk2(lo[0], lo[1]), pk2(lo[2], lo[3]), pk2(lo[4], lo[5]), pk2(lo[6], lo[7])};
            const bf16x8 ah = __builtin_bit_cast(bf16x8, ah4), al = __builtin_bit_cast(bf16x8, al4);
#pragma unroll
            for (int nt = 0; nt < 3; ++nt) { const bf16x8 bh = *(const bf16x8*)(WH + (size_t)(16 * nt + lc) * DM + k0), bl = *(const bf16x8*)(WL + (size_t)(16 * nt + lc) * DM + k0);
                acc[nt] = __builtin_amdgcn_mfma_f32_16x16x32_bf16(al, bh, acc[nt], 0, 0, 0); acc[nt] = __builtin_amdgcn_mfma_f32_16x16x32_bf16(ah, bl, acc[nt], 0, 0, 0); acc[nt] = __builtin_amdgcn_mfma_f32_16x16x32_bf16(ah, bh, acc[nt], 0, 0, 0); } }
#pragma unroll
        for (int nt = 0; nt < 3; ++nt)
#pragma unroll
            for (int q = 0; q < 4; ++q) scr[(4 * quad + q) * 49 + 16 * nt + lc] = acc[nt][q];
        asm volatile("s_waitcnt lgkmcnt(0)" ::: "memory"); __builtin_amdgcn_wave_barrier();
        if (lane < 16) { float lg[36];
#pragma unroll
            for (int i = 0; i < 36; ++i) lg[i] = scr[lane * 49 + i];
            int gi = 0; float gm = lg[32];
#pragma unroll
            for (int i = 1; i < 4; ++i) if (lg[32 + i] > gm) { gm = lg[32 + i]; gi = i; }
            float den = 0.f;
#pragma unroll
            for (int i = 0; i < 4; ++i) den += __expf(lg[32 + i] - gm);
            const float gp = 1.0f / den;
            float l8[8];
#pragma unroll
            for (int i = 0; i < 8; ++i) l8[i] = gi == 0 ? lg[i] : (gi == 1 ? lg[8 + i] : (gi == 2 ? lg[16 + i] : lg[24 + i]));
            int i1 = 0; float m1 = l8[0];
#pragma unroll
            for (int i = 1; i < 8; ++i) if (l8[i] > m1) { m1 = l8[i]; i1 = i; }
            int i2 = -1; float m2 = -INFINITY;
#pragma unroll
            for (int i = 0; i < 8; ++i) if (i != i1 && l8[i] > m2) { m2 = l8[i]; i2 = i; }
            const float e21 = __expf(m2 - m1); const float w1 = gp / (1.0f + e21), w2 = gp * e21 / (1.0f + e21);
            const int ea = gi * 8 + i1, eb = gi * 8 + i2;
            const unsigned sa = atomicAdd((unsigned*)(F.ctl + CW_MOECNT + (cl * NEXP + ea) * 16), 1u), sb = atomicAdd((unsigned*)(F.ctl + CW_MOECNT + (cl * NEXP + eb) * 16), 1u);
            unsigned* t = TI + (size_t)r * 8; *(v4u*)t = (v4u){(unsigned)ea, sa, __float_as_uint(w1), (unsigned)eb}; *(v4u*)(t + 4) = (v4u){sb, __float_as_uint(w2), __float_as_uint(rs), 0u}; }
        __builtin_amdgcn_wave_barrier(); asm volatile("" ::: "memory");
    }
}
DI void moe_prefix(const Frame& F, int l, LAS int* ps) {
    if (F.tid == 0) { int t = 0;
        for (int e = 0; e < NEXP; ++e) { const unsigned c = __hip_atomic_load(F.ctl + CW_MOECNT + (l * NEXP + e) * 16, RLX_AGENT); ps[e] = t * 256; t += (int)((c + 255u) >> 8); }
        ps[32] = t; }
    __syncthreads();
}
DI void ph_gather(const Frame& F, const Args& a, int l) {
    LAS int* ps = (LAS int*)(F.lds + RING_OFF); moe_prefix(F, l, ps);
    if (F.vcu == 0 && F.tid < NEXP) { int* TE = (int*)(a.ws + WS_TILES); const int e = F.tid; const int t0 = ps[e] >> 8, t1 = (e == NEXP - 1 ? ps[32] : ps[e + 1] >> 8);
        for (int t = t0; t < t1; ++t) TE[t] = e; if (e == 0) TE[127] = ps[32]; }
    const float* H = (const float*)(a.ws + WS_H); const float* nw = a.in[3] + (size_t)l * DM; unsigned* TI = (unsigned*)(a.ws + WS_TOKINFO); bf16* XG = (bf16*)(a.ws + WS_SCR + SC_XG);
    const int lane = F.lane;
    for (int r = F.gw; r < TT; r += F.NGW) {
        unsigned* t = TI + (size_t)r * 8; const int g0 = ps[t[0]] + (int)t[1], g1 = ps[t[3]] + (int)t[4]; const float rs = __uint_as_float(t[6]);
        if (lane == 0) { t[1] = (unsigned)g0; t[4] = (unsigned)g1; }
        const float* hr = H + (size_t)r * DM;
#pragma unroll
        for (int j = 0; j < 4; ++j) { const int e0 = (lane + 64 * j) * 8; const f32x4 x0 = *(const f32x4*)(hr + e0), x1 = *(const f32x4*)(hr + e0 + 4), w0 = *(const f32x4*)(nw + e0), w1 = *(const f32x4*)(nw + e0 + 4);
            v4u o; o.x = pk2(x0.x * rs * w0.x, x0.y * rs * w0.y); o.y = pk2(x0.z * rs * w0.z, x0.w * rs * w0.w); o.z = pk2(x1.x * rs * w1.x, x1.y * rs * w1.y); o.w = pk2(x1.z * rs * w1.z, x1.w * rs * w1.w);
            *(v4u*)(XG + (size_t)g0 * DM + e0) = o; *(v4u*)(XG + (size_t)g1 * DM + e0) = o; }
    }
}
DI void ph_combine(const Frame& F, const Args& a, int l) {
    float* H = (float*)(a.ws + WS_H); const unsigned* TI = (const unsigned*)(a.ws + WS_TOKINFO); const bf16* YB = (const bf16*)(a.ws + WS_SCR + SC_YB); bf16* HN = (bf16*)(a.ws + WS_HN);
    const int lane = F.lane; const int nrows = l == 0 ? TT : TX;
    for (int r = F.gw; r < nrows; r += F.NGW) {
        const unsigned* t = TI + (size_t)r * 8; const int g0 = (int)t[1], g1 = (int)t[4]; const float w0 = __uint_as_float(t[2]), w1 = __uint_as_float(t[5]);
        float* hr = H + (size_t)r * DM; float hv[32]; float s = 0.f;
#pragma unroll
        for (int j = 0; j < 4; ++j) { const int e0 = (lane + 64 * j) * 8; const f32x4 x0 = *(const f32x4*)(hr + e0), x1 = *(const f32x4*)(hr + e0 + 4);
            const v4u ya = *(const v4u*)(YB + (size_t)g0 * DM + e0), yc = *(const v4u*)(YB + (size_t)g1 * DM + e0);
            float* o = hv + 8 * j;
            o[0] = x0.x + w0 * bflo(ya.x) + w1 * bflo(yc.x); o[1] = x0.y + w0 * bfhi(ya.x) + w1 * bfhi(yc.x); o[2] = x0.z + w0 * bflo(ya.y) + w1 * bflo(yc.y); o[3] = x0.w + w0 * bfhi(ya.y) + w1 * bfhi(yc.y);
            o[4] = x1.x + w0 * bflo(ya.z) + w1 * bflo(yc.z); o[5] = x1.y + w0 * bfhi(ya.z) + w1 * bfhi(yc.z); o[6] = x1.z + w0 * bflo(ya.w) + w1 * bflo(yc.w); o[7] = x1.w + w0 * bfhi(ya.w) + w1 * bfhi(yc.w);
#pragma unroll
            for (int q = 0; q < 8; ++q) s += o[q] * o[q]; }
        const float rs = 1.0f / sqrtf(wave_sum(s) * (1.0f / DM) + NORM_EPS);
        if (l == 0) { const float* nw = a.in[2] + DM;
#pragma unroll
            for (int j = 0; j < 4; ++j) { const int e0 = (lane + 64 * j) * 8; const float* o = hv + 8 * j; const f32x4 wa = *(const f32x4*)(nw + e0), wb = *(const f32x4*)(nw + e0 + 4);
                *(f32x4*)(hr + e0) = (f32x4){o[0], o[1], o[2], o[3]}; *(f32x4*)(hr + e0 + 4) = (f32x4){o[4], o[5], o[6], o[7]};
                v4u p; p.x = pk2(o[0] * rs * wa.x, o[1] * rs * wa.y); p.y = pk2(o[2] * rs * wa.z, o[3] * rs * wa.w); p.z = pk2(o[4] * rs * wb.x, o[5] * rs * wb.y); p.w = pk2(o[6] * rs * wb.z, o[7] * rs * wb.w);
                *(v4u*)(HN + (size_t)r * DM + e0) = p; }
        } else { const float* nw = a.in[4]; float* orow = a.out + (size_t)r * DM;
#ifdef PROBE_TS
            { const unsigned long long* ts = (const unsigned long long*)(F.ctl + CW_TS); const float dt_us = (float)(__hip_atomic_load(ts + PROBE_TS + 1, RLX_AGENT) - __hip_atomic_load(ts + PROBE_TS, RLX_AGENT)) * 0.01f;
#pragma unroll
              for (int q = 0; q < 32; ++q) hv[q] *= 1.0f + dt_us * 0.01f; }
#endif
#pragma unroll
            for (int j = 0; j < 4; ++j) { const int e0 = (lane + 64 * j) * 8; const float* o = hv + 8 * j; const f32x4 wa = *(const f32x4*)(nw + e0), wb = *(const f32x4*)(nw + e0 + 4);
                *(f32x4*)(orow + e0) = (f32x4){o[0] * rs * wa.x, o[1] * rs * wa.y, o[2] * rs * wa.z, o[3] * rs * wa.w};
                *(f32x4*)(orow + e0 + 4) = (f32x4){o[4] * rs * wb.x, o[5] * rs * wb.y, o[6] * rs * wb.z, o[7] * rs * wb.w}; } }
    }
}

DI void ph_odd_prep(const Frame& F, const Args& a) {
    const bf16* P = (const bf16*)(a.ws + WS_PROJ); bf16* QN = (bf16*)(a.ws + WS_SCR + SC_QN); bf16* KN = (bf16*)(a.ws + WS_SCR + SC_KN); bf16* VC = (bf16*)(a.ws + WS_SCR + SC_VC);
    float* BETA = (float*)(a.ws + WS_SCR + SC_BETA); float* GG = (float*)(a.ws + WS_SCR + SC_G);
    const float* cw = a.in[26]; const int lane = F.lane;
    for (int item = F.gw; item < (TT / 8) * 16; item += F.NGW) { const int pb = item >> 4, i = item & 15, ch = i * 512 + lane * 8, p0 = pb * 8;
        f32x4 w[4][2];
#pragma unroll
        for (int j = 0; j < 4; ++j) { w[j][0] = *(const f32x4*)(cw + j * 8192 + ch); w[j][1] = *(const f32x4*)(cw + j * 8192 + ch + 4); }
        v4u x[11];
#pragma unroll
        for (int q = 0; q < 11; ++q) { const int p = p0 - 3 + q; x[q] = *(const v4u*)(P + (size_t)pos_row(p > 0 ? p : 0) * OD_NP + ch); if (p < 0) x[q] = (v4u){0u, 0u, 0u, 0u}; }
#pragma unroll
        for (int o = 0; o < 8; ++o) { const int r = pos_row(p0 + o); float acc[8] = {0.f, 0.f, 0.f, 0.f, 0.f, 0.f, 0.f, 0.f};
#pragma unroll
            for (int j = 0; j < 4; ++j) { const v4u xv = x[o + j];
                acc[0] += w[j][0].x * bflo(xv.x); acc[1] += w[j][0].y * bfhi(xv.x); acc[2] += w[j][0].z * bflo(xv.y); acc[3] += w[j][0].w * bfhi(xv.y);
                acc[4] += w[j][1].x * bflo(xv.z); acc[5] += w[j][1].y * bfhi(xv.z); acc[6] += w[j][1].z * bflo(xv.w); acc[7] += w[j][1].w * bfhi(xv.w); }
            float ss = 0.f;
#pragma unroll
            for (int q = 0; q < 8; ++q) { acc[q] = acc[q] * sigm(acc[q]); ss += acc[q] * acc[q]; }
            float sc = 1.0f;
            if (i < 8) { ss += __shfl_xor(ss, 1); ss += __shfl_xor(ss, 2); ss += __shfl_xor(ss, 4); ss += __shfl_xor(ss, 8);
                sc = (1.0f / sqrtf(ss + NORM_EPS)) * (i < 4 ? 0.08838834764831845f : 1.0f); }
            const v4u ov = (v4u){pk2(acc[0] * sc, acc[1] * sc), pk2(acc[2] * sc, acc[3] * sc), pk2(acc[4] * sc, acc[5] * sc), pk2(acc[6] * sc, acc[7] * sc)};
            bf16* dst = i < 4 ? QN + (size_t)r * 2048 + ch : (i < 8 ? KN + (size_t)r * 2048 + ch - 2048 : VC + (size_t)r * 4096 + ch - 4096);
            *(v4u*)dst = ov; }
        if (i == 0 && lane < 32) {
#pragma unroll
            for (int o = 0; o < 8; ++o) { const int r = pos_row(p0 + o); const float bb = bf2f(P[(size_t)r * OD_NP + OD_B + lane]), aa = bf2f(P[(size_t)r * OD_NP + OD_A + lane]);
                BETA[(size_t)r * 32 + lane] = sigm(bb); GG[(size_t)r * 32 + lane] = -__expf(a.in[27][lane]) * softplus(aa + a.in[28][lane]); } }
    }
}
DI void ph_odd_post(const Frame& F, const Args& a) {
    const bf16* P = (const bf16*)(a.ws + WS_PROJ); const bf16* O = (const bf16*)(a.ws + WS_SCR + SC_O); bf16* Y = (bf16*)(a.ws + WS_YMIX); const float* nw = a.in[29];
    const int lane = F.lane;
    for (int r = F.gw; r < TT; r += F.NGW) {
#pragma unroll 2
        for (int i = 0; i < 8; ++i) { const int ch = i * 512 + lane * 8; const v4u ow = *(const v4u*)(O + (size_t)r * 4096 + ch); const f32x4 o0 = (f32x4){bflo(ow.x), bfhi(ow.x), bflo(ow.y), bfhi(ow.y)}, o1 = (f32x4){bflo(ow.z), bfhi(ow.z), bflo(ow.w), bfhi(ow.w)};
            float ss = (o0.x * o0.x + o0.y * o0.y) + (o0.z * o0.z + o0.w * o0.w) + (o1.x * o1.x + o1.y * o1.y) + (o1.z * o1.z + o1.w * o1.w);
            ss += __shfl_xor(ss, 1); ss += __shfl_xor(ss, 2); ss += __shfl_xor(ss, 4); ss += __shfl_xor(ss, 8);
            const float rs = 1.0f / sqrtf(ss * (1.0f / 128.0f) + NORM_EPS);
            const v4u z = *(const v4u*)(P + (size_t)r * OD_NP + OD_Z + ch); const int c0 = ch & 127; const f32x4 w0 = *(const f32x4*)(nw + c0), w1 = *(const f32x4*)(nw + c0 + 4);
            const float zf[8] = {bflo(z.x), bfhi(z.x), bflo(z.y), bfhi(z.y), bflo(z.z), bfhi(z.z), bflo(z.w), bfhi(z.w)};
            const float of[8] = {o0.x * w0.x, o0.y * w0.y, o0.z * w0.z, o0.w * w0.w, o1.x * w1.x, o1.y * w1.y, o1.z * w1.z, o1.w * w1.w};
            float y[8];
#pragma unroll
            for (int q = 0; q < 8; ++q) y[q] = of[q] * rs * zf[q] * sigm(zf[q]);
            v4u p; p.x = pk2(y[0], y[1]); p.y = pk2(y[2], y[3]); p.z = pk2(y[4], y[5]); p.w = pk2(y[6], y[7]);
            *(v4u*)(Y + (size_t)r * 4096 + ch) = p; }
    }
}

typedef float f32x16 __attribute__((ext_vector_type(16)));
#define MFMA32(a, b, c) __builtin_amdgcn_mfma_f32_32x32x16_bf16((a), (b), (c), 0, 0, 0)
DI int crow(int reg, int h) { return (reg & 3) + 8 * (reg >> 2) + 4 * h; }
DI int chunk_row(int n, int c) { return n == 0 ? (c >= 48 ? TX + (c - 48) : -1) : 64 * (n - 1) + c; }
#ifndef GDN_NO_HELPER
#define GDN_NO_HELPER 0
#endif
constexpr int GDN_NCH = 129, GDN_UNITS = GDN_NCH * 32, GDN_KUNITS = GDN_NCH * 16, GC_STRIDE = 72;
constexpr size_t GD_WF = WS_MOEW, GD_UF = WS_MOEW + 65 * MiB, GD_IN = WS_MOEW + 130 * MiB, GD_GC = WS_MOEW + 163 * MiB, GD_KT = WS_HN, GD_QF = WS_YMIX, GD_SAVE = WS_SCR + 205 * MiB;
static_assert((size_t)GDN_UNITS * 16384 <= 65 * MiB && (size_t)GDN_UNITS * 8192 <= 33 * MiB && (size_t)GDN_KUNITS * 16384 <= 33 * MiB && GD_GC + (size_t)GDN_UNITS * GC_STRIDE * 4 <= WS_H, "gdn map");

DI void ph_gdn_chunk(const Frame& F, const Args& a, int n_lo, int n_hi, int side) {
    const bf16* QN = (const bf16*)(a.ws + WS_SCR + SC_QN); const bf16* KN = (const bf16*)(a.ws + WS_SCR + SC_KN); const bf16* VC = (const bf16*)(a.ws + WS_SCR + SC_VC);
    const float* BETA = (const float*)(a.ws + WS_SCR + SC_BETA); const float* GG = (const float*)(a.ws + WS_SCR + SC_G);
    bf16* WF = (bf16*)(a.ws + GD_WF); bf16* UF = (bf16*)(a.ws + GD_UF); bf16* INF = (bf16*)(a.ws + GD_IN); bf16* KTF = (bf16*)(a.ws + GD_KT); bf16* QF = (bf16*)(a.ws + GD_QF); float* GC = (float*)(a.ws + GD_GC);
    LAS unsigned char* L = F.lds + RING_OFF;
    LAS unsigned char* kS = L; LAS unsigned char* qS = L + 17408; LAS unsigned char* vS = L + 34816; LAS unsigned char* kbS = L + 52224;
    LAS float* Lm = (LAS float*)(L + 69632); LAS bf16* IS = (LAS bf16*)(L + 87040); LAS bf16* XS = (LAS bf16*)(L + 96256);
    LAS float* betaS = (LAS float*)(L + 130048); LAS float* gcS = betaS + 64; LAS float* egcS = betaS + 128;
    LAS unsigned char* Lb = L + 17408; LAS unsigned char* TDs = L + 26624; LAS unsigned char* YT0 = L + 28672; LAS unsigned char* XT0 = L + 130816;
    static_assert(130816 + 8 * 1792 <= LDSCTL_OFF, "gdn lds map");
    const int tid = F.tid, lane = F.lane, wave = F.wave, l31 = lane & 31, h = lane >> 5;
    int widx = F.vcu, wcnt = F.G;
    if (side) { if (F.G == 256) { const int wx = F.vcu & 31; if (wx < 20) return; widx = (F.vcu >> 5) * 12 + (wx - 20); wcnt = 96; } else { if (F.vcu < 128 || F.G <= 128) return; widx = F.vcu - 128; wcnt = F.G - 128; } }
    for (int unit = n_lo * 32 + widx; unit < n_hi * 32; unit += wcnt) {
        const int n = unit >> 5, hv = unit & 31, hk = hv >> 1; const size_t su = (size_t)hv * GDN_NCH + n;
#pragma unroll
        for (int i = 0; i < 2; ++i) { const int p = tid + 512 * i, row = p >> 4, ch = p & 15; const int rr = chunk_row(n, row);
            v4u kx = (v4u){0u, 0u, 0u, 0u}, qx = kx, vx = kx;
            if (rr >= 0) { kx = *(const v4u*)(KN + (size_t)rr * 2048 + hk * 128 + ch * 8); qx = *(const v4u*)(QN + (size_t)rr * 2048 + hk * 128 + ch * 8); vx = *(const v4u*)(VC + (size_t)rr * 4096 + hv * 128 + ch * 8); }
            *(LAS v4u*)(kS + row * 272 + ch * 16) = kx; *(LAS v4u*)(qS + row * 272 + ch * 16) = qx; *(LAS v4u*)(vS + row * 272 + ch * 16) = vx; }
        if (wave == 0) { const int rr = chunk_row(n, lane); float b = 0.f, g = 0.f; if (rr >= 0) { b = BETA[(size_t)rr * 32 + hv]; g = GG[(size_t)rr * 32 + hv]; }
#pragma unroll
            for (int o = 1; o < 64; o <<= 1) { const float t = __shfl_up(g, o); if (lane >= o) g += t; }
            betaS[lane] = b; gcS[lane] = g; egcS[lane] = __expf(g); }
        __syncthreads();
        if ((hv & 1) == 0) { const size_t kunit = (size_t)hk * GDN_NCH + n;
#pragma unroll
            for (int i = 0; i < 2; ++i) { const int p = tid + 512 * i, comb = p >> 6, ln = p & 63, t = comb >> 3, s = comb & 7; const int c = 32 * t + (ln & 31), k0 = 16 * s + 8 * (ln >> 5);
                *(v4u*)(QF + (kunit * 16 + comb) * 512 + ln * 8) = *(const LAS v4u*)(qS + c * 272 + k0 * 2); } }
#pragma unroll
        for (int i = 0; i < 2; ++i) { const int p = tid + 512 * i, row = p >> 4, ch = p & 15; const v4u kx = *(const LAS v4u*)(kS + row * 272 + ch * 16); const float b = betaS[row];
            v4u o; o.x = pk2(bflo(kx.x) * b, bfhi(kx.x) * b); o.y = pk2(bflo(kx.y) * b, bfhi(kx.y) * b); o.z = pk2(bflo(kx.z) * b, bfhi(kx.z) * b); o.w = pk2(bflo(kx.w) * b, bfhi(kx.w) * b);
            *(LAS v4u*)(kbS + row * 272 + ch * 16) = o; }
        __syncthreads();
        { const int which = wave >> 2, ti = (wave >> 1) & 1, tj = wave & 1;
          f32x16 acc;
#pragma unroll
          for (int r = 0; r < 16; ++r) acc[r] = 0.f;
          if (!(ti == 0 && tj == 1)) { const LAS unsigned char* Ab = (which == 0 ? kbS : qS) + (32 * ti + l31) * 272 + 16 * h; const LAS unsigned char* Bb = kS + (32 * tj + l31) * 272 + 16 * h;
#pragma unroll
              for (int s = 0; s < 8; ++s) acc = MFMA32(*(const LAS bf16x8*)(Ab + 32 * s), *(const LAS bf16x8*)(Bb + 32 * s), acc); }
          const int j = 32 * tj + l31; const float gj = gcS[j];
#pragma unroll
          for (int r = 0; r < 16; ++r) { const int i = 32 * ti + crow(r, h); const float e = __expf(fminf(gcS[i] - gj, 0.f));
              if (which == 0) Lm[i * 68 + j] = i > j ? acc[r] * e : 0.f;
              else IS[i * 72 + j] = (bf16)f2bf(i >= j ? acc[r] * e : 0.f); } }
        __syncthreads();
#pragma unroll
        for (int i = 0; i < 8; ++i) { const int e = tid + 512 * i, r = e >> 6, c = e & 63; *(LAS bf16*)(Lb + r * 144 + c * 2) = (bf16)f2bf(Lm[r * 68 + c]); }
        if (wave == 0) { const int b = lane >> 4, c = lane & 15; float t[16]; const LAS float* Ld = Lm + (16 * b) * 68 + 16 * b;
#pragma unroll
            for (int i = 0; i < 16; ++i) { float acc = i == c ? 1.f : 0.f;
#pragma unroll
                for (int j = 0; j < i; ++j) acc -= Ld[i * 68 + j] * t[j];
                t[i] = acc; *(LAS bf16*)(TDs + (b * 16 + i) * 32 + c * 2) = (bf16)f2bf(acc); }
        } else if (wave >= 4) { const int t2 = tid - 256;
#pragma unroll
            for (int i = 0; i < 2; ++i) { const int p = t2 + 256 * i, comb = p >> 6, ln = p & 63, t = comb >> 2, s = comb & 3; const int c = 32 * t + (ln & 31), j0 = 16 * s + 8 * (ln >> 5);
                *(v4u*)(INF + (su * 8 + comb) * 512 + ln * 8) = *(const LAS v4u*)(IS + c * 72 + j0); }
            if ((hv & 1) == 0) { const size_t kunit = (size_t)hk * GDN_NCH + n;
#pragma unroll
                for (int i = 0; i < 4; ++i) { const int p = t2 + 256 * i, comb = p >> 6, ln = p & 63, kt = comb >> 2, s = comb & 3; const int kd = 32 * kt + (ln & 31), c0 = 16 * s + 8 * (ln >> 5);
                    unsigned w[4];
#pragma unroll
                    for (int jj = 0; jj < 4; ++jj) { const unsigned lo = *(const LAS bf16*)(kS + (c0 + 2 * jj) * 272 + kd * 2), hi = *(const LAS bf16*)(kS + (c0 + 2 * jj + 1) * 272 + kd * 2); w[jj] = lo | (hi << 16); }
                    *(v4u*)(KTF + (kunit * 16 + comb) * 512 + ln * 8) = (v4u){w[0], w[1], w[2], w[3]}; } }
            if (t2 < 64) GC[su * GC_STRIDE + t2] = gcS[t2];
            else if (t2 == 64) GC[su * GC_STRIDE + 64] = gcS[63];
            else if (t2 == 65) GC[su * GC_STRIDE + 65] = egcS[63];
        }
        __syncthreads();
        { const int quad = lane >> 4, lc = lane & 15; LAS unsigned char* XTw = XT0 + wave * 1792; LAS unsigned char* YTw = YT0 + wave * 768;
          const bf16x8 z8 = (bf16x8){0, 0, 0, 0, 0, 0, 0, 0}; const f32x4 z4 = (f32x4){0.f, 0.f, 0.f, 0.f};
          bf16x8 tdf[4];
#pragma unroll
          for (int b = 0; b < 4; ++b) tdf[b] = quad < 2 ? *(const LAS bf16x8*)(TDs + (b * 16 + lc) * 32 + quad * 16) : z8;
#pragma unroll 1
          for (int tl = 0; tl < 2; ++tl) { const int col = 32 * wave + 16 * tl + lc;
              const LAS unsigned char* rz = wave < 4 ? vS + col * 2 : kbS + (col - 128) * 2; const LAS float* bz = wave < 4 ? betaS : egcS;
#pragma unroll
              for (int b = 0; b < 4; ++b) { f32x4 y;
#pragma unroll
                  for (int r = 0; r < 4; ++r) { const int i = 16 * b + 4 * quad + r; y[r] = bf2f(*(const LAS bf16*)(rz + i * 272)) * bz[i]; }
                  if (b >= 1) { f32x4 p = z4;
#pragma unroll
                      for (int kk = 0; kk < (b >= 3 ? 2 : 1); ++kk) { const bf16x8 af = *(const LAS bf16x8*)(Lb + (16 * b + lc) * 144 + (32 * kk + 8 * quad) * 2);
                          const bf16x8 bfv = (32 * kk + 8 * quad < 16 * b) ? *(const LAS bf16x8*)(XTw + lc * 112 + (32 * kk + 8 * quad) * 2) : z8;
                          p = __builtin_amdgcn_mfma_f32_16x16x32_bf16(af, bfv, p, 0, 0, 0); }
                      y = y - p; }
                  *(LAS v2u*)(YTw + lc * 48 + quad * 8) = (v2u){pk2(y[0], y[1]), pk2(y[2], y[3])};
                  asm volatile("" ::: "memory");
                  const bf16x8 yb = quad < 2 ? *(const LAS bf16x8*)(YTw + lc * 48 + quad * 16) : z8;
                  const f32x4 x = __builtin_amdgcn_mfma_f32_16x16x32_bf16(tdf[b], yb, z4, 0, 0, 0);
                  if (b < 3) *(LAS v2u*)(XTw + lc * 112 + (16 * b + 4 * quad) * 2) = (v2u){pk2(x[0], x[1]), pk2(x[2], x[3])};
                  asm volatile("" ::: "memory");
#pragma unroll
                  for (int r = 0; r < 4; ++r) XS[(16 * b + 4 * quad + r) * 264 + col] = (bf16)f2bf(x[r]); } } }
        __syncthreads();
#pragma unroll
        for (int i = 0; i < 2; ++i) { const int p = tid + 512 * i, comb = p >> 6, ln = p & 63, t = comb >> 3, s = comb & 7; const int c = 32 * t + (ln & 31), k0 = 16 * s + 8 * (ln >> 5);
            *(v4u*)(WF + (su * 16 + comb) * 512 + ln * 8) = *(const LAS v4u*)(XS + c * 264 + 128 + k0); }
        { const int t = wave >> 2, ns = wave & 3; unsigned w[8];
#pragma unroll
          for (int r = 0; r < 8; ++r) { const unsigned lo = XS[(32 * t + crow(2 * r, h)) * 264 + 32 * ns + l31], hi = XS[(32 * t + crow(2 * r + 1, h)) * 264 + 32 * ns + l31]; w[r] = lo | (hi << 16); }
          bf16* dst = UF + ((su * 8 + wave) * 64 + lane) * 16; *(v4u*)dst = (v4u){w[0], w[1], w[2], w[3]}; *(v4u*)(dst + 8) = (v4u){w[4], w[5], w[6], w[7]}; }
        __syncthreads();
    }
}

DI void ph_gdn_chain(const Frame& F, const Args& a, int n_lo, int n_hi) {
    const int xg = F.vcu >> 5, wx = F.vcu & 31; if (F.G != 256 ? F.vcu >= 128 : wx >= 20) return;
    const bool helper = F.G == 256 && wx >= 16;
    const int hv = F.G == 256 ? 4 * xg + (helper ? wx - 16 : wx >> 2) : F.vcu >> 2, ns = F.G == 256 ? wx & 3 : F.vcu & 3, hk = hv >> 1;
    const bf16* QN = (const bf16*)(a.ws + WS_SCR + SC_QN);
    const bf16* WF = (const bf16*)(a.ws + GD_WF); const bf16* UF = (const bf16*)(a.ws + GD_UF); const bf16* INF = (const bf16*)(a.ws + GD_IN); const bf16* KTF = (const bf16*)(a.ws + GD_KT); const bf16* QF = (const bf16*)(a.ws + GD_QF); const float* GC = (const float*)(a.ws + GD_GC);
    bf16* O = (bf16*)(a.ws + WS_SCR + SC_O);
    gu32* prog = F.ctl + CW_PROG + hv * 16;
    if (helper && GDN_NO_HELPER) return;
    if (helper) { unsigned sink = 0u; const int tid = F.tid;
        for (int n0 = n_lo; n0 < n_hi; n0 += 4) {
            if (n0 >= n_lo + 8) { if (tid == 0) { unsigned sp = 0; while ((int)__hip_atomic_load(prog, RLX_AGENT) < n0 - 4 && ++sp < 20000u) __builtin_amdgcn_s_sleep(8); } __syncthreads(); }
            unsigned v[5];
#pragma unroll
            for (int i = 0; i < 5; ++i) { const int li = tid + 512 * i;
                const int st = li / 580, ln = li % 580, n = n0 + st; const unsigned* p = nullptr;
                if (st < 4 && n < n_hi) { const size_t unit = (size_t)hv * GDN_NCH + n, kunit = (size_t)hk * GDN_NCH + n;
                    if (ln < 128) p = (const unsigned*)(WF + unit * 8192 + ln * 64);
                    else if (ln < 256) p = (const unsigned*)(UF + unit * 8192 + (ln - 128) * 64);
                    else if (ln < 320) p = (const unsigned*)(INF + unit * 4096 + (ln - 256) * 64);
                    else if (ln < 448) p = (const unsigned*)(KTF + kunit * 8192 + (ln - 320) * 64);
                    else if (ln < 576) p = (const unsigned*)(QF + kunit * 8192 + (ln - 448) * 64);
                    else if (ln < 579) p = (const unsigned*)(GC + unit * GC_STRIDE + (ln - 576) * 32); }
                v[i] = p ? *p : 0u; }
#pragma unroll
            for (int i = 0; i < 5; ++i) sink += v[i];
        }
        if (sink == 0x12345u) __hip_atomic_store(F.ctl + CW_TMO + 2, sink, RLX_AGENT);
        return; }
    LAS unsigned char* ST = F.lds + RING_OFF; LAS unsigned char* VN = ST + 8704; LAS unsigned char* VND = ST + 13312;
    const int lane = F.lane, wave = F.wave, l31 = lane & 31, h = lane >> 5;
    for (int i = F.tid; i < 8704 / 4; i += NWAVES * 64) ((LAS unsigned*)ST)[i] = 0u;
#define GDN_BAR() do { asm volatile("s_waitcnt lgkmcnt(0)" ::: "memory"); __builtin_amdgcn_s_barrier(); asm volatile("" ::: "memory"); } while (0)
    GDN_BAR();
    f32x16 S;
#pragma unroll
    for (int r = 0; r < 16; ++r) S[r] = 0.f;
    const int role = wave < 2 ? 0 : (wave < 4 ? 1 : 2); const int t = wave & 1, kt = wave & 3;
    bf16x8 A8[8]; bf16x8 A4[4]; v4u U0 = (v4u){0u, 0u, 0u, 0u}, U1 = U0; f32x4 G4[4]; float gl = 0.f, egl = 1.f;
#pragma unroll
    for (int s = 0; s < 8; ++s) A8[s] = (bf16x8){0, 0, 0, 0, 0, 0, 0, 0};
#pragma unroll
    for (int s = 0; s < 4; ++s) { A4[s] = (bf16x8){0, 0, 0, 0, 0, 0, 0, 0}; G4[s] = (f32x4){0.f, 0.f, 0.f, 0.f}; }
#define GDN_LOAD(nn) do { const size_t unit_ = (size_t)hv * GDN_NCH + (nn); const float* gc_ = GC + unit_ * GC_STRIDE; \
        if (role == 0) { \
            const bf16* up_ = UF + (((unit_ * 2 + t) * 4 + ns) * 64 + lane) * 16; U0 = *(const v4u*)up_; U1 = *(const v4u*)(up_ + 8); \
            _Pragma("unroll") for (int g = 0; g < 4; ++g) G4[g] = *(const f32x4*)(gc_ + 32 * t + 8 * g + 4 * h); gl = gc_[64]; } \
        else if (role == 1) { const size_t qunit_ = (size_t)hk * GDN_NCH + (nn); \
            _Pragma("unroll") for (int s = 0; s < 4; ++s) A4[s] = *(const bf16x8*)(INF + ((unit_ * 2 + t) * 4 + s) * 512 + lane * 8); \
            _Pragma("unroll") for (int g = 0; g < 4; ++g) G4[g] = *(const f32x4*)(gc_ + 32 * t + 8 * g + 4 * h); } \
        else { const size_t kunit_ = (size_t)hk * GDN_NCH + (nn); \
            _Pragma("unroll") for (int s = 0; s < 4; ++s) A4[s] = *(const bf16x8*)(KTF + ((kunit_ * 4 + kt) * 4 + s) * 512 + lane * 8); egl = gc_[65]; } } while (0)
    float* SV = (float*)(a.ws + GD_SAVE) + ((size_t)((hv * 4 + ns) * 4 + kt) * 64 + lane) * 16;
    if (n_lo > 0 && role == 2) {
#pragma unroll
        for (int g = 0; g < 4; ++g) { const f32x4 v = *(const f32x4*)(SV + 4 * g); S[4 * g] = v.x; S[4 * g + 1] = v.y; S[4 * g + 2] = v.z; S[4 * g + 3] = v.w;
            *(LAS v2u*)(ST + l31 * 272 + (32 * kt + 8 * g + 4 * h) * 2) = (v2u){pk2(v.x, v.y), pk2(v.z, v.w)}; }
    }
    GDN_BAR();
#define GDN_LOADA(AC, nn) do { if (role == 0) { const size_t u_ = (size_t)hv * GDN_NCH + (nn); _Pragma("unroll") for (int s = 0; s < 8; ++s) AC[s] = *(const bf16x8*)(WF + ((u_ * 2 + t) * 8 + s) * 512 + lane * 8); } \
        else if (role == 1) { const size_t q_ = (size_t)hk * GDN_NCH + (nn); _Pragma("unroll") for (int s = 0; s < 8; ++s) AC[s] = *(const bf16x8*)(QF + ((q_ * 2 + t) * 8 + s) * 512 + lane * 8); } } while (0)
    bf16x8 A8q[8];
#pragma unroll
    for (int s = 0; s < 8; ++s) A8q[s] = (bf16x8){0, 0, 0, 0, 0, 0, 0, 0};
    GDN_LOADA(A8, n_lo); if (n_lo + 1 < n_hi) GDN_LOADA(A8q, n_lo + 1);
    GDN_LOAD(n_lo);
#define GDN_STEP(n, AC) do { \
        bf16x8 a4[4]; const v4u u0 = U0, u1 = U1; f32x4 g4[4]; const float cgl = gl, cegl = egl; \
        _Pragma("unroll") \
        for (int s = 0; s < 4; ++s) { a4[s] = A4[s]; g4[s] = G4[s]; } \
        if (n + 1 < n_hi) GDN_LOAD(n + 1); \
        if (ns == 0 && F.tid == 0) __hip_atomic_store(prog, (unsigned)n, RLX_AGENT); \
        f32x16 acc; \
        _Pragma("unroll") \
        for (int r = 0; r < 16; ++r) acc[r] = 0.f; \
        if (role < 2) { \
        _Pragma("unroll") \
            for (int s = 0; s < 8; ++s) acc = MFMA32(AC[s], *(const LAS bf16x8*)(ST + l31 * 272 + 32 * s + 16 * h), acc); \
            asm volatile("" :: "v"(acc[0])); \
            if (n + 2 < n_hi) GDN_LOADA(AC, n + 2); \
        } \
        if (role == 0) { const unsigned uw[8] = {u0.x, u0.y, u0.z, u0.w, u1.x, u1.y, u1.z, u1.w}; \
        _Pragma("unroll") \
            for (int g = 0; g < 4; ++g) { float vn[4], vd[4]; \
        _Pragma("unroll") \
                for (int q = 0; q < 4; ++q) { const int r = 4 * g + q; const float uv = (r & 1) ? bfhi(uw[r >> 1]) : bflo(uw[r >> 1]); vn[q] = uv - acc[r]; vd[q] = vn[q] * __expf(cgl - g4[g][q]); } \
                *(LAS v2u*)(VN + l31 * 144 + (32 * t + 8 * g + 4 * h) * 2) = (v2u){pk2(vn[0], vn[1]), pk2(vn[2], vn[3])}; \
                *(LAS v2u*)(VND + l31 * 144 + (32 * t + 8 * g + 4 * h) * 2) = (v2u){pk2(vd[0], vd[1]), pk2(vd[2], vd[3])}; } \
        } else if (role == 1) { \
        _Pragma("unroll") \
            for (int g = 0; g < 4; ++g) \
        _Pragma("unroll") \
                for (int q = 0; q < 4; ++q) acc[4 * g + q] *= __expf(g4[g][q]); \
        } \
        GDN_BAR(); \
        if (role == 1) { \
        _Pragma("unroll") \
            for (int s = 0; s < 4; ++s) acc = MFMA32(a4[s], *(const LAS bf16x8*)(VN + l31 * 144 + 32 * s + 16 * h), acc); \
        _Pragma("unroll") \
            for (int r = 0; r < 16; ++r) { const int rr = chunk_row(n, 32 * t + crow(r, h)); if (rr >= 0) O[(size_t)rr * 4096 + hv * 128 + 32 * ns + l31] = (bf16)f2bf(acc[r]); } \
        } else if (role == 2) { \
        _Pragma("unroll") \
            for (int r = 0; r < 16; ++r) S[r] *= cegl; \
        _Pragma("unroll") \
            for (int s = 0; s < 4; ++s) S = MFMA32(a4[s], *(const LAS bf16x8*)(VND + l31 * 144 + 32 * s + 16 * h), S); \
        _Pragma("unroll") \
            for (int g = 0; g < 4; ++g) *(LAS v2u*)(ST + l31 * 272 + (32 * kt + 8 * g + 4 * h) * 2) = (v2u){pk2(S[4 * g], S[4 * g + 1]), pk2(S[4 * g + 2], S[4 * g + 3])}; \
        } \
        GDN_BAR(); \
    } while (0)
    for (int n2 = n_lo; n2 < n_hi; n2 += 2) { GDN_STEP(n2, A8); if (n2 + 1 < n_hi) GDN_STEP(n2 + 1, A8q); }
#undef GDN_STEP
#undef GDN_LOADA
    if (n_hi < GDN_NCH && role == 2) {
#pragma unroll
        for (int g = 0; g < 4; ++g) *(f32x4*)(SV + 4 * g) = (f32x4){S[4 * g], S[4 * g + 1], S[4 * g + 2], S[4 * g + 3]}; }
#undef GDN_LOAD
#undef GDN_BAR
}

constexpr int RW_NSC = 258, RW_UNITS = 129 * 16;
DI int sub_row(int sc, int t) { const int n = sc >> 1, sub = sc & 1; return n == 0 ? ((sub == 0 && t >= 16) ? TX + t - 16 : -1) : 64 * (n - 1) + 32 * sub + t; }
constexpr size_t RW_BASE = WS_PROJ + 92 * MiB;
constexpr size_t RW_RH = RW_BASE, RW_RL = RW_BASE + 33 * MiB, RW_GT = RW_BASE + 66 * MiB, RW_GAM = RW_BASE + 99 * MiB;
constexpr size_t RW_PR = WS_SCR + 195 * MiB, RW_AT = WS_SCR + 211 * MiB + 256 * 1024, RW_VTF = WS_SCR + 219 * MiB + 512 * 1024, RW_SALL = WS_SCR + 235 * MiB + 768 * 1024;
constexpr size_t RW_XSAVE = 1 * MiB + 640 * 1024;
constexpr size_t RW_VV = WS_YMIX + 34 * MiB, RW_BON = WS_YMIX + 52 * MiB, LR_H = WS_YMIX + 54 * MiB, LR_A = WS_YMIX + 56 * MiB, LR_C = WS_YMIX + 58 * MiB;
constexpr size_t RW_SCH = (size_t)RW_NSC * 16;
static_assert((size_t)MP * EV_NP * 2 <= 92 * MiB && RW_SCH * 8192 <= 33 * MiB && RW_GAM + RW_SCH * 256 <= WS_SCR, "rwkv map (proj region)");
static_assert(WS_SCR + SC_LIX + (size_t)MP * 4096 <= RW_PR && RW_PR + RW_SCH * 4096 <= RW_AT && RW_AT + RW_SCH * 2048 <= RW_VTF && RW_VTF + RW_SCH * 4096 <= RW_SALL && RW_SALL + RW_SCH * 8192 <= WS_END, "rwkv map (scratch region)");
static_assert((size_t)MP * DM * 2 <= 34 * MiB && RW_VV + (size_t)MP * 2048 <= RW_BON && RW_BON + (size_t)MP * 64 <= LR_H && LR_H + RW_SCH * 256 <= LR_A && LR_A + RW_SCH * 256 <= LR_C && LR_C + RW_SCH * 256 <= WS_PROJ, "rwkv map (ymix region)");

DI void sub_rows(int sc, int& t0, int& rbase) { if (sc >= 2) { t0 = 0; rbase = 64 * ((sc >> 1) - 1) + 32 * (sc & 1); } else if (sc == 0) { t0 = 16; rbase = TX - 16; } else { t0 = 32; rbase = 0; } }
DI void lru_local(const Frame& F, const Args& a) {
    const float* LA = (const float*)(a.ws + WS_SCR + SC_LA); const float* LIX = (const float*)(a.ws + WS_SCR + SC_LIX);
    float* HL = (float*)(a.ws + LR_H); float* AP = (float*)(a.ws + LR_A);
    for (int item = F.gw; item < RW_NSC * 16; item += F.NGW) { const int sc = item >> 4, c = (item & 15) * 64 + F.lane; int t0, rbase; sub_rows(sc, t0, rbase);
        float av[32], ix[32];
#pragma unroll
        for (int t = 0; t < 32; ++t) { const size_t o = (size_t)(rbase + (t >= t0 ? t : 32)) * 1024 + c; av[t] = LA[o]; ix[t] = LIX[o]; }
        float h = 0.f, p = 1.f;
#pragma unroll
        for (int t = 0; t < 32; ++t) { const float a_ = t >= t0 ? av[t] : 1.f, x_ = t >= t0 ? ix[t] : 0.f; h = a_ * h + sqrtf(fmaxf(1.0f - a_ * a_, 0.f)) * x_; p *= a_; }
        HL[sc * 1024 + c] = h; AP[sc * 1024 + c] = p; }
}
DI void lru_apply(const Frame& F, const Args& a) {
    const bf16* P = (const bf16*)(a.ws + WS_PROJ); const float* LA = (const float*)(a.ws + WS_SCR + SC_LA); const float* LIX = (const float*)(a.ws + WS_SCR + SC_LIX);
    const float* CR = (const float*)(a.ws + LR_C); bf16* Y = (bf16*)(a.ws + WS_YMIX);
    for (int item = F.gw; item < RW_NSC * 16; item += F.NGW) { const int sc = item >> 4, c = (item & 15) * 64 + F.lane; int t0, rbase; sub_rows(sc, t0, rbase); if (t0 >= 32) continue;
        float h = CR[sc * 1024 + c];
#pragma unroll
        for (int tb = 0; tb < 32; tb += 16) { float av[16], ix[16], gb[16];
#pragma unroll
            for (int t = 0; t < 16; ++t) { const size_t r_ = (size_t)(rbase + (tb + t >= t0 ? tb + t : 32)); av[t] = LA[r_ * 1024 + c]; ix[t] = LIX[r_ * 1024 + c]; gb[t] = bf2f(P[r_ * EV_NP + EV_GB + c]); }
#pragma unroll
            for (int t = 0; t < 16; ++t) { if (tb + t >= t0) { h = av[t] * h + sqrtf(fmaxf(1.0f - av[t] * av[t], 0.f)) * ix[t]; Y[(size_t)(rbase + tb + t) * DM + 1024 + c] = (bf16)f2bf(h * gelu_tanh(gb[t])); } } } }
}

DI void ph_rwkv_chunk(const Frame& F, const Args& a, int n_lo, int n_hi, int wg0) {
    if (F.vcu < wg0) return;
    const bf16* P = (const bf16*)(a.ws + WS_PROJ); const float* DEC = (const float*)(a.ws + WS_SCR + SC_DEC); const float* ICL = (const float*)(a.ws + WS_SCR + SC_ICL);
    bf16* RH = (bf16*)(a.ws + RW_RH); bf16* RL = (bf16*)(a.ws + RW_RL); bf16* GT = (bf16*)(a.ws + RW_GT); float* GAM = (float*)(a.ws + RW_GAM); bf16* PR = (bf16*)(a.ws + RW_PR); bf16* ATG = (bf16*)(a.ws + RW_AT); bf16* VTF = (bf16*)(a.ws + RW_VTF);
    bf16* VV = (bf16*)(a.ws + RW_VV); float* BON = (float*)(a.ws + RW_BON);
    LAS unsigned char* L = F.lds + RING_OFF;
    LAS float* wS = (LAS float*)L; LAS float* aS = wS + 4096; LAS float* bS = wS + 8192; LAS float* rS = wS + 12288; LAS float* kS = wS + 16384;
    LAS unsigned char* vT = L + 81920; LAS unsigned char* aT = L + 91136; LAS unsigned char* rT = L + 100352; LAS unsigned char* kT = L + 109568; LAS unsigned char* bT = L + 118784;
    LAS unsigned char* AT = L + 128000; LAS unsigned char* NT = L + 133120; LAS float* gam = (LAS float*)(L + 138240);
    LAS unsigned char* aTl = L; LAS unsigned char* bTl = L + 9216;
    const int tid = F.tid, lane = F.lane, wave = F.wave, l31 = lane & 31, h = lane >> 5;
    const float* mu = a.in[6];
    for (int unit = n_lo * 16 + (F.vcu - wg0); unit < n_hi * 16; unit += F.G - wg0) {
        const int n = unit >> 4, hd = unit & 15;
        { const int tok = tid >> 3, cg = tid & 7, c0 = hd * 64 + cg * 8; const int rr = sub_row(2 * n + (tok >> 5), tok & 31);
          float wv[8], av[8], bv[8], rv[8], kv[8], vv[8];
#pragma unroll
          for (int q = 0; q < 8; ++q) { wv[q] = 1.f; av[q] = 0.f; bv[q] = 0.f; rv[q] = 0.f; kv[q] = 0.f; vv[q] = 0.f; }
          if (rr >= 0) { const int pos = row_pos(rr); const bf16* cur = P + (size_t)rr * EV_NP + c0; const bf16* prv = pos > 0 ? P + (size_t)pos_row(pos - 1) * EV_NP + c0 : nullptr;
              const v4u z4 = (v4u){0u, 0u, 0u, 0u};
              const v4u cr = *(const v4u*)cur, ck = *(const v4u*)(cur + 1024), cv = *(const v4u*)(cur + 2048);
              const v4u qr = prv ? *(const v4u*)prv : z4, qk = prv ? *(const v4u*)(prv + 1024) : z4, qv = prv ? *(const v4u*)(prv + 2048) : z4;
              const unsigned crw[4] = {cr.x, cr.y, cr.z, cr.w}, ckw[4] = {ck.x, ck.y, ck.z, ck.w}, cvw[4] = {cv.x, cv.y, cv.z, cv.w}, qrw[4] = {qr.x, qr.y, qr.z, qr.w}, qkw[4] = {qk.x, qk.y, qk.z, qk.w}, qvw[4] = {qv.x, qv.y, qv.z, qv.w};
              float ss = 0.f, bon = 0.f; float kk[8], ic[8];
#pragma unroll
              for (int q = 0; q < 8; ++q) { const int c = c0 + q; const float crf = (q & 1) ? bfhi(crw[q >> 1]) : bflo(crw[q >> 1]), ckf = (q & 1) ? bfhi(ckw[q >> 1]) : bflo(ckw[q >> 1]), cvf = (q & 1) ? bfhi(cvw[q >> 1]) : bflo(cvw[q >> 1]);
                  const float prf = (q & 1) ? bfhi(qrw[q >> 1]) : bflo(qrw[q >> 1]), pkf = (q & 1) ? bfhi(qkw[q >> 1]) : bflo(qkw[q >> 1]), pvf = (q & 1) ? bfhi(qvw[q >> 1]) : bflo(qvw[q >> 1]);
                  rv[q] = crf + (prf - crf) * mu[c]; kk[q] = ckf + (pkf - ckf) * mu[1024 + c]; vv[q] = cvf + (pvf - cvf) * mu[2048 + c];
                  wv[q] = DEC[(size_t)rr * 1024 + c]; ic[q] = ICL[(size_t)rr * 1024 + c];
                  const float kkv = kk[q] * a.in[12][c]; av[q] = kkv; ss += kkv * kkv; kv[q] = kk[q] * (1.0f + (ic[q] - 1.0f) * a.in[13][c]); bon += rv[q] * kv[q] * a.in[14][c]; }
              ss += __shfl_xor(ss, 1); ss += __shfl_xor(ss, 2); ss += __shfl_xor(ss, 4); bon += __shfl_xor(bon, 1); bon += __shfl_xor(bon, 2); bon += __shfl_xor(bon, 4);
              const float inv = 1.0f / fmaxf(sqrtf(ss), 1e-12f);
#pragma unroll
              for (int q = 0; q < 8; ++q) { const float kkn = av[q] * inv; av[q] = -kkn; bv[q] = kkn * ic[q]; }
              if (cg == 0) BON[(size_t)rr * 16 + hd] = bon;
              *(v4u*)(VV + (size_t)rr * 1024 + c0) = (v4u){pk2(vv[0], vv[1]), pk2(vv[2], vv[3]), pk2(vv[4], vv[5]), pk2(vv[6], vv[7])}; }
          const int o = tok * 64 + cg * 8;
          *(LAS f32x4*)(wS + o) = (f32x4){wv[0], wv[1], wv[2], wv[3]}; *(LAS f32x4*)(wS + o + 4) = (f32x4){wv[4], wv[5], wv[6], wv[7]};
          *(LAS f32x4*)(aS + o) = (f32x4){av[0], av[1], av[2], av[3]}; *(LAS f32x4*)(aS + o + 4) = (f32x4){av[4], av[5], av[6], av[7]};
          *(LAS f32x4*)(bS + o) = (f32x4){bv[0], bv[1], bv[2], bv[3]}; *(LAS f32x4*)(bS + o + 4) = (f32x4){bv[4], bv[5], bv[6], bv[7]};
          *(LAS f32x4*)(rS + o) = (f32x4){rv[0], rv[1], rv[2], rv[3]}; *(LAS f32x4*)(rS + o + 4) = (f32x4){rv[4], rv[5], rv[6], rv[7]};
          *(LAS f32x4*)(kS + o) = (f32x4){kv[0], kv[1], kv[2], kv[3]}; *(LAS f32x4*)(kS + o + 4) = (f32x4){kv[4], kv[5], kv[6], kv[7]};
#pragma unroll
          for (int q = 0; q < 8; ++q) *(LAS bf16*)(vT + (cg * 8 + q) * 144 + tok * 2) = (bf16)f2bf(vv[q]); }
        __syncthreads();
        { const int p = wave >> 2, sub = (wave >> 1) & 1, half = wave & 1, sl = lane >> 2, q = lane & 3, s = 16 * half + sl, tok = 32 * sub + s, jq = 16 * q;
          const LAS float* x0p = (p == 0 ? kS : bS) + tok * 64 + jq; LAS unsigned char* OUT = p == 0 ? AT : NT;
          float x[16];
#pragma unroll
          for (int j = 0; j < 16; j += 4) { const f32x4 t4 = *(const LAS f32x4*)(x0p + j); x[j] = t4.x; x[j + 1] = t4.y; x[j + 2] = t4.z; x[j + 3] = t4.w; }
          if (half) {
#pragma unroll
              for (int i = 0; i < 4; ++i) *(LAS bf16*)(OUT + ((sub * 32 + 4 * q + i) * 40 + s) * 2) = (bf16)0; }
#pragma unroll 2
          for (int tp = 16 * half; tp < 32; ++tp) { const LAS float* bp = wS + (32 * sub + tp) * 64 + jq; const bool run = tp > s;
              f32x4 a4[4], w4[4], b4[4], r4[4];
#pragma unroll
              for (int g = 0; g < 4; ++g) { a4[g] = *(const LAS f32x4*)(bp + 4096 + 4 * g); w4[g] = *(const LAS f32x4*)(bp + 4 * g); b4[g] = *(const LAS f32x4*)(bp + 8192 + 4 * g); r4[g] = *(const LAS f32x4*)(bp + 12288 + 4 * g); }
              float c = 0.f;
#pragma unroll
              for (int g = 0; g < 4; ++g) { c += x[4 * g] * a4[g].x; c += x[4 * g + 1] * a4[g].y; c += x[4 * g + 2] * a4[g].z; c += x[4 * g + 3] * a4[g].w; }
              c += __builtin_bit_cast(float, __builtin_amdgcn_mov_dpp(__builtin_bit_cast(int, c), 0xB1, 0xF, 0xF, true));
              c += __builtin_bit_cast(float, __builtin_amdgcn_mov_dpp(__builtin_bit_cast(int, c), 0x4E, 0xF, 0xF, true));
              float o = 0.f;
#pragma unroll
              for (int g = 0; g < 4; ++g) { const float n0 = x[4 * g] * w4[g].x + c * b4[g].x, n1 = x[4 * g + 1] * w4[g].y + c * b4[g].y, n2 = x[4 * g + 2] * w4[g].z + c * b4[g].z, n3 = x[4 * g + 3] * w4[g].w + c * b4[g].w;
                  x[4 * g] = run ? n0 : x[4 * g]; x[4 * g + 1] = run ? n1 : x[4 * g + 1]; x[4 * g + 2] = run ? n2 : x[4 * g + 2]; x[4 * g + 3] = run ? n3 : x[4 * g + 3];
                  o += x[4 * g] * r4[g].x; o += x[4 * g + 1] * r4[g].y; o += x[4 * g + 2] * r4[g].z; o += x[4 * g + 3] * r4[g].w; }
              o += __builtin_bit_cast(float, __builtin_amdgcn_mov_dpp(__builtin_bit_cast(int, o), 0xB1, 0xF, 0xF, true));
              o += __builtin_bit_cast(float, __builtin_amdgcn_mov_dpp(__builtin_bit_cast(int, o), 0x4E, 0xF, 0xF, true));
              if (q == 0) *(LAS bf16*)(OUT + ((sub * 32 + tp) * 40 + s) * 2) = (bf16)f2bf(tp >= s ? o : 0.f); }
          LAS unsigned char* XT = p == 0 ? kT : bT;
#pragma unroll
          for (int j = 0; j < 16; ++j) *(LAS bf16*)(XT + (jq + j) * 144 + tok * 2) = (bf16)f2bf(x[j]);
          const bool gwave = (p == 0 && half == 1); const int j = lane;
          if (gwave) { float g = 1.f;
#pragma unroll
              for (int tp = 0; tp < 32; ++tp) { const int tk = 32 * sub + tp; const float w_ = wS[tk * 64 + j], a_ = aS[tk * 64 + j], r_ = rS[tk * 64 + j];
                  *(LAS bf16*)(aT + j * 144 + tk * 2) = (bf16)f2bf(a_ * g);
                  g *= w_; *(LAS bf16*)(rT + j * 144 + tk * 2) = (bf16)f2bf(r_ * g); }
              gam[sub * 64 + j] = g; }
        }
        __syncthreads();
        { const int sub = wave >> 2, t1 = (wave >> 1) & 1, t0 = wave & 1; const size_t sch = (size_t)hd * RW_NSC + (2 * n + sub);
          { f32x16 acc;
#pragma unroll
            for (int r = 0; r < 16; ++r) acc[r] = 0.f;
#pragma unroll
            for (int ks = 0; ks < 2; ++ks) { const int ao = (32 * t1 + l31) * 144 + (32 * sub + 16 * ks + 8 * h) * 2, bo = (32 * t0 + l31) * 144 + (32 * sub + 16 * ks + 8 * h) * 2;
                acc = MFMA32(*(const LAS bf16x8*)(aT + ao), *(const LAS bf16x8*)(bT + bo), acc); }
            const int jp = 32 * t0 + l31;
#pragma unroll
            for (int g = 0; g < 4; ++g) *(v2u*)(RH + (sch * 64 + jp) * 64 + 32 * t1 + 8 * g + 4 * h) = (v2u){pk2(acc[4 * g], acc[4 * g + 1]), pk2(acc[4 * g + 2], acc[4 * g + 3])};
            if (t1 == 0 && t0 == 0) GAM[sch * 64 + lane] = gam[sub * 64 + lane]; }
          { f32x16 acc;
#pragma unroll
            for (int r = 0; r < 16; ++r) acc[r] = 0.f;
#pragma unroll
            for (int ks = 0; ks < 2; ++ks) acc = MFMA32(*(const LAS bf16x8*)(kT + (32 * t1 + l31) * 144 + (32 * sub + 16 * ks + 8 * h) * 2), *(const LAS bf16x8*)(vT + (32 * t0 + l31) * 144 + (32 * sub + 16 * ks + 8 * h) * 2), acc);
            bf16* dst = GT + ((sch * 4 + t1 * 2 + t0) * 64 + lane) * 16;
            *(v4u*)dst = (v4u){pk2(acc[0], acc[1]), pk2(acc[2], acc[3]), pk2(acc[4], acc[5]), pk2(acc[6], acc[7])}; *(v4u*)(dst + 8) = (v4u){pk2(acc[8], acc[9]), pk2(acc[10], acc[11]), pk2(acc[12], acc[13]), pk2(acc[14], acc[15])}; } }
        if (wave < 4) { const int sub = wave >> 1, jt = wave & 1; const size_t sch = (size_t)hd * RW_NSC + (2 * n + sub);
            f32x16 acc;
#pragma unroll
            for (int r = 0; r < 16; ++r) acc[r] = bf2f(*(const LAS bf16*)(rT + (32 * jt + crow(r, h)) * 144 + (32 * sub + l31) * 2));
#pragma unroll
            for (int ks = 0; ks < 2; ++ks) acc = MFMA32(*(const LAS bf16x8*)(aT + (32 * jt + l31) * 144 + (32 * sub + 16 * ks + 8 * h) * 2), *(const LAS bf16x8*)(NT + (sub * 32 + l31) * 80 + (16 * ks + 8 * h) * 2), acc);
#pragma unroll
            for (int g = 0; g < 4; ++g) *(v2u*)(PR + (sch * 32 + l31) * 64 + 32 * jt + 8 * g + 4 * h) = (v2u){pk2(acc[4 * g], acc[4 * g + 1]), pk2(acc[4 * g + 2], acc[4 * g + 3])};
        } else { const int t2 = tid - 256, sub = t2 >> 7, t = (t2 >> 2) & 31, s8 = (t2 & 3) * 8; const size_t sch = (size_t)hd * RW_NSC + (2 * n + sub);
            *(v4u*)(ATG + (sch * 32 + t) * 32 + s8) = *(const LAS v4u*)(AT + (sub * 32 + t) * 80 + s8 * 2); }
        { const int sub = tid >> 8, it = (tid >> 7) & 1, ks = (tid >> 6) & 1; const size_t sch = (size_t)hd * RW_NSC + (2 * n + sub);
          *(v4u*)(VTF + ((sch * 4 + it * 2 + ks) * 64 + lane) * 8) = *(const LAS v4u*)(vT + (32 * it + l31) * 144 + (32 * sub + 16 * ks + 8 * h) * 2); }
        __syncthreads();
    }
}

DI void ph_rwkv_chain(const Frame& F, const Args& a, int sc_lo, int sc_hi) {
    if (F.vcu >= 16 && F.vcu < 18) { if (sc_hi < RW_NSC) return; const int c = (F.vcu - 16) * 512 + F.tid; const float* HL = (const float*)(a.ws + LR_H); const float* AP = (const float*)(a.ws + LR_A); float* CR = (float*)(a.ws + LR_C);
        float carry = 0.f;
#pragma unroll 8
        for (int sc = 0; sc < RW_NSC; ++sc) { const float hl = HL[sc * 1024 + c], ap = AP[sc * 1024 + c]; CR[sc * 1024 + c] = carry; carry = ap * carry + hl; }
        return; }
    if (F.vcu >= 16) return;
    const int hd = F.vcu; const bf16* RH = (const bf16*)(a.ws + RW_RH); const bf16* RL = (const bf16*)(a.ws + RW_RL); const bf16* GT = (const bf16*)(a.ws + RW_GT); const float* GAM = (const float*)(a.ws + RW_GAM); bf16* SALL = (bf16*)(a.ws + RW_SALL);
    constexpr int RW_NS = 7, SLOT = 8192 + 8192 + 1024;
    LAS unsigned char* XS = F.lds + RING_OFF; LAS unsigned char* RG = XS + 2 * 9216;
    const int lane = F.lane, wave = F.wave, l31 = lane & 31, h = lane >> 5, jt = (wave >> 1) & 1, it = wave & 1, lw = wave & 3;
    for (int i = F.tid; i < 2 * 9216 / 4; i += NWAVES * 64) ((LAS unsigned*)XS)[i] = 0u;
    __syncthreads();
#define RW_BAR() do { asm volatile("s_waitcnt lgkmcnt(0)" ::: "memory"); __builtin_amdgcn_s_barrier(); asm volatile("" ::: "memory"); } while (0)
    const unsigned rg0 = (unsigned)(uintptr_t)RG;
    int offR[2], offG[2];
#pragma unroll
    for (int i = 0; i < 2; ++i) { const int b = 2 * lw + i, row = 8 * b + (lane >> 3), pc = lane & 7; offR[i] = row * 64 + ((pc ^ (row & 7)) * 8); offG[i] = (b * 64 + lane) * 8; }
    const int offM = (lane & 15) * 4;
#define RW_DMA(src, dst) do { unsigned keep_; asm volatile("s_mov_b32 %0, m0\n\ts_mov_b32 m0, %2\n\ts_nop 0\n\tglobal_load_lds_dwordx4 %1, off\n\ts_mov_b32 m0, %0" : "=&s"(keep_) : "v"(src), "s"(dst) : "memory"); } while (0)
#define RW_ISSUE(scn) do { const int s_ = (scn) < RW_NSC ? (scn) : RW_NSC - 1; const size_t sch_ = (size_t)hd * RW_NSC + s_; \
        const unsigned sb_ = (unsigned)__builtin_amdgcn_readfirstlane((int)(rg0 + (unsigned)((scn) % RW_NS) * SLOT)); \
        _Pragma("unroll") for (int i_ = 0; i_ < 2; ++i_) { const unsigned bo_ = (unsigned)__builtin_amdgcn_readfirstlane((2 * lw + i_) * 1024); \
            RW_DMA(RH + sch_ * 4096 + offR[i_], sb_ + bo_); RW_DMA(GT + sch_ * 4096 + offG[i_], sb_ + 8192 + bo_); } \
        RW_DMA(GAM + sch_ * 64 + offM, sb_ + 16384); } while (0)
#define RW_WAITV(n) asm volatile("s_waitcnt vmcnt(" #n ")" ::: "memory")
    f32x16 X;
#pragma unroll
    for (int r = 0; r < 16; ++r) X[r] = 0.f;
    float* XSV = (float*)(a.ws + RW_XSAVE) + ((size_t)(hd * 4 + (wave & 3)) * 64 + lane) * 16;
    if (wave < 4 && sc_lo > 0) {
#pragma unroll
        for (int g = 0; g < 4; ++g) { const f32x4 v = *(const f32x4*)(XSV + 4 * g); X[4 * g] = v.x; X[4 * g + 1] = v.y; X[4 * g + 2] = v.z; X[4 * g + 3] = v.w;
            *(LAS v2u*)(XS + (32 * it + l31) * 144 + (32 * jt + 8 * g + 4 * h) * 2) = (v2u){pk2(v.x, v.y), pk2(v.z, v.w)}; } }
    if (wave >= 4) { RW_ISSUE(sc_lo); RW_ISSUE(sc_lo + 1); RW_ISSUE(sc_lo + 2); RW_ISSUE(sc_lo + 3); RW_ISSUE(sc_lo + 4); RW_ISSUE(sc_lo + 5); RW_WAITV(25); }
    RW_BAR();
    for (int sc = sc_lo; sc < sc_hi; ++sc) {
        if (wave < 4) {
            const LAS unsigned char* sb = RG + (sc % RW_NS) * SLOT;
            f32x16 acc; const size_t sch = (size_t)hd * RW_NSC + sc;
            { const v4u g0 = *(const LAS v4u*)(sb + 8192 + ((jt * 2 + it) * 64 + lane) * 32), g1 = *(const LAS v4u*)(sb + 8192 + ((jt * 2 + it) * 64 + lane) * 32 + 16);
              const unsigned gw_[8] = {g0.x, g0.y, g0.z, g0.w, g1.x, g1.y, g1.z, g1.w};
#pragma unroll
              for (int g = 0; g < 4; ++g) { const f32x4 m = *(const LAS f32x4*)(sb + 16384 + (32 * jt + 8 * g + 4 * h) * 4);
                  acc[4 * g] = bflo(gw_[2 * g]) + m.x * X[4 * g]; acc[4 * g + 1] = bfhi(gw_[2 * g]) + m.y * X[4 * g + 1]; acc[4 * g + 2] = bflo(gw_[2 * g + 1]) + m.z * X[4 * g + 2]; acc[4 * g + 3] = bfhi(gw_[2 * g + 1]) + m.w * X[4 * g + 3]; } }
#pragma unroll
            for (int g = 0; g < 4; ++g) *(v2u*)(SALL + (sch * 64 + 32 * it + l31) * 64 + 32 * jt + 8 * g + 4 * h) = (v2u){pk2(X[4 * g], X[4 * g + 1]), pk2(X[4 * g + 2], X[4 * g + 3])};
            const LAS unsigned char* xb = XS + (sc & 1) * 9216 + (32 * it + l31) * 144 + 16 * h; const int ar = 32 * jt + l31; const LAS unsigned char* ab = sb + ar * 128;
#pragma unroll
            for (int ks = 0; ks < 4; ++ks) { const bf16x8 xf = *(const LAS bf16x8*)(xb + 32 * ks); const int po = (((2 * ks + h) ^ (ar & 7)) * 16);
                acc = MFMA32(*(const LAS bf16x8*)(ab + po), xf, acc); }
            X = acc;
            LAS unsigned char* xn = XS + ((sc + 1) & 1) * 9216 + (32 * it + l31) * 144;
#pragma unroll
            for (int g = 0; g < 4; ++g) *(LAS v2u*)(xn + (32 * jt + 8 * g + 4 * h) * 2) = (v2u){pk2(X[4 * g], X[4 * g + 1]), pk2(X[4 * g + 2], X[4 * g + 3])};
        } else {
            RW_ISSUE(sc + RW_NS - 1);
            RW_WAITV(25);
        }
        RW_BAR();
    }
    if (wave >= 4) RW_WAITV(0);
    else if (sc_hi < RW_NSC) {
#pragma unroll
        for (int g = 0; g < 4; ++g) *(f32x4*)(XSV + 4 * g) = (f32x4){X[4 * g], X[4 * g + 1], X[4 * g + 2], X[4 * g + 3]}; }
#undef RW_ISSUE
#undef RW_DMA
#undef RW_WAITV
#undef RW_BAR
}

DI void ph_rwkv_out(const Frame& F, const Args& a) {
    const bf16* SALL = (const bf16*)(a.ws + RW_SALL); const bf16* PR = (const bf16*)(a.ws + RW_PR); const bf16* ATG = (const bf16*)(a.ws + RW_AT); const bf16* VTF = (const bf16*)(a.ws + RW_VTF);
    const bf16* VV = (const bf16*)(a.ws + RW_VV); const float* BON = (const float*)(a.ws + RW_BON); const float* GATE = (const float*)(a.ws + WS_SCR + SC_GATE); bf16* Y = (bf16*)(a.ws + WS_YMIX);
    const int lane = F.lane, l31 = lane & 31, h = lane >> 5;
    for (int item = F.gw; item < RW_NSC * 16; item += F.NGW) { const int sc = item >> 4, hd = item & 15; if (sc == 1) continue;
        const size_t sch = (size_t)hd * RW_NSC + sc; f32x16 acc[2];
#pragma unroll
        for (int it = 0; it < 2; ++it) {
#pragma unroll
            for (int r = 0; r < 16; ++r) acc[it][r] = 0.f;
#pragma unroll
            for (int ks = 0; ks < 4; ++ks) acc[it] = MFMA32(*(const bf16x8*)(SALL + (sch * 64 + 32 * it + l31) * 64 + 16 * ks + 8 * h), *(const bf16x8*)(PR + (sch * 32 + l31) * 64 + 16 * ks + 8 * h), acc[it]);
#pragma unroll
            for (int ks = 0; ks < 2; ++ks) acc[it] = MFMA32(*(const bf16x8*)(VTF + ((sch * 4 + it * 2 + ks) * 64 + lane) * 8), *(const bf16x8*)(ATG + (sch * 32 + l31) * 32 + 16 * ks + 8 * h), acc[it]); }
        float s1 = 0.f;
#pragma unroll
        for (int it = 0; it < 2; ++it)
#pragma unroll
            for (int r = 0; r < 16; ++r) s1 += acc[it][r];
        s1 += __shfl_xor(s1, 32); const float mean = s1 * (1.0f / 64.0f); float s2 = 0.f;
#pragma unroll
        for (int it = 0; it < 2; ++it)
#pragma unroll
            for (int r = 0; r < 16; ++r) { const float d = acc[it][r] - mean; s2 += d * d; }
        s2 += __shfl_xor(s2, 32); const float rstd = 1.0f / sqrtf(s2 * (1.0f / 64.0f) + 64e-5f);
        const int rr = sub_row(sc, l31);
        if (rr >= 0) { const float bon = BON[(size_t)rr * 16 + hd];
#pragma unroll
            for (int it = 0; it < 2; ++it)
#pragma unroll
                for (int g = 0; g < 4; ++g) { const int c = hd * 64 + 32 * it + 8 * g + 4 * h;
                    const f32x4 lw = *(const f32x4*)(a.in[15] + c), lb = *(const f32x4*)(a.in[16] + c), gt = *(const f32x4*)(GATE + (size_t)rr * 1024 + c); const v2u vw = *(const v2u*)(VV + (size_t)rr * 1024 + c);
                    const float o0 = ((acc[it][4 * g] - mean) * rstd * lw.x + lb.x + bon * bflo(vw.x)) * gt.x, o1 = ((acc[it][4 * g + 1] - mean) * rstd * lw.y + lb.y + bon * bfhi(vw.x)) * gt.y;
                    const float o2 = ((acc[it][4 * g + 2] - mean) * rstd * lw.z + lb.z + bon * bflo(vw.y)) * gt.z, o3 = ((acc[it][4 * g + 3] - mean) * rstd * lw.w + lb.w + bon * bfhi(vw.y)) * gt.w;
                    *(v2u*)(Y + (size_t)rr * DM + c) = (v2u){pk2(o0, o1), pk2(o2, o3)}; } }
    }
    lru_apply(F, a);
}

constexpr int N_PHASES = 33;
template <class Epi, class Sched> DI void run_gemm(const Frame& F, const pg8::Gemm& g, const Sched& S, const Epi& E) {
    pg8::gemm_phase<Epi, Sched, true, true>(F.lds + RING_OFF, g, S, E);
}
DI void moe_up_units(const Frame& F, const Args& a, int t0, int ntl, int G, int c) {
    pg8::Gemm g{(const bf16*)(a.ws + WS_SCR + SC_XG), (const bf16*)(a.ws + WS_MOEW), DM, DM, DM};
    pg8::MoeOrder S{(const int*)(a.ws + WS_TILES), t0, ntl, 4, G, c, (long)MOE_E_BYTES};
    pg8::EpiSwiglu E{(bf16*)(a.ws + WS_SCR + SC_ACT), FF};
    run_gemm(F, g, S, E);
}
DI void moe_down_units(const Frame& F, const Args& a, int t0, int ntl, int G, int c) {
    pg8::Gemm g{(const bf16*)(a.ws + WS_SCR + SC_ACT), (const bf16*)(a.ws + WS_MOEW + MOE_W2_OFF), FF, FF, FF};
    pg8::MoeOrder S{(const int*)(a.ws + WS_TILES), t0, ntl, 8, G, c, (long)MOE_E_BYTES};
    pg8::EpiBf16 E{(bf16*)(a.ws + WS_SCR + SC_YB), DM};
    run_gemm(F, g, S, E);
}
DI void ph_moe_a(const Frame& F, const Args& a) {
    const int nt = (int)__hip_atomic_load((gu32*)(a.ws + WS_TILES) + 127, RLX_AGENT), n1 = nt < 64 ? nt : 64;
    moe_up_units(F, a, 0, n1, F.G, (int)blockIdx.x);
}
DI void ph_moe_b(const Frame& F, const Args& a) {
    const int nt = (int)__hip_atomic_load((gu32*)(a.ws + WS_TILES) + 127, RLX_AGENT), n1 = nt < 64 ? nt : 64; const int c = (int)blockIdx.x;
    int nu = 4 * (nt - n1); if (nu > F.G / 2) nu = F.G / 2;
    if (c < nu) moe_up_units(F, a, n1, nt - n1, nu, c); else moe_down_units(F, a, 0, n1, F.G - nu, c - nu);
}
DI void ph_moe_c(const Frame& F, const Args& a) {
    const int nt = (int)__hip_atomic_load((gu32*)(a.ws + WS_TILES) + 127, RLX_AGENT), n1 = nt < 64 ? nt : 64;
    moe_down_units(F, a, n1, nt - n1, F.G, (int)blockIdx.x);
}

DI void gemm_tail16(const Frame& F, const Args& a, const bf16* A, int lda, const bf16* Wt, int K, int mode) {
    if (F.vcu >= 128) return;
    const int lane = F.lane, lc = lane & 15, quad = lane >> 4, w = F.vcu; LAS float* red = (LAS float*)(F.lds + RING_OFF);
    f32x4 acc = (f32x4){0.f, 0.f, 0.f, 0.f}; const int kw = K / NWAVES, kb = F.wave * kw;
    const bf16* ap = A + (size_t)(TX + lc) * lda + kb + 8 * quad; const bf16* bp = Wt + (size_t)(16 * w + lc) * K + kb + 8 * quad;
#pragma unroll 4
    for (int ks = 0; ks < kw / 32; ++ks) acc = __builtin_amdgcn_mfma_f32_16x16x32_bf16(*(const bf16x8*)(ap + 32 * ks), *(const bf16x8*)(bp + 32 * ks), acc, 0, 0, 0);
    *(LAS f32x4*)(red + (F.wave * 64 + lane) * 4) = acc;
    __syncthreads();
    if (F.wave == 0) { f32x4 s = *(const LAS f32x4*)(red + lane * 4);
#pragma unroll
        for (int v = 1; v < NWAVES; ++v) s = s + *(const LAS f32x4*)(red + (v * 64 + lane) * 4);
        float* H = (float*)(a.ws + WS_H);
#pragma unroll
        for (int r = 0; r < 4; ++r) { const int row = 4 * quad + r, col = 16 * w + lc; const float base = mode ? H[(size_t)(TX + row) * DM + col] : a.in[1][(size_t)row * DM + col];
            H[(size_t)(TX + row) * DM + col] = base + s[r]; } }
    __syncthreads();
}

__global__ void __launch_bounds__(NWAVES * 64, 2) hyb_fwd(Args a) {
    extern __shared__ __attribute__((aligned(16))) unsigned char lds[];
    Frame F;
    F.lds = (LAS unsigned char*)lds;
    F.MISC = (volatile LAS unsigned*)(F.lds + MISC_OFF);
    F.tid = threadIdx.x; F.lane = F.tid & 63; F.wave = __builtin_amdgcn_readfirstlane(F.tid >> 6);
    F.G = gridDim.x; { const int bx = blockIdx.x; F.vcu = (F.G % 8 == 0) ? (bx % 8) * (F.G / 8) + bx / 8 : bx; }
    F.gw = F.vcu * NWAVES + F.wave; F.NGW = F.G * NWAVES;
    F.ctl = (gu32*)(a.ws + WS_CTL);
    for (int u = F.tid; u < (LDS_BYTES - LDSCTL_OFF) / 4; u += NWAVES * 64) ((LAS unsigned*)(F.lds + LDSCTL_OFF))[u] = 0u;
    __syncthreads();
    XcdBarrier bar; bar.bar = (unsigned*)(F.ctl + CW_BAR); bar.x = 0; bar.st = nullptr;
    if (MK_ONE_LAUNCH) bar = xcd_barrier_post((unsigned*)(F.ctl + CW_BAR), F.MISC + 8);
    const int lo = a.ph_lo, hi = a.ph_hi;
#ifndef PH_MASK
#define PH_MASK 0xFFFFFFFFFFFFFFFFull
#endif
#define IN(k) ((((unsigned long long)(PH_MASK) >> (k)) & 1ull) && lo <= (k) && (k) < hi)
#ifndef PROBE_REP
#define PROBE_REP 0u
#endif
#define REP(k) ((((unsigned long long)(PROBE_REP) >> (k)) & 1ull) ? 2 : 1)
#ifdef PROBE_TS
#define STAMP(k) do { if (blockIdx.x == 0 && F.tid == 0) ((unsigned long long*)(F.ctl + CW_TS))[(k)] = __builtin_amdgcn_s_memrealtime(); } while (0)
#else
#define STAMP(k) do { } while (0)
#endif
#define SEAM(k) do { if (IN(k) && IN((k) + 1)) xcd_barrier(bar); STAMP((k) + 1); } while (0)
    const bf16* HN = (const bf16*)(a.ws + WS_HN); bf16* PROJ = (bf16*)(a.ws + WS_PROJ); const bf16* YMIX = (const bf16*)(a.ws + WS_YMIX); float* H = (float*)(a.ws + WS_H);

    STAMP(0);
    if (IN(0)) for (int rep_ = 0; rep_ < REP(0); ++rep_) { ph_prologue(F, a); ph_aux_convert(F, a, F.gw, F.NGW); }
    SEAM(0);
    if (IN(1)) for (int rep_ = 0; rep_ < REP(1); ++rep_) { pg8::Gemm g{HN, (const bf16*)(a.ws + WS_WEVIN), DM, DM, DM}; pg8::StaticOrder S; S.init(MP, EV_NP, F.G, (int)blockIdx.x); pg8::EpiBf16 E{PROJ, EV_NP}; run_gemm(F, g, S, E); }
    SEAM(1);
    if (IN(2)) for (int rep_ = 0; rep_ < REP(2); ++rep_) ph_even_prep(F, a);
    SEAM(2);
    if (IN(3)) for (int rep_ = 0; rep_ < REP(3); ++rep_) {
#ifndef NO_LORA
        { pg8::Gemm g{(const bf16*)(a.ws + WS_SCR + SC_ALORA), (const bf16*)(a.ws + WS_WLORA), 384, 384, 384}; pg8::StaticOrder S; S.init(MP, 3072, F.G, (int)blockIdx.x);
          static_assert(SC_ICL - SC_DEC == SC_GATE - SC_ICL, "lora outputs equally spaced");
          pg8::EpiLora E{(float*)(a.ws + WS_SCR + SC_DEC), (long)((SC_ICL - SC_DEC) / 4), a.in[7], a.in[9]}; run_gemm(F, g, S, E); }
#endif
#ifndef NO_GATES
        { pg8::Gemm g{(const bf16*)(a.ws + WS_SCR + SC_XR), (const bf16*)(a.ws + WS_WGATE), 256, 1024, 256}; pg8::StaticOrder S; S.init(MP, 2048, F.G, (int)blockIdx.x); S.amod = 4; S.astep = 512;
          pg8::EpiGates E{(float*)(a.ws + WS_SCR + SC_LA), (float*)(a.ws + WS_SCR + SC_LIX), a.in[20], a.in[22], a.in[23], (const bf16*)(a.ws + WS_SCR + SC_XR)}; run_gemm(F, g, S, E); }
#endif
    }
    SEAM(3);
    if (IN(4)) { lru_local(F, a); ph_rwkv_chunk(F, a, 0, 32, 0); }
    SEAM(4);
    if (IN(5)) { if (F.vcu < 16) ph_rwkv_chain(F, a, 0, 64); else ph_rwkv_chunk(F, a, 32, 62, 16); }
    SEAM(5);
    if (IN(6)) { if (F.vcu < 16) ph_rwkv_chain(F, a, 64, 124); else ph_rwkv_chunk(F, a, 62, 92, 16); }
    SEAM(6);
    if (IN(7)) { if (F.vcu < 16) ph_rwkv_chain(F, a, 124, 184); else ph_rwkv_chunk(F, a, 92, 122, 16); }
    SEAM(7);
    if (IN(8)) { if (F.vcu < 16) ph_rwkv_chain(F, a, 184, 244); else ph_rwkv_chunk(F, a, 122, 129, 16); }
    SEAM(8);
    if (IN(9)) { if (F.vcu < 18) ph_rwkv_chain(F, a, 244, RW_NSC); }
    SEAM(9);
    if (IN(10)) for (int rep_ = 0; rep_ < REP(10); ++rep_) ph_rwkv_out(F, a);
    SEAM(10);
    if (IN(11)) for (int rep_ = 0; rep_ < REP(11); ++rep_) { pg8::Gemm g{YMIX, (const bf16*)(a.ws + WS_WEVOUT), DM, DM, DM}; pg8::StaticOrder S; S.init(TX, DM, F.G, (int)blockIdx.x); pg8::EpiResid E{H, a.in[0], a.in[1], 0}; run_gemm(F, g, S, E); gemm_tail16(F, a, YMIX, DM, (const bf16*)(a.ws + WS_WEVOUT), DM, 0); }
    SEAM(11);
    if (IN(12)) for (int rep_ = 0; rep_ < REP(12); ++rep_) ph_route(F, a, 0, rep_);
    SEAM(12);
    if (IN(13)) for (int rep_ = 0; rep_ < REP(13); ++rep_) ph_gather(F, a, 0);
    SEAM(13);
    if (IN(14)) ph_moe_a(F, a);
    SEAM(14);
    if (IN(15)) ph_moe_b(F, a);
    SEAM(15);
    if (IN(16)) ph_moe_c(F, a);
    SEAM(16);
    if (IN(17)) for (int rep_ = 0; rep_ < REP(17); ++rep_) ph_combine(F, a, 0);
    SEAM(17);
    if (IN(18)) for (int rep_ = 0; rep_ < REP(18); ++rep_) { pg8::Gemm g{HN, (const bf16*)(a.ws + WS_WODIN), DM, DM, DM}; pg8::StaticOrder S; S.init(MP, OD_NP, F.G, (int)blockIdx.x); pg8::EpiBf16 E{PROJ, OD_NP}; run_gemm(F, g, S, E); }
    SEAM(18);
    if (IN(19)) for (int rep_ = 0; rep_ < REP(19); ++rep_) ph_odd_prep(F, a);
    SEAM(19);
    if (IN(20)) ph_gdn_chunk(F, a, 0, 33, 0);
    SEAM(20);
    if (IN(21)) { ph_gdn_chain(F, a, 0, 33); ph_gdn_chunk(F, a, 33, 65, 1); }
    SEAM(21);
    if (IN(22)) { ph_gdn_chain(F, a, 33, 65); ph_gdn_chunk(F, a, 65, 97, 1); }
    SEAM(22);
    if (IN(23)) { ph_gdn_chain(F, a, 65, 97); ph_gdn_chunk(F, a, 97, 129, 1); }
    SEAM(23);
    if (IN(24)) ph_gdn_chain(F, a, 97, 129);
    SEAM(24);
    if (IN(25)) for (int rep_ = 0; rep_ < REP(25); ++rep_) { ph_odd_post(F, a); moe_convert(F, a, 1, F.gw, F.NGW); }
    SEAM(25);
    if (IN(26)) for (int rep_ = 0; rep_ < REP(26); ++rep_) { pg8::Gemm g{YMIX, (const bf16*)(a.ws + WS_WODOUT), 4096, 4096, 4096}; pg8::StaticOrder S; S.init(TX, DM, F.G, (int)blockIdx.x); pg8::EpiResid E{H, a.in[0], a.in[1], 1}; run_gemm(F, g, S, E); gemm_tail16(F, a, YMIX, 4096, (const bf16*)(a.ws + WS_WODOUT), 4096, 1); }
    SEAM(26);
    if (IN(27)) for (int rep_ = 0; rep_ < REP(27); ++rep_) ph_route(F, a, 1, rep_);
    SEAM(27);
    if (IN(28)) for (int rep_ = 0; rep_ < REP(28); ++rep_) ph_gather(F, a, 1);
    SEAM(28);
    if (IN(29)) ph_moe_a(F, a);
    SEAM(29);
    if (IN(30)) ph_moe_b(F, a);
    SEAM(30);
    if (IN(31)) ph_moe_c(F, a);
    SEAM(31);
    if (IN(32)) for (int rep_ = 0; rep_ < REP(32); ++rep_) ph_combine(F, a, 1);
#ifdef PROBE_BARS
    for (int i_ = 0; i_ < PROBE_BARS; ++i_) xcd_barrier(bar);
#endif
#undef IN
#undef SEAM
}

extern "C" void kernel_launch(void* const* d_in, const int* in_sizes, int n_in, void* d_out, int out_size, void* d_ws, size_t ws_size, hipStream_t stream) {
    static int grid = 0;
    if (grid == 0) {
        if (n_in != 36 || out_size != TX * DM || ws_size < WS_END) { fprintf(stderr, "kernel_launch: unexpected shapes (n_in %d, out %d, ws %zu)\n", n_in, out_size, ws_size); grid = -1; return; }
        int dev = 0, cus = 0, per_cu = 0;
        if (hipGetDevice(&dev) != hipSuccess || hipDeviceGetAttribute(&cus, hipDeviceAttributeMultiprocessorCount, dev) != hipSuccess) { grid = -1; return; }
        if (hipFuncSetAttribute((const void*)hyb_fwd, hipFuncAttributeMaxDynamicSharedMemorySize, LDS_BYTES) != hipSuccess) { fprintf(stderr, "kernel_launch: hipFuncSetAttribute failed\n"); grid = -1; return; }
        if (hipOccupancyMaxActiveBlocksPerMultiprocessor(&per_cu, (const void*)hyb_fwd, NWAVES * 64, LDS_BYTES) != hipSuccess || per_cu < 1) { fprintf(stderr, "kernel_launch: occupancy query says %d\n", per_cu); per_cu = 1; }
        (void)hipGetLastError();
        grid = cus;
    }
    if (grid < 0) return;
    if (hipMemsetAsync((char*)d_ws + WS_CTL, 0, CTL_ZERO_BYTES, stream) != hipSuccess) return;
    Args a{};
    for (int i = 0; i < 36; ++i) a.in[i] = (const float*)d_in[i];
    a.out = (float*)d_out; a.ws = (unsigned char*)d_ws;
#if MK_ONE_LAUNCH
    a.ph_lo = 0; a.ph_hi = N_PHASES;
    hipLaunchKernelGGL(hyb_fwd, dim3(grid), dim3(NWAVES * 64), LDS_BYTES, stream, a);
#else
    for (int p = 0; p < N_PHASES; ++p) { a.ph_lo = p; a.ph_hi = p + 1; hipLaunchKernelGGL(hyb_fwd, dim3(grid), dim3(NWAVES * 64), LDS_BYTES, stream, a); }
#endif
}
```

```cpp
#include <hip/hip_runtime.h>
#include <cstdio>
#include <cstdint>
#include <cmath>

#ifndef MK_ONE_LAUNCH
#define MK_ONE_LAUNCH 1
#endif

namespace pg8 {
#define PG8_LAS __attribute__((address_space(3)))
typedef unsigned short bf16_t;
typedef short bf16x8 __attribute__((ext_vector_type(8)));
typedef float f32x4 __attribute__((ext_vector_type(4)));
typedef unsigned u32x4 __attribute__((ext_vector_type(4)));
typedef unsigned u32x2 __attribute__((ext_vector_type(2)));
constexpr int BM = 256, BK = 64, HALF = 128, HTB = HALF * BK * 2  , STAGE_BYTES = 8 * HTB, NXCD = 8, WGM = 8;

__host__ __device__ __forceinline__ int lds_byte(int r, int c) { const int st = (r >> 4) * 2 + (c >> 5), rr = r & 15, cc = c & 31, ob = rr * 64 + cc * 2; return st * 1024 + (ob ^ (((ob >> 9) & 1) << 5)); }
__host__ __device__ __forceinline__ void stage_rc(int b, int& R, int& C) { const int st = b / 1024, sb = b % 1024, swz = sb ^ (((sb >> 9) & 1) << 5); R = (st >> 1) * 16 + swz / 64; C = (st & 1) * 32 + (swz % 64) / 2; }
__host__ __device__ __forceinline__ int perm32(int rho) { const int n = rho >> 4, i = rho & 15; return 8 * (i >> 2) + 4 * n + (i & 3); }

struct Unit { int pm, pn; long aoff, boff; };
struct Gemm { const bf16_t* A; const bf16_t* Bt; int K, lda, ldb; };

struct StaticOrder {
    int nM, nN, nwg, G, c, amod; long astep;
    __host__ __device__ void init(int M, int N, int G_, int c_) { nM = M / BM; nN = N / BM; nwg = nM * nN; G = G_; c = c_; amod = 0; astep = 0; }
    __host__ __device__ bool next(int i, Unit& u) const {
        const long L = (long)i * G + c; if (L >= nwg) return false;
        int wgid = (int)L; { const int q = nwg / NXCD, r = nwg % NXCD, xcd = wgid % NXCD, off = wgid / NXCD; wgid = (xcd < r ? xcd * (q + 1) : r * (q + 1) + (xcd - r) * q) + off; }
        const int nig = WGM * nN, gid = wgid / nig, fm = gid * WGM, gsz = (nM - fm) < WGM ? (nM - fm) : WGM;
        u.pm = fm + ((wgid % nig) % gsz); u.pn = (wgid % nig) / gsz; u.boff = 0; u.aoff = amod ? (long)(u.pn % amod) * astep : 0; return true;
    }
    __device__ __forceinline__ void a_ready(const Unit&) const {}
    __device__ __forceinline__ void done(const Unit&) const {}
};
struct MoeOrder {
    const int* tile_e; int t0, ntiles, npn, G, c; long bstride;
    __device__ __forceinline__ bool next(int i, Unit& u) const {
        const long L = (long)i * G + c; if (c < 0 || L >= (long)ntiles * npn) return false;
        const int t = t0 + (int)(L / npn); u.pm = t; u.pn = (int)(L % npn); u.aoff = 0; u.boff = (long)tile_e[t] * bstride; return true;
    }
    __device__ __forceinline__ void a_ready(const Unit&) const {}
    __device__ __forceinline__ void done(const Unit&) const {}
};

__device__ __forceinline__ unsigned cvt_pk_bf16(float lo, float hi) { unsigned r; asm volatile("v_cvt_pk_bf16_f32 %0, %1, %2" : "=v"(r) : "v"(lo), "v"(hi)); return r; }
__device__ __forceinline__ float bf_lo(unsigned w) { return __uint_as_float(w << 16); }
__device__ __forceinline__ float bf_hi(unsigned w) { return __uint_as_float(w & 0xffff0000u); }
__device__ __forceinline__ float sigmoidf_(float x) { return 1.0f / (1.0f + __expf(-x)); }
__device__ __forceinline__ float softplusf_(float x) { return fmaxf(x, 0.f) + __logf(1.0f + __expf(-fabsf(x))); }

struct EpiBf16 {
    static constexpr bool PERM = true, AFTER_DRAIN = false;
    bf16_t* O; int ldc;
    __device__ __forceinline__ void operator()(const f32x4 (&acc)[2][2][4][2], const Unit& u, int wr, int wc, int fr, int fq) const {
        const int row0 = u.pm * BM + wr * 64 + fr; const int col0 = u.pn * BM + wc * 32 + 8 * fq;
#pragma unroll
        for (int ai = 0; ai < 2; ++ai)
#pragma unroll
            for (int m = 0; m < 4; ++m) { bf16_t* rowp = O + (size_t)(row0 + ai * HALF + m * 16) * ldc + col0;
#pragma unroll
                for (int bj = 0; bj < 2; ++bj) { const f32x4 v0 = acc[ai][bj][m][0], v1 = acc[ai][bj][m][1];
                    u32x4 w; w.x = cvt_pk_bf16(v0[0], v0[1]); w.y = cvt_pk_bf16(v0[2], v0[3]); w.z = cvt_pk_bf16(v1[0], v1[1]); w.w = cvt_pk_bf16(v1[2], v1[3]);
                    *(u32x4*)(rowp + bj * HALF) = w; } }
    }
};
struct EpiSwiglu {
    static constexpr bool PERM = true, AFTER_DRAIN = false;
    bf16_t* O; int ldc;
    __device__ __forceinline__ void operator()(const f32x4 (&acc)[2][2][4][2], const Unit& u, int wr, int wc, int fr, int fq) const {
        const int row0 = u.pm * BM + wr * 64 + fr; const int col0 = u.pn * HALF + wc * 32 + 8 * fq;
#pragma unroll
        for (int ai = 0; ai < 2; ++ai)
#pragma unroll
            for (int m = 0; m < 4; ++m) { bf16_t* rowp = O + (size_t)(row0 + ai * HALF + m * 16) * ldc + col0;
                float o[8];
#pragma unroll
                for (int n = 0; n < 2; ++n)
#pragma unroll
                    for (int j = 0; j < 4; ++j) { const float gq = acc[ai][0][m][n][j], uq = acc[ai][1][m][n][j]; o[4 * n + j] = gq * sigmoidf_(gq) * uq; }
                u32x4 w; w.x = cvt_pk_bf16(o[0], o[1]); w.y = cvt_pk_bf16(o[2], o[3]); w.z = cvt_pk_bf16(o[4], o[5]); w.w = cvt_pk_bf16(o[6], o[7]);
                *(u32x4*)rowp = w; }
    }
};
struct EpiResid {
    static constexpr bool PERM = false, AFTER_DRAIN = false;
    float* out; const float* x; const float* meta; int mode;
    __device__ __forceinline__ void operator()(const f32x4 (&acc)[2][2][4][2], const Unit& u, int wr, int wc, int fr, int fq) const {
        const int row0 = u.pm * BM + wr * 64 + fr, col0 = u.pn * BM + wc * 32 + 4 * fq;
#pragma unroll
        for (int ai = 0; ai < 2; ++ai)
#pragma unroll
            for (int m = 0; m < 4; ++m) { const int row = row0 + ai * HALF + m * 16; float* rowp = out + (size_t)row * 2048 + col0;
                const float* bp = mode ? rowp : (row < 8192 ? x + (size_t)row * 2048 + col0 : (row < 8208 ? meta + (size_t)(row - 8192) * 2048 + col0 : nullptr));
#pragma unroll
                for (int bj = 0; bj < 2; ++bj)
#pragma unroll
                    for (int n = 0; n < 2; ++n) { f32x4 b = (f32x4){0.f, 0.f, 0.f, 0.f}; if (bp) b = *(const f32x4*)(bp + bj * HALF + n * 16);
                        *(f32x4*)(rowp + bj * HALF + n * 16) = acc[ai][bj][m][n] + b; } }
    }
};
struct EpiLora {
    static constexpr bool PERM = false, AFTER_DRAIN = false;
    float* base; long gstride; const float* w0; const float* a0;
    __device__ __forceinline__ void operator()(const f32x4 (&acc)[2][2][4][2], const Unit& u, int wr, int wc, int fr, int fq) const {
        const int grp = u.pn >> 2; const int row0 = u.pm * BM + wr * 64 + fr, col0 = (u.pn & 3) * BM + wc * 32 + 4 * fq;
        float* O = base + (size_t)grp * gstride;
#pragma unroll
        for (int bj = 0; bj < 2; ++bj)
#pragma unroll
            for (int n = 0; n < 2; ++n) { const int c = col0 + bj * HALF + n * 16;
                f32x4 bv = (f32x4){0.f, 0.f, 0.f, 0.f}; if (grp == 0) bv = *(const f32x4*)(w0 + c); else if (grp == 1) bv = *(const f32x4*)(a0 + c);
#pragma unroll
                for (int ai = 0; ai < 2; ++ai)
#pragma unroll
                    for (int m = 0; m < 4; ++m) { f32x4 v = acc[ai][bj][m][n] + bv;
                        if (grp == 0) {
#pragma unroll
                            for (int j = 0; j < 4; ++j) { const float wl = -softplusf_(-v[j]) - 0.5f; v[j] = __expf(-__expf(wl)); }
                        } else if (grp == 1) {
#pragma unroll
                            for (int j = 0; j < 4; ++j) v[j] = sigmoidf_(v[j]);
                        }
                        *(f32x4*)(O + (size_t)(row0 + ai * HALF + m * 16) * 1024 + c) = v; } }
    }
};
struct EpiGates {
    static constexpr bool PERM = false, AFTER_DRAIN = false;
    float* lru_a; float* lru_ix; const float* ba; const float* bx; const float* lam; const bf16_t* xr;
    __device__ __forceinline__ void operator()(const f32x4 (&acc)[2][2][4][2], const Unit& u, int wr, int wc, int fr, int fq) const {
        const int grp = u.pn >> 2; const int row0 = u.pm * BM + wr * 64 + fr, col0 = (u.pn & 3) * BM + wc * 32 + 4 * fq;
#pragma unroll
        for (int bj = 0; bj < 2; ++bj)
#pragma unroll
            for (int n = 0; n < 2; ++n) { const int c = col0 + bj * HALF + n * 16;
                const f32x4 bv = *(const f32x4*)((grp == 0 ? ba : bx) + c); f32x4 sp = (f32x4){0.f, 0.f, 0.f, 0.f};
                if (grp == 0) { const f32x4 l = *(const f32x4*)(lam + c);
#pragma unroll
                    for (int j = 0; j < 4; ++j) sp[j] = -8.0f * softplusf_(-l[j]); }
#pragma unroll
                for (int ai = 0; ai < 2; ++ai)
#pragma unroll
                    for (int m = 0; m < 4; ++m) { const int row = row0 + ai * HALF + m * 16; f32x4 v = acc[ai][bj][m][n] + bv;
                        if (grp == 0) {
#pragma unroll
                            for (int j = 0; j < 4; ++j) v[j] = __expf(sigmoidf_(v[j]) * sp[j]);
                            *(f32x4*)(lru_a + (size_t)row * 1024 + c) = v;
                        } else { const u32x2 xw = *(const u32x2*)(xr + (size_t)row * 1024 + c);
                            v[0] = sigmoidf_(v[0]) * bf_lo(xw.x); v[1] = sigmoidf_(v[1]) * bf_hi(xw.x); v[2] = sigmoidf_(v[2]) * bf_lo(xw.y); v[3] = sigmoidf_(v[3]) * bf_hi(xw.y);
                            *(f32x4*)(lru_ix + (size_t)row * 1024 + c) = v; } } }
    }
};

template <class Epi, class Sched, bool ALIGN_EPI = false, bool SP2 = false>
__device__ __forceinline__ void gemm_phase(PG8_LAS unsigned char* lds, const Gemm g, const Sched& S, const Epi& E) {
    const int tid = threadIdx.x, wid = __builtin_amdgcn_readfirstlane(tid >> 6), lane = tid & 63, wr = wid >> 2, wc = wid & 3, fr = lane & 15, fq = lane >> 4;
    const int K = g.K, nt = K / BK;
    unsigned voffA[2], voffB[2];
#pragma unroll
    for (int i = 0; i < 2; ++i) { int R, C; stage_rc(tid * 16 + i * 8192, R, C); const int Rb = Epi::PERM ? ((R & ~31) + perm32(R & 31)) : R;
        voffA[i] = (unsigned)(R * g.lda + C) * 2u; voffB[i] = (unsigned)(Rb * g.ldb + C) * 2u; }
    const size_t kstep = (size_t)(BK * 2);
    const size_t hstepA = (size_t)HALF * g.lda * 2, hstepB = (size_t)HALF * g.ldb * 2;
    const size_t tstepA = 2 * hstepA, tstepB = 2 * hstepB;
    const unsigned ldsw = (unsigned)wid * 1024u;
    const int aoff = lds_byte(wr * 64 + fr, fq * 8), boff = lds_byte(wc * 32 + fr, fq * 8);
#define PG8_SA(b, h) (((b) * 2 + (h)) * HTB)
#define PG8_SB(b, h) ((4 + (b) * 2 + (h)) * HTB)
#define PG8_STAGE(bufoff, gbase, voff) do { _Pragma("unroll") for (int _i = 0; _i < 2; ++_i) \
        __builtin_amdgcn_global_load_lds((const unsigned*)((const char*)(gbase) + (voff)[_i]), (PG8_LAS unsigned*)(lds + (bufoff) + ldsw + _i * 8192), 16, 0, 0); } while (0)
#define PG8_LDA(dst, b, h) do { _Pragma("unroll") for (int m = 0; m < 4; ++m) _Pragma("unroll") for (int k = 0; k < 2; ++k) dst[m][k] = *(const PG8_LAS bf16x8*)(lds + PG8_SA(b, h) + aoff + m * 2048 + k * 1024); } while (0)
#define PG8_LDB(dst, b, h) do { _Pragma("unroll") for (int n = 0; n < 2; ++n) _Pragma("unroll") for (int k = 0; k < 2; ++k) dst[n][k] = *(const PG8_LAS bf16x8*)(lds + PG8_SB(b, h) + boff + n * 2048 + k * 1024); } while (0)
#define PG8_MMA(ai, bj, At, Bt) do { __builtin_amdgcn_s_setprio(1); _Pragma("unroll") for (int m = 0; m < 4; ++m) _Pragma("unroll") for (int n = 0; n < 2; ++n) _Pragma("unroll") for (int k = 0; k < 2; ++k) \
        acc[ai][bj][m][n] = __builtin_amdgcn_mfma_f32_16x16x32_bf16(Bt[n][k], At[m][k], acc[ai][bj][m][n], 0, 0, 0); __builtin_amdgcn_s_setprio(0); } while (0)
#define PG8_WAIT_V(n) asm volatile("s_waitcnt vmcnt(" #n ")" ::: "memory")
#define PG8_WAIT_L(n) asm volatile("s_waitcnt lgkmcnt(" #n ")" ::: "memory")
#define PG8_BAR __builtin_amdgcn_s_barrier()
#define PG8_SCHED __builtin_amdgcn_sched_barrier(0)
    Unit cur, nxt; int ui = 0;
    if (!S.next(0, cur)) return;
    f32x4 acc[2][2][4][2];
#pragma unroll
    for (int a = 0; a < 2; ++a)
#pragma unroll
        for (int b = 0; b < 2; ++b)
#pragma unroll
            for (int m = 0; m < 4; ++m)
#pragma unroll
                for (int n = 0; n < 2; ++n) acc[a][b][m][n] = (f32x4){0.f, 0.f, 0.f, 0.f};
    bf16x8 At[4][2], B0[2][2], B1[2][2];
    const char* cA = (const char*)g.A + (size_t)cur.pm * tstepA + cur.aoff; const char* cB = (const char*)g.Bt + (size_t)cur.pn * tstepB + cur.boff;
    S.a_ready(cur);
    if constexpr (SP2) {
        PG8_STAGE(PG8_SB(0, 0), cB, voffB); PG8_STAGE(PG8_SB(0, 1), cB + hstepB, voffB); PG8_STAGE(PG8_SA(0, 0), cA, voffA); PG8_STAGE(PG8_SA(0, 1), cA + hstepA, voffA);
        if (wr == 1) PG8_BAR;
        PG8_WAIT_V(2); PG8_BAR;
        PG8_STAGE(PG8_SB(1, 0), cB + kstep, voffB); PG8_STAGE(PG8_SA(1, 0), cA + kstep, voffA); PG8_STAGE(PG8_SB(1, 1), cB + hstepB + kstep, voffB);
        PG8_WAIT_V(6); PG8_BAR;
    } else {
        PG8_STAGE(PG8_SB(0, 0), cB, voffB); PG8_STAGE(PG8_SA(0, 0), cA, voffA); PG8_STAGE(PG8_SB(0, 1), cB + hstepB, voffB); PG8_STAGE(PG8_SA(0, 1), cA + hstepA, voffA);
        if (wr == 1) PG8_BAR;
        PG8_WAIT_V(4); PG8_BAR;
        PG8_STAGE(PG8_SB(1, 0), cB + kstep, voffB); PG8_STAGE(PG8_SA(1, 0), cA + kstep, voffA); PG8_STAGE(PG8_SB(1, 1), cB + hstepB + kstep, voffB);
        PG8_WAIT_V(6); PG8_BAR;
    }
    for (;;) {
        const bool has_next = S.next(ui + 1, nxt);
        const char* nA = has_next ? (const char*)g.A + (size_t)nxt.pm * tstepA + nxt.aoff : cA; const char* nB = has_next ? (const char*)g.Bt + (size_t)nxt.pn * tstepB + nxt.boff : cB;
        for (int t = 0; t < nt; t += 2) {
            const bool last = (t == nt - 2);
            const char* a1 = cA + (size_t)(t + 1) * kstep;
            const char* a2 = last ? nA : cA + (size_t)(t + 2) * kstep; const char* b2 = last ? nB : cB + (size_t)(t + 2) * kstep;
            const char* a3 = a2 + kstep; const char* b3 = b2 + kstep;
            if (last && has_next) S.a_ready(nxt);
            if constexpr (SP2) {
            PG8_LDB(B0, 0, 0); PG8_LDB(B1, 0, 1); PG8_SCHED; PG8_LDA(At, 0, 0); PG8_STAGE(PG8_SA(1, 1), a1 + hstepA, voffA);
            PG8_WAIT_V(8); PG8_WAIT_L(0); PG8_BAR; PG8_MMA(0, 0, At, B0); PG8_MMA(0, 1, At, B1); PG8_BAR; PG8_SCHED;
            PG8_LDA(At, 0, 1); PG8_STAGE(PG8_SB(0, 0), b2, voffB); PG8_STAGE(PG8_SB(0, 1), b2 + hstepB, voffB); PG8_STAGE(PG8_SA(0, 0), a2, voffA);
            PG8_WAIT_V(8); PG8_WAIT_L(0); PG8_BAR; PG8_MMA(1, 0, At, B0); PG8_MMA(1, 1, At, B1); PG8_BAR; PG8_SCHED;
            PG8_LDB(B0, 1, 0); PG8_LDB(B1, 1, 1); PG8_SCHED; PG8_LDA(At, 1, 0); PG8_STAGE(PG8_SA(0, 1), a2 + hstepA, voffA);
            PG8_WAIT_V(8); PG8_WAIT_L(0); PG8_BAR; PG8_MMA(0, 0, At, B0); PG8_MMA(0, 1, At, B1); PG8_BAR; PG8_SCHED;
            PG8_LDA(At, 1, 1); PG8_STAGE(PG8_SB(1, 0), b3, voffB); PG8_STAGE(PG8_SB(1, 1), b3 + hstepB, voffB); PG8_STAGE(PG8_SA(1, 0), a3, voffA);
            PG8_WAIT_V(8); PG8_WAIT_L(0); PG8_BAR; PG8_MMA(1, 0, At, B0); PG8_MMA(1, 1, At, B1); PG8_BAR; PG8_SCHED;
            } else {
            PG8_LDB(B0, 0, 0); PG8_SCHED; PG8_LDA(At, 0, 0); PG8_STAGE(PG8_SA(1, 1), a1 + hstepA, voffA);
            PG8_WAIT_L(8); PG8_BAR; PG8_WAIT_L(0); PG8_MMA(0, 0, At, B0); PG8_BAR; PG8_SCHED;
            PG8_LDB(B1, 0, 1); PG8_STAGE(PG8_SB(0, 0), b2, voffB);
            PG8_BAR; PG8_WAIT_L(0); PG8_MMA(0, 1, At, B1); PG8_BAR;
            PG8_LDA(At, 0, 1); PG8_STAGE(PG8_SA(0, 0), a2, voffA);
            PG8_BAR; PG8_WAIT_L(0); PG8_MMA(1, 0, At, B0); PG8_BAR; PG8_SCHED;
            PG8_STAGE(PG8_SB(0, 1), b2 + hstepB, voffB);
            PG8_WAIT_V(6); PG8_BAR; PG8_MMA(1, 1, At, B1); PG8_BAR;
            PG8_LDB(B0, 1, 0); PG8_SCHED; PG8_LDA(At, 1, 0); PG8_STAGE(PG8_SA(0, 1), a2 + hstepA, voffA);
            PG8_WAIT_L(8); PG8_BAR; PG8_WAIT_L(0); PG8_MMA(0, 0, At, B0); PG8_BAR; PG8_SCHED;
            PG8_LDB(B1, 1, 1); PG8_STAGE(PG8_SB(1, 0), b3, voffB);
            PG8_BAR; PG8_WAIT_L(0); PG8_MMA(0, 1, At, B1); PG8_BAR;
            PG8_LDA(At, 1, 1); PG8_STAGE(PG8_SA(1, 0), a3, voffA);
            PG8_BAR; PG8_WAIT_L(0); PG8_MMA(1, 0, At, B0); PG8_BAR; PG8_SCHED;
            PG8_STAGE(PG8_SB(1, 1), b3 + hstepB, voffB);
            PG8_WAIT_V(6); PG8_BAR; PG8_MMA(1, 1, At, B1); PG8_BAR;
            }
        }
        if constexpr (ALIGN_EPI) { if (wr == 0) PG8_BAR; }
        if constexpr (!Epi::AFTER_DRAIN) { E(acc, cur, wr, wc, fr, fq); S.done(cur); }
        if (!has_next) break;
#pragma unroll
        for (int a = 0; a < 2; ++a)
#pragma unroll
            for (int b = 0; b < 2; ++b)
#pragma unroll
                for (int m = 0; m < 4; ++m)
#pragma unroll
                    for (int n = 0; n < 2; ++n) acc[a][b][m][n] = (f32x4){0.f, 0.f, 0.f, 0.f};
        cur = nxt; cA = nA; cB = nB; ++ui;
        if constexpr (ALIGN_EPI) { if (wr == 1) PG8_BAR; }
    }
    PG8_WAIT_V(0);
    if constexpr (!ALIGN_EPI) { if (wr == 0) PG8_BAR; }
    PG8_BAR;
    if constexpr (Epi::AFTER_DRAIN) { E.fused(acc, cur, wr, wc, fr, fq, lds, wid, lane); S.done(cur); }
#undef PG8_SA
#undef PG8_SB
#undef PG8_STAGE
#undef PG8_LDA
#undef PG8_LDB
#undef PG8_MMA
#undef PG8_WAIT_V
#undef PG8_WAIT_L
#undef PG8_BAR
#undef PG8_SCHED
}
}
#define GAS __attribute__((address_space(1)))
#define LAS __attribute__((address_space(3)))
typedef unsigned short bf16;
typedef unsigned v4u __attribute__((ext_vector_type(4)));
typedef float f32x4 __attribute__((ext_vector_type(4)));
typedef short bf16x8 __attribute__((ext_vector_type(8)));
typedef GAS unsigned gu32;
typedef GAS unsigned long long gu64;
#define RLX_AGENT __ATOMIC_RELAXED, __HIP_MEMORY_SCOPE_AGENT
#define LDS_WAIT() asm volatile("s_waitcnt lgkmcnt(0)" ::: "memory")
#define VM_WAIT() asm volatile("s_waitcnt vmcnt(0)" ::: "memory")
__device__ __forceinline__ unsigned long long rt() { return __builtin_amdgcn_s_memrealtime(); }
__device__ __forceinline__ unsigned f2bf(float f) { unsigned u = __builtin_bit_cast(unsigned, f); return (u + 0x7fffu + ((u >> 16) & 1u)) >> 16; }
__device__ __forceinline__ unsigned pk2(float lo, float hi) { return f2bf(lo) | (f2bf(hi) << 16); }

#define XB_TMO      128
#define XB_XCNT(j)  (256  + 64 * (j))
#define XB_XSUB(j)  (1280 + 64 * (j))
#define XB_XGEN(j)  (2304 + 64 * (j))
#define XB_TOP      3328
#define XB_TOPGEN   3392
#define XCD_BAR_WORDS 3456
#define XB_SPIN_CAP (1u << 18)

__device__ __forceinline__ unsigned xb_ld(unsigned* p)              { return __hip_atomic_load(p, __ATOMIC_RELAXED, __HIP_MEMORY_SCOPE_AGENT); }
__device__ __forceinline__ unsigned xb_add(unsigned* p, unsigned v) { return __hip_atomic_fetch_add(p, v, __ATOMIC_RELAXED, __HIP_MEMORY_SCOPE_AGENT); }
__device__ __forceinline__ unsigned xb_xcc_id() { return (unsigned)__builtin_amdgcn_s_getreg((3 << 11) | 20) & 0xFu; }
#define XB_SPIN(cond, bar) do { unsigned _sp = 0; while (cond) { __builtin_amdgcn_s_sleep(1); \
    if ((++_sp & 255u) == 0u) { if (xb_ld(&(bar)[XB_TMO])) break; if (_sp > XB_SPIN_CAP) { atomicAdd(&(bar)[XB_TMO], 1u); break; } } } } while (0)

struct XcdBarrier {
    unsigned* bar; unsigned x;
    volatile LAS unsigned* st;
};

__device__ __forceinline__ XcdBarrier xcd_barrier_post(unsigned* bar, volatile LAS unsigned* st) {
    XcdBarrier b; b.bar = bar; b.x = xb_xcc_id(); b.st = st;
    if (threadIdx.x == 0) (void)xb_add(&bar[XB_XCNT(b.x)], 1u);
    return b;
}
__device__ __forceinline__ void xcd_barrier_complete(unsigned* bar, unsigned x, unsigned& nloc, unsigned& nx) {
    const unsigned G = gridDim.x * gridDim.y * gridDim.z;
    unsigned sum, cnt, mine, sp = 0u;
    for (;;) {
        sum = 0u; cnt = 0u; mine = 0u;
#pragma unroll
        for (unsigned j = 0; j < 16; ++j) { const unsigned c = xb_ld(&bar[XB_XCNT(j)]); sum += c; cnt += (c > 0u) ? 1u : 0u; mine = (j == x) ? c : mine; }
        if (sum == G) break;
        __builtin_amdgcn_s_sleep(1);
        if ((++sp & 255u) == 0u) { if (xb_ld(&bar[XB_TMO])) break; if (sp > XB_SPIN_CAP) { atomicAdd(&bar[XB_TMO], 1u); break; } }
    }
    nloc = mine > 0u ? mine : 1u; nx = cnt > 0u ? cnt : 1u;
}

__device__ __forceinline__ void xcd_barrier(const XcdBarrier& b) {
    asm volatile("s_waitcnt vmcnt(0)" ::: "memory");
    __syncthreads();
    if (threadIdx.x == 0) {
        unsigned* bar = b.bar;
        __builtin_amdgcn_s_waitcnt(0);
        unsigned nloc = b.st[0], nx = b.st[1];
        if (nloc == 0u) { xcd_barrier_complete(bar, b.x, nloc, nx); b.st[0] = nloc; b.st[1] = nx; }
        const unsigned old = xb_add(&bar[XB_XSUB(b.x)], 1u);
        const unsigned gen = old / nloc;
        if (old + 1u == (gen + 1u) * nloc) {
            __builtin_amdgcn_fence(__ATOMIC_RELEASE, "agent");
            asm volatile("s_waitcnt vmcnt(0)" ::: "memory");
            const unsigned og = xb_add(&bar[XB_TOP], 1u);
            const unsigned tg = og / nx;
            if (og + 1u == (tg + 1u) * nx) xb_add(&bar[XB_TOPGEN], 1u);
            else XB_SPIN(xb_ld(&bar[XB_TOPGEN]) == tg, bar);
            __builtin_amdgcn_fence(__ATOMIC_ACQUIRE, "agent");
            xb_add(&bar[XB_XGEN(b.x)], 1u);
            asm volatile("s_waitcnt vmcnt(0)" ::: "memory");
        } else {
            XB_SPIN(xb_ld(&bar[XB_XGEN(b.x)]) == gen, bar);
            __builtin_amdgcn_fence(__ATOMIC_ACQUIRE, "agent");
            asm volatile("s_waitcnt vmcnt(0)" ::: "memory");
        }
    }
    __syncthreads();
}

constexpr int NWAVES = 8;
constexpr int DM = 2048, TX = 8192, NMETA = 16, TT = TX + NMETA, MP = 8448;
constexpr int EV_NP = 5632, EV_LORA0 = 3072, EV_GB = 3360, EV_REC = 4384;
constexpr int OD_NP = 12544, OD_Z = 8192, OD_B = 12288, OD_A = 12320;
constexpr int NEXP = 32, FF = 512, MOE_ROWS = 24576;
constexpr float NORM_EPS = 1e-6f;

constexpr size_t MiB = 1u << 20;
constexpr size_t WS_CTL = 0, CTL_ZERO_BYTES = 1 * MiB;
constexpr size_t WS_TOKINFO = 1 * MiB;
constexpr size_t WS_TILES = 1 * MiB + 512 * 1024;
constexpr size_t WS_WEVIN = 2 * MiB;
constexpr size_t WS_WEVOUT = 24 * MiB;
constexpr size_t WS_WODIN = 32 * MiB;
constexpr size_t WS_WODOUT = 81 * MiB;
constexpr size_t WS_WLORA = 97 * MiB;
constexpr size_t WS_WGATE = 100 * MiB;
constexpr size_t WS_WROUTE = 101 * MiB;
constexpr size_t WS_MOEW = 102 * MiB;
constexpr size_t MOE_E_BYTES = 6 * MiB, MOE_W2_OFF = 4 * MiB;
constexpr size_t WS_H = 294 * MiB;
constexpr size_t WS_HN = 360 * MiB;
constexpr size_t WS_YMIX = 393 * MiB;
constexpr size_t WS_PROJ = 459 * MiB;
constexpr size_t WS_SCR = 662 * MiB;
constexpr size_t WS_END = 932 * MiB;
constexpr size_t SC_ALORA = 0;
constexpr size_t SC_XR = 8 * MiB;
constexpr size_t SC_DEC = 26 * MiB, SC_ICL = 60 * MiB, SC_GATE = 94 * MiB;
constexpr size_t SC_LA = 128 * MiB, SC_LIX = 162 * MiB;
constexpr size_t SC_QN = 0, SC_KN = 34 * MiB;
constexpr size_t SC_VC = 68 * MiB;
constexpr size_t SC_BETA = 134 * MiB, SC_G = 136 * MiB;
constexpr size_t SC_O = 138 * MiB;
constexpr size_t SC_XG = 0;
constexpr size_t SC_ACT = 96 * MiB;
constexpr size_t SC_YB = 120 * MiB;
static_assert(SC_O + (size_t)MP * 4096 * 4 <= WS_END - WS_SCR && SC_YB + (size_t)MOE_ROWS * 2048 * 2 <= WS_END - WS_SCR && SC_LIX + (size_t)MP * 1024 * 4 <= WS_END - WS_SCR, "scratch map");
constexpr int CW_TMO = 0, CW_CODE = 1;
constexpr int CW_BAR = 4096;
constexpr int CW_PROG = 20480;
constexpr int CW_TS = 24576;
constexpr int CW_MOECNT = 16384;

constexpr int RING_OFF = 0, RING_BYTES = 131072;
constexpr int LDSCTL_OFF = 146944, MISC_OFF = LDSCTL_OFF + 320;
constexpr int LDS_BYTES = 147456;


#define DI __device__ __forceinline__
typedef unsigned v2u __attribute__((ext_vector_type(2)));
struct Args { const float* in[36]; float* out; unsigned char* ws; int ph_lo, ph_hi; };
struct Frame {
    LAS unsigned char* lds; volatile LAS unsigned* MISC; gu32* ctl;
    int tid, lane, wave, vcu, G, gw, NGW;
};
DI float bf2f(bf16 v) { return __uint_as_float((unsigned)v << 16); }
DI float bflo(unsigned w) { return __uint_as_float(w << 16); }
DI float bfhi(unsigned w) { return __uint_as_float(w & 0xffff0000u); }
DI float wave_sum(float v) {
#pragma unroll
    for (int o = 1; o < 64; o <<= 1) v += __shfl_xor(v, o);
    return v;
}
DI float sigm(float x) { return 1.0f / (1.0f + __expf(-x)); }
DI float softplus(float x) { return fmaxf(x, 0.f) + __logf(1.0f + __expf(-fabsf(x))); }
DI float gelu_tanh(float x) { const float u = 0.7978845608028654f * (x + 0.044715f * x * x * x); return 0.5f * x * (1.0f + tanhf(u)); }
DI int pos_row(int p) { return p < NMETA ? TX + p : p - NMETA; }
DI int row_pos(int r) { return r < TX ? r + NMETA : r - TX; }

DI void tr_item(const float* W, int N, int k0, int n0, bf16* WT, int ldk, int drow0, LAS float* scr, int lane) {
#pragma unroll 8
    for (int i = 0; i < 32; ++i) { const int kk = 2 * i + (lane >> 5); scr[kk * 33 + (lane & 31)] = W[(size_t)(k0 + kk) * N + n0 + (lane & 31)]; }
    LDS_WAIT(); asm volatile("" ::: "memory");
    const int c = lane & 7;
#pragma unroll
    for (int j = 0; j < 4; ++j) { const int n = (lane >> 3) + 8 * j; const LAS float* s = scr + (8 * c) * 33 + n;
        v4u o; o.x = pk2(s[0 * 33], s[1 * 33]); o.y = pk2(s[2 * 33], s[3 * 33]); o.z = pk2(s[4 * 33], s[5 * 33]); o.w = pk2(s[6 * 33], s[7 * 33]);
        *(v4u*)(WT + (size_t)(drow0 + n) * ldk + k0 + 8 * c) = o; }
    LDS_WAIT(); asm volatile("" ::: "memory");
}
DI void moe_convert(const Frame& F, const Args& a, int l, int gw, int ngw) {
    LAS float* scr = (LAS float*)(F.lds + RING_OFF + F.wave * 16384);
    bf16* base = (bf16*)(a.ws + WS_MOEW);
    for (int it = gw; it < NEXP * 1536; it += ngw) {
        const int e = it / 1536; int j = it % 1536; bf16* eb = base + (size_t)e * (MOE_E_BYTES / 2);
        const size_t eoff = (size_t)(l * NEXP + e) * DM * FF;
        if (j < 1024) { const float* W = (j < 512 ? a.in[33] : a.in[34]) + eoff; const int hi = j >= 512; j &= 511; const int kb = j >> 4, nb = j & 15, n0 = 32 * nb;
            tr_item(W, FF, 64 * kb, n0, eb, DM, 256 * (n0 >> 7) + 128 * hi + (n0 & 127), scr, F.lane); }
        else { j -= 1024; const int kb = j >> 6, nb = j & 63; tr_item(a.in[35] + eoff, DM, 64 * kb, 32 * nb, eb + MOE_W2_OFF / 2, FF, 32 * nb, scr, F.lane); }
    }
}
DI void norm_row_bf16(int lane, const float* src, const float* w, bf16* dst) {
    f32x4 v[8]; float s = 0.f;
#pragma unroll
    for (int j = 0; j < 8; ++j) { v[j] = ((const f32x4*)src)[lane + 64 * j]; s += (v[j].x * v[j].x + v[j].y * v[j].y) + (v[j].z * v[j].z + v[j].w * v[j].w); }
    const float rs = 1.0f / sqrtf(wave_sum(s) * (1.0f / DM) + NORM_EPS);
#pragma unroll
    for (int j = 0; j < 8; ++j) { const f32x4 wv = ((const f32x4*)w)[lane + 64 * j]; v2u o; o.x = pk2(v[j].x * rs * wv.x, v[j].y * rs * wv.y); o.y = pk2(v[j].z * rs * wv.z, v[j].w * rs * wv.w);
        ((v2u*)dst)[lane + 64 * j] = o; }
}

DI void ph_prologue(const Frame& F, const Args& a) {
    LAS float* scr = (LAS float*)(F.lds + RING_OFF + F.wave * 16384);
    constexpr int I_A = 32 * 169, I_B = 32 * 64, NIT = I_A + I_B;
    for (int it = F.gw; it < NIT; it += F.NGW) {
        int r = it;
        if (r < I_A) { const int kb = r / 169, nb = r % 169; tr_item(a.in[5], 5408, 64 * kb, 32 * nb, (bf16*)(a.ws + WS_WEVIN), DM, 32 * nb, scr, F.lane); continue; } r -= I_A;
        { const int kb = r / 64, nb = r % 64; tr_item(a.in[24], DM, 64 * kb, 32 * nb, (bf16*)(a.ws + WS_WEVOUT), DM, 32 * nb, scr, F.lane); }
    }
    const int gt = F.vcu * (NWAVES * 64) + F.tid, NGT = F.G * NWAVES * 64;
    { bf16* WL = (bf16*)(a.ws + WS_WLORA); const float* wup = a.in[8]; const float* aup = a.in[10]; const float* gup = a.in[11];
      for (int idx = gt; idx < 3072 * 384; idx += NGT) { const int n = idx / 384, k = idx % 384; float v = 0.f;
          if (n < 1024) { if (k < 64) v = wup[k * 1024 + n]; }
          else if (n < 2048) { if (k >= 64 && k < 128) v = aup[(k - 64) * 1024 + n - 1024]; }
          else { if (k >= 128 && k < 288) v = gup[(k - 128) * 1024 + n - 2048]; }
          WL[idx] = (bf16)f2bf(v); } }
    { bf16* WG = (bf16*)(a.ws + WS_WGATE);
      for (int idx = gt; idx < 2048 * 256; idx += NGT) { const int n = idx >> 8, kk = idx & 255, nn = n & 1023, blk = nn >> 6, j = nn & 63, cin = (nn & ~255) + kk;
          const float* W = n < 1024 ? a.in[19] : a.in[21];
          const float v = (cin >> 6) == blk ? W[blk * 4096 + (cin & 63) * 64 + j] : 0.f;
          WG[idx] = (bf16)f2bf(v); } }
    { bf16* WR = (bf16*)(a.ws + WS_WROUTE);
      for (int idx = gt; idx < 2 * 48 * DM; idx += NGT) { const int l = idx / (48 * DM), n = (idx / DM) % 48, k = idx % DM; float v = 0.f;
          if (n < 32) v = a.in[32][((size_t)l * DM + k) * NEXP + n]; else if (n < 36) v = a.in[31][((size_t)l * DM + k) * 4 + n - 32];
          const unsigned hi = f2bf(v); WR[((size_t)(l * 2) * 48 + n) * DM + k] = (bf16)hi; WR[((size_t)(l * 2 + 1) * 48 + n) * DM + k] = (bf16)f2bf(v - __uint_as_float(hi << 16)); } }
    bf16* HN = (bf16*)(a.ws + WS_HN);
    for (int r = F.gw; r < TT; r += F.NGW) norm_row_bf16(F.lane, r < TX ? a.in[0] + (size_t)r * DM : a.in[1] + (size_t)(r - TX) * DM, a.in[2], HN + (size_t)r * DM);
}

DI void ph_aux_convert(const Frame& F, const Args& a, int gw, int ngw) {
    LAS float* scr = (LAS float*)(F.lds + RING_OFF + F.wave * 16384);
    constexpr int I_C = 32 * 386, I_D = 64 * 64, NIT = I_C + I_D;
    for (int it = gw; it < NIT; it += ngw) {
        int r = it;
        if (r < I_C) { const int kb = r / 386, nb = r % 386; tr_item(a.in[25], 12352, 64 * kb, 32 * nb, (bf16*)(a.ws + WS_WODIN), DM, 32 * nb, scr, F.lane); continue; } r -= I_C;
        { const int kb = r / 64, nb = r % 64; tr_item(a.in[30], DM, 64 * kb, 32 * nb, (bf16*)(a.ws + WS_WODOUT), 4096, 32 * nb, scr, F.lane); }
    }
    moe_convert(F, a, 0, gw, ngw);
}

DI void ph_even_prep(const Frame& F, const Args& a) {
    const bf16* P = (const bf16*)(a.ws + WS_PROJ); bf16* AL = (bf16*)(a.ws + WS_SCR + SC_ALORA); bf16* XR = (bf16*)(a.ws + WS_SCR + SC_XR);
    const float* mu = a.in[6]; const float* cw = a.in[17]; const float* cb = a.in[18];
    const int lane = F.lane;
    for (int item = F.gw; item < TT + (TT / 8) * 2; item += F.NGW) {
        if (item < TT) { const int r = item, pos = row_pos(r); const bf16* cur = P + (size_t)r * EV_NP; const bf16* prv = P + (size_t)pos_row(pos > 0 ? pos - 1 : 0) * EV_NP; const float pm = pos > 0 ? 1.f : 0.f;
            float cv[6], pv[6], mv[6];
#pragma unroll
            for (int i = 0; i < 6; ++i) { const int idx = lane + 64 * i, col = EV_LORA0 + (idx < 288 ? idx : 287); cv[i] = bf2f(cur[col]); pv[i] = bf2f(prv[col]) * pm; mv[i] = mu[col]; }
#pragma unroll
            for (int i = 0; i < 6; ++i) { const int idx = lane + 64 * i; float v = cv[i] + (pv[i] - cv[i]) * mv[i];
                if (idx < 64) v = tanhf(v); else if (idx >= 128) v = sigm(v);
                AL[(size_t)r * 384 + idx] = (bf16)f2bf(idx < 288 ? v : 0.f); }
        } else { const int it2 = item - TT, pb = it2 >> 1, c0 = (it2 & 1) * 512 + lane * 8, p0 = pb * 8;
            f32x4 w[4][2], b0 = *(const f32x4*)(cb + c0), b1 = *(const f32x4*)(cb + c0 + 4);
#pragma unroll
            for (int j = 0; j < 4; ++j) { w[j][0] = *(const f32x4*)(cw + j * 1024 + c0); w[j][1] = *(const f32x4*)(cw + j * 1024 + c0 + 4); }
            v4u x[11];
#pragma unroll
            for (int i = 0; i < 11; ++i) { const int p = p0 - 3 + i; x[i] = *(const v4u*)(P + (size_t)pos_row(p > 0 ? p : 0) * EV_NP + EV_REC + c0); if (p < 0) x[i] = (v4u){0u, 0u, 0u, 0u}; }
#pragma unroll
            for (int o = 0; o < 8; ++o) { float acc[8] = {b0.x, b0.y, b0.z, b0.w, b1.x, b1.y, b1.z, b1.w};
#pragma unroll
                for (int j = 0; j < 4; ++j) { const v4u xv = x[o + j];
                    acc[0] += w[j][0].x * bflo(xv.x); acc[1] += w[j][0].y * bfhi(xv.x); acc[2] += w[j][0].z * bflo(xv.y); acc[3] += w[j][0].w * bfhi(xv.y);
                    acc[4] += w[j][1].x * bflo(xv.z); acc[5] += w[j][1].y * bfhi(xv.z); acc[6] += w[j][1].z * bflo(xv.w); acc[7] += w[j][1].w * bfhi(xv.w); }
                *(v4u*)(XR + (size_t)pos_row(p0 + o) * 1024 + c0) = (v4u){pk2(acc[0], acc[1]), pk2(acc[2], acc[3]), pk2(acc[4], acc[5]), pk2(acc[6], acc[7])}; } }
    }
}

DI void ph_route(const Frame& F, const Args& a, int l, int dummy) {
    const float* H = (const float*)(a.ws + WS_H); const float* nw = a.in[3] + (size_t)l * DM;
    const bf16* WH = (const bf16*)(a.ws + WS_WROUTE) + (size_t)(l * 2) * 48 * DM; const bf16* WL = WH + (size_t)48 * DM;
    unsigned* TI = (unsigned*)(a.ws + WS_TOKINFO) + (dummy ? (WS_SCR + 250 * MiB - WS_TOKINFO) / 4 : 0); const int lane = F.lane, lc = lane & 15, quad = lane >> 4, wave = F.wave; const int cl = dummy ? l + 2 : l;
    LAS float* red = (LAS float*)(F.lds + RING_OFF);
    LAS float* sq = red + 8 * 3 * 64 * 4; LAS float* lgs = sq + 128;
    for (int task = F.vcu; task < TT / 16; task += F.G) {
        const int r = task * 16 + lc; const float* hr = H + (size_t)r * DM + 256 * wave + 8 * quad; const float* nwp = nw + 256 * wave + 8 * quad; float ss = 0.f;
        f32x4 acc[3];
#pragma unroll
        for (int nt = 0; nt < 3; ++nt) acc[nt] = (f32x4){0.f, 0.f, 0.f, 0.f};
#pragma unroll
        for (int ks = 0; ks < 8; ++ks) { const int k0 = 256 * wave + 32 * ks + 8 * quad; const f32x4 x0 = *(const f32x4*)(hr + 32 * ks), x1 = *(const f32x4*)(hr + 32 * ks + 4), w0 = *(const f32x4*)(nwp + 32 * ks), w1 = *(const f32x4*)(nwp + 32 * ks + 4);
            ss += (x0.x * x0.x + x0.y * x0.y) + (x0.z * x0.z + x0.w * x0.w) + (x1.x * x1.x + x1.y * x1.y) + (x1.z * x1.z + x1.w * x1.w);
            const float xn[8] = {x0.x * w0.x, x0.y * w0.y, x0.z * w0.z, x0.w * w0.w, x1.x * w1.x, x1.y * w1.y, x1.z * w1.z, x1.w * w1.w};
            unsigned hi[8]; float lo[8];
#pragma unroll
            for (int q = 0; q < 8; ++q) { hi[q] = f2bf(xn[q]); lo[q] = xn[q] - __uint_as_float(hi[q] << 16); }
            const v4u ah4 = (v4u){hi[0] | (hi[1] << 16), hi[2] | (hi[3] << 16), hi[4] | (hi[5] << 16), hi[6] | (hi[7] << 16)}, al4 = (v4u){pk2(lo[0], lo[1]), pk2(lo[2], lo[3]), pk2(lo[4], lo[5]), pk2(lo[6], lo[7])};
            const bf16x8 ah = __builtin_bit_cast(bf16x8, ah4), al = __builtin_bit_cast(bf16x8, al4);
#pragma unroll
            for (int nt = 0; nt < 3; ++nt) { const bf16x8 bh = *(const bf16x8*)(WH + (size_t)(16 * nt + lc) * DM + k0), bl = *(const bf16x8*)(WL + (size_t)(16 * nt + lc) * DM + k0);
                acc[nt] = __builtin_amdgcn_mfma_f32_16x16x32_bf16(al, bh, acc[nt], 0, 0, 0); acc[nt] = __builtin_amdgcn_mfma_f32_16x16x32_bf16(ah, bl, acc[nt], 0, 0, 0); acc[nt] = __builtin_amdgcn_mfma_f32_16x16x32_bf16(ah, bh, acc[nt], 0, 0, 0); } }
        ss += __shfl_xor(ss, 16); ss += __shfl_xor(ss, 32);
#pragma unroll
        for (int nt = 0; nt < 3; ++nt) *(LAS f32x4*)(red + ((wave * 3 + nt) * 64 + lane) * 4) = acc[nt];
        if (quad == 0) sq[wave * 16 + lc] = ss;
        __syncthreads();
        if (wave < 3) { f32x4 s = *(const LAS f32x4*)(red + (wave * 64 + lane) * 4);
#pragma unroll
            for (int v = 1; v < 8; ++v) s = s + *(const LAS f32x4*)(red + ((v * 3 + wave) * 64 + lane) * 4);
#pragma unroll
            for (int q = 0; q < 4; ++q) lgs[(4 * quad + q) * 49 + 16 * wave + lc] = s[q]; }
        __syncthreads();
        if (wave == 0 && lane < 16) { float sst = 0.f;
#pragma unroll
            for (int v = 0; v < 8; ++v) sst += sq[v * 16 + lane];
            const float rs = 1.0f / sqrtf(sst * (1.0f / DM) + NORM_EPS);
            float lg[36];
#pragma unroll
            for (int i = 0; i < 36; ++i) lg[i] = lgs[lane * 49 + i] * rs;
            int gi = 0; float gm = lg[32];
#pragma unroll
            for (int i = 1; i < 4; ++i) if (lg[32 + i] > gm) { gm = lg[32 + i]; gi = i; }
            float den = 0.f;
#pragma unroll
            for (int i = 0; i < 4; ++i) den += __expf(lg[32 + i] - gm);
            const float gp = 1.0f / den;
            float l8[8];
#pragma unroll
            for (int i = 0; i < 8; ++i) l8[i] = gi == 0 ? lg[i] : (gi == 1 ? lg[8 + i] : (gi == 2 ? lg[16 + i] : lg[24 + i]));
            int i1 = 0; float m1 = l8[0];
#pragma unroll
            for (int i = 1; i < 8; ++i) if (l8[i] > m1) { m1 = l8[i]; i1 = i; }
            int i2 = -1; float m2 = -INFINITY;
#pragma unroll
            for (int i = 0; i < 8; ++i) if (i != i1 && l8[i] > m2) { m2 = l8[i]; i2 = i; }
            const float e21 = __expf(m2 - m1); const float w1 = gp / (1.0f + e21), w2 = gp * e21 / (1.0f + e21);
            const int ea = gi * 8 + i1, eb = gi * 8 + i2; const int rt = task * 16 + lane;
            const unsigned sa = atomicAdd((unsigned*)(F.ctl + CW_MOECNT + (cl * NEXP + ea) * 16), 1u), sb = atomicAdd((unsigned*)(F.ctl + CW_MOECNT + (cl * NEXP + eb) * 16), 1u);
            unsigned* t = TI + (size_t)rt * 8; *(v4u*)t = (v4u){(unsigned)ea, sa, __float_as_uint(w1), (unsigned)eb}; *(v4u*)(t + 4) = (v4u){sb, __float_as_uint(w2), __float_as_uint(rs), 0u}; }
        __syncthreads();
    }
}
DI void moe_prefix(const Frame& F, int l, LAS int* ps) {
    if (F.tid == 0) { int t = 0;
        for (int e = 0; e < NEXP; ++e) { const unsigned c = __hip_atomic_load(F.ctl + CW_MOECNT + (l * NEXP + e) * 16, RLX_AGENT); ps[e] = t * 256; t += (int)((c + 255u) >> 8); }
        ps[32] = t; }
    __syncthreads();
}
DI void ph_gather(const Frame& F, const Args& a, int l) {
    LAS int* ps = (LAS int*)(F.lds + RING_OFF); moe_prefix(F, l, ps);
    if (F.vcu == 0 && F.tid < NEXP) { int* TE = (int*)(a.ws + WS_TILES); const int e = F.tid; const int t0 = ps[e] >> 8, t1 = (e == NEXP - 1 ? ps[32] : ps[e + 1] >> 8);
        for (int t = t0; t < t1; ++t) TE[t] = e; if (e == 0) TE[127] = ps[32]; }
    const float* H = (const float*)(a.ws + WS_H); const float* nw = a.in[3] + (size_t)l * DM; unsigned* TI = (unsigned*)(a.ws + WS_TOKINFO); bf16* XG = (bf16*)(a.ws + WS_SCR + SC_XG);
    const int lane = F.lane;
    for (int r = F.gw; r < TT; r += F.NGW) {
        unsigned* t = TI + (size_t)r * 8; const int g0 = ps[t[0]] + (int)t[1], g1 = ps[t[3]] + (int)t[4]; const float rs = __uint_as_float(t[6]);
        if (lane == 0) t[7] = (unsigned)g0 | ((unsigned)g1 << 16);
        const float* hr = H + (size_t)r * DM;
#pragma unroll
        for (int j = 0; j < 4; ++j) { const int e0 = (lane + 64 * j) * 8; const f32x4 x0 = *(const f32x4*)(hr + e0), x1 = *(const f32x4*)(hr + e0 + 4), w0 = *(const f32x4*)(nw + e0), w1 = *(const f32x4*)(nw + e0 + 4);
            v4u o; o.x = pk2(x0.x * rs * w0.x, x0.y * rs * w0.y); o.y = pk2(x0.z * rs * w0.z, x0.w * rs * w0.w); o.z = pk2(x1.x * rs * w1.x, x1.y * rs * w1.y); o.w = pk2(x1.z * rs * w1.z, x1.w * rs * w1.w);
            *(v4u*)(XG + (size_t)g0 * DM + e0) = o; *(v4u*)(XG + (size_t)g1 * DM + e0) = o; }
    }
}
DI void ph_combine(const Frame& F, const Args& a, int l) {
    float* H = (float*)(a.ws + WS_H); const unsigned* TI = (const unsigned*)(a.ws + WS_TOKINFO); const bf16* YB = (const bf16*)(a.ws + WS_SCR + SC_YB); bf16* HN = (bf16*)(a.ws + WS_HN);
    const int lane = F.lane; const int nrows = l == 0 ? TT : TX;
    for (int r = F.gw; r < nrows; r += F.NGW) {
        const unsigned* t = TI + (size_t)r * 8; const int g0 = (int)(t[7] & 0xffffu), g1 = (int)(t[7] >> 16); const float w0 = __uint_as_float(t[2]), w1 = __uint_as_float(t[5]);
        float* hr = H + (size_t)r * DM; float hv[32]; float s = 0.f;
#pragma unroll
        for (int j = 0; j < 4; ++j) { const int e0 = (lane + 64 * j) * 8; const f32x4 x0 = *(const f32x4*)(hr + e0), x1 = *(const f32x4*)(hr + e0 + 4);
            const v4u ya = *(const v4u*)(YB + (size_t)g0 * DM + e0), yc = *(const v4u*)(YB + (size_t)g1 * DM + e0);
            float* o = hv + 8 * j;
            o[0] = x0.x + w0 * bflo(ya.x) + w1 * bflo(yc.x); o[1] = x0.y + w0 * bfhi(ya.x) + w1 * bfhi(yc.x); o[2] = x0.z + w0 * bflo(ya.y) + w1 * bflo(yc.y); o[3] = x0.w + w0 * bfhi(ya.y) + w1 * bfhi(yc.y);
            o[4] = x1.x + w0 * bflo(ya.z) + w1 * bflo(yc.z); o[5] = x1.y + w0 * bfhi(ya.z) + w1 * bfhi(yc.z); o[6] = x1.z + w0 * bflo(ya.w) + w1 * bflo(yc.w); o[7] = x1.w + w0 * bfhi(ya.w) + w1 * bfhi(yc.w);
#pragma unroll
            for (int q = 0; q < 8; ++q) s += o[q] * o[q]; }
        const float rs = 1.0f / sqrtf(wave_sum(s) * (1.0f / DM) + NORM_EPS);
        if (l == 0) { const float* nw = a.in[2] + DM;
#pragma unroll
            for (int j = 0; j < 4; ++j) { const int e0 = (lane + 64 * j) * 8; const float* o = hv + 8 * j; const f32x4 wa = *(const f32x4*)(nw + e0), wb = *(const f32x4*)(nw + e0 + 4);
                *(f32x4*)(hr + e0) = (f32x4){o[0], o[1], o[2], o[3]}; *(f32x4*)(hr + e0 + 4) = (f32x4){o[4], o[5], o[6], o[7]};
                v4u p; p.x = pk2(o[0] * rs * wa.x, o[1] * rs * wa.y); p.y = pk2(o[2] * rs * wa.z, o[3] * rs * wa.w); p.z = pk2(o[4] * rs * wb.x, o[5] * rs * wb.y); p.w = pk2(o[6] * rs * wb.z, o[7] * rs * wb.w);
                *(v4u*)(HN + (size_t)r * DM + e0) = p; }
        } else { const float* nw = a.in[4]; float* orow = a.out + (size_t)r * DM;
#ifdef PROBE_TS
            { const unsigned long long* ts = (const unsigned long long*)(F.ctl + CW_TS); const float dt_us = (float)(__hip_atomic_load(ts + PROBE_TS + 1, RLX_AGENT) - __hip_atomic_load(ts + PROBE_TS, RLX_AGENT)) * 0.01f;
#pragma unroll
              for (int q = 0; q < 32; ++q) hv[q] *= 1.0f + dt_us * 0.01f; }
#endif
#pragma unroll
            for (int j = 0; j < 4; ++j) { const int e0 = (lane + 64 * j) * 8; const float* o = hv + 8 * j; const f32x4 wa = *(const f32x4*)(nw + e0), wb = *(const f32x4*)(nw + e0 + 4);
                *(f32x4*)(orow + e0) = (f32x4){o[0] * rs * wa.x, o[1] * rs * wa.y, o[2] * rs * wa.z, o[3] * rs * wa.w};
                *(f32x4*)(orow + e0 + 4) = (f32x4){o[4] * rs * wb.x, o[5] * rs * wb.y, o[6] * rs * wb.z, o[7] * rs * wb.w}; } }
    }
}

DI void ph_odd_prep(const Frame& F, const Args& a) {
    const bf16* P = (const bf16*)(a.ws + WS_PROJ); bf16* QN = (bf16*)(a.ws + WS_SCR + SC_QN); bf16* KN = (bf16*)(a.ws + WS_SCR + SC_KN); bf16* VC = (bf16*)(a.ws + WS_SCR + SC_VC);
    float* BETA = (float*)(a.ws + WS_SCR + SC_BETA); float* GG = (float*)(a.ws + WS_SCR + SC_G);
    const float* cw = a.in[26]; const int lane = F.lane;
    for (int item = F.gw; item < (TT / 8) * 16; item += F.NGW) { const int pb = item >> 4, i = item & 15, ch = i * 512 + lane * 8, p0 = pb * 8;
        f32x4 w[4][2];
#pragma unroll
        for (int j = 0; j < 4; ++j) { w[j][0] = *(const f32x4*)(cw + j * 8192 + ch); w[j][1] = *(const f32x4*)(cw + j * 8192 + ch + 4); }
        v4u x[11];
#pragma unroll
        for (int q = 0; q < 11; ++q) { const int p = p0 - 3 + q; x[q] = *(const v4u*)(P + (size_t)pos_row(p > 0 ? p : 0) * OD_NP + ch); if (p < 0) x[q] = (v4u){0u, 0u, 0u, 0u}; }
#pragma unroll
        for (int o = 0; o < 8; ++o) { const int r = pos_row(p0 + o); float acc[8] = {0.f, 0.f, 0.f, 0.f, 0.f, 0.f, 0.f, 0.f};
#pragma unroll
            for (int j = 0; j < 4; ++j) { const v4u xv = x[o + j];
                acc[0] += w[j][0].x * bflo(xv.x); acc[1] += w[j][0].y * bfhi(xv.x); acc[2] += w[j][0].z * bflo(xv.y); acc[3] += w[j][0].w * bfhi(xv.y);
                acc[4] += w[j][1].x * bflo(xv.z); acc[5] += w[j][1].y * bfhi(xv.z); acc[6] += w[j][1].z * bflo(xv.w); acc[7] += w[j][1].w * bfhi(xv.w); }
            float ss = 0.f;
#pragma unroll
            for (int q = 0; q < 8; ++q) { acc[q] = acc[q] * sigm(acc[q]); ss += acc[q] * acc[q]; }
            float sc = 1.0f;
            if (i < 8) { ss += __shfl_xor(ss, 1); ss += __shfl_xor(ss, 2); ss += __shfl_xor(ss, 4); ss += __shfl_xor(ss, 8);
                sc = (1.0f / sqrtf(ss + NORM_EPS)) * (i < 4 ? 0.08838834764831845f : 1.0f); }
            const v4u ov = (v4u){pk2(acc[0] * sc, acc[1] * sc), pk2(acc[2] * sc, acc[3] * sc), pk2(acc[4] * sc, acc[5] * sc), pk2(acc[6] * sc, acc[7] * sc)};
            bf16* dst = i < 4 ? QN + (size_t)r * 2048 + ch : (i < 8 ? KN + (size_t)r * 2048 + ch - 2048 : VC + (size_t)r * 4096 + ch - 4096);
            *(v4u*)dst = ov; }
        if (i == 0 && lane < 32) {
#pragma unroll
            for (int o = 0; o < 8; ++o) { const int r = pos_row(p0 + o); const float bb = bf2f(P[(size_t)r * OD_NP + OD_B + lane]), aa = bf2f(P[(size_t)r * OD_NP + OD_A + lane]);
                BETA[(size_t)r * 32 + lane] = sigm(bb); GG[(size_t)r * 32 + lane] = -__expf(a.in[27][lane]) * softplus(aa + a.in[28][lane]); } }
    }
}
DI void ph_odd_post(const Frame& F, const Args& a) {
    const bf16* P = (const bf16*)(a.ws + WS_PROJ); const bf16* O = (const bf16*)(a.ws + WS_SCR + SC_O); bf16* Y = (bf16*)(a.ws + WS_YMIX); const float* nw = a.in[29];
    const int lane = F.lane;
    for (int r = F.gw; r < TT; r += F.NGW) {
#pragma unroll 2
        for (int i = 0; i < 8; ++i) { const int ch = i * 512 + lane * 8; const v4u ow = *(const v4u*)(O + (size_t)r * 4096 + ch); const f32x4 o0 = (f32x4){bflo(ow.x), bfhi(ow.x), bflo(ow.y), bfhi(ow.y)}, o1 = (f32x4){bflo(ow.z), bfhi(ow.z), bflo(ow.w), bfhi(ow.w)};
            float ss = (o0.x * o0.x + o0.y * o0.y) + (o0.z * o0.z + o0.w * o0.w) + (o1.x * o1.x + o1.y * o1.y) + (o1.z * o1.z + o1.w * o1.w);
            ss += __shfl_xor(ss, 1); ss += __shfl_xor(ss, 2); ss += __shfl_xor(ss, 4); ss += __shfl_xor(ss, 8);
            const float rs = 1.0f / sqrtf(ss * (1.0f / 128.0f) + NORM_EPS);
            const v4u z = *(const v4u*)(P + (size_t)r * OD_NP + OD_Z + ch); const int c0 = ch & 127; const f32x4 w0 = *(const f32x4*)(nw + c0), w1 = *(const f32x4*)(nw + c0 + 4);
            const float zf[8] = {bflo(z.x), bfhi(z.x), bflo(z.y), bfhi(z.y), bflo(z.z), bfhi(z.z), bflo(z.w), bfhi(z.w)};
            const float of[8] = {o0.x * w0.x, o0.y * w0.y, o0.z * w0.z, o0.w * w0.w, o1.x * w1.x, o1.y * w1.y, o1.z * w1.z, o1.w * w1.w};
            float y[8];
#pragma unroll
            for (int q = 0; q < 8; ++q) y[q] = of[q] * rs * zf[q] * sigm(zf[q]);
            v4u p; p.x = pk2(y[0], y[1]); p.y = pk2(y[2], y[3]); p.z = pk2(y[4], y[5]); p.w = pk2(y[6], y[7]);
            *(v4u*)(Y + (size_t)r * 4096 + ch) = p; }
    }
}

typedef float f32x16 __attribute__((ext_vector_type(16)));
#define MFMA32(a, b, c) __builtin_amdgcn_mfma_f32_32x32x16_bf16((a), (b), (c), 0, 0, 0)
DI int crow(int reg, int h) { return (reg & 3) + 8 * (reg >> 2) + 4 * h; }
DI int chunk_row(int n, int c) { return n == 0 ? (c >= 48 ? TX + (c - 48) : -1) : 64 * (n - 1) + c; }
#ifndef GDN_NO_HELPER
#define GDN_NO_HELPER 0
#endif
constexpr int GDN_NCH = 129, GDN_UNITS = GDN_NCH * 32, GDN_KUNITS = GDN_NCH * 16, GC_STRIDE = 72;
constexpr size_t GD_WF = WS_MOEW, GD_UF = WS_MOEW + 65 * MiB, GD_IN = WS_MOEW + 130 * MiB, GD_GC = WS_MOEW + 163 * MiB, GD_KT = WS_HN, GD_QF = WS_YMIX, GD_SAVE = WS_SCR + 205 * MiB;
static_assert((size_t)GDN_UNITS * 16384 <= 65 * MiB && (size_t)GDN_UNITS * 8192 <= 33 * MiB && (size_t)GDN_KUNITS * 16384 <= 33 * MiB && GD_GC + (size_t)GDN_UNITS * GC_STRIDE * 4 <= WS_H, "gdn map");

DI void ph_gdn_chunk(const Frame& F, const Args& a, int n_lo, int n_hi, int side) {
    const bf16* QN = (const bf16*)(a.ws + WS_SCR + SC_QN); const bf16* KN = (const bf16*)(a.ws + WS_SCR + SC_KN); const bf16* VC = (const bf16*)(a.ws + WS_SCR + SC_VC);
    const float* BETA = (const float*)(a.ws + WS_SCR + SC_BETA); const float* GG = (const float*)(a.ws + WS_SCR + SC_G);
    bf16* WF = (bf16*)(a.ws + GD_WF); bf16* UF = (bf16*)(a.ws + GD_UF); bf16* INF = (bf16*)(a.ws + GD_IN); bf16* KTF = (bf16*)(a.ws + GD_KT); bf16* QF = (bf16*)(a.ws + GD_QF); float* GC = (float*)(a.ws + GD_GC);
    LAS unsigned char* L = F.lds + RING_OFF;
    LAS unsigned char* kS = L; LAS unsigned char* qS = L + 17408; LAS unsigned char* vS = L + 34816; LAS unsigned char* kbS = L + 52224;
    LAS float* Lm = (LAS float*)(L + 69632); LAS bf16* IS = (LAS bf16*)(L + 87040); LAS bf16* XS = (LAS bf16*)(L + 96256);
    LAS float* betaS = (LAS float*)(L + 130048); LAS float* gcS = betaS + 64; LAS float* egcS = betaS + 128;
    LAS unsigned char* Lb = L + 17408; LAS unsigned char* TDs = L + 26624; LAS unsigned char* YT0 = L + 28672; LAS unsigned char* XT0 = L + 130816;
    static_assert(130816 + 8 * 1792 <= LDSCTL_OFF, "gdn lds map");
    const int tid = F.tid, lane = F.lane, wave = F.wave, l31 = lane & 31, h = lane >> 5;
    int widx = F.vcu, wcnt = F.G;
    if (side) { if (F.G == 256) { const int wx = F.vcu & 31; if (wx < 20) return; widx = (F.vcu >> 5) * 12 + (wx - 20); wcnt = 96; } else { if (F.vcu < 128 || F.G <= 128) return; widx = F.vcu - 128; wcnt = F.G - 128; } }
    for (int unit = n_lo * 32 + widx; unit < n_hi * 32; unit += wcnt) {
        const int n = unit >> 5, hv = unit & 31, hk = hv >> 1; const size_t su = (size_t)hv * GDN_NCH + n;
#pragma unroll
        for (int i = 0; i < 2; ++i) { const int p = tid + 512 * i, row = p >> 4, ch = p & 15; const int rr = chunk_row(n, row);
            v4u kx = (v4u){0u, 0u, 0u, 0u}, qx = kx, vx = kx;
            if (rr >= 0) { kx = *(const v4u*)(KN + (size_t)rr * 2048 + hk * 128 + ch * 8); qx = *(const v4u*)(QN + (size_t)rr * 2048 + hk * 128 + ch * 8); vx = *(const v4u*)(VC + (size_t)rr * 4096 + hv * 128 + ch * 8); }
            *(LAS v4u*)(kS + row * 272 + ch * 16) = kx; *(LAS v4u*)(qS + row * 272 + ch * 16) = qx; *(LAS v4u*)(vS + row * 272 + ch * 16) = vx; }
        if (wave == 0) { const int rr = chunk_row(n, lane); float b = 0.f, g = 0.f; if (rr >= 0) { b = BETA[(size_t)rr * 32 + hv]; g = GG[(size_t)rr * 32 + hv]; }
#pragma unroll
            for (int o = 1; o < 64; o <<= 1) { const float t = __shfl_up(g, o); if (lane >= o) g += t; }
            betaS[lane] = b; gcS[lane] = g; egcS[lane] = __expf(g); }
        __syncthreads();
        if ((hv & 1) == 0) { const size_t kunit = (size_t)hk * GDN_NCH + n;
#pragma unroll
            for (int i = 0; i < 2; ++i) { const int p = tid + 512 * i, comb = p >> 6, ln = p & 63, t = comb >> 3, s = comb & 7; const int c = 32 * t + (ln & 31), k0 = 16 * s + 8 * (ln >> 5);
                *(v4u*)(QF + (kunit * 16 + comb) * 512 + ln * 8) = *(const LAS v4u*)(qS + c * 272 + k0 * 2); } }
#pragma unroll
        for (int i = 0; i < 2; ++i) { const int p = tid + 512 * i, row = p >> 4, ch = p & 15; const v4u kx = *(const LAS v4u*)(kS + row * 272 + ch * 16); const float b = betaS[row];
            v4u o; o.x = pk2(bflo(kx.x) * b, bfhi(kx.x) * b); o.y = pk2(bflo(kx.y) * b, bfhi(kx.y) * b); o.z = pk2(bflo(kx.z) * b, bfhi(kx.z) * b); o.w = pk2(bflo(kx.w) * b, bfhi(kx.w) * b);
            *(LAS v4u*)(kbS + row * 272 + ch * 16) = o; }
        __syncthreads();
        { const int which = wave >> 2, ti = (wave >> 1) & 1, tj = wave & 1;
          f32x16 acc;
#pragma unroll
          for (int r = 0; r < 16; ++r) acc[r] = 0.f;
          if (!(ti == 0 && tj == 1)) { const LAS unsigned char* Ab = (which == 0 ? kbS : qS) + (32 * ti + l31) * 272 + 16 * h; const LAS unsigned char* Bb = kS + (32 * tj + l31) * 272 + 16 * h;
#pragma unroll
              for (int s = 0; s < 8; ++s) acc = MFMA32(*(const LAS bf16x8*)(Ab + 32 * s), *(const LAS bf16x8*)(Bb + 32 * s), acc); }
          const int j = 32 * tj + l31; const float gj = gcS[j];
#pragma unroll
          for (int r = 0; r < 16; ++r) { const int i = 32 * ti + crow(r, h); const float e = __expf(fminf(gcS[i] - gj, 0.f));
              if (which == 0) Lm[i * 68 + j] = i > j ? acc[r] * e : 0.f;
              else IS[i * 72 + j] = (bf16)f2bf(i >= j ? acc[r] * e : 0.f); } }
        __syncthreads();
#pragma unroll
        for (int i = 0; i < 8; ++i) { const int e = tid + 512 * i, r = e >> 6, c = e & 63; *(LAS bf16*)(Lb + r * 144 + c * 2) = (bf16)f2bf(Lm[r * 68 + c]); }
        if (wave == 0) { const int b = lane >> 4, c = lane & 15; float t[16]; const LAS float* Ld = Lm + (16 * b) * 68 + 16 * b;
#pragma unroll
            for (int i = 0; i < 16; ++i) { float acc = i == c ? 1.f : 0.f;
#pragma unroll
                for (int j = 0; j < i; ++j) acc -= Ld[i * 68 + j] * t[j];
                t[i] = acc; *(LAS bf16*)(TDs + (b * 16 + i) * 32 + c * 2) = (bf16)f2bf(acc); }
        } else if (wave >= 4) { const int t2 = tid - 256;
#pragma unroll
            for (int i = 0; i < 2; ++i) { const int p = t2 + 256 * i, comb = p >> 6, ln = p & 63, t = comb >> 2, s = comb & 3; const int c = 32 * t + (ln & 31), j0 = 16 * s + 8 * (ln >> 5);
                *(v4u*)(INF + (su * 8 + comb) * 512 + ln * 8) = *(const LAS v4u*)(IS + c * 72 + j0); }
            if ((hv & 1) == 0) { const size_t kunit = (size_t)hk * GDN_NCH + n;
#pragma unroll
                for (int i = 0; i < 4; ++i) { const int p = t2 + 256 * i, comb = p >> 6, ln = p & 63, kt = comb >> 2, s = comb & 3; const int kd = 32 * kt + (ln & 31), c0 = 16 * s + 8 * (ln >> 5);
                    unsigned w[4];
#pragma unroll
                    for (int jj = 0; jj < 4; ++jj) { const unsigned lo = *(const LAS bf16*)(kS + (c0 + 2 * jj) * 272 + kd * 2), hi = *(const LAS bf16*)(kS + (c0 + 2 * jj + 1) * 272 + kd * 2); w[jj] = lo | (hi << 16); }
                    *(v4u*)(KTF + (kunit * 16 + comb) * 512 + ln * 8) = (v4u){w[0], w[1], w[2], w[3]}; } }
            if (t2 < 64) GC[su * GC_STRIDE + t2] = gcS[t2];
            else if (t2 == 64) GC[su * GC_STRIDE + 64] = gcS[63];
            else if (t2 == 65) GC[su * GC_STRIDE + 65] = egcS[63];
        }
        __syncthreads();
        { const int quad = lane >> 4, lc = lane & 15; LAS unsigned char* XTw = XT0 + wave * 1792; LAS unsigned char* YTw = YT0 + wave * 768;
          const bf16x8 z8 = (bf16x8){0, 0, 0, 0, 0, 0, 0, 0}; const f32x4 z4 = (f32x4){0.f, 0.f, 0.f, 0.f};
          bf16x8 tdf[4];
#pragma unroll
          for (int b = 0; b < 4; ++b) tdf[b] = quad < 2 ? *(const LAS bf16x8*)(TDs + (b * 16 + lc) * 32 + quad * 16) : z8;
#pragma unroll 1
          for (int tl = 0; tl < 2; ++tl) { const int col = 32 * wave + 16 * tl + lc;
              const LAS unsigned char* rz = wave < 4 ? vS + col * 2 : kbS + (col - 128) * 2; const LAS float* bz = wave < 4 ? betaS : egcS;
#pragma unroll
              for (int b = 0; b < 4; ++b) { f32x4 y;
#pragma unroll
                  for (int r = 0; r < 4; ++r) { const int i = 16 * b + 4 * quad + r; y[r] = bf2f(*(const LAS bf16*)(rz + i * 272)) * bz[i]; }
                  if (b >= 1) { f32x4 p = z4;
#pragma unroll
                      for (int kk = 0; kk < (b >= 3 ? 2 : 1); ++kk) { const bf16x8 af = *(const LAS bf16x8*)(Lb + (16 * b + lc) * 144 + (32 * kk + 8 * quad) * 2);
                          const bf16x8 bfv = (32 * kk + 8 * quad < 16 * b) ? *(const LAS bf16x8*)(XTw + lc * 112 + (32 * kk + 8 * quad) * 2) : z8;
                          p = __builtin_amdgcn_mfma_f32_16x16x32_bf16(af, bfv, p, 0, 0, 0); }
                      y = y - p; }
                  *(LAS v2u*)(YTw + lc * 48 + quad * 8) = (v2u){pk2(y[0], y[1]), pk2(y[2], y[3])};
                  asm volatile("" ::: "memory");
                  const bf16x8 yb = quad < 2 ? *(const LAS bf16x8*)(YTw + lc * 48 + quad * 16) : z8;
                  const f32x4 x = __builtin_amdgcn_mfma_f32_16x16x32_bf16(tdf[b], yb, z4, 0, 0, 0);
                  if (b < 3) *(LAS v2u*)(XTw + lc * 112 + (16 * b + 4 * quad) * 2) = (v2u){pk2(x[0], x[1]), pk2(x[2], x[3])};
                  asm volatile("" ::: "memory");
#pragma unroll
                  for (int r = 0; r < 4; ++r) XS[(16 * b + 4 * quad + r) * 264 + col] = (bf16)f2bf(x[r]); } } }
        __syncthreads();
#pragma unroll
        for (int i = 0; i < 2; ++i) { const int p = tid + 512 * i, comb = p >> 6, ln = p & 63, t = comb >> 3, s = comb & 7; const int c = 32 * t + (ln & 31), k0 = 16 * s + 8 * (ln >> 5);
            *(v4u*)(WF + (su * 16 + comb) * 512 + ln * 8) = *(const LAS v4u*)(XS + c * 264 + 128 + k0); }
        { const int t = wave >> 2, ns = wave & 3; unsigned w[8];
#pragma unroll
          for (int r = 0; r < 8; ++r) { const unsigned lo = XS[(32 * t + crow(2 * r, h)) * 264 + 32 * ns + l31], hi = XS[(32 * t + crow(2 * r + 1, h)) * 264 + 32 * ns + l31]; w[r] = lo | (hi << 16); }
          bf16* dst = UF + ((su * 8 + wave) * 64 + lane) * 16; *(v4u*)dst = (v4u){w[0], w[1], w[2], w[3]}; *(v4u*)(dst + 8) = (v4u){w[4], w[5], w[6], w[7]}; }
        __syncthreads();
    }
}

DI void ph_gdn_chain(const Frame& F, const Args& a, int n_lo, int n_hi) {
    const int xg = F.vcu >> 5, wx = F.vcu & 31; if (F.G != 256 ? F.vcu >= 128 : wx >= 20) return;
    const bool helper = F.G == 256 && wx >= 16;
    const int hv = F.G == 256 ? 4 * xg + (helper ? wx - 16 : wx >> 2) : F.vcu >> 2, ns = F.G == 256 ? wx & 3 : F.vcu & 3, hk = hv >> 1;
    const bf16* QN = (const bf16*)(a.ws + WS_SCR + SC_QN);
    const bf16* WF = (const bf16*)(a.ws + GD_WF); const bf16* UF = (const bf16*)(a.ws + GD_UF); const bf16* INF = (const bf16*)(a.ws + GD_IN); const bf16* KTF = (const bf16*)(a.ws + GD_KT); const bf16* QF = (const bf16*)(a.ws + GD_QF); const float* GC = (const float*)(a.ws + GD_GC);
    bf16* O = (bf16*)(a.ws + WS_SCR + SC_O);
    gu32* prog = F.ctl + CW_PROG + hv * 16;
    if (helper && GDN_NO_HELPER) return;
    if (helper) { unsigned sink = 0u; const int tid = F.tid;
        for (int n0 = n_lo; n0 < n_hi; n0 += 4) {
            if (n0 >= n_lo + 8) { if (tid == 0) { unsigned sp = 0; while ((int)__hip_atomic_load(prog, RLX_AGENT) < n0 - 4 && ++sp < 20000u) __builtin_amdgcn_s_sleep(8); } __syncthreads(); }
            unsigned v[5];
#pragma unroll
            for (int i = 0; i < 5; ++i) { const int li = tid + 512 * i;
                const int st = li / 580, ln = li % 580, n = n0 + st; const unsigned* p = nullptr;
                if (st < 4 && n < n_hi) { const size_t unit = (size_t)hv * GDN_NCH + n, kunit = (size_t)hk * GDN_NCH + n;
                    if (ln < 128) p = (const unsigned*)(WF + unit * 8192 + ln * 64);
                    else if (ln < 256) p = (const unsigned*)(UF + unit * 8192 + (ln - 128) * 64);
                    else if (ln < 320) p = (const unsigned*)(INF + unit * 4096 + (ln - 256) * 64);
                    else if (ln < 448) p = (const unsigned*)(KTF + kunit * 8192 + (ln - 320) * 64);
                    else if (ln < 576) p = (const unsigned*)(QF + kunit * 8192 + (ln - 448) * 64);
                    else if (ln < 579) p = (const unsigned*)(GC + unit * GC_STRIDE + (ln - 576) * 32); }
                v[i] = p ? *p : 0u; }
#pragma unroll
            for (int i = 0; i < 5; ++i) sink += v[i];
        }
        if (sink == 0x12345u) __hip_atomic_store(F.ctl + CW_TMO + 2, sink, RLX_AGENT);
        return; }
    LAS unsigned char* ST = F.lds + RING_OFF; LAS unsigned char* VN = ST + 8704; LAS unsigned char* VND = ST + 13312;
    const int lane = F.lane, wave = F.wave, l31 = lane & 31, h = lane >> 5;
    for (int i = F.tid; i < 8704 / 4; i += NWAVES * 64) ((LAS unsigned*)ST)[i] = 0u;
#define GDN_BAR() do { asm volatile("s_waitcnt lgkmcnt(0)" ::: "memory"); __builtin_amdgcn_s_barrier(); asm volatile("" ::: "memory"); } while (0)
    GDN_BAR();
    f32x16 S;
#pragma unroll
    for (int r = 0; r < 16; ++r) S[r] = 0.f;
    const int role = wave < 2 ? 0 : (wave < 4 ? 1 : 2); const int t = wave & 1, kt = wave & 3;
    bf16x8 A8[8]; bf16x8 A4[4]; v4u U0 = (v4u){0u, 0u, 0u, 0u}, U1 = U0; f32x4 G4[4]; float gl = 0.f, egl = 1.f;
#pragma unroll
    for (int s = 0; s < 8; ++s) A8[s] = (bf16x8){0, 0, 0, 0, 0, 0, 0, 0};
#pragma unroll
    for (int s = 0; s < 4; ++s) { A4[s] = (bf16x8){0, 0, 0, 0, 0, 0, 0, 0}; G4[s] = (f32x4){0.f, 0.f, 0.f, 0.f}; }
#define GDN_LOAD(nn) do { const size_t unit_ = (size_t)hv * GDN_NCH + (nn); const float* gc_ = GC + unit_ * GC_STRIDE; \
        if (role == 0) { \
            const bf16* up_ = UF + (((unit_ * 2 + t) * 4 + ns) * 64 + lane) * 16; U0 = *(const v4u*)up_; U1 = *(const v4u*)(up_ + 8); \
            _Pragma("unroll") for (int g = 0; g < 4; ++g) G4[g] = *(const f32x4*)(gc_ + 32 * t + 8 * g + 4 * h); gl = gc_[64]; } \
        else if (role == 1) { const size_t qunit_ = (size_t)hk * GDN_NCH + (nn); \
            _Pragma("unroll") for (int s = 0; s < 4; ++s) A4[s] = *(const bf16x8*)(INF + ((unit_ * 2 + t) * 4 + s) * 512 + lane * 8); \
            _Pragma("unroll") for (int g = 0; g < 4; ++g) G4[g] = *(const f32x4*)(gc_ + 32 * t + 8 * g + 4 * h); } \
        else { const size_t kunit_ = (size_t)hk * GDN_NCH + (nn); \
            _Pragma("unroll") for (int s = 0; s < 4; ++s) A4[s] = *(const bf16x8*)(KTF + ((kunit_ * 4 + kt) * 4 + s) * 512 + lane * 8); egl = gc_[65]; } } while (0)
    float* SV = (float*)(a.ws + GD_SAVE) + ((size_t)((hv * 4 + ns) * 4 + kt) * 64 + lane) * 16;
    if (n_lo > 0 && role == 2) {
#pragma unroll
        for (int g = 0; g < 4; ++g) { const f32x4 v = *(const f32x4*)(SV + 4 * g); S[4 * g] = v.x; S[4 * g + 1] = v.y; S[4 * g + 2] = v.z; S[4 * g + 3] = v.w;
            *(LAS v2u*)(ST + l31 * 272 + (32 * kt + 8 * g + 4 * h) * 2) = (v2u){pk2(v.x, v.y), pk2(v.z, v.w)}; }
    }
    GDN_BAR();
#define GDN_LOADA(AC, nn) do { if (role == 0) { const size_t u_ = (size_t)hv * GDN_NCH + (nn); _Pragma("unroll") for (int s = 0; s < 8; ++s) AC[s] = *(const bf16x8*)(WF + ((u_ * 2 + t) * 8 + s) * 512 + lane * 8); } \
        else if (role == 1) { const size_t q_ = (size_t)hk * GDN_NCH + (nn); _Pragma("unroll") for (int s = 0; s < 8; ++s) AC[s] = *(const bf16x8*)(QF + ((q_ * 2 + t) * 8 + s) * 512 + lane * 8); } } while (0)
    bf16x8 A8q[8];
#pragma unroll
    for (int s = 0; s < 8; ++s) A8q[s] = (bf16x8){0, 0, 0, 0, 0, 0, 0, 0};
    GDN_LOADA(A8, n_lo); if (n_lo + 1 < n_hi) GDN_LOADA(A8q, n_lo + 1);
    GDN_LOAD(n_lo);
#define GDN_STEP(n, AC) do { \
        bf16x8 a4[4]; const v4u u0 = U0, u1 = U1; f32x4 g4[4]; const float cgl = gl, cegl = egl; \
        _Pragma("unroll") \
        for (int s = 0; s < 4; ++s) { a4[s] = A4[s]; g4[s] = G4[s]; } \
        if (n + 1 < n_hi) GDN_LOAD(n + 1); \
        if (ns == 0 && F.tid == 0) __hip_atomic_store(prog, (unsigned)n, RLX_AGENT); \
        f32x16 acc; \
        _Pragma("unroll") \
        for (int r = 0; r < 16; ++r) acc[r] = 0.f; \
        if (role < 2) { \
        _Pragma("unroll") \
            for (int s = 0; s < 8; ++s) acc = MFMA32(AC[s], *(const LAS bf16x8*)(ST + l31 * 272 + 32 * s + 16 * h), acc); \
            asm volatile("" :: "v"(acc[0])); \
            if (n + 2 < n_hi) GDN_LOADA(AC, n + 2); \
        } \
        if (role == 0) { const unsigned uw[8] = {u0.x, u0.y, u0.z, u0.w, u1.x, u1.y, u1.z, u1.w}; \
        _Pragma("unroll") \
            for (int g = 0; g < 4; ++g) { float vn[4], vd[4]; \
        _Pragma("unroll") \
                for (int q = 0; q < 4; ++q) { const int r = 4 * g + q; const float uv = (r & 1) ? bfhi(uw[r >> 1]) : bflo(uw[r >> 1]); vn[q] = uv - acc[r]; vd[q] = vn[q] * __expf(cgl - g4[g][q]); } \
                *(LAS v2u*)(VN + l31 * 144 + (32 * t + 8 * g + 4 * h) * 2) = (v2u){pk2(vn[0], vn[1]), pk2(vn[2], vn[3])}; \
                *(LAS v2u*)(VND + l31 * 144 + (32 * t + 8 * g + 4 * h) * 2) = (v2u){pk2(vd[0], vd[1]), pk2(vd[2], vd[3])}; } \
        } else if (role == 1) { \
        _Pragma("unroll") \
            for (int g = 0; g < 4; ++g) \
        _Pragma("unroll") \
                for (int q = 0; q < 4; ++q) acc[4 * g + q] *= __expf(g4[g][q]); \
        } \
        GDN_BAR(); \
        if (role == 1) { \
        _Pragma("unroll") \
            for (int s = 0; s < 4; ++s) acc = MFMA32(a4[s], *(const LAS bf16x8*)(VN + l31 * 144 + 32 * s + 16 * h), acc); \
        _Pragma("unroll") \
            for (int r = 0; r < 16; ++r) { const int rr = chunk_row(n, 32 * t + crow(r, h)); if (rr >= 0) O[(size_t)rr * 4096 + hv * 128 + 32 * ns + l31] = (bf16)f2bf(acc[r]); } \
        } else if (role == 2) { \
        _Pragma("unroll") \
            for (int r = 0; r < 16; ++r) S[r] *= cegl; \
        _Pragma("unroll") \
            for (int s = 0; s < 4; ++s) S = MFMA32(a4[s], *(const LAS bf16x8*)(VND + l31 * 144 + 32 * s + 16 * h), S); \
        _Pragma("unroll") \
            for (int g = 0; g < 4; ++g) *(LAS v2u*)(ST + l31 * 272 + (32 * kt + 8 * g + 4 * h) * 2) = (v2u){pk2(S[4 * g], S[4 * g + 1]), pk2(S[4 * g + 2], S[4 * g + 3])}; \
        } \
        GDN_BAR(); \
    } while (0)
    for (int n2 = n_lo; n2 < n_hi; n2 += 2) { GDN_STEP(n2, A8); if (n2 + 1 < n_hi) GDN_STEP(n2 + 1, A8q); }
#undef GDN_STEP
#undef GDN_LOADA
    if (n_hi < GDN_NCH && role == 2) {
#pragma unroll
        for (int g = 0; g < 4; ++g) *(f32x4*)(SV + 4 * g) = (f32x4){S[4 * g], S[4 * g + 1], S[4 * g + 2], S[4 * g + 3]}; }
#undef GDN_LOAD
#undef GDN_BAR
}

constexpr int RW_NSC = 258, RW_UNITS = 129 * 16;
DI int sub_row(int sc, int t) { const int n = sc >> 1, sub = sc & 1; return n == 0 ? ((sub == 0 && t >= 16) ? TX + t - 16 : -1) : 64 * (n - 1) + 32 * sub + t; }
constexpr size_t RW_BASE = WS_PROJ + 92 * MiB;
constexpr size_t RW_RH = RW_BASE, RW_RL = RW_BASE + 33 * MiB, RW_GT = RW_BASE + 66 * MiB, RW_GAM = RW_BASE + 99 * MiB;
constexpr size_t RW_PR = WS_SCR + 195 * MiB, RW_AT = WS_SCR + 211 * MiB + 256 * 1024, RW_VTF = WS_SCR + 219 * MiB + 512 * 1024, RW_SALL = WS_SCR + 235 * MiB + 768 * 1024;
constexpr size_t RW_XSAVE = 1 * MiB + 640 * 1024;
constexpr size_t RW_VV = WS_YMIX + 34 * MiB, RW_BON = WS_YMIX + 52 * MiB, LR_H = WS_YMIX + 54 * MiB, LR_A = WS_YMIX + 56 * MiB, LR_C = WS_YMIX + 58 * MiB;
constexpr size_t RW_SCH = (size_t)RW_NSC * 16;
static_assert((size_t)MP * EV_NP * 2 <= 92 * MiB && RW_SCH * 8192 <= 33 * MiB && RW_GAM + RW_SCH * 256 <= WS_SCR, "rwkv map (proj region)");
static_assert(WS_SCR + SC_LIX + (size_t)MP * 4096 <= RW_PR && RW_PR + RW_SCH * 4096 <= RW_AT && RW_AT + RW_SCH * 2048 <= RW_VTF && RW_VTF + RW_SCH * 4096 <= RW_SALL && RW_SALL + RW_SCH * 8192 <= WS_END, "rwkv map (scratch region)");
static_assert((size_t)MP * DM * 2 <= 34 * MiB && RW_VV + (size_t)MP * 2048 <= RW_BON && RW_BON + (size_t)MP * 64 <= LR_H && LR_H + RW_SCH * 256 <= LR_A && LR_A + RW_SCH * 256 <= LR_C && LR_C + RW_SCH * 256 <= WS_PROJ, "rwkv map (ymix region)");

DI void sub_rows(int sc, int& t0, int& rbase) { if (sc >= 2) { t0 = 0; rbase = 64 * ((sc >> 1) - 1) + 32 * (sc & 1); } else if (sc == 0) { t0 = 16; rbase = TX - 16; } else { t0 = 32; rbase = 0; } }
DI void lru_local(const Frame& F, const Args& a) {
    const float* LA = (const float*)(a.ws + WS_SCR + SC_LA); const float* LIX = (const float*)(a.ws + WS_SCR + SC_LIX);
    float* HL = (float*)(a.ws + LR_H); float* AP = (float*)(a.ws + LR_A);
    for (int item = F.gw; item < RW_NSC * 16; item += F.NGW) { const int sc = item >> 4, c = (item & 15) * 64 + F.lane; int t0, rbase; sub_rows(sc, t0, rbase);
        float av[32], ix[32];
#pragma unroll
        for (int t = 0; t < 32; ++t) { const size_t o = (size_t)(rbase + (t >= t0 ? t : 32)) * 1024 + c; av[t] = LA[o]; ix[t] = LIX[o]; }
        float h = 0.f, p = 1.f;
#pragma unroll
        for (int t = 0; t < 32; ++t) { const float a_ = t >= t0 ? av[t] : 1.f, x_ = t >= t0 ? ix[t] : 0.f; h = a_ * h + sqrtf(fmaxf(1.0f - a_ * a_, 0.f)) * x_; p *= a_; }
        HL[sc * 1024 + c] = h; AP[sc * 1024 + c] = p; }
}
DI void lru_apply(const Frame& F, const Args& a) {
    const bf16* P = (const bf16*)(a.ws + WS_PROJ); const float* LA = (const float*)(a.ws + WS_SCR + SC_LA); const float* LIX = (const float*)(a.ws + WS_SCR + SC_LIX);
    const float* CR = (const float*)(a.ws + LR_C); bf16* Y = (bf16*)(a.ws + WS_YMIX);
    for (int item = F.gw; item < RW_NSC * 16; item += F.NGW) { const int sc = item >> 4, c = (item & 15) * 64 + F.lane; int t0, rbase; sub_rows(sc, t0, rbase); if (t0 >= 32) continue;
        float h = CR[sc * 1024 + c];
#pragma unroll
        for (int tb = 0; tb < 32; tb += 16) { float av[16], ix[16], gb[16];
#pragma unroll
            for (int t = 0; t < 16; ++t) { const size_t r_ = (size_t)(rbase + (tb + t >= t0 ? tb + t : 32)); av[t] = LA[r_ * 1024 + c]; ix[t] = LIX[r_ * 1024 + c]; gb[t] = bf2f(P[r_ * EV_NP + EV_GB + c]); }
#pragma unroll
            for (int t = 0; t < 16; ++t) { if (tb + t >= t0) { h = av[t] * h + sqrtf(fmaxf(1.0f - av[t] * av[t], 0.f)) * ix[t]; Y[(size_t)(rbase + tb + t) * DM + 1024 + c] = (bf16)f2bf(h * gelu_tanh(gb[t])); } } } }
}

DI void ph_rwkv_chunk(const Frame& F, const Args& a, int n_lo, int n_hi, int wg0) {
    if (F.vcu < wg0) return;
    const bf16* P = (const bf16*)(a.ws + WS_PROJ); const float* DEC = (const float*)(a.ws + WS_SCR + SC_DEC); const float* ICL = (const float*)(a.ws + WS_SCR + SC_ICL);
    bf16* RH = (bf16*)(a.ws + RW_RH); bf16* RL = (bf16*)(a.ws + RW_RL); bf16* GT = (bf16*)(a.ws + RW_GT); float* GAM = (float*)(a.ws + RW_GAM); bf16* PR = (bf16*)(a.ws + RW_PR); bf16* ATG = (bf16*)(a.ws + RW_AT); bf16* VTF = (bf16*)(a.ws + RW_VTF);
    bf16* VV = (bf16*)(a.ws + RW_VV); float* BON = (float*)(a.ws + RW_BON);
    LAS unsigned char* L = F.lds + RING_OFF;
    LAS float* wS = (LAS float*)L; LAS float* aS = wS + 4096; LAS float* bS = wS + 8192; LAS float* rS = wS + 12288; LAS float* kS = wS + 16384;
    LAS unsigned char* vT = L + 81920; LAS unsigned char* aT = L + 91136; LAS unsigned char* rT = L + 100352; LAS unsigned char* kT = L + 109568; LAS unsigned char* bT = L + 118784;
    LAS unsigned char* AT = L + 128000; LAS unsigned char* NT = L + 133120; LAS float* gam = (LAS float*)(L + 138240);
    LAS unsigned char* aTl = L; LAS unsigned char* bTl = L + 9216;
    const int tid = F.tid, lane = F.lane, wave = F.wave, l31 = lane & 31, h = lane >> 5;
    const float* mu = a.in[6];
    for (int unit = n_lo * 16 + (F.vcu - wg0); unit < n_hi * 16; unit += F.G - wg0) {
        const int n = unit >> 4, hd = unit & 15;
        { const int tok = tid >> 3, cg = tid & 7, c0 = hd * 64 + cg * 8; const int rr = sub_row(2 * n + (tok >> 5), tok & 31);
          float wv[8], av[8], bv[8], rv[8], kv[8], vv[8];
#pragma unroll
          for (int q = 0; q < 8; ++q) { wv[q] = 1.f; av[q] = 0.f; bv[q] = 0.f; rv[q] = 0.f; kv[q] = 0.f; vv[q] = 0.f; }
          if (rr >= 0) { const int pos = row_pos(rr); const bf16* cur = P + (size_t)rr * EV_NP + c0; const bf16* prv = pos > 0 ? P + (size_t)pos_row(pos - 1) * EV_NP + c0 : nullptr;
              const v4u z4 = (v4u){0u, 0u, 0u, 0u};
              const v4u cr = *(const v4u*)cur, ck = *(const v4u*)(cur + 1024), cv = *(const v4u*)(cur + 2048);
              const v4u qr = prv ? *(const v4u*)prv : z4, qk = prv ? *(const v4u*)(prv + 1024) : z4, qv = prv ? *(const v4u*)(prv + 2048) : z4;
              const unsigned crw[4] = {cr.x, cr.y, cr.z, cr.w}, ckw[4] = {ck.x, ck.y, ck.z, ck.w}, cvw[4] = {cv.x, cv.y, cv.z, cv.w}, qrw[4] = {qr.x, qr.y, qr.z, qr.w}, qkw[4] = {qk.x, qk.y, qk.z, qk.w}, qvw[4] = {qv.x, qv.y, qv.z, qv.w};
              float ss = 0.f, bon = 0.f; float kk[8], ic[8];
#pragma unroll
              for (int q = 0; q < 8; ++q) { const int c = c0 + q; const float crf = (q & 1) ? bfhi(crw[q >> 1]) : bflo(crw[q >> 1]), ckf = (q & 1) ? bfhi(ckw[q >> 1]) : bflo(ckw[q >> 1]), cvf = (q & 1) ? bfhi(cvw[q >> 1]) : bflo(cvw[q >> 1]);
                  const float prf = (q & 1) ? bfhi(qrw[q >> 1]) : bflo(qrw[q >> 1]), pkf = (q & 1) ? bfhi(qkw[q >> 1]) : bflo(qkw[q >> 1]), pvf = (q & 1) ? bfhi(qvw[q >> 1]) : bflo(qvw[q >> 1]);
                  rv[q] = crf + (prf - crf) * mu[c]; kk[q] = ckf + (pkf - ckf) * mu[1024 + c]; vv[q] = cvf + (pvf - cvf) * mu[2048 + c];
                  wv[q] = DEC[(size_t)rr * 1024 + c]; ic[q] = ICL[(size_t)rr * 1024 + c];
                  const float kkv = kk[q] * a.in[12][c]; av[q] = kkv; ss += kkv * kkv; kv[q] = kk[q] * (1.0f + (ic[q] - 1.0f) * a.in[13][c]); bon += rv[q] * kv[q] * a.in[14][c]; }
              ss += __shfl_xor(ss, 1); ss += __shfl_xor(ss, 2); ss += __shfl_xor(ss, 4); bon += __shfl_xor(bon, 1); bon += __shfl_xor(bon, 2); bon += __shfl_xor(bon, 4);
              const float inv = 1.0f / fmaxf(sqrtf(ss), 1e-12f);
#pragma unroll
              for (int q = 0; q < 8; ++q) { const float kkn = av[q] * inv; av[q] = -kkn; bv[q] = kkn * ic[q]; }
              if (cg == 0) BON[(size_t)rr * 16 + hd] = bon;
              *(v4u*)(VV + (size_t)rr * 1024 + c0) = (v4u){pk2(vv[0], vv[1]), pk2(vv[2], vv[3]), pk2(vv[4], vv[5]), pk2(vv[6], vv[7])}; }
          const int o = tok * 64 + cg * 8;
          *(LAS f32x4*)(wS + o) = (f32x4){wv[0], wv[1], wv[2], wv[3]}; *(LAS f32x4*)(wS + o + 4) = (f32x4){wv[4], wv[5], wv[6], wv[7]};
          *(LAS f32x4*)(aS + o) = (f32x4){av[0], av[1], av[2], av[3]}; *(LAS f32x4*)(aS + o + 4) = (f32x4){av[4], av[5], av[6], av[7]};
          *(LAS f32x4*)(bS + o) = (f32x4){bv[0], bv[1], bv[2], bv[3]}; *(LAS f32x4*)(bS + o + 4) = (f32x4){bv[4], bv[5], bv[6], bv[7]};
          *(LAS f32x4*)(rS + o) = (f32x4){rv[0], rv[1], rv[2], rv[3]}; *(LAS f32x4*)(rS + o + 4) = (f32x4){rv[4], rv[5], rv[6], rv[7]};
          *(LAS f32x4*)(kS + o) = (f32x4){kv[0], kv[1], kv[2], kv[3]}; *(LAS f32x4*)(kS + o + 4) = (f32x4){kv[4], kv[5], kv[6], kv[7]};
#pragma unroll
          for (int q = 0; q < 8; ++q) *(LAS bf16*)(vT + (cg * 8 + q) * 144 + tok * 2) = (bf16)f2bf(vv[q]); }
        __syncthreads();
        { const int p = wave >> 2, sub = (wave >> 1) & 1, half = wave & 1, sl = lane >> 2, q = lane & 3, s = 16 * half + sl, tok = 32 * sub + s, jq = 16 * q;
          const LAS float* x0p = (p == 0 ? kS : bS) + tok * 64 + jq; LAS unsigned char* OUT = p == 0 ? AT : NT;
          float x[16];
#pragma unroll
          for (int j = 0; j < 16; j += 4) { const f32x4 t4 = *(const LAS f32x4*)(x0p + j); x[j] = t4.x; x[j + 1] = t4.y; x[j + 2] = t4.z; x[j + 3] = t4.w; }
          if (half) {
#pragma unroll
              for (int i = 0; i < 4; ++i) *(LAS bf16*)(OUT + ((sub * 32 + 4 * q + i) * 40 + s) * 2) = (bf16)0; }
#pragma unroll 2
          for (int tp = 16 * half; tp < 32; ++tp) { const LAS float* bp = wS + (32 * sub + tp) * 64 + jq; const bool run = tp > s;
              f32x4 a4[4], w4[4], b4[4], r4[4];
#pragma unroll
              for (int g = 0; g < 4; ++g) { a4[g] = *(const LAS f32x4*)(bp + 4096 + 4 * g); w4[g] = *(const LAS f32x4*)(bp + 4 * g); b4[g] = *(const LAS f32x4*)(bp + 8192 + 4 * g); r4[g] = *(const LAS f32x4*)(bp + 12288 + 4 * g); }
              float c = 0.f;
#pragma unroll
              for (int g = 0; g < 4; ++g) { c += x[4 * g] * a4[g].x; c += x[4 * g + 1] * a4[g].y; c += x[4 * g + 2] * a4[g].z; c += x[4 * g + 3] * a4[g].w; }
              c += __builtin_bit_cast(float, __builtin_amdgcn_mov_dpp(__builtin_bit_cast(int, c), 0xB1, 0xF, 0xF, true));
              c += __builtin_bit_cast(float, __builtin_amdgcn_mov_dpp(__builtin_bit_cast(int, c), 0x4E, 0xF, 0xF, true));
              float o = 0.f;
#pragma unroll
              for (int g = 0; g < 4; ++g) { const float n0 = x[4 * g] * w4[g].x + c * b4[g].x, n1 = x[4 * g + 1] * w4[g].y + c * b4[g].y, n2 = x[4 * g + 2] * w4[g].z + c * b4[g].z, n3 = x[4 * g + 3] * w4[g].w + c * b4[g].w;
                  x[4 * g] = run ? n0 : x[4 * g]; x[4 * g + 1] = run ? n1 : x[4 * g + 1]; x[4 * g + 2] = run ? n2 : x[4 * g + 2]; x[4 * g + 3] = run ? n3 : x[4 * g + 3];
                  o += x[4 * g] * r4[g].x; o += x[4 * g + 1] * r4[g].y; o += x[4 * g + 2] * r4[g].z; o += x[4 * g + 3] * r4[g].w; }
              o += __builtin_bit_cast(float, __builtin_amdgcn_mov_dpp(__builtin_bit_cast(int, o), 0xB1, 0xF, 0xF, true));
              o += __builtin_bit_cast(float, __builtin_amdgcn_mov_dpp(__builtin_bit_cast(int, o), 0x4E, 0xF, 0xF, true));
              if (q == 0) *(LAS bf16*)(OUT + ((sub * 32 + tp) * 40 + s) * 2) = (bf16)f2bf(tp >= s ? o : 0.f); }
          LAS unsigned char* XT = p == 0 ? kT : bT;
#pragma unroll
          for (int j = 0; j < 16; ++j) *(LAS bf16*)(XT + (jq + j) * 144 + tok * 2) = (bf16)f2bf(x[j]);
          const bool gwave = (p == 0 && half == 1); const int j = lane;
          if (gwave) { float g = 1.f;
#pragma unroll
              for (int tp = 0; tp < 32; ++tp) { const int tk = 32 * sub + tp; const float w_ = wS[tk * 64 + j], a_ = aS[tk * 64 + j], r_ = rS[tk * 64 + j];
                  *(LAS bf16*)(aT + j * 144 + tk * 2) = (bf16)f2bf(a_ * g);
                  g *= w_; *(LAS bf16*)(rT + j * 144 + tk * 2) = (bf16)f2bf(r_ * g); }
              gam[sub * 64 + j] = g; }
        }
        __syncthreads();
        { const int sub = wave >> 2, t1 = (wave >> 1) & 1, t0 = wave & 1; const size_t sch = (size_t)hd * RW_NSC + (2 * n + sub);
          { f32x16 acc;
#pragma unroll
            for (int r = 0; r < 16; ++r) acc[r] = 0.f;
#pragma unroll
            for (int ks = 0; ks < 2; ++ks) { const int ao = (32 * t1 + l31) * 144 + (32 * sub + 16 * ks + 8 * h) * 2, bo = (32 * t0 + l31) * 144 + (32 * sub + 16 * ks + 8 * h) * 2;
                acc = MFMA32(*(const LAS bf16x8*)(aT + ao), *(const LAS bf16x8*)(bT + bo), acc); }
            const int jp = 32 * t0 + l31;
#pragma unroll
            for (int g = 0; g < 4; ++g) *(v2u*)(RH + (sch * 64 + jp) * 64 + 32 * t1 + 8 * g + 4 * h) = (v2u){pk2(acc[4 * g], acc[4 * g + 1]), pk2(acc[4 * g + 2], acc[4 * g + 3])};
            if (t1 == 0 && t0 == 0) GAM[sch * 64 + lane] = gam[sub * 64 + lane]; }
          { f32x16 acc;
#pragma unroll
            for (int r = 0; r < 16; ++r) acc[r] = 0.f;
#pragma unroll
            for (int ks = 0; ks < 2; ++ks) acc = MFMA32(*(const LAS bf16x8*)(kT + (32 * t1 + l31) * 144 + (32 * sub + 16 * ks + 8 * h) * 2), *(const LAS bf16x8*)(vT + (32 * t0 + l31) * 144 + (32 * sub + 16 * ks + 8 * h) * 2), acc);
            bf16* dst = GT + ((sch * 4 + t1 * 2 + t0) * 64 + lane) * 16;
            *(v4u*)dst = (v4u){pk2(acc[0], acc[1]), pk2(acc[2], acc[3]), pk2(acc[4], acc[5]), pk2(acc[6], acc[7])}; *(v4u*)(dst + 8) = (v4u){pk2(acc[8], acc[9]), pk2(acc[10], acc[11]), pk2(acc[12], acc[13]), pk2(acc[14], acc[15])}; } }
        if (wave < 4) { const int sub = wave >> 1, jt = wave & 1; const size_t sch = (size_t)hd * RW_NSC + (2 * n + sub);
            f32x16 acc;
#pragma unroll
            for (int r = 0; r < 16; ++r) acc[r] = bf2f(*(const LAS bf16*)(rT + (32 * jt + crow(r, h)) * 144 + (32 * sub + l31) * 2));
#pragma unroll
            for (int ks = 0; ks < 2; ++ks) acc = MFMA32(*(const LAS bf16x8*)(aT + (32 * jt + l31) * 144 + (32 * sub + 16 * ks + 8 * h) * 2), *(const LAS bf16x8*)(NT + (sub * 32 + l31) * 80 + (16 * ks + 8 * h) * 2), acc);
#pragma unroll
            for (int g = 0; g < 4; ++g) *(v2u*)(PR + (sch * 32 + l31) * 64 + 32 * jt + 8 * g + 4 * h) = (v2u){pk2(acc[4 * g], acc[4 * g + 1]), pk2(acc[4 * g + 2], acc[4 * g + 3])};
        } else { const int t2 = tid - 256, sub = t2 >> 7, t = (t2 >> 2) & 31, s8 = (t2 & 3) * 8; const size_t sch = (size_t)hd * RW_NSC + (2 * n + sub);
            *(v4u*)(ATG + (sch * 32 + t) * 32 + s8) = *(const LAS v4u*)(AT + (sub * 32 + t) * 80 + s8 * 2); }
        { const int sub = tid >> 8, it = (tid >> 7) & 1, ks = (tid >> 6) & 1; const size_t sch = (size_t)hd * RW_NSC + (2 * n + sub);
          *(v4u*)(VTF + ((sch * 4 + it * 2 + ks) * 64 + lane) * 8) = *(const LAS v4u*)(vT + (32 * it + l31) * 144 + (32 * sub + 16 * ks + 8 * h) * 2); }
        __syncthreads();
    }
}

DI void ph_rwkv_chain(const Frame& F, const Args& a, int sc_lo, int sc_hi) {
    if (F.vcu >= 16 && F.vcu < 18) { if (sc_hi < RW_NSC) return; const int c = (F.vcu - 16) * 512 + F.tid; const float* HL = (const float*)(a.ws + LR_H); const float* AP = (const float*)(a.ws + LR_A); float* CR = (float*)(a.ws + LR_C);
        float carry = 0.f;
#pragma unroll 8
        for (int sc = 0; sc < RW_NSC; ++sc) { const float hl = HL[sc * 1024 + c], ap = AP[sc * 1024 + c]; CR[sc * 1024 + c] = carry; carry = ap * carry + hl; }
        return; }
    if (F.vcu >= 16) return;
    const int hd = F.vcu; const bf16* RH = (const bf16*)(a.ws + RW_RH); const bf16* RL = (const bf16*)(a.ws + RW_RL); const bf16* GT = (const bf16*)(a.ws + RW_GT); const float* GAM = (const float*)(a.ws + RW_GAM); bf16* SALL = (bf16*)(a.ws + RW_SALL);
    constexpr int RW_NS = 7, SLOT = 8192 + 8192 + 1024;
    LAS unsigned char* XS = F.lds + RING_OFF; LAS unsigned char* RG = XS + 2 * 9216;
    const int lane = F.lane, wave = F.wave, l31 = lane & 31, h = lane >> 5, jt = (wave >> 1) & 1, it = wave & 1, lw = wave & 3;
    for (int i = F.tid; i < 2 * 9216 / 4; i += NWAVES * 64) ((LAS unsigned*)XS)[i] = 0u;
    __syncthreads();
#define RW_BAR() do { asm volatile("s_waitcnt lgkmcnt(0)" ::: "memory"); __builtin_amdgcn_s_barrier(); asm volatile("" ::: "memory"); } while (0)
    const unsigned rg0 = (unsigned)(uintptr_t)RG;
    int offR[2], offG[2];
#pragma unroll
    for (int i = 0; i < 2; ++i) { const int b = 2 * lw + i, row = 8 * b + (lane >> 3), pc = lane & 7; offR[i] = row * 64 + ((pc ^ (row & 7)) * 8); offG[i] = (b * 64 + lane) * 8; }
    const int offM = (lane & 15) * 4;
#define RW_DMA(src, dst) do { unsigned keep_; asm volatile("s_mov_b32 %0, m0\n\ts_mov_b32 m0, %2\n\ts_nop 0\n\tglobal_load_lds_dwordx4 %1, off\n\ts_mov_b32 m0, %0" : "=&s"(keep_) : "v"(src), "s"(dst) : "memory"); } while (0)
#define RW_ISSUE(scn) do { const int s_ = (scn) < RW_NSC ? (scn) : RW_NSC - 1; const size_t sch_ = (size_t)hd * RW_NSC + s_; \
        const unsigned sb_ = (unsigned)__builtin_amdgcn_readfirstlane((int)(rg0 + (unsigned)((scn) % RW_NS) * SLOT)); \
        _Pragma("unroll") for (int i_ = 0; i_ < 2; ++i_) { const unsigned bo_ = (unsigned)__builtin_amdgcn_readfirstlane((2 * lw + i_) * 1024); \
            RW_DMA(RH + sch_ * 4096 + offR[i_], sb_ + bo_); RW_DMA(GT + sch_ * 4096 + offG[i_], sb_ + 8192 + bo_); } \
        RW_DMA(GAM + sch_ * 64 + offM, sb_ + 16384); } while (0)
#define RW_WAITV(n) asm volatile("s_waitcnt vmcnt(" #n ")" ::: "memory")
    f32x16 X;
#pragma unroll
    for (int r = 0; r < 16; ++r) X[r] = 0.f;
    float* XSV = (float*)(a.ws + RW_XSAVE) + ((size_t)(hd * 4 + (wave & 3)) * 64 + lane) * 16;
    if (wave < 4 && sc_lo > 0) {
#pragma unroll
        for (int g = 0; g < 4; ++g) { const f32x4 v = *(const f32x4*)(XSV + 4 * g); X[4 * g] = v.x; X[4 * g + 1] = v.y; X[4 * g + 2] = v.z; X[4 * g + 3] = v.w;
            *(LAS v2u*)(XS + (32 * it + l31) * 144 + (32 * jt + 8 * g + 4 * h) * 2) = (v2u){pk2(v.x, v.y), pk2(v.z, v.w)}; } }
    if (wave >= 4) { RW_ISSUE(sc_lo); RW_ISSUE(sc_lo + 1); RW_ISSUE(sc_lo + 2); RW_ISSUE(sc_lo + 3); RW_ISSUE(sc_lo + 4); RW_ISSUE(sc_lo + 5); RW_WAITV(25); }
    RW_BAR();
    for (int sc = sc_lo; sc < sc_hi; ++sc) {
        if (wave < 4) {
            const LAS unsigned char* sb = RG + (sc % RW_NS) * SLOT;
            f32x16 acc; const size_t sch = (size_t)hd * RW_NSC + sc;
            { const v4u g0 = *(const LAS v4u*)(sb + 8192 + ((jt * 2 + it) * 64 + lane) * 32), g1 = *(const LAS v4u*)(sb + 8192 + ((jt * 2 + it) * 64 + lane) * 32 + 16);
              const unsigned gw_[8] = {g0.x, g0.y, g0.z, g0.w, g1.x, g1.y, g1.z, g1.w};
#pragma unroll
              for (int g = 0; g < 4; ++g) { const f32x4 m = *(const LAS f32x4*)(sb + 16384 + (32 * jt + 8 * g + 4 * h) * 4);
                  acc[4 * g] = bflo(gw_[2 * g]) + m.x * X[4 * g]; acc[4 * g + 1] = bfhi(gw_[2 * g]) + m.y * X[4 * g + 1]; acc[4 * g + 2] = bflo(gw_[2 * g + 1]) + m.z * X[4 * g + 2]; acc[4 * g + 3] = bfhi(gw_[2 * g + 1]) + m.w * X[4 * g + 3]; } }
#pragma unroll
            for (int g = 0; g < 4; ++g) *(v2u*)(SALL + (sch * 64 + 32 * it + l31) * 64 + 32 * jt + 8 * g + 4 * h) = (v2u){pk2(X[4 * g], X[4 * g + 1]), pk2(X[4 * g + 2], X[4 * g + 3])};
            const LAS unsigned char* xb = XS + (sc & 1) * 9216 + (32 * it + l31) * 144 + 16 * h; const int ar = 32 * jt + l31; const LAS unsigned char* ab = sb + ar * 128;
#pragma unroll
            for (int ks = 0; ks < 4; ++ks) { const bf16x8 xf = *(const LAS bf16x8*)(xb + 32 * ks); const int po = (((2 * ks + h) ^ (ar & 7)) * 16);
                acc = MFMA32(*(const LAS bf16x8*)(ab + po), xf, acc); }
            X = acc;
            LAS unsigned char* xn = XS + ((sc + 1) & 1) * 9216 + (32 * it + l31) * 144;
#pragma unroll
            for (int g = 0; g < 4; ++g) *(LAS v2u*)(xn + (32 * jt + 8 * g + 4 * h) * 2) = (v2u){pk2(X[4 * g], X[4 * g + 1]), pk2(X[4 * g + 2], X[4 * g + 3])};
        } else {
            RW_ISSUE(sc + RW_NS - 1);
            RW_WAITV(25);
        }
        RW_BAR();
    }
    if (wave >= 4) RW_WAITV(0);
    else if (sc_hi < RW_NSC) {
#pragma unroll
        for (int g = 0; g < 4; ++g) *(f32x4*)(XSV + 4 * g) = (f32x4){X[4 * g], X[4 * g + 1], X[4 * g + 2], X[4 * g + 3]}; }
#undef RW_ISSUE
#undef RW_DMA
#undef RW_WAITV
#undef RW_BAR
}

DI void ph_rwkv_out(const Frame& F, const Args& a) {
    const bf16* SALL = (const bf16*)(a.ws + RW_SALL); const bf16* PR = (const bf16*)(a.ws + RW_PR); const bf16* ATG = (const bf16*)(a.ws + RW_AT); const bf16* VTF = (const bf16*)(a.ws + RW_VTF);
    const bf16* VV = (const bf16*)(a.ws + RW_VV); const float* BON = (const float*)(a.ws + RW_BON); const float* GATE = (const float*)(a.ws + WS_SCR + SC_GATE); bf16* Y = (bf16*)(a.ws + WS_YMIX);
    const int lane = F.lane, l31 = lane & 31, h = lane >> 5;
    for (int item = F.gw; item < RW_NSC * 16; item += F.NGW) { const int sc = item >> 4, hd = item & 15; if (sc == 1) continue;
        const size_t sch = (size_t)hd * RW_NSC + sc; f32x16 acc[2];
#pragma unroll
        for (int it = 0; it < 2; ++it) {
#pragma unroll
            for (int r = 0; r < 16; ++r) acc[it][r] = 0.f;
#pragma unroll
            for (int ks = 0; ks < 4; ++ks) acc[it] = MFMA32(*(const bf16x8*)(SALL + (sch * 64 + 32 * it + l31) * 64 + 16 * ks + 8 * h), *(const bf16x8*)(PR + (sch * 32 + l31) * 64 + 16 * ks + 8 * h), acc[it]);
#pragma unroll
            for (int ks = 0; ks < 2; ++ks) acc[it] = MFMA32(*(const bf16x8*)(VTF + ((sch * 4 + it * 2 + ks) * 64 + lane) * 8), *(const bf16x8*)(ATG + (sch * 32 + l31) * 32 + 16 * ks + 8 * h), acc[it]); }
        float s1 = 0.f;
#pragma unroll
        for (int it = 0; it < 2; ++it)
#pragma unroll
            for (int r = 0; r < 16; ++r) s1 += acc[it][r];
        s1 += __shfl_xor(s1, 32); const float mean = s1 * (1.0f / 64.0f); float s2 = 0.f;
#pragma unroll
        for (int it = 0; it < 2; ++it)
#pragma unroll
            for (int r = 0; r < 16; ++r) { const float d = acc[it][r] - mean; s2 += d * d; }
        s2 += __shfl_xor(s2, 32); const float rstd = 1.0f / sqrtf(s2 * (1.0f / 64.0f) + 64e-5f);
        const int rr = sub_row(sc, l31);
        if (rr >= 0) { const float bon = BON[(size_t)rr * 16 + hd];
#pragma unroll
            for (int it = 0; it < 2; ++it)
#pragma unroll
                for (int g = 0; g < 4; ++g) { const int c = hd * 64 + 32 * it + 8 * g + 4 * h;
                    const f32x4 lw = *(const f32x4*)(a.in[15] + c), lb = *(const f32x4*)(a.in[16] + c), gt = *(const f32x4*)(GATE + (size_t)rr * 1024 + c); const v2u vw = *(const v2u*)(VV + (size_t)rr * 1024 + c);
                    const float o0 = ((acc[it][4 * g] - mean) * rstd * lw.x + lb.x + bon * bflo(vw.x)) * gt.x, o1 = ((acc[it][4 * g + 1] - mean) * rstd * lw.y + lb.y + bon * bfhi(vw.x)) * gt.y;
                    const float o2 = ((acc[it][4 * g + 2] - mean) * rstd * lw.z + lb.z + bon * bflo(vw.y)) * gt.z, o3 = ((acc[it][4 * g + 3] - mean) * rstd * lw.w + lb.w + bon * bfhi(vw.y)) * gt.w;
                    *(v2u*)(Y + (size_t)rr * DM + c) = (v2u){pk2(o0, o1), pk2(o2, o3)}; } }
    }
    lru_apply(F, a);
}

constexpr int N_PHASES = 33;
template <class Epi, class Sched> DI void run_gemm(const Frame& F, const pg8::Gemm& g, const Sched& S, const Epi& E) {
    pg8::gemm_phase<Epi, Sched, true, true>(F.lds + RING_OFF, g, S, E);
}
DI void moe_up_units(const Frame& F, const Args& a, int t0, int ntl, int G, int c) {
    pg8::Gemm g{(const bf16*)(a.ws + WS_SCR + SC_XG), (const bf16*)(a.ws + WS_MOEW), DM, DM, DM};
    pg8::MoeOrder S{(const int*)(a.ws + WS_TILES), t0, ntl, 4, G, c, (long)MOE_E_BYTES};
    pg8::EpiSwiglu E{(bf16*)(a.ws + WS_SCR + SC_ACT), FF};
    run_gemm(F, g, S, E);
}
DI void moe_down_units(const Frame& F, const Args& a, int t0, int ntl, int G, int c) {
    pg8::Gemm g{(const bf16*)(a.ws + WS_SCR + SC_ACT), (const bf16*)(a.ws + WS_MOEW + MOE_W2_OFF), FF, FF, FF};
    pg8::MoeOrder S{(const int*)(a.ws + WS_TILES), t0, ntl, 8, G, c, (long)MOE_E_BYTES};
    pg8::EpiBf16 E{(bf16*)(a.ws + WS_SCR + SC_YB), DM};
    run_gemm(F, g, S, E);
}
DI void ph_moe_a(const Frame& F, const Args& a) {
    const int nt = (int)__hip_atomic_load((gu32*)(a.ws + WS_TILES) + 127, RLX_AGENT), n1 = nt < 64 ? nt : 64;
    moe_up_units(F, a, 0, n1, F.G, (int)blockIdx.x);
}
DI void ph_moe_b(const Frame& F, const Args& a) {
    const int nt = (int)__hip_atomic_load((gu32*)(a.ws + WS_TILES) + 127, RLX_AGENT), n1 = nt < 64 ? nt : 64; const int c = (int)blockIdx.x;
    int nu = 4 * (nt - n1); if (nu > F.G / 2) nu = F.G / 2;
    if (c < nu) moe_up_units(F, a, n1, nt - n1, nu, c); else moe_down_units(F, a, 0, n1, F.G - nu, c - nu);
}
DI void ph_moe_c(const Frame& F, const Args& a) {
    const int nt = (int)__hip_atomic_load((gu32*)(a.ws + WS_TILES) + 127, RLX_AGENT), n1 = nt < 64 ? nt : 64;
    moe_down_units(F, a, n1, nt - n1, F.G, (int)blockIdx.x);
}

DI void gemm_tail16(const Frame& F, const Args& a, const bf16* A, int lda, const bf16* Wt, int K, int mode) {
    if (F.vcu >= 128) return;
    const int lane = F.lane, lc = lane & 15, quad = lane >> 4, w = F.vcu; LAS float* red = (LAS float*)(F.lds + RING_OFF);
    f32x4 acc = (f32x4){0.f, 0.f, 0.f, 0.f}; const int kw = K / NWAVES, kb = F.wave * kw;
    const bf16* ap = A + (size_t)(TX + lc) * lda + kb + 8 * quad; const bf16* bp = Wt + (size_t)(16 * w + lc) * K + kb + 8 * quad;
#pragma unroll 4
    for (int ks = 0; ks < kw / 32; ++ks) acc = __builtin_amdgcn_mfma_f32_16x16x32_bf16(*(const bf16x8*)(ap + 32 * ks), *(const bf16x8*)(bp + 32 * ks), acc, 0, 0, 0);
    *(LAS f32x4*)(red + (F.wave * 64 + lane) * 4) = acc;
    __syncthreads();
    if (F.wave == 0) { f32x4 s = *(const LAS f32x4*)(red + lane * 4);
#pragma unroll
        for (int v = 1; v < NWAVES; ++v) s = s + *(const LAS f32x4*)(red + (v * 64 + lane) * 4);
        float* H = (float*)(a.ws + WS_H);
#pragma unroll
        for (int r = 0; r < 4; ++r) { const int row = 4 * quad + r, col = 16 * w + lc; const float base = mode ? H[(size_t)(TX + row) * DM + col] : a.in[1][(size_t)row * DM + col];
            H[(size_t)(TX + row) * DM + col] = base + s[r]; } }
    __syncthreads();
}

__global__ void __launch_bounds__(NWAVES * 64, 2) hyb_fwd(Args a) {
    extern __shared__ __attribute__((aligned(16))) unsigned char lds[];
    Frame F;
    F.lds = (LAS unsigned char*)lds;
    F.MISC = (volatile LAS unsigned*)(F.lds + MISC_OFF);
    F.tid = threadIdx.x; F.lane = F.tid & 63; F.wave = __builtin_amdgcn_readfirstlane(F.tid >> 6);
    F.G = gridDim.x; { const int bx = blockIdx.x; F.vcu = (F.G % 8 == 0) ? (bx % 8) * (F.G / 8) + bx / 8 : bx; }
    F.gw = F.vcu * NWAVES + F.wave; F.NGW = F.G * NWAVES;
    F.ctl = (gu32*)(a.ws + WS_CTL);
    for (int u = F.tid; u < (LDS_BYTES - LDSCTL_OFF) / 4; u += NWAVES * 64) ((LAS unsigned*)(F.lds + LDSCTL_OFF))[u] = 0u;
    __syncthreads();
    XcdBarrier bar; bar.bar = (unsigned*)(F.ctl + CW_BAR); bar.x = 0; bar.st = nullptr;
    if (MK_ONE_LAUNCH) bar = xcd_barrier_post((unsigned*)(F.ctl + CW_BAR), F.MISC + 8);
    const int lo = a.ph_lo, hi = a.ph_hi;
#ifndef PH_MASK
#define PH_MASK 0xFFFFFFFFFFFFFFFFull
#endif
#define IN(k) ((((unsigned long long)(PH_MASK) >> (k)) & 1ull) && lo <= (k) && (k) < hi)
#ifndef PROBE_REP
#define PROBE_REP 0u
#endif
#define REP(k) ((((unsigned long long)(PROBE_REP) >> (k)) & 1ull) ? 2 : 1)
#ifdef PROBE_TS
#define STAMP(k) do { if (blockIdx.x == 0 && F.tid == 0) ((unsigned long long*)(F.ctl + CW_TS))[(k)] = __builtin_amdgcn_s_memrealtime(); } while (0)
#else
#define STAMP(k) do { } while (0)
#endif
#define PHASE(k, ...) do { if (IN(k)) { { const int PH_REP_ = 0; (void)PH_REP_; __VA_ARGS__; } if (REP(k) == 2) { __syncthreads(); { const int PH_REP_ = 1; (void)PH_REP_; __VA_ARGS__; } } } } while (0)
#define SEAM(k) do { if (IN(k) && IN((k) + 1)) xcd_barrier(bar); STAMP((k) + 1); } while (0)
    const bf16* HN = (const bf16*)(a.ws + WS_HN); bf16* PROJ = (bf16*)(a.ws + WS_PROJ); const bf16* YMIX = (const bf16*)(a.ws + WS_YMIX); float* H = (float*)(a.ws + WS_H);

    STAMP(0);
    PHASE(0, { ph_prologue(F, a); ph_aux_convert(F, a, F.gw, F.NGW); });
    SEAM(0);
    PHASE(1, { pg8::Gemm g{HN, (const bf16*)(a.ws + WS_WEVIN), DM, DM, DM}; pg8::StaticOrder S; S.init(MP, EV_NP, F.G, (int)blockIdx.x); pg8::EpiBf16 E{PROJ, EV_NP}; run_gemm(F, g, S, E); });
    SEAM(1);
    PHASE(2, ph_even_prep(F, a););
    SEAM(2);
    PHASE(3, {
        { pg8::Gemm g{(const bf16*)(a.ws + WS_SCR + SC_ALORA), (const bf16*)(a.ws + WS_WLORA), 384, 384, 384}; pg8::StaticOrder S; S.init(MP, 3072, F.G, (int)blockIdx.x);
          static_assert(SC_ICL - SC_DEC == SC_GATE - SC_ICL, "lora outputs equally spaced");
          pg8::EpiLora E{(float*)(a.ws + WS_SCR + SC_DEC), (long)((SC_ICL - SC_DEC) / 4), a.in[7], a.in[9]}; run_gemm(F, g, S, E); }
        { pg8::Gemm g{(const bf16*)(a.ws + WS_SCR + SC_XR), (const bf16*)(a.ws + WS_WGATE), 256, 1024, 256}; pg8::StaticOrder S; S.init(MP, 2048, F.G, (int)blockIdx.x); S.amod = 4; S.astep = 512;
          pg8::EpiGates E{(float*)(a.ws + WS_SCR + SC_LA), (float*)(a.ws + WS_SCR + SC_LIX), a.in[20], a.in[22], a.in[23], (const bf16*)(a.ws + WS_SCR + SC_XR)}; run_gemm(F, g, S, E); }
    });
    SEAM(3);
    PHASE(4, { lru_local(F, a); ph_rwkv_chunk(F, a, 0, 32, 0); });
    SEAM(4);
    PHASE(5, { if (F.vcu < 16) ph_rwkv_chain(F, a, 0, 64); else ph_rwkv_chunk(F, a, 32, 62, 16); });
    SEAM(5);
    PHASE(6, { if (F.vcu < 16) ph_rwkv_chain(F, a, 64, 124); else ph_rwkv_chunk(F, a, 62, 92, 16); });
    SEAM(6);
    PHASE(7, { if (F.vcu < 16) ph_rwkv_chain(F, a, 124, 184); else ph_rwkv_chunk(F, a, 92, 122, 16); });
    SEAM(7);
    PHASE(8, { if (F.vcu < 16) ph_rwkv_chain(F, a, 184, 244); else ph_rwkv_chunk(F, a, 122, 129, 16); });
    SEAM(8);
    PHASE(9, { if (F.vcu < 18) ph_rwkv_chain(F, a, 244, RW_NSC); });
    SEAM(9);
    PHASE(10, ph_rwkv_out(F, a););
    SEAM(10);
    PHASE(11, { pg8::Gemm g{YMIX, (const bf16*)(a.ws + WS_WEVOUT), DM, DM, DM}; pg8::StaticOrder S; S.init(TX, DM, F.G, (int)blockIdx.x); pg8::EpiResid E{H, a.in[0], a.in[1], 0}; run_gemm(F, g, S, E); gemm_tail16(F, a, YMIX, DM, (const bf16*)(a.ws + WS_WEVOUT), DM, 0); });
    SEAM(11);
    PHASE(12, ph_route(F, a, 0, PH_REP_););
    SEAM(12);
    PHASE(13, ph_gather(F, a, 0););
    SEAM(13);
    PHASE(14, ph_moe_a(F, a););
    SEAM(14);
    PHASE(15, ph_moe_b(F, a););
    SEAM(15);
    PHASE(16, ph_moe_c(F, a););
    SEAM(16);
    PHASE(17, ph_combine(F, a, 0););
    SEAM(17);
    PHASE(18, { pg8::Gemm g{HN, (const bf16*)(a.ws + WS_WODIN), DM, DM, DM}; pg8::StaticOrder S; S.init(MP, OD_NP, F.G, (int)blockIdx.x); pg8::EpiBf16 E{PROJ, OD_NP}; run_gemm(F, g, S, E); });
    SEAM(18);
    PHASE(19, ph_odd_prep(F, a););
    SEAM(19);
    PHASE(20, ph_gdn_chunk(F, a, 0, 33, 0););
    SEAM(20);
    PHASE(21, { ph_gdn_chain(F, a, 0, 33); ph_gdn_chunk(F, a, 33, 65, 1); });
    SEAM(21);
    PHASE(22, { ph_gdn_chain(F, a, 33, 65); ph_gdn_chunk(F, a, 65, 97, 1); });
    SEAM(22);
    PHASE(23, { ph_gdn_chain(F, a, 65, 97); ph_gdn_chunk(F, a, 97, 129, 1); });
    SEAM(23);
    PHASE(24, ph_gdn_chain(F, a, 97, 129););
    SEAM(24);
    PHASE(25, { ph_odd_post(F, a); moe_convert(F, a, 1, F.gw, F.NGW); });
    SEAM(25);
    PHASE(26, { pg8::Gemm g{YMIX, (const bf16*)(a.ws + WS_WODOUT), 4096, 4096, 4096}; pg8::StaticOrder S; S.init(TX, DM, F.G, (int)blockIdx.x); pg8::EpiResid E{H, a.in[0], a.in[1], 1}; run_gemm(F, g, S, E); gemm_tail16(F, a, YMIX, 4096, (const bf16*)(a.ws + WS_WODOUT), 4096, 1); });
    SEAM(26);
    PHASE(27, ph_route(F, a, 1, PH_REP_););
    SEAM(27);
    PHASE(28, ph_gather(F, a, 1););
    SEAM(28);
    PHASE(29, ph_moe_a(F, a););
    SEAM(29);
    PHASE(30, ph_moe_b(F, a););
    SEAM(30);
    PHASE(31, ph_moe_c(F, a););
    SEAM(31);
    PHASE(32, ph_combine(F, a, 1););
#ifdef PROBE_BARS
    for (int i_ = 0; i_ < PROBE_BARS; ++i_) xcd_barrier(bar);
#endif
#undef IN
#undef SEAM
}

extern "C" void kernel_launch(void* const* d_in, const int* in_sizes, int n_in, void* d_out, int out_size, void* d_ws, size_t ws_size, hipStream_t stream) {
    static int grid = 0;
    if (grid == 0) {
        if (n_in != 36 || out_size != TX * DM || ws_size < WS_END) { fprintf(stderr, "kernel_launch: unexpected shapes (n_in %d, out %d, ws %zu)\n", n_in, out_size, ws_size); grid = -1; return; }
        int dev = 0, cus = 0, per_cu = 0;
        if (hipGetDevice(&dev) != hipSuccess || hipDeviceGetAttribute(&cus, hipDeviceAttributeMultiprocessorCount, dev) != hipSuccess) { grid = -1; return; }
        if (hipFuncSetAttribute((const void*)hyb_fwd, hipFuncAttributeMaxDynamicSharedMemorySize, LDS_BYTES) != hipSuccess) { fprintf(stderr, "kernel_launch: hipFuncSetAttribute failed\n"); grid = -1; return; }
        if (hipOccupancyMaxActiveBlocksPerMultiprocessor(&per_cu, (const void*)hyb_fwd, NWAVES * 64, LDS_BYTES) != hipSuccess || per_cu < 1) { fprintf(stderr, "kernel_launch: occupancy query says %d\n", per_cu); per_cu = 1; }
        (void)hipGetLastError();
        grid = cus;
    }
    if (grid < 0) return;
    if (hipMemsetAsync((char*)d_ws + WS_CTL, 0, CTL_ZERO_BYTES, stream) != hipSuccess) return;
    Args a{};
    for (int i = 0; i < 36; ++i) a.in[i] = (const float*)d_in[i];
    a.out = (float*)d_out; a.ws = (unsigned char*)d_ws;
#if MK_ONE_LAUNCH
    a.ph_lo = 0; a.ph_hi = N_PHASES;
    hipLaunchKernelGGL(hyb_fwd, dim3(grid), dim3(NWAVES * 64), LDS_BYTES, stream, a);
#else
    for (int p = 0; p < N_PHASES; ++p) { a.ph_lo = p; a.ph_hi = p + 1; hipLaunchKernelGGL(hyb_fwd, dim3(grid), dim3(NWAVES * 64), LDS_BYTES, stream, a); }
#endif
}
```

```cpp
#include <hip/hip_runtime.h>
#include <cstdio>
#include <cstdint>
#include <cmath>

#ifndef MK_ONE_LAUNCH
#define MK_ONE_LAUNCH 1
#endif

namespace pg8 {
#define PG8_LAS __attribute__((address_space(3)))
typedef unsigned short bf16_t;
typedef short bf16x8 __attribute__((ext_vector_type(8)));
typedef float f32x4 __attribute__((ext_vector_type(4)));
typedef unsigned u32x4 __attribute__((ext_vector_type(4)));
typedef unsigned u32x2 __attribute__((ext_vector_type(2)));
constexpr int BM = 256, BK = 64, HALF = 128, HTB = HALF * BK * 2  , STAGE_BYTES = 8 * HTB, NXCD = 8, WGM = 8;

__host__ __device__ __forceinline__ int lds_byte(int r, int c) { const int st = (r >> 4) * 2 + (c >> 5), rr = r & 15, cc = c & 31, ob = rr * 64 + cc * 2; return st * 1024 + (ob ^ (((ob >> 9) & 1) << 5)); }
__host__ __device__ __forceinline__ void stage_rc(int b, int& R, int& C) { const int st = b / 1024, sb = b % 1024, swz = sb ^ (((sb >> 9) & 1) << 5); R = (st >> 1) * 16 + swz / 64; C = (st & 1) * 32 + (swz % 64) / 2; }
__host__ __device__ __forceinline__ int perm32(int rho) { const int n = rho >> 4, i = rho & 15; return 8 * (i >> 2) + 4 * n + (i & 3); }

struct Unit { int pm, pn; long aoff, boff; };
struct Gemm { const bf16_t* A; const bf16_t* Bt; int K, lda, ldb; };

struct StaticOrder {
    int nM, nN, nwg, G, c, amod; long astep;
    __host__ __device__ void init(int M, int N, int G_, int c_) { nM = M / BM; nN = N / BM; nwg = nM * nN; G = G_; c = c_; amod = 0; astep = 0; }
    __host__ __device__ bool next(int i, Unit& u) const {
        const long L = (long)i * G + c; if (L >= nwg) return false;
        int wgid = (int)L; { const int q = nwg / NXCD, r = nwg % NXCD, xcd = wgid % NXCD, off = wgid / NXCD; wgid = (xcd < r ? xcd * (q + 1) : r * (q + 1) + (xcd - r) * q) + off; }
        const int nig = WGM * nN, gid = wgid / nig, fm = gid * WGM, gsz = (nM - fm) < WGM ? (nM - fm) : WGM;
        u.pm = fm + ((wgid % nig) % gsz); u.pn = (wgid % nig) / gsz; u.boff = 0; u.aoff = amod ? (long)(u.pn % amod) * astep : 0; return true;
    }
    __device__ __forceinline__ void a_ready(const Unit&) const {}
    __device__ __forceinline__ void done(const Unit&) const {}
};
struct MoeOrder {
    const int* tile_e; int t0, ntiles, npn, G, c; long bstride;
    __device__ __forceinline__ bool next(int i, Unit& u) const {
        const long L = (long)i * G + c; if (c < 0 || L >= (long)ntiles * npn) return false;
        const int t = t0 + (int)(L / npn); u.pm = t; u.pn = (int)(L % npn); u.aoff = 0; u.boff = (long)tile_e[t] * bstride; return true;
    }
    __device__ __forceinline__ void a_ready(const Unit&) const {}
    __device__ __forceinline__ void done(const Unit&) const {}
};

__device__ __forceinline__ unsigned cvt_pk_bf16(float lo, float hi) { unsigned r; asm volatile("v_cvt_pk_bf16_f32 %0, %1, %2" : "=v"(r) : "v"(lo), "v"(hi)); return r; }
__device__ __forceinline__ float bf_lo(unsigned w) { return __uint_as_float(w << 16); }
__device__ __forceinline__ float bf_hi(unsigned w) { return __uint_as_float(w & 0xffff0000u); }
__device__ __forceinline__ float sigmoidf_(float x) { return __builtin_amdgcn_rcpf(1.0f + __expf(-x)); }
__device__ __forceinline__ float softplusf_(float x) { return fmaxf(x, 0.f) + __logf(1.0f + __expf(-fabsf(x))); }

struct EpiBf16 {
    static constexpr bool PERM = true, AFTER_DRAIN = false;
    bf16_t* O; int ldc;
    __device__ __forceinline__ void operator()(const f32x4 (&acc)[2][2][4][2], const Unit& u, int wr, int wc, int fr, int fq) const {
        const int row0 = u.pm * BM + wr * 64 + fr; const int col0 = u.pn * BM + wc * 32 + 8 * fq;
#pragma unroll
        for (int ai = 0; ai < 2; ++ai)
#pragma unroll
            for (int m = 0; m < 4; ++m) { bf16_t* rowp = O + (size_t)(row0 + ai * HALF + m * 16) * ldc + col0;
#pragma unroll
                for (int bj = 0; bj < 2; ++bj) { const f32x4 v0 = acc[ai][bj][m][0], v1 = acc[ai][bj][m][1];
                    u32x4 w; w.x = cvt_pk_bf16(v0[0], v0[1]); w.y = cvt_pk_bf16(v0[2], v0[3]); w.z = cvt_pk_bf16(v1[0], v1[1]); w.w = cvt_pk_bf16(v1[2], v1[3]);
                    *(u32x4*)(rowp + bj * HALF) = w; } }
    }
};
struct EpiSwiglu {
    static constexpr bool PERM = true, AFTER_DRAIN = false;
    bf16_t* O; int ldc;
    __device__ __forceinline__ void operator()(const f32x4 (&acc)[2][2][4][2], const Unit& u, int wr, int wc, int fr, int fq) const {
        const int row0 = u.pm * BM + wr * 64 + fr; const int col0 = u.pn * HALF + wc * 32 + 8 * fq;
#pragma unroll
        for (int ai = 0; ai < 2; ++ai)
#pragma unroll
            for (int m = 0; m < 4; ++m) { bf16_t* rowp = O + (size_t)(row0 + ai * HALF + m * 16) * ldc + col0;
                float o[8];
#pragma unroll
                for (int n = 0; n < 2; ++n)
#pragma unroll
                    for (int j = 0; j < 4; ++j) { const float gq = acc[ai][0][m][n][j], uq = acc[ai][1][m][n][j]; o[4 * n + j] = gq * sigmoidf_(gq) * uq; }
                u32x4 w; w.x = cvt_pk_bf16(o[0], o[1]); w.y = cvt_pk_bf16(o[2], o[3]); w.z = cvt_pk_bf16(o[4], o[5]); w.w = cvt_pk_bf16(o[6], o[7]);
                *(u32x4*)rowp = w; }
    }
};
struct EpiResid {
    static constexpr bool PERM = false, AFTER_DRAIN = false;
    float* out; const float* x; const float* meta; int mode;
    __device__ __forceinline__ void operator()(const f32x4 (&acc)[2][2][4][2], const Unit& u, int wr, int wc, int fr, int fq) const {
        const int row0 = u.pm * BM + wr * 64 + fr, col0 = u.pn * BM + wc * 32 + 4 * fq;
#pragma unroll
        for (int ai = 0; ai < 2; ++ai)
#pragma unroll
            for (int m = 0; m < 4; ++m) { const int row = row0 + ai * HALF + m * 16; float* rowp = out + (size_t)row * 2048 + col0;
                const float* bp = mode ? rowp : (row < 8192 ? x + (size_t)row * 2048 + col0 : (row < 8208 ? meta + (size_t)(row - 8192) * 2048 + col0 : nullptr));
#pragma unroll
                for (int bj = 0; bj < 2; ++bj)
#pragma unroll
                    for (int n = 0; n < 2; ++n) { f32x4 b = (f32x4){0.f, 0.f, 0.f, 0.f}; if (bp) b = *(const f32x4*)(bp + bj * HALF + n * 16);
                        *(f32x4*)(rowp + bj * HALF + n * 16) = acc[ai][bj][m][n] + b; } }
    }
};
__device__ __forceinline__ float one_minus_exp_neg(float e) { return e < 0.05f ? e * (1.0f - e * (0.5f - e * (1.0f / 6.0f))) : 1.0f - __expf(-e); }
struct EpiLora {
    static constexpr bool PERM = false, AFTER_DRAIN = false;
    bf16_t* base; long gstride; const float* w0; const float* a0;
    __device__ __forceinline__ void operator()(const f32x4 (&acc)[2][2][4][2], const Unit& u, int wr, int wc, int fr, int fq) const {
        const int grp = u.pn >> 2; const int row0 = u.pm * BM + wr * 64 + fr, col0 = (u.pn & 3) * BM + wc * 32 + 4 * fq;
        bf16_t* O = base + (size_t)grp * gstride;
#pragma unroll
        for (int bj = 0; bj < 2; ++bj)
#pragma unroll
            for (int n = 0; n < 2; ++n) { const int c = col0 + bj * HALF + n * 16;
                f32x4 bv = (f32x4){0.f, 0.f, 0.f, 0.f}; if (grp == 0) bv = *(const f32x4*)(w0 + c); else if (grp == 1) bv = *(const f32x4*)(a0 + c);
#pragma unroll
                for (int ai = 0; ai < 2; ++ai)
#pragma unroll
                    for (int m = 0; m < 4; ++m) { f32x4 v = acc[ai][bj][m][n] + bv;
                        if (grp == 0) {
#pragma unroll
                            for (int j = 0; j < 4; ++j) { const float wl = -softplusf_(-v[j]) - 0.5f; v[j] = one_minus_exp_neg(__expf(wl)); }
                        } else if (grp == 1) {
#pragma unroll
                            for (int j = 0; j < 4; ++j) v[j] = sigmoidf_(v[j]);
                        }
                        u32x2 w; w.x = cvt_pk_bf16(v[0], v[1]); w.y = cvt_pk_bf16(v[2], v[3]);
                        *(u32x2*)(O + (size_t)(row0 + ai * HALF + m * 16) * 1024 + c) = w; } }
    }
};
struct EpiGates {
    static constexpr bool PERM = false, AFTER_DRAIN = false;
    bf16_t* lru_a; bf16_t* lru_ix; const float* ba; const float* bx; const float* lam; const bf16_t* xr;
    __device__ __forceinline__ void operator()(const f32x4 (&acc)[2][2][4][2], const Unit& u, int wr, int wc, int fr, int fq) const {
        const int grp = u.pn >> 2; const int row0 = u.pm * BM + wr * 64 + fr, col0 = (u.pn & 3) * BM + wc * 32 + 4 * fq;
#pragma unroll
        for (int bj = 0; bj < 2; ++bj)
#pragma unroll
            for (int n = 0; n < 2; ++n) { const int c = col0 + bj * HALF + n * 16;
                const f32x4 bv = *(const f32x4*)((grp == 0 ? ba : bx) + c); f32x4 sp = (f32x4){0.f, 0.f, 0.f, 0.f};
                if (grp == 0) { const f32x4 l = *(const f32x4*)(lam + c);
#pragma unroll
                    for (int j = 0; j < 4; ++j) sp[j] = 8.0f * softplusf_(-l[j]); }
#pragma unroll
                for (int ai = 0; ai < 2; ++ai)
#pragma unroll
                    for (int m = 0; m < 4; ++m) { const int row = row0 + ai * HALF + m * 16; f32x4 v = acc[ai][bj][m][n] + bv; u32x2 w;
                        if (grp == 0) {
#pragma unroll
                            for (int j = 0; j < 4; ++j) v[j] = one_minus_exp_neg(sigmoidf_(v[j]) * sp[j]);
                            w.x = cvt_pk_bf16(v[0], v[1]); w.y = cvt_pk_bf16(v[2], v[3]); *(u32x2*)(lru_a + (size_t)row * 1024 + c) = w;
                        } else { const u32x2 xw = *(const u32x2*)(xr + (size_t)row * 1024 + c);
                            v[0] = sigmoidf_(v[0]) * bf_lo(xw.x); v[1] = sigmoidf_(v[1]) * bf_hi(xw.x); v[2] = sigmoidf_(v[2]) * bf_lo(xw.y); v[3] = sigmoidf_(v[3]) * bf_hi(xw.y);
                            w.x = cvt_pk_bf16(v[0], v[1]); w.y = cvt_pk_bf16(v[2], v[3]); *(u32x2*)(lru_ix + (size_t)row * 1024 + c) = w; } } }
    }
};

template <class Epi, class Sched, bool ALIGN_EPI = false, bool SP2 = false>
__device__ __forceinline__ void gemm_phase(PG8_LAS unsigned char* lds, const Gemm g, const Sched& S, const Epi& E) {
    const int tid = threadIdx.x, wid = __builtin_amdgcn_readfirstlane(tid >> 6), lane = tid & 63, wr = wid >> 2, wc = wid & 3, fr = lane & 15, fq = lane >> 4;
    const int K = g.K, nt = K / BK;
    unsigned voffA[2], voffB[2];
#pragma unroll
    for (int i = 0; i < 2; ++i) { int R, C; stage_rc(tid * 16 + i * 8192, R, C); const int Rb = Epi::PERM ? ((R & ~31) + perm32(R & 31)) : R;
        voffA[i] = (unsigned)(R * g.lda + C) * 2u; voffB[i] = (unsigned)(Rb * g.ldb + C) * 2u; }
    const size_t kstep = (size_t)(BK * 2);
    const size_t hstepA = (size_t)HALF * g.lda * 2, hstepB = (size_t)HALF * g.ldb * 2;
    const size_t tstepA = 2 * hstepA, tstepB = 2 * hstepB;
    const unsigned ldsw = (unsigned)wid * 1024u;
    const int aoff = lds_byte(wr * 64 + fr, fq * 8), boff = lds_byte(wc * 32 + fr, fq * 8);
#define PG8_SA(b, h) (((b) * 2 + (h)) * HTB)
#define PG8_SB(b, h) ((4 + (b) * 2 + (h)) * HTB)
#define PG8_STAGE(bufoff, gbase, voff) do { _Pragma("unroll") for (int _i = 0; _i < 2; ++_i) \
        __builtin_amdgcn_global_load_lds((const unsigned*)((const char*)(gbase) + (voff)[_i]), (PG8_LAS unsigned*)(lds + (bufoff) + ldsw + _i * 8192), 16, 0, 0); } while (0)
#define PG8_LDA(dst, b, h) do { _Pragma("unroll") for (int m = 0; m < 4; ++m) _Pragma("unroll") for (int k = 0; k < 2; ++k) dst[m][k] = *(const PG8_LAS bf16x8*)(lds + PG8_SA(b, h) + aoff + m * 2048 + k * 1024); } while (0)
#define PG8_LDB(dst, b, h) do { _Pragma("unroll") for (int n = 0; n < 2; ++n) _Pragma("unroll") for (int k = 0; k < 2; ++k) dst[n][k] = *(const PG8_LAS bf16x8*)(lds + PG8_SB(b, h) + boff + n * 2048 + k * 1024); } while (0)
#define PG8_MMA(ai, bj, At, Bt) do { __builtin_amdgcn_s_setprio(1); _Pragma("unroll") for (int m = 0; m < 4; ++m) _Pragma("unroll") for (int n = 0; n < 2; ++n) _Pragma("unroll") for (int k = 0; k < 2; ++k) \
        acc[ai][bj][m][n] = __builtin_amdgcn_mfma_f32_16x16x32_bf16(Bt[n][k], At[m][k], acc[ai][bj][m][n], 0, 0, 0); __builtin_amdgcn_s_setprio(0); } while (0)
#define PG8_WAIT_V(n) asm volatile("s_waitcnt vmcnt(" #n ")" ::: "memory")
#define PG8_WAIT_L(n) asm volatile("s_waitcnt lgkmcnt(" #n ")" ::: "memory")
#define PG8_BAR __builtin_amdgcn_s_barrier()
#define PG8_SCHED __builtin_amdgcn_sched_barrier(0)
    Unit cur, nxt; int ui = 0;
    if (!S.next(0, cur)) return;
    f32x4 acc[2][2][4][2];
#pragma unroll
    for (int a = 0; a < 2; ++a)
#pragma unroll
        for (int b = 0; b < 2; ++b)
#pragma unroll
            for (int m = 0; m < 4; ++m)
#pragma unroll
                for (int n = 0; n < 2; ++n) acc[a][b][m][n] = (f32x4){0.f, 0.f, 0.f, 0.f};
    bf16x8 At[4][2], B0[2][2], B1[2][2];
    const char* cA = (const char*)g.A + (size_t)cur.pm * tstepA + cur.aoff; const char* cB = (const char*)g.Bt + (size_t)cur.pn * tstepB + cur.boff;
    S.a_ready(cur);
    if constexpr (SP2) {
        PG8_STAGE(PG8_SB(0, 0), cB, voffB); PG8_STAGE(PG8_SB(0, 1), cB + hstepB, voffB); PG8_STAGE(PG8_SA(0, 0), cA, voffA); PG8_STAGE(PG8_SA(0, 1), cA + hstepA, voffA);
        if (wr == 1) PG8_BAR;
        PG8_WAIT_V(2); PG8_BAR;
        PG8_STAGE(PG8_SB(1, 0), cB + kstep, voffB); PG8_STAGE(PG8_SA(1, 0), cA + kstep, voffA); PG8_STAGE(PG8_SB(1, 1), cB + hstepB + kstep, voffB);
        PG8_WAIT_V(6); PG8_BAR;
    } else {
        PG8_STAGE(PG8_SB(0, 0), cB, voffB); PG8_STAGE(PG8_SA(0, 0), cA, voffA); PG8_STAGE(PG8_SB(0, 1), cB + hstepB, voffB); PG8_STAGE(PG8_SA(0, 1), cA + hstepA, voffA);
        if (wr == 1) PG8_BAR;
        PG8_WAIT_V(4); PG8_BAR;
        PG8_STAGE(PG8_SB(1, 0), cB + kstep, voffB); PG8_STAGE(PG8_SA(1, 0), cA + kstep, voffA); PG8_STAGE(PG8_SB(1, 1), cB + hstepB + kstep, voffB);
        PG8_WAIT_V(6); PG8_BAR;
    }
    for (;;) {
        const bool has_next = S.next(ui + 1, nxt);
        const char* nA = has_next ? (const char*)g.A + (size_t)nxt.pm * tstepA + nxt.aoff : cA; const char* nB = has_next ? (const char*)g.Bt + (size_t)nxt.pn * tstepB + nxt.boff : cB;
        for (int t = 0; t < nt; t += 2) {
            const bool last = (t == nt - 2);
            const char* a1 = cA + (size_t)(t + 1) * kstep;
            const char* a2 = last ? nA : cA + (size_t)(t + 2) * kstep; const char* b2 = last ? nB : cB + (size_t)(t + 2) * kstep;
            const char* a3 = a2 + kstep; const char* b3 = b2 + kstep;
            if (last && has_next) S.a_ready(nxt);
            if constexpr (SP2) {
            PG8_LDB(B0, 0, 0); PG8_LDB(B1, 0, 1); PG8_SCHED; PG8_LDA(At, 0, 0); PG8_STAGE(PG8_SA(1, 1), a1 + hstepA, voffA);
            PG8_WAIT_V(8); PG8_WAIT_L(0); PG8_BAR; PG8_MMA(0, 0, At, B0); PG8_MMA(0, 1, At, B1); PG8_BAR; PG8_SCHED;
            PG8_LDA(At, 0, 1); PG8_STAGE(PG8_SB(0, 0), b2, voffB); PG8_STAGE(PG8_SB(0, 1), b2 + hstepB, voffB); PG8_STAGE(PG8_SA(0, 0), a2, voffA);
            PG8_WAIT_V(8); PG8_WAIT_L(0); PG8_BAR; PG8_MMA(1, 0, At, B0); PG8_MMA(1, 1, At, B1); PG8_BAR; PG8_SCHED;
            PG8_LDB(B0, 1, 0); PG8_LDB(B1, 1, 1); PG8_SCHED; PG8_LDA(At, 1, 0); PG8_STAGE(PG8_SA(0, 1), a2 + hstepA, voffA);
            PG8_WAIT_V(8); PG8_WAIT_L(0); PG8_BAR; PG8_MMA(0, 0, At, B0); PG8_MMA(0, 1, At, B1); PG8_BAR; PG8_SCHED;
            PG8_LDA(At, 1, 1); PG8_STAGE(PG8_SB(1, 0), b3, voffB); PG8_STAGE(PG8_SB(1, 1), b3 + hstepB, voffB); PG8_STAGE(PG8_SA(1, 0), a3, voffA);
            PG8_WAIT_V(8); PG8_WAIT_L(0); PG8_BAR; PG8_MMA(1, 0, At, B0); PG8_MMA(1, 1, At, B1); PG8_BAR; PG8_SCHED;
            } else {
            PG8_LDB(B0, 0, 0); PG8_SCHED; PG8_LDA(At, 0, 0); PG8_STAGE(PG8_SA(1, 1), a1 + hstepA, voffA);
            PG8_WAIT_L(8); PG8_BAR; PG8_WAIT_L(0); PG8_MMA(0, 0, At, B0); PG8_BAR; PG8_SCHED;
            PG8_LDB(B1, 0, 1); PG8_STAGE(PG8_SB(0, 0), b2, voffB);
            PG8_BAR; PG8_WAIT_L(0); PG8_MMA(0, 1, At, B1); PG8_BAR;
            PG8_LDA(At, 0, 1); PG8_STAGE(PG8_SA(0, 0), a2, voffA);
            PG8_BAR; PG8_WAIT_L(0); PG8_MMA(1, 0, At, B0); PG8_BAR; PG8_SCHED;
            PG8_STAGE(PG8_SB(0, 1), b2 + hstepB, voffB);
            PG8_WAIT_V(6); PG8_BAR; PG8_MMA(1, 1, At, B1); PG8_BAR;
            PG8_LDB(B0, 1, 0); PG8_SCHED; PG8_LDA(At, 1, 0); PG8_STAGE(PG8_SA(0, 1), a2 + hstepA, voffA);
            PG8_WAIT_L(8); PG8_BAR; PG8_WAIT_L(0); PG8_MMA(0, 0, At, B0); PG8_BAR; PG8_SCHED;
            PG8_LDB(B1, 1, 1); PG8_STAGE(PG8_SB(1, 0), b3, voffB);
            PG8_BAR; PG8_WAIT_L(0); PG8_MMA(0, 1, At, B1); PG8_BAR;
            PG8_LDA(At, 1, 1); PG8_STAGE(PG8_SA(1, 0), a3, voffA);
            PG8_BAR; PG8_WAIT_L(0); PG8_MMA(1, 0, At, B0); PG8_BAR; PG8_SCHED;
            PG8_STAGE(PG8_SB(1, 1), b3 + hstepB, voffB);
            PG8_WAIT_V(6); PG8_BAR; PG8_MMA(1, 1, At, B1); PG8_BAR;
            }
        }
        if constexpr (ALIGN_EPI) { if (wr == 0) PG8_BAR; }
        if constexpr (!Epi::AFTER_DRAIN) { E(acc, cur, wr, wc, fr, fq); S.done(cur); }
        if (!has_next) break;
#pragma unroll
        for (int a = 0; a < 2; ++a)
#pragma unroll
            for (int b = 0; b < 2; ++b)
#pragma unroll
                for (int m = 0; m < 4; ++m)
#pragma unroll
                    for (int n = 0; n < 2; ++n) acc[a][b][m][n] = (f32x4){0.f, 0.f, 0.f, 0.f};
        cur = nxt; cA = nA; cB = nB; ++ui;
        if constexpr (ALIGN_EPI) { if (wr == 1) PG8_BAR; }
    }
    PG8_WAIT_V(0);
    if constexpr (!ALIGN_EPI) { if (wr == 0) PG8_BAR; }
    PG8_BAR;
    if constexpr (Epi::AFTER_DRAIN) { E.fused(acc, cur, wr, wc, fr, fq, lds, wid, lane); S.done(cur); }
#undef PG8_SA
#undef PG8_SB
#undef PG8_STAGE
#undef PG8_LDA
#undef PG8_LDB
#undef PG8_MMA
#undef PG8_WAIT_V
#undef PG8_WAIT_L
#undef PG8_BAR
#undef PG8_SCHED
}
}
#define GAS __attribute__((address_space(1)))
#define LAS __attribute__((address_space(3)))
typedef unsigned short bf16;
typedef unsigned v4u __attribute__((ext_vector_type(4)));
typedef float f32x4 __attribute__((ext_vector_type(4)));
typedef short bf16x8 __attribute__((ext_vector_type(8)));
typedef GAS unsigned gu32;
typedef GAS unsigned long long gu64;
#define RLX_AGENT __ATOMIC_RELAXED, __HIP_MEMORY_SCOPE_AGENT
#define LDS_WAIT() asm volatile("s_waitcnt lgkmcnt(0)" ::: "memory")
#define VM_WAIT() asm volatile("s_waitcnt vmcnt(0)" ::: "memory")
__device__ __forceinline__ unsigned long long rt() { return __builtin_amdgcn_s_memrealtime(); }
__device__ __forceinline__ unsigned f2bf(float f) { unsigned u = __builtin_bit_cast(unsigned, f); return (u + 0x7fffu + ((u >> 16) & 1u)) >> 16; }
__device__ __forceinline__ unsigned pk2(float lo, float hi) { return f2bf(lo) | (f2bf(hi) << 16); }

#define XB_TMO      128
#define XB_XCNT(j)  (256  + 64 * (j))
#define XB_XSUB(j)  (1280 + 64 * (j))
#define XB_XGEN(j)  (2304 + 64 * (j))
#define XB_TOP      3328
#define XB_TOPGEN   3392
#define XCD_BAR_WORDS 3456
#define XB_SPIN_CAP (1u << 18)

__device__ __forceinline__ unsigned xb_ld(unsigned* p)              { return __hip_atomic_load(p, __ATOMIC_RELAXED, __HIP_MEMORY_SCOPE_AGENT); }
__device__ __forceinline__ unsigned xb_add(unsigned* p, unsigned v) { return __hip_atomic_fetch_add(p, v, __ATOMIC_RELAXED, __HIP_MEMORY_SCOPE_AGENT); }
__device__ __forceinline__ unsigned xb_xcc_id() { return (unsigned)__builtin_amdgcn_s_getreg((3 << 11) | 20) & 0xFu; }
#define XB_SPIN(cond, bar) do { unsigned _sp = 0; while (cond) { __builtin_amdgcn_s_sleep(1); \
    if ((++_sp & 255u) == 0u) { if (xb_ld(&(bar)[XB_TMO])) break; if (_sp > XB_SPIN_CAP) { atomicAdd(&(bar)[XB_TMO], 1u); break; } } } } while (0)

struct XcdBarrier {
    unsigned* bar; unsigned x;
    volatile LAS unsigned* st;
};

__device__ __forceinline__ XcdBarrier xcd_barrier_post(unsigned* bar, volatile LAS unsigned* st) {
    XcdBarrier b; b.bar = bar; b.x = xb_xcc_id(); b.st = st;
    if (threadIdx.x == 0) (void)xb_add(&bar[XB_XCNT(b.x)], 1u);
    return b;
}
__device__ __forceinline__ void xcd_barrier_complete(unsigned* bar, unsigned x, unsigned& nloc, unsigned& nx) {
    const unsigned G = gridDim.x * gridDim.y * gridDim.z;
    unsigned sum, cnt, mine, sp = 0u;
    for (;;) {
        sum = 0u; cnt = 0u; mine = 0u;
#pragma unroll
        for (unsigned j = 0; j < 16; ++j) { const unsigned c = xb_ld(&bar[XB_XCNT(j)]); sum += c; cnt += (c > 0u) ? 1u : 0u; mine = (j == x) ? c : mine; }
        if (sum == G) break;
        __builtin_amdgcn_s_sleep(1);
        if ((++sp & 255u) == 0u) { if (xb_ld(&bar[XB_TMO])) break; if (sp > XB_SPIN_CAP) { atomicAdd(&bar[XB_TMO], 1u); break; } }
    }
    nloc = mine > 0u ? mine : 1u; nx = cnt > 0u ? cnt : 1u;
}

__device__ __forceinline__ void xcd_barrier(const XcdBarrier& b) {
    asm volatile("s_waitcnt vmcnt(0)" ::: "memory");
    __syncthreads();
    if (threadIdx.x == 0) {
        unsigned* bar = b.bar;
        __builtin_amdgcn_s_waitcnt(0);
        unsigned nloc = b.st[0], nx = b.st[1];
        if (nloc == 0u) { xcd_barrier_complete(bar, b.x, nloc, nx); b.st[0] = nloc; b.st[1] = nx; }
        const unsigned old = xb_add(&bar[XB_XSUB(b.x)], 1u);
        const unsigned gen = old / nloc;
        if (old + 1u == (gen + 1u) * nloc) {
            __builtin_amdgcn_fence(__ATOMIC_RELEASE, "agent");
            asm volatile("s_waitcnt vmcnt(0)" ::: "memory");
            const unsigned og = xb_add(&bar[XB_TOP], 1u);
            const unsigned tg = og / nx;
            if (og + 1u == (tg + 1u) * nx) xb_add(&bar[XB_TOPGEN], 1u);
            else XB_SPIN(xb_ld(&bar[XB_TOPGEN]) == tg, bar);
            __builtin_amdgcn_fence(__ATOMIC_ACQUIRE, "agent");
            xb_add(&bar[XB_XGEN(b.x)], 1u);
            asm volatile("s_waitcnt vmcnt(0)" ::: "memory");
        } else {
            XB_SPIN(xb_ld(&bar[XB_XGEN(b.x)]) == gen, bar);
            __builtin_amdgcn_fence(__ATOMIC_ACQUIRE, "agent");
            asm volatile("s_waitcnt vmcnt(0)" ::: "memory");
        }
    }
    __syncthreads();
}

constexpr int NWAVES = 8;
constexpr int DM = 2048, TX = 8192, NMETA = 16, TT = TX + NMETA, MP = 8448;
constexpr int EV_NP = 5632, EV_LORA0 = 3072, EV_GB = 3360, EV_REC = 4384;
constexpr int OD_NP = 12544, OD_Z = 8192, OD_B = 12288, OD_A = 12320;
constexpr int NEXP = 32, FF = 512, MOE_ROWS = 24576;
constexpr float NORM_EPS = 1e-6f;

constexpr size_t MiB = 1u << 20;
constexpr size_t WS_CTL = 0, CTL_ZERO_BYTES = 1 * MiB;
constexpr size_t WS_TOKINFO = 1 * MiB;
constexpr size_t WS_TILES = 1 * MiB + 512 * 1024;
constexpr size_t WS_WEVIN = 2 * MiB;
constexpr size_t WS_WEVOUT = 24 * MiB;
constexpr size_t WS_WODIN = 32 * MiB;
constexpr size_t WS_WODOUT = 81 * MiB;
constexpr size_t WS_WLORA = 97 * MiB;
constexpr size_t WS_WGATE = 100 * MiB;
constexpr size_t WS_WROUTE = 101 * MiB;
constexpr size_t WS_MOEW = 102 * MiB;
constexpr size_t MOE_E_BYTES = 6 * MiB, MOE_W2_OFF = 4 * MiB;
constexpr size_t WS_H = 294 * MiB;
constexpr size_t WS_HN = 360 * MiB;
constexpr size_t WS_YMIX = 393 * MiB;
constexpr size_t WS_PROJ = 459 * MiB;
constexpr size_t WS_SCR = 662 * MiB;
constexpr size_t WS_END = 932 * MiB;
constexpr size_t SC_ALORA = 0;
constexpr size_t SC_XR = 8 * MiB;
constexpr size_t SC_DEC = 26 * MiB, SC_ICL = 60 * MiB, SC_GATE = 94 * MiB;
constexpr size_t SC_LA = 128 * MiB, SC_LIX = 162 * MiB;
constexpr size_t SC_QN = 0, SC_KN = 34 * MiB;
constexpr size_t SC_VC = 68 * MiB;
constexpr size_t SC_BETA = 134 * MiB, SC_G = 136 * MiB;
constexpr size_t SC_O = 138 * MiB;
constexpr size_t SC_XG = 0;
constexpr size_t SC_ACT = 96 * MiB;
constexpr size_t SC_YB = 120 * MiB;
static_assert(SC_O + (size_t)MP * 4096 * 4 <= WS_END - WS_SCR && SC_YB + (size_t)MOE_ROWS * 2048 * 2 <= WS_END - WS_SCR && SC_LIX + (size_t)MP * 1024 * 4 <= WS_END - WS_SCR, "scratch map");
constexpr int CW_TMO = 0, CW_CODE = 1;
constexpr int CW_BAR = 4096;
constexpr int CW_PROG = 20480;
constexpr int CW_TS = 24576;
constexpr int CW_MOECNT = 16384;

constexpr int RING_OFF = 0, RING_BYTES = 131072;
constexpr int LDSCTL_OFF = 146944, MISC_OFF = LDSCTL_OFF + 320;
constexpr int LDS_BYTES = 147456;


#define DI __device__ __forceinline__
typedef unsigned v2u __attribute__((ext_vector_type(2)));
struct Args { const float* in[36]; float* out; unsigned char* ws; int ph_lo, ph_hi; };
struct Frame {
    LAS unsigned char* lds; volatile LAS unsigned* MISC; gu32* ctl;
    int tid, lane, wave, vcu, G, gw, NGW;
};
DI float bf2f(bf16 v) { return __uint_as_float((unsigned)v << 16); }
DI float bflo(unsigned w) { return __uint_as_float(w << 16); }
DI float bfhi(unsigned w) { return __uint_as_float(w & 0xffff0000u); }
DI float wave_sum(float v) {
#pragma unroll
    for (int o = 1; o < 64; o <<= 1) v += __shfl_xor(v, o);
    return v;
}
DI float sigm(float x) { return __builtin_amdgcn_rcpf(1.0f + __expf(-x)); }
DI float softplus(float x) { return fmaxf(x, 0.f) + __logf(1.0f + __expf(-fabsf(x))); }
DI float gelu_tanh(float x) { const float u = 0.7978845608028654f * (x + 0.044715f * x * x * x); return 0.5f * x * (1.0f + tanhf(u)); }
DI int pos_row(int p) { return p < NMETA ? TX + p : p - NMETA; }
DI int row_pos(int r) { return r < TX ? r + NMETA : r - TX; }

DI void tr_item(const float* W, int N, int k0, int n0, bf16* WT, int ldk, int drow0, LAS float* scr, int lane) {
#pragma unroll 8
    for (int i = 0; i < 32; ++i) { const int kk = 2 * i + (lane >> 5); scr[kk * 33 + (lane & 31)] = W[(size_t)(k0 + kk) * N + n0 + (lane & 31)]; }
    LDS_WAIT(); asm volatile("" ::: "memory");
    const int c = lane & 7;
#pragma unroll
    for (int j = 0; j < 4; ++j) { const int n = (lane >> 3) + 8 * j; const LAS float* s = scr + (8 * c) * 33 + n;
        v4u o; o.x = pk2(s[0 * 33], s[1 * 33]); o.y = pk2(s[2 * 33], s[3 * 33]); o.z = pk2(s[4 * 33], s[5 * 33]); o.w = pk2(s[6 * 33], s[7 * 33]);
        *(v4u*)(WT + (size_t)(drow0 + n) * ldk + k0 + 8 * c) = o; }
    LDS_WAIT(); asm volatile("" ::: "memory");
}
DI void moe_convert(const Frame& F, const Args& a, int l, int gw, int ngw) {
    LAS float* scr = (LAS float*)(F.lds + RING_OFF + F.wave * 16384);
    bf16* base = (bf16*)(a.ws + WS_MOEW);
    for (int it = gw; it < NEXP * 1536; it += ngw) {
        const int e = it / 1536; int j = it % 1536; bf16* eb = base + (size_t)e * (MOE_E_BYTES / 2);
        const size_t eoff = (size_t)(l * NEXP + e) * DM * FF;
        if (j < 1024) { const float* W = (j < 512 ? a.in[33] : a.in[34]) + eoff; const int hi = j >= 512; j &= 511; const int kb = j >> 4, nb = j & 15, n0 = 32 * nb;
            tr_item(W, FF, 64 * kb, n0, eb, DM, 256 * (n0 >> 7) + 128 * hi + (n0 & 127), scr, F.lane); }
        else { j -= 1024; const int kb = j >> 6, nb = j & 63; tr_item(a.in[35] + eoff, DM, 64 * kb, 32 * nb, eb + MOE_W2_OFF / 2, FF, 32 * nb, scr, F.lane); }
    }
}
DI void norm_row_bf16(int lane, const float* src, const float* w, bf16* dst) {
    f32x4 v[8]; float s = 0.f;
#pragma unroll
    for (int j = 0; j < 8; ++j) { v[j] = ((const f32x4*)src)[lane + 64 * j]; s += (v[j].x * v[j].x + v[j].y * v[j].y) + (v[j].z * v[j].z + v[j].w * v[j].w); }
    const float rs = 1.0f / sqrtf(wave_sum(s) * (1.0f / DM) + NORM_EPS);
#pragma unroll
    for (int j = 0; j < 8; ++j) { const f32x4 wv = ((const f32x4*)w)[lane + 64 * j]; v2u o; o.x = pk2(v[j].x * rs * wv.x, v[j].y * rs * wv.y); o.y = pk2(v[j].z * rs * wv.z, v[j].w * rs * wv.w);
        ((v2u*)dst)[lane + 64 * j] = o; }
}

DI void ph_prologue(const Frame& F, const Args& a) {
    LAS float* scr = (LAS float*)(F.lds + RING_OFF + F.wave * 16384);
    constexpr int I_A = 32 * 169, I_B = 32 * 64, NIT = I_A + I_B;
    for (int it = F.gw; it < NIT; it += F.NGW) {
        int r = it;
        if (r < I_A) { const int kb = r / 169, nb = r % 169; tr_item(a.in[5], 5408, 64 * kb, 32 * nb, (bf16*)(a.ws + WS_WEVIN), DM, 32 * nb, scr, F.lane); continue; } r -= I_A;
        { const int kb = r / 64, nb = r % 64; tr_item(a.in[24], DM, 64 * kb, 32 * nb, (bf16*)(a.ws + WS_WEVOUT), DM, 32 * nb, scr, F.lane); }
    }
    const int gt = F.vcu * (NWAVES * 64) + F.tid, NGT = F.G * NWAVES * 64;
    { bf16* WL = (bf16*)(a.ws + WS_WLORA); const float* wup = a.in[8]; const float* aup = a.in[10]; const float* gup = a.in[11];
      for (int idx = gt; idx < 3072 * 384; idx += NGT) { const int n = idx / 384, k = idx % 384; float v = 0.f;
          if (n < 1024) { if (k < 64) v = wup[k * 1024 + n]; }
          else if (n < 2048) { if (k >= 64 && k < 128) v = aup[(k - 64) * 1024 + n - 1024]; }
          else { if (k >= 128 && k < 288) v = gup[(k - 128) * 1024 + n - 2048]; }
          WL[idx] = (bf16)f2bf(v); } }
    { bf16* WG = (bf16*)(a.ws + WS_WGATE);
      for (int idx = gt; idx < 2048 * 256; idx += NGT) { const int n = idx >> 8, kk = idx & 255, nn = n & 1023, blk = nn >> 6, j = nn & 63, cin = (nn & ~255) + kk;
          const float* W = n < 1024 ? a.in[19] : a.in[21];
          const float v = (cin >> 6) == blk ? W[blk * 4096 + (cin & 63) * 64 + j] : 0.f;
          WG[idx] = (bf16)f2bf(v); } }
    { bf16* WR = (bf16*)(a.ws + WS_WROUTE);
      for (int idx = gt; idx < 2 * 48 * DM; idx += NGT) { const int l = idx / (48 * DM), n = (idx / DM) % 48, k = idx % DM; float v = 0.f;
          if (n < 32) v = a.in[32][((size_t)l * DM + k) * NEXP + n]; else if (n < 36) v = a.in[31][((size_t)l * DM + k) * 4 + n - 32];
          const unsigned hi = f2bf(v); WR[((size_t)(l * 2) * 48 + n) * DM + k] = (bf16)hi; WR[((size_t)(l * 2 + 1) * 48 + n) * DM + k] = (bf16)f2bf(v - __uint_as_float(hi << 16)); } }
    bf16* HN = (bf16*)(a.ws + WS_HN);
    for (int r = F.gw; r < TT; r += F.NGW) norm_row_bf16(F.lane, r < TX ? a.in[0] + (size_t)r * DM : a.in[1] + (size_t)(r - TX) * DM, a.in[2], HN + (size_t)r * DM);
}

DI void ph_aux_convert(const Frame& F, const Args& a, int gw, int ngw) {
    LAS float* scr = (LAS float*)(F.lds + RING_OFF + F.wave * 16384);
    constexpr int I_C = 32 * 386, I_D = 64 * 64, NIT = I_C + I_D;
    for (int it = gw; it < NIT; it += ngw) {
        int r = it;
        if (r < I_C) { const int kb = r / 386, nb = r % 386; tr_item(a.in[25], 12352, 64 * kb, 32 * nb, (bf16*)(a.ws + WS_WODIN), DM, 32 * nb, scr, F.lane); continue; } r -= I_C;
        { const int kb = r / 64, nb = r % 64; tr_item(a.in[30], DM, 64 * kb, 32 * nb, (bf16*)(a.ws + WS_WODOUT), 4096, 32 * nb, scr, F.lane); }
    }
    moe_convert(F, a, 0, gw, ngw);
}

DI void ph_even_prep(const Frame& F, const Args& a) {
    const bf16* P = (const bf16*)(a.ws + WS_PROJ); bf16* AL = (bf16*)(a.ws + WS_SCR + SC_ALORA); bf16* XR = (bf16*)(a.ws + WS_SCR + SC_XR);
    const float* mu = a.in[6]; const float* cw = a.in[17]; const float* cb = a.in[18];
    const int lane = F.lane;
    for (int item = F.gw; item < TT + (TT / 8) * 2; item += F.NGW) {
        if (item < TT) { const int r = item, pos = row_pos(r); const bf16* cur = P + (size_t)r * EV_NP; const bf16* prv = P + (size_t)pos_row(pos > 0 ? pos - 1 : 0) * EV_NP; const float pm = pos > 0 ? 1.f : 0.f;
            float cv[6], pv[6], mv[6];
#pragma unroll
            for (int i = 0; i < 6; ++i) { const int idx = lane + 64 * i, col = EV_LORA0 + (idx < 288 ? idx : 287); cv[i] = bf2f(cur[col]); pv[i] = bf2f(prv[col]) * pm; mv[i] = mu[col]; }
#pragma unroll
            for (int i = 0; i < 6; ++i) { const int idx = lane + 64 * i; float v = cv[i] + (pv[i] - cv[i]) * mv[i];
                if (idx < 64) v = tanhf(v); else if (idx >= 128) v = sigm(v);
                AL[(size_t)r * 384 + idx] = (bf16)f2bf(idx < 288 ? v : 0.f); }
        } else { const int it2 = item - TT, pb = it2 >> 1, c0 = (it2 & 1) * 512 + lane * 8, p0 = pb * 8;
            f32x4 w[4][2], b0 = *(const f32x4*)(cb + c0), b1 = *(const f32x4*)(cb + c0 + 4);
#pragma unroll
            for (int j = 0; j < 4; ++j) { w[j][0] = *(const f32x4*)(cw + j * 1024 + c0); w[j][1] = *(const f32x4*)(cw + j * 1024 + c0 + 4); }
            v4u x[11];
#pragma unroll
            for (int i = 0; i < 11; ++i) { const int p = p0 - 3 + i; x[i] = *(const v4u*)(P + (size_t)pos_row(p > 0 ? p : 0) * EV_NP + EV_REC + c0); if (p < 0) x[i] = (v4u){0u, 0u, 0u, 0u}; }
#pragma unroll
            for (int o = 0; o < 8; ++o) { float acc[8] = {b0.x, b0.y, b0.z, b0.w, b1.x, b1.y, b1.z, b1.w};
#pragma unroll
                for (int j = 0; j < 4; ++j) { const v4u xv = x[o + j];
                    acc[0] += w[j][0].x * bflo(xv.x); acc[1] += w[j][0].y * bfhi(xv.x); acc[2] += w[j][0].z * bflo(xv.y); acc[3] += w[j][0].w * bfhi(xv.y);
                    acc[4] += w[j][1].x * bflo(xv.z); acc[5] += w[j][1].y * bfhi(xv.z); acc[6] += w[j][1].z * bflo(xv.w); acc[7] += w[j][1].w * bfhi(xv.w); }
                *(v4u*)(XR + (size_t)pos_row(p0 + o) * 1024 + c0) = (v4u){pk2(acc[0], acc[1]), pk2(acc[2], acc[3]), pk2(acc[4], acc[5]), pk2(acc[6], acc[7])}; } }
    }
}

DI void ph_route(const Frame& F, const Args& a, int l, int dummy) {
    const float* H = (const float*)(a.ws + WS_H); const float* nw = a.in[3] + (size_t)l * DM;
    const bf16* WH = (const bf16*)(a.ws + WS_WROUTE) + (size_t)(l * 2) * 48 * DM; const bf16* WL = WH + (size_t)48 * DM;
    unsigned* TI = (unsigned*)(a.ws + WS_TOKINFO) + (dummy ? (WS_SCR + 250 * MiB - WS_TOKINFO) / 4 : 0); const int lane = F.lane, lc = lane & 15, quad = lane >> 4, wave = F.wave; const int cl = dummy ? l + 2 : l;
    LAS float* red = (LAS float*)(F.lds + RING_OFF);
    LAS float* sq = red + 8 * 3 * 64 * 4; LAS float* lgs = sq + 128;
    for (int task = F.vcu; task < TT / 16; task += F.G) {
        const int r = task * 16 + lc; const float* hr = H + (size_t)r * DM + 256 * wave + 8 * quad; const float* nwp = nw + 256 * wave + 8 * quad; float ss = 0.f;
        f32x4 acc[3];
#pragma unroll
        for (int nt = 0; nt < 3; ++nt) acc[nt] = (f32x4){0.f, 0.f, 0.f, 0.f};
#pragma unroll
        for (int ks = 0; ks < 8; ++ks) { const int k0 = 256 * wave + 32 * ks + 8 * quad; const f32x4 x0 = *(const f32x4*)(hr + 32 * ks), x1 = *(const f32x4*)(hr + 32 * ks + 4), w0 = *(const f32x4*)(nwp + 32 * ks), w1 = *(const f32x4*)(nwp + 32 * ks + 4);
            ss += (x0.x * x0.x + x0.y * x0.y) + (x0.z * x0.z + x0.w * x0.w) + (x1.x * x1.x + x1.y * x1.y) + (x1.z * x1.z + x1.w * x1.w);
            const float xn[8] = {x0.x * w0.x, x0.y * w0.y, x0.z * w0.z, x0.w * w0.w, x1.x * w1.x, x1.y * w1.y, x1.z * w1.z, x1.w * w1.w};
            unsigned hi[8]; float lo[8];
#pragma unroll
            for (int q = 0; q < 8; ++q) { hi[q] = f2bf(xn[q]); lo[q] = xn[q] - __uint_as_float(hi[q] << 16); }
            const v4u ah4 = (v4u){hi[0] | (hi[1] << 16), hi[2] | (hi[3] << 16), hi[4] | (hi[5] << 16), hi[6] | (hi[7] << 16)}, al4 = (v4u){pk2(lo[0], lo[1]), pk2(lo[2], lo[3]), pk2(lo[4], lo[5]), pk2(lo[6], lo[7])};
            const bf16x8 ah = __builtin_bit_cast(bf16x8, ah4), al = __builtin_bit_cast(bf16x8, al4);
#pragma unroll
            for (int nt = 0; nt < 3; ++nt) { const bf16x8 bh = *(const bf16x8*)(WH + (size_t)(16 * nt + lc) * DM + k0), bl = *(const bf16x8*)(WL + (size_t)(16 * nt + lc) * DM + k0);
                acc[nt] = __builtin_amdgcn_mfma_f32_16x16x32_bf16(al, bh, acc[nt], 0, 0, 0); acc[nt] = __builtin_amdgcn_mfma_f32_16x16x32_bf16(ah, bl, acc[nt], 0, 0, 0); acc[nt] = __builtin_amdgcn_mfma_f32_16x16x32_bf16(ah, bh, acc[nt], 0, 0, 0); } }
        ss += __shfl_xor(ss, 16); ss += __shfl_xor(ss, 32);
#pragma unroll
        for (int nt = 0; nt < 3; ++nt) *(LAS f32x4*)(red + ((wave * 3 + nt) * 64 + lane) * 4) = acc[nt];
        if (quad == 0) sq[wave * 16 + lc] = ss;
        __syncthreads();
        if (wave < 3) { f32x4 s = *(const LAS f32x4*)(red + (wave * 64 + lane) * 4);
#pragma unroll
            for (int v = 1; v < 8; ++v) s = s + *(const LAS f32x4*)(red + ((v * 3 + wave) * 64 + lane) * 4);
#pragma unroll
            for (int q = 0; q < 4; ++q) lgs[(4 * quad + q) * 49 + 16 * wave + lc] = s[q]; }
        __syncthreads();
        if (wave == 0 && lane < 16) { float sst = 0.f;
#pragma unroll
            for (int v = 0; v < 8; ++v) sst += sq[v * 16 + lane];
            const float rs = 1.0f / sqrtf(sst * (1.0f / DM) + NORM_EPS);
            float lg[36];
#pragma unroll
            for (int i = 0; i < 36; ++i) lg[i] = lgs[lane * 49 + i] * rs;
            int gi = 0; float gm = lg[32];
#pragma unroll
            for (int i = 1; i < 4; ++i) if (lg[32 + i] > gm) { gm = lg[32 + i]; gi = i; }
            float den = 0.f;
#pragma unroll
            for (int i = 0; i < 4; ++i) den += __expf(lg[32 + i] - gm);
            const float gp = 1.0f / den;
            float l8[8];
#pragma unroll
            for (int i = 0; i < 8; ++i) l8[i] = gi == 0 ? lg[i] : (gi == 1 ? lg[8 + i] : (gi == 2 ? lg[16 + i] : lg[24 + i]));
            int i1 = 0; float m1 = l8[0];
#pragma unroll
            for (int i = 1; i < 8; ++i) if (l8[i] > m1) { m1 = l8[i]; i1 = i; }
            int i2 = -1; float m2 = -INFINITY;
#pragma unroll
            for (int i = 0; i < 8; ++i) if (i != i1 && l8[i] > m2) { m2 = l8[i]; i2 = i; }
            const float e21 = __expf(m2 - m1); const float w1 = gp / (1.0f + e21), w2 = gp * e21 / (1.0f + e21);
            const int ea = gi * 8 + i1, eb = gi * 8 + i2; const int rt = task * 16 + lane;
            const unsigned sa = atomicAdd((unsigned*)(F.ctl + CW_MOECNT + (cl * NEXP + ea) * 16), 1u), sb = atomicAdd((unsigned*)(F.ctl + CW_MOECNT + (cl * NEXP + eb) * 16), 1u);
            unsigned* t = TI + (size_t)rt * 8; *(v4u*)t = (v4u){(unsigned)ea, sa, __float_as_uint(w1), (unsigned)eb}; *(v4u*)(t + 4) = (v4u){sb, __float_as_uint(w2), __float_as_uint(rs), 0u}; }
        __syncthreads();
    }
}
DI void moe_prefix(const Frame& F, int l, LAS int* ps) {
    if (F.tid == 0) { int t = 0;
        for (int e = 0; e < NEXP; ++e) { const unsigned c = __hip_atomic_load(F.ctl + CW_MOECNT + (l * NEXP + e) * 16, RLX_AGENT); ps[e] = t * 256; t += (int)((c + 255u) >> 8); }
        ps[32] = t; }
    __syncthreads();
}
DI void ph_gather(const Frame& F, const Args& a, int l) {
    LAS int* ps = (LAS int*)(F.lds + RING_OFF); moe_prefix(F, l, ps);
    if (F.vcu == 0 && F.tid < NEXP) { int* TE = (int*)(a.ws + WS_TILES); const int e = F.tid; const int t0 = ps[e] >> 8, t1 = (e == NEXP - 1 ? ps[32] : ps[e + 1] >> 8);
        for (int t = t0; t < t1; ++t) TE[t] = e; if (e == 0) TE[127] = ps[32]; }
    const float* H = (const float*)(a.ws + WS_H); const float* nw = a.in[3] + (size_t)l * DM; unsigned* TI = (unsigned*)(a.ws + WS_TOKINFO); bf16* XG = (bf16*)(a.ws + WS_SCR + SC_XG);
    const int lane = F.lane;
    for (int r = F.gw; r < TT; r += F.NGW) {
        unsigned* t = TI + (size_t)r * 8; const int g0 = ps[t[0]] + (int)t[1], g1 = ps[t[3]] + (int)t[4]; const float rs = __uint_as_float(t[6]);
        if (lane == 0) t[7] = (unsigned)g0 | ((unsigned)g1 << 16);
        const float* hr = H + (size_t)r * DM;
#pragma unroll
        for (int j = 0; j < 4; ++j) { const int e0 = (lane + 64 * j) * 8; const f32x4 x0 = *(const f32x4*)(hr + e0), x1 = *(const f32x4*)(hr + e0 + 4), w0 = *(const f32x4*)(nw + e0), w1 = *(const f32x4*)(nw + e0 + 4);
            v4u o; o.x = pk2(x0.x * rs * w0.x, x0.y * rs * w0.y); o.y = pk2(x0.z * rs * w0.z, x0.w * rs * w0.w); o.z = pk2(x1.x * rs * w1.x, x1.y * rs * w1.y); o.w = pk2(x1.z * rs * w1.z, x1.w * rs * w1.w);
            *(v4u*)(XG + (size_t)g0 * DM + e0) = o; *(v4u*)(XG + (size_t)g1 * DM + e0) = o; }
    }
}
DI void ph_combine(const Frame& F, const Args& a, int l) {
    float* H = (float*)(a.ws + WS_H); const unsigned* TI = (const unsigned*)(a.ws + WS_TOKINFO); const bf16* YB = (const bf16*)(a.ws + WS_SCR + SC_YB); bf16* HN = (bf16*)(a.ws + WS_HN);
    const int lane = F.lane; const int nrows = l == 0 ? TT : TX;
    for (int r = F.gw; r < nrows; r += F.NGW) {
        const unsigned* t = TI + (size_t)r * 8; const int g0 = (int)(t[7] & 0xffffu), g1 = (int)(t[7] >> 16); const float w0 = __uint_as_float(t[2]), w1 = __uint_as_float(t[5]);
        float* hr = H + (size_t)r * DM; float hv[32]; float s = 0.f;
#pragma unroll
        for (int j = 0; j < 4; ++j) { const int e0 = (lane + 64 * j) * 8; const f32x4 x0 = *(const f32x4*)(hr + e0), x1 = *(const f32x4*)(hr + e0 + 4);
            const v4u ya = *(const v4u*)(YB + (size_t)g0 * DM + e0), yc = *(const v4u*)(YB + (size_t)g1 * DM + e0);
            float* o = hv + 8 * j;
            o[0] = x0.x + w0 * bflo(ya.x) + w1 * bflo(yc.x); o[1] = x0.y + w0 * bfhi(ya.x) + w1 * bfhi(yc.x); o[2] = x0.z + w0 * bflo(ya.y) + w1 * bflo(yc.y); o[3] = x0.w + w0 * bfhi(ya.y) + w1 * bfhi(yc.y);
            o[4] = x1.x + w0 * bflo(ya.z) + w1 * bflo(yc.z); o[5] = x1.y + w0 * bfhi(ya.z) + w1 * bfhi(yc.z); o[6] = x1.z + w0 * bflo(ya.w) + w1 * bflo(yc.w); o[7] = x1.w + w0 * bfhi(ya.w) + w1 * bfhi(yc.w);
#pragma unroll
            for (int q = 0; q < 8; ++q) s += o[q] * o[q]; }
        const float rs = 1.0f / sqrtf(wave_sum(s) * (1.0f / DM) + NORM_EPS);
        if (l == 0) { const float* nw = a.in[2] + DM;
#pragma unroll
            for (int j = 0; j < 4; ++j) { const int e0 = (lane + 64 * j) * 8; const float* o = hv + 8 * j; const f32x4 wa = *(const f32x4*)(nw + e0), wb = *(const f32x4*)(nw + e0 + 4);
                *(f32x4*)(hr + e0) = (f32x4){o[0], o[1], o[2], o[3]}; *(f32x4*)(hr + e0 + 4) = (f32x4){o[4], o[5], o[6], o[7]};
                v4u p; p.x = pk2(o[0] * rs * wa.x, o[1] * rs * wa.y); p.y = pk2(o[2] * rs * wa.z, o[3] * rs * wa.w); p.z = pk2(o[4] * rs * wb.x, o[5] * rs * wb.y); p.w = pk2(o[6] * rs * wb.z, o[7] * rs * wb.w);
                *(v4u*)(HN + (size_t)r * DM + e0) = p; }
        } else { const float* nw = a.in[4]; float* orow = a.out + (size_t)r * DM;
#ifdef PROBE_TS
            { const unsigned long long* ts = (const unsigned long long*)(F.ctl + CW_TS); const float dt_us = (float)(__hip_atomic_load(ts + PROBE_TS + 1, RLX_AGENT) - __hip_atomic_load(ts + PROBE_TS, RLX_AGENT)) * 0.01f;
#pragma unroll
              for (int q = 0; q < 32; ++q) hv[q] *= 1.0f + dt_us * 0.01f; }
#endif
#pragma unroll
            for (int j = 0; j < 4; ++j) { const int e0 = (lane + 64 * j) * 8; const float* o = hv + 8 * j; const f32x4 wa = *(const f32x4*)(nw + e0), wb = *(const f32x4*)(nw + e0 + 4);
                *(f32x4*)(orow + e0) = (f32x4){o[0] * rs * wa.x, o[1] * rs * wa.y, o[2] * rs * wa.z, o[3] * rs * wa.w};
                *(f32x4*)(orow + e0 + 4) = (f32x4){o[4] * rs * wb.x, o[5] * rs * wb.y, o[6] * rs * wb.z, o[7] * rs * wb.w}; } }
    }
}

struct OddPrepItem { f32x4 w[4][2]; v4u x[11]; };
DI void odd_prep_load(OddPrepItem& it, const bf16* P, const float* cw, int item, int lane) {
    const int pb = item >> 4, i = item & 15, ch = i * 512 + lane * 8, p0 = pb * 8;
#pragma unroll
    for (int j = 0; j < 4; ++j) { it.w[j][0] = *(const f32x4*)(cw + j * 8192 + ch); it.w[j][1] = *(const f32x4*)(cw + j * 8192 + ch + 4); }
#pragma unroll
    for (int q = 0; q < 11; ++q) { const int p = p0 - 3 + q; it.x[q] = *(const v4u*)(P + (size_t)pos_row(p > 0 ? p : 0) * OD_NP + ch); if (p < 0) it.x[q] = (v4u){0u, 0u, 0u, 0u}; }
}
DI void odd_prep_compute(const OddPrepItem& it, const Args& a, int item, int lane) {
    const bf16* P = (const bf16*)(a.ws + WS_PROJ); bf16* QN = (bf16*)(a.ws + WS_SCR + SC_QN); bf16* KN = (bf16*)(a.ws + WS_SCR + SC_KN); bf16* VC = (bf16*)(a.ws + WS_SCR + SC_VC);
    float* BETA = (float*)(a.ws + WS_SCR + SC_BETA); float* GG = (float*)(a.ws + WS_SCR + SC_G);
    const int pb = item >> 4, i = item & 15, ch = i * 512 + lane * 8, p0 = pb * 8;
#pragma unroll
    for (int o = 0; o < 8; ++o) { const int r = pos_row(p0 + o); float acc[8] = {0.f, 0.f, 0.f, 0.f, 0.f, 0.f, 0.f, 0.f};
#pragma unroll
        for (int j = 0; j < 4; ++j) { const v4u xv = it.x[o + j];
            acc[0] += it.w[j][0].x * bflo(xv.x); acc[1] += it.w[j][0].y * bfhi(xv.x); acc[2] += it.w[j][0].z * bflo(xv.y); acc[3] += it.w[j][0].w * bfhi(xv.y);
            acc[4] += it.w[j][1].x * bflo(xv.z); acc[5] += it.w[j][1].y * bfhi(xv.z); acc[6] += it.w[j][1].z * bflo(xv.w); acc[7] += it.w[j][1].w * bfhi(xv.w); }
        float ss = 0.f;
#pragma unroll
        for (int q = 0; q < 8; ++q) { acc[q] = acc[q] * sigm(acc[q]); ss += acc[q] * acc[q]; }
        float sc = 1.0f;
        if (i < 8) { ss += __shfl_xor(ss, 1); ss += __shfl_xor(ss, 2); ss += __shfl_xor(ss, 4); ss += __shfl_xor(ss, 8);
            sc = (1.0f / sqrtf(ss + NORM_EPS)) * (i < 4 ? 0.08838834764831845f : 1.0f); }
        const v4u ov = (v4u){pk2(acc[0] * sc, acc[1] * sc), pk2(acc[2] * sc, acc[3] * sc), pk2(acc[4] * sc, acc[5] * sc), pk2(acc[6] * sc, acc[7] * sc)};
        bf16* dst = i < 4 ? QN + (size_t)r * 2048 + ch : (i < 8 ? KN + (size_t)r * 2048 + ch - 2048 : VC + (size_t)r * 4096 + ch - 4096);
        *(v4u*)dst = ov; }
    if (i == 0 && lane < 32) {
#pragma unroll
        for (int o = 0; o < 8; ++o) { const int r = pos_row(p0 + o); const float bb = bf2f(P[(size_t)r * OD_NP + OD_B + lane]), aa = bf2f(P[(size_t)r * OD_NP + OD_A + lane]);
            BETA[(size_t)r * 32 + lane] = sigm(bb); GG[(size_t)r * 32 + lane] = -__expf(a.in[27][lane]) * softplus(aa + a.in[28][lane]); } }
}
DI void ph_odd_prep(const Frame& F, const Args& a) {
    const bf16* P = (const bf16*)(a.ws + WS_PROJ); const float* cw = a.in[26]; constexpr int NI = (TT / 8) * 16;
    for (int item = F.gw; item < NI; item += 2 * F.NGW) { OddPrepItem A, B; const bool hb = item + F.NGW < NI;
        odd_prep_load(A, P, cw, item, F.lane); odd_prep_load(B, P, cw, hb ? item + F.NGW : item, F.lane);
        odd_prep_compute(A, a, item, F.lane); if (hb) odd_prep_compute(B, a, item + F.NGW, F.lane); }
}
DI void ph_odd_post(const Frame& F, const Args& a) {
    const bf16* P = (const bf16*)(a.ws + WS_PROJ); const bf16* O = (const bf16*)(a.ws + WS_SCR + SC_O); bf16* Y = (bf16*)(a.ws + WS_YMIX); const float* nw = a.in[29];
    const int lane = F.lane;
    for (int r = F.gw; r < TT; r += F.NGW) {
#pragma unroll 2
        for (int i = 0; i < 8; ++i) { const int ch = i * 512 + lane * 8; const v4u ow = *(const v4u*)(O + (size_t)r * 4096 + ch); const f32x4 o0 = (f32x4){bflo(ow.x), bfhi(ow.x), bflo(ow.y), bfhi(ow.y)}, o1 = (f32x4){bflo(ow.z), bfhi(ow.z), bflo(ow.w), bfhi(ow.w)};
            float ss = (o0.x * o0.x + o0.y * o0.y) + (o0.z * o0.z + o0.w * o0.w) + (o1.x * o1.x + o1.y * o1.y) + (o1.z * o1.z + o1.w * o1.w);
            ss += __shfl_xor(ss, 1); ss += __shfl_xor(ss, 2); ss += __shfl_xor(ss, 4); ss += __shfl_xor(ss, 8);
            const float rs = 1.0f / sqrtf(ss * (1.0f / 128.0f) + NORM_EPS);
            const v4u z = *(const v4u*)(P + (size_t)r * OD_NP + OD_Z + ch); const int c0 = ch & 127; const f32x4 w0 = *(const f32x4*)(nw + c0), w1 = *(const f32x4*)(nw + c0 + 4);
            const float zf[8] = {bflo(z.x), bfhi(z.x), bflo(z.y), bfhi(z.y), bflo(z.z), bfhi(z.z), bflo(z.w), bfhi(z.w)};
            const float of[8] = {o0.x * w0.x, o0.y * w0.y, o0.z * w0.z, o0.w * w0.w, o1.x * w1.x, o1.y * w1.y, o1.z * w1.z, o1.w * w1.w};
            float y[8];
#pragma unroll
            for (int q = 0; q < 8; ++q) y[q] = of[q] * rs * zf[q] * sigm(zf[q]);
            v4u p; p.x = pk2(y[0], y[1]); p.y = pk2(y[2], y[3]); p.z = pk2(y[4], y[5]); p.w = pk2(y[6], y[7]);
            *(v4u*)(Y + (size_t)r * 4096 + ch) = p; }
    }
}

typedef float f32x16 __attribute__((ext_vector_type(16)));
#define MFMA32(a, b, c) __builtin_amdgcn_mfma_f32_32x32x16_bf16((a), (b), (c), 0, 0, 0)
DI int crow(int reg, int h) { return (reg & 3) + 8 * (reg >> 2) + 4 * h; }
DI int chunk_row(int n, int c) { return n == 0 ? (c >= 48 ? TX + (c - 48) : -1) : 64 * (n - 1) + c; }
#ifndef GDN_NO_HELPER
#define GDN_NO_HELPER 0
#endif
constexpr int GDN_NCH = 129, GDN_UNITS = GDN_NCH * 32, GDN_KUNITS = GDN_NCH * 16, GC_STRIDE = 72;
constexpr size_t GD_WF = WS_MOEW, GD_UF = WS_MOEW + 65 * MiB, GD_IN = WS_MOEW + 130 * MiB, GD_GC = WS_MOEW + 163 * MiB, GD_KT = WS_HN, GD_QF = WS_YMIX, GD_SAVE = WS_SCR + 205 * MiB;
static_assert((size_t)GDN_UNITS * 16384 <= 65 * MiB && (size_t)GDN_UNITS * 8192 <= 33 * MiB && (size_t)GDN_KUNITS * 16384 <= 33 * MiB && GD_GC + (size_t)GDN_UNITS * GC_STRIDE * 4 <= WS_H, "gdn map");

DI void ph_gdn_chunk(const Frame& F, const Args& a, int n_lo, int n_hi, int side) {
    const bf16* QN = (const bf16*)(a.ws + WS_SCR + SC_QN); const bf16* KN = (const bf16*)(a.ws + WS_SCR + SC_KN); const bf16* VC = (const bf16*)(a.ws + WS_SCR + SC_VC);
    const float* BETA = (const float*)(a.ws + WS_SCR + SC_BETA); const float* GG = (const float*)(a.ws + WS_SCR + SC_G);
    bf16* WF = (bf16*)(a.ws + GD_WF); bf16* UF = (bf16*)(a.ws + GD_UF); bf16* INF = (bf16*)(a.ws + GD_IN); bf16* KTF = (bf16*)(a.ws + GD_KT); bf16* QF = (bf16*)(a.ws + GD_QF); float* GC = (float*)(a.ws + GD_GC);
    LAS unsigned char* L = F.lds + RING_OFF;
    LAS unsigned char* kS = L; LAS unsigned char* qS = L + 17408; LAS unsigned char* vS = L + 34816; LAS unsigned char* kbS = L + 52224;
    LAS float* Lm = (LAS float*)(L + 69632); LAS bf16* IS = (LAS bf16*)(L + 87040); LAS bf16* XS = (LAS bf16*)(L + 96256);
    LAS float* betaS = (LAS float*)(L + 130048); LAS float* gcS = betaS + 64; LAS float* egcS = betaS + 128;
    LAS unsigned char* Lb = L + 17408; LAS unsigned char* TDs = L + 26624; LAS unsigned char* YT0 = L + 28672; LAS unsigned char* XT0 = L + 130816;
    static_assert(130816 + 8 * 1792 <= LDSCTL_OFF, "gdn lds map");
    const int tid = F.tid, lane = F.lane, wave = F.wave, l31 = lane & 31, h = lane >> 5;
    int widx = F.vcu, wcnt = F.G;
    if (side) { if (F.G == 256) { const int wx = F.vcu & 31; if (wx < 20) return; widx = (F.vcu >> 5) * 12 + (wx - 20); wcnt = 96; } else { if (F.vcu < 128 || F.G <= 128) return; widx = F.vcu - 128; wcnt = F.G - 128; } }
    for (int unit = n_lo * 32 + widx; unit < n_hi * 32; unit += wcnt) {
        const int n = unit >> 5, hv = unit & 31, hk = hv >> 1; const size_t su = (size_t)hv * GDN_NCH + n;
#pragma unroll
        for (int i = 0; i < 2; ++i) { const int p = tid + 512 * i, row = p >> 4, ch = p & 15; const int rr = chunk_row(n, row);
            v4u kx = (v4u){0u, 0u, 0u, 0u}, qx = kx, vx = kx;
            if (rr >= 0) { kx = *(const v4u*)(KN + (size_t)rr * 2048 + hk * 128 + ch * 8); qx = *(const v4u*)(QN + (size_t)rr * 2048 + hk * 128 + ch * 8); vx = *(const v4u*)(VC + (size_t)rr * 4096 + hv * 128 + ch * 8); }
            *(LAS v4u*)(kS + row * 272 + ch * 16) = kx; *(LAS v4u*)(qS + row * 272 + ch * 16) = qx; *(LAS v4u*)(vS + row * 272 + ch * 16) = vx; }
        if (wave == 0) { const int rr = chunk_row(n, lane); float b = 0.f, g = 0.f; if (rr >= 0) { b = BETA[(size_t)rr * 32 + hv]; g = GG[(size_t)rr * 32 + hv]; }
#pragma unroll
            for (int o = 1; o < 64; o <<= 1) { const float t = __shfl_up(g, o); if (lane >= o) g += t; }
            betaS[lane] = b; gcS[lane] = g; egcS[lane] = __expf(g); }
        __syncthreads();
        if ((hv & 1) == 0) { const size_t kunit = (size_t)hk * GDN_NCH + n;
#pragma unroll
            for (int i = 0; i < 2; ++i) { const int p = tid + 512 * i, comb = p >> 6, ln = p & 63, t = comb >> 3, s = comb & 7; const int c = 32 * t + (ln & 31), k0 = 16 * s + 8 * (ln >> 5);
                *(v4u*)(QF + (kunit * 16 + comb) * 512 + ln * 8) = *(const LAS v4u*)(qS + c * 272 + k0 * 2); } }
#pragma unroll
        for (int i = 0; i < 2; ++i) { const int p = tid + 512 * i, row = p >> 4, ch = p & 15; const v4u kx = *(const LAS v4u*)(kS + row * 272 + ch * 16); const float b = betaS[row];
            v4u o; o.x = pk2(bflo(kx.x) * b, bfhi(kx.x) * b); o.y = pk2(bflo(kx.y) * b, bfhi(kx.y) * b); o.z = pk2(bflo(kx.z) * b, bfhi(kx.z) * b); o.w = pk2(bflo(kx.w) * b, bfhi(kx.w) * b);
            *(LAS v4u*)(kbS + row * 272 + ch * 16) = o; }
        __syncthreads();
        { const int which = wave >> 2, ti = (wave >> 1) & 1, tj = wave & 1;
          f32x16 acc;
#pragma unroll
          for (int r = 0; r < 16; ++r) acc[r] = 0.f;
          if (!(ti == 0 && tj == 1)) { const LAS unsigned char* Ab = (which == 0 ? kbS : qS) + (32 * ti + l31) * 272 + 16 * h; const LAS unsigned char* Bb = kS + (32 * tj + l31) * 272 + 16 * h;
#pragma unroll
              for (int s = 0; s < 8; ++s) acc = MFMA32(*(const LAS bf16x8*)(Ab + 32 * s), *(const LAS bf16x8*)(Bb + 32 * s), acc); }
          const int j = 32 * tj + l31; const float gj = gcS[j];
#pragma unroll
          for (int r = 0; r < 16; ++r) { const int i = 32 * ti + crow(r, h); const float e = __expf(fminf(gcS[i] - gj, 0.f));
              if (which == 0) Lm[i * 68 + j] = i > j ? acc[r] * e : 0.f;
              else IS[i * 72 + j] = (bf16)f2bf(i >= j ? acc[r] * e : 0.f); } }
        __syncthreads();
#pragma unroll
        for (int i = 0; i < 8; ++i) { const int e = tid + 512 * i, r = e >> 6, c = e & 63; *(LAS bf16*)(Lb + r * 144 + c * 2) = (bf16)f2bf(Lm[r * 68 + c]); }
        if (wave == 0) { const int b = lane >> 4, c = lane & 15; float t[16]; const LAS float* Ld = Lm + (16 * b) * 68 + 16 * b;
#pragma unroll
            for (int i = 0; i < 16; ++i) { float acc = i == c ? 1.f : 0.f;
#pragma unroll
                for (int j = 0; j < i; ++j) acc -= Ld[i * 68 + j] * t[j];
                t[i] = acc; *(LAS bf16*)(TDs + (b * 16 + i) * 32 + c * 2) = (bf16)f2bf(acc); }
        } else if (wave >= 4) { const int t2 = tid - 256;
#pragma unroll
            for (int i = 0; i < 2; ++i) { const int p = t2 + 256 * i, comb = p >> 6, ln = p & 63, t = comb >> 2, s = comb & 3; const int c = 32 * t + (ln & 31), j0 = 16 * s + 8 * (ln >> 5);
                *(v4u*)(INF + (su * 8 + comb) * 512 + ln * 8) = *(const LAS v4u*)(IS + c * 72 + j0); }
            if ((hv & 1) == 0) { const size_t kunit = (size_t)hk * GDN_NCH + n;
#pragma unroll
                for (int i = 0; i < 4; ++i) { const int p = t2 + 256 * i, comb = p >> 6, ln = p & 63, kt = comb >> 2, s = comb & 3; const int kd = 32 * kt + (ln & 31), c0 = 16 * s + 8 * (ln >> 5);
                    unsigned w[4];
#pragma unroll
                    for (int jj = 0; jj < 4; ++jj) { const unsigned lo = *(const LAS bf16*)(kS + (c0 + 2 * jj) * 272 + kd * 2), hi = *(const LAS bf16*)(kS + (c0 + 2 * jj + 1) * 272 + kd * 2); w[jj] = lo | (hi << 16); }
                    *(v4u*)(KTF + (kunit * 16 + comb) * 512 + ln * 8) = (v4u){w[0], w[1], w[2], w[3]}; } }
            if (t2 < 64) GC[su * GC_STRIDE + t2] = gcS[t2];
            else if (t2 == 64) GC[su * GC_STRIDE + 64] = gcS[63];
            else if (t2 == 65) GC[su * GC_STRIDE + 65] = egcS[63];
        }
        __syncthreads();
        { const int quad = lane >> 4, lc = lane & 15; LAS unsigned char* XTw = XT0 + wave * 1792; LAS unsigned char* YTw = YT0 + wave * 768;
          const bf16x8 z8 = (bf16x8){0, 0, 0, 0, 0, 0, 0, 0}; const f32x4 z4 = (f32x4){0.f, 0.f, 0.f, 0.f};
          bf16x8 tdf[4];
#pragma unroll
          for (int b = 0; b < 4; ++b) tdf[b] = quad < 2 ? *(const LAS bf16x8*)(TDs + (b * 16 + lc) * 32 + quad * 16) : z8;
#pragma unroll 1
          for (int tl = 0; tl < 2; ++tl) { const int col = 32 * wave + 16 * tl + lc;
              const LAS unsigned char* rz = wave < 4 ? vS + col * 2 : kbS + (col - 128) * 2; const LAS float* bz = wave < 4 ? betaS : egcS;
#pragma unroll
              for (int b = 0; b < 4; ++b) { f32x4 y;
#pragma unroll
                  for (int r = 0; r < 4; ++r) { const int i = 16 * b + 4 * quad + r; y[r] = bf2f(*(const LAS bf16*)(rz + i * 272)) * bz[i]; }
                  if (b >= 1) { f32x4 p = z4;
#pragma unroll
                      for (int kk = 0; kk < (b >= 3 ? 2 : 1); ++kk) { const bf16x8 af = *(const LAS bf16x8*)(Lb + (16 * b + lc) * 144 + (32 * kk + 8 * quad) * 2);
                          const bf16x8 bfv = (32 * kk + 8 * quad < 16 * b) ? *(const LAS bf16x8*)(XTw + lc * 112 + (32 * kk + 8 * quad) * 2) : z8;
                          p = __builtin_amdgcn_mfma_f32_16x16x32_bf16(af, bfv, p, 0, 0, 0); }
                      y = y - p; }
                  *(LAS v2u*)(YTw + lc * 48 + quad * 8) = (v2u){pk2(y[0], y[1]), pk2(y[2], y[3])};
                  asm volatile("" ::: "memory");
                  const bf16x8 yb = quad < 2 ? *(const LAS bf16x8*)(YTw + lc * 48 + quad * 16) : z8;
                  const f32x4 x = __builtin_amdgcn_mfma_f32_16x16x32_bf16(tdf[b], yb, z4, 0, 0, 0);
                  if (b < 3) *(LAS v2u*)(XTw + lc * 112 + (16 * b + 4 * quad) * 2) = (v2u){pk2(x[0], x[1]), pk2(x[2], x[3])};
                  asm volatile("" ::: "memory");
#pragma unroll
                  for (int r = 0; r < 4; ++r) XS[(16 * b + 4 * quad + r) * 264 + col] = (bf16)f2bf(x[r]); } } }
        __syncthreads();
#pragma unroll
        for (int i = 0; i < 2; ++i) { const int p = tid + 512 * i, comb = p >> 6, ln = p & 63, t = comb >> 3, s = comb & 7; const int c = 32 * t + (ln & 31), k0 = 16 * s + 8 * (ln >> 5);
            *(v4u*)(WF + (su * 16 + comb) * 512 + ln * 8) = *(const LAS v4u*)(XS + c * 264 + 128 + k0); }
        { const int t = wave >> 2, ns = wave & 3; unsigned w[8];
#pragma unroll
          for (int r = 0; r < 8; ++r) { const unsigned lo = XS[(32 * t + crow(2 * r, h)) * 264 + 32 * ns + l31], hi = XS[(32 * t + crow(2 * r + 1, h)) * 264 + 32 * ns + l31]; w[r] = lo | (hi << 16); }
          bf16* dst = UF + ((su * 8 + wave) * 64 + lane) * 16; *(v4u*)dst = (v4u){w[0], w[1], w[2], w[3]}; *(v4u*)(dst + 8) = (v4u){w[4], w[5], w[6], w[7]}; }
        __syncthreads();
    }
}

DI void ph_gdn_chain(const Frame& F, const Args& a, int n_lo, int n_hi) {
    const int xg = F.vcu >> 5, wx = F.vcu & 31; if (F.G != 256 ? F.vcu >= 128 : wx >= 20) return;
    const bool helper = F.G == 256 && wx >= 16;
    const int hv = F.G == 256 ? 4 * xg + (helper ? wx - 16 : wx >> 2) : F.vcu >> 2, ns = F.G == 256 ? wx & 3 : F.vcu & 3, hk = hv >> 1;
    const bf16* QN = (const bf16*)(a.ws + WS_SCR + SC_QN);
    const bf16* WF = (const bf16*)(a.ws + GD_WF); const bf16* UF = (const bf16*)(a.ws + GD_UF); const bf16* INF = (const bf16*)(a.ws + GD_IN); const bf16* KTF = (const bf16*)(a.ws + GD_KT); const bf16* QF = (const bf16*)(a.ws + GD_QF); const float* GC = (const float*)(a.ws + GD_GC);
    bf16* O = (bf16*)(a.ws + WS_SCR + SC_O);
    gu32* prog = F.ctl + CW_PROG + hv * 16;
    if (helper && GDN_NO_HELPER) return;
    if (helper) { unsigned sink = 0u; const int tid = F.tid;
        for (int n0 = n_lo; n0 < n_hi; n0 += 4) {
            if (n0 >= n_lo + 8) { if (tid == 0) { unsigned sp = 0; while ((int)__hip_atomic_load(prog, RLX_AGENT) < n0 - 4 && ++sp < 20000u) __builtin_amdgcn_s_sleep(8); } __syncthreads(); }
            unsigned v[5];
#pragma unroll
            for (int i = 0; i < 5; ++i) { const int li = tid + 512 * i;
                const int st = li / 580, ln = li % 580, n = n0 + st; const unsigned* p = nullptr;
                if (st < 4 && n < n_hi) { const size_t unit = (size_t)hv * GDN_NCH + n, kunit = (size_t)hk * GDN_NCH + n;
                    if (ln < 128) p = (const unsigned*)(WF + unit * 8192 + ln * 64);
                    else if (ln < 256) p = (const unsigned*)(UF + unit * 8192 + (ln - 128) * 64);
                    else if (ln < 320) p = (const unsigned*)(INF + unit * 4096 + (ln - 256) * 64);
                    else if (ln < 448) p = (const unsigned*)(KTF + kunit * 8192 + (ln - 320) * 64);
                    else if (ln < 576) p = (const unsigned*)(QF + kunit * 8192 + (ln - 448) * 64);
                    else if (ln < 579) p = (const unsigned*)(GC + unit * GC_STRIDE + (ln - 576) * 32); }
                v[i] = p ? *p : 0u; }
#pragma unroll
            for (int i = 0; i < 5; ++i) sink += v[i];
        }
        if (sink == 0x12345u) __hip_atomic_store(F.ctl + CW_TMO + 2, sink, RLX_AGENT);
        return; }
    LAS unsigned char* ST = F.lds + RING_OFF; LAS unsigned char* VN = ST + 8704; LAS unsigned char* VND = ST + 13312;
    const int lane = F.lane, wave = F.wave, l31 = lane & 31, h = lane >> 5;
    for (int i = F.tid; i < 8704 / 4; i += NWAVES * 64) ((LAS unsigned*)ST)[i] = 0u;
#define GDN_BAR() do { asm volatile("s_waitcnt lgkmcnt(0)" ::: "memory"); __builtin_amdgcn_s_barrier(); asm volatile("" ::: "memory"); } while (0)
    GDN_BAR();
    f32x16 S;
#pragma unroll
    for (int r = 0; r < 16; ++r) S[r] = 0.f;
    const int role = wave < 2 ? 0 : (wave < 4 ? 1 : 2); const int t = wave & 1, kt = wave & 3;
    bf16x8 A8[8]; bf16x8 A4[4]; v4u U0 = (v4u){0u, 0u, 0u, 0u}, U1 = U0; f32x4 G4[4]; float gl = 0.f, egl = 1.f;
#pragma unroll
    for (int s = 0; s < 8; ++s) A8[s] = (bf16x8){0, 0, 0, 0, 0, 0, 0, 0};
#pragma unroll
    for (int s = 0; s < 4; ++s) { A4[s] = (bf16x8){0, 0, 0, 0, 0, 0, 0, 0}; G4[s] = (f32x4){0.f, 0.f, 0.f, 0.f}; }
#define GDN_LOAD(nn) do { const size_t unit_ = (size_t)hv * GDN_NCH + (nn); const float* gc_ = GC + unit_ * GC_STRIDE; \
        if (role == 0) { \
            const bf16* up_ = UF + (((unit_ * 2 + t) * 4 + ns) * 64 + lane) * 16; U0 = *(const v4u*)up_; U1 = *(const v4u*)(up_ + 8); \
            _Pragma("unroll") for (int g = 0; g < 4; ++g) G4[g] = *(const f32x4*)(gc_ + 32 * t + 8 * g + 4 * h); gl = gc_[64]; } \
        else if (role == 1) { const size_t qunit_ = (size_t)hk * GDN_NCH + (nn); \
            _Pragma("unroll") for (int s = 0; s < 4; ++s) A4[s] = *(const bf16x8*)(INF + ((unit_ * 2 + t) * 4 + s) * 512 + lane * 8); \
            _Pragma("unroll") for (int g = 0; g < 4; ++g) G4[g] = *(const f32x4*)(gc_ + 32 * t + 8 * g + 4 * h); } \
        else { const size_t kunit_ = (size_t)hk * GDN_NCH + (nn); \
            _Pragma("unroll") for (int s = 0; s < 4; ++s) A4[s] = *(const bf16x8*)(KTF + ((kunit_ * 4 + kt) * 4 + s) * 512 + lane * 8); egl = gc_[65]; } } while (0)
    float* SV = (float*)(a.ws + GD_SAVE) + ((size_t)((hv * 4 + ns) * 4 + kt) * 64 + lane) * 16;
    if (n_lo > 0 && role == 2) {
#pragma unroll
        for (int g = 0; g < 4; ++g) { const f32x4 v = *(const f32x4*)(SV + 4 * g); S[4 * g] = v.x; S[4 * g + 1] = v.y; S[4 * g + 2] = v.z; S[4 * g + 3] = v.w;
            *(LAS v2u*)(ST + l31 * 272 + (32 * kt + 8 * g + 4 * h) * 2) = (v2u){pk2(v.x, v.y), pk2(v.z, v.w)}; }
    }
    GDN_BAR();
#define GDN_LOADA(AC, nn) do { if (role == 0) { const size_t u_ = (size_t)hv * GDN_NCH + (nn); _Pragma("unroll") for (int s = 0; s < 8; ++s) AC[s] = *(const bf16x8*)(WF + ((u_ * 2 + t) * 8 + s) * 512 + lane * 8); } \
        else if (role == 1) { const size_t q_ = (size_t)hk * GDN_NCH + (nn); _Pragma("unroll") for (int s = 0; s < 8; ++s) AC[s] = *(const bf16x8*)(QF + ((q_ * 2 + t) * 8 + s) * 512 + lane * 8); } } while (0)
    bf16x8 A8q[8];
#pragma unroll
    for (int s = 0; s < 8; ++s) A8q[s] = (bf16x8){0, 0, 0, 0, 0, 0, 0, 0};
    GDN_LOADA(A8, n_lo); if (n_lo + 1 < n_hi) GDN_LOADA(A8q, n_lo + 1);
    GDN_LOAD(n_lo);
#define GDN_STEP(n, AC) do { \
        bf16x8 a4[4]; const v4u u0 = U0, u1 = U1; f32x4 g4[4]; const float cgl = gl, cegl = egl; \
        _Pragma("unroll") \
        for (int s = 0; s < 4; ++s) { a4[s] = A4[s]; g4[s] = G4[s]; } \
        if (n + 1 < n_hi) GDN_LOAD(n + 1); \
        if (ns == 0 && F.tid == 0) __hip_atomic_store(prog, (unsigned)n, RLX_AGENT); \
        f32x16 acc; \
        _Pragma("unroll") \
        for (int r = 0; r < 16; ++r) acc[r] = 0.f; \
        if (role < 2) { \
        _Pragma("unroll") \
            for (int s = 0; s < 8; ++s) acc = MFMA32(AC[s], *(const LAS bf16x8*)(ST + l31 * 272 + 32 * s + 16 * h), acc); \
            asm volatile("" :: "v"(acc[0])); \
            if (n + 2 < n_hi) GDN_LOADA(AC, n + 2); \
        } \
        if (role == 0) { const unsigned uw[8] = {u0.x, u0.y, u0.z, u0.w, u1.x, u1.y, u1.z, u1.w}; \
        _Pragma("unroll") \
            for (int g = 0; g < 4; ++g) { float vn[4], vd[4]; \
        _Pragma("unroll") \
                for (int q = 0; q < 4; ++q) { const int r = 4 * g + q; const float uv = (r & 1) ? bfhi(uw[r >> 1]) : bflo(uw[r >> 1]); vn[q] = uv - acc[r]; vd[q] = vn[q] * __expf(cgl - g4[g][q]); } \
                *(LAS v2u*)(VN + l31 * 144 + (32 * t + 8 * g + 4 * h) * 2) = (v2u){pk2(vn[0], vn[1]), pk2(vn[2], vn[3])}; \
                *(LAS v2u*)(VND + l31 * 144 + (32 * t + 8 * g + 4 * h) * 2) = (v2u){pk2(vd[0], vd[1]), pk2(vd[2], vd[3])}; } \
        } else if (role == 1) { \
        _Pragma("unroll") \
            for (int g = 0; g < 4; ++g) \
        _Pragma("unroll") \
                for (int q = 0; q < 4; ++q) acc[4 * g + q] *= __expf(g4[g][q]); \
        } \
        GDN_BAR(); \
        if (role == 1) { \
        _Pragma("unroll") \
            for (int s = 0; s < 4; ++s) acc = MFMA32(a4[s], *(const LAS bf16x8*)(VN + l31 * 144 + 32 * s + 16 * h), acc); \
        _Pragma("unroll") \
            for (int r = 0; r < 16; ++r) { const int rr = chunk_row(n, 32 * t + crow(r, h)); if (rr >= 0) O[(size_t)rr * 4096 + hv * 128 + 32 * ns + l31] = (bf16)f2bf(acc[r]); } \
        } else if (role == 2) { \
        _Pragma("unroll") \
            for (int r = 0; r < 16; ++r) S[r] *= cegl; \
        _Pragma("unroll") \
            for (int s = 0; s < 4; ++s) S = MFMA32(a4[s], *(const LAS bf16x8*)(VND + l31 * 144 + 32 * s + 16 * h), S); \
        _Pragma("unroll") \
            for (int g = 0; g < 4; ++g) *(LAS v2u*)(ST + l31 * 272 + (32 * kt + 8 * g + 4 * h) * 2) = (v2u){pk2(S[4 * g], S[4 * g + 1]), pk2(S[4 * g + 2], S[4 * g + 3])}; \
        } \
        GDN_BAR(); \
    } while (0)
    for (int n2 = n_lo; n2 < n_hi; n2 += 2) { GDN_STEP(n2, A8); if (n2 + 1 < n_hi) GDN_STEP(n2 + 1, A8q); }
#undef GDN_STEP
#undef GDN_LOADA
    if (n_hi < GDN_NCH && role == 2) {
#pragma unroll
        for (int g = 0; g < 4; ++g) *(f32x4*)(SV + 4 * g) = (f32x4){S[4 * g], S[4 * g + 1], S[4 * g + 2], S[4 * g + 3]}; }
#undef GDN_LOAD
#undef GDN_BAR
}

constexpr int RW_NSC = 258, RW_UNITS = 129 * 16;
DI int sub_row(int sc, int t) { const int n = sc >> 1, sub = sc & 1; return n == 0 ? ((sub == 0 && t >= 16) ? TX + t - 16 : -1) : 64 * (n - 1) + 32 * sub + t; }
constexpr size_t RW_BASE = WS_PROJ + 92 * MiB;
constexpr size_t RW_RH = RW_BASE, RW_RL = RW_BASE + 33 * MiB, RW_GT = RW_BASE + 66 * MiB, RW_GAM = RW_BASE + 99 * MiB;
constexpr size_t RW_PR = WS_SCR + 195 * MiB, RW_AT = WS_SCR + 211 * MiB + 256 * 1024, RW_VTF = WS_SCR + 219 * MiB + 512 * 1024, RW_SALL = WS_SCR + 235 * MiB + 768 * 1024;
constexpr size_t RW_XSAVE = 1 * MiB + 640 * 1024;
constexpr size_t RW_VV = WS_YMIX + 34 * MiB, RW_BON = WS_YMIX + 52 * MiB, LR_H = WS_YMIX + 54 * MiB, LR_A = WS_YMIX + 56 * MiB, LR_C = WS_YMIX + 58 * MiB;
constexpr size_t RW_SCH = (size_t)RW_NSC * 16;
static_assert((size_t)MP * EV_NP * 2 <= 92 * MiB && RW_SCH * 8192 <= 33 * MiB && RW_GAM + RW_SCH * 256 <= WS_SCR, "rwkv map (proj region)");
static_assert(WS_SCR + SC_LIX + (size_t)MP * 4096 <= RW_PR && RW_PR + RW_SCH * 4096 <= RW_AT && RW_AT + RW_SCH * 2048 <= RW_VTF && RW_VTF + RW_SCH * 4096 <= RW_SALL && RW_SALL + RW_SCH * 8192 <= WS_END, "rwkv map (scratch region)");
static_assert((size_t)MP * DM * 2 <= 34 * MiB && RW_VV + (size_t)MP * 2048 <= RW_BON && RW_BON + (size_t)MP * 64 <= LR_H && LR_H + RW_SCH * 256 <= LR_A && LR_A + RW_SCH * 256 <= LR_C && LR_C + RW_SCH * 256 <= WS_PROJ, "rwkv map (ymix region)");

DI void sub_rows(int sc, int& t0, int& rbase) { if (sc >= 2) { t0 = 0; rbase = 64 * ((sc >> 1) - 1) + 32 * (sc & 1); } else if (sc == 0) { t0 = 16; rbase = TX - 16; } else { t0 = 32; rbase = 0; } }
DI void lru_local(const Frame& F, const Args& a) {
    const bf16* LA = (const bf16*)(a.ws + WS_SCR + SC_LA); const bf16* LIX = (const bf16*)(a.ws + WS_SCR + SC_LIX);
    float* HL = (float*)(a.ws + LR_H); float* AP = (float*)(a.ws + LR_A);
    for (int item = F.gw; item < RW_NSC * 16; item += F.NGW) { const int sc = item >> 4, c = (item & 15) * 64 + F.lane; int t0, rbase; sub_rows(sc, t0, rbase);
        float av[32], ix[32];
#pragma unroll
        for (int t = 0; t < 32; ++t) { const size_t o = (size_t)(rbase + (t >= t0 ? t : 32)) * 1024 + c; av[t] = bf2f(LA[o]); ix[t] = bf2f(LIX[o]); }
        float h = 0.f, p = 1.f;
#pragma unroll
        for (int t = 0; t < 32; ++t) { const float om = t >= t0 ? av[t] : 0.f, x_ = t >= t0 ? ix[t] : 0.f, a_ = 1.0f - om; h = a_ * h + sqrtf(om * (1.0f + a_)) * x_; p *= a_; }
        HL[sc * 1024 + c] = h; AP[sc * 1024 + c] = p; }
}
DI void lru_apply(const Frame& F, const Args& a) {
    const bf16* P = (const bf16*)(a.ws + WS_PROJ); const bf16* LA = (const bf16*)(a.ws + WS_SCR + SC_LA); const bf16* LIX = (const bf16*)(a.ws + WS_SCR + SC_LIX);
    const float* CR = (const float*)(a.ws + LR_C); bf16* Y = (bf16*)(a.ws + WS_YMIX);
    for (int item = F.gw; item < RW_NSC * 16; item += F.NGW) { const int sc = item >> 4, c = (item & 15) * 64 + F.lane; int t0, rbase; sub_rows(sc, t0, rbase); if (t0 >= 32) continue;
        float h = CR[sc * 1024 + c];
#pragma unroll
        for (int tb = 0; tb < 32; tb += 16) { float av[16], ix[16], gb[16];
#pragma unroll
            for (int t = 0; t < 16; ++t) { const size_t r_ = (size_t)(rbase + (tb + t >= t0 ? tb + t : 32)); av[t] = bf2f(LA[r_ * 1024 + c]); ix[t] = bf2f(LIX[r_ * 1024 + c]); gb[t] = bf2f(P[r_ * EV_NP + EV_GB + c]); }
#pragma unroll
            for (int t = 0; t < 16; ++t) { if (tb + t >= t0) { const float a_ = 1.0f - av[t]; h = a_ * h + sqrtf(av[t] * (1.0f + a_)) * ix[t]; Y[(size_t)(rbase + tb + t) * DM + 1024 + c] = (bf16)f2bf(h * gelu_tanh(gb[t])); } } } }
}

DI void ph_rwkv_chunk(const Frame& F, const Args& a, int n_lo, int n_hi, int wg0) {
    if (F.vcu < wg0) return;
    const bf16* P = (const bf16*)(a.ws + WS_PROJ); const bf16* DEC = (const bf16*)(a.ws + WS_SCR + SC_DEC); const bf16* ICL = (const bf16*)(a.ws + WS_SCR + SC_ICL);
    bf16* RH = (bf16*)(a.ws + RW_RH); bf16* RL = (bf16*)(a.ws + RW_RL); bf16* GT = (bf16*)(a.ws + RW_GT); float* GAM = (float*)(a.ws + RW_GAM); bf16* PR = (bf16*)(a.ws + RW_PR); bf16* ATG = (bf16*)(a.ws + RW_AT); bf16* VTF = (bf16*)(a.ws + RW_VTF);
    bf16* VV = (bf16*)(a.ws + RW_VV); float* BON = (float*)(a.ws + RW_BON);
    LAS unsigned char* L = F.lds + RING_OFF;
    LAS float* wS = (LAS float*)L; LAS float* aS = wS + 4096; LAS float* bS = wS + 8192; LAS float* rS = wS + 12288; LAS float* kS = wS + 16384;
    LAS unsigned char* vT = L + 81920; LAS unsigned char* aT = L + 91136; LAS unsigned char* rT = L + 100352; LAS unsigned char* kT = L + 109568; LAS unsigned char* bT = L + 118784;
    LAS unsigned char* AT = L + 128000; LAS unsigned char* NT = L + 133120; LAS float* gam = (LAS float*)(L + 138240);
    LAS unsigned char* aTl = L; LAS unsigned char* bTl = L + 9216;
    const int tid = F.tid, lane = F.lane, wave = F.wave, l31 = lane & 31, h = lane >> 5;
    const float* mu = a.in[6];
    for (int unit = n_lo * 16 + (F.vcu - wg0); unit < n_hi * 16; unit += F.G - wg0) {
        const int n = unit >> 4, hd = unit & 15;
        { const int tok = tid >> 3, cg = tid & 7, c0 = hd * 64 + cg * 8; const int rr = sub_row(2 * n + (tok >> 5), tok & 31);
          float wv[8], av[8], bv[8], rv[8], kv[8], vv[8];
#pragma unroll
          for (int q = 0; q < 8; ++q) { wv[q] = 1.f; av[q] = 0.f; bv[q] = 0.f; rv[q] = 0.f; kv[q] = 0.f; vv[q] = 0.f; }
          if (rr >= 0) { const int pos = row_pos(rr); const bf16* cur = P + (size_t)rr * EV_NP + c0; const bf16* prv = pos > 0 ? P + (size_t)pos_row(pos - 1) * EV_NP + c0 : nullptr;
              const v4u z4 = (v4u){0u, 0u, 0u, 0u};
              const v4u cr = *(const v4u*)cur, ck = *(const v4u*)(cur + 1024), cv = *(const v4u*)(cur + 2048);
              const v4u qr = prv ? *(const v4u*)prv : z4, qk = prv ? *(const v4u*)(prv + 1024) : z4, qv = prv ? *(const v4u*)(prv + 2048) : z4;
              const unsigned crw[4] = {cr.x, cr.y, cr.z, cr.w}, ckw[4] = {ck.x, ck.y, ck.z, ck.w}, cvw[4] = {cv.x, cv.y, cv.z, cv.w}, qrw[4] = {qr.x, qr.y, qr.z, qr.w}, qkw[4] = {qk.x, qk.y, qk.z, qk.w}, qvw[4] = {qv.x, qv.y, qv.z, qv.w};
              float ss = 0.f, bon = 0.f; float kk[8], ic[8];
#pragma unroll
              for (int q = 0; q < 8; ++q) { const int c = c0 + q; const float crf = (q & 1) ? bfhi(crw[q >> 1]) : bflo(crw[q >> 1]), ckf = (q & 1) ? bfhi(ckw[q >> 1]) : bflo(ckw[q >> 1]), cvf = (q & 1) ? bfhi(cvw[q >> 1]) : bflo(cvw[q >> 1]);
                  const float prf = (q & 1) ? bfhi(qrw[q >> 1]) : bflo(qrw[q >> 1]), pkf = (q & 1) ? bfhi(qkw[q >> 1]) : bflo(qkw[q >> 1]), pvf = (q & 1) ? bfhi(qvw[q >> 1]) : bflo(qvw[q >> 1]);
                  rv[q] = crf + (prf - crf) * mu[c]; kk[q] = ckf + (pkf - ckf) * mu[1024 + c]; vv[q] = cvf + (pvf - cvf) * mu[2048 + c];
                  wv[q] = 1.0f - bf2f(DEC[(size_t)rr * 1024 + c]); ic[q] = bf2f(ICL[(size_t)rr * 1024 + c]);
                  const float kkv = kk[q] * a.in[12][c]; av[q] = kkv; ss += kkv * kkv; kv[q] = kk[q] * (1.0f + (ic[q] - 1.0f) * a.in[13][c]); bon += rv[q] * kv[q] * a.in[14][c]; }
              ss += __shfl_xor(ss, 1); ss += __shfl_xor(ss, 2); ss += __shfl_xor(ss, 4); bon += __shfl_xor(bon, 1); bon += __shfl_xor(bon, 2); bon += __shfl_xor(bon, 4);
              const float inv = 1.0f / fmaxf(sqrtf(ss), 1e-12f);
#pragma unroll
              for (int q = 0; q < 8; ++q) { const float kkn = av[q] * inv; av[q] = -kkn; bv[q] = kkn * ic[q]; }
              if (cg == 0) BON[(size_t)rr * 16 + hd] = bon;
              *(v4u*)(VV + (size_t)rr * 1024 + c0) = (v4u){pk2(vv[0], vv[1]), pk2(vv[2], vv[3]), pk2(vv[4], vv[5]), pk2(vv[6], vv[7])}; }
          const int o = tok * 64 + cg * 8;
          *(LAS f32x4*)(wS + o) = (f32x4){wv[0], wv[1], wv[2], wv[3]}; *(LAS f32x4*)(wS + o + 4) = (f32x4){wv[4], wv[5], wv[6], wv[7]};
          *(LAS f32x4*)(aS + o) = (f32x4){av[0], av[1], av[2], av[3]}; *(LAS f32x4*)(aS + o + 4) = (f32x4){av[4], av[5], av[6], av[7]};
          *(LAS f32x4*)(bS + o) = (f32x4){bv[0], bv[1], bv[2], bv[3]}; *(LAS f32x4*)(bS + o + 4) = (f32x4){bv[4], bv[5], bv[6], bv[7]};
          *(LAS f32x4*)(rS + o) = (f32x4){rv[0], rv[1], rv[2], rv[3]}; *(LAS f32x4*)(rS + o + 4) = (f32x4){rv[4], rv[5], rv[6], rv[7]};
          *(LAS f32x4*)(kS + o) = (f32x4){kv[0], kv[1], kv[2], kv[3]}; *(LAS f32x4*)(kS + o + 4) = (f32x4){kv[4], kv[5], kv[6], kv[7]};
#pragma unroll
          for (int q = 0; q < 8; ++q) *(LAS bf16*)(vT + (cg * 8 + q) * 144 + tok * 2) = (bf16)f2bf(vv[q]); }
        __syncthreads();
        { const int p = wave >> 2, sub = (wave >> 1) & 1, half = wave & 1, sl = lane >> 2, q = lane & 3, s = 16 * half + sl, tok = 32 * sub + s, jq = 16 * q;
          const LAS float* x0p = (p == 0 ? kS : bS) + tok * 64 + jq; LAS unsigned char* OUT = p == 0 ? AT : NT;
          float x[16];
#pragma unroll
          for (int j = 0; j < 16; j += 4) { const f32x4 t4 = *(const LAS f32x4*)(x0p + j); x[j] = t4.x; x[j + 1] = t4.y; x[j + 2] = t4.z; x[j + 3] = t4.w; }
          if (half) {
#pragma unroll
              for (int i = 0; i < 4; ++i) *(LAS bf16*)(OUT + ((sub * 32 + 4 * q + i) * 40 + s) * 2) = (bf16)0; }
#pragma unroll 2
          for (int tp = 16 * half; tp < 32; ++tp) { const LAS float* bp = wS + (32 * sub + tp) * 64 + jq; const bool run = tp > s;
              f32x4 a4[4], w4[4], b4[4], r4[4];
#pragma unroll
              for (int g = 0; g < 4; ++g) { a4[g] = *(const LAS f32x4*)(bp + 4096 + 4 * g); w4[g] = *(const LAS f32x4*)(bp + 4 * g); b4[g] = *(const LAS f32x4*)(bp + 8192 + 4 * g); r4[g] = *(const LAS f32x4*)(bp + 12288 + 4 * g); }
              float c = 0.f;
#pragma unroll
              for (int g = 0; g < 4; ++g) { c += x[4 * g] * a4[g].x; c += x[4 * g + 1] * a4[g].y; c += x[4 * g + 2] * a4[g].z; c += x[4 * g + 3] * a4[g].w; }
              c += __builtin_bit_cast(float, __builtin_amdgcn_mov_dpp(__builtin_bit_cast(int, c), 0xB1, 0xF, 0xF, true));
              c += __builtin_bit_cast(float, __builtin_amdgcn_mov_dpp(__builtin_bit_cast(int, c), 0x4E, 0xF, 0xF, true));
              float o = 0.f;
#pragma unroll
              for (int g = 0; g < 4; ++g) { const float n0 = x[4 * g] * w4[g].x + c * b4[g].x, n1 = x[4 * g + 1] * w4[g].y + c * b4[g].y, n2 = x[4 * g + 2] * w4[g].z + c * b4[g].z, n3 = x[4 * g + 3] * w4[g].w + c * b4[g].w;
                  x[4 * g] = run ? n0 : x[4 * g]; x[4 * g + 1] = run ? n1 : x[4 * g + 1]; x[4 * g + 2] = run ? n2 : x[4 * g + 2]; x[4 * g + 3] = run ? n3 : x[4 * g + 3];
                  o += x[4 * g] * r4[g].x; o += x[4 * g + 1] * r4[g].y; o += x[4 * g + 2] * r4[g].z; o += x[4 * g + 3] * r4[g].w; }
              o += __builtin_bit_cast(float, __builtin_amdgcn_mov_dpp(__builtin_bit_cast(int, o), 0xB1, 0xF, 0xF, true));
              o += __builtin_bit_cast(float, __builtin_amdgcn_mov_dpp(__builtin_bit_cast(int, o), 0x4E, 0xF, 0xF, true));
              if (q == 0) *(LAS bf16*)(OUT + ((sub * 32 + tp) * 40 + s) * 2) = (bf16)f2bf(tp >= s ? o : 0.f); }
          LAS unsigned char* XT = p == 0 ? kT : bT;
#pragma unroll
          for (int j = 0; j < 16; ++j) *(LAS bf16*)(XT + (jq + j) * 144 + tok * 2) = (bf16)f2bf(x[j]);
          const bool gwave = (p == 0 && half == 1); const int j = lane;
          if (gwave) { float g = 1.f;
#pragma unroll
              for (int tp = 0; tp < 32; ++tp) { const int tk = 32 * sub + tp; const float w_ = wS[tk * 64 + j], a_ = aS[tk * 64 + j], r_ = rS[tk * 64 + j];
                  *(LAS bf16*)(aT + j * 144 + tk * 2) = (bf16)f2bf(a_ * g);
                  g *= w_; *(LAS bf16*)(rT + j * 144 + tk * 2) = (bf16)f2bf(r_ * g); }
              gam[sub * 64 + j] = g; }
        }
        __syncthreads();
        { const int sub = wave >> 2, t1 = (wave >> 1) & 1, t0 = wave & 1; const size_t sch = (size_t)hd * RW_NSC + (2 * n + sub);
          { f32x16 acc;
#pragma unroll
            for (int r = 0; r < 16; ++r) acc[r] = 0.f;
#pragma unroll
            for (int ks = 0; ks < 2; ++ks) { const int ao = (32 * t1 + l31) * 144 + (32 * sub + 16 * ks + 8 * h) * 2, bo = (32 * t0 + l31) * 144 + (32 * sub + 16 * ks + 8 * h) * 2;
                acc = MFMA32(*(const LAS bf16x8*)(aT + ao), *(const LAS bf16x8*)(bT + bo), acc); }
            const int jp = 32 * t0 + l31;
#pragma unroll
            for (int g = 0; g < 4; ++g) *(v2u*)(RH + (sch * 64 + jp) * 64 + 32 * t1 + 8 * g + 4 * h) = (v2u){pk2(acc[4 * g], acc[4 * g + 1]), pk2(acc[4 * g + 2], acc[4 * g + 3])};
            if (t1 == 0 && t0 == 0) GAM[sch * 64 + lane] = gam[sub * 64 + lane]; }
          { f32x16 acc;
#pragma unroll
            for (int r = 0; r < 16; ++r) acc[r] = 0.f;
#pragma unroll
            for (int ks = 0; ks < 2; ++ks) acc = MFMA32(*(const LAS bf16x8*)(kT + (32 * t1 + l31) * 144 + (32 * sub + 16 * ks + 8 * h) * 2), *(const LAS bf16x8*)(vT + (32 * t0 + l31) * 144 + (32 * sub + 16 * ks + 8 * h) * 2), acc);
            bf16* dst = GT + ((sch * 4 + t1 * 2 + t0) * 64 + lane) * 16;
            *(v4u*)dst = (v4u){pk2(acc[0], acc[1]), pk2(acc[2], acc[3]), pk2(acc[4], acc[5]), pk2(acc[6], acc[7])}; *(v4u*)(dst + 8) = (v4u){pk2(acc[8], acc[9]), pk2(acc[10], acc[11]), pk2(acc[12], acc[13]), pk2(acc[14], acc[15])}; } }
        if (wave < 4) { const int sub = wave >> 1, jt = wave & 1; const size_t sch = (size_t)hd * RW_NSC + (2 * n + sub);
            f32x16 acc;
#pragma unroll
            for (int r = 0; r < 16; ++r) acc[r] = bf2f(*(const LAS bf16*)(rT + (32 * jt + crow(r, h)) * 144 + (32 * sub + l31) * 2));
#pragma unroll
            for (int ks = 0; ks < 2; ++ks) acc = MFMA32(*(const LAS bf16x8*)(aT + (32 * jt + l31) * 144 + (32 * sub + 16 * ks + 8 * h) * 2), *(const LAS bf16x8*)(NT + (sub * 32 + l31) * 80 + (16 * ks + 8 * h) * 2), acc);
#pragma unroll
            for (int g = 0; g < 4; ++g) *(v2u*)(PR + (sch * 32 + l31) * 64 + 32 * jt + 8 * g + 4 * h) = (v2u){pk2(acc[4 * g], acc[4 * g + 1]), pk2(acc[4 * g + 2], acc[4 * g + 3])};
        } else { const int t2 = tid - 256, sub = t2 >> 7, t = (t2 >> 2) & 31, s8 = (t2 & 3) * 8; const size_t sch = (size_t)hd * RW_NSC + (2 * n + sub);
            *(v4u*)(ATG + (sch * 32 + t) * 32 + s8) = *(const LAS v4u*)(AT + (sub * 32 + t) * 80 + s8 * 2); }
        { const int sub = tid >> 8, it = (tid >> 7) & 1, ks = (tid >> 6) & 1; const size_t sch = (size_t)hd * RW_NSC + (2 * n + sub);
          *(v4u*)(VTF + ((sch * 4 + it * 2 + ks) * 64 + lane) * 8) = *(const LAS v4u*)(vT + (32 * it + l31) * 144 + (32 * sub + 16 * ks + 8 * h) * 2); }
        __syncthreads();
    }
}

DI void ph_rwkv_chain(const Frame& F, const Args& a, int sc_lo, int sc_hi) {
    if (F.vcu >= 16 && F.vcu < 18) { if (sc_hi < RW_NSC) return; const int c = (F.vcu - 16) * 512 + F.tid; const float* HL = (const float*)(a.ws + LR_H); const float* AP = (const float*)(a.ws + LR_A); float* CR = (float*)(a.ws + LR_C);
        float carry = 0.f;
#pragma unroll 8
        for (int sc = 0; sc < RW_NSC; ++sc) { const float hl = HL[sc * 1024 + c], ap = AP[sc * 1024 + c]; CR[sc * 1024 + c] = carry; carry = ap * carry + hl; }
        return; }
    if (F.vcu >= 16) return;
    const int hd = F.vcu; const bf16* RH = (const bf16*)(a.ws + RW_RH); const bf16* RL = (const bf16*)(a.ws + RW_RL); const bf16* GT = (const bf16*)(a.ws + RW_GT); const float* GAM = (const float*)(a.ws + RW_GAM); bf16* SALL = (bf16*)(a.ws + RW_SALL);
    constexpr int RW_NS = 7, SLOT = 8192 + 8192 + 1024;
    LAS unsigned char* XS = F.lds + RING_OFF; LAS unsigned char* RG = XS + 2 * 9216;
    const int lane = F.lane, wave = F.wave, l31 = lane & 31, h = lane >> 5, jt = (wave >> 1) & 1, it = wave & 1, lw = wave & 3;
    for (int i = F.tid; i < 2 * 9216 / 4; i += NWAVES * 64) ((LAS unsigned*)XS)[i] = 0u;
    __syncthreads();
#define RW_BAR() do { asm volatile("s_waitcnt lgkmcnt(0)" ::: "memory"); __builtin_amdgcn_s_barrier(); asm volatile("" ::: "memory"); } while (0)
    const unsigned rg0 = (unsigned)(uintptr_t)RG;
    int offR[2], offG[2];
#pragma unroll
    for (int i = 0; i < 2; ++i) { const int b = 2 * lw + i, row = 8 * b + (lane >> 3), pc = lane & 7; offR[i] = row * 64 + ((pc ^ (row & 7)) * 8); offG[i] = (b * 64 + lane) * 8; }
    const int offM = (lane & 15) * 4;
#define RW_DMA(src, dst) do { unsigned keep_; asm volatile("s_mov_b32 %0, m0\n\ts_mov_b32 m0, %2\n\ts_nop 0\n\tglobal_load_lds_dwordx4 %1, off\n\ts_mov_b32 m0, %0" : "=&s"(keep_) : "v"(src), "s"(dst) : "memory"); } while (0)
#define RW_ISSUE(scn) do { const int s_ = (scn) < RW_NSC ? (scn) : RW_NSC - 1; const size_t sch_ = (size_t)hd * RW_NSC + s_; \
        const unsigned sb_ = (unsigned)__builtin_amdgcn_readfirstlane((int)(rg0 + (unsigned)((scn) % RW_NS) * SLOT)); \
        _Pragma("unroll") for (int i_ = 0; i_ < 2; ++i_) { const unsigned bo_ = (unsigned)__builtin_amdgcn_readfirstlane((2 * lw + i_) * 1024); \
            RW_DMA(RH + sch_ * 4096 + offR[i_], sb_ + bo_); RW_DMA(GT + sch_ * 4096 + offG[i_], sb_ + 8192 + bo_); } \
        RW_DMA(GAM + sch_ * 64 + offM, sb_ + 16384); } while (0)
#define RW_WAITV(n) asm volatile("s_waitcnt vmcnt(" #n ")" ::: "memory")
    f32x16 X;
#pragma unroll
    for (int r = 0; r < 16; ++r) X[r] = 0.f;
    float* XSV = (float*)(a.ws + RW_XSAVE) + ((size_t)(hd * 4 + (wave & 3)) * 64 + lane) * 16;
    if (wave < 4 && sc_lo > 0) {
#pragma unroll
        for (int g = 0; g < 4; ++g) { const f32x4 v = *(const f32x4*)(XSV + 4 * g); X[4 * g] = v.x; X[4 * g + 1] = v.y; X[4 * g + 2] = v.z; X[4 * g + 3] = v.w;
            *(LAS v2u*)(XS + (32 * it + l31) * 144 + (32 * jt + 8 * g + 4 * h) * 2) = (v2u){pk2(v.x, v.y), pk2(v.z, v.w)}; } }
    if (wave >= 4) { RW_ISSUE(sc_lo); RW_ISSUE(sc_lo + 1); RW_ISSUE(sc_lo + 2); RW_ISSUE(sc_lo + 3); RW_ISSUE(sc_lo + 4); RW_ISSUE(sc_lo + 5); RW_WAITV(25); }
    RW_BAR();
    for (int sc = sc_lo; sc < sc_hi; ++sc) {
        if (wave < 4) {
            const LAS unsigned char* sb = RG + (sc % RW_NS) * SLOT;
            f32x16 acc; const size_t sch = (size_t)hd * RW_NSC + sc;
            { const v4u g0 = *(const LAS v4u*)(sb + 8192 + ((jt * 2 + it) * 64 + lane) * 32), g1 = *(const LAS v4u*)(sb + 8192 + ((jt * 2 + it) * 64 + lane) * 32 + 16);
              const unsigned gw_[8] = {g0.x, g0.y, g0.z, g0.w, g1.x, g1.y, g1.z, g1.w};
#pragma unroll
              for (int g = 0; g < 4; ++g) { const f32x4 m = *(const LAS f32x4*)(sb + 16384 + (32 * jt + 8 * g + 4 * h) * 4);
                  acc[4 * g] = bflo(gw_[2 * g]) + m.x * X[4 * g]; acc[4 * g + 1] = bfhi(gw_[2 * g]) + m.y * X[4 * g + 1]; acc[4 * g + 2] = bflo(gw_[2 * g + 1]) + m.z * X[4 * g + 2]; acc[4 * g + 3] = bfhi(gw_[2 * g + 1]) + m.w * X[4 * g + 3]; } }
#pragma unroll
            for (int g = 0; g < 4; ++g) *(v2u*)(SALL + (sch * 64 + 32 * it + l31) * 64 + 32 * jt + 8 * g + 4 * h) = (v2u){pk2(X[4 * g], X[4 * g + 1]), pk2(X[4 * g + 2], X[4 * g + 3])};
            const LAS unsigned char* xb = XS + (sc & 1) * 9216 + (32 * it + l31) * 144 + 16 * h; const int ar = 32 * jt + l31; const LAS unsigned char* ab = sb + ar * 128;
#pragma unroll
            for (int ks = 0; ks < 4; ++ks) { const bf16x8 xf = *(const LAS bf16x8*)(xb + 32 * ks); const int po = (((2 * ks + h) ^ (ar & 7)) * 16);
                acc = MFMA32(*(const LAS bf16x8*)(ab + po), xf, acc); }
            X = acc;
            LAS unsigned char* xn = XS + ((sc + 1) & 1) * 9216 + (32 * it + l31) * 144;
#pragma unroll
            for (int g = 0; g < 4; ++g) *(LAS v2u*)(xn + (32 * jt + 8 * g + 4 * h) * 2) = (v2u){pk2(X[4 * g], X[4 * g + 1]), pk2(X[4 * g + 2], X[4 * g + 3])};
        } else {
            RW_ISSUE(sc + RW_NS - 1);
            RW_WAITV(25);
        }
        RW_BAR();
    }
    if (wave >= 4) RW_WAITV(0);
    else if (sc_hi < RW_NSC) {
#pragma unroll
        for (int g = 0; g < 4; ++g) *(f32x4*)(XSV + 4 * g) = (f32x4){X[4 * g], X[4 * g + 1], X[4 * g + 2], X[4 * g + 3]}; }
#undef RW_ISSUE
#undef RW_DMA
#undef RW_WAITV
#undef RW_BAR
}

DI f32x4 ld_bf4(const bf16* p) { const v2u w = *(const v2u*)p; return (f32x4){bflo(w.x), bfhi(w.x), bflo(w.y), bfhi(w.y)}; }
DI void ph_rwkv_out(const Frame& F, const Args& a) {
    const bf16* SALL = (const bf16*)(a.ws + RW_SALL); const bf16* PR = (const bf16*)(a.ws + RW_PR); const bf16* ATG = (const bf16*)(a.ws + RW_AT); const bf16* VTF = (const bf16*)(a.ws + RW_VTF);
    const bf16* VV = (const bf16*)(a.ws + RW_VV); const float* BON = (const float*)(a.ws + RW_BON); const bf16* GATE = (const bf16*)(a.ws + WS_SCR + SC_GATE); bf16* Y = (bf16*)(a.ws + WS_YMIX);
    const int lane = F.lane, l31 = lane & 31, h = lane >> 5;
    for (int item = F.gw; item < RW_NSC * 16; item += F.NGW) { const int sc = item >> 4, hd = item & 15; if (sc == 1) continue;
        const size_t sch = (size_t)hd * RW_NSC + sc; f32x16 acc[2];
#pragma unroll
        for (int it = 0; it < 2; ++it) {
#pragma unroll
            for (int r = 0; r < 16; ++r) acc[it][r] = 0.f;
#pragma unroll
            for (int ks = 0; ks < 4; ++ks) acc[it] = MFMA32(*(const bf16x8*)(SALL + (sch * 64 + 32 * it + l31) * 64 + 16 * ks + 8 * h), *(const bf16x8*)(PR + (sch * 32 + l31) * 64 + 16 * ks + 8 * h), acc[it]);
#pragma unroll
            for (int ks = 0; ks < 2; ++ks) acc[it] = MFMA32(*(const bf16x8*)(VTF + ((sch * 4 + it * 2 + ks) * 64 + lane) * 8), *(const bf16x8*)(ATG + (sch * 32 + l31) * 32 + 16 * ks + 8 * h), acc[it]); }
        float s1 = 0.f;
#pragma unroll
        for (int it = 0; it < 2; ++it)
#pragma unroll
            for (int r = 0; r < 16; ++r) s1 += acc[it][r];
        s1 += __shfl_xor(s1, 32); const float mean = s1 * (1.0f / 64.0f); float s2 = 0.f;
#pragma unroll
        for (int it = 0; it < 2; ++it)
#pragma unroll
            for (int r = 0; r < 16; ++r) { const float d = acc[it][r] - mean; s2 += d * d; }
        s2 += __shfl_xor(s2, 32); const float rstd = 1.0f / sqrtf(s2 * (1.0f / 64.0f) + 64e-5f);
        const int rr = sub_row(sc, l31);
        if (rr >= 0) { const float bon = BON[(size_t)rr * 16 + hd];
#pragma unroll
            for (int it = 0; it < 2; ++it)
#pragma unroll
                for (int g = 0; g < 4; ++g) { const int c = hd * 64 + 32 * it + 8 * g + 4 * h;
                    const f32x4 lw = *(const f32x4*)(a.in[15] + c), lb = *(const f32x4*)(a.in[16] + c), gt = ld_bf4(GATE + (size_t)rr * 1024 + c); const v2u vw = *(const v2u*)(VV + (size_t)rr * 1024 + c);
                    const float o0 = ((acc[it][4 * g] - mean) * rstd * lw.x + lb.x + bon * bflo(vw.x)) * gt.x, o1 = ((acc[it][4 * g + 1] - mean) * rstd * lw.y + lb.y + bon * bfhi(vw.x)) * gt.y;
                    const float o2 = ((acc[it][4 * g + 2] - mean) * rstd * lw.z + lb.z + bon * bflo(vw.y)) * gt.z, o3 = ((acc[it][4 * g + 3] - mean) * rstd * lw.w + lb.w + bon * bfhi(vw.y)) * gt.w;
                    *(v2u*)(Y + (size_t)rr * DM + c) = (v2u){pk2(o0, o1), pk2(o2, o3)}; } }
    }
    lru_apply(F, a);
}

constexpr int N_PHASES = 33;
template <class Epi, class Sched> DI void run_gemm(const Frame& F, const pg8::Gemm& g, const Sched& S, const Epi& E) {
    pg8::gemm_phase<Epi, Sched, true, true>(F.lds + RING_OFF, g, S, E);
}
DI void moe_up_units(const Frame& F, const Args& a, int t0, int ntl, int G, int c) {
    pg8::Gemm g{(const bf16*)(a.ws + WS_SCR + SC_XG), (const bf16*)(a.ws + WS_MOEW), DM, DM, DM};
    pg8::MoeOrder S{(const int*)(a.ws + WS_TILES), t0, ntl, 4, G, c, (long)MOE_E_BYTES};
    pg8::EpiSwiglu E{(bf16*)(a.ws + WS_SCR + SC_ACT), FF};
    run_gemm(F, g, S, E);
}
DI void moe_down_units(const Frame& F, const Args& a, int t0, int ntl, int G, int c) {
    pg8::Gemm g{(const bf16*)(a.ws + WS_SCR + SC_ACT), (const bf16*)(a.ws + WS_MOEW + MOE_W2_OFF), FF, FF, FF};
    pg8::MoeOrder S{(const int*)(a.ws + WS_TILES), t0, ntl, 8, G, c, (long)MOE_E_BYTES};
    pg8::EpiBf16 E{(bf16*)(a.ws + WS_SCR + SC_YB), DM};
    run_gemm(F, g, S, E);
}
DI void ph_moe_a(const Frame& F, const Args& a) {
    const int nt = (int)__hip_atomic_load((gu32*)(a.ws + WS_TILES) + 127, RLX_AGENT), n1 = nt < 64 ? nt : 64;
    moe_up_units(F, a, 0, n1, F.G, (int)blockIdx.x);
}
DI void ph_moe_b(const Frame& F, const Args& a) {
    const int nt = (int)__hip_atomic_load((gu32*)(a.ws + WS_TILES) + 127, RLX_AGENT), n1 = nt < 64 ? nt : 64; const int c = (int)blockIdx.x;
    int nu = 4 * (nt - n1); if (nu > F.G / 2) nu = F.G / 2;
    if (c < nu) moe_up_units(F, a, n1, nt - n1, nu, c); else moe_down_units(F, a, 0, n1, F.G - nu, c - nu);
}
DI void ph_moe_c(const Frame& F, const Args& a) {
    const int nt = (int)__hip_atomic_load((gu32*)(a.ws + WS_TILES) + 127, RLX_AGENT), n1 = nt < 64 ? nt : 64;
    moe_down_units(F, a, n1, nt - n1, F.G, (int)blockIdx.x);
}

DI void gemm_tail16(const Frame& F, const Args& a, const bf16* A, int lda, const bf16* Wt, int K, int mode) {
    if (F.vcu >= 128) return;
    const int lane = F.lane, lc = lane & 15, quad = lane >> 4, w = F.vcu; LAS float* red = (LAS float*)(F.lds + RING_OFF);
    f32x4 acc = (f32x4){0.f, 0.f, 0.f, 0.f}; const int kw = K / NWAVES, kb = F.wave * kw;
    const bf16* ap = A + (size_t)(TX + lc) * lda + kb + 8 * quad; const bf16* bp = Wt + (size_t)(16 * w + lc) * K + kb + 8 * quad;
#pragma unroll 4
    for (int ks = 0; ks < kw / 32; ++ks) acc = __builtin_amdgcn_mfma_f32_16x16x32_bf16(*(const bf16x8*)(ap + 32 * ks), *(const bf16x8*)(bp + 32 * ks), acc, 0, 0, 0);
    *(LAS f32x4*)(red + (F.wave * 64 + lane) * 4) = acc;
    __syncthreads();
    if (F.wave == 0) { f32x4 s = *(const LAS f32x4*)(red + lane * 4);
#pragma unroll
        for (int v = 1; v < NWAVES; ++v) s = s + *(const LAS f32x4*)(red + (v * 64 + lane) * 4);
        float* H = (float*)(a.ws + WS_H);
#pragma unroll
        for (int r = 0; r < 4; ++r) { const int row = 4 * quad + r, col = 16 * w + lc; const float base = mode ? H[(size_t)(TX + row) * DM + col] : a.in[1][(size_t)row * DM + col];
            H[(size_t)(TX + row) * DM + col] = base + s[r]; } }
    __syncthreads();
}

__global__ void __launch_bounds__(NWAVES * 64, 2) hyb_fwd(Args a) {
    extern __shared__ __attribute__((aligned(16))) unsigned char lds[];
    Frame F;
    F.lds = (LAS unsigned char*)lds;
    F.MISC = (volatile LAS unsigned*)(F.lds + MISC_OFF);
    F.tid = threadIdx.x; F.lane = F.tid & 63; F.wave = __builtin_amdgcn_readfirstlane(F.tid >> 6);
    F.G = gridDim.x; { const int bx = blockIdx.x; F.vcu = (F.G % 8 == 0) ? (bx % 8) * (F.G / 8) + bx / 8 : bx; }
    F.gw = F.vcu * NWAVES + F.wave; F.NGW = F.G * NWAVES;
    F.ctl = (gu32*)(a.ws + WS_CTL);
    for (int u = F.tid; u < (LDS_BYTES - LDSCTL_OFF) / 4; u += NWAVES * 64) ((LAS unsigned*)(F.lds + LDSCTL_OFF))[u] = 0u;
    __syncthreads();
    XcdBarrier bar; bar.bar = (unsigned*)(F.ctl + CW_BAR); bar.x = 0; bar.st = nullptr;
    if (MK_ONE_LAUNCH) bar = xcd_barrier_post((unsigned*)(F.ctl + CW_BAR), F.MISC + 8);
    const int lo = a.ph_lo, hi = a.ph_hi;
#ifndef PH_MASK
#define PH_MASK 0xFFFFFFFFFFFFFFFFull
#endif
#define IN(k) ((((unsigned long long)(PH_MASK) >> (k)) & 1ull) && lo <= (k) && (k) < hi)
#ifndef PROBE_REP
#define PROBE_REP 0u
#endif
#define REP(k) ((((unsigned long long)(PROBE_REP) >> (k)) & 1ull) ? 2 : 1)
#ifdef PROBE_TS
#define STAMP(k) do { if (blockIdx.x == 0 && F.tid == 0) ((unsigned long long*)(F.ctl + CW_TS))[(k)] = __builtin_amdgcn_s_memrealtime(); } while (0)
#else
#define STAMP(k) do { } while (0)
#endif
#define PHASE(k, ...) do { if (IN(k)) { { const int PH_REP_ = 0; (void)PH_REP_; __VA_ARGS__; } if (REP(k) == 2) { __syncthreads(); { const int PH_REP_ = 1; (void)PH_REP_; __VA_ARGS__; } } } } while (0)
#define SEAM(k) do { if (IN(k) && IN((k) + 1)) xcd_barrier(bar); STAMP((k) + 1); } while (0)
    const bf16* HN = (const bf16*)(a.ws + WS_HN); bf16* PROJ = (bf16*)(a.ws + WS_PROJ); const bf16* YMIX = (const bf16*)(a.ws + WS_YMIX); float* H = (float*)(a.ws + WS_H);

    STAMP(0);
    PHASE(0, { ph_prologue(F, a); ph_aux_convert(F, a, F.gw, F.NGW); });
    SEAM(0);
    PHASE(1, { pg8::Gemm g{HN, (const bf16*)(a.ws + WS_WEVIN), DM, DM, DM}; pg8::StaticOrder S; S.init(MP, EV_NP, F.G, (int)blockIdx.x); pg8::EpiBf16 E{PROJ, EV_NP}; run_gemm(F, g, S, E); });
    SEAM(1);
    PHASE(2, ph_even_prep(F, a););
    SEAM(2);
    PHASE(3, {
        { pg8::Gemm g{(const bf16*)(a.ws + WS_SCR + SC_ALORA), (const bf16*)(a.ws + WS_WLORA), 384, 384, 384}; pg8::StaticOrder S; S.init(MP, 3072, F.G, (int)blockIdx.x);
          static_assert(SC_ICL - SC_DEC == SC_GATE - SC_ICL, "lora outputs equally spaced");
          pg8::EpiLora E{(bf16*)(a.ws + WS_SCR + SC_DEC), (long)((SC_ICL - SC_DEC) / 2), a.in[7], a.in[9]}; run_gemm(F, g, S, E); }
        { pg8::Gemm g{(const bf16*)(a.ws + WS_SCR + SC_XR), (const bf16*)(a.ws + WS_WGATE), 256, 1024, 256}; pg8::StaticOrder S; S.init(MP, 2048, F.G, (int)blockIdx.x); S.amod = 4; S.astep = 512;
          pg8::EpiGates E{(bf16*)(a.ws + WS_SCR + SC_LA), (bf16*)(a.ws + WS_SCR + SC_LIX), a.in[20], a.in[22], a.in[23], (const bf16*)(a.ws + WS_SCR + SC_XR)}; run_gemm(F, g, S, E); }
    });
    SEAM(3);
    PHASE(4, { lru_local(F, a); ph_rwkv_chunk(F, a, 0, 32, 0); });
    SEAM(4);
    PHASE(5, { if (F.vcu < 16) ph_rwkv_chain(F, a, 0, 64); else ph_rwkv_chunk(F, a, 32, 62, 16); });
    SEAM(5);
    PHASE(6, { if (F.vcu < 16) ph_rwkv_chain(F, a, 64, 124); else ph_rwkv_chunk(F, a, 62, 92, 16); });
    SEAM(6);
    PHASE(7, { if (F.vcu < 16) ph_rwkv_chain(F, a, 124, 184); else ph_rwkv_chunk(F, a, 92, 122, 16); });
    SEAM(7);
    PHASE(8, { if (F.vcu < 16) ph_rwkv_chain(F, a, 184, 244); else ph_rwkv_chunk(F, a, 122, 129, 16); });
    SEAM(8);
    PHASE(9, { if (F.vcu < 18) ph_rwkv_chain(F, a, 244, RW_NSC); });
    SEAM(9);
    PHASE(10, ph_rwkv_out(F, a););
    SEAM(10);
    PHASE(11, { pg8::Gemm g{YMIX, (const bf16*)(a.ws + WS_WEVOUT), DM, DM, DM}; pg8::StaticOrder S; S.init(TX, DM, F.G, (int)blockIdx.x); pg8::EpiResid E{H, a.in[0], a.in[1], 0}; run_gemm(F, g, S, E); gemm_tail16(F, a, YMIX, DM, (const bf16*)(a.ws + WS_WEVOUT), DM, 0); });
    SEAM(11);
    PHASE(12, ph_route(F, a, 0, PH_REP_););
    SEAM(12);
    PHASE(13, ph_gather(F, a, 0););
    SEAM(13);
    PHASE(14, ph_moe_a(F, a););
    SEAM(14);
    PHASE(15, ph_moe_b(F, a););
    SEAM(15);
    PHASE(16, ph_moe_c(F, a););
    SEAM(16);
    PHASE(17, ph_combine(F, a, 0););
    SEAM(17);
    PHASE(18, { pg8::Gemm g{HN, (const bf16*)(a.ws + WS_WODIN), DM, DM, DM}; pg8::StaticOrder S; S.init(MP, OD_NP, F.G, (int)blockIdx.x); pg8::EpiBf16 E{PROJ, OD_NP}; run_gemm(F, g, S, E); });
    SEAM(18);
    PHASE(19, ph_odd_prep(F, a););
    SEAM(19);
    PHASE(20, ph_gdn_chunk(F, a, 0, 33, 0););
    SEAM(20);
    PHASE(21, { ph_gdn_chain(F, a, 0, 33); ph_gdn_chunk(F, a, 33, 65, 1); });
    SEAM(21);
    PHASE(22, { ph_gdn_chain(F, a, 33, 65); ph_gdn_chunk(F, a, 65, 97, 1); });
    SEAM(22);
    PHASE(23, { ph_gdn_chain(F, a, 65, 97); ph_gdn_chunk(F, a, 97, 129, 1); });
    SEAM(23);
    PHASE(24, ph_gdn_chain(F, a, 97, 129););
    SEAM(24);
    PHASE(25, { ph_odd_post(F, a); moe_convert(F, a, 1, F.gw, F.NGW); });
    SEAM(25);
    PHASE(26, { pg8::Gemm g{YMIX, (const bf16*)(a.ws + WS_WODOUT), 4096, 4096, 4096}; pg8::StaticOrder S; S.init(TX, DM, F.G, (int)blockIdx.x); pg8::EpiResid E{H, a.in[0], a.in[1], 1}; run_gemm(F, g, S, E); gemm_tail16(F, a, YMIX, 4096, (const bf16*)(a.ws + WS_WODOUT), 4096, 1); });
    SEAM(26);
    PHASE(27, ph_route(F, a, 1, PH_REP_););
    SEAM(27);
    PHASE(28, ph_gather(F, a, 1););
    SEAM(28);
    PHASE(29, ph_moe_a(F, a););
    SEAM(29);
    PHASE(30, ph_moe_b(F, a););
    SEAM(30);
    PHASE(31, ph_moe_c(F, a););
    SEAM(31);
    PHASE(32, ph_combine(F, a, 1););
#ifdef PROBE_BARS
    for (int i_ = 0; i_ < PROBE_BARS; ++i_) xcd_barrier(bar);
#endif
#undef IN
#undef SEAM
}

extern "C" void kernel_launch(void* const* d_in, const int* in_sizes, int n_in, void* d_out, int out_size, void* d_ws, size_t ws_size, hipStream_t stream) {
    static int grid = 0;
    if (grid == 0) {
        if (n_in != 36 || out_size != TX * DM || ws_size < WS_END) { fprintf(stderr, "kernel_launch: unexpected shapes (n_in %d, out %d, ws %zu)\n", n_in, out_size, ws_size); grid = -1; return; }
        int dev = 0, cus = 0, per_cu = 0;
        if (hipGetDevice(&dev) != hipSuccess || hipDeviceGetAttribute(&cus, hipDeviceAttributeMultiprocessorCount, dev) != hipSuccess) { grid = -1; return; }
        if (hipFuncSetAttribute((const void*)hyb_fwd, hipFuncAttributeMaxDynamicSharedMemorySize, LDS_BYTES) != hipSuccess) { fprintf(stderr, "kernel_launch: hipFuncSetAttribute failed\n"); grid = -1; return; }
        if (hipOccupancyMaxActiveBlocksPerMultiprocessor(&per_cu, (const void*)hyb_fwd, NWAVES * 64, LDS_BYTES) != hipSuccess || per_cu < 1) { fprintf(stderr, "kernel_launch: occupancy query says %d\n", per_cu); per_cu = 1; }
        (void)hipGetLastError();
        grid = cus;
    }
    if (grid < 0) return;
    if (hipMemsetAsync((char*)d_ws + WS_CTL, 0, CTL_ZERO_BYTES, stream) != hipSuccess) return;
    Args a{};
    for (int i = 0; i < 36; ++i) a.in[i] = (const float*)d_in[i];
    a.out = (float*)d_out; a.ws = (unsigned char*)d_ws;
#if MK_ONE_LAUNCH
    a.ph_lo = 0; a.ph_hi = N_PHASES;
    hipLaunchKernelGGL(hyb_fwd, dim3(grid), dim3(NWAVES * 64), LDS_BYTES, stream, a);
#else
    for (int p = 0; p < N_PHASES; ++p) { a.ph_lo = p; a.ph_hi = p + 1; hipLaunchKernelGGL(hyb_fwd, dim3(grid), dim3(NWAVES * 64), LDS_BYTES, stream, a); }
#endif
}
```

```cpp
#include <hip/hip_runtime.h>
#include <cstdio>
#include <cstdint>
#include <cmath>

#ifndef MK_ONE_LAUNCH
#define MK_ONE_LAUNCH 1
#endif

namespace pg8 {
#define PG8_LAS __attribute__((address_space(3)))
typedef unsigned short bf16_t;
typedef short bf16x8 __attribute__((ext_vector_type(8)));
typedef float f32x4 __attribute__((ext_vector_type(4)));
typedef unsigned u32x4 __attribute__((ext_vector_type(4)));
typedef unsigned u32x2 __attribute__((ext_vector_type(2)));
constexpr int BM = 256, BK = 64, HALF = 128, HTB = HALF * BK * 2  , STAGE_BYTES = 8 * HTB, NXCD = 8, WGM = 8;

__host__ __device__ __forceinline__ int lds_byte(int r, int c) { const int st = (r >> 4) * 2 + (c >> 5), rr = r & 15, cc = c & 31, ob = rr * 64 + cc * 2; return st * 1024 + (ob ^ (((ob >> 9) & 1) << 5)); }
__host__ __device__ __forceinline__ void stage_rc(int b, int& R, int& C) { const int st = b / 1024, sb = b % 1024, swz = sb ^ (((sb >> 9) & 1) << 5); R = (st >> 1) * 16 + swz / 64; C = (st & 1) * 32 + (swz % 64) / 2; }
__host__ __device__ __forceinline__ int perm32(int rho) { const int n = rho >> 4, i = rho & 15; return 8 * (i >> 2) + 4 * n + (i & 3); }

struct Unit { int pm, pn; long aoff, boff; };
struct Gemm { const bf16_t* A; const bf16_t* Bt; int K, lda, ldb; };

struct StaticOrder {
    int nM, nN, nwg, G, c, amod; long astep;
    __host__ __device__ void init(int M, int N, int G_, int c_) { nM = M / BM; nN = N / BM; nwg = nM * nN; G = G_; c = c_; amod = 0; astep = 0; }
    __host__ __device__ bool next(int i, Unit& u) const {
        const long L = (long)i * G + c; if (L >= nwg) return false;
        int wgid = (int)L; { const int q = nwg / NXCD, r = nwg % NXCD, xcd = wgid % NXCD, off = wgid / NXCD; wgid = (xcd < r ? xcd * (q + 1) : r * (q + 1) + (xcd - r) * q) + off; }
        const int nig = WGM * nN, gid = wgid / nig, fm = gid * WGM, gsz = (nM - fm) < WGM ? (nM - fm) : WGM;
        u.pm = fm + ((wgid % nig) % gsz); u.pn = (wgid % nig) / gsz; u.boff = 0; u.aoff = amod ? (long)(u.pn % amod) * astep : 0; return true;
    }
    __device__ __forceinline__ void a_ready(const Unit&) const {}
    __device__ __forceinline__ void done(const Unit&) const {}
};
struct MoeOrder {
    const int* tile_e; int t0, ntiles, npn, G, c; long bstride;
    __device__ __forceinline__ bool next(int i, Unit& u) const {
        const long L = (long)i * G + c; if (c < 0 || L >= (long)ntiles * npn) return false;
        const int t = t0 + (int)(L / npn); u.pm = t; u.pn = (int)(L % npn); u.aoff = 0; u.boff = (long)tile_e[t] * bstride; return true;
    }
    __device__ __forceinline__ void a_ready(const Unit&) const {}
    __device__ __forceinline__ void done(const Unit&) const {}
};

__device__ __forceinline__ unsigned cvt_pk_bf16(float lo, float hi) { unsigned r; asm volatile("v_cvt_pk_bf16_f32 %0, %1, %2" : "=v"(r) : "v"(lo), "v"(hi)); return r; }
__device__ __forceinline__ float bf_lo(unsigned w) { return __uint_as_float(w << 16); }
__device__ __forceinline__ float bf_hi(unsigned w) { return __uint_as_float(w & 0xffff0000u); }
__device__ __forceinline__ float sigmoidf_(float x) { return __builtin_amdgcn_rcpf(1.0f + __expf(-x)); }
__device__ __forceinline__ float softplusf_(float x) { return fmaxf(x, 0.f) + __logf(1.0f + __expf(-fabsf(x))); }

struct EpiBf16 {
    static constexpr bool PERM = true, AFTER_DRAIN = false;
    bf16_t* O; int ldc;
    __device__ __forceinline__ void operator()(const f32x4 (&acc)[2][2][4][2], const Unit& u, int wr, int wc, int fr, int fq) const {
        const int row0 = u.pm * BM + wr * 64 + fr; const int col0 = u.pn * BM + wc * 32 + 8 * fq;
#pragma unroll
        for (int ai = 0; ai < 2; ++ai)
#pragma unroll
            for (int m = 0; m < 4; ++m) { bf16_t* rowp = O + (size_t)(row0 + ai * HALF + m * 16) * ldc + col0;
#pragma unroll
                for (int bj = 0; bj < 2; ++bj) { const f32x4 v0 = acc[ai][bj][m][0], v1 = acc[ai][bj][m][1];
                    u32x4 w; w.x = cvt_pk_bf16(v0[0], v0[1]); w.y = cvt_pk_bf16(v0[2], v0[3]); w.z = cvt_pk_bf16(v1[0], v1[1]); w.w = cvt_pk_bf16(v1[2], v1[3]);
                    *(u32x4*)(rowp + bj * HALF) = w; } }
    }
};
struct EpiSwiglu {
    static constexpr bool PERM = true, AFTER_DRAIN = false;
    bf16_t* O; int ldc;
    __device__ __forceinline__ void operator()(const f32x4 (&acc)[2][2][4][2], const Unit& u, int wr, int wc, int fr, int fq) const {
        const int row0 = u.pm * BM + wr * 64 + fr; const int col0 = u.pn * HALF + wc * 32 + 8 * fq;
#pragma unroll
        for (int ai = 0; ai < 2; ++ai)
#pragma unroll
            for (int m = 0; m < 4; ++m) { bf16_t* rowp = O + (size_t)(row0 + ai * HALF + m * 16) * ldc + col0;
                float o[8];
#pragma unroll
                for (int n = 0; n < 2; ++n)
#pragma unroll
                    for (int j = 0; j < 4; ++j) { const float gq = acc[ai][0][m][n][j], uq = acc[ai][1][m][n][j]; o[4 * n + j] = gq * sigmoidf_(gq) * uq; }
                u32x4 w; w.x = cvt_pk_bf16(o[0], o[1]); w.y = cvt_pk_bf16(o[2], o[3]); w.z = cvt_pk_bf16(o[4], o[5]); w.w = cvt_pk_bf16(o[6], o[7]);
                *(u32x4*)rowp = w; }
    }
};
struct EpiResid {
    static constexpr bool PERM = false, AFTER_DRAIN = false;
    float* out; const float* x; const float* meta; int mode;
    __device__ __forceinline__ void operator()(const f32x4 (&acc)[2][2][4][2], const Unit& u, int wr, int wc, int fr, int fq) const {
        const int row0 = u.pm * BM + wr * 64 + fr, col0 = u.pn * BM + wc * 32 + 4 * fq;
#pragma unroll
        for (int ai = 0; ai < 2; ++ai)
#pragma unroll
            for (int m = 0; m < 4; ++m) { const int row = row0 + ai * HALF + m * 16; float* rowp = out + (size_t)row * 2048 + col0;
                const float* bp = mode ? rowp : (row < 8192 ? x + (size_t)row * 2048 + col0 : (row < 8208 ? meta + (size_t)(row - 8192) * 2048 + col0 : nullptr));
#pragma unroll
                for (int bj = 0; bj < 2; ++bj)
#pragma unroll
                    for (int n = 0; n < 2; ++n) { f32x4 b = (f32x4){0.f, 0.f, 0.f, 0.f}; if (bp) b = *(const f32x4*)(bp + bj * HALF + n * 16);
                        *(f32x4*)(rowp + bj * HALF + n * 16) = acc[ai][bj][m][n] + b; } }
    }
};
__device__ __forceinline__ float one_minus_exp_neg(float e) { return e < 0.05f ? e * (1.0f - e * (0.5f - e * (1.0f / 6.0f))) : 1.0f - __expf(-e); }
struct EpiLora {
    static constexpr bool PERM = false, AFTER_DRAIN = false;
    bf16_t* base; long gstride; const float* w0; const float* a0;
    __device__ __forceinline__ void operator()(const f32x4 (&acc)[2][2][4][2], const Unit& u, int wr, int wc, int fr, int fq) const {
        const int grp = u.pn >> 2; const int row0 = u.pm * BM + wr * 64 + fr, col0 = (u.pn & 3) * BM + wc * 32 + 4 * fq;
        bf16_t* O = base + (size_t)grp * gstride;
#pragma unroll
        for (int bj = 0; bj < 2; ++bj)
#pragma unroll
            for (int n = 0; n < 2; ++n) { const int c = col0 + bj * HALF + n * 16;
                f32x4 bv = (f32x4){0.f, 0.f, 0.f, 0.f}; if (grp == 0) bv = *(const f32x4*)(w0 + c); else if (grp == 1) bv = *(const f32x4*)(a0 + c);
#pragma unroll
                for (int ai = 0; ai < 2; ++ai)
#pragma unroll
                    for (int m = 0; m < 4; ++m) { f32x4 v = acc[ai][bj][m][n] + bv;
                        if (grp == 0) {
#pragma unroll
                            for (int j = 0; j < 4; ++j) { const float wl = -softplusf_(-v[j]) - 0.5f; v[j] = one_minus_exp_neg(__expf(wl)); }
                        } else if (grp == 1) {
#pragma unroll
                            for (int j = 0; j < 4; ++j) v[j] = sigmoidf_(v[j]);
                        }
                        u32x2 w; w.x = cvt_pk_bf16(v[0], v[1]); w.y = cvt_pk_bf16(v[2], v[3]);
                        *(u32x2*)(O + (size_t)(row0 + ai * HALF + m * 16) * 1024 + c) = w; } }
    }
};
struct EpiGates {
    static constexpr bool PERM = false, AFTER_DRAIN = false;
    bf16_t* lru_a; bf16_t* lru_ix; const float* ba; const float* bx; const float* lam; const bf16_t* xr;
    __device__ __forceinline__ void operator()(const f32x4 (&acc)[2][2][4][2], const Unit& u, int wr, int wc, int fr, int fq) const {
        const int grp = u.pn >> 2; const int row0 = u.pm * BM + wr * 64 + fr, col0 = (u.pn & 3) * BM + wc * 32 + 4 * fq;
#pragma unroll
        for (int bj = 0; bj < 2; ++bj)
#pragma unroll
            for (int n = 0; n < 2; ++n) { const int c = col0 + bj * HALF + n * 16;
                const f32x4 bv = *(const f32x4*)((grp == 0 ? ba : bx) + c); f32x4 sp = (f32x4){0.f, 0.f, 0.f, 0.f};
                if (grp == 0) { const f32x4 l = *(const f32x4*)(lam + c);
#pragma unroll
                    for (int j = 0; j < 4; ++j) sp[j] = 8.0f * softplusf_(-l[j]); }
#pragma unroll
                for (int ai = 0; ai < 2; ++ai)
#pragma unroll
                    for (int m = 0; m < 4; ++m) { const int row = row0 + ai * HALF + m * 16; f32x4 v = acc[ai][bj][m][n] + bv; u32x2 w;
                        if (grp == 0) {
#pragma unroll
                            for (int j = 0; j < 4; ++j) v[j] = one_minus_exp_neg(sigmoidf_(v[j]) * sp[j]);
                            w.x = cvt_pk_bf16(v[0], v[1]); w.y = cvt_pk_bf16(v[2], v[3]); *(u32x2*)(lru_a + (size_t)row * 1024 + c) = w;
                        } else { const u32x2 xw = *(const u32x2*)(xr + (size_t)row * 1024 + c);
                            v[0] = sigmoidf_(v[0]) * bf_lo(xw.x); v[1] = sigmoidf_(v[1]) * bf_hi(xw.x); v[2] = sigmoidf_(v[2]) * bf_lo(xw.y); v[3] = sigmoidf_(v[3]) * bf_hi(xw.y);
                            w.x = cvt_pk_bf16(v[0], v[1]); w.y = cvt_pk_bf16(v[2], v[3]); *(u32x2*)(lru_ix + (size_t)row * 1024 + c) = w; } } }
    }
};

template <class Epi, class Sched, bool ALIGN_EPI = false, bool SP2 = false>
__device__ __forceinline__ void gemm_phase(PG8_LAS unsigned char* lds, const Gemm g, const Sched& S, const Epi& E) {
    const int tid = threadIdx.x, wid = __builtin_amdgcn_readfirstlane(tid >> 6), lane = tid & 63, wr = wid >> 2, wc = wid & 3, fr = lane & 15, fq = lane >> 4;
    const int K = g.K, nt = K / BK;
    unsigned voffA[2], voffB[2];
#pragma unroll
    for (int i = 0; i < 2; ++i) { int R, C; stage_rc(tid * 16 + i * 8192, R, C); const int Rb = Epi::PERM ? ((R & ~31) + perm32(R & 31)) : R;
        voffA[i] = (unsigned)(R * g.lda + C) * 2u; voffB[i] = (unsigned)(Rb * g.ldb + C) * 2u; }
    const size_t kstep = (size_t)(BK * 2);
    const size_t hstepA = (size_t)HALF * g.lda * 2, hstepB = (size_t)HALF * g.ldb * 2;
    const size_t tstepA = 2 * hstepA, tstepB = 2 * hstepB;
    const unsigned ldsw = (unsigned)wid * 1024u;
    const int aoff = lds_byte(wr * 64 + fr, fq * 8), boff = lds_byte(wc * 32 + fr, fq * 8);
#define PG8_SA(b, h) (((b) * 2 + (h)) * HTB)
#define PG8_SB(b, h) ((4 + (b) * 2 + (h)) * HTB)
#define PG8_STAGE(bufoff, gbase, voff) do { _Pragma("unroll") for (int _i = 0; _i < 2; ++_i) \
        __builtin_amdgcn_global_load_lds((const unsigned*)((const char*)(gbase) + (voff)[_i]), (PG8_LAS unsigned*)(lds + (bufoff) + ldsw + _i * 8192), 16, 0, 0); } while (0)
#define PG8_LDA(dst, b, h) do { _Pragma("unroll") for (int m = 0; m < 4; ++m) _Pragma("unroll") for (int k = 0; k < 2; ++k) dst[m][k] = *(const PG8_LAS bf16x8*)(lds + PG8_SA(b, h) + aoff + m * 2048 + k * 1024); } while (0)
#define PG8_LDB(dst, b, h) do { _Pragma("unroll") for (int n = 0; n < 2; ++n) _Pragma("unroll") for (int k = 0; k < 2; ++k) dst[n][k] = *(const PG8_LAS bf16x8*)(lds + PG8_SB(b, h) + boff + n * 2048 + k * 1024); } while (0)
#define PG8_MMA(ai, bj, At, Bt) do { __builtin_amdgcn_s_setprio(1); _Pragma("unroll") for (int m = 0; m < 4; ++m) _Pragma("unroll") for (int n = 0; n < 2; ++n) _Pragma("unroll") for (int k = 0; k < 2; ++k) \
        acc[ai][bj][m][n] = __builtin_amdgcn_mfma_f32_16x16x32_bf16(Bt[n][k], At[m][k], acc[ai][bj][m][n], 0, 0, 0); __builtin_amdgcn_s_setprio(0); } while (0)
#define PG8_WAIT_V(n) asm volatile("s_waitcnt vmcnt(" #n ")" ::: "memory")
#define PG8_WAIT_L(n) asm volatile("s_waitcnt lgkmcnt(" #n ")" ::: "memory")
#define PG8_BAR __builtin_amdgcn_s_barrier()
#define PG8_SCHED __builtin_amdgcn_sched_barrier(0)
    Unit cur, nxt; int ui = 0;
    if (!S.next(0, cur)) return;
    f32x4 acc[2][2][4][2];
#pragma unroll
    for (int a = 0; a < 2; ++a)
#pragma unroll
        for (int b = 0; b < 2; ++b)
#pragma unroll
            for (int m = 0; m < 4; ++m)
#pragma unroll
                for (int n = 0; n < 2; ++n) acc[a][b][m][n] = (f32x4){0.f, 0.f, 0.f, 0.f};
    bf16x8 At[4][2], B0[2][2], B1[2][2];
    const char* cA = (const char*)g.A + (size_t)cur.pm * tstepA + cur.aoff; const char* cB = (const char*)g.Bt + (size_t)cur.pn * tstepB + cur.boff;
    S.a_ready(cur);
    if constexpr (SP2) {
        PG8_STAGE(PG8_SB(0, 0), cB, voffB); PG8_STAGE(PG8_SB(0, 1), cB + hstepB, voffB); PG8_STAGE(PG8_SA(0, 0), cA, voffA); PG8_STAGE(PG8_SA(0, 1), cA + hstepA, voffA);
        if (wr == 1) PG8_BAR;
        PG8_WAIT_V(2); PG8_BAR;
        PG8_STAGE(PG8_SB(1, 0), cB + kstep, voffB); PG8_STAGE(PG8_SA(1, 0), cA + kstep, voffA); PG8_STAGE(PG8_SB(1, 1), cB + hstepB + kstep, voffB);
        PG8_WAIT_V(6); PG8_BAR;
    } else {
        PG8_STAGE(PG8_SB(0, 0), cB, voffB); PG8_STAGE(PG8_SA(0, 0), cA, voffA); PG8_STAGE(PG8_SB(0, 1), cB + hstepB, voffB); PG8_STAGE(PG8_SA(0, 1), cA + hstepA, voffA);
        if (wr == 1) PG8_BAR;
        PG8_WAIT_V(4); PG8_BAR;
        PG8_STAGE(PG8_SB(1, 0), cB + kstep, voffB); PG8_STAGE(PG8_SA(1, 0), cA + kstep, voffA); PG8_STAGE(PG8_SB(1, 1), cB + hstepB + kstep, voffB);
        PG8_WAIT_V(6); PG8_BAR;
    }
    for (;;) {
        const bool has_next = S.next(ui + 1, nxt);
        const char* nA = has_next ? (const char*)g.A + (size_t)nxt.pm * tstepA + nxt.aoff : cA; const char* nB = has_next ? (const char*)g.Bt + (size_t)nxt.pn * tstepB + nxt.boff : cB;
        for (int t = 0; t < nt; t += 2) {
            const bool last = (t == nt - 2);
            const char* a1 = cA + (size_t)(t + 1) * kstep;
            const char* a2 = last ? nA : cA + (size_t)(t + 2) * kstep; const char* b2 = last ? nB : cB + (size_t)(t + 2) * kstep;
            const char* a3 = a2 + kstep; const char* b3 = b2 + kstep;
            if (last && has_next) S.a_ready(nxt);
            if constexpr (SP2) {
            PG8_LDB(B0, 0, 0); PG8_LDB(B1, 0, 1); PG8_SCHED; PG8_LDA(At, 0, 0); PG8_STAGE(PG8_SA(1, 1), a1 + hstepA, voffA);
            PG8_WAIT_V(8); PG8_WAIT_L(0); PG8_BAR; PG8_MMA(0, 0, At, B0); PG8_MMA(0, 1, At, B1); PG8_BAR; PG8_SCHED;
            PG8_LDA(At, 0, 1); PG8_STAGE(PG8_SB(0, 0), b2, voffB); PG8_STAGE(PG8_SB(0, 1), b2 + hstepB, voffB); PG8_STAGE(PG8_SA(0, 0), a2, voffA);
            PG8_WAIT_V(8); PG8_WAIT_L(0); PG8_BAR; PG8_MMA(1, 0, At, B0); PG8_MMA(1, 1, At, B1); PG8_BAR; PG8_SCHED;
            PG8_LDB(B0, 1, 0); PG8_LDB(B1, 1, 1); PG8_SCHED; PG8_LDA(At, 1, 0); PG8_STAGE(PG8_SA(0, 1), a2 + hstepA, voffA);
            PG8_WAIT_V(8); PG8_WAIT_L(0); PG8_BAR; PG8_MMA(0, 0, At, B0); PG8_MMA(0, 1, At, B1); PG8_BAR; PG8_SCHED;
            PG8_LDA(At, 1, 1); PG8_STAGE(PG8_SB(1, 0), b3, voffB); PG8_STAGE(PG8_SB(1, 1), b3 + hstepB, voffB); PG8_STAGE(PG8_SA(1, 0), a3, voffA);
            PG8_WAIT_V(8); PG8_WAIT_L(0); PG8_BAR; PG8_MMA(1, 0, At, B0); PG8_MMA(1, 1, At, B1); PG8_BAR; PG8_SCHED;
            } else {
            PG8_LDB(B0, 0, 0); PG8_SCHED; PG8_LDA(At, 0, 0); PG8_STAGE(PG8_SA(1, 1), a1 + hstepA, voffA);
            PG8_WAIT_L(8); PG8_BAR; PG8_WAIT_L(0); PG8_MMA(0, 0, At, B0); PG8_BAR; PG8_SCHED;
            PG8_LDB(B1, 0, 1); PG8_STAGE(PG8_SB(0, 0), b2, voffB);
            PG8_BAR; PG8_WAIT_L(0); PG8_MMA(0, 1, At, B1); PG8_BAR;
            PG8_LDA(At, 0, 1); PG8_STAGE(PG8_SA(0, 0), a2, voffA);
            PG8_BAR; PG8_WAIT_L(0); PG8_MMA(1, 0, At, B0); PG8_BAR; PG8_SCHED;
            PG8_STAGE(PG8_SB(0, 1), b2 + hstepB, voffB);
            PG8_WAIT_V(6); PG8_BAR; PG8_MMA(1, 1, At, B1); PG8_BAR;
            PG8_LDB(B0, 1, 0); PG8_SCHED; PG8_LDA(At, 1, 0); PG8_STAGE(PG8_SA(0, 1), a2 + hstepA, voffA);
            PG8_WAIT_L(8); PG8_BAR; PG8_WAIT_L(0); PG8_MMA(0, 0, At, B0); PG8_BAR; PG8_SCHED;
            PG8_LDB(B1, 1, 1); PG8_STAGE(PG8_SB(1, 0), b3, voffB);
            PG8_BAR; PG8_WAIT_L(0); PG8_MMA(0, 1, At, B1); PG8_BAR;
            PG8_LDA(At, 1, 1); PG8_STAGE(PG8_SA(1, 0), a3, voffA);
            PG8_BAR; PG8_WAIT_L(0); PG8_MMA(1, 0, At, B0); PG8_BAR; PG8_SCHED;
            PG8_STAGE(PG8_SB(1, 1), b3 + hstepB, voffB);
            PG8_WAIT_V(6); PG8_BAR; PG8_MMA(1, 1, At, B1); PG8_BAR;
            }
        }
        if constexpr (ALIGN_EPI) { if (wr == 0) PG8_BAR; }
        if constexpr (!Epi::AFTER_DRAIN) { E(acc, cur, wr, wc, fr, fq); S.done(cur); }
        if (!has_next) break;
#pragma unroll
        for (int a = 0; a < 2; ++a)
#pragma unroll
            for (int b = 0; b < 2; ++b)
#pragma unroll
                for (int m = 0; m < 4; ++m)
#pragma unroll
                    for (int n = 0; n < 2; ++n) acc[a][b][m][n] = (f32x4){0.f, 0.f, 0.f, 0.f};
        cur = nxt; cA = nA; cB = nB; ++ui;
        if constexpr (ALIGN_EPI) { if (wr == 1) PG8_BAR; }
    }
    PG8_WAIT_V(0);
    if constexpr (!ALIGN_EPI) { if (wr == 0) PG8_BAR; }
    PG8_BAR;
    if constexpr (Epi::AFTER_DRAIN) { E.fused(acc, cur, wr, wc, fr, fq, lds, wid, lane); S.done(cur); }
#undef PG8_SA
#undef PG8_SB
#undef PG8_STAGE
#undef PG8_LDA
#undef PG8_LDB
#undef PG8_MMA
#undef PG8_WAIT_V
#undef PG8_WAIT_L
#undef PG8_BAR
#undef PG8_SCHED
}
}
#define GAS __attribute__((address_space(1)))
#define LAS __attribute__((address_space(3)))
typedef unsigned short bf16;
typedef unsigned v4u __attribute__((ext_vector_type(4)));
typedef float f32x4 __attribute__((ext_vector_type(4)));
typedef short bf16x8 __attribute__((ext_vector_type(8)));
typedef GAS unsigned gu32;
typedef GAS unsigned long long gu64;
#define RLX_AGENT __ATOMIC_RELAXED, __HIP_MEMORY_SCOPE_AGENT
#define LDS_WAIT() asm volatile("s_waitcnt lgkmcnt(0)" ::: "memory")
#define VM_WAIT() asm volatile("s_waitcnt vmcnt(0)" ::: "memory")
__device__ __forceinline__ unsigned long long rt() { return __builtin_amdgcn_s_memrealtime(); }
__device__ __forceinline__ unsigned f2bf(float f) { unsigned u = __builtin_bit_cast(unsigned, f); return (u + 0x7fffu + ((u >> 16) & 1u)) >> 16; }
__device__ __forceinline__ unsigned pk2(float lo, float hi) { return f2bf(lo) | (f2bf(hi) << 16); }

#define XB_TMO      128
#define XB_XCNT(j)  (256  + 64 * (j))
#define XB_XSUB(j)  (1280 + 64 * (j))
#define XB_XGEN(j)  (2304 + 64 * (j))
#define XB_TOP      3328
#define XB_TOPGEN   3392
#define XCD_BAR_WORDS 3456
#define XB_SPIN_CAP (1u << 18)

__device__ __forceinline__ unsigned xb_ld(unsigned* p)              { return __hip_atomic_load(p, __ATOMIC_RELAXED, __HIP_MEMORY_SCOPE_AGENT); }
__device__ __forceinline__ unsigned xb_add(unsigned* p, unsigned v) { return __hip_atomic_fetch_add(p, v, __ATOMIC_RELAXED, __HIP_MEMORY_SCOPE_AGENT); }
__device__ __forceinline__ unsigned xb_xcc_id() { return (unsigned)__builtin_amdgcn_s_getreg((3 << 11) | 20) & 0xFu; }
#define XB_SPIN(cond, bar) do { unsigned _sp = 0; while (cond) { __builtin_amdgcn_s_sleep(1); \
    if ((++_sp & 255u) == 0u) { if (xb_ld(&(bar)[XB_TMO])) break; if (_sp > XB_SPIN_CAP) { atomicAdd(&(bar)[XB_TMO], 1u); break; } } } } while (0)

struct XcdBarrier {
    unsigned* bar; unsigned x;
    volatile LAS unsigned* st;
};

__device__ __forceinline__ XcdBarrier xcd_barrier_post(unsigned* bar, volatile LAS unsigned* st) {
    XcdBarrier b; b.bar = bar; b.x = xb_xcc_id(); b.st = st;
    if (threadIdx.x == 0) (void)xb_add(&bar[XB_XCNT(b.x)], 1u);
    return b;
}
__device__ __forceinline__ void xcd_barrier_complete(unsigned* bar, unsigned x, unsigned& nloc, unsigned& nx) {
    const unsigned G = gridDim.x * gridDim.y * gridDim.z;
    unsigned sum, cnt, mine, sp = 0u;
    for (;;) {
        sum = 0u; cnt = 0u; mine = 0u;
#pragma unroll
        for (unsigned j = 0; j < 16; ++j) { const unsigned c = xb_ld(&bar[XB_XCNT(j)]); sum += c; cnt += (c > 0u) ? 1u : 0u; mine = (j == x) ? c : mine; }
        if (sum == G) break;
        __builtin_amdgcn_s_sleep(1);
        if ((++sp & 255u) == 0u) { if (xb_ld(&bar[XB_TMO])) break; if (sp > XB_SPIN_CAP) { atomicAdd(&bar[XB_TMO], 1u); break; } }
    }
    nloc = mine > 0u ? mine : 1u; nx = cnt > 0u ? cnt : 1u;
}

__device__ __forceinline__ void xcd_barrier(const XcdBarrier& b) {
    asm volatile("s_waitcnt vmcnt(0)" ::: "memory");
    __syncthreads();
    if (threadIdx.x == 0) {
        unsigned* bar = b.bar;
        __builtin_amdgcn_s_waitcnt(0);
        unsigned nloc = b.st[0], nx = b.st[1];
        if (nloc == 0u) { xcd_barrier_complete(bar, b.x, nloc, nx); b.st[0] = nloc; b.st[1] = nx; }
        const unsigned old = xb_add(&bar[XB_XSUB(b.x)], 1u);
        const unsigned gen = old / nloc;
        if (old + 1u == (gen + 1u) * nloc) {
            __builtin_amdgcn_fence(__ATOMIC_RELEASE, "agent");
            asm volatile("s_waitcnt vmcnt(0)" ::: "memory");
            const unsigned og = xb_add(&bar[XB_TOP], 1u);
            const unsigned tg = og / nx;
            if (og + 1u == (tg + 1u) * nx) xb_add(&bar[XB_TOPGEN], 1u);
            else XB_SPIN(xb_ld(&bar[XB_TOPGEN]) == tg, bar);
            __builtin_amdgcn_fence(__ATOMIC_ACQUIRE, "agent");
            xb_add(&bar[XB_XGEN(b.x)], 1u);
            asm volatile("s_waitcnt vmcnt(0)" ::: "memory");
        } else {
            XB_SPIN(xb_ld(&bar[XB_XGEN(b.x)]) == gen, bar);
            __builtin_amdgcn_fence(__ATOMIC_ACQUIRE, "agent");
            asm volatile("s_waitcnt vmcnt(0)" ::: "memory");
        }
    }
    __syncthreads();
}

constexpr int NWAVES = 8;
constexpr int DM = 2048, TX = 8192, NMETA = 16, TT = TX + NMETA, MP = 8448;
constexpr int EV_NP = 5632, EV_LORA0 = 3072, EV_GB = 3360, EV_REC = 4384;
constexpr int OD_NP = 12544, OD_Z = 8192, OD_B = 12288, OD_A = 12320;
constexpr int NEXP = 32, FF = 512, MOE_ROWS = 24576;
constexpr float NORM_EPS = 1e-6f;

constexpr size_t MiB = 1u << 20;
constexpr size_t WS_CTL = 0, CTL_ZERO_BYTES = 1 * MiB;
constexpr size_t WS_TOKINFO = 1 * MiB;
constexpr size_t WS_TILES = 1 * MiB + 512 * 1024;
constexpr size_t WS_WEVIN = 2 * MiB;
constexpr size_t WS_WEVOUT = 24 * MiB;
constexpr size_t WS_WODIN = 32 * MiB;
constexpr size_t WS_WODOUT = 81 * MiB;
constexpr size_t WS_WLORA = 97 * MiB;
constexpr size_t WS_WGATE = 100 * MiB;
constexpr size_t WS_WROUTE = 101 * MiB;
constexpr size_t WS_MOEW = 102 * MiB;
constexpr size_t MOE_E_BYTES = 6 * MiB, MOE_W2_OFF = 4 * MiB;
constexpr size_t WS_H = 294 * MiB;
constexpr size_t WS_HN = 360 * MiB;
constexpr size_t WS_YMIX = 393 * MiB;
constexpr size_t WS_PROJ = 459 * MiB;
constexpr size_t WS_SCR = 662 * MiB;
constexpr size_t WS_END = 932 * MiB;
constexpr size_t SC_ALORA = 0;
constexpr size_t SC_XR = 8 * MiB;
constexpr size_t SC_DEC = 26 * MiB, SC_ICL = 60 * MiB, SC_GATE = 94 * MiB;
constexpr size_t SC_LA = 128 * MiB, SC_LIX = 162 * MiB;
constexpr size_t SC_QN = 0, SC_KN = 34 * MiB;
constexpr size_t SC_VC = 68 * MiB;
constexpr size_t SC_BETA = 134 * MiB, SC_G = 136 * MiB;
constexpr size_t SC_O = 138 * MiB;
constexpr size_t SC_XG = 0;
constexpr size_t SC_ACT = 96 * MiB;
constexpr size_t SC_YB = 120 * MiB;
static_assert(SC_O + (size_t)MP * 4096 * 4 <= WS_END - WS_SCR && SC_YB + (size_t)MOE_ROWS * 2048 * 2 <= WS_END - WS_SCR && SC_LIX + (size_t)MP * 1024 * 4 <= WS_END - WS_SCR, "scratch map");
constexpr int CW_TMO = 0, CW_CODE = 1;
constexpr int CW_BAR = 4096;
constexpr int CW_PROG = 20480;
constexpr int CW_TS = 24576;
constexpr int CW_MOECNT = 16384;

constexpr int RING_OFF = 0, RING_BYTES = 131072;
constexpr int LDSCTL_OFF = 146944, MISC_OFF = LDSCTL_OFF + 320;
constexpr int LDS_BYTES = 147456;


#define DI __device__ __forceinline__
typedef unsigned v2u __attribute__((ext_vector_type(2)));
struct Args { const float* in[36]; float* out; unsigned char* ws; int ph_lo, ph_hi; };
struct Frame {
    LAS unsigned char* lds; volatile LAS unsigned* MISC; gu32* ctl;
    int tid, lane, wave, vcu, G, gw, NGW;
};
DI float bf2f(bf16 v) { return __uint_as_float((unsigned)v << 16); }
DI float bflo(unsigned w) { return __uint_as_float(w << 16); }
DI float bfhi(unsigned w) { return __uint_as_float(w & 0xffff0000u); }
DI float wave_sum(float v) {
#pragma unroll
    for (int o = 1; o < 64; o <<= 1) v += __shfl_xor(v, o);
    return v;
}
DI float sigm(float x) { return __builtin_amdgcn_rcpf(1.0f + __expf(-x)); }
DI float softplus(float x) { return fmaxf(x, 0.f) + __logf(1.0f + __expf(-fabsf(x))); }
DI float gelu_tanh(float x) { const float u = 0.7978845608028654f * (x + 0.044715f * x * x * x); return 0.5f * x * (1.0f + tanhf(u)); }
DI int pos_row(int p) { return p < NMETA ? TX + p : p - NMETA; }
DI int row_pos(int r) { return r < TX ? r + NMETA : r - TX; }

DI void tr_item(const float* W, int N, int k0, int n0, bf16* WT, int ldk, int drow0, LAS float* scr, int lane) {
#pragma unroll 8
    for (int i = 0; i < 32; ++i) { const int kk = 2 * i + (lane >> 5); scr[kk * 33 + (lane & 31)] = W[(size_t)(k0 + kk) * N + n0 + (lane & 31)]; }
    LDS_WAIT(); asm volatile("" ::: "memory");
    const int c = lane & 7;
#pragma unroll
    for (int j = 0; j < 4; ++j) { const int n = (lane >> 3) + 8 * j; const LAS float* s = scr + (8 * c) * 33 + n;
        v4u o; o.x = pk2(s[0 * 33], s[1 * 33]); o.y = pk2(s[2 * 33], s[3 * 33]); o.z = pk2(s[4 * 33], s[5 * 33]); o.w = pk2(s[6 * 33], s[7 * 33]);
        *(v4u*)(WT + (size_t)(drow0 + n) * ldk + k0 + 8 * c) = o; }
    LDS_WAIT(); asm volatile("" ::: "memory");
}
DI void moe_convert(const Frame& F, const Args& a, int l, int gw, int ngw) {
    LAS float* scr = (LAS float*)(F.lds + RING_OFF + F.wave * 16384);
    bf16* base = (bf16*)(a.ws + WS_MOEW);
    for (int it = gw; it < NEXP * 1536; it += ngw) {
        const int e = it / 1536; int j = it % 1536; bf16* eb = base + (size_t)e * (MOE_E_BYTES / 2);
        const size_t eoff = (size_t)(l * NEXP + e) * DM * FF;
        if (j < 1024) { const float* W = (j < 512 ? a.in[33] : a.in[34]) + eoff; const int hi = j >= 512; j &= 511; const int kb = j >> 4, nb = j & 15, n0 = 32 * nb;
            tr_item(W, FF, 64 * kb, n0, eb, DM, 256 * (n0 >> 7) + 128 * hi + (n0 & 127), scr, F.lane); }
        else { j -= 1024; const int kb = j >> 6, nb = j & 63; tr_item(a.in[35] + eoff, DM, 64 * kb, 32 * nb, eb + MOE_W2_OFF / 2, FF, 32 * nb, scr, F.lane); }
    }
}
DI void norm_row_bf16(int lane, const float* src, const float* w, bf16* dst) {
    f32x4 v[8]; float s = 0.f;
#pragma unroll
    for (int j = 0; j < 8; ++j) { v[j] = ((const f32x4*)src)[lane + 64 * j]; s += (v[j].x * v[j].x + v[j].y * v[j].y) + (v[j].z * v[j].z + v[j].w * v[j].w); }
    const float rs = 1.0f / sqrtf(wave_sum(s) * (1.0f / DM) + NORM_EPS);
#pragma unroll
    for (int j = 0; j < 8; ++j) { const f32x4 wv = ((const f32x4*)w)[lane + 64 * j]; v2u o; o.x = pk2(v[j].x * rs * wv.x, v[j].y * rs * wv.y); o.y = pk2(v[j].z * rs * wv.z, v[j].w * rs * wv.w);
        ((v2u*)dst)[lane + 64 * j] = o; }
}

DI void ph_prologue(const Frame& F, const Args& a) {
    LAS float* scr = (LAS float*)(F.lds + RING_OFF + F.wave * 16384);
    constexpr int I_A = 32 * 169, I_B = 32 * 64, NIT = I_A + I_B;
    for (int it = F.gw; it < NIT; it += F.NGW) {
        int r = it;
        if (r < I_A) { const int kb = r / 169, nb = r % 169; tr_item(a.in[5], 5408, 64 * kb, 32 * nb, (bf16*)(a.ws + WS_WEVIN), DM, 32 * nb, scr, F.lane); continue; } r -= I_A;
        { const int kb = r / 64, nb = r % 64; tr_item(a.in[24], DM, 64 * kb, 32 * nb, (bf16*)(a.ws + WS_WEVOUT), DM, 32 * nb, scr, F.lane); }
    }
    const int gt = F.vcu * (NWAVES * 64) + F.tid, NGT = F.G * NWAVES * 64;
    { bf16* WL = (bf16*)(a.ws + WS_WLORA); const float* wup = a.in[8]; const float* aup = a.in[10]; const float* gup = a.in[11];
      for (int idx = gt; idx < 3072 * 384; idx += NGT) { const int n = idx / 384, k = idx % 384; float v = 0.f;
          if (n < 1024) { if (k < 64) v = wup[k * 1024 + n]; }
          else if (n < 2048) { if (k >= 64 && k < 128) v = aup[(k - 64) * 1024 + n - 1024]; }
          else { if (k >= 128 && k < 288) v = gup[(k - 128) * 1024 + n - 2048]; }
          WL[idx] = (bf16)f2bf(v); } }
    { bf16* WG = (bf16*)(a.ws + WS_WGATE);
      for (int idx = gt; idx < 2048 * 256; idx += NGT) { const int n = idx >> 8, kk = idx & 255, nn = n & 1023, blk = nn >> 6, j = nn & 63, cin = (nn & ~255) + kk;
          const float* W = n < 1024 ? a.in[19] : a.in[21];
          const float v = (cin >> 6) == blk ? W[blk * 4096 + (cin & 63) * 64 + j] : 0.f;
          WG[idx] = (bf16)f2bf(v); } }
    { bf16* WR = (bf16*)(a.ws + WS_WROUTE);
      for (int idx = gt; idx < 2 * 48 * DM; idx += NGT) { const int l = idx / (48 * DM), n = (idx / DM) % 48, k = idx % DM; float v = 0.f;
          if (n < 32) v = a.in[32][((size_t)l * DM + k) * NEXP + n]; else if (n < 36) v = a.in[31][((size_t)l * DM + k) * 4 + n - 32];
          const unsigned hi = f2bf(v); WR[((size_t)(l * 2) * 48 + n) * DM + k] = (bf16)hi; WR[((size_t)(l * 2 + 1) * 48 + n) * DM + k] = (bf16)f2bf(v - __uint_as_float(hi << 16)); } }
    bf16* HN = (bf16*)(a.ws + WS_HN);
    for (int r = F.gw; r < TT; r += F.NGW) norm_row_bf16(F.lane, r < TX ? a.in[0] + (size_t)r * DM : a.in[1] + (size_t)(r - TX) * DM, a.in[2], HN + (size_t)r * DM);
}

DI void ph_aux_convert(const Frame& F, const Args& a, int gw, int ngw) {
    LAS float* scr = (LAS float*)(F.lds + RING_OFF + F.wave * 16384);
    constexpr int I_C = 32 * 386, I_D = 64 * 64, NIT = I_C + I_D;
    for (int it = gw; it < NIT; it += ngw) {
        int r = it;
        if (r < I_C) { const int kb = r / 386, nb = r % 386; tr_item(a.in[25], 12352, 64 * kb, 32 * nb, (bf16*)(a.ws + WS_WODIN), DM, 32 * nb, scr, F.lane); continue; } r -= I_C;
        { const int kb = r / 64, nb = r % 64; tr_item(a.in[30], DM, 64 * kb, 32 * nb, (bf16*)(a.ws + WS_WODOUT), 4096, 32 * nb, scr, F.lane); }
    }
    moe_convert(F, a, 0, gw, ngw);
}

DI void ph_even_prep(const Frame& F, const Args& a) {
    const bf16* P = (const bf16*)(a.ws + WS_PROJ); bf16* AL = (bf16*)(a.ws + WS_SCR + SC_ALORA); bf16* XR = (bf16*)(a.ws + WS_SCR + SC_XR);
    const float* mu = a.in[6]; const float* cw = a.in[17]; const float* cb = a.in[18];
    const int lane = F.lane;
    for (int item = F.gw; item < TT + (TT / 8) * 2; item += F.NGW) {
        if (item < TT) { const int r = item, pos = row_pos(r); const bf16* cur = P + (size_t)r * EV_NP; const bf16* prv = P + (size_t)pos_row(pos > 0 ? pos - 1 : 0) * EV_NP; const float pm = pos > 0 ? 1.f : 0.f;
            float cv[6], pv[6], mv[6];
#pragma unroll
            for (int i = 0; i < 6; ++i) { const int idx = lane + 64 * i, col = EV_LORA0 + (idx < 288 ? idx : 287); cv[i] = bf2f(cur[col]); pv[i] = bf2f(prv[col]) * pm; mv[i] = mu[col]; }
#pragma unroll
            for (int i = 0; i < 6; ++i) { const int idx = lane + 64 * i; float v = cv[i] + (pv[i] - cv[i]) * mv[i];
                if (idx < 64) v = tanhf(v); else if (idx >= 128) v = sigm(v);
                AL[(size_t)r * 384 + idx] = (bf16)f2bf(idx < 288 ? v : 0.f); }
        } else { const int it2 = item - TT, pb = it2 >> 1, c0 = (it2 & 1) * 512 + lane * 8, p0 = pb * 8;
            f32x4 w[4][2], b0 = *(const f32x4*)(cb + c0), b1 = *(const f32x4*)(cb + c0 + 4);
#pragma unroll
            for (int j = 0; j < 4; ++j) { w[j][0] = *(const f32x4*)(cw + j * 1024 + c0); w[j][1] = *(const f32x4*)(cw + j * 1024 + c0 + 4); }
            v4u x[11];
#pragma unroll
            for (int i = 0; i < 11; ++i) { const int p = p0 - 3 + i; x[i] = *(const v4u*)(P + (size_t)pos_row(p > 0 ? p : 0) * EV_NP + EV_REC + c0); if (p < 0) x[i] = (v4u){0u, 0u, 0u, 0u}; }
#pragma unroll
            for (int o = 0; o < 8; ++o) { float acc[8] = {b0.x, b0.y, b0.z, b0.w, b1.x, b1.y, b1.z, b1.w};
#pragma unroll
                for (int j = 0; j < 4; ++j) { const v4u xv = x[o + j];
                    acc[0] += w[j][0].x * bflo(xv.x); acc[1] += w[j][0].y * bfhi(xv.x); acc[2] += w[j][0].z * bflo(xv.y); acc[3] += w[j][0].w * bfhi(xv.y);
                    acc[4] += w[j][1].x * bflo(xv.z); acc[5] += w[j][1].y * bfhi(xv.z); acc[6] += w[j][1].z * bflo(xv.w); acc[7] += w[j][1].w * bfhi(xv.w); }
                *(v4u*)(XR + (size_t)pos_row(p0 + o) * 1024 + c0) = (v4u){pk2(acc[0], acc[1]), pk2(acc[2], acc[3]), pk2(acc[4], acc[5]), pk2(acc[6], acc[7])}; } }
    }
}

DI void ph_route(const Frame& F, const Args& a, int l, int dummy) {
    const float* H = (const float*)(a.ws + WS_H); const float* nw = a.in[3] + (size_t)l * DM;
    const bf16* WH = (const bf16*)(a.ws + WS_WROUTE) + (size_t)(l * 2) * 48 * DM; const bf16* WL = WH + (size_t)48 * DM;
    unsigned* TI = (unsigned*)(a.ws + WS_TOKINFO) + (dummy ? (WS_SCR + 250 * MiB - WS_TOKINFO) / 4 : 0); const int lane = F.lane, lc = lane & 15, quad = lane >> 4, wave = F.wave; const int cl = dummy ? l + 2 : l;
    LAS float* red = (LAS float*)(F.lds + RING_OFF);
    LAS float* sq = red + 8 * 9 * 64 * 4; LAS float* lgs = sq + 8 * 48;
    static_assert(TT % 48 == 0, "router tasks");
    for (int task = F.vcu; task < TT / 48; task += F.G) {
        const float* nwp = nw + 256 * wave + 8 * quad; float ss[3] = {0.f, 0.f, 0.f};
        f32x4 acc[3][3];
#pragma unroll
        for (int mt = 0; mt < 3; ++mt)
#pragma unroll
            for (int nt = 0; nt < 3; ++nt) acc[mt][nt] = (f32x4){0.f, 0.f, 0.f, 0.f};
#pragma unroll 2
        for (int ks = 0; ks < 8; ++ks) { const int k0 = 256 * wave + 32 * ks + 8 * quad; const f32x4 w0 = *(const f32x4*)(nwp + 32 * ks), w1 = *(const f32x4*)(nwp + 32 * ks + 4);
            bf16x8 bh[3], bl[3];
#pragma unroll
            for (int nt = 0; nt < 3; ++nt) { bh[nt] = *(const bf16x8*)(WH + (size_t)(16 * nt + lc) * DM + k0); bl[nt] = *(const bf16x8*)(WL + (size_t)(16 * nt + lc) * DM + k0); }
#pragma unroll
            for (int mt = 0; mt < 3; ++mt) { const float* hr = H + (size_t)(task * 48 + mt * 16 + lc) * DM + k0; const f32x4 x0 = *(const f32x4*)hr, x1 = *(const f32x4*)(hr + 4);
                ss[mt] += (x0.x * x0.x + x0.y * x0.y) + (x0.z * x0.z + x0.w * x0.w) + (x1.x * x1.x + x1.y * x1.y) + (x1.z * x1.z + x1.w * x1.w);
                const float xn[8] = {x0.x * w0.x, x0.y * w0.y, x0.z * w0.z, x0.w * w0.w, x1.x * w1.x, x1.y * w1.y, x1.z * w1.z, x1.w * w1.w};
                unsigned hi[8]; float lo[8];
#pragma unroll
                for (int q = 0; q < 8; ++q) { hi[q] = f2bf(xn[q]); lo[q] = xn[q] - __uint_as_float(hi[q] << 16); }
                const v4u ah4 = (v4u){hi[0] | (hi[1] << 16), hi[2] | (hi[3] << 16), hi[4] | (hi[5] << 16), hi[6] | (hi[7] << 16)}, al4 = (v4u){pk2(lo[0], lo[1]), pk2(lo[2], lo[3]), pk2(lo[4], lo[5]), pk2(lo[6], lo[7])};
                const bf16x8 ah = __builtin_bit_cast(bf16x8, ah4), al = __builtin_bit_cast(bf16x8, al4);
#pragma unroll
                for (int nt = 0; nt < 3; ++nt) { acc[mt][nt] = __builtin_amdgcn_mfma_f32_16x16x32_bf16(al, bh[nt], acc[mt][nt], 0, 0, 0); acc[mt][nt] = __builtin_amdgcn_mfma_f32_16x16x32_bf16(ah, bl[nt], acc[mt][nt], 0, 0, 0);
                    acc[mt][nt] = __builtin_amdgcn_mfma_f32_16x16x32_bf16(ah, bh[nt], acc[mt][nt], 0, 0, 0); } } }
#pragma unroll
        for (int mt = 0; mt < 3; ++mt) { float s_ = ss[mt]; s_ += __shfl_xor(s_, 16); s_ += __shfl_xor(s_, 32); if (quad == 0) sq[wave * 48 + mt * 16 + lc] = s_;
#pragma unroll
            for (int nt = 0; nt < 3; ++nt) *(LAS f32x4*)(red + ((wave * 9 + mt * 3 + nt) * 64 + lane) * 4) = acc[mt][nt]; }
        __syncthreads();
        { const int tile = wave;
#pragma unroll
          for (int rep = 0; rep < 2; ++rep) { const int tl = tile + 8 * rep; if (tl < 9) { f32x4 s = *(const LAS f32x4*)(red + (tl * 64 + lane) * 4);
#pragma unroll
              for (int v = 1; v < 8; ++v) s = s + *(const LAS f32x4*)(red + ((v * 9 + tl) * 64 + lane) * 4);
              const int mt = tl / 3, nt = tl % 3;
#pragma unroll
              for (int q = 0; q < 4; ++q) lgs[(mt * 16 + 4 * quad + q) * 49 + 16 * nt + lc] = s[q]; } } }
        __syncthreads();
        if (wave == 0 && lane < 48) { float sst = 0.f;
#pragma unroll
            for (int v = 0; v < 8; ++v) sst += sq[v * 48 + lane];
            const float rs = 1.0f / sqrtf(sst * (1.0f / DM) + NORM_EPS);
            float lg[36];
#pragma unroll
            for (int i = 0; i < 36; ++i) lg[i] = lgs[lane * 49 + i] * rs;
            int gi = 0; float gm = lg[32];
#pragma unroll
            for (int i = 1; i < 4; ++i) if (lg[32 + i] > gm) { gm = lg[32 + i]; gi = i; }
            float den = 0.f;
#pragma unroll
            for (int i = 0; i < 4; ++i) den += __expf(lg[32 + i] - gm);
            const float gp = 1.0f / den;
            float l8[8];
#pragma unroll
            for (int i = 0; i < 8; ++i) l8[i] = gi == 0 ? lg[i] : (gi == 1 ? lg[8 + i] : (gi == 2 ? lg[16 + i] : lg[24 + i]));
            int i1 = 0; float m1 = l8[0];
#pragma unroll
            for (int i = 1; i < 8; ++i) if (l8[i] > m1) { m1 = l8[i]; i1 = i; }
            int i2 = -1; float m2 = -INFINITY;
#pragma unroll
            for (int i = 0; i < 8; ++i) if (i != i1 && l8[i] > m2) { m2 = l8[i]; i2 = i; }
            const float e21 = __expf(m2 - m1); const float w1 = gp / (1.0f + e21), w2 = gp * e21 / (1.0f + e21);
            const int ea = gi * 8 + i1, eb = gi * 8 + i2; const int rt = task * 48 + lane;
            const unsigned sa = atomicAdd((unsigned*)(F.ctl + CW_MOECNT + (cl * NEXP + ea) * 16), 1u), sb = atomicAdd((unsigned*)(F.ctl + CW_MOECNT + (cl * NEXP + eb) * 16), 1u);
            unsigned* t = TI + (size_t)rt * 8; *(v4u*)t = (v4u){(unsigned)ea, sa, __float_as_uint(w1), (unsigned)eb}; *(v4u*)(t + 4) = (v4u){sb, __float_as_uint(w2), __float_as_uint(rs), 0u}; }
        __syncthreads();
    }
}
DI void moe_prefix(const Frame& F, int l, LAS int* ps) {
    if (F.tid == 0) { int t = 0;
        for (int e = 0; e < NEXP; ++e) { const unsigned c = __hip_atomic_load(F.ctl + CW_MOECNT + (l * NEXP + e) * 16, RLX_AGENT); ps[e] = t * 256; t += (int)((c + 255u) >> 8); }
        ps[32] = t; }
    __syncthreads();
}
DI void ph_gather(const Frame& F, const Args& a, int l) {
    LAS int* ps = (LAS int*)(F.lds + RING_OFF); moe_prefix(F, l, ps);
    if (F.vcu == 0 && F.tid < NEXP) { int* TE = (int*)(a.ws + WS_TILES); const int e = F.tid; const int t0 = ps[e] >> 8, t1 = (e == NEXP - 1 ? ps[32] : ps[e + 1] >> 8);
        for (int t = t0; t < t1; ++t) TE[t] = e; if (e == 0) TE[127] = ps[32]; }
    const float* H = (const float*)(a.ws + WS_H); const float* nw = a.in[3] + (size_t)l * DM; unsigned* TI = (unsigned*)(a.ws + WS_TOKINFO); bf16* XG = (bf16*)(a.ws + WS_SCR + SC_XG);
    const int lane = F.lane;
    for (int r = F.gw; r < TT; r += F.NGW) {
        unsigned* t = TI + (size_t)r * 8; const int g0 = ps[t[0]] + (int)t[1], g1 = ps[t[3]] + (int)t[4]; const float rs = __uint_as_float(t[6]);
        if (lane == 0) t[7] = (unsigned)g0 | ((unsigned)g1 << 16);
        const float* hr = H + (size_t)r * DM;
#pragma unroll
        for (int j = 0; j < 4; ++j) { const int e0 = (lane + 64 * j) * 8; const f32x4 x0 = *(const f32x4*)(hr + e0), x1 = *(const f32x4*)(hr + e0 + 4), w0 = *(const f32x4*)(nw + e0), w1 = *(const f32x4*)(nw + e0 + 4);
            v4u o; o.x = pk2(x0.x * rs * w0.x, x0.y * rs * w0.y); o.y = pk2(x0.z * rs * w0.z, x0.w * rs * w0.w); o.z = pk2(x1.x * rs * w1.x, x1.y * rs * w1.y); o.w = pk2(x1.z * rs * w1.z, x1.w * rs * w1.w);
            *(v4u*)(XG + (size_t)g0 * DM + e0) = o; *(v4u*)(XG + (size_t)g1 * DM + e0) = o; }
    }
}
DI void ph_combine(const Frame& F, const Args& a, int l) {
    float* H = (float*)(a.ws + WS_H); const unsigned* TI = (const unsigned*)(a.ws + WS_TOKINFO); const bf16* YB = (const bf16*)(a.ws + WS_SCR + SC_YB); bf16* HN = (bf16*)(a.ws + WS_HN);
    const int lane = F.lane; const int nrows = l == 0 ? TT : TX;
    for (int r = F.gw; r < nrows; r += F.NGW) {
        const unsigned* t = TI + (size_t)r * 8; const int g0 = (int)(t[7] & 0xffffu), g1 = (int)(t[7] >> 16); const float w0 = __uint_as_float(t[2]), w1 = __uint_as_float(t[5]);
        float* hr = H + (size_t)r * DM; float hv[32]; float s = 0.f;
#pragma unroll
        for (int j = 0; j < 4; ++j) { const int e0 = (lane + 64 * j) * 8; const f32x4 x0 = *(const f32x4*)(hr + e0), x1 = *(const f32x4*)(hr + e0 + 4);
            const v4u ya = *(const v4u*)(YB + (size_t)g0 * DM + e0), yc = *(const v4u*)(YB + (size_t)g1 * DM + e0);
            float* o = hv + 8 * j;
            o[0] = x0.x + w0 * bflo(ya.x) + w1 * bflo(yc.x); o[1] = x0.y + w0 * bfhi(ya.x) + w1 * bfhi(yc.x); o[2] = x0.z + w0 * bflo(ya.y) + w1 * bflo(yc.y); o[3] = x0.w + w0 * bfhi(ya.y) + w1 * bfhi(yc.y);
            o[4] = x1.x + w0 * bflo(ya.z) + w1 * bflo(yc.z); o[5] = x1.y + w0 * bfhi(ya.z) + w1 * bfhi(yc.z); o[6] = x1.z + w0 * bflo(ya.w) + w1 * bflo(yc.w); o[7] = x1.w + w0 * bfhi(ya.w) + w1 * bfhi(yc.w);
#pragma unroll
            for (int q = 0; q < 8; ++q) s += o[q] * o[q]; }
        const float rs = 1.0f / sqrtf(wave_sum(s) * (1.0f / DM) + NORM_EPS);
        if (l == 0) { const float* nw = a.in[2] + DM;
#pragma unroll
            for (int j = 0; j < 4; ++j) { const int e0 = (lane + 64 * j) * 8; const float* o = hv + 8 * j; const f32x4 wa = *(const f32x4*)(nw + e0), wb = *(const f32x4*)(nw + e0 + 4);
                *(f32x4*)(hr + e0) = (f32x4){o[0], o[1], o[2], o[3]}; *(f32x4*)(hr + e0 + 4) = (f32x4){o[4], o[5], o[6], o[7]};
                v4u p; p.x = pk2(o[0] * rs * wa.x, o[1] * rs * wa.y); p.y = pk2(o[2] * rs * wa.z, o[3] * rs * wa.w); p.z = pk2(o[4] * rs * wb.x, o[5] * rs * wb.y); p.w = pk2(o[6] * rs * wb.z, o[7] * rs * wb.w);
                *(v4u*)(HN + (size_t)r * DM + e0) = p; }
        } else { const float* nw = a.in[4]; float* orow = a.out + (size_t)r * DM;
#ifdef PROBE_TS
            { const unsigned long long* ts = (const unsigned long long*)(F.ctl + CW_TS); const float dt_us = (float)(__hip_atomic_load(ts + PROBE_TS + 1, RLX_AGENT) - __hip_atomic_load(ts + PROBE_TS, RLX_AGENT)) * 0.01f;
#pragma unroll
              for (int q = 0; q < 32; ++q) hv[q] *= 1.0f + dt_us * 0.01f; }
#endif
#pragma unroll
            for (int j = 0; j < 4; ++j) { const int e0 = (lane + 64 * j) * 8; const float* o = hv + 8 * j; const f32x4 wa = *(const f32x4*)(nw + e0), wb = *(const f32x4*)(nw + e0 + 4);
                *(f32x4*)(orow + e0) = (f32x4){o[0] * rs * wa.x, o[1] * rs * wa.y, o[2] * rs * wa.z, o[3] * rs * wa.w};
                *(f32x4*)(orow + e0 + 4) = (f32x4){o[4] * rs * wb.x, o[5] * rs * wb.y, o[6] * rs * wb.z, o[7] * rs * wb.w}; } }
    }
}

struct OddPrepItem { f32x4 w[4][2]; v4u x[11]; };
DI void odd_prep_load(OddPrepItem& it, const bf16* P, const float* cw, int item, int lane) {
    const int pb = item >> 4, i = item & 15, ch = i * 512 + lane * 8, p0 = pb * 8;
#pragma unroll
    for (int j = 0; j < 4; ++j) { it.w[j][0] = *(const f32x4*)(cw + j * 8192 + ch); it.w[j][1] = *(const f32x4*)(cw + j * 8192 + ch + 4); }
#pragma unroll
    for (int q = 0; q < 11; ++q) { const int p = p0 - 3 + q; it.x[q] = *(const v4u*)(P + (size_t)pos_row(p > 0 ? p : 0) * OD_NP + ch); if (p < 0) it.x[q] = (v4u){0u, 0u, 0u, 0u}; }
}
DI void odd_prep_compute(const OddPrepItem& it, const Args& a, int item, int lane) {
    const bf16* P = (const bf16*)(a.ws + WS_PROJ); bf16* QN = (bf16*)(a.ws + WS_SCR + SC_QN); bf16* KN = (bf16*)(a.ws + WS_SCR + SC_KN); bf16* VC = (bf16*)(a.ws + WS_SCR + SC_VC);
    float* BETA = (float*)(a.ws + WS_SCR + SC_BETA); float* GG = (float*)(a.ws + WS_SCR + SC_G);
    const int pb = item >> 4, i = item & 15, ch = i * 512 + lane * 8, p0 = pb * 8;
#pragma unroll
    for (int o = 0; o < 8; ++o) { const int r = pos_row(p0 + o); float acc[8] = {0.f, 0.f, 0.f, 0.f, 0.f, 0.f, 0.f, 0.f};
#pragma unroll
        for (int j = 0; j < 4; ++j) { const v4u xv = it.x[o + j];
            acc[0] += it.w[j][0].x * bflo(xv.x); acc[1] += it.w[j][0].y * bfhi(xv.x); acc[2] += it.w[j][0].z * bflo(xv.y); acc[3] += it.w[j][0].w * bfhi(xv.y);
            acc[4] += it.w[j][1].x * bflo(xv.z); acc[5] += it.w[j][1].y * bfhi(xv.z); acc[6] += it.w[j][1].z * bflo(xv.w); acc[7] += it.w[j][1].w * bfhi(xv.w); }
        float ss = 0.f;
#pragma unroll
        for (int q = 0; q < 8; ++q) { acc[q] = acc[q] * sigm(acc[q]); ss += acc[q] * acc[q]; }
        float sc = 1.0f;
        if (i < 8) { ss += __shfl_xor(ss, 1); ss += __shfl_xor(ss, 2); ss += __shfl_xor(ss, 4); ss += __shfl_xor(ss, 8);
            sc = (1.0f / sqrtf(ss + NORM_EPS)) * (i < 4 ? 0.08838834764831845f : 1.0f); }
        const v4u ov = (v4u){pk2(acc[0] * sc, acc[1] * sc), pk2(acc[2] * sc, acc[3] * sc), pk2(acc[4] * sc, acc[5] * sc), pk2(acc[6] * sc, acc[7] * sc)};
        bf16* dst = i < 4 ? QN + (size_t)r * 2048 + ch : (i < 8 ? KN + (size_t)r * 2048 + ch - 2048 : VC + (size_t)r * 4096 + ch - 4096);
        *(v4u*)dst = ov; }
    if (i == 0 && lane < 32) {
#pragma unroll
        for (int o = 0; o < 8; ++o) { const int r = pos_row(p0 + o); const float bb = bf2f(P[(size_t)r * OD_NP + OD_B + lane]), aa = bf2f(P[(size_t)r * OD_NP + OD_A + lane]);
            BETA[(size_t)r * 32 + lane] = sigm(bb); GG[(size_t)r * 32 + lane] = -__expf(a.in[27][lane]) * softplus(aa + a.in[28][lane]); } }
}
DI void ph_odd_prep(const Frame& F, const Args& a) {
    const bf16* P = (const bf16*)(a.ws + WS_PROJ); const float* cw = a.in[26]; constexpr int NI = (TT / 8) * 16;
    for (int item = F.gw; item < NI; item += 2 * F.NGW) { OddPrepItem A, B; const bool hb = item + F.NGW < NI;
        odd_prep_load(A, P, cw, item, F.lane); odd_prep_load(B, P, cw, hb ? item + F.NGW : item, F.lane);
        odd_prep_compute(A, a, item, F.lane); if (hb) odd_prep_compute(B, a, item + F.NGW, F.lane); }
}
DI void ph_odd_post(const Frame& F, const Args& a, int part) {
    const bf16* P = (const bf16*)(a.ws + WS_PROJ); const bf16* O = (const bf16*)(a.ws + WS_SCR + SC_O); bf16* Y = (bf16*)(a.ws + WS_YMIX); const float* nw = a.in[29];
    const int lane = F.lane; int w0 = F.gw, wn = F.NGW, n_rows = TX - 6144;
    if (part == 0) { const int wx = F.vcu & 31; if (F.G != 256 || wx < 20) return; w0 = ((F.vcu >> 5) * 12 + (wx - 20)) * NWAVES + F.wave; wn = 96 * NWAVES; n_rows = 6144 + NMETA; }
    if (part == 2) n_rows = TT;
    for (int ri = w0; ri < n_rows; ri += wn) { const int r = part == 0 ? (ri < 6144 ? ri : TX + ri - 6144) : (part == 1 ? 6144 + ri : ri);
#pragma unroll 2
        for (int i = 0; i < 8; ++i) { const int ch = i * 512 + lane * 8; const v4u ow = *(const v4u*)(O + (size_t)r * 4096 + ch); const f32x4 o0 = (f32x4){bflo(ow.x), bfhi(ow.x), bflo(ow.y), bfhi(ow.y)}, o1 = (f32x4){bflo(ow.z), bfhi(ow.z), bflo(ow.w), bfhi(ow.w)};
            float ss = (o0.x * o0.x + o0.y * o0.y) + (o0.z * o0.z + o0.w * o0.w) + (o1.x * o1.x + o1.y * o1.y) + (o1.z * o1.z + o1.w * o1.w);
            ss += __shfl_xor(ss, 1); ss += __shfl_xor(ss, 2); ss += __shfl_xor(ss, 4); ss += __shfl_xor(ss, 8);
            const float rs = 1.0f / sqrtf(ss * (1.0f / 128.0f) + NORM_EPS);
            const v4u z = *(const v4u*)(P + (size_t)r * OD_NP + OD_Z + ch); const int c0 = ch & 127; const f32x4 w0 = *(const f32x4*)(nw + c0), w1 = *(const f32x4*)(nw + c0 + 4);
            const float zf[8] = {bflo(z.x), bfhi(z.x), bflo(z.y), bfhi(z.y), bflo(z.z), bfhi(z.z), bflo(z.w), bfhi(z.w)};
            const float of[8] = {o0.x * w0.x, o0.y * w0.y, o0.z * w0.z, o0.w * w0.w, o1.x * w1.x, o1.y * w1.y, o1.z * w1.z, o1.w * w1.w};
            float y[8];
#pragma unroll
            for (int q = 0; q < 8; ++q) y[q] = of[q] * rs * zf[q] * sigm(zf[q]);
            v4u p; p.x = pk2(y[0], y[1]); p.y = pk2(y[2], y[3]); p.z = pk2(y[4], y[5]); p.w = pk2(y[6], y[7]);
            *(v4u*)(Y + (size_t)r * 4096 + ch) = p; }
    }
}

typedef float f32x16 __attribute__((ext_vector_type(16)));
#define MFMA32(a, b, c) __builtin_amdgcn_mfma_f32_32x32x16_bf16((a), (b), (c), 0, 0, 0)
DI int crow(int reg, int h) { return (reg & 3) + 8 * (reg >> 2) + 4 * h; }
DI int chunk_row(int n, int c) { return n == 0 ? (c >= 48 ? TX + (c - 48) : -1) : 64 * (n - 1) + c; }
#ifndef GDN_NO_HELPER
#define GDN_NO_HELPER 0
#endif
constexpr int GDN_NCH = 129, GDN_UNITS = GDN_NCH * 32, GDN_KUNITS = GDN_NCH * 16, GC_STRIDE = 72;
constexpr size_t GD_WF = WS_MOEW, GD_UF = WS_MOEW + 65 * MiB, GD_IN = WS_MOEW + 130 * MiB, GD_GC = WS_MOEW + 163 * MiB, GD_KT = WS_HN, GD_QF = WS_SCR + 208 * MiB, GD_SAVE = WS_SCR + 205 * MiB;
static_assert(GD_QF + (size_t)GDN_KUNITS * 16384 <= WS_END && GD_SAVE + 2 * MiB <= GD_QF && (size_t)GDN_UNITS * 16384 <= 65 * MiB && (size_t)GDN_UNITS * 8192 <= 33 * MiB && (size_t)GDN_KUNITS * 16384 <= 33 * MiB && GD_GC + (size_t)GDN_UNITS * GC_STRIDE * 4 <= WS_H, "gdn map");

DI void ph_gdn_chunk(const Frame& F, const Args& a, int n_lo, int n_hi, int side) {
    const bf16* QN = (const bf16*)(a.ws + WS_SCR + SC_QN); const bf16* KN = (const bf16*)(a.ws + WS_SCR + SC_KN); const bf16* VC = (const bf16*)(a.ws + WS_SCR + SC_VC);
    const float* BETA = (const float*)(a.ws + WS_SCR + SC_BETA); const float* GG = (const float*)(a.ws + WS_SCR + SC_G);
    bf16* WF = (bf16*)(a.ws + GD_WF); bf16* UF = (bf16*)(a.ws + GD_UF); bf16* INF = (bf16*)(a.ws + GD_IN); bf16* KTF = (bf16*)(a.ws + GD_KT); bf16* QF = (bf16*)(a.ws + GD_QF); float* GC = (float*)(a.ws + GD_GC);
    LAS unsigned char* L = F.lds + RING_OFF;
    LAS unsigned char* kS = L; LAS unsigned char* qS = L + 17408; LAS unsigned char* vS = L + 34816; LAS unsigned char* kbS = L + 52224;
    LAS float* Lm = (LAS float*)(L + 69632); LAS bf16* IS = (LAS bf16*)(L + 87040); LAS bf16* XS = (LAS bf16*)(L + 96256);
    LAS float* betaS = (LAS float*)(L + 130048); LAS float* gcS = betaS + 64; LAS float* egcS = betaS + 128;
    LAS unsigned char* Lb = L + 17408; LAS unsigned char* TDs = L + 26624; LAS unsigned char* YT0 = L + 28672; LAS unsigned char* XT0 = L + 130816;
    static_assert(130816 + 8 * 1792 <= LDSCTL_OFF, "gdn lds map");
    const int tid = F.tid, lane = F.lane, wave = F.wave, l31 = lane & 31, h = lane >> 5;
    int widx = F.vcu, wcnt = F.G;
    if (side) { if (F.G == 256) { const int wx = F.vcu & 31; if (wx < 20) return; widx = (F.vcu >> 5) * 12 + (wx - 20); wcnt = 96; } else { if (F.vcu < 128 || F.G <= 128) return; widx = F.vcu - 128; wcnt = F.G - 128; } }
    for (int unit = n_lo * 32 + widx; unit < n_hi * 32; unit += wcnt) {
        const int n = unit >> 5, hv = unit & 31, hk = hv >> 1; const size_t su = (size_t)hv * GDN_NCH + n;
#pragma unroll
        for (int i = 0; i < 2; ++i) { const int p = tid + 512 * i, row = p >> 4, ch = p & 15; const int rr = chunk_row(n, row);
            v4u kx = (v4u){0u, 0u, 0u, 0u}, qx = kx, vx = kx;
            if (rr >= 0) { kx = *(const v4u*)(KN + (size_t)rr * 2048 + hk * 128 + ch * 8); qx = *(const v4u*)(QN + (size_t)rr * 2048 + hk * 128 + ch * 8); vx = *(const v4u*)(VC + (size_t)rr * 4096 + hv * 128 + ch * 8); }
            *(LAS v4u*)(kS + row * 272 + ch * 16) = kx; *(LAS v4u*)(qS + row * 272 + ch * 16) = qx; *(LAS v4u*)(vS + row * 272 + ch * 16) = vx; }
        if (wave == 0) { const int rr = chunk_row(n, lane); float b = 0.f, g = 0.f; if (rr >= 0) { b = BETA[(size_t)rr * 32 + hv]; g = GG[(size_t)rr * 32 + hv]; }
#pragma unroll
            for (int o = 1; o < 64; o <<= 1) { const float t = __shfl_up(g, o); if (lane >= o) g += t; }
            betaS[lane] = b; gcS[lane] = g; egcS[lane] = __expf(g); }
        __syncthreads();
        if ((hv & 1) == 0) { const size_t kunit = (size_t)hk * GDN_NCH + n;
#pragma unroll
            for (int i = 0; i < 2; ++i) { const int p = tid + 512 * i, comb = p >> 6, ln = p & 63, t = comb >> 3, s = comb & 7; const int c = 32 * t + (ln & 31), k0 = 16 * s + 8 * (ln >> 5);
                *(v4u*)(QF + (kunit * 16 + comb) * 512 + ln * 8) = *(const LAS v4u*)(qS + c * 272 + k0 * 2); } }
#pragma unroll
        for (int i = 0; i < 2; ++i) { const int p = tid + 512 * i, row = p >> 4, ch = p & 15; const v4u kx = *(const LAS v4u*)(kS + row * 272 + ch * 16); const float b = betaS[row];
            v4u o; o.x = pk2(bflo(kx.x) * b, bfhi(kx.x) * b); o.y = pk2(bflo(kx.y) * b, bfhi(kx.y) * b); o.z = pk2(bflo(kx.z) * b, bfhi(kx.z) * b); o.w = pk2(bflo(kx.w) * b, bfhi(kx.w) * b);
            *(LAS v4u*)(kbS + row * 272 + ch * 16) = o; }
        __syncthreads();
        { const int which = wave >> 2, ti = (wave >> 1) & 1, tj = wave & 1;
          f32x16 acc;
#pragma unroll
          for (int r = 0; r < 16; ++r) acc[r] = 0.f;
          if (!(ti == 0 && tj == 1)) { const LAS unsigned char* Ab = (which == 0 ? kbS : qS) + (32 * ti + l31) * 272 + 16 * h; const LAS unsigned char* Bb = kS + (32 * tj + l31) * 272 + 16 * h;
#pragma unroll
              for (int s = 0; s < 8; ++s) acc = MFMA32(*(const LAS bf16x8*)(Ab + 32 * s), *(const LAS bf16x8*)(Bb + 32 * s), acc); }
          const int j = 32 * tj + l31; const float gj = gcS[j];
#pragma unroll
          for (int r = 0; r < 16; ++r) { const int i = 32 * ti + crow(r, h); const float e = __expf(fminf(gcS[i] - gj, 0.f));
              if (which == 0) Lm[i * 68 + j] = i > j ? acc[r] * e : 0.f;
              else IS[i * 72 + j] = (bf16)f2bf(i >= j ? acc[r] * e : 0.f); } }
        __syncthreads();
#pragma unroll
        for (int i = 0; i < 8; ++i) { const int e = tid + 512 * i, r = e >> 6, c = e & 63; *(LAS bf16*)(Lb + r * 144 + c * 2) = (bf16)f2bf(Lm[r * 68 + c]); }
        if (wave == 0) { const int b = lane >> 4, c = lane & 15; float t[16]; const LAS float* Ld = Lm + (16 * b) * 68 + 16 * b;
#pragma unroll
            for (int i = 0; i < 16; ++i) { float acc = i == c ? 1.f : 0.f;
#pragma unroll
                for (int j = 0; j < i; ++j) acc -= Ld[i * 68 + j] * t[j];
                t[i] = acc; *(LAS bf16*)(TDs + (b * 16 + i) * 32 + c * 2) = (bf16)f2bf(acc); }
        } else if (wave >= 4) { const int t2 = tid - 256;
#pragma unroll
            for (int i = 0; i < 2; ++i) { const int p = t2 + 256 * i, comb = p >> 6, ln = p & 63, t = comb >> 2, s = comb & 3; const int c = 32 * t + (ln & 31), j0 = 16 * s + 8 * (ln >> 5);
                *(v4u*)(INF + (su * 8 + comb) * 512 + ln * 8) = *(const LAS v4u*)(IS + c * 72 + j0); }
            if ((hv & 1) == 0) { const size_t kunit = (size_t)hk * GDN_NCH + n;
#pragma unroll
                for (int i = 0; i < 4; ++i) { const int p = t2 + 256 * i, comb = p >> 6, ln = p & 63, kt = comb >> 2, s = comb & 3; const int kd = 32 * kt + (ln & 31), c0 = 16 * s + 8 * (ln >> 5);
                    unsigned w[4];
#pragma unroll
                    for (int jj = 0; jj < 4; ++jj) { const unsigned lo = *(const LAS bf16*)(kS + (c0 + 2 * jj) * 272 + kd * 2), hi = *(const LAS bf16*)(kS + (c0 + 2 * jj + 1) * 272 + kd * 2); w[jj] = lo | (hi << 16); }
                    *(v4u*)(KTF + (kunit * 16 + comb) * 512 + ln * 8) = (v4u){w[0], w[1], w[2], w[3]}; } }
            if (t2 < 64) GC[su * GC_STRIDE + t2] = gcS[t2];
            else if (t2 == 64) GC[su * GC_STRIDE + 64] = gcS[63];
            else if (t2 == 65) GC[su * GC_STRIDE + 65] = egcS[63];
        }
        __syncthreads();
        { const int quad = lane >> 4, lc = lane & 15; LAS unsigned char* XTw = XT0 + wave * 1792; LAS unsigned char* YTw = YT0 + wave * 768;
          const bf16x8 z8 = (bf16x8){0, 0, 0, 0, 0, 0, 0, 0}; const f32x4 z4 = (f32x4){0.f, 0.f, 0.f, 0.f};
          bf16x8 tdf[4];
#pragma unroll
          for (int b = 0; b < 4; ++b) tdf[b] = quad < 2 ? *(const LAS bf16x8*)(TDs + (b * 16 + lc) * 32 + quad * 16) : z8;
#pragma unroll 1
          for (int tl = 0; tl < 2; ++tl) { const int col = 32 * wave + 16 * tl + lc;
              const LAS unsigned char* rz = wave < 4 ? vS + col * 2 : kbS + (col - 128) * 2; const LAS float* bz = wave < 4 ? betaS : egcS;
#pragma unroll
              for (int b = 0; b < 4; ++b) { f32x4 y;
#pragma unroll
                  for (int r = 0; r < 4; ++r) { const int i = 16 * b + 4 * quad + r; y[r] = bf2f(*(const LAS bf16*)(rz + i * 272)) * bz[i]; }
                  if (b >= 1) { f32x4 p = z4;
#pragma unroll
                      for (int kk = 0; kk < (b >= 3 ? 2 : 1); ++kk) { const bf16x8 af = *(const LAS bf16x8*)(Lb + (16 * b + lc) * 144 + (32 * kk + 8 * quad) * 2);
                          const bf16x8 bfv = (32 * kk + 8 * quad < 16 * b) ? *(const LAS bf16x8*)(XTw + lc * 112 + (32 * kk + 8 * quad) * 2) : z8;
                          p = __builtin_amdgcn_mfma_f32_16x16x32_bf16(af, bfv, p, 0, 0, 0); }
                      y = y - p; }
                  *(LAS v2u*)(YTw + lc * 48 + quad * 8) = (v2u){pk2(y[0], y[1]), pk2(y[2], y[3])};
                  asm volatile("" ::: "memory");
                  const bf16x8 yb = quad < 2 ? *(const LAS bf16x8*)(YTw + lc * 48 + quad * 16) : z8;
                  const f32x4 x = __builtin_amdgcn_mfma_f32_16x16x32_bf16(tdf[b], yb, z4, 0, 0, 0);
                  if (b < 3) *(LAS v2u*)(XTw + lc * 112 + (16 * b + 4 * quad) * 2) = (v2u){pk2(x[0], x[1]), pk2(x[2], x[3])};
                  asm volatile("" ::: "memory");
#pragma unroll
                  for (int r = 0; r < 4; ++r) XS[(16 * b + 4 * quad + r) * 264 + col] = (bf16)f2bf(x[r]); } } }
        __syncthreads();
#pragma unroll
        for (int i = 0; i < 2; ++i) { const int p = tid + 512 * i, comb = p >> 6, ln = p & 63, t = comb >> 3, s = comb & 7; const int c = 32 * t + (ln & 31), k0 = 16 * s + 8 * (ln >> 5);
            *(v4u*)(WF + (su * 16 + comb) * 512 + ln * 8) = *(const LAS v4u*)(XS + c * 264 + 128 + k0); }
        { const int t = wave >> 2, ns = wave & 3; unsigned w[8];
#pragma unroll
          for (int r = 0; r < 8; ++r) { const unsigned lo = XS[(32 * t + crow(2 * r, h)) * 264 + 32 * ns + l31], hi = XS[(32 * t + crow(2 * r + 1, h)) * 264 + 32 * ns + l31]; w[r] = lo | (hi << 16); }
          bf16* dst = UF + ((su * 8 + wave) * 64 + lane) * 16; *(v4u*)dst = (v4u){w[0], w[1], w[2], w[3]}; *(v4u*)(dst + 8) = (v4u){w[4], w[5], w[6], w[7]}; }
        __syncthreads();
    }
}

DI void ph_gdn_chain(const Frame& F, const Args& a, int n_lo, int n_hi) {
    const int xg = F.vcu >> 5, wx = F.vcu & 31; if (F.G != 256 ? F.vcu >= 128 : wx >= 20) return;
    const bool helper = F.G == 256 && wx >= 16;
    const int hv = F.G == 256 ? 4 * xg + (helper ? wx - 16 : wx >> 2) : F.vcu >> 2, ns = F.G == 256 ? wx & 3 : F.vcu & 3, hk = hv >> 1;
    const bf16* QN = (const bf16*)(a.ws + WS_SCR + SC_QN);
    const bf16* WF = (const bf16*)(a.ws + GD_WF); const bf16* UF = (const bf16*)(a.ws + GD_UF); const bf16* INF = (const bf16*)(a.ws + GD_IN); const bf16* KTF = (const bf16*)(a.ws + GD_KT); const bf16* QF = (const bf16*)(a.ws + GD_QF); const float* GC = (const float*)(a.ws + GD_GC);
    bf16* O = (bf16*)(a.ws + WS_SCR + SC_O);
    gu32* prog = F.ctl + CW_PROG + hv * 16;
    if (helper && GDN_NO_HELPER) return;
    if (helper) { unsigned sink = 0u; const int tid = F.tid;
        for (int n0 = n_lo; n0 < n_hi; n0 += 4) {
            if (n0 >= n_lo + 8) { if (tid == 0) { unsigned sp = 0; while ((int)__hip_atomic_load(prog, RLX_AGENT) < n0 - 4 && ++sp < 20000u) __builtin_amdgcn_s_sleep(8); } __syncthreads(); }
            unsigned v[5];
#pragma unroll
            for (int i = 0; i < 5; ++i) { const int li = tid + 512 * i;
                const int st = li / 580, ln = li % 580, n = n0 + st; const unsigned* p = nullptr;
                if (st < 4 && n < n_hi) { const size_t unit = (size_t)hv * GDN_NCH + n, kunit = (size_t)hk * GDN_NCH + n;
                    if (ln < 128) p = (const unsigned*)(WF + unit * 8192 + ln * 64);
                    else if (ln < 256) p = (const unsigned*)(UF + unit * 8192 + (ln - 128) * 64);
                    else if (ln < 320) p = (const unsigned*)(INF + unit * 4096 + (ln - 256) * 64);
                    else if (ln < 448) p = (const unsigned*)(KTF + kunit * 8192 + (ln - 320) * 64);
                    else if (ln < 576) p = (const unsigned*)(QF + kunit * 8192 + (ln - 448) * 64);
                    else if (ln < 579) p = (const unsigned*)(GC + unit * GC_STRIDE + (ln - 576) * 32); }
                v[i] = p ? *p : 0u; }
#pragma unroll
            for (int i = 0; i < 5; ++i) sink += v[i];
        }
        if (sink == 0x12345u) __hip_atomic_store(F.ctl + CW_TMO + 2, sink, RLX_AGENT);
        return; }
    LAS unsigned char* ST = F.lds + RING_OFF; LAS unsigned char* VN = ST + 8704; LAS unsigned char* VND = ST + 13312;
    const int lane = F.lane, wave = F.wave, l31 = lane & 31, h = lane >> 5;
    for (int i = F.tid; i < 8704 / 4; i += NWAVES * 64) ((LAS unsigned*)ST)[i] = 0u;
#define GDN_BAR() do { asm volatile("s_waitcnt lgkmcnt(0)" ::: "memory"); __builtin_amdgcn_s_barrier(); asm volatile("" ::: "memory"); } while (0)
    GDN_BAR();
    f32x16 S;
#pragma unroll
    for (int r = 0; r < 16; ++r) S[r] = 0.f;
    const int role = wave < 2 ? 0 : (wave < 4 ? 1 : 2); const int t = wave & 1, kt = wave & 3;
    bf16x8 A8[8]; bf16x8 A4[4]; v4u U0 = (v4u){0u, 0u, 0u, 0u}, U1 = U0; f32x4 G4[4]; float gl = 0.f, egl = 1.f;
#pragma unroll
    for (int s = 0; s < 8; ++s) A8[s] = (bf16x8){0, 0, 0, 0, 0, 0, 0, 0};
#pragma unroll
    for (int s = 0; s < 4; ++s) { A4[s] = (bf16x8){0, 0, 0, 0, 0, 0, 0, 0}; G4[s] = (f32x4){0.f, 0.f, 0.f, 0.f}; }
#define GDN_LOAD(nn) do { const size_t unit_ = (size_t)hv * GDN_NCH + (nn); const float* gc_ = GC + unit_ * GC_STRIDE; \
        if (role == 0) { \
            const bf16* up_ = UF + (((unit_ * 2 + t) * 4 + ns) * 64 + lane) * 16; U0 = *(const v4u*)up_; U1 = *(const v4u*)(up_ + 8); \
            _Pragma("unroll") for (int g = 0; g < 4; ++g) G4[g] = *(const f32x4*)(gc_ + 32 * t + 8 * g + 4 * h); gl = gc_[64]; } \
        else if (role == 1) { const size_t qunit_ = (size_t)hk * GDN_NCH + (nn); \
            _Pragma("unroll") for (int s = 0; s < 4; ++s) A4[s] = *(const bf16x8*)(INF + ((unit_ * 2 + t) * 4 + s) * 512 + lane * 8); \
            _Pragma("unroll") for (int g = 0; g < 4; ++g) G4[g] = *(const f32x4*)(gc_ + 32 * t + 8 * g + 4 * h); } \
        else { const size_t kunit_ = (size_t)hk * GDN_NCH + (nn); \
            _Pragma("unroll") for (int s = 0; s < 4; ++s) A4[s] = *(const bf16x8*)(KTF + ((kunit_ * 4 + kt) * 4 + s) * 512 + lane * 8); egl = gc_[65]; } } while (0)
    float* SV = (float*)(a.ws + GD_SAVE) + ((size_t)((hv * 4 + ns) * 4 + kt) * 64 + lane) * 16;
    if (n_lo > 0 && role == 2) {
#pragma unroll
        for (int g = 0; g < 4; ++g) { const f32x4 v = *(const f32x4*)(SV + 4 * g); S[4 * g] = v.x; S[4 * g + 1] = v.y; S[4 * g + 2] = v.z; S[4 * g + 3] = v.w;
            *(LAS v2u*)(ST + l31 * 272 + (32 * kt + 8 * g + 4 * h) * 2) = (v2u){pk2(v.x, v.y), pk2(v.z, v.w)}; }
    }
    GDN_BAR();
#define GDN_LOADA(AC, nn) do { if (role == 0) { const size_t u_ = (size_t)hv * GDN_NCH + (nn); _Pragma("unroll") for (int s = 0; s < 8; ++s) AC[s] = *(const bf16x8*)(WF + ((u_ * 2 + t) * 8 + s) * 512 + lane * 8); } \
        else if (role == 1) { const size_t q_ = (size_t)hk * GDN_NCH + (nn); _Pragma("unroll") for (int s = 0; s < 8; ++s) AC[s] = *(const bf16x8*)(QF + ((q_ * 2 + t) * 8 + s) * 512 + lane * 8); } } while (0)
    bf16x8 A8q[8];
#pragma unroll
    for (int s = 0; s < 8; ++s) A8q[s] = (bf16x8){0, 0, 0, 0, 0, 0, 0, 0};
    GDN_LOADA(A8, n_lo); if (n_lo + 1 < n_hi) GDN_LOADA(A8q, n_lo + 1);
    GDN_LOAD(n_lo);
#define GDN_STEP(n, AC) do { \
        bf16x8 a4[4]; const v4u u0 = U0, u1 = U1; f32x4 g4[4]; const float cgl = gl, cegl = egl; \
        _Pragma("unroll") \
        for (int s = 0; s < 4; ++s) { a4[s] = A4[s]; g4[s] = G4[s]; } \
        if (n + 1 < n_hi) GDN_LOAD(n + 1); \
        if (ns == 0 && F.tid == 0) __hip_atomic_store(prog, (unsigned)n, RLX_AGENT); \
        f32x16 acc; \
        _Pragma("unroll") \
        for (int r = 0; r < 16; ++r) acc[r] = 0.f; \
        if (role < 2) { \
        _Pragma("unroll") \
            for (int s = 0; s < 8; ++s) acc = MFMA32(AC[s], *(const LAS bf16x8*)(ST + l31 * 272 + 32 * s + 16 * h), acc); \
            asm volatile("" :: "v"(acc[0])); \
            if (n + 2 < n_hi) GDN_LOADA(AC, n + 2); \
        } \
        if (role == 0) { const unsigned uw[8] = {u0.x, u0.y, u0.z, u0.w, u1.x, u1.y, u1.z, u1.w}; \
        _Pragma("unroll") \
            for (int g = 0; g < 4; ++g) { float vn[4], vd[4]; \
        _Pragma("unroll") \
                for (int q = 0; q < 4; ++q) { const int r = 4 * g + q; const float uv = (r & 1) ? bfhi(uw[r >> 1]) : bflo(uw[r >> 1]); vn[q] = uv - acc[r]; vd[q] = vn[q] * __expf(cgl - g4[g][q]); } \
                *(LAS v2u*)(VN + l31 * 144 + (32 * t + 8 * g + 4 * h) * 2) = (v2u){pk2(vn[0], vn[1]), pk2(vn[2], vn[3])}; \
                *(LAS v2u*)(VND + l31 * 144 + (32 * t + 8 * g + 4 * h) * 2) = (v2u){pk2(vd[0], vd[1]), pk2(vd[2], vd[3])}; } \
        } else if (role == 1) { \
        _Pragma("unroll") \
            for (int g = 0; g < 4; ++g) \
        _Pragma("unroll") \
                for (int q = 0; q < 4; ++q) acc[4 * g + q] *= __expf(g4[g][q]); \
        } \
        GDN_BAR(); \
        if (role == 1) { \
        _Pragma("unroll") \
            for (int s = 0; s < 4; ++s) acc = MFMA32(a4[s], *(const LAS bf16x8*)(VN + l31 * 144 + 32 * s + 16 * h), acc); \
        _Pragma("unroll") \
            for (int r = 0; r < 16; ++r) { const int rr = chunk_row(n, 32 * t + crow(r, h)); if (rr >= 0) O[(size_t)rr * 4096 + hv * 128 + 32 * ns + l31] = (bf16)f2bf(acc[r]); } \
        } else if (role == 2) { \
        _Pragma("unroll") \
            for (int r = 0; r < 16; ++r) S[r] *= cegl; \
        _Pragma("unroll") \
            for (int s = 0; s < 4; ++s) S = MFMA32(a4[s], *(const LAS bf16x8*)(VND + l31 * 144 + 32 * s + 16 * h), S); \
        _Pragma("unroll") \
            for (int g = 0; g < 4; ++g) *(LAS v2u*)(ST + l31 * 272 + (32 * kt + 8 * g + 4 * h) * 2) = (v2u){pk2(S[4 * g], S[4 * g + 1]), pk2(S[4 * g + 2], S[4 * g + 3])}; \
        } \
        GDN_BAR(); \
    } while (0)
    for (int n2 = n_lo; n2 < n_hi; n2 += 2) { GDN_STEP(n2, A8); if (n2 + 1 < n_hi) GDN_STEP(n2 + 1, A8q); }
#undef GDN_STEP
#undef GDN_LOADA
    if (n_hi < GDN_NCH && role == 2) {
#pragma unroll
        for (int g = 0; g < 4; ++g) *(f32x4*)(SV + 4 * g) = (f32x4){S[4 * g], S[4 * g + 1], S[4 * g + 2], S[4 * g + 3]}; }
#undef GDN_LOAD
#undef GDN_BAR
}

constexpr int RW_NSC = 258, RW_UNITS = 129 * 16;
DI int sub_row(int sc, int t) { const int n = sc >> 1, sub = sc & 1; return n == 0 ? ((sub == 0 && t >= 16) ? TX + t - 16 : -1) : 64 * (n - 1) + 32 * sub + t; }
constexpr size_t RW_BASE = WS_PROJ + 92 * MiB;
constexpr size_t RW_RH = RW_BASE, RW_RL = RW_BASE + 33 * MiB, RW_GT = RW_BASE + 66 * MiB, RW_GAM = RW_BASE + 99 * MiB;
constexpr size_t RW_PR = WS_SCR + 195 * MiB, RW_AT = WS_SCR + 211 * MiB + 256 * 1024, RW_VTF = WS_SCR + 219 * MiB + 512 * 1024, RW_SALL = WS_SCR + 235 * MiB + 768 * 1024;
constexpr size_t RW_XSAVE = 1 * MiB + 640 * 1024;
constexpr size_t RW_VV = WS_YMIX + 34 * MiB, RW_BON = WS_YMIX + 52 * MiB, LR_H = WS_YMIX + 54 * MiB, LR_A = WS_YMIX + 56 * MiB, LR_C = WS_YMIX + 58 * MiB;
constexpr size_t RW_SCH = (size_t)RW_NSC * 16;
static_assert((size_t)MP * EV_NP * 2 <= 92 * MiB && RW_SCH * 8192 <= 33 * MiB && RW_GAM + RW_SCH * 256 <= WS_SCR, "rwkv map (proj region)");
static_assert(WS_SCR + SC_LIX + (size_t)MP * 4096 <= RW_PR && RW_PR + RW_SCH * 4096 <= RW_AT && RW_AT + RW_SCH * 2048 <= RW_VTF && RW_VTF + RW_SCH * 4096 <= RW_SALL && RW_SALL + RW_SCH * 8192 <= WS_END, "rwkv map (scratch region)");
static_assert((size_t)MP * DM * 2 <= 34 * MiB && RW_VV + (size_t)MP * 2048 <= RW_BON && RW_BON + (size_t)MP * 64 <= LR_H && LR_H + RW_SCH * 256 <= LR_A && LR_A + RW_SCH * 256 <= LR_C && LR_C + RW_SCH * 256 <= WS_PROJ, "rwkv map (ymix region)");

DI void sub_rows(int sc, int& t0, int& rbase) { if (sc >= 2) { t0 = 0; rbase = 64 * ((sc >> 1) - 1) + 32 * (sc & 1); } else if (sc == 0) { t0 = 16; rbase = TX - 16; } else { t0 = 32; rbase = 0; } }
DI void lru_local(const Frame& F, const Args& a) {
    const bf16* LA = (const bf16*)(a.ws + WS_SCR + SC_LA); const bf16* LIX = (const bf16*)(a.ws + WS_SCR + SC_LIX);
    float* HL = (float*)(a.ws + LR_H); float* AP = (float*)(a.ws + LR_A);
    for (int item = F.gw; item < RW_NSC * 16; item += F.NGW) { const int sc = item >> 4, c = (item & 15) * 64 + F.lane; int t0, rbase; sub_rows(sc, t0, rbase);
        float av[32], ix[32];
#pragma unroll
        for (int t = 0; t < 32; ++t) { const size_t o = (size_t)(rbase + (t >= t0 ? t : 32)) * 1024 + c; av[t] = bf2f(LA[o]); ix[t] = bf2f(LIX[o]); }
        float h = 0.f, p = 1.f;
#pragma unroll
        for (int t = 0; t < 32; ++t) { const float om = t >= t0 ? av[t] : 0.f, x_ = t >= t0 ? ix[t] : 0.f, a_ = 1.0f - om; h = a_ * h + sqrtf(om * (1.0f + a_)) * x_; p *= a_; }
        HL[sc * 1024 + c] = h; AP[sc * 1024 + c] = p; }
}
DI void lru_apply(const Frame& F, const Args& a) {
    const bf16* P = (const bf16*)(a.ws + WS_PROJ); const bf16* LA = (const bf16*)(a.ws + WS_SCR + SC_LA); const bf16* LIX = (const bf16*)(a.ws + WS_SCR + SC_LIX);
    const float* CR = (const float*)(a.ws + LR_C); bf16* Y = (bf16*)(a.ws + WS_YMIX);
    for (int item = F.gw; item < RW_NSC * 16; item += F.NGW) { const int sc = item >> 4, c = (item & 15) * 64 + F.lane; int t0, rbase; sub_rows(sc, t0, rbase); if (t0 >= 32) continue;
        float h = CR[sc * 1024 + c];
#pragma unroll
        for (int tb = 0; tb < 32; tb += 16) { float av[16], ix[16], gb[16];
#pragma unroll
            for (int t = 0; t < 16; ++t) { const size_t r_ = (size_t)(rbase + (tb + t >= t0 ? tb + t : 32)); av[t] = bf2f(LA[r_ * 1024 + c]); ix[t] = bf2f(LIX[r_ * 1024 + c]); gb[t] = bf2f(P[r_ * EV_NP + EV_GB + c]); }
#pragma unroll
            for (int t = 0; t < 16; ++t) { if (tb + t >= t0) { const float a_ = 1.0f - av[t]; h = a_ * h + sqrtf(av[t] * (1.0f + a_)) * ix[t]; Y[(size_t)(rbase + tb + t) * DM + 1024 + c] = (bf16)f2bf(h * gelu_tanh(gb[t])); } } } }
}

DI void ph_rwkv_chunk(const Frame& F, const Args& a, int n_lo, int n_hi, int wg0) {
    if (F.vcu < wg0) return;
    const bf16* P = (const bf16*)(a.ws + WS_PROJ); const bf16* DEC = (const bf16*)(a.ws + WS_SCR + SC_DEC); const bf16* ICL = (const bf16*)(a.ws + WS_SCR + SC_ICL);
    bf16* RH = (bf16*)(a.ws + RW_RH); bf16* RL = (bf16*)(a.ws + RW_RL); bf16* GT = (bf16*)(a.ws + RW_GT); float* GAM = (float*)(a.ws + RW_GAM); bf16* PR = (bf16*)(a.ws + RW_PR); bf16* ATG = (bf16*)(a.ws + RW_AT); bf16* VTF = (bf16*)(a.ws + RW_VTF);
    bf16* VV = (bf16*)(a.ws + RW_VV); float* BON = (float*)(a.ws + RW_BON);
    LAS unsigned char* L = F.lds + RING_OFF;
    LAS float* wS = (LAS float*)L; LAS float* aS = wS + 4096; LAS float* bS = wS + 8192; LAS float* rS = wS + 12288; LAS float* kS = wS + 16384;
    LAS unsigned char* vT = L + 81920; LAS unsigned char* aT = L + 91136; LAS unsigned char* rT = L + 100352; LAS unsigned char* kT = L + 109568; LAS unsigned char* bT = L + 118784;
    LAS unsigned char* AT = L + 128000; LAS unsigned char* NT = L + 133120; LAS float* gam = (LAS float*)(L + 138240);
    LAS unsigned char* aTl = L; LAS unsigned char* bTl = L + 9216;
    const int tid = F.tid, lane = F.lane, wave = F.wave, l31 = lane & 31, h = lane >> 5;
    const float* mu = a.in[6];
    for (int unit = n_lo * 16 + (F.vcu - wg0); unit < n_hi * 16; unit += F.G - wg0) {
        const int n = unit >> 4, hd = unit & 15;
        { const int tok = tid >> 3, cg = tid & 7, c0 = hd * 64 + cg * 8; const int rr = sub_row(2 * n + (tok >> 5), tok & 31);
          float wv[8], av[8], bv[8], rv[8], kv[8], vv[8];
#pragma unroll
          for (int q = 0; q < 8; ++q) { wv[q] = 1.f; av[q] = 0.f; bv[q] = 0.f; rv[q] = 0.f; kv[q] = 0.f; vv[q] = 0.f; }
          if (rr >= 0) { const int pos = row_pos(rr); const bf16* cur = P + (size_t)rr * EV_NP + c0; const bf16* prv = pos > 0 ? P + (size_t)pos_row(pos - 1) * EV_NP + c0 : nullptr;
              const v4u z4 = (v4u){0u, 0u, 0u, 0u};
              const v4u cr = *(const v4u*)cur, ck = *(const v4u*)(cur + 1024), cv = *(const v4u*)(cur + 2048);
              const v4u qr = prv ? *(const v4u*)prv : z4, qk = prv ? *(const v4u*)(prv + 1024) : z4, qv = prv ? *(const v4u*)(prv + 2048) : z4;
              const unsigned crw[4] = {cr.x, cr.y, cr.z, cr.w}, ckw[4] = {ck.x, ck.y, ck.z, ck.w}, cvw[4] = {cv.x, cv.y, cv.z, cv.w}, qrw[4] = {qr.x, qr.y, qr.z, qr.w}, qkw[4] = {qk.x, qk.y, qk.z, qk.w}, qvw[4] = {qv.x, qv.y, qv.z, qv.w};
              float ss = 0.f, bon = 0.f; float kk[8], ic[8];
#pragma unroll
              for (int q = 0; q < 8; ++q) { const int c = c0 + q; const float crf = (q & 1) ? bfhi(crw[q >> 1]) : bflo(crw[q >> 1]), ckf = (q & 1) ? bfhi(ckw[q >> 1]) : bflo(ckw[q >> 1]), cvf = (q & 1) ? bfhi(cvw[q >> 1]) : bflo(cvw[q >> 1]);
                  const float prf = (q & 1) ? bfhi(qrw[q >> 1]) : bflo(qrw[q >> 1]), pkf = (q & 1) ? bfhi(qkw[q >> 1]) : bflo(qkw[q >> 1]), pvf = (q & 1) ? bfhi(qvw[q >> 1]) : bflo(qvw[q >> 1]);
                  rv[q] = crf + (prf - crf) * mu[c]; kk[q] = ckf + (pkf - ckf) * mu[1024 + c]; vv[q] = cvf + (pvf - cvf) * mu[2048 + c];
                  wv[q] = 1.0f - bf2f(DEC[(size_t)rr * 1024 + c]); ic[q] = bf2f(ICL[(size_t)rr * 1024 + c]);
                  const float kkv = kk[q] * a.in[12][c]; av[q] = kkv; ss += kkv * kkv; kv[q] = kk[q] * (1.0f + (ic[q] - 1.0f) * a.in[13][c]); bon += rv[q] * kv[q] * a.in[14][c]; }
              ss += __shfl_xor(ss, 1); ss += __shfl_xor(ss, 2); ss += __shfl_xor(ss, 4); bon += __shfl_xor(bon, 1); bon += __shfl_xor(bon, 2); bon += __shfl_xor(bon, 4);
              const float inv = 1.0f / fmaxf(sqrtf(ss), 1e-12f);
#pragma unroll
              for (int q = 0; q < 8; ++q) { const float kkn = av[q] * inv; av[q] = -kkn; bv[q] = kkn * ic[q]; }
              if (cg == 0) BON[(size_t)rr * 16 + hd] = bon;
              *(v4u*)(VV + (size_t)rr * 1024 + c0) = (v4u){pk2(vv[0], vv[1]), pk2(vv[2], vv[3]), pk2(vv[4], vv[5]), pk2(vv[6], vv[7])}; }
          const int o = tok * 64 + cg * 8;
          *(LAS f32x4*)(wS + o) = (f32x4){wv[0], wv[1], wv[2], wv[3]}; *(LAS f32x4*)(wS + o + 4) = (f32x4){wv[4], wv[5], wv[6], wv[7]};
          *(LAS f32x4*)(aS + o) = (f32x4){av[0], av[1], av[2], av[3]}; *(LAS f32x4*)(aS + o + 4) = (f32x4){av[4], av[5], av[6], av[7]};
          *(LAS f32x4*)(bS + o) = (f32x4){bv[0], bv[1], bv[2], bv[3]}; *(LAS f32x4*)(bS + o + 4) = (f32x4){bv[4], bv[5], bv[6], bv[7]};
          *(LAS f32x4*)(rS + o) = (f32x4){rv[0], rv[1], rv[2], rv[3]}; *(LAS f32x4*)(rS + o + 4) = (f32x4){rv[4], rv[5], rv[6], rv[7]};
          *(LAS f32x4*)(kS + o) = (f32x4){kv[0], kv[1], kv[2], kv[3]}; *(LAS f32x4*)(kS + o + 4) = (f32x4){kv[4], kv[5], kv[6], kv[7]};
#pragma unroll
          for (int q = 0; q < 8; ++q) *(LAS bf16*)(vT + (cg * 8 + q) * 144 + tok * 2) = (bf16)f2bf(vv[q]); }
        __syncthreads();
        { const int p = wave >> 2, sub = (wave >> 1) & 1, half = wave & 1, sl = lane >> 2, q = lane & 3, s = 16 * half + sl, tok = 32 * sub + s, jq = 16 * q;
          const LAS float* x0p = (p == 0 ? kS : bS) + tok * 64 + jq; LAS unsigned char* OUT = p == 0 ? AT : NT;
          float x[16];
#pragma unroll
          for (int j = 0; j < 16; j += 4) { const f32x4 t4 = *(const LAS f32x4*)(x0p + j); x[j] = t4.x; x[j + 1] = t4.y; x[j + 2] = t4.z; x[j + 3] = t4.w; }
          if (half) {
#pragma unroll
              for (int i = 0; i < 4; ++i) *(LAS bf16*)(OUT + ((sub * 32 + 4 * q + i) * 40 + s) * 2) = (bf16)0; }
#pragma unroll 2
          for (int tp = 16 * half; tp < 32; ++tp) { const LAS float* bp = wS + (32 * sub + tp) * 64 + jq; const bool run = tp > s;
              f32x4 a4[4], w4[4], b4[4], r4[4];
#pragma unroll
              for (int g = 0; g < 4; ++g) { a4[g] = *(const LAS f32x4*)(bp + 4096 + 4 * g); w4[g] = *(const LAS f32x4*)(bp + 4 * g); b4[g] = *(const LAS f32x4*)(bp + 8192 + 4 * g); r4[g] = *(const LAS f32x4*)(bp + 12288 + 4 * g); }
              float c = 0.f;
#pragma unroll
              for (int g = 0; g < 4; ++g) { c += x[4 * g] * a4[g].x; c += x[4 * g + 1] * a4[g].y; c += x[4 * g + 2] * a4[g].z; c += x[4 * g + 3] * a4[g].w; }
              c += __builtin_bit_cast(float, __builtin_amdgcn_mov_dpp(__builtin_bit_cast(int, c), 0xB1, 0xF, 0xF, true));
              c += __builtin_bit_cast(float, __builtin_amdgcn_mov_dpp(__builtin_bit_cast(int, c), 0x4E, 0xF, 0xF, true));
              float o = 0.f;
#pragma unroll
              for (int g = 0; g < 4; ++g) { const float n0 = x[4 * g] * w4[g].x + c * b4[g].x, n1 = x[4 * g + 1] * w4[g].y + c * b4[g].y, n2 = x[4 * g + 2] * w4[g].z + c * b4[g].z, n3 = x[4 * g + 3] * w4[g].w + c * b4[g].w;
                  x[4 * g] = run ? n0 : x[4 * g]; x[4 * g + 1] = run ? n1 : x[4 * g + 1]; x[4 * g + 2] = run ? n2 : x[4 * g + 2]; x[4 * g + 3] = run ? n3 : x[4 * g + 3];
                  o += x[4 * g] * r4[g].x; o += x[4 * g + 1] * r4[g].y; o += x[4 * g + 2] * r4[g].z; o += x[4 * g + 3] * r4[g].w; }
              o += __builtin_bit_cast(float, __builtin_amdgcn_mov_dpp(__builtin_bit_cast(int, o), 0xB1, 0xF, 0xF, true));
              o += __builtin_bit_cast(float, __builtin_amdgcn_mov_dpp(__builtin_bit_cast(int, o), 0x4E, 0xF, 0xF, true));
              if (q == 0) *(LAS bf16*)(OUT + ((sub * 32 + tp) * 40 + s) * 2) = (bf16)f2bf(tp >= s ? o : 0.f); }
          LAS unsigned char* XT = p == 0 ? kT : bT;
#pragma unroll
          for (int j = 0; j < 16; ++j) *(LAS bf16*)(XT + (jq + j) * 144 + tok * 2) = (bf16)f2bf(x[j]);
          const bool gwave = (p == 0 && half == 1); const int j = lane;
          if (gwave) { float g = 1.f;
#pragma unroll
              for (int tp = 0; tp < 32; ++tp) { const int tk = 32 * sub + tp; const float w_ = wS[tk * 64 + j], a_ = aS[tk * 64 + j], r_ = rS[tk * 64 + j];
                  *(LAS bf16*)(aT + j * 144 + tk * 2) = (bf16)f2bf(a_ * g);
                  g *= w_; *(LAS bf16*)(rT + j * 144 + tk * 2) = (bf16)f2bf(r_ * g); }
              gam[sub * 64 + j] = g; }
        }
        __syncthreads();
        { const int sub = wave >> 2, t1 = (wave >> 1) & 1, t0 = wave & 1; const size_t sch = (size_t)hd * RW_NSC + (2 * n + sub);
          { f32x16 acc;
#pragma unroll
            for (int r = 0; r < 16; ++r) acc[r] = 0.f;
#pragma unroll
            for (int ks = 0; ks < 2; ++ks) { const int ao = (32 * t1 + l31) * 144 + (32 * sub + 16 * ks + 8 * h) * 2, bo = (32 * t0 + l31) * 144 + (32 * sub + 16 * ks + 8 * h) * 2;
                acc = MFMA32(*(const LAS bf16x8*)(aT + ao), *(const LAS bf16x8*)(bT + bo), acc); }
            const int jp = 32 * t0 + l31;
#pragma unroll
            for (int g = 0; g < 4; ++g) *(v2u*)(RH + (sch * 64 + jp) * 64 + 32 * t1 + 8 * g + 4 * h) = (v2u){pk2(acc[4 * g], acc[4 * g + 1]), pk2(acc[4 * g + 2], acc[4 * g + 3])};
            if (t1 == 0 && t0 == 0) GAM[sch * 64 + lane] = gam[sub * 64 + lane]; }
          { f32x16 acc;
#pragma unroll
            for (int r = 0; r < 16; ++r) acc[r] = 0.f;
#pragma unroll
            for (int ks = 0; ks < 2; ++ks) acc = MFMA32(*(const LAS bf16x8*)(kT + (32 * t1 + l31) * 144 + (32 * sub + 16 * ks + 8 * h) * 2), *(const LAS bf16x8*)(vT + (32 * t0 + l31) * 144 + (32 * sub + 16 * ks + 8 * h) * 2), acc);
            bf16* dst = GT + ((sch * 4 + t1 * 2 + t0) * 64 + lane) * 16;
            *(v4u*)dst = (v4u){pk2(acc[0], acc[1]), pk2(acc[2], acc[3]), pk2(acc[4], acc[5]), pk2(acc[6], acc[7])}; *(v4u*)(dst + 8) = (v4u){pk2(acc[8], acc[9]), pk2(acc[10], acc[11]), pk2(acc[12], acc[13]), pk2(acc[14], acc[15])}; } }
        if (wave < 4) { const int sub = wave >> 1, jt = wave & 1; const size_t sch = (size_t)hd * RW_NSC + (2 * n + sub);
            f32x16 acc;
#pragma unroll
            for (int r = 0; r < 16; ++r) acc[r] = bf2f(*(const LAS bf16*)(rT + (32 * jt + crow(r, h)) * 144 + (32 * sub + l31) * 2));
#pragma unroll
            for (int ks = 0; ks < 2; ++ks) acc = MFMA32(*(const LAS bf16x8*)(aT + (32 * jt + l31) * 144 + (32 * sub + 16 * ks + 8 * h) * 2), *(const LAS bf16x8*)(NT + (sub * 32 + l31) * 80 + (16 * ks + 8 * h) * 2), acc);
#pragma unroll
            for (int g = 0; g < 4; ++g) *(v2u*)(PR + (sch * 32 + l31) * 64 + 32 * jt + 8 * g + 4 * h) = (v2u){pk2(acc[4 * g], acc[4 * g + 1]), pk2(acc[4 * g + 2], acc[4 * g + 3])};
        } else { const int t2 = tid - 256, sub = t2 >> 7, t = (t2 >> 2) & 31, s8 = (t2 & 3) * 8; const size_t sch = (size_t)hd * RW_NSC + (2 * n + sub);
            *(v4u*)(ATG + (sch * 32 + t) * 32 + s8) = *(const LAS v4u*)(AT + (sub * 32 + t) * 80 + s8 * 2); }
        { const int sub = tid >> 8, it = (tid >> 7) & 1, ks = (tid >> 6) & 1; const size_t sch = (size_t)hd * RW_NSC + (2 * n + sub);
          *(v4u*)(VTF + ((sch * 4 + it * 2 + ks) * 64 + lane) * 8) = *(const LAS v4u*)(vT + (32 * it + l31) * 144 + (32 * sub + 16 * ks + 8 * h) * 2); }
        __syncthreads();
    }
}

DI void ph_rwkv_chain(const Frame& F, const Args& a, int sc_lo, int sc_hi) {
    if (F.vcu >= 16 && F.vcu < 18) { if (sc_hi < RW_NSC) return; const int c = (F.vcu - 16) * 512 + F.tid; const float* HL = (const float*)(a.ws + LR_H); const float* AP = (const float*)(a.ws + LR_A); float* CR = (float*)(a.ws + LR_C);
        float carry = 0.f;
#pragma unroll 8
        for (int sc = 0; sc < RW_NSC; ++sc) { const float hl = HL[sc * 1024 + c], ap = AP[sc * 1024 + c]; CR[sc * 1024 + c] = carry; carry = ap * carry + hl; }
        return; }
    if (F.vcu >= 16) return;
    const int hd = F.vcu; const bf16* RH = (const bf16*)(a.ws + RW_RH); const bf16* RL = (const bf16*)(a.ws + RW_RL); const bf16* GT = (const bf16*)(a.ws + RW_GT); const float* GAM = (const float*)(a.ws + RW_GAM); bf16* SALL = (bf16*)(a.ws + RW_SALL);
    constexpr int RW_NS = 7, SLOT = 8192 + 8192 + 1024;
    LAS unsigned char* XS = F.lds + RING_OFF; LAS unsigned char* RG = XS + 2 * 9216;
    const int lane = F.lane, wave = F.wave, l31 = lane & 31, h = lane >> 5, jt = (wave >> 1) & 1, it = wave & 1, lw = wave & 3;
    for (int i = F.tid; i < 2 * 9216 / 4; i += NWAVES * 64) ((LAS unsigned*)XS)[i] = 0u;
    __syncthreads();
#define RW_BAR() do { asm volatile("s_waitcnt lgkmcnt(0)" ::: "memory"); __builtin_amdgcn_s_barrier(); asm volatile("" ::: "memory"); } while (0)
    const unsigned rg0 = (unsigned)(uintptr_t)RG;
    int offR[2], offG[2];
#pragma unroll
    for (int i = 0; i < 2; ++i) { const int b = 2 * lw + i, row = 8 * b + (lane >> 3), pc = lane & 7; offR[i] = row * 64 + ((pc ^ (row & 7)) * 8); offG[i] = (b * 64 + lane) * 8; }
    const int offM = (lane & 15) * 4;
#define RW_DMA(src, dst) do { unsigned keep_; asm volatile("s_mov_b32 %0, m0\n\ts_mov_b32 m0, %2\n\ts_nop 0\n\tglobal_load_lds_dwordx4 %1, off\n\ts_mov_b32 m0, %0" : "=&s"(keep_) : "v"(src), "s"(dst) : "memory"); } while (0)
#define RW_ISSUE(scn) do { const int s_ = (scn) < RW_NSC ? (scn) : RW_NSC - 1; const size_t sch_ = (size_t)hd * RW_NSC + s_; \
        const unsigned sb_ = (unsigned)__builtin_amdgcn_readfirstlane((int)(rg0 + (unsigned)((scn) % RW_NS) * SLOT)); \
        _Pragma("unroll") for (int i_ = 0; i_ < 2; ++i_) { const unsigned bo_ = (unsigned)__builtin_amdgcn_readfirstlane((2 * lw + i_) * 1024); \
            RW_DMA(RH + sch_ * 4096 + offR[i_], sb_ + bo_); RW_DMA(GT + sch_ * 4096 + offG[i_], sb_ + 8192 + bo_); } \
        RW_DMA(GAM + sch_ * 64 + offM, sb_ + 16384); } while (0)
#define RW_WAITV(n) asm volatile("s_waitcnt vmcnt(" #n ")" ::: "memory")
    f32x16 X;
#pragma unroll
    for (int r = 0; r < 16; ++r) X[r] = 0.f;
    float* XSV = (float*)(a.ws + RW_XSAVE) + ((size_t)(hd * 4 + (wave & 3)) * 64 + lane) * 16;
    if (wave < 4 && sc_lo > 0) {
#pragma unroll
        for (int g = 0; g < 4; ++g) { const f32x4 v = *(const f32x4*)(XSV + 4 * g); X[4 * g] = v.x; X[4 * g + 1] = v.y; X[4 * g + 2] = v.z; X[4 * g + 3] = v.w;
            *(LAS v2u*)(XS + (32 * it + l31) * 144 + (32 * jt + 8 * g + 4 * h) * 2) = (v2u){pk2(v.x, v.y), pk2(v.z, v.w)}; } }
    if (wave >= 4) { RW_ISSUE(sc_lo); RW_ISSUE(sc_lo + 1); RW_ISSUE(sc_lo + 2); RW_ISSUE(sc_lo + 3); RW_ISSUE(sc_lo + 4); RW_ISSUE(sc_lo + 5); RW_WAITV(25); }
    RW_BAR();
    for (int sc = sc_lo; sc < sc_hi; ++sc) {
        if (wave < 4) {
            const LAS unsigned char* sb = RG + (sc % RW_NS) * SLOT;
            f32x16 acc; const size_t sch = (size_t)hd * RW_NSC + sc;
            { const v4u g0 = *(const LAS v4u*)(sb + 8192 + ((jt * 2 + it) * 64 + lane) * 32), g1 = *(const LAS v4u*)(sb + 8192 + ((jt * 2 + it) * 64 + lane) * 32 + 16);
              const unsigned gw_[8] = {g0.x, g0.y, g0.z, g0.w, g1.x, g1.y, g1.z, g1.w};
#pragma unroll
              for (int g = 0; g < 4; ++g) { const f32x4 m = *(const LAS f32x4*)(sb + 16384 + (32 * jt + 8 * g + 4 * h) * 4);
                  acc[4 * g] = bflo(gw_[2 * g]) + m.x * X[4 * g]; acc[4 * g + 1] = bfhi(gw_[2 * g]) + m.y * X[4 * g + 1]; acc[4 * g + 2] = bflo(gw_[2 * g + 1]) + m.z * X[4 * g + 2]; acc[4 * g + 3] = bfhi(gw_[2 * g + 1]) + m.w * X[4 * g + 3]; } }
#pragma unroll
            for (int g = 0; g < 4; ++g) *(v2u*)(SALL + (sch * 64 + 32 * it + l31) * 64 + 32 * jt + 8 * g + 4 * h) = (v2u){pk2(X[4 * g], X[4 * g + 1]), pk2(X[4 * g + 2], X[4 * g + 3])};
            const LAS unsigned char* xb = XS + (sc & 1) * 9216 + (32 * it + l31) * 144 + 16 * h; const int ar = 32 * jt + l31; const LAS unsigned char* ab = sb + ar * 128;
#pragma unroll
            for (int ks = 0; ks < 4; ++ks) { const bf16x8 xf = *(const LAS bf16x8*)(xb + 32 * ks); const int po = (((2 * ks + h) ^ (ar & 7)) * 16);
                acc = MFMA32(*(const LAS bf16x8*)(ab + po), xf, acc); }
            X = acc;
            LAS unsigned char* xn = XS + ((sc + 1) & 1) * 9216 + (32 * it + l31) * 144;
#pragma unroll
            for (int g = 0; g < 4; ++g) *(LAS v2u*)(xn + (32 * jt + 8 * g + 4 * h) * 2) = (v2u){pk2(X[4 * g], X[4 * g + 1]), pk2(X[4 * g + 2], X[4 * g + 3])};
        } else {
            RW_ISSUE(sc + RW_NS - 1);
            RW_WAITV(25);
        }
        RW_BAR();
    }
    if (wave >= 4) RW_WAITV(0);
    else if (sc_hi < RW_NSC) {
#pragma unroll
        for (int g = 0; g < 4; ++g) *(f32x4*)(XSV + 4 * g) = (f32x4){X[4 * g], X[4 * g + 1], X[4 * g + 2], X[4 * g + 3]}; }
#undef RW_ISSUE
#undef RW_DMA
#undef RW_WAITV
#undef RW_BAR
}

DI f32x4 ld_bf4(const bf16* p) { const v2u w = *(const v2u*)p; return (f32x4){bflo(w.x), bfhi(w.x), bflo(w.y), bfhi(w.y)}; }
DI void ph_rwkv_out(const Frame& F, const Args& a) {
    const bf16* SALL = (const bf16*)(a.ws + RW_SALL); const bf16* PR = (const bf16*)(a.ws + RW_PR); const bf16* ATG = (const bf16*)(a.ws + RW_AT); const bf16* VTF = (const bf16*)(a.ws + RW_VTF);
    const bf16* VV = (const bf16*)(a.ws + RW_VV); const float* BON = (const float*)(a.ws + RW_BON); const bf16* GATE = (const bf16*)(a.ws + WS_SCR + SC_GATE); bf16* Y = (bf16*)(a.ws + WS_YMIX);
    const int lane = F.lane, l31 = lane & 31, h = lane >> 5;
    for (int item = F.gw; item < RW_NSC * 16; item += F.NGW) { const int sc = item >> 4, hd = item & 15; if (sc == 1) continue;
        const size_t sch = (size_t)hd * RW_NSC + sc; f32x16 acc[2];
#pragma unroll
        for (int it = 0; it < 2; ++it) {
#pragma unroll
            for (int r = 0; r < 16; ++r) acc[it][r] = 0.f;
#pragma unroll
            for (int ks = 0; ks < 4; ++ks) acc[it] = MFMA32(*(const bf16x8*)(SALL + (sch * 64 + 32 * it + l31) * 64 + 16 * ks + 8 * h), *(const bf16x8*)(PR + (sch * 32 + l31) * 64 + 16 * ks + 8 * h), acc[it]);
#pragma unroll
            for (int ks = 0; ks < 2; ++ks) acc[it] = MFMA32(*(const bf16x8*)(VTF + ((sch * 4 + it * 2 + ks) * 64 + lane) * 8), *(const bf16x8*)(ATG + (sch * 32 + l31) * 32 + 16 * ks + 8 * h), acc[it]); }
        float s1 = 0.f;
#pragma unroll
        for (int it = 0; it < 2; ++it)
#pragma unroll
            for (int r = 0; r < 16; ++r) s1 += acc[it][r];
        s1 += __shfl_xor(s1, 32); const float mean = s1 * (1.0f / 64.0f); float s2 = 0.f;
#pragma unroll
        for (int it = 0; it < 2; ++it)
#pragma unroll
            for (int r = 0; r < 16; ++r) { const float d = acc[it][r] - mean; s2 += d * d; }
        s2 += __shfl_xor(s2, 32); const float rstd = 1.0f / sqrtf(s2 * (1.0f / 64.0f) + 64e-5f);
        const int rr = sub_row(sc, l31);
        if (rr >= 0) { const float bon = BON[(size_t)rr * 16 + hd];
#pragma unroll
            for (int it = 0; it < 2; ++it)
#pragma unroll
                for (int g = 0; g < 4; ++g) { const int c = hd * 64 + 32 * it + 8 * g + 4 * h;
                    const f32x4 lw = *(const f32x4*)(a.in[15] + c), lb = *(const f32x4*)(a.in[16] + c), gt = ld_bf4(GATE + (size_t)rr * 1024 + c); const v2u vw = *(const v2u*)(VV + (size_t)rr * 1024 + c);
                    const float o0 = ((acc[it][4 * g] - mean) * rstd * lw.x + lb.x + bon * bflo(vw.x)) * gt.x, o1 = ((acc[it][4 * g + 1] - mean) * rstd * lw.y + lb.y + bon * bfhi(vw.x)) * gt.y;
                    const float o2 = ((acc[it][4 * g + 2] - mean) * rstd * lw.z + lb.z + bon * bflo(vw.y)) * gt.z, o3 = ((acc[it][4 * g + 3] - mean) * rstd * lw.w + lb.w + bon * bfhi(vw.y)) * gt.w;
                    *(v2u*)(Y + (size_t)rr * DM + c) = (v2u){pk2(o0, o1), pk2(o2, o3)}; } }
    }
    lru_apply(F, a);
}

constexpr int N_PHASES = 33;
template <class Epi, class Sched> DI void run_gemm(const Frame& F, const pg8::Gemm& g, const Sched& S, const Epi& E) {
    pg8::gemm_phase<Epi, Sched, true, true>(F.lds + RING_OFF, g, S, E);
}
DI void moe_up_units(const Frame& F, const Args& a, int t0, int ntl, int G, int c) {
    pg8::Gemm g{(const bf16*)(a.ws + WS_SCR + SC_XG), (const bf16*)(a.ws + WS_MOEW), DM, DM, DM};
    pg8::MoeOrder S{(const int*)(a.ws + WS_TILES), t0, ntl, 4, G, c, (long)MOE_E_BYTES};
    pg8::EpiSwiglu E{(bf16*)(a.ws + WS_SCR + SC_ACT), FF};
    run_gemm(F, g, S, E);
}
DI void moe_down_units(const Frame& F, const Args& a, int t0, int ntl, int G, int c) {
    pg8::Gemm g{(const bf16*)(a.ws + WS_SCR + SC_ACT), (const bf16*)(a.ws + WS_MOEW + MOE_W2_OFF), FF, FF, FF};
    pg8::MoeOrder S{(const int*)(a.ws + WS_TILES), t0, ntl, 8, G, c, (long)MOE_E_BYTES};
    pg8::EpiBf16 E{(bf16*)(a.ws + WS_SCR + SC_YB), DM};
    run_gemm(F, g, S, E);
}
DI void ph_moe_a(const Frame& F, const Args& a) {
    const int nt = (int)__hip_atomic_load((gu32*)(a.ws + WS_TILES) + 127, RLX_AGENT), n1 = nt < 64 ? nt : 64;
    moe_up_units(F, a, 0, n1, F.G, (int)blockIdx.x);
}
DI void ph_moe_b(const Frame& F, const Args& a) {
    const int nt = (int)__hip_atomic_load((gu32*)(a.ws + WS_TILES) + 127, RLX_AGENT), n1 = nt < 64 ? nt : 64; const int c = (int)blockIdx.x;
    int nu = 4 * (nt - n1); if (nu > F.G / 2) nu = F.G / 2;
    if (c < nu) moe_up_units(F, a, n1, nt - n1, nu, c); else moe_down_units(F, a, 0, n1, F.G - nu, c - nu);
}
DI void ph_moe_c(const Frame& F, const Args& a) {
    const int nt = (int)__hip_atomic_load((gu32*)(a.ws + WS_TILES) + 127, RLX_AGENT), n1 = nt < 64 ? nt : 64;
    moe_down_units(F, a, n1, nt - n1, F.G, (int)blockIdx.x);
}

DI void gemm_tail16(const Frame& F, const Args& a, const bf16* A, int lda, const bf16* Wt, int K, int mode) {
    if (F.vcu >= 128) return;
    const int lane = F.lane, lc = lane & 15, quad = lane >> 4, w = F.vcu; LAS float* red = (LAS float*)(F.lds + RING_OFF);
    f32x4 acc = (f32x4){0.f, 0.f, 0.f, 0.f}; const int kw = K / NWAVES, kb = F.wave * kw;
    const bf16* ap = A + (size_t)(TX + lc) * lda + kb + 8 * quad; const bf16* bp = Wt + (size_t)(16 * w + lc) * K + kb + 8 * quad;
#pragma unroll 4
    for (int ks = 0; ks < kw / 32; ++ks) acc = __builtin_amdgcn_mfma_f32_16x16x32_bf16(*(const bf16x8*)(ap + 32 * ks), *(const bf16x8*)(bp + 32 * ks), acc, 0, 0, 0);
    *(LAS f32x4*)(red + (F.wave * 64 + lane) * 4) = acc;
    __syncthreads();
    if (F.wave == 0) { f32x4 s = *(const LAS f32x4*)(red + lane * 4);
#pragma unroll
        for (int v = 1; v < NWAVES; ++v) s = s + *(const LAS f32x4*)(red + (v * 64 + lane) * 4);
        float* H = (float*)(a.ws + WS_H);
#pragma unroll
        for (int r = 0; r < 4; ++r) { const int row = 4 * quad + r, col = 16 * w + lc; const float base = mode ? H[(size_t)(TX + row) * DM + col] : a.in[1][(size_t)row * DM + col];
            H[(size_t)(TX + row) * DM + col] = base + s[r]; } }
    __syncthreads();
}

__global__ void __launch_bounds__(NWAVES * 64, 2) hyb_fwd(Args a) {
    extern __shared__ __attribute__((aligned(16))) unsigned char lds[];
    Frame F;
    F.lds = (LAS unsigned char*)lds;
    F.MISC = (volatile LAS unsigned*)(F.lds + MISC_OFF);
    F.tid = threadIdx.x; F.lane = F.tid & 63; F.wave = __builtin_amdgcn_readfirstlane(F.tid >> 6);
    F.G = gridDim.x; { const int bx = blockIdx.x; F.vcu = (F.G % 8 == 0) ? (bx % 8) * (F.G / 8) + bx / 8 : bx; }
    F.gw = F.vcu * NWAVES + F.wave; F.NGW = F.G * NWAVES;
    F.ctl = (gu32*)(a.ws + WS_CTL);
    for (int u = F.tid; u < (LDS_BYTES - LDSCTL_OFF) / 4; u += NWAVES * 64) ((LAS unsigned*)(F.lds + LDSCTL_OFF))[u] = 0u;
    __syncthreads();
    XcdBarrier bar; bar.bar = (unsigned*)(F.ctl + CW_BAR); bar.x = 0; bar.st = nullptr;
    if (MK_ONE_LAUNCH) bar = xcd_barrier_post((unsigned*)(F.ctl + CW_BAR), F.MISC + 8);
    const int lo = a.ph_lo, hi = a.ph_hi;
#ifndef PH_MASK
#define PH_MASK 0xFFFFFFFFFFFFFFFFull
#endif
#define IN(k) ((((unsigned long long)(PH_MASK) >> (k)) & 1ull) && lo <= (k) && (k) < hi)
#ifndef PROBE_REP
#define PROBE_REP 0u
#endif
#define REP(k) ((((unsigned long long)(PROBE_REP) >> (k)) & 1ull) ? 2 : 1)
#ifdef PROBE_TS
#define STAMP(k) do { if (blockIdx.x == 0 && F.tid == 0) ((unsigned long long*)(F.ctl + CW_TS))[(k)] = __builtin_amdgcn_s_memrealtime(); } while (0)
#else
#define STAMP(k) do { } while (0)
#endif
#define PHASE(k, ...) do { if (IN(k)) { { const int PH_REP_ = 0; (void)PH_REP_; __VA_ARGS__; } if (REP(k) == 2) { __syncthreads(); { const int PH_REP_ = 1; (void)PH_REP_; __VA_ARGS__; } } } } while (0)
#define SEAM(k) do { if (IN(k) && IN((k) + 1)) xcd_barrier(bar); STAMP((k) + 1); } while (0)
    const bf16* HN = (const bf16*)(a.ws + WS_HN); bf16* PROJ = (bf16*)(a.ws + WS_PROJ); const bf16* YMIX = (const bf16*)(a.ws + WS_YMIX); float* H = (float*)(a.ws + WS_H);

    STAMP(0);
    PHASE(0, { ph_prologue(F, a); ph_aux_convert(F, a, F.gw, F.NGW); });
    SEAM(0);
    PHASE(1, { pg8::Gemm g{HN, (const bf16*)(a.ws + WS_WEVIN), DM, DM, DM}; pg8::StaticOrder S; S.init(MP, EV_NP, F.G, (int)blockIdx.x); pg8::EpiBf16 E{PROJ, EV_NP}; run_gemm(F, g, S, E); });
    SEAM(1);
    PHASE(2, ph_even_prep(F, a););
    SEAM(2);
    PHASE(3, {
        { pg8::Gemm g{(const bf16*)(a.ws + WS_SCR + SC_ALORA), (const bf16*)(a.ws + WS_WLORA), 384, 384, 384}; pg8::StaticOrder S; S.init(MP, 3072, F.G, (int)blockIdx.x);
          static_assert(SC_ICL - SC_DEC == SC_GATE - SC_ICL, "lora outputs equally spaced");
          pg8::EpiLora E{(bf16*)(a.ws + WS_SCR + SC_DEC), (long)((SC_ICL - SC_DEC) / 2), a.in[7], a.in[9]}; run_gemm(F, g, S, E); }
        { pg8::Gemm g{(const bf16*)(a.ws + WS_SCR + SC_XR), (const bf16*)(a.ws + WS_WGATE), 256, 1024, 256}; pg8::StaticOrder S; S.init(MP, 2048, F.G, (int)blockIdx.x); S.amod = 4; S.astep = 512;
          pg8::EpiGates E{(bf16*)(a.ws + WS_SCR + SC_LA), (bf16*)(a.ws + WS_SCR + SC_LIX), a.in[20], a.in[22], a.in[23], (const bf16*)(a.ws + WS_SCR + SC_XR)}; run_gemm(F, g, S, E); }
    });
    SEAM(3);
    PHASE(4, { lru_local(F, a); ph_rwkv_chunk(F, a, 0, 32, 0); });
    SEAM(4);
    PHASE(5, { if (F.vcu < 16) ph_rwkv_chain(F, a, 0, 64); else ph_rwkv_chunk(F, a, 32, 62, 16); });
    SEAM(5);
    PHASE(6, { if (F.vcu < 16) ph_rwkv_chain(F, a, 64, 124); else ph_rwkv_chunk(F, a, 62, 92, 16); });
    SEAM(6);
    PHASE(7, { if (F.vcu < 16) ph_rwkv_chain(F, a, 124, 184); else ph_rwkv_chunk(F, a, 92, 122, 16); });
    SEAM(7);
    PHASE(8, { if (F.vcu < 16) ph_rwkv_chain(F, a, 184, 244); else ph_rwkv_chunk(F, a, 122, 129, 16); });
    SEAM(8);
    PHASE(9, { if (F.vcu < 18) ph_rwkv_chain(F, a, 244, RW_NSC); });
    SEAM(9);
    PHASE(10, ph_rwkv_out(F, a););
    SEAM(10);
    PHASE(11, { pg8::Gemm g{YMIX, (const bf16*)(a.ws + WS_WEVOUT), DM, DM, DM}; pg8::StaticOrder S; S.init(TX, DM, F.G, (int)blockIdx.x); pg8::EpiResid E{H, a.in[0], a.in[1], 0}; run_gemm(F, g, S, E); gemm_tail16(F, a, YMIX, DM, (const bf16*)(a.ws + WS_WEVOUT), DM, 0); });
    SEAM(11);
    PHASE(12, ph_route(F, a, 0, PH_REP_););
    SEAM(12);
    PHASE(13, ph_gather(F, a, 0););
    SEAM(13);
    PHASE(14, ph_moe_a(F, a););
    SEAM(14);
    PHASE(15, ph_moe_b(F, a););
    SEAM(15);
    PHASE(16, ph_moe_c(F, a););
    SEAM(16);
    PHASE(17, ph_combine(F, a, 0););
    SEAM(17);
    PHASE(18, { pg8::Gemm g{HN, (const bf16*)(a.ws + WS_WODIN), DM, DM, DM}; pg8::StaticOrder S; S.init(MP, OD_NP, F.G, (int)blockIdx.x); pg8::EpiBf16 E{PROJ, OD_NP}; run_gemm(F, g, S, E); });
    SEAM(18);
    PHASE(19, ph_odd_prep(F, a););
    SEAM(19);
    PHASE(20, ph_gdn_chunk(F, a, 0, 33, 0););
    SEAM(20);
    PHASE(21, { ph_gdn_chain(F, a, 0, 33); ph_gdn_chunk(F, a, 33, 65, 1); });
    SEAM(21);
    PHASE(22, { ph_gdn_chain(F, a, 33, 65); ph_gdn_chunk(F, a, 65, 97, 1); });
    SEAM(22);
    PHASE(23, { ph_gdn_chain(F, a, 65, 97); ph_gdn_chunk(F, a, 97, 129, 1); });
    SEAM(23);
    PHASE(24, { ph_gdn_chain(F, a, 97, 129); ph_odd_post(F, a, 0); });
    SEAM(24);
    PHASE(25, { ph_odd_post(F, a, F.G == 256 ? 1 : 2); moe_convert(F, a, 1, F.gw, F.NGW); });
    SEAM(25);
    PHASE(26, { pg8::Gemm g{YMIX, (const bf16*)(a.ws + WS_WODOUT), 4096, 4096, 4096}; pg8::StaticOrder S; S.init(TX, DM, F.G, (int)blockIdx.x); pg8::EpiResid E{H, a.in[0], a.in[1], 1}; run_gemm(F, g, S, E); gemm_tail16(F, a, YMIX, 4096, (const bf16*)(a.ws + WS_WODOUT), 4096, 1); });
    SEAM(26);
    PHASE(27, ph_route(F, a, 1, PH_REP_););
    SEAM(27);
    PHASE(28, ph_gather(F, a, 1););
    SEAM(28);
    PHASE(29, ph_moe_a(F, a););
    SEAM(29);
    PHASE(30, ph_moe_b(F, a););
    SEAM(30);
    PHASE(31, ph_moe_c(F, a););
    SEAM(31);
    PHASE(32, ph_combine(F, a, 1););
#ifdef PROBE_BARS
    for (int i_ = 0; i_ < PROBE_BARS; ++i_) xcd_barrier(bar);
#endif
#undef IN
#undef SEAM
}

extern "C" void kernel_launch(void* const* d_in, const int* in_sizes, int n_in, void* d_out, int out_size, void* d_ws, size_t ws_size, hipStream_t stream) {
    static int grid = 0;
    if (grid == 0) {
        if (n_in != 36 || out_size != TX * DM || ws_size < WS_END) { fprintf(stderr, "kernel_launch: unexpected shapes (n_in %d, out %d, ws %zu)\n", n_in, out_size, ws_size); grid = -1; return; }
        int dev = 0, cus = 0, per_cu = 0;
        if (hipGetDevice(&dev) != hipSuccess || hipDeviceGetAttribute(&cus, hipDeviceAttributeMultiprocessorCount, dev) != hipSuccess) { grid = -1; return; }
        if (hipFuncSetAttribute((const void*)hyb_fwd, hipFuncAttributeMaxDynamicSharedMemorySize, LDS_BYTES) != hipSuccess) { fprintf(stderr, "kernel_launch: hipFuncSetAttribute failed\n"); grid = -1; return; }
        if (hipOccupancyMaxActiveBlocksPerMultiprocessor(&per_cu, (const void*)hyb_fwd, NWAVES * 64, LDS_BYTES) != hipSuccess || per_cu < 1) { fprintf(stderr, "kernel_launch: occupancy query says %d\n", per_cu); per_cu = 1; }
        (void)hipGetLastError();
        grid = cus;
    }
    if (grid < 0) return;
    if (hipMemsetAsync((char*)d_ws + WS_CTL, 0, CTL_ZERO_BYTES, stream) != hipSuccess) return;
    Args a{};
    for (int i = 0; i < 36; ++i) a.in[i] = (const float*)d_in[i];
    a.out = (float*)d_out; a.ws = (unsigned char*)d_ws;
#if MK_ONE_LAUNCH
    a.ph_lo = 0; a.ph_hi = N_PHASES;
    hipLaunchKernelGGL(hyb_fwd, dim3(grid), dim3(NWAVES * 64), LDS_BYTES, stream, a);
#else
    for (int p = 0; p < N_PHASES; ++p) { a.ph_lo = p; a.ph_hi = p + 1; hipLaunchKernelGGL(hyb_fwd, dim3(grid), dim3(NWAVES * 64), LDS_BYTES, stream, a); }
#endif
}
```

```cpp
#include <hip/hip_runtime.h>
#include <cstdio>
#include <cstdint>
#include <cmath>

#ifndef MK_ONE_LAUNCH
#define MK_ONE_LAUNCH 1
#endif

namespace pg8 {
#define PG8_LAS __attribute__((address_space(3)))
typedef unsigned short bf16_t;
typedef short bf16x8 __attribute__((ext_vector_type(8)));
typedef float f32x4 __attribute__((ext_vector_type(4)));
typedef unsigned u32x4 __attribute__((ext_vector_type(4)));
typedef unsigned u32x2 __attribute__((ext_vector_type(2)));
constexpr int BM = 256, BK = 64, HALF = 128, HTB = HALF * BK * 2  , STAGE_BYTES = 8 * HTB, NXCD = 8, WGM = 8;

__host__ __device__ __forceinline__ int lds_byte(int r, int c) { const int st = (r >> 4) * 2 + (c >> 5), rr = r & 15, cc = c & 31, ob = rr * 64 + cc * 2; return st * 1024 + (ob ^ (((ob >> 9) & 1) << 5)); }
__host__ __device__ __forceinline__ void stage_rc(int b, int& R, int& C) { const int st = b / 1024, sb = b % 1024, swz = sb ^ (((sb >> 9) & 1) << 5); R = (st >> 1) * 16 + swz / 64; C = (st & 1) * 32 + (swz % 64) / 2; }
__host__ __device__ __forceinline__ int perm32(int rho) { const int n = rho >> 4, i = rho & 15; return 8 * (i >> 2) + 4 * n + (i & 3); }

struct Unit { int pm, pn; long aoff, boff; };
struct Gemm { const bf16_t* A; const bf16_t* Bt; int K, lda, ldb; };

struct StaticOrder {
    int nM, nN, nwg, G, c, amod; long astep;
    __host__ __device__ void init(int M, int N, int G_, int c_) { nM = M / BM; nN = N / BM; nwg = nM * nN; G = G_; c = c_; amod = 0; astep = 0; }
    __host__ __device__ bool next(int i, Unit& u) const {
        const long L = (long)i * G + c; if (L >= nwg) return false;
        int wgid = (int)L; { const int q = nwg / NXCD, r = nwg % NXCD, xcd = wgid % NXCD, off = wgid / NXCD; wgid = (xcd < r ? xcd * (q + 1) : r * (q + 1) + (xcd - r) * q) + off; }
        const int nig = WGM * nN, gid = wgid / nig, fm = gid * WGM, gsz = (nM - fm) < WGM ? (nM - fm) : WGM;
        u.pm = fm + ((wgid % nig) % gsz); u.pn = (wgid % nig) / gsz; u.boff = 0; u.aoff = amod ? (long)(u.pn % amod) * astep : 0; return true;
    }
    __device__ __forceinline__ void a_ready(const Unit&) const {}
    __device__ __forceinline__ void done(const Unit&) const {}
};
struct MoeOrder {
    const int* tile_e; int t0, ntiles, npn, G, c; long bstride;
    __device__ __forceinline__ bool next(int i, Unit& u) const {
        const long L = (long)i * G + c; if (c < 0 || L >= (long)ntiles * npn) return false;
        const int t = t0 + (int)(L / npn); u.pm = t; u.pn = (int)(L % npn); u.aoff = 0; u.boff = (long)tile_e[t] * bstride; return true;
    }
    __device__ __forceinline__ void a_ready(const Unit&) const {}
    __device__ __forceinline__ void done(const Unit&) const {}
};

__device__ __forceinline__ unsigned cvt_pk_bf16(float lo, float hi) { unsigned r; asm volatile("v_cvt_pk_bf16_f32 %0, %1, %2" : "=v"(r) : "v"(lo), "v"(hi)); return r; }
__device__ __forceinline__ float bf_lo(unsigned w) { return __uint_as_float(w << 16); }
__device__ __forceinline__ float bf_hi(unsigned w) { return __uint_as_float(w & 0xffff0000u); }
__device__ __forceinline__ float sigmoidf_(float x) { return __builtin_amdgcn_rcpf(1.0f + __expf(-x)); }
__device__ __forceinline__ float softplusf_(float x) { return fmaxf(x, 0.f) + __logf(1.0f + __expf(-fabsf(x))); }

struct EpiBf16 {
    static constexpr bool PERM = true, AFTER_DRAIN = false;
    bf16_t* O; int ldc;
    __device__ __forceinline__ void operator()(const f32x4 (&acc)[2][2][4][2], const Unit& u, int wr, int wc, int fr, int fq) const {
        const int row0 = u.pm * BM + wr * 64 + fr; const int col0 = u.pn * BM + wc * 32 + 8 * fq;
#pragma unroll
        for (int ai = 0; ai < 2; ++ai)
#pragma unroll
            for (int m = 0; m < 4; ++m) { bf16_t* rowp = O + (size_t)(row0 + ai * HALF + m * 16) * ldc + col0;
#pragma unroll
                for (int bj = 0; bj < 2; ++bj) { const f32x4 v0 = acc[ai][bj][m][0], v1 = acc[ai][bj][m][1];
                    u32x4 w; w.x = cvt_pk_bf16(v0[0], v0[1]); w.y = cvt_pk_bf16(v0[2], v0[3]); w.z = cvt_pk_bf16(v1[0], v1[1]); w.w = cvt_pk_bf16(v1[2], v1[3]);
                    *(u32x4*)(rowp + bj * HALF) = w; } }
    }
};
struct EpiSwiglu {
    static constexpr bool PERM = true, AFTER_DRAIN = false;
    bf16_t* O; int ldc;
    __device__ __forceinline__ void operator()(const f32x4 (&acc)[2][2][4][2], const Unit& u, int wr, int wc, int fr, int fq) const {
        const int row0 = u.pm * BM + wr * 64 + fr; const int col0 = u.pn * HALF + wc * 32 + 8 * fq;
#pragma unroll
        for (int ai = 0; ai < 2; ++ai)
#pragma unroll
            for (int m = 0; m < 4; ++m) { bf16_t* rowp = O + (size_t)(row0 + ai * HALF + m * 16) * ldc + col0;
                float o[8];
#pragma unroll
                for (int n = 0; n < 2; ++n)
#pragma unroll
                    for (int j = 0; j < 4; ++j) { const float gq = acc[ai][0][m][n][j], uq = acc[ai][1][m][n][j]; o[4 * n + j] = gq * sigmoidf_(gq) * uq; }
                u32x4 w; w.x = cvt_pk_bf16(o[0], o[1]); w.y = cvt_pk_bf16(o[2], o[3]); w.z = cvt_pk_bf16(o[4], o[5]); w.w = cvt_pk_bf16(o[6], o[7]);
                *(u32x4*)rowp = w; }
    }
};
struct EpiResid {
    static constexpr bool PERM = false, AFTER_DRAIN = false;
    float* out; const float* x; const float* meta; int mode;
    __device__ __forceinline__ void operator()(const f32x4 (&acc)[2][2][4][2], const Unit& u, int wr, int wc, int fr, int fq) const {
        const int row0 = u.pm * BM + wr * 64 + fr, col0 = u.pn * BM + wc * 32 + 4 * fq;
#pragma unroll
        for (int ai = 0; ai < 2; ++ai)
#pragma unroll
            for (int m = 0; m < 4; ++m) { const int row = row0 + ai * HALF + m * 16; float* rowp = out + (size_t)row * 2048 + col0;
                const float* bp = mode ? rowp : (row < 8192 ? x + (size_t)row * 2048 + col0 : (row < 8208 ? meta + (size_t)(row - 8192) * 2048 + col0 : nullptr));
#pragma unroll
                for (int bj = 0; bj < 2; ++bj)
#pragma unroll
                    for (int n = 0; n < 2; ++n) { f32x4 b = (f32x4){0.f, 0.f, 0.f, 0.f}; if (bp) b = *(const f32x4*)(bp + bj * HALF + n * 16);
                        *(f32x4*)(rowp + bj * HALF + n * 16) = acc[ai][bj][m][n] + b; } }
    }
};
__device__ __forceinline__ float one_minus_exp_neg(float e) { return e < 0.05f ? e * (1.0f - e * (0.5f - e * (1.0f / 6.0f))) : 1.0f - __expf(-e); }
struct EpiLora {
    static constexpr bool PERM = false, AFTER_DRAIN = false;
    bf16_t* base; long gstride; const float* w0; const float* a0;
    __device__ __forceinline__ void operator()(const f32x4 (&acc)[2][2][4][2], const Unit& u, int wr, int wc, int fr, int fq) const {
        const int grp = u.pn >> 2; const int row0 = u.pm * BM + wr * 64 + fr, col0 = (u.pn & 3) * BM + wc * 32 + 4 * fq;
        bf16_t* O = base + (size_t)grp * gstride;
#pragma unroll
        for (int bj = 0; bj < 2; ++bj)
#pragma unroll
            for (int n = 0; n < 2; ++n) { const int c = col0 + bj * HALF + n * 16;
                f32x4 bv = (f32x4){0.f, 0.f, 0.f, 0.f}; if (grp == 0) bv = *(const f32x4*)(w0 + c); else if (grp == 1) bv = *(const f32x4*)(a0 + c);
#pragma unroll
                for (int ai = 0; ai < 2; ++ai)
#pragma unroll
                    for (int m = 0; m < 4; ++m) { f32x4 v = acc[ai][bj][m][n] + bv;
                        if (grp == 0) {
#pragma unroll
                            for (int j = 0; j < 4; ++j) { const float wl = -softplusf_(-v[j]) - 0.5f; v[j] = one_minus_exp_neg(__expf(wl)); }
                        } else if (grp == 1) {
#pragma unroll
                            for (int j = 0; j < 4; ++j) v[j] = sigmoidf_(v[j]);
                        }
                        u32x2 w; w.x = cvt_pk_bf16(v[0], v[1]); w.y = cvt_pk_bf16(v[2], v[3]);
                        *(u32x2*)(O + (size_t)(row0 + ai * HALF + m * 16) * 1024 + c) = w; } }
    }
};
struct EpiGates {
    static constexpr bool PERM = false, AFTER_DRAIN = false;
    bf16_t* lru_a; bf16_t* lru_ix; const float* ba; const float* bx; const float* lam; const bf16_t* xr;
    __device__ __forceinline__ void operator()(const f32x4 (&acc)[2][2][4][2], const Unit& u, int wr, int wc, int fr, int fq) const {
        const int grp = u.pn >> 2; const int row0 = u.pm * BM + wr * 64 + fr, col0 = (u.pn & 3) * BM + wc * 32 + 4 * fq;
#pragma unroll
        for (int bj = 0; bj < 2; ++bj)
#pragma unroll
            for (int n = 0; n < 2; ++n) { const int c = col0 + bj * HALF + n * 16;
                const f32x4 bv = *(const f32x4*)((grp == 0 ? ba : bx) + c); f32x4 sp = (f32x4){0.f, 0.f, 0.f, 0.f};
                if (grp == 0) { const f32x4 l = *(const f32x4*)(lam + c);
#pragma unroll
                    for (int j = 0; j < 4; ++j) sp[j] = 8.0f * softplusf_(-l[j]); }
#pragma unroll
                for (int ai = 0; ai < 2; ++ai)
#pragma unroll
                    for (int m = 0; m < 4; ++m) { const int row = row0 + ai * HALF + m * 16; f32x4 v = acc[ai][bj][m][n] + bv; u32x2 w;
                        if (grp == 0) {
#pragma unroll
                            for (int j = 0; j < 4; ++j) v[j] = one_minus_exp_neg(sigmoidf_(v[j]) * sp[j]);
                            w.x = cvt_pk_bf16(v[0], v[1]); w.y = cvt_pk_bf16(v[2], v[3]); *(u32x2*)(lru_a + (size_t)row * 1024 + c) = w;
                        } else { const u32x2 xw = *(const u32x2*)(xr + (size_t)row * 1024 + c);
                            v[0] = sigmoidf_(v[0]) * bf_lo(xw.x); v[1] = sigmoidf_(v[1]) * bf_hi(xw.x); v[2] = sigmoidf_(v[2]) * bf_lo(xw.y); v[3] = sigmoidf_(v[3]) * bf_hi(xw.y);
                            w.x = cvt_pk_bf16(v[0], v[1]); w.y = cvt_pk_bf16(v[2], v[3]); *(u32x2*)(lru_ix + (size_t)row * 1024 + c) = w; } } }
    }
};

template <class Epi, class Sched, bool ALIGN_EPI = false, bool SP2 = false>
__device__ __forceinline__ void gemm_phase(PG8_LAS unsigned char* lds, const Gemm g, const Sched& S, const Epi& E) {
    const int tid = threadIdx.x, wid = __builtin_amdgcn_readfirstlane(tid >> 6), lane = tid & 63, wr = wid >> 2, wc = wid & 3, fr = lane & 15, fq = lane >> 4;
    const int K = g.K, nt = K / BK;
    unsigned voffA[2], voffB[2];
#pragma unroll
    for (int i = 0; i < 2; ++i) { int R, C; stage_rc(tid * 16 + i * 8192, R, C); const int Rb = Epi::PERM ? ((R & ~31) + perm32(R & 31)) : R;
        voffA[i] = (unsigned)(R * g.lda + C) * 2u; voffB[i] = (unsigned)(Rb * g.ldb + C) * 2u; }
    const size_t kstep = (size_t)(BK * 2);
    const size_t hstepA = (size_t)HALF * g.lda * 2, hstepB = (size_t)HALF * g.ldb * 2;
    const size_t tstepA = 2 * hstepA, tstepB = 2 * hstepB;
    const unsigned ldsw = (unsigned)wid * 1024u;
    const int aoff = lds_byte(wr * 64 + fr, fq * 8), boff = lds_byte(wc * 32 + fr, fq * 8);
#define PG8_SA(b, h) (((b) * 2 + (h)) * HTB)
#define PG8_SB(b, h) ((4 + (b) * 2 + (h)) * HTB)
#define PG8_STAGE(bufoff, gbase, voff) do { _Pragma("unroll") for (int _i = 0; _i < 2; ++_i) \
        __builtin_amdgcn_global_load_lds((const unsigned*)((const char*)(gbase) + (voff)[_i]), (PG8_LAS unsigned*)(lds + (bufoff) + ldsw + _i * 8192), 16, 0, 0); } while (0)
#define PG8_LDA(dst, b, h) do { _Pragma("unroll") for (int m = 0; m < 4; ++m) _Pragma("unroll") for (int k = 0; k < 2; ++k) dst[m][k] = *(const PG8_LAS bf16x8*)(lds + PG8_SA(b, h) + aoff + m * 2048 + k * 1024); } while (0)
#define PG8_LDB(dst, b, h) do { _Pragma("unroll") for (int n = 0; n < 2; ++n) _Pragma("unroll") for (int k = 0; k < 2; ++k) dst[n][k] = *(const PG8_LAS bf16x8*)(lds + PG8_SB(b, h) + boff + n * 2048 + k * 1024); } while (0)
#define PG8_MMA(ai, bj, At, Bt) do { __builtin_amdgcn_s_setprio(1); _Pragma("unroll") for (int m = 0; m < 4; ++m) _Pragma("unroll") for (int n = 0; n < 2; ++n) _Pragma("unroll") for (int k = 0; k < 2; ++k) \
        acc[ai][bj][m][n] = __builtin_amdgcn_mfma_f32_16x16x32_bf16(Bt[n][k], At[m][k], acc[ai][bj][m][n], 0, 0, 0); __builtin_amdgcn_s_setprio(0); } while (0)
#define PG8_WAIT_V(n) asm volatile("s_waitcnt vmcnt(" #n ")" ::: "memory")
#define PG8_WAIT_L(n) asm volatile("s_waitcnt lgkmcnt(" #n ")" ::: "memory")
#define PG8_BAR __builtin_amdgcn_s_barrier()
#define PG8_SCHED __builtin_amdgcn_sched_barrier(0)
    Unit cur, nxt; int ui = 0;
    if (!S.next(0, cur)) return;
    f32x4 acc[2][2][4][2];
#pragma unroll
    for (int a = 0; a < 2; ++a)
#pragma unroll
        for (int b = 0; b < 2; ++b)
#pragma unroll
            for (int m = 0; m < 4; ++m)
#pragma unroll
                for (int n = 0; n < 2; ++n) acc[a][b][m][n] = (f32x4){0.f, 0.f, 0.f, 0.f};
    bf16x8 At[4][2], B0[2][2], B1[2][2];
    const char* cA = (const char*)g.A + (size_t)cur.pm * tstepA + cur.aoff; const char* cB = (const char*)g.Bt + (size_t)cur.pn * tstepB + cur.boff;
    S.a_ready(cur);
    if constexpr (SP2) {
        PG8_STAGE(PG8_SB(0, 0), cB, voffB); PG8_STAGE(PG8_SB(0, 1), cB + hstepB, voffB); PG8_STAGE(PG8_SA(0, 0), cA, voffA); PG8_STAGE(PG8_SA(0, 1), cA + hstepA, voffA);
        if (wr == 1) PG8_BAR;
        PG8_WAIT_V(2); PG8_BAR;
        PG8_STAGE(PG8_SB(1, 0), cB + kstep, voffB); PG8_STAGE(PG8_SA(1, 0), cA + kstep, voffA); PG8_STAGE(PG8_SB(1, 1), cB + hstepB + kstep, voffB);
        PG8_WAIT_V(6); PG8_BAR;
    } else {
        PG8_STAGE(PG8_SB(0, 0), cB, voffB); PG8_STAGE(PG8_SA(0, 0), cA, voffA); PG8_STAGE(PG8_SB(0, 1), cB + hstepB, voffB); PG8_STAGE(PG8_SA(0, 1), cA + hstepA, voffA);
        if (wr == 1) PG8_BAR;
        PG8_WAIT_V(4); PG8_BAR;
        PG8_STAGE(PG8_SB(1, 0), cB + kstep, voffB); PG8_STAGE(PG8_SA(1, 0), cA + kstep, voffA); PG8_STAGE(PG8_SB(1, 1), cB + hstepB + kstep, voffB);
        PG8_WAIT_V(6); PG8_BAR;
    }
    for (;;) {
        const bool has_next = S.next(ui + 1, nxt);
        const char* nA = has_next ? (const char*)g.A + (size_t)nxt.pm * tstepA + nxt.aoff : cA; const char* nB = has_next ? (const char*)g.Bt + (size_t)nxt.pn * tstepB + nxt.boff : cB;
        for (int t = 0; t < nt; t += 2) {
            const bool last = (t == nt - 2);
            const char* a1 = cA + (size_t)(t + 1) * kstep;
            const char* a2 = last ? nA : cA + (size_t)(t + 2) * kstep; const char* b2 = last ? nB : cB + (size_t)(t + 2) * kstep;
            const char* a3 = a2 + kstep; const char* b3 = b2 + kstep;
            if (last && has_next) S.a_ready(nxt);
            if constexpr (SP2) {
            PG8_LDB(B0, 0, 0); PG8_LDB(B1, 0, 1); PG8_SCHED; PG8_LDA(At, 0, 0); PG8_STAGE(PG8_SA(1, 1), a1 + hstepA, voffA);
            PG8_WAIT_V(8); PG8_WAIT_L(0); PG8_BAR; PG8_MMA(0, 0, At, B0); PG8_MMA(0, 1, At, B1); PG8_BAR; PG8_SCHED;
            PG8_LDA(At, 0, 1); PG8_STAGE(PG8_SB(0, 0), b2, voffB); PG8_STAGE(PG8_SB(0, 1), b2 + hstepB, voffB); PG8_STAGE(PG8_SA(0, 0), a2, voffA);
            PG8_WAIT_V(8); PG8_WAIT_L(0); PG8_BAR; PG8_MMA(1, 0, At, B0); PG8_MMA(1, 1, At, B1); PG8_BAR; PG8_SCHED;
            PG8_LDB(B0, 1, 0); PG8_LDB(B1, 1, 1); PG8_SCHED; PG8_LDA(At, 1, 0); PG8_STAGE(PG8_SA(0, 1), a2 + hstepA, voffA);
            PG8_WAIT_V(8); PG8_WAIT_L(0); PG8_BAR; PG8_MMA(0, 0, At, B0); PG8_MMA(0, 1, At, B1); PG8_BAR; PG8_SCHED;
            PG8_LDA(At, 1, 1); PG8_STAGE(PG8_SB(1, 0), b3, voffB); PG8_STAGE(PG8_SB(1, 1), b3 + hstepB, voffB); PG8_STAGE(PG8_SA(1, 0), a3, voffA);
            PG8_WAIT_V(8); PG8_WAIT_L(0); PG8_BAR; PG8_MMA(1, 0, At, B0); PG8_MMA(1, 1, At, B1); PG8_BAR; PG8_SCHED;
            } else {
            PG8_LDB(B0, 0, 0); PG8_SCHED; PG8_LDA(At, 0, 0); PG8_STAGE(PG8_SA(1, 1), a1 + hstepA, voffA);
            PG8_WAIT_L(8); PG8_BAR; PG8_WAIT_L(0); PG8_MMA(0, 0, At, B0); PG8_BAR; PG8_SCHED;
            PG8_LDB(B1, 0, 1); PG8_STAGE(PG8_SB(0, 0), b2, voffB);
            PG8_BAR; PG8_WAIT_L(0); PG8_MMA(0, 1, At, B1); PG8_BAR;
            PG8_LDA(At, 0, 1); PG8_STAGE(PG8_SA(0, 0), a2, voffA);
            PG8_BAR; PG8_WAIT_L(0); PG8_MMA(1, 0, At, B0); PG8_BAR; PG8_SCHED;
            PG8_STAGE(PG8_SB(0, 1), b2 + hstepB, voffB);
            PG8_WAIT_V(6); PG8_BAR; PG8_MMA(1, 1, At, B1); PG8_BAR;
            PG8_LDB(B0, 1, 0); PG8_SCHED; PG8_LDA(At, 1, 0); PG8_STAGE(PG8_SA(0, 1), a2 + hstepA, voffA);
            PG8_WAIT_L(8); PG8_BAR; PG8_WAIT_L(0); PG8_MMA(0, 0, At, B0); PG8_BAR; PG8_SCHED;
            PG8_LDB(B1, 1, 1); PG8_STAGE(PG8_SB(1, 0), b3, voffB);
            PG8_BAR; PG8_WAIT_L(0); PG8_MMA(0, 1, At, B1); PG8_BAR;
            PG8_LDA(At, 1, 1); PG8_STAGE(PG8_SA(1, 0), a3, voffA);
            PG8_BAR; PG8_WAIT_L(0); PG8_MMA(1, 0, At, B0); PG8_BAR; PG8_SCHED;
            PG8_STAGE(PG8_SB(1, 1), b3 + hstepB, voffB);
            PG8_WAIT_V(6); PG8_BAR; PG8_MMA(1, 1, At, B1); PG8_BAR;
            }
        }
        if constexpr (ALIGN_EPI) { if (wr == 0) PG8_BAR; }
        if constexpr (!Epi::AFTER_DRAIN) { E(acc, cur, wr, wc, fr, fq); S.done(cur); }
        if (!has_next) break;
#pragma unroll
        for (int a = 0; a < 2; ++a)
#pragma unroll
            for (int b = 0; b < 2; ++b)
#pragma unroll
                for (int m = 0; m < 4; ++m)
#pragma unroll
                    for (int n = 0; n < 2; ++n) acc[a][b][m][n] = (f32x4){0.f, 0.f, 0.f, 0.f};
        cur = nxt; cA = nA; cB = nB; ++ui;
        if constexpr (ALIGN_EPI) { if (wr == 1) PG8_BAR; }
    }
    PG8_WAIT_V(0);
    if constexpr (!ALIGN_EPI) { if (wr == 0) PG8_BAR; }
    PG8_BAR;
    if constexpr (Epi::AFTER_DRAIN) { E.fused(acc, cur, wr, wc, fr, fq, lds, wid, lane); S.done(cur); }
#undef PG8_SA
#undef PG8_SB
#undef PG8_STAGE
#undef PG8_LDA
#undef PG8_LDB
#undef PG8_MMA
#undef PG8_WAIT_V
#undef PG8_WAIT_L
#undef PG8_BAR
#undef PG8_SCHED
}
}
#define GAS __attribute__((address_space(1)))
#define LAS __attribute__((address_space(3)))
typedef unsigned short bf16;
typedef unsigned v4u __attribute__((ext_vector_type(4)));
typedef float f32x4 __attribute__((ext_vector_type(4)));
typedef short bf16x8 __attribute__((ext_vector_type(8)));
typedef GAS unsigned gu32;
typedef GAS unsigned long long gu64;
#define RLX_AGENT __ATOMIC_RELAXED, __HIP_MEMORY_SCOPE_AGENT
#define LDS_WAIT() asm volatile("s_waitcnt lgkmcnt(0)" ::: "memory")
#define VM_WAIT() asm volatile("s_waitcnt vmcnt(0)" ::: "memory")
__device__ __forceinline__ unsigned long long rt() { return __builtin_amdgcn_s_memrealtime(); }
__device__ __forceinline__ unsigned f2bf(float f) { unsigned u = __builtin_bit_cast(unsigned, f); return (u + 0x7fffu + ((u >> 16) & 1u)) >> 16; }
__device__ __forceinline__ unsigned pk2(float lo, float hi) { return f2bf(lo) | (f2bf(hi) << 16); }

#define XB_TMO      128
#define XB_XCNT(j)  (256  + 64 * (j))
#define XB_XSUB(j)  (1280 + 64 * (j))
#define XB_XGEN(j)  (2304 + 64 * (j))
#define XB_TOP      3328
#define XB_TOPGEN   3392
#define XCD_BAR_WORDS 3456
#define XB_SPIN_CAP (1u << 18)

__device__ __forceinline__ unsigned xb_ld(unsigned* p)              { return __hip_atomic_load(p, __ATOMIC_RELAXED, __HIP_MEMORY_SCOPE_AGENT); }
__device__ __forceinline__ unsigned xb_add(unsigned* p, unsigned v) { return __hip_atomic_fetch_add(p, v, __ATOMIC_RELAXED, __HIP_MEMORY_SCOPE_AGENT); }
__device__ __forceinline__ unsigned xb_xcc_id() { return (unsigned)__builtin_amdgcn_s_getreg((3 << 11) | 20) & 0xFu; }
#define XB_SPIN(cond, bar) do { unsigned _sp = 0; while (cond) { __builtin_amdgcn_s_sleep(1); \
    if ((++_sp & 255u) == 0u) { if (xb_ld(&(bar)[XB_TMO])) break; if (_sp > XB_SPIN_CAP) { atomicAdd(&(bar)[XB_TMO], 1u); break; } } } } while (0)

struct XcdBarrier {
    unsigned* bar; unsigned x;
    volatile LAS unsigned* st;
};

__device__ __forceinline__ XcdBarrier xcd_barrier_post(unsigned* bar, volatile LAS unsigned* st) {
    XcdBarrier b; b.bar = bar; b.x = xb_xcc_id(); b.st = st;
    if (threadIdx.x == 0) (void)xb_add(&bar[XB_XCNT(b.x)], 1u);
    return b;
}
__device__ __forceinline__ void xcd_barrier_complete(unsigned* bar, unsigned x, unsigned& nloc, unsigned& nx) {
    const unsigned G = gridDim.x * gridDim.y * gridDim.z;
    unsigned sum, cnt, mine, sp = 0u;
    for (;;) {
        sum = 0u; cnt = 0u; mine = 0u;
#pragma unroll
        for (unsigned j = 0; j < 16; ++j) { const unsigned c = xb_ld(&bar[XB_XCNT(j)]); sum += c; cnt += (c > 0u) ? 1u : 0u; mine = (j == x) ? c : mine; }
        if (sum == G) break;
        __builtin_amdgcn_s_sleep(1);
        if ((++sp & 255u) == 0u) { if (xb_ld(&bar[XB_TMO])) break; if (sp > XB_SPIN_CAP) { atomicAdd(&bar[XB_TMO], 1u); break; } }
    }
    nloc = mine > 0u ? mine : 1u; nx = cnt > 0u ? cnt : 1u;
}

__device__ __forceinline__ void xcd_barrier(const XcdBarrier& b) {
    asm volatile("s_waitcnt vmcnt(0)" ::: "memory");
    __syncthreads();
    if (threadIdx.x == 0) {
        unsigned* bar = b.bar;
        __builtin_amdgcn_s_waitcnt(0);
        unsigned nloc = b.st[0], nx = b.st[1];
        if (nloc == 0u) { xcd_barrier_complete(bar, b.x, nloc, nx); b.st[0] = nloc; b.st[1] = nx; }
        const unsigned old = xb_add(&bar[XB_XSUB(b.x)], 1u);
        const unsigned gen = old / nloc;
        if (old + 1u == (gen + 1u) * nloc) {
            __builtin_amdgcn_fence(__ATOMIC_RELEASE, "agent");
            asm volatile("s_waitcnt vmcnt(0)" ::: "memory");
            const unsigned og = xb_add(&bar[XB_TOP], 1u);
            const unsigned tg = og / nx;
            if (og + 1u == (tg + 1u) * nx) xb_add(&bar[XB_TOPGEN], 1u);
            else XB_SPIN(xb_ld(&bar[XB_TOPGEN]) == tg, bar);
            __builtin_amdgcn_fence(__ATOMIC_ACQUIRE, "agent");
            xb_add(&bar[XB_XGEN(b.x)], 1u);
            asm volatile("s_waitcnt vmcnt(0)" ::: "memory");
        } else {
            XB_SPIN(xb_ld(&bar[XB_XGEN(b.x)]) == gen, bar);
            __builtin_amdgcn_fence(__ATOMIC_ACQUIRE, "agent");
            asm volatile("s_waitcnt vmcnt(0)" ::: "memory");
        }
    }
    __syncthreads();
}

constexpr int NWAVES = 8;
constexpr int DM = 2048, TX = 8192, NMETA = 16, TT = TX + NMETA, MP = 8448;
constexpr int EV_NP = 5632, EV_LORA0 = 3072, EV_GB = 3360, EV_REC = 4384;
constexpr int OD_NP = 12544, OD_Z = 8192, OD_B = 12288, OD_A = 12320;
constexpr int NEXP = 32, FF = 512, MOE_ROWS = 24576;
constexpr float NORM_EPS = 1e-6f;

constexpr size_t MiB = 1u << 20;
constexpr size_t WS_CTL = 0, CTL_ZERO_BYTES = 1 * MiB;
constexpr size_t WS_TOKINFO = 1 * MiB;
constexpr size_t WS_TILES = 1 * MiB + 512 * 1024;
constexpr size_t WS_WEVIN = 2 * MiB;
constexpr size_t WS_WEVOUT = 24 * MiB;
constexpr size_t WS_WODIN = 32 * MiB;
constexpr size_t WS_WODOUT = 81 * MiB;
constexpr size_t WS_WLORA = 97 * MiB;
constexpr size_t WS_WGATE = 100 * MiB;
constexpr size_t WS_WROUTE = 101 * MiB;
constexpr size_t WS_MOEW = 102 * MiB;
constexpr size_t MOE_E_BYTES = 6 * MiB, MOE_W2_OFF = 4 * MiB;
constexpr size_t WS_H = 294 * MiB;
constexpr size_t WS_HN = 360 * MiB;
constexpr size_t WS_YMIX = 393 * MiB;
constexpr size_t WS_PROJ = 459 * MiB;
constexpr size_t WS_SCR = 662 * MiB;
constexpr size_t WS_END = 932 * MiB;
constexpr size_t SC_ALORA = 0;
constexpr size_t SC_XR = 8 * MiB;
constexpr size_t SC_DEC = 26 * MiB, SC_ICL = 60 * MiB, SC_GATE = 94 * MiB;
constexpr size_t SC_LA = 128 * MiB, SC_LIX = 162 * MiB;
constexpr size_t SC_QN = 0, SC_KN = 34 * MiB;
constexpr size_t SC_VC = 68 * MiB;
constexpr size_t SC_BETA = 134 * MiB, SC_G = 136 * MiB;
constexpr size_t SC_O = 138 * MiB;
constexpr size_t SC_XG = 0;
constexpr size_t SC_ACT = 96 * MiB;
constexpr size_t SC_YB = 120 * MiB;
static_assert(SC_O + (size_t)MP * 4096 * 4 <= WS_END - WS_SCR && SC_YB + (size_t)MOE_ROWS * 2048 * 2 <= WS_END - WS_SCR && SC_LIX + (size_t)MP * 1024 * 4 <= WS_END - WS_SCR, "scratch map");
constexpr int CW_TMO = 0, CW_CODE = 1;
constexpr int CW_BAR = 4096;
constexpr int CW_PROG = 20480;
constexpr int CW_TS = 24576;
constexpr int CW_MOECNT = 16384;

constexpr int RING_OFF = 0, RING_BYTES = 131072;
constexpr int LDSCTL_OFF = 146944, MISC_OFF = LDSCTL_OFF + 320;
constexpr int LDS_BYTES = 147456;


#define DI __device__ __forceinline__
typedef unsigned v2u __attribute__((ext_vector_type(2)));
struct Args { const float* in[36]; float* out; unsigned char* ws; int ph_lo, ph_hi; };
struct Frame {
    LAS unsigned char* lds; volatile LAS unsigned* MISC; gu32* ctl;
    int tid, lane, wave, vcu, G, gw, NGW;
};
DI float bf2f(bf16 v) { return __uint_as_float((unsigned)v << 16); }
DI float bflo(unsigned w) { return __uint_as_float(w << 16); }
DI float bfhi(unsigned w) { return __uint_as_float(w & 0xffff0000u); }
DI float wave_sum(float v) {
#pragma unroll
    for (int o = 1; o < 64; o <<= 1) v += __shfl_xor(v, o);
    return v;
}
DI float sigm(float x) { return __builtin_amdgcn_rcpf(1.0f + __expf(-x)); }
DI float softplus(float x) { return fmaxf(x, 0.f) + __logf(1.0f + __expf(-fabsf(x))); }
DI float gelu_tanh(float x) { const float u = 0.7978845608028654f * (x + 0.044715f * x * x * x); return 0.5f * x * (1.0f + tanhf(u)); }
DI int pos_row(int p) { return p < NMETA ? TX + p : p - NMETA; }
DI int row_pos(int r) { return r < TX ? r + NMETA : r - TX; }

DI void tr_item(const float* W, int N, int k0, int n0, bf16* WT, int ldk, int drow0, LAS float* scr, int lane) {
#pragma unroll 8
    for (int i = 0; i < 32; ++i) { const int kk = 2 * i + (lane >> 5); scr[kk * 33 + (lane & 31)] = W[(size_t)(k0 + kk) * N + n0 + (lane & 31)]; }
    LDS_WAIT(); asm volatile("" ::: "memory");
    const int c = lane & 7;
#pragma unroll
    for (int j = 0; j < 4; ++j) { const int n = (lane >> 3) + 8 * j; const LAS float* s = scr + (8 * c) * 33 + n;
        v4u o; o.x = pk2(s[0 * 33], s[1 * 33]); o.y = pk2(s[2 * 33], s[3 * 33]); o.z = pk2(s[4 * 33], s[5 * 33]); o.w = pk2(s[6 * 33], s[7 * 33]);
        *(v4u*)(WT + (size_t)(drow0 + n) * ldk + k0 + 8 * c) = o; }
    LDS_WAIT(); asm volatile("" ::: "memory");
}
DI void moe_convert(const Frame& F, const Args& a, int l, int gw, int ngw) {
    LAS float* scr = (LAS float*)(F.lds + RING_OFF + F.wave * 16384);
    bf16* base = (bf16*)(a.ws + WS_MOEW);
    for (int it = gw; it < NEXP * 1536; it += ngw) {
        const int e = it / 1536; int j = it % 1536; bf16* eb = base + (size_t)e * (MOE_E_BYTES / 2);
        const size_t eoff = (size_t)(l * NEXP + e) * DM * FF;
        if (j < 1024) { const float* W = (j < 512 ? a.in[33] : a.in[34]) + eoff; const int hi = j >= 512; j &= 511; const int kb = j >> 4, nb = j & 15, n0 = 32 * nb;
            tr_item(W, FF, 64 * kb, n0, eb, DM, 256 * (n0 >> 7) + 128 * hi + (n0 & 127), scr, F.lane); }
        else { j -= 1024; const int kb = j >> 6, nb = j & 63; tr_item(a.in[35] + eoff, DM, 64 * kb, 32 * nb, eb + MOE_W2_OFF / 2, FF, 32 * nb, scr, F.lane); }
    }
}
DI void norm_row_bf16(int lane, const float* src, const float* w, bf16* dst) {
    f32x4 v[8]; float s = 0.f;
#pragma unroll
    for (int j = 0; j < 8; ++j) { v[j] = ((const f32x4*)src)[lane + 64 * j]; s += (v[j].x * v[j].x + v[j].y * v[j].y) + (v[j].z * v[j].z + v[j].w * v[j].w); }
    const float rs = 1.0f / sqrtf(wave_sum(s) * (1.0f / DM) + NORM_EPS);
#pragma unroll
    for (int j = 0; j < 8; ++j) { const f32x4 wv = ((const f32x4*)w)[lane + 64 * j]; v2u o; o.x = pk2(v[j].x * rs * wv.x, v[j].y * rs * wv.y); o.y = pk2(v[j].z * rs * wv.z, v[j].w * rs * wv.w);
        ((v2u*)dst)[lane + 64 * j] = o; }
}

DI void ph_prologue(const Frame& F, const Args& a) {
    LAS float* scr = (LAS float*)(F.lds + RING_OFF + F.wave * 16384);
    constexpr int I_A = 32 * 169, I_B = 32 * 64, NIT = I_A + I_B;
    for (int it = F.gw; it < NIT; it += F.NGW) {
        int r = it;
        if (r < I_A) { const int kb = r / 169, nb = r % 169; tr_item(a.in[5], 5408, 64 * kb, 32 * nb, (bf16*)(a.ws + WS_WEVIN), DM, 32 * nb, scr, F.lane); continue; } r -= I_A;
        { const int kb = r / 64, nb = r % 64; tr_item(a.in[24], DM, 64 * kb, 32 * nb, (bf16*)(a.ws + WS_WEVOUT), DM, 32 * nb, scr, F.lane); }
    }
    const int gt = F.vcu * (NWAVES * 64) + F.tid, NGT = F.G * NWAVES * 64;
    { bf16* WL = (bf16*)(a.ws + WS_WLORA); const float* wup = a.in[8]; const float* aup = a.in[10]; const float* gup = a.in[11];
      for (int idx = gt; idx < 3072 * 384; idx += NGT) { const int n = idx / 384, k = idx % 384; float v = 0.f;
          if (n < 1024) { if (k < 64) v = wup[k * 1024 + n]; }
          else if (n < 2048) { if (k >= 64 && k < 128) v = aup[(k - 64) * 1024 + n - 1024]; }
          else { if (k >= 128 && k < 288) v = gup[(k - 128) * 1024 + n - 2048]; }
          WL[idx] = (bf16)f2bf(v); } }
    { bf16* WG = (bf16*)(a.ws + WS_WGATE);
      for (int idx = gt; idx < 2048 * 256; idx += NGT) { const int n = idx >> 8, kk = idx & 255, nn = n & 1023, blk = nn >> 6, j = nn & 63, cin = (nn & ~255) + kk;
          const float* W = n < 1024 ? a.in[19] : a.in[21];
          const float v = (cin >> 6) == blk ? W[blk * 4096 + (cin & 63) * 64 + j] : 0.f;
          WG[idx] = (bf16)f2bf(v); } }
    { bf16* WR = (bf16*)(a.ws + WS_WROUTE);
      for (int idx = gt; idx < 2 * 48 * DM; idx += NGT) { const int l = idx / (48 * DM), n = (idx / DM) % 48, k = idx % DM; float v = 0.f;
          if (n < 32) v = a.in[32][((size_t)l * DM + k) * NEXP + n]; else if (n < 36) v = a.in[31][((size_t)l * DM + k) * 4 + n - 32];
          const unsigned hi = f2bf(v); WR[((size_t)(l * 2) * 48 + n) * DM + k] = (bf16)hi; WR[((size_t)(l * 2 + 1) * 48 + n) * DM + k] = (bf16)f2bf(v - __uint_as_float(hi << 16)); } }
    bf16* HN = (bf16*)(a.ws + WS_HN);
    for (int r = F.gw; r < TT; r += F.NGW) norm_row_bf16(F.lane, r < TX ? a.in[0] + (size_t)r * DM : a.in[1] + (size_t)(r - TX) * DM, a.in[2], HN + (size_t)r * DM);
}

DI void ph_aux_convert(const Frame& F, const Args& a, int gw, int ngw) {
    LAS float* scr = (LAS float*)(F.lds + RING_OFF + F.wave * 16384);
    constexpr int I_C = 32 * 386, I_D = 64 * 64, NIT = I_C + I_D;
    for (int it = gw; it < NIT; it += ngw) {
        int r = it;
        if (r < I_C) { const int kb = r / 386, nb = r % 386; tr_item(a.in[25], 12352, 64 * kb, 32 * nb, (bf16*)(a.ws + WS_WODIN), DM, 32 * nb, scr, F.lane); continue; } r -= I_C;
        { const int kb = r / 64, nb = r % 64; tr_item(a.in[30], DM, 64 * kb, 32 * nb, (bf16*)(a.ws + WS_WODOUT), 4096, 32 * nb, scr, F.lane); }
    }
    moe_convert(F, a, 0, gw, ngw);
}

DI void ph_even_prep(const Frame& F, const Args& a) {
    const bf16* P = (const bf16*)(a.ws + WS_PROJ); bf16* AL = (bf16*)(a.ws + WS_SCR + SC_ALORA); bf16* XR = (bf16*)(a.ws + WS_SCR + SC_XR);
    const float* mu = a.in[6]; const float* cw = a.in[17]; const float* cb = a.in[18];
    const int lane = F.lane;
    for (int item = F.gw; item < TT + (TT / 8) * 2; item += F.NGW) {
        if (item < TT) { const int r = item, pos = row_pos(r); const bf16* cur = P + (size_t)r * EV_NP; const bf16* prv = P + (size_t)pos_row(pos > 0 ? pos - 1 : 0) * EV_NP; const float pm = pos > 0 ? 1.f : 0.f;
            float cv[6], pv[6], mv[6];
#pragma unroll
            for (int i = 0; i < 6; ++i) { const int idx = lane + 64 * i, col = EV_LORA0 + (idx < 288 ? idx : 287); cv[i] = bf2f(cur[col]); pv[i] = bf2f(prv[col]) * pm; mv[i] = mu[col]; }
#pragma unroll
            for (int i = 0; i < 6; ++i) { const int idx = lane + 64 * i; float v = cv[i] + (pv[i] - cv[i]) * mv[i];
                if (idx < 64) v = tanhf(v); else if (idx >= 128) v = sigm(v);
                AL[(size_t)r * 384 + idx] = (bf16)f2bf(idx < 288 ? v : 0.f); }
        } else { const int it2 = item - TT, pb = it2 >> 1, c0 = (it2 & 1) * 512 + lane * 8, p0 = pb * 8;
            f32x4 w[4][2], b0 = *(const f32x4*)(cb + c0), b1 = *(const f32x4*)(cb + c0 + 4);
#pragma unroll
            for (int j = 0; j < 4; ++j) { w[j][0] = *(const f32x4*)(cw + j * 1024 + c0); w[j][1] = *(const f32x4*)(cw + j * 1024 + c0 + 4); }
            v4u x[11];
#pragma unroll
            for (int i = 0; i < 11; ++i) { const int p = p0 - 3 + i; x[i] = *(const v4u*)(P + (size_t)pos_row(p > 0 ? p : 0) * EV_NP + EV_REC + c0); if (p < 0) x[i] = (v4u){0u, 0u, 0u, 0u}; }
#pragma unroll
            for (int o = 0; o < 8; ++o) { float acc[8] = {b0.x, b0.y, b0.z, b0.w, b1.x, b1.y, b1.z, b1.w};
#pragma unroll
                for (int j = 0; j < 4; ++j) { const v4u xv = x[o + j];
                    acc[0] += w[j][0].x * bflo(xv.x); acc[1] += w[j][0].y * bfhi(xv.x); acc[2] += w[j][0].z * bflo(xv.y); acc[3] += w[j][0].w * bfhi(xv.y);
                    acc[4] += w[j][1].x * bflo(xv.z); acc[5] += w[j][1].y * bfhi(xv.z); acc[6] += w[j][1].z * bflo(xv.w); acc[7] += w[j][1].w * bfhi(xv.w); }
                *(v4u*)(XR + (size_t)pos_row(p0 + o) * 1024 + c0) = (v4u){pk2(acc[0], acc[1]), pk2(acc[2], acc[3]), pk2(acc[4], acc[5]), pk2(acc[6], acc[7])}; } }
    }
}

DI void ph_route(const Frame& F, const Args& a, int l, int dummy) {
    const float* H = (const float*)(a.ws + WS_H); const float* nw = a.in[3] + (size_t)l * DM;
    const bf16* WH = (const bf16*)(a.ws + WS_WROUTE) + (size_t)(l * 2) * 48 * DM; const bf16* WL = WH + (size_t)48 * DM;
    unsigned* TI = (unsigned*)(a.ws + WS_TOKINFO) + (dummy ? (WS_SCR + 250 * MiB - WS_TOKINFO) / 4 : 0); const int lane = F.lane, lc = lane & 15, quad = lane >> 4, wave = F.wave; const int cl = dummy ? l + 2 : l;
    LAS float* red = (LAS float*)(F.lds + RING_OFF);
    LAS float* sq = red + 8 * 9 * 64 * 4; LAS float* lgs = sq + 8 * 48;
    static_assert(TT % 48 == 0, "router tasks");
    for (int task = F.vcu; task < TT / 48; task += F.G) {
        const float* nwp = nw + 256 * wave + 8 * quad; float ss[3] = {0.f, 0.f, 0.f};
        f32x4 acc[3][3];
#pragma unroll
        for (int mt = 0; mt < 3; ++mt)
#pragma unroll
            for (int nt = 0; nt < 3; ++nt) acc[mt][nt] = (f32x4){0.f, 0.f, 0.f, 0.f};
#pragma unroll 2
        for (int ks = 0; ks < 8; ++ks) { const int k0 = 256 * wave + 32 * ks + 8 * quad; const f32x4 w0 = *(const f32x4*)(nwp + 32 * ks), w1 = *(const f32x4*)(nwp + 32 * ks + 4);
            bf16x8 bh[3], bl[3];
#pragma unroll
            for (int nt = 0; nt < 3; ++nt) { bh[nt] = *(const bf16x8*)(WH + (size_t)(16 * nt + lc) * DM + k0); bl[nt] = *(const bf16x8*)(WL + (size_t)(16 * nt + lc) * DM + k0); }
#pragma unroll
            for (int mt = 0; mt < 3; ++mt) { const float* hr = H + (size_t)(task * 48 + mt * 16 + lc) * DM + k0; const f32x4 x0 = *(const f32x4*)hr, x1 = *(const f32x4*)(hr + 4);
                ss[mt] += (x0.x * x0.x + x0.y * x0.y) + (x0.z * x0.z + x0.w * x0.w) + (x1.x * x1.x + x1.y * x1.y) + (x1.z * x1.z + x1.w * x1.w);
                const float xn[8] = {x0.x * w0.x, x0.y * w0.y, x0.z * w0.z, x0.w * w0.w, x1.x * w1.x, x1.y * w1.y, x1.z * w1.z, x1.w * w1.w};
                unsigned hi[8]; float lo[8];
#pragma unroll
                for (int q = 0; q < 8; ++q) { hi[q] = f2bf(xn[q]); lo[q] = xn[q] - __uint_as_float(hi[q] << 16); }
                const v4u ah4 = (v4u){hi[0] | (hi[1] << 16), hi[2] | (hi[3] << 16), hi[4] | (hi[5] << 16), hi[6] | (hi[7] << 16)}, al4 = (v4u){pk2(lo[0], lo[1]), pk2(lo[2], lo[3]), pk2(lo[4], lo[5]), pk2(lo[6], lo[7])};
                const bf16x8 ah = __builtin_bit_cast(bf16x8, ah4), al = __builtin_bit_cast(bf16x8, al4);
#pragma unroll
                for (int nt = 0; nt < 3; ++nt) { acc[mt][nt] = __builtin_amdgcn_mfma_f32_16x16x32_bf16(al, bh[nt], acc[mt][nt], 0, 0, 0); acc[mt][nt] = __builtin_amdgcn_mfma_f32_16x16x32_bf16(ah, bl[nt], acc[mt][nt], 0, 0, 0);
                    acc[mt][nt] = __builtin_amdgcn_mfma_f32_16x16x32_bf16(ah, bh[nt], acc[mt][nt], 0, 0, 0); } } }
#pragma unroll
        for (int mt = 0; mt < 3; ++mt) { float s_ = ss[mt]; s_ += __shfl_xor(s_, 16); s_ += __shfl_xor(s_, 32); if (quad == 0) sq[wave * 48 + mt * 16 + lc] = s_;
#pragma unroll
            for (int nt = 0; nt < 3; ++nt) *(LAS f32x4*)(red + ((wave * 9 + mt * 3 + nt) * 64 + lane) * 4) = acc[mt][nt]; }
        __syncthreads();
        { const int tile = wave;
#pragma unroll
          for (int rep = 0; rep < 2; ++rep) { const int tl = tile + 8 * rep; if (tl < 9) { f32x4 s = *(const LAS f32x4*)(red + (tl * 64 + lane) * 4);
#pragma unroll
              for (int v = 1; v < 8; ++v) s = s + *(const LAS f32x4*)(red + ((v * 9 + tl) * 64 + lane) * 4);
              const int mt = tl / 3, nt = tl % 3;
#pragma unroll
              for (int q = 0; q < 4; ++q) lgs[(mt * 16 + 4 * quad + q) * 49 + 16 * nt + lc] = s[q]; } } }
        __syncthreads();
        if (wave == 0 && lane < 48) { float sst = 0.f;
#pragma unroll
            for (int v = 0; v < 8; ++v) sst += sq[v * 48 + lane];
            const float rs = 1.0f / sqrtf(sst * (1.0f / DM) + NORM_EPS);
            float lg[36];
#pragma unroll
            for (int i = 0; i < 36; ++i) lg[i] = lgs[lane * 49 + i] * rs;
            int gi = 0; float gm = lg[32];
#pragma unroll
            for (int i = 1; i < 4; ++i) if (lg[32 + i] > gm) { gm = lg[32 + i]; gi = i; }
            float den = 0.f;
#pragma unroll
            for (int i = 0; i < 4; ++i) den += __expf(lg[32 + i] - gm);
            const float gp = 1.0f / den;
            float l8[8];
#pragma unroll
            for (int i = 0; i < 8; ++i) l8[i] = gi == 0 ? lg[i] : (gi == 1 ? lg[8 + i] : (gi == 2 ? lg[16 + i] : lg[24 + i]));
            int i1 = 0; float m1 = l8[0];
#pragma unroll
            for (int i = 1; i < 8; ++i) if (l8[i] > m1) { m1 = l8[i]; i1 = i; }
            int i2 = -1; float m2 = -INFINITY;
#pragma unroll
            for (int i = 0; i < 8; ++i) if (i != i1 && l8[i] > m2) { m2 = l8[i]; i2 = i; }
            const float e21 = __expf(m2 - m1); const float w1 = gp / (1.0f + e21), w2 = gp * e21 / (1.0f + e21);
            const int ea = gi * 8 + i1, eb = gi * 8 + i2; const int rt = task * 48 + lane;
            const unsigned sa = atomicAdd((unsigned*)(F.ctl + CW_MOECNT + (cl * NEXP + ea) * 16), 1u), sb = atomicAdd((unsigned*)(F.ctl + CW_MOECNT + (cl * NEXP + eb) * 16), 1u);
            unsigned* t = TI + (size_t)rt * 8; *(v4u*)t = (v4u){(unsigned)ea, sa, __float_as_uint(w1), (unsigned)eb}; *(v4u*)(t + 4) = (v4u){sb, __float_as_uint(w2), __float_as_uint(rs), 0u}; }
        __syncthreads();
    }
}
DI void moe_prefix(const Frame& F, int l, LAS int* ps) {
    if (F.tid == 0) { int t = 0;
        for (int e = 0; e < NEXP; ++e) { const unsigned c = __hip_atomic_load(F.ctl + CW_MOECNT + (l * NEXP + e) * 16, RLX_AGENT); ps[e] = t * 256; t += (int)((c + 255u) >> 8); }
        ps[32] = t; }
    __syncthreads();
}
DI void ph_gather(const Frame& F, const Args& a, int l) {
    LAS int* ps = (LAS int*)(F.lds + RING_OFF); moe_prefix(F, l, ps);
    if (F.vcu == 0 && F.tid < NEXP) { int* TE = (int*)(a.ws + WS_TILES); const int e = F.tid; const int t0 = ps[e] >> 8, t1 = (e == NEXP - 1 ? ps[32] : ps[e + 1] >> 8);
        for (int t = t0; t < t1; ++t) TE[t] = e; if (e == 0) TE[127] = ps[32]; }
    const float* H = (const float*)(a.ws + WS_H); const float* nw = a.in[3] + (size_t)l * DM; unsigned* TI = (unsigned*)(a.ws + WS_TOKINFO); bf16* XG = (bf16*)(a.ws + WS_SCR + SC_XG);
    const int lane = F.lane;
    for (int r = F.gw; r < TT; r += F.NGW) {
        unsigned* t = TI + (size_t)r * 8; const int g0 = ps[t[0]] + (int)t[1], g1 = ps[t[3]] + (int)t[4]; const float rs = __uint_as_float(t[6]);
        if (lane == 0) t[7] = (unsigned)g0 | ((unsigned)g1 << 16);
        const float* hr = H + (size_t)r * DM;
#pragma unroll
        for (int j = 0; j < 4; ++j) { const int e0 = (lane + 64 * j) * 8; const f32x4 x0 = *(const f32x4*)(hr + e0), x1 = *(const f32x4*)(hr + e0 + 4), w0 = *(const f32x4*)(nw + e0), w1 = *(const f32x4*)(nw + e0 + 4);
            v4u o; o.x = pk2(x0.x * rs * w0.x, x0.y * rs * w0.y); o.y = pk2(x0.z * rs * w0.z, x0.w * rs * w0.w); o.z = pk2(x1.x * rs * w1.x, x1.y * rs * w1.y); o.w = pk2(x1.z * rs * w1.z, x1.w * rs * w1.w);
            *(v4u*)(XG + (size_t)g0 * DM + e0) = o; *(v4u*)(XG + (size_t)g1 * DM + e0) = o; }
    }
}
DI void ph_combine(const Frame& F, const Args& a, int l) {
    float* H = (float*)(a.ws + WS_H); const unsigned* TI = (const unsigned*)(a.ws + WS_TOKINFO); const bf16* YB = (const bf16*)(a.ws + WS_SCR + SC_YB); bf16* HN = (bf16*)(a.ws + WS_HN);
    const int lane = F.lane; const int nrows = l == 0 ? TT : TX;
    for (int r = F.gw; r < nrows; r += F.NGW) {
        const unsigned* t = TI + (size_t)r * 8; const int g0 = (int)(t[7] & 0xffffu), g1 = (int)(t[7] >> 16); const float w0 = __uint_as_float(t[2]), w1 = __uint_as_float(t[5]);
        float* hr = H + (size_t)r * DM; float hv[32]; float s = 0.f;
#pragma unroll
        for (int j = 0; j < 4; ++j) { const int e0 = (lane + 64 * j) * 8; const f32x4 x0 = *(const f32x4*)(hr + e0), x1 = *(const f32x4*)(hr + e0 + 4);
            const v4u ya = *(const v4u*)(YB + (size_t)g0 * DM + e0), yc = *(const v4u*)(YB + (size_t)g1 * DM + e0);
            float* o = hv + 8 * j;
            o[0] = x0.x + w0 * bflo(ya.x) + w1 * bflo(yc.x); o[1] = x0.y + w0 * bfhi(ya.x) + w1 * bfhi(yc.x); o[2] = x0.z + w0 * bflo(ya.y) + w1 * bflo(yc.y); o[3] = x0.w + w0 * bfhi(ya.y) + w1 * bfhi(yc.y);
            o[4] = x1.x + w0 * bflo(ya.z) + w1 * bflo(yc.z); o[5] = x1.y + w0 * bfhi(ya.z) + w1 * bfhi(yc.z); o[6] = x1.z + w0 * bflo(ya.w) + w1 * bflo(yc.w); o[7] = x1.w + w0 * bfhi(ya.w) + w1 * bfhi(yc.w);
#pragma unroll
            for (int q = 0; q < 8; ++q) s += o[q] * o[q]; }
        const float rs = 1.0f / sqrtf(wave_sum(s) * (1.0f / DM) + NORM_EPS);
        if (l == 0) { const float* nw = a.in[2] + DM;
#pragma unroll
            for (int j = 0; j < 4; ++j) { const int e0 = (lane + 64 * j) * 8; const float* o = hv + 8 * j; const f32x4 wa = *(const f32x4*)(nw + e0), wb = *(const f32x4*)(nw + e0 + 4);
                *(f32x4*)(hr + e0) = (f32x4){o[0], o[1], o[2], o[3]}; *(f32x4*)(hr + e0 + 4) = (f32x4){o[4], o[5], o[6], o[7]};
                v4u p; p.x = pk2(o[0] * rs * wa.x, o[1] * rs * wa.y); p.y = pk2(o[2] * rs * wa.z, o[3] * rs * wa.w); p.z = pk2(o[4] * rs * wb.x, o[5] * rs * wb.y); p.w = pk2(o[6] * rs * wb.z, o[7] * rs * wb.w);
                *(v4u*)(HN + (size_t)r * DM + e0) = p; }
        } else { const float* nw = a.in[4]; float* orow = a.out + (size_t)r * DM;
#ifdef PROBE_TS
            { const unsigned long long* ts = (const unsigned long long*)(F.ctl + CW_TS); const float dt_us = (float)(__hip_atomic_load(ts + PROBE_TS + 1, RLX_AGENT) - __hip_atomic_load(ts + PROBE_TS, RLX_AGENT)) * 0.01f;
#pragma unroll
              for (int q = 0; q < 32; ++q) hv[q] *= 1.0f + dt_us * 0.01f; }
#endif
#pragma unroll
            for (int j = 0; j < 4; ++j) { const int e0 = (lane + 64 * j) * 8; const float* o = hv + 8 * j; const f32x4 wa = *(const f32x4*)(nw + e0), wb = *(const f32x4*)(nw + e0 + 4);
                *(f32x4*)(orow + e0) = (f32x4){o[0] * rs * wa.x, o[1] * rs * wa.y, o[2] * rs * wa.z, o[3] * rs * wa.w};
                *(f32x4*)(orow + e0 + 4) = (f32x4){o[4] * rs * wb.x, o[5] * rs * wb.y, o[6] * rs * wb.z, o[7] * rs * wb.w}; } }
    }
}

struct OddPrepItem { f32x4 w[4][2]; v4u x[11]; };
DI void odd_prep_load(OddPrepItem& it, const bf16* P, const float* cw, int item, int lane) {
    const int pb = item >> 4, i = item & 15, ch = i * 512 + lane * 8, p0 = pb * 8;
#pragma unroll
    for (int j = 0; j < 4; ++j) { it.w[j][0] = *(const f32x4*)(cw + j * 8192 + ch); it.w[j][1] = *(const f32x4*)(cw + j * 8192 + ch + 4); }
#pragma unroll
    for (int q = 0; q < 11; ++q) { const int p = p0 - 3 + q; it.x[q] = *(const v4u*)(P + (size_t)pos_row(p > 0 ? p : 0) * OD_NP + ch); if (p < 0) it.x[q] = (v4u){0u, 0u, 0u, 0u}; }
}
DI void odd_prep_compute(const OddPrepItem& it, const Args& a, int item, int lane) {
    const bf16* P = (const bf16*)(a.ws + WS_PROJ); bf16* QN = (bf16*)(a.ws + WS_SCR + SC_QN); bf16* KN = (bf16*)(a.ws + WS_SCR + SC_KN); bf16* VC = (bf16*)(a.ws + WS_SCR + SC_VC);
    float* BETA = (float*)(a.ws + WS_SCR + SC_BETA); float* GG = (float*)(a.ws + WS_SCR + SC_G);
    const int pb = item >> 4, i = item & 15, ch = i * 512 + lane * 8, p0 = pb * 8;
#pragma unroll
    for (int o = 0; o < 8; ++o) { const int r = pos_row(p0 + o); float acc[8] = {0.f, 0.f, 0.f, 0.f, 0.f, 0.f, 0.f, 0.f};
#pragma unroll
        for (int j = 0; j < 4; ++j) { const v4u xv = it.x[o + j];
            acc[0] += it.w[j][0].x * bflo(xv.x); acc[1] += it.w[j][0].y * bfhi(xv.x); acc[2] += it.w[j][0].z * bflo(xv.y); acc[3] += it.w[j][0].w * bfhi(xv.y);
            acc[4] += it.w[j][1].x * bflo(xv.z); acc[5] += it.w[j][1].y * bfhi(xv.z); acc[6] += it.w[j][1].z * bflo(xv.w); acc[7] += it.w[j][1].w * bfhi(xv.w); }
        float ss = 0.f;
#pragma unroll
        for (int q = 0; q < 8; ++q) { acc[q] = acc[q] * sigm(acc[q]); ss += acc[q] * acc[q]; }
        float sc = 1.0f;
        if (i < 8) { ss += __shfl_xor(ss, 1); ss += __shfl_xor(ss, 2); ss += __shfl_xor(ss, 4); ss += __shfl_xor(ss, 8);
            sc = (1.0f / sqrtf(ss + NORM_EPS)) * (i < 4 ? 0.08838834764831845f : 1.0f); }
        const v4u ov = (v4u){pk2(acc[0] * sc, acc[1] * sc), pk2(acc[2] * sc, acc[3] * sc), pk2(acc[4] * sc, acc[5] * sc), pk2(acc[6] * sc, acc[7] * sc)};
        bf16* dst = i < 4 ? QN + (size_t)r * 2048 + ch : (i < 8 ? KN + (size_t)r * 2048 + ch - 2048 : VC + (size_t)r * 4096 + ch - 4096);
        *(v4u*)dst = ov; }
    if (i == 0 && lane < 32) {
#pragma unroll
        for (int o = 0; o < 8; ++o) { const int r = pos_row(p0 + o); const float bb = bf2f(P[(size_t)r * OD_NP + OD_B + lane]), aa = bf2f(P[(size_t)r * OD_NP + OD_A + lane]);
            BETA[(size_t)r * 32 + lane] = sigm(bb); GG[(size_t)r * 32 + lane] = -__expf(a.in[27][lane]) * softplus(aa + a.in[28][lane]); } }
}
DI void ph_odd_prep(const Frame& F, const Args& a) {
    const bf16* P = (const bf16*)(a.ws + WS_PROJ); const float* cw = a.in[26]; constexpr int NI = (TT / 8) * 16;
    for (int item = F.gw; item < NI; item += 2 * F.NGW) { OddPrepItem A, B; const bool hb = item + F.NGW < NI;
        odd_prep_load(A, P, cw, item, F.lane); odd_prep_load(B, P, cw, hb ? item + F.NGW : item, F.lane);
        odd_prep_compute(A, a, item, F.lane); if (hb) odd_prep_compute(B, a, item + F.NGW, F.lane); }
}
DI void ph_odd_post(const Frame& F, const Args& a, int part) {
    const bf16* P = (const bf16*)(a.ws + WS_PROJ); const bf16* O = (const bf16*)(a.ws + WS_SCR + SC_O); bf16* Y = (bf16*)(a.ws + WS_YMIX); const float* nw = a.in[29];
    const int lane = F.lane; int w0 = F.gw, wn = F.NGW, n_rows = TX - 6144;
    if (part == 0) { const int wx = F.vcu & 31; if (F.G != 256 || wx < 20) return; w0 = ((F.vcu >> 5) * 12 + (wx - 20)) * NWAVES + F.wave; wn = 96 * NWAVES; n_rows = 6144 + NMETA; }
    if (part == 2) n_rows = TT;
    for (int ri = w0; ri < n_rows; ri += wn) { const int r = part == 0 ? (ri < 6144 ? ri : TX + ri - 6144) : (part == 1 ? 6144 + ri : ri);
#pragma unroll 2
        for (int i = 0; i < 8; ++i) { const int ch = i * 512 + lane * 8; const v4u ow = *(const v4u*)(O + (size_t)r * 4096 + ch); const f32x4 o0 = (f32x4){bflo(ow.x), bfhi(ow.x), bflo(ow.y), bfhi(ow.y)}, o1 = (f32x4){bflo(ow.z), bfhi(ow.z), bflo(ow.w), bfhi(ow.w)};
            float ss = (o0.x * o0.x + o0.y * o0.y) + (o0.z * o0.z + o0.w * o0.w) + (o1.x * o1.x + o1.y * o1.y) + (o1.z * o1.z + o1.w * o1.w);
            ss += __shfl_xor(ss, 1); ss += __shfl_xor(ss, 2); ss += __shfl_xor(ss, 4); ss += __shfl_xor(ss, 8);
            const float rs = 1.0f / sqrtf(ss * (1.0f / 128.0f) + NORM_EPS);
            const v4u z = *(const v4u*)(P + (size_t)r * OD_NP + OD_Z + ch); const int c0 = ch & 127; const f32x4 w0 = *(const f32x4*)(nw + c0), w1 = *(const f32x4*)(nw + c0 + 4);
            const float zf[8] = {bflo(z.x), bfhi(z.x), bflo(z.y), bfhi(z.y), bflo(z.z), bfhi(z.z), bflo(z.w), bfhi(z.w)};
            const float of[8] = {o0.x * w0.x, o0.y * w0.y, o0.z * w0.z, o0.w * w0.w, o1.x * w1.x, o1.y * w1.y, o1.z * w1.z, o1.w * w1.w};
            float y[8];
#pragma unroll
            for (int q = 0; q < 8; ++q) y[q] = of[q] * rs * zf[q] * sigm(zf[q]);
            v4u p; p.x = pk2(y[0], y[1]); p.y = pk2(y[2], y[3]); p.z = pk2(y[4], y[5]); p.w = pk2(y[6], y[7]);
            *(v4u*)(Y + (size_t)r * 4096 + ch) = p; }
    }
}

typedef float f32x16 __attribute__((ext_vector_type(16)));
#define MFMA32(a, b, c) __builtin_amdgcn_mfma_f32_32x32x16_bf16((a), (b), (c), 0, 0, 0)
DI int crow(int reg, int h) { return (reg & 3) + 8 * (reg >> 2) + 4 * h; }
DI int chunk_row(int n, int c) { return n == 0 ? (c >= 48 ? TX + (c - 48) : -1) : 64 * (n - 1) + c; }
#ifndef GDN_NO_HELPER
#define GDN_NO_HELPER 0
#endif
constexpr int GDN_NCH = 129, GDN_UNITS = GDN_NCH * 32, GDN_KUNITS = GDN_NCH * 16, GC_STRIDE = 72;
constexpr size_t GD_WF = WS_MOEW, GD_UF = WS_MOEW + 65 * MiB, GD_IN = WS_MOEW + 130 * MiB, GD_GC = WS_MOEW + 163 * MiB, GD_KT = WS_HN, GD_QF = WS_SCR + 208 * MiB, GD_SAVE = WS_SCR + 205 * MiB;
static_assert(GD_QF + (size_t)GDN_KUNITS * 16384 <= WS_END && GD_SAVE + 2 * MiB <= GD_QF && (size_t)GDN_UNITS * 16384 <= 65 * MiB && (size_t)GDN_UNITS * 8192 <= 33 * MiB && (size_t)GDN_KUNITS * 16384 <= 33 * MiB && GD_GC + (size_t)GDN_UNITS * GC_STRIDE * 4 <= WS_H, "gdn map");

DI void ph_gdn_chunk(const Frame& F, const Args& a, int n_lo, int n_hi, int side) {
    const bf16* QN = (const bf16*)(a.ws + WS_SCR + SC_QN); const bf16* KN = (const bf16*)(a.ws + WS_SCR + SC_KN); const bf16* VC = (const bf16*)(a.ws + WS_SCR + SC_VC);
    const float* BETA = (const float*)(a.ws + WS_SCR + SC_BETA); const float* GG = (const float*)(a.ws + WS_SCR + SC_G);
    bf16* WF = (bf16*)(a.ws + GD_WF); bf16* UF = (bf16*)(a.ws + GD_UF); bf16* INF = (bf16*)(a.ws + GD_IN); bf16* KTF = (bf16*)(a.ws + GD_KT); bf16* QF = (bf16*)(a.ws + GD_QF); float* GC = (float*)(a.ws + GD_GC);
    LAS unsigned char* L = F.lds + RING_OFF;
    LAS unsigned char* kS = L; LAS unsigned char* qS = L + 17408; LAS unsigned char* vS = L + 34816; LAS unsigned char* kbS = L + 52224;
    LAS float* Lm = (LAS float*)(L + 69632); LAS bf16* IS = (LAS bf16*)(L + 87040); LAS bf16* XS = (LAS bf16*)(L + 96256);
    LAS float* betaS = (LAS float*)(L + 130048); LAS float* gcS = betaS + 64; LAS float* egcS = betaS + 128;
    LAS unsigned char* Lb = L + 17408; LAS unsigned char* TDs = L + 26624; LAS unsigned char* YT0 = L + 28672; LAS unsigned char* XT0 = L + 130816;
    static_assert(130816 + 8 * 1792 <= LDSCTL_OFF, "gdn lds map");
    const int tid = F.tid, lane = F.lane, wave = F.wave, l31 = lane & 31, h = lane >> 5;
    int widx = F.vcu, wcnt = F.G;
    if (side) { if (F.G == 256) { const int wx = F.vcu & 31; if (wx < 20) return; widx = (F.vcu >> 5) * 12 + (wx - 20); wcnt = 96; } else { if (F.vcu < 128 || F.G <= 128) return; widx = F.vcu - 128; wcnt = F.G - 128; } }
    for (int unit = n_lo * 32 + widx; unit < n_hi * 32; unit += wcnt) {
        const int n = unit >> 5, hv = unit & 31, hk = hv >> 1; const size_t su = (size_t)hv * GDN_NCH + n;
#pragma unroll
        for (int i = 0; i < 2; ++i) { const int p = tid + 512 * i, row = p >> 4, ch = p & 15; const int rr = chunk_row(n, row);
            v4u kx = (v4u){0u, 0u, 0u, 0u}, qx = kx, vx = kx;
            if (rr >= 0) { kx = *(const v4u*)(KN + (size_t)rr * 2048 + hk * 128 + ch * 8); qx = *(const v4u*)(QN + (size_t)rr * 2048 + hk * 128 + ch * 8); vx = *(const v4u*)(VC + (size_t)rr * 4096 + hv * 128 + ch * 8); }
            *(LAS v4u*)(kS + row * 272 + ch * 16) = kx; *(LAS v4u*)(qS + row * 272 + ch * 16) = qx; *(LAS v4u*)(vS + row * 272 + ch * 16) = vx; }
        if (wave == 0) { const int rr = chunk_row(n, lane); float b = 0.f, g = 0.f; if (rr >= 0) { b = BETA[(size_t)rr * 32 + hv]; g = GG[(size_t)rr * 32 + hv]; }
#pragma unroll
            for (int o = 1; o < 64; o <<= 1) { const float t = __shfl_up(g, o); if (lane >= o) g += t; }
            betaS[lane] = b; gcS[lane] = g; egcS[lane] = __expf(g); }
        __syncthreads();
        if ((hv & 1) == 0) { const size_t kunit = (size_t)hk * GDN_NCH + n;
#pragma unroll
            for (int i = 0; i < 2; ++i) { const int p = tid + 512 * i, comb = p >> 6, ln = p & 63, t = comb >> 3, s = comb & 7; const int c = 32 * t + (ln & 31), k0 = 16 * s + 8 * (ln >> 5);
                *(v4u*)(QF + (kunit * 16 + comb) * 512 + ln * 8) = *(const LAS v4u*)(qS + c * 272 + k0 * 2); } }
#pragma unroll
        for (int i = 0; i < 2; ++i) { const int p = tid + 512 * i, row = p >> 4, ch = p & 15; const v4u kx = *(const LAS v4u*)(kS + row * 272 + ch * 16); const float b = betaS[row];
            v4u o; o.x = pk2(bflo(kx.x) * b, bfhi(kx.x) * b); o.y = pk2(bflo(kx.y) * b, bfhi(kx.y) * b); o.z = pk2(bflo(kx.z) * b, bfhi(kx.z) * b); o.w = pk2(bflo(kx.w) * b, bfhi(kx.w) * b);
            *(LAS v4u*)(kbS + row * 272 + ch * 16) = o; }
        __syncthreads();
        { const int which = wave >> 2, ti = (wave >> 1) & 1, tj = wave & 1;
          f32x16 acc;
#pragma unroll
          for (int r = 0; r < 16; ++r) acc[r] = 0.f;
          if (!(ti == 0 && tj == 1)) { const LAS unsigned char* Ab = (which == 0 ? kbS : qS) + (32 * ti + l31) * 272 + 16 * h; const LAS unsigned char* Bb = kS + (32 * tj + l31) * 272 + 16 * h;
#pragma unroll
              for (int s = 0; s < 8; ++s) acc = MFMA32(*(const LAS bf16x8*)(Ab + 32 * s), *(const LAS bf16x8*)(Bb + 32 * s), acc); }
          const int j = 32 * tj + l31; const float gj = gcS[j];
#pragma unroll
          for (int r = 0; r < 16; ++r) { const int i = 32 * ti + crow(r, h); const float e = __expf(fminf(gcS[i] - gj, 0.f));
              if (which == 0) Lm[i * 68 + j] = i > j ? acc[r] * e : 0.f;
              else IS[i * 72 + j] = (bf16)f2bf(i >= j ? acc[r] * e : 0.f); } }
        __syncthreads();
#pragma unroll
        for (int i = 0; i < 8; ++i) { const int e = tid + 512 * i, r = e >> 6, c = e & 63; *(LAS bf16*)(Lb + r * 144 + c * 2) = (bf16)f2bf(Lm[r * 68 + c]); }
        if (wave == 0) { const int b = lane >> 4, c = lane & 15; float t[16]; const LAS float* Ld = Lm + (16 * b) * 68 + 16 * b;
#pragma unroll
            for (int i = 0; i < 16; ++i) { float acc = i == c ? 1.f : 0.f;
#pragma unroll
                for (int j = 0; j < i; ++j) acc -= Ld[i * 68 + j] * t[j];
                t[i] = acc; *(LAS bf16*)(TDs + (b * 16 + i) * 32 + c * 2) = (bf16)f2bf(acc); }
        } else if (wave >= 4) { const int t2 = tid - 256;
#pragma unroll
            for (int i = 0; i < 2; ++i) { const int p = t2 + 256 * i, comb = p >> 6, ln = p & 63, t = comb >> 2, s = comb & 3; const int c = 32 * t + (ln & 31), j0 = 16 * s + 8 * (ln >> 5);
                *(v4u*)(INF + (su * 8 + comb) * 512 + ln * 8) = *(const LAS v4u*)(IS + c * 72 + j0); }
            if ((hv & 1) == 0) { const size_t kunit = (size_t)hk * GDN_NCH + n;
#pragma unroll
                for (int i = 0; i < 4; ++i) { const int p = t2 + 256 * i, comb = p >> 6, ln = p & 63, kt = comb >> 2, s = comb & 3; const int kd = 32 * kt + (ln & 31), c0 = 16 * s + 8 * (ln >> 5);
                    unsigned w[4];
#pragma unroll
                    for (int jj = 0; jj < 4; ++jj) { const unsigned lo = *(const LAS bf16*)(kS + (c0 + 2 * jj) * 272 + kd * 2), hi = *(const LAS bf16*)(kS + (c0 + 2 * jj + 1) * 272 + kd * 2); w[jj] = lo | (hi << 16); }
                    *(v4u*)(KTF + (kunit * 16 + comb) * 512 + ln * 8) = (v4u){w[0], w[1], w[2], w[3]}; } }
            if (t2 < 64) GC[su * GC_STRIDE + t2] = gcS[t2];
            else if (t2 == 64) GC[su * GC_STRIDE + 64] = gcS[63];
            else if (t2 == 65) GC[su * GC_STRIDE + 65] = egcS[63];
        }
        __syncthreads();
        { const int quad = lane >> 4, lc = lane & 15; LAS unsigned char* XTw = XT0 + wave * 1792; LAS unsigned char* YTw = YT0 + wave * 768;
          const bf16x8 z8 = (bf16x8){0, 0, 0, 0, 0, 0, 0, 0}; const f32x4 z4 = (f32x4){0.f, 0.f, 0.f, 0.f};
          bf16x8 tdf[4];
#pragma unroll
          for (int b = 0; b < 4; ++b) tdf[b] = quad < 2 ? *(const LAS bf16x8*)(TDs + (b * 16 + lc) * 32 + quad * 16) : z8;
#pragma unroll 1
          for (int tl = 0; tl < 2; ++tl) { const int col = 32 * wave + 16 * tl + lc;
              const LAS unsigned char* rz = wave < 4 ? vS + col * 2 : kbS + (col - 128) * 2; const LAS float* bz = wave < 4 ? betaS : egcS;
#pragma unroll
              for (int b = 0; b < 4; ++b) { f32x4 y;
#pragma unroll
                  for (int r = 0; r < 4; ++r) { const int i = 16 * b + 4 * quad + r; y[r] = bf2f(*(const LAS bf16*)(rz + i * 272)) * bz[i]; }
                  if (b >= 1) { f32x4 p = z4;
#pragma unroll
                      for (int kk = 0; kk < (b >= 3 ? 2 : 1); ++kk) { const bf16x8 af = *(const LAS bf16x8*)(Lb + (16 * b + lc) * 144 + (32 * kk + 8 * quad) * 2);
                          const bf16x8 bfv = (32 * kk + 8 * quad < 16 * b) ? *(const LAS bf16x8*)(XTw + lc * 112 + (32 * kk + 8 * quad) * 2) : z8;
                          p = __builtin_amdgcn_mfma_f32_16x16x32_bf16(af, bfv, p, 0, 0, 0); }
                      y = y - p; }
                  *(LAS v2u*)(YTw + lc * 48 + quad * 8) = (v2u){pk2(y[0], y[1]), pk2(y[2], y[3])};
                  asm volatile("" ::: "memory");
                  const bf16x8 yb = quad < 2 ? *(const LAS bf16x8*)(YTw + lc * 48 + quad * 16) : z8;
                  const f32x4 x = __builtin_amdgcn_mfma_f32_16x16x32_bf16(tdf[b], yb, z4, 0, 0, 0);
                  if (b < 3) *(LAS v2u*)(XTw + lc * 112 + (16 * b + 4 * quad) * 2) = (v2u){pk2(x[0], x[1]), pk2(x[2], x[3])};
                  asm volatile("" ::: "memory");
#pragma unroll
                  for (int r = 0; r < 4; ++r) XS[(16 * b + 4 * quad + r) * 264 + col] = (bf16)f2bf(x[r]); } } }
        __syncthreads();
#pragma unroll
        for (int i = 0; i < 2; ++i) { const int p = tid + 512 * i, comb = p >> 6, ln = p & 63, t = comb >> 3, s = comb & 7; const int c = 32 * t + (ln & 31), k0 = 16 * s + 8 * (ln >> 5);
            *(v4u*)(WF + (su * 16 + comb) * 512 + ln * 8) = *(const LAS v4u*)(XS + c * 264 + 128 + k0); }
        { const int t = wave >> 2, ns = wave & 3; unsigned w[8];
#pragma unroll
          for (int r = 0; r < 8; ++r) { const unsigned lo = XS[(32 * t + crow(2 * r, h)) * 264 + 32 * ns + l31], hi = XS[(32 * t + crow(2 * r + 1, h)) * 264 + 32 * ns + l31]; w[r] = lo | (hi << 16); }
          bf16* dst = UF + ((su * 8 + wave) * 64 + lane) * 16; *(v4u*)dst = (v4u){w[0], w[1], w[2], w[3]}; *(v4u*)(dst + 8) = (v4u){w[4], w[5], w[6], w[7]}; }
        __syncthreads();
    }
}

DI void ph_gdn_chain(const Frame& F, const Args& a, int n_lo, int n_hi) {
    const int xg = F.vcu >> 5, wx = F.vcu & 31; if (F.G != 256 ? F.vcu >= 128 : wx >= 20) return;
    const bool helper = F.G == 256 && wx >= 16;
    const int hv = F.G == 256 ? 4 * xg + (helper ? wx - 16 : wx >> 2) : F.vcu >> 2, ns = F.G == 256 ? wx & 3 : F.vcu & 3, hk = hv >> 1;
    const bf16* QN = (const bf16*)(a.ws + WS_SCR + SC_QN);
    const bf16* WF = (const bf16*)(a.ws + GD_WF); const bf16* UF = (const bf16*)(a.ws + GD_UF); const bf16* INF = (const bf16*)(a.ws + GD_IN); const bf16* KTF = (const bf16*)(a.ws + GD_KT); const bf16* QF = (const bf16*)(a.ws + GD_QF); const float* GC = (const float*)(a.ws + GD_GC);
    bf16* O = (bf16*)(a.ws + WS_SCR + SC_O);
    gu32* prog = F.ctl + CW_PROG + hv * 16;
    if (helper && GDN_NO_HELPER) return;
    if (helper) { unsigned sink = 0u; const int tid = F.tid;
        for (int n0 = n_lo; n0 < n_hi; n0 += 4) {
            if (n0 >= n_lo + 8) { if (tid == 0) { unsigned sp = 0; while ((int)__hip_atomic_load(prog, RLX_AGENT) < n0 - 4 && ++sp < 20000u) __builtin_amdgcn_s_sleep(8); } __syncthreads(); }
            unsigned v[5];
#pragma unroll
            for (int i = 0; i < 5; ++i) { const int li = tid + 512 * i;
                const int st = li / 580, ln = li % 580, n = n0 + st; const unsigned* p = nullptr;
                if (st < 4 && n < n_hi) { const size_t unit = (size_t)hv * GDN_NCH + n, kunit = (size_t)hk * GDN_NCH + n;
                    if (ln < 128) p = (const unsigned*)(WF + unit * 8192 + ln * 64);
                    else if (ln < 256) p = (const unsigned*)(UF + unit * 8192 + (ln - 128) * 64);
                    else if (ln < 320) p = (const unsigned*)(INF + unit * 4096 + (ln - 256) * 64);
                    else if (ln < 448) p = (const unsigned*)(KTF + kunit * 8192 + (ln - 320) * 64);
                    else if (ln < 576) p = (const unsigned*)(QF + kunit * 8192 + (ln - 448) * 64);
                    else if (ln < 579) p = (const unsigned*)(GC + unit * GC_STRIDE + (ln - 576) * 32); }
                v[i] = p ? *p : 0u; }
#pragma unroll
            for (int i = 0; i < 5; ++i) sink += v[i];
        }
        if (sink == 0x12345u) __hip_atomic_store(F.ctl + CW_TMO + 2, sink, RLX_AGENT);
        return; }
    LAS unsigned char* ST = F.lds + RING_OFF; LAS unsigned char* VN = ST + 8704; LAS unsigned char* VND = ST + 13312;
    const int lane = F.lane, wave = F.wave, l31 = lane & 31, h = lane >> 5;
    for (int i = F.tid; i < 8704 / 4; i += NWAVES * 64) ((LAS unsigned*)ST)[i] = 0u;
#define GDN_BAR() do { asm volatile("s_waitcnt lgkmcnt(0)" ::: "memory"); __builtin_amdgcn_s_barrier(); asm volatile("" ::: "memory"); } while (0)
    GDN_BAR();
    f32x16 S;
#pragma unroll
    for (int r = 0; r < 16; ++r) S[r] = 0.f;
    const int role = wave < 2 ? 0 : (wave < 4 ? 1 : 2); const int t = wave & 1, kt = wave & 3;
    bf16x8 A8[8]; bf16x8 A4[4]; v4u U0 = (v4u){0u, 0u, 0u, 0u}, U1 = U0; f32x4 G4[4]; float gl = 0.f, egl = 1.f;
#pragma unroll
    for (int s = 0; s < 8; ++s) A8[s] = (bf16x8){0, 0, 0, 0, 0, 0, 0, 0};
#pragma unroll
    for (int s = 0; s < 4; ++s) { A4[s] = (bf16x8){0, 0, 0, 0, 0, 0, 0, 0}; G4[s] = (f32x4){0.f, 0.f, 0.f, 0.f}; }
#define GDN_LOAD(nn) do { const size_t unit_ = (size_t)hv * GDN_NCH + (nn); const float* gc_ = GC + unit_ * GC_STRIDE; \
        if (role == 0) { \
            const bf16* up_ = UF + (((unit_ * 2 + t) * 4 + ns) * 64 + lane) * 16; U0 = *(const v4u*)up_; U1 = *(const v4u*)(up_ + 8); \
            _Pragma("unroll") for (int g = 0; g < 4; ++g) G4[g] = *(const f32x4*)(gc_ + 32 * t + 8 * g + 4 * h); gl = gc_[64]; } \
        else if (role == 1) { const size_t qunit_ = (size_t)hk * GDN_NCH + (nn); \
            _Pragma("unroll") for (int s = 0; s < 4; ++s) A4[s] = *(const bf16x8*)(INF + ((unit_ * 2 + t) * 4 + s) * 512 + lane * 8); \
            _Pragma("unroll") for (int g = 0; g < 4; ++g) G4[g] = *(const f32x4*)(gc_ + 32 * t + 8 * g + 4 * h); } \
        else { const size_t kunit_ = (size_t)hk * GDN_NCH + (nn); \
            _Pragma("unroll") for (int s = 0; s < 4; ++s) A4[s] = *(const bf16x8*)(KTF + ((kunit_ * 4 + kt) * 4 + s) * 512 + lane * 8); egl = gc_[65]; } } while (0)
    float* SV = (float*)(a.ws + GD_SAVE) + ((size_t)((hv * 4 + ns) * 4 + kt) * 64 + lane) * 16;
    if (n_lo > 0 && role == 2) {
#pragma unroll
        for (int g = 0; g < 4; ++g) { const f32x4 v = *(const f32x4*)(SV + 4 * g); S[4 * g] = v.x; S[4 * g + 1] = v.y; S[4 * g + 2] = v.z; S[4 * g + 3] = v.w;
            *(LAS v2u*)(ST + l31 * 272 + (32 * kt + 8 * g + 4 * h) * 2) = (v2u){pk2(v.x, v.y), pk2(v.z, v.w)}; }
    }
    GDN_BAR();
#define GDN_LOADA(AC, nn) do { if (role == 0) { const size_t u_ = (size_t)hv * GDN_NCH + (nn); _Pragma("unroll") for (int s = 0; s < 8; ++s) AC[s] = *(const bf16x8*)(WF + ((u_ * 2 + t) * 8 + s) * 512 + lane * 8); } \
        else if (role == 1) { const size_t q_ = (size_t)hk * GDN_NCH + (nn); _Pragma("unroll") for (int s = 0; s < 8; ++s) AC[s] = *(const bf16x8*)(QF + ((q_ * 2 + t) * 8 + s) * 512 + lane * 8); } } while (0)
    bf16x8 A8q[8];
#pragma unroll
    for (int s = 0; s < 8; ++s) A8q[s] = (bf16x8){0, 0, 0, 0, 0, 0, 0, 0};
    GDN_LOADA(A8, n_lo); if (n_lo + 1 < n_hi) GDN_LOADA(A8q, n_lo + 1);
    GDN_LOAD(n_lo);
#define GDN_STEP(n, AC) do { \
        bf16x8 a4[4]; const v4u u0 = U0, u1 = U1; f32x4 g4[4]; const float cgl = gl, cegl = egl; \
        _Pragma("unroll") \
        for (int s = 0; s < 4; ++s) { a4[s] = A4[s]; g4[s] = G4[s]; } \
        if (n + 1 < n_hi) GDN_LOAD(n + 1); \
        if (ns == 0 && F.tid == 0) __hip_atomic_store(prog, (unsigned)n, RLX_AGENT); \
        f32x16 acc; \
        _Pragma("unroll") \
        for (int r = 0; r < 16; ++r) acc[r] = 0.f; \
        if (role < 2) { \
        _Pragma("unroll") \
            for (int s = 0; s < 8; ++s) acc = MFMA32(AC[s], *(const LAS bf16x8*)(ST + l31 * 272 + 32 * s + 16 * h), acc); \
            asm volatile("" :: "v"(acc[0])); \
            if (n + 2 < n_hi) GDN_LOADA(AC, n + 2); \
        } \
        if (role == 0) { const unsigned uw[8] = {u0.x, u0.y, u0.z, u0.w, u1.x, u1.y, u1.z, u1.w}; \
        _Pragma("unroll") \
            for (int g = 0; g < 4; ++g) { float vn[4], vd[4]; \
        _Pragma("unroll") \
                for (int q = 0; q < 4; ++q) { const int r = 4 * g + q; const float uv = (r & 1) ? bfhi(uw[r >> 1]) : bflo(uw[r >> 1]); vn[q] = uv - acc[r]; vd[q] = vn[q] * __expf(cgl - g4[g][q]); } \
                *(LAS v2u*)(VN + l31 * 144 + (32 * t + 8 * g + 4 * h) * 2) = (v2u){pk2(vn[0], vn[1]), pk2(vn[2], vn[3])}; \
                *(LAS v2u*)(VND + l31 * 144 + (32 * t + 8 * g + 4 * h) * 2) = (v2u){pk2(vd[0], vd[1]), pk2(vd[2], vd[3])}; } \
        } else if (role == 1) { \
        _Pragma("unroll") \
            for (int g = 0; g < 4; ++g) \
        _Pragma("unroll") \
                for (int q = 0; q < 4; ++q) acc[4 * g + q] *= __expf(g4[g][q]); \
        } \
        GDN_BAR(); \
        if (role == 1) { \
        _Pragma("unroll") \
            for (int s = 0; s < 4; ++s) acc = MFMA32(a4[s], *(const LAS bf16x8*)(VN + l31 * 144 + 32 * s + 16 * h), acc); \
        _Pragma("unroll") \
            for (int r = 0; r < 16; ++r) { const int rr = chunk_row(n, 32 * t + crow(r, h)); if (rr >= 0) O[(size_t)rr * 4096 + hv * 128 + 32 * ns + l31] = (bf16)f2bf(acc[r]); } \
        } else if (role == 2) { \
        _Pragma("unroll") \
            for (int r = 0; r < 16; ++r) S[r] *= cegl; \
        _Pragma("unroll") \
            for (int s = 0; s < 4; ++s) S = MFMA32(a4[s], *(const LAS bf16x8*)(VND + l31 * 144 + 32 * s + 16 * h), S); \
        _Pragma("unroll") \
            for (int g = 0; g < 4; ++g) *(LAS v2u*)(ST + l31 * 272 + (32 * kt + 8 * g + 4 * h) * 2) = (v2u){pk2(S[4 * g], S[4 * g + 1]), pk2(S[4 * g + 2], S[4 * g + 3])}; \
        } \
        GDN_BAR(); \
    } while (0)
    for (int n2 = n_lo; n2 < n_hi; n2 += 2) { GDN_STEP(n2, A8); if (n2 + 1 < n_hi) GDN_STEP(n2 + 1, A8q); }
#undef GDN_STEP
#undef GDN_LOADA
    if (n_hi < GDN_NCH && role == 2) {
#pragma unroll
        for (int g = 0; g < 4; ++g) *(f32x4*)(SV + 4 * g) = (f32x4){S[4 * g], S[4 * g + 1], S[4 * g + 2], S[4 * g + 3]}; }
#undef GDN_LOAD
#undef GDN_BAR
}

constexpr int RW_NSC = 258, RW_UNITS = 129 * 16;
DI int sub_row(int sc, int t) { const int n = sc >> 1, sub = sc & 1; return n == 0 ? ((sub == 0 && t >= 16) ? TX + t - 16 : -1) : 64 * (n - 1) + 32 * sub + t; }
constexpr size_t RW_BASE = WS_PROJ + 92 * MiB;
constexpr size_t RW_RH = RW_BASE, RW_RL = RW_BASE + 33 * MiB, RW_GT = RW_BASE + 66 * MiB, RW_GAM = RW_BASE + 99 * MiB;
constexpr size_t RW_PR = WS_SCR + 195 * MiB, RW_AT = WS_SCR + 211 * MiB + 256 * 1024, RW_VTF = WS_SCR + 219 * MiB + 512 * 1024, RW_SALL = WS_SCR + 235 * MiB + 768 * 1024;
constexpr size_t RW_XSAVE = 1 * MiB + 640 * 1024;
constexpr size_t RW_VV = WS_YMIX + 34 * MiB, RW_BON = WS_YMIX + 52 * MiB, LR_H = WS_YMIX + 54 * MiB, LR_A = WS_YMIX + 56 * MiB, LR_C = WS_YMIX + 58 * MiB;
constexpr size_t RW_SCH = (size_t)RW_NSC * 16;
static_assert((size_t)MP * EV_NP * 2 <= 92 * MiB && RW_SCH * 8192 <= 33 * MiB && RW_GAM + RW_SCH * 256 <= WS_SCR, "rwkv map (proj region)");
static_assert(WS_SCR + SC_LIX + (size_t)MP * 4096 <= RW_PR && RW_PR + RW_SCH * 4096 <= RW_AT && RW_AT + RW_SCH * 2048 <= RW_VTF && RW_VTF + RW_SCH * 4096 <= RW_SALL && RW_SALL + RW_SCH * 8192 <= WS_END, "rwkv map (scratch region)");
static_assert((size_t)MP * DM * 2 <= 34 * MiB && RW_VV + (size_t)MP * 2048 <= RW_BON && RW_BON + (size_t)MP * 64 <= LR_H && LR_H + RW_SCH * 256 <= LR_A && LR_A + RW_SCH * 256 <= LR_C && LR_C + RW_SCH * 256 <= WS_PROJ, "rwkv map (ymix region)");

DI void sub_rows(int sc, int& t0, int& rbase) { if (sc >= 2) { t0 = 0; rbase = 64 * ((sc >> 1) - 1) + 32 * (sc & 1); } else if (sc == 0) { t0 = 16; rbase = TX - 16; } else { t0 = 32; rbase = 0; } }
DI void lru_local(const Frame& F, const Args& a, int gw, int ngw) {
    const bf16* LA = (const bf16*)(a.ws + WS_SCR + SC_LA); const bf16* LIX = (const bf16*)(a.ws + WS_SCR + SC_LIX);
    float* HL = (float*)(a.ws + LR_H); float* AP = (float*)(a.ws + LR_A);
    for (int item = gw; item < RW_NSC * 16; item += ngw) { const int sc = item >> 4, c = (item & 15) * 64 + F.lane; int t0, rbase; sub_rows(sc, t0, rbase);
        float av[32], ix[32];
#pragma unroll
        for (int t = 0; t < 32; ++t) { const size_t o = (size_t)(rbase + (t >= t0 ? t : 32)) * 1024 + c; av[t] = bf2f(LA[o]); ix[t] = bf2f(LIX[o]); }
        float h = 0.f, p = 1.f;
#pragma unroll
        for (int t = 0; t < 32; ++t) { const float om = t >= t0 ? av[t] : 0.f, x_ = t >= t0 ? ix[t] : 0.f, a_ = 1.0f - om; h = a_ * h + sqrtf(om * (1.0f + a_)) * x_; p *= a_; }
        HL[sc * 1024 + c] = h; AP[sc * 1024 + c] = p; }
}
DI void lru_apply(const Frame& F, const Args& a) {
    const bf16* P = (const bf16*)(a.ws + WS_PROJ); const bf16* LA = (const bf16*)(a.ws + WS_SCR + SC_LA); const bf16* LIX = (const bf16*)(a.ws + WS_SCR + SC_LIX);
    const float* CR = (const float*)(a.ws + LR_C); bf16* Y = (bf16*)(a.ws + WS_YMIX);
    for (int item = F.gw; item < RW_NSC * 16; item += F.NGW) { const int sc = item >> 4, c = (item & 15) * 64 + F.lane; int t0, rbase; sub_rows(sc, t0, rbase); if (t0 >= 32) continue;
        float h = CR[sc * 1024 + c];
#pragma unroll
        for (int tb = 0; tb < 32; tb += 16) { float av[16], ix[16], gb[16];
#pragma unroll
            for (int t = 0; t < 16; ++t) { const size_t r_ = (size_t)(rbase + (tb + t >= t0 ? tb + t : 32)); av[t] = bf2f(LA[r_ * 1024 + c]); ix[t] = bf2f(LIX[r_ * 1024 + c]); gb[t] = bf2f(P[r_ * EV_NP + EV_GB + c]); }
#pragma unroll
            for (int t = 0; t < 16; ++t) { if (tb + t >= t0) { const float a_ = 1.0f - av[t]; h = a_ * h + sqrtf(av[t] * (1.0f + a_)) * ix[t]; Y[(size_t)(rbase + tb + t) * DM + 1024 + c] = (bf16)f2bf(h * gelu_tanh(gb[t])); } } } }
}

DI void ph_rwkv_chunk(const Frame& F, const Args& a, int n_lo, int n_hi, int wg0) {
    if (F.vcu < wg0) return;
    const bf16* P = (const bf16*)(a.ws + WS_PROJ); const bf16* DEC = (const bf16*)(a.ws + WS_SCR + SC_DEC); const bf16* ICL = (const bf16*)(a.ws + WS_SCR + SC_ICL);
    bf16* RH = (bf16*)(a.ws + RW_RH); bf16* RL = (bf16*)(a.ws + RW_RL); bf16* GT = (bf16*)(a.ws + RW_GT); float* GAM = (float*)(a.ws + RW_GAM); bf16* PR = (bf16*)(a.ws + RW_PR); bf16* ATG = (bf16*)(a.ws + RW_AT); bf16* VTF = (bf16*)(a.ws + RW_VTF);
    bf16* VV = (bf16*)(a.ws + RW_VV); float* BON = (float*)(a.ws + RW_BON);
    LAS unsigned char* L = F.lds + RING_OFF;
    LAS float* wS = (LAS float*)L; LAS float* aS = wS + 4096; LAS float* bS = wS + 8192; LAS float* rS = wS + 12288; LAS float* kS = wS + 16384;
    LAS unsigned char* vT = L + 81920; LAS unsigned char* aT = L + 91136; LAS unsigned char* rT = L + 100352; LAS unsigned char* kT = L + 109568; LAS unsigned char* bT = L + 118784;
    LAS unsigned char* AT = L + 128000; LAS unsigned char* NT = L + 133120; LAS float* gam = (LAS float*)(L + 138240);
    LAS unsigned char* aTl = L; LAS unsigned char* bTl = L + 9216;
    const int tid = F.tid, lane = F.lane, wave = F.wave, l31 = lane & 31, h = lane >> 5;
    const float* mu = a.in[6];
    for (int unit = n_lo * 16 + (F.vcu - wg0); unit < n_hi * 16; unit += F.G - wg0) {
        const int n = unit >> 4, hd = unit & 15;
        { const int tok = tid >> 3, cg = tid & 7, c0 = hd * 64 + cg * 8; const int rr = sub_row(2 * n + (tok >> 5), tok & 31);
          float wv[8], av[8], bv[8], rv[8], kv[8], vv[8];
#pragma unroll
          for (int q = 0; q < 8; ++q) { wv[q] = 1.f; av[q] = 0.f; bv[q] = 0.f; rv[q] = 0.f; kv[q] = 0.f; vv[q] = 0.f; }
          if (rr >= 0) { const int pos = row_pos(rr); const bf16* cur = P + (size_t)rr * EV_NP + c0; const bf16* prv = pos > 0 ? P + (size_t)pos_row(pos - 1) * EV_NP + c0 : nullptr;
              const v4u z4 = (v4u){0u, 0u, 0u, 0u};
              const v4u cr = *(const v4u*)cur, ck = *(const v4u*)(cur + 1024), cv = *(const v4u*)(cur + 2048);
              const v4u qr = prv ? *(const v4u*)prv : z4, qk = prv ? *(const v4u*)(prv + 1024) : z4, qv = prv ? *(const v4u*)(prv + 2048) : z4;
              const unsigned crw[4] = {cr.x, cr.y, cr.z, cr.w}, ckw[4] = {ck.x, ck.y, ck.z, ck.w}, cvw[4] = {cv.x, cv.y, cv.z, cv.w}, qrw[4] = {qr.x, qr.y, qr.z, qr.w}, qkw[4] = {qk.x, qk.y, qk.z, qk.w}, qvw[4] = {qv.x, qv.y, qv.z, qv.w};
              float ss = 0.f, bon = 0.f; float kk[8], ic[8];
#pragma unroll
              for (int q = 0; q < 8; ++q) { const int c = c0 + q; const float crf = (q & 1) ? bfhi(crw[q >> 1]) : bflo(crw[q >> 1]), ckf = (q & 1) ? bfhi(ckw[q >> 1]) : bflo(ckw[q >> 1]), cvf = (q & 1) ? bfhi(cvw[q >> 1]) : bflo(cvw[q >> 1]);
                  const float prf = (q & 1) ? bfhi(qrw[q >> 1]) : bflo(qrw[q >> 1]), pkf = (q & 1) ? bfhi(qkw[q >> 1]) : bflo(qkw[q >> 1]), pvf = (q & 1) ? bfhi(qvw[q >> 1]) : bflo(qvw[q >> 1]);
                  rv[q] = crf + (prf - crf) * mu[c]; kk[q] = ckf + (pkf - ckf) * mu[1024 + c]; vv[q] = cvf + (pvf - cvf) * mu[2048 + c];
                  wv[q] = 1.0f - bf2f(DEC[(size_t)rr * 1024 + c]); ic[q] = bf2f(ICL[(size_t)rr * 1024 + c]);
                  const float kkv = kk[q] * a.in[12][c]; av[q] = kkv; ss += kkv * kkv; kv[q] = kk[q] * (1.0f + (ic[q] - 1.0f) * a.in[13][c]); bon += rv[q] * kv[q] * a.in[14][c]; }
              ss += __shfl_xor(ss, 1); ss += __shfl_xor(ss, 2); ss += __shfl_xor(ss, 4); bon += __shfl_xor(bon, 1); bon += __shfl_xor(bon, 2); bon += __shfl_xor(bon, 4);
              const float inv = 1.0f / fmaxf(sqrtf(ss), 1e-12f);
#pragma unroll
              for (int q = 0; q < 8; ++q) { const float kkn = av[q] * inv; av[q] = -kkn; bv[q] = kkn * ic[q]; }
              if (cg == 0) BON[(size_t)rr * 16 + hd] = bon;
              *(v4u*)(VV + (size_t)rr * 1024 + c0) = (v4u){pk2(vv[0], vv[1]), pk2(vv[2], vv[3]), pk2(vv[4], vv[5]), pk2(vv[6], vv[7])}; }
          const int o = tok * 64 + cg * 8;
          *(LAS f32x4*)(wS + o) = (f32x4){wv[0], wv[1], wv[2], wv[3]}; *(LAS f32x4*)(wS + o + 4) = (f32x4){wv[4], wv[5], wv[6], wv[7]};
          *(LAS f32x4*)(aS + o) = (f32x4){av[0], av[1], av[2], av[3]}; *(LAS f32x4*)(aS + o + 4) = (f32x4){av[4], av[5], av[6], av[7]};
          *(LAS f32x4*)(bS + o) = (f32x4){bv[0], bv[1], bv[2], bv[3]}; *(LAS f32x4*)(bS + o + 4) = (f32x4){bv[4], bv[5], bv[6], bv[7]};
          *(LAS f32x4*)(rS + o) = (f32x4){rv[0], rv[1], rv[2], rv[3]}; *(LAS f32x4*)(rS + o + 4) = (f32x4){rv[4], rv[5], rv[6], rv[7]};
          *(LAS f32x4*)(kS + o) = (f32x4){kv[0], kv[1], kv[2], kv[3]}; *(LAS f32x4*)(kS + o + 4) = (f32x4){kv[4], kv[5], kv[6], kv[7]};
#pragma unroll
          for (int q = 0; q < 8; ++q) *(LAS bf16*)(vT + (cg * 8 + q) * 144 + tok * 2) = (bf16)f2bf(vv[q]); }
        __syncthreads();
        { const int p = wave >> 2, sub = (wave >> 1) & 1, half = wave & 1, sl = lane >> 2, q = lane & 3, s = 16 * half + sl, tok = 32 * sub + s, jq = 16 * q;
          const LAS float* x0p = (p == 0 ? kS : bS) + tok * 64 + jq; LAS unsigned char* OUT = p == 0 ? AT : NT;
          float x[16];
#pragma unroll
          for (int j = 0; j < 16; j += 4) { const f32x4 t4 = *(const LAS f32x4*)(x0p + j); x[j] = t4.x; x[j + 1] = t4.y; x[j + 2] = t4.z; x[j + 3] = t4.w; }
          if (half) {
#pragma unroll
              for (int i = 0; i < 4; ++i) *(LAS bf16*)(OUT + ((sub * 32 + 4 * q + i) * 40 + s) * 2) = (bf16)0; }
#pragma unroll 2
          for (int tp = 16 * half; tp < 32; ++tp) { const LAS float* bp = wS + (32 * sub + tp) * 64 + jq; const bool run = tp > s;
              f32x4 a4[4], w4[4], b4[4], r4[4];
#pragma unroll
              for (int g = 0; g < 4; ++g) { a4[g] = *(const LAS f32x4*)(bp + 4096 + 4 * g); w4[g] = *(const LAS f32x4*)(bp + 4 * g); b4[g] = *(const LAS f32x4*)(bp + 8192 + 4 * g); r4[g] = *(const LAS f32x4*)(bp + 12288 + 4 * g); }
              float c = 0.f;
#pragma unroll
              for (int g = 0; g < 4; ++g) { c += x[4 * g] * a4[g].x; c += x[4 * g + 1] * a4[g].y; c += x[4 * g + 2] * a4[g].z; c += x[4 * g + 3] * a4[g].w; }
              c += __builtin_bit_cast(float, __builtin_amdgcn_mov_dpp(__builtin_bit_cast(int, c), 0xB1, 0xF, 0xF, true));
              c += __builtin_bit_cast(float, __builtin_amdgcn_mov_dpp(__builtin_bit_cast(int, c), 0x4E, 0xF, 0xF, true));
              float o = 0.f;
#pragma unroll
              for (int g = 0; g < 4; ++g) { const float n0 = x[4 * g] * w4[g].x + c * b4[g].x, n1 = x[4 * g + 1] * w4[g].y + c * b4[g].y, n2 = x[4 * g + 2] * w4[g].z + c * b4[g].z, n3 = x[4 * g + 3] * w4[g].w + c * b4[g].w;
                  x[4 * g] = run ? n0 : x[4 * g]; x[4 * g + 1] = run ? n1 : x[4 * g + 1]; x[4 * g + 2] = run ? n2 : x[4 * g + 2]; x[4 * g + 3] = run ? n3 : x[4 * g + 3];
                  o += x[4 * g] * r4[g].x; o += x[4 * g + 1] * r4[g].y; o += x[4 * g + 2] * r4[g].z; o += x[4 * g + 3] * r4[g].w; }
              o += __builtin_bit_cast(float, __builtin_amdgcn_mov_dpp(__builtin_bit_cast(int, o), 0xB1, 0xF, 0xF, true));
              o += __builtin_bit_cast(float, __builtin_amdgcn_mov_dpp(__builtin_bit_cast(int, o), 0x4E, 0xF, 0xF, true));
              if (q == 0) *(LAS bf16*)(OUT + ((sub * 32 + tp) * 40 + s) * 2) = (bf16)f2bf(tp >= s ? o : 0.f); }
          LAS unsigned char* XT = p == 0 ? kT : bT;
#pragma unroll
          for (int j = 0; j < 16; ++j) *(LAS bf16*)(XT + (jq + j) * 144 + tok * 2) = (bf16)f2bf(x[j]);
          const bool gwave = (p == 0 && half == 1); const int j = lane;
          if (gwave) { float g = 1.f;
#pragma unroll
              for (int tp = 0; tp < 32; ++tp) { const int tk = 32 * sub + tp; const float w_ = wS[tk * 64 + j], a_ = aS[tk * 64 + j], r_ = rS[tk * 64 + j];
                  *(LAS bf16*)(aT + j * 144 + tk * 2) = (bf16)f2bf(a_ * g);
                  g *= w_; *(LAS bf16*)(rT + j * 144 + tk * 2) = (bf16)f2bf(r_ * g); }
              gam[sub * 64 + j] = g; }
        }
        __syncthreads();
        { const int sub = wave >> 2, t1 = (wave >> 1) & 1, t0 = wave & 1; const size_t sch = (size_t)hd * RW_NSC + (2 * n + sub);
          { f32x16 acc;
#pragma unroll
            for (int r = 0; r < 16; ++r) acc[r] = 0.f;
#pragma unroll
            for (int ks = 0; ks < 2; ++ks) { const int ao = (32 * t1 + l31) * 144 + (32 * sub + 16 * ks + 8 * h) * 2, bo = (32 * t0 + l31) * 144 + (32 * sub + 16 * ks + 8 * h) * 2;
                acc = MFMA32(*(const LAS bf16x8*)(aT + ao), *(const LAS bf16x8*)(bT + bo), acc); }
            const int jp = 32 * t0 + l31;
#pragma unroll
            for (int g = 0; g < 4; ++g) *(v2u*)(RH + (sch * 64 + jp) * 64 + 32 * t1 + 8 * g + 4 * h) = (v2u){pk2(acc[4 * g], acc[4 * g + 1]), pk2(acc[4 * g + 2], acc[4 * g + 3])};
            if (t1 == 0 && t0 == 0) GAM[sch * 64 + lane] = gam[sub * 64 + lane]; }
          { f32x16 acc;
#pragma unroll
            for (int r = 0; r < 16; ++r) acc[r] = 0.f;
#pragma unroll
            for (int ks = 0; ks < 2; ++ks) acc = MFMA32(*(const LAS bf16x8*)(kT + (32 * t1 + l31) * 144 + (32 * sub + 16 * ks + 8 * h) * 2), *(const LAS bf16x8*)(vT + (32 * t0 + l31) * 144 + (32 * sub + 16 * ks + 8 * h) * 2), acc);
            bf16* dst = GT + ((sch * 4 + t1 * 2 + t0) * 64 + lane) * 16;
            *(v4u*)dst = (v4u){pk2(acc[0], acc[1]), pk2(acc[2], acc[3]), pk2(acc[4], acc[5]), pk2(acc[6], acc[7])}; *(v4u*)(dst + 8) = (v4u){pk2(acc[8], acc[9]), pk2(acc[10], acc[11]), pk2(acc[12], acc[13]), pk2(acc[14], acc[15])}; } }
        if (wave < 4) { const int sub = wave >> 1, jt = wave & 1; const size_t sch = (size_t)hd * RW_NSC + (2 * n + sub);
            f32x16 acc;
#pragma unroll
            for (int r = 0; r < 16; ++r) acc[r] = bf2f(*(const LAS bf16*)(rT + (32 * jt + crow(r, h)) * 144 + (32 * sub + l31) * 2));
#pragma unroll
            for (int ks = 0; ks < 2; ++ks) acc = MFMA32(*(const LAS bf16x8*)(aT + (32 * jt + l31) * 144 + (32 * sub + 16 * ks + 8 * h) * 2), *(const LAS bf16x8*)(NT + (sub * 32 + l31) * 80 + (16 * ks + 8 * h) * 2), acc);
#pragma unroll
            for (int g = 0; g < 4; ++g) *(v2u*)(PR + (sch * 32 + l31) * 64 + 32 * jt + 8 * g + 4 * h) = (v2u){pk2(acc[4 * g], acc[4 * g + 1]), pk2(acc[4 * g + 2], acc[4 * g + 3])};
        } else { const int t2 = tid - 256, sub = t2 >> 7, t = (t2 >> 2) & 31, s8 = (t2 & 3) * 8; const size_t sch = (size_t)hd * RW_NSC + (2 * n + sub);
            *(v4u*)(ATG + (sch * 32 + t) * 32 + s8) = *(const LAS v4u*)(AT + (sub * 32 + t) * 80 + s8 * 2); }
        { const int sub = tid >> 8, it = (tid >> 7) & 1, ks = (tid >> 6) & 1; const size_t sch = (size_t)hd * RW_NSC + (2 * n + sub);
          *(v4u*)(VTF + ((sch * 4 + it * 2 + ks) * 64 + lane) * 8) = *(const LAS v4u*)(vT + (32 * it + l31) * 144 + (32 * sub + 16 * ks + 8 * h) * 2); }
        __syncthreads();
    }
}

DI void ph_rwkv_chain(const Frame& F, const Args& a, int sc_lo, int sc_hi) {
    if (F.vcu >= 16 && F.vcu < 18) { if (sc_hi < RW_NSC) return; const int c = (F.vcu - 16) * 512 + F.tid; const float* HL = (const float*)(a.ws + LR_H); const float* AP = (const float*)(a.ws + LR_A); float* CR = (float*)(a.ws + LR_C);
        float carry = 0.f;
#pragma unroll 8
        for (int sc = 0; sc < RW_NSC; ++sc) { const float hl = HL[sc * 1024 + c], ap = AP[sc * 1024 + c]; CR[sc * 1024 + c] = carry; carry = ap * carry + hl; }
        return; }
    if (F.vcu >= 16) return;
    const int hd = F.vcu; const bf16* RH = (const bf16*)(a.ws + RW_RH); const bf16* RL = (const bf16*)(a.ws + RW_RL); const bf16* GT = (const bf16*)(a.ws + RW_GT); const float* GAM = (const float*)(a.ws + RW_GAM); bf16* SALL = (bf16*)(a.ws + RW_SALL);
    constexpr int RW_NS = 7, SLOT = 8192 + 8192 + 1024;
    LAS unsigned char* XS = F.lds + RING_OFF; LAS unsigned char* RG = XS + 2 * 9216;
    const int lane = F.lane, wave = F.wave, l31 = lane & 31, h = lane >> 5, jt = (wave >> 1) & 1, it = wave & 1, lw = wave & 3;
    for (int i = F.tid; i < 2 * 9216 / 4; i += NWAVES * 64) ((LAS unsigned*)XS)[i] = 0u;
    __syncthreads();
#define RW_BAR() do { asm volatile("s_waitcnt lgkmcnt(0)" ::: "memory"); __builtin_amdgcn_s_barrier(); asm volatile("" ::: "memory"); } while (0)
    const unsigned rg0 = (unsigned)(uintptr_t)RG;
    int offR[2], offG[2];
#pragma unroll
    for (int i = 0; i < 2; ++i) { const int b = 2 * lw + i, row = 8 * b + (lane >> 3), pc = lane & 7; offR[i] = row * 64 + ((pc ^ (row & 7)) * 8); offG[i] = (b * 64 + lane) * 8; }
    const int offM = (lane & 15) * 4;
#define RW_DMA(src, dst) do { unsigned keep_; asm volatile("s_mov_b32 %0, m0\n\ts_mov_b32 m0, %2\n\ts_nop 0\n\tglobal_load_lds_dwordx4 %1, off\n\ts_mov_b32 m0, %0" : "=&s"(keep_) : "v"(src), "s"(dst) : "memory"); } while (0)
#define RW_ISSUE(scn) do { const int s_ = (scn) < RW_NSC ? (scn) : RW_NSC - 1; const size_t sch_ = (size_t)hd * RW_NSC + s_; \
        const unsigned sb_ = (unsigned)__builtin_amdgcn_readfirstlane((int)(rg0 + (unsigned)((scn) % RW_NS) * SLOT)); \
        _Pragma("unroll") for (int i_ = 0; i_ < 2; ++i_) { const unsigned bo_ = (unsigned)__builtin_amdgcn_readfirstlane((2 * lw + i_) * 1024); \
            RW_DMA(RH + sch_ * 4096 + offR[i_], sb_ + bo_); RW_DMA(GT + sch_ * 4096 + offG[i_], sb_ + 8192 + bo_); } \
        RW_DMA(GAM + sch_ * 64 + offM, sb_ + 16384); } while (0)
#define RW_WAITV(n) asm volatile("s_waitcnt vmcnt(" #n ")" ::: "memory")
    f32x16 X;
#pragma unroll
    for (int r = 0; r < 16; ++r) X[r] = 0.f;
    float* XSV = (float*)(a.ws + RW_XSAVE) + ((size_t)(hd * 4 + (wave & 3)) * 64 + lane) * 16;
    if (wave < 4 && sc_lo > 0) {
#pragma unroll
        for (int g = 0; g < 4; ++g) { const f32x4 v = *(const f32x4*)(XSV + 4 * g); X[4 * g] = v.x; X[4 * g + 1] = v.y; X[4 * g + 2] = v.z; X[4 * g + 3] = v.w;
            *(LAS v2u*)(XS + (32 * it + l31) * 144 + (32 * jt + 8 * g + 4 * h) * 2) = (v2u){pk2(v.x, v.y), pk2(v.z, v.w)}; } }
    if (wave >= 4) { RW_ISSUE(sc_lo); RW_ISSUE(sc_lo + 1); RW_ISSUE(sc_lo + 2); RW_ISSUE(sc_lo + 3); RW_ISSUE(sc_lo + 4); RW_ISSUE(sc_lo + 5); RW_WAITV(25); }
    RW_BAR();
    for (int sc = sc_lo; sc < sc_hi; ++sc) {
        if (wave < 4) {
            const LAS unsigned char* sb = RG + (sc % RW_NS) * SLOT;
            f32x16 acc; const size_t sch = (size_t)hd * RW_NSC + sc;
            { const v4u g0 = *(const LAS v4u*)(sb + 8192 + ((jt * 2 + it) * 64 + lane) * 32), g1 = *(const LAS v4u*)(sb + 8192 + ((jt * 2 + it) * 64 + lane) * 32 + 16);
              const unsigned gw_[8] = {g0.x, g0.y, g0.z, g0.w, g1.x, g1.y, g1.z, g1.w};
#pragma unroll
              for (int g = 0; g < 4; ++g) { const f32x4 m = *(const LAS f32x4*)(sb + 16384 + (32 * jt + 8 * g + 4 * h) * 4);
                  acc[4 * g] = bflo(gw_[2 * g]) + m.x * X[4 * g]; acc[4 * g + 1] = bfhi(gw_[2 * g]) + m.y * X[4 * g + 1]; acc[4 * g + 2] = bflo(gw_[2 * g + 1]) + m.z * X[4 * g + 2]; acc[4 * g + 3] = bfhi(gw_[2 * g + 1]) + m.w * X[4 * g + 3]; } }
#pragma unroll
            for (int g = 0; g < 4; ++g) *(v2u*)(SALL + (sch * 64 + 32 * it + l31) * 64 + 32 * jt + 8 * g + 4 * h) = (v2u){pk2(X[4 * g], X[4 * g + 1]), pk2(X[4 * g + 2], X[4 * g + 3])};
            const LAS unsigned char* xb = XS + (sc & 1) * 9216 + (32 * it + l31) * 144 + 16 * h; const int ar = 32 * jt + l31; const LAS unsigned char* ab = sb + ar * 128;
#pragma unroll
            for (int ks = 0; ks < 4; ++ks) { const bf16x8 xf = *(const LAS bf16x8*)(xb + 32 * ks); const int po = (((2 * ks + h) ^ (ar & 7)) * 16);
                acc = MFMA32(*(const LAS bf16x8*)(ab + po), xf, acc); }
            X = acc;
            LAS unsigned char* xn = XS + ((sc + 1) & 1) * 9216 + (32 * it + l31) * 144;
#pragma unroll
            for (int g = 0; g < 4; ++g) *(LAS v2u*)(xn + (32 * jt + 8 * g + 4 * h) * 2) = (v2u){pk2(X[4 * g], X[4 * g + 1]), pk2(X[4 * g + 2], X[4 * g + 3])};
        } else {
            RW_ISSUE(sc + RW_NS - 1);
            RW_WAITV(25);
        }
        RW_BAR();
    }
    if (wave >= 4) RW_WAITV(0);
    else if (sc_hi < RW_NSC) {
#pragma unroll
        for (int g = 0; g < 4; ++g) *(f32x4*)(XSV + 4 * g) = (f32x4){X[4 * g], X[4 * g + 1], X[4 * g + 2], X[4 * g + 3]}; }
#undef RW_ISSUE
#undef RW_DMA
#undef RW_WAITV
#undef RW_BAR
}

DI f32x4 ld_bf4(const bf16* p) { const v2u w = *(const v2u*)p; return (f32x4){bflo(w.x), bfhi(w.x), bflo(w.y), bfhi(w.y)}; }
DI void ph_rwkv_out(const Frame& F, const Args& a, int sc_lo, int sc_hi, int gw, int ngw) {
    const bf16* SALL = (const bf16*)(a.ws + RW_SALL); const bf16* PR = (const bf16*)(a.ws + RW_PR); const bf16* ATG = (const bf16*)(a.ws + RW_AT); const bf16* VTF = (const bf16*)(a.ws + RW_VTF);
    const bf16* VV = (const bf16*)(a.ws + RW_VV); const float* BON = (const float*)(a.ws + RW_BON); const bf16* GATE = (const bf16*)(a.ws + WS_SCR + SC_GATE); bf16* Y = (bf16*)(a.ws + WS_YMIX);
    const int lane = F.lane, l31 = lane & 31, h = lane >> 5;
    for (int item = sc_lo * 16 + gw; item < sc_hi * 16; item += ngw) { const int sc = item >> 4, hd = item & 15; if (sc == 1) continue;
        const size_t sch = (size_t)hd * RW_NSC + sc; f32x16 acc[2];
#pragma unroll
        for (int it = 0; it < 2; ++it) {
#pragma unroll
            for (int r = 0; r < 16; ++r) acc[it][r] = 0.f;
#pragma unroll
            for (int ks = 0; ks < 4; ++ks) acc[it] = MFMA32(*(const bf16x8*)(SALL + (sch * 64 + 32 * it + l31) * 64 + 16 * ks + 8 * h), *(const bf16x8*)(PR + (sch * 32 + l31) * 64 + 16 * ks + 8 * h), acc[it]);
#pragma unroll
            for (int ks = 0; ks < 2; ++ks) acc[it] = MFMA32(*(const bf16x8*)(VTF + ((sch * 4 + it * 2 + ks) * 64 + lane) * 8), *(const bf16x8*)(ATG + (sch * 32 + l31) * 32 + 16 * ks + 8 * h), acc[it]); }
        float s1 = 0.f;
#pragma unroll
        for (int it = 0; it < 2; ++it)
#pragma unroll
            for (int r = 0; r < 16; ++r) s1 += acc[it][r];
        s1 += __shfl_xor(s1, 32); const float mean = s1 * (1.0f / 64.0f); float s2 = 0.f;
#pragma unroll
        for (int it = 0; it < 2; ++it)
#pragma unroll
            for (int r = 0; r < 16; ++r) { const float d = acc[it][r] - mean; s2 += d * d; }
        s2 += __shfl_xor(s2, 32); const float rstd = 1.0f / sqrtf(s2 * (1.0f / 64.0f) + 64e-5f);
        const int rr = sub_row(sc, l31);
        if (rr >= 0) { const float bon = BON[(size_t)rr * 16 + hd];
#pragma unroll
            for (int it = 0; it < 2; ++it)
#pragma unroll
                for (int g = 0; g < 4; ++g) { const int c = hd * 64 + 32 * it + 8 * g + 4 * h;
                    const f32x4 lw = *(const f32x4*)(a.in[15] + c), lb = *(const f32x4*)(a.in[16] + c), gt = ld_bf4(GATE + (size_t)rr * 1024 + c); const v2u vw = *(const v2u*)(VV + (size_t)rr * 1024 + c);
                    const float o0 = ((acc[it][4 * g] - mean) * rstd * lw.x + lb.x + bon * bflo(vw.x)) * gt.x, o1 = ((acc[it][4 * g + 1] - mean) * rstd * lw.y + lb.y + bon * bfhi(vw.x)) * gt.y;
                    const float o2 = ((acc[it][4 * g + 2] - mean) * rstd * lw.z + lb.z + bon * bflo(vw.y)) * gt.z, o3 = ((acc[it][4 * g + 3] - mean) * rstd * lw.w + lb.w + bon * bfhi(vw.y)) * gt.w;
                    *(v2u*)(Y + (size_t)rr * DM + c) = (v2u){pk2(o0, o1), pk2(o2, o3)}; } }
    }
}

constexpr int N_PHASES = 33;
template <class Epi, class Sched> DI void run_gemm(const Frame& F, const pg8::Gemm& g, const Sched& S, const Epi& E) {
    pg8::gemm_phase<Epi, Sched, true, true>(F.lds + RING_OFF, g, S, E);
}
DI void moe_up_units(const Frame& F, const Args& a, int t0, int ntl, int G, int c) {
    pg8::Gemm g{(const bf16*)(a.ws + WS_SCR + SC_XG), (const bf16*)(a.ws + WS_MOEW), DM, DM, DM};
    pg8::MoeOrder S{(const int*)(a.ws + WS_TILES), t0, ntl, 4, G, c, (long)MOE_E_BYTES};
    pg8::EpiSwiglu E{(bf16*)(a.ws + WS_SCR + SC_ACT), FF};
    run_gemm(F, g, S, E);
}
DI void moe_down_units(const Frame& F, const Args& a, int t0, int ntl, int G, int c) {
    pg8::Gemm g{(const bf16*)(a.ws + WS_SCR + SC_ACT), (const bf16*)(a.ws + WS_MOEW + MOE_W2_OFF), FF, FF, FF};
    pg8::MoeOrder S{(const int*)(a.ws + WS_TILES), t0, ntl, 8, G, c, (long)MOE_E_BYTES};
    pg8::EpiBf16 E{(bf16*)(a.ws + WS_SCR + SC_YB), DM};
    run_gemm(F, g, S, E);
}
DI void ph_moe_a(const Frame& F, const Args& a) {
    const int nt = (int)__hip_atomic_load((gu32*)(a.ws + WS_TILES) + 127, RLX_AGENT), n1 = nt < 64 ? nt : 64;
    moe_up_units(F, a, 0, n1, F.G, (int)blockIdx.x);
}
DI void ph_moe_b(const Frame& F, const Args& a) {
    const int nt = (int)__hip_atomic_load((gu32*)(a.ws + WS_TILES) + 127, RLX_AGENT), n1 = nt < 64 ? nt : 64; const int c = (int)blockIdx.x;
    int nu = 4 * (nt - n1); if (nu > F.G / 2) nu = F.G / 2;
    if (c < nu) moe_up_units(F, a, n1, nt - n1, nu, c); else moe_down_units(F, a, 0, n1, F.G - nu, c - nu);
}
DI void ph_moe_c(const Frame& F, const Args& a) {
    const int nt = (int)__hip_atomic_load((gu32*)(a.ws + WS_TILES) + 127, RLX_AGENT), n1 = nt < 64 ? nt : 64;
    moe_down_units(F, a, n1, nt - n1, F.G, (int)blockIdx.x);
}

DI void gemm_tail16(const Frame& F, const Args& a, const bf16* A, int lda, const bf16* Wt, int K, int mode) {
    if (F.vcu >= 128) return;
    const int lane = F.lane, lc = lane & 15, quad = lane >> 4, w = F.vcu; LAS float* red = (LAS float*)(F.lds + RING_OFF);
    f32x4 acc = (f32x4){0.f, 0.f, 0.f, 0.f}; const int kw = K / NWAVES, kb = F.wave * kw;
    const bf16* ap = A + (size_t)(TX + lc) * lda + kb + 8 * quad; const bf16* bp = Wt + (size_t)(16 * w + lc) * K + kb + 8 * quad;
#pragma unroll 4
    for (int ks = 0; ks < kw / 32; ++ks) acc = __builtin_amdgcn_mfma_f32_16x16x32_bf16(*(const bf16x8*)(ap + 32 * ks), *(const bf16x8*)(bp + 32 * ks), acc, 0, 0, 0);
    *(LAS f32x4*)(red + (F.wave * 64 + lane) * 4) = acc;
    __syncthreads();
    if (F.wave == 0) { f32x4 s = *(const LAS f32x4*)(red + lane * 4);
#pragma unroll
        for (int v = 1; v < NWAVES; ++v) s = s + *(const LAS f32x4*)(red + (v * 64 + lane) * 4);
        float* H = (float*)(a.ws + WS_H);
#pragma unroll
        for (int r = 0; r < 4; ++r) { const int row = 4 * quad + r, col = 16 * w + lc; const float base = mode ? H[(size_t)(TX + row) * DM + col] : a.in[1][(size_t)row * DM + col];
            H[(size_t)(TX + row) * DM + col] = base + s[r]; } }
    __syncthreads();
}

__global__ void __launch_bounds__(NWAVES * 64, 2) hyb_fwd(Args a) {
    extern __shared__ __attribute__((aligned(16))) unsigned char lds[];
    Frame F;
    F.lds = (LAS unsigned char*)lds;
    F.MISC = (volatile LAS unsigned*)(F.lds + MISC_OFF);
    F.tid = threadIdx.x; F.lane = F.tid & 63; F.wave = __builtin_amdgcn_readfirstlane(F.tid >> 6);
    F.G = gridDim.x; { const int bx = blockIdx.x; F.vcu = (F.G % 8 == 0) ? (bx % 8) * (F.G / 8) + bx / 8 : bx; }
    F.gw = F.vcu * NWAVES + F.wave; F.NGW = F.G * NWAVES;
    F.ctl = (gu32*)(a.ws + WS_CTL);
    for (int u = F.tid; u < (LDS_BYTES - LDSCTL_OFF) / 4; u += NWAVES * 64) ((LAS unsigned*)(F.lds + LDSCTL_OFF))[u] = 0u;
    __syncthreads();
    XcdBarrier bar; bar.bar = (unsigned*)(F.ctl + CW_BAR); bar.x = 0; bar.st = nullptr;
    if (MK_ONE_LAUNCH) bar = xcd_barrier_post((unsigned*)(F.ctl + CW_BAR), F.MISC + 8);
    const int lo = a.ph_lo, hi = a.ph_hi;
#ifndef PH_MASK
#define PH_MASK 0xFFFFFFFFFFFFFFFFull
#endif
#define IN(k) ((((unsigned long long)(PH_MASK) >> (k)) & 1ull) && lo <= (k) && (k) < hi)
#ifndef PROBE_REP
#define PROBE_REP 0u
#endif
#define REP(k) ((((unsigned long long)(PROBE_REP) >> (k)) & 1ull) ? 2 : 1)
#ifdef PROBE_TS
#define STAMP(k) do { if (blockIdx.x == 0 && F.tid == 0) ((unsigned long long*)(F.ctl + CW_TS))[(k)] = __builtin_amdgcn_s_memrealtime(); } while (0)
#else
#define STAMP(k) do { } while (0)
#endif
#define PHASE(k, ...) do { if (IN(k)) { { const int PH_REP_ = 0; (void)PH_REP_; __VA_ARGS__; } if (REP(k) == 2) { __syncthreads(); { const int PH_REP_ = 1; (void)PH_REP_; __VA_ARGS__; } } } } while (0)
#define SEAM(k) do { if (IN(k) && IN((k) + 1)) xcd_barrier(bar); STAMP((k) + 1); } while (0)
    const bf16* HN = (const bf16*)(a.ws + WS_HN); bf16* PROJ = (bf16*)(a.ws + WS_PROJ); const bf16* YMIX = (const bf16*)(a.ws + WS_YMIX); float* H = (float*)(a.ws + WS_H);

    STAMP(0);
    PHASE(0, { ph_prologue(F, a); ph_aux_convert(F, a, F.gw, F.NGW); });
    SEAM(0);
    PHASE(1, { pg8::Gemm g{HN, (const bf16*)(a.ws + WS_WEVIN), DM, DM, DM}; pg8::StaticOrder S; S.init(MP, EV_NP, F.G, (int)blockIdx.x); pg8::EpiBf16 E{PROJ, EV_NP}; run_gemm(F, g, S, E); });
    SEAM(1);
    PHASE(2, ph_even_prep(F, a););
    SEAM(2);
    PHASE(3, {
        { pg8::Gemm g{(const bf16*)(a.ws + WS_SCR + SC_ALORA), (const bf16*)(a.ws + WS_WLORA), 384, 384, 384}; pg8::StaticOrder S; S.init(MP, 3072, F.G, (int)blockIdx.x);
          static_assert(SC_ICL - SC_DEC == SC_GATE - SC_ICL, "lora outputs equally spaced");
          pg8::EpiLora E{(bf16*)(a.ws + WS_SCR + SC_DEC), (long)((SC_ICL - SC_DEC) / 2), a.in[7], a.in[9]}; run_gemm(F, g, S, E); }
        { pg8::Gemm g{(const bf16*)(a.ws + WS_SCR + SC_XR), (const bf16*)(a.ws + WS_WGATE), 256, 1024, 256}; pg8::StaticOrder S; S.init(MP, 2048, F.G, (int)blockIdx.x); S.amod = 4; S.astep = 512;
          pg8::EpiGates E{(bf16*)(a.ws + WS_SCR + SC_LA), (bf16*)(a.ws + WS_SCR + SC_LIX), a.in[20], a.in[22], a.in[23], (const bf16*)(a.ws + WS_SCR + SC_XR)}; run_gemm(F, g, S, E); }
    });
    SEAM(3);
    PHASE(4, ph_rwkv_chunk(F, a, 0, 32, 0););
    SEAM(4);
    PHASE(5, { if (F.vcu < 16) ph_rwkv_chain(F, a, 0, 64); else ph_rwkv_chunk(F, a, 32, 62, 16); });
    SEAM(5);
    PHASE(6, { if (F.vcu < 16) ph_rwkv_chain(F, a, 64, 124); else ph_rwkv_chunk(F, a, 62, 92, 16); });
    SEAM(6);
    PHASE(7, { if (F.vcu < 16) ph_rwkv_chain(F, a, 124, 184); else ph_rwkv_chunk(F, a, 92, 122, 16); });
    SEAM(7);
    PHASE(8, { if (F.vcu < 16) ph_rwkv_chain(F, a, 184, 244); else { ph_rwkv_chunk(F, a, 122, 129, 16); lru_local(F, a, (F.vcu - 16) * NWAVES + F.wave, (F.G - 16) * NWAVES); } });
    SEAM(8);
    PHASE(9, { if (F.vcu < 18) ph_rwkv_chain(F, a, 244, RW_NSC); else ph_rwkv_out(F, a, 0, 244, (F.vcu - 18) * NWAVES + F.wave, (F.G - 18) * NWAVES); });
    SEAM(9);
    PHASE(10, { ph_rwkv_out(F, a, 244, RW_NSC, F.gw, F.NGW); lru_apply(F, a); });
    SEAM(10);
    PHASE(11, { pg8::Gemm g{YMIX, (const bf16*)(a.ws + WS_WEVOUT), DM, DM, DM}; pg8::StaticOrder S; S.init(TX, DM, F.G, (int)blockIdx.x); pg8::EpiResid E{H, a.in[0], a.in[1], 0}; run_gemm(F, g, S, E); gemm_tail16(F, a, YMIX, DM, (const bf16*)(a.ws + WS_WEVOUT), DM, 0); });
    SEAM(11);
    PHASE(12, ph_route(F, a, 0, PH_REP_););
    SEAM(12);
    PHASE(13, ph_gather(F, a, 0););
    SEAM(13);
    PHASE(14, ph_moe_a(F, a););
    SEAM(14);
    PHASE(15, ph_moe_b(F, a););
    SEAM(15);
    PHASE(16, ph_moe_c(F, a););
    SEAM(16);
    PHASE(17, ph_combine(F, a, 0););
    SEAM(17);
    PHASE(18, { pg8::Gemm g{HN, (const bf16*)(a.ws + WS_WODIN), DM, DM, DM}; pg8::StaticOrder S; S.init(MP, OD_NP, F.G, (int)blockIdx.x); pg8::EpiBf16 E{PROJ, OD_NP}; run_gemm(F, g, S, E); });
    SEAM(18);
    PHASE(19, ph_odd_prep(F, a););
    SEAM(19);
    PHASE(20, ph_gdn_chunk(F, a, 0, 33, 0););
    SEAM(20);
    PHASE(21, { ph_gdn_chain(F, a, 0, 33); ph_gdn_chunk(F, a, 33, 65, 1); });
    SEAM(21);
    PHASE(22, { ph_gdn_chain(F, a, 33, 65); ph_gdn_chunk(F, a, 65, 97, 1); });
    SEAM(22);
    PHASE(23, { ph_gdn_chain(F, a, 65, 97); ph_gdn_chunk(F, a, 97, 129, 1); });
    SEAM(23);
    PHASE(24, { ph_gdn_chain(F, a, 97, 129); ph_odd_post(F, a, 0); });
    SEAM(24);
    PHASE(25, { ph_odd_post(F, a, F.G == 256 ? 1 : 2); moe_convert(F, a, 1, F.gw, F.NGW); });
    SEAM(25);
    PHASE(26, { pg8::Gemm g{YMIX, (const bf16*)(a.ws + WS_WODOUT), 4096, 4096, 4096}; pg8::StaticOrder S; S.init(TX, DM, F.G, (int)blockIdx.x); pg8::EpiResid E{H, a.in[0], a.in[1], 1}; run_gemm(F, g, S, E); gemm_tail16(F, a, YMIX, 4096, (const bf16*)(a.ws + WS_WODOUT), 4096, 1); });
    SEAM(26);
    PHASE(27, ph_route(F, a, 1, PH_REP_););
    SEAM(27);
    PHASE(28, ph_gather(F, a, 1););
    SEAM(28);
    PHASE(29, ph_moe_a(F, a););
    SEAM(29);
    PHASE(30, ph_moe_b(F, a););
    SEAM(30);
    PHASE(31, ph_moe_c(F, a););
    SEAM(31);
    PHASE(32, ph_combine(F, a, 1););
#ifdef PROBE_BARS
    for (int i_ = 0; i_ < PROBE_BARS; ++i_) xcd_barrier(bar);
#endif
#undef IN
#undef SEAM
}

extern "C" void kernel_launch(void* const* d_in, const int* in_sizes, int n_in, void* d_out, int out_size, void* d_ws, size_t ws_size, hipStream_t stream) {
    static int grid = 0;
    if (grid == 0) {
        if (n_in != 36 || out_size != TX * DM || ws_size < WS_END) { fprintf(stderr, "kernel_launch: unexpected shapes (n_in %d, out %d, ws %zu)\n", n_in, out_size, ws_size); grid = -1; return; }
        int dev = 0, cus = 0, per_cu = 0;
        if (hipGetDevice(&dev) != hipSuccess || hipDeviceGetAttribute(&cus, hipDeviceAttributeMultiprocessorCount, dev) != hipSuccess) { grid = -1; return; }
        if (hipFuncSetAttribute((const void*)hyb_fwd, hipFuncAttributeMaxDynamicSharedMemorySize, LDS_BYTES) != hipSuccess) { fprintf(stderr, "kernel_launch: hipFuncSetAttribute failed\n"); grid = -1; return; }
        if (hipOccupancyMaxActiveBlocksPerMultiprocessor(&per_cu, (const void*)hyb_fwd, NWAVES * 64, LDS_BYTES) != hipSuccess || per_cu < 1) { fprintf(stderr, "kernel_launch: occupancy query says %d\n", per_cu); per_cu = 1; }
        (void)hipGetLastError();
        grid = cus;
    }
    if (grid < 0) return;
    if (hipMemsetAsync((char*)d_ws + WS_CTL, 0, CTL_ZERO_BYTES, stream) != hipSuccess) return;
    Args a{};
    for (int i = 0; i < 36; ++i) a.in[i] = (const float*)d_in[i];
    a.out = (float*)d_out; a.ws = (unsigned char*)d_ws;
#if MK_ONE_LAUNCH
    a.ph_lo = 0; a.ph_hi = N_PHASES;
    hipLaunchKernelGGL(hyb_fwd, dim3(grid), dim3(NWAVES * 64), LDS_BYTES, stream, a);
#else
    for (int p = 0; p < N_PHASES; ++p) { a.ph_lo = p; a.ph_hi = p + 1; hipLaunchKernelGGL(hyb_fwd, dim3(grid), dim3(NWAVES * 64), LDS_BYTES, stream, a); }
#endif
}
```

```cpp
#include <hip/hip_runtime.h>
#include <cstdio>
#include <cstdint>
#include <cmath>

#ifndef MK_ONE_LAUNCH
#define MK_ONE_LAUNCH 1
#endif

namespace pg8 {
#define PG8_LAS __attribute__((address_space(3)))
typedef unsigned short bf16_t;
typedef short bf16x8 __attribute__((ext_vector_type(8)));
typedef float f32x4 __attribute__((ext_vector_type(4)));
typedef unsigned u32x4 __attribute__((ext_vector_type(4)));
typedef unsigned u32x2 __attribute__((ext_vector_type(2)));
constexpr int BM = 256, BK = 64, HALF = 128, HTB = HALF * BK * 2  , STAGE_BYTES = 8 * HTB, NXCD = 8, WGM = 8;

__host__ __device__ __forceinline__ int lds_byte(int r, int c) { const int st = (r >> 4) * 2 + (c >> 5), rr = r & 15, cc = c & 31, ob = rr * 64 + cc * 2; return st * 1024 + (ob ^ (((ob >> 9) & 1) << 5)); }
__host__ __device__ __forceinline__ void stage_rc(int b, int& R, int& C) { const int st = b / 1024, sb = b % 1024, swz = sb ^ (((sb >> 9) & 1) << 5); R = (st >> 1) * 16 + swz / 64; C = (st & 1) * 32 + (swz % 64) / 2; }
__host__ __device__ __forceinline__ int perm32(int rho) { const int n = rho >> 4, i = rho & 15; return 8 * (i >> 2) + 4 * n + (i & 3); }

struct Unit { int pm, pn; long aoff, boff; };
struct Gemm { const bf16_t* A; const bf16_t* Bt; int K, lda, ldb; };

struct StaticOrder {
    int nM, nN, nwg, G, c, amod; long astep;
    __host__ __device__ void init(int M, int N, int G_, int c_) { nM = M / BM; nN = N / BM; nwg = nM * nN; G = G_; c = c_; amod = 0; astep = 0; }
    __host__ __device__ bool next(int i, Unit& u) const {
        const long L = (long)i * G + c; if (L >= nwg) return false;
        int wgid = (int)L; { const int q = nwg / NXCD, r = nwg % NXCD, xcd = wgid % NXCD, off = wgid / NXCD; wgid = (xcd < r ? xcd * (q + 1) : r * (q + 1) + (xcd - r) * q) + off; }
        const int nig = WGM * nN, gid = wgid / nig, fm = gid * WGM, gsz = (nM - fm) < WGM ? (nM - fm) : WGM;
        u.pm = fm + ((wgid % nig) % gsz); u.pn = (wgid % nig) / gsz; u.boff = 0; u.aoff = amod ? (long)(u.pn % amod) * astep : 0; return true;
    }
    __device__ __forceinline__ void a_ready(const Unit&) const {}
    __device__ __forceinline__ void done(const Unit&) const {}
};
struct MoeOrder {
    const int* tile_e; int t0, ntiles, npn, G, c; long bstride;
    __device__ __forceinline__ bool next(int i, Unit& u) const {
        const long L = (long)i * G + c; if (c < 0 || L >= (long)ntiles * npn) return false;
        const int t = t0 + (int)(L / npn); u.pm = t; u.pn = (int)(L % npn); u.aoff = 0; u.boff = (long)tile_e[t] * bstride; return true;
    }
    __device__ __forceinline__ void a_ready(const Unit&) const {}
    __device__ __forceinline__ void done(const Unit&) const {}
};

__device__ __forceinline__ unsigned cvt_pk_bf16(float lo, float hi) { unsigned r; asm volatile("v_cvt_pk_bf16_f32 %0, %1, %2" : "=v"(r) : "v"(lo), "v"(hi)); return r; }
__device__ __forceinline__ float bf_lo(unsigned w) { return __uint_as_float(w << 16); }
__device__ __forceinline__ float bf_hi(unsigned w) { return __uint_as_float(w & 0xffff0000u); }
__device__ __forceinline__ float sigmoidf_(float x) { return __builtin_amdgcn_rcpf(1.0f + __expf(-x)); }
__device__ __forceinline__ float softplusf_(float x) { return fmaxf(x, 0.f) + __logf(1.0f + __expf(-fabsf(x))); }

struct EpiBf16 {
    static constexpr bool PERM = true, AFTER_DRAIN = false;
    bf16_t* O; int ldc;
    __device__ __forceinline__ void operator()(const f32x4 (&acc)[2][2][4][2], const Unit& u, int wr, int wc, int fr, int fq) const {
        const int row0 = u.pm * BM + wr * 64 + fr; const int col0 = u.pn * BM + wc * 32 + 8 * fq;
#pragma unroll
        for (int ai = 0; ai < 2; ++ai)
#pragma unroll
            for (int m = 0; m < 4; ++m) { bf16_t* rowp = O + (size_t)(row0 + ai * HALF + m * 16) * ldc + col0;
#pragma unroll
                for (int bj = 0; bj < 2; ++bj) { const f32x4 v0 = acc[ai][bj][m][0], v1 = acc[ai][bj][m][1];
                    u32x4 w; w.x = cvt_pk_bf16(v0[0], v0[1]); w.y = cvt_pk_bf16(v0[2], v0[3]); w.z = cvt_pk_bf16(v1[0], v1[1]); w.w = cvt_pk_bf16(v1[2], v1[3]);
                    *(u32x4*)(rowp + bj * HALF) = w; } }
    }
};
struct EpiSwiglu {
    static constexpr bool PERM = true, AFTER_DRAIN = false;
    bf16_t* O; int ldc;
    __device__ __forceinline__ void operator()(const f32x4 (&acc)[2][2][4][2], const Unit& u, int wr, int wc, int fr, int fq) const {
        const int row0 = u.pm * BM + wr * 64 + fr; const int col0 = u.pn * HALF + wc * 32 + 8 * fq;
#pragma unroll
        for (int ai = 0; ai < 2; ++ai)
#pragma unroll
            for (int m = 0; m < 4; ++m) { bf16_t* rowp = O + (size_t)(row0 + ai * HALF + m * 16) * ldc + col0;
                float o[8];
#pragma unroll
                for (int n = 0; n < 2; ++n)
#pragma unroll
                    for (int j = 0; j < 4; ++j) { const float gq = acc[ai][0][m][n][j], uq = acc[ai][1][m][n][j]; o[4 * n + j] = gq * sigmoidf_(gq) * uq; }
                u32x4 w; w.x = cvt_pk_bf16(o[0], o[1]); w.y = cvt_pk_bf16(o[2], o[3]); w.z = cvt_pk_bf16(o[4], o[5]); w.w = cvt_pk_bf16(o[6], o[7]);
                *(u32x4*)rowp = w; }
    }
};
struct EpiResid {
    static constexpr bool PERM = false, AFTER_DRAIN = false;
    float* out; const float* x; const float* meta; int mode;
    __device__ __forceinline__ void operator()(const f32x4 (&acc)[2][2][4][2], const Unit& u, int wr, int wc, int fr, int fq) const {
        const int row0 = u.pm * BM + wr * 64 + fr, col0 = u.pn * BM + wc * 32 + 4 * fq;
#pragma unroll
        for (int ai = 0; ai < 2; ++ai)
#pragma unroll
            for (int m = 0; m < 4; ++m) { const int row = row0 + ai * HALF + m * 16; float* rowp = out + (size_t)row * 2048 + col0;
                const float* bp = mode ? rowp : (row < 8192 ? x + (size_t)row * 2048 + col0 : (row < 8208 ? meta + (size_t)(row - 8192) * 2048 + col0 : nullptr));
#pragma unroll
                for (int bj = 0; bj < 2; ++bj)
#pragma unroll
                    for (int n = 0; n < 2; ++n) { f32x4 b = (f32x4){0.f, 0.f, 0.f, 0.f}; if (bp) b = *(const f32x4*)(bp + bj * HALF + n * 16);
                        *(f32x4*)(rowp + bj * HALF + n * 16) = acc[ai][bj][m][n] + b; } }
    }
};
__device__ __forceinline__ float one_minus_exp_neg(float e) { return e < 0.05f ? e * (1.0f - e * (0.5f - e * (1.0f / 6.0f))) : 1.0f - __expf(-e); }
struct EpiLora {
    static constexpr bool PERM = false, AFTER_DRAIN = false;
    bf16_t* base; long gstride; const float* w0; const float* a0;
    __device__ __forceinline__ void operator()(const f32x4 (&acc)[2][2][4][2], const Unit& u, int wr, int wc, int fr, int fq) const {
        const int grp = u.pn >> 2; const int row0 = u.pm * BM + wr * 64 + fr, col0 = (u.pn & 3) * BM + wc * 32 + 4 * fq;
        bf16_t* O = base + (size_t)grp * gstride;
#pragma unroll
        for (int bj = 0; bj < 2; ++bj)
#pragma unroll
            for (int n = 0; n < 2; ++n) { const int c = col0 + bj * HALF + n * 16;
                f32x4 bv = (f32x4){0.f, 0.f, 0.f, 0.f}; if (grp == 0) bv = *(const f32x4*)(w0 + c); else if (grp == 1) bv = *(const f32x4*)(a0 + c);
#pragma unroll
                for (int ai = 0; ai < 2; ++ai)
#pragma unroll
                    for (int m = 0; m < 4; ++m) { f32x4 v = acc[ai][bj][m][n] + bv;
                        if (grp == 0) {
#pragma unroll
                            for (int j = 0; j < 4; ++j) { const float wl = -softplusf_(-v[j]) - 0.5f; v[j] = one_minus_exp_neg(__expf(wl)); }
                        } else if (grp == 1) {
#pragma unroll
                            for (int j = 0; j < 4; ++j) v[j] = sigmoidf_(v[j]);
                        }
                        u32x2 w; w.x = cvt_pk_bf16(v[0], v[1]); w.y = cvt_pk_bf16(v[2], v[3]);
                        *(u32x2*)(O + (size_t)(row0 + ai * HALF + m * 16) * 1024 + c) = w; } }
    }
};
struct EpiGates {
    static constexpr bool PERM = false, AFTER_DRAIN = false;
    bf16_t* lru_a; bf16_t* lru_ix; const float* ba; const float* bx; const float* lam; const bf16_t* xr;
    __device__ __forceinline__ void operator()(const f32x4 (&acc)[2][2][4][2], const Unit& u, int wr, int wc, int fr, int fq) const {
        const int grp = u.pn >> 2; const int row0 = u.pm * BM + wr * 64 + fr, col0 = (u.pn & 3) * BM + wc * 32 + 4 * fq;
#pragma unroll
        for (int bj = 0; bj < 2; ++bj)
#pragma unroll
            for (int n = 0; n < 2; ++n) { const int c = col0 + bj * HALF + n * 16;
                const f32x4 bv = *(const f32x4*)((grp == 0 ? ba : bx) + c); f32x4 sp = (f32x4){0.f, 0.f, 0.f, 0.f};
                if (grp == 0) { const f32x4 l = *(const f32x4*)(lam + c);
#pragma unroll
                    for (int j = 0; j < 4; ++j) sp[j] = 8.0f * softplusf_(-l[j]); }
#pragma unroll
                for (int ai = 0; ai < 2; ++ai)
#pragma unroll
                    for (int m = 0; m < 4; ++m) { const int row = row0 + ai * HALF + m * 16; f32x4 v = acc[ai][bj][m][n] + bv; u32x2 w;
                        if (grp == 0) {
#pragma unroll
                            for (int j = 0; j < 4; ++j) v[j] = one_minus_exp_neg(sigmoidf_(v[j]) * sp[j]);
                            w.x = cvt_pk_bf16(v[0], v[1]); w.y = cvt_pk_bf16(v[2], v[3]); *(u32x2*)(lru_a + (size_t)row * 1024 + c) = w;
                        } else { const u32x2 xw = *(const u32x2*)(xr + (size_t)row * 1024 + c);
                            v[0] = sigmoidf_(v[0]) * bf_lo(xw.x); v[1] = sigmoidf_(v[1]) * bf_hi(xw.x); v[2] = sigmoidf_(v[2]) * bf_lo(xw.y); v[3] = sigmoidf_(v[3]) * bf_hi(xw.y);
                            w.x = cvt_pk_bf16(v[0], v[1]); w.y = cvt_pk_bf16(v[2], v[3]); *(u32x2*)(lru_ix + (size_t)row * 1024 + c) = w; } } }
    }
};

template <class Epi, class Sched, bool ALIGN_EPI = false, bool SP2 = false>
__device__ __forceinline__ void gemm_phase(PG8_LAS unsigned char* lds, const Gemm g, const Sched& S, const Epi& E) {
    const int tid = threadIdx.x, wid = __builtin_amdgcn_readfirstlane(tid >> 6), lane = tid & 63, wr = wid >> 2, wc = wid & 3, fr = lane & 15, fq = lane >> 4;
    const int K = g.K, nt = K / BK;
    unsigned voffA[2], voffB[2];
#pragma unroll
    for (int i = 0; i < 2; ++i) { int R, C; stage_rc(tid * 16 + i * 8192, R, C); const int Rb = Epi::PERM ? ((R & ~31) + perm32(R & 31)) : R;
        voffA[i] = (unsigned)(R * g.lda + C) * 2u; voffB[i] = (unsigned)(Rb * g.ldb + C) * 2u; }
    const size_t kstep = (size_t)(BK * 2);
    const size_t hstepA = (size_t)HALF * g.lda * 2, hstepB = (size_t)HALF * g.ldb * 2;
    const size_t tstepA = 2 * hstepA, tstepB = 2 * hstepB;
    const unsigned ldsw = (unsigned)wid * 1024u;
    const int aoff = lds_byte(wr * 64 + fr, fq * 8), boff = lds_byte(wc * 32 + fr, fq * 8);
#define PG8_SA(b, h) (((b) * 2 + (h)) * HTB)
#define PG8_SB(b, h) ((4 + (b) * 2 + (h)) * HTB)
#define PG8_STAGE(bufoff, gbase, voff) do { _Pragma("unroll") for (int _i = 0; _i < 2; ++_i) \
        __builtin_amdgcn_global_load_lds((const unsigned*)((const char*)(gbase) + (voff)[_i]), (PG8_LAS unsigned*)(lds + (bufoff) + ldsw + _i * 8192), 16, 0, 0); } while (0)
#define PG8_LDA(dst, b, h) do { _Pragma("unroll") for (int m = 0; m < 4; ++m) _Pragma("unroll") for (int k = 0; k < 2; ++k) dst[m][k] = *(const PG8_LAS bf16x8*)(lds + PG8_SA(b, h) + aoff + m * 2048 + k * 1024); } while (0)
#define PG8_LDB(dst, b, h) do { _Pragma("unroll") for (int n = 0; n < 2; ++n) _Pragma("unroll") for (int k = 0; k < 2; ++k) dst[n][k] = *(const PG8_LAS bf16x8*)(lds + PG8_SB(b, h) + boff + n * 2048 + k * 1024); } while (0)
#define PG8_MMA(ai, bj, At, Bt) do { __builtin_amdgcn_s_setprio(1); _Pragma("unroll") for (int m = 0; m < 4; ++m) _Pragma("unroll") for (int n = 0; n < 2; ++n) _Pragma("unroll") for (int k = 0; k < 2; ++k) \
        acc[ai][bj][m][n] = __builtin_amdgcn_mfma_f32_16x16x32_bf16(Bt[n][k], At[m][k], acc[ai][bj][m][n], 0, 0, 0); __builtin_amdgcn_s_setprio(0); } while (0)
#define PG8_WAIT_V(n) asm volatile("s_waitcnt vmcnt(" #n ")" ::: "memory")
#define PG8_WAIT_L(n) asm volatile("s_waitcnt lgkmcnt(" #n ")" ::: "memory")
#define PG8_BAR __builtin_amdgcn_s_barrier()
#define PG8_SCHED __builtin_amdgcn_sched_barrier(0)
    Unit cur, nxt; int ui = 0;
    if (!S.next(0, cur)) return;
    f32x4 acc[2][2][4][2];
#pragma unroll
    for (int a = 0; a < 2; ++a)
#pragma unroll
        for (int b = 0; b < 2; ++b)
#pragma unroll
            for (int m = 0; m < 4; ++m)
#pragma unroll
                for (int n = 0; n < 2; ++n) acc[a][b][m][n] = (f32x4){0.f, 0.f, 0.f, 0.f};
    bf16x8 At[4][2], B0[2][2], B1[2][2];
    const char* cA = (const char*)g.A + (size_t)cur.pm * tstepA + cur.aoff; const char* cB = (const char*)g.Bt + (size_t)cur.pn * tstepB + cur.boff;
    S.a_ready(cur);
    if constexpr (SP2) {
        PG8_STAGE(PG8_SB(0, 0), cB, voffB); PG8_STAGE(PG8_SB(0, 1), cB + hstepB, voffB); PG8_STAGE(PG8_SA(0, 0), cA, voffA); PG8_STAGE(PG8_SA(0, 1), cA + hstepA, voffA);
        if (wr == 1) PG8_BAR;
        PG8_WAIT_V(2); PG8_BAR;
        PG8_STAGE(PG8_SB(1, 0), cB + kstep, voffB); PG8_STAGE(PG8_SA(1, 0), cA + kstep, voffA); PG8_STAGE(PG8_SB(1, 1), cB + hstepB + kstep, voffB);
        PG8_WAIT_V(6); PG8_BAR;
    } else {
        PG8_STAGE(PG8_SB(0, 0), cB, voffB); PG8_STAGE(PG8_SA(0, 0), cA, voffA); PG8_STAGE(PG8_SB(0, 1), cB + hstepB, voffB); PG8_STAGE(PG8_SA(0, 1), cA + hstepA, voffA);
        if (wr == 1) PG8_BAR;
        PG8_WAIT_V(4); PG8_BAR;
        PG8_STAGE(PG8_SB(1, 0), cB + kstep, voffB); PG8_STAGE(PG8_SA(1, 0), cA + kstep, voffA); PG8_STAGE(PG8_SB(1, 1), cB + hstepB + kstep, voffB);
        PG8_WAIT_V(6); PG8_BAR;
    }
    for (;;) {
        const bool has_next = S.next(ui + 1, nxt);
        const char* nA = has_next ? (const char*)g.A + (size_t)nxt.pm * tstepA + nxt.aoff : cA; const char* nB = has_next ? (const char*)g.Bt + (size_t)nxt.pn * tstepB + nxt.boff : cB;
        for (int t = 0; t < nt; t += 2) {
            const bool last = (t == nt - 2);
            const char* a1 = cA + (size_t)(t + 1) * kstep;
            const char* a2 = last ? nA : cA + (size_t)(t + 2) * kstep; const char* b2 = last ? nB : cB + (size_t)(t + 2) * kstep;
            const char* a3 = a2 + kstep; const char* b3 = b2 + kstep;
            if (last && has_next) S.a_ready(nxt);
            if constexpr (SP2) {
            PG8_LDB(B0, 0, 0); PG8_LDB(B1, 0, 1); PG8_SCHED; PG8_LDA(At, 0, 0); PG8_STAGE(PG8_SA(1, 1), a1 + hstepA, voffA);
            PG8_WAIT_V(8); PG8_WAIT_L(0); PG8_BAR; PG8_MMA(0, 0, At, B0); PG8_MMA(0, 1, At, B1); PG8_BAR; PG8_SCHED;
            PG8_LDA(At, 0, 1); PG8_STAGE(PG8_SB(0, 0), b2, voffB); PG8_STAGE(PG8_SB(0, 1), b2 + hstepB, voffB); PG8_STAGE(PG8_SA(0, 0), a2, voffA);
            PG8_WAIT_V(8); PG8_WAIT_L(0); PG8_BAR; PG8_MMA(1, 0, At, B0); PG8_MMA(1, 1, At, B1); PG8_BAR; PG8_SCHED;
            PG8_LDB(B0, 1, 0); PG8_LDB(B1, 1, 1); PG8_SCHED; PG8_LDA(At, 1, 0); PG8_STAGE(PG8_SA(0, 1), a2 + hstepA, voffA);
            PG8_WAIT_V(8); PG8_WAIT_L(0); PG8_BAR; PG8_MMA(0, 0, At, B0); PG8_MMA(0, 1, At, B1); PG8_BAR; PG8_SCHED;
            PG8_LDA(At, 1, 1); PG8_STAGE(PG8_SB(1, 0), b3, voffB); PG8_STAGE(PG8_SB(1, 1), b3 + hstepB, voffB); PG8_STAGE(PG8_SA(1, 0), a3, voffA);
            PG8_WAIT_V(8); PG8_WAIT_L(0); PG8_BAR; PG8_MMA(1, 0, At, B0); PG8_MMA(1, 1, At, B1); PG8_BAR; PG8_SCHED;
            } else {
            PG8_LDB(B0, 0, 0); PG8_SCHED; PG8_LDA(At, 0, 0); PG8_STAGE(PG8_SA(1, 1), a1 + hstepA, voffA);
            PG8_WAIT_L(8); PG8_BAR; PG8_WAIT_L(0); PG8_MMA(0, 0, At, B0); PG8_BAR; PG8_SCHED;
            PG8_LDB(B1, 0, 1); PG8_STAGE(PG8_SB(0, 0), b2, voffB);
            PG8_BAR; PG8_WAIT_L(0); PG8_MMA(0, 1, At, B1); PG8_BAR;
            PG8_LDA(At, 0, 1); PG8_STAGE(PG8_SA(0, 0), a2, voffA);
            PG8_BAR; PG8_WAIT_L(0); PG8_MMA(1, 0, At, B0); PG8_BAR; PG8_SCHED;
            PG8_STAGE(PG8_SB(0, 1), b2 + hstepB, voffB);
            PG8_WAIT_V(6); PG8_BAR; PG8_MMA(1, 1, At, B1); PG8_BAR;
            PG8_LDB(B0, 1, 0); PG8_SCHED; PG8_LDA(At, 1, 0); PG8_STAGE(PG8_SA(0, 1), a2 + hstepA, voffA);
            PG8_WAIT_L(8); PG8_BAR; PG8_WAIT_L(0); PG8_MMA(0, 0, At, B0); PG8_BAR; PG8_SCHED;
            PG8_LDB(B1, 1, 1); PG8_STAGE(PG8_SB(1, 0), b3, voffB);
            PG8_BAR; PG8_WAIT_L(0); PG8_MMA(0, 1, At, B1); PG8_BAR;
            PG8_LDA(At, 1, 1); PG8_STAGE(PG8_SA(1, 0), a3, voffA);
            PG8_BAR; PG8_WAIT_L(0); PG8_MMA(1, 0, At, B0); PG8_BAR; PG8_SCHED;
            PG8_STAGE(PG8_SB(1, 1), b3 + hstepB, voffB);
            PG8_WAIT_V(6); PG8_BAR; PG8_MMA(1, 1, At, B1); PG8_BAR;
            }
        }
        if constexpr (ALIGN_EPI) { if (wr == 0) PG8_BAR; }
        if constexpr (!Epi::AFTER_DRAIN) { E(acc, cur, wr, wc, fr, fq); S.done(cur); }
        if (!has_next) break;
#pragma unroll
        for (int a = 0; a < 2; ++a)
#pragma unroll
            for (int b = 0; b < 2; ++b)
#pragma unroll
                for (int m = 0; m < 4; ++m)
#pragma unroll
                    for (int n = 0; n < 2; ++n) acc[a][b][m][n] = (f32x4){0.f, 0.f, 0.f, 0.f};
        cur = nxt; cA = nA; cB = nB; ++ui;
        if constexpr (ALIGN_EPI) { if (wr == 1) PG8_BAR; }
    }
    PG8_WAIT_V(0);
    if constexpr (!ALIGN_EPI) { if (wr == 0) PG8_BAR; }
    PG8_BAR;
    if constexpr (Epi::AFTER_DRAIN) { E.fused(acc, cur, wr, wc, fr, fq, lds, wid, lane); S.done(cur); }
#undef PG8_SA
#undef PG8_SB
#undef PG8_STAGE
#undef PG8_LDA
#undef PG8_LDB
#undef PG8_MMA
#undef PG8_WAIT_V
#undef PG8_WAIT_L
#undef PG8_BAR
#undef PG8_SCHED
}
}
#define GAS __attribute__((address_space(1)))
#define LAS __attribute__((address_space(3)))
typedef unsigned short bf16;
typedef unsigned v4u __attribute__((ext_vector_type(4)));
typedef float f32x4 __attribute__((ext_vector_type(4)));
typedef short bf16x8 __attribute__((ext_vector_type(8)));
typedef GAS unsigned gu32;
typedef GAS unsigned long long gu64;
#define RLX_AGENT __ATOMIC_RELAXED, __HIP_MEMORY_SCOPE_AGENT
#define LDS_WAIT() asm volatile("s_waitcnt lgkmcnt(0)" ::: "memory")
#define VM_WAIT() asm volatile("s_waitcnt vmcnt(0)" ::: "memory")
__device__ __forceinline__ unsigned long long rt() { return __builtin_amdgcn_s_memrealtime(); }
__device__ __forceinline__ unsigned f2bf(float f) { unsigned u = __builtin_bit_cast(unsigned, f); return (u + 0x7fffu + ((u >> 16) & 1u)) >> 16; }
__device__ __forceinline__ unsigned pk2(float lo, float hi) { return f2bf(lo) | (f2bf(hi) << 16); }

#define XB_TMO      128
#define XB_XCNT(j)  (256  + 64 * (j))
#define XB_XSUB(j)  (1280 + 64 * (j))
#define XB_XGEN(j)  (2304 + 64 * (j))
#define XB_TOP      3328
#define XB_TOPGEN   3392
#define XCD_BAR_WORDS 3456
#define XB_SPIN_CAP (1u << 18)

__device__ __forceinline__ unsigned xb_ld(unsigned* p)              { return __hip_atomic_load(p, __ATOMIC_RELAXED, __HIP_MEMORY_SCOPE_AGENT); }
__device__ __forceinline__ unsigned xb_add(unsigned* p, unsigned v) { return __hip_atomic_fetch_add(p, v, __ATOMIC_RELAXED, __HIP_MEMORY_SCOPE_AGENT); }
__device__ __forceinline__ unsigned xb_xcc_id() { return (unsigned)__builtin_amdgcn_s_getreg((3 << 11) | 20) & 0xFu; }
#define XB_SPIN(cond, bar) do { unsigned _sp = 0; while (cond) { __builtin_amdgcn_s_sleep(1); \
    if ((++_sp & 255u) == 0u) { if (xb_ld(&(bar)[XB_TMO])) break; if (_sp > XB_SPIN_CAP) { atomicAdd(&(bar)[XB_TMO], 1u); break; } } } } while (0)

struct XcdBarrier {
    unsigned* bar; unsigned x;
    volatile LAS unsigned* st;
};

__device__ __forceinline__ XcdBarrier xcd_barrier_post(unsigned* bar, volatile LAS unsigned* st) {
    XcdBarrier b; b.bar = bar; b.x = xb_xcc_id(); b.st = st;
    if (threadIdx.x == 0) (void)xb_add(&bar[XB_XCNT(b.x)], 1u);
    return b;
}
__device__ __forceinline__ void xcd_barrier_complete(unsigned* bar, unsigned x, unsigned& nloc, unsigned& nx) {
    const unsigned G = gridDim.x * gridDim.y * gridDim.z;
    unsigned sum, cnt, mine, sp = 0u;
    for (;;) {
        sum = 0u; cnt = 0u; mine = 0u;
#pragma unroll
        for (unsigned j = 0; j < 16; ++j) { const unsigned c = xb_ld(&bar[XB_XCNT(j)]); sum += c; cnt += (c > 0u) ? 1u : 0u; mine = (j == x) ? c : mine; }
        if (sum == G) break;
        __builtin_amdgcn_s_sleep(1);
        if ((++sp & 255u) == 0u) { if (xb_ld(&bar[XB_TMO])) break; if (sp > XB_SPIN_CAP) { atomicAdd(&bar[XB_TMO], 1u); break; } }
    }
    nloc = mine > 0u ? mine : 1u; nx = cnt > 0u ? cnt : 1u;
}

__device__ __forceinline__ void xcd_barrier(const XcdBarrier& b) {
    asm volatile("s_waitcnt vmcnt(0)" ::: "memory");
    __syncthreads();
    if (threadIdx.x == 0) {
        unsigned* bar = b.bar;
        __builtin_amdgcn_s_waitcnt(0);
        unsigned nloc = b.st[0], nx = b.st[1];
        if (nloc == 0u) { xcd_barrier_complete(bar, b.x, nloc, nx); b.st[0] = nloc; b.st[1] = nx; }
        const unsigned old = xb_add(&bar[XB_XSUB(b.x)], 1u);
        const unsigned gen = old / nloc;
        if (old + 1u == (gen + 1u) * nloc) {
            __builtin_amdgcn_fence(__ATOMIC_RELEASE, "agent");
            asm volatile("s_waitcnt vmcnt(0)" ::: "memory");
            const unsigned og = xb_add(&bar[XB_TOP], 1u);
            const unsigned tg = og / nx;
            if (og + 1u == (tg + 1u) * nx) xb_add(&bar[XB_TOPGEN], 1u);
            else XB_SPIN(xb_ld(&bar[XB_TOPGEN]) == tg, bar);
            __builtin_amdgcn_fence(__ATOMIC_ACQUIRE, "agent");
            xb_add(&bar[XB_XGEN(b.x)], 1u);
            asm volatile("s_waitcnt vmcnt(0)" ::: "memory");
        } else {
            XB_SPIN(xb_ld(&bar[XB_XGEN(b.x)]) == gen, bar);
            __builtin_amdgcn_fence(__ATOMIC_ACQUIRE, "agent");
            asm volatile("s_waitcnt vmcnt(0)" ::: "memory");
        }
    }
    __syncthreads();
}

constexpr int NWAVES = 8;
constexpr int DM = 2048, TX = 8192, NMETA = 16, TT = TX + NMETA, MP = 8448;
constexpr int EV_NP = 5632, EV_LORA0 = 3072, EV_GB = 3360, EV_REC = 4384;
constexpr int OD_NP = 12544, OD_Z = 8192, OD_B = 12288, OD_A = 12320;
constexpr int NEXP = 32, FF = 512, MOE_ROWS = 24576;
constexpr float NORM_EPS = 1e-6f;

constexpr size_t MiB = 1u << 20;
constexpr size_t WS_CTL = 0, CTL_ZERO_BYTES = 1 * MiB;
constexpr size_t WS_TOKINFO = 1 * MiB;
constexpr size_t WS_TILES = 1 * MiB + 512 * 1024;
constexpr size_t WS_WEVIN = 2 * MiB;
constexpr size_t WS_WEVOUT = 24 * MiB;
constexpr size_t WS_WODIN = 32 * MiB;
constexpr size_t WS_WODOUT = 81 * MiB;
constexpr size_t WS_WLORA = 97 * MiB;
constexpr size_t WS_WGATE = 100 * MiB;
constexpr size_t WS_WROUTE = 101 * MiB;
constexpr size_t WS_MOEW = 102 * MiB;
constexpr size_t MOE_E_BYTES = 6 * MiB, MOE_W2_OFF = 4 * MiB;
constexpr size_t WS_H = 294 * MiB;
constexpr size_t WS_HN = 360 * MiB;
constexpr size_t WS_YMIX = 393 * MiB;
constexpr size_t WS_PROJ = 459 * MiB;
constexpr size_t WS_SCR = 662 * MiB;
constexpr size_t WS_END = 932 * MiB;
constexpr size_t SC_ALORA = 0;
constexpr size_t SC_XR = 8 * MiB;
constexpr size_t SC_DEC = 26 * MiB, SC_ICL = 60 * MiB, SC_GATE = 94 * MiB;
constexpr size_t SC_LA = 128 * MiB, SC_LIX = 162 * MiB;
constexpr size_t SC_QN = 0, SC_KN = 34 * MiB;
constexpr size_t SC_VC = 68 * MiB;
constexpr size_t SC_BETA = 134 * MiB, SC_G = 136 * MiB;
constexpr size_t SC_O = 138 * MiB;
constexpr size_t SC_XG = 0;
constexpr size_t SC_ACT = 96 * MiB;
constexpr size_t SC_YB = 120 * MiB;
static_assert(SC_O + (size_t)MP * 4096 * 4 <= WS_END - WS_SCR && SC_YB + (size_t)MOE_ROWS * 2048 * 2 <= WS_END - WS_SCR && SC_LIX + (size_t)MP * 1024 * 4 <= WS_END - WS_SCR, "scratch map");
constexpr int CW_TMO = 0, CW_CODE = 1;
constexpr int CW_BAR = 4096;
constexpr int CW_PROG = 20480;
constexpr int CW_TS = 24576;
constexpr int CW_MOECNT = 16384;

constexpr int RING_OFF = 0, RING_BYTES = 131072;
constexpr int LDSCTL_OFF = 146944, MISC_OFF = LDSCTL_OFF + 320;
constexpr int LDS_BYTES = 147456;


#define DI __device__ __forceinline__
typedef unsigned v2u __attribute__((ext_vector_type(2)));
struct Args { const float* in[36]; float* out; unsigned char* ws; int ph_lo, ph_hi; };
struct Frame {
    LAS unsigned char* lds; volatile LAS unsigned* MISC; gu32* ctl;
    int tid, lane, wave, vcu, G, gw, NGW;
};
DI float bf2f(bf16 v) { return __uint_as_float((unsigned)v << 16); }
DI float bflo(unsigned w) { return __uint_as_float(w << 16); }
DI float bfhi(unsigned w) { return __uint_as_float(w & 0xffff0000u); }
DI float wave_sum(float v) {
#pragma unroll
    for (int o = 1; o < 64; o <<= 1) v += __shfl_xor(v, o);
    return v;
}
DI float sigm(float x) { return __builtin_amdgcn_rcpf(1.0f + __expf(-x)); }
DI float softplus(float x) { return fmaxf(x, 0.f) + __logf(1.0f + __expf(-fabsf(x))); }
DI float gelu_tanh(float x) { const float u = 0.7978845608028654f * (x + 0.044715f * x * x * x); return 0.5f * x * (1.0f + tanhf(u)); }
DI int pos_row(int p) { return p < NMETA ? TX + p : p - NMETA; }
DI int row_pos(int r) { return r < TX ? r + NMETA : r - TX; }

DI void tr_item(const float* W, int N, int k0, int n0, bf16* WT, int ldk, int drow0, LAS float* scr, int lane) {
#pragma unroll 8
    for (int i = 0; i < 32; ++i) { const int kk = 2 * i + (lane >> 5); scr[kk * 33 + (lane & 31)] = W[(size_t)(k0 + kk) * N + n0 + (lane & 31)]; }
    LDS_WAIT(); asm volatile("" ::: "memory");
    const int c = lane & 7;
#pragma unroll
    for (int j = 0; j < 4; ++j) { const int n = (lane >> 3) + 8 * j; const LAS float* s = scr + (8 * c) * 33 + n;
        v4u o; o.x = pk2(s[0 * 33], s[1 * 33]); o.y = pk2(s[2 * 33], s[3 * 33]); o.z = pk2(s[4 * 33], s[5 * 33]); o.w = pk2(s[6 * 33], s[7 * 33]);
        *(v4u*)(WT + (size_t)(drow0 + n) * ldk + k0 + 8 * c) = o; }
    LDS_WAIT(); asm volatile("" ::: "memory");
}
DI void moe_convert(const Frame& F, const Args& a, int l, int gw, int ngw) {
    LAS float* scr = (LAS float*)(F.lds + RING_OFF + F.wave * 16384);
    bf16* base = (bf16*)(a.ws + WS_MOEW);
    for (int it = gw; it < NEXP * 1536; it += ngw) {
        const int e = it / 1536; int j = it % 1536; bf16* eb = base + (size_t)e * (MOE_E_BYTES / 2);
        const size_t eoff = (size_t)(l * NEXP + e) * DM * FF;
        if (j < 1024) { const float* W = (j < 512 ? a.in[33] : a.in[34]) + eoff; const int hi = j >= 512; j &= 511; const int kb = j >> 4, nb = j & 15, n0 = 32 * nb;
            tr_item(W, FF, 64 * kb, n0, eb, DM, 256 * (n0 >> 7) + 128 * hi + (n0 & 127), scr, F.lane); }
        else { j -= 1024; const int kb = j >> 6, nb = j & 63; tr_item(a.in[35] + eoff, DM, 64 * kb, 32 * nb, eb + MOE_W2_OFF / 2, FF, 32 * nb, scr, F.lane); }
    }
}
DI void norm_row_bf16(int lane, const float* src, const float* w, bf16* dst) {
    f32x4 v[8]; float s = 0.f;
#pragma unroll
    for (int j = 0; j < 8; ++j) { v[j] = ((const f32x4*)src)[lane + 64 * j]; s += (v[j].x * v[j].x + v[j].y * v[j].y) + (v[j].z * v[j].z + v[j].w * v[j].w); }
    const float rs = 1.0f / sqrtf(wave_sum(s) * (1.0f / DM) + NORM_EPS);
#pragma unroll
    for (int j = 0; j < 8; ++j) { const f32x4 wv = ((const f32x4*)w)[lane + 64 * j]; v2u o; o.x = pk2(v[j].x * rs * wv.x, v[j].y * rs * wv.y); o.y = pk2(v[j].z * rs * wv.z, v[j].w * rs * wv.w);
        ((v2u*)dst)[lane + 64 * j] = o; }
}

DI void ph_prologue(const Frame& F, const Args& a) {
    LAS float* scr = (LAS float*)(F.lds + RING_OFF + F.wave * 16384);
    constexpr int I_A = 32 * 169, I_B = 32 * 64, NIT = I_A + I_B;
    for (int it = F.gw; it < NIT; it += F.NGW) {
        int r = it;
        if (r < I_A) { const int kb = r / 169, nb = r % 169; tr_item(a.in[5], 5408, 64 * kb, 32 * nb, (bf16*)(a.ws + WS_WEVIN), DM, 32 * nb, scr, F.lane); continue; } r -= I_A;
        { const int kb = r / 64, nb = r % 64; tr_item(a.in[24], DM, 64 * kb, 32 * nb, (bf16*)(a.ws + WS_WEVOUT), DM, 32 * nb, scr, F.lane); }
    }
    const int gt = F.vcu * (NWAVES * 64) + F.tid, NGT = F.G * NWAVES * 64;
    { bf16* WL = (bf16*)(a.ws + WS_WLORA); const float* wup = a.in[8]; const float* aup = a.in[10]; const float* gup = a.in[11];
      for (int idx = gt; idx < 3072 * 384; idx += NGT) { const int n = idx / 384, k = idx % 384; float v = 0.f;
          if (n < 1024) { if (k < 64) v = wup[k * 1024 + n]; }
          else if (n < 2048) { if (k >= 64 && k < 128) v = aup[(k - 64) * 1024 + n - 1024]; }
          else { if (k >= 128 && k < 288) v = gup[(k - 128) * 1024 + n - 2048]; }
          WL[idx] = (bf16)f2bf(v); } }
    { bf16* WG = (bf16*)(a.ws + WS_WGATE);
      for (int idx = gt; idx < 2048 * 256; idx += NGT) { const int n = idx >> 8, kk = idx & 255, nn = n & 1023, blk = nn >> 6, j = nn & 63, cin = (nn & ~255) + kk;
          const float* W = n < 1024 ? a.in[19] : a.in[21];
          const float v = (cin >> 6) == blk ? W[blk * 4096 + (cin & 63) * 64 + j] : 0.f;
          WG[idx] = (bf16)f2bf(v); } }
    { bf16* WR = (bf16*)(a.ws + WS_WROUTE);
      for (int idx = gt; idx < 2 * 48 * DM; idx += NGT) { const int l = idx / (48 * DM), n = (idx / DM) % 48, k = idx % DM; float v = 0.f;
          if (n < 32) v = a.in[32][((size_t)l * DM + k) * NEXP + n]; else if (n < 36) v = a.in[31][((size_t)l * DM + k) * 4 + n - 32];
          const unsigned hi = f2bf(v); WR[((size_t)(l * 2) * 48 + n) * DM + k] = (bf16)hi; WR[((size_t)(l * 2 + 1) * 48 + n) * DM + k] = (bf16)f2bf(v - __uint_as_float(hi << 16)); } }
    bf16* HN = (bf16*)(a.ws + WS_HN);
    for (int r = F.gw; r < TT; r += F.NGW) norm_row_bf16(F.lane, r < TX ? a.in[0] + (size_t)r * DM : a.in[1] + (size_t)(r - TX) * DM, a.in[2], HN + (size_t)r * DM);
}

DI void ph_aux_convert(const Frame& F, const Args& a, int gw, int ngw) {
    LAS float* scr = (LAS float*)(F.lds + RING_OFF + F.wave * 16384);
    constexpr int I_C = 32 * 386, I_D = 64 * 64, NIT = I_C + I_D;
    for (int it = gw; it < NIT; it += ngw) {
        int r = it;
        if (r < I_C) { const int kb = r / 386, nb = r % 386; tr_item(a.in[25], 12352, 64 * kb, 32 * nb, (bf16*)(a.ws + WS_WODIN), DM, 32 * nb, scr, F.lane); continue; } r -= I_C;
        { const int kb = r / 64, nb = r % 64; tr_item(a.in[30], DM, 64 * kb, 32 * nb, (bf16*)(a.ws + WS_WODOUT), 4096, 32 * nb, scr, F.lane); }
    }
    moe_convert(F, a, 0, gw, ngw);
}

DI void ph_even_prep(const Frame& F, const Args& a) {
    const bf16* P = (const bf16*)(a.ws + WS_PROJ); bf16* AL = (bf16*)(a.ws + WS_SCR + SC_ALORA); bf16* XR = (bf16*)(a.ws + WS_SCR + SC_XR);
    const float* mu = a.in[6]; const float* cw = a.in[17]; const float* cb = a.in[18];
    const int lane = F.lane;
    for (int item = F.gw; item < TT + (TT / 8) * 2; item += F.NGW) {
        if (item < TT) { const int r = item, pos = row_pos(r); const bf16* cur = P + (size_t)r * EV_NP; const bf16* prv = P + (size_t)pos_row(pos > 0 ? pos - 1 : 0) * EV_NP; const float pm = pos > 0 ? 1.f : 0.f;
            float cv[6], pv[6], mv[6];
#pragma unroll
            for (int i = 0; i < 6; ++i) { const int idx = lane + 64 * i, col = EV_LORA0 + (idx < 288 ? idx : 287); cv[i] = bf2f(cur[col]); pv[i] = bf2f(prv[col]) * pm; mv[i] = mu[col]; }
#pragma unroll
            for (int i = 0; i < 6; ++i) { const int idx = lane + 64 * i; float v = cv[i] + (pv[i] - cv[i]) * mv[i];
                if (idx < 64) v = tanhf(v); else if (idx >= 128) v = sigm(v);
                AL[(size_t)r * 384 + idx] = (bf16)f2bf(idx < 288 ? v : 0.f); }
        } else { const int it2 = item - TT, pb = it2 >> 1, c0 = (it2 & 1) * 512 + lane * 8, p0 = pb * 8;
            f32x4 w[4][2], b0 = *(const f32x4*)(cb + c0), b1 = *(const f32x4*)(cb + c0 + 4);
#pragma unroll
            for (int j = 0; j < 4; ++j) { w[j][0] = *(const f32x4*)(cw + j * 1024 + c0); w[j][1] = *(const f32x4*)(cw + j * 1024 + c0 + 4); }
            v4u x[11];
#pragma unroll
            for (int i = 0; i < 11; ++i) { const int p = p0 - 3 + i; x[i] = *(const v4u*)(P + (size_t)pos_row(p > 0 ? p : 0) * EV_NP + EV_REC + c0); if (p < 0) x[i] = (v4u){0u, 0u, 0u, 0u}; }
#pragma unroll
            for (int o = 0; o < 8; ++o) { float acc[8] = {b0.x, b0.y, b0.z, b0.w, b1.x, b1.y, b1.z, b1.w};
#pragma unroll
                for (int j = 0; j < 4; ++j) { const v4u xv = x[o + j];
                    acc[0] += w[j][0].x * bflo(xv.x); acc[1] += w[j][0].y * bfhi(xv.x); acc[2] += w[j][0].z * bflo(xv.y); acc[3] += w[j][0].w * bfhi(xv.y);
                    acc[4] += w[j][1].x * bflo(xv.z); acc[5] += w[j][1].y * bfhi(xv.z); acc[6] += w[j][1].z * bflo(xv.w); acc[7] += w[j][1].w * bfhi(xv.w); }
                *(v4u*)(XR + (size_t)pos_row(p0 + o) * 1024 + c0) = (v4u){pk2(acc[0], acc[1]), pk2(acc[2], acc[3]), pk2(acc[4], acc[5]), pk2(acc[6], acc[7])}; } }
    }
}

DI void ph_route(const Frame& F, const Args& a, int l, int dummy) {
    const float* H = (const float*)(a.ws + WS_H); const float* nw = a.in[3] + (size_t)l * DM;
    const bf16* WH = (const bf16*)(a.ws + WS_WROUTE) + (size_t)(l * 2) * 48 * DM; const bf16* WL = WH + (size_t)48 * DM;
    unsigned* TI = (unsigned*)(a.ws + WS_TOKINFO) + (dummy ? (WS_SCR + 250 * MiB - WS_TOKINFO) / 4 : 0); const int lane = F.lane, lc = lane & 15, quad = lane >> 4, wave = F.wave; const int cl = dummy ? l + 2 : l;
    LAS float* red = (LAS float*)(F.lds + RING_OFF);
    LAS float* sq = red + 8 * 9 * 64 * 4; LAS float* lgs = sq + 8 * 48;
    static_assert(TT % 48 == 0, "router tasks");
    for (int task = F.vcu; task < TT / 48; task += F.G) {
        const float* nwp = nw + 256 * wave + 8 * quad; float ss[3] = {0.f, 0.f, 0.f};
        f32x4 acc[3][3];
#pragma unroll
        for (int mt = 0; mt < 3; ++mt)
#pragma unroll
            for (int nt = 0; nt < 3; ++nt) acc[mt][nt] = (f32x4){0.f, 0.f, 0.f, 0.f};
#pragma unroll 2
        for (int ks = 0; ks < 8; ++ks) { const int k0 = 256 * wave + 32 * ks + 8 * quad; const f32x4 w0 = *(const f32x4*)(nwp + 32 * ks), w1 = *(const f32x4*)(nwp + 32 * ks + 4);
            bf16x8 bh[3], bl[3];
#pragma unroll
            for (int nt = 0; nt < 3; ++nt) { bh[nt] = *(const bf16x8*)(WH + (size_t)(16 * nt + lc) * DM + k0); bl[nt] = *(const bf16x8*)(WL + (size_t)(16 * nt + lc) * DM + k0); }
#pragma unroll
            for (int mt = 0; mt < 3; ++mt) { const float* hr = H + (size_t)(task * 48 + mt * 16 + lc) * DM + k0; const f32x4 x0 = *(const f32x4*)hr, x1 = *(const f32x4*)(hr + 4);
                ss[mt] += (x0.x * x0.x + x0.y * x0.y) + (x0.z * x0.z + x0.w * x0.w) + (x1.x * x1.x + x1.y * x1.y) + (x1.z * x1.z + x1.w * x1.w);
                const float xn[8] = {x0.x * w0.x, x0.y * w0.y, x0.z * w0.z, x0.w * w0.w, x1.x * w1.x, x1.y * w1.y, x1.z * w1.z, x1.w * w1.w};
                unsigned hi[8]; float lo[8];
#pragma unroll
                for (int q = 0; q < 8; ++q) { hi[q] = f2bf(xn[q]); lo[q] = xn[q] - __uint_as_float(hi[q] << 16); }
                const v4u ah4 = (v4u){hi[0] | (hi[1] << 16), hi[2] | (hi[3] << 16), hi[4] | (hi[5] << 16), hi[6] | (hi[7] << 16)}, al4 = (v4u){pk2(lo[0], lo[1]), pk2(lo[2], lo[3]), pk2(lo[4], lo[5]), pk2(lo[6], lo[7])};
                const bf16x8 ah = __builtin_bit_cast(bf16x8, ah4), al = __builtin_bit_cast(bf16x8, al4);
#pragma unroll
                for (int nt = 0; nt < 3; ++nt) { acc[mt][nt] = __builtin_amdgcn_mfma_f32_16x16x32_bf16(al, bh[nt], acc[mt][nt], 0, 0, 0); acc[mt][nt] = __builtin_amdgcn_mfma_f32_16x16x32_bf16(ah, bl[nt], acc[mt][nt], 0, 0, 0);
                    acc[mt][nt] = __builtin_amdgcn_mfma_f32_16x16x32_bf16(ah, bh[nt], acc[mt][nt], 0, 0, 0); } } }
#pragma unroll
        for (int mt = 0; mt < 3; ++mt) { float s_ = ss[mt]; s_ += __shfl_xor(s_, 16); s_ += __shfl_xor(s_, 32); if (quad == 0) sq[wave * 48 + mt * 16 + lc] = s_;
#pragma unroll
            for (int nt = 0; nt < 3; ++nt) *(LAS f32x4*)(red + ((wave * 9 + mt * 3 + nt) * 64 + lane) * 4) = acc[mt][nt]; }
        __syncthreads();
        { const int tile = wave;
#pragma unroll
          for (int rep = 0; rep < 2; ++rep) { const int tl = tile + 8 * rep; if (tl < 9) { f32x4 s = *(const LAS f32x4*)(red + (tl * 64 + lane) * 4);
#pragma unroll
              for (int v = 1; v < 8; ++v) s = s + *(const LAS f32x4*)(red + ((v * 9 + tl) * 64 + lane) * 4);
              const int mt = tl / 3, nt = tl % 3;
#pragma unroll
              for (int q = 0; q < 4; ++q) lgs[(mt * 16 + 4 * quad + q) * 49 + 16 * nt + lc] = s[q]; } } }
        __syncthreads();
        if (wave == 0 && lane < 48) { float sst = 0.f;
#pragma unroll
            for (int v = 0; v < 8; ++v) sst += sq[v * 48 + lane];
            const float rs = 1.0f / sqrtf(sst * (1.0f / DM) + NORM_EPS);
            float lg[36];
#pragma unroll
            for (int i = 0; i < 36; ++i) lg[i] = lgs[lane * 49 + i] * rs;
            int gi = 0; float gm = lg[32];
#pragma unroll
            for (int i = 1; i < 4; ++i) if (lg[32 + i] > gm) { gm = lg[32 + i]; gi = i; }
            float den = 0.f;
#pragma unroll
            for (int i = 0; i < 4; ++i) den += __expf(lg[32 + i] - gm);
            const float gp = 1.0f / den;
            float l8[8];
#pragma unroll
            for (int i = 0; i < 8; ++i) l8[i] = gi == 0 ? lg[i] : (gi == 1 ? lg[8 + i] : (gi == 2 ? lg[16 + i] : lg[24 + i]));
            int i1 = 0; float m1 = l8[0];
#pragma unroll
            for (int i = 1; i < 8; ++i) if (l8[i] > m1) { m1 = l8[i]; i1 = i; }
            int i2 = -1; float m2 = -INFINITY;
#pragma unroll
            for (int i = 0; i < 8; ++i) if (i != i1 && l8[i] > m2) { m2 = l8[i]; i2 = i; }
            const float e21 = __expf(m2 - m1); const float w1 = gp / (1.0f + e21), w2 = gp * e21 / (1.0f + e21);
            const int ea = gi * 8 + i1, eb = gi * 8 + i2; const int rt = task * 48 + lane;
            const unsigned sa = atomicAdd((unsigned*)(F.ctl + CW_MOECNT + (cl * NEXP + ea) * 16), 1u), sb = atomicAdd((unsigned*)(F.ctl + CW_MOECNT + (cl * NEXP + eb) * 16), 1u);
            unsigned* t = TI + (size_t)rt * 8; *(v4u*)t = (v4u){(unsigned)ea, sa, __float_as_uint(w1), (unsigned)eb}; *(v4u*)(t + 4) = (v4u){sb, __float_as_uint(w2), __float_as_uint(rs), 0u}; }
        __syncthreads();
    }
}
DI void moe_prefix(const Frame& F, int l, LAS int* ps) {
    if (F.tid == 0) { int t = 0;
        for (int e = 0; e < NEXP; ++e) { const unsigned c = __hip_atomic_load(F.ctl + CW_MOECNT + (l * NEXP + e) * 16, RLX_AGENT); ps[e] = t * 256; t += (int)((c + 255u) >> 8); }
        ps[32] = t; }
    __syncthreads();
}
DI void ph_gather(const Frame& F, const Args& a, int l) {
    LAS int* ps = (LAS int*)(F.lds + RING_OFF); moe_prefix(F, l, ps);
    if (F.vcu == 0 && F.tid < NEXP) { int* TE = (int*)(a.ws + WS_TILES); const int e = F.tid; const int t0 = ps[e] >> 8, t1 = (e == NEXP - 1 ? ps[32] : ps[e + 1] >> 8);
        for (int t = t0; t < t1; ++t) TE[t] = e; if (e == 0) TE[127] = ps[32]; }
    const float* H = (const float*)(a.ws + WS_H); const float* nw = a.in[3] + (size_t)l * DM; unsigned* TI = (unsigned*)(a.ws + WS_TOKINFO); bf16* XG = (bf16*)(a.ws + WS_SCR + SC_XG);
    const int lane = F.lane;
    for (int r = F.gw; r < TT; r += F.NGW) {
        unsigned* t = TI + (size_t)r * 8; const int g0 = ps[t[0]] + (int)t[1], g1 = ps[t[3]] + (int)t[4]; const float rs = __uint_as_float(t[6]);
        if (lane == 0) t[7] = (unsigned)g0 | ((unsigned)g1 << 16);
        const float* hr = H + (size_t)r * DM;
#pragma unroll
        for (int j = 0; j < 4; ++j) { const int e0 = (lane + 64 * j) * 8; const f32x4 x0 = *(const f32x4*)(hr + e0), x1 = *(const f32x4*)(hr + e0 + 4), w0 = *(const f32x4*)(nw + e0), w1 = *(const f32x4*)(nw + e0 + 4);
            v4u o; o.x = pk2(x0.x * rs * w0.x, x0.y * rs * w0.y); o.y = pk2(x0.z * rs * w0.z, x0.w * rs * w0.w); o.z = pk2(x1.x * rs * w1.x, x1.y * rs * w1.y); o.w = pk2(x1.z * rs * w1.z, x1.w * rs * w1.w);
            *(v4u*)(XG + (size_t)g0 * DM + e0) = o; *(v4u*)(XG + (size_t)g1 * DM + e0) = o; }
    }
}
DI void ph_combine(const Frame& F, const Args& a, int l) {
    float* H = (float*)(a.ws + WS_H); const unsigned* TI = (const unsigned*)(a.ws + WS_TOKINFO); const bf16* YB = (const bf16*)(a.ws + WS_SCR + SC_YB); bf16* HN = (bf16*)(a.ws + WS_HN);
    const int lane = F.lane; const int nrows = l == 0 ? TT : TX;
    for (int r = F.gw; r < nrows; r += F.NGW) {
        const unsigned* t = TI + (size_t)r * 8; const int g0 = (int)(t[7] & 0xffffu), g1 = (int)(t[7] >> 16); const float w0 = __uint_as_float(t[2]), w1 = __uint_as_float(t[5]);
        float* hr = H + (size_t)r * DM; float hv[32]; float s = 0.f;
#pragma unroll
        for (int j = 0; j < 4; ++j) { const int e0 = (lane + 64 * j) * 8; const f32x4 x0 = *(const f32x4*)(hr + e0), x1 = *(const f32x4*)(hr + e0 + 4);
            const v4u ya = *(const v4u*)(YB + (size_t)g0 * DM + e0), yc = *(const v4u*)(YB + (size_t)g1 * DM + e0);
            float* o = hv + 8 * j;
            o[0] = x0.x + w0 * bflo(ya.x) + w1 * bflo(yc.x); o[1] = x0.y + w0 * bfhi(ya.x) + w1 * bfhi(yc.x); o[2] = x0.z + w0 * bflo(ya.y) + w1 * bflo(yc.y); o[3] = x0.w + w0 * bfhi(ya.y) + w1 * bfhi(yc.y);
            o[4] = x1.x + w0 * bflo(ya.z) + w1 * bflo(yc.z); o[5] = x1.y + w0 * bfhi(ya.z) + w1 * bfhi(yc.z); o[6] = x1.z + w0 * bflo(ya.w) + w1 * bflo(yc.w); o[7] = x1.w + w0 * bfhi(ya.w) + w1 * bfhi(yc.w);
#pragma unroll
            for (int q = 0; q < 8; ++q) s += o[q] * o[q]; }
        const float rs = 1.0f / sqrtf(wave_sum(s) * (1.0f / DM) + NORM_EPS);
        if (l == 0) { const float* nw = a.in[2] + DM;
#pragma unroll
            for (int j = 0; j < 4; ++j) { const int e0 = (lane + 64 * j) * 8; const float* o = hv + 8 * j; const f32x4 wa = *(const f32x4*)(nw + e0), wb = *(const f32x4*)(nw + e0 + 4);
                *(f32x4*)(hr + e0) = (f32x4){o[0], o[1], o[2], o[3]}; *(f32x4*)(hr + e0 + 4) = (f32x4){o[4], o[5], o[6], o[7]};
                v4u p; p.x = pk2(o[0] * rs * wa.x, o[1] * rs * wa.y); p.y = pk2(o[2] * rs * wa.z, o[3] * rs * wa.w); p.z = pk2(o[4] * rs * wb.x, o[5] * rs * wb.y); p.w = pk2(o[6] * rs * wb.z, o[7] * rs * wb.w);
                *(v4u*)(HN + (size_t)r * DM + e0) = p; }
        } else { const float* nw = a.in[4]; float* orow = a.out + (size_t)r * DM;
#ifdef PROBE_TS
            { const unsigned long long* ts = (const unsigned long long*)(F.ctl + CW_TS); const float dt_us = (float)(__hip_atomic_load(ts + PROBE_TS + 1, RLX_AGENT) - __hip_atomic_load(ts + PROBE_TS, RLX_AGENT)) * 0.01f;
#pragma unroll
              for (int q = 0; q < 32; ++q) hv[q] *= 1.0f + dt_us * 0.01f; }
#endif
#pragma unroll
            for (int j = 0; j < 4; ++j) { const int e0 = (lane + 64 * j) * 8; const float* o = hv + 8 * j; const f32x4 wa = *(const f32x4*)(nw + e0), wb = *(const f32x4*)(nw + e0 + 4);
                *(f32x4*)(orow + e0) = (f32x4){o[0] * rs * wa.x, o[1] * rs * wa.y, o[2] * rs * wa.z, o[3] * rs * wa.w};
                *(f32x4*)(orow + e0 + 4) = (f32x4){o[4] * rs * wb.x, o[5] * rs * wb.y, o[6] * rs * wb.z, o[7] * rs * wb.w}; } }
    }
}

struct OddPrepItem { f32x4 w[4][2]; v4u x[11]; };
DI void odd_prep_load(OddPrepItem& it, const bf16* P, const float* cw, int item, int lane) {
    const int pb = item >> 4, i = item & 15, ch = i * 512 + lane * 8, p0 = pb * 8;
#pragma unroll
    for (int j = 0; j < 4; ++j) { it.w[j][0] = *(const f32x4*)(cw + j * 8192 + ch); it.w[j][1] = *(const f32x4*)(cw + j * 8192 + ch + 4); }
#pragma unroll
    for (int q = 0; q < 11; ++q) { const int p = p0 - 3 + q; it.x[q] = *(const v4u*)(P + (size_t)pos_row(p > 0 ? p : 0) * OD_NP + ch); if (p < 0) it.x[q] = (v4u){0u, 0u, 0u, 0u}; }
}
DI void odd_prep_compute(const OddPrepItem& it, const Args& a, int item, int lane) {
    const bf16* P = (const bf16*)(a.ws + WS_PROJ); bf16* QN = (bf16*)(a.ws + WS_SCR + SC_QN); bf16* KN = (bf16*)(a.ws + WS_SCR + SC_KN); bf16* VC = (bf16*)(a.ws + WS_SCR + SC_VC);
    float* BETA = (float*)(a.ws + WS_SCR + SC_BETA); float* GG = (float*)(a.ws + WS_SCR + SC_G);
    const int pb = item >> 4, i = item & 15, ch = i * 512 + lane * 8, p0 = pb * 8;
#pragma unroll
    for (int o = 0; o < 8; ++o) { const int r = pos_row(p0 + o); float acc[8] = {0.f, 0.f, 0.f, 0.f, 0.f, 0.f, 0.f, 0.f};
#pragma unroll
        for (int j = 0; j < 4; ++j) { const v4u xv = it.x[o + j];
            acc[0] += it.w[j][0].x * bflo(xv.x); acc[1] += it.w[j][0].y * bfhi(xv.x); acc[2] += it.w[j][0].z * bflo(xv.y); acc[3] += it.w[j][0].w * bfhi(xv.y);
            acc[4] += it.w[j][1].x * bflo(xv.z); acc[5] += it.w[j][1].y * bfhi(xv.z); acc[6] += it.w[j][1].z * bflo(xv.w); acc[7] += it.w[j][1].w * bfhi(xv.w); }
        float ss = 0.f;
#pragma unroll
        for (int q = 0; q < 8; ++q) { acc[q] = acc[q] * sigm(acc[q]); ss += acc[q] * acc[q]; }
        float sc = 1.0f;
        if (i < 8) { ss += __shfl_xor(ss, 1); ss += __shfl_xor(ss, 2); ss += __shfl_xor(ss, 4); ss += __shfl_xor(ss, 8);
            sc = (1.0f / sqrtf(ss + NORM_EPS)) * (i < 4 ? 0.08838834764831845f : 1.0f); }
        const v4u ov = (v4u){pk2(acc[0] * sc, acc[1] * sc), pk2(acc[2] * sc, acc[3] * sc), pk2(acc[4] * sc, acc[5] * sc), pk2(acc[6] * sc, acc[7] * sc)};
        bf16* dst = i < 4 ? QN + (size_t)r * 2048 + ch : (i < 8 ? KN + (size_t)r * 2048 + ch - 2048 : VC + (size_t)r * 4096 + ch - 4096);
        *(v4u*)dst = ov; }
    if (i == 0 && lane < 32) {
#pragma unroll
        for (int o = 0; o < 8; ++o) { const int r = pos_row(p0 + o); const float bb = bf2f(P[(size_t)r * OD_NP + OD_B + lane]), aa = bf2f(P[(size_t)r * OD_NP + OD_A + lane]);
            BETA[(size_t)r * 32 + lane] = sigm(bb); GG[(size_t)r * 32 + lane] = -__expf(a.in[27][lane]) * softplus(aa + a.in[28][lane]); } }
}
DI void ph_odd_prep(const Frame& F, const Args& a) {
    const bf16* P = (const bf16*)(a.ws + WS_PROJ); const float* cw = a.in[26]; constexpr int NI = (TT / 8) * 16;
    for (int item = F.gw; item < NI; item += 2 * F.NGW) { OddPrepItem A, B; const bool hb = item + F.NGW < NI;
        odd_prep_load(A, P, cw, item, F.lane); odd_prep_load(B, P, cw, hb ? item + F.NGW : item, F.lane);
        odd_prep_compute(A, a, item, F.lane); if (hb) odd_prep_compute(B, a, item + F.NGW, F.lane); }
}
constexpr int ODD_POST_ROWS0 = 64 * 113;
DI void ph_odd_post(const Frame& F, const Args& a, int part) {
    const bf16* P = (const bf16*)(a.ws + WS_PROJ); const bf16* O = (const bf16*)(a.ws + WS_SCR + SC_O); bf16* Y = (bf16*)(a.ws + WS_YMIX); const float* nw = a.in[29];
    const int lane = F.lane; int w0 = F.gw, wn = F.NGW, n_rows = TX - ODD_POST_ROWS0;
    if (part == 0) { const int wx = F.vcu & 31; if (F.G != 256 || wx < 20) return; w0 = ((F.vcu >> 5) * 12 + (wx - 20)) * NWAVES + F.wave; wn = 96 * NWAVES; n_rows = ODD_POST_ROWS0 + NMETA; }
    if (part == 2) n_rows = TT;
    for (int ri = w0; ri < n_rows; ri += wn) { const int r = part == 0 ? (ri < ODD_POST_ROWS0 ? ri : TX + ri - ODD_POST_ROWS0) : (part == 1 ? ODD_POST_ROWS0 + ri : ri);
#pragma unroll 2
        for (int i = 0; i < 8; ++i) { const int ch = i * 512 + lane * 8; const v4u ow = *(const v4u*)(O + (size_t)r * 4096 + ch); const f32x4 o0 = (f32x4){bflo(ow.x), bfhi(ow.x), bflo(ow.y), bfhi(ow.y)}, o1 = (f32x4){bflo(ow.z), bfhi(ow.z), bflo(ow.w), bfhi(ow.w)};
            float ss = (o0.x * o0.x + o0.y * o0.y) + (o0.z * o0.z + o0.w * o0.w) + (o1.x * o1.x + o1.y * o1.y) + (o1.z * o1.z + o1.w * o1.w);
            ss += __shfl_xor(ss, 1); ss += __shfl_xor(ss, 2); ss += __shfl_xor(ss, 4); ss += __shfl_xor(ss, 8);
            const float rs = 1.0f / sqrtf(ss * (1.0f / 128.0f) + NORM_EPS);
            const v4u z = *(const v4u*)(P + (size_t)r * OD_NP + OD_Z + ch); const int c0 = ch & 127; const f32x4 w0 = *(const f32x4*)(nw + c0), w1 = *(const f32x4*)(nw + c0 + 4);
            const float zf[8] = {bflo(z.x), bfhi(z.x), bflo(z.y), bfhi(z.y), bflo(z.z), bfhi(z.z), bflo(z.w), bfhi(z.w)};
            const float of[8] = {o0.x * w0.x, o0.y * w0.y, o0.z * w0.z, o0.w * w0.w, o1.x * w1.x, o1.y * w1.y, o1.z * w1.z, o1.w * w1.w};
            float y[8];
#pragma unroll
            for (int q = 0; q < 8; ++q) y[q] = of[q] * rs * zf[q] * sigm(zf[q]);
            v4u p; p.x = pk2(y[0], y[1]); p.y = pk2(y[2], y[3]); p.z = pk2(y[4], y[5]); p.w = pk2(y[6], y[7]);
            *(v4u*)(Y + (size_t)r * 4096 + ch) = p; }
    }
}

typedef float f32x16 __attribute__((ext_vector_type(16)));
#define MFMA32(a, b, c) __builtin_amdgcn_mfma_f32_32x32x16_bf16((a), (b), (c), 0, 0, 0)
DI int crow(int reg, int h) { return (reg & 3) + 8 * (reg >> 2) + 4 * h; }
DI int chunk_row(int n, int c) { return n == 0 ? (c >= 48 ? TX + (c - 48) : -1) : 64 * (n - 1) + c; }
#ifndef GDN_NO_HELPER
#define GDN_NO_HELPER 0
#endif
constexpr int GDN_NCH = 129, GDN_UNITS = GDN_NCH * 32, GDN_KUNITS = GDN_NCH * 16, GC_STRIDE = 72;
constexpr size_t GD_WF = WS_MOEW, GD_UF = WS_MOEW + 65 * MiB, GD_IN = WS_MOEW + 130 * MiB, GD_GC = WS_MOEW + 163 * MiB, GD_KT = WS_HN, GD_QF = WS_SCR + 208 * MiB, GD_SAVE = WS_SCR + 205 * MiB;
static_assert(GD_QF + (size_t)GDN_KUNITS * 16384 <= WS_END && GD_SAVE + 2 * MiB <= GD_QF && (size_t)GDN_UNITS * 16384 <= 65 * MiB && (size_t)GDN_UNITS * 8192 <= 33 * MiB && (size_t)GDN_KUNITS * 16384 <= 33 * MiB && GD_GC + (size_t)GDN_UNITS * GC_STRIDE * 4 <= WS_H, "gdn map");

DI void ph_gdn_chunk(const Frame& F, const Args& a, int n_lo, int n_hi, int side) {
    const bf16* QN = (const bf16*)(a.ws + WS_SCR + SC_QN); const bf16* KN = (const bf16*)(a.ws + WS_SCR + SC_KN); const bf16* VC = (const bf16*)(a.ws + WS_SCR + SC_VC);
    const float* BETA = (const float*)(a.ws + WS_SCR + SC_BETA); const float* GG = (const float*)(a.ws + WS_SCR + SC_G);
    bf16* WF = (bf16*)(a.ws + GD_WF); bf16* UF = (bf16*)(a.ws + GD_UF); bf16* INF = (bf16*)(a.ws + GD_IN); bf16* KTF = (bf16*)(a.ws + GD_KT); bf16* QF = (bf16*)(a.ws + GD_QF); float* GC = (float*)(a.ws + GD_GC);
    LAS unsigned char* L = F.lds + RING_OFF;
    LAS unsigned char* kS = L; LAS unsigned char* qS = L + 17408; LAS unsigned char* vS = L + 34816; LAS unsigned char* kbS = L + 52224;
    LAS float* Lm = (LAS float*)(L + 69632); LAS bf16* IS = (LAS bf16*)(L + 87040); LAS bf16* XS = (LAS bf16*)(L + 96256);
    LAS float* betaS = (LAS float*)(L + 130048); LAS float* gcS = betaS + 64; LAS float* egcS = betaS + 128;
    LAS unsigned char* Lb = L + 17408; LAS unsigned char* TDs = L + 26624; LAS unsigned char* YT0 = L + 28672; LAS unsigned char* XT0 = L + 130816;
    static_assert(130816 + 8 * 1792 <= LDSCTL_OFF, "gdn lds map");
    const int tid = F.tid, lane = F.lane, wave = F.wave, l31 = lane & 31, h = lane >> 5;
    int widx = F.vcu, wcnt = F.G;
    if (side) { if (F.G == 256) { const int wx = F.vcu & 31; if (wx < 20) return; widx = (F.vcu >> 5) * 12 + (wx - 20); wcnt = 96; } else { if (F.vcu < 128 || F.G <= 128) return; widx = F.vcu - 128; wcnt = F.G - 128; } }
#define G1_BAR() do { asm volatile("s_waitcnt lgkmcnt(0)" ::: "memory"); __builtin_amdgcn_s_barrier(); asm volatile("" ::: "memory"); } while (0)
    v4u pkx[2], pqx[2], pvx[2]; float pbeta = 0.f, pgl = 0.f;
#define G1_FETCH(uu) do { const int n_ = (uu) >> 5, hv_ = (uu) & 31, hk_ = hv_ >> 1; \
        _Pragma("unroll") for (int i = 0; i < 2; ++i) { const int p = tid + 512 * i, row = p >> 4, ch = p & 15; const int rr = chunk_row(n_, row); const size_t r_ = (size_t)(rr >= 0 ? rr : 0); \
            pkx[i] = *(const v4u*)(KN + r_ * 2048 + hk_ * 128 + ch * 8); pqx[i] = *(const v4u*)(QN + r_ * 2048 + hk_ * 128 + ch * 8); pvx[i] = *(const v4u*)(VC + r_ * 4096 + hv_ * 128 + ch * 8); \
            if (rr < 0) { pkx[i] = (v4u){0u, 0u, 0u, 0u}; pqx[i] = pkx[i]; pvx[i] = pkx[i]; } } \
        if (wave == 0) { const int rr = chunk_row(n_, lane); const size_t r_ = (size_t)(rr >= 0 ? rr : 0); pbeta = BETA[r_ * 32 + hv_]; pgl = GG[r_ * 32 + hv_]; if (rr < 0) { pbeta = 0.f; pgl = 0.f; } } } while (0)
    const int unit0 = n_lo * 32 + widx;
    if (unit0 < n_hi * 32) G1_FETCH(unit0);
    for (int unit = unit0; unit < n_hi * 32; unit += wcnt) {
        const int n = unit >> 5, hv = unit & 31, hk = hv >> 1; const size_t su = (size_t)hv * GDN_NCH + n;
#pragma unroll
        for (int i = 0; i < 2; ++i) { const int p = tid + 512 * i, row = p >> 4, ch = p & 15;
            *(LAS v4u*)(kS + row * 272 + ch * 16) = pkx[i]; *(LAS v4u*)(qS + row * 272 + ch * 16) = pqx[i]; *(LAS v4u*)(vS + row * 272 + ch * 16) = pvx[i]; }
        if (wave == 0) { float b = pbeta, g = pgl;
#pragma unroll
            for (int o = 1; o < 64; o <<= 1) { const float t = __shfl_up(g, o); if (lane >= o) g += t; }
            betaS[lane] = b; gcS[lane] = g; egcS[lane] = __expf(g); }
        if (unit + wcnt < n_hi * 32) G1_FETCH(unit + wcnt);
        G1_BAR();
        if ((hv & 1) == 0) { const size_t kunit = (size_t)hk * GDN_NCH + n;
#pragma unroll
            for (int i = 0; i < 2; ++i) { const int p = tid + 512 * i, comb = p >> 6, ln = p & 63, t = comb >> 3, s = comb & 7; const int c = 32 * t + (ln & 31), k0 = 16 * s + 8 * (ln >> 5);
                *(v4u*)(QF + (kunit * 16 + comb) * 512 + ln * 8) = *(const LAS v4u*)(qS + c * 272 + k0 * 2); } }
#pragma unroll
        for (int i = 0; i < 2; ++i) { const int p = tid + 512 * i, row = p >> 4, ch = p & 15; const v4u kx = *(const LAS v4u*)(kS + row * 272 + ch * 16); const float b = betaS[row];
            v4u o; o.x = pk2(bflo(kx.x) * b, bfhi(kx.x) * b); o.y = pk2(bflo(kx.y) * b, bfhi(kx.y) * b); o.z = pk2(bflo(kx.z) * b, bfhi(kx.z) * b); o.w = pk2(bflo(kx.w) * b, bfhi(kx.w) * b);
            *(LAS v4u*)(kbS + row * 272 + ch * 16) = o; }
        G1_BAR();
        { const int which = wave >> 2, ti = (wave >> 1) & 1, tj = wave & 1;
          f32x16 acc;
#pragma unroll
          for (int r = 0; r < 16; ++r) acc[r] = 0.f;
          if (!(ti == 0 && tj == 1)) { const LAS unsigned char* Ab = (which == 0 ? kbS : qS) + (32 * ti + l31) * 272 + 16 * h; const LAS unsigned char* Bb = kS + (32 * tj + l31) * 272 + 16 * h;
#pragma unroll
              for (int s = 0; s < 8; ++s) acc = MFMA32(*(const LAS bf16x8*)(Ab + 32 * s), *(const LAS bf16x8*)(Bb + 32 * s), acc); }
          const int j = 32 * tj + l31; const float gj = gcS[j];
#pragma unroll
          for (int r = 0; r < 16; ++r) { const int i = 32 * ti + crow(r, h); const float e = __expf(fminf(gcS[i] - gj, 0.f));
              if (which == 0) Lm[i * 68 + j] = i > j ? acc[r] * e : 0.f;
              else IS[i * 72 + j] = (bf16)f2bf(i >= j ? acc[r] * e : 0.f); } }
        G1_BAR();
#pragma unroll
        for (int i = 0; i < 8; ++i) { const int e = tid + 512 * i, r = e >> 6, c = e & 63; *(LAS bf16*)(Lb + r * 144 + c * 2) = (bf16)f2bf(Lm[r * 68 + c]); }
        if (wave == 0) { const int b = lane >> 4, c = lane & 15; float t[16]; const LAS float* Ld = Lm + (16 * b) * 68 + 16 * b;
            t[0] = c == 0 ? 1.f : 0.f; *(LAS bf16*)(TDs + (b * 16) * 32 + c * 2) = (bf16)f2bf(t[0]);
#define G1_INV_ROWS(I0, I1) do { f32x4 Lr[(I1) - (I0)][4]; \
            _Pragma("unroll") for (int i = (I0); i < (I1); ++i) _Pragma("unroll") for (int q = 0; q < (i + 3) / 4; ++q) Lr[i - (I0)][q] = *(const LAS f32x4*)(Ld + i * 68 + 4 * q); \
            _Pragma("unroll") for (int i = (I0); i < (I1); ++i) { float a0 = i == c ? 1.f : 0.f, a1 = 0.f; \
                _Pragma("unroll") for (int j = 0; j < i; ++j) { const float lv = Lr[i - (I0)][j >> 2][j & 3]; if (j & 1) a1 -= lv * t[j]; else a0 -= lv * t[j]; } \
                t[i] = a0 + a1; *(LAS bf16*)(TDs + (b * 16 + i) * 32 + c * 2) = (bf16)f2bf(t[i]); } } while (0)
            G1_INV_ROWS(1, 9); G1_INV_ROWS(9, 13); G1_INV_ROWS(13, 16);
#undef G1_INV_ROWS
        } else if (wave >= 4) { const int t2 = tid - 256;
#pragma unroll
            for (int i = 0; i < 2; ++i) { const int p = t2 + 256 * i, comb = p >> 6, ln = p & 63, t = comb >> 2, s = comb & 3; const int c = 32 * t + (ln & 31), j0 = 16 * s + 8 * (ln >> 5);
                *(v4u*)(INF + (su * 8 + comb) * 512 + ln * 8) = *(const LAS v4u*)(IS + c * 72 + j0); }
            if ((hv & 1) == 0) { const size_t kunit = (size_t)hk * GDN_NCH + n;
#pragma unroll
                for (int i = 0; i < 4; ++i) { const int p = t2 + 256 * i, comb = p >> 6, ln = p & 63, kt = comb >> 2, s = comb & 3; const int kd = 32 * kt + (ln & 31), c0 = 16 * s + 8 * (ln >> 5);
                    unsigned w[4];
#pragma unroll
                    for (int jj = 0; jj < 4; ++jj) { const unsigned lo = *(const LAS bf16*)(kS + (c0 + 2 * jj) * 272 + kd * 2), hi = *(const LAS bf16*)(kS + (c0 + 2 * jj + 1) * 272 + kd * 2); w[jj] = lo | (hi << 16); }
                    *(v4u*)(KTF + (kunit * 16 + comb) * 512 + ln * 8) = (v4u){w[0], w[1], w[2], w[3]}; } }
            if (t2 < 64) GC[su * GC_STRIDE + t2] = gcS[t2];
            else if (t2 == 64) GC[su * GC_STRIDE + 64] = gcS[63];
            else if (t2 == 65) GC[su * GC_STRIDE + 65] = egcS[63];
        }
        G1_BAR();
        { const int quad = lane >> 4, lc = lane & 15; LAS unsigned char* XTw = XT0 + wave * 1792; LAS unsigned char* YTw = YT0 + wave * 768;
          const bf16x8 z8 = (bf16x8){0, 0, 0, 0, 0, 0, 0, 0}; const f32x4 z4 = (f32x4){0.f, 0.f, 0.f, 0.f};
          bf16x8 tdf[4];
#pragma unroll
          for (int b = 0; b < 4; ++b) tdf[b] = quad < 2 ? *(const LAS bf16x8*)(TDs + (b * 16 + lc) * 32 + quad * 16) : z8;
#pragma unroll 1
          for (int tl = 0; tl < 2; ++tl) { const int col = 32 * wave + 16 * tl + lc;
              const LAS unsigned char* rz = wave < 4 ? vS + col * 2 : kbS + (col - 128) * 2; const LAS float* bz = wave < 4 ? betaS : egcS;
#pragma unroll
              for (int b = 0; b < 4; ++b) { f32x4 y;
#pragma unroll
                  for (int r = 0; r < 4; ++r) { const int i = 16 * b + 4 * quad + r; y[r] = bf2f(*(const LAS bf16*)(rz + i * 272)) * bz[i]; }
                  if (b >= 1) { f32x4 p = z4;
#pragma unroll
                      for (int kk = 0; kk < (b >= 3 ? 2 : 1); ++kk) { const bf16x8 af = *(const LAS bf16x8*)(Lb + (16 * b + lc) * 144 + (32 * kk + 8 * quad) * 2);
                          const bf16x8 bfv = (32 * kk + 8 * quad < 16 * b) ? *(const LAS bf16x8*)(XTw + lc * 112 + (32 * kk + 8 * quad) * 2) : z8;
                          p = __builtin_amdgcn_mfma_f32_16x16x32_bf16(af, bfv, p, 0, 0, 0); }
                      y = y - p; }
                  *(LAS v2u*)(YTw + lc * 48 + quad * 8) = (v2u){pk2(y[0], y[1]), pk2(y[2], y[3])};
                  asm volatile("" ::: "memory");
                  const bf16x8 yb = quad < 2 ? *(const LAS bf16x8*)(YTw + lc * 48 + quad * 16) : z8;
                  const f32x4 x = __builtin_amdgcn_mfma_f32_16x16x32_bf16(tdf[b], yb, z4, 0, 0, 0);
                  if (b < 3) *(LAS v2u*)(XTw + lc * 112 + (16 * b + 4 * quad) * 2) = (v2u){pk2(x[0], x[1]), pk2(x[2], x[3])};
                  asm volatile("" ::: "memory");
#pragma unroll
                  for (int r = 0; r < 4; ++r) XS[(16 * b + 4 * quad + r) * 264 + col] = (bf16)f2bf(x[r]); } } }
        G1_BAR();
#pragma unroll
        for (int i = 0; i < 2; ++i) { const int p = tid + 512 * i, comb = p >> 6, ln = p & 63, t = comb >> 3, s = comb & 7; const int c = 32 * t + (ln & 31), k0 = 16 * s + 8 * (ln >> 5);
            *(v4u*)(WF + (su * 16 + comb) * 512 + ln * 8) = *(const LAS v4u*)(XS + c * 264 + 128 + k0); }
        { const int t = wave >> 2, ns = wave & 3; unsigned w[8];
#pragma unroll
          for (int r = 0; r < 8; ++r) { const unsigned lo = XS[(32 * t + crow(2 * r, h)) * 264 + 32 * ns + l31], hi = XS[(32 * t + crow(2 * r + 1, h)) * 264 + 32 * ns + l31]; w[r] = lo | (hi << 16); }
          bf16* dst = UF + ((su * 8 + wave) * 64 + lane) * 16; *(v4u*)dst = (v4u){w[0], w[1], w[2], w[3]}; *(v4u*)(dst + 8) = (v4u){w[4], w[5], w[6], w[7]}; }
        G1_BAR();
    }
}

#undef G1_BAR
#undef G1_FETCH
DI void ph_gdn_chain(const Frame& F, const Args& a, int n_lo, int n_hi) {
    const int xg = F.vcu >> 5, wx = F.vcu & 31; if (F.G != 256 ? F.vcu >= 128 : wx >= 20) return;
    const bool helper = F.G == 256 && wx >= 16;
    const int hv = F.G == 256 ? 4 * xg + (helper ? wx - 16 : wx >> 2) : F.vcu >> 2, ns = F.G == 256 ? wx & 3 : F.vcu & 3, hk = hv >> 1;
    const bf16* QN = (const bf16*)(a.ws + WS_SCR + SC_QN);
    const bf16* WF = (const bf16*)(a.ws + GD_WF); const bf16* UF = (const bf16*)(a.ws + GD_UF); const bf16* INF = (const bf16*)(a.ws + GD_IN); const bf16* KTF = (const bf16*)(a.ws + GD_KT); const bf16* QF = (const bf16*)(a.ws + GD_QF); const float* GC = (const float*)(a.ws + GD_GC);
    bf16* O = (bf16*)(a.ws + WS_SCR + SC_O);
    gu32* prog = F.ctl + CW_PROG + hv * 16;
    if (helper && GDN_NO_HELPER) return;
    if (helper) { unsigned sink = 0u; const int tid = F.tid;
        for (int n0 = n_lo; n0 < n_hi; n0 += 4) {
            if (n0 >= n_lo + 8) { if (tid == 0) { unsigned sp = 0; while ((int)__hip_atomic_load(prog, RLX_AGENT) < n0 - 4 && ++sp < 20000u) __builtin_amdgcn_s_sleep(8); } __syncthreads(); }
            unsigned v[5];
#pragma unroll
            for (int i = 0; i < 5; ++i) { const int li = tid + 512 * i;
                const int st = li / 580, ln = li % 580, n = n0 + st; const unsigned* p = nullptr;
                if (st < 4 && n < n_hi) { const size_t unit = (size_t)hv * GDN_NCH + n, kunit = (size_t)hk * GDN_NCH + n;
                    if (ln < 128) p = (const unsigned*)(WF + unit * 8192 + ln * 64);
                    else if (ln < 256) p = (const unsigned*)(UF + unit * 8192 + (ln - 128) * 64);
                    else if (ln < 320) p = (const unsigned*)(INF + unit * 4096 + (ln - 256) * 64);
                    else if (ln < 448) p = (const unsigned*)(KTF + kunit * 8192 + (ln - 320) * 64);
                    else if (ln < 576) p = (const unsigned*)(QF + kunit * 8192 + (ln - 448) * 64);
                    else if (ln < 579) p = (const unsigned*)(GC + unit * GC_STRIDE + (ln - 576) * 32); }
                v[i] = p ? *p : 0u; }
#pragma unroll
            for (int i = 0; i < 5; ++i) sink += v[i];
        }
        if (sink == 0x12345u) __hip_atomic_store(F.ctl + CW_TMO + 2, sink, RLX_AGENT);
        return; }
    LAS unsigned char* ST = F.lds + RING_OFF; LAS unsigned char* VN = ST + 8704; LAS unsigned char* VND = ST + 13312;
    const int lane = F.lane, wave = F.wave, l31 = lane & 31, h = lane >> 5;
    for (int i = F.tid; i < 8704 / 4; i += NWAVES * 64) ((LAS unsigned*)ST)[i] = 0u;
#define GDN_BAR() do { asm volatile("s_waitcnt lgkmcnt(0)" ::: "memory"); __builtin_amdgcn_s_barrier(); asm volatile("" ::: "memory"); } while (0)
    GDN_BAR();
    f32x16 S;
#pragma unroll
    for (int r = 0; r < 16; ++r) S[r] = 0.f;
    const int role = wave < 2 ? 0 : (wave < 4 ? 1 : 2); const int t = wave & 1, kt = wave & 3;
    bf16x8 A8[8]; bf16x8 A4[4]; v4u U0 = (v4u){0u, 0u, 0u, 0u}, U1 = U0; f32x4 G4[4]; float gl = 0.f, egl = 1.f;
#pragma unroll
    for (int s = 0; s < 8; ++s) A8[s] = (bf16x8){0, 0, 0, 0, 0, 0, 0, 0};
#pragma unroll
    for (int s = 0; s < 4; ++s) { A4[s] = (bf16x8){0, 0, 0, 0, 0, 0, 0, 0}; G4[s] = (f32x4){0.f, 0.f, 0.f, 0.f}; }
#define GDN_LOAD(nn) do { const size_t unit_ = (size_t)hv * GDN_NCH + (nn); const float* gc_ = GC + unit_ * GC_STRIDE; \
        if (role == 0) { \
            const bf16* up_ = UF + (((unit_ * 2 + t) * 4 + ns) * 64 + lane) * 16; U0 = *(const v4u*)up_; U1 = *(const v4u*)(up_ + 8); \
            _Pragma("unroll") for (int g = 0; g < 4; ++g) G4[g] = *(const f32x4*)(gc_ + 32 * t + 8 * g + 4 * h); gl = gc_[64]; } \
        else if (role == 1) { const size_t qunit_ = (size_t)hk * GDN_NCH + (nn); \
            _Pragma("unroll") for (int s = 0; s < 4; ++s) A4[s] = *(const bf16x8*)(INF + ((unit_ * 2 + t) * 4 + s) * 512 + lane * 8); \
            _Pragma("unroll") for (int g = 0; g < 4; ++g) G4[g] = *(const f32x4*)(gc_ + 32 * t + 8 * g + 4 * h); } \
        else { const size_t kunit_ = (size_t)hk * GDN_NCH + (nn); \
            _Pragma("unroll") for (int s = 0; s < 4; ++s) A4[s] = *(const bf16x8*)(KTF + ((kunit_ * 4 + kt) * 4 + s) * 512 + lane * 8); egl = gc_[65]; } } while (0)
    float* SV = (float*)(a.ws + GD_SAVE) + ((size_t)((hv * 4 + ns) * 4 + kt) * 64 + lane) * 16;
    if (n_lo > 0 && role == 2) {
#pragma unroll
        for (int g = 0; g < 4; ++g) { const f32x4 v = *(const f32x4*)(SV + 4 * g); S[4 * g] = v.x; S[4 * g + 1] = v.y; S[4 * g + 2] = v.z; S[4 * g + 3] = v.w;
            *(LAS v2u*)(ST + l31 * 272 + (32 * kt + 8 * g + 4 * h) * 2) = (v2u){pk2(v.x, v.y), pk2(v.z, v.w)}; }
    }
    GDN_BAR();
#define GDN_LOADA(AC, nn) do { if (role == 0) { const size_t u_ = (size_t)hv * GDN_NCH + (nn); _Pragma("unroll") for (int s = 0; s < 8; ++s) AC[s] = *(const bf16x8*)(WF + ((u_ * 2 + t) * 8 + s) * 512 + lane * 8); } \
        else if (role == 1) { const size_t q_ = (size_t)hk * GDN_NCH + (nn); _Pragma("unroll") for (int s = 0; s < 8; ++s) AC[s] = *(const bf16x8*)(QF + ((q_ * 2 + t) * 8 + s) * 512 + lane * 8); } } while (0)
    bf16x8 A8q[8];
#pragma unroll
    for (int s = 0; s < 8; ++s) A8q[s] = (bf16x8){0, 0, 0, 0, 0, 0, 0, 0};
    GDN_LOADA(A8, n_lo); if (n_lo + 1 < n_hi) GDN_LOADA(A8q, n_lo + 1);
    GDN_LOAD(n_lo);
#define GDN_STEP(n, AC) do { \
        bf16x8 a4[4]; const v4u u0 = U0, u1 = U1; f32x4 g4[4]; const float cgl = gl, cegl = egl; \
        _Pragma("unroll") \
        for (int s = 0; s < 4; ++s) { a4[s] = A4[s]; g4[s] = G4[s]; } \
        if (n + 1 < n_hi) GDN_LOAD(n + 1); \
        if (ns == 0 && F.tid == 0) __hip_atomic_store(prog, (unsigned)n, RLX_AGENT); \
        f32x16 acc; \
        _Pragma("unroll") \
        for (int r = 0; r < 16; ++r) acc[r] = 0.f; \
        if (role < 2) { \
        _Pragma("unroll") \
            for (int s = 0; s < 8; ++s) acc = MFMA32(AC[s], *(const LAS bf16x8*)(ST + l31 * 272 + 32 * s + 16 * h), acc); \
            asm volatile("" :: "v"(acc[0])); \
            if (n + 2 < n_hi) GDN_LOADA(AC, n + 2); \
        } \
        if (role == 0) { const unsigned uw[8] = {u0.x, u0.y, u0.z, u0.w, u1.x, u1.y, u1.z, u1.w}; \
        _Pragma("unroll") \
            for (int g = 0; g < 4; ++g) { float vn[4], vd[4]; \
        _Pragma("unroll") \
                for (int q = 0; q < 4; ++q) { const int r = 4 * g + q; const float uv = (r & 1) ? bfhi(uw[r >> 1]) : bflo(uw[r >> 1]); vn[q] = uv - acc[r]; vd[q] = vn[q] * __expf(cgl - g4[g][q]); } \
                *(LAS v2u*)(VN + l31 * 144 + (32 * t + 8 * g + 4 * h) * 2) = (v2u){pk2(vn[0], vn[1]), pk2(vn[2], vn[3])}; \
                *(LAS v2u*)(VND + l31 * 144 + (32 * t + 8 * g + 4 * h) * 2) = (v2u){pk2(vd[0], vd[1]), pk2(vd[2], vd[3])}; } \
        } else if (role == 1) { \
        _Pragma("unroll") \
            for (int g = 0; g < 4; ++g) \
        _Pragma("unroll") \
                for (int q = 0; q < 4; ++q) acc[4 * g + q] *= __expf(g4[g][q]); \
        } \
        GDN_BAR(); \
        if (role == 1) { \
        _Pragma("unroll") \
            for (int s = 0; s < 4; ++s) acc = MFMA32(a4[s], *(const LAS bf16x8*)(VN + l31 * 144 + 32 * s + 16 * h), acc); \
        _Pragma("unroll") \
            for (int r = 0; r < 16; ++r) { const int rr = chunk_row(n, 32 * t + crow(r, h)); if (rr >= 0) O[(size_t)rr * 4096 + hv * 128 + 32 * ns + l31] = (bf16)f2bf(acc[r]); } \
        } else if (role == 2) { \
        _Pragma("unroll") \
            for (int r = 0; r < 16; ++r) S[r] *= cegl; \
        _Pragma("unroll") \
            for (int s = 0; s < 4; ++s) S = MFMA32(a4[s], *(const LAS bf16x8*)(VND + l31 * 144 + 32 * s + 16 * h), S); \
        _Pragma("unroll") \
            for (int g = 0; g < 4; ++g) *(LAS v2u*)(ST + l31 * 272 + (32 * kt + 8 * g + 4 * h) * 2) = (v2u){pk2(S[4 * g], S[4 * g + 1]), pk2(S[4 * g + 2], S[4 * g + 3])}; \
        } \
        GDN_BAR(); \
    } while (0)
    for (int n2 = n_lo; n2 < n_hi; n2 += 2) { GDN_STEP(n2, A8); if (n2 + 1 < n_hi) GDN_STEP(n2 + 1, A8q); }
#undef GDN_STEP
#undef GDN_LOADA
    if (n_hi < GDN_NCH && role == 2) {
#pragma unroll
        for (int g = 0; g < 4; ++g) *(f32x4*)(SV + 4 * g) = (f32x4){S[4 * g], S[4 * g + 1], S[4 * g + 2], S[4 * g + 3]}; }
#undef GDN_LOAD
#undef GDN_BAR
}

constexpr int RW_NSC = 258, RW_UNITS = 129 * 16;
DI int sub_row(int sc, int t) { const int n = sc >> 1, sub = sc & 1; return n == 0 ? ((sub == 0 && t >= 16) ? TX + t - 16 : -1) : 64 * (n - 1) + 32 * sub + t; }
constexpr size_t RW_BASE = WS_PROJ + 92 * MiB;
constexpr size_t RW_RH = RW_BASE, RW_RL = RW_BASE + 33 * MiB, RW_GT = RW_BASE + 66 * MiB, RW_GAM = RW_BASE + 99 * MiB;
constexpr size_t RW_PR = WS_SCR + 195 * MiB, RW_AT = WS_SCR + 211 * MiB + 256 * 1024, RW_VTF = WS_SCR + 219 * MiB + 512 * 1024, RW_SALL = WS_SCR + 235 * MiB + 768 * 1024;
constexpr size_t RW_XSAVE = 1 * MiB + 640 * 1024;
constexpr size_t RW_VV = WS_YMIX + 34 * MiB, RW_BON = WS_YMIX + 52 * MiB, LR_H = WS_YMIX + 54 * MiB, LR_A = WS_YMIX + 56 * MiB, LR_C = WS_YMIX + 58 * MiB;
constexpr size_t RW_SCH = (size_t)RW_NSC * 16;
static_assert((size_t)MP * EV_NP * 2 <= 92 * MiB && RW_SCH * 8192 <= 33 * MiB && RW_GAM + RW_SCH * 256 <= WS_SCR, "rwkv map (proj region)");
static_assert(WS_SCR + SC_LIX + (size_t)MP * 4096 <= RW_PR && RW_PR + RW_SCH * 4096 <= RW_AT && RW_AT + RW_SCH * 2048 <= RW_VTF && RW_VTF + RW_SCH * 4096 <= RW_SALL && RW_SALL + RW_SCH * 8192 <= WS_END, "rwkv map (scratch region)");
static_assert((size_t)MP * DM * 2 <= 34 * MiB && RW_VV + (size_t)MP * 2048 <= RW_BON && RW_BON + (size_t)MP * 64 <= LR_H && LR_H + RW_SCH * 256 <= LR_A && LR_A + RW_SCH * 256 <= LR_C && LR_C + RW_SCH * 256 <= WS_PROJ, "rwkv map (ymix region)");

DI void sub_rows(int sc, int& t0, int& rbase) { if (sc >= 2) { t0 = 0; rbase = 64 * ((sc >> 1) - 1) + 32 * (sc & 1); } else if (sc == 0) { t0 = 16; rbase = TX - 16; } else { t0 = 32; rbase = 0; } }
DI void lru_local(const Frame& F, const Args& a, int gw, int ngw) {
    const bf16* LA = (const bf16*)(a.ws + WS_SCR + SC_LA); const bf16* LIX = (const bf16*)(a.ws + WS_SCR + SC_LIX);
    float* HL = (float*)(a.ws + LR_H); float* AP = (float*)(a.ws + LR_A);
    for (int item = gw; item < RW_NSC * 16; item += ngw) { const int sc = item >> 4, c = (item & 15) * 64 + F.lane; int t0, rbase; sub_rows(sc, t0, rbase);
        float av[32], ix[32];
#pragma unroll
        for (int t = 0; t < 32; ++t) { const size_t o = (size_t)(rbase + (t >= t0 ? t : 32)) * 1024 + c; av[t] = bf2f(LA[o]); ix[t] = bf2f(LIX[o]); }
        float h = 0.f, p = 1.f;
#pragma unroll
        for (int t = 0; t < 32; ++t) { const float om = t >= t0 ? av[t] : 0.f, x_ = t >= t0 ? ix[t] : 0.f, a_ = 1.0f - om; h = a_ * h + sqrtf(om * (1.0f + a_)) * x_; p *= a_; }
        HL[sc * 1024 + c] = h; AP[sc * 1024 + c] = p; }
}
DI void lru_apply(const Frame& F, const Args& a) {
    const bf16* P = (const bf16*)(a.ws + WS_PROJ); const bf16* LA = (const bf16*)(a.ws + WS_SCR + SC_LA); const bf16* LIX = (const bf16*)(a.ws + WS_SCR + SC_LIX);
    const float* CR = (const float*)(a.ws + LR_C); bf16* Y = (bf16*)(a.ws + WS_YMIX);
    for (int item = F.gw; item < RW_NSC * 16; item += F.NGW) { const int sc = item >> 4, c = (item & 15) * 64 + F.lane; int t0, rbase; sub_rows(sc, t0, rbase); if (t0 >= 32) continue;
        float h = CR[sc * 1024 + c];
#pragma unroll
        for (int tb = 0; tb < 32; tb += 16) { float av[16], ix[16], gb[16];
#pragma unroll
            for (int t = 0; t < 16; ++t) { const size_t r_ = (size_t)(rbase + (tb + t >= t0 ? tb + t : 32)); av[t] = bf2f(LA[r_ * 1024 + c]); ix[t] = bf2f(LIX[r_ * 1024 + c]); gb[t] = bf2f(P[r_ * EV_NP + EV_GB + c]); }
#pragma unroll
            for (int t = 0; t < 16; ++t) { if (tb + t >= t0) { const float a_ = 1.0f - av[t]; h = a_ * h + sqrtf(av[t] * (1.0f + a_)) * ix[t]; Y[(size_t)(rbase + tb + t) * DM + 1024 + c] = (bf16)f2bf(h * gelu_tanh(gb[t])); } } } }
}

DI void ph_rwkv_chunk(const Frame& F, const Args& a, int n_lo, int n_hi, int wg0) {
    if (F.vcu < wg0) return;
    const bf16* P = (const bf16*)(a.ws + WS_PROJ); const bf16* DEC = (const bf16*)(a.ws + WS_SCR + SC_DEC); const bf16* ICL = (const bf16*)(a.ws + WS_SCR + SC_ICL);
    bf16* RH = (bf16*)(a.ws + RW_RH); bf16* RL = (bf16*)(a.ws + RW_RL); bf16* GT = (bf16*)(a.ws + RW_GT); float* GAM = (float*)(a.ws + RW_GAM); bf16* PR = (bf16*)(a.ws + RW_PR); bf16* ATG = (bf16*)(a.ws + RW_AT); bf16* VTF = (bf16*)(a.ws + RW_VTF);
    bf16* VV = (bf16*)(a.ws + RW_VV); float* BON = (float*)(a.ws + RW_BON);
    LAS unsigned char* L = F.lds + RING_OFF;
    LAS float* wS = (LAS float*)L; LAS float* aS = wS + 4096; LAS float* bS = wS + 8192; LAS float* rS = wS + 12288; LAS float* kS = wS + 16384;
    LAS unsigned char* vT = L + 81920; LAS unsigned char* aT = L + 91136; LAS unsigned char* rT = L + 100352; LAS unsigned char* kT = L + 109568; LAS unsigned char* bT = L + 118784;
    LAS unsigned char* AT = L + 128000; LAS unsigned char* NT = L + 133120; LAS float* gam = (LAS float*)(L + 138240);
    LAS unsigned char* aTl = L; LAS unsigned char* bTl = L + 9216;
    const int tid = F.tid, lane = F.lane, wave = F.wave, l31 = lane & 31, h = lane >> 5;
    const float* mu = a.in[6];
    for (int unit = n_lo * 16 + (F.vcu - wg0); unit < n_hi * 16; unit += F.G - wg0) {
        const int n = unit >> 4, hd = unit & 15;
        { const int tok = tid >> 3, cg = tid & 7, c0 = hd * 64 + cg * 8; const int rr = sub_row(2 * n + (tok >> 5), tok & 31);
          float wv[8], av[8], bv[8], rv[8], kv[8], vv[8];
#pragma unroll
          for (int q = 0; q < 8; ++q) { wv[q] = 1.f; av[q] = 0.f; bv[q] = 0.f; rv[q] = 0.f; kv[q] = 0.f; vv[q] = 0.f; }
          if (rr >= 0) { const int pos = row_pos(rr); const bf16* cur = P + (size_t)rr * EV_NP + c0; const bf16* prv = pos > 0 ? P + (size_t)pos_row(pos - 1) * EV_NP + c0 : nullptr;
              const v4u z4 = (v4u){0u, 0u, 0u, 0u};
              const v4u cr = *(const v4u*)cur, ck = *(const v4u*)(cur + 1024), cv = *(const v4u*)(cur + 2048);
              const v4u qr = prv ? *(const v4u*)prv : z4, qk = prv ? *(const v4u*)(prv + 1024) : z4, qv = prv ? *(const v4u*)(prv + 2048) : z4;
              const unsigned crw[4] = {cr.x, cr.y, cr.z, cr.w}, ckw[4] = {ck.x, ck.y, ck.z, ck.w}, cvw[4] = {cv.x, cv.y, cv.z, cv.w}, qrw[4] = {qr.x, qr.y, qr.z, qr.w}, qkw[4] = {qk.x, qk.y, qk.z, qk.w}, qvw[4] = {qv.x, qv.y, qv.z, qv.w};
              float ss = 0.f, bon = 0.f; float kk[8], ic[8];
#pragma unroll
              for (int q = 0; q < 8; ++q) { const int c = c0 + q; const float crf = (q & 1) ? bfhi(crw[q >> 1]) : bflo(crw[q >> 1]), ckf = (q & 1) ? bfhi(ckw[q >> 1]) : bflo(ckw[q >> 1]), cvf = (q & 1) ? bfhi(cvw[q >> 1]) : bflo(cvw[q >> 1]);
                  const float prf = (q & 1) ? bfhi(qrw[q >> 1]) : bflo(qrw[q >> 1]), pkf = (q & 1) ? bfhi(qkw[q >> 1]) : bflo(qkw[q >> 1]), pvf = (q & 1) ? bfhi(qvw[q >> 1]) : bflo(qvw[q >> 1]);
                  rv[q] = crf + (prf - crf) * mu[c]; kk[q] = ckf + (pkf - ckf) * mu[1024 + c]; vv[q] = cvf + (pvf - cvf) * mu[2048 + c];
                  wv[q] = 1.0f - bf2f(DEC[(size_t)rr * 1024 + c]); ic[q] = bf2f(ICL[(size_t)rr * 1024 + c]);
                  const float kkv = kk[q] * a.in[12][c]; av[q] = kkv; ss += kkv * kkv; kv[q] = kk[q] * (1.0f + (ic[q] - 1.0f) * a.in[13][c]); bon += rv[q] * kv[q] * a.in[14][c]; }
              ss += __shfl_xor(ss, 1); ss += __shfl_xor(ss, 2); ss += __shfl_xor(ss, 4); bon += __shfl_xor(bon, 1); bon += __shfl_xor(bon, 2); bon += __shfl_xor(bon, 4);
              const float inv = 1.0f / fmaxf(sqrtf(ss), 1e-12f);
#pragma unroll
              for (int q = 0; q < 8; ++q) { const float kkn = av[q] * inv; av[q] = -kkn; bv[q] = kkn * ic[q]; }
              if (cg == 0) BON[(size_t)rr * 16 + hd] = bon;
              *(v4u*)(VV + (size_t)rr * 1024 + c0) = (v4u){pk2(vv[0], vv[1]), pk2(vv[2], vv[3]), pk2(vv[4], vv[5]), pk2(vv[6], vv[7])}; }
          const int o = tok * 64 + cg * 8;
          *(LAS f32x4*)(wS + o) = (f32x4){wv[0], wv[1], wv[2], wv[3]}; *(LAS f32x4*)(wS + o + 4) = (f32x4){wv[4], wv[5], wv[6], wv[7]};
          *(LAS f32x4*)(aS + o) = (f32x4){av[0], av[1], av[2], av[3]}; *(LAS f32x4*)(aS + o + 4) = (f32x4){av[4], av[5], av[6], av[7]};
          *(LAS f32x4*)(bS + o) = (f32x4){bv[0], bv[1], bv[2], bv[3]}; *(LAS f32x4*)(bS + o + 4) = (f32x4){bv[4], bv[5], bv[6], bv[7]};
          *(LAS f32x4*)(rS + o) = (f32x4){rv[0], rv[1], rv[2], rv[3]}; *(LAS f32x4*)(rS + o + 4) = (f32x4){rv[4], rv[5], rv[6], rv[7]};
          *(LAS f32x4*)(kS + o) = (f32x4){kv[0], kv[1], kv[2], kv[3]}; *(LAS f32x4*)(kS + o + 4) = (f32x4){kv[4], kv[5], kv[6], kv[7]};
#pragma unroll
          for (int q = 0; q < 8; ++q) *(LAS bf16*)(vT + (cg * 8 + q) * 144 + tok * 2) = (bf16)f2bf(vv[q]); }
        __syncthreads();
        { const int p = wave >> 2, sub = (wave >> 1) & 1, half = wave & 1, sl = lane >> 2, q = lane & 3, s = 16 * half + sl, tok = 32 * sub + s, jq = 16 * q;
          const LAS float* x0p = (p == 0 ? kS : bS) + tok * 64 + jq; LAS unsigned char* OUT = p == 0 ? AT : NT;
          float x[16];
#pragma unroll
          for (int j = 0; j < 16; j += 4) { const f32x4 t4 = *(const LAS f32x4*)(x0p + j); x[j] = t4.x; x[j + 1] = t4.y; x[j + 2] = t4.z; x[j + 3] = t4.w; }
          if (half) {
#pragma unroll
              for (int i = 0; i < 4; ++i) *(LAS bf16*)(OUT + ((sub * 32 + 4 * q + i) * 40 + s) * 2) = (bf16)0; }
#pragma unroll 2
          for (int tp = 16 * half; tp < 32; ++tp) { const LAS float* bp = wS + (32 * sub + tp) * 64 + jq; const bool run = tp > s;
              f32x4 a4[4], w4[4], b4[4], r4[4];
#pragma unroll
              for (int g = 0; g < 4; ++g) { a4[g] = *(const LAS f32x4*)(bp + 4096 + 4 * g); w4[g] = *(const LAS f32x4*)(bp + 4 * g); b4[g] = *(const LAS f32x4*)(bp + 8192 + 4 * g); r4[g] = *(const LAS f32x4*)(bp + 12288 + 4 * g); }
              float c = 0.f;
#pragma unroll
              for (int g = 0; g < 4; ++g) { c += x[4 * g] * a4[g].x; c += x[4 * g + 1] * a4[g].y; c += x[4 * g + 2] * a4[g].z; c += x[4 * g + 3] * a4[g].w; }
              c += __builtin_bit_cast(float, __builtin_amdgcn_mov_dpp(__builtin_bit_cast(int, c), 0xB1, 0xF, 0xF, true));
              c += __builtin_bit_cast(float, __builtin_amdgcn_mov_dpp(__builtin_bit_cast(int, c), 0x4E, 0xF, 0xF, true));
              float o = 0.f;
#pragma unroll
              for (int g = 0; g < 4; ++g) { const float n0 = x[4 * g] * w4[g].x + c * b4[g].x, n1 = x[4 * g + 1] * w4[g].y + c * b4[g].y, n2 = x[4 * g + 2] * w4[g].z + c * b4[g].z, n3 = x[4 * g + 3] * w4[g].w + c * b4[g].w;
                  x[4 * g] = run ? n0 : x[4 * g]; x[4 * g + 1] = run ? n1 : x[4 * g + 1]; x[4 * g + 2] = run ? n2 : x[4 * g + 2]; x[4 * g + 3] = run ? n3 : x[4 * g + 3];
                  o += x[4 * g] * r4[g].x; o += x[4 * g + 1] * r4[g].y; o += x[4 * g + 2] * r4[g].z; o += x[4 * g + 3] * r4[g].w; }
              o += __builtin_bit_cast(float, __builtin_amdgcn_mov_dpp(__builtin_bit_cast(int, o), 0xB1, 0xF, 0xF, true));
              o += __builtin_bit_cast(float, __builtin_amdgcn_mov_dpp(__builtin_bit_cast(int, o), 0x4E, 0xF, 0xF, true));
              if (q == 0) *(LAS bf16*)(OUT + ((sub * 32 + tp) * 40 + s) * 2) = (bf16)f2bf(tp >= s ? o : 0.f); }
          LAS unsigned char* XT = p == 0 ? kT : bT;
#pragma unroll
          for (int j = 0; j < 16; ++j) *(LAS bf16*)(XT + (jq + j) * 144 + tok * 2) = (bf16)f2bf(x[j]);
          const bool gwave = (p == 0 && half == 1); const int j = lane;
          if (gwave) { float g = 1.f;
#pragma unroll
              for (int tp = 0; tp < 32; ++tp) { const int tk = 32 * sub + tp; const float w_ = wS[tk * 64 + j], a_ = aS[tk * 64 + j], r_ = rS[tk * 64 + j];
                  *(LAS bf16*)(aT + j * 144 + tk * 2) = (bf16)f2bf(a_ * g);
                  g *= w_; *(LAS bf16*)(rT + j * 144 + tk * 2) = (bf16)f2bf(r_ * g); }
              gam[sub * 64 + j] = g; }
        }
        __syncthreads();
        { const int sub = wave >> 2, t1 = (wave >> 1) & 1, t0 = wave & 1; const size_t sch = (size_t)hd * RW_NSC + (2 * n + sub);
          { f32x16 acc;
#pragma unroll
            for (int r = 0; r < 16; ++r) acc[r] = 0.f;
#pragma unroll
            for (int ks = 0; ks < 2; ++ks) { const int ao = (32 * t1 + l31) * 144 + (32 * sub + 16 * ks + 8 * h) * 2, bo = (32 * t0 + l31) * 144 + (32 * sub + 16 * ks + 8 * h) * 2;
                acc = MFMA32(*(const LAS bf16x8*)(aT + ao), *(const LAS bf16x8*)(bT + bo), acc); }
            const int jp = 32 * t0 + l31;
#pragma unroll
            for (int g = 0; g < 4; ++g) *(v2u*)(RH + (sch * 64 + jp) * 64 + 32 * t1 + 8 * g + 4 * h) = (v2u){pk2(acc[4 * g], acc[4 * g + 1]), pk2(acc[4 * g + 2], acc[4 * g + 3])};
            if (t1 == 0 && t0 == 0) GAM[sch * 64 + lane] = gam[sub * 64 + lane]; }
          { f32x16 acc;
#pragma unroll
            for (int r = 0; r < 16; ++r) acc[r] = 0.f;
#pragma unroll
            for (int ks = 0; ks < 2; ++ks) acc = MFMA32(*(const LAS bf16x8*)(kT + (32 * t1 + l31) * 144 + (32 * sub + 16 * ks + 8 * h) * 2), *(const LAS bf16x8*)(vT + (32 * t0 + l31) * 144 + (32 * sub + 16 * ks + 8 * h) * 2), acc);
            bf16* dst = GT + ((sch * 4 + t1 * 2 + t0) * 64 + lane) * 16;
            *(v4u*)dst = (v4u){pk2(acc[0], acc[1]), pk2(acc[2], acc[3]), pk2(acc[4], acc[5]), pk2(acc[6], acc[7])}; *(v4u*)(dst + 8) = (v4u){pk2(acc[8], acc[9]), pk2(acc[10], acc[11]), pk2(acc[12], acc[13]), pk2(acc[14], acc[15])}; } }
        if (wave < 4) { const int sub = wave >> 1, jt = wave & 1; const size_t sch = (size_t)hd * RW_NSC + (2 * n + sub);
            f32x16 acc;
#pragma unroll
            for (int r = 0; r < 16; ++r) acc[r] = bf2f(*(const LAS bf16*)(rT + (32 * jt + crow(r, h)) * 144 + (32 * sub + l31) * 2));
#pragma unroll
            for (int ks = 0; ks < 2; ++ks) acc = MFMA32(*(const LAS bf16x8*)(aT + (32 * jt + l31) * 144 + (32 * sub + 16 * ks + 8 * h) * 2), *(const LAS bf16x8*)(NT + (sub * 32 + l31) * 80 + (16 * ks + 8 * h) * 2), acc);
#pragma unroll
            for (int g = 0; g < 4; ++g) *(v2u*)(PR + (sch * 32 + l31) * 64 + 32 * jt + 8 * g + 4 * h) = (v2u){pk2(acc[4 * g], acc[4 * g + 1]), pk2(acc[4 * g + 2], acc[4 * g + 3])};
        } else { const int t2 = tid - 256, sub = t2 >> 7, t = (t2 >> 2) & 31, s8 = (t2 & 3) * 8; const size_t sch = (size_t)hd * RW_NSC + (2 * n + sub);
            *(v4u*)(ATG + (sch * 32 + t) * 32 + s8) = *(const LAS v4u*)(AT + (sub * 32 + t) * 80 + s8 * 2); }
        { const int sub = tid >> 8, it = (tid >> 7) & 1, ks = (tid >> 6) & 1; const size_t sch = (size_t)hd * RW_NSC + (2 * n + sub);
          *(v4u*)(VTF + ((sch * 4 + it * 2 + ks) * 64 + lane) * 8) = *(const LAS v4u*)(vT + (32 * it + l31) * 144 + (32 * sub + 16 * ks + 8 * h) * 2); }
        __syncthreads();
    }
}

DI void ph_rwkv_chain(const Frame& F, const Args& a, int sc_lo, int sc_hi) {
    if (F.vcu >= 16 && F.vcu < 18) { if (sc_hi < RW_NSC) return; const int c = (F.vcu - 16) * 512 + F.tid; const float* HL = (const float*)(a.ws + LR_H); const float* AP = (const float*)(a.ws + LR_A); float* CR = (float*)(a.ws + LR_C);
        float carry = 0.f;
#pragma unroll 8
        for (int sc = 0; sc < RW_NSC; ++sc) { const float hl = HL[sc * 1024 + c], ap = AP[sc * 1024 + c]; CR[sc * 1024 + c] = carry; carry = ap * carry + hl; }
        return; }
    if (F.vcu >= 16) return;
    const int hd = F.vcu; const bf16* RH = (const bf16*)(a.ws + RW_RH); const bf16* RL = (const bf16*)(a.ws + RW_RL); const bf16* GT = (const bf16*)(a.ws + RW_GT); const float* GAM = (const float*)(a.ws + RW_GAM); bf16* SALL = (bf16*)(a.ws + RW_SALL);
    constexpr int RW_NS = 7, SLOT = 8192 + 8192 + 1024;
    LAS unsigned char* XS = F.lds + RING_OFF; LAS unsigned char* RG = XS + 2 * 9216;
    const int lane = F.lane, wave = F.wave, l31 = lane & 31, h = lane >> 5, jt = (wave >> 1) & 1, it = wave & 1, lw = wave & 3;
    for (int i = F.tid; i < 2 * 9216 / 4; i += NWAVES * 64) ((LAS unsigned*)XS)[i] = 0u;
    __syncthreads();
#define RW_BAR() do { asm volatile("s_waitcnt lgkmcnt(0)" ::: "memory"); __builtin_amdgcn_s_barrier(); asm volatile("" ::: "memory"); } while (0)
    const unsigned rg0 = (unsigned)(uintptr_t)RG;
    int offR[2], offG[2];
#pragma unroll
    for (int i = 0; i < 2; ++i) { const int b = 2 * lw + i, row = 8 * b + (lane >> 3), pc = lane & 7; offR[i] = row * 64 + ((pc ^ (row & 7)) * 8); offG[i] = (b * 64 + lane) * 8; }
    const int offM = (lane & 15) * 4;
#define RW_DMA(src, dst) do { unsigned keep_; asm volatile("s_mov_b32 %0, m0\n\ts_mov_b32 m0, %2\n\ts_nop 0\n\tglobal_load_lds_dwordx4 %1, off\n\ts_mov_b32 m0, %0" : "=&s"(keep_) : "v"(src), "s"(dst) : "memory"); } while (0)
#define RW_ISSUE(scn) do { const int s_ = (scn) < RW_NSC ? (scn) : RW_NSC - 1; const size_t sch_ = (size_t)hd * RW_NSC + s_; \
        const unsigned sb_ = (unsigned)__builtin_amdgcn_readfirstlane((int)(rg0 + (unsigned)((scn) % RW_NS) * SLOT)); \
        _Pragma("unroll") for (int i_ = 0; i_ < 2; ++i_) { const unsigned bo_ = (unsigned)__builtin_amdgcn_readfirstlane((2 * lw + i_) * 1024); \
            RW_DMA(RH + sch_ * 4096 + offR[i_], sb_ + bo_); RW_DMA(GT + sch_ * 4096 + offG[i_], sb_ + 8192 + bo_); } \
        RW_DMA(GAM + sch_ * 64 + offM, sb_ + 16384); } while (0)
#define RW_WAITV(n) asm volatile("s_waitcnt vmcnt(" #n ")" ::: "memory")
    f32x16 X;
#pragma unroll
    for (int r = 0; r < 16; ++r) X[r] = 0.f;
    float* XSV = (float*)(a.ws + RW_XSAVE) + ((size_t)(hd * 4 + (wave & 3)) * 64 + lane) * 16;
    if (wave < 4 && sc_lo > 0) {
#pragma unroll
        for (int g = 0; g < 4; ++g) { const f32x4 v = *(const f32x4*)(XSV + 4 * g); X[4 * g] = v.x; X[4 * g + 1] = v.y; X[4 * g + 2] = v.z; X[4 * g + 3] = v.w;
            *(LAS v2u*)(XS + (32 * it + l31) * 144 + (32 * jt + 8 * g + 4 * h) * 2) = (v2u){pk2(v.x, v.y), pk2(v.z, v.w)}; } }
    if (wave >= 4) { RW_ISSUE(sc_lo); RW_ISSUE(sc_lo + 1); RW_ISSUE(sc_lo + 2); RW_ISSUE(sc_lo + 3); RW_ISSUE(sc_lo + 4); RW_ISSUE(sc_lo + 5); RW_WAITV(25); }
    RW_BAR();
    for (int sc = sc_lo; sc < sc_hi; ++sc) {
        if (wave < 4) {
            const LAS unsigned char* sb = RG + (sc % RW_NS) * SLOT;
            f32x16 acc; const size_t sch = (size_t)hd * RW_NSC + sc;
            { const v4u g0 = *(const LAS v4u*)(sb + 8192 + ((jt * 2 + it) * 64 + lane) * 32), g1 = *(const LAS v4u*)(sb + 8192 + ((jt * 2 + it) * 64 + lane) * 32 + 16);
              const unsigned gw_[8] = {g0.x, g0.y, g0.z, g0.w, g1.x, g1.y, g1.z, g1.w};
#pragma unroll
              for (int g = 0; g < 4; ++g) { const f32x4 m = *(const LAS f32x4*)(sb + 16384 + (32 * jt + 8 * g + 4 * h) * 4);
                  acc[4 * g] = bflo(gw_[2 * g]) + m.x * X[4 * g]; acc[4 * g + 1] = bfhi(gw_[2 * g]) + m.y * X[4 * g + 1]; acc[4 * g + 2] = bflo(gw_[2 * g + 1]) + m.z * X[4 * g + 2]; acc[4 * g + 3] = bfhi(gw_[2 * g + 1]) + m.w * X[4 * g + 3]; } }
#pragma unroll
            for (int g = 0; g < 4; ++g) *(v2u*)(SALL + (sch * 64 + 32 * it + l31) * 64 + 32 * jt + 8 * g + 4 * h) = (v2u){pk2(X[4 * g], X[4 * g + 1]), pk2(X[4 * g + 2], X[4 * g + 3])};
            const LAS unsigned char* xb = XS + (sc & 1) * 9216 + (32 * it + l31) * 144 + 16 * h; const int ar = 32 * jt + l31; const LAS unsigned char* ab = sb + ar * 128;
#pragma unroll
            for (int ks = 0; ks < 4; ++ks) { const bf16x8 xf = *(const LAS bf16x8*)(xb + 32 * ks); const int po = (((2 * ks + h) ^ (ar & 7)) * 16);
                acc = MFMA32(*(const LAS bf16x8*)(ab + po), xf, acc); }
            X = acc;
            LAS unsigned char* xn = XS + ((sc + 1) & 1) * 9216 + (32 * it + l31) * 144;
#pragma unroll
            for (int g = 0; g < 4; ++g) *(LAS v2u*)(xn + (32 * jt + 8 * g + 4 * h) * 2) = (v2u){pk2(X[4 * g], X[4 * g + 1]), pk2(X[4 * g + 2], X[4 * g + 3])};
        } else {
            RW_ISSUE(sc + RW_NS - 1);
            RW_WAITV(25);
        }
        RW_BAR();
    }
    if (wave >= 4) RW_WAITV(0);
    else if (sc_hi < RW_NSC) {
#pragma unroll
        for (int g = 0; g < 4; ++g) *(f32x4*)(XSV + 4 * g) = (f32x4){X[4 * g], X[4 * g + 1], X[4 * g + 2], X[4 * g + 3]}; }
#undef RW_ISSUE
#undef RW_DMA
#undef RW_WAITV
#undef RW_BAR
}

DI f32x4 ld_bf4(const bf16* p) { const v2u w = *(const v2u*)p; return (f32x4){bflo(w.x), bfhi(w.x), bflo(w.y), bfhi(w.y)}; }
DI void ph_rwkv_out(const Frame& F, const Args& a, int sc_lo, int sc_hi, int gw, int ngw) {
    const bf16* SALL = (const bf16*)(a.ws + RW_SALL); const bf16* PR = (const bf16*)(a.ws + RW_PR); const bf16* ATG = (const bf16*)(a.ws + RW_AT); const bf16* VTF = (const bf16*)(a.ws + RW_VTF);
    const bf16* VV = (const bf16*)(a.ws + RW_VV); const float* BON = (const float*)(a.ws + RW_BON); const bf16* GATE = (const bf16*)(a.ws + WS_SCR + SC_GATE); bf16* Y = (bf16*)(a.ws + WS_YMIX);
    const int lane = F.lane, l31 = lane & 31, h = lane >> 5;
    for (int item = sc_lo * 16 + gw; item < sc_hi * 16; item += ngw) { const int sc = item >> 4, hd = item & 15; if (sc == 1) continue;
        const size_t sch = (size_t)hd * RW_NSC + sc; f32x16 acc[2];
#pragma unroll
        for (int it = 0; it < 2; ++it) {
#pragma unroll
            for (int r = 0; r < 16; ++r) acc[it][r] = 0.f;
#pragma unroll
            for (int ks = 0; ks < 4; ++ks) acc[it] = MFMA32(*(const bf16x8*)(SALL + (sch * 64 + 32 * it + l31) * 64 + 16 * ks + 8 * h), *(const bf16x8*)(PR + (sch * 32 + l31) * 64 + 16 * ks + 8 * h), acc[it]);
#pragma unroll
            for (int ks = 0; ks < 2; ++ks) acc[it] = MFMA32(*(const bf16x8*)(VTF + ((sch * 4 + it * 2 + ks) * 64 + lane) * 8), *(const bf16x8*)(ATG + (sch * 32 + l31) * 32 + 16 * ks + 8 * h), acc[it]); }
        float s1 = 0.f;
#pragma unroll
        for (int it = 0; it < 2; ++it)
#pragma unroll
            for (int r = 0; r < 16; ++r) s1 += acc[it][r];
        s1 += __shfl_xor(s1, 32); const float mean = s1 * (1.0f / 64.0f); float s2 = 0.f;
#pragma unroll
        for (int it = 0; it < 2; ++it)
#pragma unroll
            for (int r = 0; r < 16; ++r) { const float d = acc[it][r] - mean; s2 += d * d; }
        s2 += __shfl_xor(s2, 32); const float rstd = 1.0f / sqrtf(s2 * (1.0f / 64.0f) + 64e-5f);
        const int rr = sub_row(sc, l31);
        if (rr >= 0) { const float bon = BON[(size_t)rr * 16 + hd];
#pragma unroll
            for (int it = 0; it < 2; ++it)
#pragma unroll
                for (int g = 0; g < 4; ++g) { const int c = hd * 64 + 32 * it + 8 * g + 4 * h;
                    const f32x4 lw = *(const f32x4*)(a.in[15] + c), lb = *(const f32x4*)(a.in[16] + c), gt = ld_bf4(GATE + (size_t)rr * 1024 + c); const v2u vw = *(const v2u*)(VV + (size_t)rr * 1024 + c);
                    const float o0 = ((acc[it][4 * g] - mean) * rstd * lw.x + lb.x + bon * bflo(vw.x)) * gt.x, o1 = ((acc[it][4 * g + 1] - mean) * rstd * lw.y + lb.y + bon * bfhi(vw.x)) * gt.y;
                    const float o2 = ((acc[it][4 * g + 2] - mean) * rstd * lw.z + lb.z + bon * bflo(vw.y)) * gt.z, o3 = ((acc[it][4 * g + 3] - mean) * rstd * lw.w + lb.w + bon * bfhi(vw.y)) * gt.w;
                    *(v2u*)(Y + (size_t)rr * DM + c) = (v2u){pk2(o0, o1), pk2(o2, o3)}; } }
    }
}

constexpr int N_PHASES = 33;
template <class Epi, class Sched> DI void run_gemm(const Frame& F, const pg8::Gemm& g, const Sched& S, const Epi& E) {
    pg8::gemm_phase<Epi, Sched, true, true>(F.lds + RING_OFF, g, S, E);
}
DI void moe_up_units(const Frame& F, const Args& a, int t0, int ntl, int G, int c) {
    pg8::Gemm g{(const bf16*)(a.ws + WS_SCR + SC_XG), (const bf16*)(a.ws + WS_MOEW), DM, DM, DM};
    pg8::MoeOrder S{(const int*)(a.ws + WS_TILES), t0, ntl, 4, G, c, (long)MOE_E_BYTES};
    pg8::EpiSwiglu E{(bf16*)(a.ws + WS_SCR + SC_ACT), FF};
    run_gemm(F, g, S, E);
}
DI void moe_down_units(const Frame& F, const Args& a, int t0, int ntl, int G, int c) {
    pg8::Gemm g{(const bf16*)(a.ws + WS_SCR + SC_ACT), (const bf16*)(a.ws + WS_MOEW + MOE_W2_OFF), FF, FF, FF};
    pg8::MoeOrder S{(const int*)(a.ws + WS_TILES), t0, ntl, 8, G, c, (long)MOE_E_BYTES};
    pg8::EpiBf16 E{(bf16*)(a.ws + WS_SCR + SC_YB), DM};
    run_gemm(F, g, S, E);
}
DI void ph_moe_a(const Frame& F, const Args& a) {
    const int nt = (int)__hip_atomic_load((gu32*)(a.ws + WS_TILES) + 127, RLX_AGENT), n1 = nt < 64 ? nt : 64;
    moe_up_units(F, a, 0, n1, F.G, (int)blockIdx.x);
}
DI void ph_moe_b(const Frame& F, const Args& a) {
    const int nt = (int)__hip_atomic_load((gu32*)(a.ws + WS_TILES) + 127, RLX_AGENT), n1 = nt < 64 ? nt : 64; const int c = (int)blockIdx.x;
    int nu = 4 * (nt - n1); if (nu > F.G / 2) nu = F.G / 2;
    if (c < nu) moe_up_units(F, a, n1, nt - n1, nu, c); else moe_down_units(F, a, 0, n1, F.G - nu, c - nu);
}
DI void ph_moe_c(const Frame& F, const Args& a) {
    const int nt = (int)__hip_atomic_load((gu32*)(a.ws + WS_TILES) + 127, RLX_AGENT), n1 = nt < 64 ? nt : 64;
    moe_down_units(F, a, n1, nt - n1, F.G, (int)blockIdx.x);
}

DI void gemm_tail16(const Frame& F, const Args& a, const bf16* A, int lda, const bf16* Wt, int K, int mode) {
    if (F.vcu >= 128) return;
    const int lane = F.lane, lc = lane & 15, quad = lane >> 4, w = F.vcu; LAS float* red = (LAS float*)(F.lds + RING_OFF);
    f32x4 acc = (f32x4){0.f, 0.f, 0.f, 0.f}; const int kw = K / NWAVES, kb = F.wave * kw;
    const bf16* ap = A + (size_t)(TX + lc) * lda + kb + 8 * quad; const bf16* bp = Wt + (size_t)(16 * w + lc) * K + kb + 8 * quad;
#pragma unroll 4
    for (int ks = 0; ks < kw / 32; ++ks) acc = __builtin_amdgcn_mfma_f32_16x16x32_bf16(*(const bf16x8*)(ap + 32 * ks), *(const bf16x8*)(bp + 32 * ks), acc, 0, 0, 0);
    *(LAS f32x4*)(red + (F.wave * 64 + lane) * 4) = acc;
    __syncthreads();
    if (F.wave == 0) { f32x4 s = *(const LAS f32x4*)(red + lane * 4);
#pragma unroll
        for (int v = 1; v < NWAVES; ++v) s = s + *(const LAS f32x4*)(red + (v * 64 + lane) * 4);
        float* H = (float*)(a.ws + WS_H);
#pragma unroll
        for (int r = 0; r < 4; ++r) { const int row = 4 * quad + r, col = 16 * w + lc; const float base = mode ? H[(size_t)(TX + row) * DM + col] : a.in[1][(size_t)row * DM + col];
            H[(size_t)(TX + row) * DM + col] = base + s[r]; } }
    __syncthreads();
}

__global__ void __launch_bounds__(NWAVES * 64, 2) hyb_fwd(Args a) {
    extern __shared__ __attribute__((aligned(16))) unsigned char lds[];
    Frame F;
    F.lds = (LAS unsigned char*)lds;
    F.MISC = (volatile LAS unsigned*)(F.lds + MISC_OFF);
    F.tid = threadIdx.x; F.lane = F.tid & 63; F.wave = __builtin_amdgcn_readfirstlane(F.tid >> 6);
    F.G = gridDim.x; { const int bx = blockIdx.x; F.vcu = (F.G % 8 == 0) ? (bx % 8) * (F.G / 8) + bx / 8 : bx; }
    F.gw = F.vcu * NWAVES + F.wave; F.NGW = F.G * NWAVES;
    F.ctl = (gu32*)(a.ws + WS_CTL);
    for (int u = F.tid; u < (LDS_BYTES - LDSCTL_OFF) / 4; u += NWAVES * 64) ((LAS unsigned*)(F.lds + LDSCTL_OFF))[u] = 0u;
    __syncthreads();
    XcdBarrier bar; bar.bar = (unsigned*)(F.ctl + CW_BAR); bar.x = 0; bar.st = nullptr;
    if (MK_ONE_LAUNCH) bar = xcd_barrier_post((unsigned*)(F.ctl + CW_BAR), F.MISC + 8);
    const int lo = a.ph_lo, hi = a.ph_hi;
#ifndef PH_MASK
#define PH_MASK 0xFFFFFFFFFFFFFFFFull
#endif
#define IN(k) ((((unsigned long long)(PH_MASK) >> (k)) & 1ull) && lo <= (k) && (k) < hi)
#ifndef PROBE_REP
#define PROBE_REP 0u
#endif
#define REP(k) ((((unsigned long long)(PROBE_REP) >> (k)) & 1ull) ? 2 : 1)
#ifdef PROBE_TS
#define STAMP(k) do { if (blockIdx.x == 0 && F.tid == 0) ((unsigned long long*)(F.ctl + CW_TS))[(k)] = __builtin_amdgcn_s_memrealtime(); } while (0)
#else
#define STAMP(k) do { } while (0)
#endif
#define PHASE(k, ...) do { if (IN(k)) { { const int PH_REP_ = 0; (void)PH_REP_; __VA_ARGS__; } if (REP(k) == 2) { __syncthreads(); { const int PH_REP_ = 1; (void)PH_REP_; __VA_ARGS__; } } } } while (0)
#define SEAM(k) do { if (IN(k) && IN((k) + 1)) xcd_barrier(bar); STAMP((k) + 1); } while (0)
    const bf16* HN = (const bf16*)(a.ws + WS_HN); bf16* PROJ = (bf16*)(a.ws + WS_PROJ); const bf16* YMIX = (const bf16*)(a.ws + WS_YMIX); float* H = (float*)(a.ws + WS_H);

    STAMP(0);
    PHASE(0, { ph_prologue(F, a); ph_aux_convert(F, a, F.gw, F.NGW); });
    SEAM(0);
    PHASE(1, { pg8::Gemm g{HN, (const bf16*)(a.ws + WS_WEVIN), DM, DM, DM}; pg8::StaticOrder S; S.init(MP, EV_NP, F.G, (int)blockIdx.x); pg8::EpiBf16 E{PROJ, EV_NP}; run_gemm(F, g, S, E); });
    SEAM(1);
    PHASE(2, ph_even_prep(F, a););
    SEAM(2);
    PHASE(3, {
        { pg8::Gemm g{(const bf16*)(a.ws + WS_SCR + SC_ALORA), (const bf16*)(a.ws + WS_WLORA), 384, 384, 384}; pg8::StaticOrder S; S.init(MP, 3072, F.G, (int)blockIdx.x);
          static_assert(SC_ICL - SC_DEC == SC_GATE - SC_ICL, "lora outputs equally spaced");
          pg8::EpiLora E{(bf16*)(a.ws + WS_SCR + SC_DEC), (long)((SC_ICL - SC_DEC) / 2), a.in[7], a.in[9]}; run_gemm(F, g, S, E); }
        { pg8::Gemm g{(const bf16*)(a.ws + WS_SCR + SC_XR), (const bf16*)(a.ws + WS_WGATE), 256, 1024, 256}; pg8::StaticOrder S; S.init(MP, 2048, F.G, (int)blockIdx.x); S.amod = 4; S.astep = 512;
          pg8::EpiGates E{(bf16*)(a.ws + WS_SCR + SC_LA), (bf16*)(a.ws + WS_SCR + SC_LIX), a.in[20], a.in[22], a.in[23], (const bf16*)(a.ws + WS_SCR + SC_XR)}; run_gemm(F, g, S, E); }
    });
    SEAM(3);
    PHASE(4, ph_rwkv_chunk(F, a, 0, 32, 0););
    SEAM(4);
    PHASE(5, { if (F.vcu < 16) ph_rwkv_chain(F, a, 0, 64); else ph_rwkv_chunk(F, a, 32, 62, 16); });
    SEAM(5);
#if defined(PROBE_X) && PROBE_X == 1
    PHASE(6, { if (F.vcu < 16) { ph_rwkv_chain(F, a, 64, 124); __syncthreads(); ph_rwkv_chain(F, a, 64, 124); } else ph_rwkv_chunk(F, a, 62, 92, 16); });
#elif defined(PROBE_X) && PROBE_X == 2
    PHASE(6, { if (F.vcu < 16) ph_rwkv_chain(F, a, 64, 124); else { ph_rwkv_chunk(F, a, 62, 92, 16); __syncthreads(); ph_rwkv_chunk(F, a, 62, 92, 16); } });
#else
    PHASE(6, { if (F.vcu < 16) ph_rwkv_chain(F, a, 64, 124); else ph_rwkv_chunk(F, a, 62, 92, 16); });
#endif
    SEAM(6);
    PHASE(7, { if (F.vcu < 16) ph_rwkv_chain(F, a, 124, 184); else ph_rwkv_chunk(F, a, 92, 122, 16); });
    SEAM(7);
    PHASE(8, { if (F.vcu < 16) ph_rwkv_chain(F, a, 184, 244); else { ph_rwkv_chunk(F, a, 122, 129, 16); lru_local(F, a, (F.vcu - 16) * NWAVES + F.wave, (F.G - 16) * NWAVES); } });
    SEAM(8);
    PHASE(9, { if (F.vcu < 18) ph_rwkv_chain(F, a, 244, RW_NSC); else ph_rwkv_out(F, a, 0, 244, (F.vcu - 18) * NWAVES + F.wave, (F.G - 18) * NWAVES); });
    SEAM(9);
    PHASE(10, { ph_rwkv_out(F, a, 244, RW_NSC, F.gw, F.NGW); lru_apply(F, a); });
    SEAM(10);
    PHASE(11, { pg8::Gemm g{YMIX, (const bf16*)(a.ws + WS_WEVOUT), DM, DM, DM}; pg8::StaticOrder S; S.init(TX, DM, F.G, (int)blockIdx.x); pg8::EpiResid E{H, a.in[0], a.in[1], 0}; run_gemm(F, g, S, E); gemm_tail16(F, a, YMIX, DM, (const bf16*)(a.ws + WS_WEVOUT), DM, 0); });
    SEAM(11);
    PHASE(12, ph_route(F, a, 0, PH_REP_););
    SEAM(12);
    PHASE(13, ph_gather(F, a, 0););
    SEAM(13);
    PHASE(14, ph_moe_a(F, a););
    SEAM(14);
    PHASE(15, ph_moe_b(F, a););
    SEAM(15);
    PHASE(16, ph_moe_c(F, a););
    SEAM(16);
    PHASE(17, ph_combine(F, a, 0););
    SEAM(17);
    PHASE(18, { pg8::Gemm g{HN, (const bf16*)(a.ws + WS_WODIN), DM, DM, DM}; pg8::StaticOrder S; S.init(MP, OD_NP, F.G, (int)blockIdx.x); pg8::EpiBf16 E{PROJ, OD_NP}; run_gemm(F, g, S, E); });
    SEAM(18);
    PHASE(19, ph_odd_prep(F, a););
    SEAM(19);
    PHASE(20, ph_gdn_chunk(F, a, 0, 54, 0););
    SEAM(20);
    PHASE(21, { ph_gdn_chain(F, a, 0, 54); ph_gdn_chunk(F, a, 54, 90, 1); });
    SEAM(21);
#if defined(PROBE_X) && PROBE_X == 3
    PHASE(22, { ph_gdn_chain(F, a, 54, 90); __syncthreads(); ph_gdn_chain(F, a, 54, 90); ph_gdn_chunk(F, a, 90, 114, 1); });
#elif defined(PROBE_X) && PROBE_X == 4
    PHASE(22, { ph_gdn_chain(F, a, 54, 90); ph_gdn_chunk(F, a, 90, 114, 1); __syncthreads(); ph_gdn_chunk(F, a, 90, 114, 1); });
#else
    PHASE(22, { ph_gdn_chain(F, a, 54, 90); ph_gdn_chunk(F, a, 90, 114, 1); });
#endif
    SEAM(22);
    PHASE(23, { ph_gdn_chain(F, a, 90, 114); ph_gdn_chunk(F, a, 114, 129, 1); });
    SEAM(23);
    PHASE(24, { ph_gdn_chain(F, a, 114, 129); ph_odd_post(F, a, 0); });
    SEAM(24);
    PHASE(25, { ph_odd_post(F, a, F.G == 256 ? 1 : 2); moe_convert(F, a, 1, F.gw, F.NGW); });
    SEAM(25);
    PHASE(26, { pg8::Gemm g{YMIX, (const bf16*)(a.ws + WS_WODOUT), 4096, 4096, 4096}; pg8::StaticOrder S; S.init(TX, DM, F.G, (int)blockIdx.x); pg8::EpiResid E{H, a.in[0], a.in[1], 1}; run_gemm(F, g, S, E); gemm_tail16(F, a, YMIX, 4096, (const bf16*)(a.ws + WS_WODOUT), 4096, 1); });
    SEAM(26);
    PHASE(27, ph_route(F, a, 1, PH_REP_););
    SEAM(27);
    PHASE(28, ph_gather(F, a, 1););
    SEAM(28);
    PHASE(29, ph_moe_a(F, a););
    SEAM(29);
    PHASE(30, ph_moe_b(F, a););
    SEAM(30);
    PHASE(31, ph_moe_c(F, a););
    SEAM(31);
    PHASE(32, ph_combine(F, a, 1););
#ifdef PROBE_BARS
    for (int i_ = 0; i_ < PROBE_BARS; ++i_) xcd_barrier(bar);
#endif
#undef IN
#undef SEAM
}

extern "C" void kernel_launch(void* const* d_in, const int* in_sizes, int n_in, void* d_out, int out_size, void* d_ws, size_t ws_size, hipStream_t stream) {
    static int grid = 0;
    if (grid == 0) {
        if (n_in != 36 || out_size != TX * DM || ws_size < WS_END) { fprintf(stderr, "kernel_launch: unexpected shapes (n_in %d, out %d, ws %zu)\n", n_in, out_size, ws_size); grid = -1; return; }
        int dev = 0, cus = 0, per_cu = 0;
        if (hipGetDevice(&dev) != hipSuccess || hipDeviceGetAttribute(&cus, hipDeviceAttributeMultiprocessorCount, dev) != hipSuccess) { grid = -1; return; }
        if (hipFuncSetAttribute((const void*)hyb_fwd, hipFuncAttributeMaxDynamicSharedMemorySize, LDS_BYTES) != hipSuccess) { fprintf(stderr, "kernel_launch: hipFuncSetAttribute failed\n"); grid = -1; return; }
        if (hipOccupancyMaxActiveBlocksPerMultiprocessor(&per_cu, (const void*)hyb_fwd, NWAVES * 64, LDS_BYTES) != hipSuccess || per_cu < 1) { fprintf(stderr, "kernel_launch: occupancy query says %d\n", per_cu); per_cu = 1; }
        (void)hipGetLastError();
        grid = cus;
    }
    if (grid < 0) return;
    if (hipMemsetAsync((char*)d_ws + WS_CTL, 0, CTL_ZERO_BYTES, stream) != hipSuccess) return;
    Args a{};
    for (int i = 0; i < 36; ++i) a.in[i] = (const float*)d_in[i];
    a.out = (float*)d_out; a.ws = (unsigned char*)d_ws;
#if MK_ONE_LAUNCH
    a.ph_lo = 0; a.ph_hi = N_PHASES;
    hipLaunchKernelGGL(hyb_fwd, dim3(grid), dim3(NWAVES * 64), LDS_BYTES, stream, a);
#else
    for (int p = 0; p < N_PHASES; ++p) { a.ph_lo = p; a.ph_hi = p + 1; hipLaunchKernelGGL(hyb_fwd, dim3(grid), dim3(NWAVES * 64), LDS_BYTES, stream, a); }
#endif
}
```

```cpp
#include <hip/hip_runtime.h>
#include <cstdio>
#include <cstdint>
#include <cmath>

#ifndef MK_ONE_LAUNCH
#define MK_ONE_LAUNCH 1
#endif

namespace pg8 {
#define PG8_LAS __attribute__((address_space(3)))
typedef unsigned short bf16_t;
typedef short bf16x8 __attribute__((ext_vector_type(8)));
typedef float f32x4 __attribute__((ext_vector_type(4)));
typedef unsigned u32x4 __attribute__((ext_vector_type(4)));
typedef unsigned u32x2 __attribute__((ext_vector_type(2)));
constexpr int BM = 256, BK = 64, HALF = 128, HTB = HALF * BK * 2  , STAGE_BYTES = 8 * HTB, NXCD = 8, WGM = 8;

__host__ __device__ __forceinline__ int lds_byte(int r, int c) { const int st = (r >> 4) * 2 + (c >> 5), rr = r & 15, cc = c & 31, ob = rr * 64 + cc * 2; return st * 1024 + (ob ^ (((ob >> 9) & 1) << 5)); }
__host__ __device__ __forceinline__ void stage_rc(int b, int& R, int& C) { const int st = b / 1024, sb = b % 1024, swz = sb ^ (((sb >> 9) & 1) << 5); R = (st >> 1) * 16 + swz / 64; C = (st & 1) * 32 + (swz % 64) / 2; }
__host__ __device__ __forceinline__ int perm32(int rho) { const int n = rho >> 4, i = rho & 15; return 8 * (i >> 2) + 4 * n + (i & 3); }

struct Unit { int pm, pn; long aoff, boff; };
struct Gemm { const bf16_t* A; const bf16_t* Bt; int K, lda, ldb; };

struct StaticOrder {
    int nM, nN, nwg, G, c, amod; long astep;
    __host__ __device__ void init(int M, int N, int G_, int c_) { nM = M / BM; nN = N / BM; nwg = nM * nN; G = G_; c = c_; amod = 0; astep = 0; }
    __host__ __device__ bool next(int i, Unit& u) const {
        const long L = (long)i * G + c; if (L >= nwg) return false;
        int wgid = (int)L; { const int q = nwg / NXCD, r = nwg % NXCD, xcd = wgid % NXCD, off = wgid / NXCD; wgid = (xcd < r ? xcd * (q + 1) : r * (q + 1) + (xcd - r) * q) + off; }
        const int nig = WGM * nN, gid = wgid / nig, fm = gid * WGM, gsz = (nM - fm) < WGM ? (nM - fm) : WGM;
        u.pm = fm + ((wgid % nig) % gsz); u.pn = (wgid % nig) / gsz; u.boff = 0; u.aoff = amod ? (long)(u.pn % amod) * astep : 0; return true;
    }
    __device__ __forceinline__ void a_ready(const Unit&) const {}
    __device__ __forceinline__ void done(const Unit&) const {}
};
struct MoeOrder {
    const int* tile_e; int t0, ntiles, npn, G, c; long bstride;
    __device__ __forceinline__ bool next(int i, Unit& u) const {
        const long L = (long)i * G + c; if (c < 0 || L >= (long)ntiles * npn) return false;
        const int t = t0 + (int)(L / npn); u.pm = t; u.pn = (int)(L % npn); u.aoff = 0; u.boff = (long)tile_e[t] * bstride; return true;
    }
    __device__ __forceinline__ void a_ready(const Unit&) const {}
    __device__ __forceinline__ void done(const Unit&) const {}
};

__device__ __forceinline__ unsigned cvt_pk_bf16(float lo, float hi) { unsigned r; asm volatile("v_cvt_pk_bf16_f32 %0, %1, %2" : "=v"(r) : "v"(lo), "v"(hi)); return r; }
__device__ __forceinline__ float bf_lo(unsigned w) { return __uint_as_float(w << 16); }
__device__ __forceinline__ float bf_hi(unsigned w) { return __uint_as_float(w & 0xffff0000u); }
__device__ __forceinline__ float sigmoidf_(float x) { return __builtin_amdgcn_rcpf(1.0f + __expf(-x)); }
__device__ __forceinline__ float softplusf_(float x) { return fmaxf(x, 0.f) + __logf(1.0f + __expf(-fabsf(x))); }

struct EpiBf16 {
    static constexpr bool PERM = true, AFTER_DRAIN = false;
    bf16_t* O; int ldc;
    __device__ __forceinline__ void operator()(const f32x4 (&acc)[2][2][4][2], const Unit& u, int wr, int wc, int fr, int fq) const {
        const int row0 = u.pm * BM + wr * 64 + fr; const int col0 = u.pn * BM + wc * 32 + 8 * fq;
#pragma unroll
        for (int ai = 0; ai < 2; ++ai)
#pragma unroll
            for (int m = 0; m < 4; ++m) { bf16_t* rowp = O + (size_t)(row0 + ai * HALF + m * 16) * ldc + col0;
#pragma unroll
                for (int bj = 0; bj < 2; ++bj) { const f32x4 v0 = acc[ai][bj][m][0], v1 = acc[ai][bj][m][1];
                    u32x4 w; w.x = cvt_pk_bf16(v0[0], v0[1]); w.y = cvt_pk_bf16(v0[2], v0[3]); w.z = cvt_pk_bf16(v1[0], v1[1]); w.w = cvt_pk_bf16(v1[2], v1[3]);
                    *(u32x4*)(rowp + bj * HALF) = w; } }
    }
};
struct EpiSwiglu {
    static constexpr bool PERM = true, AFTER_DRAIN = false;
    bf16_t* O; int ldc;
    __device__ __forceinline__ void operator()(const f32x4 (&acc)[2][2][4][2], const Unit& u, int wr, int wc, int fr, int fq) const {
        const int row0 = u.pm * BM + wr * 64 + fr; const int col0 = u.pn * HALF + wc * 32 + 8 * fq;
#pragma unroll
        for (int ai = 0; ai < 2; ++ai)
#pragma unroll
            for (int m = 0; m < 4; ++m) { bf16_t* rowp = O + (size_t)(row0 + ai * HALF + m * 16) * ldc + col0;
                float o[8];
#pragma unroll
                for (int n = 0; n < 2; ++n)
#pragma unroll
                    for (int j = 0; j < 4; ++j) { const float gq = acc[ai][0][m][n][j], uq = acc[ai][1][m][n][j]; o[4 * n + j] = gq * sigmoidf_(gq) * uq; }
                u32x4 w; w.x = cvt_pk_bf16(o[0], o[1]); w.y = cvt_pk_bf16(o[2], o[3]); w.z = cvt_pk_bf16(o[4], o[5]); w.w = cvt_pk_bf16(o[6], o[7]);
                *(u32x4*)rowp = w; }
    }
};
struct EpiResid {
    static constexpr bool PERM = false, AFTER_DRAIN = false;
    float* out; const float* x; const float* meta; int mode;
    __device__ __forceinline__ void operator()(const f32x4 (&acc)[2][2][4][2], const Unit& u, int wr, int wc, int fr, int fq) const {
        const int row0 = u.pm * BM + wr * 64 + fr, col0 = u.pn * BM + wc * 32 + 4 * fq;
#pragma unroll
        for (int ai = 0; ai < 2; ++ai)
#pragma unroll
            for (int m = 0; m < 4; ++m) { const int row = row0 + ai * HALF + m * 16; float* rowp = out + (size_t)row * 2048 + col0;
                const float* bp = mode ? rowp : (row < 8192 ? x + (size_t)row * 2048 + col0 : (row < 8208 ? meta + (size_t)(row - 8192) * 2048 + col0 : nullptr));
#pragma unroll
                for (int bj = 0; bj < 2; ++bj)
#pragma unroll
                    for (int n = 0; n < 2; ++n) { f32x4 b = (f32x4){0.f, 0.f, 0.f, 0.f}; if (bp) b = *(const f32x4*)(bp + bj * HALF + n * 16);
                        *(f32x4*)(rowp + bj * HALF + n * 16) = acc[ai][bj][m][n] + b; } }
    }
};
__device__ __forceinline__ float one_minus_exp_neg(float e) { return e < 0.05f ? e * (1.0f - e * (0.5f - e * (1.0f / 6.0f))) : 1.0f - __expf(-e); }
struct EpiLora {
    static constexpr bool PERM = false, AFTER_DRAIN = false;
    bf16_t* base; long gstride; const float* w0; const float* a0;
    __device__ __forceinline__ void operator()(const f32x4 (&acc)[2][2][4][2], const Unit& u, int wr, int wc, int fr, int fq) const {
        const int grp = u.pn >> 2; const int row0 = u.pm * BM + wr * 64 + fr, col0 = (u.pn & 3) * BM + wc * 32 + 4 * fq;
        bf16_t* O = base + (size_t)grp * gstride;
#pragma unroll
        for (int bj = 0; bj < 2; ++bj)
#pragma unroll
            for (int n = 0; n < 2; ++n) { const int c = col0 + bj * HALF + n * 16;
                f32x4 bv = (f32x4){0.f, 0.f, 0.f, 0.f}; if (grp == 0) bv = *(const f32x4*)(w0 + c); else if (grp == 1) bv = *(const f32x4*)(a0 + c);
#pragma unroll
                for (int ai = 0; ai < 2; ++ai)
#pragma unroll
                    for (int m = 0; m < 4; ++m) { f32x4 v = acc[ai][bj][m][n] + bv;
                        if (grp == 0) {
#pragma unroll
                            for (int j = 0; j < 4; ++j) { const float wl = -softplusf_(-v[j]) - 0.5f; v[j] = one_minus_exp_neg(__expf(wl)); }
                        } else if (grp == 1) {
#pragma unroll
                            for (int j = 0; j < 4; ++j) v[j] = sigmoidf_(v[j]);
                        }
                        u32x2 w; w.x = cvt_pk_bf16(v[0], v[1]); w.y = cvt_pk_bf16(v[2], v[3]);
                        *(u32x2*)(O + (size_t)(row0 + ai * HALF + m * 16) * 1024 + c) = w; } }
    }
};
struct EpiGates {
    static constexpr bool PERM = false, AFTER_DRAIN = false;
    bf16_t* lru_a; bf16_t* lru_ix; const float* ba; const float* bx; const float* lam; const bf16_t* xr;
    __device__ __forceinline__ void operator()(const f32x4 (&acc)[2][2][4][2], const Unit& u, int wr, int wc, int fr, int fq) const {
        const int grp = u.pn >> 2; const int row0 = u.pm * BM + wr * 64 + fr, col0 = (u.pn & 3) * BM + wc * 32 + 4 * fq;
#pragma unroll
        for (int bj = 0; bj < 2; ++bj)
#pragma unroll
            for (int n = 0; n < 2; ++n) { const int c = col0 + bj * HALF + n * 16;
                const f32x4 bv = *(const f32x4*)((grp == 0 ? ba : bx) + c); f32x4 sp = (f32x4){0.f, 0.f, 0.f, 0.f};
                if (grp == 0) { const f32x4 l = *(const f32x4*)(lam + c);
#pragma unroll
                    for (int j = 0; j < 4; ++j) sp[j] = 8.0f * softplusf_(-l[j]); }
#pragma unroll
                for (int ai = 0; ai < 2; ++ai)
#pragma unroll
                    for (int m = 0; m < 4; ++m) { const int row = row0 + ai * HALF + m * 16; f32x4 v = acc[ai][bj][m][n] + bv; u32x2 w;
                        if (grp == 0) {
#pragma unroll
                            for (int j = 0; j < 4; ++j) v[j] = one_minus_exp_neg(sigmoidf_(v[j]) * sp[j]);
                            w.x = cvt_pk_bf16(v[0], v[1]); w.y = cvt_pk_bf16(v[2], v[3]); *(u32x2*)(lru_a + (size_t)row * 1024 + c) = w;
                        } else { const u32x2 xw = *(const u32x2*)(xr + (size_t)row * 1024 + c);
                            v[0] = sigmoidf_(v[0]) * bf_lo(xw.x); v[1] = sigmoidf_(v[1]) * bf_hi(xw.x); v[2] = sigmoidf_(v[2]) * bf_lo(xw.y); v[3] = sigmoidf_(v[3]) * bf_hi(xw.y);
                            w.x = cvt_pk_bf16(v[0], v[1]); w.y = cvt_pk_bf16(v[2], v[3]); *(u32x2*)(lru_ix + (size_t)row * 1024 + c) = w; } } }
    }
};

template <class Epi, class Sched, bool ALIGN_EPI = false, bool SP2 = false>
__device__ __forceinline__ void gemm_phase(PG8_LAS unsigned char* lds, const Gemm g, const Sched& S, const Epi& E) {
    const int tid = threadIdx.x, wid = __builtin_amdgcn_readfirstlane(tid >> 6), lane = tid & 63, wr = wid >> 2, wc = wid & 3, fr = lane & 15, fq = lane >> 4;
    const int K = g.K, nt = K / BK;
    unsigned voffA[2], voffB[2];
#pragma unroll
    for (int i = 0; i < 2; ++i) { int R, C; stage_rc(tid * 16 + i * 8192, R, C); const int Rb = Epi::PERM ? ((R & ~31) + perm32(R & 31)) : R;
        voffA[i] = (unsigned)(R * g.lda + C) * 2u; voffB[i] = (unsigned)(Rb * g.ldb + C) * 2u; }
    const size_t kstep = (size_t)(BK * 2);
    const size_t hstepA = (size_t)HALF * g.lda * 2, hstepB = (size_t)HALF * g.ldb * 2;
    const size_t tstepA = 2 * hstepA, tstepB = 2 * hstepB;
    const unsigned ldsw = (unsigned)wid * 1024u;
    const int aoff = lds_byte(wr * 64 + fr, fq * 8), boff = lds_byte(wc * 32 + fr, fq * 8);
#define PG8_SA(b, h) (((b) * 2 + (h)) * HTB)
#define PG8_SB(b, h) ((4 + (b) * 2 + (h)) * HTB)
#define PG8_STAGE(bufoff, gbase, voff) do { _Pragma("unroll") for (int _i = 0; _i < 2; ++_i) \
        __builtin_amdgcn_global_load_lds((const unsigned*)((const char*)(gbase) + (voff)[_i]), (PG8_LAS unsigned*)(lds + (bufoff) + ldsw + _i * 8192), 16, 0, 0); } while (0)
#define PG8_LDA(dst, b, h) do { _Pragma("unroll") for (int m = 0; m < 4; ++m) _Pragma("unroll") for (int k = 0; k < 2; ++k) dst[m][k] = *(const PG8_LAS bf16x8*)(lds + PG8_SA(b, h) + aoff + m * 2048 + k * 1024); } while (0)
#define PG8_LDB(dst, b, h) do { _Pragma("unroll") for (int n = 0; n < 2; ++n) _Pragma("unroll") for (int k = 0; k < 2; ++k) dst[n][k] = *(const PG8_LAS bf16x8*)(lds + PG8_SB(b, h) + boff + n * 2048 + k * 1024); } while (0)
#define PG8_MMA(ai, bj, At, Bt) do { __builtin_amdgcn_s_setprio(1); _Pragma("unroll") for (int m = 0; m < 4; ++m) _Pragma("unroll") for (int n = 0; n < 2; ++n) _Pragma("unroll") for (int k = 0; k < 2; ++k) \
        acc[ai][bj][m][n] = __builtin_amdgcn_mfma_f32_16x16x32_bf16(Bt[n][k], At[m][k], acc[ai][bj][m][n], 0, 0, 0); __builtin_amdgcn_s_setprio(0); } while (0)
#define PG8_WAIT_V(n) asm volatile("s_waitcnt vmcnt(" #n ")" ::: "memory")
#define PG8_WAIT_L(n) asm volatile("s_waitcnt lgkmcnt(" #n ")" ::: "memory")
#define PG8_BAR __builtin_amdgcn_s_barrier()
#define PG8_SCHED __builtin_amdgcn_sched_barrier(0)
    Unit cur, nxt; int ui = 0;
    if (!S.next(0, cur)) return;
    f32x4 acc[2][2][4][2];
#pragma unroll
    for (int a = 0; a < 2; ++a)
#pragma unroll
        for (int b = 0; b < 2; ++b)
#pragma unroll
            for (int m = 0; m < 4; ++m)
#pragma unroll
                for (int n = 0; n < 2; ++n) acc[a][b][m][n] = (f32x4){0.f, 0.f, 0.f, 0.f};
    bf16x8 At[4][2], B0[2][2], B1[2][2];
    const char* cA = (const char*)g.A + (size_t)cur.pm * tstepA + cur.aoff; const char* cB = (const char*)g.Bt + (size_t)cur.pn * tstepB + cur.boff;
    S.a_ready(cur);
    if constexpr (SP2) {
        PG8_STAGE(PG8_SB(0, 0), cB, voffB); PG8_STAGE(PG8_SB(0, 1), cB + hstepB, voffB); PG8_STAGE(PG8_SA(0, 0), cA, voffA); PG8_STAGE(PG8_SA(0, 1), cA + hstepA, voffA);
        if (wr == 1) PG8_BAR;
        PG8_WAIT_V(2); PG8_BAR;
        PG8_STAGE(PG8_SB(1, 0), cB + kstep, voffB); PG8_STAGE(PG8_SA(1, 0), cA + kstep, voffA); PG8_STAGE(PG8_SB(1, 1), cB + hstepB + kstep, voffB);
        PG8_WAIT_V(6); PG8_BAR;
    } else {
        PG8_STAGE(PG8_SB(0, 0), cB, voffB); PG8_STAGE(PG8_SA(0, 0), cA, voffA); PG8_STAGE(PG8_SB(0, 1), cB + hstepB, voffB); PG8_STAGE(PG8_SA(0, 1), cA + hstepA, voffA);
        if (wr == 1) PG8_BAR;
        PG8_WAIT_V(4); PG8_BAR;
        PG8_STAGE(PG8_SB(1, 0), cB + kstep, voffB); PG8_STAGE(PG8_SA(1, 0), cA + kstep, voffA); PG8_STAGE(PG8_SB(1, 1), cB + hstepB + kstep, voffB);
        PG8_WAIT_V(6); PG8_BAR;
    }
    for (;;) {
        const bool has_next = S.next(ui + 1, nxt);
        const char* nA = has_next ? (const char*)g.A + (size_t)nxt.pm * tstepA + nxt.aoff : cA; const char* nB = has_next ? (const char*)g.Bt + (size_t)nxt.pn * tstepB + nxt.boff : cB;
        for (int t = 0; t < nt; t += 2) {
            const bool last = (t == nt - 2);
            const char* a1 = cA + (size_t)(t + 1) * kstep;
            const char* a2 = last ? nA : cA + (size_t)(t + 2) * kstep; const char* b2 = last ? nB : cB + (size_t)(t + 2) * kstep;
            const char* a3 = a2 + kstep; const char* b3 = b2 + kstep;
            if (last && has_next) S.a_ready(nxt);
            if constexpr (SP2) {
            PG8_LDB(B0, 0, 0); PG8_LDB(B1, 0, 1); PG8_SCHED; PG8_LDA(At, 0, 0); PG8_STAGE(PG8_SA(1, 1), a1 + hstepA, voffA);
            PG8_WAIT_V(8); PG8_WAIT_L(0); PG8_BAR; PG8_MMA(0, 0, At, B0); PG8_MMA(0, 1, At, B1); PG8_BAR; PG8_SCHED;
            PG8_LDA(At, 0, 1); PG8_STAGE(PG8_SB(0, 0), b2, voffB); PG8_STAGE(PG8_SB(0, 1), b2 + hstepB, voffB); PG8_STAGE(PG8_SA(0, 0), a2, voffA);
            PG8_WAIT_V(8); PG8_WAIT_L(0); PG8_BAR; PG8_MMA(1, 0, At, B0); PG8_MMA(1, 1, At, B1); PG8_BAR; PG8_SCHED;
            PG8_LDB(B0, 1, 0); PG8_LDB(B1, 1, 1); PG8_SCHED; PG8_LDA(At, 1, 0); PG8_STAGE(PG8_SA(0, 1), a2 + hstepA, voffA);
            PG8_WAIT_V(8); PG8_WAIT_L(0); PG8_BAR; PG8_MMA(0, 0, At, B0); PG8_MMA(0, 1, At, B1); PG8_BAR; PG8_SCHED;
            PG8_LDA(At, 1, 1); PG8_STAGE(PG8_SB(1, 0), b3, voffB); PG8_STAGE(PG8_SB(1, 1), b3 + hstepB, voffB); PG8_STAGE(PG8_SA(1, 0), a3, voffA);
            PG8_WAIT_V(8); PG8_WAIT_L(0); PG8_BAR; PG8_MMA(1, 0, At, B0); PG8_MMA(1, 1, At, B1); PG8_BAR; PG8_SCHED;
            } else {
            PG8_LDB(B0, 0, 0); PG8_SCHED; PG8_LDA(At, 0, 0); PG8_STAGE(PG8_SA(1, 1), a1 + hstepA, voffA);
            PG8_WAIT_L(8); PG8_BAR; PG8_WAIT_L(0); PG8_MMA(0, 0, At, B0); PG8_BAR; PG8_SCHED;
            PG8_LDB(B1, 0, 1); PG8_STAGE(PG8_SB(0, 0), b2, voffB);
            PG8_BAR; PG8_WAIT_L(0); PG8_MMA(0, 1, At, B1); PG8_BAR;
            PG8_LDA(At, 0, 1); PG8_STAGE(PG8_SA(0, 0), a2, voffA);
            PG8_BAR; PG8_WAIT_L(0); PG8_MMA(1, 0, At, B0); PG8_BAR; PG8_SCHED;
            PG8_STAGE(PG8_SB(0, 1), b2 + hstepB, voffB);
            PG8_WAIT_V(6); PG8_BAR; PG8_MMA(1, 1, At, B1); PG8_BAR;
            PG8_LDB(B0, 1, 0); PG8_SCHED; PG8_LDA(At, 1, 0); PG8_STAGE(PG8_SA(0, 1), a2 + hstepA, voffA);
            PG8_WAIT_L(8); PG8_BAR; PG8_WAIT_L(0); PG8_MMA(0, 0, At, B0); PG8_BAR; PG8_SCHED;
            PG8_LDB(B1, 1, 1); PG8_STAGE(PG8_SB(1, 0), b3, voffB);
            PG8_BAR; PG8_WAIT_L(0); PG8_MMA(0, 1, At, B1); PG8_BAR;
            PG8_LDA(At, 1, 1); PG8_STAGE(PG8_SA(1, 0), a3, voffA);
            PG8_BAR; PG8_WAIT_L(0); PG8_MMA(1, 0, At, B0); PG8_BAR; PG8_SCHED;
            PG8_STAGE(PG8_SB(1, 1), b3 + hstepB, voffB);
            PG8_WAIT_V(6); PG8_BAR; PG8_MMA(1, 1, At, B1); PG8_BAR;
            }
        }
        if constexpr (ALIGN_EPI) { if (wr == 0) PG8_BAR; }
        if constexpr (!Epi::AFTER_DRAIN) { E(acc, cur, wr, wc, fr, fq); S.done(cur); }
        if (!has_next) break;
#pragma unroll
        for (int a = 0; a < 2; ++a)
#pragma unroll
            for (int b = 0; b < 2; ++b)
#pragma unroll
                for (int m = 0; m < 4; ++m)
#pragma unroll
                    for (int n = 0; n < 2; ++n) acc[a][b][m][n] = (f32x4){0.f, 0.f, 0.f, 0.f};
        cur = nxt; cA = nA; cB = nB; ++ui;
        if constexpr (ALIGN_EPI) { if (wr == 1) PG8_BAR; }
    }
    PG8_WAIT_V(0);
    if constexpr (!ALIGN_EPI) { if (wr == 0) PG8_BAR; }
    PG8_BAR;
    if constexpr (Epi::AFTER_DRAIN) { E.fused(acc, cur, wr, wc, fr, fq, lds, wid, lane); S.done(cur); }
#undef PG8_SA
#undef PG8_SB
#undef PG8_STAGE
#undef PG8_LDA
#undef PG8_LDB
#undef PG8_MMA
#undef PG8_WAIT_V
#undef PG8_WAIT_L
#undef PG8_BAR
#undef PG8_SCHED
}
}
#define GAS __attribute__((address_space(1)))
#define LAS __attribute__((address_space(3)))
typedef unsigned short bf16;
typedef unsigned v4u __attribute__((ext_vector_type(4)));
typedef float f32x4 __attribute__((ext_vector_type(4)));
typedef short bf16x8 __attribute__((ext_vector_type(8)));
typedef GAS unsigned gu32;
typedef GAS unsigned long long gu64;
#define RLX_AGENT __ATOMIC_RELAXED, __HIP_MEMORY_SCOPE_AGENT
#define LDS_WAIT() asm volatile("s_waitcnt lgkmcnt(0)" ::: "memory")
#define VM_WAIT() asm volatile("s_waitcnt vmcnt(0)" ::: "memory")
__device__ __forceinline__ unsigned long long rt() { return __builtin_amdgcn_s_memrealtime(); }
__device__ __forceinline__ unsigned f2bf(float f) { unsigned u = __builtin_bit_cast(unsigned, f); return (u + 0x7fffu + ((u >> 16) & 1u)) >> 16; }
__device__ __forceinline__ unsigned pk2(float lo, float hi) { return f2bf(lo) | (f2bf(hi) << 16); }

#define XB_TMO      128
#define XB_XCNT(j)  (256  + 64 * (j))
#define XB_XSUB(j)  (1280 + 64 * (j))
#define XB_XGEN(j)  (2304 + 64 * (j))
#define XB_TOP      3328
#define XB_TOPGEN   3392
#define XCD_BAR_WORDS 3456
#define XB_SPIN_CAP (1u << 18)

__device__ __forceinline__ unsigned xb_ld(unsigned* p)              { return __hip_atomic_load(p, __ATOMIC_RELAXED, __HIP_MEMORY_SCOPE_AGENT); }
__device__ __forceinline__ unsigned xb_add(unsigned* p, unsigned v) { return __hip_atomic_fetch_add(p, v, __ATOMIC_RELAXED, __HIP_MEMORY_SCOPE_AGENT); }
__device__ __forceinline__ unsigned xb_xcc_id() { return (unsigned)__builtin_amdgcn_s_getreg((3 << 11) | 20) & 0xFu; }
#define XB_SPIN(cond, bar) do { unsigned _sp = 0; while (cond) { __builtin_amdgcn_s_sleep(1); \
    if ((++_sp & 255u) == 0u) { if (xb_ld(&(bar)[XB_TMO])) break; if (_sp > XB_SPIN_CAP) { atomicAdd(&(bar)[XB_TMO], 1u); break; } } } } while (0)

struct XcdBarrier {
    unsigned* bar; unsigned x;
    volatile LAS unsigned* st;
};

__device__ __forceinline__ XcdBarrier xcd_barrier_post(unsigned* bar, volatile LAS unsigned* st) {
    XcdBarrier b; b.bar = bar; b.x = xb_xcc_id(); b.st = st;
    if (threadIdx.x == 0) (void)xb_add(&bar[XB_XCNT(b.x)], 1u);
    return b;
}
__device__ __forceinline__ void xcd_barrier_complete(unsigned* bar, unsigned x, unsigned& nloc, unsigned& nx) {
    const unsigned G = gridDim.x * gridDim.y * gridDim.z;
    unsigned sum, cnt, mine, sp = 0u;
    for (;;) {
        sum = 0u; cnt = 0u; mine = 0u;
#pragma unroll
        for (unsigned j = 0; j < 16; ++j) { const unsigned c = xb_ld(&bar[XB_XCNT(j)]); sum += c; cnt += (c > 0u) ? 1u : 0u; mine = (j == x) ? c : mine; }
        if (sum == G) break;
        __builtin_amdgcn_s_sleep(1);
        if ((++sp & 255u) == 0u) { if (xb_ld(&bar[XB_TMO])) break; if (sp > XB_SPIN_CAP) { atomicAdd(&bar[XB_TMO], 1u); break; } }
    }
    nloc = mine > 0u ? mine : 1u; nx = cnt > 0u ? cnt : 1u;
}

__device__ __forceinline__ void xcd_barrier(const XcdBarrier& b) {
    asm volatile("s_waitcnt vmcnt(0)" ::: "memory");
    __syncthreads();
    if (threadIdx.x == 0) {
        unsigned* bar = b.bar;
        __builtin_amdgcn_s_waitcnt(0);
        unsigned nloc = b.st[0], nx = b.st[1];
        if (nloc == 0u) { xcd_barrier_complete(bar, b.x, nloc, nx); b.st[0] = nloc; b.st[1] = nx; }
        const unsigned old = xb_add(&bar[XB_XSUB(b.x)], 1u);
        const unsigned gen = old / nloc;
        if (old + 1u == (gen + 1u) * nloc) {
            __builtin_amdgcn_fence(__ATOMIC_RELEASE, "agent");
            asm volatile("s_waitcnt vmcnt(0)" ::: "memory");
            const unsigned og = xb_add(&bar[XB_TOP], 1u);
            const unsigned tg = og / nx;
            if (og + 1u == (tg + 1u) * nx) xb_add(&bar[XB_TOPGEN], 1u);
            else XB_SPIN(xb_ld(&bar[XB_TOPGEN]) == tg, bar);
            __builtin_amdgcn_fence(__ATOMIC_ACQUIRE, "agent");
            xb_add(&bar[XB_XGEN(b.x)], 1u);
            asm volatile("s_waitcnt vmcnt(0)" ::: "memory");
        } else {
            XB_SPIN(xb_ld(&bar[XB_XGEN(b.x)]) == gen, bar);
            __builtin_amdgcn_fence(__ATOMIC_ACQUIRE, "agent");
            asm volatile("s_waitcnt vmcnt(0)" ::: "memory");
        }
    }
    __syncthreads();
}

constexpr int NWAVES = 8;
constexpr int DM = 2048, TX = 8192, NMETA = 16, TT = TX + NMETA, MP = 8448;
constexpr int EV_NP = 5632, EV_LORA0 = 3072, EV_GB = 3360, EV_REC = 4384;
constexpr int OD_NP = 12544, OD_Z = 8192, OD_B = 12288, OD_A = 12320;
constexpr int NEXP = 32, FF = 512, MOE_ROWS = 24576;
constexpr float NORM_EPS = 1e-6f;

constexpr size_t MiB = 1u << 20;
constexpr size_t WS_CTL = 0, CTL_ZERO_BYTES = 1 * MiB;
constexpr size_t WS_TOKINFO = 1 * MiB;
constexpr size_t WS_TILES = 1 * MiB + 512 * 1024;
constexpr size_t WS_WEVIN = 2 * MiB;
constexpr size_t WS_WEVOUT = 24 * MiB;
constexpr size_t WS_WODIN = 32 * MiB;
constexpr size_t WS_WODOUT = 81 * MiB;
constexpr size_t WS_WLORA = 97 * MiB;
constexpr size_t WS_WGATE = 100 * MiB;
constexpr size_t WS_WROUTE = 101 * MiB;
constexpr size_t WS_MOEW = 102 * MiB;
constexpr size_t MOE_E_BYTES = 6 * MiB, MOE_W2_OFF = 4 * MiB;
constexpr size_t WS_H = 294 * MiB;
constexpr size_t WS_HN = 360 * MiB;
constexpr size_t WS_YMIX = 393 * MiB;
constexpr size_t WS_PROJ = 459 * MiB;
constexpr size_t WS_SCR = 662 * MiB;
constexpr size_t WS_END = 932 * MiB;
constexpr size_t SC_ALORA = 0;
constexpr size_t SC_XR = 8 * MiB;
constexpr size_t SC_DEC = 26 * MiB, SC_ICL = 60 * MiB, SC_GATE = 94 * MiB;
constexpr size_t SC_LA = 128 * MiB, SC_LIX = 162 * MiB;
constexpr size_t SC_QN = 0, SC_KN = 34 * MiB;
constexpr size_t SC_VC = 68 * MiB;
constexpr size_t SC_BETA = 134 * MiB, SC_G = 136 * MiB;
constexpr size_t SC_O = 138 * MiB;
constexpr size_t SC_XG = 0;
constexpr size_t SC_ACT = 96 * MiB;
constexpr size_t SC_YB = 120 * MiB;
static_assert(SC_O + (size_t)MP * 4096 * 4 <= WS_END - WS_SCR && SC_YB + (size_t)MOE_ROWS * 2048 * 2 <= WS_END - WS_SCR && SC_LIX + (size_t)MP * 1024 * 4 <= WS_END - WS_SCR, "scratch map");
constexpr int CW_TMO = 0, CW_CODE = 1;
constexpr int CW_BAR = 4096;
constexpr int CW_PROG = 20480;
constexpr int CW_TS = 24576;
constexpr int CW_MOECNT = 16384;

constexpr int RING_OFF = 0, RING_BYTES = 131072;
constexpr int LDSCTL_OFF = 146944, MISC_OFF = LDSCTL_OFF + 320;
constexpr int LDS_BYTES = 147456;


#define DI __device__ __forceinline__
typedef unsigned v2u __attribute__((ext_vector_type(2)));
struct Args { const float* in[36]; float* out; unsigned char* ws; int ph_lo, ph_hi; };
struct Frame {
    LAS unsigned char* lds; volatile LAS unsigned* MISC; gu32* ctl;
    int tid, lane, wave, vcu, G, gw, NGW;
};
DI float bf2f(bf16 v) { return __uint_as_float((unsigned)v << 16); }
DI float bflo(unsigned w) { return __uint_as_float(w << 16); }
DI float bfhi(unsigned w) { return __uint_as_float(w & 0xffff0000u); }
DI float wave_sum(float v) {
#pragma unroll
    for (int o = 1; o < 64; o <<= 1) v += __shfl_xor(v, o);
    return v;
}
DI float sigm(float x) { return __builtin_amdgcn_rcpf(1.0f + __expf(-x)); }
DI float softplus(float x) { return fmaxf(x, 0.f) + __logf(1.0f + __expf(-fabsf(x))); }
DI float gelu_tanh(float x) { const float u = 0.7978845608028654f * (x + 0.044715f * x * x * x); return 0.5f * x * (1.0f + tanhf(u)); }
DI int pos_row(int p) { return p < NMETA ? TX + p : p - NMETA; }
DI int row_pos(int r) { return r < TX ? r + NMETA : r - TX; }

DI void tr_item(const float* W, int N, int k0, int n0, bf16* WT, int ldk, int drow0, LAS float* scr, int lane) {
#pragma unroll 8
    for (int i = 0; i < 32; ++i) { const int kk = 2 * i + (lane >> 5); scr[kk * 33 + (lane & 31)] = W[(size_t)(k0 + kk) * N + n0 + (lane & 31)]; }
    LDS_WAIT(); asm volatile("" ::: "memory");
    const int c = lane & 7;
#pragma unroll
    for (int j = 0; j < 4; ++j) { const int n = (lane >> 3) + 8 * j; const LAS float* s = scr + (8 * c) * 33 + n;
        v4u o; o.x = pk2(s[0 * 33], s[1 * 33]); o.y = pk2(s[2 * 33], s[3 * 33]); o.z = pk2(s[4 * 33], s[5 * 33]); o.w = pk2(s[6 * 33], s[7 * 33]);
        *(v4u*)(WT + (size_t)(drow0 + n) * ldk + k0 + 8 * c) = o; }
    LDS_WAIT(); asm volatile("" ::: "memory");
}
DI void moe_convert(const Frame& F, const Args& a, int l, int gw, int ngw) {
    LAS float* scr = (LAS float*)(F.lds + RING_OFF + F.wave * 16384);
    bf16* base = (bf16*)(a.ws + WS_MOEW);
    for (int it = gw; it < NEXP * 1536; it += ngw) {
        const int e = it / 1536; int j = it % 1536; bf16* eb = base + (size_t)e * (MOE_E_BYTES / 2);
        const size_t eoff = (size_t)(l * NEXP + e) * DM * FF;
        if (j < 1024) { const float* W = (j < 512 ? a.in[33] : a.in[34]) + eoff; const int hi = j >= 512; j &= 511; const int kb = j >> 4, nb = j & 15, n0 = 32 * nb;
            tr_item(W, FF, 64 * kb, n0, eb, DM, 256 * (n0 >> 7) + 128 * hi + (n0 & 127), scr, F.lane); }
        else { j -= 1024; const int kb = j >> 6, nb = j & 63; tr_item(a.in[35] + eoff, DM, 64 * kb, 32 * nb, eb + MOE_W2_OFF / 2, FF, 32 * nb, scr, F.lane); }
    }
}
DI void norm_row_bf16(int lane, const float* src, const float* w, bf16* dst) {
    f32x4 v[8]; float s = 0.f;
#pragma unroll
    for (int j = 0; j < 8; ++j) { v[j] = ((const f32x4*)src)[lane + 64 * j]; s += (v[j].x * v[j].x + v[j].y * v[j].y) + (v[j].z * v[j].z + v[j].w * v[j].w); }
    const float rs = 1.0f / sqrtf(wave_sum(s) * (1.0f / DM) + NORM_EPS);
#pragma unroll
    for (int j = 0; j < 8; ++j) { const f32x4 wv = ((const f32x4*)w)[lane + 64 * j]; v2u o; o.x = pk2(v[j].x * rs * wv.x, v[j].y * rs * wv.y); o.y = pk2(v[j].z * rs * wv.z, v[j].w * rs * wv.w);
        ((v2u*)dst)[lane + 64 * j] = o; }
}

DI void ph_prologue(const Frame& F, const Args& a) {
    LAS float* scr = (LAS float*)(F.lds + RING_OFF + F.wave * 16384);
    constexpr int I_A = 32 * 169, I_B = 32 * 64, NIT = I_A + I_B;
    for (int it = F.gw; it < NIT; it += F.NGW) {
        int r = it;
        if (r < I_A) { const int kb = r / 169, nb = r % 169; tr_item(a.in[5], 5408, 64 * kb, 32 * nb, (bf16*)(a.ws + WS_WEVIN), DM, 32 * nb, scr, F.lane); continue; } r -= I_A;
        { const int kb = r / 64, nb = r % 64; tr_item(a.in[24], DM, 64 * kb, 32 * nb, (bf16*)(a.ws + WS_WEVOUT), DM, 32 * nb, scr, F.lane); }
    }
    const int gt = F.vcu * (NWAVES * 64) + F.tid, NGT = F.G * NWAVES * 64;
    { bf16* WL = (bf16*)(a.ws + WS_WLORA); const float* wup = a.in[8]; const float* aup = a.in[10]; const float* gup = a.in[11];
      for (int idx = gt; idx < 3072 * 384; idx += NGT) { const int n = idx / 384, k = idx % 384; float v = 0.f;
          if (n < 1024) { if (k < 64) v = wup[k * 1024 + n]; }
          else if (n < 2048) { if (k >= 64 && k < 128) v = aup[(k - 64) * 1024 + n - 1024]; }
          else { if (k >= 128 && k < 288) v = gup[(k - 128) * 1024 + n - 2048]; }
          WL[idx] = (bf16)f2bf(v); } }
    { bf16* WG = (bf16*)(a.ws + WS_WGATE);
      for (int idx = gt; idx < 2048 * 256; idx += NGT) { const int n = idx >> 8, kk = idx & 255, nn = n & 1023, blk = nn >> 6, j = nn & 63, cin = (nn & ~255) + kk;
          const float* W = n < 1024 ? a.in[19] : a.in[21];
          const float v = (cin >> 6) == blk ? W[blk * 4096 + (cin & 63) * 64 + j] : 0.f;
          WG[idx] = (bf16)f2bf(v); } }
    { bf16* WR = (bf16*)(a.ws + WS_WROUTE);
      for (int idx = gt; idx < 2 * 48 * DM; idx += NGT) { const int l = idx / (48 * DM), n = (idx / DM) % 48, k = idx % DM; float v = 0.f;
          if (n < 32) v = a.in[32][((size_t)l * DM + k) * NEXP + n]; else if (n < 36) v = a.in[31][((size_t)l * DM + k) * 4 + n - 32];
          const unsigned hi = f2bf(v); WR[((size_t)(l * 2) * 48 + n) * DM + k] = (bf16)hi; WR[((size_t)(l * 2 + 1) * 48 + n) * DM + k] = (bf16)f2bf(v - __uint_as_float(hi << 16)); } }
    bf16* HN = (bf16*)(a.ws + WS_HN);
    for (int r = F.gw; r < TT; r += F.NGW) norm_row_bf16(F.lane, r < TX ? a.in[0] + (size_t)r * DM : a.in[1] + (size_t)(r - TX) * DM, a.in[2], HN + (size_t)r * DM);
}

DI void ph_aux_convert(const Frame& F, const Args& a, int gw, int ngw) {
    LAS float* scr = (LAS float*)(F.lds + RING_OFF + F.wave * 16384);
    constexpr int I_C = 32 * 386, I_D = 64 * 64, NIT = I_C + I_D;
    for (int it = gw; it < NIT; it += ngw) {
        int r = it;
        if (r < I_C) { const int kb = r / 386, nb = r % 386; tr_item(a.in[25], 12352, 64 * kb, 32 * nb, (bf16*)(a.ws + WS_WODIN), DM, 32 * nb, scr, F.lane); continue; } r -= I_C;
        { const int kb = r / 64, nb = r % 64; tr_item(a.in[30], DM, 64 * kb, 32 * nb, (bf16*)(a.ws + WS_WODOUT), 4096, 32 * nb, scr, F.lane); }
    }
    moe_convert(F, a, 0, gw, ngw);
}

DI void ph_even_prep(const Frame& F, const Args& a) {
    const bf16* P = (const bf16*)(a.ws + WS_PROJ); bf16* AL = (bf16*)(a.ws + WS_SCR + SC_ALORA); bf16* XR = (bf16*)(a.ws + WS_SCR + SC_XR);
    const float* mu = a.in[6]; const float* cw = a.in[17]; const float* cb = a.in[18];
    const int lane = F.lane;
    for (int item = F.gw; item < TT + (TT / 8) * 2; item += F.NGW) {
        if (item < TT) { const int r = item, pos = row_pos(r); const bf16* cur = P + (size_t)r * EV_NP; const bf16* prv = P + (size_t)pos_row(pos > 0 ? pos - 1 : 0) * EV_NP; const float pm = pos > 0 ? 1.f : 0.f;
            float cv[6], pv[6], mv[6];
#pragma unroll
            for (int i = 0; i < 6; ++i) { const int idx = lane + 64 * i, col = EV_LORA0 + (idx < 288 ? idx : 287); cv[i] = bf2f(cur[col]); pv[i] = bf2f(prv[col]) * pm; mv[i] = mu[col]; }
#pragma unroll
            for (int i = 0; i < 6; ++i) { const int idx = lane + 64 * i; float v = cv[i] + (pv[i] - cv[i]) * mv[i];
                if (idx < 64) v = tanhf(v); else if (idx >= 128) v = sigm(v);
                AL[(size_t)r * 384 + idx] = (bf16)f2bf(idx < 288 ? v : 0.f); }
        } else { const int it2 = item - TT, pb = it2 >> 1, c0 = (it2 & 1) * 512 + lane * 8, p0 = pb * 8;
            f32x4 w[4][2], b0 = *(const f32x4*)(cb + c0), b1 = *(const f32x4*)(cb + c0 + 4);
#pragma unroll
            for (int j = 0; j < 4; ++j) { w[j][0] = *(const f32x4*)(cw + j * 1024 + c0); w[j][1] = *(const f32x4*)(cw + j * 1024 + c0 + 4); }
            v4u x[11];
#pragma unroll
            for (int i = 0; i < 11; ++i) { const int p = p0 - 3 + i; x[i] = *(const v4u*)(P + (size_t)pos_row(p > 0 ? p : 0) * EV_NP + EV_REC + c0); if (p < 0) x[i] = (v4u){0u, 0u, 0u, 0u}; }
#pragma unroll
            for (int o = 0; o < 8; ++o) { float acc[8] = {b0.x, b0.y, b0.z, b0.w, b1.x, b1.y, b1.z, b1.w};
#pragma unroll
                for (int j = 0; j < 4; ++j) { const v4u xv = x[o + j];
                    acc[0] += w[j][0].x * bflo(xv.x); acc[1] += w[j][0].y * bfhi(xv.x); acc[2] += w[j][0].z * bflo(xv.y); acc[3] += w[j][0].w * bfhi(xv.y);
                    acc[4] += w[j][1].x * bflo(xv.z); acc[5] += w[j][1].y * bfhi(xv.z); acc[6] += w[j][1].z * bflo(xv.w); acc[7] += w[j][1].w * bfhi(xv.w); }
                *(v4u*)(XR + (size_t)pos_row(p0 + o) * 1024 + c0) = (v4u){pk2(acc[0], acc[1]), pk2(acc[2], acc[3]), pk2(acc[4], acc[5]), pk2(acc[6], acc[7])}; } }
    }
}

DI void ph_route(const Frame& F, const Args& a, int l, int dummy) {
    const float* H = (const float*)(a.ws + WS_H); const float* nw = a.in[3] + (size_t)l * DM;
    const bf16* WH = (const bf16*)(a.ws + WS_WROUTE) + (size_t)(l * 2) * 48 * DM; const bf16* WL = WH + (size_t)48 * DM;
    unsigned* TI = (unsigned*)(a.ws + WS_TOKINFO) + (dummy ? (WS_SCR + 250 * MiB - WS_TOKINFO) / 4 : 0); const int lane = F.lane, lc = lane & 15, quad = lane >> 4, wave = F.wave; const int cl = dummy ? l + 2 : l;
    LAS float* red = (LAS float*)(F.lds + RING_OFF);
    LAS float* sq = red + 8 * 9 * 64 * 4; LAS float* lgs = sq + 8 * 48;
    static_assert(TT % 48 == 0, "router tasks");
    for (int task = F.vcu; task < TT / 48; task += F.G) {
        const float* nwp = nw + 256 * wave + 8 * quad; float ss[3] = {0.f, 0.f, 0.f};
        f32x4 acc[3][3];
#pragma unroll
        for (int mt = 0; mt < 3; ++mt)
#pragma unroll
            for (int nt = 0; nt < 3; ++nt) acc[mt][nt] = (f32x4){0.f, 0.f, 0.f, 0.f};
#pragma unroll 2
        for (int ks = 0; ks < 8; ++ks) { const int k0 = 256 * wave + 32 * ks + 8 * quad; const f32x4 w0 = *(const f32x4*)(nwp + 32 * ks), w1 = *(const f32x4*)(nwp + 32 * ks + 4);
            bf16x8 bh[3], bl[3];
#pragma unroll
            for (int nt = 0; nt < 3; ++nt) { bh[nt] = *(const bf16x8*)(WH + (size_t)(16 * nt + lc) * DM + k0); bl[nt] = *(const bf16x8*)(WL + (size_t)(16 * nt + lc) * DM + k0); }
#pragma unroll
            for (int mt = 0; mt < 3; ++mt) { const float* hr = H + (size_t)(task * 48 + mt * 16 + lc) * DM + k0; const f32x4 x0 = *(const f32x4*)hr, x1 = *(const f32x4*)(hr + 4);
                ss[mt] += (x0.x * x0.x + x0.y * x0.y) + (x0.z * x0.z + x0.w * x0.w) + (x1.x * x1.x + x1.y * x1.y) + (x1.z * x1.z + x1.w * x1.w);
                const float xn[8] = {x0.x * w0.x, x0.y * w0.y, x0.z * w0.z, x0.w * w0.w, x1.x * w1.x, x1.y * w1.y, x1.z * w1.z, x1.w * w1.w};
                unsigned hi[8]; float lo[8];
#pragma unroll
                for (int q = 0; q < 8; ++q) { hi[q] = f2bf(xn[q]); lo[q] = xn[q] - __uint_as_float(hi[q] << 16); }
                const v4u ah4 = (v4u){hi[0] | (hi[1] << 16), hi[2] | (hi[3] << 16), hi[4] | (hi[5] << 16), hi[6] | (hi[7] << 16)}, al4 = (v4u){pk2(lo[0], lo[1]), pk2(lo[2], lo[3]), pk2(lo[4], lo[5]), pk2(lo[6], lo[7])};
                const bf16x8 ah = __builtin_bit_cast(bf16x8, ah4), al = __builtin_bit_cast(bf16x8, al4);
#pragma unroll
                for (int nt = 0; nt < 3; ++nt) { acc[mt][nt] = __builtin_amdgcn_mfma_f32_16x16x32_bf16(al, bh[nt], acc[mt][nt], 0, 0, 0); acc[mt][nt] = __builtin_amdgcn_mfma_f32_16x16x32_bf16(ah, bl[nt], acc[mt][nt], 0, 0, 0);
                    acc[mt][nt] = __builtin_amdgcn_mfma_f32_16x16x32_bf16(ah, bh[nt], acc[mt][nt], 0, 0, 0); } } }
#pragma unroll
        for (int mt = 0; mt < 3; ++mt) { float s_ = ss[mt]; s_ += __shfl_xor(s_, 16); s_ += __shfl_xor(s_, 32); if (quad == 0) sq[wave * 48 + mt * 16 + lc] = s_;
#pragma unroll
            for (int nt = 0; nt < 3; ++nt) *(LAS f32x4*)(red + ((wave * 9 + mt * 3 + nt) * 64 + lane) * 4) = acc[mt][nt]; }
        __syncthreads();
        { const int tile = wave;
#pragma unroll
          for (int rep = 0; rep < 2; ++rep) { const int tl = tile + 8 * rep; if (tl < 9) { f32x4 s = *(const LAS f32x4*)(red + (tl * 64 + lane) * 4);
#pragma unroll
              for (int v = 1; v < 8; ++v) s = s + *(const LAS f32x4*)(red + ((v * 9 + tl) * 64 + lane) * 4);
              const int mt = tl / 3, nt = tl % 3;
#pragma unroll
              for (int q = 0; q < 4; ++q) lgs[(mt * 16 + 4 * quad + q) * 49 + 16 * nt + lc] = s[q]; } } }
        __syncthreads();
        if (wave == 0 && lane < 48) { float sst = 0.f;
#pragma unroll
            for (int v = 0; v < 8; ++v) sst += sq[v * 48 + lane];
            const float rs = 1.0f / sqrtf(sst * (1.0f / DM) + NORM_EPS);
            float lg[36];
#pragma unroll
            for (int i = 0; i < 36; ++i) lg[i] = lgs[lane * 49 + i] * rs;
            int gi = 0; float gm = lg[32];
#pragma unroll
            for (int i = 1; i < 4; ++i) if (lg[32 + i] > gm) { gm = lg[32 + i]; gi = i; }
            float den = 0.f;
#pragma unroll
            for (int i = 0; i < 4; ++i) den += __expf(lg[32 + i] - gm);
            const float gp = 1.0f / den;
            float l8[8];
#pragma unroll
            for (int i = 0; i < 8; ++i) l8[i] = gi == 0 ? lg[i] : (gi == 1 ? lg[8 + i] : (gi == 2 ? lg[16 + i] : lg[24 + i]));
            int i1 = 0; float m1 = l8[0];
#pragma unroll
            for (int i = 1; i < 8; ++i) if (l8[i] > m1) { m1 = l8[i]; i1 = i; }
            int i2 = -1; float m2 = -INFINITY;
#pragma unroll
            for (int i = 0; i < 8; ++i) if (i != i1 && l8[i] > m2) { m2 = l8[i]; i2 = i; }
            const float e21 = __expf(m2 - m1); const float w1 = gp / (1.0f + e21), w2 = gp * e21 / (1.0f + e21);
            const int ea = gi * 8 + i1, eb = gi * 8 + i2; const int rt = task * 48 + lane;
            const unsigned sa = atomicAdd((unsigned*)(F.ctl + CW_MOECNT + (cl * NEXP + ea) * 16), 1u), sb = atomicAdd((unsigned*)(F.ctl + CW_MOECNT + (cl * NEXP + eb) * 16), 1u);
            unsigned* t = TI + (size_t)rt * 8; *(v4u*)t = (v4u){(unsigned)ea, sa, __float_as_uint(w1), (unsigned)eb}; *(v4u*)(t + 4) = (v4u){sb, __float_as_uint(w2), __float_as_uint(rs), 0u}; }
        __syncthreads();
    }
}
DI void moe_prefix(const Frame& F, int l, LAS int* ps) {
    if (F.tid == 0) { int t = 0;
        for (int e = 0; e < NEXP; ++e) { const unsigned c = __hip_atomic_load(F.ctl + CW_MOECNT + (l * NEXP + e) * 16, RLX_AGENT); ps[e] = t * 256; t += (int)((c + 255u) >> 8); }
        ps[32] = t; }
    __syncthreads();
}
DI void ph_gather(const Frame& F, const Args& a, int l) {
    LAS int* ps = (LAS int*)(F.lds + RING_OFF); moe_prefix(F, l, ps);
    if (F.vcu == 0 && F.tid < NEXP) { int* TE = (int*)(a.ws + WS_TILES); const int e = F.tid; const int t0 = ps[e] >> 8, t1 = (e == NEXP - 1 ? ps[32] : ps[e + 1] >> 8);
        for (int t = t0; t < t1; ++t) TE[t] = e; if (e == 0) TE[127] = ps[32]; }
    const float* H = (const float*)(a.ws + WS_H); const float* nw = a.in[3] + (size_t)l * DM; unsigned* TI = (unsigned*)(a.ws + WS_TOKINFO); bf16* XG = (bf16*)(a.ws + WS_SCR + SC_XG);
    const int lane = F.lane;
    for (int r = F.gw; r < TT; r += F.NGW) {
        unsigned* t = TI + (size_t)r * 8; const int g0 = ps[t[0]] + (int)t[1], g1 = ps[t[3]] + (int)t[4]; const float rs = __uint_as_float(t[6]);
        if (lane == 0) t[7] = (unsigned)g0 | ((unsigned)g1 << 16);
        const float* hr = H + (size_t)r * DM;
#pragma unroll
        for (int j = 0; j < 4; ++j) { const int e0 = (lane + 64 * j) * 8; const f32x4 x0 = *(const f32x4*)(hr + e0), x1 = *(const f32x4*)(hr + e0 + 4), w0 = *(const f32x4*)(nw + e0), w1 = *(const f32x4*)(nw + e0 + 4);
            v4u o; o.x = pk2(x0.x * rs * w0.x, x0.y * rs * w0.y); o.y = pk2(x0.z * rs * w0.z, x0.w * rs * w0.w); o.z = pk2(x1.x * rs * w1.x, x1.y * rs * w1.y); o.w = pk2(x1.z * rs * w1.z, x1.w * rs * w1.w);
            *(v4u*)(XG + (size_t)g0 * DM + e0) = o; *(v4u*)(XG + (size_t)g1 * DM + e0) = o; }
    }
}
DI void ph_combine(const Frame& F, const Args& a, int l) {
    float* H = (float*)(a.ws + WS_H); const unsigned* TI = (const unsigned*)(a.ws + WS_TOKINFO); const bf16* YB = (const bf16*)(a.ws + WS_SCR + SC_YB); bf16* HN = (bf16*)(a.ws + WS_HN);
    const int lane = F.lane; const int nrows = l == 0 ? TT : TX;
    for (int r = F.gw; r < nrows; r += F.NGW) {
        const unsigned* t = TI + (size_t)r * 8; const int g0 = (int)(t[7] & 0xffffu), g1 = (int)(t[7] >> 16); const float w0 = __uint_as_float(t[2]), w1 = __uint_as_float(t[5]);
        float* hr = H + (size_t)r * DM; float hv[32]; float s = 0.f;
#pragma unroll
        for (int j = 0; j < 4; ++j) { const int e0 = (lane + 64 * j) * 8; const f32x4 x0 = *(const f32x4*)(hr + e0), x1 = *(const f32x4*)(hr + e0 + 4);
            const v4u ya = *(const v4u*)(YB + (size_t)g0 * DM + e0), yc = *(const v4u*)(YB + (size_t)g1 * DM + e0);
            float* o = hv + 8 * j;
            o[0] = x0.x + w0 * bflo(ya.x) + w1 * bflo(yc.x); o[1] = x0.y + w0 * bfhi(ya.x) + w1 * bfhi(yc.x); o[2] = x0.z + w0 * bflo(ya.y) + w1 * bflo(yc.y); o[3] = x0.w + w0 * bfhi(ya.y) + w1 * bfhi(yc.y);
            o[4] = x1.x + w0 * bflo(ya.z) + w1 * bflo(yc.z); o[5] = x1.y + w0 * bfhi(ya.z) + w1 * bfhi(yc.z); o[6] = x1.z + w0 * bflo(ya.w) + w1 * bflo(yc.w); o[7] = x1.w + w0 * bfhi(ya.w) + w1 * bfhi(yc.w);
#pragma unroll
            for (int q = 0; q < 8; ++q) s += o[q] * o[q]; }
        const float rs = 1.0f / sqrtf(wave_sum(s) * (1.0f / DM) + NORM_EPS);
        if (l == 0) { const float* nw = a.in[2] + DM;
#pragma unroll
            for (int j = 0; j < 4; ++j) { const int e0 = (lane + 64 * j) * 8; const float* o = hv + 8 * j; const f32x4 wa = *(const f32x4*)(nw + e0), wb = *(const f32x4*)(nw + e0 + 4);
                *(f32x4*)(hr + e0) = (f32x4){o[0], o[1], o[2], o[3]}; *(f32x4*)(hr + e0 + 4) = (f32x4){o[4], o[5], o[6], o[7]};
                v4u p; p.x = pk2(o[0] * rs * wa.x, o[1] * rs * wa.y); p.y = pk2(o[2] * rs * wa.z, o[3] * rs * wa.w); p.z = pk2(o[4] * rs * wb.x, o[5] * rs * wb.y); p.w = pk2(o[6] * rs * wb.z, o[7] * rs * wb.w);
                *(v4u*)(HN + (size_t)r * DM + e0) = p; }
        } else { const float* nw = a.in[4]; float* orow = a.out + (size_t)r * DM;
#ifdef PROBE_TS
            { const unsigned long long* ts = (const unsigned long long*)(F.ctl + CW_TS); const float dt_us = (float)(__hip_atomic_load(ts + PROBE_TS + 1, RLX_AGENT) - __hip_atomic_load(ts + PROBE_TS, RLX_AGENT)) * 0.01f;
#pragma unroll
              for (int q = 0; q < 32; ++q) hv[q] *= 1.0f + dt_us * 0.01f; }
#endif
#pragma unroll
            for (int j = 0; j < 4; ++j) { const int e0 = (lane + 64 * j) * 8; const float* o = hv + 8 * j; const f32x4 wa = *(const f32x4*)(nw + e0), wb = *(const f32x4*)(nw + e0 + 4);
                *(f32x4*)(orow + e0) = (f32x4){o[0] * rs * wa.x, o[1] * rs * wa.y, o[2] * rs * wa.z, o[3] * rs * wa.w};
                *(f32x4*)(orow + e0 + 4) = (f32x4){o[4] * rs * wb.x, o[5] * rs * wb.y, o[6] * rs * wb.z, o[7] * rs * wb.w}; } }
    }
}

struct OddPrepItem { f32x4 w[4][2]; v4u x[11]; };
DI void odd_prep_load(OddPrepItem& it, const bf16* P, const float* cw, int item, int lane) {
    const int pb = item >> 4, i = item & 15, ch = i * 512 + lane * 8, p0 = pb * 8;
#pragma unroll
    for (int j = 0; j < 4; ++j) { it.w[j][0] = *(const f32x4*)(cw + j * 8192 + ch); it.w[j][1] = *(const f32x4*)(cw + j * 8192 + ch + 4); }
#pragma unroll
    for (int q = 0; q < 11; ++q) { const int p = p0 - 3 + q; it.x[q] = *(const v4u*)(P + (size_t)pos_row(p > 0 ? p : 0) * OD_NP + ch); if (p < 0) it.x[q] = (v4u){0u, 0u, 0u, 0u}; }
}
DI void odd_prep_compute(const OddPrepItem& it, const Args& a, int item, int lane) {
    const bf16* P = (const bf16*)(a.ws + WS_PROJ); bf16* QN = (bf16*)(a.ws + WS_SCR + SC_QN); bf16* KN = (bf16*)(a.ws + WS_SCR + SC_KN); bf16* VC = (bf16*)(a.ws + WS_SCR + SC_VC);
    float* BETA = (float*)(a.ws + WS_SCR + SC_BETA); float* GG = (float*)(a.ws + WS_SCR + SC_G);
    const int pb = item >> 4, i = item & 15, ch = i * 512 + lane * 8, p0 = pb * 8;
#pragma unroll
    for (int o = 0; o < 8; ++o) { const int r = pos_row(p0 + o); float acc[8] = {0.f, 0.f, 0.f, 0.f, 0.f, 0.f, 0.f, 0.f};
#pragma unroll
        for (int j = 0; j < 4; ++j) { const v4u xv = it.x[o + j];
            acc[0] += it.w[j][0].x * bflo(xv.x); acc[1] += it.w[j][0].y * bfhi(xv.x); acc[2] += it.w[j][0].z * bflo(xv.y); acc[3] += it.w[j][0].w * bfhi(xv.y);
            acc[4] += it.w[j][1].x * bflo(xv.z); acc[5] += it.w[j][1].y * bfhi(xv.z); acc[6] += it.w[j][1].z * bflo(xv.w); acc[7] += it.w[j][1].w * bfhi(xv.w); }
        float ss = 0.f;
#pragma unroll
        for (int q = 0; q < 8; ++q) { acc[q] = acc[q] * sigm(acc[q]); ss += acc[q] * acc[q]; }
        float sc = 1.0f;
        if (i < 8) { ss += __shfl_xor(ss, 1); ss += __shfl_xor(ss, 2); ss += __shfl_xor(ss, 4); ss += __shfl_xor(ss, 8);
            sc = (1.0f / sqrtf(ss + NORM_EPS)) * (i < 4 ? 0.08838834764831845f : 1.0f); }
        const v4u ov = (v4u){pk2(acc[0] * sc, acc[1] * sc), pk2(acc[2] * sc, acc[3] * sc), pk2(acc[4] * sc, acc[5] * sc), pk2(acc[6] * sc, acc[7] * sc)};
        bf16* dst = i < 4 ? QN + (size_t)r * 2048 + ch : (i < 8 ? KN + (size_t)r * 2048 + ch - 2048 : VC + (size_t)r * 4096 + ch - 4096);
        *(v4u*)dst = ov; }
    if (i == 0 && lane < 32) {
#pragma unroll
        for (int o = 0; o < 8; ++o) { const int r = pos_row(p0 + o); const float bb = bf2f(P[(size_t)r * OD_NP + OD_B + lane]), aa = bf2f(P[(size_t)r * OD_NP + OD_A + lane]);
            BETA[(size_t)r * 32 + lane] = sigm(bb); GG[(size_t)r * 32 + lane] = -__expf(a.in[27][lane]) * softplus(aa + a.in[28][lane]); } }
}
DI void ph_odd_prep(const Frame& F, const Args& a) {
    const bf16* P = (const bf16*)(a.ws + WS_PROJ); const float* cw = a.in[26]; constexpr int NI = (TT / 8) * 16;
    for (int item = F.gw; item < NI; item += 2 * F.NGW) { OddPrepItem A, B; const bool hb = item + F.NGW < NI;
        odd_prep_load(A, P, cw, item, F.lane); odd_prep_load(B, P, cw, hb ? item + F.NGW : item, F.lane);
        odd_prep_compute(A, a, item, F.lane); if (hb) odd_prep_compute(B, a, item + F.NGW, F.lane); }
}
constexpr int ODD_POST_ROWS0 = 64 * 113;
DI void ph_odd_post(const Frame& F, const Args& a, int part) {
    const bf16* P = (const bf16*)(a.ws + WS_PROJ); const bf16* O = (const bf16*)(a.ws + WS_SCR + SC_O); bf16* Y = (bf16*)(a.ws + WS_YMIX); const float* nw = a.in[29];
    const int lane = F.lane; int w0 = F.gw, wn = F.NGW, n_rows = TX - ODD_POST_ROWS0;
    if (part == 0) { const int wx = F.vcu & 31; if (F.G != 256 || wx < 20) return; w0 = ((F.vcu >> 5) * 12 + (wx - 20)) * NWAVES + F.wave; wn = 96 * NWAVES; n_rows = ODD_POST_ROWS0 + NMETA; }
    if (part == 2) n_rows = TT;
    for (int ri = w0; ri < n_rows; ri += wn) { const int r = part == 0 ? (ri < ODD_POST_ROWS0 ? ri : TX + ri - ODD_POST_ROWS0) : (part == 1 ? ODD_POST_ROWS0 + ri : ri);
#pragma unroll 2
        for (int i = 0; i < 8; ++i) { const int ch = i * 512 + lane * 8; const v4u ow = *(const v4u*)(O + (size_t)r * 4096 + ch); const f32x4 o0 = (f32x4){bflo(ow.x), bfhi(ow.x), bflo(ow.y), bfhi(ow.y)}, o1 = (f32x4){bflo(ow.z), bfhi(ow.z), bflo(ow.w), bfhi(ow.w)};
            float ss = (o0.x * o0.x + o0.y * o0.y) + (o0.z * o0.z + o0.w * o0.w) + (o1.x * o1.x + o1.y * o1.y) + (o1.z * o1.z + o1.w * o1.w);
            ss += __shfl_xor(ss, 1); ss += __shfl_xor(ss, 2); ss += __shfl_xor(ss, 4); ss += __shfl_xor(ss, 8);
            const float rs = 1.0f / sqrtf(ss * (1.0f / 128.0f) + NORM_EPS);
            const v4u z = *(const v4u*)(P + (size_t)r * OD_NP + OD_Z + ch); const int c0 = ch & 127; const f32x4 w0 = *(const f32x4*)(nw + c0), w1 = *(const f32x4*)(nw + c0 + 4);
            const float zf[8] = {bflo(z.x), bfhi(z.x), bflo(z.y), bfhi(z.y), bflo(z.z), bfhi(z.z), bflo(z.w), bfhi(z.w)};
            const float of[8] = {o0.x * w0.x, o0.y * w0.y, o0.z * w0.z, o0.w * w0.w, o1.x * w1.x, o1.y * w1.y, o1.z * w1.z, o1.w * w1.w};
            float y[8];
#pragma unroll
            for (int q = 0; q < 8; ++q) y[q] = of[q] * rs * zf[q] * sigm(zf[q]);
            v4u p; p.x = pk2(y[0], y[1]); p.y = pk2(y[2], y[3]); p.z = pk2(y[4], y[5]); p.w = pk2(y[6], y[7]);
            *(v4u*)(Y + (size_t)r * 4096 + ch) = p; }
    }
}

typedef float f32x16 __attribute__((ext_vector_type(16)));
#define MFMA32(a, b, c) __builtin_amdgcn_mfma_f32_32x32x16_bf16((a), (b), (c), 0, 0, 0)
DI int crow(int reg, int h) { return (reg & 3) + 8 * (reg >> 2) + 4 * h; }
DI int chunk_row(int n, int c) { return n == 0 ? (c >= 48 ? TX + (c - 48) : -1) : 64 * (n - 1) + c; }
#ifndef GDN_NO_HELPER
#define GDN_NO_HELPER 0
#endif
constexpr int GDN_NCH = 129, GDN_UNITS = GDN_NCH * 32, GDN_KUNITS = GDN_NCH * 16, GC_STRIDE = 72;
constexpr size_t GD_WF = WS_MOEW, GD_UF = WS_MOEW + 65 * MiB, GD_IN = WS_MOEW + 130 * MiB, GD_GC = WS_MOEW + 163 * MiB, GD_KT = WS_HN, GD_QF = WS_SCR + 208 * MiB, GD_SAVE = WS_SCR + 205 * MiB;
static_assert(GD_QF + (size_t)GDN_KUNITS * 16384 <= WS_END && GD_SAVE + 2 * MiB <= GD_QF && (size_t)GDN_UNITS * 16384 <= 65 * MiB && (size_t)GDN_UNITS * 8192 <= 33 * MiB && (size_t)GDN_KUNITS * 16384 <= 33 * MiB && GD_GC + (size_t)GDN_UNITS * GC_STRIDE * 4 <= WS_H, "gdn map");

DI void ph_gdn_chunk(const Frame& F, const Args& a, int n_lo, int n_hi, int side) {
    const bf16* QN = (const bf16*)(a.ws + WS_SCR + SC_QN); const bf16* KN = (const bf16*)(a.ws + WS_SCR + SC_KN); const bf16* VC = (const bf16*)(a.ws + WS_SCR + SC_VC);
    const float* BETA = (const float*)(a.ws + WS_SCR + SC_BETA); const float* GG = (const float*)(a.ws + WS_SCR + SC_G);
    bf16* WF = (bf16*)(a.ws + GD_WF); bf16* UF = (bf16*)(a.ws + GD_UF); bf16* INF = (bf16*)(a.ws + GD_IN); bf16* KTF = (bf16*)(a.ws + GD_KT); bf16* QF = (bf16*)(a.ws + GD_QF); float* GC = (float*)(a.ws + GD_GC);
    LAS unsigned char* L = F.lds + RING_OFF;
    LAS unsigned char* kS = L; LAS unsigned char* qS = L + 17408; LAS unsigned char* vS = L + 34816; LAS unsigned char* kbS = L + 52224;
    LAS float* Lm = (LAS float*)(L + 69632); LAS bf16* IS = (LAS bf16*)(L + 87040); LAS bf16* XS = (LAS bf16*)(L + 96256);
    LAS float* betaS = (LAS float*)(L + 130048); LAS float* gcS = betaS + 64; LAS float* egcS = betaS + 128;
    LAS unsigned char* Lb = L + 17408; LAS unsigned char* TDs = L + 26624; LAS unsigned char* YT0 = L + 28672; LAS unsigned char* XT0 = L + 130816;
    static_assert(130816 + 8 * 1792 <= LDSCTL_OFF, "gdn lds map");
    const int tid = F.tid, lane = F.lane, wave = F.wave, l31 = lane & 31, h = lane >> 5;
    int widx = F.vcu, wcnt = F.G;
    if (side) { if (F.G == 256) { const int wx = F.vcu & 31; if (wx < 20) return; widx = (F.vcu >> 5) * 12 + (wx - 20); wcnt = 96; } else { if (F.vcu < 128 || F.G <= 128) return; widx = F.vcu - 128; wcnt = F.G - 128; } }
#define G1_BAR() do { asm volatile("s_waitcnt lgkmcnt(0)" ::: "memory"); __builtin_amdgcn_s_barrier(); asm volatile("" ::: "memory"); } while (0)
    v4u pkx[2], pqx[2], pvx[2]; float pbeta = 0.f, pgl = 0.f;
#define G1_FETCH(uu) do { const int n_ = (uu) >> 5, hv_ = (uu) & 31, hk_ = hv_ >> 1; \
        _Pragma("unroll") for (int i = 0; i < 2; ++i) { const int p = tid + 512 * i, row = p >> 4, ch = p & 15; const int rr = chunk_row(n_, row); const size_t r_ = (size_t)(rr >= 0 ? rr : 0); \
            pkx[i] = *(const v4u*)(KN + r_ * 2048 + hk_ * 128 + ch * 8); pqx[i] = *(const v4u*)(QN + r_ * 2048 + hk_ * 128 + ch * 8); pvx[i] = *(const v4u*)(VC + r_ * 4096 + hv_ * 128 + ch * 8); \
            if (rr < 0) { pkx[i] = (v4u){0u, 0u, 0u, 0u}; pqx[i] = pkx[i]; pvx[i] = pkx[i]; } } \
        if (wave == 0) { const int rr = chunk_row(n_, lane); const size_t r_ = (size_t)(rr >= 0 ? rr : 0); pbeta = BETA[r_ * 32 + hv_]; pgl = GG[r_ * 32 + hv_]; if (rr < 0) { pbeta = 0.f; pgl = 0.f; } } } while (0)
    const int unit0 = n_lo * 32 + widx;
    if (unit0 < n_hi * 32) G1_FETCH(unit0);
    for (int unit = unit0; unit < n_hi * 32; unit += wcnt) {
        const int n = unit >> 5, hv = unit & 31, hk = hv >> 1; const size_t su = (size_t)hv * GDN_NCH + n;
#pragma unroll
        for (int i = 0; i < 2; ++i) { const int p = tid + 512 * i, row = p >> 4, ch = p & 15;
            *(LAS v4u*)(kS + row * 272 + ch * 16) = pkx[i]; *(LAS v4u*)(qS + row * 272 + ch * 16) = pqx[i]; *(LAS v4u*)(vS + row * 272 + ch * 16) = pvx[i]; }
        if (wave == 0) { float b = pbeta, g = pgl;
#pragma unroll
            for (int o = 1; o < 64; o <<= 1) { const float t = __shfl_up(g, o); if (lane >= o) g += t; }
            betaS[lane] = b; gcS[lane] = g; egcS[lane] = __expf(g); }
        if (unit + wcnt < n_hi * 32) G1_FETCH(unit + wcnt);
        G1_BAR();
        if ((hv & 1) == 0) { const size_t kunit = (size_t)hk * GDN_NCH + n;
#pragma unroll
            for (int i = 0; i < 2; ++i) { const int p = tid + 512 * i, comb = p >> 6, ln = p & 63, t = comb >> 3, s = comb & 7; const int c = 32 * t + (ln & 31), k0 = 16 * s + 8 * (ln >> 5);
                *(v4u*)(QF + (kunit * 16 + comb) * 512 + ln * 8) = *(const LAS v4u*)(qS + c * 272 + k0 * 2); } }
#pragma unroll
        for (int i = 0; i < 2; ++i) { const int p = tid + 512 * i, row = p >> 4, ch = p & 15; const v4u kx = *(const LAS v4u*)(kS + row * 272 + ch * 16); const float b = betaS[row];
            v4u o; o.x = pk2(bflo(kx.x) * b, bfhi(kx.x) * b); o.y = pk2(bflo(kx.y) * b, bfhi(kx.y) * b); o.z = pk2(bflo(kx.z) * b, bfhi(kx.z) * b); o.w = pk2(bflo(kx.w) * b, bfhi(kx.w) * b);
            *(LAS v4u*)(kbS + row * 272 + ch * 16) = o; }
        G1_BAR();
        { const int which = wave >> 2, ti = (wave >> 1) & 1, tj = wave & 1;
          f32x16 acc;
#pragma unroll
          for (int r = 0; r < 16; ++r) acc[r] = 0.f;
          if (!(ti == 0 && tj == 1)) { const LAS unsigned char* Ab = (which == 0 ? kbS : qS) + (32 * ti + l31) * 272 + 16 * h; const LAS unsigned char* Bb = kS + (32 * tj + l31) * 272 + 16 * h;
#pragma unroll
              for (int s = 0; s < 8; ++s) acc = MFMA32(*(const LAS bf16x8*)(Ab + 32 * s), *(const LAS bf16x8*)(Bb + 32 * s), acc); }
          const int j = 32 * tj + l31; const float gj = gcS[j];
#pragma unroll
          for (int r = 0; r < 16; ++r) { const int i = 32 * ti + crow(r, h); const float e = __expf(fminf(gcS[i] - gj, 0.f));
              if (which == 0) Lm[i * 68 + j] = i > j ? acc[r] * e : 0.f;
              else IS[i * 72 + j] = (bf16)f2bf(i >= j ? acc[r] * e : 0.f); } }
        G1_BAR();
#pragma unroll
        for (int i = 0; i < 8; ++i) { const int e = tid + 512 * i, r = e >> 6, c = e & 63; *(LAS bf16*)(Lb + r * 144 + c * 2) = (bf16)f2bf(Lm[r * 68 + c]); }
        if (wave == 0) { const int b = lane >> 4, c = lane & 15; float t[16]; const LAS float* Ld = Lm + (16 * b) * 68 + 16 * b;
            t[0] = c == 0 ? 1.f : 0.f; *(LAS bf16*)(TDs + (b * 16) * 32 + c * 2) = (bf16)f2bf(t[0]);
#define G1_INV_ROWS(I0, I1) do { f32x4 Lr[(I1) - (I0)][4]; \
            _Pragma("unroll") for (int i = (I0); i < (I1); ++i) _Pragma("unroll") for (int q = 0; q < (i + 3) / 4; ++q) Lr[i - (I0)][q] = *(const LAS f32x4*)(Ld + i * 68 + 4 * q); \
            _Pragma("unroll") for (int i = (I0); i < (I1); ++i) { float a0 = i == c ? 1.f : 0.f, a1 = 0.f; \
                _Pragma("unroll") for (int j = 0; j < i; ++j) { const float lv = Lr[i - (I0)][j >> 2][j & 3]; if (j & 1) a1 -= lv * t[j]; else a0 -= lv * t[j]; } \
                t[i] = a0 + a1; *(LAS bf16*)(TDs + (b * 16 + i) * 32 + c * 2) = (bf16)f2bf(t[i]); } } while (0)
            G1_INV_ROWS(1, 9); G1_INV_ROWS(9, 13); G1_INV_ROWS(13, 16);
#undef G1_INV_ROWS
        } else if (wave >= 4) { const int t2 = tid - 256;
#pragma unroll
            for (int i = 0; i < 2; ++i) { const int p = t2 + 256 * i, comb = p >> 6, ln = p & 63, t = comb >> 2, s = comb & 3; const int c = 32 * t + (ln & 31), j0 = 16 * s + 8 * (ln >> 5);
                *(v4u*)(INF + (su * 8 + comb) * 512 + ln * 8) = *(const LAS v4u*)(IS + c * 72 + j0); }
            if ((hv & 1) == 0) { const size_t kunit = (size_t)hk * GDN_NCH + n;
#pragma unroll
                for (int i = 0; i < 4; ++i) { const int p = t2 + 256 * i, comb = p >> 6, ln = p & 63, kt = comb >> 2, s = comb & 3; const int kd = 32 * kt + (ln & 31), c0 = 16 * s + 8 * (ln >> 5);
                    unsigned w[4];
#pragma unroll
                    for (int jj = 0; jj < 4; ++jj) { const unsigned lo = *(const LAS bf16*)(kS + (c0 + 2 * jj) * 272 + kd * 2), hi = *(const LAS bf16*)(kS + (c0 + 2 * jj + 1) * 272 + kd * 2); w[jj] = lo | (hi << 16); }
                    *(v4u*)(KTF + (kunit * 16 + comb) * 512 + ln * 8) = (v4u){w[0], w[1], w[2], w[3]}; } }
            if (t2 < 64) GC[su * GC_STRIDE + t2] = gcS[t2];
            else if (t2 == 64) GC[su * GC_STRIDE + 64] = gcS[63];
            else if (t2 == 65) GC[su * GC_STRIDE + 65] = egcS[63];
        }
        G1_BAR();
        { const int quad = lane >> 4, lc = lane & 15; LAS unsigned char* XTw = XT0 + wave * 1792; LAS unsigned char* YTw = YT0 + wave * 768;
          const bf16x8 z8 = (bf16x8){0, 0, 0, 0, 0, 0, 0, 0}; const f32x4 z4 = (f32x4){0.f, 0.f, 0.f, 0.f};
          bf16x8 tdf[4];
#pragma unroll
          for (int b = 0; b < 4; ++b) tdf[b] = quad < 2 ? *(const LAS bf16x8*)(TDs + (b * 16 + lc) * 32 + quad * 16) : z8;
#pragma unroll 1
          for (int tl = 0; tl < 2; ++tl) { const int col = 32 * wave + 16 * tl + lc;
              const LAS unsigned char* rz = wave < 4 ? vS + col * 2 : kbS + (col - 128) * 2; const LAS float* bz = wave < 4 ? betaS : egcS;
#pragma unroll
              for (int b = 0; b < 4; ++b) { f32x4 y;
#pragma unroll
                  for (int r = 0; r < 4; ++r) { const int i = 16 * b + 4 * quad + r; y[r] = bf2f(*(const LAS bf16*)(rz + i * 272)) * bz[i]; }
                  if (b >= 1) { f32x4 p = z4;
#pragma unroll
                      for (int kk = 0; kk < (b >= 3 ? 2 : 1); ++kk) { const bf16x8 af = *(const LAS bf16x8*)(Lb + (16 * b + lc) * 144 + (32 * kk + 8 * quad) * 2);
                          const bf16x8 bfv = (32 * kk + 8 * quad < 16 * b) ? *(const LAS bf16x8*)(XTw + lc * 112 + (32 * kk + 8 * quad) * 2) : z8;
                          p = __builtin_amdgcn_mfma_f32_16x16x32_bf16(af, bfv, p, 0, 0, 0); }
                      y = y - p; }
                  *(LAS v2u*)(YTw + lc * 48 + quad * 8) = (v2u){pk2(y[0], y[1]), pk2(y[2], y[3])};
                  asm volatile("" ::: "memory");
                  const bf16x8 yb = quad < 2 ? *(const LAS bf16x8*)(YTw + lc * 48 + quad * 16) : z8;
                  const f32x4 x = __builtin_amdgcn_mfma_f32_16x16x32_bf16(tdf[b], yb, z4, 0, 0, 0);
                  if (b < 3) *(LAS v2u*)(XTw + lc * 112 + (16 * b + 4 * quad) * 2) = (v2u){pk2(x[0], x[1]), pk2(x[2], x[3])};
                  asm volatile("" ::: "memory");
#pragma unroll
                  for (int r = 0; r < 4; ++r) XS[(16 * b + 4 * quad + r) * 264 + col] = (bf16)f2bf(x[r]); } } }
        G1_BAR();
#pragma unroll
        for (int i = 0; i < 2; ++i) { const int p = tid + 512 * i, comb = p >> 6, ln = p & 63, t = comb >> 3, s = comb & 7; const int c = 32 * t + (ln & 31), k0 = 16 * s + 8 * (ln >> 5);
            *(v4u*)(WF + (su * 16 + comb) * 512 + ln * 8) = *(const LAS v4u*)(XS + c * 264 + 128 + k0); }
        { const int t = wave >> 2, ns = wave & 3; unsigned w[8];
#pragma unroll
          for (int r = 0; r < 8; ++r) { const unsigned lo = XS[(32 * t + crow(2 * r, h)) * 264 + 32 * ns + l31], hi = XS[(32 * t + crow(2 * r + 1, h)) * 264 + 32 * ns + l31]; w[r] = lo | (hi << 16); }
          bf16* dst = UF + ((su * 8 + wave) * 64 + lane) * 16; *(v4u*)dst = (v4u){w[0], w[1], w[2], w[3]}; *(v4u*)(dst + 8) = (v4u){w[4], w[5], w[6], w[7]}; }
        G1_BAR();
    }
}

#undef G1_BAR
#undef G1_FETCH
DI void ph_gdn_chain(const Frame& F, const Args& a, int n_lo, int n_hi) {
    const int xg = F.vcu >> 5, wx = F.vcu & 31; if (F.G != 256 ? F.vcu >= 128 : wx >= 20) return;
    const bool helper = F.G == 256 && wx >= 16;
    const int hv = F.G == 256 ? 4 * xg + (helper ? wx - 16 : wx >> 2) : F.vcu >> 2, ns = F.G == 256 ? wx & 3 : F.vcu & 3, hk = hv >> 1;
    const bf16* QN = (const bf16*)(a.ws + WS_SCR + SC_QN);
    const bf16* WF = (const bf16*)(a.ws + GD_WF); const bf16* UF = (const bf16*)(a.ws + GD_UF); const bf16* INF = (const bf16*)(a.ws + GD_IN); const bf16* KTF = (const bf16*)(a.ws + GD_KT); const bf16* QF = (const bf16*)(a.ws + GD_QF); const float* GC = (const float*)(a.ws + GD_GC);
    bf16* O = (bf16*)(a.ws + WS_SCR + SC_O);
    gu32* prog = F.ctl + CW_PROG + hv * 16;
    if (helper && GDN_NO_HELPER) return;
    if (helper) { unsigned sink = 0u; const int tid = F.tid;
        for (int n0 = n_lo; n0 < n_hi; n0 += 4) {
            if (n0 >= n_lo + 8) { if (tid == 0) { unsigned sp = 0; while ((int)__hip_atomic_load(prog, RLX_AGENT) < n0 - 4 && ++sp < 20000u) __builtin_amdgcn_s_sleep(8); } __syncthreads(); }
            unsigned v[5];
#pragma unroll
            for (int i = 0; i < 5; ++i) { const int li = tid + 512 * i;
                const int st = li / 580, ln = li % 580, n = n0 + st; const unsigned* p = nullptr;
                if (st < 4 && n < n_hi) { const size_t unit = (size_t)hv * GDN_NCH + n, kunit = (size_t)hk * GDN_NCH + n;
                    if (ln < 128) p = (const unsigned*)(WF + unit * 8192 + ln * 64);
                    else if (ln < 256) p = (const unsigned*)(UF + unit * 8192 + (ln - 128) * 64);
                    else if (ln < 320) p = (const unsigned*)(INF + unit * 4096 + (ln - 256) * 64);
                    else if (ln < 448) p = (const unsigned*)(KTF + kunit * 8192 + (ln - 320) * 64);
                    else if (ln < 576) p = (const unsigned*)(QF + kunit * 8192 + (ln - 448) * 64);
                    else if (ln < 579) p = (const unsigned*)(GC + unit * GC_STRIDE + (ln - 576) * 32); }
                v[i] = p ? *p : 0u; }
#pragma unroll
            for (int i = 0; i < 5; ++i) sink += v[i];
        }
        if (sink == 0x12345u) __hip_atomic_store(F.ctl + CW_TMO + 2, sink, RLX_AGENT);
        return; }
    LAS unsigned char* ST = F.lds + RING_OFF; LAS unsigned char* VN = ST + 8704; LAS unsigned char* VND = ST + 13312;
    const int lane = F.lane, wave = F.wave, l31 = lane & 31, h = lane >> 5;
    for (int i = F.tid; i < 8704 / 4; i += NWAVES * 64) ((LAS unsigned*)ST)[i] = 0u;
#define GDN_BAR() do { asm volatile("s_waitcnt lgkmcnt(0)" ::: "memory"); __builtin_amdgcn_s_barrier(); asm volatile("" ::: "memory"); } while (0)
    GDN_BAR();
    f32x16 S;
#pragma unroll
    for (int r = 0; r < 16; ++r) S[r] = 0.f;
    const int role = wave < 2 ? 0 : (wave < 4 ? 1 : 2); const int t = wave & 1, kt = wave & 3;
    bf16x8 A8[8]; bf16x8 A4[4]; v4u U0 = (v4u){0u, 0u, 0u, 0u}, U1 = U0; f32x4 G4[4]; float gl = 0.f, egl = 1.f;
#pragma unroll
    for (int s = 0; s < 8; ++s) A8[s] = (bf16x8){0, 0, 0, 0, 0, 0, 0, 0};
#pragma unroll
    for (int s = 0; s < 4; ++s) { A4[s] = (bf16x8){0, 0, 0, 0, 0, 0, 0, 0}; G4[s] = (f32x4){0.f, 0.f, 0.f, 0.f}; }
#define GDN_LOAD(nn) do { const size_t unit_ = (size_t)hv * GDN_NCH + (nn); const float* gc_ = GC + unit_ * GC_STRIDE; \
        if (role == 0) { \
            const bf16* up_ = UF + (((unit_ * 2 + t) * 4 + ns) * 64 + lane) * 16; U0 = *(const v4u*)up_; U1 = *(const v4u*)(up_ + 8); \
            _Pragma("unroll") for (int g = 0; g < 4; ++g) G4[g] = *(const f32x4*)(gc_ + 32 * t + 8 * g + 4 * h); gl = gc_[64]; } \
        else if (role == 1) { const size_t qunit_ = (size_t)hk * GDN_NCH + (nn); \
            _Pragma("unroll") for (int s = 0; s < 4; ++s) A4[s] = *(const bf16x8*)(INF + ((unit_ * 2 + t) * 4 + s) * 512 + lane * 8); \
            _Pragma("unroll") for (int g = 0; g < 4; ++g) G4[g] = *(const f32x4*)(gc_ + 32 * t + 8 * g + 4 * h); } \
        else { const size_t kunit_ = (size_t)hk * GDN_NCH + (nn); \
            _Pragma("unroll") for (int s = 0; s < 4; ++s) A4[s] = *(const bf16x8*)(KTF + ((kunit_ * 4 + kt) * 4 + s) * 512 + lane * 8); egl = gc_[65]; } } while (0)
    float* SV = (float*)(a.ws + GD_SAVE) + ((size_t)((hv * 4 + ns) * 4 + kt) * 64 + lane) * 16;
    if (n_lo > 0 && role == 2) {
#pragma unroll
        for (int g = 0; g < 4; ++g) { const f32x4 v = *(const f32x4*)(SV + 4 * g); S[4 * g] = v.x; S[4 * g + 1] = v.y; S[4 * g + 2] = v.z; S[4 * g + 3] = v.w;
            *(LAS v2u*)(ST + l31 * 272 + (32 * kt + 8 * g + 4 * h) * 2) = (v2u){pk2(v.x, v.y), pk2(v.z, v.w)}; }
    }
    GDN_BAR();
#define GDN_LOADA(AC, nn) do { if (role == 0) { const size_t u_ = (size_t)hv * GDN_NCH + (nn); _Pragma("unroll") for (int s = 0; s < 8; ++s) AC[s] = *(const bf16x8*)(WF + ((u_ * 2 + t) * 8 + s) * 512 + lane * 8); } \
        else if (role == 1) { const size_t q_ = (size_t)hk * GDN_NCH + (nn); _Pragma("unroll") for (int s = 0; s < 8; ++s) AC[s] = *(const bf16x8*)(QF + ((q_ * 2 + t) * 8 + s) * 512 + lane * 8); } } while (0)
    bf16x8 A8q[8];
#pragma unroll
    for (int s = 0; s < 8; ++s) A8q[s] = (bf16x8){0, 0, 0, 0, 0, 0, 0, 0};
    GDN_LOADA(A8, n_lo); if (n_lo + 1 < n_hi) GDN_LOADA(A8q, n_lo + 1);
    GDN_LOAD(n_lo);
#define GDN_STEP(n, AC) do { \
        bf16x8 a4[4]; const v4u u0 = U0, u1 = U1; f32x4 g4[4]; const float cgl = gl, cegl = egl; \
        _Pragma("unroll") \
        for (int s = 0; s < 4; ++s) { a4[s] = A4[s]; g4[s] = G4[s]; } \
        if (n + 1 < n_hi) GDN_LOAD(n + 1); \
        if (ns == 0 && F.tid == 0) __hip_atomic_store(prog, (unsigned)n, RLX_AGENT); \
        f32x16 acc; \
        _Pragma("unroll") \
        for (int r = 0; r < 16; ++r) acc[r] = 0.f; \
        if (role < 2) { \
        _Pragma("unroll") \
            for (int s = 0; s < 8; ++s) acc = MFMA32(AC[s], *(const LAS bf16x8*)(ST + l31 * 272 + 32 * s + 16 * h), acc); \
            asm volatile("" :: "v"(acc[0])); \
            if (n + 2 < n_hi) GDN_LOADA(AC, n + 2); \
        } \
        if (role == 0) { const unsigned uw[8] = {u0.x, u0.y, u0.z, u0.w, u1.x, u1.y, u1.z, u1.w}; \
        _Pragma("unroll") \
            for (int g = 0; g < 4; ++g) { float vn[4], vd[4]; \
        _Pragma("unroll") \
                for (int q = 0; q < 4; ++q) { const int r = 4 * g + q; const float uv = (r & 1) ? bfhi(uw[r >> 1]) : bflo(uw[r >> 1]); vn[q] = uv - acc[r]; vd[q] = vn[q] * __expf(cgl - g4[g][q]); } \
                *(LAS v2u*)(VN + l31 * 144 + (32 * t + 8 * g + 4 * h) * 2) = (v2u){pk2(vn[0], vn[1]), pk2(vn[2], vn[3])}; \
                *(LAS v2u*)(VND + l31 * 144 + (32 * t + 8 * g + 4 * h) * 2) = (v2u){pk2(vd[0], vd[1]), pk2(vd[2], vd[3])}; } \
        } else if (role == 1) { \
        _Pragma("unroll") \
            for (int g = 0; g < 4; ++g) \
        _Pragma("unroll") \
                for (int q = 0; q < 4; ++q) acc[4 * g + q] *= __expf(g4[g][q]); \
        } \
        GDN_BAR(); \
        if (role == 1) { \
        _Pragma("unroll") \
            for (int s = 0; s < 4; ++s) acc = MFMA32(a4[s], *(const LAS bf16x8*)(VN + l31 * 144 + 32 * s + 16 * h), acc); \
        _Pragma("unroll") \
            for (int r = 0; r < 16; ++r) { const int rr = chunk_row(n, 32 * t + crow(r, h)); if (rr >= 0) O[(size_t)rr * 4096 + hv * 128 + 32 * ns + l31] = (bf16)f2bf(acc[r]); } \
        } else if (role == 2) { \
        _Pragma("unroll") \
            for (int r = 0; r < 16; ++r) S[r] *= cegl; \
        _Pragma("unroll") \
            for (int s = 0; s < 4; ++s) S = MFMA32(a4[s], *(const LAS bf16x8*)(VND + l31 * 144 + 32 * s + 16 * h), S); \
        _Pragma("unroll") \
            for (int g = 0; g < 4; ++g) *(LAS v2u*)(ST + l31 * 272 + (32 * kt + 8 * g + 4 * h) * 2) = (v2u){pk2(S[4 * g], S[4 * g + 1]), pk2(S[4 * g + 2], S[4 * g + 3])}; \
        } \
        GDN_BAR(); \
    } while (0)
    for (int n2 = n_lo; n2 < n_hi; n2 += 2) { GDN_STEP(n2, A8); if (n2 + 1 < n_hi) GDN_STEP(n2 + 1, A8q); }
#undef GDN_STEP
#undef GDN_LOADA
    if (n_hi < GDN_NCH && role == 2) {
#pragma unroll
        for (int g = 0; g < 4; ++g) *(f32x4*)(SV + 4 * g) = (f32x4){S[4 * g], S[4 * g + 1], S[4 * g + 2], S[4 * g + 3]}; }
#undef GDN_LOAD
#undef GDN_BAR
}

constexpr int RW_NSC = 258, RW_UNITS = 129 * 16;
DI int sub_row(int sc, int t) { const int n = sc >> 1, sub = sc & 1; return n == 0 ? ((sub == 0 && t >= 16) ? TX + t - 16 : -1) : 64 * (n - 1) + 32 * sub + t; }
constexpr size_t RW_BASE = WS_PROJ + 92 * MiB;
constexpr size_t RW_RH = RW_BASE, RW_RL = RW_BASE + 33 * MiB, RW_GT = RW_BASE + 66 * MiB, RW_GAM = RW_BASE + 99 * MiB;
constexpr size_t RW_PR = WS_SCR + 195 * MiB, RW_AT = WS_SCR + 211 * MiB + 256 * 1024, RW_VTF = WS_SCR + 219 * MiB + 512 * 1024, RW_SALL = WS_SCR + 235 * MiB + 768 * 1024;
constexpr size_t RW_XSAVE = 1 * MiB + 640 * 1024;
constexpr size_t RW_VV = WS_YMIX + 34 * MiB, RW_BON = WS_YMIX + 52 * MiB, LR_H = WS_YMIX + 54 * MiB, LR_A = WS_YMIX + 56 * MiB, LR_C = WS_YMIX + 58 * MiB;
constexpr size_t RW_SCH = (size_t)RW_NSC * 16;
static_assert((size_t)MP * EV_NP * 2 <= 92 * MiB && RW_SCH * 8192 <= 33 * MiB && RW_GAM + RW_SCH * 256 <= WS_SCR, "rwkv map (proj region)");
static_assert(WS_SCR + SC_LIX + (size_t)MP * 4096 <= RW_PR && RW_PR + RW_SCH * 4096 <= RW_AT && RW_AT + RW_SCH * 2048 <= RW_VTF && RW_VTF + RW_SCH * 4096 <= RW_SALL && RW_SALL + RW_SCH * 8192 <= WS_END, "rwkv map (scratch region)");
static_assert((size_t)MP * DM * 2 <= 34 * MiB && RW_VV + (size_t)MP * 2048 <= RW_BON && RW_BON + (size_t)MP * 64 <= LR_H && LR_H + RW_SCH * 256 <= LR_A && LR_A + RW_SCH * 256 <= LR_C && LR_C + RW_SCH * 256 <= WS_PROJ, "rwkv map (ymix region)");

DI void sub_rows(int sc, int& t0, int& rbase) { if (sc >= 2) { t0 = 0; rbase = 64 * ((sc >> 1) - 1) + 32 * (sc & 1); } else if (sc == 0) { t0 = 16; rbase = TX - 16; } else { t0 = 32; rbase = 0; } }
DI void lru_local(const Frame& F, const Args& a, int gw, int ngw) {
    const bf16* LA = (const bf16*)(a.ws + WS_SCR + SC_LA); const bf16* LIX = (const bf16*)(a.ws + WS_SCR + SC_LIX);
    float* HL = (float*)(a.ws + LR_H); float* AP = (float*)(a.ws + LR_A);
    for (int item = gw; item < RW_NSC * 16; item += ngw) { const int sc = item >> 4, c = (item & 15) * 64 + F.lane; int t0, rbase; sub_rows(sc, t0, rbase);
        float av[32], ix[32];
#pragma unroll
        for (int t = 0; t < 32; ++t) { const size_t o = (size_t)(rbase + (t >= t0 ? t : 32)) * 1024 + c; av[t] = bf2f(LA[o]); ix[t] = bf2f(LIX[o]); }
        float h = 0.f, p = 1.f;
#pragma unroll
        for (int t = 0; t < 32; ++t) { const float om = t >= t0 ? av[t] : 0.f, x_ = t >= t0 ? ix[t] : 0.f, a_ = 1.0f - om; h = a_ * h + sqrtf(om * (1.0f + a_)) * x_; p *= a_; }
        HL[sc * 1024 + c] = h; AP[sc * 1024 + c] = p; }
}
DI void lru_apply(const Frame& F, const Args& a) {
    const bf16* P = (const bf16*)(a.ws + WS_PROJ); const bf16* LA = (const bf16*)(a.ws + WS_SCR + SC_LA); const bf16* LIX = (const bf16*)(a.ws + WS_SCR + SC_LIX);
    const float* CR = (const float*)(a.ws + LR_C); bf16* Y = (bf16*)(a.ws + WS_YMIX);
    for (int item = F.gw; item < RW_NSC * 16; item += F.NGW) { const int sc = item >> 4, c = (item & 15) * 64 + F.lane; int t0, rbase; sub_rows(sc, t0, rbase); if (t0 >= 32) continue;
        float h = CR[sc * 1024 + c];
#pragma unroll
        for (int tb = 0; tb < 32; tb += 16) { float av[16], ix[16], gb[16];
#pragma unroll
            for (int t = 0; t < 16; ++t) { const size_t r_ = (size_t)(rbase + (tb + t >= t0 ? tb + t : 32)); av[t] = bf2f(LA[r_ * 1024 + c]); ix[t] = bf2f(LIX[r_ * 1024 + c]); gb[t] = bf2f(P[r_ * EV_NP + EV_GB + c]); }
#pragma unroll
            for (int t = 0; t < 16; ++t) { if (tb + t >= t0) { const float a_ = 1.0f - av[t]; h = a_ * h + sqrtf(av[t] * (1.0f + a_)) * ix[t]; Y[(size_t)(rbase + tb + t) * DM + 1024 + c] = (bf16)f2bf(h * gelu_tanh(gb[t])); } } } }
}

DI void ph_rwkv_chunk(const Frame& F, const Args& a, int n_lo, int n_hi, int wg0) {
    if (F.vcu < wg0) return;
    const bf16* P = (const bf16*)(a.ws + WS_PROJ); const bf16* DEC = (const bf16*)(a.ws + WS_SCR + SC_DEC); const bf16* ICL = (const bf16*)(a.ws + WS_SCR + SC_ICL);
    bf16* RH = (bf16*)(a.ws + RW_RH); bf16* RL = (bf16*)(a.ws + RW_RL); bf16* GT = (bf16*)(a.ws + RW_GT); float* GAM = (float*)(a.ws + RW_GAM); bf16* PR = (bf16*)(a.ws + RW_PR); bf16* ATG = (bf16*)(a.ws + RW_AT); bf16* VTF = (bf16*)(a.ws + RW_VTF);
    bf16* VV = (bf16*)(a.ws + RW_VV); float* BON = (float*)(a.ws + RW_BON);
    LAS unsigned char* L = F.lds + RING_OFF;
    LAS float* wS = (LAS float*)L; LAS float* aS = wS + 4096; LAS float* bS = wS + 8192; LAS float* rS = wS + 12288; LAS float* kS = wS + 16384;
    LAS unsigned char* vT = L + 81920; LAS unsigned char* aT = L + 91136; LAS unsigned char* rT = L + 100352; LAS unsigned char* kT = L + 109568; LAS unsigned char* bT = L + 118784;
    LAS unsigned char* AT = L + 128000; LAS unsigned char* NT = L + 133120; LAS float* gam = (LAS float*)(L + 138240);
    LAS unsigned char* aTl = L; LAS unsigned char* bTl = L + 9216;
    const int tid = F.tid, lane = F.lane, wave = F.wave, l31 = lane & 31, h = lane >> 5;
    const float* mu = a.in[6];
    for (int unit = n_lo * 16 + (F.vcu - wg0); unit < n_hi * 16; unit += F.G - wg0) {
        const int n = unit >> 4, hd = unit & 15;
#ifdef R1_REP_A
        _Pragma("unroll 1") for (int rep_ = 0; rep_ < 2; ++rep_)
#endif
        { const int tok = tid >> 3, cg = tid & 7, c0 = hd * 64 + cg * 8; const int rr = sub_row(2 * n + (tok >> 5), tok & 31);
          float wv[8], av[8], bv[8], rv[8], kv[8], vv[8];
#pragma unroll
          for (int q = 0; q < 8; ++q) { wv[q] = 1.f; av[q] = 0.f; bv[q] = 0.f; rv[q] = 0.f; kv[q] = 0.f; vv[q] = 0.f; }
          if (rr >= 0) { const int pos = row_pos(rr); const bf16* cur = P + (size_t)rr * EV_NP + c0; const bf16* prv = pos > 0 ? P + (size_t)pos_row(pos - 1) * EV_NP + c0 : nullptr;
              const v4u z4 = (v4u){0u, 0u, 0u, 0u};
              const v4u cr = *(const v4u*)cur, ck = *(const v4u*)(cur + 1024), cv = *(const v4u*)(cur + 2048);
              const v4u qr = prv ? *(const v4u*)prv : z4, qk = prv ? *(const v4u*)(prv + 1024) : z4, qv = prv ? *(const v4u*)(prv + 2048) : z4;
              const unsigned crw[4] = {cr.x, cr.y, cr.z, cr.w}, ckw[4] = {ck.x, ck.y, ck.z, ck.w}, cvw[4] = {cv.x, cv.y, cv.z, cv.w}, qrw[4] = {qr.x, qr.y, qr.z, qr.w}, qkw[4] = {qk.x, qk.y, qk.z, qk.w}, qvw[4] = {qv.x, qv.y, qv.z, qv.w};
              float ss = 0.f, bon = 0.f; float kk[8], ic[8];
#pragma unroll
              for (int q = 0; q < 8; ++q) { const int c = c0 + q; const float crf = (q & 1) ? bfhi(crw[q >> 1]) : bflo(crw[q >> 1]), ckf = (q & 1) ? bfhi(ckw[q >> 1]) : bflo(ckw[q >> 1]), cvf = (q & 1) ? bfhi(cvw[q >> 1]) : bflo(cvw[q >> 1]);
                  const float prf = (q & 1) ? bfhi(qrw[q >> 1]) : bflo(qrw[q >> 1]), pkf = (q & 1) ? bfhi(qkw[q >> 1]) : bflo(qkw[q >> 1]), pvf = (q & 1) ? bfhi(qvw[q >> 1]) : bflo(qvw[q >> 1]);
                  rv[q] = crf + (prf - crf) * mu[c]; kk[q] = ckf + (pkf - ckf) * mu[1024 + c]; vv[q] = cvf + (pvf - cvf) * mu[2048 + c];
                  wv[q] = 1.0f - bf2f(DEC[(size_t)rr * 1024 + c]); ic[q] = bf2f(ICL[(size_t)rr * 1024 + c]);
                  const float kkv = kk[q] * a.in[12][c]; av[q] = kkv; ss += kkv * kkv; kv[q] = kk[q] * (1.0f + (ic[q] - 1.0f) * a.in[13][c]); bon += rv[q] * kv[q] * a.in[14][c]; }
              ss += __shfl_xor(ss, 1); ss += __shfl_xor(ss, 2); ss += __shfl_xor(ss, 4); bon += __shfl_xor(bon, 1); bon += __shfl_xor(bon, 2); bon += __shfl_xor(bon, 4);
              const float inv = 1.0f / fmaxf(sqrtf(ss), 1e-12f);
#pragma unroll
              for (int q = 0; q < 8; ++q) { const float kkn = av[q] * inv; av[q] = -kkn; bv[q] = kkn * ic[q]; }
              if (cg == 0) BON[(size_t)rr * 16 + hd] = bon;
              *(v4u*)(VV + (size_t)rr * 1024 + c0) = (v4u){pk2(vv[0], vv[1]), pk2(vv[2], vv[3]), pk2(vv[4], vv[5]), pk2(vv[6], vv[7])}; }
          const int o = tok * 64 + cg * 8;
          *(LAS f32x4*)(wS + o) = (f32x4){wv[0], wv[1], wv[2], wv[3]}; *(LAS f32x4*)(wS + o + 4) = (f32x4){wv[4], wv[5], wv[6], wv[7]};
          *(LAS f32x4*)(aS + o) = (f32x4){av[0], av[1], av[2], av[3]}; *(LAS f32x4*)(aS + o + 4) = (f32x4){av[4], av[5], av[6], av[7]};
          *(LAS f32x4*)(bS + o) = (f32x4){bv[0], bv[1], bv[2], bv[3]}; *(LAS f32x4*)(bS + o + 4) = (f32x4){bv[4], bv[5], bv[6], bv[7]};
          *(LAS f32x4*)(rS + o) = (f32x4){rv[0], rv[1], rv[2], rv[3]}; *(LAS f32x4*)(rS + o + 4) = (f32x4){rv[4], rv[5], rv[6], rv[7]};
          *(LAS f32x4*)(kS + o) = (f32x4){kv[0], kv[1], kv[2], kv[3]}; *(LAS f32x4*)(kS + o + 4) = (f32x4){kv[4], kv[5], kv[6], kv[7]};
#pragma unroll
          for (int q = 0; q < 8; ++q) *(LAS bf16*)(vT + (cg * 8 + q) * 144 + tok * 2) = (bf16)f2bf(vv[q]); }
        __syncthreads();
#ifdef R1_REP_B
        _Pragma("unroll 1") for (int rep_ = 0; rep_ < 2; ++rep_)
#endif
        { const int p = wave >> 2, sub = (wave >> 1) & 1, half = (wave & 1) ^ p, sl = lane >> 2, q = lane & 3, s = 16 * half + sl, tok = 32 * sub + s, jq = 16 * q;
          const LAS float* x0p = (p == 0 ? kS : bS) + tok * 64 + jq; LAS unsigned char* OUT = p == 0 ? AT : NT;
          float x[16];
#pragma unroll
          for (int j = 0; j < 16; j += 4) { const f32x4 t4 = *(const LAS f32x4*)(x0p + j); x[j] = t4.x; x[j + 1] = t4.y; x[j + 2] = t4.z; x[j + 3] = t4.w; }
          if (half) {
#pragma unroll
              for (int i = 0; i < 4; ++i) *(LAS bf16*)(OUT + ((sub * 32 + 4 * q + i) * 40 + s) * 2) = (bf16)0; }
#pragma unroll 2
          for (int tp = 16 * half; tp < 32; ++tp) { const LAS float* bp = wS + (32 * sub + tp) * 64 + jq; const bool run = tp > s;
              f32x4 a4[4], w4[4], b4[4], r4[4];
#pragma unroll
              for (int g = 0; g < 4; ++g) { a4[g] = *(const LAS f32x4*)(bp + 4096 + 4 * g); w4[g] = *(const LAS f32x4*)(bp + 4 * g); b4[g] = *(const LAS f32x4*)(bp + 8192 + 4 * g); r4[g] = *(const LAS f32x4*)(bp + 12288 + 4 * g); }
              float c = 0.f;
#pragma unroll
              for (int g = 0; g < 4; ++g) { c += x[4 * g] * a4[g].x; c += x[4 * g + 1] * a4[g].y; c += x[4 * g + 2] * a4[g].z; c += x[4 * g + 3] * a4[g].w; }
              c += __builtin_bit_cast(float, __builtin_amdgcn_mov_dpp(__builtin_bit_cast(int, c), 0xB1, 0xF, 0xF, true));
              c += __builtin_bit_cast(float, __builtin_amdgcn_mov_dpp(__builtin_bit_cast(int, c), 0x4E, 0xF, 0xF, true));
              float o = 0.f;
#pragma unroll
              for (int g = 0; g < 4; ++g) { const float n0 = x[4 * g] * w4[g].x + c * b4[g].x, n1 = x[4 * g + 1] * w4[g].y + c * b4[g].y, n2 = x[4 * g + 2] * w4[g].z + c * b4[g].z, n3 = x[4 * g + 3] * w4[g].w + c * b4[g].w;
                  x[4 * g] = run ? n0 : x[4 * g]; x[4 * g + 1] = run ? n1 : x[4 * g + 1]; x[4 * g + 2] = run ? n2 : x[4 * g + 2]; x[4 * g + 3] = run ? n3 : x[4 * g + 3];
                  o += x[4 * g] * r4[g].x; o += x[4 * g + 1] * r4[g].y; o += x[4 * g + 2] * r4[g].z; o += x[4 * g + 3] * r4[g].w; }
              o += __builtin_bit_cast(float, __builtin_amdgcn_mov_dpp(__builtin_bit_cast(int, o), 0xB1, 0xF, 0xF, true));
              o += __builtin_bit_cast(float, __builtin_amdgcn_mov_dpp(__builtin_bit_cast(int, o), 0x4E, 0xF, 0xF, true));
              if (q == 0) *(LAS bf16*)(OUT + ((sub * 32 + tp) * 40 + s) * 2) = (bf16)f2bf(tp >= s ? o : 0.f); }
          LAS unsigned char* XT = p == 0 ? kT : bT;
#pragma unroll
          for (int j = 0; j < 16; ++j) *(LAS bf16*)(XT + (jq + j) * 144 + tok * 2) = (bf16)f2bf(x[j]);
          const bool gwave = (p == 0 && half == 1); const int j = lane;
          if (gwave) { float g = 1.f;
#pragma unroll
              for (int tp = 0; tp < 32; ++tp) { const int tk = 32 * sub + tp; const float w_ = wS[tk * 64 + j], a_ = aS[tk * 64 + j], r_ = rS[tk * 64 + j];
                  *(LAS bf16*)(aT + j * 144 + tk * 2) = (bf16)f2bf(a_ * g);
                  g *= w_; *(LAS bf16*)(rT + j * 144 + tk * 2) = (bf16)f2bf(r_ * g); }
              gam[sub * 64 + j] = g; }
        }
        __syncthreads();
#ifdef R1_REP_C
        _Pragma("unroll 1") for (int rep_ = 0; rep_ < 2; ++rep_) {
#endif
        { const int sub = wave >> 2, t1 = (wave >> 1) & 1, t0 = wave & 1; const size_t sch = (size_t)hd * RW_NSC + (2 * n + sub);
          { f32x16 acc;
#pragma unroll
            for (int r = 0; r < 16; ++r) acc[r] = 0.f;
#pragma unroll
            for (int ks = 0; ks < 2; ++ks) { const int ao = (32 * t1 + l31) * 144 + (32 * sub + 16 * ks + 8 * h) * 2, bo = (32 * t0 + l31) * 144 + (32 * sub + 16 * ks + 8 * h) * 2;
                acc = MFMA32(*(const LAS bf16x8*)(aT + ao), *(const LAS bf16x8*)(bT + bo), acc); }
            const int jp = 32 * t0 + l31;
#pragma unroll
            for (int g = 0; g < 4; ++g) *(v2u*)(RH + (sch * 64 + jp) * 64 + 32 * t1 + 8 * g + 4 * h) = (v2u){pk2(acc[4 * g], acc[4 * g + 1]), pk2(acc[4 * g + 2], acc[4 * g + 3])};
            if (t1 == 0 && t0 == 0) GAM[sch * 64 + lane] = gam[sub * 64 + lane]; }
          { f32x16 acc;
#pragma unroll
            for (int r = 0; r < 16; ++r) acc[r] = 0.f;
#pragma unroll
            for (int ks = 0; ks < 2; ++ks) acc = MFMA32(*(const LAS bf16x8*)(kT + (32 * t1 + l31) * 144 + (32 * sub + 16 * ks + 8 * h) * 2), *(const LAS bf16x8*)(vT + (32 * t0 + l31) * 144 + (32 * sub + 16 * ks + 8 * h) * 2), acc);
            bf16* dst = GT + ((sch * 4 + t1 * 2 + t0) * 64 + lane) * 16;
            *(v4u*)dst = (v4u){pk2(acc[0], acc[1]), pk2(acc[2], acc[3]), pk2(acc[4], acc[5]), pk2(acc[6], acc[7])}; *(v4u*)(dst + 8) = (v4u){pk2(acc[8], acc[9]), pk2(acc[10], acc[11]), pk2(acc[12], acc[13]), pk2(acc[14], acc[15])}; } }
        if (wave < 4) { const int sub = wave >> 1, jt = wave & 1; const size_t sch = (size_t)hd * RW_NSC + (2 * n + sub);
            f32x16 acc;
#pragma unroll
            for (int r = 0; r < 16; ++r) acc[r] = bf2f(*(const LAS bf16*)(rT + (32 * jt + crow(r, h)) * 144 + (32 * sub + l31) * 2));
#pragma unroll
            for (int ks = 0; ks < 2; ++ks) acc = MFMA32(*(const LAS bf16x8*)(aT + (32 * jt + l31) * 144 + (32 * sub + 16 * ks + 8 * h) * 2), *(const LAS bf16x8*)(NT + (sub * 32 + l31) * 80 + (16 * ks + 8 * h) * 2), acc);
#pragma unroll
            for (int g = 0; g < 4; ++g) *(v2u*)(PR + (sch * 32 + l31) * 64 + 32 * jt + 8 * g + 4 * h) = (v2u){pk2(acc[4 * g], acc[4 * g + 1]), pk2(acc[4 * g + 2], acc[4 * g + 3])};
        } else { const int t2 = tid - 256, sub = t2 >> 7, t = (t2 >> 2) & 31, s8 = (t2 & 3) * 8; const size_t sch = (size_t)hd * RW_NSC + (2 * n + sub);
            *(v4u*)(ATG + (sch * 32 + t) * 32 + s8) = *(const LAS v4u*)(AT + (sub * 32 + t) * 80 + s8 * 2); }
        { const int sub = tid >> 8, it = (tid >> 7) & 1, ks = (tid >> 6) & 1; const size_t sch = (size_t)hd * RW_NSC + (2 * n + sub);
          *(v4u*)(VTF + ((sch * 4 + it * 2 + ks) * 64 + lane) * 8) = *(const LAS v4u*)(vT + (32 * it + l31) * 144 + (32 * sub + 16 * ks + 8 * h) * 2); }
#ifdef R1_REP_C
        }
#endif
        __syncthreads();
    }
}

DI void ph_rwkv_chain(const Frame& F, const Args& a, int sc_lo, int sc_hi) {
    if (F.vcu >= 16 && F.vcu < 18) { if (sc_hi < RW_NSC) return; const int c = (F.vcu - 16) * 512 + F.tid; const float* HL = (const float*)(a.ws + LR_H); const float* AP = (const float*)(a.ws + LR_A); float* CR = (float*)(a.ws + LR_C);
        float carry = 0.f;
#pragma unroll 8
        for (int sc = 0; sc < RW_NSC; ++sc) { const float hl = HL[sc * 1024 + c], ap = AP[sc * 1024 + c]; CR[sc * 1024 + c] = carry; carry = ap * carry + hl; }
        return; }
    if (F.vcu >= 16) return;
    const int hd = F.vcu; const bf16* RH = (const bf16*)(a.ws + RW_RH); const bf16* RL = (const bf16*)(a.ws + RW_RL); const bf16* GT = (const bf16*)(a.ws + RW_GT); const float* GAM = (const float*)(a.ws + RW_GAM); bf16* SALL = (bf16*)(a.ws + RW_SALL);
    constexpr int RW_NS = 7, SLOT = 8192 + 8192 + 1024;
    LAS unsigned char* XS = F.lds + RING_OFF; LAS unsigned char* RG = XS + 2 * 9216;
    const int lane = F.lane, wave = F.wave, l31 = lane & 31, h = lane >> 5, jt = (wave >> 1) & 1, it = wave & 1, lw = wave & 3;
    for (int i = F.tid; i < 2 * 9216 / 4; i += NWAVES * 64) ((LAS unsigned*)XS)[i] = 0u;
    __syncthreads();
#define RW_BAR() do { asm volatile("s_waitcnt lgkmcnt(0)" ::: "memory"); __builtin_amdgcn_s_barrier(); asm volatile("" ::: "memory"); } while (0)
    const unsigned rg0 = (unsigned)(uintptr_t)RG;
    int offR[4], offG[4]; const int lw2 = wave & 1;
#pragma unroll
    for (int i = 0; i < 4; ++i) { const int b = 4 * lw2 + i, row = 8 * b + (lane >> 3), pc = lane & 7; offR[i] = row * 64 + ((pc ^ (row & 7)) * 8); offG[i] = (b * 64 + lane) * 8; }
    const int offM = (lane & 15) * 4;
#define RW_DMA(src, dst) do { unsigned keep_; asm volatile("s_mov_b32 %0, m0\n\ts_mov_b32 m0, %2\n\ts_nop 0\n\tglobal_load_lds_dwordx4 %1, off\n\ts_mov_b32 m0, %0" : "=&s"(keep_) : "v"(src), "s"(dst) : "memory"); } while (0)
#define RW_ISSUE(scn) do { const int s_ = (scn) < RW_NSC ? (scn) : RW_NSC - 1; const size_t sch_ = (size_t)hd * RW_NSC + s_; \
        const unsigned sb_ = (unsigned)__builtin_amdgcn_readfirstlane((int)(rg0 + (unsigned)((scn) % RW_NS) * SLOT)); \
        _Pragma("unroll") for (int i_ = 0; i_ < 4; ++i_) { const unsigned bo_ = (unsigned)__builtin_amdgcn_readfirstlane((4 * lw2 + i_) * 1024); \
            RW_DMA(RH + sch_ * 4096 + offR[i_], sb_ + bo_); RW_DMA(GT + sch_ * 4096 + offG[i_], sb_ + 8192 + bo_); } \
        RW_DMA(GAM + sch_ * 64 + offM, sb_ + 16384); } while (0)
#define RW_WAITV(n) asm volatile("s_waitcnt vmcnt(" #n ")" ::: "memory")
    f32x16 X;
#pragma unroll
    for (int r = 0; r < 16; ++r) X[r] = 0.f;
    float* XSV = (float*)(a.ws + RW_XSAVE) + ((size_t)(hd * 4 + (wave & 3)) * 64 + lane) * 16;
    if (wave < 4 && sc_lo > 0) {
#pragma unroll
        for (int g = 0; g < 4; ++g) { const f32x4 v = *(const f32x4*)(XSV + 4 * g); X[4 * g] = v.x; X[4 * g + 1] = v.y; X[4 * g + 2] = v.z; X[4 * g + 3] = v.w;
            *(LAS v2u*)(XS + (32 * it + l31) * 144 + (32 * jt + 8 * g + 4 * h) * 2) = (v2u){pk2(v.x, v.y), pk2(v.z, v.w)}; } }
    if (wave == 4 || wave == 5) { RW_ISSUE(sc_lo); RW_ISSUE(sc_lo + 1); RW_ISSUE(sc_lo + 2); RW_ISSUE(sc_lo + 3); RW_ISSUE(sc_lo + 4); RW_ISSUE(sc_lo + 5); RW_WAITV(45); }
    RW_BAR();
    for (int sc = sc_lo; sc < sc_hi; ++sc) {
        if (wave < 4) {
            const LAS unsigned char* sb = RG + (sc % RW_NS) * SLOT;
            f32x16 acc; const size_t sch = (size_t)hd * RW_NSC + sc;
            { const v4u g0 = *(const LAS v4u*)(sb + 8192 + ((jt * 2 + it) * 64 + lane) * 32), g1 = *(const LAS v4u*)(sb + 8192 + ((jt * 2 + it) * 64 + lane) * 32 + 16);
              const unsigned gw_[8] = {g0.x, g0.y, g0.z, g0.w, g1.x, g1.y, g1.z, g1.w};
#pragma unroll
              for (int g = 0; g < 4; ++g) { const f32x4 m = *(const LAS f32x4*)(sb + 16384 + (32 * jt + 8 * g + 4 * h) * 4);
                  acc[4 * g] = bflo(gw_[2 * g]) + m.x * X[4 * g]; acc[4 * g + 1] = bfhi(gw_[2 * g]) + m.y * X[4 * g + 1]; acc[4 * g + 2] = bflo(gw_[2 * g + 1]) + m.z * X[4 * g + 2]; acc[4 * g + 3] = bfhi(gw_[2 * g + 1]) + m.w * X[4 * g + 3]; } }
            const LAS unsigned char* xb = XS + (sc & 1) * 9216 + (32 * it + l31) * 144 + 16 * h; const int ar = 32 * jt + l31; const LAS unsigned char* ab = sb + ar * 128;
#pragma unroll
            for (int ks = 0; ks < 4; ++ks) { const bf16x8 xf = *(const LAS bf16x8*)(xb + 32 * ks); const int po = (((2 * ks + h) ^ (ar & 7)) * 16);
                acc = MFMA32(*(const LAS bf16x8*)(ab + po), xf, acc); }
            X = acc;
            LAS unsigned char* xn = XS + ((sc + 1) & 1) * 9216 + (32 * it + l31) * 144;
#pragma unroll
            for (int g = 0; g < 4; ++g) *(LAS v2u*)(xn + (32 * jt + 8 * g + 4 * h) * 2) = (v2u){pk2(X[4 * g], X[4 * g + 1]), pk2(X[4 * g + 2], X[4 * g + 3])};
        } else if (wave < 6) {
            RW_ISSUE(sc + RW_NS - 1);
            RW_WAITV(45);
        } else {
            const LAS unsigned char* xi = XS + (sc & 1) * 9216; bf16* so = SALL + ((size_t)hd * RW_NSC + sc) * 4096;
#pragma unroll
            for (int q = 0; q < 4; ++q) { const int pc = (wave & 1) * 256 + 64 * q + lane, row = pc >> 3, ch = pc & 7; *(v4u*)(so + row * 64 + ch * 8) = *(const LAS v4u*)(xi + row * 144 + ch * 16); }
        }
        RW_BAR();
    }
    if (wave == 4 || wave == 5) RW_WAITV(0);
    else if (wave < 4 && sc_hi < RW_NSC) {
#pragma unroll
        for (int g = 0; g < 4; ++g) *(f32x4*)(XSV + 4 * g) = (f32x4){X[4 * g], X[4 * g + 1], X[4 * g + 2], X[4 * g + 3]}; }
#undef RW_ISSUE
#undef RW_DMA
#undef RW_WAITV
#undef RW_BAR
}

DI f32x4 ld_bf4(const bf16* p) { const v2u w = *(const v2u*)p; return (f32x4){bflo(w.x), bfhi(w.x), bflo(w.y), bfhi(w.y)}; }
DI void ph_rwkv_out(const Frame& F, const Args& a, int sc_lo, int sc_hi, int gw, int ngw) {
    const bf16* SALL = (const bf16*)(a.ws + RW_SALL); const bf16* PR = (const bf16*)(a.ws + RW_PR); const bf16* ATG = (const bf16*)(a.ws + RW_AT); const bf16* VTF = (const bf16*)(a.ws + RW_VTF);
    const bf16* VV = (const bf16*)(a.ws + RW_VV); const float* BON = (const float*)(a.ws + RW_BON); const bf16* GATE = (const bf16*)(a.ws + WS_SCR + SC_GATE); bf16* Y = (bf16*)(a.ws + WS_YMIX);
    const int lane = F.lane, l31 = lane & 31, h = lane >> 5;
    for (int item = sc_lo * 16 + gw; item < sc_hi * 16; item += ngw) { const int sc = item >> 4, hd = item & 15; if (sc == 1) continue;
        const size_t sch = (size_t)hd * RW_NSC + sc; f32x16 acc[2];
#pragma unroll
        for (int it = 0; it < 2; ++it) {
#pragma unroll
            for (int r = 0; r < 16; ++r) acc[it][r] = 0.f;
#pragma unroll
            for (int ks = 0; ks < 4; ++ks) acc[it] = MFMA32(*(const bf16x8*)(SALL + (sch * 64 + 32 * it + l31) * 64 + 16 * ks + 8 * h), *(const bf16x8*)(PR + (sch * 32 + l31) * 64 + 16 * ks + 8 * h), acc[it]);
#pragma unroll
            for (int ks = 0; ks < 2; ++ks) acc[it] = MFMA32(*(const bf16x8*)(VTF + ((sch * 4 + it * 2 + ks) * 64 + lane) * 8), *(const bf16x8*)(ATG + (sch * 32 + l31) * 32 + 16 * ks + 8 * h), acc[it]); }
        float s1 = 0.f;
#pragma unroll
        for (int it = 0; it < 2; ++it)
#pragma unroll
            for (int r = 0; r < 16; ++r) s1 += acc[it][r];
        s1 += __shfl_xor(s1, 32); const float mean = s1 * (1.0f / 64.0f); float s2 = 0.f;
#pragma unroll
        for (int it = 0; it < 2; ++it)
#pragma unroll
            for (int r = 0; r < 16; ++r) { const float d = acc[it][r] - mean; s2 += d * d; }
        s2 += __shfl_xor(s2, 32); const float rstd = 1.0f / sqrtf(s2 * (1.0f / 64.0f) + 64e-5f);
        const int rr = sub_row(sc, l31);
        if (rr >= 0) { const float bon = BON[(size_t)rr * 16 + hd];
#pragma unroll
            for (int it = 0; it < 2; ++it)
#pragma unroll
                for (int g = 0; g < 4; ++g) { const int c = hd * 64 + 32 * it + 8 * g + 4 * h;
                    const f32x4 lw = *(const f32x4*)(a.in[15] + c), lb = *(const f32x4*)(a.in[16] + c), gt = ld_bf4(GATE + (size_t)rr * 1024 + c); const v2u vw = *(const v2u*)(VV + (size_t)rr * 1024 + c);
                    const float o0 = ((acc[it][4 * g] - mean) * rstd * lw.x + lb.x + bon * bflo(vw.x)) * gt.x, o1 = ((acc[it][4 * g + 1] - mean) * rstd * lw.y + lb.y + bon * bfhi(vw.x)) * gt.y;
                    const float o2 = ((acc[it][4 * g + 2] - mean) * rstd * lw.z + lb.z + bon * bflo(vw.y)) * gt.z, o3 = ((acc[it][4 * g + 3] - mean) * rstd * lw.w + lb.w + bon * bfhi(vw.y)) * gt.w;
                    *(v2u*)(Y + (size_t)rr * DM + c) = (v2u){pk2(o0, o1), pk2(o2, o3)}; } }
    }
}

constexpr int N_PHASES = 33;
template <class Epi, class Sched> DI void run_gemm(const Frame& F, const pg8::Gemm& g, const Sched& S, const Epi& E) {
    pg8::gemm_phase<Epi, Sched, true, true>(F.lds + RING_OFF, g, S, E);
}
DI void moe_up_units(const Frame& F, const Args& a, int t0, int ntl, int G, int c) {
    pg8::Gemm g{(const bf16*)(a.ws + WS_SCR + SC_XG), (const bf16*)(a.ws + WS_MOEW), DM, DM, DM};
    pg8::MoeOrder S{(const int*)(a.ws + WS_TILES), t0, ntl, 4, G, c, (long)MOE_E_BYTES};
    pg8::EpiSwiglu E{(bf16*)(a.ws + WS_SCR + SC_ACT), FF};
    run_gemm(F, g, S, E);
}
DI void moe_down_units(const Frame& F, const Args& a, int t0, int ntl, int G, int c) {
    pg8::Gemm g{(const bf16*)(a.ws + WS_SCR + SC_ACT), (const bf16*)(a.ws + WS_MOEW + MOE_W2_OFF), FF, FF, FF};
    pg8::MoeOrder S{(const int*)(a.ws + WS_TILES), t0, ntl, 8, G, c, (long)MOE_E_BYTES};
    pg8::EpiBf16 E{(bf16*)(a.ws + WS_SCR + SC_YB), DM};
    run_gemm(F, g, S, E);
}
DI void ph_moe_a(const Frame& F, const Args& a) {
    const int nt = (int)__hip_atomic_load((gu32*)(a.ws + WS_TILES) + 127, RLX_AGENT), n1 = nt < 64 ? nt : 64;
    moe_up_units(F, a, 0, n1, F.G, (int)blockIdx.x);
}
DI void ph_moe_b(const Frame& F, const Args& a) {
    const int nt = (int)__hip_atomic_load((gu32*)(a.ws + WS_TILES) + 127, RLX_AGENT), n1 = nt < 64 ? nt : 64; const int c = (int)blockIdx.x;
    int nu = 4 * (nt - n1); if (nu > F.G / 2) nu = F.G / 2;
    if (c < nu) moe_up_units(F, a, n1, nt - n1, nu, c); else moe_down_units(F, a, 0, n1, F.G - nu, c - nu);
}
DI void ph_moe_c(const Frame& F, const Args& a) {
    const int nt = (int)__hip_atomic_load((gu32*)(a.ws + WS_TILES) + 127, RLX_AGENT), n1 = nt < 64 ? nt : 64;
    moe_down_units(F, a, n1, nt - n1, F.G, (int)blockIdx.x);
}

DI void gemm_tail16(const Frame& F, const Args& a, const bf16* A, int lda, const bf16* Wt, int K, int mode) {
    if (F.vcu >= 128) return;
    const int lane = F.lane, lc = lane & 15, quad = lane >> 4, w = F.vcu; LAS float* red = (LAS float*)(F.lds + RING_OFF);
    f32x4 acc = (f32x4){0.f, 0.f, 0.f, 0.f}; const int kw = K / NWAVES, kb = F.wave * kw;
    const bf16* ap = A + (size_t)(TX + lc) * lda + kb + 8 * quad; const bf16* bp = Wt + (size_t)(16 * w + lc) * K + kb + 8 * quad;
#pragma unroll 4
    for (int ks = 0; ks < kw / 32; ++ks) acc = __builtin_amdgcn_mfma_f32_16x16x32_bf16(*(const bf16x8*)(ap + 32 * ks), *(const bf16x8*)(bp + 32 * ks), acc, 0, 0, 0);
    *(LAS f32x4*)(red + (F.wave * 64 + lane) * 4) = acc;
    __syncthreads();
    if (F.wave == 0) { f32x4 s = *(const LAS f32x4*)(red + lane * 4);
#pragma unroll
        for (int v = 1; v < NWAVES; ++v) s = s + *(const LAS f32x4*)(red + (v * 64 + lane) * 4);
        float* H = (float*)(a.ws + WS_H);
#pragma unroll
        for (int r = 0; r < 4; ++r) { const int row = 4 * quad + r, col = 16 * w + lc; const float base = mode ? H[(size_t)(TX + row) * DM + col] : a.in[1][(size_t)row * DM + col];
            H[(size_t)(TX + row) * DM + col] = base + s[r]; } }
    __syncthreads();
}

__global__ void __launch_bounds__(NWAVES * 64, 2) hyb_fwd(Args a) {
    extern __shared__ __attribute__((aligned(16))) unsigned char lds[];
    Frame F;
    F.lds = (LAS unsigned char*)lds;
    F.MISC = (volatile LAS unsigned*)(F.lds + MISC_OFF);
    F.tid = threadIdx.x; F.lane = F.tid & 63; F.wave = __builtin_amdgcn_readfirstlane(F.tid >> 6);
    F.G = gridDim.x; { const int bx = blockIdx.x; F.vcu = (F.G % 8 == 0) ? (bx % 8) * (F.G / 8) + bx / 8 : bx; }
    F.gw = F.vcu * NWAVES + F.wave; F.NGW = F.G * NWAVES;
    F.ctl = (gu32*)(a.ws + WS_CTL);
    for (int u = F.tid; u < (LDS_BYTES - LDSCTL_OFF) / 4; u += NWAVES * 64) ((LAS unsigned*)(F.lds + LDSCTL_OFF))[u] = 0u;
    __syncthreads();
    XcdBarrier bar; bar.bar = (unsigned*)(F.ctl + CW_BAR); bar.x = 0; bar.st = nullptr;
    if (MK_ONE_LAUNCH) bar = xcd_barrier_post((unsigned*)(F.ctl + CW_BAR), F.MISC + 8);
    const int lo = a.ph_lo, hi = a.ph_hi;
#ifndef PH_MASK
#define PH_MASK 0xFFFFFFFFFFFFFFFFull
#endif
#define IN(k) ((((unsigned long long)(PH_MASK) >> (k)) & 1ull) && lo <= (k) && (k) < hi)
#ifndef PROBE_REP
#define PROBE_REP 0u
#endif
#define REP(k) ((((unsigned long long)(PROBE_REP) >> (k)) & 1ull) ? 2 : 1)
#ifdef PROBE_TS
#define STAMP(k) do { if (blockIdx.x == 0 && F.tid == 0) ((unsigned long long*)(F.ctl + CW_TS))[(k)] = __builtin_amdgcn_s_memrealtime(); } while (0)
#else
#define STAMP(k) do { } while (0)
#endif
#define PHASE(k, ...) do { if (IN(k)) { { const int PH_REP_ = 0; (void)PH_REP_; __VA_ARGS__; } if (REP(k) == 2) { __syncthreads(); { const int PH_REP_ = 1; (void)PH_REP_; __VA_ARGS__; } } } } while (0)
#define SEAM(k) do { if (IN(k) && IN((k) + 1)) xcd_barrier(bar); STAMP((k) + 1); } while (0)
    const bf16* HN = (const bf16*)(a.ws + WS_HN); bf16* PROJ = (bf16*)(a.ws + WS_PROJ); const bf16* YMIX = (const bf16*)(a.ws + WS_YMIX); float* H = (float*)(a.ws + WS_H);

    STAMP(0);
    PHASE(0, { ph_prologue(F, a); ph_aux_convert(F, a, F.gw, F.NGW); });
    SEAM(0);
    PHASE(1, { pg8::Gemm g{HN, (const bf16*)(a.ws + WS_WEVIN), DM, DM, DM}; pg8::StaticOrder S; S.init(MP, EV_NP, F.G, (int)blockIdx.x); pg8::EpiBf16 E{PROJ, EV_NP}; run_gemm(F, g, S, E); });
    SEAM(1);
    PHASE(2, ph_even_prep(F, a););
    SEAM(2);
    PHASE(3, {
        { pg8::Gemm g{(const bf16*)(a.ws + WS_SCR + SC_ALORA), (const bf16*)(a.ws + WS_WLORA), 384, 384, 384}; pg8::StaticOrder S; S.init(MP, 3072, F.G, (int)blockIdx.x);
          static_assert(SC_ICL - SC_DEC == SC_GATE - SC_ICL, "lora outputs equally spaced");
          pg8::EpiLora E{(bf16*)(a.ws + WS_SCR + SC_DEC), (long)((SC_ICL - SC_DEC) / 2), a.in[7], a.in[9]}; run_gemm(F, g, S, E); }
        { pg8::Gemm g{(const bf16*)(a.ws + WS_SCR + SC_XR), (const bf16*)(a.ws + WS_WGATE), 256, 1024, 256}; pg8::StaticOrder S; S.init(MP, 2048, F.G, (int)blockIdx.x); S.amod = 4; S.astep = 512;
          pg8::EpiGates E{(bf16*)(a.ws + WS_SCR + SC_LA), (bf16*)(a.ws + WS_SCR + SC_LIX), a.in[20], a.in[22], a.in[23], (const bf16*)(a.ws + WS_SCR + SC_XR)}; run_gemm(F, g, S, E); }
    });
    SEAM(3);
    PHASE(4, ph_rwkv_chunk(F, a, 0, 32, 0););
    SEAM(4);
    PHASE(5, { if (F.vcu < 16) ph_rwkv_chain(F, a, 0, 64); else ph_rwkv_chunk(F, a, 32, 62, 16); });
    SEAM(5);
#if defined(PROBE_X) && PROBE_X == 1
    PHASE(6, { if (F.vcu < 16) { ph_rwkv_chain(F, a, 64, 124); __syncthreads(); ph_rwkv_chain(F, a, 64, 124); } else ph_rwkv_chunk(F, a, 62, 92, 16); });
#elif defined(PROBE_X) && PROBE_X == 2
    PHASE(6, { if (F.vcu < 16) ph_rwkv_chain(F, a, 64, 124); else { ph_rwkv_chunk(F, a, 62, 92, 16); __syncthreads(); ph_rwkv_chunk(F, a, 62, 92, 16); } });
#else
    PHASE(6, { if (F.vcu < 16) ph_rwkv_chain(F, a, 64, 124); else ph_rwkv_chunk(F, a, 62, 92, 16); });
#endif
    SEAM(6);
    PHASE(7, { if (F.vcu < 16) ph_rwkv_chain(F, a, 124, 184); else ph_rwkv_chunk(F, a, 92, 122, 16); });
    SEAM(7);
    PHASE(8, { if (F.vcu < 16) ph_rwkv_chain(F, a, 184, 244); else { ph_rwkv_chunk(F, a, 122, 129, 16); lru_local(F, a, (F.vcu - 16) * NWAVES + F.wave, (F.G - 16) * NWAVES); } });
    SEAM(8);
    PHASE(9, { if (F.vcu < 18) ph_rwkv_chain(F, a, 244, RW_NSC); else ph_rwkv_out(F, a, 0, 244, (F.vcu - 18) * NWAVES + F.wave, (F.G - 18) * NWAVES); });
    SEAM(9);
    PHASE(10, { ph_rwkv_out(F, a, 244, RW_NSC, F.gw, F.NGW); lru_apply(F, a); });
    SEAM(10);
    PHASE(11, { pg8::Gemm g{YMIX, (const bf16*)(a.ws + WS_WEVOUT), DM, DM, DM}; pg8::StaticOrder S; S.init(TX, DM, F.G, (int)blockIdx.x); pg8::EpiResid E{H, a.in[0], a.in[1], 0}; run_gemm(F, g, S, E); gemm_tail16(F, a, YMIX, DM, (const bf16*)(a.ws + WS_WEVOUT), DM, 0); });
    SEAM(11);
    PHASE(12, ph_route(F, a, 0, PH_REP_););
    SEAM(12);
    PHASE(13, ph_gather(F, a, 0););
    SEAM(13);
    PHASE(14, ph_moe_a(F, a););
    SEAM(14);
    PHASE(15, ph_moe_b(F, a););
    SEAM(15);
    PHASE(16, ph_moe_c(F, a););
    SEAM(16);
    PHASE(17, ph_combine(F, a, 0););
    SEAM(17);
    PHASE(18, { pg8::Gemm g{HN, (const bf16*)(a.ws + WS_WODIN), DM, DM, DM}; pg8::StaticOrder S; S.init(MP, OD_NP, F.G, (int)blockIdx.x); pg8::EpiBf16 E{PROJ, OD_NP}; run_gemm(F, g, S, E); });
    SEAM(18);
    PHASE(19, ph_odd_prep(F, a););
    SEAM(19);
    PHASE(20, ph_gdn_chunk(F, a, 0, 54, 0););
    SEAM(20);
    PHASE(21, { ph_gdn_chain(F, a, 0, 54); ph_gdn_chunk(F, a, 54, 90, 1); });
    SEAM(21);
#if defined(PROBE_X) && PROBE_X == 3
    PHASE(22, { ph_gdn_chain(F, a, 54, 90); __syncthreads(); ph_gdn_chain(F, a, 54, 90); ph_gdn_chunk(F, a, 90, 114, 1); });
#elif defined(PROBE_X) && PROBE_X == 4
    PHASE(22, { ph_gdn_chain(F, a, 54, 90); ph_gdn_chunk(F, a, 90, 114, 1); __syncthreads(); ph_gdn_chunk(F, a, 90, 114, 1); });
#else
    PHASE(22, { ph_gdn_chain(F, a, 54, 90); ph_gdn_chunk(F, a, 90, 114, 1); });
#endif
    SEAM(22);
    PHASE(23, { ph_gdn_chain(F, a, 90, 114); ph_gdn_chunk(F, a, 114, 129, 1); });
    SEAM(23);
    PHASE(24, { ph_gdn_chain(F, a, 114, 129); ph_odd_post(F, a, 0); });
    SEAM(24);
    PHASE(25, { ph_odd_post(F, a, F.G == 256 ? 1 : 2); moe_convert(F, a, 1, F.gw, F.NGW); });
    SEAM(25);
    PHASE(26, { pg8::Gemm g{YMIX, (const bf16*)(a.ws + WS_WODOUT), 4096, 4096, 4096}; pg8::StaticOrder S; S.init(TX, DM, F.G, (int)blockIdx.x); pg8::EpiResid E{H, a.in[0], a.in[1], 1}; run_gemm(F, g, S, E); gemm_tail16(F, a, YMIX, 4096, (const bf16*)(a.ws + WS_WODOUT), 4096, 1); });
    SEAM(26);
    PHASE(27, ph_route(F, a, 1, PH_REP_););
    SEAM(27);
    PHASE(28, ph_gather(F, a, 1););
    SEAM(28);
    PHASE(29, ph_moe_a(F, a););
    SEAM(29);
    PHASE(30, ph_moe_b(F, a););
    SEAM(30);
    PHASE(31, ph_moe_c(F, a););
    SEAM(31);
    PHASE(32, ph_combine(F, a, 1););
#ifdef PROBE_BARS
    for (int i_ = 0; i_ < PROBE_BARS; ++i_) xcd_barrier(bar);
#endif
#undef IN
#undef SEAM
}

extern "C" void kernel_launch(void* const* d_in, const int* in_sizes, int n_in, void* d_out, int out_size, void* d_ws, size_t ws_size, hipStream_t stream) {
    static int grid = 0;
    if (grid == 0) {
        if (n_in != 36 || out_size != TX * DM || ws_size < WS_END) { fprintf(stderr, "kernel_launch: unexpected shapes (n_in %d, out %d, ws %zu)\n", n_in, out_size, ws_size); grid = -1; return; }
        int dev = 0, cus = 0, per_cu = 0;
        if (hipGetDevice(&dev) != hipSuccess || hipDeviceGetAttribute(&cus, hipDeviceAttributeMultiprocessorCount, dev) != hipSuccess) { grid = -1; return; }
        if (hipFuncSetAttribute((const void*)hyb_fwd, hipFuncAttributeMaxDynamicSharedMemorySize, LDS_BYTES) != hipSuccess) { fprintf(stderr, "kernel_launch: hipFuncSetAttribute failed\n"); grid = -1; return; }
        if (hipOccupancyMaxActiveBlocksPerMultiprocessor(&per_cu, (const void*)hyb_fwd, NWAVES * 64, LDS_BYTES) != hipSuccess || per_cu < 1) { fprintf(stderr, "kernel_launch: occupancy query says %d\n", per_cu); per_cu = 1; }
        (void)hipGetLastError();
        grid = cus;
    }
    if (grid < 0) return;
    if (hipMemsetAsync((char*)d_ws + WS_CTL, 0, CTL_ZERO_BYTES, stream) != hipSuccess) return;
    Args a{};
    for (int i = 0; i < 36; ++i) a.in[i] = (const float*)d_in[i];
    a.out = (float*)d_out; a.ws = (unsigned char*)d_ws;
#if MK_ONE_LAUNCH
    a.ph_lo = 0; a.ph_hi = N_PHASES;
    hipLaunchKernelGGL(hyb_fwd, dim3(grid), dim3(NWAVES * 64), LDS_BYTES, stream, a);
#else
    for (int p = 0; p < N_PHASES; ++p) { a.ph_lo = p; a.ph_hi = p + 1; hipLaunchKernelGGL(hyb_fwd, dim3(grid), dim3(NWAVES * 64), LDS_BYTES, stream, a); }
#endif
}
```

```cpp
#include <hip/hip_runtime.h>
#include <cstdio>
#include <cstdint>
#include <cmath>

#ifndef MK_ONE_LAUNCH
#define MK_ONE_LAUNCH 1
#endif

namespace pg8 {
#define PG8_LAS __attribute__((address_space(3)))
typedef unsigned short bf16_t;
typedef short bf16x8 __attribute__((ext_vector_type(8)));
typedef float f32x4 __attribute__((ext_vector_type(4)));
typedef unsigned u32x4 __attribute__((ext_vector_type(4)));
typedef unsigned u32x2 __attribute__((ext_vector_type(2)));
constexpr int BM = 256, BK = 64, HALF = 128, HTB = HALF * BK * 2  , STAGE_BYTES = 8 * HTB, NXCD = 8, WGM = 8;

__host__ __device__ __forceinline__ int lds_byte(int r, int c) { const int st = (r >> 4) * 2 + (c >> 5), rr = r & 15, cc = c & 31, ob = rr * 64 + cc * 2; return st * 1024 + (ob ^ (((ob >> 9) & 1) << 5)); }
__host__ __device__ __forceinline__ void stage_rc(int b, int& R, int& C) { const int st = b / 1024, sb = b % 1024, swz = sb ^ (((sb >> 9) & 1) << 5); R = (st >> 1) * 16 + swz / 64; C = (st & 1) * 32 + (swz % 64) / 2; }
__host__ __device__ __forceinline__ int perm32(int rho) { const int n = rho >> 4, i = rho & 15; return 8 * (i >> 2) + 4 * n + (i & 3); }

struct Unit { int pm, pn; long aoff, boff; };
struct Gemm { const bf16_t* A; const bf16_t* Bt; int K, lda, ldb; };

struct StaticOrder {
    int nM, nN, nwg, G, c, amod; long astep;
    __host__ __device__ void init(int M, int N, int G_, int c_) { nM = M / BM; nN = N / BM; nwg = nM * nN; G = G_; c = c_; amod = 0; astep = 0; }
    __host__ __device__ bool next(int i, Unit& u) const {
        const long L = (long)i * G + c; if (L >= nwg) return false;
        int wgid = (int)L; { const int q = nwg / NXCD, r = nwg % NXCD, xcd = wgid % NXCD, off = wgid / NXCD; wgid = (xcd < r ? xcd * (q + 1) : r * (q + 1) + (xcd - r) * q) + off; }
        const int nig = WGM * nN, gid = wgid / nig, fm = gid * WGM, gsz = (nM - fm) < WGM ? (nM - fm) : WGM;
        u.pm = fm + ((wgid % nig) % gsz); u.pn = (wgid % nig) / gsz; u.boff = 0; u.aoff = amod ? (long)(u.pn % amod) * astep : 0; return true;
    }
    __device__ __forceinline__ void a_ready(const Unit&) const {}
    __device__ __forceinline__ void done(const Unit&) const {}
};
struct MoeOrder {
    const int* tile_e; int t0, ntiles, npn, G, c; long bstride;
    __device__ __forceinline__ bool next(int i, Unit& u) const {
        const long L = (long)i * G + c; if (c < 0 || L >= (long)ntiles * npn) return false;
        const int t = t0 + (int)(L / npn); u.pm = t; u.pn = (int)(L % npn); u.aoff = 0; u.boff = (long)tile_e[t] * bstride; return true;
    }
    __device__ __forceinline__ void a_ready(const Unit&) const {}
    __device__ __forceinline__ void done(const Unit&) const {}
};

__device__ __forceinline__ unsigned cvt_pk_bf16(float lo, float hi) { unsigned r; asm volatile("v_cvt_pk_bf16_f32 %0, %1, %2" : "=v"(r) : "v"(lo), "v"(hi)); return r; }
__device__ __forceinline__ float bf_lo(unsigned w) { return __uint_as_float(w << 16); }
__device__ __forceinline__ float bf_hi(unsigned w) { return __uint_as_float(w & 0xffff0000u); }
__device__ __forceinline__ float sigmoidf_(float x) { return __builtin_amdgcn_rcpf(1.0f + __expf(-x)); }
__device__ __forceinline__ float softplusf_(float x) { return fmaxf(x, 0.f) + __logf(1.0f + __expf(-fabsf(x))); }

struct EpiBf16 {
    static constexpr bool PERM = true, AFTER_DRAIN = false;
    bf16_t* O; int ldc;
    __device__ __forceinline__ void operator()(const f32x4 (&acc)[2][2][4][2], const Unit& u, int wr, int wc, int fr, int fq) const {
        const int row0 = u.pm * BM + wr * 64 + fr; const int col0 = u.pn * BM + wc * 32 + 8 * fq;
#pragma unroll
        for (int ai = 0; ai < 2; ++ai)
#pragma unroll
            for (int m = 0; m < 4; ++m) { bf16_t* rowp = O + (size_t)(row0 + ai * HALF + m * 16) * ldc + col0;
#pragma unroll
                for (int bj = 0; bj < 2; ++bj) { const f32x4 v0 = acc[ai][bj][m][0], v1 = acc[ai][bj][m][1];
                    u32x4 w; w.x = cvt_pk_bf16(v0[0], v0[1]); w.y = cvt_pk_bf16(v0[2], v0[3]); w.z = cvt_pk_bf16(v1[0], v1[1]); w.w = cvt_pk_bf16(v1[2], v1[3]);
                    *(u32x4*)(rowp + bj * HALF) = w; } }
    }
};
struct EpiSwiglu {
    static constexpr bool PERM = true, AFTER_DRAIN = false;
    bf16_t* O; int ldc;
    __device__ __forceinline__ void operator()(const f32x4 (&acc)[2][2][4][2], const Unit& u, int wr, int wc, int fr, int fq) const {
        const int row0 = u.pm * BM + wr * 64 + fr; const int col0 = u.pn * HALF + wc * 32 + 8 * fq;
#pragma unroll
        for (int ai = 0; ai < 2; ++ai)
#pragma unroll
            for (int m = 0; m < 4; ++m) { bf16_t* rowp = O + (size_t)(row0 + ai * HALF + m * 16) * ldc + col0;
                float o[8];
#pragma unroll
                for (int n = 0; n < 2; ++n)
#pragma unroll
                    for (int j = 0; j < 4; ++j) { const float gq = acc[ai][0][m][n][j], uq = acc[ai][1][m][n][j]; o[4 * n + j] = gq * sigmoidf_(gq) * uq; }
                u32x4 w; w.x = cvt_pk_bf16(o[0], o[1]); w.y = cvt_pk_bf16(o[2], o[3]); w.z = cvt_pk_bf16(o[4], o[5]); w.w = cvt_pk_bf16(o[6], o[7]);
                *(u32x4*)rowp = w; }
    }
};
struct EpiResid {
    static constexpr bool PERM = false, AFTER_DRAIN = false;
    float* out; const float* x; const float* meta; int mode;
    __device__ __forceinline__ void operator()(const f32x4 (&acc)[2][2][4][2], const Unit& u, int wr, int wc, int fr, int fq) const {
        const int row0 = u.pm * BM + wr * 64 + fr, col0 = u.pn * BM + wc * 32 + 4 * fq;
#pragma unroll
        for (int ai = 0; ai < 2; ++ai)
#pragma unroll
            for (int m = 0; m < 4; ++m) { const int row = row0 + ai * HALF + m * 16; float* rowp = out + (size_t)row * 2048 + col0;
                const float* bp = mode ? rowp : (row < 8192 ? x + (size_t)row * 2048 + col0 : (row < 8208 ? meta + (size_t)(row - 8192) * 2048 + col0 : nullptr));
#pragma unroll
                for (int bj = 0; bj < 2; ++bj)
#pragma unroll
                    for (int n = 0; n < 2; ++n) { f32x4 b = (f32x4){0.f, 0.f, 0.f, 0.f}; if (bp) b = *(const f32x4*)(bp + bj * HALF + n * 16);
                        *(f32x4*)(rowp + bj * HALF + n * 16) = acc[ai][bj][m][n] + b; } }
    }
};
__device__ __forceinline__ float one_minus_exp_neg(float e) { return e < 0.05f ? e * (1.0f - e * (0.5f - e * (1.0f / 6.0f))) : 1.0f - __expf(-e); }
struct EpiLora {
    static constexpr bool PERM = false, AFTER_DRAIN = false;
    bf16_t* base; long gstride; const float* w0; const float* a0;
    __device__ __forceinline__ void operator()(const f32x4 (&acc)[2][2][4][2], const Unit& u, int wr, int wc, int fr, int fq) const {
        const int grp = u.pn >> 2; const int row0 = u.pm * BM + wr * 64 + fr, col0 = (u.pn & 3) * BM + wc * 32 + 4 * fq;
        bf16_t* O = base + (size_t)grp * gstride;
#pragma unroll
        for (int bj = 0; bj < 2; ++bj)
#pragma unroll
            for (int n = 0; n < 2; ++n) { const int c = col0 + bj * HALF + n * 16;
                f32x4 bv = (f32x4){0.f, 0.f, 0.f, 0.f}; if (grp == 0) bv = *(const f32x4*)(w0 + c); else if (grp == 1) bv = *(const f32x4*)(a0 + c);
#pragma unroll
                for (int ai = 0; ai < 2; ++ai)
#pragma unroll
                    for (int m = 0; m < 4; ++m) { f32x4 v = acc[ai][bj][m][n] + bv;
                        if (grp == 0) {
#pragma unroll
                            for (int j = 0; j < 4; ++j) { const float wl = -softplusf_(-v[j]) - 0.5f; v[j] = one_minus_exp_neg(__expf(wl)); }
                        } else if (grp == 1) {
#pragma unroll
                            for (int j = 0; j < 4; ++j) v[j] = sigmoidf_(v[j]);
                        }
                        u32x2 w; w.x = cvt_pk_bf16(v[0], v[1]); w.y = cvt_pk_bf16(v[2], v[3]);
                        *(u32x2*)(O + (size_t)(row0 + ai * HALF + m * 16) * 1024 + c) = w; } }
    }
};
struct EpiGates {
    static constexpr bool PERM = false, AFTER_DRAIN = false;
    bf16_t* lru_a; bf16_t* lru_ix; const float* ba; const float* bx; const float* lam; const bf16_t* xr;
    __device__ __forceinline__ void operator()(const f32x4 (&acc)[2][2][4][2], const Unit& u, int wr, int wc, int fr, int fq) const {
        const int grp = u.pn >> 2; const int row0 = u.pm * BM + wr * 64 + fr, col0 = (u.pn & 3) * BM + wc * 32 + 4 * fq;
#pragma unroll
        for (int bj = 0; bj < 2; ++bj)
#pragma unroll
            for (int n = 0; n < 2; ++n) { const int c = col0 + bj * HALF + n * 16;
                const f32x4 bv = *(const f32x4*)((grp == 0 ? ba : bx) + c); f32x4 sp = (f32x4){0.f, 0.f, 0.f, 0.f};
                if (grp == 0) { const f32x4 l = *(const f32x4*)(lam + c);
#pragma unroll
                    for (int j = 0; j < 4; ++j) sp[j] = 8.0f * softplusf_(-l[j]); }
#pragma unroll
                for (int ai = 0; ai < 2; ++ai)
#pragma unroll
                    for (int m = 0; m < 4; ++m) { const int row = row0 + ai * HALF + m * 16; f32x4 v = acc[ai][bj][m][n] + bv; u32x2 w;
                        if (grp == 0) {
#pragma unroll
                            for (int j = 0; j < 4; ++j) v[j] = one_minus_exp_neg(sigmoidf_(v[j]) * sp[j]);
                            w.x = cvt_pk_bf16(v[0], v[1]); w.y = cvt_pk_bf16(v[2], v[3]); *(u32x2*)(lru_a + (size_t)row * 1024 + c) = w;
                        } else { const u32x2 xw = *(const u32x2*)(xr + (size_t)row * 1024 + c);
                            v[0] = sigmoidf_(v[0]) * bf_lo(xw.x); v[1] = sigmoidf_(v[1]) * bf_hi(xw.x); v[2] = sigmoidf_(v[2]) * bf_lo(xw.y); v[3] = sigmoidf_(v[3]) * bf_hi(xw.y);
                            w.x = cvt_pk_bf16(v[0], v[1]); w.y = cvt_pk_bf16(v[2], v[3]); *(u32x2*)(lru_ix + (size_t)row * 1024 + c) = w; } } }
    }
};

template <class Epi, class Sched, bool ALIGN_EPI = false, bool SP2 = false>
__device__ __forceinline__ void gemm_phase(PG8_LAS unsigned char* lds, const Gemm g, const Sched& S, const Epi& E) {
    const int tid = threadIdx.x, wid = __builtin_amdgcn_readfirstlane(tid >> 6), lane = tid & 63, wr = wid >> 2, wc = wid & 3, fr = lane & 15, fq = lane >> 4;
    const int K = g.K, nt = K / BK;
    unsigned voffA[2], voffB[2];
#pragma unroll
    for (int i = 0; i < 2; ++i) { int R, C; stage_rc(tid * 16 + i * 8192, R, C); const int Rb = Epi::PERM ? ((R & ~31) + perm32(R & 31)) : R;
        voffA[i] = (unsigned)(R * g.lda + C) * 2u; voffB[i] = (unsigned)(Rb * g.ldb + C) * 2u; }
    const size_t kstep = (size_t)(BK * 2);
    const size_t hstepA = (size_t)HALF * g.lda * 2, hstepB = (size_t)HALF * g.ldb * 2;
    const size_t tstepA = 2 * hstepA, tstepB = 2 * hstepB;
    const unsigned ldsw = (unsigned)wid * 1024u;
    const int aoff = lds_byte(wr * 64 + fr, fq * 8), boff = lds_byte(wc * 32 + fr, fq * 8);
#define PG8_SA(b, h) (((b) * 2 + (h)) * HTB)
#define PG8_SB(b, h) ((4 + (b) * 2 + (h)) * HTB)
#define PG8_STAGE(bufoff, gbase, voff) do { _Pragma("unroll") for (int _i = 0; _i < 2; ++_i) \
        __builtin_amdgcn_global_load_lds((const unsigned*)((const char*)(gbase) + (voff)[_i]), (PG8_LAS unsigned*)(lds + (bufoff) + ldsw + _i * 8192), 16, 0, 0); } while (0)
#define PG8_LDA(dst, b, h) do { _Pragma("unroll") for (int m = 0; m < 4; ++m) _Pragma("unroll") for (int k = 0; k < 2; ++k) dst[m][k] = *(const PG8_LAS bf16x8*)(lds + PG8_SA(b, h) + aoff + m * 2048 + k * 1024); } while (0)
#define PG8_LDB(dst, b, h) do { _Pragma("unroll") for (int n = 0; n < 2; ++n) _Pragma("unroll") for (int k = 0; k < 2; ++k) dst[n][k] = *(const PG8_LAS bf16x8*)(lds + PG8_SB(b, h) + boff + n * 2048 + k * 1024); } while (0)
#define PG8_MMA(ai, bj, At, Bt) do { __builtin_amdgcn_s_setprio(1); _Pragma("unroll") for (int m = 0; m < 4; ++m) _Pragma("unroll") for (int n = 0; n < 2; ++n) _Pragma("unroll") for (int k = 0; k < 2; ++k) \
        acc[ai][bj][m][n] = __builtin_amdgcn_mfma_f32_16x16x32_bf16(Bt[n][k], At[m][k], acc[ai][bj][m][n], 0, 0, 0); __builtin_amdgcn_s_setprio(0); } while (0)
#define PG8_WAIT_V(n) asm volatile("s_waitcnt vmcnt(" #n ")" ::: "memory")
#define PG8_WAIT_L(n) asm volatile("s_waitcnt lgkmcnt(" #n ")" ::: "memory")
#define PG8_BAR __builtin_amdgcn_s_barrier()
#define PG8_SCHED __builtin_amdgcn_sched_barrier(0)
    Unit cur, nxt; int ui = 0;
    if (!S.next(0, cur)) return;
    f32x4 acc[2][2][4][2];
#pragma unroll
    for (int a = 0; a < 2; ++a)
#pragma unroll
        for (int b = 0; b < 2; ++b)
#pragma unroll
            for (int m = 0; m < 4; ++m)
#pragma unroll
                for (int n = 0; n < 2; ++n) acc[a][b][m][n] = (f32x4){0.f, 0.f, 0.f, 0.f};
    bf16x8 At[4][2], B0[2][2], B1[2][2];
    const char* cA = (const char*)g.A + (size_t)cur.pm * tstepA + cur.aoff; const char* cB = (const char*)g.Bt + (size_t)cur.pn * tstepB + cur.boff;
    S.a_ready(cur);
    if constexpr (SP2) {
        PG8_STAGE(PG8_SB(0, 0), cB, voffB); PG8_STAGE(PG8_SB(0, 1), cB + hstepB, voffB); PG8_STAGE(PG8_SA(0, 0), cA, voffA); PG8_STAGE(PG8_SA(0, 1), cA + hstepA, voffA);
        if (wr == 1) PG8_BAR;
        PG8_WAIT_V(2); PG8_BAR;
        PG8_STAGE(PG8_SB(1, 0), cB + kstep, voffB); PG8_STAGE(PG8_SA(1, 0), cA + kstep, voffA); PG8_STAGE(PG8_SB(1, 1), cB + hstepB + kstep, voffB);
        PG8_WAIT_V(6); PG8_BAR;
    } else {
        PG8_STAGE(PG8_SB(0, 0), cB, voffB); PG8_STAGE(PG8_SA(0, 0), cA, voffA); PG8_STAGE(PG8_SB(0, 1), cB + hstepB, voffB); PG8_STAGE(PG8_SA(0, 1), cA + hstepA, voffA);
        if (wr == 1) PG8_BAR;
        PG8_WAIT_V(4); PG8_BAR;
        PG8_STAGE(PG8_SB(1, 0), cB + kstep, voffB); PG8_STAGE(PG8_SA(1, 0), cA + kstep, voffA); PG8_STAGE(PG8_SB(1, 1), cB + hstepB + kstep, voffB);
        PG8_WAIT_V(6); PG8_BAR;
    }
    for (;;) {
        const bool has_next = S.next(ui + 1, nxt);
        const char* nA = has_next ? (const char*)g.A + (size_t)nxt.pm * tstepA + nxt.aoff : cA; const char* nB = has_next ? (const char*)g.Bt + (size_t)nxt.pn * tstepB + nxt.boff : cB;
        for (int t = 0; t < nt; t += 2) {
            const bool last = (t == nt - 2);
            const char* a1 = cA + (size_t)(t + 1) * kstep;
            const char* a2 = last ? nA : cA + (size_t)(t + 2) * kstep; const char* b2 = last ? nB : cB + (size_t)(t + 2) * kstep;
            const char* a3 = a2 + kstep; const char* b3 = b2 + kstep;
            if (last && has_next) S.a_ready(nxt);
            if constexpr (SP2) {
            PG8_LDB(B0, 0, 0); PG8_LDB(B1, 0, 1); PG8_SCHED; PG8_LDA(At, 0, 0); PG8_STAGE(PG8_SA(1, 1), a1 + hstepA, voffA);
            PG8_WAIT_V(8); PG8_WAIT_L(0); PG8_BAR; PG8_MMA(0, 0, At, B0); PG8_MMA(0, 1, At, B1); PG8_BAR; PG8_SCHED;
            PG8_LDA(At, 0, 1); PG8_STAGE(PG8_SB(0, 0), b2, voffB); PG8_STAGE(PG8_SB(0, 1), b2 + hstepB, voffB); PG8_STAGE(PG8_SA(0, 0), a2, voffA);
            PG8_WAIT_V(8); PG8_WAIT_L(0); PG8_BAR; PG8_MMA(1, 0, At, B0); PG8_MMA(1, 1, At, B1); PG8_BAR; PG8_SCHED;
            PG8_LDB(B0, 1, 0); PG8_LDB(B1, 1, 1); PG8_SCHED; PG8_LDA(At, 1, 0); PG8_STAGE(PG8_SA(0, 1), a2 + hstepA, voffA);
            PG8_WAIT_V(8); PG8_WAIT_L(0); PG8_BAR; PG8_MMA(0, 0, At, B0); PG8_MMA(0, 1, At, B1); PG8_BAR; PG8_SCHED;
            PG8_LDA(At, 1, 1); PG8_STAGE(PG8_SB(1, 0), b3, voffB); PG8_STAGE(PG8_SB(1, 1), b3 + hstepB, voffB); PG8_STAGE(PG8_SA(1, 0), a3, voffA);
            PG8_WAIT_V(8); PG8_WAIT_L(0); PG8_BAR; PG8_MMA(1, 0, At, B0); PG8_MMA(1, 1, At, B1); PG8_BAR; PG8_SCHED;
            } else {
            PG8_LDB(B0, 0, 0); PG8_SCHED; PG8_LDA(At, 0, 0); PG8_STAGE(PG8_SA(1, 1), a1 + hstepA, voffA);
            PG8_WAIT_L(8); PG8_BAR; PG8_WAIT_L(0); PG8_MMA(0, 0, At, B0); PG8_BAR; PG8_SCHED;
            PG8_LDB(B1, 0, 1); PG8_STAGE(PG8_SB(0, 0), b2, voffB);
            PG8_BAR; PG8_WAIT_L(0); PG8_MMA(0, 1, At, B1); PG8_BAR;
            PG8_LDA(At, 0, 1); PG8_STAGE(PG8_SA(0, 0), a2, voffA);
            PG8_BAR; PG8_WAIT_L(0); PG8_MMA(1, 0, At, B0); PG8_BAR; PG8_SCHED;
            PG8_STAGE(PG8_SB(0, 1), b2 + hstepB, voffB);
            PG8_WAIT_V(6); PG8_BAR; PG8_MMA(1, 1, At, B1); PG8_BAR;
            PG8_LDB(B0, 1, 0); PG8_SCHED; PG8_LDA(At, 1, 0); PG8_STAGE(PG8_SA(0, 1), a2 + hstepA, voffA);
            PG8_WAIT_L(8); PG8_BAR; PG8_WAIT_L(0); PG8_MMA(0, 0, At, B0); PG8_BAR; PG8_SCHED;
            PG8_LDB(B1, 1, 1); PG8_STAGE(PG8_SB(1, 0), b3, voffB);
            PG8_BAR; PG8_WAIT_L(0); PG8_MMA(0, 1, At, B1); PG8_BAR;
            PG8_LDA(At, 1, 1); PG8_STAGE(PG8_SA(1, 0), a3, voffA);
            PG8_BAR; PG8_WAIT_L(0); PG8_MMA(1, 0, At, B0); PG8_BAR; PG8_SCHED;
            PG8_STAGE(PG8_SB(1, 1), b3 + hstepB, voffB);
            PG8_WAIT_V(6); PG8_BAR; PG8_MMA(1, 1, At, B1); PG8_BAR;
            }
        }
        if constexpr (ALIGN_EPI) { if (wr == 0) PG8_BAR; }
        if constexpr (!Epi::AFTER_DRAIN) { E(acc, cur, wr, wc, fr, fq); S.done(cur); }
        if (!has_next) break;
#pragma unroll
        for (int a = 0; a < 2; ++a)
#pragma unroll
            for (int b = 0; b < 2; ++b)
#pragma unroll
                for (int m = 0; m < 4; ++m)
#pragma unroll
                    for (int n = 0; n < 2; ++n) acc[a][b][m][n] = (f32x4){0.f, 0.f, 0.f, 0.f};
        cur = nxt; cA = nA; cB = nB; ++ui;
        if constexpr (ALIGN_EPI) { if (wr == 1) PG8_BAR; }
    }
    PG8_WAIT_V(0);
    if constexpr (!ALIGN_EPI) { if (wr == 0) PG8_BAR; }
    PG8_BAR;
    if constexpr (Epi::AFTER_DRAIN) { E.fused(acc, cur, wr, wc, fr, fq, lds, wid, lane); S.done(cur); }
#undef PG8_SA
#undef PG8_SB
#undef PG8_STAGE
#undef PG8_LDA
#undef PG8_LDB
#undef PG8_MMA
#undef PG8_WAIT_V
#undef PG8_WAIT_L
#undef PG8_BAR
#undef PG8_SCHED
}
}
#define GAS __attribute__((address_space(1)))
#define LAS __attribute__((address_space(3)))
typedef unsigned short bf16;
typedef unsigned v4u __attribute__((ext_vector_type(4)));
typedef float f32x4 __attribute__((ext_vector_type(4)));
typedef short bf16x8 __attribute__((ext_vector_type(8)));
typedef GAS unsigned gu32;
typedef GAS unsigned long long gu64;
#define RLX_AGENT __ATOMIC_RELAXED, __HIP_MEMORY_SCOPE_AGENT
#define LDS_WAIT() asm volatile("s_waitcnt lgkmcnt(0)" ::: "memory")
#define VM_WAIT() asm volatile("s_waitcnt vmcnt(0)" ::: "memory")
__device__ __forceinline__ unsigned long long rt() { return __builtin_amdgcn_s_memrealtime(); }
__device__ __forceinline__ unsigned f2bf(float f) { unsigned u = __builtin_bit_cast(unsigned, f); return (u + 0x7fffu + ((u >> 16) & 1u)) >> 16; }
__device__ __forceinline__ unsigned pk2(float lo, float hi) { return f2bf(lo) | (f2bf(hi) << 16); }

#define XB_TMO      128
#define XB_XCNT(j)  (256  + 64 * (j))
#define XB_XSUB(j)  (1280 + 64 * (j))
#define XB_XGEN(j)  (2304 + 64 * (j))
#define XB_TOP      3328
#define XB_TOPGEN   3392
#define XCD_BAR_WORDS 3456
#define XB_SPIN_CAP (1u << 18)

__device__ __forceinline__ unsigned xb_ld(unsigned* p)              { return __hip_atomic_load(p, __ATOMIC_RELAXED, __HIP_MEMORY_SCOPE_AGENT); }
__device__ __forceinline__ unsigned xb_add(unsigned* p, unsigned v) { return __hip_atomic_fetch_add(p, v, __ATOMIC_RELAXED, __HIP_MEMORY_SCOPE_AGENT); }
__device__ __forceinline__ unsigned xb_xcc_id() { return (unsigned)__builtin_amdgcn_s_getreg((3 << 11) | 20) & 0xFu; }
#define XB_SPIN(cond, bar) do { unsigned _sp = 0; while (cond) { __builtin_amdgcn_s_sleep(1); \
    if ((++_sp & 255u) == 0u) { if (xb_ld(&(bar)[XB_TMO])) break; if (_sp > XB_SPIN_CAP) { atomicAdd(&(bar)[XB_TMO], 1u); break; } } } } while (0)

struct XcdBarrier {
    unsigned* bar; unsigned x;
    volatile LAS unsigned* st;
};

__device__ __forceinline__ XcdBarrier xcd_barrier_post(unsigned* bar, volatile LAS unsigned* st) {
    XcdBarrier b; b.bar = bar; b.x = xb_xcc_id(); b.st = st;
    if (threadIdx.x == 0) (void)xb_add(&bar[XB_XCNT(b.x)], 1u);
    return b;
}
__device__ __forceinline__ void xcd_barrier_complete(unsigned* bar, unsigned x, unsigned& nloc, unsigned& nx) {
    const unsigned G = gridDim.x * gridDim.y * gridDim.z;
    unsigned sum, cnt, mine, sp = 0u;
    for (;;) {
        sum = 0u; cnt = 0u; mine = 0u;
#pragma unroll
        for (unsigned j = 0; j < 16; ++j) { const unsigned c = xb_ld(&bar[XB_XCNT(j)]); sum += c; cnt += (c > 0u) ? 1u : 0u; mine = (j == x) ? c : mine; }
        if (sum == G) break;
        __builtin_amdgcn_s_sleep(1);
        if ((++sp & 255u) == 0u) { if (xb_ld(&bar[XB_TMO])) break; if (sp > XB_SPIN_CAP) { atomicAdd(&bar[XB_TMO], 1u); break; } }
    }
    nloc = mine > 0u ? mine : 1u; nx = cnt > 0u ? cnt : 1u;
}

__device__ __forceinline__ void xcd_barrier(const XcdBarrier& b) {
    asm volatile("s_waitcnt vmcnt(0)" ::: "memory");
    __syncthreads();
    if (threadIdx.x == 0) {
        unsigned* bar = b.bar;
        __builtin_amdgcn_s_waitcnt(0);
        unsigned nloc = b.st[0], nx = b.st[1];
        if (nloc == 0u) { xcd_barrier_complete(bar, b.x, nloc, nx); b.st[0] = nloc; b.st[1] = nx; }
        const unsigned old = xb_add(&bar[XB_XSUB(b.x)], 1u);
        const unsigned gen = old / nloc;
        if (old + 1u == (gen + 1u) * nloc) {
            __builtin_amdgcn_fence(__ATOMIC_RELEASE, "agent");
            asm volatile("s_waitcnt vmcnt(0)" ::: "memory");
            const unsigned og = xb_add(&bar[XB_TOP], 1u);
            const unsigned tg = og / nx;
            if (og + 1u == (tg + 1u) * nx) xb_add(&bar[XB_TOPGEN], 1u);
            else XB_SPIN(xb_ld(&bar[XB_TOPGEN]) == tg, bar);
            __builtin_amdgcn_fence(__ATOMIC_ACQUIRE, "agent");
            xb_add(&bar[XB_XGEN(b.x)], 1u);
            asm volatile("s_waitcnt vmcnt(0)" ::: "memory");
        } else {
            XB_SPIN(xb_ld(&bar[XB_XGEN(b.x)]) == gen, bar);
            __builtin_amdgcn_fence(__ATOMIC_ACQUIRE, "agent");
            asm volatile("s_waitcnt vmcnt(0)" ::: "memory");
        }
    }
    __syncthreads();
}

constexpr int NWAVES = 8;
constexpr int DM = 2048, TX = 8192, NMETA = 16, TT = TX + NMETA, MP = 8448;
constexpr int EV_NP = 5632, EV_LORA0 = 3072, EV_GB = 3360, EV_REC = 4384;
constexpr int OD_NP = 12544, OD_Z = 8192, OD_B = 12288, OD_A = 12320;
constexpr int NEXP = 32, FF = 512, MOE_ROWS = 24576;
constexpr float NORM_EPS = 1e-6f;

constexpr size_t MiB = 1u << 20;
constexpr size_t WS_CTL = 0, CTL_ZERO_BYTES = 1 * MiB;
constexpr size_t WS_TOKINFO = 1 * MiB;
constexpr size_t WS_TILES = 1 * MiB + 512 * 1024;
constexpr size_t WS_WEVIN = 2 * MiB;
constexpr size_t WS_WEVOUT = 24 * MiB;
constexpr size_t WS_WODIN = 32 * MiB;
constexpr size_t WS_WODOUT = 81 * MiB;
constexpr size_t WS_WLORA = 97 * MiB;
constexpr size_t WS_WGATE = 100 * MiB;
constexpr size_t WS_WROUTE = 101 * MiB;
constexpr size_t WS_MOEW = 102 * MiB;
constexpr size_t MOE_E_BYTES = 6 * MiB, MOE_W2_OFF = 4 * MiB;
constexpr size_t WS_H = 294 * MiB;
constexpr size_t WS_HN = 360 * MiB;
constexpr size_t WS_YMIX = 393 * MiB;
constexpr size_t WS_PROJ = 459 * MiB;
constexpr size_t WS_SCR = 662 * MiB;
constexpr size_t WS_END = 932 * MiB;
constexpr size_t SC_ALORA = 0;
constexpr size_t SC_XR = 8 * MiB;
constexpr size_t SC_DEC = 26 * MiB, SC_ICL = 60 * MiB, SC_GATE = 94 * MiB;
constexpr size_t SC_LA = 128 * MiB, SC_LIX = 162 * MiB;
constexpr size_t SC_QN = 0, SC_KN = 34 * MiB;
constexpr size_t SC_VC = 68 * MiB;
constexpr size_t SC_BETA = 134 * MiB, SC_G = 136 * MiB;
constexpr size_t SC_O = 138 * MiB;
constexpr size_t SC_XG = 0;
constexpr size_t SC_ACT = 96 * MiB;
constexpr size_t SC_YB = 120 * MiB;
static_assert(SC_O + (size_t)MP * 4096 * 4 <= WS_END - WS_SCR && SC_YB + (size_t)MOE_ROWS * 2048 * 2 <= WS_END - WS_SCR && SC_LIX + (size_t)MP * 1024 * 4 <= WS_END - WS_SCR, "scratch map");
constexpr int CW_TMO = 0, CW_CODE = 1;
constexpr int CW_BAR = 4096;
constexpr int CW_PROG = 20480;
constexpr int CW_TS = 24576;
constexpr int CW_MOECNT = 16384;

constexpr int RING_OFF = 0, RING_BYTES = 131072;
constexpr int LDSCTL_OFF = 146944, MISC_OFF = LDSCTL_OFF + 320;
constexpr int LDS_BYTES = 147456;


#define DI __device__ __forceinline__
typedef unsigned v2u __attribute__((ext_vector_type(2)));
struct Args { const float* in[36]; float* out; unsigned char* ws; int ph_lo, ph_hi; };
struct Frame {
    LAS unsigned char* lds; volatile LAS unsigned* MISC; gu32* ctl;
    int tid, lane, wave, vcu, G, gw, NGW;
};
DI float bf2f(bf16 v) { return __uint_as_float((unsigned)v << 16); }
DI float bflo(unsigned w) { return __uint_as_float(w << 16); }
DI float bfhi(unsigned w) { return __uint_as_float(w & 0xffff0000u); }
DI float wave_sum(float v) {
#pragma unroll
    for (int o = 1; o < 64; o <<= 1) v += __shfl_xor(v, o);
    return v;
}
DI float sigm(float x) { return __builtin_amdgcn_rcpf(1.0f + __expf(-x)); }
DI float softplus(float x) { return fmaxf(x, 0.f) + __logf(1.0f + __expf(-fabsf(x))); }
DI float gelu_tanh(float x) { const float u = 0.7978845608028654f * (x + 0.044715f * x * x * x); return 0.5f * x * (1.0f + tanhf(u)); }
DI int pos_row(int p) { return p < NMETA ? TX + p : p - NMETA; }
DI int row_pos(int r) { return r < TX ? r + NMETA : r - TX; }

DI void tr_item(const float* W, int N, int k0, int n0, bf16* WT, int ldk, int drow0, LAS float* scr, int lane) {
#pragma unroll 8
    for (int i = 0; i < 32; ++i) { const int kk = 2 * i + (lane >> 5); scr[kk * 33 + (lane & 31)] = W[(size_t)(k0 + kk) * N + n0 + (lane & 31)]; }
    LDS_WAIT(); asm volatile("" ::: "memory");
    const int c = lane & 7;
#pragma unroll
    for (int j = 0; j < 4; ++j) { const int n = (lane >> 3) + 8 * j; const LAS float* s = scr + (8 * c) * 33 + n;
        v4u o; o.x = pk2(s[0 * 33], s[1 * 33]); o.y = pk2(s[2 * 33], s[3 * 33]); o.z = pk2(s[4 * 33], s[5 * 33]); o.w = pk2(s[6 * 33], s[7 * 33]);
        *(v4u*)(WT + (size_t)(drow0 + n) * ldk + k0 + 8 * c) = o; }
    LDS_WAIT(); asm volatile("" ::: "memory");
}
DI void moe_convert(const Frame& F, const Args& a, int l, int gw, int ngw) {
    LAS float* scr = (LAS float*)(F.lds + RING_OFF + F.wave * 16384);
    bf16* base = (bf16*)(a.ws + WS_MOEW);
    for (int it = gw; it < NEXP * 1536; it += ngw) {
        const int e = it / 1536; int j = it % 1536; bf16* eb = base + (size_t)e * (MOE_E_BYTES / 2);
        const size_t eoff = (size_t)(l * NEXP + e) * DM * FF;
        if (j < 1024) { const float* W = (j < 512 ? a.in[33] : a.in[34]) + eoff; const int hi = j >= 512; j &= 511; const int kb = j >> 4, nb = j & 15, n0 = 32 * nb;
            tr_item(W, FF, 64 * kb, n0, eb, DM, 256 * (n0 >> 7) + 128 * hi + (n0 & 127), scr, F.lane); }
        else { j -= 1024; const int kb = j >> 6, nb = j & 63; tr_item(a.in[35] + eoff, DM, 64 * kb, 32 * nb, eb + MOE_W2_OFF / 2, FF, 32 * nb, scr, F.lane); }
    }
}
DI void norm_row_bf16(int lane, const float* src, const float* w, bf16* dst) {
    f32x4 v[8]; float s = 0.f;
#pragma unroll
    for (int j = 0; j < 8; ++j) { v[j] = ((const f32x4*)src)[lane + 64 * j]; s += (v[j].x * v[j].x + v[j].y * v[j].y) + (v[j].z * v[j].z + v[j].w * v[j].w); }
    const float rs = 1.0f / sqrtf(wave_sum(s) * (1.0f / DM) + NORM_EPS);
#pragma unroll
    for (int j = 0; j < 8; ++j) { const f32x4 wv = ((const f32x4*)w)[lane + 64 * j]; v2u o; o.x = pk2(v[j].x * rs * wv.x, v[j].y * rs * wv.y); o.y = pk2(v[j].z * rs * wv.z, v[j].w * rs * wv.w);
        ((v2u*)dst)[lane + 64 * j] = o; }
}

DI void ph_prologue(const Frame& F, const Args& a) {
    LAS float* scr = (LAS float*)(F.lds + RING_OFF + F.wave * 16384);
    constexpr int I_A = 32 * 169, I_B = 32 * 64, NIT = I_A + I_B;
    for (int it = F.gw; it < NIT; it += F.NGW) {
        int r = it;
        if (r < I_A) { const int kb = r / 169, nb = r % 169; tr_item(a.in[5], 5408, 64 * kb, 32 * nb, (bf16*)(a.ws + WS_WEVIN), DM, 32 * nb, scr, F.lane); continue; } r -= I_A;
        { const int kb = r / 64, nb = r % 64; tr_item(a.in[24], DM, 64 * kb, 32 * nb, (bf16*)(a.ws + WS_WEVOUT), DM, 32 * nb, scr, F.lane); }
    }
    const int gt = F.vcu * (NWAVES * 64) + F.tid, NGT = F.G * NWAVES * 64;
    { bf16* WL = (bf16*)(a.ws + WS_WLORA); const float* wup = a.in[8]; const float* aup = a.in[10]; const float* gup = a.in[11];
      for (int idx = gt; idx < 3072 * 384; idx += NGT) { const int n = idx / 384, k = idx % 384; float v = 0.f;
          if (n < 1024) { if (k < 64) v = wup[k * 1024 + n]; }
          else if (n < 2048) { if (k >= 64 && k < 128) v = aup[(k - 64) * 1024 + n - 1024]; }
          else { if (k >= 128 && k < 288) v = gup[(k - 128) * 1024 + n - 2048]; }
          WL[idx] = (bf16)f2bf(v); } }
    { bf16* WG = (bf16*)(a.ws + WS_WGATE);
      for (int idx = gt; idx < 2048 * 256; idx += NGT) { const int n = idx >> 8, kk = idx & 255, nn = n & 1023, blk = nn >> 6, j = nn & 63, cin = (nn & ~255) + kk;
          const float* W = n < 1024 ? a.in[19] : a.in[21];
          const float v = (cin >> 6) == blk ? W[blk * 4096 + (cin & 63) * 64 + j] : 0.f;
          WG[idx] = (bf16)f2bf(v); } }
    { bf16* WR = (bf16*)(a.ws + WS_WROUTE);
      for (int idx = gt; idx < 2 * 48 * DM; idx += NGT) { const int l = idx / (48 * DM), n = (idx / DM) % 48, k = idx % DM; float v = 0.f;
          if (n < 32) v = a.in[32][((size_t)l * DM + k) * NEXP + n]; else if (n < 36) v = a.in[31][((size_t)l * DM + k) * 4 + n - 32];
          const unsigned hi = f2bf(v); WR[((size_t)(l * 2) * 48 + n) * DM + k] = (bf16)hi; WR[((size_t)(l * 2 + 1) * 48 + n) * DM + k] = (bf16)f2bf(v - __uint_as_float(hi << 16)); } }
    bf16* HN = (bf16*)(a.ws + WS_HN);
    for (int r = F.gw; r < TT; r += F.NGW) norm_row_bf16(F.lane, r < TX ? a.in[0] + (size_t)r * DM : a.in[1] + (size_t)(r - TX) * DM, a.in[2], HN + (size_t)r * DM);
}

DI void ph_aux_convert(const Frame& F, const Args& a, int gw, int ngw) {
    LAS float* scr = (LAS float*)(F.lds + RING_OFF + F.wave * 16384);
    constexpr int I_C = 32 * 386, I_D = 64 * 64, NIT = I_C + I_D;
    for (int it = gw; it < NIT; it += ngw) {
        int r = it;
        if (r < I_C) { const int kb = r / 386, nb = r % 386; tr_item(a.in[25], 12352, 64 * kb, 32 * nb, (bf16*)(a.ws + WS_WODIN), DM, 32 * nb, scr, F.lane); continue; } r -= I_C;
        { const int kb = r / 64, nb = r % 64; tr_item(a.in[30], DM, 64 * kb, 32 * nb, (bf16*)(a.ws + WS_WODOUT), 4096, 32 * nb, scr, F.lane); }
    }
    moe_convert(F, a, 0, gw, ngw);
}

DI void ph_even_prep(const Frame& F, const Args& a) {
    const bf16* P = (const bf16*)(a.ws + WS_PROJ); bf16* AL = (bf16*)(a.ws + WS_SCR + SC_ALORA); bf16* XR = (bf16*)(a.ws + WS_SCR + SC_XR);
    const float* mu = a.in[6]; const float* cw = a.in[17]; const float* cb = a.in[18];
    const int lane = F.lane;
    for (int item = F.gw; item < TT + (TT / 8) * 2; item += F.NGW) {
        if (item < TT) { const int r = item, pos = row_pos(r); const bf16* cur = P + (size_t)r * EV_NP; const bf16* prv = P + (size_t)pos_row(pos > 0 ? pos - 1 : 0) * EV_NP; const float pm = pos > 0 ? 1.f : 0.f;
            float cv[6], pv[6], mv[6];
#pragma unroll
            for (int i = 0; i < 6; ++i) { const int idx = lane + 64 * i, col = EV_LORA0 + (idx < 288 ? idx : 287); cv[i] = bf2f(cur[col]); pv[i] = bf2f(prv[col]) * pm; mv[i] = mu[col]; }
#pragma unroll
            for (int i = 0; i < 6; ++i) { const int idx = lane + 64 * i; float v = cv[i] + (pv[i] - cv[i]) * mv[i];
                if (idx < 64) v = tanhf(v); else if (idx >= 128) v = sigm(v);
                AL[(size_t)r * 384 + idx] = (bf16)f2bf(idx < 288 ? v : 0.f); }
        } else { const int it2 = item - TT, pb = it2 >> 1, c0 = (it2 & 1) * 512 + lane * 8, p0 = pb * 8;
            f32x4 w[4][2], b0 = *(const f32x4*)(cb + c0), b1 = *(const f32x4*)(cb + c0 + 4);
#pragma unroll
            for (int j = 0; j < 4; ++j) { w[j][0] = *(const f32x4*)(cw + j * 1024 + c0); w[j][1] = *(const f32x4*)(cw + j * 1024 + c0 + 4); }
            v4u x[11];
#pragma unroll
            for (int i = 0; i < 11; ++i) { const int p = p0 - 3 + i; x[i] = *(const v4u*)(P + (size_t)pos_row(p > 0 ? p : 0) * EV_NP + EV_REC + c0); if (p < 0) x[i] = (v4u){0u, 0u, 0u, 0u}; }
#pragma unroll
            for (int o = 0; o < 8; ++o) { float acc[8] = {b0.x, b0.y, b0.z, b0.w, b1.x, b1.y, b1.z, b1.w};
#pragma unroll
                for (int j = 0; j < 4; ++j) { const v4u xv = x[o + j];
                    acc[0] += w[j][0].x * bflo(xv.x); acc[1] += w[j][0].y * bfhi(xv.x); acc[2] += w[j][0].z * bflo(xv.y); acc[3] += w[j][0].w * bfhi(xv.y);
                    acc[4] += w[j][1].x * bflo(xv.z); acc[5] += w[j][1].y * bfhi(xv.z); acc[6] += w[j][1].z * bflo(xv.w); acc[7] += w[j][1].w * bfhi(xv.w); }
                *(v4u*)(XR + (size_t)pos_row(p0 + o) * 1024 + c0) = (v4u){pk2(acc[0], acc[1]), pk2(acc[2], acc[3]), pk2(acc[4], acc[5]), pk2(acc[6], acc[7])}; } }
    }
}

DI void ph_route(const Frame& F, const Args& a, int l, int dummy) {
    const float* H = (const float*)(a.ws + WS_H); const float* nw = a.in[3] + (size_t)l * DM;
    const bf16* WH = (const bf16*)(a.ws + WS_WROUTE) + (size_t)(l * 2) * 48 * DM; const bf16* WL = WH + (size_t)48 * DM;
    unsigned* TI = (unsigned*)(a.ws + WS_TOKINFO) + (dummy ? (WS_SCR + 250 * MiB - WS_TOKINFO) / 4 : 0); const int lane = F.lane, lc = lane & 15, quad = lane >> 4, wave = F.wave; const int cl = dummy ? l + 2 : l;
    LAS float* red = (LAS float*)(F.lds + RING_OFF);
    LAS float* sq = red + 8 * 9 * 64 * 4; LAS float* lgs = sq + 8 * 48;
    static_assert(TT % 48 == 0, "router tasks");
    for (int task = F.vcu; task < TT / 48; task += F.G) {
        const float* nwp = nw + 256 * wave + 8 * quad; float ss[3] = {0.f, 0.f, 0.f};
        f32x4 acc[3][3];
#pragma unroll
        for (int mt = 0; mt < 3; ++mt)
#pragma unroll
            for (int nt = 0; nt < 3; ++nt) acc[mt][nt] = (f32x4){0.f, 0.f, 0.f, 0.f};
#pragma unroll 2
        for (int ks = 0; ks < 8; ++ks) { const int k0 = 256 * wave + 32 * ks + 8 * quad; const f32x4 w0 = *(const f32x4*)(nwp + 32 * ks), w1 = *(const f32x4*)(nwp + 32 * ks + 4);
            bf16x8 bh[3], bl[3];
#pragma unroll
            for (int nt = 0; nt < 3; ++nt) { bh[nt] = *(const bf16x8*)(WH + (size_t)(16 * nt + lc) * DM + k0); bl[nt] = *(const bf16x8*)(WL + (size_t)(16 * nt + lc) * DM + k0); }
#pragma unroll
            for (int mt = 0; mt < 3; ++mt) { const float* hr = H + (size_t)(task * 48 + mt * 16 + lc) * DM + k0; const f32x4 x0 = *(const f32x4*)hr, x1 = *(const f32x4*)(hr + 4);
                ss[mt] += (x0.x * x0.x + x0.y * x0.y) + (x0.z * x0.z + x0.w * x0.w) + (x1.x * x1.x + x1.y * x1.y) + (x1.z * x1.z + x1.w * x1.w);
                const float xn[8] = {x0.x * w0.x, x0.y * w0.y, x0.z * w0.z, x0.w * w0.w, x1.x * w1.x, x1.y * w1.y, x1.z * w1.z, x1.w * w1.w};
                unsigned hi[8]; float lo[8];
#pragma unroll
                for (int q = 0; q < 8; ++q) { hi[q] = f2bf(xn[q]); lo[q] = xn[q] - __uint_as_float(hi[q] << 16); }
                const v4u ah4 = (v4u){hi[0] | (hi[1] << 16), hi[2] | (hi[3] << 16), hi[4] | (hi[5] << 16), hi[6] | (hi[7] << 16)}, al4 = (v4u){pk2(lo[0], lo[1]), pk2(lo[2], lo[3]), pk2(lo[4], lo[5]), pk2(lo[6], lo[7])};
                const bf16x8 ah = __builtin_bit_cast(bf16x8, ah4), al = __builtin_bit_cast(bf16x8, al4);
#pragma unroll
                for (int nt = 0; nt < 3; ++nt) { acc[mt][nt] = __builtin_amdgcn_mfma_f32_16x16x32_bf16(al, bh[nt], acc[mt][nt], 0, 0, 0); acc[mt][nt] = __builtin_amdgcn_mfma_f32_16x16x32_bf16(ah, bl[nt], acc[mt][nt], 0, 0, 0);
                    acc[mt][nt] = __builtin_amdgcn_mfma_f32_16x16x32_bf16(ah, bh[nt], acc[mt][nt], 0, 0, 0); } } }
#pragma unroll
        for (int mt = 0; mt < 3; ++mt) { float s_ = ss[mt]; s_ += __shfl_xor(s_, 16); s_ += __shfl_xor(s_, 32); if (quad == 0) sq[wave * 48 + mt * 16 + lc] = s_;
#pragma unroll
            for (int nt = 0; nt < 3; ++nt) *(LAS f32x4*)(red + ((wave * 9 + mt * 3 + nt) * 64 + lane) * 4) = acc[mt][nt]; }
        __syncthreads();
        { const int tile = wave;
#pragma unroll
          for (int rep = 0; rep < 2; ++rep) { const int tl = tile + 8 * rep; if (tl < 9) { f32x4 s = *(const LAS f32x4*)(red + (tl * 64 + lane) * 4);
#pragma unroll
              for (int v = 1; v < 8; ++v) s = s + *(const LAS f32x4*)(red + ((v * 9 + tl) * 64 + lane) * 4);
              const int mt = tl / 3, nt = tl % 3;
#pragma unroll
              for (int q = 0; q < 4; ++q) lgs[(mt * 16 + 4 * quad + q) * 49 + 16 * nt + lc] = s[q]; } } }
        __syncthreads();
        if (wave == 0 && lane < 48) { float sst = 0.f;
#pragma unroll
            for (int v = 0; v < 8; ++v) sst += sq[v * 48 + lane];
            const float rs = 1.0f / sqrtf(sst * (1.0f / DM) + NORM_EPS);
            float lg[36];
#pragma unroll
            for (int i = 0; i < 36; ++i) lg[i] = lgs[lane * 49 + i] * rs;
            int gi = 0; float gm = lg[32];
#pragma unroll
            for (int i = 1; i < 4; ++i) if (lg[32 + i] > gm) { gm = lg[32 + i]; gi = i; }
            float den = 0.f;
#pragma unroll
            for (int i = 0; i < 4; ++i) den += __expf(lg[32 + i] - gm);
            const float gp = 1.0f / den;
            float l8[8];
#pragma unroll
            for (int i = 0; i < 8; ++i) l8[i] = gi == 0 ? lg[i] : (gi == 1 ? lg[8 + i] : (gi == 2 ? lg[16 + i] : lg[24 + i]));
            int i1 = 0; float m1 = l8[0];
#pragma unroll
            for (int i = 1; i < 8; ++i) if (l8[i] > m1) { m1 = l8[i]; i1 = i; }
            int i2 = -1; float m2 = -INFINITY;
#pragma unroll
            for (int i = 0; i < 8; ++i) if (i != i1 && l8[i] > m2) { m2 = l8[i]; i2 = i; }
            const float e21 = __expf(m2 - m1); const float w1 = gp / (1.0f + e21), w2 = gp * e21 / (1.0f + e21);
            const int ea = gi * 8 + i1, eb = gi * 8 + i2; const int rt = task * 48 + lane;
            const unsigned sa = atomicAdd((unsigned*)(F.ctl + CW_MOECNT + (cl * NEXP + ea) * 16), 1u), sb = atomicAdd((unsigned*)(F.ctl + CW_MOECNT + (cl * NEXP + eb) * 16), 1u);
            unsigned* t = TI + (size_t)rt * 8; *(v4u*)t = (v4u){(unsigned)ea, sa, __float_as_uint(w1), (unsigned)eb}; *(v4u*)(t + 4) = (v4u){sb, __float_as_uint(w2), __float_as_uint(rs), 0u}; }
        __syncthreads();
    }
}
DI void moe_prefix(const Frame& F, int l, LAS int* ps) {
    if (F.tid == 0) { int t = 0;
        for (int e = 0; e < NEXP; ++e) { const unsigned c = __hip_atomic_load(F.ctl + CW_MOECNT + (l * NEXP + e) * 16, RLX_AGENT); ps[e] = t * 256; t += (int)((c + 255u) >> 8); }
        ps[32] = t; }
    __syncthreads();
}
DI void ph_gather(const Frame& F, const Args& a, int l) {
    LAS int* ps = (LAS int*)(F.lds + RING_OFF); moe_prefix(F, l, ps);
    if (F.vcu == 0 && F.tid < NEXP) { int* TE = (int*)(a.ws + WS_TILES); const int e = F.tid; const int t0 = ps[e] >> 8, t1 = (e == NEXP - 1 ? ps[32] : ps[e + 1] >> 8);
        for (int t = t0; t < t1; ++t) TE[t] = e; if (e == 0) TE[127] = ps[32]; }
    const float* H = (const float*)(a.ws + WS_H); const float* nw = a.in[3] + (size_t)l * DM; unsigned* TI = (unsigned*)(a.ws + WS_TOKINFO); bf16* XG = (bf16*)(a.ws + WS_SCR + SC_XG);
    const int lane = F.lane;
    for (int r = F.gw; r < TT; r += F.NGW) {
        unsigned* t = TI + (size_t)r * 8; const int g0 = ps[t[0]] + (int)t[1], g1 = ps[t[3]] + (int)t[4]; const float rs = __uint_as_float(t[6]);
        if (lane == 0) t[7] = (unsigned)g0 | ((unsigned)g1 << 16);
        const float* hr = H + (size_t)r * DM;
#pragma unroll
        for (int j = 0; j < 4; ++j) { const int e0 = (lane + 64 * j) * 8; const f32x4 x0 = *(const f32x4*)(hr + e0), x1 = *(const f32x4*)(hr + e0 + 4), w0 = *(const f32x4*)(nw + e0), w1 = *(const f32x4*)(nw + e0 + 4);
            v4u o; o.x = pk2(x0.x * rs * w0.x, x0.y * rs * w0.y); o.y = pk2(x0.z * rs * w0.z, x0.w * rs * w0.w); o.z = pk2(x1.x * rs * w1.x, x1.y * rs * w1.y); o.w = pk2(x1.z * rs * w1.z, x1.w * rs * w1.w);
            *(v4u*)(XG + (size_t)g0 * DM + e0) = o; *(v4u*)(XG + (size_t)g1 * DM + e0) = o; }
    }
}
DI void ph_combine(const Frame& F, const Args& a, int l) {
    float* H = (float*)(a.ws + WS_H); const unsigned* TI = (const unsigned*)(a.ws + WS_TOKINFO); const bf16* YB = (const bf16*)(a.ws + WS_SCR + SC_YB); bf16* HN = (bf16*)(a.ws + WS_HN);
    const int lane = F.lane; const int nrows = l == 0 ? TT : TX;
    for (int r = F.gw; r < nrows; r += F.NGW) {
        const unsigned* t = TI + (size_t)r * 8; const int g0 = (int)(t[7] & 0xffffu), g1 = (int)(t[7] >> 16); const float w0 = __uint_as_float(t[2]), w1 = __uint_as_float(t[5]);
        float* hr = H + (size_t)r * DM; float hv[32]; float s = 0.f;
#pragma unroll
        for (int j = 0; j < 4; ++j) { const int e0 = (lane + 64 * j) * 8; const f32x4 x0 = *(const f32x4*)(hr + e0), x1 = *(const f32x4*)(hr + e0 + 4);
            const v4u ya = *(const v4u*)(YB + (size_t)g0 * DM + e0), yc = *(const v4u*)(YB + (size_t)g1 * DM + e0);
            float* o = hv + 8 * j;
            o[0] = x0.x + w0 * bflo(ya.x) + w1 * bflo(yc.x); o[1] = x0.y + w0 * bfhi(ya.x) + w1 * bfhi(yc.x); o[2] = x0.z + w0 * bflo(ya.y) + w1 * bflo(yc.y); o[3] = x0.w + w0 * bfhi(ya.y) + w1 * bfhi(yc.y);
            o[4] = x1.x + w0 * bflo(ya.z) + w1 * bflo(yc.z); o[5] = x1.y + w0 * bfhi(ya.z) + w1 * bfhi(yc.z); o[6] = x1.z + w0 * bflo(ya.w) + w1 * bflo(yc.w); o[7] = x1.w + w0 * bfhi(ya.w) + w1 * bfhi(yc.w);
#pragma unroll
            for (int q = 0; q < 8; ++q) s += o[q] * o[q]; }
        const float rs = 1.0f / sqrtf(wave_sum(s) * (1.0f / DM) + NORM_EPS);
        if (l == 0) { const float* nw = a.in[2] + DM;
#pragma unroll
            for (int j = 0; j < 4; ++j) { const int e0 = (lane + 64 * j) * 8; const float* o = hv + 8 * j; const f32x4 wa = *(const f32x4*)(nw + e0), wb = *(const f32x4*)(nw + e0 + 4);
                *(f32x4*)(hr + e0) = (f32x4){o[0], o[1], o[2], o[3]}; *(f32x4*)(hr + e0 + 4) = (f32x4){o[4], o[5], o[6], o[7]};
                v4u p; p.x = pk2(o[0] * rs * wa.x, o[1] * rs * wa.y); p.y = pk2(o[2] * rs * wa.z, o[3] * rs * wa.w); p.z = pk2(o[4] * rs * wb.x, o[5] * rs * wb.y); p.w = pk2(o[6] * rs * wb.z, o[7] * rs * wb.w);
                *(v4u*)(HN + (size_t)r * DM + e0) = p; }
        } else { const float* nw = a.in[4]; float* orow = a.out + (size_t)r * DM;
#ifdef PROBE_TS
            { const unsigned long long* ts = (const unsigned long long*)(F.ctl + CW_TS); const float dt_us = (float)(__hip_atomic_load(ts + PROBE_TS + 1, RLX_AGENT) - __hip_atomic_load(ts + PROBE_TS, RLX_AGENT)) * 0.01f;
#pragma unroll
              for (int q = 0; q < 32; ++q) hv[q] *= 1.0f + dt_us * 0.01f; }
#endif
#pragma unroll
            for (int j = 0; j < 4; ++j) { const int e0 = (lane + 64 * j) * 8; const float* o = hv + 8 * j; const f32x4 wa = *(const f32x4*)(nw + e0), wb = *(const f32x4*)(nw + e0 + 4);
                *(f32x4*)(orow + e0) = (f32x4){o[0] * rs * wa.x, o[1] * rs * wa.y, o[2] * rs * wa.z, o[3] * rs * wa.w};
                *(f32x4*)(orow + e0 + 4) = (f32x4){o[4] * rs * wb.x, o[5] * rs * wb.y, o[6] * rs * wb.z, o[7] * rs * wb.w}; } }
    }
}

struct OddPrepItem { f32x4 w[4][2]; v4u x[11]; };
DI void odd_prep_load(OddPrepItem& it, const bf16* P, const float* cw, int item, int lane) {
    const int pb = item >> 4, i = item & 15, ch = i * 512 + lane * 8, p0 = pb * 8;
#pragma unroll
    for (int j = 0; j < 4; ++j) { it.w[j][0] = *(const f32x4*)(cw + j * 8192 + ch); it.w[j][1] = *(const f32x4*)(cw + j * 8192 + ch + 4); }
#pragma unroll
    for (int q = 0; q < 11; ++q) { const int p = p0 - 3 + q; it.x[q] = *(const v4u*)(P + (size_t)pos_row(p > 0 ? p : 0) * OD_NP + ch); if (p < 0) it.x[q] = (v4u){0u, 0u, 0u, 0u}; }
}
DI void odd_prep_compute(const OddPrepItem& it, const Args& a, int item, int lane) {
    const bf16* P = (const bf16*)(a.ws + WS_PROJ); bf16* QN = (bf16*)(a.ws + WS_SCR + SC_QN); bf16* KN = (bf16*)(a.ws + WS_SCR + SC_KN); bf16* VC = (bf16*)(a.ws + WS_SCR + SC_VC);
    float* BETA = (float*)(a.ws + WS_SCR + SC_BETA); float* GG = (float*)(a.ws + WS_SCR + SC_G);
    const int pb = item >> 4, i = item & 15, ch = i * 512 + lane * 8, p0 = pb * 8;
#pragma unroll
    for (int o = 0; o < 8; ++o) { const int r = pos_row(p0 + o); float acc[8] = {0.f, 0.f, 0.f, 0.f, 0.f, 0.f, 0.f, 0.f};
#pragma unroll
        for (int j = 0; j < 4; ++j) { const v4u xv = it.x[o + j];
            acc[0] += it.w[j][0].x * bflo(xv.x); acc[1] += it.w[j][0].y * bfhi(xv.x); acc[2] += it.w[j][0].z * bflo(xv.y); acc[3] += it.w[j][0].w * bfhi(xv.y);
            acc[4] += it.w[j][1].x * bflo(xv.z); acc[5] += it.w[j][1].y * bfhi(xv.z); acc[6] += it.w[j][1].z * bflo(xv.w); acc[7] += it.w[j][1].w * bfhi(xv.w); }
        float ss = 0.f;
#pragma unroll
        for (int q = 0; q < 8; ++q) { acc[q] = acc[q] * sigm(acc[q]); ss += acc[q] * acc[q]; }
        float sc = 1.0f;
        if (i < 8) { ss += __shfl_xor(ss, 1); ss += __shfl_xor(ss, 2); ss += __shfl_xor(ss, 4); ss += __shfl_xor(ss, 8);
            sc = (1.0f / sqrtf(ss + NORM_EPS)) * (i < 4 ? 0.08838834764831845f : 1.0f); }
        const v4u ov = (v4u){pk2(acc[0] * sc, acc[1] * sc), pk2(acc[2] * sc, acc[3] * sc), pk2(acc[4] * sc, acc[5] * sc), pk2(acc[6] * sc, acc[7] * sc)};
        bf16* dst = i < 4 ? QN + (size_t)r * 2048 + ch : (i < 8 ? KN + (size_t)r * 2048 + ch - 2048 : VC + (size_t)r * 4096 + ch - 4096);
        *(v4u*)dst = ov; }
    if (i == 0 && lane < 32) {
#pragma unroll
        for (int o = 0; o < 8; ++o) { const int r = pos_row(p0 + o); const float bb = bf2f(P[(size_t)r * OD_NP + OD_B + lane]), aa = bf2f(P[(size_t)r * OD_NP + OD_A + lane]);
            BETA[(size_t)r * 32 + lane] = sigm(bb); GG[(size_t)r * 32 + lane] = -__expf(a.in[27][lane]) * softplus(aa + a.in[28][lane]); } }
}
DI void ph_odd_prep(const Frame& F, const Args& a) {
    const bf16* P = (const bf16*)(a.ws + WS_PROJ); const float* cw = a.in[26]; constexpr int NI = (TT / 8) * 16;
    for (int item = F.gw; item < NI; item += 2 * F.NGW) { OddPrepItem A, B; const bool hb = item + F.NGW < NI;
        odd_prep_load(A, P, cw, item, F.lane); odd_prep_load(B, P, cw, hb ? item + F.NGW : item, F.lane);
        odd_prep_compute(A, a, item, F.lane); if (hb) odd_prep_compute(B, a, item + F.NGW, F.lane); }
}
constexpr int ODD_POST_ROWS0 = 64 * 113;
DI void ph_odd_post(const Frame& F, const Args& a, int part) {
    const bf16* P = (const bf16*)(a.ws + WS_PROJ); const bf16* O = (const bf16*)(a.ws + WS_SCR + SC_O); bf16* Y = (bf16*)(a.ws + WS_YMIX); const float* nw = a.in[29];
    const int lane = F.lane; int w0 = F.gw, wn = F.NGW, n_rows = TX - ODD_POST_ROWS0;
    if (part == 0) { const int wx = F.vcu & 31; if (F.G != 256 || wx < 20) return; w0 = ((F.vcu >> 5) * 12 + (wx - 20)) * NWAVES + F.wave; wn = 96 * NWAVES; n_rows = ODD_POST_ROWS0 + NMETA; }
    if (part == 2) n_rows = TT;
    for (int ri = w0; ri < n_rows; ri += wn) { const int r = part == 0 ? (ri < ODD_POST_ROWS0 ? ri : TX + ri - ODD_POST_ROWS0) : (part == 1 ? ODD_POST_ROWS0 + ri : ri);
#pragma unroll 2
        for (int i = 0; i < 8; ++i) { const int ch = i * 512 + lane * 8; const v4u ow = *(const v4u*)(O + (size_t)r * 4096 + ch); const f32x4 o0 = (f32x4){bflo(ow.x), bfhi(ow.x), bflo(ow.y), bfhi(ow.y)}, o1 = (f32x4){bflo(ow.z), bfhi(ow.z), bflo(ow.w), bfhi(ow.w)};
            float ss = (o0.x * o0.x + o0.y * o0.y) + (o0.z * o0.z + o0.w * o0.w) + (o1.x * o1.x + o1.y * o1.y) + (o1.z * o1.z + o1.w * o1.w);
            ss += __shfl_xor(ss, 1); ss += __shfl_xor(ss, 2); ss += __shfl_xor(ss, 4); ss += __shfl_xor(ss, 8);
            const float rs = 1.0f / sqrtf(ss * (1.0f / 128.0f) + NORM_EPS);
            const v4u z = *(const v4u*)(P + (size_t)r * OD_NP + OD_Z + ch); const int c0 = ch & 127; const f32x4 w0 = *(const f32x4*)(nw + c0), w1 = *(const f32x4*)(nw + c0 + 4);
            const float zf[8] = {bflo(z.x), bfhi(z.x), bflo(z.y), bfhi(z.y), bflo(z.z), bfhi(z.z), bflo(z.w), bfhi(z.w)};
            const float of[8] = {o0.x * w0.x, o0.y * w0.y, o0.z * w0.z, o0.w * w0.w, o1.x * w1.x, o1.y * w1.y, o1.z * w1.z, o1.w * w1.w};
            float y[8];
#pragma unroll
            for (int q = 0; q < 8; ++q) y[q] = of[q] * rs * zf[q] * sigm(zf[q]);
            v4u p; p.x = pk2(y[0], y[1]); p.y = pk2(y[2], y[3]); p.z = pk2(y[4], y[5]); p.w = pk2(y[6], y[7]);
            *(v4u*)(Y + (size_t)r * 4096 + ch) = p; }
    }
}

typedef float f32x16 __attribute__((ext_vector_type(16)));
#define MFMA32(a, b, c) __builtin_amdgcn_mfma_f32_32x32x16_bf16((a), (b), (c), 0, 0, 0)
DI int crow(int reg, int h) { return (reg & 3) + 8 * (reg >> 2) + 4 * h; }
DI int chunk_row(int n, int c) { return n == 0 ? (c >= 48 ? TX + (c - 48) : -1) : 64 * (n - 1) + c; }
#ifndef GDN_NO_HELPER
#define GDN_NO_HELPER 0
#endif
constexpr int GDN_NCH = 129, GDN_UNITS = GDN_NCH * 32, GDN_KUNITS = GDN_NCH * 16, GC_STRIDE = 72;
constexpr size_t GD_WF = WS_MOEW, GD_UF = WS_MOEW + 65 * MiB, GD_IN = WS_MOEW + 130 * MiB, GD_GC = WS_MOEW + 163 * MiB, GD_KT = WS_HN, GD_QF = WS_SCR + 208 * MiB, GD_SAVE = WS_SCR + 205 * MiB;
static_assert(GD_QF + (size_t)GDN_KUNITS * 16384 <= WS_END && GD_SAVE + 2 * MiB <= GD_QF && (size_t)GDN_UNITS * 16384 <= 65 * MiB && (size_t)GDN_UNITS * 8192 <= 33 * MiB && (size_t)GDN_KUNITS * 16384 <= 33 * MiB && GD_GC + (size_t)GDN_UNITS * GC_STRIDE * 4 <= WS_H, "gdn map");

DI void ph_gdn_chunk(const Frame& F, const Args& a, int n_lo, int n_hi, int side) {
    const bf16* QN = (const bf16*)(a.ws + WS_SCR + SC_QN); const bf16* KN = (const bf16*)(a.ws + WS_SCR + SC_KN); const bf16* VC = (const bf16*)(a.ws + WS_SCR + SC_VC);
    const float* BETA = (const float*)(a.ws + WS_SCR + SC_BETA); const float* GG = (const float*)(a.ws + WS_SCR + SC_G);
    bf16* WF = (bf16*)(a.ws + GD_WF); bf16* UF = (bf16*)(a.ws + GD_UF); bf16* INF = (bf16*)(a.ws + GD_IN); bf16* KTF = (bf16*)(a.ws + GD_KT); bf16* QF = (bf16*)(a.ws + GD_QF); float* GC = (float*)(a.ws + GD_GC);
    LAS unsigned char* L = F.lds + RING_OFF;
    LAS unsigned char* kS = L; LAS unsigned char* qS = L + 17408; LAS unsigned char* vS = L + 34816; LAS unsigned char* kbS = L + 52224;
    LAS float* Lm = (LAS float*)(L + 69632); LAS bf16* IS = (LAS bf16*)(L + 87040); LAS bf16* XS = (LAS bf16*)(L + 96256);
    LAS float* betaS = (LAS float*)(L + 130048); LAS float* gcS = betaS + 64; LAS float* egcS = betaS + 128;
    LAS unsigned char* Lb = L + 17408; LAS unsigned char* TDs = L + 26624; LAS unsigned char* YT0 = L + 28672; LAS unsigned char* XT0 = L + 130816;
    static_assert(130816 + 8 * 1792 <= LDSCTL_OFF, "gdn lds map");
    const int tid = F.tid, lane = F.lane, wave = F.wave, l31 = lane & 31, h = lane >> 5;
    int widx = F.vcu, wcnt = F.G;
    if (side) { if (F.G == 256) { const int wx = F.vcu & 31; if (wx < 20) return; widx = (F.vcu >> 5) * 12 + (wx - 20); wcnt = 96; } else { if (F.vcu < 128 || F.G <= 128) return; widx = F.vcu - 128; wcnt = F.G - 128; } }
#define G1_BAR() do { asm volatile("s_waitcnt lgkmcnt(0)" ::: "memory"); __builtin_amdgcn_s_barrier(); asm volatile("" ::: "memory"); } while (0)
    v4u pkx[2], pqx[2], pvx[2]; float pbeta = 0.f, pgl = 0.f;
#define G1_FETCH(uu) do { const int n_ = (uu) >> 5, hv_ = (uu) & 31, hk_ = hv_ >> 1; \
        _Pragma("unroll") for (int i = 0; i < 2; ++i) { const int p = tid + 512 * i, row = p >> 4, ch = p & 15; const int rr = chunk_row(n_, row); const size_t r_ = (size_t)(rr >= 0 ? rr : 0); \
            pkx[i] = *(const v4u*)(KN + r_ * 2048 + hk_ * 128 + ch * 8); pqx[i] = *(const v4u*)(QN + r_ * 2048 + hk_ * 128 + ch * 8); pvx[i] = *(const v4u*)(VC + r_ * 4096 + hv_ * 128 + ch * 8); \
            if (rr < 0) { pkx[i] = (v4u){0u, 0u, 0u, 0u}; pqx[i] = pkx[i]; pvx[i] = pkx[i]; } } \
        if (wave == 0) { const int rr = chunk_row(n_, lane); const size_t r_ = (size_t)(rr >= 0 ? rr : 0); pbeta = BETA[r_ * 32 + hv_]; pgl = GG[r_ * 32 + hv_]; if (rr < 0) { pbeta = 0.f; pgl = 0.f; } } } while (0)
    const int unit0 = n_lo * 32 + widx;
    if (unit0 < n_hi * 32) G1_FETCH(unit0);
    for (int unit = unit0; unit < n_hi * 32; unit += wcnt) {
        const int n = unit >> 5, hv = unit & 31, hk = hv >> 1; const size_t su = (size_t)hv * GDN_NCH + n;
#pragma unroll
        for (int i = 0; i < 2; ++i) { const int p = tid + 512 * i, row = p >> 4, ch = p & 15;
            *(LAS v4u*)(kS + row * 272 + ch * 16) = pkx[i]; *(LAS v4u*)(qS + row * 272 + ch * 16) = pqx[i]; *(LAS v4u*)(vS + row * 272 + ch * 16) = pvx[i]; }
        if (wave == 0) { float b = pbeta, g = pgl;
#pragma unroll
            for (int o = 1; o < 64; o <<= 1) { const float t = __shfl_up(g, o); if (lane >= o) g += t; }
            betaS[lane] = b; gcS[lane] = g; egcS[lane] = __expf(g); }
        if (unit + wcnt < n_hi * 32) G1_FETCH(unit + wcnt);
        G1_BAR();
        if ((hv & 1) == 0) { const size_t kunit = (size_t)hk * GDN_NCH + n;
#pragma unroll
            for (int i = 0; i < 2; ++i) { const int p = tid + 512 * i, comb = p >> 6, ln = p & 63, t = comb >> 3, s = comb & 7; const int c = 32 * t + (ln & 31), k0 = 16 * s + 8 * (ln >> 5);
                *(v4u*)(QF + (kunit * 16 + comb) * 512 + ln * 8) = *(const LAS v4u*)(qS + c * 272 + k0 * 2); } }
#pragma unroll
        for (int i = 0; i < 2; ++i) { const int p = tid + 512 * i, row = p >> 4, ch = p & 15; const v4u kx = *(const LAS v4u*)(kS + row * 272 + ch * 16); const float b = betaS[row];
            v4u o; o.x = pk2(bflo(kx.x) * b, bfhi(kx.x) * b); o.y = pk2(bflo(kx.y) * b, bfhi(kx.y) * b); o.z = pk2(bflo(kx.z) * b, bfhi(kx.z) * b); o.w = pk2(bflo(kx.w) * b, bfhi(kx.w) * b);
            *(LAS v4u*)(kbS + row * 272 + ch * 16) = o; }
        G1_BAR();
        { const int which = wave >> 2, ti = (wave >> 1) & 1, tj = wave & 1;
          f32x16 acc;
#pragma unroll
          for (int r = 0; r < 16; ++r) acc[r] = 0.f;
          if (!(ti == 0 && tj == 1)) { const LAS unsigned char* Ab = (which == 0 ? kbS : qS) + (32 * ti + l31) * 272 + 16 * h; const LAS unsigned char* Bb = kS + (32 * tj + l31) * 272 + 16 * h;
#pragma unroll
              for (int s = 0; s < 8; ++s) acc = MFMA32(*(const LAS bf16x8*)(Ab + 32 * s), *(const LAS bf16x8*)(Bb + 32 * s), acc); }
          const int j = 32 * tj + l31; const float gj = gcS[j];
#pragma unroll
          for (int r = 0; r < 16; ++r) { const int i = 32 * ti + crow(r, h); const float e = __expf(fminf(gcS[i] - gj, 0.f));
              if (which == 0) Lm[i * 68 + j] = i > j ? acc[r] * e : 0.f;
              else IS[i * 72 + j] = (bf16)f2bf(i >= j ? acc[r] * e : 0.f); } }
        G1_BAR();
#pragma unroll
        for (int i = 0; i < 8; ++i) { const int e = tid + 512 * i, r = e >> 6, c = e & 63; *(LAS bf16*)(Lb + r * 144 + c * 2) = (bf16)f2bf(Lm[r * 68 + c]); }
        if (wave == 0) { const int b = lane >> 4, c = lane & 15; float t[16]; const LAS float* Ld = Lm + (16 * b) * 68 + 16 * b;
            t[0] = c == 0 ? 1.f : 0.f; *(LAS bf16*)(TDs + (b * 16) * 32 + c * 2) = (bf16)f2bf(t[0]);
#define G1_INV_ROWS(I0, I1) do { f32x4 Lr[(I1) - (I0)][4]; \
            _Pragma("unroll") for (int i = (I0); i < (I1); ++i) _Pragma("unroll") for (int q = 0; q < (i + 3) / 4; ++q) Lr[i - (I0)][q] = *(const LAS f32x4*)(Ld + i * 68 + 4 * q); \
            _Pragma("unroll") for (int i = (I0); i < (I1); ++i) { float a0 = i == c ? 1.f : 0.f, a1 = 0.f; \
                _Pragma("unroll") for (int j = 0; j < i; ++j) { const float lv = Lr[i - (I0)][j >> 2][j & 3]; if (j & 1) a1 -= lv * t[j]; else a0 -= lv * t[j]; } \
                t[i] = a0 + a1; *(LAS bf16*)(TDs + (b * 16 + i) * 32 + c * 2) = (bf16)f2bf(t[i]); } } while (0)
            G1_INV_ROWS(1, 9); G1_INV_ROWS(9, 13); G1_INV_ROWS(13, 16);
#undef G1_INV_ROWS
        } else if (wave >= 4) { const int t2 = tid - 256;
#pragma unroll
            for (int i = 0; i < 2; ++i) { const int p = t2 + 256 * i, comb = p >> 6, ln = p & 63, t = comb >> 2, s = comb & 3; const int c = 32 * t + (ln & 31), j0 = 16 * s + 8 * (ln >> 5);
                *(v4u*)(INF + (su * 8 + comb) * 512 + ln * 8) = *(const LAS v4u*)(IS + c * 72 + j0); }
            if ((hv & 1) == 0) { const size_t kunit = (size_t)hk * GDN_NCH + n;
#pragma unroll
                for (int i = 0; i < 4; ++i) { const int p = t2 + 256 * i, comb = p >> 6, ln = p & 63, kt = comb >> 2, s = comb & 3; const int kd = 32 * kt + (ln & 31), c0 = 16 * s + 8 * (ln >> 5);
                    unsigned w[4];
#pragma unroll
                    for (int jj = 0; jj < 4; ++jj) { const unsigned lo = *(const LAS bf16*)(kS + (c0 + 2 * jj) * 272 + kd * 2), hi = *(const LAS bf16*)(kS + (c0 + 2 * jj + 1) * 272 + kd * 2); w[jj] = lo | (hi << 16); }
                    *(v4u*)(KTF + (kunit * 16 + comb) * 512 + ln * 8) = (v4u){w[0], w[1], w[2], w[3]}; } }
            if (t2 < 64) GC[su * GC_STRIDE + t2] = gcS[t2];
            else if (t2 == 64) GC[su * GC_STRIDE + 64] = gcS[63];
            else if (t2 == 65) GC[su * GC_STRIDE + 65] = egcS[63];
        }
        G1_BAR();
        { const int quad = lane >> 4, lc = lane & 15; LAS unsigned char* XTw = XT0 + wave * 1792; LAS unsigned char* YTw = YT0 + wave * 768;
          const bf16x8 z8 = (bf16x8){0, 0, 0, 0, 0, 0, 0, 0}; const f32x4 z4 = (f32x4){0.f, 0.f, 0.f, 0.f};
          bf16x8 tdf[4];
#pragma unroll
          for (int b = 0; b < 4; ++b) tdf[b] = quad < 2 ? *(const LAS bf16x8*)(TDs + (b * 16 + lc) * 32 + quad * 16) : z8;
#pragma unroll 1
          for (int tl = 0; tl < 2; ++tl) { const int col = 32 * wave + 16 * tl + lc;
              const LAS unsigned char* rz = wave < 4 ? vS + col * 2 : kbS + (col - 128) * 2; const LAS float* bz = wave < 4 ? betaS : egcS;
#pragma unroll
              for (int b = 0; b < 4; ++b) { f32x4 y;
#pragma unroll
                  for (int r = 0; r < 4; ++r) { const int i = 16 * b + 4 * quad + r; y[r] = bf2f(*(const LAS bf16*)(rz + i * 272)) * bz[i]; }
                  if (b >= 1) { f32x4 p = z4;
#pragma unroll
                      for (int kk = 0; kk < (b >= 3 ? 2 : 1); ++kk) { const bf16x8 af = *(const LAS bf16x8*)(Lb + (16 * b + lc) * 144 + (32 * kk + 8 * quad) * 2);
                          const bf16x8 bfv = (32 * kk + 8 * quad < 16 * b) ? *(const LAS bf16x8*)(XTw + lc * 112 + (32 * kk + 8 * quad) * 2) : z8;
                          p = __builtin_amdgcn_mfma_f32_16x16x32_bf16(af, bfv, p, 0, 0, 0); }
                      y = y - p; }
                  *(LAS v2u*)(YTw + lc * 48 + quad * 8) = (v2u){pk2(y[0], y[1]), pk2(y[2], y[3])};
                  asm volatile("" ::: "memory");
                  const bf16x8 yb = quad < 2 ? *(const LAS bf16x8*)(YTw + lc * 48 + quad * 16) : z8;
                  const f32x4 x = __builtin_amdgcn_mfma_f32_16x16x32_bf16(tdf[b], yb, z4, 0, 0, 0);
                  if (b < 3) *(LAS v2u*)(XTw + lc * 112 + (16 * b + 4 * quad) * 2) = (v2u){pk2(x[0], x[1]), pk2(x[2], x[3])};
                  asm volatile("" ::: "memory");
#pragma unroll
                  for (int r = 0; r < 4; ++r) XS[(16 * b + 4 * quad + r) * 264 + col] = (bf16)f2bf(x[r]); } } }
        G1_BAR();
#pragma unroll
        for (int i = 0; i < 2; ++i) { const int p = tid + 512 * i, comb = p >> 6, ln = p & 63, t = comb >> 3, s = comb & 7; const int c = 32 * t + (ln & 31), k0 = 16 * s + 8 * (ln >> 5);
            *(v4u*)(WF + (su * 16 + comb) * 512 + ln * 8) = *(const LAS v4u*)(XS + c * 264 + 128 + k0); }
        { const int t = wave >> 2, ns = wave & 3; unsigned w[8];
#pragma unroll
          for (int r = 0; r < 8; ++r) { const unsigned lo = XS[(32 * t + crow(2 * r, h)) * 264 + 32 * ns + l31], hi = XS[(32 * t + crow(2 * r + 1, h)) * 264 + 32 * ns + l31]; w[r] = lo | (hi << 16); }
          bf16* dst = UF + ((su * 8 + wave) * 64 + lane) * 16; *(v4u*)dst = (v4u){w[0], w[1], w[2], w[3]}; *(v4u*)(dst + 8) = (v4u){w[4], w[5], w[6], w[7]}; }
        G1_BAR();
    }
}

#undef G1_BAR
#undef G1_FETCH
DI void ph_gdn_chain(const Frame& F, const Args& a, int n_lo, int n_hi) {
    const int xg = F.vcu >> 5, wx = F.vcu & 31; if (F.G != 256 ? F.vcu >= 128 : wx >= 20) return;
    const bool helper = F.G == 256 && wx >= 16;
    const int hv = F.G == 256 ? 4 * xg + (helper ? wx - 16 : wx >> 2) : F.vcu >> 2, ns = F.G == 256 ? wx & 3 : F.vcu & 3, hk = hv >> 1;
    const bf16* QN = (const bf16*)(a.ws + WS_SCR + SC_QN);
    const bf16* WF = (const bf16*)(a.ws + GD_WF); const bf16* UF = (const bf16*)(a.ws + GD_UF); const bf16* INF = (const bf16*)(a.ws + GD_IN); const bf16* KTF = (const bf16*)(a.ws + GD_KT); const bf16* QF = (const bf16*)(a.ws + GD_QF); const float* GC = (const float*)(a.ws + GD_GC);
    bf16* O = (bf16*)(a.ws + WS_SCR + SC_O);
    gu32* prog = F.ctl + CW_PROG + hv * 16;
    if (helper && GDN_NO_HELPER) return;
    if (helper) { unsigned sink = 0u; const int tid = F.tid;
        for (int n0 = n_lo; n0 < n_hi; n0 += 4) {
            if (n0 >= n_lo + 8) { if (tid == 0) { unsigned sp = 0; while ((int)__hip_atomic_load(prog, RLX_AGENT) < n0 - 4 && ++sp < 20000u) __builtin_amdgcn_s_sleep(8); } __syncthreads(); }
            unsigned v[5];
#pragma unroll
            for (int i = 0; i < 5; ++i) { const int li = tid + 512 * i;
                const int st = li / 580, ln = li % 580, n = n0 + st; const unsigned* p = nullptr;
                if (st < 4 && n < n_hi) { const size_t unit = (size_t)hv * GDN_NCH + n, kunit = (size_t)hk * GDN_NCH + n;
                    if (ln < 128) p = (const unsigned*)(WF + unit * 8192 + ln * 64);
                    else if (ln < 256) p = (const unsigned*)(UF + unit * 8192 + (ln - 128) * 64);
                    else if (ln < 320) p = (const unsigned*)(INF + unit * 4096 + (ln - 256) * 64);
                    else if (ln < 448) p = (const unsigned*)(KTF + kunit * 8192 + (ln - 320) * 64);
                    else if (ln < 576) p = (const unsigned*)(QF + kunit * 8192 + (ln - 448) * 64);
                    else if (ln < 579) p = (const unsigned*)(GC + unit * GC_STRIDE + (ln - 576) * 32); }
                v[i] = p ? *p : 0u; }
#pragma unroll
            for (int i = 0; i < 5; ++i) sink += v[i];
        }
        if (sink == 0x12345u) __hip_atomic_store(F.ctl + CW_TMO + 2, sink, RLX_AGENT);
        return; }
    LAS unsigned char* ST = F.lds + RING_OFF; LAS unsigned char* VN = ST + 8704; LAS unsigned char* VND = ST + 13312;
    const int lane = F.lane, wave = F.wave, l31 = lane & 31, h = lane >> 5;
    for (int i = F.tid; i < 8704 / 4; i += NWAVES * 64) ((LAS unsigned*)ST)[i] = 0u;
#define GDN_BAR() do { asm volatile("s_waitcnt lgkmcnt(0)" ::: "memory"); __builtin_amdgcn_s_barrier(); asm volatile("" ::: "memory"); } while (0)
    GDN_BAR();
    f32x16 S;
#pragma unroll
    for (int r = 0; r < 16; ++r) S[r] = 0.f;
    const int role = wave < 2 ? 0 : (wave < 4 ? 1 : 2); const int t = wave & 1, kt = wave & 3;
    bf16x8 A8[8]; bf16x8 A4[4]; v4u U0 = (v4u){0u, 0u, 0u, 0u}, U1 = U0; f32x4 G4[4]; float gl = 0.f, egl = 1.f;
#pragma unroll
    for (int s = 0; s < 8; ++s) A8[s] = (bf16x8){0, 0, 0, 0, 0, 0, 0, 0};
#pragma unroll
    for (int s = 0; s < 4; ++s) { A4[s] = (bf16x8){0, 0, 0, 0, 0, 0, 0, 0}; G4[s] = (f32x4){0.f, 0.f, 0.f, 0.f}; }
#define GDN_LOAD(nn) do { const size_t unit_ = (size_t)hv * GDN_NCH + (nn); const float* gc_ = GC + unit_ * GC_STRIDE; \
        if (role == 0) { \
            const bf16* up_ = UF + (((unit_ * 2 + t) * 4 + ns) * 64 + lane) * 16; U0 = *(const v4u*)up_; U1 = *(const v4u*)(up_ + 8); \
            _Pragma("unroll") for (int g = 0; g < 4; ++g) G4[g] = *(const f32x4*)(gc_ + 32 * t + 8 * g + 4 * h); gl = gc_[64]; } \
        else if (role == 1) { const size_t qunit_ = (size_t)hk * GDN_NCH + (nn); \
            _Pragma("unroll") for (int s = 0; s < 4; ++s) A4[s] = *(const bf16x8*)(INF + ((unit_ * 2 + t) * 4 + s) * 512 + lane * 8); \
            _Pragma("unroll") for (int g = 0; g < 4; ++g) G4[g] = *(const f32x4*)(gc_ + 32 * t + 8 * g + 4 * h); } \
        else { const size_t kunit_ = (size_t)hk * GDN_NCH + (nn); \
            _Pragma("unroll") for (int s = 0; s < 4; ++s) A4[s] = *(const bf16x8*)(KTF + ((kunit_ * 4 + kt) * 4 + s) * 512 + lane * 8); egl = gc_[65]; } } while (0)
    float* SV = (float*)(a.ws + GD_SAVE) + ((size_t)((hv * 4 + ns) * 4 + kt) * 64 + lane) * 16;
    if (n_lo > 0 && role == 2) {
#pragma unroll
        for (int g = 0; g < 4; ++g) { const f32x4 v = *(const f32x4*)(SV + 4 * g); S[4 * g] = v.x; S[4 * g + 1] = v.y; S[4 * g + 2] = v.z; S[4 * g + 3] = v.w;
            *(LAS v2u*)(ST + l31 * 272 + (32 * kt + 8 * g + 4 * h) * 2) = (v2u){pk2(v.x, v.y), pk2(v.z, v.w)}; }
    }
    GDN_BAR();
#define GDN_LOADA(AC, nn) do { if (role == 0) { const size_t u_ = (size_t)hv * GDN_NCH + (nn); _Pragma("unroll") for (int s = 0; s < 8; ++s) AC[s] = *(const bf16x8*)(WF + ((u_ * 2 + t) * 8 + s) * 512 + lane * 8); } \
        else if (role == 1) { const size_t q_ = (size_t)hk * GDN_NCH + (nn); _Pragma("unroll") for (int s = 0; s < 8; ++s) AC[s] = *(const bf16x8*)(QF + ((q_ * 2 + t) * 8 + s) * 512 + lane * 8); } } while (0)
    bf16x8 A8q[8];
#pragma unroll
    for (int s = 0; s < 8; ++s) A8q[s] = (bf16x8){0, 0, 0, 0, 0, 0, 0, 0};
    GDN_LOADA(A8, n_lo); if (n_lo + 1 < n_hi) GDN_LOADA(A8q, n_lo + 1);
    GDN_LOAD(n_lo);
#define GDN_STEP(n, AC) do { \
        bf16x8 a4[4]; const v4u u0 = U0, u1 = U1; f32x4 g4[4]; const float cgl = gl, cegl = egl; \
        _Pragma("unroll") \
        for (int s = 0; s < 4; ++s) { a4[s] = A4[s]; g4[s] = G4[s]; } \
        if (n + 1 < n_hi) GDN_LOAD(n + 1); \
        if (ns == 0 && F.tid == 0) __hip_atomic_store(prog, (unsigned)n, RLX_AGENT); \
        f32x16 acc; \
        _Pragma("unroll") \
        for (int r = 0; r < 16; ++r) acc[r] = 0.f; \
        if (role < 2) { \
        _Pragma("unroll") \
            for (int s = 0; s < 8; ++s) acc = MFMA32(AC[s], *(const LAS bf16x8*)(ST + l31 * 272 + 32 * s + 16 * h), acc); \
            asm volatile("" :: "v"(acc[0])); \
            if (n + 2 < n_hi) GDN_LOADA(AC, n + 2); \
        } \
        if (role == 0) { const unsigned uw[8] = {u0.x, u0.y, u0.z, u0.w, u1.x, u1.y, u1.z, u1.w}; \
        _Pragma("unroll") \
            for (int g = 0; g < 4; ++g) { float vn[4], vd[4]; \
        _Pragma("unroll") \
                for (int q = 0; q < 4; ++q) { const int r = 4 * g + q; const float uv = (r & 1) ? bfhi(uw[r >> 1]) : bflo(uw[r >> 1]); vn[q] = uv - acc[r]; vd[q] = vn[q] * __expf(cgl - g4[g][q]); } \
                *(LAS v2u*)(VN + l31 * 144 + (32 * t + 8 * g + 4 * h) * 2) = (v2u){pk2(vn[0], vn[1]), pk2(vn[2], vn[3])}; \
                *(LAS v2u*)(VND + l31 * 144 + (32 * t + 8 * g + 4 * h) * 2) = (v2u){pk2(vd[0], vd[1]), pk2(vd[2], vd[3])}; } \
        } else if (role == 1) { \
        _Pragma("unroll") \
            for (int g = 0; g < 4; ++g) \
        _Pragma("unroll") \
                for (int q = 0; q < 4; ++q) acc[4 * g + q] *= __expf(g4[g][q]); \
        } \
        GDN_BAR(); \
        if (role == 1) { \
        _Pragma("unroll") \
            for (int s = 0; s < 4; ++s) acc = MFMA32(a4[s], *(const LAS bf16x8*)(VN + l31 * 144 + 32 * s + 16 * h), acc); \
        _Pragma("unroll") \
            for (int r = 0; r < 16; ++r) { const int rr = chunk_row(n, 32 * t + crow(r, h)); if (rr >= 0) O[(size_t)rr * 4096 + hv * 128 + 32 * ns + l31] = (bf16)f2bf(acc[r]); } \
        } else if (role == 2) { \
        _Pragma("unroll") \
            for (int r = 0; r < 16; ++r) S[r] *= cegl; \
        _Pragma("unroll") \
            for (int s = 0; s < 4; ++s) S = MFMA32(a4[s], *(const LAS bf16x8*)(VND + l31 * 144 + 32 * s + 16 * h), S); \
        _Pragma("unroll") \
            for (int g = 0; g < 4; ++g) *(LAS v2u*)(ST + l31 * 272 + (32 * kt + 8 * g + 4 * h) * 2) = (v2u){pk2(S[4 * g], S[4 * g + 1]), pk2(S[4 * g + 2], S[4 * g + 3])}; \
        } \
        GDN_BAR(); \
    } while (0)
    for (int n2 = n_lo; n2 < n_hi; n2 += 2) { GDN_STEP(n2, A8); if (n2 + 1 < n_hi) GDN_STEP(n2 + 1, A8q); }
#undef GDN_STEP
#undef GDN_LOADA
    if (n_hi < GDN_NCH && role == 2) {
#pragma unroll
        for (int g = 0; g < 4; ++g) *(f32x4*)(SV + 4 * g) = (f32x4){S[4 * g], S[4 * g + 1], S[4 * g + 2], S[4 * g + 3]}; }
#undef GDN_LOAD
#undef GDN_BAR
}

constexpr int RW_NSC = 258, RW_UNITS = 129 * 16;
DI int sub_row(int sc, int t) { const int n = sc >> 1, sub = sc & 1; return n == 0 ? ((sub == 0 && t >= 16) ? TX + t - 16 : -1) : 64 * (n - 1) + 32 * sub + t; }
constexpr size_t RW_BASE = WS_PROJ + 92 * MiB;
constexpr size_t RW_RH = RW_BASE, RW_RL = RW_BASE + 33 * MiB, RW_GT = RW_BASE + 66 * MiB, RW_GAM = RW_BASE + 99 * MiB;
constexpr size_t RW_PR = WS_SCR + 195 * MiB, RW_AT = WS_SCR + 211 * MiB + 256 * 1024, RW_VTF = WS_SCR + 219 * MiB + 512 * 1024, RW_SALL = WS_SCR + 235 * MiB + 768 * 1024;
constexpr size_t RW_XSAVE = 1 * MiB + 640 * 1024;
constexpr size_t RW_VV = WS_YMIX + 34 * MiB, RW_BON = WS_YMIX + 52 * MiB, LR_H = WS_YMIX + 54 * MiB, LR_A = WS_YMIX + 56 * MiB, LR_C = WS_YMIX + 58 * MiB;
constexpr size_t RW_SCH = (size_t)RW_NSC * 16;
static_assert((size_t)MP * EV_NP * 2 <= 92 * MiB && RW_SCH * 8192 <= 33 * MiB && RW_GAM + RW_SCH * 256 <= WS_SCR, "rwkv map (proj region)");
static_assert(WS_SCR + SC_LIX + (size_t)MP * 4096 <= RW_PR && RW_PR + RW_SCH * 4096 <= RW_AT && RW_AT + RW_SCH * 2048 <= RW_VTF && RW_VTF + RW_SCH * 4096 <= RW_SALL && RW_SALL + RW_SCH * 8192 <= WS_END, "rwkv map (scratch region)");
static_assert((size_t)MP * DM * 2 <= 34 * MiB && RW_VV + (size_t)MP * 2048 <= RW_BON && RW_BON + (size_t)MP * 64 <= LR_H && LR_H + RW_SCH * 256 <= LR_A && LR_A + RW_SCH * 256 <= LR_C && LR_C + RW_SCH * 256 <= WS_PROJ, "rwkv map (ymix region)");

DI void sub_rows(int sc, int& t0, int& rbase) { if (sc >= 2) { t0 = 0; rbase = 64 * ((sc >> 1) - 1) + 32 * (sc & 1); } else if (sc == 0) { t0 = 16; rbase = TX - 16; } else { t0 = 32; rbase = 0; } }
DI void lru_local(const Frame& F, const Args& a, int gw, int ngw) {
    const bf16* LA = (const bf16*)(a.ws + WS_SCR + SC_LA); const bf16* LIX = (const bf16*)(a.ws + WS_SCR + SC_LIX);
    float* HL = (float*)(a.ws + LR_H); float* AP = (float*)(a.ws + LR_A);
    for (int item = gw; item < RW_NSC * 16; item += ngw) { const int sc = item >> 4, c = (item & 15) * 64 + F.lane; int t0, rbase; sub_rows(sc, t0, rbase);
        float av[32], ix[32];
#pragma unroll
        for (int t = 0; t < 32; ++t) { const size_t o = (size_t)(rbase + (t >= t0 ? t : 32)) * 1024 + c; av[t] = bf2f(LA[o]); ix[t] = bf2f(LIX[o]); }
        float h = 0.f, p = 1.f;
#pragma unroll
        for (int t = 0; t < 32; ++t) { const float om = t >= t0 ? av[t] : 0.f, x_ = t >= t0 ? ix[t] : 0.f, a_ = 1.0f - om; h = a_ * h + sqrtf(om * (1.0f + a_)) * x_; p *= a_; }
        HL[sc * 1024 + c] = h; AP[sc * 1024 + c] = p; }
}
DI void lru_apply(const Frame& F, const Args& a) {
    const bf16* P = (const bf16*)(a.ws + WS_PROJ); const bf16* LA = (const bf16*)(a.ws + WS_SCR + SC_LA); const bf16* LIX = (const bf16*)(a.ws + WS_SCR + SC_LIX);
    const float* CR = (const float*)(a.ws + LR_C); bf16* Y = (bf16*)(a.ws + WS_YMIX);
    for (int item = F.gw; item < RW_NSC * 16; item += F.NGW) { const int sc = item >> 4, c = (item & 15) * 64 + F.lane; int t0, rbase; sub_rows(sc, t0, rbase); if (t0 >= 32) continue;
        float h = CR[sc * 1024 + c];
#pragma unroll
        for (int tb = 0; tb < 32; tb += 16) { float av[16], ix[16], gb[16];
#pragma unroll
            for (int t = 0; t < 16; ++t) { const size_t r_ = (size_t)(rbase + (tb + t >= t0 ? tb + t : 32)); av[t] = bf2f(LA[r_ * 1024 + c]); ix[t] = bf2f(LIX[r_ * 1024 + c]); gb[t] = bf2f(P[r_ * EV_NP + EV_GB + c]); }
#pragma unroll
            for (int t = 0; t < 16; ++t) { if (tb + t >= t0) { const float a_ = 1.0f - av[t]; h = a_ * h + sqrtf(av[t] * (1.0f + a_)) * ix[t]; Y[(size_t)(rbase + tb + t) * DM + 1024 + c] = (bf16)f2bf(h * gelu_tanh(gb[t])); } } } }
}

DI void ph_rwkv_chunk(const Frame& F, const Args& a, int n_lo, int n_hi, int wg0) {
    if (F.vcu < wg0) return;
    const bf16* P = (const bf16*)(a.ws + WS_PROJ); const bf16* DEC = (const bf16*)(a.ws + WS_SCR + SC_DEC); const bf16* ICL = (const bf16*)(a.ws + WS_SCR + SC_ICL);
    bf16* RH = (bf16*)(a.ws + RW_RH); bf16* RL = (bf16*)(a.ws + RW_RL); bf16* GT = (bf16*)(a.ws + RW_GT); float* GAM = (float*)(a.ws + RW_GAM); bf16* PR = (bf16*)(a.ws + RW_PR); bf16* ATG = (bf16*)(a.ws + RW_AT); bf16* VTF = (bf16*)(a.ws + RW_VTF);
    bf16* VV = (bf16*)(a.ws + RW_VV); float* BON = (float*)(a.ws + RW_BON);
    LAS unsigned char* L = F.lds + RING_OFF;
    LAS float* wS = (LAS float*)L; LAS float* aS = wS + 4096; LAS float* bS = wS + 8192; LAS float* rS = wS + 12288; LAS float* kS = wS + 16384;
    LAS unsigned char* vT = L + 81920; LAS unsigned char* aT = L + 91136; LAS unsigned char* rT = L + 100352; LAS unsigned char* kT = L + 109568; LAS unsigned char* bT = L + 118784;
    LAS unsigned char* AT = L + 128000; LAS unsigned char* NT = L + 133120; LAS float* gam = (LAS float*)(L + 138240);
    LAS unsigned char* aTl = L; LAS unsigned char* bTl = L + 9216;
    const int tid = F.tid, lane = F.lane, wave = F.wave, l31 = lane & 31, h = lane >> 5;
    const float* mu = a.in[6];
    for (int unit = n_lo * 16 + (F.vcu - wg0); unit < n_hi * 16; unit += F.G - wg0) {
        const int n = unit >> 4, hd = unit & 15;
#ifdef R1_REP_A
        _Pragma("unroll 1") for (int rep_ = 0; rep_ < 2; ++rep_)
#endif
        { const int tok = tid >> 3, cg = tid & 7, c0 = hd * 64 + cg * 8; const int rr = sub_row(2 * n + (tok >> 5), tok & 31);
          float wv[8], av[8], bv[8], rv[8], kv[8], vv[8];
#pragma unroll
          for (int q = 0; q < 8; ++q) { wv[q] = 0.f; av[q] = 0.f; bv[q] = 0.f; rv[q] = 0.f; kv[q] = 0.f; vv[q] = 0.f; }
          if (rr >= 0) { const int pos = row_pos(rr); const bf16* cur = P + (size_t)rr * EV_NP + c0; const bf16* prv = pos > 0 ? P + (size_t)pos_row(pos - 1) * EV_NP + c0 : nullptr;
              const v4u z4 = (v4u){0u, 0u, 0u, 0u};
              const v4u cr = *(const v4u*)cur, ck = *(const v4u*)(cur + 1024), cv = *(const v4u*)(cur + 2048);
              const v4u qr = prv ? *(const v4u*)prv : z4, qk = prv ? *(const v4u*)(prv + 1024) : z4, qv = prv ? *(const v4u*)(prv + 2048) : z4;
              const unsigned crw[4] = {cr.x, cr.y, cr.z, cr.w}, ckw[4] = {ck.x, ck.y, ck.z, ck.w}, cvw[4] = {cv.x, cv.y, cv.z, cv.w}, qrw[4] = {qr.x, qr.y, qr.z, qr.w}, qkw[4] = {qk.x, qk.y, qk.z, qk.w}, qvw[4] = {qv.x, qv.y, qv.z, qv.w};
              float ss = 0.f, bon = 0.f; float kk[8], ic[8];
#pragma unroll
              for (int q = 0; q < 8; ++q) { const int c = c0 + q; const float crf = (q & 1) ? bfhi(crw[q >> 1]) : bflo(crw[q >> 1]), ckf = (q & 1) ? bfhi(ckw[q >> 1]) : bflo(ckw[q >> 1]), cvf = (q & 1) ? bfhi(cvw[q >> 1]) : bflo(cvw[q >> 1]);
                  const float prf = (q & 1) ? bfhi(qrw[q >> 1]) : bflo(qrw[q >> 1]), pkf = (q & 1) ? bfhi(qkw[q >> 1]) : bflo(qkw[q >> 1]), pvf = (q & 1) ? bfhi(qvw[q >> 1]) : bflo(qvw[q >> 1]);
                  rv[q] = crf + (prf - crf) * mu[c]; kk[q] = ckf + (pkf - ckf) * mu[1024 + c]; vv[q] = cvf + (pvf - cvf) * mu[2048 + c];
                  wv[q] = -bf2f(DEC[(size_t)rr * 1024 + c])  ; ic[q] = bf2f(ICL[(size_t)rr * 1024 + c]);
                  const float kkv = kk[q] * a.in[12][c]; av[q] = kkv; ss += kkv * kkv; kv[q] = kk[q] * (1.0f + (ic[q] - 1.0f) * a.in[13][c]); bon += rv[q] * kv[q] * a.in[14][c]; }
              ss += __shfl_xor(ss, 1); ss += __shfl_xor(ss, 2); ss += __shfl_xor(ss, 4); bon += __shfl_xor(bon, 1); bon += __shfl_xor(bon, 2); bon += __shfl_xor(bon, 4);
              const float inv = 1.0f / fmaxf(sqrtf(ss), 1e-12f);
#pragma unroll
              for (int q = 0; q < 8; ++q) { const float kkn = av[q] * inv; av[q] = -kkn; bv[q] = kkn * ic[q]; }
              if (cg == 0) BON[(size_t)rr * 16 + hd] = bon;
              *(v4u*)(VV + (size_t)rr * 1024 + c0) = (v4u){pk2(vv[0], vv[1]), pk2(vv[2], vv[3]), pk2(vv[4], vv[5]), pk2(vv[6], vv[7])}; }
          const int o = tok * 64 + cg * 8;
          *(LAS f32x4*)(wS + o) = (f32x4){wv[0], wv[1], wv[2], wv[3]}; *(LAS f32x4*)(wS + o + 4) = (f32x4){wv[4], wv[5], wv[6], wv[7]};
          *(LAS f32x4*)(aS + o) = (f32x4){av[0], av[1], av[2], av[3]}; *(LAS f32x4*)(aS + o + 4) = (f32x4){av[4], av[5], av[6], av[7]};
          *(LAS f32x4*)(bS + o) = (f32x4){bv[0], bv[1], bv[2], bv[3]}; *(LAS f32x4*)(bS + o + 4) = (f32x4){bv[4], bv[5], bv[6], bv[7]};
          *(LAS f32x4*)(rS + o) = (f32x4){rv[0], rv[1], rv[2], rv[3]}; *(LAS f32x4*)(rS + o + 4) = (f32x4){rv[4], rv[5], rv[6], rv[7]};
          *(LAS f32x4*)(kS + o) = (f32x4){kv[0], kv[1], kv[2], kv[3]}; *(LAS f32x4*)(kS + o + 4) = (f32x4){kv[4], kv[5], kv[6], kv[7]};
#pragma unroll
          for (int q = 0; q < 8; ++q) *(LAS bf16*)(vT + (cg * 8 + q) * 144 + tok * 2) = (bf16)f2bf(vv[q]); }
        __syncthreads();
        { typedef float f32x2 __attribute__((ext_vector_type(2)));
          const int sub = wave >> 2, blk = sub ? 3 - (wave & 3) : (wave & 3), tkn = lane >> 3, e = lane & 7, s = 8 * blk + tkn, tok = 32 * sub + s, j8 = 8 * e;
          f32x2 xk[4], xb[4];
          { const f32x4 t0 = *(const LAS f32x4*)(kS + tok * 64 + j8), t1 = *(const LAS f32x4*)(kS + tok * 64 + j8 + 4), u0 = *(const LAS f32x4*)(bS + tok * 64 + j8), u1 = *(const LAS f32x4*)(bS + tok * 64 + j8 + 4);
            xk[0] = (f32x2){t0.x, t0.y}; xk[1] = (f32x2){t0.z, t0.w}; xk[2] = (f32x2){t1.x, t1.y}; xk[3] = (f32x2){t1.z, t1.w};
            xb[0] = (f32x2){u0.x, u0.y}; xb[1] = (f32x2){u0.z, u0.w}; xb[2] = (f32x2){u1.x, u1.y}; xb[3] = (f32x2){u1.z, u1.w}; }
          for (int i = e; i < 8 * blk; i += 8) { *(LAS bf16*)(AT + ((sub * 32 + i) * 40 + s) * 2) = (bf16)0; *(LAS bf16*)(NT + ((sub * 32 + i) * 40 + s) * 2) = (bf16)0; }
#define RW_RED8(v) do { v += __builtin_bit_cast(float, __builtin_amdgcn_mov_dpp(__builtin_bit_cast(int, v), 0xB1, 0xF, 0xF, true)); v += __builtin_bit_cast(float, __builtin_amdgcn_mov_dpp(__builtin_bit_cast(int, v), 0x4E, 0xF, 0xF, true)); \
              v += __builtin_bit_cast(float, __builtin_amdgcn_mov_dpp(__builtin_bit_cast(int, v), 0x141, 0xF, 0xF, true)); } while (0)
#define RW_PASS(X_, OUTP) do { f32x2 c2 = X_[0] * a2[0]; c2 = X_[1] * a2[1] + c2; c2 = X_[2] * a2[2] + c2; c2 = X_[3] * a2[3] + c2; float c = c2.x + c2.y; RW_RED8(c); \
              const float cm = c * m; const f32x2 cm2 = (f32x2){cm, cm}; \
              _Pragma("unroll") for (int i = 0; i < 4; ++i) X_[i] = X_[i] * mw[i] + (cm2 * b2[i] + X_[i]); \
              f32x2 o2 = X_[0] * r2[0]; o2 = X_[1] * r2[1] + o2; o2 = X_[2] * r2[2] + o2; o2 = X_[3] * r2[3] + o2; float o = o2.x + o2.y; RW_RED8(o); \
              *(LAS bf16*)(OUTP + ((sub * 32 + tp) * 40 + s) * 2) = (bf16)f2bf(o * mge); } while (0)
          const LAS float* bp = wS + (32 * sub + 8 * blk) * 64 + j8;
#pragma unroll 2
          for (int tp = 8 * blk; tp < 32; ++tp, bp += 64) {
              const f32x4 wA = *(const LAS f32x4*)(bp), wB = *(const LAS f32x4*)(bp + 4), aA = *(const LAS f32x4*)(bp + 4096), aB = *(const LAS f32x4*)(bp + 4100);
              const f32x4 bA = *(const LAS f32x4*)(bp + 8192), bB = *(const LAS f32x4*)(bp + 8196), rA = *(const LAS f32x4*)(bp + 12288), rB = *(const LAS f32x4*)(bp + 12292);
              const float m = tp > s ? 1.f : 0.f, mge = tp >= s ? 1.f : 0.f; const f32x2 m2 = (f32x2){m, m};
              const f32x2 a2[4] = {(f32x2){aA.x, aA.y}, (f32x2){aA.z, aA.w}, (f32x2){aB.x, aB.y}, (f32x2){aB.z, aB.w}}, b2[4] = {(f32x2){bA.x, bA.y}, (f32x2){bA.z, bA.w}, (f32x2){bB.x, bB.y}, (f32x2){bB.z, bB.w}};
              const f32x2 r2[4] = {(f32x2){rA.x, rA.y}, (f32x2){rA.z, rA.w}, (f32x2){rB.x, rB.y}, (f32x2){rB.z, rB.w}};
              const f32x2 mw[4] = {m2 * (f32x2){wA.x, wA.y}, m2 * (f32x2){wA.z, wA.w}, m2 * (f32x2){wB.x, wB.y}, m2 * (f32x2){wB.z, wB.w}};
              RW_PASS(xk, AT); RW_PASS(xb, NT); }
#undef RW_PASS
#undef RW_RED8
#pragma unroll
          for (int i = 0; i < 4; ++i) { *(LAS bf16*)(kT + (j8 + 2 * i) * 144 + tok * 2) = (bf16)f2bf(xk[i].x); *(LAS bf16*)(kT + (j8 + 2 * i + 1) * 144 + tok * 2) = (bf16)f2bf(xk[i].y);
              *(LAS bf16*)(bT + (j8 + 2 * i) * 144 + tok * 2) = (bf16)f2bf(xb[i].x); *(LAS bf16*)(bT + (j8 + 2 * i + 1) * 144 + tok * 2) = (bf16)f2bf(xb[i].y); }
          const bool gwave = (blk == 3); const int j = lane;
          if (gwave) { float g = 1.f;
#pragma unroll
              for (int tp = 0; tp < 32; ++tp) { const int tk = 32 * sub + tp; const float w_ = 1.0f + wS[tk * 64 + j], a_ = aS[tk * 64 + j], r_ = rS[tk * 64 + j];
                  *(LAS bf16*)(aT + j * 144 + tk * 2) = (bf16)f2bf(a_ * g);
                  g *= w_; *(LAS bf16*)(rT + j * 144 + tk * 2) = (bf16)f2bf(r_ * g); }
              gam[sub * 64 + j] = g; }
        }
        __syncthreads();
#ifdef R1_REP_C
        _Pragma("unroll 1") for (int rep_ = 0; rep_ < 2; ++rep_) {
#endif
        { const int sub = wave >> 2, t1 = (wave >> 1) & 1, t0 = wave & 1; const size_t sch = (size_t)hd * RW_NSC + (2 * n + sub);
          { f32x16 acc;
#pragma unroll
            for (int r = 0; r < 16; ++r) acc[r] = 0.f;
#pragma unroll
            for (int ks = 0; ks < 2; ++ks) { const int ao = (32 * t1 + l31) * 144 + (32 * sub + 16 * ks + 8 * h) * 2, bo = (32 * t0 + l31) * 144 + (32 * sub + 16 * ks + 8 * h) * 2;
                acc = MFMA32(*(const LAS bf16x8*)(aT + ao), *(const LAS bf16x8*)(bT + bo), acc); }
            const int jp = 32 * t0 + l31;
#pragma unroll
            for (int g = 0; g < 4; ++g) *(v2u*)(RH + (sch * 64 + jp) * 64 + 32 * t1 + 8 * g + 4 * h) = (v2u){pk2(acc[4 * g], acc[4 * g + 1]), pk2(acc[4 * g + 2], acc[4 * g + 3])};
            if (t1 == 0 && t0 == 0) GAM[sch * 64 + lane] = gam[sub * 64 + lane]; }
          { f32x16 acc;
#pragma unroll
            for (int r = 0; r < 16; ++r) acc[r] = 0.f;
#pragma unroll
            for (int ks = 0; ks < 2; ++ks) acc = MFMA32(*(const LAS bf16x8*)(kT + (32 * t1 + l31) * 144 + (32 * sub + 16 * ks + 8 * h) * 2), *(const LAS bf16x8*)(vT + (32 * t0 + l31) * 144 + (32 * sub + 16 * ks + 8 * h) * 2), acc);
            bf16* dst = GT + ((sch * 4 + t1 * 2 + t0) * 64 + lane) * 16;
            *(v4u*)dst = (v4u){pk2(acc[0], acc[1]), pk2(acc[2], acc[3]), pk2(acc[4], acc[5]), pk2(acc[6], acc[7])}; *(v4u*)(dst + 8) = (v4u){pk2(acc[8], acc[9]), pk2(acc[10], acc[11]), pk2(acc[12], acc[13]), pk2(acc[14], acc[15])}; } }
        if (wave < 4) { const int sub = wave >> 1, jt = wave & 1; const size_t sch = (size_t)hd * RW_NSC + (2 * n + sub);
            f32x16 acc;
#pragma unroll
            for (int r = 0; r < 16; ++r) acc[r] = bf2f(*(const LAS bf16*)(rT + (32 * jt + crow(r, h)) * 144 + (32 * sub + l31) * 2));
#pragma unroll
            for (int ks = 0; ks < 2; ++ks) acc = MFMA32(*(const LAS bf16x8*)(aT + (32 * jt + l31) * 144 + (32 * sub + 16 * ks + 8 * h) * 2), *(const LAS bf16x8*)(NT + (sub * 32 + l31) * 80 + (16 * ks + 8 * h) * 2), acc);
#pragma unroll
            for (int g = 0; g < 4; ++g) *(v2u*)(PR + (sch * 32 + l31) * 64 + 32 * jt + 8 * g + 4 * h) = (v2u){pk2(acc[4 * g], acc[4 * g + 1]), pk2(acc[4 * g + 2], acc[4 * g + 3])};
        } else { const int t2 = tid - 256, sub = t2 >> 7, t = (t2 >> 2) & 31, s8 = (t2 & 3) * 8; const size_t sch = (size_t)hd * RW_NSC + (2 * n + sub);
            *(v4u*)(ATG + (sch * 32 + t) * 32 + s8) = *(const LAS v4u*)(AT + (sub * 32 + t) * 80 + s8 * 2); }
        { const int sub = tid >> 8, it = (tid >> 7) & 1, ks = (tid >> 6) & 1; const size_t sch = (size_t)hd * RW_NSC + (2 * n + sub);
          *(v4u*)(VTF + ((sch * 4 + it * 2 + ks) * 64 + lane) * 8) = *(const LAS v4u*)(vT + (32 * it + l31) * 144 + (32 * sub + 16 * ks + 8 * h) * 2); }
#ifdef R1_REP_C
        }
#endif
        __syncthreads();
    }
}

DI void ph_rwkv_chain(const Frame& F, const Args& a, int sc_lo, int sc_hi) {
    if (F.vcu >= 16 && F.vcu < 18) { if (sc_hi < RW_NSC) return; const int c = (F.vcu - 16) * 512 + F.tid; const float* HL = (const float*)(a.ws + LR_H); const float* AP = (const float*)(a.ws + LR_A); float* CR = (float*)(a.ws + LR_C);
        float carry = 0.f;
#pragma unroll 8
        for (int sc = 0; sc < RW_NSC; ++sc) { const float hl = HL[sc * 1024 + c], ap = AP[sc * 1024 + c]; CR[sc * 1024 + c] = carry; carry = ap * carry + hl; }
        return; }
    if (F.vcu >= 16) return;
    const int hd = F.vcu; const bf16* RH = (const bf16*)(a.ws + RW_RH); const bf16* RL = (const bf16*)(a.ws + RW_RL); const bf16* GT = (const bf16*)(a.ws + RW_GT); const float* GAM = (const float*)(a.ws + RW_GAM); bf16* SALL = (bf16*)(a.ws + RW_SALL);
    constexpr int RW_NS = 7, SLOT = 8192 + 8192 + 1024;
    LAS unsigned char* XS = F.lds + RING_OFF; LAS unsigned char* RG = XS + 2 * 9216;
    const int lane = F.lane, wave = F.wave, l31 = lane & 31, h = lane >> 5, jt = (wave >> 1) & 1, it = wave & 1, lw = wave & 3;
    for (int i = F.tid; i < 2 * 9216 / 4; i += NWAVES * 64) ((LAS unsigned*)XS)[i] = 0u;
    __syncthreads();
#define RW_BAR() do { asm volatile("s_waitcnt lgkmcnt(0)" ::: "memory"); __builtin_amdgcn_s_barrier(); asm volatile("" ::: "memory"); } while (0)
    const unsigned rg0 = (unsigned)(uintptr_t)RG;
    int offR[4], offG[4]; const int lw2 = wave & 1;
#pragma unroll
    for (int i = 0; i < 4; ++i) { const int b = 4 * lw2 + i, row = 8 * b + (lane >> 3), pc = lane & 7; offR[i] = row * 64 + ((pc ^ (row & 7)) * 8); offG[i] = (b * 64 + lane) * 8; }
    const int offM = (lane & 15) * 4;
#define RW_DMA(src, dst) do { unsigned keep_; asm volatile("s_mov_b32 %0, m0\n\ts_mov_b32 m0, %2\n\ts_nop 0\n\tglobal_load_lds_dwordx4 %1, off\n\ts_mov_b32 m0, %0" : "=&s"(keep_) : "v"(src), "s"(dst) : "memory"); } while (0)
#define RW_ISSUE(scn) do { const int s_ = (scn) < RW_NSC ? (scn) : RW_NSC - 1; const size_t sch_ = (size_t)hd * RW_NSC + s_; \
        const unsigned sb_ = (unsigned)__builtin_amdgcn_readfirstlane((int)(rg0 + (unsigned)((scn) % RW_NS) * SLOT)); \
        _Pragma("unroll") for (int i_ = 0; i_ < 4; ++i_) { const unsigned bo_ = (unsigned)__builtin_amdgcn_readfirstlane((4 * lw2 + i_) * 1024); \
            RW_DMA(RH + sch_ * 4096 + offR[i_], sb_ + bo_); RW_DMA(GT + sch_ * 4096 + offG[i_], sb_ + 8192 + bo_); } \
        RW_DMA(GAM + sch_ * 64 + offM, sb_ + 16384); } while (0)
#define RW_WAITV(n) asm volatile("s_waitcnt vmcnt(" #n ")" ::: "memory")
    f32x16 X;
#pragma unroll
    for (int r = 0; r < 16; ++r) X[r] = 0.f;
    float* XSV = (float*)(a.ws + RW_XSAVE) + ((size_t)(hd * 4 + (wave & 3)) * 64 + lane) * 16;
    if (wave < 4 && sc_lo > 0) {
#pragma unroll
        for (int g = 0; g < 4; ++g) { const f32x4 v = *(const f32x4*)(XSV + 4 * g); X[4 * g] = v.x; X[4 * g + 1] = v.y; X[4 * g + 2] = v.z; X[4 * g + 3] = v.w;
            *(LAS v2u*)(XS + (32 * it + l31) * 144 + (32 * jt + 8 * g + 4 * h) * 2) = (v2u){pk2(v.x, v.y), pk2(v.z, v.w)}; } }
    if (wave == 4 || wave == 5) { RW_ISSUE(sc_lo); RW_ISSUE(sc_lo + 1); RW_ISSUE(sc_lo + 2); RW_ISSUE(sc_lo + 3); RW_ISSUE(sc_lo + 4); RW_ISSUE(sc_lo + 5); RW_WAITV(45); }
    RW_BAR();
    for (int sc = sc_lo; sc < sc_hi; ++sc) {
        if (wave < 4) {
            const LAS unsigned char* sb = RG + (sc % RW_NS) * SLOT;
            f32x16 acc; const size_t sch = (size_t)hd * RW_NSC + sc;
            { const v4u g0 = *(const LAS v4u*)(sb + 8192 + ((jt * 2 + it) * 64 + lane) * 32), g1 = *(const LAS v4u*)(sb + 8192 + ((jt * 2 + it) * 64 + lane) * 32 + 16);
              const unsigned gw_[8] = {g0.x, g0.y, g0.z, g0.w, g1.x, g1.y, g1.z, g1.w};
#pragma unroll
              for (int g = 0; g < 4; ++g) { const f32x4 m = *(const LAS f32x4*)(sb + 16384 + (32 * jt + 8 * g + 4 * h) * 4);
                  acc[4 * g] = bflo(gw_[2 * g]) + m.x * X[4 * g]; acc[4 * g + 1] = bfhi(gw_[2 * g]) + m.y * X[4 * g + 1]; acc[4 * g + 2] = bflo(gw_[2 * g + 1]) + m.z * X[4 * g + 2]; acc[4 * g + 3] = bfhi(gw_[2 * g + 1]) + m.w * X[4 * g + 3]; } }
            const LAS unsigned char* xb = XS + (sc & 1) * 9216 + (32 * it + l31) * 144 + 16 * h; const int ar = 32 * jt + l31; const LAS unsigned char* ab = sb + ar * 128;
#pragma unroll
            for (int ks = 0; ks < 4; ++ks) { const bf16x8 xf = *(const LAS bf16x8*)(xb + 32 * ks); const int po = (((2 * ks + h) ^ (ar & 7)) * 16);
                acc = MFMA32(*(const LAS bf16x8*)(ab + po), xf, acc); }
            X = acc;
            LAS unsigned char* xn = XS + ((sc + 1) & 1) * 9216 + (32 * it + l31) * 144;
#pragma unroll
            for (int g = 0; g < 4; ++g) *(LAS v2u*)(xn + (32 * jt + 8 * g + 4 * h) * 2) = (v2u){pk2(X[4 * g], X[4 * g + 1]), pk2(X[4 * g + 2], X[4 * g + 3])};
        } else if (wave < 6) {
            RW_ISSUE(sc + RW_NS - 1);
            RW_WAITV(45);
        } else {
            const LAS unsigned char* xi = XS + (sc & 1) * 9216; bf16* so = SALL + ((size_t)hd * RW_NSC + sc) * 4096;
#pragma unroll
            for (int q = 0; q < 4; ++q) { const int pc = (wave & 1) * 256 + 64 * q + lane, row = pc >> 3, ch = pc & 7; *(v4u*)(so + row * 64 + ch * 8) = *(const LAS v4u*)(xi + row * 144 + ch * 16); }
        }
        RW_BAR();
    }
    if (wave == 4 || wave == 5) RW_WAITV(0);
    else if (wave < 4 && sc_hi < RW_NSC) {
#pragma unroll
        for (int g = 0; g < 4; ++g) *(f32x4*)(XSV + 4 * g) = (f32x4){X[4 * g], X[4 * g + 1], X[4 * g + 2], X[4 * g + 3]}; }
#undef RW_ISSUE
#undef RW_DMA
#undef RW_WAITV
#undef RW_BAR
}

DI f32x4 ld_bf4(const bf16* p) { const v2u w = *(const v2u*)p; return (f32x4){bflo(w.x), bfhi(w.x), bflo(w.y), bfhi(w.y)}; }
DI void ph_rwkv_out(const Frame& F, const Args& a, int sc_lo, int sc_hi, int gw, int ngw) {
    const bf16* SALL = (const bf16*)(a.ws + RW_SALL); const bf16* PR = (const bf16*)(a.ws + RW_PR); const bf16* ATG = (const bf16*)(a.ws + RW_AT); const bf16* VTF = (const bf16*)(a.ws + RW_VTF);
    const bf16* VV = (const bf16*)(a.ws + RW_VV); const float* BON = (const float*)(a.ws + RW_BON); const bf16* GATE = (const bf16*)(a.ws + WS_SCR + SC_GATE); bf16* Y = (bf16*)(a.ws + WS_YMIX);
    const int lane = F.lane, l31 = lane & 31, h = lane >> 5;
    for (int item = sc_lo * 16 + gw; item < sc_hi * 16; item += ngw) { const int sc = item >> 4, hd = item & 15; if (sc == 1) continue;
        const size_t sch = (size_t)hd * RW_NSC + sc; f32x16 acc[2];
#pragma unroll
        for (int it = 0; it < 2; ++it) {
#pragma unroll
            for (int r = 0; r < 16; ++r) acc[it][r] = 0.f;
#pragma unroll
            for (int ks = 0; ks < 4; ++ks) acc[it] = MFMA32(*(const bf16x8*)(SALL + (sch * 64 + 32 * it + l31) * 64 + 16 * ks + 8 * h), *(const bf16x8*)(PR + (sch * 32 + l31) * 64 + 16 * ks + 8 * h), acc[it]);
#pragma unroll
            for (int ks = 0; ks < 2; ++ks) acc[it] = MFMA32(*(const bf16x8*)(VTF + ((sch * 4 + it * 2 + ks) * 64 + lane) * 8), *(const bf16x8*)(ATG + (sch * 32 + l31) * 32 + 16 * ks + 8 * h), acc[it]); }
        float s1 = 0.f;
#pragma unroll
        for (int it = 0; it < 2; ++it)
#pragma unroll
            for (int r = 0; r < 16; ++r) s1 += acc[it][r];
        s1 += __shfl_xor(s1, 32); const float mean = s1 * (1.0f / 64.0f); float s2 = 0.f;
#pragma unroll
        for (int it = 0; it < 2; ++it)
#pragma unroll
            for (int r = 0; r < 16; ++r) { const float d = acc[it][r] - mean; s2 += d * d; }
        s2 += __shfl_xor(s2, 32); const float rstd = 1.0f / sqrtf(s2 * (1.0f / 64.0f) + 64e-5f);
        const int rr = sub_row(sc, l31);
        if (rr >= 0) { const float bon = BON[(size_t)rr * 16 + hd];
#pragma unroll
            for (int it = 0; it < 2; ++it)
#pragma unroll
                for (int g = 0; g < 4; ++g) { const int c = hd * 64 + 32 * it + 8 * g + 4 * h;
                    const f32x4 lw = *(const f32x4*)(a.in[15] + c), lb = *(const f32x4*)(a.in[16] + c), gt = ld_bf4(GATE + (size_t)rr * 1024 + c); const v2u vw = *(const v2u*)(VV + (size_t)rr * 1024 + c);
                    const float o0 = ((acc[it][4 * g] - mean) * rstd * lw.x + lb.x + bon * bflo(vw.x)) * gt.x, o1 = ((acc[it][4 * g + 1] - mean) * rstd * lw.y + lb.y + bon * bfhi(vw.x)) * gt.y;
                    const float o2 = ((acc[it][4 * g + 2] - mean) * rstd * lw.z + lb.z + bon * bflo(vw.y)) * gt.z, o3 = ((acc[it][4 * g + 3] - mean) * rstd * lw.w + lb.w + bon * bfhi(vw.y)) * gt.w;
                    *(v2u*)(Y + (size_t)rr * DM + c) = (v2u){pk2(o0, o1), pk2(o2, o3)}; } }
    }
}

constexpr int N_PHASES = 33;
template <class Epi, class Sched> DI void run_gemm(const Frame& F, const pg8::Gemm& g, const Sched& S, const Epi& E) {
    pg8::gemm_phase<Epi, Sched, true, true>(F.lds + RING_OFF, g, S, E);
}
DI void moe_up_units(const Frame& F, const Args& a, int t0, int ntl, int G, int c) {
    pg8::Gemm g{(const bf16*)(a.ws + WS_SCR + SC_XG), (const bf16*)(a.ws + WS_MOEW), DM, DM, DM};
    pg8::MoeOrder S{(const int*)(a.ws + WS_TILES), t0, ntl, 4, G, c, (long)MOE_E_BYTES};
    pg8::EpiSwiglu E{(bf16*)(a.ws + WS_SCR + SC_ACT), FF};
    run_gemm(F, g, S, E);
}
DI void moe_down_units(const Frame& F, const Args& a, int t0, int ntl, int G, int c) {
    pg8::Gemm g{(const bf16*)(a.ws + WS_SCR + SC_ACT), (const bf16*)(a.ws + WS_MOEW + MOE_W2_OFF), FF, FF, FF};
    pg8::MoeOrder S{(const int*)(a.ws + WS_TILES), t0, ntl, 8, G, c, (long)MOE_E_BYTES};
    pg8::EpiBf16 E{(bf16*)(a.ws + WS_SCR + SC_YB), DM};
    run_gemm(F, g, S, E);
}
DI void ph_moe_a(const Frame& F, const Args& a) {
    const int nt = (int)__hip_atomic_load((gu32*)(a.ws + WS_TILES) + 127, RLX_AGENT), n1 = nt < 64 ? nt : 64;
    moe_up_units(F, a, 0, n1, F.G, (int)blockIdx.x);
}
DI void ph_moe_b(const Frame& F, const Args& a) {
    const int nt = (int)__hip_atomic_load((gu32*)(a.ws + WS_TILES) + 127, RLX_AGENT), n1 = nt < 64 ? nt : 64; const int c = (int)blockIdx.x;
    int nu = 4 * (nt - n1); if (nu > F.G / 2) nu = F.G / 2;
    if (c < nu) moe_up_units(F, a, n1, nt - n1, nu, c); else moe_down_units(F, a, 0, n1, F.G - nu, c - nu);
}
DI void ph_moe_c(const Frame& F, const Args& a) {
    const int nt = (int)__hip_atomic_load((gu32*)(a.ws + WS_TILES) + 127, RLX_AGENT), n1 = nt < 64 ? nt : 64;
    moe_down_units(F, a, n1, nt - n1, F.G, (int)blockIdx.x);
}

DI void gemm_tail16(const Frame& F, const Args& a, const bf16* A, int lda, const bf16* Wt, int K, int mode) {
    if (F.vcu >= 128) return;
    const int lane = F.lane, lc = lane & 15, quad = lane >> 4, w = F.vcu; LAS float* red = (LAS float*)(F.lds + RING_OFF);
    f32x4 acc = (f32x4){0.f, 0.f, 0.f, 0.f}; const int kw = K / NWAVES, kb = F.wave * kw;
    const bf16* ap = A + (size_t)(TX + lc) * lda + kb + 8 * quad; const bf16* bp = Wt + (size_t)(16 * w + lc) * K + kb + 8 * quad;
#pragma unroll 4
    for (int ks = 0; ks < kw / 32; ++ks) acc = __builtin_amdgcn_mfma_f32_16x16x32_bf16(*(const bf16x8*)(ap + 32 * ks), *(const bf16x8*)(bp + 32 * ks), acc, 0, 0, 0);
    *(LAS f32x4*)(red + (F.wave * 64 + lane) * 4) = acc;
    __syncthreads();
    if (F.wave == 0) { f32x4 s = *(const LAS f32x4*)(red + lane * 4);
#pragma unroll
        for (int v = 1; v < NWAVES; ++v) s = s + *(const LAS f32x4*)(red + (v * 64 + lane) * 4);
        float* H = (float*)(a.ws + WS_H);
#pragma unroll
        for (int r = 0; r < 4; ++r) { const int row = 4 * quad + r, col = 16 * w + lc; const float base = mode ? H[(size_t)(TX + row) * DM + col] : a.in[1][(size_t)row * DM + col];
            H[(size_t)(TX + row) * DM + col] = base + s[r]; } }
    __syncthreads();
}

__global__ void __launch_bounds__(NWAVES * 64, 2) hyb_fwd(Args a) {
    extern __shared__ __attribute__((aligned(16))) unsigned char lds[];
    Frame F;
    F.lds = (LAS unsigned char*)lds;
    F.MISC = (volatile LAS unsigned*)(F.lds + MISC_OFF);
    F.tid = threadIdx.x; F.lane = F.tid & 63; F.wave = __builtin_amdgcn_readfirstlane(F.tid >> 6);
    F.G = gridDim.x; { const int bx = blockIdx.x; F.vcu = (F.G % 8 == 0) ? (bx % 8) * (F.G / 8) + bx / 8 : bx; }
    F.gw = F.vcu * NWAVES + F.wave; F.NGW = F.G * NWAVES;
    F.ctl = (gu32*)(a.ws + WS_CTL);
    for (int u = F.tid; u < (LDS_BYTES - LDSCTL_OFF) / 4; u += NWAVES * 64) ((LAS unsigned*)(F.lds + LDSCTL_OFF))[u] = 0u;
    __syncthreads();
    XcdBarrier bar; bar.bar = (unsigned*)(F.ctl + CW_BAR); bar.x = 0; bar.st = nullptr;
    if (MK_ONE_LAUNCH) bar = xcd_barrier_post((unsigned*)(F.ctl + CW_BAR), F.MISC + 8);
    const int lo = a.ph_lo, hi = a.ph_hi;
#ifndef PH_MASK
#define PH_MASK 0xFFFFFFFFFFFFFFFFull
#endif
#define IN(k) ((((unsigned long long)(PH_MASK) >> (k)) & 1ull) && lo <= (k) && (k) < hi)
#ifndef PROBE_REP
#define PROBE_REP 0u
#endif
#define REP(k) ((((unsigned long long)(PROBE_REP) >> (k)) & 1ull) ? 2 : 1)
#ifdef PROBE_TS
#define STAMP(k) do { if (blockIdx.x == 0 && F.tid == 0) ((unsigned long long*)(F.ctl + CW_TS))[(k)] = __builtin_amdgcn_s_memrealtime(); } while (0)
#else
#define STAMP(k) do { } while (0)
#endif
#define PHASE(k, ...) do { if (IN(k)) { { const int PH_REP_ = 0; (void)PH_REP_; __VA_ARGS__; } if (REP(k) == 2) { __syncthreads(); { const int PH_REP_ = 1; (void)PH_REP_; __VA_ARGS__; } } } } while (0)
#define SEAM(k) do { if (IN(k) && IN((k) + 1)) xcd_barrier(bar); STAMP((k) + 1); } while (0)
    const bf16* HN = (const bf16*)(a.ws + WS_HN); bf16* PROJ = (bf16*)(a.ws + WS_PROJ); const bf16* YMIX = (const bf16*)(a.ws + WS_YMIX); float* H = (float*)(a.ws + WS_H);

    STAMP(0);
    PHASE(0, { ph_prologue(F, a); ph_aux_convert(F, a, F.gw, F.NGW); });
    SEAM(0);
    PHASE(1, { pg8::Gemm g{HN, (const bf16*)(a.ws + WS_WEVIN), DM, DM, DM}; pg8::StaticOrder S; S.init(MP, EV_NP, F.G, (int)blockIdx.x); pg8::EpiBf16 E{PROJ, EV_NP}; run_gemm(F, g, S, E); });
    SEAM(1);
    PHASE(2, ph_even_prep(F, a););
    SEAM(2);
    PHASE(3, {
        { pg8::Gemm g{(const bf16*)(a.ws + WS_SCR + SC_ALORA), (const bf16*)(a.ws + WS_WLORA), 384, 384, 384}; pg8::StaticOrder S; S.init(MP, 3072, F.G, (int)blockIdx.x);
          static_assert(SC_ICL - SC_DEC == SC_GATE - SC_ICL, "lora outputs equally spaced");
          pg8::EpiLora E{(bf16*)(a.ws + WS_SCR + SC_DEC), (long)((SC_ICL - SC_DEC) / 2), a.in[7], a.in[9]}; run_gemm(F, g, S, E); }
        { pg8::Gemm g{(const bf16*)(a.ws + WS_SCR + SC_XR), (const bf16*)(a.ws + WS_WGATE), 256, 1024, 256}; pg8::StaticOrder S; S.init(MP, 2048, F.G, (int)blockIdx.x); S.amod = 4; S.astep = 512;
          pg8::EpiGates E{(bf16*)(a.ws + WS_SCR + SC_LA), (bf16*)(a.ws + WS_SCR + SC_LIX), a.in[20], a.in[22], a.in[23], (const bf16*)(a.ws + WS_SCR + SC_XR)}; run_gemm(F, g, S, E); }
    });
    SEAM(3);
    PHASE(4, ph_rwkv_chunk(F, a, 0, 32, 0););
    SEAM(4);
    PHASE(5, { if (F.vcu < 16) ph_rwkv_chain(F, a, 0, 64); else ph_rwkv_chunk(F, a, 32, 62, 16); });
    SEAM(5);
#if defined(PROBE_X) && PROBE_X == 1
    PHASE(6, { if (F.vcu < 16) { ph_rwkv_chain(F, a, 64, 124); __syncthreads(); ph_rwkv_chain(F, a, 64, 124); } else ph_rwkv_chunk(F, a, 62, 92, 16); });
#elif defined(PROBE_X) && PROBE_X == 2
    PHASE(6, { if (F.vcu < 16) ph_rwkv_chain(F, a, 64, 124); else { ph_rwkv_chunk(F, a, 62, 92, 16); __syncthreads(); ph_rwkv_chunk(F, a, 62, 92, 16); } });
#else
    PHASE(6, { if (F.vcu < 16) ph_rwkv_chain(F, a, 64, 124); else ph_rwkv_chunk(F, a, 62, 92, 16); });
#endif
    SEAM(6);
    PHASE(7, { if (F.vcu < 16) ph_rwkv_chain(F, a, 124, 184); else ph_rwkv_chunk(F, a, 92, 122, 16); });
    SEAM(7);
    PHASE(8, { if (F.vcu < 16) ph_rwkv_chain(F, a, 184, 244); else { ph_rwkv_chunk(F, a, 122, 129, 16); lru_local(F, a, (F.vcu - 16) * NWAVES + F.wave, (F.G - 16) * NWAVES); } });
    SEAM(8);
    PHASE(9, { if (F.vcu < 18) ph_rwkv_chain(F, a, 244, RW_NSC); else ph_rwkv_out(F, a, 0, 244, (F.vcu - 18) * NWAVES + F.wave, (F.G - 18) * NWAVES); });
    SEAM(9);
    PHASE(10, { ph_rwkv_out(F, a, 244, RW_NSC, F.gw, F.NGW); lru_apply(F, a); });
    SEAM(10);
    PHASE(11, { pg8::Gemm g{YMIX, (const bf16*)(a.ws + WS_WEVOUT), DM, DM, DM}; pg8::StaticOrder S; S.init(TX, DM, F.G, (int)blockIdx.x); pg8::EpiResid E{H, a.in[0], a.in[1], 0}; run_gemm(F, g, S, E); gemm_tail16(F, a, YMIX, DM, (const bf16*)(a.ws + WS_WEVOUT), DM, 0); });
    SEAM(11);
    PHASE(12, ph_route(F, a, 0, PH_REP_););
    SEAM(12);
    PHASE(13, ph_gather(F, a, 0););
    SEAM(13);
    PHASE(14, ph_moe_a(F, a););
    SEAM(14);
    PHASE(15, ph_moe_b(F, a););
    SEAM(15);
    PHASE(16, ph_moe_c(F, a););
    SEAM(16);
    PHASE(17, ph_combine(F, a, 0););
    SEAM(17);
    PHASE(18, { pg8::Gemm g{HN, (const bf16*)(a.ws + WS_WODIN), DM, DM, DM}; pg8::StaticOrder S; S.init(MP, OD_NP, F.G, (int)blockIdx.x); pg8::EpiBf16 E{PROJ, OD_NP}; run_gemm(F, g, S, E); });
    SEAM(18);
    PHASE(19, ph_odd_prep(F, a););
    SEAM(19);
    PHASE(20, ph_gdn_chunk(F, a, 0, 54, 0););
    SEAM(20);
    PHASE(21, { ph_gdn_chain(F, a, 0, 54); ph_gdn_chunk(F, a, 54, 90, 1); });
    SEAM(21);
#if defined(PROBE_X) && PROBE_X == 3
    PHASE(22, { ph_gdn_chain(F, a, 54, 90); __syncthreads(); ph_gdn_chain(F, a, 54, 90); ph_gdn_chunk(F, a, 90, 114, 1); });
#elif defined(PROBE_X) && PROBE_X == 4
    PHASE(22, { ph_gdn_chain(F, a, 54, 90); ph_gdn_chunk(F, a, 90, 114, 1); __syncthreads(); ph_gdn_chunk(F, a, 90, 114, 1); });
#else
    PHASE(22, { ph_gdn_chain(F, a, 54, 90); ph_gdn_chunk(F, a, 90, 114, 1); });
#endif
    SEAM(22);
    PHASE(23, { ph_gdn_chain(F, a, 90, 114); ph_gdn_chunk(F, a, 114, 129, 1); });
    SEAM(23);
    PHASE(24, { ph_gdn_chain(F, a, 114, 129); ph_odd_post(F, a, 0); });
    SEAM(24);
    PHASE(25, { ph_odd_post(F, a, F.G == 256 ? 1 : 2); moe_convert(F, a, 1, F.gw, F.NGW); });
    SEAM(25);
    PHASE(26, { pg8::Gemm g{YMIX, (const bf16*)(a.ws + WS_WODOUT), 4096, 4096, 4096}; pg8::StaticOrder S; S.init(TX, DM, F.G, (int)blockIdx.x); pg8::EpiResid E{H, a.in[0], a.in[1], 1}; run_gemm(F, g, S, E); gemm_tail16(F, a, YMIX, 4096, (const bf16*)(a.ws + WS_WODOUT), 4096, 1); });
    SEAM(26);
    PHASE(27, ph_route(F, a, 1, PH_REP_););
    SEAM(27);
    PHASE(28, ph_gather(F, a, 1););
    SEAM(28);
    PHASE(29, ph_moe_a(F, a););
    SEAM(29);
    PHASE(30, ph_moe_b(F, a););
    SEAM(30);
    PHASE(31, ph_moe_c(F, a););
    SEAM(31);
    PHASE(32, ph_combine(F, a, 1););
#ifdef PROBE_BARS
    for (int i_ = 0; i_ < PROBE_BARS; ++i_) xcd_barrier(bar);
#endif
#undef IN
#undef SEAM
}

extern "C" void kernel_launch(void* const* d_in, const int* in_sizes, int n_in, void* d_out, int out_size, void* d_ws, size_t ws_size, hipStream_t stream) {
    static int grid = 0;
    if (grid == 0) {
        if (n_in != 36 || out_size != TX * DM || ws_size < WS_END) { fprintf(stderr, "kernel_launch: unexpected shapes (n_in %d, out %d, ws %zu)\n", n_in, out_size, ws_size); grid = -1; return; }
        int dev = 0, cus = 0, per_cu = 0;
        if (hipGetDevice(&dev) != hipSuccess || hipDeviceGetAttribute(&cus, hipDeviceAttributeMultiprocessorCount, dev) != hipSuccess) { grid = -1; return; }
        if (hipFuncSetAttribute((const void*)hyb_fwd, hipFuncAttributeMaxDynamicSharedMemorySize, LDS_BYTES) != hipSuccess) { fprintf(stderr, "kernel_launch: hipFuncSetAttribute failed\n"); grid = -1; return; }
        if (hipOccupancyMaxActiveBlocksPerMultiprocessor(&per_cu, (const void*)hyb_fwd, NWAVES * 64, LDS_BYTES) != hipSuccess || per_cu < 1) { fprintf(stderr, "kernel_launch: occupancy query says %d\n", per_cu); per_cu = 1; }
        (void)hipGetLastError();
        grid = cus;
    }
    if (grid < 0) return;
    if (hipMemsetAsync((char*)d_ws + WS_CTL, 0, CTL_ZERO_BYTES, stream) != hipSuccess) return;
    Args a{};
    for (int i = 0; i < 36; ++i) a.in[i] = (const float*)d_in[i];
    a.out = (float*)d_out; a.ws = (unsigned char*)d_ws;
#if MK_ONE_LAUNCH
    a.ph_lo = 0; a.ph_hi = N_PHASES;
    hipLaunchKernelGGL(hyb_fwd, dim3(grid), dim3(NWAVES * 64), LDS_BYTES, stream, a);
#else
    for (int p = 0; p < N_PHASES; ++p) { a.ph_lo = p; a.ph_hi = p + 1; hipLaunchKernelGGL(hyb_fwd, dim3(grid), dim3(NWAVES * 64), LDS_BYTES, stream, a); }
#endif
}
```

```cpp
#include <hip/hip_runtime.h>
#include <cstdio>
#include <cstdint>
#include <cmath>

#ifndef MK_ONE_LAUNCH
#define MK_ONE_LAUNCH 1
#endif

namespace pg8 {
#define PG8_LAS __attribute__((address_space(3)))
typedef unsigned short bf16_t;
typedef short bf16x8 __attribute__((ext_vector_type(8)));
typedef float f32x4 __attribute__((ext_vector_type(4)));
typedef unsigned u32x4 __attribute__((ext_vector_type(4)));
typedef unsigned u32x2 __attribute__((ext_vector_type(2)));
constexpr int BM = 256, BK = 64, HALF = 128, HTB = HALF * BK * 2  , STAGE_BYTES = 8 * HTB, NXCD = 8, WGM = 8;

__host__ __device__ __forceinline__ int lds_byte(int r, int c) { const int st = (r >> 4) * 2 + (c >> 5), rr = r & 15, cc = c & 31, ob = rr * 64 + cc * 2; return st * 1024 + (ob ^ (((ob >> 9) & 1) << 5)); }
__host__ __device__ __forceinline__ void stage_rc(int b, int& R, int& C) { const int st = b / 1024, sb = b % 1024, swz = sb ^ (((sb >> 9) & 1) << 5); R = (st >> 1) * 16 + swz / 64; C = (st & 1) * 32 + (swz % 64) / 2; }
__host__ __device__ __forceinline__ int perm32(int rho) { const int n = rho >> 4, i = rho & 15; return 8 * (i >> 2) + 4 * n + (i & 3); }

struct Unit { int pm, pn; long aoff, boff; };
struct Gemm { const bf16_t* A; const bf16_t* Bt; int K, lda, ldb; };

struct StaticOrder {
    int nM, nN, nwg, G, c, amod; long astep;
    __host__ __device__ void init(int M, int N, int G_, int c_) { nM = M / BM; nN = N / BM; nwg = nM * nN; G = G_; c = c_; amod = 0; astep = 0; }
    __host__ __device__ bool next(int i, Unit& u) const {
        const long L = (long)i * G + c; if (L >= nwg) return false;
        int wgid = (int)L; { const int q = nwg / NXCD, r = nwg % NXCD, xcd = wgid % NXCD, off = wgid / NXCD; wgid = (xcd < r ? xcd * (q + 1) : r * (q + 1) + (xcd - r) * q) + off; }
        const int nig = WGM * nN, gid = wgid / nig, fm = gid * WGM, gsz = (nM - fm) < WGM ? (nM - fm) : WGM;
        u.pm = fm + ((wgid % nig) % gsz); u.pn = (wgid % nig) / gsz; u.boff = 0; u.aoff = amod ? (long)(u.pn % amod) * astep : 0; return true;
    }
    __device__ __forceinline__ void a_ready(const Unit&) const {}
    __device__ __forceinline__ void done(const Unit&) const {}
};
struct MoeOrder {
    const int* tile_e; int t0, ntiles, npn, G, c; long bstride;
    __device__ __forceinline__ bool next(int i, Unit& u) const {
        const long L = (long)i * G + c; if (c < 0 || L >= (long)ntiles * npn) return false;
        const int t = t0 + (int)(L / npn); u.pm = t; u.pn = (int)(L % npn); u.aoff = 0; u.boff = (long)tile_e[t] * bstride; return true;
    }
    __device__ __forceinline__ void a_ready(const Unit&) const {}
    __device__ __forceinline__ void done(const Unit&) const {}
};

__device__ __forceinline__ unsigned cvt_pk_bf16(float lo, float hi) { unsigned r; asm volatile("v_cvt_pk_bf16_f32 %0, %1, %2" : "=v"(r) : "v"(lo), "v"(hi)); return r; }
__device__ __forceinline__ float bf_lo(unsigned w) { return __uint_as_float(w << 16); }
__device__ __forceinline__ float bf_hi(unsigned w) { return __uint_as_float(w & 0xffff0000u); }
__device__ __forceinline__ float sigmoidf_(float x) { return __builtin_amdgcn_rcpf(1.0f + __expf(-x)); }
__device__ __forceinline__ float softplusf_(float x) { return fmaxf(x, 0.f) + __logf(1.0f + __expf(-fabsf(x))); }

struct EpiBf16 {
    static constexpr bool PERM = true, AFTER_DRAIN = false;
    bf16_t* O; int ldc;
    __device__ __forceinline__ void operator()(const f32x4 (&acc)[2][2][4][2], const Unit& u, int wr, int wc, int fr, int fq) const {
        const int row0 = u.pm * BM + wr * 64 + fr; const int col0 = u.pn * BM + wc * 32 + 8 * fq;
#pragma unroll
        for (int ai = 0; ai < 2; ++ai)
#pragma unroll
            for (int m = 0; m < 4; ++m) { bf16_t* rowp = O + (size_t)(row0 + ai * HALF + m * 16) * ldc + col0;
#pragma unroll
                for (int bj = 0; bj < 2; ++bj) { const f32x4 v0 = acc[ai][bj][m][0], v1 = acc[ai][bj][m][1];
                    u32x4 w; w.x = cvt_pk_bf16(v0[0], v0[1]); w.y = cvt_pk_bf16(v0[2], v0[3]); w.z = cvt_pk_bf16(v1[0], v1[1]); w.w = cvt_pk_bf16(v1[2], v1[3]);
                    *(u32x4*)(rowp + bj * HALF) = w; } }
    }
};
struct EpiSwiglu {
    static constexpr bool PERM = true, AFTER_DRAIN = false;
    bf16_t* O; int ldc;
    __device__ __forceinline__ void operator()(const f32x4 (&acc)[2][2][4][2], const Unit& u, int wr, int wc, int fr, int fq) const {
        const int row0 = u.pm * BM + wr * 64 + fr; const int col0 = u.pn * HALF + wc * 32 + 8 * fq;
#pragma unroll
        for (int ai = 0; ai < 2; ++ai)
#pragma unroll
            for (int m = 0; m < 4; ++m) { bf16_t* rowp = O + (size_t)(row0 + ai * HALF + m * 16) * ldc + col0;
                float o[8];
#pragma unroll
                for (int n = 0; n < 2; ++n)
#pragma unroll
                    for (int j = 0; j < 4; ++j) { const float gq = acc[ai][0][m][n][j], uq = acc[ai][1][m][n][j]; o[4 * n + j] = gq * sigmoidf_(gq) * uq; }
                u32x4 w; w.x = cvt_pk_bf16(o[0], o[1]); w.y = cvt_pk_bf16(o[2], o[3]); w.z = cvt_pk_bf16(o[4], o[5]); w.w = cvt_pk_bf16(o[6], o[7]);
                *(u32x4*)rowp = w; }
    }
};
struct EpiResid {
    static constexpr bool PERM = false, AFTER_DRAIN = false;
    float* out; const float* x; const float* meta; int mode;
    __device__ __forceinline__ void operator()(const f32x4 (&acc)[2][2][4][2], const Unit& u, int wr, int wc, int fr, int fq) const {
        const int row0 = u.pm * BM + wr * 64 + fr, col0 = u.pn * BM + wc * 32 + 4 * fq;
#pragma unroll
        for (int ai = 0; ai < 2; ++ai)
#pragma unroll
            for (int m = 0; m < 4; ++m) { const int row = row0 + ai * HALF + m * 16; float* rowp = out + (size_t)row * 2048 + col0;
                const float* bp = mode ? rowp : (row < 8192 ? x + (size_t)row * 2048 + col0 : (row < 8208 ? meta + (size_t)(row - 8192) * 2048 + col0 : nullptr));
#pragma unroll
                for (int bj = 0; bj < 2; ++bj)
#pragma unroll
                    for (int n = 0; n < 2; ++n) { f32x4 b = (f32x4){0.f, 0.f, 0.f, 0.f}; if (bp) b = *(const f32x4*)(bp + bj * HALF + n * 16);
                        *(f32x4*)(rowp + bj * HALF + n * 16) = acc[ai][bj][m][n] + b; } }
    }
};
__device__ __forceinline__ float one_minus_exp_neg(float e) { return e < 0.05f ? e * (1.0f - e * (0.5f - e * (1.0f / 6.0f))) : 1.0f - __expf(-e); }
struct EpiLora {
    static constexpr bool PERM = false, AFTER_DRAIN = false;
    bf16_t* base; long gstride; const float* w0; const float* a0;
    __device__ __forceinline__ void operator()(const f32x4 (&acc)[2][2][4][2], const Unit& u, int wr, int wc, int fr, int fq) const {
        const int grp = u.pn >> 2; const int row0 = u.pm * BM + wr * 64 + fr, col0 = (u.pn & 3) * BM + wc * 32 + 4 * fq;
        bf16_t* O = base + (size_t)grp * gstride;
#pragma unroll
        for (int bj = 0; bj < 2; ++bj)
#pragma unroll
            for (int n = 0; n < 2; ++n) { const int c = col0 + bj * HALF + n * 16;
                f32x4 bv = (f32x4){0.f, 0.f, 0.f, 0.f}; if (grp == 0) bv = *(const f32x4*)(w0 + c); else if (grp == 1) bv = *(const f32x4*)(a0 + c);
#pragma unroll
                for (int ai = 0; ai < 2; ++ai)
#pragma unroll
                    for (int m = 0; m < 4; ++m) { f32x4 v = acc[ai][bj][m][n] + bv;
                        if (grp == 0) {
#pragma unroll
                            for (int j = 0; j < 4; ++j) { const float wl = -softplusf_(-v[j]) - 0.5f; v[j] = one_minus_exp_neg(__expf(wl)); }
                        } else if (grp == 1) {
#pragma unroll
                            for (int j = 0; j < 4; ++j) v[j] = sigmoidf_(v[j]);
                        }
                        u32x2 w; w.x = cvt_pk_bf16(v[0], v[1]); w.y = cvt_pk_bf16(v[2], v[3]);
                        *(u32x2*)(O + (size_t)(row0 + ai * HALF + m * 16) * 1024 + c) = w; } }
    }
};
struct EpiGates {
    static constexpr bool PERM = false, AFTER_DRAIN = false;
    bf16_t* lru_a; bf16_t* lru_ix; const float* ba; const float* bx; const float* lam; const bf16_t* xr;
    __device__ __forceinline__ void operator()(const f32x4 (&acc)[2][2][4][2], const Unit& u, int wr, int wc, int fr, int fq) const {
        const int grp = u.pn >> 2; const int row0 = u.pm * BM + wr * 64 + fr, col0 = (u.pn & 3) * BM + wc * 32 + 4 * fq;
#pragma unroll
        for (int bj = 0; bj < 2; ++bj)
#pragma unroll
            for (int n = 0; n < 2; ++n) { const int c = col0 + bj * HALF + n * 16;
                const f32x4 bv = *(const f32x4*)((grp == 0 ? ba : bx) + c); f32x4 sp = (f32x4){0.f, 0.f, 0.f, 0.f};
                if (grp == 0) { const f32x4 l = *(const f32x4*)(lam + c);
#pragma unroll
                    for (int j = 0; j < 4; ++j) sp[j] = 8.0f * softplusf_(-l[j]); }
#pragma unroll
                for (int ai = 0; ai < 2; ++ai)
#pragma unroll
                    for (int m = 0; m < 4; ++m) { const int row = row0 + ai * HALF + m * 16; f32x4 v = acc[ai][bj][m][n] + bv; u32x2 w;
                        if (grp == 0) {
#pragma unroll
                            for (int j = 0; j < 4; ++j) v[j] = one_minus_exp_neg(sigmoidf_(v[j]) * sp[j]);
                            w.x = cvt_pk_bf16(v[0], v[1]); w.y = cvt_pk_bf16(v[2], v[3]); *(u32x2*)(lru_a + (size_t)row * 1024 + c) = w;
                        } else { const u32x2 xw = *(const u32x2*)(xr + (size_t)row * 1024 + c);
                            v[0] = sigmoidf_(v[0]) * bf_lo(xw.x); v[1] = sigmoidf_(v[1]) * bf_hi(xw.x); v[2] = sigmoidf_(v[2]) * bf_lo(xw.y); v[3] = sigmoidf_(v[3]) * bf_hi(xw.y);
                            w.x = cvt_pk_bf16(v[0], v[1]); w.y = cvt_pk_bf16(v[2], v[3]); *(u32x2*)(lru_ix + (size_t)row * 1024 + c) = w; } } }
    }
};

template <class Epi, class Sched, bool ALIGN_EPI = false, bool SP2 = false>
__device__ __forceinline__ void gemm_phase(PG8_LAS unsigned char* lds, const Gemm g, const Sched& S, const Epi& E) {
    const int tid = threadIdx.x, wid = __builtin_amdgcn_readfirstlane(tid >> 6), lane = tid & 63, wr = wid >> 2, wc = wid & 3, fr = lane & 15, fq = lane >> 4;
    const int K = g.K, nt = K / BK;
    unsigned voffA[2], voffB[2];
#pragma unroll
    for (int i = 0; i < 2; ++i) { int R, C; stage_rc(tid * 16 + i * 8192, R, C); const int Rb = Epi::PERM ? ((R & ~31) + perm32(R & 31)) : R;
        voffA[i] = (unsigned)(R * g.lda + C) * 2u; voffB[i] = (unsigned)(Rb * g.ldb + C) * 2u; }
    const size_t kstep = (size_t)(BK * 2);
    const size_t hstepA = (size_t)HALF * g.lda * 2, hstepB = (size_t)HALF * g.ldb * 2;
    const size_t tstepA = 2 * hstepA, tstepB = 2 * hstepB;
    const unsigned ldsw = (unsigned)wid * 1024u;
    const int aoff = lds_byte(wr * 64 + fr, fq * 8), boff = lds_byte(wc * 32 + fr, fq * 8);
#define PG8_SA(b, h) (((b) * 2 + (h)) * HTB)
#define PG8_SB(b, h) ((4 + (b) * 2 + (h)) * HTB)
#define PG8_STAGE(bufoff, gbase, voff) do { _Pragma("unroll") for (int _i = 0; _i < 2; ++_i) \
        __builtin_amdgcn_global_load_lds((const unsigned*)((const char*)(gbase) + (voff)[_i]), (PG8_LAS unsigned*)(lds + (bufoff) + ldsw + _i * 8192), 16, 0, 0); } while (0)
#define PG8_LDA(dst, b, h) do { _Pragma("unroll") for (int m = 0; m < 4; ++m) _Pragma("unroll") for (int k = 0; k < 2; ++k) dst[m][k] = *(const PG8_LAS bf16x8*)(lds + PG8_SA(b, h) + aoff + m * 2048 + k * 1024); } while (0)
#define PG8_LDB(dst, b, h) do { _Pragma("unroll") for (int n = 0; n < 2; ++n) _Pragma("unroll") for (int k = 0; k < 2; ++k) dst[n][k] = *(const PG8_LAS bf16x8*)(lds + PG8_SB(b, h) + boff + n * 2048 + k * 1024); } while (0)
#define PG8_MMA(ai, bj, At, Bt) do { __builtin_amdgcn_s_setprio(1); _Pragma("unroll") for (int m = 0; m < 4; ++m) _Pragma("unroll") for (int n = 0; n < 2; ++n) _Pragma("unroll") for (int k = 0; k < 2; ++k) \
        acc[ai][bj][m][n] = __builtin_amdgcn_mfma_f32_16x16x32_bf16(Bt[n][k], At[m][k], acc[ai][bj][m][n], 0, 0, 0); __builtin_amdgcn_s_setprio(0); } while (0)
#define PG8_WAIT_V(n) asm volatile("s_waitcnt vmcnt(" #n ")" ::: "memory")
#define PG8_WAIT_L(n) asm volatile("s_waitcnt lgkmcnt(" #n ")" ::: "memory")
#define PG8_BAR __builtin_amdgcn_s_barrier()
#define PG8_SCHED __builtin_amdgcn_sched_barrier(0)
    Unit cur, nxt; int ui = 0;
    if (!S.next(0, cur)) return;
    f32x4 acc[2][2][4][2];
#pragma unroll
    for (int a = 0; a < 2; ++a)
#pragma unroll
        for (int b = 0; b < 2; ++b)
#pragma unroll
            for (int m = 0; m < 4; ++m)
#pragma unroll
                for (int n = 0; n < 2; ++n) acc[a][b][m][n] = (f32x4){0.f, 0.f, 0.f, 0.f};
    bf16x8 At[4][2], B0[2][2], B1[2][2];
    const char* cA = (const char*)g.A + (size_t)cur.pm * tstepA + cur.aoff; const char* cB = (const char*)g.Bt + (size_t)cur.pn * tstepB + cur.boff;
    S.a_ready(cur);
    if constexpr (SP2) {
        PG8_STAGE(PG8_SB(0, 0), cB, voffB); PG8_STAGE(PG8_SB(0, 1), cB + hstepB, voffB); PG8_STAGE(PG8_SA(0, 0), cA, voffA); PG8_STAGE(PG8_SA(0, 1), cA + hstepA, voffA);
        if (wr == 1) PG8_BAR;
        PG8_WAIT_V(2); PG8_BAR;
        PG8_STAGE(PG8_SB(1, 0), cB + kstep, voffB); PG8_STAGE(PG8_SA(1, 0), cA + kstep, voffA); PG8_STAGE(PG8_SB(1, 1), cB + hstepB + kstep, voffB);
        PG8_WAIT_V(6); PG8_BAR;
    } else {
        PG8_STAGE(PG8_SB(0, 0), cB, voffB); PG8_STAGE(PG8_SA(0, 0), cA, voffA); PG8_STAGE(PG8_SB(0, 1), cB + hstepB, voffB); PG8_STAGE(PG8_SA(0, 1), cA + hstepA, voffA);
        if (wr == 1) PG8_BAR;
        PG8_WAIT_V(4); PG8_BAR;
        PG8_STAGE(PG8_SB(1, 0), cB + kstep, voffB); PG8_STAGE(PG8_SA(1, 0), cA + kstep, voffA); PG8_STAGE(PG8_SB(1, 1), cB + hstepB + kstep, voffB);
        PG8_WAIT_V(6); PG8_BAR;
    }
    for (;;) {
        const bool has_next = S.next(ui + 1, nxt);
        const char* nA = has_next ? (const char*)g.A + (size_t)nxt.pm * tstepA + nxt.aoff : cA; const char* nB = has_next ? (const char*)g.Bt + (size_t)nxt.pn * tstepB + nxt.boff : cB;
        for (int t = 0; t < nt; t += 2) {
            const bool last = (t == nt - 2);
            const char* a1 = cA + (size_t)(t + 1) * kstep;
            const char* a2 = last ? nA : cA + (size_t)(t + 2) * kstep; const char* b2 = last ? nB : cB + (size_t)(t + 2) * kstep;
            const char* a3 = a2 + kstep; const char* b3 = b2 + kstep;
            if (last && has_next) S.a_ready(nxt);
            if constexpr (SP2) {
            PG8_LDB(B0, 0, 0); PG8_LDB(B1, 0, 1); PG8_SCHED; PG8_LDA(At, 0, 0); PG8_STAGE(PG8_SA(1, 1), a1 + hstepA, voffA);
            PG8_WAIT_V(8); PG8_WAIT_L(0); PG8_BAR; PG8_MMA(0, 0, At, B0); PG8_MMA(0, 1, At, B1); PG8_BAR; PG8_SCHED;
            PG8_LDA(At, 0, 1); PG8_STAGE(PG8_SB(0, 0), b2, voffB); PG8_STAGE(PG8_SB(0, 1), b2 + hstepB, voffB); PG8_STAGE(PG8_SA(0, 0), a2, voffA);
            PG8_WAIT_V(8); PG8_WAIT_L(0); PG8_BAR; PG8_MMA(1, 0, At, B0); PG8_MMA(1, 1, At, B1); PG8_BAR; PG8_SCHED;
            PG8_LDB(B0, 1, 0); PG8_LDB(B1, 1, 1); PG8_SCHED; PG8_LDA(At, 1, 0); PG8_STAGE(PG8_SA(0, 1), a2 + hstepA, voffA);
            PG8_WAIT_V(8); PG8_WAIT_L(0); PG8_BAR; PG8_MMA(0, 0, At, B0); PG8_MMA(0, 1, At, B1); PG8_BAR; PG8_SCHED;
            PG8_LDA(At, 1, 1); PG8_STAGE(PG8_SB(1, 0), b3, voffB); PG8_STAGE(PG8_SB(1, 1), b3 + hstepB, voffB); PG8_STAGE(PG8_SA(1, 0), a3, voffA);
            PG8_WAIT_V(8); PG8_WAIT_L(0); PG8_BAR; PG8_MMA(1, 0, At, B0); PG8_MMA(1, 1, At, B1); PG8_BAR; PG8_SCHED;
            } else {
            PG8_LDB(B0, 0, 0); PG8_SCHED; PG8_LDA(At, 0, 0); PG8_STAGE(PG8_SA(1, 1), a1 + hstepA, voffA);
            PG8_WAIT_L(8); PG8_BAR; PG8_WAIT_L(0); PG8_MMA(0, 0, At, B0); PG8_BAR; PG8_SCHED;
            PG8_LDB(B1, 0, 1); PG8_STAGE(PG8_SB(0, 0), b2, voffB);
            PG8_BAR; PG8_WAIT_L(0); PG8_MMA(0, 1, At, B1); PG8_BAR;
            PG8_LDA(At, 0, 1); PG8_STAGE(PG8_SA(0, 0), a2, voffA);
            PG8_BAR; PG8_WAIT_L(0); PG8_MMA(1, 0, At, B0); PG8_BAR; PG8_SCHED;
            PG8_STAGE(PG8_SB(0, 1), b2 + hstepB, voffB);
            PG8_WAIT_V(6); PG8_BAR; PG8_MMA(1, 1, At, B1); PG8_BAR;
            PG8_LDB(B0, 1, 0); PG8_SCHED; PG8_LDA(At, 1, 0); PG8_STAGE(PG8_SA(0, 1), a2 + hstepA, voffA);
            PG8_WAIT_L(8); PG8_BAR; PG8_WAIT_L(0); PG8_MMA(0, 0, At, B0); PG8_BAR; PG8_SCHED;
            PG8_LDB(B1, 1, 1); PG8_STAGE(PG8_SB(1, 0), b3, voffB);
            PG8_BAR; PG8_WAIT_L(0); PG8_MMA(0, 1, At, B1); PG8_BAR;
            PG8_LDA(At, 1, 1); PG8_STAGE(PG8_SA(1, 0), a3, voffA);
            PG8_BAR; PG8_WAIT_L(0); PG8_MMA(1, 0, At, B0); PG8_BAR; PG8_SCHED;
            PG8_STAGE(PG8_SB(1, 1), b3 + hstepB, voffB);
            PG8_WAIT_V(6); PG8_BAR; PG8_MMA(1, 1, At, B1); PG8_BAR;
            }
        }
        if constexpr (ALIGN_EPI) { if (wr == 0) PG8_BAR; }
        if constexpr (!Epi::AFTER_DRAIN) { E(acc, cur, wr, wc, fr, fq); S.done(cur); }
        if (!has_next) break;
#pragma unroll
        for (int a = 0; a < 2; ++a)
#pragma unroll
            for (int b = 0; b < 2; ++b)
#pragma unroll
                for (int m = 0; m < 4; ++m)
#pragma unroll
                    for (int n = 0; n < 2; ++n) acc[a][b][m][n] = (f32x4){0.f, 0.f, 0.f, 0.f};
        cur = nxt; cA = nA; cB = nB; ++ui;
        if constexpr (ALIGN_EPI) { if (wr == 1) PG8_BAR; }
    }
    PG8_WAIT_V(0);
    if constexpr (!ALIGN_EPI) { if (wr == 0) PG8_BAR; }
    PG8_BAR;
    if constexpr (Epi::AFTER_DRAIN) { E.fused(acc, cur, wr, wc, fr, fq, lds, wid, lane); S.done(cur); }
#undef PG8_SA
#undef PG8_SB
#undef PG8_STAGE
#undef PG8_LDA
#undef PG8_LDB
#undef PG8_MMA
#undef PG8_WAIT_V
#undef PG8_WAIT_L
#undef PG8_BAR
#undef PG8_SCHED
}
}
#define GAS __attribute__((address_space(1)))
#define LAS __attribute__((address_space(3)))
typedef unsigned short bf16;
typedef unsigned v4u __attribute__((ext_vector_type(4)));
typedef float f32x4 __attribute__((ext_vector_type(4)));
typedef short bf16x8 __attribute__((ext_vector_type(8)));
typedef GAS unsigned gu32;
typedef GAS unsigned long long gu64;
#define RLX_AGENT __ATOMIC_RELAXED, __HIP_MEMORY_SCOPE_AGENT
#define LDS_WAIT() asm volatile("s_waitcnt lgkmcnt(0)" ::: "memory")
#define VM_WAIT() asm volatile("s_waitcnt vmcnt(0)" ::: "memory")
__device__ __forceinline__ unsigned long long rt() { return __builtin_amdgcn_s_memrealtime(); }
__device__ __forceinline__ unsigned f2bf(float f) { unsigned u = __builtin_bit_cast(unsigned, f); return (u + 0x7fffu + ((u >> 16) & 1u)) >> 16; }
__device__ __forceinline__ unsigned pk2(float lo, float hi) { return f2bf(lo) | (f2bf(hi) << 16); }

#define XB_TMO      128
#define XB_XCNT(j)  (256  + 64 * (j))
#define XB_XSUB(j)  (1280 + 64 * (j))
#define XB_XGEN(j)  (2304 + 64 * (j))
#define XB_TOP      3328
#define XB_TOPGEN   3392
#define XCD_BAR_WORDS 3456
#define XB_SPIN_CAP (1u << 18)

__device__ __forceinline__ unsigned xb_ld(unsigned* p)              { return __hip_atomic_load(p, __ATOMIC_RELAXED, __HIP_MEMORY_SCOPE_AGENT); }
__device__ __forceinline__ unsigned xb_add(unsigned* p, unsigned v) { return __hip_atomic_fetch_add(p, v, __ATOMIC_RELAXED, __HIP_MEMORY_SCOPE_AGENT); }
__device__ __forceinline__ unsigned xb_xcc_id() { return (unsigned)__builtin_amdgcn_s_getreg((3 << 11) | 20) & 0xFu; }
#define XB_SPIN(cond, bar) do { unsigned _sp = 0; while (cond) { __builtin_amdgcn_s_sleep(1); \
    if ((++_sp & 255u) == 0u) { if (xb_ld(&(bar)[XB_TMO])) break; if (_sp > XB_SPIN_CAP) { atomicAdd(&(bar)[XB_TMO], 1u); break; } } } } while (0)

struct XcdBarrier {
    unsigned* bar; unsigned x;
    volatile LAS unsigned* st;
};

__device__ __forceinline__ XcdBarrier xcd_barrier_post(unsigned* bar, volatile LAS unsigned* st) {
    XcdBarrier b; b.bar = bar; b.x = xb_xcc_id(); b.st = st;
    if (threadIdx.x == 0) (void)xb_add(&bar[XB_XCNT(b.x)], 1u);
    return b;
}
__device__ __forceinline__ void xcd_barrier_complete(unsigned* bar, unsigned x, unsigned& nloc, unsigned& nx) {
    const unsigned G = gridDim.x * gridDim.y * gridDim.z;
    unsigned sum, cnt, mine, sp = 0u;
    for (;;) {
        sum = 0u; cnt = 0u; mine = 0u;
#pragma unroll
        for (unsigned j = 0; j < 16; ++j) { const unsigned c = xb_ld(&bar[XB_XCNT(j)]); sum += c; cnt += (c > 0u) ? 1u : 0u; mine = (j == x) ? c : mine; }
        if (sum == G) break;
        __builtin_amdgcn_s_sleep(1);
        if ((++sp & 255u) == 0u) { if (xb_ld(&bar[XB_TMO])) break; if (sp > XB_SPIN_CAP) { atomicAdd(&bar[XB_TMO], 1u); break; } }
    }
    nloc = mine > 0u ? mine : 1u; nx = cnt > 0u ? cnt : 1u;
}

__device__ __forceinline__ void xcd_barrier(const XcdBarrier& b) {
    asm volatile("s_waitcnt vmcnt(0)" ::: "memory");
    __syncthreads();
    if (threadIdx.x == 0) {
        unsigned* bar = b.bar;
        __builtin_amdgcn_s_waitcnt(0);
        unsigned nloc = b.st[0], nx = b.st[1];
        if (nloc == 0u) { xcd_barrier_complete(bar, b.x, nloc, nx); b.st[0] = nloc; b.st[1] = nx; }
        const unsigned old = xb_add(&bar[XB_XSUB(b.x)], 1u);
        const unsigned gen = old / nloc;
        if (old + 1u == (gen + 1u) * nloc) {
            __builtin_amdgcn_fence(__ATOMIC_RELEASE, "agent");
            asm volatile("s_waitcnt vmcnt(0)" ::: "memory");
            const unsigned og = xb_add(&bar[XB_TOP], 1u);
            const unsigned tg = og / nx;
            if (og + 1u == (tg + 1u) * nx) xb_add(&bar[XB_TOPGEN], 1u);
            else XB_SPIN(xb_ld(&bar[XB_TOPGEN]) == tg, bar);
            __builtin_amdgcn_fence(__ATOMIC_ACQUIRE, "agent");
            xb_add(&bar[XB_XGEN(b.x)], 1u);
            asm volatile("s_waitcnt vmcnt(0)" ::: "memory");
        } else {
            XB_SPIN(xb_ld(&bar[XB_XGEN(b.x)]) == gen, bar);
            __builtin_amdgcn_fence(__ATOMIC_ACQUIRE, "agent");
            asm volatile("s_waitcnt vmcnt(0)" ::: "memory");
        }
    }
    __syncthreads();
}

constexpr int NWAVES = 8;
constexpr int DM = 2048, TX = 8192, NMETA = 16, TT = TX + NMETA, MP = 8448;
constexpr int EV_NP = 5632, EV_LORA0 = 3072, EV_GB = 3360, EV_REC = 4384;
constexpr int OD_NP = 12544, OD_Z = 8192, OD_B = 12288, OD_A = 12320;
constexpr int NEXP = 32, FF = 512, MOE_ROWS = 24576;
constexpr float NORM_EPS = 1e-6f;

constexpr size_t MiB = 1u << 20;
constexpr size_t WS_CTL = 0, CTL_ZERO_BYTES = 1 * MiB;
constexpr size_t WS_TOKINFO = 1 * MiB;
constexpr size_t WS_TILES = 1 * MiB + 512 * 1024;
constexpr size_t WS_WEVIN = 2 * MiB;
constexpr size_t WS_WEVOUT = 24 * MiB;
constexpr size_t WS_WODIN = 32 * MiB;
constexpr size_t WS_WODOUT = 81 * MiB;
constexpr size_t WS_WLORA = 97 * MiB;
constexpr size_t WS_WGATE = 100 * MiB;
constexpr size_t WS_WROUTE = 101 * MiB;
constexpr size_t WS_MOEW = 102 * MiB;
constexpr size_t MOE_E_BYTES = 6 * MiB, MOE_W2_OFF = 4 * MiB;
constexpr size_t WS_H = 294 * MiB;
constexpr size_t WS_HN = 360 * MiB;
constexpr size_t WS_YMIX = 393 * MiB;
constexpr size_t WS_PROJ = 459 * MiB;
constexpr size_t WS_SCR = 662 * MiB;
constexpr size_t WS_END = 932 * MiB;
constexpr size_t SC_ALORA = 0;
constexpr size_t SC_XR = 8 * MiB;
constexpr size_t SC_DEC = 26 * MiB, SC_ICL = 60 * MiB, SC_GATE = 94 * MiB;
constexpr size_t SC_LA = 128 * MiB, SC_LIX = 162 * MiB;
constexpr size_t SC_QN = 0, SC_KN = 34 * MiB;
constexpr size_t SC_VC = 68 * MiB;
constexpr size_t SC_BETA = 134 * MiB, SC_G = 136 * MiB;
constexpr size_t SC_O = 138 * MiB;
constexpr size_t SC_XG = 0;
constexpr size_t SC_ACT = 96 * MiB;
constexpr size_t SC_YB = 120 * MiB;
static_assert(SC_O + (size_t)MP * 4096 * 4 <= WS_END - WS_SCR && SC_YB + (size_t)MOE_ROWS * 2048 * 2 <= WS_END - WS_SCR && SC_LIX + (size_t)MP * 1024 * 4 <= WS_END - WS_SCR, "scratch map");
constexpr int CW_TMO = 0, CW_CODE = 1;
constexpr int CW_BAR = 4096;
constexpr int CW_PROG = 20480;
constexpr int CW_TS = 24576;
constexpr int CW_MOECNT = 16384;

constexpr int RING_OFF = 0, RING_BYTES = 131072;
constexpr int LDSCTL_OFF = 146944, MISC_OFF = LDSCTL_OFF + 320;
constexpr int LDS_BYTES = 147456;


#define DI __device__ __forceinline__
typedef unsigned v2u __attribute__((ext_vector_type(2)));
struct Args { const float* in[36]; float* out; unsigned char* ws; int ph_lo, ph_hi; };
struct Frame {
    LAS unsigned char* lds; volatile LAS unsigned* MISC; gu32* ctl;
    int tid, lane, wave, vcu, G, gw, NGW;
};
DI float bf2f(bf16 v) { return __uint_as_float((unsigned)v << 16); }
DI float bflo(unsigned w) { return __uint_as_float(w << 16); }
DI float bfhi(unsigned w) { return __uint_as_float(w & 0xffff0000u); }
DI float wave_sum(float v) {
#pragma unroll
    for (int o = 1; o < 64; o <<= 1) v += __shfl_xor(v, o);
    return v;
}
DI float sigm(float x) { return __builtin_amdgcn_rcpf(1.0f + __expf(-x)); }
DI float softplus(float x) { return fmaxf(x, 0.f) + __logf(1.0f + __expf(-fabsf(x))); }
DI float gelu_tanh(float x) { const float u = 0.7978845608028654f * (x + 0.044715f * x * x * x); return 0.5f * x * (1.0f + tanhf(u)); }
DI int pos_row(int p) { return p < NMETA ? TX + p : p - NMETA; }
DI int row_pos(int r) { return r < TX ? r + NMETA : r - TX; }

DI void tr_item(const float* W, int N, int k0, int n0, bf16* WT, int ldk, int drow0, LAS float* scr, int lane) {
#pragma unroll 8
    for (int i = 0; i < 32; ++i) { const int kk = 2 * i + (lane >> 5); scr[kk * 33 + (lane & 31)] = W[(size_t)(k0 + kk) * N + n0 + (lane & 31)]; }
    LDS_WAIT(); asm volatile("" ::: "memory");
    const int c = lane & 7;
#pragma unroll
    for (int j = 0; j < 4; ++j) { const int n = (lane >> 3) + 8 * j; const LAS float* s = scr + (8 * c) * 33 + n;
        v4u o; o.x = pk2(s[0 * 33], s[1 * 33]); o.y = pk2(s[2 * 33], s[3 * 33]); o.z = pk2(s[4 * 33], s[5 * 33]); o.w = pk2(s[6 * 33], s[7 * 33]);
        *(v4u*)(WT + (size_t)(drow0 + n) * ldk + k0 + 8 * c) = o; }
    LDS_WAIT(); asm volatile("" ::: "memory");
}
DI void moe_convert(const Frame& F, const Args& a, int l, int gw, int ngw) {
    LAS float* scr = (LAS float*)(F.lds + RING_OFF + F.wave * 16384);
    bf16* base = (bf16*)(a.ws + WS_MOEW);
    for (int it = gw; it < NEXP * 1536; it += ngw) {
        const int e = it / 1536; int j = it % 1536; bf16* eb = base + (size_t)e * (MOE_E_BYTES / 2);
        const size_t eoff = (size_t)(l * NEXP + e) * DM * FF;
        if (j < 1024) { const float* W = (j < 512 ? a.in[33] : a.in[34]) + eoff; const int hi = j >= 512; j &= 511; const int kb = j >> 4, nb = j & 15, n0 = 32 * nb;
            tr_item(W, FF, 64 * kb, n0, eb, DM, 256 * (n0 >> 7) + 128 * hi + (n0 & 127), scr, F.lane); }
        else { j -= 1024; const int kb = j >> 6, nb = j & 63; tr_item(a.in[35] + eoff, DM, 64 * kb, 32 * nb, eb + MOE_W2_OFF / 2, FF, 32 * nb, scr, F.lane); }
    }
}
DI void norm_row_bf16(int lane, const float* src, const float* w, bf16* dst) {
    f32x4 v[8]; float s = 0.f;
#pragma unroll
    for (int j = 0; j < 8; ++j) { v[j] = ((const f32x4*)src)[lane + 64 * j]; s += (v[j].x * v[j].x + v[j].y * v[j].y) + (v[j].z * v[j].z + v[j].w * v[j].w); }
    const float rs = 1.0f / sqrtf(wave_sum(s) * (1.0f / DM) + NORM_EPS);
#pragma unroll
    for (int j = 0; j < 8; ++j) { const f32x4 wv = ((const f32x4*)w)[lane + 64 * j]; v2u o; o.x = pk2(v[j].x * rs * wv.x, v[j].y * rs * wv.y); o.y = pk2(v[j].z * rs * wv.z, v[j].w * rs * wv.w);
        ((v2u*)dst)[lane + 64 * j] = o; }
}

DI void ph_prologue(const Frame& F, const Args& a) {
    LAS float* scr = (LAS float*)(F.lds + RING_OFF + F.wave * 16384);
    constexpr int I_A = 32 * 169, I_B = 32 * 64, NIT = I_A + I_B;
    for (int it = F.gw; it < NIT; it += F.NGW) {
        int r = it;
        if (r < I_A) { const int kb = r / 169, nb = r % 169; tr_item(a.in[5], 5408, 64 * kb, 32 * nb, (bf16*)(a.ws + WS_WEVIN), DM, 32 * nb, scr, F.lane); continue; } r -= I_A;
        { const int kb = r / 64, nb = r % 64; tr_item(a.in[24], DM, 64 * kb, 32 * nb, (bf16*)(a.ws + WS_WEVOUT), DM, 32 * nb, scr, F.lane); }
    }
    const int gt = F.vcu * (NWAVES * 64) + F.tid, NGT = F.G * NWAVES * 64;
    { bf16* WL = (bf16*)(a.ws + WS_WLORA); const float* wup = a.in[8]; const float* aup = a.in[10]; const float* gup = a.in[11];
      for (int idx = gt; idx < 3072 * 384; idx += NGT) { const int n = idx / 384, k = idx % 384; float v = 0.f;
          if (n < 1024) { if (k < 64) v = wup[k * 1024 + n]; }
          else if (n < 2048) { if (k >= 64 && k < 128) v = aup[(k - 64) * 1024 + n - 1024]; }
          else { if (k >= 128 && k < 288) v = gup[(k - 128) * 1024 + n - 2048]; }
          WL[idx] = (bf16)f2bf(v); } }
    { bf16* WG = (bf16*)(a.ws + WS_WGATE);
      for (int idx = gt; idx < 2048 * 256; idx += NGT) { const int n = idx >> 8, kk = idx & 255, nn = n & 1023, blk = nn >> 6, j = nn & 63, cin = (nn & ~255) + kk;
          const float* W = n < 1024 ? a.in[19] : a.in[21];
          const float v = (cin >> 6) == blk ? W[blk * 4096 + (cin & 63) * 64 + j] : 0.f;
          WG[idx] = (bf16)f2bf(v); } }
    { bf16* WR = (bf16*)(a.ws + WS_WROUTE);
      for (int idx = gt; idx < 2 * 48 * DM; idx += NGT) { const int l = idx / (48 * DM), n = (idx / DM) % 48, k = idx % DM; float v = 0.f;
          if (n < 32) v = a.in[32][((size_t)l * DM + k) * NEXP + n]; else if (n < 36) v = a.in[31][((size_t)l * DM + k) * 4 + n - 32];
          const unsigned hi = f2bf(v); WR[((size_t)(l * 2) * 48 + n) * DM + k] = (bf16)hi; WR[((size_t)(l * 2 + 1) * 48 + n) * DM + k] = (bf16)f2bf(v - __uint_as_float(hi << 16)); } }
    bf16* HN = (bf16*)(a.ws + WS_HN);
    for (int r = F.gw; r < TT; r += F.NGW) norm_row_bf16(F.lane, r < TX ? a.in[0] + (size_t)r * DM : a.in[1] + (size_t)(r - TX) * DM, a.in[2], HN + (size_t)r * DM);
}

DI void ph_aux_convert(const Frame& F, const Args& a, int gw, int ngw) {
    LAS float* scr = (LAS float*)(F.lds + RING_OFF + F.wave * 16384);
    constexpr int I_C = 32 * 386, I_D = 64 * 64, NIT = I_C + I_D;
    for (int it = gw; it < NIT; it += ngw) {
        int r = it;
        if (r < I_C) { const int kb = r / 386, nb = r % 386; tr_item(a.in[25], 12352, 64 * kb, 32 * nb, (bf16*)(a.ws + WS_WODIN), DM, 32 * nb, scr, F.lane); continue; } r -= I_C;
        { const int kb = r / 64, nb = r % 64; tr_item(a.in[30], DM, 64 * kb, 32 * nb, (bf16*)(a.ws + WS_WODOUT), 4096, 32 * nb, scr, F.lane); }
    }
    moe_convert(F, a, 0, gw, ngw);
}

DI void ph_even_prep(const Frame& F, const Args& a) {
    const bf16* P = (const bf16*)(a.ws + WS_PROJ); bf16* AL = (bf16*)(a.ws + WS_SCR + SC_ALORA); bf16* XR = (bf16*)(a.ws + WS_SCR + SC_XR);
    const float* mu = a.in[6]; const float* cw = a.in[17]; const float* cb = a.in[18];
    const int lane = F.lane;
    for (int item = F.gw; item < TT + (TT / 8) * 2; item += F.NGW) {
        if (item < TT) { const int r = item, pos = row_pos(r); const bf16* cur = P + (size_t)r * EV_NP; const bf16* prv = P + (size_t)pos_row(pos > 0 ? pos - 1 : 0) * EV_NP; const float pm = pos > 0 ? 1.f : 0.f;
            float cv[6], pv[6], mv[6];
#pragma unroll
            for (int i = 0; i < 6; ++i) { const int idx = lane + 64 * i, col = EV_LORA0 + (idx < 288 ? idx : 287); cv[i] = bf2f(cur[col]); pv[i] = bf2f(prv[col]) * pm; mv[i] = mu[col]; }
#pragma unroll
            for (int i = 0; i < 6; ++i) { const int idx = lane + 64 * i; float v = cv[i] + (pv[i] - cv[i]) * mv[i];
                if (idx < 64) v = tanhf(v); else if (idx >= 128) v = sigm(v);
                AL[(size_t)r * 384 + idx] = (bf16)f2bf(idx < 288 ? v : 0.f); }
        } else { const int it2 = item - TT, pb = it2 >> 1, c0 = (it2 & 1) * 512 + lane * 8, p0 = pb * 8;
            f32x4 w[4][2], b0 = *(const f32x4*)(cb + c0), b1 = *(const f32x4*)(cb + c0 + 4);
#pragma unroll
            for (int j = 0; j < 4; ++j) { w[j][0] = *(const f32x4*)(cw + j * 1024 + c0); w[j][1] = *(const f32x4*)(cw + j * 1024 + c0 + 4); }
            v4u x[11];
#pragma unroll
            for (int i = 0; i < 11; ++i) { const int p = p0 - 3 + i; x[i] = *(const v4u*)(P + (size_t)pos_row(p > 0 ? p : 0) * EV_NP + EV_REC + c0); if (p < 0) x[i] = (v4u){0u, 0u, 0u, 0u}; }
#pragma unroll
            for (int o = 0; o < 8; ++o) { float acc[8] = {b0.x, b0.y, b0.z, b0.w, b1.x, b1.y, b1.z, b1.w};
#pragma unroll
                for (int j = 0; j < 4; ++j) { const v4u xv = x[o + j];
                    acc[0] += w[j][0].x * bflo(xv.x); acc[1] += w[j][0].y * bfhi(xv.x); acc[2] += w[j][0].z * bflo(xv.y); acc[3] += w[j][0].w * bfhi(xv.y);
                    acc[4] += w[j][1].x * bflo(xv.z); acc[5] += w[j][1].y * bfhi(xv.z); acc[6] += w[j][1].z * bflo(xv.w); acc[7] += w[j][1].w * bfhi(xv.w); }
                *(v4u*)(XR + (size_t)pos_row(p0 + o) * 1024 + c0) = (v4u){pk2(acc[0], acc[1]), pk2(acc[2], acc[3]), pk2(acc[4], acc[5]), pk2(acc[6], acc[7])}; } }
    }
}

DI void ph_route(const Frame& F, const Args& a, int l, int dummy) {
    const float* H = (const float*)(a.ws + WS_H); const float* nw = a.in[3] + (size_t)l * DM;
    const bf16* WH = (const bf16*)(a.ws + WS_WROUTE) + (size_t)(l * 2) * 48 * DM; const bf16* WL = WH + (size_t)48 * DM;
    unsigned* TI = (unsigned*)(a.ws + WS_TOKINFO) + (dummy ? (WS_SCR + 250 * MiB - WS_TOKINFO) / 4 : 0); const int lane = F.lane, lc = lane & 15, quad = lane >> 4, wave = F.wave; const int cl = dummy ? l + 2 : l;
    LAS float* red = (LAS float*)(F.lds + RING_OFF);
    LAS float* sq = red + 8 * 9 * 64 * 4; LAS float* lgs = sq + 8 * 48;
    static_assert(TT % 48 == 0, "router tasks");
    for (int task = F.vcu; task < TT / 48; task += F.G) {
        const float* nwp = nw + 256 * wave + 8 * quad; float ss[3] = {0.f, 0.f, 0.f};
        f32x4 acc[3][3];
#pragma unroll
        for (int mt = 0; mt < 3; ++mt)
#pragma unroll
            for (int nt = 0; nt < 3; ++nt) acc[mt][nt] = (f32x4){0.f, 0.f, 0.f, 0.f};
#pragma unroll 2
        for (int ks = 0; ks < 8; ++ks) { const int k0 = 256 * wave + 32 * ks + 8 * quad; const f32x4 w0 = *(const f32x4*)(nwp + 32 * ks), w1 = *(const f32x4*)(nwp + 32 * ks + 4);
            bf16x8 bh[3], bl[3];
#pragma unroll
            for (int nt = 0; nt < 3; ++nt) { bh[nt] = *(const bf16x8*)(WH + (size_t)(16 * nt + lc) * DM + k0); bl[nt] = *(const bf16x8*)(WL + (size_t)(16 * nt + lc) * DM + k0); }
#pragma unroll
            for (int mt = 0; mt < 3; ++mt) { const float* hr = H + (size_t)(task * 48 + mt * 16 + lc) * DM + k0; const f32x4 x0 = *(const f32x4*)hr, x1 = *(const f32x4*)(hr + 4);
                ss[mt] += (x0.x * x0.x + x0.y * x0.y) + (x0.z * x0.z + x0.w * x0.w) + (x1.x * x1.x + x1.y * x1.y) + (x1.z * x1.z + x1.w * x1.w);
                const float xn[8] = {x0.x * w0.x, x0.y * w0.y, x0.z * w0.z, x0.w * w0.w, x1.x * w1.x, x1.y * w1.y, x1.z * w1.z, x1.w * w1.w};
                unsigned hi[8]; float lo[8];
#pragma unroll
                for (int q = 0; q < 8; ++q) { hi[q] = f2bf(xn[q]); lo[q] = xn[q] - __uint_as_float(hi[q] << 16); }
                const v4u ah4 = (v4u){hi[0] | (hi[1] << 16), hi[2] | (hi[3] << 16), hi[4] | (hi[5] << 16), hi[6] | (hi[7] << 16)}, al4 = (v4u){pk2(lo[0], lo[1]), pk2(lo[2], lo[3]), pk2(lo[4], lo[5]), pk2(lo[6], lo[7])};
                const bf16x8 ah = __builtin_bit_cast(bf16x8, ah4), al = __builtin_bit_cast(bf16x8, al4);
#pragma unroll
                for (int nt = 0; nt < 3; ++nt) { acc[mt][nt] = __builtin_amdgcn_mfma_f32_16x16x32_bf16(al, bh[nt], acc[mt][nt], 0, 0, 0); acc[mt][nt] = __builtin_amdgcn_mfma_f32_16x16x32_bf16(ah, bl[nt], acc[mt][nt], 0, 0, 0);
                    acc[mt][nt] = __builtin_amdgcn_mfma_f32_16x16x32_bf16(ah, bh[nt], acc[mt][nt], 0, 0, 0); } } }
#pragma unroll
        for (int mt = 0; mt < 3; ++mt) { float s_ = ss[mt]; s_ += __shfl_xor(s_, 16); s_ += __shfl_xor(s_, 32); if (quad == 0) sq[wave * 48 + mt * 16 + lc] = s_;
#pragma unroll
            for (int nt = 0; nt < 3; ++nt) *(LAS f32x4*)(red + ((wave * 9 + mt * 3 + nt) * 64 + lane) * 4) = acc[mt][nt]; }
        __syncthreads();
        { const int tile = wave;
#pragma unroll
          for (int rep = 0; rep < 2; ++rep) { const int tl = tile + 8 * rep; if (tl < 9) { f32x4 s = *(const LAS f32x4*)(red + (tl * 64 + lane) * 4);
#pragma unroll
              for (int v = 1; v < 8; ++v) s = s + *(const LAS f32x4*)(red + ((v * 9 + tl) * 64 + lane) * 4);
              const int mt = tl / 3, nt = tl % 3;
#pragma unroll
              for (int q = 0; q < 4; ++q) lgs[(mt * 16 + 4 * quad + q) * 49 + 16 * nt + lc] = s[q]; } } }
        __syncthreads();
        if (wave == 0 && lane < 48) { float sst = 0.f;
#pragma unroll
            for (int v = 0; v < 8; ++v) sst += sq[v * 48 + lane];
            const float rs = 1.0f / sqrtf(sst * (1.0f / DM) + NORM_EPS);
            float lg[36];
#pragma unroll
            for (int i = 0; i < 36; ++i) lg[i] = lgs[lane * 49 + i] * rs;
            int gi = 0; float gm = lg[32];
#pragma unroll
            for (int i = 1; i < 4; ++i) if (lg[32 + i] > gm) { gm = lg[32 + i]; gi = i; }
            float den = 0.f;
#pragma unroll
            for (int i = 0; i < 4; ++i) den += __expf(lg[32 + i] - gm);
            const float gp = 1.0f / den;
            float l8[8];
#pragma unroll
            for (int i = 0; i < 8; ++i) l8[i] = gi == 0 ? lg[i] : (gi == 1 ? lg[8 + i] : (gi == 2 ? lg[16 + i] : lg[24 + i]));
            int i1 = 0; float m1 = l8[0];
#pragma unroll
            for (int i = 1; i < 8; ++i) if (l8[i] > m1) { m1 = l8[i]; i1 = i; }
            int i2 = -1; float m2 = -INFINITY;
#pragma unroll
            for (int i = 0; i < 8; ++i) if (i != i1 && l8[i] > m2) { m2 = l8[i]; i2 = i; }
            const float e21 = __expf(m2 - m1); const float w1 = gp / (1.0f + e21), w2 = gp * e21 / (1.0f + e21);
            const int ea = gi * 8 + i1, eb = gi * 8 + i2; const int rt = task * 48 + lane;
            const unsigned sa = atomicAdd((unsigned*)(F.ctl + CW_MOECNT + (cl * NEXP + ea) * 16), 1u), sb = atomicAdd((unsigned*)(F.ctl + CW_MOECNT + (cl * NEXP + eb) * 16), 1u);
            unsigned* t = TI + (size_t)rt * 8; *(v4u*)t = (v4u){(unsigned)ea, sa, __float_as_uint(w1), (unsigned)eb}; *(v4u*)(t + 4) = (v4u){sb, __float_as_uint(w2), __float_as_uint(rs), 0u}; }
        __syncthreads();
    }
}
DI void moe_prefix(const Frame& F, int l, LAS int* ps) {
    if (F.tid == 0) { int t = 0;
        for (int e = 0; e < NEXP; ++e) { const unsigned c = __hip_atomic_load(F.ctl + CW_MOECNT + (l * NEXP + e) * 16, RLX_AGENT); ps[e] = t * 256; t += (int)((c + 255u) >> 8); }
        ps[32] = t; }
    __syncthreads();
}
DI void ph_gather(const Frame& F, const Args& a, int l) {
    LAS int* ps = (LAS int*)(F.lds + RING_OFF); moe_prefix(F, l, ps);
    if (F.vcu == 0 && F.tid < NEXP) { int* TE = (int*)(a.ws + WS_TILES); const int e = F.tid; const int t0 = ps[e] >> 8, t1 = (e == NEXP - 1 ? ps[32] : ps[e + 1] >> 8);
        for (int t = t0; t < t1; ++t) TE[t] = e; if (e == 0) TE[127] = ps[32]; }
    const float* H = (const float*)(a.ws + WS_H); const float* nw = a.in[3] + (size_t)l * DM; unsigned* TI = (unsigned*)(a.ws + WS_TOKINFO); bf16* XG = (bf16*)(a.ws + WS_SCR + SC_XG);
    const int lane = F.lane;
    for (int r = F.gw; r < TT; r += F.NGW) {
        unsigned* t = TI + (size_t)r * 8; const int g0 = ps[t[0]] + (int)t[1], g1 = ps[t[3]] + (int)t[4]; const float rs = __uint_as_float(t[6]);
        if (lane == 0) t[7] = (unsigned)g0 | ((unsigned)g1 << 16);
        const float* hr = H + (size_t)r * DM;
#pragma unroll
        for (int j = 0; j < 4; ++j) { const int e0 = (lane + 64 * j) * 8; const f32x4 x0 = *(const f32x4*)(hr + e0), x1 = *(const f32x4*)(hr + e0 + 4), w0 = *(const f32x4*)(nw + e0), w1 = *(const f32x4*)(nw + e0 + 4);
            v4u o; o.x = pk2(x0.x * rs * w0.x, x0.y * rs * w0.y); o.y = pk2(x0.z * rs * w0.z, x0.w * rs * w0.w); o.z = pk2(x1.x * rs * w1.x, x1.y * rs * w1.y); o.w = pk2(x1.z * rs * w1.z, x1.w * rs * w1.w);
            *(v4u*)(XG + (size_t)g0 * DM + e0) = o; *(v4u*)(XG + (size_t)g1 * DM + e0) = o; }
    }
}
DI void ph_combine(const Frame& F, const Args& a, int l) {
    float* H = (float*)(a.ws + WS_H); const unsigned* TI = (const unsigned*)(a.ws + WS_TOKINFO); const bf16* YB = (const bf16*)(a.ws + WS_SCR + SC_YB); bf16* HN = (bf16*)(a.ws + WS_HN);
    const int lane = F.lane; const int nrows = l == 0 ? TT : TX;
    for (int r = F.gw; r < nrows; r += F.NGW) {
        const unsigned* t = TI + (size_t)r * 8; const int g0 = (int)(t[7] & 0xffffu), g1 = (int)(t[7] >> 16); const float w0 = __uint_as_float(t[2]), w1 = __uint_as_float(t[5]);
        float* hr = H + (size_t)r * DM; float hv[32]; float s = 0.f;
#pragma unroll
        for (int j = 0; j < 4; ++j) { const int e0 = (lane + 64 * j) * 8; const f32x4 x0 = *(const f32x4*)(hr + e0), x1 = *(const f32x4*)(hr + e0 + 4);
            const v4u ya = *(const v4u*)(YB + (size_t)g0 * DM + e0), yc = *(const v4u*)(YB + (size_t)g1 * DM + e0);
            float* o = hv + 8 * j;
            o[0] = x0.x + w0 * bflo(ya.x) + w1 * bflo(yc.x); o[1] = x0.y + w0 * bfhi(ya.x) + w1 * bfhi(yc.x); o[2] = x0.z + w0 * bflo(ya.y) + w1 * bflo(yc.y); o[3] = x0.w + w0 * bfhi(ya.y) + w1 * bfhi(yc.y);
            o[4] = x1.x + w0 * bflo(ya.z) + w1 * bflo(yc.z); o[5] = x1.y + w0 * bfhi(ya.z) + w1 * bfhi(yc.z); o[6] = x1.z + w0 * bflo(ya.w) + w1 * bflo(yc.w); o[7] = x1.w + w0 * bfhi(ya.w) + w1 * bfhi(yc.w);
#pragma unroll
            for (int q = 0; q < 8; ++q) s += o[q] * o[q]; }
        const float rs = 1.0f / sqrtf(wave_sum(s) * (1.0f / DM) + NORM_EPS);
        if (l == 0) { const float* nw = a.in[2] + DM;
#pragma unroll
            for (int j = 0; j < 4; ++j) { const int e0 = (lane + 64 * j) * 8; const float* o = hv + 8 * j; const f32x4 wa = *(const f32x4*)(nw + e0), wb = *(const f32x4*)(nw + e0 + 4);
                *(f32x4*)(hr + e0) = (f32x4){o[0], o[1], o[2], o[3]}; *(f32x4*)(hr + e0 + 4) = (f32x4){o[4], o[5], o[6], o[7]};
                v4u p; p.x = pk2(o[0] * rs * wa.x, o[1] * rs * wa.y); p.y = pk2(o[2] * rs * wa.z, o[3] * rs * wa.w); p.z = pk2(o[4] * rs * wb.x, o[5] * rs * wb.y); p.w = pk2(o[6] * rs * wb.z, o[7] * rs * wb.w);
                *(v4u*)(HN + (size_t)r * DM + e0) = p; }
        } else { const float* nw = a.in[4]; float* orow = a.out + (size_t)r * DM;
#ifdef PROBE_TS
            { const unsigned long long* ts = (const unsigned long long*)(F.ctl + CW_TS); const float dt_us = (float)(__hip_atomic_load(ts + PROBE_TS + 1, RLX_AGENT) - __hip_atomic_load(ts + PROBE_TS, RLX_AGENT)) * 0.01f;
#pragma unroll
              for (int q = 0; q < 32; ++q) hv[q] *= 1.0f + dt_us * 0.01f; }
#endif
#pragma unroll
            for (int j = 0; j < 4; ++j) { const int e0 = (lane + 64 * j) * 8; const float* o = hv + 8 * j; const f32x4 wa = *(const f32x4*)(nw + e0), wb = *(const f32x4*)(nw + e0 + 4);
                *(f32x4*)(orow + e0) = (f32x4){o[0] * rs * wa.x, o[1] * rs * wa.y, o[2] * rs * wa.z, o[3] * rs * wa.w};
                *(f32x4*)(orow + e0 + 4) = (f32x4){o[4] * rs * wb.x, o[5] * rs * wb.y, o[6] * rs * wb.z, o[7] * rs * wb.w}; } }
    }
}

struct OddPrepItem { f32x4 w[4][2]; v4u x[11]; };
DI void odd_prep_load(OddPrepItem& it, const bf16* P, const float* cw, int item, int lane) {
    const int pb = item >> 4, i = item & 15, ch = i * 512 + lane * 8, p0 = pb * 8;
#pragma unroll
    for (int j = 0; j < 4; ++j) { it.w[j][0] = *(const f32x4*)(cw + j * 8192 + ch); it.w[j][1] = *(const f32x4*)(cw + j * 8192 + ch + 4); }
#pragma unroll
    for (int q = 0; q < 11; ++q) { const int p = p0 - 3 + q; it.x[q] = *(const v4u*)(P + (size_t)pos_row(p > 0 ? p : 0) * OD_NP + ch); if (p < 0) it.x[q] = (v4u){0u, 0u, 0u, 0u}; }
}
DI void odd_prep_compute(const OddPrepItem& it, const Args& a, int item, int lane) {
    const bf16* P = (const bf16*)(a.ws + WS_PROJ); bf16* QN = (bf16*)(a.ws + WS_SCR + SC_QN); bf16* KN = (bf16*)(a.ws + WS_SCR + SC_KN); bf16* VC = (bf16*)(a.ws + WS_SCR + SC_VC);
    float* BETA = (float*)(a.ws + WS_SCR + SC_BETA); float* GG = (float*)(a.ws + WS_SCR + SC_G);
    const int pb = item >> 4, i = item & 15, ch = i * 512 + lane * 8, p0 = pb * 8;
#pragma unroll
    for (int o = 0; o < 8; ++o) { const int r = pos_row(p0 + o); float acc[8] = {0.f, 0.f, 0.f, 0.f, 0.f, 0.f, 0.f, 0.f};
#pragma unroll
        for (int j = 0; j < 4; ++j) { const v4u xv = it.x[o + j];
            acc[0] += it.w[j][0].x * bflo(xv.x); acc[1] += it.w[j][0].y * bfhi(xv.x); acc[2] += it.w[j][0].z * bflo(xv.y); acc[3] += it.w[j][0].w * bfhi(xv.y);
            acc[4] += it.w[j][1].x * bflo(xv.z); acc[5] += it.w[j][1].y * bfhi(xv.z); acc[6] += it.w[j][1].z * bflo(xv.w); acc[7] += it.w[j][1].w * bfhi(xv.w); }
        float ss = 0.f;
#pragma unroll
        for (int q = 0; q < 8; ++q) { acc[q] = acc[q] * sigm(acc[q]); ss += acc[q] * acc[q]; }
        float sc = 1.0f;
        if (i < 8) { ss += __shfl_xor(ss, 1); ss += __shfl_xor(ss, 2); ss += __shfl_xor(ss, 4); ss += __shfl_xor(ss, 8);
            sc = (1.0f / sqrtf(ss + NORM_EPS)) * (i < 4 ? 0.08838834764831845f : 1.0f); }
        const v4u ov = (v4u){pk2(acc[0] * sc, acc[1] * sc), pk2(acc[2] * sc, acc[3] * sc), pk2(acc[4] * sc, acc[5] * sc), pk2(acc[6] * sc, acc[7] * sc)};
        bf16* dst = i < 4 ? QN + (size_t)r * 2048 + ch : (i < 8 ? KN + (size_t)r * 2048 + ch - 2048 : VC + (size_t)r * 4096 + ch - 4096);
        *(v4u*)dst = ov; }
    if (i == 0 && lane < 32) {
#pragma unroll
        for (int o = 0; o < 8; ++o) { const int r = pos_row(p0 + o); const float bb = bf2f(P[(size_t)r * OD_NP + OD_B + lane]), aa = bf2f(P[(size_t)r * OD_NP + OD_A + lane]);
            BETA[(size_t)r * 32 + lane] = sigm(bb); GG[(size_t)r * 32 + lane] = -__expf(a.in[27][lane]) * softplus(aa + a.in[28][lane]); } }
}
DI void ph_odd_prep(const Frame& F, const Args& a) {
    const bf16* P = (const bf16*)(a.ws + WS_PROJ); const float* cw = a.in[26]; constexpr int NI = (TT / 8) * 16;
    for (int item = F.gw; item < NI; item += 2 * F.NGW) { OddPrepItem A, B; const bool hb = item + F.NGW < NI;
        odd_prep_load(A, P, cw, item, F.lane); odd_prep_load(B, P, cw, hb ? item + F.NGW : item, F.lane);
        odd_prep_compute(A, a, item, F.lane); if (hb) odd_prep_compute(B, a, item + F.NGW, F.lane); }
}
constexpr int ODD_POST_ROWS0 = 64 * 113;
DI void ph_odd_post(const Frame& F, const Args& a, int part) {
    const bf16* P = (const bf16*)(a.ws + WS_PROJ); const bf16* O = (const bf16*)(a.ws + WS_SCR + SC_O); bf16* Y = (bf16*)(a.ws + WS_YMIX); const float* nw = a.in[29];
    const int lane = F.lane; int w0 = F.gw, wn = F.NGW, n_rows = TX - ODD_POST_ROWS0;
    if (part == 0) { const int wx = F.vcu & 31; if (F.G != 256 || wx < 20) return; w0 = ((F.vcu >> 5) * 12 + (wx - 20)) * NWAVES + F.wave; wn = 96 * NWAVES; n_rows = ODD_POST_ROWS0 + NMETA; }
    if (part == 2) n_rows = TT;
    for (int ri = w0; ri < n_rows; ri += wn) { const int r = part == 0 ? (ri < ODD_POST_ROWS0 ? ri : TX + ri - ODD_POST_ROWS0) : (part == 1 ? ODD_POST_ROWS0 + ri : ri);
#pragma unroll 2
        for (int i = 0; i < 8; ++i) { const int ch = i * 512 + lane * 8; const v4u ow = *(const v4u*)(O + (size_t)r * 4096 + ch); const f32x4 o0 = (f32x4){bflo(ow.x), bfhi(ow.x), bflo(ow.y), bfhi(ow.y)}, o1 = (f32x4){bflo(ow.z), bfhi(ow.z), bflo(ow.w), bfhi(ow.w)};
            float ss = (o0.x * o0.x + o0.y * o0.y) + (o0.z * o0.z + o0.w * o0.w) + (o1.x * o1.x + o1.y * o1.y) + (o1.z * o1.z + o1.w * o1.w);
            ss += __shfl_xor(ss, 1); ss += __shfl_xor(ss, 2); ss += __shfl_xor(ss, 4); ss += __shfl_xor(ss, 8);
            const float rs = 1.0f / sqrtf(ss * (1.0f / 128.0f) + NORM_EPS);
            const v4u z = *(const v4u*)(P + (size_t)r * OD_NP + OD_Z + ch); const int c0 = ch & 127; const f32x4 w0 = *(const f32x4*)(nw + c0), w1 = *(const f32x4*)(nw + c0 + 4);
            const float zf[8] = {bflo(z.x), bfhi(z.x), bflo(z.y), bfhi(z.y), bflo(z.z), bfhi(z.z), bflo(z.w), bfhi(z.w)};
            const float of[8] = {o0.x * w0.x, o0.y * w0.y, o0.z * w0.z, o0.w * w0.w, o1.x * w1.x, o1.y * w1.y, o1.z * w1.z, o1.w * w1.w};
            float y[8];
#pragma unroll
            for (int q = 0; q < 8; ++q) y[q] = of[q] * rs * zf[q] * sigm(zf[q]);
            v4u p; p.x = pk2(y[0], y[1]); p.y = pk2(y[2], y[3]); p.z = pk2(y[4], y[5]); p.w = pk2(y[6], y[7]);
            *(v4u*)(Y + (size_t)r * 4096 + ch) = p; }
    }
}

typedef float f32x16 __attribute__((ext_vector_type(16)));
#define MFMA32(a, b, c) __builtin_amdgcn_mfma_f32_32x32x16_bf16((a), (b), (c), 0, 0, 0)
DI int crow(int reg, int h) { return (reg & 3) + 8 * (reg >> 2) + 4 * h; }
DI int chunk_row(int n, int c) { return n == 0 ? (c >= 48 ? TX + (c - 48) : -1) : 64 * (n - 1) + c; }
#ifndef GDN_NO_HELPER
#define GDN_NO_HELPER 0
#endif
constexpr int GDN_NCH = 129, GDN_UNITS = GDN_NCH * 32, GDN_KUNITS = GDN_NCH * 16, GC_STRIDE = 72;
constexpr size_t GD_WF = WS_MOEW, GD_UF = WS_MOEW + 65 * MiB, GD_IN = WS_MOEW + 130 * MiB, GD_GC = WS_MOEW + 163 * MiB, GD_KT = WS_HN, GD_QF = WS_SCR + 208 * MiB, GD_SAVE = WS_SCR + 205 * MiB;
static_assert(GD_QF + (size_t)GDN_KUNITS * 16384 <= WS_END && GD_SAVE + 2 * MiB <= GD_QF && (size_t)GDN_UNITS * 16384 <= 65 * MiB && (size_t)GDN_UNITS * 8192 <= 33 * MiB && (size_t)GDN_KUNITS * 16384 <= 33 * MiB && GD_GC + (size_t)GDN_UNITS * GC_STRIDE * 4 <= WS_H, "gdn map");

DI void ph_gdn_chunk(const Frame& F, const Args& a, int n_lo, int n_hi, int side) {
    const bf16* QN = (const bf16*)(a.ws + WS_SCR + SC_QN); const bf16* KN = (const bf16*)(a.ws + WS_SCR + SC_KN); const bf16* VC = (const bf16*)(a.ws + WS_SCR + SC_VC);
    const float* BETA = (const float*)(a.ws + WS_SCR + SC_BETA); const float* GG = (const float*)(a.ws + WS_SCR + SC_G);
    bf16* WF = (bf16*)(a.ws + GD_WF); bf16* UF = (bf16*)(a.ws + GD_UF); bf16* INF = (bf16*)(a.ws + GD_IN); bf16* KTF = (bf16*)(a.ws + GD_KT); bf16* QF = (bf16*)(a.ws + GD_QF); float* GC = (float*)(a.ws + GD_GC);
    LAS unsigned char* L = F.lds + RING_OFF;
    LAS unsigned char* kS = L; LAS unsigned char* qS = L + 17408; LAS unsigned char* vS = L + 34816; LAS unsigned char* kbS = L + 52224;
    LAS float* Lm = (LAS float*)(L + 69632); LAS bf16* IS = (LAS bf16*)(L + 87040); LAS bf16* XS = (LAS bf16*)(L + 96256);
    LAS float* betaS = (LAS float*)(L + 130048); LAS float* gcS = betaS + 64; LAS float* egcS = betaS + 128;
    LAS unsigned char* Lb = L + 17408; LAS unsigned char* TDs = L + 26624; LAS unsigned char* YT0 = L + 28672; LAS unsigned char* XT0 = L + 130816;
    static_assert(130816 + 8 * 1792 <= LDSCTL_OFF, "gdn lds map");
    const int tid = F.tid, lane = F.lane, wave = F.wave, l31 = lane & 31, h = lane >> 5;
    int widx = F.vcu, wcnt = F.G;
    if (side) { if (F.G == 256) { const int wx = F.vcu & 31; if (wx < 20) return; widx = (F.vcu >> 5) * 12 + (wx - 20); wcnt = 96; } else { if (F.vcu < 128 || F.G <= 128) return; widx = F.vcu - 128; wcnt = F.G - 128; } }
#define G1_BAR() do { asm volatile("s_waitcnt lgkmcnt(0)" ::: "memory"); __builtin_amdgcn_s_barrier(); asm volatile("" ::: "memory"); } while (0)
    v4u pkx[2], pqx[2], pvx[2]; float pbeta = 0.f, pgl = 0.f;
#define G1_FETCH(uu) do { const int n_ = (uu) >> 5, hv_ = (uu) & 31, hk_ = hv_ >> 1; \
        _Pragma("unroll") for (int i = 0; i < 2; ++i) { const int p = tid + 512 * i, row = p >> 4, ch = p & 15; const int rr = chunk_row(n_, row); const size_t r_ = (size_t)(rr >= 0 ? rr : 0); \
            pkx[i] = *(const v4u*)(KN + r_ * 2048 + hk_ * 128 + ch * 8); pqx[i] = *(const v4u*)(QN + r_ * 2048 + hk_ * 128 + ch * 8); pvx[i] = *(const v4u*)(VC + r_ * 4096 + hv_ * 128 + ch * 8); \
            if (rr < 0) { pkx[i] = (v4u){0u, 0u, 0u, 0u}; pqx[i] = pkx[i]; pvx[i] = pkx[i]; } } \
        if (wave == 0) { const int rr = chunk_row(n_, lane); const size_t r_ = (size_t)(rr >= 0 ? rr : 0); pbeta = BETA[r_ * 32 + hv_]; pgl = GG[r_ * 32 + hv_]; if (rr < 0) { pbeta = 0.f; pgl = 0.f; } } } while (0)
    const int unit0 = n_lo * 32 + widx;
    if (unit0 < n_hi * 32) G1_FETCH(unit0);
    for (int unit = unit0; unit < n_hi * 32; unit += wcnt) {
        const int n = unit >> 5, hv = unit & 31, hk = hv >> 1; const size_t su = (size_t)hv * GDN_NCH + n;
#pragma unroll
        for (int i = 0; i < 2; ++i) { const int p = tid + 512 * i, row = p >> 4, ch = p & 15;
            *(LAS v4u*)(kS + row * 272 + ch * 16) = pkx[i]; *(LAS v4u*)(qS + row * 272 + ch * 16) = pqx[i]; *(LAS v4u*)(vS + row * 272 + ch * 16) = pvx[i]; }
        if (wave == 0) { float b = pbeta, g = pgl;
#pragma unroll
            for (int o = 1; o < 64; o <<= 1) { const float t = __shfl_up(g, o); if (lane >= o) g += t; }
            betaS[lane] = b; gcS[lane] = g; egcS[lane] = __expf(g); }
        if (unit + wcnt < n_hi * 32) G1_FETCH(unit + wcnt);
        G1_BAR();
        if ((hv & 1) == 0) { const size_t kunit = (size_t)hk * GDN_NCH + n;
#pragma unroll
            for (int i = 0; i < 2; ++i) { const int p = tid + 512 * i, comb = p >> 6, ln = p & 63, t = comb >> 3, s = comb & 7; const int c = 32 * t + (ln & 31), k0 = 16 * s + 8 * (ln >> 5);
                *(v4u*)(QF + (kunit * 16 + comb) * 512 + ln * 8) = *(const LAS v4u*)(qS + c * 272 + k0 * 2); } }
#pragma unroll
        for (int i = 0; i < 2; ++i) { const int p = tid + 512 * i, row = p >> 4, ch = p & 15; const v4u kx = *(const LAS v4u*)(kS + row * 272 + ch * 16); const float b = betaS[row];
            v4u o; o.x = pk2(bflo(kx.x) * b, bfhi(kx.x) * b); o.y = pk2(bflo(kx.y) * b, bfhi(kx.y) * b); o.z = pk2(bflo(kx.z) * b, bfhi(kx.z) * b); o.w = pk2(bflo(kx.w) * b, bfhi(kx.w) * b);
            *(LAS v4u*)(kbS + row * 272 + ch * 16) = o; }
        G1_BAR();
        { const int which = wave >> 2, ti = (wave >> 1) & 1, tj = wave & 1;
          f32x16 acc;
#pragma unroll
          for (int r = 0; r < 16; ++r) acc[r] = 0.f;
          if (!(ti == 0 && tj == 1)) { const LAS unsigned char* Ab = (which == 0 ? kbS : qS) + (32 * ti + l31) * 272 + 16 * h; const LAS unsigned char* Bb = kS + (32 * tj + l31) * 272 + 16 * h;
#pragma unroll
              for (int s = 0; s < 8; ++s) acc = MFMA32(*(const LAS bf16x8*)(Ab + 32 * s), *(const LAS bf16x8*)(Bb + 32 * s), acc); }
          const int j = 32 * tj + l31; const float gj = gcS[j];
#pragma unroll
          for (int r = 0; r < 16; ++r) { const int i = 32 * ti + crow(r, h); const float e = __expf(fminf(gcS[i] - gj, 0.f));
              if (which == 0) Lm[i * 68 + j] = i > j ? acc[r] * e : 0.f;
              else IS[i * 72 + j] = (bf16)f2bf(i >= j ? acc[r] * e : 0.f); } }
        G1_BAR();
#pragma unroll
        for (int i = 0; i < 8; ++i) { const int e = tid + 512 * i, r = e >> 6, c = e & 63; *(LAS bf16*)(Lb + r * 144 + c * 2) = (bf16)f2bf(Lm[r * 68 + c]); }
        if (wave == 0) { const int b = lane >> 4, c = lane & 15; float t[16]; const LAS float* Ld = Lm + (16 * b) * 68 + 16 * b;
            t[0] = c == 0 ? 1.f : 0.f; *(LAS bf16*)(TDs + (b * 16) * 32 + c * 2) = (bf16)f2bf(t[0]);
#define G1_INV_ROWS(I0, I1) do { f32x4 Lr[(I1) - (I0)][4]; \
            _Pragma("unroll") for (int i = (I0); i < (I1); ++i) _Pragma("unroll") for (int q = 0; q < (i + 3) / 4; ++q) Lr[i - (I0)][q] = *(const LAS f32x4*)(Ld + i * 68 + 4 * q); \
            _Pragma("unroll") for (int i = (I0); i < (I1); ++i) { float a0 = i == c ? 1.f : 0.f, a1 = 0.f; \
                _Pragma("unroll") for (int j = 0; j < i; ++j) { const float lv = Lr[i - (I0)][j >> 2][j & 3]; if (j & 1) a1 -= lv * t[j]; else a0 -= lv * t[j]; } \
                t[i] = a0 + a1; *(LAS bf16*)(TDs + (b * 16 + i) * 32 + c * 2) = (bf16)f2bf(t[i]); } } while (0)
            G1_INV_ROWS(1, 9); G1_INV_ROWS(9, 13); G1_INV_ROWS(13, 16);
#undef G1_INV_ROWS
        } else if (wave >= 4) { const int t2 = tid - 256;
#pragma unroll
            for (int i = 0; i < 2; ++i) { const int p = t2 + 256 * i, comb = p >> 6, ln = p & 63, t = comb >> 2, s = comb & 3; const int c = 32 * t + (ln & 31), j0 = 16 * s + 8 * (ln >> 5);
                *(v4u*)(INF + (su * 8 + comb) * 512 + ln * 8) = *(const LAS v4u*)(IS + c * 72 + j0); }
            if ((hv & 1) == 0) { const size_t kunit = (size_t)hk * GDN_NCH + n;
#pragma unroll
                for (int i = 0; i < 4; ++i) { const int p = t2 + 256 * i, comb = p >> 6, ln = p & 63, kt = comb >> 2, s = comb & 3; const int kd = 32 * kt + (ln & 31), c0 = 16 * s + 8 * (ln >> 5);
                    unsigned w[4];
#pragma unroll
                    for (int jj = 0; jj < 4; ++jj) { const unsigned lo = *(const LAS bf16*)(kS + (c0 + 2 * jj) * 272 + kd * 2), hi = *(const LAS bf16*)(kS + (c0 + 2 * jj + 1) * 272 + kd * 2); w[jj] = lo | (hi << 16); }
                    *(v4u*)(KTF + (kunit * 16 + comb) * 512 + ln * 8) = (v4u){w[0], w[1], w[2], w[3]}; } }
            if (t2 < 64) GC[su * GC_STRIDE + t2] = gcS[t2];
            else if (t2 == 64) GC[su * GC_STRIDE + 64] = gcS[63];
            else if (t2 == 65) GC[su * GC_STRIDE + 65] = egcS[63];
        }
        G1_BAR();
        { const int quad = lane >> 4, lc = lane & 15; LAS unsigned char* XTw = XT0 + wave * 1792; LAS unsigned char* YTw = YT0 + wave * 768;
          const bf16x8 z8 = (bf16x8){0, 0, 0, 0, 0, 0, 0, 0}; const f32x4 z4 = (f32x4){0.f, 0.f, 0.f, 0.f};
          bf16x8 tdf[4];
#pragma unroll
          for (int b = 0; b < 4; ++b) tdf[b] = quad < 2 ? *(const LAS bf16x8*)(TDs + (b * 16 + lc) * 32 + quad * 16) : z8;
#pragma unroll 1
          for (int tl = 0; tl < 2; ++tl) { const int col = 32 * wave + 16 * tl + lc;
              const LAS unsigned char* rz = wave < 4 ? vS + col * 2 : kbS + (col - 128) * 2; const LAS float* bz = wave < 4 ? betaS : egcS;
#pragma unroll
              for (int b = 0; b < 4; ++b) { f32x4 y;
#pragma unroll
                  for (int r = 0; r < 4; ++r) { const int i = 16 * b + 4 * quad + r; y[r] = bf2f(*(const LAS bf16*)(rz + i * 272)) * bz[i]; }
                  if (b >= 1) { f32x4 p = z4;
#pragma unroll
                      for (int kk = 0; kk < (b >= 3 ? 2 : 1); ++kk) { const bf16x8 af = *(const LAS bf16x8*)(Lb + (16 * b + lc) * 144 + (32 * kk + 8 * quad) * 2);
                          const bf16x8 bfv = (32 * kk + 8 * quad < 16 * b) ? *(const LAS bf16x8*)(XTw + lc * 112 + (32 * kk + 8 * quad) * 2) : z8;
                          p = __builtin_amdgcn_mfma_f32_16x16x32_bf16(af, bfv, p, 0, 0, 0); }
                      y = y - p; }
                  *(LAS v2u*)(YTw + lc * 48 + quad * 8) = (v2u){pk2(y[0], y[1]), pk2(y[2], y[3])};
                  asm volatile("" ::: "memory");
                  const bf16x8 yb = quad < 2 ? *(const LAS bf16x8*)(YTw + lc * 48 + quad * 16) : z8;
                  const f32x4 x = __builtin_amdgcn_mfma_f32_16x16x32_bf16(tdf[b], yb, z4, 0, 0, 0);
                  if (b < 3) *(LAS v2u*)(XTw + lc * 112 + (16 * b + 4 * quad) * 2) = (v2u){pk2(x[0], x[1]), pk2(x[2], x[3])};
                  asm volatile("" ::: "memory");
#pragma unroll
                  for (int r = 0; r < 4; ++r) XS[(16 * b + 4 * quad + r) * 264 + col] = (bf16)f2bf(x[r]); } } }
        G1_BAR();
#pragma unroll
        for (int i = 0; i < 2; ++i) { const int p = tid + 512 * i, comb = p >> 6, ln = p & 63, t = comb >> 3, s = comb & 7; const int c = 32 * t + (ln & 31), k0 = 16 * s + 8 * (ln >> 5);
            *(v4u*)(WF + (su * 16 + comb) * 512 + ln * 8) = *(const LAS v4u*)(XS + c * 264 + 128 + k0); }
        { const int t = wave >> 2, ns = wave & 3; unsigned w[8];
#pragma unroll
          for (int r = 0; r < 8; ++r) { const unsigned lo = XS[(32 * t + crow(2 * r, h)) * 264 + 32 * ns + l31], hi = XS[(32 * t + crow(2 * r + 1, h)) * 264 + 32 * ns + l31]; w[r] = lo | (hi << 16); }
          bf16* dst = UF + ((su * 8 + wave) * 64 + lane) * 16; *(v4u*)dst = (v4u){w[0], w[1], w[2], w[3]}; *(v4u*)(dst + 8) = (v4u){w[4], w[5], w[6], w[7]}; }
        G1_BAR();
    }
}

#undef G1_BAR
#undef G1_FETCH
DI void ph_gdn_chain(const Frame& F, const Args& a, int n_lo, int n_hi) {
    const int xg = F.vcu >> 5, wx = F.vcu & 31; if (F.G != 256 ? F.vcu >= 128 : wx >= 20) return;
    const bool helper = F.G == 256 && wx >= 16;
    const int hv = F.G == 256 ? 4 * xg + (helper ? wx - 16 : wx >> 2) : F.vcu >> 2, ns = F.G == 256 ? wx & 3 : F.vcu & 3, hk = hv >> 1;
    const bf16* QN = (const bf16*)(a.ws + WS_SCR + SC_QN);
    const bf16* WF = (const bf16*)(a.ws + GD_WF); const bf16* UF = (const bf16*)(a.ws + GD_UF); const bf16* INF = (const bf16*)(a.ws + GD_IN); const bf16* KTF = (const bf16*)(a.ws + GD_KT); const bf16* QF = (const bf16*)(a.ws + GD_QF); const float* GC = (const float*)(a.ws + GD_GC);
    bf16* O = (bf16*)(a.ws + WS_SCR + SC_O);
    gu32* prog = F.ctl + CW_PROG + hv * 16;
    if (helper && GDN_NO_HELPER) return;
    if (helper) { unsigned sink = 0u; const int tid = F.tid;
        for (int n0 = n_lo; n0 < n_hi; n0 += 4) {
            if (n0 >= n_lo + 8) { if (tid == 0) { unsigned sp = 0; while ((int)__hip_atomic_load(prog, RLX_AGENT) < n0 - 4 && ++sp < 20000u) __builtin_amdgcn_s_sleep(8); } __syncthreads(); }
            unsigned v[5];
#pragma unroll
            for (int i = 0; i < 5; ++i) { const int li = tid + 512 * i;
                const int st = li / 580, ln = li % 580, n = n0 + st; const unsigned* p = nullptr;
                if (st < 4 && n < n_hi) { const size_t unit = (size_t)hv * GDN_NCH + n, kunit = (size_t)hk * GDN_NCH + n;
                    if (ln < 128) p = (const unsigned*)(WF + unit * 8192 + ln * 64);
                    else if (ln < 256) p = (const unsigned*)(UF + unit * 8192 + (ln - 128) * 64);
                    else if (ln < 320) p = (const unsigned*)(INF + unit * 4096 + (ln - 256) * 64);
                    else if (ln < 448) p = (const unsigned*)(KTF + kunit * 8192 + (ln - 320) * 64);
                    else if (ln < 576) p = (const unsigned*)(QF + kunit * 8192 + (ln - 448) * 64);
                    else if (ln < 579) p = (const unsigned*)(GC + unit * GC_STRIDE + (ln - 576) * 32); }
                v[i] = p ? *p : 0u; }
#pragma unroll
            for (int i = 0; i < 5; ++i) sink += v[i];
        }
        if (sink == 0x12345u) __hip_atomic_store(F.ctl + CW_TMO + 2, sink, RLX_AGENT);
        return; }
    LAS unsigned char* ST = F.lds + RING_OFF; LAS unsigned char* VN = ST + 8704; LAS unsigned char* VND = ST + 13312;
    const int lane = F.lane, wave = F.wave, l31 = lane & 31, h = lane >> 5;
    for (int i = F.tid; i < 8704 / 4; i += NWAVES * 64) ((LAS unsigned*)ST)[i] = 0u;
#define GDN_BAR() do { asm volatile("s_waitcnt lgkmcnt(0)" ::: "memory"); __builtin_amdgcn_s_barrier(); asm volatile("" ::: "memory"); } while (0)
    GDN_BAR();
    f32x16 S;
#pragma unroll
    for (int r = 0; r < 16; ++r) S[r] = 0.f;
    const int role = wave < 2 ? 0 : (wave < 4 ? 1 : 2); const int t = wave & 1, kt = wave & 3;
    bf16x8 A8[8]; bf16x8 A4[4]; v4u U0 = (v4u){0u, 0u, 0u, 0u}, U1 = U0; f32x4 G4[4]; float gl = 0.f, egl = 1.f;
#pragma unroll
    for (int s = 0; s < 8; ++s) A8[s] = (bf16x8){0, 0, 0, 0, 0, 0, 0, 0};
#pragma unroll
    for (int s = 0; s < 4; ++s) { A4[s] = (bf16x8){0, 0, 0, 0, 0, 0, 0, 0}; G4[s] = (f32x4){0.f, 0.f, 0.f, 0.f}; }
#define GDN_LOAD(nn) do { const size_t unit_ = (size_t)hv * GDN_NCH + (nn); const float* gc_ = GC + unit_ * GC_STRIDE; \
        if (role == 0) { \
            const bf16* up_ = UF + (((unit_ * 2 + t) * 4 + ns) * 64 + lane) * 16; U0 = *(const v4u*)up_; U1 = *(const v4u*)(up_ + 8); \
            _Pragma("unroll") for (int g = 0; g < 4; ++g) G4[g] = *(const f32x4*)(gc_ + 32 * t + 8 * g + 4 * h); gl = gc_[64]; } \
        else if (role == 1) { const size_t qunit_ = (size_t)hk * GDN_NCH + (nn); \
            _Pragma("unroll") for (int s = 0; s < 4; ++s) A4[s] = *(const bf16x8*)(INF + ((unit_ * 2 + t) * 4 + s) * 512 + lane * 8); \
            _Pragma("unroll") for (int g = 0; g < 4; ++g) G4[g] = *(const f32x4*)(gc_ + 32 * t + 8 * g + 4 * h); } \
        else { const size_t kunit_ = (size_t)hk * GDN_NCH + (nn); \
            _Pragma("unroll") for (int s = 0; s < 4; ++s) A4[s] = *(const bf16x8*)(KTF + ((kunit_ * 4 + kt) * 4 + s) * 512 + lane * 8); egl = gc_[65]; } } while (0)
    float* SV = (float*)(a.ws + GD_SAVE) + ((size_t)((hv * 4 + ns) * 4 + kt) * 64 + lane) * 16;
    if (n_lo > 0 && role == 2) {
#pragma unroll
        for (int g = 0; g < 4; ++g) { const f32x4 v = *(const f32x4*)(SV + 4 * g); S[4 * g] = v.x; S[4 * g + 1] = v.y; S[4 * g + 2] = v.z; S[4 * g + 3] = v.w;
            *(LAS v2u*)(ST + l31 * 272 + (32 * kt + 8 * g + 4 * h) * 2) = (v2u){pk2(v.x, v.y), pk2(v.z, v.w)}; }
    }
    GDN_BAR();
#define GDN_LOADA(AC, nn) do { if (role == 0) { const size_t u_ = (size_t)hv * GDN_NCH + (nn); _Pragma("unroll") for (int s = 0; s < 8; ++s) AC[s] = *(const bf16x8*)(WF + ((u_ * 2 + t) * 8 + s) * 512 + lane * 8); } \
        else if (role == 1) { const size_t q_ = (size_t)hk * GDN_NCH + (nn); _Pragma("unroll") for (int s = 0; s < 8; ++s) AC[s] = *(const bf16x8*)(QF + ((q_ * 2 + t) * 8 + s) * 512 + lane * 8); } } while (0)
    bf16x8 A8q[8];
#pragma unroll
    for (int s = 0; s < 8; ++s) A8q[s] = (bf16x8){0, 0, 0, 0, 0, 0, 0, 0};
    GDN_LOADA(A8, n_lo); if (n_lo + 1 < n_hi) GDN_LOADA(A8q, n_lo + 1);
    GDN_LOAD(n_lo);
#define GDN_STEP(n, AC) do { \
        bf16x8 a4[4]; const v4u u0 = U0, u1 = U1; f32x4 g4[4]; const float cgl = gl, cegl = egl; \
        _Pragma("unroll") \
        for (int s = 0; s < 4; ++s) { a4[s] = A4[s]; g4[s] = G4[s]; } \
        if (n + 1 < n_hi) GDN_LOAD(n + 1); \
        if (ns == 0 && F.tid == 0) __hip_atomic_store(prog, (unsigned)n, RLX_AGENT); \
        f32x16 acc; \
        _Pragma("unroll") \
        for (int r = 0; r < 16; ++r) acc[r] = 0.f; \
        if (role < 2) { \
        _Pragma("unroll") \
            for (int s = 0; s < 8; ++s) acc = MFMA32(AC[s], *(const LAS bf16x8*)(ST + l31 * 272 + 32 * s + 16 * h), acc); \
            asm volatile("" :: "v"(acc[0])); \
            if (n + 2 < n_hi) GDN_LOADA(AC, n + 2); \
        } \
        if (role == 0) { const unsigned uw[8] = {u0.x, u0.y, u0.z, u0.w, u1.x, u1.y, u1.z, u1.w}; \
        _Pragma("unroll") \
            for (int g = 0; g < 4; ++g) { float vn[4], vd[4]; \
        _Pragma("unroll") \
                for (int q = 0; q < 4; ++q) { const int r = 4 * g + q; const float uv = (r & 1) ? bfhi(uw[r >> 1]) : bflo(uw[r >> 1]); vn[q] = uv - acc[r]; vd[q] = vn[q] * __expf(cgl - g4[g][q]); } \
                *(LAS v2u*)(VN + l31 * 144 + (32 * t + 8 * g + 4 * h) * 2) = (v2u){pk2(vn[0], vn[1]), pk2(vn[2], vn[3])}; \
                *(LAS v2u*)(VND + l31 * 144 + (32 * t + 8 * g + 4 * h) * 2) = (v2u){pk2(vd[0], vd[1]), pk2(vd[2], vd[3])}; } \
        } else if (role == 1) { \
        _Pragma("unroll") \
            for (int g = 0; g < 4; ++g) \
        _Pragma("unroll") \
                for (int q = 0; q < 4; ++q) acc[4 * g + q] *= __expf(g4[g][q]); \
        } \
        GDN_BAR(); \
        if (role == 1) { \
        _Pragma("unroll") \
            for (int s = 0; s < 4; ++s) acc = MFMA32(a4[s], *(const LAS bf16x8*)(VN + l31 * 144 + 32 * s + 16 * h), acc); \
        _Pragma("unroll") \
            for (int r = 0; r < 16; ++r) { const int rr = chunk_row(n, 32 * t + crow(r, h)); if (rr >= 0) O[(size_t)rr * 4096 + hv * 128 + 32 * ns + l31] = (bf16)f2bf(acc[r]); } \
        } else if (role == 2) { \
        _Pragma("unroll") \
            for (int r = 0; r < 16; ++r) S[r] *= cegl; \
        _Pragma("unroll") \
            for (int s = 0; s < 4; ++s) S = MFMA32(a4[s], *(const LAS bf16x8*)(VND + l31 * 144 + 32 * s + 16 * h), S); \
        _Pragma("unroll") \
            for (int g = 0; g < 4; ++g) *(LAS v2u*)(ST + l31 * 272 + (32 * kt + 8 * g + 4 * h) * 2) = (v2u){pk2(S[4 * g], S[4 * g + 1]), pk2(S[4 * g + 2], S[4 * g + 3])}; \
        } \
        GDN_BAR(); \
    } while (0)
    for (int n2 = n_lo; n2 < n_hi; n2 += 2) { GDN_STEP(n2, A8); if (n2 + 1 < n_hi) GDN_STEP(n2 + 1, A8q); }
#undef GDN_STEP
#undef GDN_LOADA
    if (n_hi < GDN_NCH && role == 2) {
#pragma unroll
        for (int g = 0; g < 4; ++g) *(f32x4*)(SV + 4 * g) = (f32x4){S[4 * g], S[4 * g + 1], S[4 * g + 2], S[4 * g + 3]}; }
#undef GDN_LOAD
#undef GDN_BAR
}

constexpr int RW_NSC = 258, RW_UNITS = 129 * 16;
DI int sub_row(int sc, int t) { const int n = sc >> 1, sub = sc & 1; return n == 0 ? ((sub == 0 && t >= 16) ? TX + t - 16 : -1) : 64 * (n - 1) + 32 * sub + t; }
constexpr size_t RW_BASE = WS_PROJ + 92 * MiB;
constexpr size_t RW_RH = RW_BASE, RW_RL = RW_BASE + 33 * MiB, RW_GT = RW_BASE + 66 * MiB, RW_GAM = RW_BASE + 99 * MiB;
constexpr size_t RW_PR = WS_SCR + 195 * MiB, RW_AT = WS_SCR + 211 * MiB + 256 * 1024, RW_VTF = WS_SCR + 219 * MiB + 512 * 1024, RW_SALL = WS_SCR + 235 * MiB + 768 * 1024;
constexpr size_t RW_XSAVE = 1 * MiB + 640 * 1024;
constexpr size_t RW_VV = WS_YMIX + 34 * MiB, RW_BON = WS_YMIX + 52 * MiB, LR_H = WS_YMIX + 54 * MiB, LR_A = WS_YMIX + 56 * MiB, LR_C = WS_YMIX + 58 * MiB;
constexpr size_t RW_SCH = (size_t)RW_NSC * 16;
static_assert((size_t)MP * EV_NP * 2 <= 92 * MiB && RW_SCH * 8192 <= 33 * MiB && RW_GAM + RW_SCH * 256 <= WS_SCR, "rwkv map (proj region)");
static_assert(WS_SCR + SC_LIX + (size_t)MP * 4096 <= RW_PR && RW_PR + RW_SCH * 4096 <= RW_AT && RW_AT + RW_SCH * 2048 <= RW_VTF && RW_VTF + RW_SCH * 4096 <= RW_SALL && RW_SALL + RW_SCH * 8192 <= WS_END, "rwkv map (scratch region)");
static_assert((size_t)MP * DM * 2 <= 34 * MiB && RW_VV + (size_t)MP * 2048 <= RW_BON && RW_BON + (size_t)MP * 64 <= LR_H && LR_H + RW_SCH * 256 <= LR_A && LR_A + RW_SCH * 256 <= LR_C && LR_C + RW_SCH * 256 <= WS_PROJ, "rwkv map (ymix region)");

DI void sub_rows(int sc, int& t0, int& rbase) { if (sc >= 2) { t0 = 0; rbase = 64 * ((sc >> 1) - 1) + 32 * (sc & 1); } else if (sc == 0) { t0 = 16; rbase = TX - 16; } else { t0 = 32; rbase = 0; } }
DI void lru_local(const Frame& F, const Args& a, int gw, int ngw) {
    const bf16* LA = (const bf16*)(a.ws + WS_SCR + SC_LA); const bf16* LIX = (const bf16*)(a.ws + WS_SCR + SC_LIX);
    float* HL = (float*)(a.ws + LR_H); float* AP = (float*)(a.ws + LR_A);
    for (int item = gw; item < RW_NSC * 16; item += ngw) { const int sc = item >> 4, c = (item & 15) * 64 + F.lane; int t0, rbase; sub_rows(sc, t0, rbase);
        float av[32], ix[32];
#pragma unroll
        for (int t = 0; t < 32; ++t) { const size_t o = (size_t)(rbase + (t >= t0 ? t : 32)) * 1024 + c; av[t] = bf2f(LA[o]); ix[t] = bf2f(LIX[o]); }
        float h = 0.f, p = 1.f;
#pragma unroll
        for (int t = 0; t < 32; ++t) { const float om = t >= t0 ? av[t] : 0.f, x_ = t >= t0 ? ix[t] : 0.f, a_ = 1.0f - om; h = a_ * h + sqrtf(om * (1.0f + a_)) * x_; p *= a_; }
        HL[sc * 1024 + c] = h; AP[sc * 1024 + c] = p; }
}
DI void lru_apply(const Frame& F, const Args& a) {
    const bf16* P = (const bf16*)(a.ws + WS_PROJ); const bf16* LA = (const bf16*)(a.ws + WS_SCR + SC_LA); const bf16* LIX = (const bf16*)(a.ws + WS_SCR + SC_LIX);
    const float* CR = (const float*)(a.ws + LR_C); bf16* Y = (bf16*)(a.ws + WS_YMIX);
    for (int item = F.gw; item < RW_NSC * 16; item += F.NGW) { const int sc = item >> 4, c = (item & 15) * 64 + F.lane; int t0, rbase; sub_rows(sc, t0, rbase); if (t0 >= 32) continue;
        float h = CR[sc * 1024 + c];
#pragma unroll
        for (int tb = 0; tb < 32; tb += 16) { float av[16], ix[16], gb[16];
#pragma unroll
            for (int t = 0; t < 16; ++t) { const size_t r_ = (size_t)(rbase + (tb + t >= t0 ? tb + t : 32)); av[t] = bf2f(LA[r_ * 1024 + c]); ix[t] = bf2f(LIX[r_ * 1024 + c]); gb[t] = bf2f(P[r_ * EV_NP + EV_GB + c]); }
#pragma unroll
            for (int t = 0; t < 16; ++t) { if (tb + t >= t0) { const float a_ = 1.0f - av[t]; h = a_ * h + sqrtf(av[t] * (1.0f + a_)) * ix[t]; Y[(size_t)(rbase + tb + t) * DM + 1024 + c] = (bf16)f2bf(h * gelu_tanh(gb[t])); } } } }
}

DI void ph_rwkv_chunk(const Frame& F, const Args& a, int n_lo, int n_hi, int wg0) {
    if (F.vcu < wg0) return;
    const bf16* P = (const bf16*)(a.ws + WS_PROJ); const bf16* DEC = (const bf16*)(a.ws + WS_SCR + SC_DEC); const bf16* ICL = (const bf16*)(a.ws + WS_SCR + SC_ICL);
    bf16* RH = (bf16*)(a.ws + RW_RH); bf16* RL = (bf16*)(a.ws + RW_RL); bf16* GT = (bf16*)(a.ws + RW_GT); float* GAM = (float*)(a.ws + RW_GAM); bf16* PR = (bf16*)(a.ws + RW_PR); bf16* ATG = (bf16*)(a.ws + RW_AT); bf16* VTF = (bf16*)(a.ws + RW_VTF);
    bf16* VV = (bf16*)(a.ws + RW_VV); float* BON = (float*)(a.ws + RW_BON);
    LAS unsigned char* L = F.lds + RING_OFF;
    LAS float* wS = (LAS float*)L; LAS float* aS = wS + 4096; LAS float* bS = wS + 8192; LAS float* rS = wS + 12288; LAS float* kS = wS + 16384;
    LAS unsigned char* vT = L + 81920; LAS unsigned char* aT = L + 91136; LAS unsigned char* rT = L + 100352; LAS unsigned char* kT = L + 109568; LAS unsigned char* bT = L + 118784;
    LAS unsigned char* AT = L + 128000; LAS unsigned char* NT = L + 133120; LAS float* gam = (LAS float*)(L + 138240);
    LAS unsigned char* aTl = L; LAS unsigned char* bTl = L + 9216;
    const int tid = F.tid, lane = F.lane, wave = F.wave, l31 = lane & 31, h = lane >> 5;
    const float* mu = a.in[6];
    for (int unit = n_lo * 16 + (F.vcu - wg0); unit < n_hi * 16; unit += F.G - wg0) {
        const int n = unit >> 4, hd = unit & 15;
#ifdef R1_REP_A
        _Pragma("unroll 1") for (int rep_ = 0; rep_ < 2; ++rep_)
#endif
        { const int tok = tid >> 3, cg = tid & 7, c0 = hd * 64 + cg * 8; const int rr = sub_row(2 * n + (tok >> 5), tok & 31);
          float wv[8], av[8], bv[8], rv[8], kv[8], vv[8];
#pragma unroll
          for (int q = 0; q < 8; ++q) { wv[q] = 0.f; av[q] = 0.f; bv[q] = 0.f; rv[q] = 0.f; kv[q] = 0.f; vv[q] = 0.f; }
          if (rr >= 0) { const int pos = row_pos(rr); const bf16* cur = P + (size_t)rr * EV_NP + c0; const bf16* prv = pos > 0 ? P + (size_t)pos_row(pos - 1) * EV_NP + c0 : nullptr;
              const v4u z4 = (v4u){0u, 0u, 0u, 0u};
              const v4u cr = *(const v4u*)cur, ck = *(const v4u*)(cur + 1024), cv = *(const v4u*)(cur + 2048);
              const v4u qr = prv ? *(const v4u*)prv : z4, qk = prv ? *(const v4u*)(prv + 1024) : z4, qv = prv ? *(const v4u*)(prv + 2048) : z4;
              const unsigned crw[4] = {cr.x, cr.y, cr.z, cr.w}, ckw[4] = {ck.x, ck.y, ck.z, ck.w}, cvw[4] = {cv.x, cv.y, cv.z, cv.w}, qrw[4] = {qr.x, qr.y, qr.z, qr.w}, qkw[4] = {qk.x, qk.y, qk.z, qk.w}, qvw[4] = {qv.x, qv.y, qv.z, qv.w};
              float ss = 0.f, bon = 0.f; float kk[8], ic[8];
#pragma unroll
              for (int q = 0; q < 8; ++q) { const int c = c0 + q; const float crf = (q & 1) ? bfhi(crw[q >> 1]) : bflo(crw[q >> 1]), ckf = (q & 1) ? bfhi(ckw[q >> 1]) : bflo(ckw[q >> 1]), cvf = (q & 1) ? bfhi(cvw[q >> 1]) : bflo(cvw[q >> 1]);
                  const float prf = (q & 1) ? bfhi(qrw[q >> 1]) : bflo(qrw[q >> 1]), pkf = (q & 1) ? bfhi(qkw[q >> 1]) : bflo(qkw[q >> 1]), pvf = (q & 1) ? bfhi(qvw[q >> 1]) : bflo(qvw[q >> 1]);
                  rv[q] = crf + (prf - crf) * mu[c]; kk[q] = ckf + (pkf - ckf) * mu[1024 + c]; vv[q] = cvf + (pvf - cvf) * mu[2048 + c];
                  wv[q] = -bf2f(DEC[(size_t)rr * 1024 + c])  ; ic[q] = bf2f(ICL[(size_t)rr * 1024 + c]);
                  const float kkv = kk[q] * a.in[12][c]; av[q] = kkv; ss += kkv * kkv; kv[q] = kk[q] * (1.0f + (ic[q] - 1.0f) * a.in[13][c]); bon += rv[q] * kv[q] * a.in[14][c]; }
              ss += __shfl_xor(ss, 1); ss += __shfl_xor(ss, 2); ss += __shfl_xor(ss, 4); bon += __shfl_xor(bon, 1); bon += __shfl_xor(bon, 2); bon += __shfl_xor(bon, 4);
              const float inv = 1.0f / fmaxf(sqrtf(ss), 1e-12f);
#pragma unroll
              for (int q = 0; q < 8; ++q) { const float kkn = av[q] * inv; av[q] = -kkn; bv[q] = kkn * ic[q]; }
              if (cg == 0) BON[(size_t)rr * 16 + hd] = bon;
              *(v4u*)(VV + (size_t)rr * 1024 + c0) = (v4u){pk2(vv[0], vv[1]), pk2(vv[2], vv[3]), pk2(vv[4], vv[5]), pk2(vv[6], vv[7])}; }
          const int o = tok * 64 + cg * 8;
          *(LAS f32x4*)(wS + o) = (f32x4){wv[0], wv[1], wv[2], wv[3]}; *(LAS f32x4*)(wS + o + 4) = (f32x4){wv[4], wv[5], wv[6], wv[7]};
          *(LAS f32x4*)(aS + o) = (f32x4){av[0], av[1], av[2], av[3]}; *(LAS f32x4*)(aS + o + 4) = (f32x4){av[4], av[5], av[6], av[7]};
          *(LAS f32x4*)(bS + o) = (f32x4){bv[0], bv[1], bv[2], bv[3]}; *(LAS f32x4*)(bS + o + 4) = (f32x4){bv[4], bv[5], bv[6], bv[7]};
          *(LAS f32x4*)(rS + o) = (f32x4){rv[0], rv[1], rv[2], rv[3]}; *(LAS f32x4*)(rS + o + 4) = (f32x4){rv[4], rv[5], rv[6], rv[7]};
          *(LAS f32x4*)(kS + o) = (f32x4){kv[0], kv[1], kv[2], kv[3]}; *(LAS f32x4*)(kS + o + 4) = (f32x4){kv[4], kv[5], kv[6], kv[7]};
#pragma unroll
          for (int q = 0; q < 8; ++q) *(LAS bf16*)(vT + (cg * 8 + q) * 144 + tok * 2) = (bf16)f2bf(vv[q]); }
        __syncthreads();
        { typedef float f32x2 __attribute__((ext_vector_type(2)));
          const int sub = wave >> 2, blk = sub ? 3 - (wave & 3) : (wave & 3), tkn = lane >> 3, e = lane & 7, s = 8 * blk + tkn, tok = 32 * sub + s, j8 = 8 * e;
          f32x2 xk[4], xb[4];
          { const f32x4 t0 = *(const LAS f32x4*)(kS + tok * 64 + j8), t1 = *(const LAS f32x4*)(kS + tok * 64 + j8 + 4), u0 = *(const LAS f32x4*)(bS + tok * 64 + j8), u1 = *(const LAS f32x4*)(bS + tok * 64 + j8 + 4);
            xk[0] = (f32x2){t0.x, t0.y}; xk[1] = (f32x2){t0.z, t0.w}; xk[2] = (f32x2){t1.x, t1.y}; xk[3] = (f32x2){t1.z, t1.w};
            xb[0] = (f32x2){u0.x, u0.y}; xb[1] = (f32x2){u0.z, u0.w}; xb[2] = (f32x2){u1.x, u1.y}; xb[3] = (f32x2){u1.z, u1.w}; }
          for (int i = e; i < 8 * blk; i += 8) { *(LAS bf16*)(AT + ((sub * 32 + i) * 40 + s) * 2) = (bf16)0; *(LAS bf16*)(NT + ((sub * 32 + i) * 40 + s) * 2) = (bf16)0; }
#define RW_RED8(v) do { v += __builtin_bit_cast(float, __builtin_amdgcn_mov_dpp(__builtin_bit_cast(int, v), 0xB1, 0xF, 0xF, true)); v += __builtin_bit_cast(float, __builtin_amdgcn_mov_dpp(__builtin_bit_cast(int, v), 0x4E, 0xF, 0xF, true)); \
              v += __builtin_bit_cast(float, __builtin_amdgcn_mov_dpp(__builtin_bit_cast(int, v), 0x141, 0xF, 0xF, true)); } while (0)
#define RW_PASS(X_, OUTP) do { f32x2 c2 = X_[0] * a2[0]; c2 = X_[1] * a2[1] + c2; c2 = X_[2] * a2[2] + c2; c2 = X_[3] * a2[3] + c2; float c = c2.x + c2.y; RW_RED8(c); \
              const float cm = c * m; const f32x2 cm2 = (f32x2){cm, cm}; \
              _Pragma("unroll") for (int i = 0; i < 4; ++i) X_[i] = X_[i] * mw[i] + (cm2 * b2[i] + X_[i]); \
              f32x2 o2 = X_[0] * r2[0]; o2 = X_[1] * r2[1] + o2; o2 = X_[2] * r2[2] + o2; o2 = X_[3] * r2[3] + o2; float o = o2.x + o2.y; RW_RED8(o); \
              *(LAS bf16*)(OUTP + ((sub * 32 + tp) * 40 + s) * 2) = (bf16)f2bf(o * mge); } while (0)
          const LAS float* bp = wS + (32 * sub + 8 * blk) * 64 + j8;
#define RW_LOAD(P_, p_) do { P_[0] = *(const LAS f32x4*)(p_); P_[1] = *(const LAS f32x4*)((p_) + 4); P_[2] = *(const LAS f32x4*)((p_) + 4096); P_[3] = *(const LAS f32x4*)((p_) + 4100); \
              P_[4] = *(const LAS f32x4*)((p_) + 8192); P_[5] = *(const LAS f32x4*)((p_) + 8196); P_[6] = *(const LAS f32x4*)((p_) + 12288); P_[7] = *(const LAS f32x4*)((p_) + 12292); } while (0)
#define RW_STEP(P_, tp_) do { const int tp = (tp_); const float m = tp > s ? 1.f : 0.f, mge = tp >= s ? 1.f : 0.f; const f32x2 m2 = (f32x2){m, m}; \
              const f32x2 a2[4] = {(f32x2){P_[2].x, P_[2].y}, (f32x2){P_[2].z, P_[2].w}, (f32x2){P_[3].x, P_[3].y}, (f32x2){P_[3].z, P_[3].w}}, b2[4] = {(f32x2){P_[4].x, P_[4].y}, (f32x2){P_[4].z, P_[4].w}, (f32x2){P_[5].x, P_[5].y}, (f32x2){P_[5].z, P_[5].w}}; \
              const f32x2 r2[4] = {(f32x2){P_[6].x, P_[6].y}, (f32x2){P_[6].z, P_[6].w}, (f32x2){P_[7].x, P_[7].y}, (f32x2){P_[7].z, P_[7].w}}; \
              const f32x2 mw[4] = {m2 * (f32x2){P_[0].x, P_[0].y}, m2 * (f32x2){P_[0].z, P_[0].w}, m2 * (f32x2){P_[1].x, P_[1].y}, m2 * (f32x2){P_[1].z, P_[1].w}}; \
              RW_PASS(xk, AT); RW_PASS(xb, NT); } while (0)
          f32x4 PA[8], PB[8]; RW_LOAD(PA, bp);
          for (int t2 = 8 * blk; t2 < 32; t2 += 2, bp += 128) { RW_LOAD(PB, bp + 64); __builtin_amdgcn_sched_barrier(0); RW_STEP(PA, t2); RW_LOAD(PA, bp + 128); __builtin_amdgcn_sched_barrier(0); RW_STEP(PB, t2 + 1); }
#undef RW_STEP
#undef RW_LOAD
#undef RW_PASS
#undef RW_RED8
#pragma unroll
          for (int i = 0; i < 4; ++i) { *(LAS bf16*)(kT + (j8 + 2 * i) * 144 + tok * 2) = (bf16)f2bf(xk[i].x); *(LAS bf16*)(kT + (j8 + 2 * i + 1) * 144 + tok * 2) = (bf16)f2bf(xk[i].y);
              *(LAS bf16*)(bT + (j8 + 2 * i) * 144 + tok * 2) = (bf16)f2bf(xb[i].x); *(LAS bf16*)(bT + (j8 + 2 * i + 1) * 144 + tok * 2) = (bf16)f2bf(xb[i].y); }
          const bool gwave = (blk == 3); const int j = lane;
          if (gwave) { float g = 1.f;
#pragma unroll
              for (int tp = 0; tp < 32; ++tp) { const int tk = 32 * sub + tp; const float w_ = 1.0f + wS[tk * 64 + j], a_ = aS[tk * 64 + j], r_ = rS[tk * 64 + j];
                  *(LAS bf16*)(aT + j * 144 + tk * 2) = (bf16)f2bf(a_ * g);
                  g *= w_; *(LAS bf16*)(rT + j * 144 + tk * 2) = (bf16)f2bf(r_ * g); }
              gam[sub * 64 + j] = g; }
        }
        __syncthreads();
#ifdef R1_REP_C
        _Pragma("unroll 1") for (int rep_ = 0; rep_ < 2; ++rep_) {
#endif
        { const int sub = wave >> 2, t1 = (wave >> 1) & 1, t0 = wave & 1; const size_t sch = (size_t)hd * RW_NSC + (2 * n + sub);
          { f32x16 acc;
#pragma unroll
            for (int r = 0; r < 16; ++r) acc[r] = 0.f;
#pragma unroll
            for (int ks = 0; ks < 2; ++ks) { const int ao = (32 * t1 + l31) * 144 + (32 * sub + 16 * ks + 8 * h) * 2, bo = (32 * t0 + l31) * 144 + (32 * sub + 16 * ks + 8 * h) * 2;
                acc = MFMA32(*(const LAS bf16x8*)(aT + ao), *(const LAS bf16x8*)(bT + bo), acc); }
            const int jp = 32 * t0 + l31;
#pragma unroll
            for (int g = 0; g < 4; ++g) *(v2u*)(RH + (sch * 64 + jp) * 64 + 32 * t1 + 8 * g + 4 * h) = (v2u){pk2(acc[4 * g], acc[4 * g + 1]), pk2(acc[4 * g + 2], acc[4 * g + 3])};
            if (t1 == 0 && t0 == 0) GAM[sch * 64 + lane] = gam[sub * 64 + lane]; }
          { f32x16 acc;
#pragma unroll
            for (int r = 0; r < 16; ++r) acc[r] = 0.f;
#pragma unroll
            for (int ks = 0; ks < 2; ++ks) acc = MFMA32(*(const LAS bf16x8*)(kT + (32 * t1 + l31) * 144 + (32 * sub + 16 * ks + 8 * h) * 2), *(const LAS bf16x8*)(vT + (32 * t0 + l31) * 144 + (32 * sub + 16 * ks + 8 * h) * 2), acc);
            bf16* dst = GT + ((sch * 4 + t1 * 2 + t0) * 64 + lane) * 16;
            *(v4u*)dst = (v4u){pk2(acc[0], acc[1]), pk2(acc[2], acc[3]), pk2(acc[4], acc[5]), pk2(acc[6], acc[7])}; *(v4u*)(dst + 8) = (v4u){pk2(acc[8], acc[9]), pk2(acc[10], acc[11]), pk2(acc[12], acc[13]), pk2(acc[14], acc[15])}; } }
        if (wave < 4) { const int sub = wave >> 1, jt = wave & 1; const size_t sch = (size_t)hd * RW_NSC + (2 * n + sub);
            f32x16 acc;
#pragma unroll
            for (int r = 0; r < 16; ++r) acc[r] = bf2f(*(const LAS bf16*)(rT + (32 * jt + crow(r, h)) * 144 + (32 * sub + l31) * 2));
#pragma unroll
            for (int ks = 0; ks < 2; ++ks) acc = MFMA32(*(const LAS bf16x8*)(aT + (32 * jt + l31) * 144 + (32 * sub + 16 * ks + 8 * h) * 2), *(const LAS bf16x8*)(NT + (sub * 32 + l31) * 80 + (16 * ks + 8 * h) * 2), acc);
#pragma unroll
            for (int g = 0; g < 4; ++g) *(v2u*)(PR + (sch * 32 + l31) * 64 + 32 * jt + 8 * g + 4 * h) = (v2u){pk2(acc[4 * g], acc[4 * g + 1]), pk2(acc[4 * g + 2], acc[4 * g + 3])};
        } else { const int t2 = tid - 256, sub = t2 >> 7, t = (t2 >> 2) & 31, s8 = (t2 & 3) * 8; const size_t sch = (size_t)hd * RW_NSC + (2 * n + sub);
            *(v4u*)(ATG + (sch * 32 + t) * 32 + s8) = *(const LAS v4u*)(AT + (sub * 32 + t) * 80 + s8 * 2); }
        { const int sub = tid >> 8, it = (tid >> 7) & 1, ks = (tid >> 6) & 1; const size_t sch = (size_t)hd * RW_NSC + (2 * n + sub);
          *(v4u*)(VTF + ((sch * 4 + it * 2 + ks) * 64 + lane) * 8) = *(const LAS v4u*)(vT + (32 * it + l31) * 144 + (32 * sub + 16 * ks + 8 * h) * 2); }
#ifdef R1_REP_C
        }
#endif
        __syncthreads();
    }
}

DI void ph_rwkv_chain(const Frame& F, const Args& a, int sc_lo, int sc_hi) {
    if (F.vcu >= 16 && F.vcu < 32) {
        if (sc_hi < RW_NSC) return;
        constexpr int GS = 33; static_assert(8 * GS >= RW_NSC, "carry groups");
        const int g = F.tid >> 6, c = (F.vcu - 16) * 64 + F.lane; const float* HL = (const float*)(a.ws + LR_H); const float* AP = (const float*)(a.ws + LR_A); float* CR = (float*)(a.ws + LR_C);
        float hl[GS], ap[GS];
#pragma unroll
        for (int i = 0; i < GS; ++i) { const int sc = g * GS + i, scc = sc < RW_NSC ? sc : RW_NSC - 1; hl[i] = HL[scc * 1024 + c]; ap[i] = AP[scc * 1024 + c]; }
        float A = 1.f, H = 0.f;
#pragma unroll
        for (int i = 0; i < GS; ++i) if (g * GS + i < RW_NSC) { H = ap[i] * H + hl[i]; A *= ap[i]; }
        LAS float* cs = (LAS float*)(F.lds + RING_OFF);
        cs[(g * 64 + F.lane) * 2] = A; cs[(g * 64 + F.lane) * 2 + 1] = H;
        __syncthreads();
        float carry = 0.f;
        for (int q = 0; q < g; ++q) carry = cs[(q * 64 + F.lane) * 2] * carry + cs[(q * 64 + F.lane) * 2 + 1];
#pragma unroll
        for (int i = 0; i < GS; ++i) { const int sc = g * GS + i; if (sc < RW_NSC) { CR[sc * 1024 + c] = carry; carry = ap[i] * carry + hl[i]; } }
        return; }
    if (F.vcu >= 16) return;
    const int hd = F.vcu; const bf16* RH = (const bf16*)(a.ws + RW_RH); const bf16* RL = (const bf16*)(a.ws + RW_RL); const bf16* GT = (const bf16*)(a.ws + RW_GT); const float* GAM = (const float*)(a.ws + RW_GAM); bf16* SALL = (bf16*)(a.ws + RW_SALL);
    constexpr int RW_NS = 7, SLOT = 8192 + 8192 + 1024;
    LAS unsigned char* XS = F.lds + RING_OFF; LAS unsigned char* RG = XS + 2 * 9216;
    const int lane = F.lane, wave = F.wave, l31 = lane & 31, h = lane >> 5, jt = (wave >> 1) & 1, it = wave & 1, lw = wave & 3;
    for (int i = F.tid; i < 2 * 9216 / 4; i += NWAVES * 64) ((LAS unsigned*)XS)[i] = 0u;
    __syncthreads();
#define RW_BAR() do { asm volatile("s_waitcnt lgkmcnt(0)" ::: "memory"); __builtin_amdgcn_s_barrier(); asm volatile("" ::: "memory"); } while (0)
    const unsigned rg0 = (unsigned)(uintptr_t)RG;
    int offR[4], offG[4]; const int lw2 = wave & 1;
#pragma unroll
    for (int i = 0; i < 4; ++i) { const int b = 4 * lw2 + i, row = 8 * b + (lane >> 3), pc = lane & 7; offR[i] = row * 64 + ((pc ^ (row & 7)) * 8); offG[i] = (b * 64 + lane) * 8; }
    const int offM = (lane & 15) * 4;
#define RW_DMA(src, dst) do { unsigned keep_; asm volatile("s_mov_b32 %0, m0\n\ts_mov_b32 m0, %2\n\ts_nop 0\n\tglobal_load_lds_dwordx4 %1, off\n\ts_mov_b32 m0, %0" : "=&s"(keep_) : "v"(src), "s"(dst) : "memory"); } while (0)
#define RW_ISSUE(scn) do { const int s_ = (scn) < RW_NSC ? (scn) : RW_NSC - 1; const size_t sch_ = (size_t)hd * RW_NSC + s_; \
        const unsigned sb_ = (unsigned)__builtin_amdgcn_readfirstlane((int)(rg0 + (unsigned)((scn) % RW_NS) * SLOT)); \
        _Pragma("unroll") for (int i_ = 0; i_ < 4; ++i_) { const unsigned bo_ = (unsigned)__builtin_amdgcn_readfirstlane((4 * lw2 + i_) * 1024); \
            RW_DMA(RH + sch_ * 4096 + offR[i_], sb_ + bo_); RW_DMA(GT + sch_ * 4096 + offG[i_], sb_ + 8192 + bo_); } \
        RW_DMA(GAM + sch_ * 64 + offM, sb_ + 16384); } while (0)
#define RW_WAITV(n) asm volatile("s_waitcnt vmcnt(" #n ")" ::: "memory")
    f32x16 X;
#pragma unroll
    for (int r = 0; r < 16; ++r) X[r] = 0.f;
    float* XSV = (float*)(a.ws + RW_XSAVE) + ((size_t)(hd * 4 + (wave & 3)) * 64 + lane) * 16;
    if (wave < 4 && sc_lo > 0) {
#pragma unroll
        for (int g = 0; g < 4; ++g) { const f32x4 v = *(const f32x4*)(XSV + 4 * g); X[4 * g] = v.x; X[4 * g + 1] = v.y; X[4 * g + 2] = v.z; X[4 * g + 3] = v.w;
            *(LAS v2u*)(XS + (32 * it + l31) * 144 + (32 * jt + 8 * g + 4 * h) * 2) = (v2u){pk2(v.x, v.y), pk2(v.z, v.w)}; } }
    if (wave == 4 || wave == 5) { RW_ISSUE(sc_lo); RW_ISSUE(sc_lo + 1); RW_ISSUE(sc_lo + 2); RW_ISSUE(sc_lo + 3); RW_ISSUE(sc_lo + 4); RW_ISSUE(sc_lo + 5); RW_WAITV(45); }
    RW_BAR();
    for (int sc = sc_lo; sc < sc_hi; ++sc) {
        if (wave < 4) {
            const LAS unsigned char* sb = RG + (sc % RW_NS) * SLOT;
            f32x16 acc; const size_t sch = (size_t)hd * RW_NSC + sc;
            { const v4u g0 = *(const LAS v4u*)(sb + 8192 + ((jt * 2 + it) * 64 + lane) * 32), g1 = *(const LAS v4u*)(sb + 8192 + ((jt * 2 + it) * 64 + lane) * 32 + 16);
              const unsigned gw_[8] = {g0.x, g0.y, g0.z, g0.w, g1.x, g1.y, g1.z, g1.w};
#pragma unroll
              for (int g = 0; g < 4; ++g) { const f32x4 m = *(const LAS f32x4*)(sb + 16384 + (32 * jt + 8 * g + 4 * h) * 4);
                  acc[4 * g] = bflo(gw_[2 * g]) + m.x * X[4 * g]; acc[4 * g + 1] = bfhi(gw_[2 * g]) + m.y * X[4 * g + 1]; acc[4 * g + 2] = bflo(gw_[2 * g + 1]) + m.z * X[4 * g + 2]; acc[4 * g + 3] = bfhi(gw_[2 * g + 1]) + m.w * X[4 * g + 3]; } }
            const LAS unsigned char* xb = XS + (sc & 1) * 9216 + (32 * it + l31) * 144 + 16 * h; const int ar = 32 * jt + l31; const LAS unsigned char* ab = sb + ar * 128;
#pragma unroll
            for (int ks = 0; ks < 4; ++ks) { const bf16x8 xf = *(const LAS bf16x8*)(xb + 32 * ks); const int po = (((2 * ks + h) ^ (ar & 7)) * 16);
                acc = MFMA32(*(const LAS bf16x8*)(ab + po), xf, acc); }
            X = acc;
            LAS unsigned char* xn = XS + ((sc + 1) & 1) * 9216 + (32 * it + l31) * 144;
#pragma unroll
            for (int g = 0; g < 4; ++g) *(LAS v2u*)(xn + (32 * jt + 8 * g + 4 * h) * 2) = (v2u){pk2(X[4 * g], X[4 * g + 1]), pk2(X[4 * g + 2], X[4 * g + 3])};
        } else if (wave < 6) {
            RW_ISSUE(sc + RW_NS - 1);
            RW_WAITV(45);
        } else {
            const LAS unsigned char* xi = XS + (sc & 1) * 9216; bf16* so = SALL + ((size_t)hd * RW_NSC + sc) * 4096;
#pragma unroll
            for (int q = 0; q < 4; ++q) { const int pc = (wave & 1) * 256 + 64 * q + lane, row = pc >> 3, ch = pc & 7; *(v4u*)(so + row * 64 + ch * 8) = *(const LAS v4u*)(xi + row * 144 + ch * 16); }
        }
        RW_BAR();
    }
    if (wave == 4 || wave == 5) RW_WAITV(0);
    else if (wave < 4 && sc_hi < RW_NSC) {
#pragma unroll
        for (int g = 0; g < 4; ++g) *(f32x4*)(XSV + 4 * g) = (f32x4){X[4 * g], X[4 * g + 1], X[4 * g + 2], X[4 * g + 3]}; }
#undef RW_ISSUE
#undef RW_DMA
#undef RW_WAITV
#undef RW_BAR
}

DI f32x4 ld_bf4(const bf16* p) { const v2u w = *(const v2u*)p; return (f32x4){bflo(w.x), bfhi(w.x), bflo(w.y), bfhi(w.y)}; }
DI void ph_rwkv_out(const Frame& F, const Args& a, int sc_lo, int sc_hi, int gw, int ngw) {
    const bf16* SALL = (const bf16*)(a.ws + RW_SALL); const bf16* PR = (const bf16*)(a.ws + RW_PR); const bf16* ATG = (const bf16*)(a.ws + RW_AT); const bf16* VTF = (const bf16*)(a.ws + RW_VTF);
    const bf16* VV = (const bf16*)(a.ws + RW_VV); const float* BON = (const float*)(a.ws + RW_BON); const bf16* GATE = (const bf16*)(a.ws + WS_SCR + SC_GATE); bf16* Y = (bf16*)(a.ws + WS_YMIX);
    const int lane = F.lane, l31 = lane & 31, h = lane >> 5;
    for (int item = sc_lo * 16 + gw; item < sc_hi * 16; item += ngw) { const int sc = item >> 4, hd = item & 15; if (sc == 1) continue;
        const size_t sch = (size_t)hd * RW_NSC + sc; f32x16 acc[2];
#pragma unroll
        for (int it = 0; it < 2; ++it) {
#pragma unroll
            for (int r = 0; r < 16; ++r) acc[it][r] = 0.f;
#pragma unroll
            for (int ks = 0; ks < 4; ++ks) acc[it] = MFMA32(*(const bf16x8*)(SALL + (sch * 64 + 32 * it + l31) * 64 + 16 * ks + 8 * h), *(const bf16x8*)(PR + (sch * 32 + l31) * 64 + 16 * ks + 8 * h), acc[it]);
#pragma unroll
            for (int ks = 0; ks < 2; ++ks) acc[it] = MFMA32(*(const bf16x8*)(VTF + ((sch * 4 + it * 2 + ks) * 64 + lane) * 8), *(const bf16x8*)(ATG + (sch * 32 + l31) * 32 + 16 * ks + 8 * h), acc[it]); }
        float s1 = 0.f;
#pragma unroll
        for (int it = 0; it < 2; ++it)
#pragma unroll
            for (int r = 0; r < 16; ++r) s1 += acc[it][r];
        s1 += __shfl_xor(s1, 32); const float mean = s1 * (1.0f / 64.0f); float s2 = 0.f;
#pragma unroll
        for (int it = 0; it < 2; ++it)
#pragma unroll
            for (int r = 0; r < 16; ++r) { const float d = acc[it][r] - mean; s2 += d * d; }
        s2 += __shfl_xor(s2, 32); const float rstd = 1.0f / sqrtf(s2 * (1.0f / 64.0f) + 64e-5f);
        const int rr = sub_row(sc, l31);
        if (rr >= 0) { const float bon = BON[(size_t)rr * 16 + hd];
#pragma unroll
            for (int it = 0; it < 2; ++it)
#pragma unroll
                for (int g = 0; g < 4; ++g) { const int c = hd * 64 + 32 * it + 8 * g + 4 * h;
                    const f32x4 lw = *(const f32x4*)(a.in[15] + c), lb = *(const f32x4*)(a.in[16] + c), gt = ld_bf4(GATE + (size_t)rr * 1024 + c); const v2u vw = *(const v2u*)(VV + (size_t)rr * 1024 + c);
                    const float o0 = ((acc[it][4 * g] - mean) * rstd * lw.x + lb.x + bon * bflo(vw.x)) * gt.x, o1 = ((acc[it][4 * g + 1] - mean) * rstd * lw.y + lb.y + bon * bfhi(vw.x)) * gt.y;
                    const float o2 = ((acc[it][4 * g + 2] - mean) * rstd * lw.z + lb.z + bon * bflo(vw.y)) * gt.z, o3 = ((acc[it][4 * g + 3] - mean) * rstd * lw.w + lb.w + bon * bfhi(vw.y)) * gt.w;
                    *(v2u*)(Y + (size_t)rr * DM + c) = (v2u){pk2(o0, o1), pk2(o2, o3)}; } }
    }
}

constexpr int N_PHASES = 33;
template <class Epi, class Sched> DI void run_gemm(const Frame& F, const pg8::Gemm& g, const Sched& S, const Epi& E) {
    pg8::gemm_phase<Epi, Sched, true, true>(F.lds + RING_OFF, g, S, E);
}
DI void moe_up_units(const Frame& F, const Args& a, int t0, int ntl, int G, int c) {
    pg8::Gemm g{(const bf16*)(a.ws + WS_SCR + SC_XG), (const bf16*)(a.ws + WS_MOEW), DM, DM, DM};
    pg8::MoeOrder S{(const int*)(a.ws + WS_TILES), t0, ntl, 4, G, c, (long)MOE_E_BYTES};
    pg8::EpiSwiglu E{(bf16*)(a.ws + WS_SCR + SC_ACT), FF};
    run_gemm(F, g, S, E);
}
DI void moe_down_units(const Frame& F, const Args& a, int t0, int ntl, int G, int c) {
    pg8::Gemm g{(const bf16*)(a.ws + WS_SCR + SC_ACT), (const bf16*)(a.ws + WS_MOEW + MOE_W2_OFF), FF, FF, FF};
    pg8::MoeOrder S{(const int*)(a.ws + WS_TILES), t0, ntl, 8, G, c, (long)MOE_E_BYTES};
    pg8::EpiBf16 E{(bf16*)(a.ws + WS_SCR + SC_YB), DM};
    run_gemm(F, g, S, E);
}
DI void ph_moe_a(const Frame& F, const Args& a) {
    const int nt = (int)__hip_atomic_load((gu32*)(a.ws + WS_TILES) + 127, RLX_AGENT), n1 = nt < 64 ? nt : 64;
    moe_up_units(F, a, 0, n1, F.G, (int)blockIdx.x);
}
DI void ph_moe_b(const Frame& F, const Args& a) {
    const int nt = (int)__hip_atomic_load((gu32*)(a.ws + WS_TILES) + 127, RLX_AGENT), n1 = nt < 64 ? nt : 64; const int c = (int)blockIdx.x;
    int nu = 4 * (nt - n1); if (nu > F.G / 2) nu = F.G / 2;
    if (c < nu) moe_up_units(F, a, n1, nt - n1, nu, c); else moe_down_units(F, a, 0, n1, F.G - nu, c - nu);
}
DI void ph_moe_c(const Frame& F, const Args& a) {
    const int nt = (int)__hip_atomic_load((gu32*)(a.ws + WS_TILES) + 127, RLX_AGENT), n1 = nt < 64 ? nt : 64;
    moe_down_units(F, a, n1, nt - n1, F.G, (int)blockIdx.x);
}

DI void gemm_tail16(const Frame& F, const Args& a, const bf16* A, int lda, const bf16* Wt, int K, int mode) {
    if (F.vcu >= 128) return;
    const int lane = F.lane, lc = lane & 15, quad = lane >> 4, w = F.vcu; LAS float* red = (LAS float*)(F.lds + RING_OFF);
    f32x4 acc = (f32x4){0.f, 0.f, 0.f, 0.f}; const int kw = K / NWAVES, kb = F.wave * kw;
    const bf16* ap = A + (size_t)(TX + lc) * lda + kb + 8 * quad; const bf16* bp = Wt + (size_t)(16 * w + lc) * K + kb + 8 * quad;
#pragma unroll 4
    for (int ks = 0; ks < kw / 32; ++ks) acc = __builtin_amdgcn_mfma_f32_16x16x32_bf16(*(const bf16x8*)(ap + 32 * ks), *(const bf16x8*)(bp + 32 * ks), acc, 0, 0, 0);
    *(LAS f32x4*)(red + (F.wave * 64 + lane) * 4) = acc;
    __syncthreads();
    if (F.wave == 0) { f32x4 s = *(const LAS f32x4*)(red + lane * 4);
#pragma unroll
        for (int v = 1; v < NWAVES; ++v) s = s + *(const LAS f32x4*)(red + (v * 64 + lane) * 4);
        float* H = (float*)(a.ws + WS_H);
#pragma unroll
        for (int r = 0; r < 4; ++r) { const int row = 4 * quad + r, col = 16 * w + lc; const float base = mode ? H[(size_t)(TX + row) * DM + col] : a.in[1][(size_t)row * DM + col];
            H[(size_t)(TX + row) * DM + col] = base + s[r]; } }
    __syncthreads();
}

__global__ void __launch_bounds__(NWAVES * 64, 2) hyb_fwd(Args a) {
    extern __shared__ __attribute__((aligned(16))) unsigned char lds[];
    Frame F;
    F.lds = (LAS unsigned char*)lds;
    F.MISC = (volatile LAS unsigned*)(F.lds + MISC_OFF);
    F.tid = threadIdx.x; F.lane = F.tid & 63; F.wave = __builtin_amdgcn_readfirstlane(F.tid >> 6);
    F.G = gridDim.x; { const int bx = blockIdx.x; F.vcu = (F.G % 8 == 0) ? (bx % 8) * (F.G / 8) + bx / 8 : bx; }
    F.gw = F.vcu * NWAVES + F.wave; F.NGW = F.G * NWAVES;
    F.ctl = (gu32*)(a.ws + WS_CTL);
    for (int u = F.tid; u < (LDS_BYTES - LDSCTL_OFF) / 4; u += NWAVES * 64) ((LAS unsigned*)(F.lds + LDSCTL_OFF))[u] = 0u;
    __syncthreads();
    XcdBarrier bar; bar.bar = (unsigned*)(F.ctl + CW_BAR); bar.x = 0; bar.st = nullptr;
    if (MK_ONE_LAUNCH) bar = xcd_barrier_post((unsigned*)(F.ctl + CW_BAR), F.MISC + 8);
    const int lo = a.ph_lo, hi = a.ph_hi;
#ifndef PH_MASK
#define PH_MASK 0xFFFFFFFFFFFFFFFFull
#endif
#define IN(k) ((((unsigned long long)(PH_MASK) >> (k)) & 1ull) && lo <= (k) && (k) < hi)
#ifndef PROBE_REP
#define PROBE_REP 0u
#endif
#define REP(k) ((((unsigned long long)(PROBE_REP) >> (k)) & 1ull) ? 2 : 1)
#ifdef PROBE_TS
#define STAMP(k) do { if (blockIdx.x == 0 && F.tid == 0) ((unsigned long long*)(F.ctl + CW_TS))[(k)] = __builtin_amdgcn_s_memrealtime(); } while (0)
#else
#define STAMP(k) do { } while (0)
#endif
#define PHASE(k, ...) do { if (IN(k)) { { const int PH_REP_ = 0; (void)PH_REP_; __VA_ARGS__; } if (REP(k) == 2) { __syncthreads(); { const int PH_REP_ = 1; (void)PH_REP_; __VA_ARGS__; } } } } while (0)
#define SEAM(k) do { if (IN(k) && IN((k) + 1)) xcd_barrier(bar); STAMP((k) + 1); } while (0)
    const bf16* HN = (const bf16*)(a.ws + WS_HN); bf16* PROJ = (bf16*)(a.ws + WS_PROJ); const bf16* YMIX = (const bf16*)(a.ws + WS_YMIX); float* H = (float*)(a.ws + WS_H);

    STAMP(0);
    PHASE(0, { ph_prologue(F, a); ph_aux_convert(F, a, F.gw, F.NGW); });
    SEAM(0);
    PHASE(1, { pg8::Gemm g{HN, (const bf16*)(a.ws + WS_WEVIN), DM, DM, DM}; pg8::StaticOrder S; S.init(MP, EV_NP, F.G, (int)blockIdx.x); pg8::EpiBf16 E{PROJ, EV_NP}; run_gemm(F, g, S, E); });
    SEAM(1);
    PHASE(2, ph_even_prep(F, a););
    SEAM(2);
    PHASE(3, {
        { pg8::Gemm g{(const bf16*)(a.ws + WS_SCR + SC_ALORA), (const bf16*)(a.ws + WS_WLORA), 384, 384, 384}; pg8::StaticOrder S; S.init(MP, 3072, F.G, (int)blockIdx.x);
          static_assert(SC_ICL - SC_DEC == SC_GATE - SC_ICL, "lora outputs equally spaced");
          pg8::EpiLora E{(bf16*)(a.ws + WS_SCR + SC_DEC), (long)((SC_ICL - SC_DEC) / 2), a.in[7], a.in[9]}; run_gemm(F, g, S, E); }
        { pg8::Gemm g{(const bf16*)(a.ws + WS_SCR + SC_XR), (const bf16*)(a.ws + WS_WGATE), 256, 1024, 256}; pg8::StaticOrder S; S.init(MP, 2048, F.G, (int)blockIdx.x); S.amod = 4; S.astep = 512;
          pg8::EpiGates E{(bf16*)(a.ws + WS_SCR + SC_LA), (bf16*)(a.ws + WS_SCR + SC_LIX), a.in[20], a.in[22], a.in[23], (const bf16*)(a.ws + WS_SCR + SC_XR)}; run_gemm(F, g, S, E); }
    });
    SEAM(3);
    PHASE(4, ph_rwkv_chunk(F, a, 0, 32, 0););
    SEAM(4);
    PHASE(5, { if (F.vcu < 16) ph_rwkv_chain(F, a, 0, 64); else ph_rwkv_chunk(F, a, 32, 62, 16); });
    SEAM(5);
#if defined(PROBE_X) && PROBE_X == 1
    PHASE(6, { if (F.vcu < 16) { ph_rwkv_chain(F, a, 64, 124); __syncthreads(); ph_rwkv_chain(F, a, 64, 124); } else ph_rwkv_chunk(F, a, 62, 92, 16); });
#elif defined(PROBE_X) && PROBE_X == 2
    PHASE(6, { if (F.vcu < 16) ph_rwkv_chain(F, a, 64, 124); else { ph_rwkv_chunk(F, a, 62, 92, 16); __syncthreads(); ph_rwkv_chunk(F, a, 62, 92, 16); } });
#else
    PHASE(6, { if (F.vcu < 16) ph_rwkv_chain(F, a, 64, 124); else ph_rwkv_chunk(F, a, 62, 92, 16); });
#endif
    SEAM(6);
    PHASE(7, { if (F.vcu < 16) ph_rwkv_chain(F, a, 124, 184); else ph_rwkv_chunk(F, a, 92, 122, 16); });
    SEAM(7);
    PHASE(8, { if (F.vcu < 16) ph_rwkv_chain(F, a, 184, 244); else { ph_rwkv_chunk(F, a, 122, 129, 16); lru_local(F, a, (F.vcu - 16) * NWAVES + F.wave, (F.G - 16) * NWAVES); } });
    SEAM(8);
#if defined(PROBE_X) && PROBE_X == 3
    PHASE(9, { if (F.vcu < 18) { ph_rwkv_chain(F, a, 244, RW_NSC); if (F.vcu >= 16) { __syncthreads(); ph_rwkv_chain(F, a, 244, RW_NSC); } } else ph_rwkv_out(F, a, 0, 244, (F.vcu - 18) * NWAVES + F.wave, (F.G - 18) * NWAVES); });
#elif defined(PROBE_X) && PROBE_X == 5
    PHASE(9, { if (F.vcu < 18) ph_rwkv_chain(F, a, 244, RW_NSC); else { ph_rwkv_out(F, a, 0, 244, (F.vcu - 18) * NWAVES + F.wave, (F.G - 18) * NWAVES); __syncthreads(); ph_rwkv_out(F, a, 0, 244, (F.vcu - 18) * NWAVES + F.wave, (F.G - 18) * NWAVES); } });
#else
    PHASE(9, { if (F.vcu < 32) ph_rwkv_chain(F, a, 244, RW_NSC); else ph_rwkv_out(F, a, 0, 244, (F.vcu - 32) * NWAVES + F.wave, (F.G - 32) * NWAVES); });
#endif
    SEAM(9);
#if defined(PROBE_X) && PROBE_X == 4
    PHASE(10, { ph_rwkv_out(F, a, 244, RW_NSC, F.gw, F.NGW); lru_apply(F, a); __syncthreads(); lru_apply(F, a); });
#else
    PHASE(10, { ph_rwkv_out(F, a, 244, RW_NSC, F.gw, F.NGW); lru_apply(F, a); });
#endif
    SEAM(10);
    PHASE(11, { pg8::Gemm g{YMIX, (const bf16*)(a.ws + WS_WEVOUT), DM, DM, DM}; pg8::StaticOrder S; S.init(TX, DM, F.G, (int)blockIdx.x); pg8::EpiResid E{H, a.in[0], a.in[1], 0}; run_gemm(F, g, S, E); gemm_tail16(F, a, YMIX, DM, (const bf16*)(a.ws + WS_WEVOUT), DM, 0); });
    SEAM(11);
    PHASE(12, ph_route(F, a, 0, PH_REP_););
    SEAM(12);
    PHASE(13, ph_gather(F, a, 0););
    SEAM(13);
    PHASE(14, ph_moe_a(F, a););
    SEAM(14);
    PHASE(15, ph_moe_b(F, a););
    SEAM(15);
    PHASE(16, ph_moe_c(F, a););
    SEAM(16);
    PHASE(17, ph_combine(F, a, 0););
    SEAM(17);
    PHASE(18, { pg8::Gemm g{HN, (const bf16*)(a.ws + WS_WODIN), DM, DM, DM}; pg8::StaticOrder S; S.init(MP, OD_NP, F.G, (int)blockIdx.x); pg8::EpiBf16 E{PROJ, OD_NP}; run_gemm(F, g, S, E); });
    SEAM(18);
    PHASE(19, ph_odd_prep(F, a););
    SEAM(19);
    PHASE(20, ph_gdn_chunk(F, a, 0, 54, 0););
    SEAM(20);
    PHASE(21, { ph_gdn_chain(F, a, 0, 54); ph_gdn_chunk(F, a, 54, 90, 1); });
    SEAM(21);
#if defined(PROBE_X) && PROBE_X == 3
    PHASE(22, { ph_gdn_chain(F, a, 54, 90); __syncthreads(); ph_gdn_chain(F, a, 54, 90); ph_gdn_chunk(F, a, 90, 114, 1); });
#elif defined(PROBE_X) && PROBE_X == 4
    PHASE(22, { ph_gdn_chain(F, a, 54, 90); ph_gdn_chunk(F, a, 90, 114, 1); __syncthreads(); ph_gdn_chunk(F, a, 90, 114, 1); });
#else
    PHASE(22, { ph_gdn_chain(F, a, 54, 90); ph_gdn_chunk(F, a, 90, 114, 1); });
#endif
    SEAM(22);
    PHASE(23, { ph_gdn_chain(F, a, 90, 114); ph_gdn_chunk(F, a, 114, 129, 1); });
    SEAM(23);
    PHASE(24, { ph_gdn_chain(F, a, 114, 129); ph_odd_post(F, a, 0); });
    SEAM(24);
    PHASE(25, { ph_odd_post(F, a, F.G == 256 ? 1 : 2); moe_convert(F, a, 1, F.gw, F.NGW); });
    SEAM(25);
    PHASE(26, { pg8::Gemm g{YMIX, (const bf16*)(a.ws + WS_WODOUT), 4096, 4096, 4096}; pg8::StaticOrder S; S.init(TX, DM, F.G, (int)blockIdx.x); pg8::EpiResid E{H, a.in[0], a.in[1], 1}; run_gemm(F, g, S, E); gemm_tail16(F, a, YMIX, 4096, (const bf16*)(a.ws + WS_WODOUT), 4096, 1); });
    SEAM(26);
    PHASE(27, ph_route(F, a, 1, PH_REP_););
    SEAM(27);
    PHASE(28, ph_gather(F, a, 1););
    SEAM(28);
    PHASE(29, ph_moe_a(F, a););
    SEAM(29);
    PHASE(30, ph_moe_b(F, a););
    SEAM(30);
    PHASE(31, ph_moe_c(F, a););
    SEAM(31);
    PHASE(32, ph_combine(F, a, 1););
#ifdef PROBE_BARS
    for (int i_ = 0; i_ < PROBE_BARS; ++i_) xcd_barrier(bar);
#endif
#undef IN
#undef SEAM
}

extern "C" void kernel_launch(void* const* d_in, const int* in_sizes, int n_in, void* d_out, int out_size, void* d_ws, size_t ws_size, hipStream_t stream) {
    static int grid = 0;
    if (grid == 0) {
        if (n_in != 36 || out_size != TX * DM || ws_size < WS_END) { fprintf(stderr, "kernel_launch: unexpected shapes (n_in %d, out %d, ws %zu)\n", n_in, out_size, ws_size); grid = -1; return; }
        int dev = 0, cus = 0, per_cu = 0;
        if (hipGetDevice(&dev) != hipSuccess || hipDeviceGetAttribute(&cus, hipDeviceAttributeMultiprocessorCount, dev) != hipSuccess) { grid = -1; return; }
        if (hipFuncSetAttribute((const void*)hyb_fwd, hipFuncAttributeMaxDynamicSharedMemorySize, LDS_BYTES) != hipSuccess) { fprintf(stderr, "kernel_launch: hipFuncSetAttribute failed\n"); grid = -1; return; }
        if (hipOccupancyMaxActiveBlocksPerMultiprocessor(&per_cu, (const void*)hyb_fwd, NWAVES * 64, LDS_BYTES) != hipSuccess || per_cu < 1) { fprintf(stderr, "kernel_launch: occupancy query says %d\n", per_cu); per_cu = 1; }
        (void)hipGetLastError();
        grid = cus;
    }
    if (grid < 0) return;
    if (hipMemsetAsync((char*)d_ws + WS_CTL, 0, CTL_ZERO_BYTES, stream) != hipSuccess) return;
    Args a{};
    for (int i = 0; i < 36; ++i) a.in[i] = (const float*)d_in[i];
    a.out = (float*)d_out; a.ws = (unsigned char*)d_ws;
#if MK_ONE_LAUNCH
    a.ph_lo = 0; a.ph_hi = N_PHASES;
    hipLaunchKernelGGL(hyb_fwd, dim3(grid), dim3(NWAVES * 64), LDS_BYTES, stream, a);
#else
    for (int p = 0; p < N_PHASES; ++p) { a.ph_lo = p; a.ph_hi = p + 1; hipLaunchKernelGGL(hyb_fwd, dim3(grid), dim3(NWAVES * 64), LDS_BYTES, stream, a); }
#endif
}
```

```cpp
#include <hip/hip_runtime.h>
#include <cstdio>
#include <cstdint>
#include <cmath>

#ifndef MK_ONE_LAUNCH
#define MK_ONE_LAUNCH 1
#endif

namespace pg8 {
#define PG8_LAS __attribute__((address_space(3)))
typedef unsigned short bf16_t;
typedef short bf16x8 __attribute__((ext_vector_type(8)));
typedef float f32x4 __attribute__((ext_vector_type(4)));
typedef unsigned u32x4 __attribute__((ext_vector_type(4)));
typedef unsigned u32x2 __attribute__((ext_vector_type(2)));
constexpr int BM = 256, BK = 64, HALF = 128, HTB = HALF * BK * 2  , STAGE_BYTES = 8 * HTB, NXCD = 8, WGM = 8;

__host__ __device__ __forceinline__ int lds_byte(int r, int c) { const int st = (r >> 4) * 2 + (c >> 5), rr = r & 15, cc = c & 31, ob = rr * 64 + cc * 2; return st * 1024 + (ob ^ (((ob >> 9) & 1) << 5)); }
__host__ __device__ __forceinline__ void stage_rc(int b, int& R, int& C) { const int st = b / 1024, sb = b % 1024, swz = sb ^ (((sb >> 9) & 1) << 5); R = (st >> 1) * 16 + swz / 64; C = (st & 1) * 32 + (swz % 64) / 2; }
__host__ __device__ __forceinline__ int perm32(int rho) { const int n = rho >> 4, i = rho & 15; return 8 * (i >> 2) + 4 * n + (i & 3); }

struct Unit { int pm, pn; long aoff, boff; };
struct Gemm { const bf16_t* A; const bf16_t* Bt; int K, lda, ldb; };

struct StaticOrder {
    int nM, nN, nwg, G, c, amod; long astep;
    __host__ __device__ void init(int M, int N, int G_, int c_) { nM = M / BM; nN = N / BM; nwg = nM * nN; G = G_; c = c_; amod = 0; astep = 0; }
    __host__ __device__ bool next(int i, Unit& u) const {
        const long L = (long)i * G + c; if (L >= nwg) return false;
        int wgid = (int)L; { const int q = nwg / NXCD, r = nwg % NXCD, xcd = wgid % NXCD, off = wgid / NXCD; wgid = (xcd < r ? xcd * (q + 1) : r * (q + 1) + (xcd - r) * q) + off; }
        const int nig = WGM * nN, gid = wgid / nig, fm = gid * WGM, gsz = (nM - fm) < WGM ? (nM - fm) : WGM;
        u.pm = fm + ((wgid % nig) % gsz); u.pn = (wgid % nig) / gsz; u.boff = 0; u.aoff = amod ? (long)(u.pn % amod) * astep : 0; return true;
    }
    __device__ __forceinline__ void a_ready(const Unit&) const {}
    __device__ __forceinline__ void done(const Unit&) const {}
};
struct MoeOrder {
    const int* tile_e; int t0, ntiles, npn, G, c; long bstride;
    __device__ __forceinline__ bool next(int i, Unit& u) const {
        const long L = (long)i * G + c; if (c < 0 || L >= (long)ntiles * npn) return false;
        const int t = t0 + (int)(L / npn); u.pm = t; u.pn = (int)(L % npn); u.aoff = 0; u.boff = (long)tile_e[t] * bstride; return true;
    }
    __device__ __forceinline__ void a_ready(const Unit&) const {}
    __device__ __forceinline__ void done(const Unit&) const {}
};

struct MoeUpOrder {
    const int* tile_e; int t0, ntiles, G, c; long bstride; unsigned* done_cnt;
    __device__ __forceinline__ bool next(int i, Unit& u) const {
        const int L = i * G + c; if (L >= ntiles * 4) return false;
        const int t = t0 + (L >> 2); u.pm = t; u.pn = L & 3; u.aoff = 0; u.boff = (long)tile_e[t] * bstride; return true;
    }
    __device__ __forceinline__ void a_ready(const Unit&) const {}
    __device__ __forceinline__ void done(const Unit& u) const {
        __syncthreads();
        if (threadIdx.x == 0) { __builtin_amdgcn_fence(__ATOMIC_RELEASE, "agent"); __hip_atomic_fetch_add(done_cnt + u.pm * 16, 8u, __ATOMIC_RELAXED, __HIP_MEMORY_SCOPE_AGENT); }
    }
};
struct MoeDownOrder {
    const int* tile_e; int t0, ntiles, G, c; long bstride; const unsigned* done_cnt;
    __device__ __forceinline__ bool next(int i, Unit& u) const {
        const int nup = ntiles * 4, ndn = ntiles * 8, r = nup % G, ns = G - r;
        int compN = r ? 3 * ns : 0; if (compN > ndn) compN = ndn;
        int ncomp = 0;
        if (r && c >= r) { for (int j = 0; j < 3; ++j) if (j * ns + (c - r) < compN) ++ncomp; }
        int d;
        if (i < ncomp) d = i * ns + (c - r); else { d = compN + (i - ncomp) * G + c; if (d >= ndn) return false; }
        const int t = t0 + (d >> 3); u.pm = t; u.pn = d & 7; u.aoff = 0; u.boff = (long)tile_e[t] * bstride; return true;
    }
    __device__ __forceinline__ void a_ready(const Unit& u) const {
        while (__hip_atomic_load(done_cnt + u.pm * 16, __ATOMIC_RELAXED, __HIP_MEMORY_SCOPE_AGENT) < 32u) __builtin_amdgcn_s_sleep(1);
        asm volatile("" ::: "memory");
    }
    __device__ __forceinline__ void done(const Unit&) const {}
};

__device__ __forceinline__ unsigned cvt_pk_bf16(float lo, float hi) { unsigned r; asm volatile("v_cvt_pk_bf16_f32 %0, %1, %2" : "=v"(r) : "v"(lo), "v"(hi)); return r; }
__device__ __forceinline__ float bf_lo(unsigned w) { return __uint_as_float(w << 16); }
__device__ __forceinline__ float bf_hi(unsigned w) { return __uint_as_float(w & 0xffff0000u); }
__device__ __forceinline__ float sigmoidf_(float x) { return __builtin_amdgcn_rcpf(1.0f + __expf(-x)); }
__device__ __forceinline__ float softplusf_(float x) { return fmaxf(x, 0.f) + __logf(1.0f + __expf(-fabsf(x))); }

struct EpiBf16 {
    static constexpr bool PERM = true, AFTER_DRAIN = false;
    bf16_t* O; int ldc;
    __device__ __forceinline__ void operator()(const f32x4 (&acc)[2][2][4][2], const Unit& u, int wr, int wc, int fr, int fq) const {
        const int row0 = u.pm * BM + wr * 64 + fr; const int col0 = u.pn * BM + wc * 32 + 8 * fq;
#pragma unroll
        for (int ai = 0; ai < 2; ++ai)
#pragma unroll
            for (int m = 0; m < 4; ++m) { bf16_t* rowp = O + (size_t)(row0 + ai * HALF + m * 16) * ldc + col0;
#pragma unroll
                for (int bj = 0; bj < 2; ++bj) { const f32x4 v0 = acc[ai][bj][m][0], v1 = acc[ai][bj][m][1];
                    u32x4 w; w.x = cvt_pk_bf16(v0[0], v0[1]); w.y = cvt_pk_bf16(v0[2], v0[3]); w.z = cvt_pk_bf16(v1[0], v1[1]); w.w = cvt_pk_bf16(v1[2], v1[3]);
                    *(u32x4*)(rowp + bj * HALF) = w; } }
    }
};
struct EpiSwiglu {
    static constexpr bool PERM = true, AFTER_DRAIN = false;
    bf16_t* O; int ldc;
    __device__ __forceinline__ void operator()(const f32x4 (&acc)[2][2][4][2], const Unit& u, int wr, int wc, int fr, int fq) const {
        const int row0 = u.pm * BM + wr * 64 + fr; const int col0 = u.pn * HALF + wc * 32 + 8 * fq;
#pragma unroll
        for (int ai = 0; ai < 2; ++ai)
#pragma unroll
            for (int m = 0; m < 4; ++m) { bf16_t* rowp = O + (size_t)(row0 + ai * HALF + m * 16) * ldc + col0;
                float o[8];
#pragma unroll
                for (int n = 0; n < 2; ++n)
#pragma unroll
                    for (int j = 0; j < 4; ++j) { const float gq = acc[ai][0][m][n][j], uq = acc[ai][1][m][n][j]; o[4 * n + j] = gq * sigmoidf_(gq) * uq; }
                u32x4 w; w.x = cvt_pk_bf16(o[0], o[1]); w.y = cvt_pk_bf16(o[2], o[3]); w.z = cvt_pk_bf16(o[4], o[5]); w.w = cvt_pk_bf16(o[6], o[7]);
                *(u32x4*)rowp = w; }
    }
};
struct EpiResid {
    static constexpr bool PERM = false, AFTER_DRAIN = false;
    float* out; const float* x; const float* meta; int mode;
    __device__ __forceinline__ void operator()(const f32x4 (&acc)[2][2][4][2], const Unit& u, int wr, int wc, int fr, int fq) const {
        const int row0 = u.pm * BM + wr * 64 + fr, col0 = u.pn * BM + wc * 32 + 4 * fq;
#pragma unroll
        for (int ai = 0; ai < 2; ++ai)
#pragma unroll
            for (int m = 0; m < 4; ++m) { const int row = row0 + ai * HALF + m * 16; float* rowp = out + (size_t)row * 2048 + col0;
                const float* bp = mode ? rowp : (row < 8192 ? x + (size_t)row * 2048 + col0 : (row < 8208 ? meta + (size_t)(row - 8192) * 2048 + col0 : nullptr));
#pragma unroll
                for (int bj = 0; bj < 2; ++bj)
#pragma unroll
                    for (int n = 0; n < 2; ++n) { f32x4 b = (f32x4){0.f, 0.f, 0.f, 0.f}; if (bp) b = *(const f32x4*)(bp + bj * HALF + n * 16);
                        *(f32x4*)(rowp + bj * HALF + n * 16) = acc[ai][bj][m][n] + b; } }
    }
};
__device__ __forceinline__ float one_minus_exp_neg(float e) { return e < 0.05f ? e * (1.0f - e * (0.5f - e * (1.0f / 6.0f))) : 1.0f - __expf(-e); }
struct EpiLora {
    static constexpr bool PERM = false, AFTER_DRAIN = false;
    bf16_t* base; long gstride; const float* w0; const float* a0;
    __device__ __forceinline__ void operator()(const f32x4 (&acc)[2][2][4][2], const Unit& u, int wr, int wc, int fr, int fq) const {
        const int grp = u.pn >> 2; const int row0 = u.pm * BM + wr * 64 + fr, col0 = (u.pn & 3) * BM + wc * 32 + 4 * fq;
        bf16_t* O = base + (size_t)grp * gstride;
#pragma unroll
        for (int bj = 0; bj < 2; ++bj)
#pragma unroll
            for (int n = 0; n < 2; ++n) { const int c = col0 + bj * HALF + n * 16;
                f32x4 bv = (f32x4){0.f, 0.f, 0.f, 0.f}; if (grp == 0) bv = *(const f32x4*)(w0 + c); else if (grp == 1) bv = *(const f32x4*)(a0 + c);
#pragma unroll
                for (int ai = 0; ai < 2; ++ai)
#pragma unroll
                    for (int m = 0; m < 4; ++m) { f32x4 v = acc[ai][bj][m][n] + bv;
                        if (grp == 0) {
#pragma unroll
                            for (int j = 0; j < 4; ++j) { const float wl = -softplusf_(-v[j]) - 0.5f; v[j] = one_minus_exp_neg(__expf(wl)); }
                        } else if (grp == 1) {
#pragma unroll
                            for (int j = 0; j < 4; ++j) v[j] = sigmoidf_(v[j]);
                        }
                        u32x2 w; w.x = cvt_pk_bf16(v[0], v[1]); w.y = cvt_pk_bf16(v[2], v[3]);
                        *(u32x2*)(O + (size_t)(row0 + ai * HALF + m * 16) * 1024 + c) = w; } }
    }
};
struct EpiGates {
    static constexpr bool PERM = false, AFTER_DRAIN = false;
    bf16_t* lru_a; bf16_t* lru_ix; const float* ba; const float* bx; const float* lam; const bf16_t* xr;
    __device__ __forceinline__ void operator()(const f32x4 (&acc)[2][2][4][2], const Unit& u, int wr, int wc, int fr, int fq) const {
        const int grp = u.pn >> 2; const int row0 = u.pm * BM + wr * 64 + fr, col0 = (u.pn & 3) * BM + wc * 32 + 4 * fq;
#pragma unroll
        for (int bj = 0; bj < 2; ++bj)
#pragma unroll
            for (int n = 0; n < 2; ++n) { const int c = col0 + bj * HALF + n * 16;
                const f32x4 bv = *(const f32x4*)((grp == 0 ? ba : bx) + c); f32x4 sp = (f32x4){0.f, 0.f, 0.f, 0.f};
                if (grp == 0) { const f32x4 l = *(const f32x4*)(lam + c);
#pragma unroll
                    for (int j = 0; j < 4; ++j) sp[j] = 8.0f * softplusf_(-l[j]); }
#pragma unroll
                for (int ai = 0; ai < 2; ++ai)
#pragma unroll
                    for (int m = 0; m < 4; ++m) { const int row = row0 + ai * HALF + m * 16; f32x4 v = acc[ai][bj][m][n] + bv; u32x2 w;
                        if (grp == 0) {
#pragma unroll
                            for (int j = 0; j < 4; ++j) v[j] = one_minus_exp_neg(sigmoidf_(v[j]) * sp[j]);
                            w.x = cvt_pk_bf16(v[0], v[1]); w.y = cvt_pk_bf16(v[2], v[3]); *(u32x2*)(lru_a + (size_t)row * 1024 + c) = w;
                        } else { const u32x2 xw = *(const u32x2*)(xr + (size_t)row * 1024 + c);
                            v[0] = sigmoidf_(v[0]) * bf_lo(xw.x); v[1] = sigmoidf_(v[1]) * bf_hi(xw.x); v[2] = sigmoidf_(v[2]) * bf_lo(xw.y); v[3] = sigmoidf_(v[3]) * bf_hi(xw.y);
                            w.x = cvt_pk_bf16(v[0], v[1]); w.y = cvt_pk_bf16(v[2], v[3]); *(u32x2*)(lru_ix + (size_t)row * 1024 + c) = w; } } }
    }
};

template <class Epi, class Sched, bool ALIGN_EPI = false, bool SP2 = false>
__device__ __forceinline__ void gemm_phase(PG8_LAS unsigned char* lds, const Gemm g, const Sched& S, const Epi& E) {
    const int tid = threadIdx.x, wid = __builtin_amdgcn_readfirstlane(tid >> 6), lane = tid & 63, wr = wid >> 2, wc = wid & 3, fr = lane & 15, fq = lane >> 4;
    const int K = g.K, nt = K / BK;
    unsigned voffA[2], voffB[2];
#pragma unroll
    for (int i = 0; i < 2; ++i) { int R, C; stage_rc(tid * 16 + i * 8192, R, C); const int Rb = Epi::PERM ? ((R & ~31) + perm32(R & 31)) : R;
        voffA[i] = (unsigned)(R * g.lda + C) * 2u; voffB[i] = (unsigned)(Rb * g.ldb + C) * 2u; }
    const size_t kstep = (size_t)(BK * 2);
    const size_t hstepA = (size_t)HALF * g.lda * 2, hstepB = (size_t)HALF * g.ldb * 2;
    const size_t tstepA = 2 * hstepA, tstepB = 2 * hstepB;
    const unsigned ldsw = (unsigned)wid * 1024u;
    const int aoff = lds_byte(wr * 64 + fr, fq * 8), boff = lds_byte(wc * 32 + fr, fq * 8);
#define PG8_SA(b, h) (((b) * 2 + (h)) * HTB)
#define PG8_SB(b, h) ((4 + (b) * 2 + (h)) * HTB)
#define PG8_STAGE(bufoff, gbase, voff) do { _Pragma("unroll") for (int _i = 0; _i < 2; ++_i) \
        __builtin_amdgcn_global_load_lds((const unsigned*)((const char*)(gbase) + (voff)[_i]), (PG8_LAS unsigned*)(lds + (bufoff) + ldsw + _i * 8192), 16, 0, 0); } while (0)
#define PG8_LDA(dst, b, h) do { _Pragma("unroll") for (int m = 0; m < 4; ++m) _Pragma("unroll") for (int k = 0; k < 2; ++k) dst[m][k] = *(const PG8_LAS bf16x8*)(lds + PG8_SA(b, h) + aoff + m * 2048 + k * 1024); } while (0)
#define PG8_LDB(dst, b, h) do { _Pragma("unroll") for (int n = 0; n < 2; ++n) _Pragma("unroll") for (int k = 0; k < 2; ++k) dst[n][k] = *(const PG8_LAS bf16x8*)(lds + PG8_SB(b, h) + boff + n * 2048 + k * 1024); } while (0)
#define PG8_MMA(ai, bj, At, Bt) do { __builtin_amdgcn_s_setprio(1); _Pragma("unroll") for (int m = 0; m < 4; ++m) _Pragma("unroll") for (int n = 0; n < 2; ++n) _Pragma("unroll") for (int k = 0; k < 2; ++k) \
        acc[ai][bj][m][n] = __builtin_amdgcn_mfma_f32_16x16x32_bf16(Bt[n][k], At[m][k], acc[ai][bj][m][n], 0, 0, 0); __builtin_amdgcn_s_setprio(0); } while (0)
#define PG8_WAIT_V(n) asm volatile("s_waitcnt vmcnt(" #n ")" ::: "memory")
#define PG8_WAIT_L(n) asm volatile("s_waitcnt lgkmcnt(" #n ")" ::: "memory")
#define PG8_BAR __builtin_amdgcn_s_barrier()
#define PG8_SCHED __builtin_amdgcn_sched_barrier(0)
    Unit cur, nxt; int ui = 0;
    if (!S.next(0, cur)) return;
    f32x4 acc[2][2][4][2];
#pragma unroll
    for (int a = 0; a < 2; ++a)
#pragma unroll
        for (int b = 0; b < 2; ++b)
#pragma unroll
            for (int m = 0; m < 4; ++m)
#pragma unroll
                for (int n = 0; n < 2; ++n) acc[a][b][m][n] = (f32x4){0.f, 0.f, 0.f, 0.f};
    bf16x8 At[4][2], B0[2][2], B1[2][2];
    const char* cA = (const char*)g.A + (size_t)cur.pm * tstepA + cur.aoff; const char* cB = (const char*)g.Bt + (size_t)cur.pn * tstepB + cur.boff;
    S.a_ready(cur);
    if constexpr (SP2) {
        PG8_STAGE(PG8_SB(0, 0), cB, voffB); PG8_STAGE(PG8_SB(0, 1), cB + hstepB, voffB); PG8_STAGE(PG8_SA(0, 0), cA, voffA); PG8_STAGE(PG8_SA(0, 1), cA + hstepA, voffA);
        if (wr == 1) PG8_BAR;
        PG8_WAIT_V(2); PG8_BAR;
        PG8_STAGE(PG8_SB(1, 0), cB + kstep, voffB); PG8_STAGE(PG8_SA(1, 0), cA + kstep, voffA); PG8_STAGE(PG8_SB(1, 1), cB + hstepB + kstep, voffB);
        PG8_WAIT_V(6); PG8_BAR;
    } else {
        PG8_STAGE(PG8_SB(0, 0), cB, voffB); PG8_STAGE(PG8_SA(0, 0), cA, voffA); PG8_STAGE(PG8_SB(0, 1), cB + hstepB, voffB); PG8_STAGE(PG8_SA(0, 1), cA + hstepA, voffA);
        if (wr == 1) PG8_BAR;
        PG8_WAIT_V(4); PG8_BAR;
        PG8_STAGE(PG8_SB(1, 0), cB + kstep, voffB); PG8_STAGE(PG8_SA(1, 0), cA + kstep, voffA); PG8_STAGE(PG8_SB(1, 1), cB + hstepB + kstep, voffB);
        PG8_WAIT_V(6); PG8_BAR;
    }
    for (;;) {
        const bool has_next = S.next(ui + 1, nxt);
        const char* nA = has_next ? (const char*)g.A + (size_t)nxt.pm * tstepA + nxt.aoff : cA; const char* nB = has_next ? (const char*)g.Bt + (size_t)nxt.pn * tstepB + nxt.boff : cB;
        for (int t = 0; t < nt; t += 2) {
            const bool last = (t == nt - 2);
            const char* a1 = cA + (size_t)(t + 1) * kstep;
            const char* a2 = last ? nA : cA + (size_t)(t + 2) * kstep; const char* b2 = last ? nB : cB + (size_t)(t + 2) * kstep;
            const char* a3 = a2 + kstep; const char* b3 = b2 + kstep;
            if (last && has_next) S.a_ready(nxt);
            if constexpr (SP2) {
            PG8_LDB(B0, 0, 0); PG8_LDB(B1, 0, 1); PG8_SCHED; PG8_LDA(At, 0, 0); PG8_STAGE(PG8_SA(1, 1), a1 + hstepA, voffA);
            PG8_WAIT_V(8); PG8_WAIT_L(0); PG8_BAR; PG8_MMA(0, 0, At, B0); PG8_MMA(0, 1, At, B1); PG8_BAR; PG8_SCHED;
            PG8_LDA(At, 0, 1); PG8_STAGE(PG8_SB(0, 0), b2, voffB); PG8_STAGE(PG8_SB(0, 1), b2 + hstepB, voffB); PG8_STAGE(PG8_SA(0, 0), a2, voffA);
            PG8_WAIT_V(8); PG8_WAIT_L(0); PG8_BAR; PG8_MMA(1, 0, At, B0); PG8_MMA(1, 1, At, B1); PG8_BAR; PG8_SCHED;
            PG8_LDB(B0, 1, 0); PG8_LDB(B1, 1, 1); PG8_SCHED; PG8_LDA(At, 1, 0); PG8_STAGE(PG8_SA(0, 1), a2 + hstepA, voffA);
            PG8_WAIT_V(8); PG8_WAIT_L(0); PG8_BAR; PG8_MMA(0, 0, At, B0); PG8_MMA(0, 1, At, B1); PG8_BAR; PG8_SCHED;
            PG8_LDA(At, 1, 1); PG8_STAGE(PG8_SB(1, 0), b3, voffB); PG8_STAGE(PG8_SB(1, 1), b3 + hstepB, voffB); PG8_STAGE(PG8_SA(1, 0), a3, voffA);
            PG8_WAIT_V(8); PG8_WAIT_L(0); PG8_BAR; PG8_MMA(1, 0, At, B0); PG8_MMA(1, 1, At, B1); PG8_BAR; PG8_SCHED;
            } else {
            PG8_LDB(B0, 0, 0); PG8_SCHED; PG8_LDA(At, 0, 0); PG8_STAGE(PG8_SA(1, 1), a1 + hstepA, voffA);
            PG8_WAIT_L(8); PG8_BAR; PG8_WAIT_L(0); PG8_MMA(0, 0, At, B0); PG8_BAR; PG8_SCHED;
            PG8_LDB(B1, 0, 1); PG8_STAGE(PG8_SB(0, 0), b2, voffB);
            PG8_BAR; PG8_WAIT_L(0); PG8_MMA(0, 1, At, B1); PG8_BAR;
            PG8_LDA(At, 0, 1); PG8_STAGE(PG8_SA(0, 0), a2, voffA);
            PG8_BAR; PG8_WAIT_L(0); PG8_MMA(1, 0, At, B0); PG8_BAR; PG8_SCHED;
            PG8_STAGE(PG8_SB(0, 1), b2 + hstepB, voffB);
            PG8_WAIT_V(6); PG8_BAR; PG8_MMA(1, 1, At, B1); PG8_BAR;
            PG8_LDB(B0, 1, 0); PG8_SCHED; PG8_LDA(At, 1, 0); PG8_STAGE(PG8_SA(0, 1), a2 + hstepA, voffA);
            PG8_WAIT_L(8); PG8_BAR; PG8_WAIT_L(0); PG8_MMA(0, 0, At, B0); PG8_BAR; PG8_SCHED;
            PG8_LDB(B1, 1, 1); PG8_STAGE(PG8_SB(1, 0), b3, voffB);
            PG8_BAR; PG8_WAIT_L(0); PG8_MMA(0, 1, At, B1); PG8_BAR;
            PG8_LDA(At, 1, 1); PG8_STAGE(PG8_SA(1, 0), a3, voffA);
            PG8_BAR; PG8_WAIT_L(0); PG8_MMA(1, 0, At, B0); PG8_BAR; PG8_SCHED;
            PG8_STAGE(PG8_SB(1, 1), b3 + hstepB, voffB);
            PG8_WAIT_V(6); PG8_BAR; PG8_MMA(1, 1, At, B1); PG8_BAR;
            }
        }
        if constexpr (ALIGN_EPI) { if (wr == 0) PG8_BAR; }
        if constexpr (!Epi::AFTER_DRAIN) { E(acc, cur, wr, wc, fr, fq); S.done(cur); }
        if (!has_next) break;
#pragma unroll
        for (int a = 0; a < 2; ++a)
#pragma unroll
            for (int b = 0; b < 2; ++b)
#pragma unroll
                for (int m = 0; m < 4; ++m)
#pragma unroll
                    for (int n = 0; n < 2; ++n) acc[a][b][m][n] = (f32x4){0.f, 0.f, 0.f, 0.f};
        cur = nxt; cA = nA; cB = nB; ++ui;
        if constexpr (ALIGN_EPI) { if (wr == 1) PG8_BAR; }
    }
    PG8_WAIT_V(0);
    if constexpr (!ALIGN_EPI) { if (wr == 0) PG8_BAR; }
    PG8_BAR;
    if constexpr (Epi::AFTER_DRAIN) { E.fused(acc, cur, wr, wc, fr, fq, lds, wid, lane); S.done(cur); }
#undef PG8_SA
#undef PG8_SB
#undef PG8_STAGE
#undef PG8_LDA
#undef PG8_LDB
#undef PG8_MMA
#undef PG8_WAIT_V
#undef PG8_WAIT_L
#undef PG8_BAR
#undef PG8_SCHED
}
}
#define GAS __attribute__((address_space(1)))
#define LAS __attribute__((address_space(3)))
typedef unsigned short bf16;
typedef unsigned v4u __attribute__((ext_vector_type(4)));
typedef float f32x4 __attribute__((ext_vector_type(4)));
typedef short bf16x8 __attribute__((ext_vector_type(8)));
typedef GAS unsigned gu32;
typedef GAS unsigned long long gu64;
#define RLX_AGENT __ATOMIC_RELAXED, __HIP_MEMORY_SCOPE_AGENT
#define LDS_WAIT() asm volatile("s_waitcnt lgkmcnt(0)" ::: "memory")
#define VM_WAIT() asm volatile("s_waitcnt vmcnt(0)" ::: "memory")
__device__ __forceinline__ unsigned long long rt() { return __builtin_amdgcn_s_memrealtime(); }
__device__ __forceinline__ unsigned f2bf(float f) { unsigned u = __builtin_bit_cast(unsigned, f); return (u + 0x7fffu + ((u >> 16) & 1u)) >> 16; }
__device__ __forceinline__ unsigned pk2(float lo, float hi) { return f2bf(lo) | (f2bf(hi) << 16); }

#define XB_TMO      128
#define XB_XCNT(j)  (256  + 64 * (j))
#define XB_XSUB(j)  (1280 + 64 * (j))
#define XB_XGEN(j)  (2304 + 64 * (j))
#define XB_TOP      3328
#define XB_TOPGEN   3392
#define XCD_BAR_WORDS 3456
#define XB_SPIN_CAP (1u << 18)

__device__ __forceinline__ unsigned xb_ld(unsigned* p)              { return __hip_atomic_load(p, __ATOMIC_RELAXED, __HIP_MEMORY_SCOPE_AGENT); }
__device__ __forceinline__ unsigned xb_add(unsigned* p, unsigned v) { return __hip_atomic_fetch_add(p, v, __ATOMIC_RELAXED, __HIP_MEMORY_SCOPE_AGENT); }
__device__ __forceinline__ unsigned xb_xcc_id() { return (unsigned)__builtin_amdgcn_s_getreg((3 << 11) | 20) & 0xFu; }
#define XB_SPIN(cond, bar) do { unsigned _sp = 0; while (cond) { __builtin_amdgcn_s_sleep(1); \
    if ((++_sp & 255u) == 0u) { if (xb_ld(&(bar)[XB_TMO])) break; if (_sp > XB_SPIN_CAP) { atomicAdd(&(bar)[XB_TMO], 1u); break; } } } } while (0)

struct XcdBarrier {
    unsigned* bar; unsigned x;
    volatile LAS unsigned* st;
};

__device__ __forceinline__ XcdBarrier xcd_barrier_post(unsigned* bar, volatile LAS unsigned* st) {
    XcdBarrier b; b.bar = bar; b.x = xb_xcc_id(); b.st = st;
    if (threadIdx.x == 0) (void)xb_add(&bar[XB_XCNT(b.x)], 1u);
    return b;
}
__device__ __forceinline__ void xcd_barrier_complete(unsigned* bar, unsigned x, unsigned& nloc, unsigned& nx) {
    const unsigned G = gridDim.x * gridDim.y * gridDim.z;
    unsigned sum, cnt, mine, sp = 0u;
    for (;;) {
        sum = 0u; cnt = 0u; mine = 0u;
#pragma unroll
        for (unsigned j = 0; j < 16; ++j) { const unsigned c = xb_ld(&bar[XB_XCNT(j)]); sum += c; cnt += (c > 0u) ? 1u : 0u; mine = (j == x) ? c : mine; }
        if (sum == G) break;
        __builtin_amdgcn_s_sleep(1);
        if ((++sp & 255u) == 0u) { if (xb_ld(&bar[XB_TMO])) break; if (sp > XB_SPIN_CAP) { atomicAdd(&bar[XB_TMO], 1u); break; } }
    }
    nloc = mine > 0u ? mine : 1u; nx = cnt > 0u ? cnt : 1u;
}

__device__ __forceinline__ void xcd_barrier(const XcdBarrier& b) {
    asm volatile("s_waitcnt vmcnt(0)" ::: "memory");
    __syncthreads();
    if (threadIdx.x == 0) {
        unsigned* bar = b.bar;
        __builtin_amdgcn_s_waitcnt(0);
        unsigned nloc = b.st[0], nx = b.st[1];
        if (nloc == 0u) { xcd_barrier_complete(bar, b.x, nloc, nx); b.st[0] = nloc; b.st[1] = nx; }
        const unsigned old = xb_add(&bar[XB_XSUB(b.x)], 1u);
        const unsigned gen = old / nloc;
        if (old + 1u == (gen + 1u) * nloc) {
            __builtin_amdgcn_fence(__ATOMIC_RELEASE, "agent");
            asm volatile("s_waitcnt vmcnt(0)" ::: "memory");
            const unsigned og = xb_add(&bar[XB_TOP], 1u);
            const unsigned tg = og / nx;
            if (og + 1u == (tg + 1u) * nx) xb_add(&bar[XB_TOPGEN], 1u);
            else XB_SPIN(xb_ld(&bar[XB_TOPGEN]) == tg, bar);
            __builtin_amdgcn_fence(__ATOMIC_ACQUIRE, "agent");
            xb_add(&bar[XB_XGEN(b.x)], 1u);
            asm volatile("s_waitcnt vmcnt(0)" ::: "memory");
        } else {
            XB_SPIN(xb_ld(&bar[XB_XGEN(b.x)]) == gen, bar);
            __builtin_amdgcn_fence(__ATOMIC_ACQUIRE, "agent");
            asm volatile("s_waitcnt vmcnt(0)" ::: "memory");
        }
    }
    __syncthreads();
}

constexpr int NWAVES = 8;
constexpr int DM = 2048, TX = 8192, NMETA = 16, TT = TX + NMETA, MP = 8448;
constexpr int EV_NP = 5632, EV_LORA0 = 3072, EV_GB = 3360, EV_REC = 4384;
constexpr int OD_NP = 12544, OD_Z = 8192, OD_B = 12288, OD_A = 12320;
constexpr int NEXP = 32, FF = 512, MOE_ROWS = 24576;
constexpr float NORM_EPS = 1e-6f;

constexpr size_t MiB = 1u << 20;
constexpr size_t WS_CTL = 0, CTL_ZERO_BYTES = 1 * MiB;
constexpr size_t WS_TOKINFO = 1 * MiB;
constexpr size_t WS_TILES = 1 * MiB + 512 * 1024;
constexpr size_t WS_WEVIN = 2 * MiB;
constexpr size_t WS_WEVOUT = 24 * MiB;
constexpr size_t WS_WODIN = 32 * MiB;
constexpr size_t WS_WODOUT = 81 * MiB;
constexpr size_t WS_WLORA = 97 * MiB;
constexpr size_t WS_WGATE = 100 * MiB;
constexpr size_t WS_WROUTE = 101 * MiB;
constexpr size_t WS_MOEW = 102 * MiB;
constexpr size_t MOE_E_BYTES = 6 * MiB, MOE_W2_OFF = 4 * MiB;
constexpr size_t WS_H = 294 * MiB;
constexpr size_t WS_HN = 360 * MiB;
constexpr size_t WS_YMIX = 393 * MiB;
constexpr size_t WS_PROJ = 459 * MiB;
constexpr size_t WS_SCR = 662 * MiB;
constexpr size_t WS_END = 932 * MiB;
constexpr size_t SC_ALORA = 0;
constexpr size_t SC_XR = 8 * MiB;
constexpr size_t SC_DEC = 26 * MiB, SC_ICL = 60 * MiB, SC_GATE = 94 * MiB;
constexpr size_t SC_LA = 128 * MiB, SC_LIX = 162 * MiB;
constexpr size_t SC_QN = 0, SC_KN = 34 * MiB;
constexpr size_t SC_VC = 68 * MiB;
constexpr size_t SC_BETA = 134 * MiB, SC_G = 136 * MiB;
constexpr size_t SC_O = 138 * MiB;
constexpr size_t SC_XG = 0;
constexpr size_t SC_ACT = 96 * MiB;
constexpr size_t SC_YB = 120 * MiB;
static_assert(SC_O + (size_t)MP * 4096 * 4 <= WS_END - WS_SCR && SC_YB + (size_t)MOE_ROWS * 2048 * 2 <= WS_END - WS_SCR && SC_LIX + (size_t)MP * 1024 * 4 <= WS_END - WS_SCR, "scratch map");
constexpr int CW_TMO = 0, CW_CODE = 1;
constexpr int CW_BAR = 4096;
constexpr int CW_PROG = 20480;
constexpr int CW_TS = 24576;
constexpr int CW_MOEDONE = 28672;
constexpr int CW_MOECNT = 16384;

constexpr int RING_OFF = 0, RING_BYTES = 131072;
constexpr int LDSCTL_OFF = 146944, MISC_OFF = LDSCTL_OFF + 320;
constexpr int LDS_BYTES = 147456;


#define DI __device__ __forceinline__
typedef unsigned v2u __attribute__((ext_vector_type(2)));
struct Args { const float* in[36]; float* out; unsigned char* ws; int ph_lo, ph_hi; };
struct Frame {
    LAS unsigned char* lds; volatile LAS unsigned* MISC; gu32* ctl;
    int tid, lane, wave, vcu, G, gw, NGW;
};
DI float bf2f(bf16 v) { return __uint_as_float((unsigned)v << 16); }
DI float bflo(unsigned w) { return __uint_as_float(w << 16); }
DI float bfhi(unsigned w) { return __uint_as_float(w & 0xffff0000u); }
DI float wave_sum(float v) {
#pragma unroll
    for (int o = 1; o < 64; o <<= 1) v += __shfl_xor(v, o);
    return v;
}
DI float sigm(float x) { return __builtin_amdgcn_rcpf(1.0f + __expf(-x)); }
DI float softplus(float x) { return fmaxf(x, 0.f) + __logf(1.0f + __expf(-fabsf(x))); }
DI float gelu_tanh(float x) { const float u = 0.7978845608028654f * (x + 0.044715f * x * x * x); return 0.5f * x * (1.0f + tanhf(u)); }
DI int pos_row(int p) { return p < NMETA ? TX + p : p - NMETA; }
DI int row_pos(int r) { return r < TX ? r + NMETA : r - TX; }

DI void tr_item(const float* W, int N, int k0, int n0, bf16* WT, int ldk, int drow0, LAS float* scr, int lane) {
#pragma unroll 8
    for (int i = 0; i < 32; ++i) { const int kk = 2 * i + (lane >> 5); scr[kk * 33 + (lane & 31)] = W[(size_t)(k0 + kk) * N + n0 + (lane & 31)]; }
    LDS_WAIT(); asm volatile("" ::: "memory");
    const int c = lane & 7;
#pragma unroll
    for (int j = 0; j < 4; ++j) { const int n = (lane >> 3) + 8 * j; const LAS float* s = scr + (8 * c) * 33 + n;
        v4u o; o.x = pk2(s[0 * 33], s[1 * 33]); o.y = pk2(s[2 * 33], s[3 * 33]); o.z = pk2(s[4 * 33], s[5 * 33]); o.w = pk2(s[6 * 33], s[7 * 33]);
        *(v4u*)(WT + (size_t)(drow0 + n) * ldk + k0 + 8 * c) = o; }
    LDS_WAIT(); asm volatile("" ::: "memory");
}
DI void moe_convert(const Frame& F, const Args& a, int l, int gw, int ngw) {
    LAS float* scr = (LAS float*)(F.lds + RING_OFF + F.wave * 16384);
    bf16* base = (bf16*)(a.ws + WS_MOEW);
    for (int it = gw; it < NEXP * 1536; it += ngw) {
        const int e = it / 1536; int j = it % 1536; bf16* eb = base + (size_t)e * (MOE_E_BYTES / 2);
        const size_t eoff = (size_t)(l * NEXP + e) * DM * FF;
        if (j < 1024) { const float* W = (j < 512 ? a.in[33] : a.in[34]) + eoff; const int hi = j >= 512; j &= 511; const int kb = j >> 4, nb = j & 15, n0 = 32 * nb;
            tr_item(W, FF, 64 * kb, n0, eb, DM, 256 * (n0 >> 7) + 128 * hi + (n0 & 127), scr, F.lane); }
        else { j -= 1024; const int kb = j >> 6, nb = j & 63; tr_item(a.in[35] + eoff, DM, 64 * kb, 32 * nb, eb + MOE_W2_OFF / 2, FF, 32 * nb, scr, F.lane); }
    }
}
DI void norm_row_bf16(int lane, const float* src, const float* w, bf16* dst) {
    f32x4 v[8]; float s = 0.f;
#pragma unroll
    for (int j = 0; j < 8; ++j) { v[j] = ((const f32x4*)src)[lane + 64 * j]; s += (v[j].x * v[j].x + v[j].y * v[j].y) + (v[j].z * v[j].z + v[j].w * v[j].w); }
    const float rs = 1.0f / sqrtf(wave_sum(s) * (1.0f / DM) + NORM_EPS);
#pragma unroll
    for (int j = 0; j < 8; ++j) { const f32x4 wv = ((const f32x4*)w)[lane + 64 * j]; v2u o; o.x = pk2(v[j].x * rs * wv.x, v[j].y * rs * wv.y); o.y = pk2(v[j].z * rs * wv.z, v[j].w * rs * wv.w);
        ((v2u*)dst)[lane + 64 * j] = o; }
}

DI void ph_prologue(const Frame& F, const Args& a) {
    LAS float* scr = (LAS float*)(F.lds + RING_OFF + F.wave * 16384);
    constexpr int I_A = 32 * 169, I_B = 32 * 64, NIT = I_A + I_B;
    for (int it = F.gw; it < NIT; it += F.NGW) {
        int r = it;
        if (r < I_A) { const int kb = r / 169, nb = r % 169; tr_item(a.in[5], 5408, 64 * kb, 32 * nb, (bf16*)(a.ws + WS_WEVIN), DM, 32 * nb, scr, F.lane); continue; } r -= I_A;
        { const int kb = r / 64, nb = r % 64; tr_item(a.in[24], DM, 64 * kb, 32 * nb, (bf16*)(a.ws + WS_WEVOUT), DM, 32 * nb, scr, F.lane); }
    }
    const int gt = F.vcu * (NWAVES * 64) + F.tid, NGT = F.G * NWAVES * 64;
    { bf16* WL = (bf16*)(a.ws + WS_WLORA); const float* wup = a.in[8]; const float* aup = a.in[10]; const float* gup = a.in[11];
      for (int idx = gt; idx < 3072 * 384; idx += NGT) { const int n = idx / 384, k = idx % 384; float v = 0.f;
          if (n < 1024) { if (k < 64) v = wup[k * 1024 + n]; }
          else if (n < 2048) { if (k >= 64 && k < 128) v = aup[(k - 64) * 1024 + n - 1024]; }
          else { if (k >= 128 && k < 288) v = gup[(k - 128) * 1024 + n - 2048]; }
          WL[idx] = (bf16)f2bf(v); } }
    { bf16* WG = (bf16*)(a.ws + WS_WGATE);
      for (int idx = gt; idx < 2048 * 256; idx += NGT) { const int n = idx >> 8, kk = idx & 255, nn = n & 1023, blk = nn >> 6, j = nn & 63, cin = (nn & ~255) + kk;
          const float* W = n < 1024 ? a.in[19] : a.in[21];
          const float v = (cin >> 6) == blk ? W[blk * 4096 + (cin & 63) * 64 + j] : 0.f;
          WG[idx] = (bf16)f2bf(v); } }
    { bf16* WR = (bf16*)(a.ws + WS_WROUTE);
      for (int idx = gt; idx < 2 * 48 * DM; idx += NGT) { const int l = idx / (48 * DM), n = (idx / DM) % 48, k = idx % DM; float v = 0.f;
          if (n < 32) v = a.in[32][((size_t)l * DM + k) * NEXP + n]; else if (n < 36) v = a.in[31][((size_t)l * DM + k) * 4 + n - 32];
          const unsigned hi = f2bf(v); WR[((size_t)(l * 2) * 48 + n) * DM + k] = (bf16)hi; WR[((size_t)(l * 2 + 1) * 48 + n) * DM + k] = (bf16)f2bf(v - __uint_as_float(hi << 16)); } }
    bf16* HN = (bf16*)(a.ws + WS_HN);
    for (int r = F.gw; r < TT; r += F.NGW) norm_row_bf16(F.lane, r < TX ? a.in[0] + (size_t)r * DM : a.in[1] + (size_t)(r - TX) * DM, a.in[2], HN + (size_t)r * DM);
}

DI void ph_aux_convert(const Frame& F, const Args& a, int gw, int ngw) {
    LAS float* scr = (LAS float*)(F.lds + RING_OFF + F.wave * 16384);
    constexpr int I_C = 32 * 386, I_D = 64 * 64, NIT = I_C + I_D;
    for (int it = gw; it < NIT; it += ngw) {
        int r = it;
        if (r < I_C) { const int kb = r / 386, nb = r % 386; tr_item(a.in[25], 12352, 64 * kb, 32 * nb, (bf16*)(a.ws + WS_WODIN), DM, 32 * nb, scr, F.lane); continue; } r -= I_C;
        { const int kb = r / 64, nb = r % 64; tr_item(a.in[30], DM, 64 * kb, 32 * nb, (bf16*)(a.ws + WS_WODOUT), 4096, 32 * nb, scr, F.lane); }
    }
    moe_convert(F, a, 0, gw, ngw);
}

DI void ph_even_prep(const Frame& F, const Args& a) {
    const bf16* P = (const bf16*)(a.ws + WS_PROJ); bf16* AL = (bf16*)(a.ws + WS_SCR + SC_ALORA); bf16* XR = (bf16*)(a.ws + WS_SCR + SC_XR);
    const float* mu = a.in[6]; const float* cw = a.in[17]; const float* cb = a.in[18];
    const int lane = F.lane;
    for (int item = F.gw; item < TT + (TT / 8) * 2; item += F.NGW) {
        if (item < TT) { const int r = item, pos = row_pos(r); const bf16* cur = P + (size_t)r * EV_NP; const bf16* prv = P + (size_t)pos_row(pos > 0 ? pos - 1 : 0) * EV_NP; const float pm = pos > 0 ? 1.f : 0.f;
            float cv[6], pv[6], mv[6];
#pragma unroll
            for (int i = 0; i < 6; ++i) { const int idx = lane + 64 * i, col = EV_LORA0 + (idx < 288 ? idx : 287); cv[i] = bf2f(cur[col]); pv[i] = bf2f(prv[col]) * pm; mv[i] = mu[col]; }
#pragma unroll
            for (int i = 0; i < 6; ++i) { const int idx = lane + 64 * i; float v = cv[i] + (pv[i] - cv[i]) * mv[i];
                if (idx < 64) v = tanhf(v); else if (idx >= 128) v = sigm(v);
                AL[(size_t)r * 384 + idx] = (bf16)f2bf(idx < 288 ? v : 0.f); }
        } else { const int it2 = item - TT, pb = it2 >> 1, c0 = (it2 & 1) * 512 + lane * 8, p0 = pb * 8;
            f32x4 w[4][2], b0 = *(const f32x4*)(cb + c0), b1 = *(const f32x4*)(cb + c0 + 4);
#pragma unroll
            for (int j = 0; j < 4; ++j) { w[j][0] = *(const f32x4*)(cw + j * 1024 + c0); w[j][1] = *(const f32x4*)(cw + j * 1024 + c0 + 4); }
            v4u x[11];
#pragma unroll
            for (int i = 0; i < 11; ++i) { const int p = p0 - 3 + i; x[i] = *(const v4u*)(P + (size_t)pos_row(p > 0 ? p : 0) * EV_NP + EV_REC + c0); if (p < 0) x[i] = (v4u){0u, 0u, 0u, 0u}; }
#pragma unroll
            for (int o = 0; o < 8; ++o) { float acc[8] = {b0.x, b0.y, b0.z, b0.w, b1.x, b1.y, b1.z, b1.w};
#pragma unroll
                for (int j = 0; j < 4; ++j) { const v4u xv = x[o + j];
                    acc[0] += w[j][0].x * bflo(xv.x); acc[1] += w[j][0].y * bfhi(xv.x); acc[2] += w[j][0].z * bflo(xv.y); acc[3] += w[j][0].w * bfhi(xv.y);
                    acc[4] += w[j][1].x * bflo(xv.z); acc[5] += w[j][1].y * bfhi(xv.z); acc[6] += w[j][1].z * bflo(xv.w); acc[7] += w[j][1].w * bfhi(xv.w); }
                *(v4u*)(XR + (size_t)pos_row(p0 + o) * 1024 + c0) = (v4u){pk2(acc[0], acc[1]), pk2(acc[2], acc[3]), pk2(acc[4], acc[5]), pk2(acc[6], acc[7])}; } }
    }
}

DI void ph_route(const Frame& F, const Args& a, int l, int dummy) {
    const float* H = (const float*)(a.ws + WS_H); const float* nw = a.in[3] + (size_t)l * DM;
    const bf16* WH = (const bf16*)(a.ws + WS_WROUTE) + (size_t)(l * 2) * 48 * DM; const bf16* WL = WH + (size_t)48 * DM;
    unsigned* TI = (unsigned*)(a.ws + WS_TOKINFO) + (dummy ? (WS_SCR + 250 * MiB - WS_TOKINFO) / 4 : 0); const int lane = F.lane, lc = lane & 15, quad = lane >> 4, wave = F.wave; const int cl = dummy ? l + 2 : l;
    LAS float* red = (LAS float*)(F.lds + RING_OFF);
    LAS float* sq = red + 8 * 9 * 64 * 4; LAS float* lgs = sq + 8 * 48;
    static_assert(TT % 48 == 0, "router tasks");
    for (int task = F.vcu; task < TT / 48; task += F.G) {
        const float* nwp = nw + 256 * wave + 8 * quad; float ss[3] = {0.f, 0.f, 0.f};
        f32x4 acc[3][3];
#pragma unroll
        for (int mt = 0; mt < 3; ++mt)
#pragma unroll
            for (int nt = 0; nt < 3; ++nt) acc[mt][nt] = (f32x4){0.f, 0.f, 0.f, 0.f};
#pragma unroll 2
        for (int ks = 0; ks < 8; ++ks) { const int k0 = 256 * wave + 32 * ks + 8 * quad; const f32x4 w0 = *(const f32x4*)(nwp + 32 * ks), w1 = *(const f32x4*)(nwp + 32 * ks + 4);
            bf16x8 bh[3], bl[3];
#pragma unroll
            for (int nt = 0; nt < 3; ++nt) { bh[nt] = *(const bf16x8*)(WH + (size_t)(16 * nt + lc) * DM + k0); bl[nt] = *(const bf16x8*)(WL + (size_t)(16 * nt + lc) * DM + k0); }
#pragma unroll
            for (int mt = 0; mt < 3; ++mt) { const float* hr = H + (size_t)(task * 48 + mt * 16 + lc) * DM + k0; const f32x4 x0 = *(const f32x4*)hr, x1 = *(const f32x4*)(hr + 4);
                ss[mt] += (x0.x * x0.x + x0.y * x0.y) + (x0.z * x0.z + x0.w * x0.w) + (x1.x * x1.x + x1.y * x1.y) + (x1.z * x1.z + x1.w * x1.w);
                const float xn[8] = {x0.x * w0.x, x0.y * w0.y, x0.z * w0.z, x0.w * w0.w, x1.x * w1.x, x1.y * w1.y, x1.z * w1.z, x1.w * w1.w};
                unsigned hi[8]; float lo[8];
#pragma unroll
                for (int q = 0; q < 8; ++q) { hi[q] = f2bf(xn[q]); lo[q] = xn[q] - __uint_as_float(hi[q] << 16); }
                const v4u ah4 = (v4u){hi[0] | (hi[1] << 16), hi[2] | (hi[3] << 16), hi[4] | (hi[5] << 16), hi[6] | (hi[7] << 16)}, al4 = (v4u){pk2(lo[0], lo[1]), pk2(lo[2], lo[3]), pk2(lo[4], lo[5]), pk2(lo[6], lo[7])};
                const bf16x8 ah = __builtin_bit_cast(bf16x8, ah4), al = __builtin_bit_cast(bf16x8, al4);
#pragma unroll
                for (int nt = 0; nt < 3; ++nt) { acc[mt][nt] = __builtin_amdgcn_mfma_f32_16x16x32_bf16(al, bh[nt], acc[mt][nt], 0, 0, 0); acc[mt][nt] = __builtin_amdgcn_mfma_f32_16x16x32_bf16(ah, bl[nt], acc[mt][nt], 0, 0, 0);
                    acc[mt][nt] = __builtin_amdgcn_mfma_f32_16x16x32_bf16(ah, bh[nt], acc[mt][nt], 0, 0, 0); } } }
#pragma unroll
        for (int mt = 0; mt < 3; ++mt) { float s_ = ss[mt]; s_ += __shfl_xor(s_, 16); s_ += __shfl_xor(s_, 32); if (quad == 0) sq[wave * 48 + mt * 16 + lc] = s_;
#pragma unroll
            for (int nt = 0; nt < 3; ++nt) *(LAS f32x4*)(red + ((wave * 9 + mt * 3 + nt) * 64 + lane) * 4) = acc[mt][nt]; }
        __syncthreads();
        { const int tile = wave;
#pragma unroll
          for (int rep = 0; rep < 2; ++rep) { const int tl = tile + 8 * rep; if (tl < 9) { f32x4 s = *(const LAS f32x4*)(red + (tl * 64 + lane) * 4);
#pragma unroll
              for (int v = 1; v < 8; ++v) s = s + *(const LAS f32x4*)(red + ((v * 9 + tl) * 64 + lane) * 4);
              const int mt = tl / 3, nt = tl % 3;
#pragma unroll
              for (int q = 0; q < 4; ++q) lgs[(mt * 16 + 4 * quad + q) * 49 + 16 * nt + lc] = s[q]; } } }
        __syncthreads();
        if (wave == 0 && lane < 48) { float sst = 0.f;
#pragma unroll
            for (int v = 0; v < 8; ++v) sst += sq[v * 48 + lane];
            const float rs = 1.0f / sqrtf(sst * (1.0f / DM) + NORM_EPS);
            float lg[36];
#pragma unroll
            for (int i = 0; i < 36; ++i) lg[i] = lgs[lane * 49 + i] * rs;
            int gi = 0; float gm = lg[32];
#pragma unroll
            for (int i = 1; i < 4; ++i) if (lg[32 + i] > gm) { gm = lg[32 + i]; gi = i; }
            float den = 0.f;
#pragma unroll
            for (int i = 0; i < 4; ++i) den += __expf(lg[32 + i] - gm);
            const float gp = 1.0f / den;
            float l8[8];
#pragma unroll
            for (int i = 0; i < 8; ++i) l8[i] = gi == 0 ? lg[i] : (gi == 1 ? lg[8 + i] : (gi == 2 ? lg[16 + i] : lg[24 + i]));
            int i1 = 0; float m1 = l8[0];
#pragma unroll
            for (int i = 1; i < 8; ++i) if (l8[i] > m1) { m1 = l8[i]; i1 = i; }
            int i2 = -1; float m2 = -INFINITY;
#pragma unroll
            for (int i = 0; i < 8; ++i) if (i != i1 && l8[i] > m2) { m2 = l8[i]; i2 = i; }
            const float e21 = __expf(m2 - m1); const float w1 = gp / (1.0f + e21), w2 = gp * e21 / (1.0f + e21);
            const int ea = gi * 8 + i1, eb = gi * 8 + i2; const int rt = task * 48 + lane;
            const unsigned sa = atomicAdd((unsigned*)(F.ctl + CW_MOECNT + (cl * NEXP + ea) * 16), 1u), sb = atomicAdd((unsigned*)(F.ctl + CW_MOECNT + (cl * NEXP + eb) * 16), 1u);
            unsigned* t = TI + (size_t)rt * 8; *(v4u*)t = (v4u){(unsigned)ea, sa, __float_as_uint(w1), (unsigned)eb}; *(v4u*)(t + 4) = (v4u){sb, __float_as_uint(w2), __float_as_uint(rs), 0u}; }
        __syncthreads();
    }
}
DI void moe_prefix(const Frame& F, int l, LAS int* ps) {
    if (F.tid == 0) { int t = 0;
        for (int e = 0; e < NEXP; ++e) { const unsigned c = __hip_atomic_load(F.ctl + CW_MOECNT + (l * NEXP + e) * 16, RLX_AGENT); ps[e] = t * 256; t += (int)((c + 255u) >> 8); }
        ps[32] = t; }
    __syncthreads();
}
DI void ph_gather(const Frame& F, const Args& a, int l) {
    LAS int* ps = (LAS int*)(F.lds + RING_OFF); moe_prefix(F, l, ps);
    if (F.vcu == 0 && F.tid < NEXP) { int* TE = (int*)(a.ws + WS_TILES); const int e = F.tid; const int t0 = ps[e] >> 8, t1 = (e == NEXP - 1 ? ps[32] : ps[e + 1] >> 8);
        for (int t = t0; t < t1; ++t) TE[t] = e; if (e == 0) TE[127] = ps[32]; }
    const float* H = (const float*)(a.ws + WS_H); const float* nw = a.in[3] + (size_t)l * DM; unsigned* TI = (unsigned*)(a.ws + WS_TOKINFO); bf16* XG = (bf16*)(a.ws + WS_SCR + SC_XG);
    const int lane = F.lane;
    for (int r = F.gw; r < TT; r += F.NGW) {
        unsigned* t = TI + (size_t)r * 8; const int g0 = ps[t[0]] + (int)t[1], g1 = ps[t[3]] + (int)t[4]; const float rs = __uint_as_float(t[6]);
        if (lane == 0) t[7] = (unsigned)g0 | ((unsigned)g1 << 16);
        const float* hr = H + (size_t)r * DM;
#pragma unroll
        for (int j = 0; j < 4; ++j) { const int e0 = (lane + 64 * j) * 8; const f32x4 x0 = *(const f32x4*)(hr + e0), x1 = *(const f32x4*)(hr + e0 + 4), w0 = *(const f32x4*)(nw + e0), w1 = *(const f32x4*)(nw + e0 + 4);
            v4u o; o.x = pk2(x0.x * rs * w0.x, x0.y * rs * w0.y); o.y = pk2(x0.z * rs * w0.z, x0.w * rs * w0.w); o.z = pk2(x1.x * rs * w1.x, x1.y * rs * w1.y); o.w = pk2(x1.z * rs * w1.z, x1.w * rs * w1.w);
            *(v4u*)(XG + (size_t)g0 * DM + e0) = o; *(v4u*)(XG + (size_t)g1 * DM + e0) = o; }
    }
}
DI void ph_combine(const Frame& F, const Args& a, int l) {
    float* H = (float*)(a.ws + WS_H); const unsigned* TI = (const unsigned*)(a.ws + WS_TOKINFO); const bf16* YB = (const bf16*)(a.ws + WS_SCR + SC_YB); bf16* HN = (bf16*)(a.ws + WS_HN);
    const int lane = F.lane; const int nrows = l == 0 ? TT : TX;
    for (int r = F.gw; r < nrows; r += F.NGW) {
        const unsigned* t = TI + (size_t)r * 8; const int g0 = (int)(t[7] & 0xffffu), g1 = (int)(t[7] >> 16); const float w0 = __uint_as_float(t[2]), w1 = __uint_as_float(t[5]);
        float* hr = H + (size_t)r * DM; float hv[32]; float s = 0.f;
#pragma unroll
        for (int j = 0; j < 4; ++j) { const int e0 = (lane + 64 * j) * 8; const f32x4 x0 = *(const f32x4*)(hr + e0), x1 = *(const f32x4*)(hr + e0 + 4);
            const v4u ya = *(const v4u*)(YB + (size_t)g0 * DM + e0), yc = *(const v4u*)(YB + (size_t)g1 * DM + e0);
            float* o = hv + 8 * j;
            o[0] = x0.x + w0 * bflo(ya.x) + w1 * bflo(yc.x); o[1] = x0.y + w0 * bfhi(ya.x) + w1 * bfhi(yc.x); o[2] = x0.z + w0 * bflo(ya.y) + w1 * bflo(yc.y); o[3] = x0.w + w0 * bfhi(ya.y) + w1 * bfhi(yc.y);
            o[4] = x1.x + w0 * bflo(ya.z) + w1 * bflo(yc.z); o[5] = x1.y + w0 * bfhi(ya.z) + w1 * bfhi(yc.z); o[6] = x1.z + w0 * bflo(ya.w) + w1 * bflo(yc.w); o[7] = x1.w + w0 * bfhi(ya.w) + w1 * bfhi(yc.w);
#pragma unroll
            for (int q = 0; q < 8; ++q) s += o[q] * o[q]; }
        const float rs = 1.0f / sqrtf(wave_sum(s) * (1.0f / DM) + NORM_EPS);
        if (l == 0) { const float* nw = a.in[2] + DM;
#pragma unroll
            for (int j = 0; j < 4; ++j) { const int e0 = (lane + 64 * j) * 8; const float* o = hv + 8 * j; const f32x4 wa = *(const f32x4*)(nw + e0), wb = *(const f32x4*)(nw + e0 + 4);
                *(f32x4*)(hr + e0) = (f32x4){o[0], o[1], o[2], o[3]}; *(f32x4*)(hr + e0 + 4) = (f32x4){o[4], o[5], o[6], o[7]};
                v4u p; p.x = pk2(o[0] * rs * wa.x, o[1] * rs * wa.y); p.y = pk2(o[2] * rs * wa.z, o[3] * rs * wa.w); p.z = pk2(o[4] * rs * wb.x, o[5] * rs * wb.y); p.w = pk2(o[6] * rs * wb.z, o[7] * rs * wb.w);
                *(v4u*)(HN + (size_t)r * DM + e0) = p; }
        } else { const float* nw = a.in[4]; float* orow = a.out + (size_t)r * DM;
#ifdef PROBE_TS
            { const unsigned long long* ts = (const unsigned long long*)(F.ctl + CW_TS); const float dt_us = (float)(__hip_atomic_load(ts + PROBE_TS + 1, RLX_AGENT) - __hip_atomic_load(ts + PROBE_TS, RLX_AGENT)) * 0.01f;
#pragma unroll
              for (int q = 0; q < 32; ++q) hv[q] *= 1.0f + dt_us * 0.01f; }
#endif
#pragma unroll
            for (int j = 0; j < 4; ++j) { const int e0 = (lane + 64 * j) * 8; const float* o = hv + 8 * j; const f32x4 wa = *(const f32x4*)(nw + e0), wb = *(const f32x4*)(nw + e0 + 4);
                *(f32x4*)(orow + e0) = (f32x4){o[0] * rs * wa.x, o[1] * rs * wa.y, o[2] * rs * wa.z, o[3] * rs * wa.w};
                *(f32x4*)(orow + e0 + 4) = (f32x4){o[4] * rs * wb.x, o[5] * rs * wb.y, o[6] * rs * wb.z, o[7] * rs * wb.w}; } }
    }
}

struct OddPrepItem { f32x4 w[4][2]; v4u x[11]; };
DI void odd_prep_load(OddPrepItem& it, const bf16* P, const float* cw, int item, int lane) {
    const int pb = item >> 4, i = item & 15, ch = i * 512 + lane * 8, p0 = pb * 8;
#pragma unroll
    for (int j = 0; j < 4; ++j) { it.w[j][0] = *(const f32x4*)(cw + j * 8192 + ch); it.w[j][1] = *(const f32x4*)(cw + j * 8192 + ch + 4); }
#pragma unroll
    for (int q = 0; q < 11; ++q) { const int p = p0 - 3 + q; it.x[q] = *(const v4u*)(P + (size_t)pos_row(p > 0 ? p : 0) * OD_NP + ch); if (p < 0) it.x[q] = (v4u){0u, 0u, 0u, 0u}; }
}
DI void odd_prep_compute(const OddPrepItem& it, const Args& a, int item, int lane) {
    const bf16* P = (const bf16*)(a.ws + WS_PROJ); bf16* QN = (bf16*)(a.ws + WS_SCR + SC_QN); bf16* KN = (bf16*)(a.ws + WS_SCR + SC_KN); bf16* VC = (bf16*)(a.ws + WS_SCR + SC_VC);
    float* BETA = (float*)(a.ws + WS_SCR + SC_BETA); float* GG = (float*)(a.ws + WS_SCR + SC_G);
    const int pb = item >> 4, i = item & 15, ch = i * 512 + lane * 8, p0 = pb * 8;
#pragma unroll
    for (int o = 0; o < 8; ++o) { const int r = pos_row(p0 + o); float acc[8] = {0.f, 0.f, 0.f, 0.f, 0.f, 0.f, 0.f, 0.f};
#pragma unroll
        for (int j = 0; j < 4; ++j) { const v4u xv = it.x[o + j];
            acc[0] += it.w[j][0].x * bflo(xv.x); acc[1] += it.w[j][0].y * bfhi(xv.x); acc[2] += it.w[j][0].z * bflo(xv.y); acc[3] += it.w[j][0].w * bfhi(xv.y);
            acc[4] += it.w[j][1].x * bflo(xv.z); acc[5] += it.w[j][1].y * bfhi(xv.z); acc[6] += it.w[j][1].z * bflo(xv.w); acc[7] += it.w[j][1].w * bfhi(xv.w); }
        float ss = 0.f;
#pragma unroll
        for (int q = 0; q < 8; ++q) { acc[q] = acc[q] * sigm(acc[q]); ss += acc[q] * acc[q]; }
        float sc = 1.0f;
        if (i < 8) { ss += __shfl_xor(ss, 1); ss += __shfl_xor(ss, 2); ss += __shfl_xor(ss, 4); ss += __shfl_xor(ss, 8);
            sc = (1.0f / sqrtf(ss + NORM_EPS)) * (i < 4 ? 0.08838834764831845f : 1.0f); }
        const v4u ov = (v4u){pk2(acc[0] * sc, acc[1] * sc), pk2(acc[2] * sc, acc[3] * sc), pk2(acc[4] * sc, acc[5] * sc), pk2(acc[6] * sc, acc[7] * sc)};
        bf16* dst = i < 4 ? QN + (size_t)r * 2048 + ch : (i < 8 ? KN + (size_t)r * 2048 + ch - 2048 : VC + (size_t)r * 4096 + ch - 4096);
        *(v4u*)dst = ov; }
    if (i == 0 && lane < 32) {
#pragma unroll
        for (int o = 0; o < 8; ++o) { const int r = pos_row(p0 + o); const float bb = bf2f(P[(size_t)r * OD_NP + OD_B + lane]), aa = bf2f(P[(size_t)r * OD_NP + OD_A + lane]);
            BETA[(size_t)r * 32 + lane] = sigm(bb); GG[(size_t)r * 32 + lane] = -__expf(a.in[27][lane]) * softplus(aa + a.in[28][lane]); } }
}
DI void ph_odd_prep(const Frame& F, const Args& a) {
    const bf16* P = (const bf16*)(a.ws + WS_PROJ); const float* cw = a.in[26]; constexpr int NI = (TT / 8) * 16;
    for (int item = F.gw; item < NI; item += 2 * F.NGW) { OddPrepItem A, B; const bool hb = item + F.NGW < NI;
        odd_prep_load(A, P, cw, item, F.lane); odd_prep_load(B, P, cw, hb ? item + F.NGW : item, F.lane);
        odd_prep_compute(A, a, item, F.lane); if (hb) odd_prep_compute(B, a, item + F.NGW, F.lane); }
}
constexpr int ODD_POST_ROWS0 = 64 * 113;
DI void ph_odd_post(const Frame& F, const Args& a, int part) {
    const bf16* P = (const bf16*)(a.ws + WS_PROJ); const bf16* O = (const bf16*)(a.ws + WS_SCR + SC_O); bf16* Y = (bf16*)(a.ws + WS_YMIX); const float* nw = a.in[29];
    const int lane = F.lane; int w0 = F.gw, wn = F.NGW, n_rows = TX - ODD_POST_ROWS0;
    if (part == 0) { const int wx = F.vcu & 31; if (F.G != 256 || wx < 20) return; w0 = ((F.vcu >> 5) * 12 + (wx - 20)) * NWAVES + F.wave; wn = 96 * NWAVES; n_rows = ODD_POST_ROWS0 + NMETA; }
    if (part == 2) n_rows = TT;
    for (int ri = w0; ri < n_rows; ri += wn) { const int r = part == 0 ? (ri < ODD_POST_ROWS0 ? ri : TX + ri - ODD_POST_ROWS0) : (part == 1 ? ODD_POST_ROWS0 + ri : ri);
#pragma unroll 2
        for (int i = 0; i < 8; ++i) { const int ch = i * 512 + lane * 8; const v4u ow = *(const v4u*)(O + (size_t)r * 4096 + ch); const f32x4 o0 = (f32x4){bflo(ow.x), bfhi(ow.x), bflo(ow.y), bfhi(ow.y)}, o1 = (f32x4){bflo(ow.z), bfhi(ow.z), bflo(ow.w), bfhi(ow.w)};
            float ss = (o0.x * o0.x + o0.y * o0.y) + (o0.z * o0.z + o0.w * o0.w) + (o1.x * o1.x + o1.y * o1.y) + (o1.z * o1.z + o1.w * o1.w);
            ss += __shfl_xor(ss, 1); ss += __shfl_xor(ss, 2); ss += __shfl_xor(ss, 4); ss += __shfl_xor(ss, 8);
            const float rs = 1.0f / sqrtf(ss * (1.0f / 128.0f) + NORM_EPS);
            const v4u z = *(const v4u*)(P + (size_t)r * OD_NP + OD_Z + ch); const int c0 = ch & 127; const f32x4 w0 = *(const f32x4*)(nw + c0), w1 = *(const f32x4*)(nw + c0 + 4);
            const float zf[8] = {bflo(z.x), bfhi(z.x), bflo(z.y), bfhi(z.y), bflo(z.z), bfhi(z.z), bflo(z.w), bfhi(z.w)};
            const float of[8] = {o0.x * w0.x, o0.y * w0.y, o0.z * w0.z, o0.w * w0.w, o1.x * w1.x, o1.y * w1.y, o1.z * w1.z, o1.w * w1.w};
            float y[8];
#pragma unroll
            for (int q = 0; q < 8; ++q) y[q] = of[q] * rs * zf[q] * sigm(zf[q]);
            v4u p; p.x = pk2(y[0], y[1]); p.y = pk2(y[2], y[3]); p.z = pk2(y[4], y[5]); p.w = pk2(y[6], y[7]);
            *(v4u*)(Y + (size_t)r * 4096 + ch) = p; }
    }
}

typedef float f32x16 __attribute__((ext_vector_type(16)));
#define MFMA32(a, b, c) __builtin_amdgcn_mfma_f32_32x32x16_bf16((a), (b), (c), 0, 0, 0)
DI int crow(int reg, int h) { return (reg & 3) + 8 * (reg >> 2) + 4 * h; }
DI int chunk_row(int n, int c) { return n == 0 ? (c >= 48 ? TX + (c - 48) : -1) : 64 * (n - 1) + c; }
#ifndef GDN_NO_HELPER
#define GDN_NO_HELPER 0
#endif
constexpr int GDN_NCH = 129, GDN_UNITS = GDN_NCH * 32, GDN_KUNITS = GDN_NCH * 16, GC_STRIDE = 72;
constexpr size_t GD_WF = WS_MOEW, GD_UF = WS_MOEW + 65 * MiB, GD_IN = WS_MOEW + 130 * MiB, GD_GC = WS_MOEW + 163 * MiB, GD_KT = WS_HN, GD_QF = WS_SCR + 208 * MiB, GD_SAVE = WS_SCR + 205 * MiB;
static_assert(GD_QF + (size_t)GDN_KUNITS * 16384 <= WS_END && GD_SAVE + 2 * MiB <= GD_QF && (size_t)GDN_UNITS * 16384 <= 65 * MiB && (size_t)GDN_UNITS * 8192 <= 33 * MiB && (size_t)GDN_KUNITS * 16384 <= 33 * MiB && GD_GC + (size_t)GDN_UNITS * GC_STRIDE * 4 <= WS_H, "gdn map");

DI void ph_gdn_chunk(const Frame& F, const Args& a, int n_lo, int n_hi, int side) {
    const bf16* QN = (const bf16*)(a.ws + WS_SCR + SC_QN); const bf16* KN = (const bf16*)(a.ws + WS_SCR + SC_KN); const bf16* VC = (const bf16*)(a.ws + WS_SCR + SC_VC);
    const float* BETA = (const float*)(a.ws + WS_SCR + SC_BETA); const float* GG = (const float*)(a.ws + WS_SCR + SC_G);
    bf16* WF = (bf16*)(a.ws + GD_WF); bf16* UF = (bf16*)(a.ws + GD_UF); bf16* INF = (bf16*)(a.ws + GD_IN); bf16* KTF = (bf16*)(a.ws + GD_KT); bf16* QF = (bf16*)(a.ws + GD_QF); float* GC = (float*)(a.ws + GD_GC);
    LAS unsigned char* L = F.lds + RING_OFF;
    LAS unsigned char* kS = L; LAS unsigned char* qS = L + 17408; LAS unsigned char* vS = L + 34816; LAS unsigned char* kbS = L + 52224;
    LAS float* Lm = (LAS float*)(L + 69632); LAS bf16* IS = (LAS bf16*)(L + 87040); LAS bf16* XS = (LAS bf16*)(L + 96256);
    LAS float* betaS = (LAS float*)(L + 130048); LAS float* gcS = betaS + 64; LAS float* egcS = betaS + 128;
    LAS unsigned char* Lb = L + 17408; LAS unsigned char* TDs = L + 26624; LAS unsigned char* YT0 = L + 28672; LAS unsigned char* XT0 = L + 130816;
    static_assert(130816 + 8 * 1792 <= LDSCTL_OFF, "gdn lds map");
    const int tid = F.tid, lane = F.lane, wave = F.wave, l31 = lane & 31, h = lane >> 5;
    int widx = F.vcu, wcnt = F.G;
    if (side) { if (F.G == 256) { const int wx = F.vcu & 31; if (wx < 20) return; widx = (F.vcu >> 5) * 12 + (wx - 20); wcnt = 96; } else { if (F.vcu < 128 || F.G <= 128) return; widx = F.vcu - 128; wcnt = F.G - 128; } }
#define G1_BAR() do { asm volatile("s_waitcnt lgkmcnt(0)" ::: "memory"); __builtin_amdgcn_s_barrier(); asm volatile("" ::: "memory"); } while (0)
    v4u pkx[2], pqx[2], pvx[2]; float pbeta = 0.f, pgl = 0.f;
#define G1_FETCH(uu) do { const int n_ = (uu) >> 5, hv_ = (uu) & 31, hk_ = hv_ >> 1; \
        _Pragma("unroll") for (int i = 0; i < 2; ++i) { const int p = tid + 512 * i, row = p >> 4, ch = p & 15; const int rr = chunk_row(n_, row); const size_t r_ = (size_t)(rr >= 0 ? rr : 0); \
            pkx[i] = *(const v4u*)(KN + r_ * 2048 + hk_ * 128 + ch * 8); pqx[i] = *(const v4u*)(QN + r_ * 2048 + hk_ * 128 + ch * 8); pvx[i] = *(const v4u*)(VC + r_ * 4096 + hv_ * 128 + ch * 8); \
            if (rr < 0) { pkx[i] = (v4u){0u, 0u, 0u, 0u}; pqx[i] = pkx[i]; pvx[i] = pkx[i]; } } \
        if (wave == 0) { const int rr = chunk_row(n_, lane); const size_t r_ = (size_t)(rr >= 0 ? rr : 0); pbeta = BETA[r_ * 32 + hv_]; pgl = GG[r_ * 32 + hv_]; if (rr < 0) { pbeta = 0.f; pgl = 0.f; } } } while (0)
    const int unit0 = n_lo * 32 + widx;
    if (unit0 < n_hi * 32) G1_FETCH(unit0);
    for (int unit = unit0; unit < n_hi * 32; unit += wcnt) {
        const int n = unit >> 5, hv = unit & 31, hk = hv >> 1; const size_t su = (size_t)hv * GDN_NCH + n;
#pragma unroll
        for (int i = 0; i < 2; ++i) { const int p = tid + 512 * i, row = p >> 4, ch = p & 15;
            *(LAS v4u*)(kS + row * 272 + ch * 16) = pkx[i]; *(LAS v4u*)(qS + row * 272 + ch * 16) = pqx[i]; *(LAS v4u*)(vS + row * 272 + ch * 16) = pvx[i]; }
        if (wave == 0) { float b = pbeta, g = pgl;
#pragma unroll
            for (int o = 1; o < 64; o <<= 1) { const float t = __shfl_up(g, o); if (lane >= o) g += t; }
            betaS[lane] = b; gcS[lane] = g; egcS[lane] = __expf(g); }
        if (unit + wcnt < n_hi * 32) G1_FETCH(unit + wcnt);
        G1_BAR();
        if ((hv & 1) == 0) { const size_t kunit = (size_t)hk * GDN_NCH + n;
#pragma unroll
            for (int i = 0; i < 2; ++i) { const int p = tid + 512 * i, comb = p >> 6, ln = p & 63, t = comb >> 3, s = comb & 7; const int c = 32 * t + (ln & 31), k0 = 16 * s + 8 * (ln >> 5);
                *(v4u*)(QF + (kunit * 16 + comb) * 512 + ln * 8) = *(const LAS v4u*)(qS + c * 272 + k0 * 2); } }
#pragma unroll
        for (int i = 0; i < 2; ++i) { const int p = tid + 512 * i, row = p >> 4, ch = p & 15; const v4u kx = *(const LAS v4u*)(kS + row * 272 + ch * 16); const float b = betaS[row];
            v4u o; o.x = pk2(bflo(kx.x) * b, bfhi(kx.x) * b); o.y = pk2(bflo(kx.y) * b, bfhi(kx.y) * b); o.z = pk2(bflo(kx.z) * b, bfhi(kx.z) * b); o.w = pk2(bflo(kx.w) * b, bfhi(kx.w) * b);
            *(LAS v4u*)(kbS + row * 272 + ch * 16) = o; }
        G1_BAR();
        { const int which = wave >> 2, ti = (wave >> 1) & 1, tj = wave & 1;
          f32x16 acc;
#pragma unroll
          for (int r = 0; r < 16; ++r) acc[r] = 0.f;
          if (!(ti == 0 && tj == 1)) { const LAS unsigned char* Ab = (which == 0 ? kbS : qS) + (32 * ti + l31) * 272 + 16 * h; const LAS unsigned char* Bb = kS + (32 * tj + l31) * 272 + 16 * h;
#pragma unroll
              for (int s = 0; s < 8; ++s) acc = MFMA32(*(const LAS bf16x8*)(Ab + 32 * s), *(const LAS bf16x8*)(Bb + 32 * s), acc); }
          const int j = 32 * tj + l31; const float gj = gcS[j];
#pragma unroll
          for (int r = 0; r < 16; ++r) { const int i = 32 * ti + crow(r, h); const float e = __expf(fminf(gcS[i] - gj, 0.f));
              if (which == 0) Lm[i * 68 + j] = i > j ? acc[r] * e : 0.f;
              else IS[i * 72 + j] = (bf16)f2bf(i >= j ? acc[r] * e : 0.f); } }
        G1_BAR();
#pragma unroll
        for (int i = 0; i < 8; ++i) { const int e = tid + 512 * i, r = e >> 6, c = e & 63; *(LAS bf16*)(Lb + r * 144 + c * 2) = (bf16)f2bf(Lm[r * 68 + c]); }
        if (wave == 0) { const int b = lane >> 4, c = lane & 15; float t[16]; const LAS float* Ld = Lm + (16 * b) * 68 + 16 * b;
            t[0] = c == 0 ? 1.f : 0.f; *(LAS bf16*)(TDs + (b * 16) * 32 + c * 2) = (bf16)f2bf(t[0]);
#define G1_INV_ROWS(I0, I1) do { f32x4 Lr[(I1) - (I0)][4]; \
            _Pragma("unroll") for (int i = (I0); i < (I1); ++i) _Pragma("unroll") for (int q = 0; q < (i + 3) / 4; ++q) Lr[i - (I0)][q] = *(const LAS f32x4*)(Ld + i * 68 + 4 * q); \
            _Pragma("unroll") for (int i = (I0); i < (I1); ++i) { float a0 = i == c ? 1.f : 0.f, a1 = 0.f; \
                _Pragma("unroll") for (int j = 0; j < i; ++j) { const float lv = Lr[i - (I0)][j >> 2][j & 3]; if (j & 1) a1 -= lv * t[j]; else a0 -= lv * t[j]; } \
                t[i] = a0 + a1; *(LAS bf16*)(TDs + (b * 16 + i) * 32 + c * 2) = (bf16)f2bf(t[i]); } } while (0)
            G1_INV_ROWS(1, 9); G1_INV_ROWS(9, 13); G1_INV_ROWS(13, 16);
#undef G1_INV_ROWS
        } else if (wave >= 4) { const int t2 = tid - 256;
#pragma unroll
            for (int i = 0; i < 2; ++i) { const int p = t2 + 256 * i, comb = p >> 6, ln = p & 63, t = comb >> 2, s = comb & 3; const int c = 32 * t + (ln & 31), j0 = 16 * s + 8 * (ln >> 5);
                *(v4u*)(INF + (su * 8 + comb) * 512 + ln * 8) = *(const LAS v4u*)(IS + c * 72 + j0); }
            if ((hv & 1) == 0) { const size_t kunit = (size_t)hk * GDN_NCH + n;
#pragma unroll
                for (int i = 0; i < 4; ++i) { const int p = t2 + 256 * i, comb = p >> 6, ln = p & 63, kt = comb >> 2, s = comb & 3; const int kd = 32 * kt + (ln & 31), c0 = 16 * s + 8 * (ln >> 5);
                    unsigned w[4];
#pragma unroll
                    for (int jj = 0; jj < 4; ++jj) { const unsigned lo = *(const LAS bf16*)(kS + (c0 + 2 * jj) * 272 + kd * 2), hi = *(const LAS bf16*)(kS + (c0 + 2 * jj + 1) * 272 + kd * 2); w[jj] = lo | (hi << 16); }
                    *(v4u*)(KTF + (kunit * 16 + comb) * 512 + ln * 8) = (v4u){w[0], w[1], w[2], w[3]}; } }
            if (t2 < 64) GC[su * GC_STRIDE + t2] = gcS[t2];
            else if (t2 == 64) GC[su * GC_STRIDE + 64] = gcS[63];
            else if (t2 == 65) GC[su * GC_STRIDE + 65] = egcS[63];
        }
        G1_BAR();
        { const int quad = lane >> 4, lc = lane & 15; LAS unsigned char* XTw = XT0 + wave * 1792; LAS unsigned char* YTw = YT0 + wave * 768;
          const bf16x8 z8 = (bf16x8){0, 0, 0, 0, 0, 0, 0, 0}; const f32x4 z4 = (f32x4){0.f, 0.f, 0.f, 0.f};
          bf16x8 tdf[4];
#pragma unroll
          for (int b = 0; b < 4; ++b) tdf[b] = quad < 2 ? *(const LAS bf16x8*)(TDs + (b * 16 + lc) * 32 + quad * 16) : z8;
#pragma unroll 1
          for (int tl = 0; tl < 2; ++tl) { const int col = 32 * wave + 16 * tl + lc;
              const LAS unsigned char* rz = wave < 4 ? vS + col * 2 : kbS + (col - 128) * 2; const LAS float* bz = wave < 4 ? betaS : egcS;
#pragma unroll
              for (int b = 0; b < 4; ++b) { f32x4 y;
#pragma unroll
                  for (int r = 0; r < 4; ++r) { const int i = 16 * b + 4 * quad + r; y[r] = bf2f(*(const LAS bf16*)(rz + i * 272)) * bz[i]; }
                  if (b >= 1) { f32x4 p = z4;
#pragma unroll
                      for (int kk = 0; kk < (b >= 3 ? 2 : 1); ++kk) { const bf16x8 af = *(const LAS bf16x8*)(Lb + (16 * b + lc) * 144 + (32 * kk + 8 * quad) * 2);
                          const bf16x8 bfv = (32 * kk + 8 * quad < 16 * b) ? *(const LAS bf16x8*)(XTw + lc * 112 + (32 * kk + 8 * quad) * 2) : z8;
                          p = __builtin_amdgcn_mfma_f32_16x16x32_bf16(af, bfv, p, 0, 0, 0); }
                      y = y - p; }
                  *(LAS v2u*)(YTw + lc * 48 + quad * 8) = (v2u){pk2(y[0], y[1]), pk2(y[2], y[3])};
                  asm volatile("" ::: "memory");
                  const bf16x8 yb = quad < 2 ? *(const LAS bf16x8*)(YTw + lc * 48 + quad * 16) : z8;
                  const f32x4 x = __builtin_amdgcn_mfma_f32_16x16x32_bf16(tdf[b], yb, z4, 0, 0, 0);
                  if (b < 3) *(LAS v2u*)(XTw + lc * 112 + (16 * b + 4 * quad) * 2) = (v2u){pk2(x[0], x[1]), pk2(x[2], x[3])};
                  asm volatile("" ::: "memory");
#pragma unroll
                  for (int r = 0; r < 4; ++r) XS[(16 * b + 4 * quad + r) * 264 + col] = (bf16)f2bf(x[r]); } } }
        G1_BAR();
#pragma unroll
        for (int i = 0; i < 2; ++i) { const int p = tid + 512 * i, comb = p >> 6, ln = p & 63, t = comb >> 3, s = comb & 7; const int c = 32 * t + (ln & 31), k0 = 16 * s + 8 * (ln >> 5);
            *(v4u*)(WF + (su * 16 + comb) * 512 + ln * 8) = *(const LAS v4u*)(XS + c * 264 + 128 + k0); }
        { const int t = wave >> 2, ns = wave & 3; unsigned w[8];
#pragma unroll
          for (int r = 0; r < 8; ++r) { const unsigned lo = XS[(32 * t + crow(2 * r, h)) * 264 + 32 * ns + l31], hi = XS[(32 * t + crow(2 * r + 1, h)) * 264 + 32 * ns + l31]; w[r] = lo | (hi << 16); }
          bf16* dst = UF + ((su * 8 + wave) * 64 + lane) * 16; *(v4u*)dst = (v4u){w[0], w[1], w[2], w[3]}; *(v4u*)(dst + 8) = (v4u){w[4], w[5], w[6], w[7]}; }
        G1_BAR();
    }
}

#undef G1_BAR
#undef G1_FETCH
DI void ph_gdn_chain(const Frame& F, const Args& a, int n_lo, int n_hi) {
    const int xg = F.vcu >> 5, wx = F.vcu & 31; if (F.G != 256 ? F.vcu >= 128 : wx >= 20) return;
    const bool helper = F.G == 256 && wx >= 16;
    const int hv = F.G == 256 ? 4 * xg + (helper ? wx - 16 : wx >> 2) : F.vcu >> 2, ns = F.G == 256 ? wx & 3 : F.vcu & 3, hk = hv >> 1;
    const bf16* QN = (const bf16*)(a.ws + WS_SCR + SC_QN);
    const bf16* WF = (const bf16*)(a.ws + GD_WF); const bf16* UF = (const bf16*)(a.ws + GD_UF); const bf16* INF = (const bf16*)(a.ws + GD_IN); const bf16* KTF = (const bf16*)(a.ws + GD_KT); const bf16* QF = (const bf16*)(a.ws + GD_QF); const float* GC = (const float*)(a.ws + GD_GC);
    bf16* O = (bf16*)(a.ws + WS_SCR + SC_O);
    gu32* prog = F.ctl + CW_PROG + hv * 16;
    if (helper && GDN_NO_HELPER) return;
    if (helper) { unsigned sink = 0u; const int tid = F.tid;
        for (int n0 = n_lo; n0 < n_hi; n0 += 4) {
            if (n0 >= n_lo + 8) { if (tid == 0) { unsigned sp = 0; while ((int)__hip_atomic_load(prog, RLX_AGENT) < n0 - 4 && ++sp < 20000u) __builtin_amdgcn_s_sleep(8); } __syncthreads(); }
            unsigned v[5];
#pragma unroll
            for (int i = 0; i < 5; ++i) { const int li = tid + 512 * i;
                const int st = li / 580, ln = li % 580, n = n0 + st; const unsigned* p = nullptr;
                if (st < 4 && n < n_hi) { const size_t unit = (size_t)hv * GDN_NCH + n, kunit = (size_t)hk * GDN_NCH + n;
                    if (ln < 128) p = (const unsigned*)(WF + unit * 8192 + ln * 64);
                    else if (ln < 256) p = (const unsigned*)(UF + unit * 8192 + (ln - 128) * 64);
                    else if (ln < 320) p = (const unsigned*)(INF + unit * 4096 + (ln - 256) * 64);
                    else if (ln < 448) p = (const unsigned*)(KTF + kunit * 8192 + (ln - 320) * 64);
                    else if (ln < 576) p = (const unsigned*)(QF + kunit * 8192 + (ln - 448) * 64);
                    else if (ln < 579) p = (const unsigned*)(GC + unit * GC_STRIDE + (ln - 576) * 32); }
                v[i] = p ? *p : 0u; }
#pragma unroll
            for (int i = 0; i < 5; ++i) sink += v[i];
        }
        if (sink == 0x12345u) __hip_atomic_store(F.ctl + CW_TMO + 2, sink, RLX_AGENT);
        return; }
    LAS unsigned char* ST = F.lds + RING_OFF; LAS unsigned char* VN = ST + 8704; LAS unsigned char* VND = ST + 13312;
    const int lane = F.lane, wave = F.wave, l31 = lane & 31, h = lane >> 5;
    for (int i = F.tid; i < 8704 / 4; i += NWAVES * 64) ((LAS unsigned*)ST)[i] = 0u;
#define GDN_BAR() do { asm volatile("s_waitcnt lgkmcnt(0)" ::: "memory"); __builtin_amdgcn_s_barrier(); asm volatile("" ::: "memory"); } while (0)
    GDN_BAR();
    f32x16 S;
#pragma unroll
    for (int r = 0; r < 16; ++r) S[r] = 0.f;
    const int role = wave < 2 ? 0 : (wave < 4 ? 1 : 2); const int t = wave & 1, kt = wave & 3;
    bf16x8 A8[8]; bf16x8 A4[4]; v4u U0 = (v4u){0u, 0u, 0u, 0u}, U1 = U0; f32x4 G4[4]; float gl = 0.f, egl = 1.f;
#pragma unroll
    for (int s = 0; s < 8; ++s) A8[s] = (bf16x8){0, 0, 0, 0, 0, 0, 0, 0};
#pragma unroll
    for (int s = 0; s < 4; ++s) { A4[s] = (bf16x8){0, 0, 0, 0, 0, 0, 0, 0}; G4[s] = (f32x4){0.f, 0.f, 0.f, 0.f}; }
#define GDN_LOAD(nn) do { const size_t unit_ = (size_t)hv * GDN_NCH + (nn); const float* gc_ = GC + unit_ * GC_STRIDE; \
        if (role == 0) { \
            const bf16* up_ = UF + (((unit_ * 2 + t) * 4 + ns) * 64 + lane) * 16; U0 = *(const v4u*)up_; U1 = *(const v4u*)(up_ + 8); \
            _Pragma("unroll") for (int g = 0; g < 4; ++g) G4[g] = *(const f32x4*)(gc_ + 32 * t + 8 * g + 4 * h); gl = gc_[64]; } \
        else if (role == 1) { const size_t qunit_ = (size_t)hk * GDN_NCH + (nn); \
            _Pragma("unroll") for (int s = 0; s < 4; ++s) A4[s] = *(const bf16x8*)(INF + ((unit_ * 2 + t) * 4 + s) * 512 + lane * 8); \
            _Pragma("unroll") for (int g = 0; g < 4; ++g) G4[g] = *(const f32x4*)(gc_ + 32 * t + 8 * g + 4 * h); } \
        else { const size_t kunit_ = (size_t)hk * GDN_NCH + (nn); \
            _Pragma("unroll") for (int s = 0; s < 4; ++s) A4[s] = *(const bf16x8*)(KTF + ((kunit_ * 4 + kt) * 4 + s) * 512 + lane * 8); egl = gc_[65]; } } while (0)
    float* SV = (float*)(a.ws + GD_SAVE) + ((size_t)((hv * 4 + ns) * 4 + kt) * 64 + lane) * 16;
    if (n_lo > 0 && role == 2) {
#pragma unroll
        for (int g = 0; g < 4; ++g) { const f32x4 v = *(const f32x4*)(SV + 4 * g); S[4 * g] = v.x; S[4 * g + 1] = v.y; S[4 * g + 2] = v.z; S[4 * g + 3] = v.w;
            *(LAS v2u*)(ST + l31 * 272 + (32 * kt + 8 * g + 4 * h) * 2) = (v2u){pk2(v.x, v.y), pk2(v.z, v.w)}; }
    }
    GDN_BAR();
#define GDN_LOADA(AC, nn) do { if (role == 0) { const size_t u_ = (size_t)hv * GDN_NCH + (nn); _Pragma("unroll") for (int s = 0; s < 8; ++s) AC[s] = *(const bf16x8*)(WF + ((u_ * 2 + t) * 8 + s) * 512 + lane * 8); } \
        else if (role == 1) { const size_t q_ = (size_t)hk * GDN_NCH + (nn); _Pragma("unroll") for (int s = 0; s < 8; ++s) AC[s] = *(const bf16x8*)(QF + ((q_ * 2 + t) * 8 + s) * 512 + lane * 8); } } while (0)
    bf16x8 A8q[8];
#pragma unroll
    for (int s = 0; s < 8; ++s) A8q[s] = (bf16x8){0, 0, 0, 0, 0, 0, 0, 0};
    GDN_LOADA(A8, n_lo); if (n_lo + 1 < n_hi) GDN_LOADA(A8q, n_lo + 1);
    GDN_LOAD(n_lo);
#define GDN_STEP(n, AC) do { \
        bf16x8 a4[4]; const v4u u0 = U0, u1 = U1; f32x4 g4[4]; const float cgl = gl, cegl = egl; \
        _Pragma("unroll") \
        for (int s = 0; s < 4; ++s) { a4[s] = A4[s]; g4[s] = G4[s]; } \
        if (n + 1 < n_hi) GDN_LOAD(n + 1); \
        if (ns == 0 && F.tid == 0) __hip_atomic_store(prog, (unsigned)n, RLX_AGENT); \
        f32x16 acc; \
        _Pragma("unroll") \
        for (int r = 0; r < 16; ++r) acc[r] = 0.f; \
        if (role < 2) { \
        _Pragma("unroll") \
            for (int s = 0; s < 8; ++s) acc = MFMA32(AC[s], *(const LAS bf16x8*)(ST + l31 * 272 + 32 * s + 16 * h), acc); \
            asm volatile("" :: "v"(acc[0])); \
            if (n + 2 < n_hi) GDN_LOADA(AC, n + 2); \
        } \
        if (role == 0) { const unsigned uw[8] = {u0.x, u0.y, u0.z, u0.w, u1.x, u1.y, u1.z, u1.w}; \
        _Pragma("unroll") \
            for (int g = 0; g < 4; ++g) { float vn[4], vd[4]; \
        _Pragma("unroll") \
                for (int q = 0; q < 4; ++q) { const int r = 4 * g + q; const float uv = (r & 1) ? bfhi(uw[r >> 1]) : bflo(uw[r >> 1]); vn[q] = uv - acc[r]; vd[q] = vn[q] * __expf(cgl - g4[g][q]); } \
                *(LAS v2u*)(VN + l31 * 144 + (32 * t + 8 * g + 4 * h) * 2) = (v2u){pk2(vn[0], vn[1]), pk2(vn[2], vn[3])}; \
                *(LAS v2u*)(VND + l31 * 144 + (32 * t + 8 * g + 4 * h) * 2) = (v2u){pk2(vd[0], vd[1]), pk2(vd[2], vd[3])}; } \
        } else if (role == 1) { \
        _Pragma("unroll") \
            for (int g = 0; g < 4; ++g) \
        _Pragma("unroll") \
                for (int q = 0; q < 4; ++q) acc[4 * g + q] *= __expf(g4[g][q]); \
        } \
        GDN_BAR(); \
        if (role == 1) { \
        _Pragma("unroll") \
            for (int s = 0; s < 4; ++s) acc = MFMA32(a4[s], *(const LAS bf16x8*)(VN + l31 * 144 + 32 * s + 16 * h), acc); \
        _Pragma("unroll") \
            for (int r = 0; r < 16; ++r) { const int rr = chunk_row(n, 32 * t + crow(r, h)); if (rr >= 0) O[(size_t)rr * 4096 + hv * 128 + 32 * ns + l31] = (bf16)f2bf(acc[r]); } \
        } else if (role == 2) { \
        _Pragma("unroll") \
            for (int r = 0; r < 16; ++r) S[r] *= cegl; \
        _Pragma("unroll") \
            for (int s = 0; s < 4; ++s) S = MFMA32(a4[s], *(const LAS bf16x8*)(VND + l31 * 144 + 32 * s + 16 * h), S); \
        _Pragma("unroll") \
            for (int g = 0; g < 4; ++g) *(LAS v2u*)(ST + l31 * 272 + (32 * kt + 8 * g + 4 * h) * 2) = (v2u){pk2(S[4 * g], S[4 * g + 1]), pk2(S[4 * g + 2], S[4 * g + 3])}; \
        } \
        GDN_BAR(); \
    } while (0)
    for (int n2 = n_lo; n2 < n_hi; n2 += 2) { GDN_STEP(n2, A8); if (n2 + 1 < n_hi) GDN_STEP(n2 + 1, A8q); }
#undef GDN_STEP
#undef GDN_LOADA
    if (n_hi < GDN_NCH && role == 2) {
#pragma unroll
        for (int g = 0; g < 4; ++g) *(f32x4*)(SV + 4 * g) = (f32x4){S[4 * g], S[4 * g + 1], S[4 * g + 2], S[4 * g + 3]}; }
#undef GDN_LOAD
#undef GDN_BAR
}

constexpr int RW_NSC = 258, RW_UNITS = 129 * 16;
DI int sub_row(int sc, int t) { const int n = sc >> 1, sub = sc & 1; return n == 0 ? ((sub == 0 && t >= 16) ? TX + t - 16 : -1) : 64 * (n - 1) + 32 * sub + t; }
constexpr size_t RW_BASE = WS_PROJ + 92 * MiB;
constexpr size_t RW_RH = RW_BASE, RW_RL = RW_BASE + 33 * MiB, RW_GT = RW_BASE + 66 * MiB, RW_GAM = RW_BASE + 99 * MiB;
constexpr size_t RW_PR = WS_SCR + 195 * MiB, RW_AT = WS_SCR + 211 * MiB + 256 * 1024, RW_VTF = WS_SCR + 219 * MiB + 512 * 1024, RW_SALL = WS_SCR + 235 * MiB + 768 * 1024;
constexpr size_t RW_XSAVE = 1 * MiB + 640 * 1024;
constexpr size_t RW_VV = WS_YMIX + 34 * MiB, RW_BON = WS_YMIX + 52 * MiB, LR_H = WS_YMIX + 54 * MiB, LR_A = WS_YMIX + 56 * MiB, LR_C = WS_YMIX + 58 * MiB;
constexpr size_t RW_SCH = (size_t)RW_NSC * 16;
static_assert((size_t)MP * EV_NP * 2 <= 92 * MiB && RW_SCH * 8192 <= 33 * MiB && RW_GAM + RW_SCH * 256 <= WS_SCR, "rwkv map (proj region)");
static_assert(WS_SCR + SC_LIX + (size_t)MP * 4096 <= RW_PR && RW_PR + RW_SCH * 4096 <= RW_AT && RW_AT + RW_SCH * 2048 <= RW_VTF && RW_VTF + RW_SCH * 4096 <= RW_SALL && RW_SALL + RW_SCH * 8192 <= WS_END, "rwkv map (scratch region)");
static_assert((size_t)MP * DM * 2 <= 34 * MiB && RW_VV + (size_t)MP * 2048 <= RW_BON && RW_BON + (size_t)MP * 64 <= LR_H && LR_H + RW_SCH * 256 <= LR_A && LR_A + RW_SCH * 256 <= LR_C && LR_C + RW_SCH * 256 <= WS_PROJ, "rwkv map (ymix region)");

DI void sub_rows(int sc, int& t0, int& rbase) { if (sc >= 2) { t0 = 0; rbase = 64 * ((sc >> 1) - 1) + 32 * (sc & 1); } else if (sc == 0) { t0 = 16; rbase = TX - 16; } else { t0 = 32; rbase = 0; } }
DI void lru_local(const Frame& F, const Args& a, int gw, int ngw) {
    const bf16* LA = (const bf16*)(a.ws + WS_SCR + SC_LA); const bf16* LIX = (const bf16*)(a.ws + WS_SCR + SC_LIX);
    float* HL = (float*)(a.ws + LR_H); float* AP = (float*)(a.ws + LR_A);
    for (int item = gw; item < RW_NSC * 16; item += ngw) { const int sc = item >> 4, c = (item & 15) * 64 + F.lane; int t0, rbase; sub_rows(sc, t0, rbase);
        float av[32], ix[32];
#pragma unroll
        for (int t = 0; t < 32; ++t) { const size_t o = (size_t)(rbase + (t >= t0 ? t : 32)) * 1024 + c; av[t] = bf2f(LA[o]); ix[t] = bf2f(LIX[o]); }
        float h = 0.f, p = 1.f;
#pragma unroll
        for (int t = 0; t < 32; ++t) { const float om = t >= t0 ? av[t] : 0.f, x_ = t >= t0 ? ix[t] : 0.f, a_ = 1.0f - om; h = a_ * h + sqrtf(om * (1.0f + a_)) * x_; p *= a_; }
        HL[sc * 1024 + c] = h; AP[sc * 1024 + c] = p; }
}
DI void lru_apply(const Frame& F, const Args& a) {
    const bf16* P = (const bf16*)(a.ws + WS_PROJ); const bf16* LA = (const bf16*)(a.ws + WS_SCR + SC_LA); const bf16* LIX = (const bf16*)(a.ws + WS_SCR + SC_LIX);
    const float* CR = (const float*)(a.ws + LR_C); bf16* Y = (bf16*)(a.ws + WS_YMIX);
    for (int item = F.gw; item < RW_NSC * 16; item += F.NGW) { const int sc = item >> 4, c = (item & 15) * 64 + F.lane; int t0, rbase; sub_rows(sc, t0, rbase); if (t0 >= 32) continue;
        float h = CR[sc * 1024 + c];
#pragma unroll
        for (int tb = 0; tb < 32; tb += 16) { float av[16], ix[16], gb[16];
#pragma unroll
            for (int t = 0; t < 16; ++t) { const size_t r_ = (size_t)(rbase + (tb + t >= t0 ? tb + t : 32)); av[t] = bf2f(LA[r_ * 1024 + c]); ix[t] = bf2f(LIX[r_ * 1024 + c]); gb[t] = bf2f(P[r_ * EV_NP + EV_GB + c]); }
#pragma unroll
            for (int t = 0; t < 16; ++t) { if (tb + t >= t0) { const float a_ = 1.0f - av[t]; h = a_ * h + sqrtf(av[t] * (1.0f + a_)) * ix[t]; Y[(size_t)(rbase + tb + t) * DM + 1024 + c] = (bf16)f2bf(h * gelu_tanh(gb[t])); } } } }
}

DI void ph_rwkv_chunk(const Frame& F, const Args& a, int n_lo, int n_hi, int wg0) {
    if (F.vcu < wg0) return;
    const bf16* P = (const bf16*)(a.ws + WS_PROJ); const bf16* DEC = (const bf16*)(a.ws + WS_SCR + SC_DEC); const bf16* ICL = (const bf16*)(a.ws + WS_SCR + SC_ICL);
    bf16* RH = (bf16*)(a.ws + RW_RH); bf16* RL = (bf16*)(a.ws + RW_RL); bf16* GT = (bf16*)(a.ws + RW_GT); float* GAM = (float*)(a.ws + RW_GAM); bf16* PR = (bf16*)(a.ws + RW_PR); bf16* ATG = (bf16*)(a.ws + RW_AT); bf16* VTF = (bf16*)(a.ws + RW_VTF);
    bf16* VV = (bf16*)(a.ws + RW_VV); float* BON = (float*)(a.ws + RW_BON);
    LAS unsigned char* L = F.lds + RING_OFF;
    LAS float* wS = (LAS float*)L; LAS float* aS = wS + 4096; LAS float* bS = wS + 8192; LAS float* rS = wS + 12288; LAS float* kS = wS + 16384;
    LAS unsigned char* vT = L + 81920; LAS unsigned char* aT = L + 91136; LAS unsigned char* rT = L + 100352; LAS unsigned char* kT = L + 109568; LAS unsigned char* bT = L + 118784;
    LAS unsigned char* AT = L + 128000; LAS unsigned char* NT = L + 133120; LAS float* gam = (LAS float*)(L + 138240);
    LAS unsigned char* aTl = L; LAS unsigned char* bTl = L + 9216;
    const int tid = F.tid, lane = F.lane, wave = F.wave, l31 = lane & 31, h = lane >> 5;
    const float* mu = a.in[6];
    for (int unit = n_lo * 16 + (F.vcu - wg0); unit < n_hi * 16; unit += F.G - wg0) {
        const int n = unit >> 4, hd = unit & 15;
#ifdef R1_REP_A
        _Pragma("unroll 1") for (int rep_ = 0; rep_ < 2; ++rep_)
#endif
        { const int tok = tid >> 3, cg = tid & 7, c0 = hd * 64 + cg * 8; const int rr = sub_row(2 * n + (tok >> 5), tok & 31);
          float wv[8], av[8], bv[8], rv[8], kv[8], vv[8];
#pragma unroll
          for (int q = 0; q < 8; ++q) { wv[q] = 0.f; av[q] = 0.f; bv[q] = 0.f; rv[q] = 0.f; kv[q] = 0.f; vv[q] = 0.f; }
          if (rr >= 0) { const int pos = row_pos(rr); const bf16* cur = P + (size_t)rr * EV_NP + c0; const bf16* prv = pos > 0 ? P + (size_t)pos_row(pos - 1) * EV_NP + c0 : nullptr;
              const v4u z4 = (v4u){0u, 0u, 0u, 0u};
              const v4u cr = *(const v4u*)cur, ck = *(const v4u*)(cur + 1024), cv = *(const v4u*)(cur + 2048);
              const v4u qr = prv ? *(const v4u*)prv : z4, qk = prv ? *(const v4u*)(prv + 1024) : z4, qv = prv ? *(const v4u*)(prv + 2048) : z4;
              const unsigned crw[4] = {cr.x, cr.y, cr.z, cr.w}, ckw[4] = {ck.x, ck.y, ck.z, ck.w}, cvw[4] = {cv.x, cv.y, cv.z, cv.w}, qrw[4] = {qr.x, qr.y, qr.z, qr.w}, qkw[4] = {qk.x, qk.y, qk.z, qk.w}, qvw[4] = {qv.x, qv.y, qv.z, qv.w};
              float ss = 0.f, bon = 0.f; float kk[8], ic[8];
#pragma unroll
              for (int q = 0; q < 8; ++q) { const int c = c0 + q; const float crf = (q & 1) ? bfhi(crw[q >> 1]) : bflo(crw[q >> 1]), ckf = (q & 1) ? bfhi(ckw[q >> 1]) : bflo(ckw[q >> 1]), cvf = (q & 1) ? bfhi(cvw[q >> 1]) : bflo(cvw[q >> 1]);
                  const float prf = (q & 1) ? bfhi(qrw[q >> 1]) : bflo(qrw[q >> 1]), pkf = (q & 1) ? bfhi(qkw[q >> 1]) : bflo(qkw[q >> 1]), pvf = (q & 1) ? bfhi(qvw[q >> 1]) : bflo(qvw[q >> 1]);
                  rv[q] = crf + (prf - crf) * mu[c]; kk[q] = ckf + (pkf - ckf) * mu[1024 + c]; vv[q] = cvf + (pvf - cvf) * mu[2048 + c];
                  wv[q] = -bf2f(DEC[(size_t)rr * 1024 + c])  ; ic[q] = bf2f(ICL[(size_t)rr * 1024 + c]);
                  const float kkv = kk[q] * a.in[12][c]; av[q] = kkv; ss += kkv * kkv; kv[q] = kk[q] * (1.0f + (ic[q] - 1.0f) * a.in[13][c]); bon += rv[q] * kv[q] * a.in[14][c]; }
              ss += __shfl_xor(ss, 1); ss += __shfl_xor(ss, 2); ss += __shfl_xor(ss, 4); bon += __shfl_xor(bon, 1); bon += __shfl_xor(bon, 2); bon += __shfl_xor(bon, 4);
              const float inv = 1.0f / fmaxf(sqrtf(ss), 1e-12f);
#pragma unroll
              for (int q = 0; q < 8; ++q) { const float kkn = av[q] * inv; av[q] = -kkn; bv[q] = kkn * ic[q]; }
              if (cg == 0) BON[(size_t)rr * 16 + hd] = bon;
              *(v4u*)(VV + (size_t)rr * 1024 + c0) = (v4u){pk2(vv[0], vv[1]), pk2(vv[2], vv[3]), pk2(vv[4], vv[5]), pk2(vv[6], vv[7])}; }
          const int o = tok * 64 + cg * 8;
          *(LAS f32x4*)(wS + o) = (f32x4){wv[0], wv[1], wv[2], wv[3]}; *(LAS f32x4*)(wS + o + 4) = (f32x4){wv[4], wv[5], wv[6], wv[7]};
          *(LAS f32x4*)(aS + o) = (f32x4){av[0], av[1], av[2], av[3]}; *(LAS f32x4*)(aS + o + 4) = (f32x4){av[4], av[5], av[6], av[7]};
          *(LAS f32x4*)(bS + o) = (f32x4){bv[0], bv[1], bv[2], bv[3]}; *(LAS f32x4*)(bS + o + 4) = (f32x4){bv[4], bv[5], bv[6], bv[7]};
          *(LAS f32x4*)(rS + o) = (f32x4){rv[0], rv[1], rv[2], rv[3]}; *(LAS f32x4*)(rS + o + 4) = (f32x4){rv[4], rv[5], rv[6], rv[7]};
          *(LAS f32x4*)(kS + o) = (f32x4){kv[0], kv[1], kv[2], kv[3]}; *(LAS f32x4*)(kS + o + 4) = (f32x4){kv[4], kv[5], kv[6], kv[7]};
#pragma unroll
          for (int q = 0; q < 8; ++q) *(LAS bf16*)(vT + (cg * 8 + q) * 144 + tok * 2) = (bf16)f2bf(vv[q]); }
        __syncthreads();
        { typedef float f32x2 __attribute__((ext_vector_type(2)));
          const int sub = wave >> 2, blk = sub ? 3 - (wave & 3) : (wave & 3), tkn = lane >> 3, e = lane & 7, s = 8 * blk + tkn, tok = 32 * sub + s, j8 = 8 * e;
          f32x2 xk[4], xb[4];
          { const f32x4 t0 = *(const LAS f32x4*)(kS + tok * 64 + j8), t1 = *(const LAS f32x4*)(kS + tok * 64 + j8 + 4), u0 = *(const LAS f32x4*)(bS + tok * 64 + j8), u1 = *(const LAS f32x4*)(bS + tok * 64 + j8 + 4);
            xk[0] = (f32x2){t0.x, t0.y}; xk[1] = (f32x2){t0.z, t0.w}; xk[2] = (f32x2){t1.x, t1.y}; xk[3] = (f32x2){t1.z, t1.w};
            xb[0] = (f32x2){u0.x, u0.y}; xb[1] = (f32x2){u0.z, u0.w}; xb[2] = (f32x2){u1.x, u1.y}; xb[3] = (f32x2){u1.z, u1.w}; }
          for (int i = e; i < 8 * blk; i += 8) { *(LAS bf16*)(AT + ((sub * 32 + i) * 40 + s) * 2) = (bf16)0; *(LAS bf16*)(NT + ((sub * 32 + i) * 40 + s) * 2) = (bf16)0; }
#define RW_RED8(v) do { v += __builtin_bit_cast(float, __builtin_amdgcn_mov_dpp(__builtin_bit_cast(int, v), 0xB1, 0xF, 0xF, true)); v += __builtin_bit_cast(float, __builtin_amdgcn_mov_dpp(__builtin_bit_cast(int, v), 0x4E, 0xF, 0xF, true)); \
              v += __builtin_bit_cast(float, __builtin_amdgcn_mov_dpp(__builtin_bit_cast(int, v), 0x141, 0xF, 0xF, true)); } while (0)
#define RW_PASS(X_, OUTP) do { f32x2 c2 = X_[0] * a2[0]; c2 = X_[1] * a2[1] + c2; c2 = X_[2] * a2[2] + c2; c2 = X_[3] * a2[3] + c2; float c = c2.x + c2.y; RW_RED8(c); \
              const float cm = c * m; const f32x2 cm2 = (f32x2){cm, cm}; \
              _Pragma("unroll") for (int i = 0; i < 4; ++i) X_[i] = X_[i] * mw[i] + (cm2 * b2[i] + X_[i]); \
              f32x2 o2 = X_[0] * r2[0]; o2 = X_[1] * r2[1] + o2; o2 = X_[2] * r2[2] + o2; o2 = X_[3] * r2[3] + o2; float o = o2.x + o2.y; RW_RED8(o); \
              *(LAS bf16*)(OUTP + ((sub * 32 + tp) * 40 + s) * 2) = (bf16)f2bf(o * mge); } while (0)
          const LAS float* bp = wS + (32 * sub + 8 * blk) * 64 + j8;
#define RW_LOAD(P_, p_) do { P_[0] = *(const LAS f32x4*)(p_); P_[1] = *(const LAS f32x4*)((p_) + 4); P_[2] = *(const LAS f32x4*)((p_) + 4096); P_[3] = *(const LAS f32x4*)((p_) + 4100); \
              P_[4] = *(const LAS f32x4*)((p_) + 8192); P_[5] = *(const LAS f32x4*)((p_) + 8196); P_[6] = *(const LAS f32x4*)((p_) + 12288); P_[7] = *(const LAS f32x4*)((p_) + 12292); } while (0)
#define RW_STEP(P_, tp_) do { const int tp = (tp_); const float m = tp > s ? 1.f : 0.f, mge = tp >= s ? 1.f : 0.f; const f32x2 m2 = (f32x2){m, m}; \
              const f32x2 a2[4] = {(f32x2){P_[2].x, P_[2].y}, (f32x2){P_[2].z, P_[2].w}, (f32x2){P_[3].x, P_[3].y}, (f32x2){P_[3].z, P_[3].w}}, b2[4] = {(f32x2){P_[4].x, P_[4].y}, (f32x2){P_[4].z, P_[4].w}, (f32x2){P_[5].x, P_[5].y}, (f32x2){P_[5].z, P_[5].w}}; \
              const f32x2 r2[4] = {(f32x2){P_[6].x, P_[6].y}, (f32x2){P_[6].z, P_[6].w}, (f32x2){P_[7].x, P_[7].y}, (f32x2){P_[7].z, P_[7].w}}; \
              const f32x2 mw[4] = {m2 * (f32x2){P_[0].x, P_[0].y}, m2 * (f32x2){P_[0].z, P_[0].w}, m2 * (f32x2){P_[1].x, P_[1].y}, m2 * (f32x2){P_[1].z, P_[1].w}}; \
              RW_PASS(xk, AT); RW_PASS(xb, NT); } while (0)
          f32x4 PA[8], PB[8]; RW_LOAD(PA, bp);
          for (int t2 = 8 * blk; t2 < 32; t2 += 2, bp += 128) { RW_LOAD(PB, bp + 64); __builtin_amdgcn_sched_barrier(0); RW_STEP(PA, t2); RW_LOAD(PA, bp + 128); __builtin_amdgcn_sched_barrier(0); RW_STEP(PB, t2 + 1); }
#undef RW_STEP
#undef RW_LOAD
#undef RW_PASS
#undef RW_RED8
#pragma unroll
          for (int i = 0; i < 4; ++i) { *(LAS bf16*)(kT + (j8 + 2 * i) * 144 + tok * 2) = (bf16)f2bf(xk[i].x); *(LAS bf16*)(kT + (j8 + 2 * i + 1) * 144 + tok * 2) = (bf16)f2bf(xk[i].y);
              *(LAS bf16*)(bT + (j8 + 2 * i) * 144 + tok * 2) = (bf16)f2bf(xb[i].x); *(LAS bf16*)(bT + (j8 + 2 * i + 1) * 144 + tok * 2) = (bf16)f2bf(xb[i].y); }
          const bool gwave = (blk == 3); const int j = lane;
          if (gwave) { float g = 1.f;
#pragma unroll
              for (int tp = 0; tp < 32; ++tp) { const int tk = 32 * sub + tp; const float w_ = 1.0f + wS[tk * 64 + j], a_ = aS[tk * 64 + j], r_ = rS[tk * 64 + j];
                  *(LAS bf16*)(aT + j * 144 + tk * 2) = (bf16)f2bf(a_ * g);
                  g *= w_; *(LAS bf16*)(rT + j * 144 + tk * 2) = (bf16)f2bf(r_ * g); }
              gam[sub * 64 + j] = g; }
        }
        __syncthreads();
#ifdef R1_REP_C
        _Pragma("unroll 1") for (int rep_ = 0; rep_ < 2; ++rep_) {
#endif
        { const int sub = wave >> 2, t1 = (wave >> 1) & 1, t0 = wave & 1; const size_t sch = (size_t)hd * RW_NSC + (2 * n + sub);
          { f32x16 acc;
#pragma unroll
            for (int r = 0; r < 16; ++r) acc[r] = 0.f;
#pragma unroll
            for (int ks = 0; ks < 2; ++ks) { const int ao = (32 * t1 + l31) * 144 + (32 * sub + 16 * ks + 8 * h) * 2, bo = (32 * t0 + l31) * 144 + (32 * sub + 16 * ks + 8 * h) * 2;
                acc = MFMA32(*(const LAS bf16x8*)(aT + ao), *(const LAS bf16x8*)(bT + bo), acc); }
            const int jp = 32 * t0 + l31;
#pragma unroll
            for (int g = 0; g < 4; ++g) *(v2u*)(RH + (sch * 64 + jp) * 64 + 32 * t1 + 8 * g + 4 * h) = (v2u){pk2(acc[4 * g], acc[4 * g + 1]), pk2(acc[4 * g + 2], acc[4 * g + 3])};
            if (t1 == 0 && t0 == 0) GAM[sch * 64 + lane] = gam[sub * 64 + lane]; }
          { f32x16 acc;
#pragma unroll
            for (int r = 0; r < 16; ++r) acc[r] = 0.f;
#pragma unroll
            for (int ks = 0; ks < 2; ++ks) acc = MFMA32(*(const LAS bf16x8*)(kT + (32 * t1 + l31) * 144 + (32 * sub + 16 * ks + 8 * h) * 2), *(const LAS bf16x8*)(vT + (32 * t0 + l31) * 144 + (32 * sub + 16 * ks + 8 * h) * 2), acc);
            bf16* dst = GT + ((sch * 4 + t1 * 2 + t0) * 64 + lane) * 16;
            *(v4u*)dst = (v4u){pk2(acc[0], acc[1]), pk2(acc[2], acc[3]), pk2(acc[4], acc[5]), pk2(acc[6], acc[7])}; *(v4u*)(dst + 8) = (v4u){pk2(acc[8], acc[9]), pk2(acc[10], acc[11]), pk2(acc[12], acc[13]), pk2(acc[14], acc[15])}; } }
        if (wave < 4) { const int sub = wave >> 1, jt = wave & 1; const size_t sch = (size_t)hd * RW_NSC + (2 * n + sub);
            f32x16 acc;
#pragma unroll
            for (int r = 0; r < 16; ++r) acc[r] = bf2f(*(const LAS bf16*)(rT + (32 * jt + crow(r, h)) * 144 + (32 * sub + l31) * 2));
#pragma unroll
            for (int ks = 0; ks < 2; ++ks) acc = MFMA32(*(const LAS bf16x8*)(aT + (32 * jt + l31) * 144 + (32 * sub + 16 * ks + 8 * h) * 2), *(const LAS bf16x8*)(NT + (sub * 32 + l31) * 80 + (16 * ks + 8 * h) * 2), acc);
#pragma unroll
            for (int g = 0; g < 4; ++g) *(v2u*)(PR + (sch * 32 + l31) * 64 + 32 * jt + 8 * g + 4 * h) = (v2u){pk2(acc[4 * g], acc[4 * g + 1]), pk2(acc[4 * g + 2], acc[4 * g + 3])};
        } else { const int t2 = tid - 256, sub = t2 >> 7, t = (t2 >> 2) & 31, s8 = (t2 & 3) * 8; const size_t sch = (size_t)hd * RW_NSC + (2 * n + sub);
            *(v4u*)(ATG + (sch * 32 + t) * 32 + s8) = *(const LAS v4u*)(AT + (sub * 32 + t) * 80 + s8 * 2); }
        { const int sub = tid >> 8, it = (tid >> 7) & 1, ks = (tid >> 6) & 1; const size_t sch = (size_t)hd * RW_NSC + (2 * n + sub);
          *(v4u*)(VTF + ((sch * 4 + it * 2 + ks) * 64 + lane) * 8) = *(const LAS v4u*)(vT + (32 * it + l31) * 144 + (32 * sub + 16 * ks + 8 * h) * 2); }
#ifdef R1_REP_C
        }
#endif
        __syncthreads();
    }
}

DI void ph_rwkv_chain(const Frame& F, const Args& a, int sc_lo, int sc_hi) {
    if (F.vcu >= 16 && F.vcu < 32) {
        if (sc_hi < RW_NSC) return;
        constexpr int GS = 33; static_assert(8 * GS >= RW_NSC, "carry groups");
        const int g = F.tid >> 6, c = (F.vcu - 16) * 64 + F.lane; const float* HL = (const float*)(a.ws + LR_H); const float* AP = (const float*)(a.ws + LR_A); float* CR = (float*)(a.ws + LR_C);
        float hl[GS], ap[GS];
#pragma unroll
        for (int i = 0; i < GS; ++i) { const int sc = g * GS + i, scc = sc < RW_NSC ? sc : RW_NSC - 1; hl[i] = HL[scc * 1024 + c]; ap[i] = AP[scc * 1024 + c]; }
        float A = 1.f, H = 0.f;
#pragma unroll
        for (int i = 0; i < GS; ++i) if (g * GS + i < RW_NSC) { H = ap[i] * H + hl[i]; A *= ap[i]; }
        LAS float* cs = (LAS float*)(F.lds + RING_OFF);
        cs[(g * 64 + F.lane) * 2] = A; cs[(g * 64 + F.lane) * 2 + 1] = H;
        __syncthreads();
        float carry = 0.f;
        for (int q = 0; q < g; ++q) carry = cs[(q * 64 + F.lane) * 2] * carry + cs[(q * 64 + F.lane) * 2 + 1];
#pragma unroll
        for (int i = 0; i < GS; ++i) { const int sc = g * GS + i; if (sc < RW_NSC) { CR[sc * 1024 + c] = carry; carry = ap[i] * carry + hl[i]; } }
        return; }
    if (F.vcu >= 16) return;
    const int hd = F.vcu; const bf16* RH = (const bf16*)(a.ws + RW_RH); const bf16* RL = (const bf16*)(a.ws + RW_RL); const bf16* GT = (const bf16*)(a.ws + RW_GT); const float* GAM = (const float*)(a.ws + RW_GAM); bf16* SALL = (bf16*)(a.ws + RW_SALL);
    constexpr int RW_NS = 7, SLOT = 8192 + 8192 + 1024;
    LAS unsigned char* XS = F.lds + RING_OFF; LAS unsigned char* RG = XS + 2 * 9216;
    const int lane = F.lane, wave = F.wave, l31 = lane & 31, h = lane >> 5, jt = (wave >> 1) & 1, it = wave & 1, lw = wave & 3;
    for (int i = F.tid; i < 2 * 9216 / 4; i += NWAVES * 64) ((LAS unsigned*)XS)[i] = 0u;
    __syncthreads();
#define RW_BAR() do { asm volatile("s_waitcnt lgkmcnt(0)" ::: "memory"); __builtin_amdgcn_s_barrier(); asm volatile("" ::: "memory"); } while (0)
    const unsigned rg0 = (unsigned)(uintptr_t)RG;
    int offR[4], offG[4]; const int lw2 = wave & 1;
#pragma unroll
    for (int i = 0; i < 4; ++i) { const int b = 4 * lw2 + i, row = 8 * b + (lane >> 3), pc = lane & 7; offR[i] = row * 64 + ((pc ^ (row & 7)) * 8); offG[i] = (b * 64 + lane) * 8; }
    const int offM = (lane & 15) * 4;
#define RW_DMA(src, dst) do { unsigned keep_; asm volatile("s_mov_b32 %0, m0\n\ts_mov_b32 m0, %2\n\ts_nop 0\n\tglobal_load_lds_dwordx4 %1, off\n\ts_mov_b32 m0, %0" : "=&s"(keep_) : "v"(src), "s"(dst) : "memory"); } while (0)
#define RW_ISSUE(scn) do { const int s_ = (scn) < RW_NSC ? (scn) : RW_NSC - 1; const size_t sch_ = (size_t)hd * RW_NSC + s_; \
        const unsigned sb_ = (unsigned)__builtin_amdgcn_readfirstlane((int)(rg0 + (unsigned)((scn) % RW_NS) * SLOT)); \
        _Pragma("unroll") for (int i_ = 0; i_ < 4; ++i_) { const unsigned bo_ = (unsigned)__builtin_amdgcn_readfirstlane((4 * lw2 + i_) * 1024); \
            RW_DMA(RH + sch_ * 4096 + offR[i_], sb_ + bo_); RW_DMA(GT + sch_ * 4096 + offG[i_], sb_ + 8192 + bo_); } \
        RW_DMA(GAM + sch_ * 64 + offM, sb_ + 16384); } while (0)
#define RW_WAITV(n) asm volatile("s_waitcnt vmcnt(" #n ")" ::: "memory")
    f32x16 X;
#pragma unroll
    for (int r = 0; r < 16; ++r) X[r] = 0.f;
    float* XSV = (float*)(a.ws + RW_XSAVE) + ((size_t)(hd * 4 + (wave & 3)) * 64 + lane) * 16;
    if (wave < 4 && sc_lo > 0) {
#pragma unroll
        for (int g = 0; g < 4; ++g) { const f32x4 v = *(const f32x4*)(XSV + 4 * g); X[4 * g] = v.x; X[4 * g + 1] = v.y; X[4 * g + 2] = v.z; X[4 * g + 3] = v.w;
            *(LAS v2u*)(XS + (32 * it + l31) * 144 + (32 * jt + 8 * g + 4 * h) * 2) = (v2u){pk2(v.x, v.y), pk2(v.z, v.w)}; } }
    if (wave == 4 || wave == 5) { RW_ISSUE(sc_lo); RW_ISSUE(sc_lo + 1); RW_ISSUE(sc_lo + 2); RW_ISSUE(sc_lo + 3); RW_ISSUE(sc_lo + 4); RW_ISSUE(sc_lo + 5); RW_WAITV(45); }
    RW_BAR();
    for (int sc = sc_lo; sc < sc_hi; ++sc) {
        if (wave < 4) {
            const LAS unsigned char* sb = RG + (sc % RW_NS) * SLOT;
            f32x16 acc; const size_t sch = (size_t)hd * RW_NSC + sc;
            { const v4u g0 = *(const LAS v4u*)(sb + 8192 + ((jt * 2 + it) * 64 + lane) * 32), g1 = *(const LAS v4u*)(sb + 8192 + ((jt * 2 + it) * 64 + lane) * 32 + 16);
              const unsigned gw_[8] = {g0.x, g0.y, g0.z, g0.w, g1.x, g1.y, g1.z, g1.w};
#pragma unroll
              for (int g = 0; g < 4; ++g) { const f32x4 m = *(const LAS f32x4*)(sb + 16384 + (32 * jt + 8 * g + 4 * h) * 4);
                  acc[4 * g] = bflo(gw_[2 * g]) + m.x * X[4 * g]; acc[4 * g + 1] = bfhi(gw_[2 * g]) + m.y * X[4 * g + 1]; acc[4 * g + 2] = bflo(gw_[2 * g + 1]) + m.z * X[4 * g + 2]; acc[4 * g + 3] = bfhi(gw_[2 * g + 1]) + m.w * X[4 * g + 3]; } }
            const LAS unsigned char* xb = XS + (sc & 1) * 9216 + (32 * it + l31) * 144 + 16 * h; const int ar = 32 * jt + l31; const LAS unsigned char* ab = sb + ar * 128;
#pragma unroll
            for (int ks = 0; ks < 4; ++ks) { const bf16x8 xf = *(const LAS bf16x8*)(xb + 32 * ks); const int po = (((2 * ks + h) ^ (ar & 7)) * 16);
                acc = MFMA32(*(const LAS bf16x8*)(ab + po), xf, acc); }
            X = acc;
            LAS unsigned char* xn = XS + ((sc + 1) & 1) * 9216 + (32 * it + l31) * 144;
#pragma unroll
            for (int g = 0; g < 4; ++g) *(LAS v2u*)(xn + (32 * jt + 8 * g + 4 * h) * 2) = (v2u){pk2(X[4 * g], X[4 * g + 1]), pk2(X[4 * g + 2], X[4 * g + 3])};
        } else if (wave < 6) {
            RW_ISSUE(sc + RW_NS - 1);
            RW_WAITV(45);
        } else {
            const LAS unsigned char* xi = XS + (sc & 1) * 9216; bf16* so = SALL + ((size_t)hd * RW_NSC + sc) * 4096;
#pragma unroll
            for (int q = 0; q < 4; ++q) { const int pc = (wave & 1) * 256 + 64 * q + lane, row = pc >> 3, ch = pc & 7; *(v4u*)(so + row * 64 + ch * 8) = *(const LAS v4u*)(xi + row * 144 + ch * 16); }
        }
        RW_BAR();
    }
    if (wave == 4 || wave == 5) RW_WAITV(0);
    else if (wave < 4 && sc_hi < RW_NSC) {
#pragma unroll
        for (int g = 0; g < 4; ++g) *(f32x4*)(XSV + 4 * g) = (f32x4){X[4 * g], X[4 * g + 1], X[4 * g + 2], X[4 * g + 3]}; }
#undef RW_ISSUE
#undef RW_DMA
#undef RW_WAITV
#undef RW_BAR
}

DI f32x4 ld_bf4(const bf16* p) { const v2u w = *(const v2u*)p; return (f32x4){bflo(w.x), bfhi(w.x), bflo(w.y), bfhi(w.y)}; }
DI void ph_rwkv_out(const Frame& F, const Args& a, int sc_lo, int sc_hi, int gw, int ngw) {
    const bf16* SALL = (const bf16*)(a.ws + RW_SALL); const bf16* PR = (const bf16*)(a.ws + RW_PR); const bf16* ATG = (const bf16*)(a.ws + RW_AT); const bf16* VTF = (const bf16*)(a.ws + RW_VTF);
    const bf16* VV = (const bf16*)(a.ws + RW_VV); const float* BON = (const float*)(a.ws + RW_BON); const bf16* GATE = (const bf16*)(a.ws + WS_SCR + SC_GATE); bf16* Y = (bf16*)(a.ws + WS_YMIX);
    const int lane = F.lane, l31 = lane & 31, h = lane >> 5;
    for (int item = sc_lo * 16 + gw; item < sc_hi * 16; item += ngw) { const int sc = item >> 4, hd = item & 15; if (sc == 1) continue;
        const size_t sch = (size_t)hd * RW_NSC + sc; f32x16 acc[2];
#pragma unroll
        for (int it = 0; it < 2; ++it) {
#pragma unroll
            for (int r = 0; r < 16; ++r) acc[it][r] = 0.f;
#pragma unroll
            for (int ks = 0; ks < 4; ++ks) acc[it] = MFMA32(*(const bf16x8*)(SALL + (sch * 64 + 32 * it + l31) * 64 + 16 * ks + 8 * h), *(const bf16x8*)(PR + (sch * 32 + l31) * 64 + 16 * ks + 8 * h), acc[it]);
#pragma unroll
            for (int ks = 0; ks < 2; ++ks) acc[it] = MFMA32(*(const bf16x8*)(VTF + ((sch * 4 + it * 2 + ks) * 64 + lane) * 8), *(const bf16x8*)(ATG + (sch * 32 + l31) * 32 + 16 * ks + 8 * h), acc[it]); }
        float s1 = 0.f;
#pragma unroll
        for (int it = 0; it < 2; ++it)
#pragma unroll
            for (int r = 0; r < 16; ++r) s1 += acc[it][r];
        s1 += __shfl_xor(s1, 32); const float mean = s1 * (1.0f / 64.0f); float s2 = 0.f;
#pragma unroll
        for (int it = 0; it < 2; ++it)
#pragma unroll
            for (int r = 0; r < 16; ++r) { const float d = acc[it][r] - mean; s2 += d * d; }
        s2 += __shfl_xor(s2, 32); const float rstd = 1.0f / sqrtf(s2 * (1.0f / 64.0f) + 64e-5f);
        const int rr = sub_row(sc, l31);
        if (rr >= 0) { const float bon = BON[(size_t)rr * 16 + hd];
#pragma unroll
            for (int it = 0; it < 2; ++it)
#pragma unroll
                for (int g = 0; g < 4; ++g) { const int c = hd * 64 + 32 * it + 8 * g + 4 * h;
                    const f32x4 lw = *(const f32x4*)(a.in[15] + c), lb = *(const f32x4*)(a.in[16] + c), gt = ld_bf4(GATE + (size_t)rr * 1024 + c); const v2u vw = *(const v2u*)(VV + (size_t)rr * 1024 + c);
                    const float o0 = ((acc[it][4 * g] - mean) * rstd * lw.x + lb.x + bon * bflo(vw.x)) * gt.x, o1 = ((acc[it][4 * g + 1] - mean) * rstd * lw.y + lb.y + bon * bfhi(vw.x)) * gt.y;
                    const float o2 = ((acc[it][4 * g + 2] - mean) * rstd * lw.z + lb.z + bon * bflo(vw.y)) * gt.z, o3 = ((acc[it][4 * g + 3] - mean) * rstd * lw.w + lb.w + bon * bfhi(vw.y)) * gt.w;
                    *(v2u*)(Y + (size_t)rr * DM + c) = (v2u){pk2(o0, o1), pk2(o2, o3)}; } }
    }
}

constexpr int N_PHASES = 33;
template <class Epi, class Sched> DI void run_gemm(const Frame& F, const pg8::Gemm& g, const Sched& S, const Epi& E) {
    pg8::gemm_phase<Epi, Sched, true, true>(F.lds + RING_OFF, g, S, E);
}
DI void moe_up_units(const Frame& F, const Args& a, int t0, int ntl, int G, int c) {
    pg8::Gemm g{(const bf16*)(a.ws + WS_SCR + SC_XG), (const bf16*)(a.ws + WS_MOEW), DM, DM, DM};
    pg8::MoeOrder S{(const int*)(a.ws + WS_TILES), t0, ntl, 4, G, c, (long)MOE_E_BYTES};
    pg8::EpiSwiglu E{(bf16*)(a.ws + WS_SCR + SC_ACT), FF};
    run_gemm(F, g, S, E);
}
DI void moe_down_units(const Frame& F, const Args& a, int t0, int ntl, int G, int c) {
    pg8::Gemm g{(const bf16*)(a.ws + WS_SCR + SC_ACT), (const bf16*)(a.ws + WS_MOEW + MOE_W2_OFF), FF, FF, FF};
    pg8::MoeOrder S{(const int*)(a.ws + WS_TILES), t0, ntl, 8, G, c, (long)MOE_E_BYTES};
    pg8::EpiBf16 E{(bf16*)(a.ws + WS_SCR + SC_YB), DM};
    run_gemm(F, g, S, E);
}
DI void ph_moe(const Frame& F, const Args& a, int l) {
    const int nt = (int)__hip_atomic_load((gu32*)(a.ws + WS_TILES) + 127, RLX_AGENT); unsigned* cnt = (unsigned*)(F.ctl + CW_MOEDONE + l * 2048);
    int t0 = 0, ntl = nt, G = F.G, c = (int)blockIdx.x;
    if (F.G == 256) { const int x = F.vcu >> 5; t0 = (x * nt) >> 3; ntl = (((x + 1) * nt) >> 3) - t0; G = 32; c = F.vcu & 31; }
    { pg8::Gemm g{(const bf16*)(a.ws + WS_SCR + SC_XG), (const bf16*)(a.ws + WS_MOEW), DM, DM, DM};
      pg8::MoeUpOrder S{(const int*)(a.ws + WS_TILES), t0, ntl, G, c, (long)MOE_E_BYTES, cnt};
      pg8::EpiSwiglu E{(bf16*)(a.ws + WS_SCR + SC_ACT), FF};
      run_gemm(F, g, S, E); }
    { pg8::Gemm g{(const bf16*)(a.ws + WS_SCR + SC_ACT), (const bf16*)(a.ws + WS_MOEW + MOE_W2_OFF), FF, FF, FF};
      pg8::MoeDownOrder S{(const int*)(a.ws + WS_TILES), t0, ntl, G, c, (long)MOE_E_BYTES, cnt};
      pg8::EpiBf16 E{(bf16*)(a.ws + WS_SCR + SC_YB), DM};
      run_gemm(F, g, S, E); }
}
DI void ph_moe_a(const Frame& F, const Args& a) {
    const int nt = (int)__hip_atomic_load((gu32*)(a.ws + WS_TILES) + 127, RLX_AGENT), n1 = nt < 64 ? nt : 64;
    moe_up_units(F, a, 0, n1, F.G, (int)blockIdx.x);
}
DI void ph_moe_b(const Frame& F, const Args& a) {
    const int nt = (int)__hip_atomic_load((gu32*)(a.ws + WS_TILES) + 127, RLX_AGENT), n1 = nt < 64 ? nt : 64; const int c = (int)blockIdx.x;
    int nu = 4 * (nt - n1); if (nu > F.G / 2) nu = F.G / 2;
    if (c < nu) moe_up_units(F, a, n1, nt - n1, nu, c); else moe_down_units(F, a, 0, n1, F.G - nu, c - nu);
}
DI void ph_moe_c(const Frame& F, const Args& a) {
    const int nt = (int)__hip_atomic_load((gu32*)(a.ws + WS_TILES) + 127, RLX_AGENT), n1 = nt < 64 ? nt : 64;
    moe_down_units(F, a, n1, nt - n1, F.G, (int)blockIdx.x);
}

DI void gemm_tail16(const Frame& F, const Args& a, const bf16* A, int lda, const bf16* Wt, int K, int mode) {
    if (F.vcu >= 128) return;
    const int lane = F.lane, lc = lane & 15, quad = lane >> 4, w = F.vcu; LAS float* red = (LAS float*)(F.lds + RING_OFF);
    f32x4 acc = (f32x4){0.f, 0.f, 0.f, 0.f}; const int kw = K / NWAVES, kb = F.wave * kw;
    const bf16* ap = A + (size_t)(TX + lc) * lda + kb + 8 * quad; const bf16* bp = Wt + (size_t)(16 * w + lc) * K + kb + 8 * quad;
#pragma unroll 4
    for (int ks = 0; ks < kw / 32; ++ks) acc = __builtin_amdgcn_mfma_f32_16x16x32_bf16(*(const bf16x8*)(ap + 32 * ks), *(const bf16x8*)(bp + 32 * ks), acc, 0, 0, 0);
    *(LAS f32x4*)(red + (F.wave * 64 + lane) * 4) = acc;
    __syncthreads();
    if (F.wave == 0) { f32x4 s = *(const LAS f32x4*)(red + lane * 4);
#pragma unroll
        for (int v = 1; v < NWAVES; ++v) s = s + *(const LAS f32x4*)(red + (v * 64 + lane) * 4);
        float* H = (float*)(a.ws + WS_H);
#pragma unroll
        for (int r = 0; r < 4; ++r) { const int row = 4 * quad + r, col = 16 * w + lc; const float base = mode ? H[(size_t)(TX + row) * DM + col] : a.in[1][(size_t)row * DM + col];
            H[(size_t)(TX + row) * DM + col] = base + s[r]; } }
    __syncthreads();
}

__global__ void __launch_bounds__(NWAVES * 64, 2) hyb_fwd(Args a) {
    extern __shared__ __attribute__((aligned(16))) unsigned char lds[];
    Frame F;
    F.lds = (LAS unsigned char*)lds;
    F.MISC = (volatile LAS unsigned*)(F.lds + MISC_OFF);
    F.tid = threadIdx.x; F.lane = F.tid & 63; F.wave = __builtin_amdgcn_readfirstlane(F.tid >> 6);
    F.G = gridDim.x; { const int bx = blockIdx.x; F.vcu = (F.G % 8 == 0) ? (bx % 8) * (F.G / 8) + bx / 8 : bx; }
    F.gw = F.vcu * NWAVES + F.wave; F.NGW = F.G * NWAVES;
    F.ctl = (gu32*)(a.ws + WS_CTL);
    for (int u = F.tid; u < (LDS_BYTES - LDSCTL_OFF) / 4; u += NWAVES * 64) ((LAS unsigned*)(F.lds + LDSCTL_OFF))[u] = 0u;
    __syncthreads();
    XcdBarrier bar; bar.bar = (unsigned*)(F.ctl + CW_BAR); bar.x = 0; bar.st = nullptr;
    if (MK_ONE_LAUNCH) bar = xcd_barrier_post((unsigned*)(F.ctl + CW_BAR), F.MISC + 8);
    const int lo = a.ph_lo, hi = a.ph_hi;
#ifndef PH_MASK
#define PH_MASK 0xFFFFFFFFFFFFFFFFull
#endif
#define IN(k) ((((unsigned long long)(PH_MASK) >> (k)) & 1ull) && lo <= (k) && (k) < hi)
#ifndef PROBE_REP
#define PROBE_REP 0u
#endif
#define REP(k) ((((unsigned long long)(PROBE_REP) >> (k)) & 1ull) ? 2 : 1)
#ifdef PROBE_TS
#define STAMP(k) do { if (blockIdx.x == 0 && F.tid == 0) ((unsigned long long*)(F.ctl + CW_TS))[(k)] = __builtin_amdgcn_s_memrealtime(); } while (0)
#else
#define STAMP(k) do { } while (0)
#endif
#define PHASE(k, ...) do { if (IN(k)) { { const int PH_REP_ = 0; (void)PH_REP_; __VA_ARGS__; } if (REP(k) == 2) { __syncthreads(); { const int PH_REP_ = 1; (void)PH_REP_; __VA_ARGS__; } } } } while (0)
#define SEAM(k) do { if (IN(k) && IN((k) + 1)) xcd_barrier(bar); STAMP((k) + 1); } while (0)
    const bf16* HN = (const bf16*)(a.ws + WS_HN); bf16* PROJ = (bf16*)(a.ws + WS_PROJ); const bf16* YMIX = (const bf16*)(a.ws + WS_YMIX); float* H = (float*)(a.ws + WS_H);

    STAMP(0);
    PHASE(0, { ph_prologue(F, a); ph_aux_convert(F, a, F.gw, F.NGW); });
    SEAM(0);
    PHASE(1, { pg8::Gemm g{HN, (const bf16*)(a.ws + WS_WEVIN), DM, DM, DM}; pg8::StaticOrder S; S.init(MP, EV_NP, F.G, (int)blockIdx.x); pg8::EpiBf16 E{PROJ, EV_NP}; run_gemm(F, g, S, E); });
    SEAM(1);
    PHASE(2, ph_even_prep(F, a););
    SEAM(2);
    PHASE(3, {
        { pg8::Gemm g{(const bf16*)(a.ws + WS_SCR + SC_ALORA), (const bf16*)(a.ws + WS_WLORA), 384, 384, 384}; pg8::StaticOrder S; S.init(MP, 3072, F.G, (int)blockIdx.x);
          static_assert(SC_ICL - SC_DEC == SC_GATE - SC_ICL, "lora outputs equally spaced");
          pg8::EpiLora E{(bf16*)(a.ws + WS_SCR + SC_DEC), (long)((SC_ICL - SC_DEC) / 2), a.in[7], a.in[9]}; run_gemm(F, g, S, E); }
        { pg8::Gemm g{(const bf16*)(a.ws + WS_SCR + SC_XR), (const bf16*)(a.ws + WS_WGATE), 256, 1024, 256}; pg8::StaticOrder S; S.init(MP, 2048, F.G, (int)blockIdx.x); S.amod = 4; S.astep = 512;
          pg8::EpiGates E{(bf16*)(a.ws + WS_SCR + SC_LA), (bf16*)(a.ws + WS_SCR + SC_LIX), a.in[20], a.in[22], a.in[23], (const bf16*)(a.ws + WS_SCR + SC_XR)}; run_gemm(F, g, S, E); }
    });
    SEAM(3);
    PHASE(4, ph_rwkv_chunk(F, a, 0, 64, 0););
    SEAM(4);
    PHASE(5, { if (F.vcu < 16) ph_rwkv_chain(F, a, 0, 128); else ph_rwkv_chunk(F, a, 64, 109, 16); });
    SEAM(5);
    PHASE(6, { if (F.vcu < 16) ph_rwkv_chain(F, a, 128, 218); else { ph_rwkv_chunk(F, a, 109, 129, 16); lru_local(F, a, (F.vcu - 16) * NWAVES + F.wave, (F.G - 16) * NWAVES); } });
    SEAM(6);
    PHASE(7, { if (F.vcu < 32) ph_rwkv_chain(F, a, 218, RW_NSC); else ph_rwkv_out(F, a, 0, 218, (F.vcu - 32) * NWAVES + F.wave, (F.G - 32) * NWAVES); });
    SEAM(7);
    PHASE(8, { ph_rwkv_out(F, a, 218, RW_NSC, F.gw, F.NGW); lru_apply(F, a); });
    SEAM(8);
    PHASE(11, { pg8::Gemm g{YMIX, (const bf16*)(a.ws + WS_WEVOUT), DM, DM, DM}; pg8::StaticOrder S; S.init(TX, DM, F.G, (int)blockIdx.x); pg8::EpiResid E{H, a.in[0], a.in[1], 0}; run_gemm(F, g, S, E); gemm_tail16(F, a, YMIX, DM, (const bf16*)(a.ws + WS_WEVOUT), DM, 0); });
    SEAM(11);
    PHASE(12, ph_route(F, a, 0, PH_REP_););
    SEAM(12);
    PHASE(13, ph_gather(F, a, 0););
    SEAM(13);
    PHASE(14, ph_moe(F, a, 0););
    SEAM(16);
    PHASE(17, ph_combine(F, a, 0););
    SEAM(17);
    PHASE(18, { pg8::Gemm g{HN, (const bf16*)(a.ws + WS_WODIN), DM, DM, DM}; pg8::StaticOrder S; S.init(MP, OD_NP, F.G, (int)blockIdx.x); pg8::EpiBf16 E{PROJ, OD_NP}; run_gemm(F, g, S, E); });
    SEAM(18);
    PHASE(19, ph_odd_prep(F, a););
    SEAM(19);
    PHASE(20, ph_gdn_chunk(F, a, 0, 54, 0););
    SEAM(20);
    PHASE(21, { ph_gdn_chain(F, a, 0, 54); ph_gdn_chunk(F, a, 54, 90, 1); });
    SEAM(21);
#if defined(PROBE_X) && PROBE_X == 3
    PHASE(22, { ph_gdn_chain(F, a, 54, 90); __syncthreads(); ph_gdn_chain(F, a, 54, 90); ph_gdn_chunk(F, a, 90, 114, 1); });
#elif defined(PROBE_X) && PROBE_X == 4
    PHASE(22, { ph_gdn_chain(F, a, 54, 90); ph_gdn_chunk(F, a, 90, 114, 1); __syncthreads(); ph_gdn_chunk(F, a, 90, 114, 1); });
#else
    PHASE(22, { ph_gdn_chain(F, a, 54, 90); ph_gdn_chunk(F, a, 90, 114, 1); });
#endif
    SEAM(22);
    PHASE(23, { ph_gdn_chain(F, a, 90, 114); ph_gdn_chunk(F, a, 114, 129, 1); });
    SEAM(23);
    PHASE(24, { ph_gdn_chain(F, a, 114, 129); ph_odd_post(F, a, 0); });
    SEAM(24);
    PHASE(25, { ph_odd_post(F, a, F.G == 256 ? 1 : 2); moe_convert(F, a, 1, F.gw, F.NGW); });
    SEAM(25);
    PHASE(26, { pg8::Gemm g{YMIX, (const bf16*)(a.ws + WS_WODOUT), 4096, 4096, 4096}; pg8::StaticOrder S; S.init(TX, DM, F.G, (int)blockIdx.x); pg8::EpiResid E{H, a.in[0], a.in[1], 1}; run_gemm(F, g, S, E); gemm_tail16(F, a, YMIX, 4096, (const bf16*)(a.ws + WS_WODOUT), 4096, 1); });
    SEAM(26);
    PHASE(27, ph_route(F, a, 1, PH_REP_););
    SEAM(27);
    PHASE(28, ph_gather(F, a, 1););
    SEAM(28);
    PHASE(29, ph_moe(F, a, 1););
    SEAM(31);
    PHASE(32, ph_combine(F, a, 1););
#ifdef PROBE_BARS
    for (int i_ = 0; i_ < PROBE_BARS; ++i_) xcd_barrier(bar);
#endif
#undef IN
#undef SEAM
}

extern "C" void kernel_launch(void* const* d_in, const int* in_sizes, int n_in, void* d_out, int out_size, void* d_ws, size_t ws_size, hipStream_t stream) {
    static int grid = 0;
    if (grid == 0) {
        if (n_in != 36 || out_size != TX * DM || ws_size < WS_END) { fprintf(stderr, "kernel_launch: unexpected shapes (n_in %d, out %d, ws %zu)\n", n_in, out_size, ws_size); grid = -1; return; }
        int dev = 0, cus = 0, per_cu = 0;
        if (hipGetDevice(&dev) != hipSuccess || hipDeviceGetAttribute(&cus, hipDeviceAttributeMultiprocessorCount, dev) != hipSuccess) { grid = -1; return; }
        if (hipFuncSetAttribute((const void*)hyb_fwd, hipFuncAttributeMaxDynamicSharedMemorySize, LDS_BYTES) != hipSuccess) { fprintf(stderr, "kernel_launch: hipFuncSetAttribute failed\n"); grid = -1; return; }
        if (hipOccupancyMaxActiveBlocksPerMultiprocessor(&per_cu, (const void*)hyb_fwd, NWAVES * 64, LDS_BYTES) != hipSuccess || per_cu < 1) { fprintf(stderr, "kernel_launch: occupancy query says %d\n", per_cu); per_cu = 1; }
        (void)hipGetLastError();
        grid = cus;
    }
    if (grid < 0) return;
    if (hipMemsetAsync((char*)d_ws + WS_CTL, 0, CTL_ZERO_BYTES, stream) != hipSuccess) return;
    Args a{};
    for (int i = 0; i < 36; ++i) a.in[i] = (const float*)d_in[i];
    a.out = (float*)d_out; a.ws = (unsigned char*)d_ws;
#if MK_ONE_LAUNCH
    a.ph_lo = 0; a.ph_hi = N_PHASES;
    hipLaunchKernelGGL(hyb_fwd, dim3(grid), dim3(NWAVES * 64), LDS_BYTES, stream, a);
#else
    for (int p = 0; p < N_PHASES; ++p) { a.ph_lo = p; a.ph_hi = p + 1; hipLaunchKernelGGL(hyb_fwd, dim3(grid), dim3(NWAVES * 64), LDS_BYTES, stream, a); }
#endif
}
```

```cpp
#include <hip/hip_runtime.h>
#include <cstdio>
#include <cstdint>
#include <cmath>

#ifndef MK_ONE_LAUNCH
#define MK_ONE_LAUNCH 1
#endif

namespace pg8 {
#define PG8_LAS __attribute__((address_space(3)))
typedef unsigned short bf16_t;
typedef short bf16x8 __attribute__((ext_vector_type(8)));
typedef float f32x4 __attribute__((ext_vector_type(4)));
typedef unsigned u32x4 __attribute__((ext_vector_type(4)));
typedef unsigned u32x2 __attribute__((ext_vector_type(2)));
constexpr int BM = 256, BK = 64, HALF = 128, HTB = HALF * BK * 2  , STAGE_BYTES = 8 * HTB, NXCD = 8, WGM = 8;

__host__ __device__ __forceinline__ int lds_byte(int r, int c) { const int st = (r >> 4) * 2 + (c >> 5), rr = r & 15, cc = c & 31, ob = rr * 64 + cc * 2; return st * 1024 + (ob ^ (((ob >> 9) & 1) << 5)); }
__host__ __device__ __forceinline__ void stage_rc(int b, int& R, int& C) { const int st = b / 1024, sb = b % 1024, swz = sb ^ (((sb >> 9) & 1) << 5); R = (st >> 1) * 16 + swz / 64; C = (st & 1) * 32 + (swz % 64) / 2; }
__host__ __device__ __forceinline__ int perm32(int rho) { const int n = rho >> 4, i = rho & 15; return 8 * (i >> 2) + 4 * n + (i & 3); }

struct Unit { int pm, pn; long aoff, boff; };
struct Gemm { const bf16_t* A; const bf16_t* Bt; int K, lda, ldb; };

struct StaticOrder {
    int nM, nN, nwg, G, c, amod; long astep;
    __host__ __device__ void init(int M, int N, int G_, int c_) { nM = M / BM; nN = N / BM; nwg = nM * nN; G = G_; c = c_; amod = 0; astep = 0; }
    __host__ __device__ bool next(int i, Unit& u) const {
        const long L = (long)i * G + c; if (L >= nwg) return false;
        int wgid = (int)L; { const int q = nwg / NXCD, r = nwg % NXCD, xcd = wgid % NXCD, off = wgid / NXCD; wgid = (xcd < r ? xcd * (q + 1) : r * (q + 1) + (xcd - r) * q) + off; }
        const int nig = WGM * nN, gid = wgid / nig, fm = gid * WGM, gsz = (nM - fm) < WGM ? (nM - fm) : WGM;
        u.pm = fm + ((wgid % nig) % gsz); u.pn = (wgid % nig) / gsz; u.boff = 0; u.aoff = amod ? (long)(u.pn % amod) * astep : 0; return true;
    }
    __device__ __forceinline__ void a_ready(const Unit&) const {}
    __device__ __forceinline__ void done(const Unit&) const {}
};
struct MoeOrder {
    const int* tile_e; int t0, ntiles, npn, G, c; long bstride;
    __device__ __forceinline__ bool next(int i, Unit& u) const {
        const long L = (long)i * G + c; if (c < 0 || L >= (long)ntiles * npn) return false;
        const int t = t0 + (int)(L / npn); u.pm = t; u.pn = (int)(L % npn); u.aoff = 0; u.boff = (long)tile_e[t] * bstride; return true;
    }
    __device__ __forceinline__ void a_ready(const Unit&) const {}
    __device__ __forceinline__ void done(const Unit&) const {}
};

struct MoeUpOrder {
    const int* tile_e; int t0, ntiles, G, c; long bstride; unsigned* done_cnt;
    __device__ __forceinline__ bool next(int i, Unit& u) const {
        const int L = i * G + c; if (L >= ntiles * 4) return false;
        const int t = t0 + (L >> 2); u.pm = t; u.pn = L & 3; u.aoff = 0; u.boff = (long)tile_e[t] * bstride; return true;
    }
    __device__ __forceinline__ void a_ready(const Unit&) const {}
    __device__ __forceinline__ void done(const Unit& u) const {
        __syncthreads();
        if (threadIdx.x == 0) { __builtin_amdgcn_fence(__ATOMIC_RELEASE, "agent"); __hip_atomic_fetch_add(done_cnt + u.pm * 16, 8u, __ATOMIC_RELAXED, __HIP_MEMORY_SCOPE_AGENT); }
    }
};
struct MoeDownOrder {
    const int* tile_e; int t0, ntiles, G, c; long bstride; const unsigned* done_cnt;
    __device__ __forceinline__ bool next(int i, Unit& u) const {
        const int nup = ntiles * 4, ndn = ntiles * 8, r = nup % G, ns = G - r;
        int compN = r ? 3 * ns : 0; if (compN > ndn) compN = ndn;
        int ncomp = 0;
        if (r && c >= r) { for (int j = 0; j < 3; ++j) if (j * ns + (c - r) < compN) ++ncomp; }
        int d;
        if (i < ncomp) d = i * ns + (c - r); else { d = compN + (i - ncomp) * G + c; if (d >= ndn) return false; }
        const int t = t0 + (d >> 3); u.pm = t; u.pn = d & 7; u.aoff = 0; u.boff = (long)tile_e[t] * bstride; return true;
    }
    __device__ __forceinline__ void a_ready(const Unit& u) const {
        while (__hip_atomic_load(done_cnt + u.pm * 16, __ATOMIC_RELAXED, __HIP_MEMORY_SCOPE_AGENT) < 32u) __builtin_amdgcn_s_sleep(1);
        asm volatile("" ::: "memory");
    }
    __device__ __forceinline__ void done(const Unit&) const {}
};

__device__ __forceinline__ unsigned cvt_pk_bf16(float lo, float hi) { unsigned r; asm volatile("v_cvt_pk_bf16_f32 %0, %1, %2" : "=v"(r) : "v"(lo), "v"(hi)); return r; }
__device__ __forceinline__ float bf_lo(unsigned w) { return __uint_as_float(w << 16); }
__device__ __forceinline__ float bf_hi(unsigned w) { return __uint_as_float(w & 0xffff0000u); }
__device__ __forceinline__ float sigmoidf_(float x) { return __builtin_amdgcn_rcpf(1.0f + __expf(-x)); }
__device__ __forceinline__ float softplusf_(float x) { return fmaxf(x, 0.f) + __logf(1.0f + __expf(-fabsf(x))); }

struct EpiBf16 {
    static constexpr bool PERM = true, AFTER_DRAIN = false;
    bf16_t* O; int ldc;
    __device__ __forceinline__ void operator()(const f32x4 (&acc)[2][2][4][2], const Unit& u, int wr, int wc, int fr, int fq) const {
        const int row0 = u.pm * BM + wr * 64 + fr; const int col0 = u.pn * BM + wc * 32 + 8 * fq;
#pragma unroll
        for (int ai = 0; ai < 2; ++ai)
#pragma unroll
            for (int m = 0; m < 4; ++m) { bf16_t* rowp = O + (size_t)(row0 + ai * HALF + m * 16) * ldc + col0;
#pragma unroll
                for (int bj = 0; bj < 2; ++bj) { const f32x4 v0 = acc[ai][bj][m][0], v1 = acc[ai][bj][m][1];
                    u32x4 w; w.x = cvt_pk_bf16(v0[0], v0[1]); w.y = cvt_pk_bf16(v0[2], v0[3]); w.z = cvt_pk_bf16(v1[0], v1[1]); w.w = cvt_pk_bf16(v1[2], v1[3]);
                    *(u32x4*)(rowp + bj * HALF) = w; } }
    }
};
struct EpiSwiglu {
    static constexpr bool PERM = true, AFTER_DRAIN = false;
    bf16_t* O; int ldc;
    __device__ __forceinline__ void operator()(const f32x4 (&acc)[2][2][4][2], const Unit& u, int wr, int wc, int fr, int fq) const {
        const int row0 = u.pm * BM + wr * 64 + fr; const int col0 = u.pn * HALF + wc * 32 + 8 * fq;
#pragma unroll
        for (int ai = 0; ai < 2; ++ai)
#pragma unroll
            for (int m = 0; m < 4; ++m) { bf16_t* rowp = O + (size_t)(row0 + ai * HALF + m * 16) * ldc + col0;
                float o[8];
#pragma unroll
                for (int n = 0; n < 2; ++n)
#pragma unroll
                    for (int j = 0; j < 4; ++j) { const float gq = acc[ai][0][m][n][j], uq = acc[ai][1][m][n][j]; o[4 * n + j] = gq * sigmoidf_(gq) * uq; }
                u32x4 w; w.x = cvt_pk_bf16(o[0], o[1]); w.y = cvt_pk_bf16(o[2], o[3]); w.z = cvt_pk_bf16(o[4], o[5]); w.w = cvt_pk_bf16(o[6], o[7]);
                *(u32x4*)rowp = w; }
    }
};
struct EpiResid {
    static constexpr bool PERM = false, AFTER_DRAIN = false;
    float* out; const float* x; const float* meta; int mode;
    __device__ __forceinline__ void operator()(const f32x4 (&acc)[2][2][4][2], const Unit& u, int wr, int wc, int fr, int fq) const {
        const int row0 = u.pm * BM + wr * 64 + fr, col0 = u.pn * BM + wc * 32 + 4 * fq;
#pragma unroll
        for (int ai = 0; ai < 2; ++ai)
#pragma unroll
            for (int m = 0; m < 4; ++m) { const int row = row0 + ai * HALF + m * 16; float* rowp = out + (size_t)row * 2048 + col0;
                const float* bp = mode ? rowp : (row < 8192 ? x + (size_t)row * 2048 + col0 : (row < 8208 ? meta + (size_t)(row - 8192) * 2048 + col0 : nullptr));
#pragma unroll
                for (int bj = 0; bj < 2; ++bj)
#pragma unroll
                    for (int n = 0; n < 2; ++n) { f32x4 b = (f32x4){0.f, 0.f, 0.f, 0.f}; if (bp) b = *(const f32x4*)(bp + bj * HALF + n * 16);
                        *(f32x4*)(rowp + bj * HALF + n * 16) = acc[ai][bj][m][n] + b; } }
    }
};
__device__ __forceinline__ float one_minus_exp_neg(float e) { return e < 0.05f ? e * (1.0f - e * (0.5f - e * (1.0f / 6.0f))) : 1.0f - __expf(-e); }
struct EpiLora {
    static constexpr bool PERM = false, AFTER_DRAIN = false;
    bf16_t* base; long gstride; const float* w0; const float* a0;
    __device__ __forceinline__ void operator()(const f32x4 (&acc)[2][2][4][2], const Unit& u, int wr, int wc, int fr, int fq) const {
        const int grp = u.pn >> 2; const int row0 = u.pm * BM + wr * 64 + fr, col0 = (u.pn & 3) * BM + wc * 32 + 4 * fq;
        bf16_t* O = base + (size_t)grp * gstride;
#pragma unroll
        for (int bj = 0; bj < 2; ++bj)
#pragma unroll
            for (int n = 0; n < 2; ++n) { const int c = col0 + bj * HALF + n * 16;
                f32x4 bv = (f32x4){0.f, 0.f, 0.f, 0.f}; if (grp == 0) bv = *(const f32x4*)(w0 + c); else if (grp == 1) bv = *(const f32x4*)(a0 + c);
#pragma unroll
                for (int ai = 0; ai < 2; ++ai)
#pragma unroll
                    for (int m = 0; m < 4; ++m) { f32x4 v = acc[ai][bj][m][n] + bv;
                        if (grp == 0) {
#pragma unroll
                            for (int j = 0; j < 4; ++j) { const float wl = -softplusf_(-v[j]) - 0.5f; v[j] = one_minus_exp_neg(__expf(wl)); }
                        } else if (grp == 1) {
#pragma unroll
                            for (int j = 0; j < 4; ++j) v[j] = sigmoidf_(v[j]);
                        }
                        u32x2 w; w.x = cvt_pk_bf16(v[0], v[1]); w.y = cvt_pk_bf16(v[2], v[3]);
                        *(u32x2*)(O + (size_t)(row0 + ai * HALF + m * 16) * 1024 + c) = w; } }
    }
};
struct EpiGates {
    static constexpr bool PERM = false, AFTER_DRAIN = false;
    bf16_t* lru_a; bf16_t* lru_ix; const float* ba; const float* bx; const float* lam; const bf16_t* xr;
    __device__ __forceinline__ void operator()(const f32x4 (&acc)[2][2][4][2], const Unit& u, int wr, int wc, int fr, int fq) const {
        const int grp = u.pn >> 2; const int row0 = u.pm * BM + wr * 64 + fr, col0 = (u.pn & 3) * BM + wc * 32 + 4 * fq;
#pragma unroll
        for (int bj = 0; bj < 2; ++bj)
#pragma unroll
            for (int n = 0; n < 2; ++n) { const int c = col0 + bj * HALF + n * 16;
                const f32x4 bv = *(const f32x4*)((grp == 0 ? ba : bx) + c); f32x4 sp = (f32x4){0.f, 0.f, 0.f, 0.f};
                if (grp == 0) { const f32x4 l = *(const f32x4*)(lam + c);
#pragma unroll
                    for (int j = 0; j < 4; ++j) sp[j] = 8.0f * softplusf_(-l[j]); }
#pragma unroll
                for (int ai = 0; ai < 2; ++ai)
#pragma unroll
                    for (int m = 0; m < 4; ++m) { const int row = row0 + ai * HALF + m * 16; f32x4 v = acc[ai][bj][m][n] + bv; u32x2 w;
                        if (grp == 0) {
#pragma unroll
                            for (int j = 0; j < 4; ++j) v[j] = one_minus_exp_neg(sigmoidf_(v[j]) * sp[j]);
                            w.x = cvt_pk_bf16(v[0], v[1]); w.y = cvt_pk_bf16(v[2], v[3]); *(u32x2*)(lru_a + (size_t)row * 1024 + c) = w;
                        } else { const u32x2 xw = *(const u32x2*)(xr + (size_t)row * 1024 + c);
                            v[0] = sigmoidf_(v[0]) * bf_lo(xw.x); v[1] = sigmoidf_(v[1]) * bf_hi(xw.x); v[2] = sigmoidf_(v[2]) * bf_lo(xw.y); v[3] = sigmoidf_(v[3]) * bf_hi(xw.y);
                            w.x = cvt_pk_bf16(v[0], v[1]); w.y = cvt_pk_bf16(v[2], v[3]); *(u32x2*)(lru_ix + (size_t)row * 1024 + c) = w; } } }
    }
};

template <class Epi, class Sched, bool ALIGN_EPI = false, bool SP2 = false>
__device__ __forceinline__ void gemm_phase(PG8_LAS unsigned char* lds, const Gemm g, const Sched& S, const Epi& E) {
    const int tid = threadIdx.x, wid = __builtin_amdgcn_readfirstlane(tid >> 6), lane = tid & 63, wr = wid >> 2, wc = wid & 3, fr = lane & 15, fq = lane >> 4;
    const int K = g.K, nt = K / BK;
    unsigned voffA[2], voffB[2];
#pragma unroll
    for (int i = 0; i < 2; ++i) { int R, C; stage_rc(tid * 16 + i * 8192, R, C); const int Rb = Epi::PERM ? ((R & ~31) + perm32(R & 31)) : R;
        voffA[i] = (unsigned)(R * g.lda + C) * 2u; voffB[i] = (unsigned)(Rb * g.ldb + C) * 2u; }
    const size_t kstep = (size_t)(BK * 2);
    const size_t hstepA = (size_t)HALF * g.lda * 2, hstepB = (size_t)HALF * g.ldb * 2;
    const size_t tstepA = 2 * hstepA, tstepB = 2 * hstepB;
    const unsigned ldsw = (unsigned)wid * 1024u;
    const int aoff = lds_byte(wr * 64 + fr, fq * 8), boff = lds_byte(wc * 32 + fr, fq * 8);
#define PG8_SA(b, h) (((b) * 2 + (h)) * HTB)
#define PG8_SB(b, h) ((4 + (b) * 2 + (h)) * HTB)
#define PG8_STAGE(bufoff, gbase, voff) do { _Pragma("unroll") for (int _i = 0; _i < 2; ++_i) \
        __builtin_amdgcn_global_load_lds((const unsigned*)((const char*)(gbase) + (voff)[_i]), (PG8_LAS unsigned*)(lds + (bufoff) + ldsw + _i * 8192), 16, 0, 0); } while (0)
#define PG8_LDA(dst, b, h) do { _Pragma("unroll") for (int m = 0; m < 4; ++m) _Pragma("unroll") for (int k = 0; k < 2; ++k) dst[m][k] = *(const PG8_LAS bf16x8*)(lds + PG8_SA(b, h) + aoff + m * 2048 + k * 1024); } while (0)
#define PG8_LDB(dst, b, h) do { _Pragma("unroll") for (int n = 0; n < 2; ++n) _Pragma("unroll") for (int k = 0; k < 2; ++k) dst[n][k] = *(const PG8_LAS bf16x8*)(lds + PG8_SB(b, h) + boff + n * 2048 + k * 1024); } while (0)
#define PG8_MMA(ai, bj, At, Bt) do { __builtin_amdgcn_s_setprio(1); _Pragma("unroll") for (int m = 0; m < 4; ++m) _Pragma("unroll") for (int n = 0; n < 2; ++n) _Pragma("unroll") for (int k = 0; k < 2; ++k) \
        acc[ai][bj][m][n] = __builtin_amdgcn_mfma_f32_16x16x32_bf16(Bt[n][k], At[m][k], acc[ai][bj][m][n], 0, 0, 0); __builtin_amdgcn_s_setprio(0); } while (0)
#define PG8_WAIT_V(n) asm volatile("s_waitcnt vmcnt(" #n ")" ::: "memory")
#define PG8_WAIT_L(n) asm volatile("s_waitcnt lgkmcnt(" #n ")" ::: "memory")
#define PG8_BAR __builtin_amdgcn_s_barrier()
#define PG8_SCHED __builtin_amdgcn_sched_barrier(0)
    Unit cur, nxt; int ui = 0;
    if (!S.next(0, cur)) return;
    f32x4 acc[2][2][4][2];
#pragma unroll
    for (int a = 0; a < 2; ++a)
#pragma unroll
        for (int b = 0; b < 2; ++b)
#pragma unroll
            for (int m = 0; m < 4; ++m)
#pragma unroll
                for (int n = 0; n < 2; ++n) acc[a][b][m][n] = (f32x4){0.f, 0.f, 0.f, 0.f};
    bf16x8 At[4][2], B0[2][2], B1[2][2];
    const char* cA = (const char*)g.A + (size_t)cur.pm * tstepA + cur.aoff; const char* cB = (const char*)g.Bt + (size_t)cur.pn * tstepB + cur.boff;
    S.a_ready(cur);
    if constexpr (SP2) {
        PG8_STAGE(PG8_SB(0, 0), cB, voffB); PG8_STAGE(PG8_SB(0, 1), cB + hstepB, voffB); PG8_STAGE(PG8_SA(0, 0), cA, voffA); PG8_STAGE(PG8_SA(0, 1), cA + hstepA, voffA);
        if (wr == 1) PG8_BAR;
        PG8_WAIT_V(2); PG8_BAR;
        PG8_STAGE(PG8_SB(1, 0), cB + kstep, voffB); PG8_STAGE(PG8_SA(1, 0), cA + kstep, voffA); PG8_STAGE(PG8_SB(1, 1), cB + hstepB + kstep, voffB);
        PG8_WAIT_V(6); PG8_BAR;
    } else {
        PG8_STAGE(PG8_SB(0, 0), cB, voffB); PG8_STAGE(PG8_SA(0, 0), cA, voffA); PG8_STAGE(PG8_SB(0, 1), cB + hstepB, voffB); PG8_STAGE(PG8_SA(0, 1), cA + hstepA, voffA);
        if (wr == 1) PG8_BAR;
        PG8_WAIT_V(4); PG8_BAR;
        PG8_STAGE(PG8_SB(1, 0), cB + kstep, voffB); PG8_STAGE(PG8_SA(1, 0), cA + kstep, voffA); PG8_STAGE(PG8_SB(1, 1), cB + hstepB + kstep, voffB);
        PG8_WAIT_V(6); PG8_BAR;
    }
    for (;;) {
        const bool has_next = S.next(ui + 1, nxt);
        const char* nA = has_next ? (const char*)g.A + (size_t)nxt.pm * tstepA + nxt.aoff : cA; const char* nB = has_next ? (const char*)g.Bt + (size_t)nxt.pn * tstepB + nxt.boff : cB;
        for (int t = 0; t < nt; t += 2) {
            const bool last = (t == nt - 2);
            const char* a1 = cA + (size_t)(t + 1) * kstep;
            const char* a2 = last ? nA : cA + (size_t)(t + 2) * kstep; const char* b2 = last ? nB : cB + (size_t)(t + 2) * kstep;
            const char* a3 = a2 + kstep; const char* b3 = b2 + kstep;
            if (last && has_next) S.a_ready(nxt);
            if constexpr (SP2) {
            PG8_LDB(B0, 0, 0); PG8_LDB(B1, 0, 1); PG8_SCHED; PG8_LDA(At, 0, 0); PG8_STAGE(PG8_SA(1, 1), a1 + hstepA, voffA);
            PG8_WAIT_V(8); PG8_WAIT_L(0); PG8_BAR; PG8_MMA(0, 0, At, B0); PG8_MMA(0, 1, At, B1); PG8_BAR; PG8_SCHED;
            PG8_LDA(At, 0, 1); PG8_STAGE(PG8_SB(0, 0), b2, voffB); PG8_STAGE(PG8_SB(0, 1), b2 + hstepB, voffB); PG8_STAGE(PG8_SA(0, 0), a2, voffA);
            PG8_WAIT_V(8); PG8_WAIT_L(0); PG8_BAR; PG8_MMA(1, 0, At, B0); PG8_MMA(1, 1, At, B1); PG8_BAR; PG8_SCHED;
            PG8_LDB(B0, 1, 0); PG8_LDB(B1, 1, 1); PG8_SCHED; PG8_LDA(At, 1, 0); PG8_STAGE(PG8_SA(0, 1), a2 + hstepA, voffA);
            PG8_WAIT_V(8); PG8_WAIT_L(0); PG8_BAR; PG8_MMA(0, 0, At, B0); PG8_MMA(0, 1, At, B1); PG8_BAR; PG8_SCHED;
            PG8_LDA(At, 1, 1); PG8_STAGE(PG8_SB(1, 0), b3, voffB); PG8_STAGE(PG8_SB(1, 1), b3 + hstepB, voffB); PG8_STAGE(PG8_SA(1, 0), a3, voffA);
            PG8_WAIT_V(8); PG8_WAIT_L(0); PG8_BAR; PG8_MMA(1, 0, At, B0); PG8_MMA(1, 1, At, B1); PG8_BAR; PG8_SCHED;
            } else {
            PG8_LDB(B0, 0, 0); PG8_SCHED; PG8_LDA(At, 0, 0); PG8_STAGE(PG8_SA(1, 1), a1 + hstepA, voffA);
            PG8_WAIT_L(8); PG8_BAR; PG8_WAIT_L(0); PG8_MMA(0, 0, At, B0); PG8_BAR; PG8_SCHED;
            PG8_LDB(B1, 0, 1); PG8_STAGE(PG8_SB(0, 0), b2, voffB);
            PG8_BAR; PG8_WAIT_L(0); PG8_MMA(0, 1, At, B1); PG8_BAR;
            PG8_LDA(At, 0, 1); PG8_STAGE(PG8_SA(0, 0), a2, voffA);
            PG8_BAR; PG8_WAIT_L(0); PG8_MMA(1, 0, At, B0); PG8_BAR; PG8_SCHED;
            PG8_STAGE(PG8_SB(0, 1), b2 + hstepB, voffB);
            PG8_WAIT_V(6); PG8_BAR; PG8_MMA(1, 1, At, B1); PG8_BAR;
            PG8_LDB(B0, 1, 0); PG8_SCHED; PG8_LDA(At, 1, 0); PG8_STAGE(PG8_SA(0, 1), a2 + hstepA, voffA);
            PG8_WAIT_L(8); PG8_BAR; PG8_WAIT_L(0); PG8_MMA(0, 0, At, B0); PG8_BAR; PG8_SCHED;
            PG8_LDB(B1, 1, 1); PG8_STAGE(PG8_SB(1, 0), b3, voffB);
            PG8_BAR; PG8_WAIT_L(0); PG8_MMA(0, 1, At, B1); PG8_BAR;
            PG8_LDA(At, 1, 1); PG8_STAGE(PG8_SA(1, 0), a3, voffA);
            PG8_BAR; PG8_WAIT_L(0); PG8_MMA(1, 0, At, B0); PG8_BAR; PG8_SCHED;
            PG8_STAGE(PG8_SB(1, 1), b3 + hstepB, voffB);
            PG8_WAIT_V(6); PG8_BAR; PG8_MMA(1, 1, At, B1); PG8_BAR;
            }
        }
        if constexpr (ALIGN_EPI) { if (wr == 0) PG8_BAR; }
        if constexpr (!Epi::AFTER_DRAIN) { E(acc, cur, wr, wc, fr, fq); S.done(cur); }
        if (!has_next) break;
#pragma unroll
        for (int a = 0; a < 2; ++a)
#pragma unroll
            for (int b = 0; b < 2; ++b)
#pragma unroll
                for (int m = 0; m < 4; ++m)
#pragma unroll
                    for (int n = 0; n < 2; ++n) acc[a][b][m][n] = (f32x4){0.f, 0.f, 0.f, 0.f};
        cur = nxt; cA = nA; cB = nB; ++ui;
        if constexpr (ALIGN_EPI) { if (wr == 1) PG8_BAR; }
    }
    PG8_WAIT_V(0);
    if constexpr (!ALIGN_EPI) { if (wr == 0) PG8_BAR; }
    PG8_BAR;
    if constexpr (Epi::AFTER_DRAIN) { E.fused(acc, cur, wr, wc, fr, fq, lds, wid, lane); S.done(cur); }
#undef PG8_SA
#undef PG8_SB
#undef PG8_STAGE
#undef PG8_LDA
#undef PG8_LDB
#undef PG8_MMA
#undef PG8_WAIT_V
#undef PG8_WAIT_L
#undef PG8_BAR
#undef PG8_SCHED
}
}
#define GAS __attribute__((address_space(1)))
#define LAS __attribute__((address_space(3)))
typedef unsigned short bf16;
typedef unsigned v4u __attribute__((ext_vector_type(4)));
typedef float f32x4 __attribute__((ext_vector_type(4)));
typedef short bf16x8 __attribute__((ext_vector_type(8)));
typedef GAS unsigned gu32;
typedef GAS unsigned long long gu64;
#define RLX_AGENT __ATOMIC_RELAXED, __HIP_MEMORY_SCOPE_AGENT
#define LDS_WAIT() asm volatile("s_waitcnt lgkmcnt(0)" ::: "memory")
#define VM_WAIT() asm volatile("s_waitcnt vmcnt(0)" ::: "memory")
__device__ __forceinline__ unsigned long long rt() { return __builtin_amdgcn_s_memrealtime(); }
__device__ __forceinline__ unsigned f2bf(float f) { unsigned u = __builtin_bit_cast(unsigned, f); return (u + 0x7fffu + ((u >> 16) & 1u)) >> 16; }
__device__ __forceinline__ unsigned pk2(float lo, float hi) { return f2bf(lo) | (f2bf(hi) << 16); }

#define XB_TMO      128
#define XB_XCNT(j)  (256  + 64 * (j))
#define XB_XSUB(j)  (1280 + 64 * (j))
#define XB_XGEN(j)  (2304 + 64 * (j))
#define XB_TOP      3328
#define XB_TOPGEN   3392
#define XCD_BAR_WORDS 3456
#define XB_SPIN_CAP (1u << 18)

__device__ __forceinline__ unsigned xb_ld(unsigned* p)              { return __hip_atomic_load(p, __ATOMIC_RELAXED, __HIP_MEMORY_SCOPE_AGENT); }
__device__ __forceinline__ unsigned xb_add(unsigned* p, unsigned v) { return __hip_atomic_fetch_add(p, v, __ATOMIC_RELAXED, __HIP_MEMORY_SCOPE_AGENT); }
__device__ __forceinline__ unsigned xb_xcc_id() { return (unsigned)__builtin_amdgcn_s_getreg((3 << 11) | 20) & 0xFu; }
#define XB_SPIN(cond, bar) do { unsigned _sp = 0; while (cond) { __builtin_amdgcn_s_sleep(1); \
    if ((++_sp & 255u) == 0u) { if (xb_ld(&(bar)[XB_TMO])) break; if (_sp > XB_SPIN_CAP) { atomicAdd(&(bar)[XB_TMO], 1u); break; } } } } while (0)

struct XcdBarrier {
    unsigned* bar; unsigned x;
    volatile LAS unsigned* st;
};

__device__ __forceinline__ XcdBarrier xcd_barrier_post(unsigned* bar, volatile LAS unsigned* st) {
    XcdBarrier b; b.bar = bar; b.x = xb_xcc_id(); b.st = st;
    if (threadIdx.x == 0) (void)xb_add(&bar[XB_XCNT(b.x)], 1u);
    return b;
}
__device__ __forceinline__ void xcd_barrier_complete(unsigned* bar, unsigned x, unsigned& nloc, unsigned& nx) {
    const unsigned G = gridDim.x * gridDim.y * gridDim.z;
    unsigned sum, cnt, mine, sp = 0u;
    for (;;) {
        sum = 0u; cnt = 0u; mine = 0u;
#pragma unroll
        for (unsigned j = 0; j < 16; ++j) { const unsigned c = xb_ld(&bar[XB_XCNT(j)]); sum += c; cnt += (c > 0u) ? 1u : 0u; mine = (j == x) ? c : mine; }
        if (sum == G) break;
        __builtin_amdgcn_s_sleep(1);
        if ((++sp & 255u) == 0u) { if (xb_ld(&bar[XB_TMO])) break; if (sp > XB_SPIN_CAP) { atomicAdd(&bar[XB_TMO], 1u); break; } }
    }
    nloc = mine > 0u ? mine : 1u; nx = cnt > 0u ? cnt : 1u;
}

__device__ __forceinline__ void xcd_barrier(const XcdBarrier& b) {
    asm volatile("s_waitcnt vmcnt(0)" ::: "memory");
    __syncthreads();
    if (threadIdx.x == 0) {
        unsigned* bar = b.bar;
        __builtin_amdgcn_s_waitcnt(0);
        unsigned nloc = b.st[0], nx = b.st[1];
        if (nloc == 0u) { xcd_barrier_complete(bar, b.x, nloc, nx); b.st[0] = nloc; b.st[1] = nx; }
        const unsigned old = xb_add(&bar[XB_XSUB(b.x)], 1u);
        const unsigned gen = old / nloc;
        if (old + 1u == (gen + 1u) * nloc) {
            __builtin_amdgcn_fence(__ATOMIC_RELEASE, "agent");
            asm volatile("s_waitcnt vmcnt(0)" ::: "memory");
            const unsigned og = xb_add(&bar[XB_TOP], 1u);
            const unsigned tg = og / nx;
            if (og + 1u == (tg + 1u) * nx) xb_add(&bar[XB_TOPGEN], 1u);
            else XB_SPIN(xb_ld(&bar[XB_TOPGEN]) == tg, bar);
            __builtin_amdgcn_fence(__ATOMIC_ACQUIRE, "agent");
            xb_add(&bar[XB_XGEN(b.x)], 1u);
            asm volatile("s_waitcnt vmcnt(0)" ::: "memory");
        } else {
            XB_SPIN(xb_ld(&bar[XB_XGEN(b.x)]) == gen, bar);
            __builtin_amdgcn_fence(__ATOMIC_ACQUIRE, "agent");
            asm volatile("s_waitcnt vmcnt(0)" ::: "memory");
        }
    }
    __syncthreads();
}

constexpr int NWAVES = 8;
constexpr int DM = 2048, TX = 8192, NMETA = 16, TT = TX + NMETA, MP = 8448;
constexpr int EV_NP = 5632, EV_LORA0 = 3072, EV_GB = 3360, EV_REC = 4384;
constexpr int OD_NP = 12544, OD_Z = 8448, OD_B = 8192, OD_A = 8224;
constexpr int OD_N0 = 46 * 256;
constexpr int NEXP = 32, FF = 512, MOE_ROWS = 24576;
constexpr float NORM_EPS = 1e-6f;

constexpr size_t MiB = 1u << 20;
constexpr size_t WS_CTL = 0, CTL_ZERO_BYTES = 1 * MiB;
constexpr size_t WS_TOKINFO = 1 * MiB;
constexpr size_t WS_TILES = 1 * MiB + 512 * 1024;
constexpr size_t WS_WEVIN = 2 * MiB;
constexpr size_t WS_WEVOUT = 24 * MiB;
constexpr size_t WS_WODIN = 32 * MiB;
constexpr size_t WS_WODOUT = 81 * MiB;
constexpr size_t WS_WLORA = 97 * MiB;
constexpr size_t WS_WGATE = 100 * MiB;
constexpr size_t WS_WROUTE = 101 * MiB;
constexpr size_t WS_MOEW = 102 * MiB;
constexpr size_t MOE_E_BYTES = 6 * MiB, MOE_W2_OFF = 4 * MiB;
constexpr size_t WS_H = 294 * MiB;
constexpr size_t WS_HN = 360 * MiB;
constexpr size_t WS_YMIX = 393 * MiB;
constexpr size_t WS_PROJ = 459 * MiB;
constexpr size_t WS_SCR = 662 * MiB;
constexpr size_t WS_END = 932 * MiB;
constexpr size_t SC_ALORA = 0;
constexpr size_t SC_XR = 8 * MiB;
constexpr size_t SC_DEC = 26 * MiB, SC_ICL = 60 * MiB, SC_GATE = 94 * MiB;
constexpr size_t SC_LA = 128 * MiB, SC_LIX = 162 * MiB;
constexpr size_t SC_QN = 0, SC_KN = 34 * MiB;
constexpr size_t SC_VC = 68 * MiB;
constexpr size_t SC_BETA = 134 * MiB, SC_G = 136 * MiB;
constexpr size_t SC_O = 138 * MiB;
constexpr size_t SC_XG = 0;
constexpr size_t SC_ACT = 96 * MiB;
constexpr size_t SC_YB = 120 * MiB;
static_assert(SC_O + (size_t)MP * 4096 * 4 <= WS_END - WS_SCR && SC_YB + (size_t)MOE_ROWS * 2048 * 2 <= WS_END - WS_SCR && SC_LIX + (size_t)MP * 1024 * 4 <= WS_END - WS_SCR, "scratch map");
constexpr int CW_TMO = 0, CW_CODE = 1;
constexpr int CW_BAR = 4096;
constexpr int CW_PROG = 20480;
constexpr int CW_TS = 24576;
constexpr int CW_MOEDONE = 28672;
constexpr int CW_MOECNT = 16384;

constexpr int RING_OFF = 0, RING_BYTES = 131072;
constexpr int LDSCTL_OFF = 146944, MISC_OFF = LDSCTL_OFF + 320;
constexpr int LDS_BYTES = 147456;


#define DI __device__ __forceinline__
typedef unsigned v2u __attribute__((ext_vector_type(2)));
struct Args { const float* in[36]; float* out; unsigned char* ws; int ph_lo, ph_hi; };
struct Frame {
    LAS unsigned char* lds; volatile LAS unsigned* MISC; gu32* ctl;
    int tid, lane, wave, vcu, G, gw, NGW;
};
DI float bf2f(bf16 v) { return __uint_as_float((unsigned)v << 16); }
DI float bflo(unsigned w) { return __uint_as_float(w << 16); }
DI float bfhi(unsigned w) { return __uint_as_float(w & 0xffff0000u); }
DI float wave_sum(float v) {
#pragma unroll
    for (int o = 1; o < 64; o <<= 1) v += __shfl_xor(v, o);
    return v;
}
DI float sigm(float x) { return __builtin_amdgcn_rcpf(1.0f + __expf(-x)); }
DI float softplus(float x) { return fmaxf(x, 0.f) + __logf(1.0f + __expf(-fabsf(x))); }
DI float gelu_tanh(float x) { const float u = 0.7978845608028654f * (x + 0.044715f * x * x * x); return 0.5f * x * (1.0f + tanhf(u)); }
DI int pos_row(int p) { return p < NMETA ? TX + p : p - NMETA; }
DI int row_pos(int r) { return r < TX ? r + NMETA : r - TX; }

DI void tr_item(const float* W, int N, int k0, int n0, bf16* WT, int ldk, int drow0, LAS float* scr, int lane) {
#pragma unroll 8
    for (int i = 0; i < 32; ++i) { const int kk = 2 * i + (lane >> 5); scr[kk * 33 + (lane & 31)] = W[(size_t)(k0 + kk) * N + n0 + (lane & 31)]; }
    LDS_WAIT(); asm volatile("" ::: "memory");
    const int c = lane & 7;
#pragma unroll
    for (int j = 0; j < 4; ++j) { const int n = (lane >> 3) + 8 * j; const LAS float* s = scr + (8 * c) * 33 + n;
        v4u o; o.x = pk2(s[0 * 33], s[1 * 33]); o.y = pk2(s[2 * 33], s[3 * 33]); o.z = pk2(s[4 * 33], s[5 * 33]); o.w = pk2(s[6 * 33], s[7 * 33]);
        *(v4u*)(WT + (size_t)(drow0 + n) * ldk + k0 + 8 * c) = o; }
    LDS_WAIT(); asm volatile("" ::: "memory");
}
DI void moe_convert(const Frame& F, const Args& a, int l, int gw, int ngw) {
    LAS float* scr = (LAS float*)(F.lds + RING_OFF + F.wave * 16384);
    bf16* base = (bf16*)(a.ws + WS_MOEW);
    for (int it = gw; it < NEXP * 1536; it += ngw) {
        const int e = it / 1536; int j = it % 1536; bf16* eb = base + (size_t)e * (MOE_E_BYTES / 2);
        const size_t eoff = (size_t)(l * NEXP + e) * DM * FF;
        if (j < 1024) { const float* W = (j < 512 ? a.in[33] : a.in[34]) + eoff; const int hi = j >= 512; j &= 511; const int kb = j >> 4, nb = j & 15, n0 = 32 * nb;
            tr_item(W, FF, 64 * kb, n0, eb, DM, 256 * (n0 >> 7) + 128 * hi + (n0 & 127), scr, F.lane); }
        else { j -= 1024; const int kb = j >> 6, nb = j & 63; tr_item(a.in[35] + eoff, DM, 64 * kb, 32 * nb, eb + MOE_W2_OFF / 2, FF, 32 * nb, scr, F.lane); }
    }
}
DI void norm_row_bf16(int lane, const float* src, const float* w, bf16* dst) {
    f32x4 v[8]; float s = 0.f;
#pragma unroll
    for (int j = 0; j < 8; ++j) { v[j] = ((const f32x4*)src)[lane + 64 * j]; s += (v[j].x * v[j].x + v[j].y * v[j].y) + (v[j].z * v[j].z + v[j].w * v[j].w); }
    const float rs = 1.0f / sqrtf(wave_sum(s) * (1.0f / DM) + NORM_EPS);
#pragma unroll
    for (int j = 0; j < 8; ++j) { const f32x4 wv = ((const f32x4*)w)[lane + 64 * j]; v2u o; o.x = pk2(v[j].x * rs * wv.x, v[j].y * rs * wv.y); o.y = pk2(v[j].z * rs * wv.z, v[j].w * rs * wv.w);
        ((v2u*)dst)[lane + 64 * j] = o; }
}

DI void ph_prologue(const Frame& F, const Args& a) {
    LAS float* scr = (LAS float*)(F.lds + RING_OFF + F.wave * 16384);
    constexpr int I_A = 32 * 169, I_B = 32 * 64, NIT = I_A + I_B;
    for (int it = F.gw; it < NIT; it += F.NGW) {
        int r = it;
        if (r < I_A) { const int kb = r / 169, nb = r % 169; tr_item(a.in[5], 5408, 64 * kb, 32 * nb, (bf16*)(a.ws + WS_WEVIN), DM, 32 * nb, scr, F.lane); continue; } r -= I_A;
        { const int kb = r / 64, nb = r % 64; tr_item(a.in[24], DM, 64 * kb, 32 * nb, (bf16*)(a.ws + WS_WEVOUT), DM, 32 * nb, scr, F.lane); }
    }
    const int gt = F.vcu * (NWAVES * 64) + F.tid, NGT = F.G * NWAVES * 64;
    { bf16* WL = (bf16*)(a.ws + WS_WLORA); const float* wup = a.in[8]; const float* aup = a.in[10]; const float* gup = a.in[11];
      for (int idx = gt; idx < 3072 * 384; idx += NGT) { const int n = idx / 384, k = idx % 384; float v = 0.f;
          if (n < 1024) { if (k < 64) v = wup[k * 1024 + n]; }
          else if (n < 2048) { if (k >= 64 && k < 128) v = aup[(k - 64) * 1024 + n - 1024]; }
          else { if (k >= 128 && k < 288) v = gup[(k - 128) * 1024 + n - 2048]; }
          WL[idx] = (bf16)f2bf(v); } }
    { bf16* WG = (bf16*)(a.ws + WS_WGATE);
      for (int idx = gt; idx < 2048 * 256; idx += NGT) { const int n = idx >> 8, kk = idx & 255, nn = n & 1023, blk = nn >> 6, j = nn & 63, cin = (nn & ~255) + kk;
          const float* W = n < 1024 ? a.in[19] : a.in[21];
          const float v = (cin >> 6) == blk ? W[blk * 4096 + (cin & 63) * 64 + j] : 0.f;
          WG[idx] = (bf16)f2bf(v); } }
    { bf16* WR = (bf16*)(a.ws + WS_WROUTE);
      for (int idx = gt; idx < 2 * 48 * DM; idx += NGT) { const int l = idx / (48 * DM), n = (idx / DM) % 48, k = idx % DM; float v = 0.f;
          if (n < 32) v = a.in[32][((size_t)l * DM + k) * NEXP + n]; else if (n < 36) v = a.in[31][((size_t)l * DM + k) * 4 + n - 32];
          const unsigned hi = f2bf(v); WR[((size_t)(l * 2) * 48 + n) * DM + k] = (bf16)hi; WR[((size_t)(l * 2 + 1) * 48 + n) * DM + k] = (bf16)f2bf(v - __uint_as_float(hi << 16)); } }
    bf16* HN = (bf16*)(a.ws + WS_HN);
    for (int r = F.gw; r < TT; r += F.NGW) norm_row_bf16(F.lane, r < TX ? a.in[0] + (size_t)r * DM : a.in[1] + (size_t)(r - TX) * DM, a.in[2], HN + (size_t)r * DM);
}

DI void ph_aux_convert(const Frame& F, const Args& a, int gw, int ngw) {
    LAS float* scr = (LAS float*)(F.lds + RING_OFF + F.wave * 16384);
    constexpr int I_C = 32 * 386, I_D = 64 * 64, NIT = I_C + I_D;
    for (int it = gw; it < NIT; it += ngw) {
        int r = it;
        if (r < I_C) { const int kb = r / 386, nb = r % 386; const int c_ = 32 * nb, dr_ = c_ < 8192 ? c_ : (c_ < 12288 ? c_ - 8192 + OD_Z : c_ - 12288 + OD_B);
            tr_item(a.in[25], 12352, 64 * kb, c_, (bf16*)(a.ws + WS_WODIN), DM, dr_, scr, F.lane); continue; } r -= I_C;
        { const int kb = r / 64, nb = r % 64; tr_item(a.in[30], DM, 64 * kb, 32 * nb, (bf16*)(a.ws + WS_WODOUT), 4096, 32 * nb, scr, F.lane); }
    }
    moe_convert(F, a, 0, gw, ngw);
}

DI void ph_even_prep(const Frame& F, const Args& a) {
    const bf16* P = (const bf16*)(a.ws + WS_PROJ); bf16* AL = (bf16*)(a.ws + WS_SCR + SC_ALORA); bf16* XR = (bf16*)(a.ws + WS_SCR + SC_XR);
    const float* mu = a.in[6]; const float* cw = a.in[17]; const float* cb = a.in[18];
    const int lane = F.lane;
    for (int item = F.gw; item < TT + (TT / 8) * 2; item += F.NGW) {
        if (item < TT) { const int r = item, pos = row_pos(r); const bf16* cur = P + (size_t)r * EV_NP; const bf16* prv = P + (size_t)pos_row(pos > 0 ? pos - 1 : 0) * EV_NP; const float pm = pos > 0 ? 1.f : 0.f;
            float cv[6], pv[6], mv[6];
#pragma unroll
            for (int i = 0; i < 6; ++i) { const int idx = lane + 64 * i, col = EV_LORA0 + (idx < 288 ? idx : 287); cv[i] = bf2f(cur[col]); pv[i] = bf2f(prv[col]) * pm; mv[i] = mu[col]; }
#pragma unroll
            for (int i = 0; i < 6; ++i) { const int idx = lane + 64 * i; float v = cv[i] + (pv[i] - cv[i]) * mv[i];
                if (idx < 64) v = tanhf(v); else if (idx >= 128) v = sigm(v);
                AL[(size_t)r * 384 + idx] = (bf16)f2bf(idx < 288 ? v : 0.f); }
        } else { const int it2 = item - TT, pb = it2 >> 1, c0 = (it2 & 1) * 512 + lane * 8, p0 = pb * 8;
            f32x4 w[4][2], b0 = *(const f32x4*)(cb + c0), b1 = *(const f32x4*)(cb + c0 + 4);
#pragma unroll
            for (int j = 0; j < 4; ++j) { w[j][0] = *(const f32x4*)(cw + j * 1024 + c0); w[j][1] = *(const f32x4*)(cw + j * 1024 + c0 + 4); }
            v4u x[11];
#pragma unroll
            for (int i = 0; i < 11; ++i) { const int p = p0 - 3 + i; x[i] = *(const v4u*)(P + (size_t)pos_row(p > 0 ? p : 0) * EV_NP + EV_REC + c0); if (p < 0) x[i] = (v4u){0u, 0u, 0u, 0u}; }
#pragma unroll
            for (int o = 0; o < 8; ++o) { float acc[8] = {b0.x, b0.y, b0.z, b0.w, b1.x, b1.y, b1.z, b1.w};
#pragma unroll
                for (int j = 0; j < 4; ++j) { const v4u xv = x[o + j];
                    acc[0] += w[j][0].x * bflo(xv.x); acc[1] += w[j][0].y * bfhi(xv.x); acc[2] += w[j][0].z * bflo(xv.y); acc[3] += w[j][0].w * bfhi(xv.y);
                    acc[4] += w[j][1].x * bflo(xv.z); acc[5] += w[j][1].y * bfhi(xv.z); acc[6] += w[j][1].z * bflo(xv.w); acc[7] += w[j][1].w * bfhi(xv.w); }
                *(v4u*)(XR + (size_t)pos_row(p0 + o) * 1024 + c0) = (v4u){pk2(acc[0], acc[1]), pk2(acc[2], acc[3]), pk2(acc[4], acc[5]), pk2(acc[6], acc[7])}; } }
    }
}

DI void ph_route(const Frame& F, const Args& a, int l, int dummy) {
    const float* H = (const float*)(a.ws + WS_H); const float* nw = a.in[3] + (size_t)l * DM;
    const bf16* WH = (const bf16*)(a.ws + WS_WROUTE) + (size_t)(l * 2) * 48 * DM; const bf16* WL = WH + (size_t)48 * DM;
    unsigned* TI = (unsigned*)(a.ws + WS_TOKINFO) + (dummy ? (WS_SCR + 250 * MiB - WS_TOKINFO) / 4 : 0); const int lane = F.lane, lc = lane & 15, quad = lane >> 4, wave = F.wave; const int cl = dummy ? l + 2 : l;
    LAS float* red = (LAS float*)(F.lds + RING_OFF);
    LAS float* sq = red + 8 * 9 * 64 * 4; LAS float* lgs = sq + 8 * 48;
    static_assert(TT % 48 == 0, "router tasks");
    for (int task = F.vcu; task < TT / 48; task += F.G) {
        const float* nwp = nw + 256 * wave + 8 * quad; float ss[3] = {0.f, 0.f, 0.f};
        f32x4 acc[3][3];
#pragma unroll
        for (int mt = 0; mt < 3; ++mt)
#pragma unroll
            for (int nt = 0; nt < 3; ++nt) acc[mt][nt] = (f32x4){0.f, 0.f, 0.f, 0.f};
#pragma unroll 2
        for (int ks = 0; ks < 8; ++ks) { const int k0 = 256 * wave + 32 * ks + 8 * quad; const f32x4 w0 = *(const f32x4*)(nwp + 32 * ks), w1 = *(const f32x4*)(nwp + 32 * ks + 4);
            bf16x8 bh[3], bl[3];
#pragma unroll
            for (int nt = 0; nt < 3; ++nt) { bh[nt] = *(const bf16x8*)(WH + (size_t)(16 * nt + lc) * DM + k0); bl[nt] = *(const bf16x8*)(WL + (size_t)(16 * nt + lc) * DM + k0); }
#pragma unroll
            for (int mt = 0; mt < 3; ++mt) { const float* hr = H + (size_t)(task * 48 + mt * 16 + lc) * DM + k0; const f32x4 x0 = *(const f32x4*)hr, x1 = *(const f32x4*)(hr + 4);
                ss[mt] += (x0.x * x0.x + x0.y * x0.y) + (x0.z * x0.z + x0.w * x0.w) + (x1.x * x1.x + x1.y * x1.y) + (x1.z * x1.z + x1.w * x1.w);
                const float xn[8] = {x0.x * w0.x, x0.y * w0.y, x0.z * w0.z, x0.w * w0.w, x1.x * w1.x, x1.y * w1.y, x1.z * w1.z, x1.w * w1.w};
                unsigned hi[8]; float lo[8];
#pragma unroll
                for (int q = 0; q < 8; ++q) { hi[q] = f2bf(xn[q]); lo[q] = xn[q] - __uint_as_float(hi[q] << 16); }
                const v4u ah4 = (v4u){hi[0] | (hi[1] << 16), hi[2] | (hi[3] << 16), hi[4] | (hi[5] << 16), hi[6] | (hi[7] << 16)}, al4 = (v4u){pk2(lo[0], lo[1]), pk2(lo[2], lo[3]), pk2(lo[4], lo[5]), pk2(lo[6], lo[7])};
                const bf16x8 ah = __builtin_bit_cast(bf16x8, ah4), al = __builtin_bit_cast(bf16x8, al4);
#pragma unroll
                for (int nt = 0; nt < 3; ++nt) { acc[mt][nt] = __builtin_amdgcn_mfma_f32_16x16x32_bf16(al, bh[nt], acc[mt][nt], 0, 0, 0); acc[mt][nt] = __builtin_amdgcn_mfma_f32_16x16x32_bf16(ah, bl[nt], acc[mt][nt], 0, 0, 0);
                    acc[mt][nt] = __builtin_amdgcn_mfma_f32_16x16x32_bf16(ah, bh[nt], acc[mt][nt], 0, 0, 0); } } }
#pragma unroll
        for (int mt = 0; mt < 3; ++mt) { float s_ = ss[mt]; s_ += __shfl_xor(s_, 16); s_ += __shfl_xor(s_, 32); if (quad == 0) sq[wave * 48 + mt * 16 + lc] = s_;
#pragma unroll
            for (int nt = 0; nt < 3; ++nt) *(LAS f32x4*)(red + ((wave * 9 + mt * 3 + nt) * 64 + lane) * 4) = acc[mt][nt]; }
        __syncthreads();
        { const int tile = wave;
#pragma unroll
          for (int rep = 0; rep < 2; ++rep) { const int tl = tile + 8 * rep; if (tl < 9) { f32x4 s = *(const LAS f32x4*)(red + (tl * 64 + lane) * 4);
#pragma unroll
              for (int v = 1; v < 8; ++v) s = s + *(const LAS f32x4*)(red + ((v * 9 + tl) * 64 + lane) * 4);
              const int mt = tl / 3, nt = tl % 3;
#pragma unroll
              for (int q = 0; q < 4; ++q) lgs[(mt * 16 + 4 * quad + q) * 49 + 16 * nt + lc] = s[q]; } } }
        __syncthreads();
        if (wave == 0 && lane < 48) { float sst = 0.f;
#pragma unroll
            for (int v = 0; v < 8; ++v) sst += sq[v * 48 + lane];
            const float rs = 1.0f / sqrtf(sst * (1.0f / DM) + NORM_EPS);
            float lg[36];
#pragma unroll
            for (int i = 0; i < 36; ++i) lg[i] = lgs[lane * 49 + i] * rs;
            int gi = 0; float gm = lg[32];
#pragma unroll
            for (int i = 1; i < 4; ++i) if (lg[32 + i] > gm) { gm = lg[32 + i]; gi = i; }
            float den = 0.f;
#pragma unroll
            for (int i = 0; i < 4; ++i) den += __expf(lg[32 + i] - gm);
            const float gp = 1.0f / den;
            float l8[8];
#pragma unroll
            for (int i = 0; i < 8; ++i) l8[i] = gi == 0 ? lg[i] : (gi == 1 ? lg[8 + i] : (gi == 2 ? lg[16 + i] : lg[24 + i]));
            int i1 = 0; float m1 = l8[0];
#pragma unroll
            for (int i = 1; i < 8; ++i) if (l8[i] > m1) { m1 = l8[i]; i1 = i; }
            int i2 = -1; float m2 = -INFINITY;
#pragma unroll
            for (int i = 0; i < 8; ++i) if (i != i1 && l8[i] > m2) { m2 = l8[i]; i2 = i; }
            const float e21 = __expf(m2 - m1); const float w1 = gp / (1.0f + e21), w2 = gp * e21 / (1.0f + e21);
            const int ea = gi * 8 + i1, eb = gi * 8 + i2; const int rt = task * 48 + lane;
            const unsigned long long ltm = (1ull << lane) - 1ull; unsigned cnt_e = 0u, ra = 0u, rb = 0u;
#pragma unroll 8
            for (int e = 0; e < NEXP; ++e) { const unsigned long long ma = __ballot(ea == e), mb = __ballot(eb == e); const unsigned ca = (unsigned)__popcll(ma);
                if (lane == e) cnt_e = ca + (unsigned)__popcll(mb);
                if (ea == e) ra = (unsigned)__popcll(ma & ltm);
                if (eb == e) rb = ca + (unsigned)__popcll(mb & ltm); }
            unsigned base = 0u; if (lane < NEXP && cnt_e) base = atomicAdd((unsigned*)(F.ctl + CW_MOECNT + (cl * NEXP + lane) * 16), cnt_e);
            const unsigned sa = (unsigned)__shfl((int)base, ea) + ra, sb = (unsigned)__shfl((int)base, eb) + rb;
            unsigned* t = TI + (size_t)rt * 8; *(v4u*)t = (v4u){(unsigned)ea, sa, __float_as_uint(w1), (unsigned)eb}; *(v4u*)(t + 4) = (v4u){sb, __float_as_uint(w2), __float_as_uint(rs), 0u}; }
        __syncthreads();
    }
}
DI void moe_prefix(const Frame& F, int l, LAS int* ps) {
    if (F.tid < 32) { const int e = F.tid; const unsigned c = __hip_atomic_load(F.ctl + CW_MOECNT + (l * NEXP + e) * 16, RLX_AGENT);
        const int nt_ = (int)((c + 255u) >> 8); int incl = nt_;
#pragma unroll
        for (int o = 1; o < 32; o <<= 1) { const int t = __shfl_up(incl, o); if (e >= o) incl += t; }
        ps[e] = (incl - nt_) * 256; if (e == 31) ps[32] = incl; }
    __syncthreads();
}
DI void ph_gather(const Frame& F, const Args& a, int l) {
    LAS int* ps = (LAS int*)(F.lds + RING_OFF); moe_prefix(F, l, ps);
    if (F.vcu == 0 && F.tid < NEXP) { int* TE = (int*)(a.ws + WS_TILES); const int e = F.tid; const int t0 = ps[e] >> 8, t1 = (e == NEXP - 1 ? ps[32] : ps[e + 1] >> 8);
        for (int t = t0; t < t1; ++t) TE[t] = e; if (e == 0) TE[127] = ps[32]; }
    const float* H = (const float*)(a.ws + WS_H); const float* nw = a.in[3] + (size_t)l * DM; unsigned* TI = (unsigned*)(a.ws + WS_TOKINFO); bf16* XG = (bf16*)(a.ws + WS_SCR + SC_XG);
    const int lane = F.lane;
    f32x4 nwv[4][2];
#pragma unroll
    for (int j = 0; j < 4; ++j) { const int e0 = (lane + 64 * j) * 8; nwv[j][0] = *(const f32x4*)(nw + e0); nwv[j][1] = *(const f32x4*)(nw + e0 + 4); }
    for (int r = F.gw; r < TT; r += 2 * F.NGW) { const int r2 = r + F.NGW; const bool h2 = r2 < TT; const int rb = h2 ? r2 : r;
        unsigned* ta = TI + (size_t)r * 8; unsigned* tb = TI + (size_t)rb * 8;
        const unsigned a0 = ta[0], a1 = ta[1], a3 = ta[3], a4 = ta[4], a6 = ta[6], b0 = tb[0], b1 = tb[1], b3 = tb[3], b4 = tb[4], b6 = tb[6];
        const float* hra = H + (size_t)r * DM; const float* hrb = H + (size_t)rb * DM; f32x4 xa[4][2], xb[4][2];
#pragma unroll
        for (int j = 0; j < 4; ++j) { const int e0 = (lane + 64 * j) * 8; xa[j][0] = *(const f32x4*)(hra + e0); xa[j][1] = *(const f32x4*)(hra + e0 + 4); xb[j][0] = *(const f32x4*)(hrb + e0); xb[j][1] = *(const f32x4*)(hrb + e0 + 4); }
#pragma unroll
        for (int q = 0; q < 2; ++q) { if (q == 1 && !h2) break;
            unsigned* t = q ? tb : ta; const int g0 = ps[q ? b0 : a0] + (int)(q ? b1 : a1), g1 = ps[q ? b3 : a3] + (int)(q ? b4 : a4); const float rs = __uint_as_float(q ? b6 : a6);
            if (lane == 0) t[7] = (unsigned)g0 | ((unsigned)g1 << 16);
#pragma unroll
            for (int j = 0; j < 4; ++j) { const int e0 = (lane + 64 * j) * 8; const f32x4 x0 = q ? xb[j][0] : xa[j][0], x1 = q ? xb[j][1] : xa[j][1], w0 = nwv[j][0], w1 = nwv[j][1];
                v4u o; o.x = pk2(x0.x * rs * w0.x, x0.y * rs * w0.y); o.y = pk2(x0.z * rs * w0.z, x0.w * rs * w0.w); o.z = pk2(x1.x * rs * w1.x, x1.y * rs * w1.y); o.w = pk2(x1.z * rs * w1.z, x1.w * rs * w1.w);
                *(v4u*)(XG + (size_t)g0 * DM + e0) = o; *(v4u*)(XG + (size_t)g1 * DM + e0) = o; } }
    }
}
DI void ph_combine(const Frame& F, const Args& a, int l) {
    float* H = (float*)(a.ws + WS_H); const unsigned* TI = (const unsigned*)(a.ws + WS_TOKINFO); const bf16* YB = (const bf16*)(a.ws + WS_SCR + SC_YB); bf16* HN = (bf16*)(a.ws + WS_HN);
    const int lane = F.lane; const int nrows = l == 0 ? TT : TX;
    f32x4 nwc[4][2]; { const float* nwp = l == 0 ? a.in[2] + DM : a.in[4];
#pragma unroll
      for (int j = 0; j < 4; ++j) { const int e0 = (lane + 64 * j) * 8; nwc[j][0] = *(const f32x4*)(nwp + e0); nwc[j][1] = *(const f32x4*)(nwp + e0 + 4); } }
    for (int r = F.gw; r < nrows; r += F.NGW) {
        const unsigned* t = TI + (size_t)r * 8; const int g0 = (int)(t[7] & 0xffffu), g1 = (int)(t[7] >> 16); const float w0 = __uint_as_float(t[2]), w1 = __uint_as_float(t[5]);
        float* hr = H + (size_t)r * DM; float hv[32]; float s = 0.f;
#pragma unroll
        for (int j = 0; j < 4; ++j) { const int e0 = (lane + 64 * j) * 8; const f32x4 x0 = *(const f32x4*)(hr + e0), x1 = *(const f32x4*)(hr + e0 + 4);
            const v4u ya = *(const v4u*)(YB + (size_t)g0 * DM + e0), yc = *(const v4u*)(YB + (size_t)g1 * DM + e0);
            float* o = hv + 8 * j;
            o[0] = x0.x + w0 * bflo(ya.x) + w1 * bflo(yc.x); o[1] = x0.y + w0 * bfhi(ya.x) + w1 * bfhi(yc.x); o[2] = x0.z + w0 * bflo(ya.y) + w1 * bflo(yc.y); o[3] = x0.w + w0 * bfhi(ya.y) + w1 * bfhi(yc.y);
            o[4] = x1.x + w0 * bflo(ya.z) + w1 * bflo(yc.z); o[5] = x1.y + w0 * bfhi(ya.z) + w1 * bfhi(yc.z); o[6] = x1.z + w0 * bflo(ya.w) + w1 * bflo(yc.w); o[7] = x1.w + w0 * bfhi(ya.w) + w1 * bfhi(yc.w);
#pragma unroll
            for (int q = 0; q < 8; ++q) s += o[q] * o[q]; }
        const float rs = 1.0f / sqrtf(wave_sum(s) * (1.0f / DM) + NORM_EPS);
        if (l == 0) { const float* nw = a.in[2] + DM;
#pragma unroll
            for (int j = 0; j < 4; ++j) { const int e0 = (lane + 64 * j) * 8; const float* o = hv + 8 * j; const f32x4 wa = nwc[j][0], wb = nwc[j][1];
                *(f32x4*)(hr + e0) = (f32x4){o[0], o[1], o[2], o[3]}; *(f32x4*)(hr + e0 + 4) = (f32x4){o[4], o[5], o[6], o[7]};
                v4u p; p.x = pk2(o[0] * rs * wa.x, o[1] * rs * wa.y); p.y = pk2(o[2] * rs * wa.z, o[3] * rs * wa.w); p.z = pk2(o[4] * rs * wb.x, o[5] * rs * wb.y); p.w = pk2(o[6] * rs * wb.z, o[7] * rs * wb.w);
                *(v4u*)(HN + (size_t)r * DM + e0) = p; }
        } else { const float* nw = a.in[4]; float* orow = a.out + (size_t)r * DM;
#ifdef PROBE_TS
            { const unsigned long long* ts = (const unsigned long long*)(F.ctl + CW_TS); const float dt_us = (float)(__hip_atomic_load(ts + PROBE_TS + 1, RLX_AGENT) - __hip_atomic_load(ts + PROBE_TS, RLX_AGENT)) * 0.01f;
#pragma unroll
              for (int q = 0; q < 32; ++q) hv[q] *= 1.0f + dt_us * 0.01f; }
#endif
#pragma unroll
            for (int j = 0; j < 4; ++j) { const int e0 = (lane + 64 * j) * 8; const float* o = hv + 8 * j; const f32x4 wa = nwc[j][0], wb = nwc[j][1];
                *(f32x4*)(orow + e0) = (f32x4){o[0] * rs * wa.x, o[1] * rs * wa.y, o[2] * rs * wa.z, o[3] * rs * wa.w};
                *(f32x4*)(orow + e0 + 4) = (f32x4){o[4] * rs * wb.x, o[5] * rs * wb.y, o[6] * rs * wb.z, o[7] * rs * wb.w}; } }
    }
}

struct OddPrepW { f32x4 w[4][2]; };
struct OddPrepX { v4u x[11]; };
DI void odd_prep_load_w(OddPrepW& W, const float* cw, int item, int lane) {
    const int i = item & 15, ch = i * 512 + lane * 8;
#pragma unroll
    for (int j = 0; j < 4; ++j) { W.w[j][0] = *(const f32x4*)(cw + j * 8192 + ch); W.w[j][1] = *(const f32x4*)(cw + j * 8192 + ch + 4); }
}
DI void odd_prep_load_x(OddPrepX& it, const bf16* P, int item, int lane) {
    const int pb = item >> 4, i = item & 15, ch = i * 512 + lane * 8, p0 = pb * 8;
#pragma unroll
    for (int q = 0; q < 11; ++q) { const int p = p0 - 3 + q; it.x[q] = *(const v4u*)(P + (size_t)pos_row(p > 0 ? p : 0) * OD_NP + ch); if (p < 0) it.x[q] = (v4u){0u, 0u, 0u, 0u}; }
}
DI void odd_prep_compute(const OddPrepX& it, const OddPrepW& W, const Args& a, int item, int lane) {
    const bf16* P = (const bf16*)(a.ws + WS_PROJ); bf16* QN = (bf16*)(a.ws + WS_SCR + SC_QN); bf16* KN = (bf16*)(a.ws + WS_SCR + SC_KN); bf16* VC = (bf16*)(a.ws + WS_SCR + SC_VC);
    float* BETA = (float*)(a.ws + WS_SCR + SC_BETA); float* GG = (float*)(a.ws + WS_SCR + SC_G);
    const int pb = item >> 4, i = item & 15, ch = i * 512 + lane * 8, p0 = pb * 8;
#pragma unroll
    for (int o = 0; o < 8; ++o) { const int r = pos_row(p0 + o); float acc[8] = {0.f, 0.f, 0.f, 0.f, 0.f, 0.f, 0.f, 0.f};
#pragma unroll
        for (int j = 0; j < 4; ++j) { const v4u xv = it.x[o + j];
            acc[0] += W.w[j][0].x * bflo(xv.x); acc[1] += W.w[j][0].y * bfhi(xv.x); acc[2] += W.w[j][0].z * bflo(xv.y); acc[3] += W.w[j][0].w * bfhi(xv.y);
            acc[4] += W.w[j][1].x * bflo(xv.z); acc[5] += W.w[j][1].y * bfhi(xv.z); acc[6] += W.w[j][1].z * bflo(xv.w); acc[7] += W.w[j][1].w * bfhi(xv.w); }
        float ss = 0.f;
#pragma unroll
        for (int q = 0; q < 8; ++q) { acc[q] = acc[q] * sigm(acc[q]); ss += acc[q] * acc[q]; }
        float sc = 1.0f;
        if (i < 8) { ss += __shfl_xor(ss, 1); ss += __shfl_xor(ss, 2); ss += __shfl_xor(ss, 4); ss += __shfl_xor(ss, 8);
            sc = (1.0f / sqrtf(ss + NORM_EPS)) * (i < 4 ? 0.08838834764831845f : 1.0f); }
        const v4u ov = (v4u){pk2(acc[0] * sc, acc[1] * sc), pk2(acc[2] * sc, acc[3] * sc), pk2(acc[4] * sc, acc[5] * sc), pk2(acc[6] * sc, acc[7] * sc)};
        bf16* dst = i < 4 ? QN + (size_t)r * 2048 + ch : (i < 8 ? KN + (size_t)r * 2048 + ch - 2048 : VC + (size_t)r * 4096 + ch - 4096);
        *(v4u*)dst = ov; }
    if (i == 0 && lane < 32) {
#pragma unroll
        for (int o = 0; o < 8; ++o) { const int r = pos_row(p0 + o); const float bb = bf2f(P[(size_t)r * OD_NP + OD_B + lane]), aa = bf2f(P[(size_t)r * OD_NP + OD_A + lane]);
            BETA[(size_t)r * 32 + lane] = sigm(bb); GG[(size_t)r * 32 + lane] = -__expf(a.in[27][lane]) * softplus(aa + a.in[28][lane]); } }
}
#ifndef ODP_WL
#define ODP_WL 10
#endif
DI void ph_odd_prep(const Frame& F, const Args& a, int nlight = 0) {
    const bf16* P = (const bf16*)(a.ws + WS_PROJ); const float* cw = a.in[26]; constexpr int NI = (TT / 8) * 16; const bool wfixed = (F.NGW & 15) == 0;
    if (nlight > 0 && F.NGW == 2048) { constexpr int NPB = TT / 8; const int i = F.gw & 15, m = F.gw >> 4;
        const int nl = (nlight - (i >> 3) + 1) >> 1;
        const int wtot = ODP_WL * nl + 26 * (128 - nl), w0 = m < nl ? ODP_WL * m : ODP_WL * nl + 26 * (m - nl), w1 = w0 + (m < nl ? ODP_WL : 26);
        const int pb0 = (int)(((long)NPB * w0) / wtot), pb1 = (int)(((long)NPB * w1) / wtot);
        OddPrepW W; odd_prep_load_w(W, cw, i, F.lane);
        for (int pb = pb0; pb < pb1; pb += 3) { OddPrepX A, B, C; const int ia = pb * 16 + i, ib = ia + 16, ic = ia + 32; const bool hb = pb + 1 < pb1, hc = pb + 2 < pb1;
            odd_prep_load_x(A, P, ia, F.lane); odd_prep_load_x(B, P, hb ? ib : ia, F.lane); odd_prep_load_x(C, P, hc ? ic : ia, F.lane);
            odd_prep_compute(A, W, a, ia, F.lane); if (hb) odd_prep_compute(B, W, a, ib, F.lane); if (hc) odd_prep_compute(C, W, a, ic, F.lane); }
        return; }
    OddPrepW W; if (F.gw < NI) odd_prep_load_w(W, cw, F.gw, F.lane);
    for (int item = F.gw; item < NI; item += 3 * F.NGW) { OddPrepX A, B, C; const int itb = item + F.NGW, itc = item + 2 * F.NGW; const bool hb = itb < NI, hc = itc < NI;
        odd_prep_load_x(A, P, item, F.lane); odd_prep_load_x(B, P, hb ? itb : item, F.lane); odd_prep_load_x(C, P, hc ? itc : item, F.lane);
        if (!wfixed) odd_prep_load_w(W, cw, item, F.lane);
        odd_prep_compute(A, W, a, item, F.lane);
        if (hb) { if (!wfixed) odd_prep_load_w(W, cw, itb, F.lane); odd_prep_compute(B, W, a, itb, F.lane); }
        if (hc) { if (!wfixed) odd_prep_load_w(W, cw, itc, F.lane); odd_prep_compute(C, W, a, itc, F.lane); } }
}
constexpr int ODD_POST_ROWS0 = 64 * 113;
DI void ph_odd_post(const Frame& F, const Args& a, int part) {
    const bf16* P = (const bf16*)(a.ws + WS_PROJ); const bf16* O = (const bf16*)(a.ws + WS_SCR + SC_O); bf16* Y = (bf16*)(a.ws + WS_YMIX); const float* nw = a.in[29];
    const int lane = F.lane; int w0 = F.gw, wn = F.NGW, n_rows = TX - ODD_POST_ROWS0;
    if (part == 0) { const int wx = F.vcu & 31; if (F.G != 256 || wx < 20) return; w0 = ((F.vcu >> 5) * 12 + (wx - 20)) * NWAVES + F.wave; wn = 96 * NWAVES; n_rows = ODD_POST_ROWS0 + NMETA; }
    if (part == 2) n_rows = TT;
    const f32x4 nw0 = *(const f32x4*)(nw + ((lane * 8) & 127)), nw1 = *(const f32x4*)(nw + ((lane * 8) & 127) + 4);
    for (int ri = w0; ri < n_rows; ri += wn) { const int r = part == 0 ? (ri < ODD_POST_ROWS0 ? ri : TX + ri - ODD_POST_ROWS0) : (part == 1 ? ODD_POST_ROWS0 + ri : ri);
        v4u owv[8], zv[8];
#pragma unroll
        for (int i = 0; i < 8; ++i) { const int ch = i * 512 + lane * 8; owv[i] = *(const v4u*)(O + (size_t)r * 4096 + ch); zv[i] = *(const v4u*)(P + (size_t)r * OD_NP + OD_Z + ch); }
#pragma unroll
        for (int i = 0; i < 8; ++i) { const int ch = i * 512 + lane * 8; const v4u ow = owv[i]; const f32x4 o0 = (f32x4){bflo(ow.x), bfhi(ow.x), bflo(ow.y), bfhi(ow.y)}, o1 = (f32x4){bflo(ow.z), bfhi(ow.z), bflo(ow.w), bfhi(ow.w)};
            float ss = (o0.x * o0.x + o0.y * o0.y) + (o0.z * o0.z + o0.w * o0.w) + (o1.x * o1.x + o1.y * o1.y) + (o1.z * o1.z + o1.w * o1.w);
            ss += __shfl_xor(ss, 1); ss += __shfl_xor(ss, 2); ss += __shfl_xor(ss, 4); ss += __shfl_xor(ss, 8);
            const float rs = 1.0f / sqrtf(ss * (1.0f / 128.0f) + NORM_EPS);
            const v4u z = zv[i]; const f32x4 w0 = nw0, w1 = nw1;
            const float zf[8] = {bflo(z.x), bfhi(z.x), bflo(z.y), bfhi(z.y), bflo(z.z), bfhi(z.z), bflo(z.w), bfhi(z.w)};
            const float of[8] = {o0.x * w0.x, o0.y * w0.y, o0.z * w0.z, o0.w * w0.w, o1.x * w1.x, o1.y * w1.y, o1.z * w1.z, o1.w * w1.w};
            float y[8];
#pragma unroll
            for (int q = 0; q < 8; ++q) y[q] = of[q] * rs * zf[q] * sigm(zf[q]);
            v4u p; p.x = pk2(y[0], y[1]); p.y = pk2(y[2], y[3]); p.z = pk2(y[4], y[5]); p.w = pk2(y[6], y[7]);
            *(v4u*)(Y + (size_t)r * 4096 + ch) = p; }
    }
}

typedef float f32x16 __attribute__((ext_vector_type(16)));
#define MFMA32(a, b, c) __builtin_amdgcn_mfma_f32_32x32x16_bf16((a), (b), (c), 0, 0, 0)
DI int crow(int reg, int h) { return (reg & 3) + 8 * (reg >> 2) + 4 * h; }
DI int chunk_row(int n, int c) { return n == 0 ? (c >= 48 ? TX + (c - 48) : -1) : 64 * (n - 1) + c; }
#ifndef GDN_NO_HELPER
#define GDN_NO_HELPER 0
#endif
constexpr int GDN_NCH = 129, GDN_UNITS = GDN_NCH * 32, GDN_KUNITS = GDN_NCH * 16, GC_STRIDE = 72;
constexpr size_t GD_WF = WS_MOEW, GD_UF = WS_MOEW + 65 * MiB, GD_IN = WS_MOEW + 130 * MiB, GD_GC = WS_MOEW + 163 * MiB, GD_KT = WS_HN, GD_QF = WS_SCR + 208 * MiB, GD_SAVE = WS_SCR + 205 * MiB;
static_assert(GD_QF + (size_t)GDN_KUNITS * 16384 <= WS_END && GD_SAVE + 2 * MiB <= GD_QF && (size_t)GDN_UNITS * 16384 <= 65 * MiB && (size_t)GDN_UNITS * 8192 <= 33 * MiB && (size_t)GDN_KUNITS * 16384 <= 33 * MiB && GD_GC + (size_t)GDN_UNITS * GC_STRIDE * 4 <= WS_H, "gdn map");

DI void ph_gdn_chunk(const Frame& F, const Args& a, int n_lo, int n_hi, int side) {
    const bf16* QN = (const bf16*)(a.ws + WS_SCR + SC_QN); const bf16* KN = (const bf16*)(a.ws + WS_SCR + SC_KN); const bf16* VC = (const bf16*)(a.ws + WS_SCR + SC_VC);
    const float* BETA = (const float*)(a.ws + WS_SCR + SC_BETA); const float* GG = (const float*)(a.ws + WS_SCR + SC_G);
    bf16* WF = (bf16*)(a.ws + GD_WF); bf16* UF = (bf16*)(a.ws + GD_UF); bf16* INF = (bf16*)(a.ws + GD_IN); bf16* KTF = (bf16*)(a.ws + GD_KT); bf16* QF = (bf16*)(a.ws + GD_QF); float* GC = (float*)(a.ws + GD_GC);
    LAS unsigned char* L = F.lds + RING_OFF;
    LAS unsigned char* kS = L; LAS unsigned char* qS = L + 17408; LAS unsigned char* vS = L + 34816; LAS unsigned char* kbS = L + 52224;
    LAS float* Lm = (LAS float*)(L + 69632); LAS bf16* IS = (LAS bf16*)(L + 87040); LAS bf16* XS = (LAS bf16*)(L + 96256);
    LAS float* betaS = (LAS float*)(L + 130048); LAS float* gcS = betaS + 64; LAS float* egcS = betaS + 128;
    LAS unsigned char* XUT = L;
    LAS unsigned char* Lb = L + 74752; LAS float* LmD = (LAS float*)(L + 69632); LAS unsigned char* TDs = L + 26624;     LAS unsigned char* YT0 = L + 28672; LAS unsigned char* XT0 = L + 130816;
    static_assert(130816 + 8 * 1792 <= LDSCTL_OFF, "gdn lds map");
    const int tid = F.tid, lane = F.lane, wave = F.wave, l31 = lane & 31, h = lane >> 5;
    int widx = F.vcu, wcnt = F.G;
    if (side) { if (F.G == 256) { const int wx = F.vcu & 31; if (wx < 20) return; widx = (F.vcu >> 5) * 12 + (wx - 20); wcnt = 96; } else { if (F.vcu < 128 || F.G <= 128) return; widx = F.vcu - 128; wcnt = F.G - 128; } }
#define G1_BAR() do { asm volatile("s_waitcnt lgkmcnt(0)" ::: "memory"); __builtin_amdgcn_s_barrier(); asm volatile("" ::: "memory"); } while (0)
    v4u pkx[2], pqx[2], pvx[2]; float pbeta = 0.f, pgl = 0.f, pb2[2] = {0.f, 0.f};
#define G1_FETCH(uu) do { const int n_ = (uu) >> 5, hv_ = (uu) & 31, hk_ = hv_ >> 1; \
        _Pragma("unroll") for (int i = 0; i < 2; ++i) { const int p = tid + 512 * i, row = p >> 4, ch = p & 15; const int rr = chunk_row(n_, row); const size_t r_ = (size_t)(rr >= 0 ? rr : 0); \
            pkx[i] = *(const v4u*)(KN + r_ * 2048 + hk_ * 128 + ch * 8); pqx[i] = *(const v4u*)(QN + r_ * 2048 + hk_ * 128 + ch * 8); pvx[i] = *(const v4u*)(VC + r_ * 4096 + hv_ * 128 + ch * 8); \
            pb2[i] = BETA[r_ * 32 + hv_]; \
            if (rr < 0) { pkx[i] = (v4u){0u, 0u, 0u, 0u}; pqx[i] = pkx[i]; pvx[i] = pkx[i]; pb2[i] = 0.f; } } \
        if (wave == 0) { const int rr = chunk_row(n_, lane); const size_t r_ = (size_t)(rr >= 0 ? rr : 0); pbeta = BETA[r_ * 32 + hv_]; pgl = GG[r_ * 32 + hv_]; if (rr < 0) { pbeta = 0.f; pgl = 0.f; } } } while (0)
    const int unit0 = n_lo * 32 + widx;
    if (unit0 < n_hi * 32) G1_FETCH(unit0);
    for (int unit = unit0; unit < n_hi * 32; unit += wcnt) {
        const int n = unit >> 5, hv = unit & 31, hk = hv >> 1; const size_t su = (size_t)hv * GDN_NCH + n;
#pragma unroll
        for (int i = 0; i < 2; ++i) { const int p = tid + 512 * i, row = p >> 4, ch = p & 15;
            *(LAS v4u*)(kS + row * 272 + ch * 16) = pkx[i]; *(LAS v4u*)(qS + row * 272 + ch * 16) = pqx[i]; *(LAS v4u*)(vS + row * 272 + ch * 16) = pvx[i];
            { const v4u kx = pkx[i]; const float b = pb2[i]; v4u o; o.x = pk2(bflo(kx.x) * b, bfhi(kx.x) * b); o.y = pk2(bflo(kx.y) * b, bfhi(kx.y) * b); o.z = pk2(bflo(kx.z) * b, bfhi(kx.z) * b); o.w = pk2(bflo(kx.w) * b, bfhi(kx.w) * b);
              *(LAS v4u*)(kbS + row * 272 + ch * 16) = o; } }
        if (wave == 0) { float b = pbeta, g = pgl;
#pragma unroll
            for (int o = 1; o < 64; o <<= 1) { const float t = __shfl_up(g, o); if (lane >= o) g += t; }
            betaS[lane] = b; gcS[lane] = g; egcS[lane] = __expf(g); }
        if (unit + wcnt < n_hi * 32) G1_FETCH(unit + wcnt);
        G1_BAR();
        if ((hv & 1) == 0) { const size_t kunit = (size_t)hk * GDN_NCH + n;
#pragma unroll
            for (int i = 0; i < 2; ++i) { const int p = tid + 512 * i, comb = p >> 6, ln = p & 63, t = comb >> 3, s = comb & 7; const int c = 32 * t + (ln & 31), k0 = 16 * s + 8 * (ln >> 5);
                *(v4u*)(QF + (kunit * 16 + comb) * 512 + ln * 8) = *(const LAS v4u*)(qS + c * 272 + k0 * 2); } }
        { const int which = wave >> 2, ti = (wave >> 1) & 1, tj = wave & 1;
          f32x16 acc;
#pragma unroll
          for (int r = 0; r < 16; ++r) acc[r] = 0.f;
          if (!(ti == 0 && tj == 1)) { const LAS unsigned char* Ab = (which == 0 ? kbS : qS) + (32 * ti + l31) * 272 + 16 * h; const LAS unsigned char* Bb = kS + (32 * tj + l31) * 272 + 16 * h;
#pragma unroll
              for (int s = 0; s < 8; ++s) acc = MFMA32(*(const LAS bf16x8*)(Ab + 32 * s), *(const LAS bf16x8*)(Bb + 32 * s), acc); }
          const int j = 32 * tj + l31; const float gj = gcS[j];
          f32x4 gci[4];
#pragma unroll
          for (int g_ = 0; g_ < 4; ++g_) gci[g_] = *(const LAS f32x4*)(gcS + 32 * ti + 8 * g_ + 4 * h);
#pragma unroll
          for (int r = 0; r < 16; ++r) { const int i = 32 * ti + crow(r, h); const float e = __expf(fminf(gci[r >> 2][r & 3] - gj, 0.f));
              if (which == 0) { const float lv = i > j ? acc[r] * e : 0.f; *(LAS bf16*)(Lb + i * 144 + j * 2) = (bf16)f2bf(lv); if ((i >> 4) == (j >> 4)) LmD[(i >> 4) * 320 + (i & 15) * 20 + (j & 15)] = lv; }
              else IS[i * 72 + j] = (bf16)f2bf(i >= j ? acc[r] * e : 0.f); } }
        G1_BAR();
        if (wave == 0) { const int b = lane >> 4, c = lane & 15; float t[16]; const LAS float* Ld = LmD + b * 320;
            t[0] = c == 0 ? 1.f : 0.f; *(LAS bf16*)(TDs + (b * 16) * 32 + c * 2) = (bf16)f2bf(t[0]);
#define G1_INV_ROWS(I0, I1) do { f32x4 Lr[(I1) - (I0)][4]; \
            _Pragma("unroll") for (int i = (I0); i < (I1); ++i) _Pragma("unroll") for (int q = 0; q < (i + 3) / 4; ++q) Lr[i - (I0)][q] = *(const LAS f32x4*)(Ld + i * 20 + 4 * q); \
            _Pragma("unroll") for (int i = (I0); i < (I1); ++i) { float a0 = i == c ? 1.f : 0.f, a1 = 0.f; \
                _Pragma("unroll") for (int j = 0; j < i; ++j) { const float lv = Lr[i - (I0)][j >> 2][j & 3]; if (j & 1) a1 -= lv * t[j]; else a0 -= lv * t[j]; } \
                t[i] = a0 + a1; *(LAS bf16*)(TDs + (b * 16 + i) * 32 + c * 2) = (bf16)f2bf(t[i]); } } while (0)
            G1_INV_ROWS(1, 9); G1_INV_ROWS(9, 13); G1_INV_ROWS(13, 16);
#undef G1_INV_ROWS
        } else if (wave >= 4) { const int t2 = tid - 256;
#pragma unroll
            for (int i = 0; i < 2; ++i) { const int p = t2 + 256 * i, comb = p >> 6, ln = p & 63, t = comb >> 2, s = comb & 3; const int c = 32 * t + (ln & 31), j0 = 16 * s + 8 * (ln >> 5);
                *(v4u*)(INF + (su * 8 + comb) * 512 + ln * 8) = *(const LAS v4u*)(IS + c * 72 + j0); }
            if ((hv & 1) == 0) { const size_t kunit = (size_t)hk * GDN_NCH + n;
#pragma unroll
                for (int i = 0; i < 4; ++i) { const int p = t2 + 256 * i, comb = p >> 6, ln = p & 63, kt = comb >> 2, s = comb & 3; const int kd = 32 * kt + (ln & 31), c0 = 16 * s + 8 * (ln >> 5);
                    unsigned w[4];
#pragma unroll
                    for (int jj = 0; jj < 4; ++jj) { const unsigned lo = *(const LAS bf16*)(kS + (c0 + 2 * jj) * 272 + kd * 2), hi = *(const LAS bf16*)(kS + (c0 + 2 * jj + 1) * 272 + kd * 2); w[jj] = lo | (hi << 16); }
                    *(v4u*)(KTF + (kunit * 16 + comb) * 512 + ln * 8) = (v4u){w[0], w[1], w[2], w[3]}; } }
            if (t2 < 64) GC[su * GC_STRIDE + t2] = gcS[t2];
            else if (t2 == 64) GC[su * GC_STRIDE + 64] = gcS[63];
            else if (t2 == 65) GC[su * GC_STRIDE + 65] = egcS[63];
        }
        G1_BAR();
        { const int quad = lane >> 4, lc = lane & 15; LAS unsigned char* XTw = XT0 + wave * 1792; LAS unsigned char* YTw = YT0 + wave * 768;
          const bf16x8 z8 = (bf16x8){0, 0, 0, 0, 0, 0, 0, 0}; const f32x4 z4 = (f32x4){0.f, 0.f, 0.f, 0.f};
          bf16x8 tdf[4];
#pragma unroll
          for (int b = 0; b < 4; ++b) tdf[b] = quad < 2 ? *(const LAS bf16x8*)(TDs + (b * 16 + lc) * 32 + quad * 16) : z8;
          f32x4 bz4[4]; { const LAS float* bz = wave < 4 ? betaS : egcS;
#pragma unroll
            for (int b = 0; b < 4; ++b) bz4[b] = *(const LAS f32x4*)(bz + 16 * b + 4 * quad); }
#pragma unroll 1
          for (int tl = 0; tl < 2; ++tl) { const int col = 32 * wave + 16 * tl + lc;
              const LAS unsigned char* rz = wave < 4 ? vS + col * 2 : kbS + (col - 128) * 2;
#pragma unroll
              for (int b = 0; b < 4; ++b) { f32x4 y;
#pragma unroll
                  for (int r = 0; r < 4; ++r) { const int i = 16 * b + 4 * quad + r; y[r] = bf2f(*(const LAS bf16*)(rz + i * 272)) * bz4[b][r]; }
                  if (b >= 1) { f32x4 p = z4;
#pragma unroll
                      for (int kk = 0; kk < (b >= 3 ? 2 : 1); ++kk) { const bf16x8 af = *(const LAS bf16x8*)(Lb + (16 * b + lc) * 144 + (32 * kk + 8 * quad) * 2);
                          const bf16x8 bfv = (32 * kk + 8 * quad < 16 * b) ? *(const LAS bf16x8*)(XTw + lc * 112 + (32 * kk + 8 * quad) * 2) : z8;
                          p = __builtin_amdgcn_mfma_f32_16x16x32_bf16(af, bfv, p, 0, 0, 0); }
                      y = y - p; }
                  *(LAS v2u*)(YTw + lc * 48 + quad * 8) = (v2u){pk2(y[0], y[1]), pk2(y[2], y[3])};
                  asm volatile("" ::: "memory");
                  const bf16x8 yb = quad < 2 ? *(const LAS bf16x8*)(YTw + lc * 48 + quad * 16) : z8;
                  const f32x4 x = __builtin_amdgcn_mfma_f32_16x16x32_bf16(tdf[b], yb, z4, 0, 0, 0);
                  const v2u xp = (v2u){pk2(x[0], x[1]), pk2(x[2], x[3])};
                  if (b < 3) *(LAS v2u*)(XTw + lc * 112 + (16 * b + 4 * quad) * 2) = xp;
                  asm volatile("" ::: "memory");
#pragma unroll
                  for (int r = 0; r < 4; ++r) if (wave >= 4) XS[(16 * b + 4 * quad + r) * 264 + col] = (bf16)f2bf(x[r]);
                  if (wave < 4) *(LAS v2u*)(XUT + col * 136 + (16 * b + 4 * quad) * 2) = xp; } } }
        G1_BAR();
#pragma unroll
        for (int i = 0; i < 2; ++i) { const int p = tid + 512 * i, comb = p >> 6, ln = p & 63, t = comb >> 3, s = comb & 7; const int c = 32 * t + (ln & 31), k0 = 16 * s + 8 * (ln >> 5);
            *(v4u*)(WF + (su * 16 + comb) * 512 + ln * 8) = *(const LAS v4u*)(XS + c * 264 + 128 + k0); }
        { const int t = wave >> 2, ns = wave & 3; unsigned w[8];
#pragma unroll
          for (int g_ = 0; g_ < 4; ++g_) { const v2u p_ = *(const LAS v2u*)(XUT + (32 * ns + l31) * 136 + (32 * t + 8 * g_ + 4 * h) * 2); w[2 * g_] = p_.x; w[2 * g_ + 1] = p_.y; }
          bf16* dst = UF + ((su * 8 + wave) * 64 + lane) * 16; *(v4u*)dst = (v4u){w[0], w[1], w[2], w[3]}; *(v4u*)(dst + 8) = (v4u){w[4], w[5], w[6], w[7]}; }
        G1_BAR();
    }
}

#undef G1_BAR
#undef G1_FETCH
DI void ph_gdn_chain(const Frame& F, const Args& a, int n_lo, int n_hi) {
    const int xg = F.vcu >> 5, wx = F.vcu & 31; if (F.G != 256 ? F.vcu >= 128 : wx >= 20) return;
    const bool helper = F.G == 256 && wx >= 16;
    const int hv = F.G == 256 ? 4 * xg + (helper ? wx - 16 : wx >> 2) : F.vcu >> 2, ns = F.G == 256 ? wx & 3 : F.vcu & 3, hk = hv >> 1;
    const bf16* QN = (const bf16*)(a.ws + WS_SCR + SC_QN);
    const bf16* WF = (const bf16*)(a.ws + GD_WF); const bf16* UF = (const bf16*)(a.ws + GD_UF); const bf16* INF = (const bf16*)(a.ws + GD_IN); const bf16* KTF = (const bf16*)(a.ws + GD_KT); const bf16* QF = (const bf16*)(a.ws + GD_QF); const float* GC = (const float*)(a.ws + GD_GC);
    bf16* O = (bf16*)(a.ws + WS_SCR + SC_O);
    gu32* prog = F.ctl + CW_PROG + hv * 16;
    if (helper && GDN_NO_HELPER) return;
    if (helper) { unsigned sink = 0u; const int tid = F.tid;
        for (int n0 = n_lo; n0 < n_hi; n0 += 4) {
            if (n0 >= n_lo + 8) { if (tid == 0) { unsigned sp = 0; while ((int)__hip_atomic_load(prog, RLX_AGENT) < n0 - 4 && ++sp < 20000u) __builtin_amdgcn_s_sleep(8); } __syncthreads(); }
            unsigned v[5];
#pragma unroll
            for (int i = 0; i < 5; ++i) { const int li = tid + 512 * i;
                const int st = li / 580, ln = li % 580, n = n0 + st; const unsigned* p = nullptr;
                if (st < 4 && n < n_hi) { const size_t unit = (size_t)hv * GDN_NCH + n, kunit = (size_t)hk * GDN_NCH + n;
                    if (ln < 128) p = (const unsigned*)(WF + unit * 8192 + ln * 64);
                    else if (ln < 256) p = (const unsigned*)(UF + unit * 8192 + (ln - 128) * 64);
                    else if (ln < 320) p = (const unsigned*)(INF + unit * 4096 + (ln - 256) * 64);
                    else if (ln < 448) p = (const unsigned*)(KTF + kunit * 8192 + (ln - 320) * 64);
                    else if (ln < 576) p = (const unsigned*)(QF + kunit * 8192 + (ln - 448) * 64);
                    else if (ln < 579) p = (const unsigned*)(GC + unit * GC_STRIDE + (ln - 576) * 32); }
                v[i] = p ? *p : 0u; }
#pragma unroll
            for (int i = 0; i < 5; ++i) sink += v[i];
        }
        if (sink == 0x12345u) __hip_atomic_store(F.ctl + CW_TMO + 2, sink, RLX_AGENT);
        return; }
    LAS unsigned char* ST = F.lds + RING_OFF; LAS unsigned char* VN = ST + 8704; LAS unsigned char* VND = ST + 13312;
    const int lane = F.lane, wave = F.wave, l31 = lane & 31, h = lane >> 5;
    for (int i = F.tid; i < 8704 / 4; i += NWAVES * 64) ((LAS unsigned*)ST)[i] = 0u;
#define GDN_BAR() do { asm volatile("s_waitcnt lgkmcnt(0)" ::: "memory"); __builtin_amdgcn_s_barrier(); asm volatile("" ::: "memory"); } while (0)
    GDN_BAR();
    f32x16 S;
#pragma unroll
    for (int r = 0; r < 16; ++r) S[r] = 0.f;
    const int role = wave < 2 ? 0 : (wave < 4 ? 1 : 2); const int t = wave & 1, kt = wave & 3;
    bf16x8 A8[8]; bf16x8 A4[4]; v4u U0 = (v4u){0u, 0u, 0u, 0u}, U1 = U0; f32x4 G4[4]; float gl = 0.f, egl = 1.f;
#pragma unroll
    for (int s = 0; s < 8; ++s) A8[s] = (bf16x8){0, 0, 0, 0, 0, 0, 0, 0};
#pragma unroll
    for (int s = 0; s < 4; ++s) { A4[s] = (bf16x8){0, 0, 0, 0, 0, 0, 0, 0}; G4[s] = (f32x4){0.f, 0.f, 0.f, 0.f}; }
#define GDN_LOAD(nn) do { const size_t unit_ = (size_t)hv * GDN_NCH + (nn); const float* gc_ = GC + unit_ * GC_STRIDE; \
        if (role == 0) { \
            const bf16* up_ = UF + (((unit_ * 2 + t) * 4 + ns) * 64 + lane) * 16; U0 = *(const v4u*)up_; U1 = *(const v4u*)(up_ + 8); \
            _Pragma("unroll") for (int g = 0; g < 4; ++g) G4[g] = *(const f32x4*)(gc_ + 32 * t + 8 * g + 4 * h); gl = gc_[64]; } \
        else if (role == 1) { const size_t qunit_ = (size_t)hk * GDN_NCH + (nn); \
            _Pragma("unroll") for (int s = 0; s < 4; ++s) A4[s] = *(const bf16x8*)(INF + ((unit_ * 2 + t) * 4 + s) * 512 + lane * 8); \
            _Pragma("unroll") for (int g = 0; g < 4; ++g) G4[g] = *(const f32x4*)(gc_ + 32 * t + 8 * g + 4 * h); } \
        else { const size_t kunit_ = (size_t)hk * GDN_NCH + (nn); \
            _Pragma("unroll") for (int s = 0; s < 4; ++s) A4[s] = *(const bf16x8*)(KTF + ((kunit_ * 4 + kt) * 4 + s) * 512 + lane * 8); egl = gc_[65]; } } while (0)
    float* SV = (float*)(a.ws + GD_SAVE) + ((size_t)((hv * 4 + ns) * 4 + kt) * 64 + lane) * 16;
    if (n_lo > 0 && role == 2) {
#pragma unroll
        for (int g = 0; g < 4; ++g) { const f32x4 v = *(const f32x4*)(SV + 4 * g); S[4 * g] = v.x; S[4 * g + 1] = v.y; S[4 * g + 2] = v.z; S[4 * g + 3] = v.w;
            *(LAS v2u*)(ST + l31 * 272 + (32 * kt + 8 * g + 4 * h) * 2) = (v2u){pk2(v.x, v.y), pk2(v.z, v.w)}; }
    }
    GDN_BAR();
#define GDN_LOADA(AC, nn) do { if (role == 0) { const size_t u_ = (size_t)hv * GDN_NCH + (nn); _Pragma("unroll") for (int s = 0; s < 8; ++s) AC[s] = *(const bf16x8*)(WF + ((u_ * 2 + t) * 8 + s) * 512 + lane * 8); } \
        else if (role == 1) { const size_t q_ = (size_t)hk * GDN_NCH + (nn); _Pragma("unroll") for (int s = 0; s < 8; ++s) AC[s] = *(const bf16x8*)(QF + ((q_ * 2 + t) * 8 + s) * 512 + lane * 8); } } while (0)
    bf16x8 A8q[8];
#pragma unroll
    for (int s = 0; s < 8; ++s) A8q[s] = (bf16x8){0, 0, 0, 0, 0, 0, 0, 0};
    GDN_LOADA(A8, n_lo); if (n_lo + 1 < n_hi) GDN_LOADA(A8q, n_lo + 1);
    GDN_LOAD(n_lo);
#define GDN_STEP(n, AC) do { \
        bf16x8 a4[4]; const v4u u0 = U0, u1 = U1; f32x4 g4[4]; const float cgl = gl, cegl = egl; \
        _Pragma("unroll") \
        for (int s = 0; s < 4; ++s) { a4[s] = A4[s]; g4[s] = G4[s]; } \
        if (n + 1 < n_hi) GDN_LOAD(n + 1); \
        if (ns == 0 && F.tid == 0) __hip_atomic_store(prog, (unsigned)n, RLX_AGENT); \
        f32x16 acc; \
        _Pragma("unroll") \
        for (int r = 0; r < 16; ++r) acc[r] = 0.f; \
        if (role < 2) { \
        _Pragma("unroll") \
            for (int s = 0; s < 8; ++s) acc = MFMA32(AC[s], *(const LAS bf16x8*)(ST + l31 * 272 + 32 * s + 16 * h), acc); \
            asm volatile("" :: "v"(acc[0])); \
            if (n + 2 < n_hi) GDN_LOADA(AC, n + 2); \
        } \
        if (role == 0) { const unsigned uw[8] = {u0.x, u0.y, u0.z, u0.w, u1.x, u1.y, u1.z, u1.w}; \
        _Pragma("unroll") \
            for (int g = 0; g < 4; ++g) { float vn[4], vd[4]; \
        _Pragma("unroll") \
                for (int q = 0; q < 4; ++q) { const int r = 4 * g + q; const float uv = (r & 1) ? bfhi(uw[r >> 1]) : bflo(uw[r >> 1]); vn[q] = uv - acc[r]; vd[q] = vn[q] * __expf(cgl - g4[g][q]); } \
                *(LAS v2u*)(VN + l31 * 144 + (32 * t + 8 * g + 4 * h) * 2) = (v2u){pk2(vn[0], vn[1]), pk2(vn[2], vn[3])}; \
                *(LAS v2u*)(VND + l31 * 144 + (32 * t + 8 * g + 4 * h) * 2) = (v2u){pk2(vd[0], vd[1]), pk2(vd[2], vd[3])}; } \
        } else if (role == 1) { \
        _Pragma("unroll") \
            for (int g = 0; g < 4; ++g) \
        _Pragma("unroll") \
                for (int q = 0; q < 4; ++q) acc[4 * g + q] *= __expf(g4[g][q]); \
        } \
        GDN_BAR(); \
        if (role == 1) { \
        _Pragma("unroll") \
            for (int s = 0; s < 4; ++s) acc = MFMA32(a4[s], *(const LAS bf16x8*)(VN + l31 * 144 + 32 * s + 16 * h), acc); \
        _Pragma("unroll") \
            for (int r = 0; r < 16; ++r) { const int rr = chunk_row(n, 32 * t + crow(r, h)); if (rr >= 0) O[(size_t)rr * 4096 + hv * 128 + 32 * ns + l31] = (bf16)f2bf(acc[r]); } \
        } else if (role == 2) { \
        _Pragma("unroll") \
            for (int r = 0; r < 16; ++r) S[r] *= cegl; \
        _Pragma("unroll") \
            for (int s = 0; s < 4; ++s) S = MFMA32(a4[s], *(const LAS bf16x8*)(VND + l31 * 144 + 32 * s + 16 * h), S); \
        _Pragma("unroll") \
            for (int g = 0; g < 4; ++g) *(LAS v2u*)(ST + l31 * 272 + (32 * kt + 8 * g + 4 * h) * 2) = (v2u){pk2(S[4 * g], S[4 * g + 1]), pk2(S[4 * g + 2], S[4 * g + 3])}; \
        } \
        GDN_BAR(); \
    } while (0)
    for (int n2 = n_lo; n2 < n_hi; n2 += 2) { GDN_STEP(n2, A8); if (n2 + 1 < n_hi) GDN_STEP(n2 + 1, A8q); }
#undef GDN_STEP
#undef GDN_LOADA
    if (n_hi < GDN_NCH && role == 2) {
#pragma unroll
        for (int g = 0; g < 4; ++g) *(f32x4*)(SV + 4 * g) = (f32x4){S[4 * g], S[4 * g + 1], S[4 * g + 2], S[4 * g + 3]}; }
#undef GDN_LOAD
#undef GDN_BAR
}

constexpr int RW_NSC = 258, RW_UNITS = 129 * 16;
DI int sub_row(int sc, int t) { const int n = sc >> 1, sub = sc & 1; return n == 0 ? ((sub == 0 && t >= 16) ? TX + t - 16 : -1) : 64 * (n - 1) + 32 * sub + t; }
constexpr size_t RW_BASE = WS_PROJ + 92 * MiB;
constexpr size_t RW_RH = RW_BASE, RW_RL = RW_BASE + 33 * MiB, RW_GT = RW_BASE + 66 * MiB, RW_GAM = RW_BASE + 99 * MiB;
constexpr size_t RW_PR = WS_SCR + 195 * MiB, RW_AT = WS_SCR + 211 * MiB + 256 * 1024, RW_VTF = WS_SCR + 219 * MiB + 512 * 1024, RW_SALL = WS_SCR + 235 * MiB + 768 * 1024;
constexpr size_t RW_XSAVE = 1 * MiB + 640 * 1024;
constexpr size_t RW_VV = WS_YMIX + 34 * MiB, RW_BON = WS_YMIX + 52 * MiB, LR_H = WS_YMIX + 54 * MiB, LR_A = WS_YMIX + 56 * MiB, LR_C = WS_YMIX + 58 * MiB;
constexpr size_t RW_SCH = (size_t)RW_NSC * 16;
static_assert((size_t)MP * EV_NP * 2 <= 92 * MiB && RW_SCH * 8192 <= 33 * MiB && RW_GAM + RW_SCH * 256 <= WS_SCR, "rwkv map (proj region)");
static_assert(WS_SCR + SC_LIX + (size_t)MP * 4096 <= RW_PR && RW_PR + RW_SCH * 4096 <= RW_AT && RW_AT + RW_SCH * 2048 <= RW_VTF && RW_VTF + RW_SCH * 4096 <= RW_SALL && RW_SALL + RW_SCH * 8192 <= WS_END, "rwkv map (scratch region)");
static_assert((size_t)MP * DM * 2 <= 34 * MiB && RW_VV + (size_t)MP * 2048 <= RW_BON && RW_BON + (size_t)MP * 64 <= LR_H && LR_H + RW_SCH * 256 <= LR_A && LR_A + RW_SCH * 256 <= LR_C && LR_C + RW_SCH * 256 <= WS_PROJ, "rwkv map (ymix region)");

DI void sub_rows(int sc, int& t0, int& rbase) { if (sc >= 2) { t0 = 0; rbase = 64 * ((sc >> 1) - 1) + 32 * (sc & 1); } else if (sc == 0) { t0 = 16; rbase = TX - 16; } else { t0 = 32; rbase = 0; } }
DI void lru_local(const Frame& F, const Args& a, int gw, int ngw) {
    const bf16* LA = (const bf16*)(a.ws + WS_SCR + SC_LA); const bf16* LIX = (const bf16*)(a.ws + WS_SCR + SC_LIX);
    float* HL = (float*)(a.ws + LR_H); float* AP = (float*)(a.ws + LR_A);
    for (int item = gw; item < RW_NSC * 16; item += ngw) { const int sc = item >> 4, c = (item & 15) * 64 + F.lane; int t0, rbase; sub_rows(sc, t0, rbase);
        float av[32], ix[32];
#pragma unroll
        for (int t = 0; t < 32; ++t) { const size_t o = (size_t)(rbase + (t >= t0 ? t : 32)) * 1024 + c; av[t] = bf2f(LA[o]); ix[t] = bf2f(LIX[o]); }
        float h = 0.f, p = 1.f;
#pragma unroll
        for (int t = 0; t < 32; ++t) { const float om = t >= t0 ? av[t] : 0.f, x_ = t >= t0 ? ix[t] : 0.f, a_ = 1.0f - om; h = a_ * h + sqrtf(om * (1.0f + a_)) * x_; p *= a_; }
        HL[sc * 1024 + c] = h; AP[sc * 1024 + c] = p; }
}
DI void lru_apply(const Frame& F, const Args& a, int gw, int ngw) {
    const bf16* P = (const bf16*)(a.ws + WS_PROJ); const bf16* LA = (const bf16*)(a.ws + WS_SCR + SC_LA); const bf16* LIX = (const bf16*)(a.ws + WS_SCR + SC_LIX);
    const float* CR = (const float*)(a.ws + LR_C); bf16* Y = (bf16*)(a.ws + WS_YMIX);
    for (int item = gw; item < RW_NSC * 16; item += ngw) { const int sc = item >> 4, c = (item & 15) * 64 + F.lane; int t0, rbase; sub_rows(sc, t0, rbase); if (t0 >= 32) continue;
        float h = CR[sc * 1024 + c];
#pragma unroll
        for (int tb = 0; tb < 32; tb += 16) { float av[16], ix[16], gb[16];
#pragma unroll
            for (int t = 0; t < 16; ++t) { const size_t r_ = (size_t)(rbase + (tb + t >= t0 ? tb + t : 32)); av[t] = bf2f(LA[r_ * 1024 + c]); ix[t] = bf2f(LIX[r_ * 1024 + c]); gb[t] = bf2f(P[r_ * EV_NP + EV_GB + c]); }
#pragma unroll
            for (int t = 0; t < 16; ++t) { if (tb + t >= t0) { const float a_ = 1.0f - av[t]; h = a_ * h + sqrtf(av[t] * (1.0f + a_)) * ix[t]; Y[(size_t)(rbase + tb + t) * DM + 1024 + c] = (bf16)f2bf(h * gelu_tanh(gb[t])); } } } }
}

DI void ph_rwkv_chunk(const Frame& F, const Args& a, int n_lo, int n_hi, int wg0) {
    if (F.vcu < wg0) return;
    const bf16* P = (const bf16*)(a.ws + WS_PROJ); const bf16* DEC = (const bf16*)(a.ws + WS_SCR + SC_DEC); const bf16* ICL = (const bf16*)(a.ws + WS_SCR + SC_ICL);
    bf16* RH = (bf16*)(a.ws + RW_RH); bf16* RL = (bf16*)(a.ws + RW_RL); bf16* GT = (bf16*)(a.ws + RW_GT); float* GAM = (float*)(a.ws + RW_GAM); bf16* PR = (bf16*)(a.ws + RW_PR); bf16* ATG = (bf16*)(a.ws + RW_AT); bf16* VTF = (bf16*)(a.ws + RW_VTF);
    bf16* VV = (bf16*)(a.ws + RW_VV); float* BON = (float*)(a.ws + RW_BON);
    LAS unsigned char* L = F.lds + RING_OFF;
    LAS float* wS = (LAS float*)L; LAS float* aS = wS + 4096; LAS float* bS = wS + 8192; LAS float* rS = wS + 12288; LAS float* kS = wS + 16384;
    LAS unsigned char* vT = L + 81920; LAS unsigned char* aT = L + 91136; LAS unsigned char* rT = L + 100352; LAS unsigned char* kT = L + 109568; LAS unsigned char* bT = L + 118784;
    LAS unsigned char* AT = L + 128000; LAS unsigned char* NT = L + 133120; LAS float* gam = (LAS float*)(L + 138240);
    LAS unsigned char* aTl = L; LAS unsigned char* bTl = L + 9216;
    const int tid = F.tid, lane = F.lane, wave = F.wave, l31 = lane & 31, h = lane >> 5;
    const float* mu = a.in[6];
    for (int unit = n_lo * 16 + (F.vcu - wg0); unit < n_hi * 16; unit += F.G - wg0) {
        const int n = unit >> 4, hd = unit & 15;
#ifdef R1_REP_A
        _Pragma("unroll 1") for (int rep_ = 0; rep_ < 2; ++rep_)
#endif
        { const int tok = tid >> 3, cg = tid & 7, c0 = hd * 64 + cg * 8; const int rr = sub_row(2 * n + (tok >> 5), tok & 31);
          float wv[8], av[8], bv[8], rv[8], kv[8], vv[8];
#pragma unroll
          for (int q = 0; q < 8; ++q) { wv[q] = 0.f; av[q] = 0.f; bv[q] = 0.f; rv[q] = 0.f; kv[q] = 0.f; vv[q] = 0.f; }
          if (rr >= 0) { const int pos = row_pos(rr); const bf16* cur = P + (size_t)rr * EV_NP + c0; const bf16* prv = pos > 0 ? P + (size_t)pos_row(pos - 1) * EV_NP + c0 : nullptr;
              const v4u z4 = (v4u){0u, 0u, 0u, 0u};
              const v4u cr = *(const v4u*)cur, ck = *(const v4u*)(cur + 1024), cv = *(const v4u*)(cur + 2048);
              const v4u qr = prv ? *(const v4u*)prv : z4, qk = prv ? *(const v4u*)(prv + 1024) : z4, qv = prv ? *(const v4u*)(prv + 2048) : z4;
              const unsigned crw[4] = {cr.x, cr.y, cr.z, cr.w}, ckw[4] = {ck.x, ck.y, ck.z, ck.w}, cvw[4] = {cv.x, cv.y, cv.z, cv.w}, qrw[4] = {qr.x, qr.y, qr.z, qr.w}, qkw[4] = {qk.x, qk.y, qk.z, qk.w}, qvw[4] = {qv.x, qv.y, qv.z, qv.w};
              float ss = 0.f, bon = 0.f; float kk[8], ic[8];
#pragma unroll
              for (int q = 0; q < 8; ++q) { const int c = c0 + q; const float crf = (q & 1) ? bfhi(crw[q >> 1]) : bflo(crw[q >> 1]), ckf = (q & 1) ? bfhi(ckw[q >> 1]) : bflo(ckw[q >> 1]), cvf = (q & 1) ? bfhi(cvw[q >> 1]) : bflo(cvw[q >> 1]);
                  const float prf = (q & 1) ? bfhi(qrw[q >> 1]) : bflo(qrw[q >> 1]), pkf = (q & 1) ? bfhi(qkw[q >> 1]) : bflo(qkw[q >> 1]), pvf = (q & 1) ? bfhi(qvw[q >> 1]) : bflo(qvw[q >> 1]);
                  rv[q] = crf + (prf - crf) * mu[c]; kk[q] = ckf + (pkf - ckf) * mu[1024 + c]; vv[q] = cvf + (pvf - cvf) * mu[2048 + c];
                  wv[q] = -bf2f(DEC[(size_t)rr * 1024 + c])  ; ic[q] = bf2f(ICL[(size_t)rr * 1024 + c]);
                  const float kkv = kk[q] * a.in[12][c]; av[q] = kkv; ss += kkv * kkv; kv[q] = kk[q] * (1.0f + (ic[q] - 1.0f) * a.in[13][c]); bon += rv[q] * kv[q] * a.in[14][c]; }
              ss += __shfl_xor(ss, 1); ss += __shfl_xor(ss, 2); ss += __shfl_xor(ss, 4); bon += __shfl_xor(bon, 1); bon += __shfl_xor(bon, 2); bon += __shfl_xor(bon, 4);
              const float inv = 1.0f / fmaxf(sqrtf(ss), 1e-12f);
#pragma unroll
              for (int q = 0; q < 8; ++q) { const float kkn = av[q] * inv; av[q] = -kkn; bv[q] = kkn * ic[q]; }
              if (cg == 0) BON[(size_t)rr * 16 + hd] = bon;
              *(v4u*)(VV + (size_t)rr * 1024 + c0) = (v4u){pk2(vv[0], vv[1]), pk2(vv[2], vv[3]), pk2(vv[4], vv[5]), pk2(vv[6], vv[7])}; }
          const int o = tok * 64 + cg * 8;
          *(LAS f32x4*)(wS + o) = (f32x4){wv[0], wv[1], wv[2], wv[3]}; *(LAS f32x4*)(wS + o + 4) = (f32x4){wv[4], wv[5], wv[6], wv[7]};
          *(LAS f32x4*)(aS + o) = (f32x4){av[0], av[1], av[2], av[3]}; *(LAS f32x4*)(aS + o + 4) = (f32x4){av[4], av[5], av[6], av[7]};
          *(LAS f32x4*)(bS + o) = (f32x4){bv[0], bv[1], bv[2], bv[3]}; *(LAS f32x4*)(bS + o + 4) = (f32x4){bv[4], bv[5], bv[6], bv[7]};
          *(LAS f32x4*)(rS + o) = (f32x4){rv[0], rv[1], rv[2], rv[3]}; *(LAS f32x4*)(rS + o + 4) = (f32x4){rv[4], rv[5], rv[6], rv[7]};
          *(LAS f32x4*)(kS + o) = (f32x4){kv[0], kv[1], kv[2], kv[3]}; *(LAS f32x4*)(kS + o + 4) = (f32x4){kv[4], kv[5], kv[6], kv[7]};
#pragma unroll
          for (int q = 0; q < 8; ++q) *(LAS bf16*)(vT + (cg * 8 + q) * 144 + tok * 2) = (bf16)f2bf(vv[q]); }
        __syncthreads();
        { typedef float f32x2 __attribute__((ext_vector_type(2)));
          const int sub = wave >> 2, blk = sub ? 3 - (wave & 3) : (wave & 3), tkn = lane >> 3, e = lane & 7, s = 8 * blk + tkn, tok = 32 * sub + s, j8 = 8 * e;
          f32x2 xk[4], xb[4];
          { const f32x4 t0 = *(const LAS f32x4*)(kS + tok * 64 + j8), t1 = *(const LAS f32x4*)(kS + tok * 64 + j8 + 4), u0 = *(const LAS f32x4*)(bS + tok * 64 + j8), u1 = *(const LAS f32x4*)(bS + tok * 64 + j8 + 4);
            xk[0] = (f32x2){t0.x, t0.y}; xk[1] = (f32x2){t0.z, t0.w}; xk[2] = (f32x2){t1.x, t1.y}; xk[3] = (f32x2){t1.z, t1.w};
            xb[0] = (f32x2){u0.x, u0.y}; xb[1] = (f32x2){u0.z, u0.w}; xb[2] = (f32x2){u1.x, u1.y}; xb[3] = (f32x2){u1.z, u1.w}; }
          for (int i = e; i < 8 * blk; i += 8) { *(LAS bf16*)(AT + ((sub * 32 + i) * 40 + s) * 2) = (bf16)0; *(LAS bf16*)(NT + ((sub * 32 + i) * 40 + s) * 2) = (bf16)0; }
#define RW_RED8(v) do { v += __builtin_bit_cast(float, __builtin_amdgcn_mov_dpp(__builtin_bit_cast(int, v), 0xB1, 0xF, 0xF, true)); v += __builtin_bit_cast(float, __builtin_amdgcn_mov_dpp(__builtin_bit_cast(int, v), 0x4E, 0xF, 0xF, true)); \
              v += __builtin_bit_cast(float, __builtin_amdgcn_mov_dpp(__builtin_bit_cast(int, v), 0x141, 0xF, 0xF, true)); } while (0)
#define RW_PASS(X_, OUTP) do { f32x2 c2 = X_[0] * a2[0]; c2 = X_[1] * a2[1] + c2; c2 = X_[2] * a2[2] + c2; c2 = X_[3] * a2[3] + c2; float c = c2.x + c2.y; RW_RED8(c); \
              const float cm = c * m; const f32x2 cm2 = (f32x2){cm, cm}; \
              _Pragma("unroll") for (int i = 0; i < 4; ++i) X_[i] = X_[i] * mw[i] + (cm2 * b2[i] + X_[i]); \
              f32x2 o2 = X_[0] * r2[0]; o2 = X_[1] * r2[1] + o2; o2 = X_[2] * r2[2] + o2; o2 = X_[3] * r2[3] + o2; float o = o2.x + o2.y; RW_RED8(o); \
              *(LAS bf16*)(OUTP + ((sub * 32 + tp) * 40 + s) * 2) = (bf16)f2bf(o * mge); } while (0)
          const LAS float* bp = wS + (32 * sub + 8 * blk) * 64 + j8;
#define RW_LOAD(P_, p_) do { P_[0] = *(const LAS f32x4*)(p_); P_[1] = *(const LAS f32x4*)((p_) + 4); P_[2] = *(const LAS f32x4*)((p_) + 4096); P_[3] = *(const LAS f32x4*)((p_) + 4100); \
              P_[4] = *(const LAS f32x4*)((p_) + 8192); P_[5] = *(const LAS f32x4*)((p_) + 8196); P_[6] = *(const LAS f32x4*)((p_) + 12288); P_[7] = *(const LAS f32x4*)((p_) + 12292); } while (0)
#define RW_STEP(P_, tp_) do { const int tp = (tp_); const float m = tp > s ? 1.f : 0.f, mge = tp >= s ? 1.f : 0.f; const f32x2 m2 = (f32x2){m, m}; \
              const f32x2 a2[4] = {(f32x2){P_[2].x, P_[2].y}, (f32x2){P_[2].z, P_[2].w}, (f32x2){P_[3].x, P_[3].y}, (f32x2){P_[3].z, P_[3].w}}, b2[4] = {(f32x2){P_[4].x, P_[4].y}, (f32x2){P_[4].z, P_[4].w}, (f32x2){P_[5].x, P_[5].y}, (f32x2){P_[5].z, P_[5].w}}; \
              const f32x2 r2[4] = {(f32x2){P_[6].x, P_[6].y}, (f32x2){P_[6].z, P_[6].w}, (f32x2){P_[7].x, P_[7].y}, (f32x2){P_[7].z, P_[7].w}}; \
              const f32x2 mw[4] = {m2 * (f32x2){P_[0].x, P_[0].y}, m2 * (f32x2){P_[0].z, P_[0].w}, m2 * (f32x2){P_[1].x, P_[1].y}, m2 * (f32x2){P_[1].z, P_[1].w}}; \
              RW_PASS(xk, AT); RW_PASS(xb, NT); } while (0)
          f32x4 PA[8], PB[8]; RW_LOAD(PA, bp);
          for (int t2 = 8 * blk; t2 < 32; t2 += 2, bp += 128) { RW_LOAD(PB, bp + 64); __builtin_amdgcn_sched_barrier(0); RW_STEP(PA, t2); RW_LOAD(PA, bp + 128); __builtin_amdgcn_sched_barrier(0); RW_STEP(PB, t2 + 1); }
#undef RW_STEP
#undef RW_LOAD
#undef RW_PASS
#undef RW_RED8
#pragma unroll
          for (int i = 0; i < 4; ++i) { *(LAS bf16*)(kT + (j8 + 2 * i) * 144 + tok * 2) = (bf16)f2bf(xk[i].x); *(LAS bf16*)(kT + (j8 + 2 * i + 1) * 144 + tok * 2) = (bf16)f2bf(xk[i].y);
              *(LAS bf16*)(bT + (j8 + 2 * i) * 144 + tok * 2) = (bf16)f2bf(xb[i].x); *(LAS bf16*)(bT + (j8 + 2 * i + 1) * 144 + tok * 2) = (bf16)f2bf(xb[i].y); }
          const bool gwave = (blk == 3); const int j = lane;
          if (gwave) { float g = 1.f;
#pragma unroll
              for (int tp = 0; tp < 32; ++tp) { const int tk = 32 * sub + tp; const float w_ = 1.0f + wS[tk * 64 + j], a_ = aS[tk * 64 + j], r_ = rS[tk * 64 + j];
                  *(LAS bf16*)(aT + j * 144 + tk * 2) = (bf16)f2bf(a_ * g);
                  g *= w_; *(LAS bf16*)(rT + tk * 144 + j * 2) = (bf16)f2bf(r_ * g); }
              gam[sub * 64 + j] = g; }
        }
        __syncthreads();
#ifdef R1_REP_C
        _Pragma("unroll 1") for (int rep_ = 0; rep_ < 2; ++rep_) {
#endif
        { const int sub = wave >> 2, t1 = (wave >> 1) & 1, t0 = wave & 1; const size_t sch = (size_t)hd * RW_NSC + (2 * n + sub);
          { f32x16 acc;
#pragma unroll
            for (int r = 0; r < 16; ++r) acc[r] = 0.f;
#pragma unroll
            for (int ks = 0; ks < 2; ++ks) { const int ao = (32 * t1 + l31) * 144 + (32 * sub + 16 * ks + 8 * h) * 2, bo = (32 * t0 + l31) * 144 + (32 * sub + 16 * ks + 8 * h) * 2;
                acc = MFMA32(*(const LAS bf16x8*)(aT + ao), *(const LAS bf16x8*)(bT + bo), acc); }
            const int jp = 32 * t0 + l31;
#pragma unroll
            for (int g = 0; g < 4; ++g) *(v2u*)(RH + (sch * 64 + jp) * 64 + 32 * t1 + 8 * g + 4 * h) = (v2u){pk2(acc[4 * g], acc[4 * g + 1]), pk2(acc[4 * g + 2], acc[4 * g + 3])};
            if (t1 == 0 && t0 == 0) GAM[sch * 64 + lane] = gam[sub * 64 + lane]; }
          { f32x16 acc;
#pragma unroll
            for (int r = 0; r < 16; ++r) acc[r] = 0.f;
#pragma unroll
            for (int ks = 0; ks < 2; ++ks) acc = MFMA32(*(const LAS bf16x8*)(kT + (32 * t1 + l31) * 144 + (32 * sub + 16 * ks + 8 * h) * 2), *(const LAS bf16x8*)(vT + (32 * t0 + l31) * 144 + (32 * sub + 16 * ks + 8 * h) * 2), acc);
            bf16* dst = GT + ((sch * 4 + t1 * 2 + t0) * 64 + lane) * 16;
            *(v4u*)dst = (v4u){pk2(acc[0], acc[1]), pk2(acc[2], acc[3]), pk2(acc[4], acc[5]), pk2(acc[6], acc[7])}; *(v4u*)(dst + 8) = (v4u){pk2(acc[8], acc[9]), pk2(acc[10], acc[11]), pk2(acc[12], acc[13]), pk2(acc[14], acc[15])}; } }
        if (wave < 4) { const int sub = wave >> 1, jt = wave & 1; const size_t sch = (size_t)hd * RW_NSC + (2 * n + sub);
            f32x16 acc;
#pragma unroll
            for (int g = 0; g < 4; ++g) { const v2u rw = *(const LAS v2u*)(rT + (32 * sub + l31) * 144 + (32 * jt + 8 * g + 4 * h) * 2); acc[4 * g] = bflo(rw.x); acc[4 * g + 1] = bfhi(rw.x); acc[4 * g + 2] = bflo(rw.y); acc[4 * g + 3] = bfhi(rw.y); }
#pragma unroll
            for (int ks = 0; ks < 2; ++ks) acc = MFMA32(*(const LAS bf16x8*)(aT + (32 * jt + l31) * 144 + (32 * sub + 16 * ks + 8 * h) * 2), *(const LAS bf16x8*)(NT + (sub * 32 + l31) * 80 + (16 * ks + 8 * h) * 2), acc);
#pragma unroll
            for (int g = 0; g < 4; ++g) *(v2u*)(PR + (sch * 32 + l31) * 64 + 32 * jt + 8 * g + 4 * h) = (v2u){pk2(acc[4 * g], acc[4 * g + 1]), pk2(acc[4 * g + 2], acc[4 * g + 3])};
        } else { const int t2 = tid - 256, sub = t2 >> 7, t = (t2 >> 2) & 31, s8 = (t2 & 3) * 8; const size_t sch = (size_t)hd * RW_NSC + (2 * n + sub);
            *(v4u*)(ATG + (sch * 32 + t) * 32 + s8) = *(const LAS v4u*)(AT + (sub * 32 + t) * 80 + s8 * 2); }
        { const int sub = tid >> 8, it = (tid >> 7) & 1, ks = (tid >> 6) & 1; const size_t sch = (size_t)hd * RW_NSC + (2 * n + sub);
          *(v4u*)(VTF + ((sch * 4 + it * 2 + ks) * 64 + lane) * 8) = *(const LAS v4u*)(vT + (32 * it + l31) * 144 + (32 * sub + 16 * ks + 8 * h) * 2); }
#ifdef R1_REP_C
        }
#endif
        __syncthreads();
    }
}

DI void ph_rwkv_chain(const Frame& F, const Args& a, int sc_lo, int sc_hi) {
    if (F.vcu >= 16 && F.vcu < 32) {
        if (sc_hi < RW_NSC) return;
        constexpr int GS = 33; static_assert(8 * GS >= RW_NSC, "carry groups");
        const int g = F.tid >> 6, c = (F.vcu - 16) * 64 + F.lane; const float* HL = (const float*)(a.ws + LR_H); const float* AP = (const float*)(a.ws + LR_A); float* CR = (float*)(a.ws + LR_C);
        float hl[GS], ap[GS];
#pragma unroll
        for (int i = 0; i < GS; ++i) { const int sc = g * GS + i, scc = sc < RW_NSC ? sc : RW_NSC - 1; hl[i] = HL[scc * 1024 + c]; ap[i] = AP[scc * 1024 + c]; }
        float A = 1.f, H = 0.f;
#pragma unroll
        for (int i = 0; i < GS; ++i) if (g * GS + i < RW_NSC) { H = ap[i] * H + hl[i]; A *= ap[i]; }
        LAS float* cs = (LAS float*)(F.lds + RING_OFF);
        cs[(g * 64 + F.lane) * 2] = A; cs[(g * 64 + F.lane) * 2 + 1] = H;
        __syncthreads();
        float carry = 0.f;
        for (int q = 0; q < g; ++q) carry = cs[(q * 64 + F.lane) * 2] * carry + cs[(q * 64 + F.lane) * 2 + 1];
#pragma unroll
        for (int i = 0; i < GS; ++i) { const int sc = g * GS + i; if (sc < RW_NSC) { CR[sc * 1024 + c] = carry; carry = ap[i] * carry + hl[i]; } }
        return; }
    if (F.vcu >= 16) return;
    const int hd = F.vcu; const bf16* RH = (const bf16*)(a.ws + RW_RH); const bf16* RL = (const bf16*)(a.ws + RW_RL); const bf16* GT = (const bf16*)(a.ws + RW_GT); const float* GAM = (const float*)(a.ws + RW_GAM); bf16* SALL = (bf16*)(a.ws + RW_SALL);
    constexpr int RW_NS = 7, SLOT = 8192 + 8192 + 1024;
    LAS unsigned char* XS = F.lds + RING_OFF; LAS unsigned char* RG = XS + 2 * 9216;
    const int lane = F.lane, wave = F.wave, l31 = lane & 31, h = lane >> 5, jt = (wave >> 1) & 1, it = wave & 1, lw = wave & 3;
    for (int i = F.tid; i < 2 * 9216 / 4; i += NWAVES * 64) ((LAS unsigned*)XS)[i] = 0u;
    __syncthreads();
#define RW_BAR() do { asm volatile("s_waitcnt lgkmcnt(0)" ::: "memory"); __builtin_amdgcn_s_barrier(); asm volatile("" ::: "memory"); } while (0)
    const unsigned rg0 = (unsigned)(uintptr_t)RG;
    int offR[4], offG[4]; const int lw2 = wave & 1;
#pragma unroll
    for (int i = 0; i < 4; ++i) { const int b = 4 * lw2 + i, row = 8 * b + (lane >> 3), pc = lane & 7; offR[i] = row * 64 + ((pc ^ (row & 7)) * 8); offG[i] = (b * 64 + lane) * 8; }
    const int offM = (lane & 15) * 4;
#define RW_DMA(src, dst) do { unsigned keep_; asm volatile("s_mov_b32 %0, m0\n\ts_mov_b32 m0, %2\n\ts_nop 0\n\tglobal_load_lds_dwordx4 %1, off\n\ts_mov_b32 m0, %0" : "=&s"(keep_) : "v"(src), "s"(dst) : "memory"); } while (0)
#define RW_ISSUE(scn) do { const int s_ = (scn) < RW_NSC ? (scn) : RW_NSC - 1; const size_t sch_ = (size_t)hd * RW_NSC + s_; \
        const unsigned sb_ = (unsigned)__builtin_amdgcn_readfirstlane((int)(rg0 + (unsigned)((scn) % RW_NS) * SLOT)); \
        _Pragma("unroll") for (int i_ = 0; i_ < 4; ++i_) { const unsigned bo_ = (unsigned)__builtin_amdgcn_readfirstlane((4 * lw2 + i_) * 1024); \
            RW_DMA(RH + sch_ * 4096 + offR[i_], sb_ + bo_); RW_DMA(GT + sch_ * 4096 + offG[i_], sb_ + 8192 + bo_); } \
        RW_DMA(GAM + sch_ * 64 + offM, sb_ + 16384); } while (0)
#define RW_WAITV(n) asm volatile("s_waitcnt vmcnt(" #n ")" ::: "memory")
    f32x16 X;
#pragma unroll
    for (int r = 0; r < 16; ++r) X[r] = 0.f;
    float* XSV = (float*)(a.ws + RW_XSAVE) + ((size_t)(hd * 4 + (wave & 3)) * 64 + lane) * 16;
    if (wave < 4 && sc_lo > 0) {
#pragma unroll
        for (int g = 0; g < 4; ++g) { const f32x4 v = *(const f32x4*)(XSV + 4 * g); X[4 * g] = v.x; X[4 * g + 1] = v.y; X[4 * g + 2] = v.z; X[4 * g + 3] = v.w;
            *(LAS v2u*)(XS + (32 * it + l31) * 144 + (32 * jt + 8 * g + 4 * h) * 2) = (v2u){pk2(v.x, v.y), pk2(v.z, v.w)}; } }
    if (wave == 4 || wave == 5) { RW_ISSUE(sc_lo); RW_ISSUE(sc_lo + 1); RW_ISSUE(sc_lo + 2); RW_ISSUE(sc_lo + 3); RW_ISSUE(sc_lo + 4); RW_ISSUE(sc_lo + 5); RW_WAITV(45); }
    RW_BAR();
    for (int sc = sc_lo; sc < sc_hi; ++sc) {
        if (wave < 4) {
            const LAS unsigned char* sb = RG + (sc % RW_NS) * SLOT;
            f32x16 acc; const size_t sch = (size_t)hd * RW_NSC + sc;
            { const v4u g0 = *(const LAS v4u*)(sb + 8192 + ((jt * 2 + it) * 64 + lane) * 32), g1 = *(const LAS v4u*)(sb + 8192 + ((jt * 2 + it) * 64 + lane) * 32 + 16);
              const unsigned gw_[8] = {g0.x, g0.y, g0.z, g0.w, g1.x, g1.y, g1.z, g1.w};
#pragma unroll
              for (int g = 0; g < 4; ++g) { const f32x4 m = *(const LAS f32x4*)(sb + 16384 + (32 * jt + 8 * g + 4 * h) * 4);
                  acc[4 * g] = bflo(gw_[2 * g]) + m.x * X[4 * g]; acc[4 * g + 1] = bfhi(gw_[2 * g]) + m.y * X[4 * g + 1]; acc[4 * g + 2] = bflo(gw_[2 * g + 1]) + m.z * X[4 * g + 2]; acc[4 * g + 3] = bfhi(gw_[2 * g + 1]) + m.w * X[4 * g + 3]; } }
            const LAS unsigned char* xb = XS + (sc & 1) * 9216 + (32 * it + l31) * 144 + 16 * h; const int ar = 32 * jt + l31; const LAS unsigned char* ab = sb + ar * 128;
#pragma unroll
            for (int ks = 0; ks < 4; ++ks) { const bf16x8 xf = *(const LAS bf16x8*)(xb + 32 * ks); const int po = (((2 * ks + h) ^ (ar & 7)) * 16);
                acc = MFMA32(*(const LAS bf16x8*)(ab + po), xf, acc); }
            X = acc;
            LAS unsigned char* xn = XS + ((sc + 1) & 1) * 9216 + (32 * it + l31) * 144;
#pragma unroll
            for (int g = 0; g < 4; ++g) *(LAS v2u*)(xn + (32 * jt + 8 * g + 4 * h) * 2) = (v2u){pk2(X[4 * g], X[4 * g + 1]), pk2(X[4 * g + 2], X[4 * g + 3])};
        } else if (wave < 6) {
            RW_ISSUE(sc + RW_NS - 1);
            RW_WAITV(45);
        } else {
            const LAS unsigned char* xi = XS + (sc & 1) * 9216; bf16* so = SALL + ((size_t)hd * RW_NSC + sc) * 4096;
#pragma unroll
            for (int q = 0; q < 4; ++q) { const int pc = (wave & 1) * 256 + 64 * q + lane, row = pc >> 3, ch = pc & 7; *(v4u*)(so + row * 64 + ch * 8) = *(const LAS v4u*)(xi + row * 144 + ch * 16); }
        }
        RW_BAR();
    }
    if (wave == 4 || wave == 5) RW_WAITV(0);
    else if (wave < 4 && sc_hi < RW_NSC) {
#pragma unroll
        for (int g = 0; g < 4; ++g) *(f32x4*)(XSV + 4 * g) = (f32x4){X[4 * g], X[4 * g + 1], X[4 * g + 2], X[4 * g + 3]}; }
#undef RW_ISSUE
#undef RW_DMA
#undef RW_WAITV
#undef RW_BAR
}

DI f32x4 ld_bf4(const bf16* p) { const v2u w = *(const v2u*)p; return (f32x4){bflo(w.x), bfhi(w.x), bflo(w.y), bfhi(w.y)}; }
struct R3Ops { bf16x8 s[2][4], p[4], v[2][2], t[2]; };
DI void r3_load(R3Ops& o, const Args& a, int item, int lane) {
    const bf16* SALL = (const bf16*)(a.ws + RW_SALL); const bf16* PR = (const bf16*)(a.ws + RW_PR); const bf16* ATG = (const bf16*)(a.ws + RW_AT); const bf16* VTF = (const bf16*)(a.ws + RW_VTF);
    const int l31 = lane & 31, h = lane >> 5, sc = item >> 4, hd = item & 15; const size_t sch = (size_t)hd * RW_NSC + sc;
#pragma unroll
    for (int ks = 0; ks < 4; ++ks) { o.p[ks] = *(const bf16x8*)(PR + (sch * 32 + l31) * 64 + 16 * ks + 8 * h);
#pragma unroll
        for (int it = 0; it < 2; ++it) o.s[it][ks] = *(const bf16x8*)(SALL + (sch * 64 + 32 * it + l31) * 64 + 16 * ks + 8 * h); }
#pragma unroll
    for (int ks = 0; ks < 2; ++ks) { o.t[ks] = *(const bf16x8*)(ATG + (sch * 32 + l31) * 32 + 16 * ks + 8 * h);
#pragma unroll
        for (int it = 0; it < 2; ++it) o.v[it][ks] = *(const bf16x8*)(VTF + ((sch * 4 + it * 2 + ks) * 64 + lane) * 8); }
}
DI void r3_compute(const R3Ops& o, const Args& a, int item, int lane) {
    const bf16* VV = (const bf16*)(a.ws + RW_VV); const float* BON = (const float*)(a.ws + RW_BON); const bf16* GATE = (const bf16*)(a.ws + WS_SCR + SC_GATE); bf16* Y = (bf16*)(a.ws + WS_YMIX);
    const int l31 = lane & 31, h = lane >> 5, sc = item >> 4, hd = item & 15; f32x16 acc[2];
#pragma unroll
    for (int it = 0; it < 2; ++it) {
#pragma unroll
        for (int r = 0; r < 16; ++r) acc[it][r] = 0.f;
#pragma unroll
        for (int ks = 0; ks < 4; ++ks) acc[it] = MFMA32(o.s[it][ks], o.p[ks], acc[it]);
#pragma unroll
        for (int ks = 0; ks < 2; ++ks) acc[it] = MFMA32(o.v[it][ks], o.t[ks], acc[it]); }
    float s1 = 0.f;
#pragma unroll
    for (int it = 0; it < 2; ++it)
#pragma unroll
        for (int r = 0; r < 16; ++r) s1 += acc[it][r];
    s1 += __shfl_xor(s1, 32); const float mean = s1 * (1.0f / 64.0f); float s2 = 0.f;
#pragma unroll
    for (int it = 0; it < 2; ++it)
#pragma unroll
        for (int r = 0; r < 16; ++r) { const float d = acc[it][r] - mean; s2 += d * d; }
    s2 += __shfl_xor(s2, 32); const float rstd = 1.0f / sqrtf(s2 * (1.0f / 64.0f) + 64e-5f);
    const int rr = sub_row(sc, l31);
    if (rr >= 0) { const float bon = BON[(size_t)rr * 16 + hd];
#pragma unroll
        for (int it = 0; it < 2; ++it)
#pragma unroll
            for (int g = 0; g < 4; ++g) { const int c = hd * 64 + 32 * it + 8 * g + 4 * h;
                const f32x4 lw = *(const f32x4*)(a.in[15] + c), lb = *(const f32x4*)(a.in[16] + c), gt = ld_bf4(GATE + (size_t)rr * 1024 + c); const v2u vw = *(const v2u*)(VV + (size_t)rr * 1024 + c);
                const float o0 = ((acc[it][4 * g] - mean) * rstd * lw.x + lb.x + bon * bflo(vw.x)) * gt.x, o1 = ((acc[it][4 * g + 1] - mean) * rstd * lw.y + lb.y + bon * bfhi(vw.x)) * gt.y;
                const float o2 = ((acc[it][4 * g + 2] - mean) * rstd * lw.z + lb.z + bon * bflo(vw.y)) * gt.z, o3 = ((acc[it][4 * g + 3] - mean) * rstd * lw.w + lb.w + bon * bfhi(vw.y)) * gt.w;
                *(v2u*)(Y + (size_t)rr * DM + c) = (v2u){pk2(o0, o1), pk2(o2, o3)}; } }
}
DI void ph_rwkv_out(const Frame& F, const Args& a, int sc_lo, int sc_hi, int gw, int ngw) {
    const int i_hi = sc_hi * 16;
    for (int item = sc_lo * 16 + gw; item < i_hi; item += 2 * ngw) { const int itb = item + ngw; const bool ha = (item >> 4) != 1, hb = itb < i_hi && (itb >> 4) != 1;
        R3Ops A, B; if (ha) r3_load(A, a, item, F.lane); if (hb) r3_load(B, a, itb, F.lane);
        if (ha) r3_compute(A, a, item, F.lane); if (hb) r3_compute(B, a, itb, F.lane); }
}

constexpr int N_PHASES = 33;
template <class Epi, class Sched> DI void run_gemm(const Frame& F, const pg8::Gemm& g, const Sched& S, const Epi& E) {
    pg8::gemm_phase<Epi, Sched, true, true>(F.lds + RING_OFF, g, S, E);
}
DI void moe_up_units(const Frame& F, const Args& a, int t0, int ntl, int G, int c) {
    pg8::Gemm g{(const bf16*)(a.ws + WS_SCR + SC_XG), (const bf16*)(a.ws + WS_MOEW), DM, DM, DM};
    pg8::MoeOrder S{(const int*)(a.ws + WS_TILES), t0, ntl, 4, G, c, (long)MOE_E_BYTES};
    pg8::EpiSwiglu E{(bf16*)(a.ws + WS_SCR + SC_ACT), FF};
    run_gemm(F, g, S, E);
}
DI void moe_down_units(const Frame& F, const Args& a, int t0, int ntl, int G, int c) {
    pg8::Gemm g{(const bf16*)(a.ws + WS_SCR + SC_ACT), (const bf16*)(a.ws + WS_MOEW + MOE_W2_OFF), FF, FF, FF};
    pg8::MoeOrder S{(const int*)(a.ws + WS_TILES), t0, ntl, 8, G, c, (long)MOE_E_BYTES};
    pg8::EpiBf16 E{(bf16*)(a.ws + WS_SCR + SC_YB), DM};
    run_gemm(F, g, S, E);
}
DI void ph_moe(const Frame& F, const Args& a, int l) {
    const int nt = (int)__hip_atomic_load((gu32*)(a.ws + WS_TILES) + 127, RLX_AGENT); unsigned* cnt = (unsigned*)(F.ctl + CW_MOEDONE + l * 2048);
    int t0 = 0, ntl = nt, G = F.G, c = (int)blockIdx.x;
    if (F.G == 256) { const int x = F.vcu >> 5; t0 = (x * nt) >> 3; ntl = (((x + 1) * nt) >> 3) - t0; G = 32; c = F.vcu & 31; }
    { pg8::Gemm g{(const bf16*)(a.ws + WS_SCR + SC_XG), (const bf16*)(a.ws + WS_MOEW), DM, DM, DM};
      pg8::MoeUpOrder S{(const int*)(a.ws + WS_TILES), t0, ntl, G, c, (long)MOE_E_BYTES, cnt};
      pg8::EpiSwiglu E{(bf16*)(a.ws + WS_SCR + SC_ACT), FF};
      run_gemm(F, g, S, E);
    }
    { pg8::Gemm g{(const bf16*)(a.ws + WS_SCR + SC_ACT), (const bf16*)(a.ws + WS_MOEW + MOE_W2_OFF), FF, FF, FF};
      pg8::MoeDownOrder S{(const int*)(a.ws + WS_TILES), t0, ntl, G, c, (long)MOE_E_BYTES, cnt};
      pg8::EpiBf16 E{(bf16*)(a.ws + WS_SCR + SC_YB), DM};
      run_gemm(F, g, S, E);
    }
}
DI void ph_moe_a(const Frame& F, const Args& a) {
    const int nt = (int)__hip_atomic_load((gu32*)(a.ws + WS_TILES) + 127, RLX_AGENT), n1 = nt < 64 ? nt : 64;
    moe_up_units(F, a, 0, n1, F.G, (int)blockIdx.x);
}
DI void ph_moe_b(const Frame& F, const Args& a) {
    const int nt = (int)__hip_atomic_load((gu32*)(a.ws + WS_TILES) + 127, RLX_AGENT), n1 = nt < 64 ? nt : 64; const int c = (int)blockIdx.x;
    int nu = 4 * (nt - n1); if (nu > F.G / 2) nu = F.G / 2;
    if (c < nu) moe_up_units(F, a, n1, nt - n1, nu, c); else moe_down_units(F, a, 0, n1, F.G - nu, c - nu);
}
DI void ph_moe_c(const Frame& F, const Args& a) {
    const int nt = (int)__hip_atomic_load((gu32*)(a.ws + WS_TILES) + 127, RLX_AGENT), n1 = nt < 64 ? nt : 64;
    moe_down_units(F, a, n1, nt - n1, F.G, (int)blockIdx.x);
}

DI void gemm_tail16(const Frame& F, const Args& a, const bf16* A, int lda, const bf16* Wt, int K, int mode) {
    if (F.vcu >= 128) return;
    const int lane = F.lane, lc = lane & 15, quad = lane >> 4, w = F.vcu; LAS float* red = (LAS float*)(F.lds + RING_OFF);
    f32x4 acc = (f32x4){0.f, 0.f, 0.f, 0.f}; const int kw = K / NWAVES, kb = F.wave * kw;
    const bf16* ap = A + (size_t)(TX + lc) * lda + kb + 8 * quad; const bf16* bp = Wt + (size_t)(16 * w + lc) * K + kb + 8 * quad;
#pragma unroll 4
    for (int ks = 0; ks < kw / 32; ++ks) acc = __builtin_amdgcn_mfma_f32_16x16x32_bf16(*(const bf16x8*)(ap + 32 * ks), *(const bf16x8*)(bp + 32 * ks), acc, 0, 0, 0);
    *(LAS f32x4*)(red + (F.wave * 64 + lane) * 4) = acc;
    __syncthreads();
    if (F.wave == 0) { f32x4 s = *(const LAS f32x4*)(red + lane * 4);
#pragma unroll
        for (int v = 1; v < NWAVES; ++v) s = s + *(const LAS f32x4*)(red + (v * 64 + lane) * 4);
        float* H = (float*)(a.ws + WS_H);
#pragma unroll
        for (int r = 0; r < 4; ++r) { const int row = 4 * quad + r, col = 16 * w + lc; const float base = mode ? H[(size_t)(TX + row) * DM + col] : a.in[1][(size_t)row * DM + col];
            H[(size_t)(TX + row) * DM + col] = base + s[r]; } }
    __syncthreads();
}

__global__ void __launch_bounds__(NWAVES * 64, 2) hyb_fwd(Args a) {
    extern __shared__ __attribute__((aligned(16))) unsigned char lds[];
    Frame F;
    F.lds = (LAS unsigned char*)lds;
    F.MISC = (volatile LAS unsigned*)(F.lds + MISC_OFF);
    F.tid = threadIdx.x; F.lane = F.tid & 63; F.wave = __builtin_amdgcn_readfirstlane(F.tid >> 6);
    F.G = gridDim.x; { const int bx = blockIdx.x; F.vcu = (F.G % 8 == 0) ? (bx % 8) * (F.G / 8) + bx / 8 : bx; }
    F.gw = F.vcu * NWAVES + F.wave; F.NGW = F.G * NWAVES;
    F.ctl = (gu32*)(a.ws + WS_CTL);
    for (int u = F.tid; u < (LDS_BYTES - LDSCTL_OFF) / 4; u += NWAVES * 64) ((LAS unsigned*)(F.lds + LDSCTL_OFF))[u] = 0u;
    __syncthreads();
    XcdBarrier bar; bar.bar = (unsigned*)(F.ctl + CW_BAR); bar.x = 0; bar.st = nullptr;
    if (MK_ONE_LAUNCH) bar = xcd_barrier_post((unsigned*)(F.ctl + CW_BAR), F.MISC + 8);
    const int lo = a.ph_lo, hi = a.ph_hi;
#ifndef PH_MASK
#define PH_MASK 0xFFFFFFFFFFFFFFFFull
#endif
#define IN(k) ((((unsigned long long)(PH_MASK) >> (k)) & 1ull) && lo <= (k) && (k) < hi)
#ifndef PROBE_REP
#define PROBE_REP 0u
#endif
#define REP(k) ((((unsigned long long)(PROBE_REP) >> (k)) & 1ull) ? 2 : 1)
#ifdef PROBE_TS
#define STAMP(k) do { if (blockIdx.x == 0 && F.tid == 0) ((unsigned long long*)(F.ctl + CW_TS))[(k)] = __builtin_amdgcn_s_memrealtime(); } while (0)
#else
#define STAMP(k) do { } while (0)
#endif
#define PHASE(k, ...) do { if (IN(k)) { { const int PH_REP_ = 0; (void)PH_REP_; __VA_ARGS__; } if (REP(k) == 2) { __syncthreads(); { const int PH_REP_ = 1; (void)PH_REP_; __VA_ARGS__; } } } } while (0)
#define SEAM(k) do { if (IN(k) && IN((k) + 1)) xcd_barrier(bar); STAMP((k) + 1); } while (0)
    const bf16* HN = (const bf16*)(a.ws + WS_HN); bf16* PROJ = (bf16*)(a.ws + WS_PROJ); const bf16* YMIX = (const bf16*)(a.ws + WS_YMIX); float* H = (float*)(a.ws + WS_H);

    STAMP(0);
    PHASE(0, { ph_prologue(F, a); ph_aux_convert(F, a, F.gw, F.NGW); });
    SEAM(0);
    PHASE(1, { pg8::Gemm g{HN, (const bf16*)(a.ws + WS_WEVIN), DM, DM, DM}; pg8::StaticOrder S; S.init(MP, EV_NP, F.G, (int)blockIdx.x); pg8::EpiBf16 E{PROJ, EV_NP}; run_gemm(F, g, S, E); });
    SEAM(1);
    PHASE(2, ph_even_prep(F, a););
    SEAM(2);
    PHASE(3, {
        { pg8::Gemm g{(const bf16*)(a.ws + WS_SCR + SC_ALORA), (const bf16*)(a.ws + WS_WLORA), 384, 384, 384}; pg8::StaticOrder S; S.init(MP, 3072, F.G, (int)blockIdx.x);
          static_assert(SC_ICL - SC_DEC == SC_GATE - SC_ICL, "lora outputs equally spaced");
          pg8::EpiLora E{(bf16*)(a.ws + WS_SCR + SC_DEC), (long)((SC_ICL - SC_DEC) / 2), a.in[7], a.in[9]}; run_gemm(F, g, S, E); }
        { pg8::Gemm g{(const bf16*)(a.ws + WS_SCR + SC_XR), (const bf16*)(a.ws + WS_WGATE), 256, 1024, 256}; pg8::StaticOrder S;
          { constexpr int nl = ((MP / 256) * (3072 / 256)) % 256, sh = (nl + 7) & ~7; S.init(MP, 2048, F.G, F.G == 256 ? ((int)blockIdx.x - sh + 256) % 256 : (int)blockIdx.x); } S.amod = 4; S.astep = 512;
          pg8::EpiGates E{(bf16*)(a.ws + WS_SCR + SC_LA), (bf16*)(a.ws + WS_SCR + SC_LIX), a.in[20], a.in[22], a.in[23], (const bf16*)(a.ws + WS_SCR + SC_XR)}; run_gemm(F, g, S, E); }
    });
    SEAM(3);
    PHASE(4, ph_rwkv_chunk(F, a, 0, 64, 0););
    SEAM(4);
    PHASE(5, { if (F.vcu < 16) ph_rwkv_chain(F, a, 0, 128); else ph_rwkv_chunk(F, a, 64, 109, 16); });
    SEAM(5);
    PHASE(6, { if (F.vcu < 16) ph_rwkv_chain(F, a, 128, 218); else { ph_rwkv_chunk(F, a, 109, 129, 16); lru_local(F, a, (F.vcu - 16) * NWAVES + F.wave, (F.G - 16) * NWAVES); } });
    SEAM(6);
    PHASE(7, { if (F.vcu < 32) ph_rwkv_chain(F, a, 218, RW_NSC); else ph_rwkv_out(F, a, 0, 218, (F.vcu - 32) * NWAVES + F.wave, (F.G - 32) * NWAVES); });
    SEAM(7);
    PHASE(8, { constexpr int NR3 = (RW_NSC - 218) * 16; if (F.NGW > 2 * NR3) { if (F.gw < NR3) ph_rwkv_out(F, a, 218, RW_NSC, F.gw, NR3); else lru_apply(F, a, F.gw - NR3, F.NGW - NR3); }
               else { ph_rwkv_out(F, a, 218, RW_NSC, F.gw, F.NGW); lru_apply(F, a, F.gw, F.NGW); } });
    SEAM(8);
    PHASE(11, { pg8::Gemm g{YMIX, (const bf16*)(a.ws + WS_WEVOUT), DM, DM, DM}; pg8::StaticOrder S; S.init(TX, DM, F.G, (int)blockIdx.x); pg8::EpiResid E{H, a.in[0], a.in[1], 0}; run_gemm(F, g, S, E); gemm_tail16(F, a, YMIX, DM, (const bf16*)(a.ws + WS_WEVOUT), DM, 0); });
    SEAM(11);
    PHASE(12, ph_route(F, a, 0, PH_REP_););
    SEAM(12);
    PHASE(13, ph_gather(F, a, 0););
    SEAM(13);
    PHASE(14, ph_moe(F, a, 0););
    SEAM(16);
    PHASE(17, ph_combine(F, a, 0););
    SEAM(17);
    PHASE(18, { pg8::Gemm g{HN, (const bf16*)(a.ws + WS_WODIN), DM, DM, DM}; pg8::StaticOrder S; S.init(MP, F.G == 256 ? OD_N0 : OD_NP, F.G, (int)blockIdx.x); pg8::EpiBf16 E{PROJ, OD_NP}; run_gemm(F, g, S, E); });
    SEAM(18);
    PHASE(19, { constexpr int NZT = (MP / 256) * ((OD_NP - OD_N0) / 256);
        if (F.G == 256) { if (F.vcu < NZT) { pg8::Gemm g{HN, (const bf16*)(a.ws + WS_WODIN) + (size_t)OD_N0 * DM, DM, DM, DM}; pg8::StaticOrder S; S.init(MP, OD_NP - OD_N0, NZT, F.vcu); pg8::EpiBf16 E{PROJ + OD_N0, OD_NP}; run_gemm(F, g, S, E); }
                          ph_odd_prep(F, a, NZT); }
        else ph_odd_prep(F, a); });
    SEAM(19);
    PHASE(20, ph_gdn_chunk(F, a, 0, 54, 0););
    SEAM(20);
    PHASE(21, { ph_gdn_chain(F, a, 0, 54); ph_gdn_chunk(F, a, 54, 90, 1); });
    SEAM(21);
#if defined(PROBE_X) && PROBE_X == 3
    PHASE(22, { ph_gdn_chain(F, a, 54, 90); __syncthreads(); ph_gdn_chain(F, a, 54, 90); ph_gdn_chunk(F, a, 90, 114, 1); });
#elif defined(PROBE_X) && PROBE_X == 4
    PHASE(22, { ph_gdn_chain(F, a, 54, 90); ph_gdn_chunk(F, a, 90, 114, 1); __syncthreads(); ph_gdn_chunk(F, a, 90, 114, 1); });
#else
    PHASE(22, { ph_gdn_chain(F, a, 54, 90); ph_gdn_chunk(F, a, 90, 114, 1); });
#endif
    SEAM(22);
    PHASE(23, { ph_gdn_chain(F, a, 90, 114); ph_gdn_chunk(F, a, 114, 129, 1); });
    SEAM(23);
    PHASE(24, { ph_gdn_chain(F, a, 114, 129); ph_odd_post(F, a, 0); });
    SEAM(24);
    PHASE(25, { ph_odd_post(F, a, F.G == 256 ? 1 : 2); moe_convert(F, a, 1, F.gw, F.NGW); });
    SEAM(25);
    PHASE(26, { pg8::Gemm g{YMIX, (const bf16*)(a.ws + WS_WODOUT), 4096, 4096, 4096}; pg8::StaticOrder S; S.init(TX, DM, F.G, (int)blockIdx.x); pg8::EpiResid E{H, a.in[0], a.in[1], 1}; run_gemm(F, g, S, E); gemm_tail16(F, a, YMIX, 4096, (const bf16*)(a.ws + WS_WODOUT), 4096, 1); });
    SEAM(26);
    PHASE(27, ph_route(F, a, 1, PH_REP_););
    SEAM(27);
    PHASE(28, ph_gather(F, a, 1););
    SEAM(28);
    PHASE(29, ph_moe(F, a, 1););
    SEAM(31);
    PHASE(32, ph_combine(F, a, 1););
#ifdef PROBE_BARS
    for (int i_ = 0; i_ < PROBE_BARS; ++i_) xcd_barrier(bar);
#endif
#undef IN
#undef SEAM
}

extern "C" void kernel_launch(void* const* d_in, const int* in_sizes, int n_in, void* d_out, int out_size, void* d_ws, size_t ws_size, hipStream_t stream) {
    static int grid = 0;
    if (grid == 0) {
        if (n_in != 36 || out_size != TX * DM || ws_size < WS_END) { fprintf(stderr, "kernel_launch: unexpected shapes (n_in %d, out %d, ws %zu)\n", n_in, out_size, ws_size); grid = -1; return; }
        int dev = 0, cus = 0, per_cu = 0;
        if (hipGetDevice(&dev) != hipSuccess || hipDeviceGetAttribute(&cus, hipDeviceAttributeMultiprocessorCount, dev) != hipSuccess) { grid = -1; return; }
        if (hipFuncSetAttribute((const void*)hyb_fwd, hipFuncAttributeMaxDynamicSharedMemorySize, LDS_BYTES) != hipSuccess) { fprintf(stderr, "kernel_launch: hipFuncSetAttribute failed\n"); grid = -1; return; }
        if (hipOccupancyMaxActiveBlocksPerMultiprocessor(&per_cu, (const void*)hyb_fwd, NWAVES * 64, LDS_BYTES) != hipSuccess || per_cu < 1) { fprintf(stderr, "kernel_launch: occupancy query says %d\n", per_cu); per_cu = 1; }
        (void)hipGetLastError();
        grid = cus;
    }
    if (grid < 0) return;
    if (hipMemsetAsync((char*)d_ws + WS_CTL, 0, CTL_ZERO_BYTES, stream) != hipSuccess) return;
    Args a{};
    for (int i = 0; i < 36; ++i) a.in[i] = (const float*)d_in[i];
    a.out = (float*)d_out; a.ws = (unsigned char*)d_ws;
#if MK_ONE_LAUNCH
    a.ph_lo = 0; a.ph_hi = N_PHASES;
    hipLaunchKernelGGL(hyb_fwd, dim3(grid), dim3(NWAVES * 64), LDS_BYTES, stream, a);
#else
    for (int p = 0; p < N_PHASES; ++p) { a.ph_lo = p; a.ph_hi = p + 1; hipLaunchKernelGGL(hyb_fwd, dim3(grid), dim3(NWAVES * 64), LDS_BYTES, stream, a); }
#endif
}
```
